# Optimizing an MI355X kernel written in HIP

```python
import jax, jax.numpy as jnp
from jax import lax
import numpy as np

D_MODEL = 2048
BATCH = 8
SEQ = 2048
DEPTH = 1

MIX_WIDTH = D_MODEL
HGRN_WIDTH = MIX_WIDTH // 2
HGRN_DK = 128
HGRN_HEADS = HGRN_WIDTH // HGRN_DK
HGRN_DV = HGRN_WIDTH // HGRN_HEADS
HGRN_CHUNK = 64
MLA_WIDTH = MIX_WIDTH - HGRN_WIDTH
MLA_V_DIM = 128
MLA_HEADS = MLA_WIDTH // MLA_V_DIM
MLA_NOPE = 128
MLA_ROPE = 64
MLA_QK = MLA_NOPE + MLA_ROPE
Q_LORA = D_MODEL // 4
KV_LORA = D_MODEL // 8
ATTN_BLOCK = 128
ROPE_BASE = 10000.0
IN_COLS = 4 * HGRN_WIDTH + Q_LORA + KV_LORA + MLA_ROPE
N_GROUPS = 4
EXPERTS_PER_GROUP = 8
N_EXPERTS = N_GROUPS * EXPERTS_PER_GROUP
TOP_K_IN_GROUP = 2
D_EXPERT = D_MODEL // 4
MOE_BLOCK = 256
EPS = 1e-6

kernel_name = "hymba_hgrn2_mla_hmoe_adaln"


def _rmsnorm(x, g):
    xf = x.astype(jnp.float32)
    y = xf * lax.rsqrt(jnp.mean(xf * xf, axis=-1, keepdims=True) + EPS)
    return (y * g.astype(jnp.float32)).astype(x.dtype)


def _modulate(h, shift, scale):
    return h * (1 + scale[:, None, :]) + shift[:, None, :]


def _rope(x, positions):
    inv_freq = ROPE_BASE ** (-jnp.arange(0, MLA_ROPE, 2, dtype=jnp.float32) / MLA_ROPE)
    ang = positions.astype(jnp.float32)[..., None] * inv_freq
    cos = jnp.cos(ang)[:, :, None, :]
    sin = jnp.sin(ang)[:, :, None, :]
    xf = x.astype(jnp.float32)
    x1, x2 = xf[..., : MLA_ROPE // 2], xf[..., MLA_ROPE // 2:]
    out = jnp.concatenate([x1 * cos - x2 * sin, x2 * cos + x1 * sin], axis=-1)
    return out.astype(x.dtype)


def _hgrn2_chunked(q, f_logit, v, lb):
    B, S = q.shape[0], q.shape[1]
    C = HGRN_CHUNK
    N = S // C
    f = lb + (1.0 - lb) * jax.nn.sigmoid(f_logit.astype(jnp.float32))
    log_f = jnp.log(f)
    k = 1.0 - f
    qf = q.astype(jnp.float32) * HGRN_DK ** -0.5
    vf = v.astype(jnp.float32)

    def chunks(t):
        return t.reshape(B, N, C, t.shape[2], t.shape[3]).transpose(0, 3, 1, 2, 4)

    qc, kc, vc, lfc = chunks(qf), chunks(k), chunks(vf), chunks(log_f)
    b = jnp.cumsum(lfc, axis=3)
    b_last = b[..., C - 1:C, :]
    b_mid = b[..., C // 2 - 1:C // 2, :]
    q_in = qc * jnp.exp(b - b_mid)
    k_in = kc * jnp.exp(b_mid - b)
    A = jnp.einsum('bhnqd,bhnkd->bhnqk', q_in, k_in)
    causal = jnp.tril(jnp.ones((C, C), dtype=bool))
    A = jnp.where(causal, A, 0.0)
    o_intra = jnp.einsum('bhnqk,bhnkv->bhnqv', A, vc)
    U = jnp.einsum('bhnkd,bhnkv->bhndv', kc * jnp.exp(b_last - b), vc)
    decay = jnp.exp(b_last[..., 0, :])

    def step(state, xs):
        d, u = xs
        return d[..., None] * state + u, state

    s0 = jnp.zeros((B, q.shape[2], HGRN_DK, v.shape[3]), jnp.float32)
    _, s_prev = lax.scan(step, s0, (jnp.moveaxis(decay, 2, 0), jnp.moveaxis(U, 2, 0)))
    s_prev = jnp.moveaxis(s_prev, 0, 2)
    o_inter = jnp.einsum('bhnqd,bhndv->bhnqv', qc * jnp.exp(b), s_prev)
    o = o_intra + o_inter
    return o.transpose(0, 2, 3, 1, 4).reshape(B, S, q.shape[2], v.shape[3])


def _causal_block_attention(q, k, v):
    B, H, S, dqk = q.shape
    dv = v.shape[-1]
    nb = S // ATTN_BLOCK
    scale = dqk ** -0.5
    qb = q.reshape(B, H, nb, ATTN_BLOCK, dqk).transpose(2, 0, 1, 3, 4)
    k_pos = jnp.arange(S)
    neg = jnp.finfo(jnp.float32).min

    def one_block(args):
        qblk, blk = args
        s = jnp.einsum('bhqd,bhkd->bhqk', qblk, k).astype(jnp.float32) * scale
        q_pos = blk * ATTN_BLOCK + jnp.arange(ATTN_BLOCK)
        s = jnp.where(k_pos[None, :] <= q_pos[:, None], s, neg)
        p = jax.nn.softmax(s, axis=-1)
        return jnp.einsum('bhqk,bhkv->bhqv', p.astype(v.dtype), v)

    out = lax.map(one_block, (qb, jnp.arange(nb)))
    return out.transpose(1, 0, 3, 2, 4).reshape(B, S, H, dv)


def _hier_moe(h, w_group, b_group, w_router, b_router, w_gate, w_up, w_down):
    B, S, D = h.shape
    T = B * S
    xt = h.reshape(T, D)
    g_logits = (xt @ w_group).astype(jnp.float32) + b_group.astype(jnp.float32)
    g_prob = jax.nn.softmax(g_logits, axis=-1)
    g_sel = jnp.argmax(g_logits, axis=-1)
    p_group = jnp.take_along_axis(g_prob, g_sel[:, None], axis=-1)[:, 0]
    e_logits = ((xt @ w_router).astype(jnp.float32) + b_router.astype(jnp.float32))
    e_logits = e_logits.reshape(T, N_GROUPS, EXPERTS_PER_GROUP)
    e_in = jnp.take_along_axis(e_logits, g_sel[:, None, None], axis=1)[:, 0]
    top_val, top_idx = lax.top_k(e_in, TOP_K_IN_GROUP)
    weights = p_group[:, None] * jax.nn.softmax(top_val, axis=-1)
    expert_ids = g_sel[:, None] * EXPERTS_PER_GROUP + top_idx

    A = T * TOP_K_IN_GROUP
    e_flat = expert_ids.reshape(A).astype(jnp.int32)
    w_flat = weights.reshape(A)
    tok = jnp.arange(A, dtype=jnp.int32) // TOP_K_IN_GROUP
    counts = jax.ops.segment_sum(jnp.ones((A,), jnp.int32), e_flat, num_segments=N_EXPERTS)
    padded = ((counts + MOE_BLOCK - 1) // MOE_BLOCK) * MOE_BLOCK
    pad_end = jnp.cumsum(padded)
    pad_start = pad_end - padded
    start = jnp.cumsum(counts) - counts
    order = jnp.argsort(e_flat)
    e_sorted = e_flat[order]
    dest_sorted = pad_start[e_sorted] + (jnp.arange(A, dtype=jnp.int32) - start[e_sorted])
    dest = jnp.zeros((A,), jnp.int32).at[order].set(dest_sorted.astype(jnp.int32))
    n_blocks = -(-A // MOE_BLOCK) + N_EXPERTS
    R = n_blocks * MOE_BLOCK
    x_buf = jnp.zeros((R, D), xt.dtype).at[dest].set(xt[tok])
    blk_start = jnp.arange(n_blocks, dtype=jnp.int32) * MOE_BLOCK
    blk_e = jnp.minimum(jnp.searchsorted(pad_end, blk_start, side='right'), N_EXPERTS - 1)

    def expert_block(args):
        xb, e = args
        hid = jax.nn.silu(xb @ w_gate[e]) * (xb @ w_up[e])
        return hid @ w_down[e]

    y_buf = lax.map(expert_block, (x_buf.reshape(n_blocks, MOE_BLOCK, D), blk_e)).reshape(R, D)
    contrib = y_buf[dest] * w_flat[:, None].astype(y_buf.dtype)
    y = jax.ops.segment_sum(contrib, tok, num_segments=T)
    return y.reshape(B, S, D)


def setup_inputs(seed: int = 0) -> dict:
    key = jax.random.key(seed)
    ks = jax.random.split(key, 24)
    L = DEPTH

    def w(k, shape, fan_in, mult=1.0):
        return jax.random.normal(k, shape, jnp.float32) * (mult * fan_in ** -0.5)

    def gain(k, shape):
        return 1.0 + 0.02 * jax.random.normal(k, shape, jnp.float32)

    x = jax.random.normal(ks[0], (BATCH, SEQ, D_MODEL), jnp.float32)
    c = jax.random.normal(ks[1], (BATCH, D_MODEL), jnp.float32)
    offsets = jax.random.randint(ks[2], (BATCH, 1), 0, 512, dtype=jnp.int32)
    positions = offsets + jnp.arange(SEQ, dtype=jnp.int32)[None, :]
    return {
        "x": x,
        "c": c,
        "positions": positions,
        "w_ada": w(ks[3], (L, D_MODEL, 6 * D_MODEL), D_MODEL, 0.5),
        "b_ada": 0.01 * jax.random.normal(ks[4], (L, 6 * D_MODEL), jnp.float32),
        "norm1_g": gain(ks[5], (L, D_MODEL)),
        "w_in": w(ks[6], (L, D_MODEL, IN_COLS), D_MODEL),
        "hgrn_lb_logits": 1.0 + 0.1 * jax.random.normal(ks[7], (L + 1, HGRN_WIDTH), jnp.float32),
        "hgrn_onorm_g": gain(ks[8], (L, HGRN_DV)),
        "q_a_norm_g": gain(ks[9], (L, Q_LORA)),
        "w_q_up": w(ks[10], (L, Q_LORA, MLA_HEADS * MLA_QK), Q_LORA),
        "kv_a_norm_g": gain(ks[11], (L, KV_LORA)),
        "w_kv_up": w(ks[12], (L, KV_LORA, MLA_HEADS * (MLA_NOPE + MLA_V_DIM)), KV_LORA),
        "q_norm_g": gain(ks[13], (L, MLA_QK)),
        "k_norm_g": gain(ks[14], (L, MLA_QK)),
        "attn_onorm_g": gain(ks[15], (L, MLA_V_DIM)),
        "w_out": w(ks[16], (L, MIX_WIDTH, D_MODEL), MIX_WIDTH),
        "norm2_g": gain(ks[17], (L, D_MODEL)),
        "w_group": w(ks[18], (L, D_MODEL, N_GROUPS), D_MODEL),
        "b_group": 0.01 * jax.random.normal(ks[19], (L, N_GROUPS), jnp.float32),
        "w_router": w(ks[20], (L, D_MODEL, N_EXPERTS), D_MODEL),
        "b_router": 0.01 * jax.random.normal(ks[21], (L, N_EXPERTS), jnp.float32),
        "w_gate": w(ks[22], (L, N_EXPERTS, D_MODEL, D_EXPERT), D_MODEL),
        "w_up": w(jax.random.fold_in(ks[22], 1), (L, N_EXPERTS, D_MODEL, D_EXPERT), D_MODEL),
        "w_down": w(ks[23], (L, N_EXPERTS, D_EXPERT, D_MODEL), D_EXPERT),
    }


def reference(x, c, positions, w_ada, b_ada, norm1_g, w_in, hgrn_lb_logits, hgrn_onorm_g,
              q_a_norm_g, w_q_up, kv_a_norm_g, w_kv_up, q_norm_g, k_norm_g, attn_onorm_g,
              w_out, norm2_g, w_group, b_group, w_router, b_router, w_gate, w_up, w_down):
    B, S, D = x.shape
    lb_all = jnp.cumsum(jax.nn.softmax(hgrn_lb_logits.astype(jnp.float32), axis=0), axis=0)
    c_act = jax.nn.silu(c)
    split_idx = [HGRN_WIDTH, 2 * HGRN_WIDTH, 3 * HGRN_WIDTH, 4 * HGRN_WIDTH,
                 4 * HGRN_WIDTH + Q_LORA, 4 * HGRN_WIDTH + Q_LORA + KV_LORA]
    for l in range(DEPTH):
        mod = c_act @ w_ada[l] + b_ada[l]
        sh1, sc1, g1, sh2, sc2, g2 = jnp.split(mod, 6, axis=-1)

        h = _modulate(_rmsnorm(x, norm1_g[l]), sh1, sc1)
        proj = h @ w_in[l]
        hq, hf, hi, hg, q_a, kv_a, k_pe = jnp.split(proj, split_idx, axis=-1)

        def heads_a(t):
            return t.reshape(B, S, HGRN_HEADS, HGRN_DK)
        lb = lb_all[l].reshape(HGRN_HEADS, HGRN_DK)
        o_a = _hgrn2_chunked(heads_a(hq), heads_a(hf), heads_a(hi), lb).astype(x.dtype)
        o_a = _rmsnorm(o_a, hgrn_onorm_g[l]) * jax.nn.silu(heads_a(hg))
        o_a = o_a.reshape(B, S, HGRN_WIDTH)

        qh = (_rmsnorm(q_a, q_a_norm_g[l]) @ w_q_up[l]).reshape(B, S, MLA_HEADS, MLA_QK)
        kv = (_rmsnorm(kv_a, kv_a_norm_g[l]) @ w_kv_up[l]).reshape(B, S, MLA_HEADS, MLA_NOPE + MLA_V_DIM)
        k_nope, v = kv[..., :MLA_NOPE], kv[..., MLA_NOPE:]
        kh = jnp.concatenate(
            [k_nope, jnp.broadcast_to(k_pe[:, :, None, :], (B, S, MLA_HEADS, MLA_ROPE))], axis=-1)
        qh = _rmsnorm(qh, q_norm_g[l])
        kh = _rmsnorm(kh, k_norm_g[l])
        qh = jnp.concatenate([qh[..., :MLA_NOPE], _rope(qh[..., MLA_NOPE:], positions)], axis=-1)
        kh = jnp.concatenate([kh[..., :MLA_NOPE], _rope(kh[..., MLA_NOPE:], positions)], axis=-1)
        o_b = _causal_block_attention(qh.transpose(0, 2, 1, 3), kh.transpose(0, 2, 1, 3),
                                      v.transpose(0, 2, 1, 3))
        o_b = _rmsnorm(o_b, attn_onorm_g[l]).reshape(B, S, MLA_WIDTH)

        mix = jnp.concatenate([o_a, o_b], axis=-1) @ w_out[l]
        x = x + g1[:, None, :] * mix

        h2 = _modulate(_rmsnorm(x, norm2_g[l]), sh2, sc2)
        y = _hier_moe(h2, w_group[l], b_group[l], w_router[l], b_router[l],
                      w_gate[l], w_up[l], w_down[l])
        x = x + g2[:, None, :] * y
    return x
```

```cpp
#include <hip/hip_runtime.h>
#include <cstdio>
#include <cstdint>

#define GAS __attribute__((address_space(1)))
#define LAS __attribute__((address_space(3)))
typedef unsigned short bf16_t;
typedef short bf16x8 __attribute__((ext_vector_type(8)));
typedef short s16x4 __attribute__((ext_vector_type(4)));
typedef float f32x4 __attribute__((ext_vector_type(4)));
typedef float f32x2 __attribute__((ext_vector_type(2)));
typedef float f32x16 __attribute__((ext_vector_type(16)));
typedef unsigned u32x4 __attribute__((ext_vector_type(4)));
typedef unsigned u32x2 __attribute__((ext_vector_type(2)));
typedef GAS unsigned gu32;
#define RLX_AGENT __ATOMIC_RELAXED, __HIP_MEMORY_SCOPE_AGENT
#define LDS_WAIT() asm volatile("s_waitcnt lgkmcnt(0)" ::: "memory")
#define VM_WAIT() asm volatile("s_waitcnt vmcnt(0)" ::: "memory")

constexpr int DM = 2048, NB = 8, SEQ = 2048, T = NB * SEQ;
constexpr int HW = 1024, HH = 8, HDK = 128, HDV = 128;
constexpr int MH = 8, MNOPE = 128, MROPE = 64, MQK = 192, MV = 128, QLORA = 512, KVLORA = 256;
constexpr int INC = 4 * HW + QLORA + KVLORA + MROPE;
constexpr int INCP = 5120;
constexpr int C_QA = 4096, C_KVA = 4608, C_KPE = 4864;
constexpr int NG = 4, EPG = 8, NE = 32, DE = 512;
constexpr int RMAX = (T * 2 / 256 + NE) * 256;
constexpr float EPS = 1e-6f;
constexpr int NWAVES = 8, NTHR = 512;

__device__ __forceinline__ unsigned cvt_pk_bf16(float lo, float hi) { unsigned r; asm volatile("v_cvt_pk_bf16_f32 %0, %1, %2" : "=v"(r) : "v"(lo), "v"(hi)); return r; }
__device__ __forceinline__ float bf_lo(unsigned w) { return __builtin_bit_cast(float, w << 16); }
__device__ __forceinline__ float bf_hi(unsigned w) { return __builtin_bit_cast(float, w & 0xffff0000u); }
__device__ __forceinline__ float bf2f(bf16_t h) { return __builtin_bit_cast(float, (unsigned)h << 16); }
__device__ __forceinline__ float wave_sum(float v) {
#pragma unroll
    for (int o = 1; o < 64; o <<= 1) v += __shfl_xor(v, o);
    return v;
}
__device__ __forceinline__ float siluf(float v) { return v / (1.f + __expf(-v)); }

#define XB_TMO      128
#define XB_XCNT(j)  (256  + 64 * (j))
#define XB_XSUB(j)  (1280 + 64 * (j))
#define XB_XGEN(j)  (2304 + 64 * (j))
#define XB_TOP      3328
#define XB_TOPGEN   3392
#define XCD_BAR_WORDS 3456
#define XB_SPIN_CAP (1u << 18)

__device__ __forceinline__ unsigned xb_ld(unsigned* p)              { return __hip_atomic_load(p, __ATOMIC_RELAXED, __HIP_MEMORY_SCOPE_AGENT); }
__device__ __forceinline__ unsigned xb_add(unsigned* p, unsigned v) { return __hip_atomic_fetch_add(p, v, __ATOMIC_RELAXED, __HIP_MEMORY_SCOPE_AGENT); }
__device__ __forceinline__ unsigned xb_xcc_id() { return (unsigned)__builtin_amdgcn_s_getreg((3 << 11) | 20) & 0xFu; }
#define XB_SPIN(cond, bar) do { unsigned _sp = 0; while (cond) { __builtin_amdgcn_s_sleep(1); \
    if ((++_sp & 255u) == 0u) { if (xb_ld(&(bar)[XB_TMO])) break; if (_sp > XB_SPIN_CAP) { atomicAdd(&(bar)[XB_TMO], 1u); break; } } } } while (0)

struct XcdBarrier {
    unsigned* bar; unsigned x;
    volatile LAS unsigned* st;
};
__device__ __forceinline__ XcdBarrier xcd_barrier_post(unsigned* bar, volatile LAS unsigned* st) {
    XcdBarrier b; b.bar = bar; b.x = xb_xcc_id(); b.st = st;
    if (threadIdx.x == 0) (void)xb_add(&bar[XB_XCNT(b.x)], 1u);
    return b;
}
__device__ __forceinline__ void xcd_barrier_complete(unsigned* bar, unsigned x, unsigned& nloc, unsigned& nx) {
    const unsigned G = gridDim.x * gridDim.y * gridDim.z;
    unsigned sum, cnt, mine, sp = 0u;
    for (;;) {
        sum = 0u; cnt = 0u; mine = 0u;
#pragma unroll
        for (unsigned j = 0; j < 16; ++j) { const unsigned c = xb_ld(&bar[XB_XCNT(j)]); sum += c; cnt += (c > 0u) ? 1u : 0u; mine = (j == x) ? c : mine; }
        if (sum == G) break;
        __builtin_amdgcn_s_sleep(1);
        if ((++sp & 255u) == 0u) { if (xb_ld(&bar[XB_TMO])) break; if (sp > XB_SPIN_CAP) { atomicAdd(&bar[XB_TMO], 1u); break; } }
    }
    nloc = mine > 0u ? mine : 1u; nx = cnt > 0u ? cnt : 1u;
}
__device__ __forceinline__ void xcd_barrier(const XcdBarrier& b) {
    asm volatile("s_waitcnt vmcnt(0)" ::: "memory");
    __syncthreads();
    if (threadIdx.x == 0) {
        unsigned* bar = b.bar;
        __builtin_amdgcn_s_waitcnt(0);
        unsigned nloc = b.st[0], nx = b.st[1];
        if (nloc == 0u) { xcd_barrier_complete(bar, b.x, nloc, nx); b.st[0] = nloc; b.st[1] = nx; }
        const unsigned old = xb_add(&bar[XB_XSUB(b.x)], 1u);
        const unsigned gen = old / nloc;
        if (old + 1u == (gen + 1u) * nloc) {
            __builtin_amdgcn_fence(__ATOMIC_RELEASE, "agent");
            asm volatile("s_waitcnt vmcnt(0)" ::: "memory");
            const unsigned og = xb_add(&bar[XB_TOP], 1u);
            const unsigned tg = og / nx;
            if (og + 1u == (tg + 1u) * nx) xb_add(&bar[XB_TOPGEN], 1u);
            else XB_SPIN(xb_ld(&bar[XB_TOPGEN]) == tg, bar);
            __builtin_amdgcn_fence(__ATOMIC_ACQUIRE, "agent");
            xb_add(&bar[XB_XGEN(b.x)], 1u);
            asm volatile("s_waitcnt vmcnt(0)" ::: "memory");
        } else {
            XB_SPIN(xb_ld(&bar[XB_XGEN(b.x)]) == gen, bar);
            __builtin_amdgcn_fence(__ATOMIC_ACQUIRE, "agent");
            asm volatile("s_waitcnt vmcnt(0)" ::: "memory");
        }
    }
    __syncthreads();
}

namespace pg8 {
constexpr int BM = 256, BK = 64, HALF = 128, HTB = HALF * BK * 2, STAGE_BYTES = 8 * HTB, NXCD = 8, WGM = 8;
__host__ __device__ __forceinline__ int lds_byte(int r, int c) { const int st = (r >> 4) * 2 + (c >> 5), rr = r & 15, cc = c & 31, ob = rr * 64 + cc * 2; return st * 1024 + (ob ^ (((ob >> 9) & 1) << 5)); }
__host__ __device__ __forceinline__ void stage_rc(int b, int& R, int& C) { const int st = b / 1024, sb = b % 1024, swz = sb ^ (((sb >> 9) & 1) << 5); R = (st >> 1) * 16 + swz / 64; C = (st & 1) * 32 + (swz % 64) / 2; }
__host__ __device__ __forceinline__ int perm32(int rho) { const int n = rho >> 4, i = rho & 15; return 8 * (i >> 2) + 4 * n + (i & 3); }

struct Unit { int pm, pn, pb; };
struct Gemm { const bf16_t* A; const bf16_t* Bt; int lda, ldb, K; };

struct DenseOrder {
    int nM, nN, nwg, G, c;
    __device__ void init(int nM_, int nN_, int G_, int c_) { nM = nM_; nN = nN_; nwg = nM * nN; G = G_; c = c_; }
    __device__ bool next(int i, Unit& u) const {
        const long L = (long)i * G + c; if (L >= nwg) return false;
        int wgid = (int)L; { const int q = nwg / NXCD, r = nwg % NXCD, xcd = wgid % NXCD, off = wgid / NXCD; wgid = (xcd < r ? xcd * (q + 1) : r * (q + 1) + (xcd - r) * q) + off; }
        const int nig = WGM * nN, gid = wgid / nig, fm = gid * WGM, gsz = (nM - fm) < WGM ? (nM - fm) : WGM;
        u.pm = fm + ((wgid % nig) % gsz); u.pn = (wgid % nig) / gsz; u.pb = u.pn; return true;
    }
};
struct GroupedOrder {
    int nM, nN, nwg, G, c; const int* blk_e;
    __device__ void init(int nM_, int nN_, int G_, int c_, const int* be) { nM = nM_; nN = nN_; nwg = nM * nN; G = G_; c = c_; blk_e = be; }
    __device__ bool next(int i, Unit& u) const {
        const long L = (long)i * G + c; if (L >= nwg) return false;
        const int w = (int)L; u.pn = w % nN; u.pm = w / nN; u.pb = blk_e[u.pm] * nN + u.pn; return true;
    }
};

template <class Epi, class Sched>
__device__ __forceinline__ void gemm_phase(LAS unsigned char* lds, const Gemm g, const Sched& S, const Epi& E) {
    const int tid = threadIdx.x, wid = __builtin_amdgcn_readfirstlane(tid >> 6), lane = tid & 63, wr = wid >> 2, wc = wid & 3, fr = lane & 15, fq = lane >> 4;
    const int K = g.K, nt = K / BK;
    unsigned voffA[2], voffB[2];
#pragma unroll
    for (int i = 0; i < 2; ++i) { int R, C; stage_rc(tid * 16 + i * 8192, R, C); const int Rb = (R & ~31) + perm32(R & 31);
        voffA[i] = (unsigned)(R * g.lda + C) * 2u; voffB[i] = (unsigned)(Rb * g.ldb + C) * 2u; }
    const size_t kstep = (size_t)(BK * 2);
    const size_t hsA = (size_t)HALF * g.lda * 2, hsB = (size_t)HALF * g.ldb * 2;
    const unsigned ldsw = (unsigned)wid * 1024u;
    const int aoff = lds_byte(wr * 64 + fr, fq * 8), boff = lds_byte(wc * 32 + fr, fq * 8);
#define PG8_SA(b, h) (((b) * 2 + (h)) * HTB)
#define PG8_SB(b, h) ((4 + (b) * 2 + (h)) * HTB)
#define PG8_STAGE(bufoff, gbase, voff) do { _Pragma("unroll") for (int _i = 0; _i < 2; ++_i) \
        __builtin_amdgcn_global_load_lds((const unsigned*)((const char*)(gbase) + (voff)[_i]), (LAS unsigned*)(lds + (bufoff) + ldsw + _i * 8192), 16, 0, 0); } while (0)
#define PG8_LDA(dst, b, h) do { _Pragma("unroll") for (int m = 0; m < 4; ++m) _Pragma("unroll") for (int k = 0; k < 2; ++k) dst[m][k] = *(const LAS bf16x8*)(lds + PG8_SA(b, h) + aoff + m * 2048 + k * 1024); } while (0)
#define PG8_LDB(dst, b, h) do { _Pragma("unroll") for (int n = 0; n < 2; ++n) _Pragma("unroll") for (int k = 0; k < 2; ++k) dst[n][k] = *(const LAS bf16x8*)(lds + PG8_SB(b, h) + boff + n * 2048 + k * 1024); } while (0)
#define PG8_MMA(ai, bj, At, Bt) do { __builtin_amdgcn_s_setprio(1); _Pragma("unroll") for (int m = 0; m < 4; ++m) _Pragma("unroll") for (int n = 0; n < 2; ++n) _Pragma("unroll") for (int k = 0; k < 2; ++k) \
        acc[ai][bj][m][n] = __builtin_amdgcn_mfma_f32_16x16x32_bf16(Bt[n][k], At[m][k], acc[ai][bj][m][n], 0, 0, 0); __builtin_amdgcn_s_setprio(0); } while (0)
#define PG8_WAIT_V(n) asm volatile("s_waitcnt vmcnt(" #n ")" ::: "memory")
#define PG8_WAIT_L(n) asm volatile("s_waitcnt lgkmcnt(" #n ")" ::: "memory")
#define PG8_BAR __builtin_amdgcn_s_barrier()
#define PG8_SCHED __builtin_amdgcn_sched_barrier(0)
    Unit cur, nxt; int ui = 0;
    if (!S.next(0, cur)) return;
    f32x4 acc[2][2][4][2];
#pragma unroll
    for (int a = 0; a < 2; ++a)
#pragma unroll
        for (int b = 0; b < 2; ++b)
#pragma unroll
            for (int m = 0; m < 4; ++m)
#pragma unroll
                for (int n = 0; n < 2; ++n) acc[a][b][m][n] = (f32x4){0.f, 0.f, 0.f, 0.f};
    bf16x8 At[4][2], B0[2][2], B1[2][2];
    const char* cA = (const char*)g.A + (size_t)cur.pm * 2 * hsA; const char* cB = (const char*)g.Bt + (size_t)cur.pb * 2 * hsB;
    PG8_STAGE(PG8_SB(0, 0), cB, voffB); PG8_STAGE(PG8_SB(0, 1), cB + hsB, voffB); PG8_STAGE(PG8_SA(0, 0), cA, voffA); PG8_STAGE(PG8_SA(0, 1), cA + hsA, voffA);
    if (wr == 1) PG8_BAR;
    PG8_WAIT_V(2); PG8_BAR;
    PG8_STAGE(PG8_SB(1, 0), cB + kstep, voffB); PG8_STAGE(PG8_SA(1, 0), cA + kstep, voffA); PG8_STAGE(PG8_SB(1, 1), cB + hsB + kstep, voffB);
    PG8_WAIT_V(6); PG8_BAR;
    for (;;) {
        const bool has_next = S.next(ui + 1, nxt);
        const char* nA = has_next ? (const char*)g.A + (size_t)nxt.pm * 2 * hsA : cA; const char* nB = has_next ? (const char*)g.Bt + (size_t)nxt.pb * 2 * hsB : cB;
        for (int t = 0; t < nt; t += 2) {
            const bool last = (t == nt - 2);
            const char* a1 = cA + (size_t)(t + 1) * kstep;
            const char* a2 = last ? nA : cA + (size_t)(t + 2) * kstep; const char* b2 = last ? nB : cB + (size_t)(t + 2) * kstep;
            const char* a3 = a2 + kstep; const char* b3 = b2 + kstep;
            PG8_LDB(B0, 0, 0); PG8_LDB(B1, 0, 1); PG8_SCHED; PG8_LDA(At, 0, 0); PG8_STAGE(PG8_SA(1, 1), a1 + hsA, voffA);
            PG8_WAIT_V(8); PG8_WAIT_L(0); PG8_BAR; PG8_MMA(0, 0, At, B0); PG8_MMA(0, 1, At, B1); PG8_BAR; PG8_SCHED;
            PG8_LDA(At, 0, 1); PG8_STAGE(PG8_SB(0, 0), b2, voffB); PG8_STAGE(PG8_SB(0, 1), b2 + hsB, voffB); PG8_STAGE(PG8_SA(0, 0), a2, voffA);
            PG8_WAIT_V(8); PG8_WAIT_L(0); PG8_BAR; PG8_MMA(1, 0, At, B0); PG8_MMA(1, 1, At, B1); PG8_BAR; PG8_SCHED;
            PG8_LDB(B0, 1, 0); PG8_LDB(B1, 1, 1); PG8_SCHED; PG8_LDA(At, 1, 0); PG8_STAGE(PG8_SA(0, 1), a2 + hsA, voffA);
            PG8_WAIT_V(8); PG8_WAIT_L(0); PG8_BAR; PG8_MMA(0, 0, At, B0); PG8_MMA(0, 1, At, B1); PG8_BAR; PG8_SCHED;
            PG8_LDA(At, 1, 1); PG8_STAGE(PG8_SB(1, 0), b3, voffB); PG8_STAGE(PG8_SB(1, 1), b3 + hsB, voffB); PG8_STAGE(PG8_SA(1, 0), a3, voffA);
            PG8_WAIT_V(8); PG8_WAIT_L(0); PG8_BAR; PG8_MMA(1, 0, At, B0); PG8_MMA(1, 1, At, B1); PG8_BAR; PG8_SCHED;
        }
        if (wr == 0) PG8_BAR;
        E(acc, cur, wr, wc, fr, fq);
        if (!has_next) break;
#pragma unroll
        for (int a = 0; a < 2; ++a)
#pragma unroll
            for (int b = 0; b < 2; ++b)
#pragma unroll
                for (int m = 0; m < 4; ++m)
#pragma unroll
                    for (int n = 0; n < 2; ++n) acc[a][b][m][n] = (f32x4){0.f, 0.f, 0.f, 0.f};
        cur = nxt; cA = nA; cB = nB; ++ui;
        if (wr == 1) PG8_BAR;
    }
    PG8_WAIT_V(0);
    PG8_BAR;
#undef PG8_SA
#undef PG8_SB
#undef PG8_STAGE
#undef PG8_LDA
#undef PG8_LDB
#undef PG8_MMA
#undef PG8_WAIT_V
#undef PG8_WAIT_L
#undef PG8_BAR
#undef PG8_SCHED
}

struct EpiStore {
    bf16_t* O; int ldc; const float* rowscale;
    __device__ __forceinline__ void operator()(const f32x4 (&acc)[2][2][4][2], const Unit& u, int wr, int wc, int fr, int fq) const {
        const int row0 = u.pm * BM + wr * 64 + fr, col0 = u.pn * BM + wc * 32 + 8 * fq;
#pragma unroll
        for (int ai = 0; ai < 2; ++ai)
#pragma unroll
            for (int m = 0; m < 4; ++m) { const int row = row0 + ai * HALF + m * 16; const float rs = rowscale ? rowscale[row] : 1.f;
                bf16_t* rowp = O + (size_t)row * ldc + col0;
#pragma unroll
                for (int bj = 0; bj < 2; ++bj) { const f32x4 v0 = acc[ai][bj][m][0] * rs, v1 = acc[ai][bj][m][1] * rs;
                    u32x4 w; w.x = cvt_pk_bf16(v0[0], v0[1]); w.y = cvt_pk_bf16(v0[2], v0[3]); w.z = cvt_pk_bf16(v1[0], v1[1]); w.w = cvt_pk_bf16(v1[2], v1[3]);
                    *(u32x4*)(rowp + bj * HALF) = w; } }
    }
};
struct EpiResid {
    const float* X; float* O; const float* gate; int gpitch;
    __device__ __forceinline__ void operator()(const f32x4 (&acc)[2][2][4][2], const Unit& u, int wr, int wc, int fr, int fq) const {
        const int row0 = u.pm * BM + wr * 64 + fr, col0 = u.pn * BM + wc * 32 + 8 * fq;
        const float* gp = gate + (size_t)((u.pm * BM) / SEQ) * gpitch + col0;
        f32x4 gv[2][2];
#pragma unroll
        for (int bj = 0; bj < 2; ++bj)
#pragma unroll
            for (int n = 0; n < 2; ++n) gv[bj][n] = *(const f32x4*)(gp + bj * HALF + 4 * n);
#pragma unroll
        for (int ai = 0; ai < 2; ++ai)
#pragma unroll
            for (int m = 0; m < 4; ++m) { const size_t off = (size_t)(row0 + ai * HALF + m * 16) * DM + col0;
#pragma unroll
                for (int bj = 0; bj < 2; ++bj)
#pragma unroll
                    for (int n = 0; n < 2; ++n) { const f32x4 xv = *(const f32x4*)(X + off + bj * HALF + 4 * n);
                        *(f32x4*)(O + off + bj * HALF + 4 * n) = xv + gv[bj][n] * acc[ai][bj][m][n]; } }
    }
};
struct EpiSwiGLU {
    bf16_t* O;
    __device__ __forceinline__ void operator()(const f32x4 (&acc)[2][2][4][2], const Unit& u, int wr, int wc, int fr, int fq) const {
        const int row0 = u.pm * BM + wr * 64 + fr, col0 = u.pn * HALF + wc * 32 + 8 * fq;
#pragma unroll
        for (int ai = 0; ai < 2; ++ai)
#pragma unroll
            for (int m = 0; m < 4; ++m) { const int row = row0 + ai * HALF + m * 16;
                float h[8];
#pragma unroll
                for (int n = 0; n < 2; ++n)
#pragma unroll
                    for (int j = 0; j < 4; ++j) { const float gt = acc[ai][0][m][n][j], up = acc[ai][1][m][n][j]; h[4 * n + j] = gt / (1.f + __expf(-gt)) * up; }
                u32x4 w; w.x = cvt_pk_bf16(h[0], h[1]); w.y = cvt_pk_bf16(h[2], h[3]); w.z = cvt_pk_bf16(h[4], h[5]); w.w = cvt_pk_bf16(h[6], h[7]);
                *(u32x4*)(O + (size_t)row * DE + col0) = w; }
    }
};
}
constexpr size_t MiB = 1u << 20;
constexpr size_t WS_CTL = 0, CTL_ZERO_BYTES = 1 * MiB;
constexpr size_t WS_MOD = 1 * MiB;
constexpr size_t WS_ROPEC = 1 * MiB + 512 * 1024;
constexpr size_t WS_ROPES = WS_ROPEC + 2 * MiB;
constexpr size_t WS_WCT = WS_ROPES + 2 * MiB;
constexpr size_t WS_RSTDQ = 6 * MiB;
constexpr size_t WS_RSTDKV = WS_RSTDQ + 64 * 1024;
constexpr size_t WS_TOKE = WS_RSTDKV + 64 * 1024;
constexpr size_t WS_TOKW = WS_TOKE + 128 * 1024;
constexpr size_t WS_TOKS = WS_TOKW + 128 * 1024;
constexpr size_t WS_BLKE = WS_TOKS + 128 * 1024;
constexpr size_t WS_WIN = 8 * MiB;
constexpr size_t WS_WQUP = 28 * MiB;
constexpr size_t WS_WKVUP = WS_WQUP + 1536 * 1024;
constexpr size_t WS_WOUT = 31 * MiB;
constexpr size_t WS_A = 40 * MiB;
constexpr size_t WS_B = 200 * MiB;
constexpr size_t WS_C = 264 * MiB;
constexpr size_t WS_D = 328 * MiB;
constexpr size_t WS_E = 456 * MiB;
constexpr size_t WS_END = 520 * MiB;
constexpr size_t QN_BYTES = (size_t)T * MH * MQK * 2;

constexpr int CW_BAR = 4096;
constexpr int CW_CNT = 8192;

constexpr int RING_BYTES = 131072, MISC_OFF = RING_BYTES + 320, LDS_BYTES = 147456;

struct Args { const float* in[25]; float* out; unsigned char* ws; int ph_lo, ph_hi, pad0, pad1; };

struct Frame {
    LAS unsigned char* lds;
    volatile LAS unsigned* MISC;
    gu32* ctl;
    int tid, lane, wave, vcu, G;
    unsigned char* ws; float* out;
};

__device__ __forceinline__ void transpose_item(const float* W, int N, int k0, int n0, bf16_t* dst, int ldt, const float* gk, LAS float* scr, int lane) {
#pragma unroll 8
    for (int i = 0; i < 32; ++i) { const int kk = 2 * i + (lane >> 5); float v = W[(size_t)(k0 + kk) * N + n0 + (lane & 31)]; if (gk) v *= gk[k0 + kk]; scr[kk * 33 + (lane & 31)] = v; }
    LDS_WAIT(); asm volatile("" ::: "memory");
    const int c = lane & 7;
#pragma unroll
    for (int j = 0; j < 4; ++j) { const int n = (lane >> 3) + 8 * j; const LAS float* s = scr + (8 * c) * 33 + n;
        u32x4 o; o.x = cvt_pk_bf16(s[0 * 33], s[1 * 33]); o.y = cvt_pk_bf16(s[2 * 33], s[3 * 33]); o.z = cvt_pk_bf16(s[4 * 33], s[5 * 33]); o.w = cvt_pk_bf16(s[6 * 33], s[7 * 33]);
        *(u32x4*)(dst + (size_t)n * ldt + k0 + 8 * c) = o; }
    LDS_WAIT(); asm volatile("" ::: "memory");
}

__device__ __forceinline__ void adaln_phase(Frame& F, const float* c, const float* w_ada, const float* b_ada, float* mod) {
    LAS float* cact = (LAS float*)F.lds;
    LAS float* part = (LAS float*)(F.lds + 65536);
    for (int i = F.tid; i < NB * DM; i += NTHR) cact[i] = siluf(c[i]);
    __syncthreads();
    const int cg = F.tid & 7, rs = F.tid >> 3;
    for (int it = blockIdx.x; it < 6 * DM / 32; it += F.G) {
        const int n0 = it * 32 + cg * 4;
        f32x4 acc[8];
#pragma unroll
        for (int b = 0; b < 8; ++b) acc[b] = (f32x4){0.f, 0.f, 0.f, 0.f};
#pragma unroll 4
        for (int i = 0; i < 32; ++i) { const int k = rs + 64 * i; const f32x4 w = *(const f32x4*)(w_ada + (size_t)k * (6 * DM) + n0);
#pragma unroll
            for (int b = 0; b < 8; ++b) acc[b] += w * cact[b * DM + k]; }
#pragma unroll
        for (int b = 0; b < 8; ++b) *(LAS f32x4*)(part + (rs * 8 + b) * 32 + cg * 4) = acc[b];
        __syncthreads();
        if (F.tid < 256) { const int b = F.tid >> 5, n = F.tid & 31; float s = 0.f;
#pragma unroll 8
            for (int r = 0; r < 64; ++r) s += part[(r * 8 + b) * 32 + n];
            mod[b * (6 * DM) + it * 32 + n] = s + b_ada[it * 32 + n]; }
        __syncthreads();
    }
}

__device__ __forceinline__ void p0_phase(Frame& F, const Args& a) {
    unsigned char* ws = F.ws;
    adaln_phase(F, a.in[1], a.in[3], a.in[4], (float*)(ws + WS_MOD));
    LAS float* scr = (LAS float*)(F.lds + F.wave * 16384);
    const int gw = F.vcu * NWAVES + F.wave, NGW = F.G * NWAVES;
    constexpr int I_IN = (DM / 64) * (INC / 32), I_QUP = (QLORA / 64) * (MH * MQK / 32), I_KVUP = (KVLORA / 64) * (MH * 256 / 32), I_OUT = (DM / 64) * (DM / 32);
    constexpr int NITEMS = I_IN + I_QUP + I_KVUP + I_OUT;
    for (int it = gw; it < NITEMS; it += NGW) {
        int r = it;
        if (r < I_IN) { const int nblk = INC / 32, kb = r / nblk, nb = r % nblk; transpose_item(a.in[6], INC, 64 * kb, 32 * nb, (bf16_t*)(ws + WS_WIN) + (size_t)(32 * nb) * DM, DM, nullptr, scr, F.lane); continue; } r -= I_IN;
        if (r < I_QUP) { const int nblk = MH * MQK / 32, kb = r / nblk, nb = r % nblk; transpose_item(a.in[10], MH * MQK, 64 * kb, 32 * nb, (bf16_t*)(ws + WS_WQUP) + (size_t)(32 * nb) * QLORA, QLORA, a.in[9], scr, F.lane); continue; } r -= I_QUP;
        if (r < I_KVUP) { const int nblk = MH * 256 / 32, kb = r / nblk, nb = r % nblk; transpose_item(a.in[12], MH * 256, 64 * kb, 32 * nb, (bf16_t*)(ws + WS_WKVUP) + (size_t)(32 * nb) * KVLORA, KVLORA, a.in[11], scr, F.lane); continue; } r -= I_KVUP;
        { const int nblk = DM / 32, kb = r / nblk, nb = r % nblk; transpose_item(a.in[16], DM, 64 * kb, 32 * nb, (bf16_t*)(ws + WS_WOUT) + (size_t)(32 * nb) * DM, DM, nullptr, scr, F.lane); }
    }
    { const int* pos = (const int*)a.in[2]; float* rc = (float*)(ws + WS_ROPEC); float* rsn = (float*)(ws + WS_ROPES);
      const int gt = F.vcu * NTHR + F.tid, NGT = F.G * NTHR;
      for (int e = gt; e < T * 32; e += NGT) { const int i = e & 31, tk = e >> 5;
          const float invf = (float)exp2(-(double)i * (13.287712379549449 / 32.0));
          const float ang = (float)pos[tk] * invf;
          rc[e] = cosf(ang); rsn[e] = sinf(ang); }
      float* wct = (float*)(ws + WS_WCT);
      for (int e = gt; e < 48 * DM; e += NGT) { const int n = e / DM, k = e % DM;
          wct[e] = n < 4 ? a.in[18][k * NG + n] : (n < 36 ? a.in[20][k * NE + (n - 4)] : 0.f); } }
}

__device__ __forceinline__ void modnorm_row(const float* xrow, const float* g, const float* shift, const float* scale, bf16_t* orow, int lane) {
    const f32x4* xr = (const f32x4*)xrow + lane;
    f32x4 v[8]; float s = 0.f;
#pragma unroll
    for (int j = 0; j < 8; ++j) { v[j] = xr[64 * j]; s += (v[j].x * v[j].x + v[j].y * v[j].y) + (v[j].z * v[j].z + v[j].w * v[j].w); }
    const float rstd = rsqrtf(wave_sum(s) * (1.f / DM) + EPS);
    u32x2* o8 = (u32x2*)orow + lane;
#pragma unroll
    for (int j = 0; j < 8; ++j) { const f32x4 gg = ((const f32x4*)g)[64 * j + lane], sh = ((const f32x4*)shift)[64 * j + lane], sc = ((const f32x4*)scale)[64 * j + lane];
        const f32x4 h = v[j] * rstd * gg * (sc + 1.f) + sh;
        u32x2 w; w.x = cvt_pk_bf16(h.x, h.y); w.y = cvt_pk_bf16(h.z, h.w); o8[64 * j] = w; }
}
__device__ __forceinline__ void p1_phase(Frame& F, const Args& a) {
    const int gw = F.vcu * NWAVES + F.wave, NGW = F.G * NWAVES;
    const float* mod = (const float*)(F.ws + WS_MOD);
    bf16_t* H = (bf16_t*)(F.ws + WS_B);
    for (int m = gw; m < T; m += NGW) { const int b = m / SEQ;
        modnorm_row(a.in[0] + (size_t)m * DM, a.in[5], mod + b * (6 * DM), mod + b * (6 * DM) + DM, H + (size_t)m * DM, F.lane); }
}

template <int CTRL> __device__ __forceinline__ float dppf(float x) { return __builtin_bit_cast(float, __builtin_amdgcn_update_dpp(0, __builtin_bit_cast(int, x), CTRL, 0xF, 0xF, true)); }
__device__ __forceinline__ void unpack8(const u32x4 w, float* f) { f[0] = bf_lo(w.x); f[1] = bf_hi(w.x); f[2] = bf_lo(w.y); f[3] = bf_hi(w.y); f[4] = bf_lo(w.z); f[5] = bf_hi(w.z); f[6] = bf_lo(w.w); f[7] = bf_hi(w.w); }

__device__ __forceinline__ void p3_phase(Frame& F, const Args& a) {
    const bf16_t* PROJ = (const bf16_t*)(F.ws + WS_A);
    {
        const int gw = F.vcu * NWAVES + F.wave, NGW = F.G * NWAVES;
        float* rq = (float*)(F.ws + WS_RSTDQ); float* rkv = (float*)(F.ws + WS_RSTDKV);
        for (int m = gw; m < T; m += NGW) {
            float f[8]; unpack8(*(const u32x4*)(PROJ + (size_t)m * INCP + C_QA + F.lane * 8), f);
            float s = 0.f;
#pragma unroll
            for (int j = 0; j < 8; ++j) s += f[j] * f[j];
            s = wave_sum(s);
            float s2 = 0.f;
            if (F.lane < 32) { unpack8(*(const u32x4*)(PROJ + (size_t)m * INCP + C_KVA + F.lane * 8), f);
#pragma unroll
                for (int j = 0; j < 8; ++j) s2 += f[j] * f[j]; }
            s2 = wave_sum(s2);
            if (F.lane == 0) { rq[m] = rsqrtf(s * (1.f / QLORA) + EPS); rkv[m] = rsqrtf(s2 * (1.f / KVLORA) + EPS); }
        }
    }
    LAS float* fS = (LAS float*)F.lds;
    LAS float* qS = (LAS float*)(F.lds + 32768);
    LAS float* vS = (LAS float*)(F.lds + 65536);
    LAS float* oS = (LAS float*)(F.lds + 73728);
    bf16_t* MIX = (bf16_t*)(F.ws + WS_E);
    const float* lbl = a.in[7];
    const int cc = F.tid & 15, r0 = F.tid >> 4;
    const int kg = F.lane & 15, d = (F.lane >> 4) + 4 * F.wave;
    for (int it = blockIdx.x; it < NB * HH * 4; it += F.G) {
        const int dq = it & 3, h = (it >> 2) & 7, b = it >> 5;
        float lb[8];
#pragma unroll
        for (int j = 0; j < 8; ++j) { const int k = h * 128 + cc * 8 + j; lb[j] = 1.f / (1.f + __expf(lbl[HW + k] - lbl[k])); }
        float S[8];
#pragma unroll
        for (int j = 0; j < 8; ++j) S[j] = 0.f;
        const bf16_t* base = PROJ + (size_t)(b * SEQ) * INCP + h * 128;
        u32x4 gq[2], gf[2], gv;
#define HG_LOAD(c) do { _Pragma("unroll") for (int i = 0; i < 2; ++i) { const bf16_t* p = base + (size_t)((c) * 64 + r0 + 32 * i) * INCP + cc * 8; gq[i] = *(const u32x4*)p; gf[i] = *(const u32x4*)(p + HW); } \
            if (F.tid < 256) gv = *(const u32x4*)(base + (size_t)((c) * 64 + (F.tid >> 2)) * INCP + 2 * HW + dq * 32 + (F.tid & 3) * 8); } while (0)
        HG_LOAD(0);
        for (int c = 0; c < SEQ / 64; ++c) {
            __syncthreads();
#pragma unroll
            for (int i = 0; i < 2; ++i) { float q[8], fl[8]; unpack8(gq[i], q); unpack8(gf[i], fl);
                f32x4 o0, o1, p0, p1;
#pragma unroll
                for (int j = 0; j < 8; ++j) { const float sg = 1.f / (1.f + __expf(-fl[j])); const float fv = lb[j] + (1.f - lb[j]) * sg; const float qv = q[j] * 0.08838834764831845f;
                    if (j < 4) { o0[j] = fv; p0[j] = qv; } else { o1[j - 4] = fv; p1[j - 4] = qv; } }
                LAS float* fp = fS + (r0 + 32 * i) * 128 + cc * 8; LAS float* qp = qS + (r0 + 32 * i) * 128 + cc * 8;
                *(LAS f32x4*)fp = o0; *(LAS f32x4*)(fp + 4) = o1; *(LAS f32x4*)qp = p0; *(LAS f32x4*)(qp + 4) = p1; }
            if (F.tid < 256) { float v[8]; unpack8(gv, v); LAS float* vp = vS + (F.tid >> 2) * 32 + (F.tid & 3) * 8;
                *(LAS f32x4*)vp = (f32x4){v[0], v[1], v[2], v[3]}; *(LAS f32x4*)(vp + 4) = (f32x4){v[4], v[5], v[6], v[7]}; }
            if (c + 1 < SEQ / 64) HG_LOAD(c + 1);
            __syncthreads();
#pragma unroll 4
            for (int st = 0; st < 64; ++st) {
                const f32x4 f0 = *(const LAS f32x4*)(fS + st * 128 + kg * 8), f1 = *(const LAS f32x4*)(fS + st * 128 + kg * 8 + 4);
                const f32x4 q0 = *(const LAS f32x4*)(qS + st * 128 + kg * 8), q1 = *(const LAS f32x4*)(qS + st * 128 + kg * 8 + 4);
                const float vv = vS[st * 32 + d];
                float part = 0.f;
#pragma unroll
                for (int j = 0; j < 4; ++j) { S[j] = f0[j] * (S[j] - vv) + vv; part += S[j] * q0[j]; S[4 + j] = f1[j] * (S[4 + j] - vv) + vv; part += S[4 + j] * q1[j]; }
                part += dppf<0xB1>(part); part += dppf<0x4E>(part); part += dppf<0x141>(part); part += dppf<0x140>(part);
                if (kg == 0) oS[st * 32 + d] = part;
            }
            __syncthreads();
            if (F.tid < 256) { const int row = F.tid >> 2, c8 = (F.tid & 3) * 8; const LAS float* op = oS + row * 32 + c8;
                const f32x4 x0 = *(const LAS f32x4*)op, x1 = *(const LAS f32x4*)(op + 4);
                u32x4 w; w.x = cvt_pk_bf16(x0[0], x0[1]); w.y = cvt_pk_bf16(x0[2], x0[3]); w.z = cvt_pk_bf16(x1[0], x1[1]); w.w = cvt_pk_bf16(x1[2], x1[3]);
                *(u32x4*)(MIX + (size_t)(b * SEQ + c * 64 + row) * DM + h * 128 + dq * 32 + c8) = w; }
        }
#undef HG_LOAD
        __syncthreads();
    }
}

__device__ __forceinline__ float sum8(float v) { v += __shfl_xor(v, 1); v += __shfl_xor(v, 2); v += __shfl_xor(v, 4); return v; }
__device__ __forceinline__ u32x4 pack8f(const float* f) { u32x4 w; w.x = cvt_pk_bf16(f[0], f[1]); w.y = cvt_pk_bf16(f[2], f[3]); w.z = cvt_pk_bf16(f[4], f[5]); w.w = cvt_pk_bf16(f[6], f[7]); return w; }

__device__ __forceinline__ void p5_phase(Frame& F, const Args& a) {
    const int gw = F.vcu * NWAVES + F.wave, NGW = F.G * NWAVES;
    const bf16_t* PROJ = (const bf16_t*)(F.ws + WS_A);
    const bf16_t* QH = (const bf16_t*)(F.ws + WS_B);
    const bf16_t* KV = (const bf16_t*)(F.ws + WS_C);
    bf16_t* Qn = (bf16_t*)(F.ws + WS_D); bf16_t* Kn = (bf16_t*)(F.ws + WS_D + QN_BYTES); bf16_t* Vh = (bf16_t*)(F.ws + WS_D + 2 * QN_BYTES);
    bf16_t* MIX = (bf16_t*)(F.ws + WS_E);
    const float* rc = (const float*)(F.ws + WS_ROPEC); const float* rsn = (const float*)(F.ws + WS_ROPES);
    const float* gqn = a.in[13]; const float* gkn = a.in[14]; const float* gon = a.in[8];
    const int h = F.lane >> 3, sub = F.lane & 7;
    for (int t = gw; t < T; t += NGW) {
        const int b = t / SEQ, s = t % SEQ;
        const size_t hrow = ((size_t)(b * MH + h) * SEQ + s);
        float cs[8], sn[8];
        { const int ii = (sub & 3) * 8; const float* cp = rc + (size_t)t * 32 + ii; const float* sp = rsn + (size_t)t * 32 + ii;
#pragma unroll
          for (int j = 0; j < 8; ++j) { cs[j] = cp[j]; sn[j] = sp[j]; } }
        const float sgn = sub < 4 ? -1.f : 1.f;
        { float q[3][8]; float ss = 0.f;
#pragma unroll
          for (int i = 0; i < 3; ++i) { unpack8(*(const u32x4*)(QH + (size_t)t * (MH * MQK) + h * MQK + (sub + 8 * i) * 8), q[i]);
#pragma unroll
              for (int j = 0; j < 8; ++j) ss += q[i][j] * q[i][j]; }
          const float rs = rsqrtf(sum8(ss) * (1.f / MQK) + EPS);
#pragma unroll
          for (int i = 0; i < 3; ++i)
#pragma unroll
              for (int j = 0; j < 8; ++j) q[i][j] *= rs * gqn[(sub + 8 * i) * 8 + j];
#pragma unroll
          for (int j = 0; j < 8; ++j) { const float pv = __shfl_xor(q[2][j], 4); q[2][j] = q[2][j] * cs[j] + sgn * pv * sn[j]; }
#pragma unroll
          for (int i = 0; i < 3; ++i) *(u32x4*)(Qn + hrow * MQK + (sub + 8 * i) * 8) = pack8f(q[i]); }
        { float k[3][8]; float ss = 0.f;
#pragma unroll
          for (int i = 0; i < 2; ++i) unpack8(*(const u32x4*)(KV + (size_t)t * (MH * 256) + h * 256 + (sub + 8 * i) * 8), k[i]);
          unpack8(*(const u32x4*)(PROJ + (size_t)t * INCP + C_KPE + sub * 8), k[2]);
#pragma unroll
          for (int i = 0; i < 3; ++i)
#pragma unroll
              for (int j = 0; j < 8; ++j) ss += k[i][j] * k[i][j];
          const float rs = rsqrtf(sum8(ss) * (1.f / MQK) + EPS);
#pragma unroll
          for (int i = 0; i < 3; ++i)
#pragma unroll
              for (int j = 0; j < 8; ++j) k[i][j] *= rs * gkn[(sub + 8 * i) * 8 + j];
#pragma unroll
          for (int j = 0; j < 8; ++j) { const float pv = __shfl_xor(k[2][j], 4); k[2][j] = k[2][j] * cs[j] + sgn * pv * sn[j]; }
#pragma unroll
          for (int i = 0; i < 3; ++i) *(u32x4*)(Kn + hrow * MQK + (sub + 8 * i) * 8) = pack8f(k[i]); }
#pragma unroll
        for (int i = 0; i < 2; ++i) *(u32x4*)(Vh + hrow * MV + (sub + 8 * i) * 8) = *(const u32x4*)(KV + (size_t)t * (MH * 256) + h * 256 + 128 + (sub + 8 * i) * 8);
        { float o[2][8], gt[2][8]; float ss = 0.f;
#pragma unroll
          for (int i = 0; i < 2; ++i) { unpack8(*(const u32x4*)(MIX + (size_t)t * DM + h * 128 + (sub + 8 * i) * 8), o[i]); unpack8(*(const u32x4*)(PROJ + (size_t)t * INCP + 3 * HW + h * 128 + (sub + 8 * i) * 8), gt[i]);
#pragma unroll
              for (int j = 0; j < 8; ++j) ss += o[i][j] * o[i][j]; }
          const float rs = rsqrtf(sum8(ss) * (1.f / HDV) + EPS);
#pragma unroll
          for (int i = 0; i < 2; ++i) {
#pragma unroll
              for (int j = 0; j < 8; ++j) o[i][j] = o[i][j] * rs * gon[(sub + 8 * i) * 8 + j] * siluf(gt[i][j]);
              *(u32x4*)(MIX + (size_t)t * DM + h * 128 + (sub + 8 * i) * 8) = pack8f(o[i]); } }
    }
}
namespace att {
constexpr int QBLK = 32, KVBLK = 64, QB = 256;
constexpr int KROW = 512, SHM_K = KVBLK * KROW, SHM_V = KVBLK * MV * 2;
constexpr int OFF_V = 0, OFF_K = 2 * SHM_V, OFF_WS = OFF_K + 2 * SHM_K;
constexpr float SCALE = 0.07216878364870322f;
constexpr float THR = 8.f;
#define SBAR() __builtin_amdgcn_sched_barrier(0)
__device__ __forceinline__ int v_st(int k, int c) { const int kk = (k & ~0xC) | ((k & 4) << 1) | ((k & 8) >> 1); return ((kk >> 3) * 4 + (c >> 5)) * 512 + ((kk & 7) * 32 + (c & 31)) * 2; }
__device__ __forceinline__ int v_rd_base(int lane) { return ((lane & 3) << 3) | (((lane >> 2) & 3) << 6) | (((lane >> 4) & 1) << 5) | (((lane >> 5) & 1) << 8); }
constexpr int v_rd_off(int d0, int ks, int half) { return d0 * 512 + ks * 4096 + half * 2048; }
__device__ __forceinline__ int crow(int r, int hi) { return (r & 3) + 8 * (r >> 2) + 4 * hi; }
__device__ __forceinline__ unsigned cvtpk(float lo, float hi) { unsigned r; asm volatile("v_cvt_pk_bf16_f32 %0, %1, %2" : "=v"(r) : "v"(lo), "v"(hi)); return r; }

__device__ __forceinline__ void mask_tile(f32x16& p0, f32x16& p1, int dq) {
    const float NEG = -__builtin_inff();
#pragma unroll
    for (int r = 0; r < 16; ++r) {
        const int c = (r & 3) + 8 * (r >> 2);
        if (dq - c < 0) p0[r] = NEG;
        if (dq - c - 32 < 0) p1[r] = NEG;
    }
}
__device__ __forceinline__ void partialSM(f32x16& p0, f32x16& p1, float& m_reg, float& mn, float& alpha) {
    float pmax = p0[0];
#pragma unroll
    for (int r = 1; r < 16; ++r) pmax = fmaxf(pmax, p0[r]);
#pragma unroll
    for (int r = 0; r < 16; ++r) pmax = fmaxf(pmax, p1[r]);
    { auto rr = __builtin_amdgcn_permlane32_swap(__float_as_uint(pmax), __float_as_uint(pmax), false, false);
      pmax = fmaxf(__uint_as_float(rr[0]), __uint_as_float(rr[1])); }
    constexpr float C2 = 1.4426950408889634f * SCALE;
    if (__builtin_expect(__all((pmax - m_reg) * SCALE <= THR), 1)) { mn = m_reg; alpha = 1.f; }
    else { mn = fmaxf(m_reg, pmax); alpha = __builtin_amdgcn_exp2f((m_reg - mn) * C2); m_reg = mn; }
    const float mnL = -mn * C2;
#pragma unroll
    for (int r = 0; r < 16; ++r) p0[r] = fmaf(p0[r], C2, mnL);
#pragma unroll
    for (int r = 0; r < 16; ++r) p1[r] = fmaf(p1[r], C2, mnL);
#pragma unroll
    for (int r = 0; r < 16; ++r) p0[r] = __builtin_amdgcn_exp2f(p0[r]);
}
__device__ __forceinline__ void finishSM(f32x16& p0, f32x16& p1, float alpha, float& l_reg, bf16x8& pa0, bf16x8& pa1, bf16x8& pa2, bf16x8& pa3) {
#pragma unroll
    for (int r = 0; r < 16; ++r) p1[r] = __builtin_amdgcn_exp2f(p1[r]);
    float ps = 0;
#pragma unroll
    for (int r = 0; r < 16; ++r) ps += p0[r];
#pragma unroll
    for (int r = 0; r < 16; ++r) ps += p1[r];
    { auto rr = __builtin_amdgcn_permlane32_swap(__float_as_uint(ps), __float_as_uint(ps), false, false);
      ps = __uint_as_float(rr[0]) + __uint_as_float(rr[1]); }
    l_reg = l_reg * alpha + ps;
#define PK4(P, B_, OUT) do { unsigned a0 = cvtpk(P[B_+0], P[B_+1]), a1 = cvtpk(P[B_+2], P[B_+3]);                          \
        unsigned b0 = cvtpk(P[B_+4], P[B_+5]), b1 = cvtpk(P[B_+6], P[B_+7]);                                             \
        auto r0 = __builtin_amdgcn_permlane32_swap(a0, b0, false, false); auto r1 = __builtin_amdgcn_permlane32_swap(a1, b1, false, false); \
        u32x4 w = {r0[0], r1[0], r0[1], r1[1]}; OUT = __builtin_bit_cast(bf16x8, w); } while (0)
    PK4(p0, 0, pa0); PK4(p0, 8, pa1); PK4(p1, 0, pa2); PK4(p1, 8, pa3);
#undef PK4
}
template <int KB>
__device__ __forceinline__ void qkt(f32x16& p0, f32x16& p1, LAS unsigned char* lds, int r32, int hi, const bf16x8* qr) {
    p0 = f32x16{}; p1 = f32x16{};
    int sw = r32 & 15; asm volatile("" : "+v"(sw));
    const int rb = OFF_K + KB * SHM_K + r32 * KROW;
    int ab[8];
#pragma unroll
    for (int d = 0; d < 8; ++d) ab[d] = rb + (((2 * d + hi) ^ sw) << 4);
#pragma unroll
    for (int d0 = 0; d0 < 12; ++d0) { const int a = ab[d0 & 7] + (d0 >> 3) * 256;
        const bf16x8 b0 = *(const LAS bf16x8*)(lds + a);
        const bf16x8 b1 = *(const LAS bf16x8*)(lds + a + 32 * KROW);
        p0 = __builtin_amdgcn_mfma_f32_32x32x16_bf16(b0, qr[d0], p0, 0, 0, 0);
        p1 = __builtin_amdgcn_mfma_f32_32x32x16_bf16(b1, qr[d0], p1, 0, 0, 0); }
}
template <int VB>
__device__ __forceinline__ void pv_tile(f32x16* o, int vb0, bf16x8 pa0, bf16x8 pa1, bf16x8 pa2, bf16x8 pa3) {
#define TRRD(dst, off) asm volatile("ds_read_b64_tr_b16 %0, %1 offset:%2" : "=&v"(dst) : "v"(vb0), "i"(off) : "memory")
#define PV_D0(d0) do { s16x4 l0, l1, l2, l3, h0, h1, h2, h3; constexpr int b_ = OFF_V + VB * SHM_V + v_rd_off(d0, 0, 0); \
        TRRD(l0, b_); TRRD(h0, b_ + 2048); TRRD(l1, b_ + 4096); TRRD(h1, b_ + 6144); TRRD(l2, b_ + 8192); TRRD(h2, b_ + 10240); TRRD(l3, b_ + 12288); TRRD(h3, b_ + 14336); \
        asm volatile("s_waitcnt lgkmcnt(0)" ::: "memory"); SBAR();   \
        o[d0] = __builtin_amdgcn_mfma_f32_32x32x16_bf16(pa0, (bf16x8){l0[0], l0[1], l0[2], l0[3], h0[0], h0[1], h0[2], h0[3]}, o[d0], 0, 0, 0);   \
        o[d0] = __builtin_amdgcn_mfma_f32_32x32x16_bf16(pa1, (bf16x8){l1[0], l1[1], l1[2], l1[3], h1[0], h1[1], h1[2], h1[3]}, o[d0], 0, 0, 0);   \
        o[d0] = __builtin_amdgcn_mfma_f32_32x32x16_bf16(pa2, (bf16x8){l2[0], l2[1], l2[2], l2[3], h2[0], h2[1], h2[2], h2[3]}, o[d0], 0, 0, 0);   \
        o[d0] = __builtin_amdgcn_mfma_f32_32x32x16_bf16(pa3, (bf16x8){l3[0], l3[1], l3[2], l3[3], h3[0], h3[1], h3[2], h3[3]}, o[d0], 0, 0, 0); } while (0)
    PV_D0(0); PV_D0(1); PV_D0(2); PV_D0(3);
#undef PV_D0
#undef TRRD
}

__device__ __forceinline__ void attn_block(const bf16_t* Q, const bf16_t* K, const bf16_t* V, bf16_t* O, int P0, const float* gon, LAS unsigned char* lds) {
    const int tid = threadIdx.x, wid = __builtin_amdgcn_readfirstlane(tid >> 6), lane = tid & 63, r32 = lane & 31, hi = lane >> 5;
    const int NT = P0 / KVBLK + 4;
    const int qlo = P0 + wid * QBLK, qm = qlo + r32 - 4 * hi;
    LAS float* wsf = (LAS float*)(lds + OFF_WS) + wid * 64; LAS float* li_l = wsf; LAS float* al_l = wsf + 32;
    float m_reg = -1e30f, l_reg = 0.f; f32x16 o[4] = {};
    bf16x8 qr[12];
#pragma unroll
    for (int d0 = 0; d0 < 12; ++d0) qr[d0] = *(const bf16x8*)(Q + (size_t)(qlo + r32) * MQK + d0 * 16 + hi * 8);
    int ksrc[4], vsrc[2];
#pragma unroll
    for (int i = 0; i < 4; ++i) { const int row = 2 * (wid * 4 + i) + (lane >> 5), c = (lane & 31) ^ (row & 15); ksrc[i] = row * MQK + (c < 24 ? c : 0) * 8; }
#pragma unroll
    for (int i = 0; i < 2; ++i) { const int id = (wid * 2 + i) * 2 + (lane >> 5), kk = ((id >> 2) << 3) | ((lane & 31) >> 2), k = (kk & ~0xC) | ((kk & 4) << 1) | ((kk & 8) >> 1);
        vsrc[i] = k * MV + (id & 3) * 32 + (lane & 3) * 8; }
    const int vb0 = (int)(unsigned)(uintptr_t)lds + v_rd_base(lane);
#define ALOAD(t, bf) do { const bf16_t* kp = K + (size_t)(t) * KVBLK * MQK; const bf16_t* vp = V + (size_t)(t) * KVBLK * MV; \
        _Pragma("unroll") for (int i = 0; i < 4; ++i) __builtin_amdgcn_global_load_lds((const unsigned*)(kp + ksrc[i]), (LAS unsigned*)(lds + OFF_K + (bf) * SHM_K + (wid * 4 + i) * 1024), 16, 0, 0); \
        _Pragma("unroll") for (int i = 0; i < 2; ++i) __builtin_amdgcn_global_load_lds((const unsigned*)(vp + vsrc[i]), (LAS unsigned*)(lds + OFF_V + (bf) * SHM_V + (wid * 2 + i) * 1024), 16, 0, 0); } while (0)
#define RESC(a) do { if (__any((a) < 1.f)) { if (hi == 0) al_l[r32] = (a); asm volatile("s_waitcnt lgkmcnt(0)" ::: "memory"); \
        _Pragma("unroll") for (int d_ = 0; d_ < 4; ++d_) _Pragma("unroll") for (int r = 0; r < 16; ++r) o[d_][r] *= al_l[crow(r, hi)]; } } while (0)
#define STEP(t, BF) do { f32x16 p0, p1; float mn, al; bf16x8 pa0, pa1, pa2, pa3; \
        if ((t) + 1 < NT) ALOAD((t) + 1, 1 - (BF)); \
        SBAR(); qkt<BF>(p0, p1, lds, r32, hi, qr); \
        { const int kb_ = (t) * KVBLK; if (kb_ + KVBLK - 1 > qlo) mask_tile(p0, p1, qm - kb_); } \
        partialSM(p0, p1, m_reg, mn, al); RESC(al); finishSM(p0, p1, al, l_reg, pa0, pa1, pa2, pa3); SBAR(); \
        pv_tile<BF>(o, vb0, pa0, pa1, pa2, pa3); SBAR(); \
        asm volatile("s_waitcnt vmcnt(0)" ::: "memory"); __syncthreads(); } while (0)
    ALOAD(0, 0); asm volatile("s_waitcnt vmcnt(0)" ::: "memory"); __syncthreads();
    for (int t = 0; t < NT; t += 2) { STEP(t, 0); STEP(t + 1, 1); }
#undef STEP
#undef RESC
#undef ALOAD
    if (hi == 0) li_l[r32] = l_reg;
    asm volatile("s_waitcnt lgkmcnt(0)" ::: "memory");
    float gv[4];
#pragma unroll
    for (int d0 = 0; d0 < 4; ++d0) gv[d0] = gon[d0 * 32 + r32];
#pragma unroll
    for (int r = 0; r < 16; ++r) { const float rl = 1.f / li_l[crow(r, hi)];
        float ss = 0.f;
#pragma unroll
        for (int d0 = 0; d0 < 4; ++d0) { o[d0][r] *= rl; ss += o[d0][r] * o[d0][r]; }
        ss += __shfl_xor(ss, 1); ss += __shfl_xor(ss, 2); ss += __shfl_xor(ss, 4); ss += __shfl_xor(ss, 8); ss += __shfl_xor(ss, 16);
        const float rs = rsqrtf(ss * (1.f / MV) + EPS);
        bf16_t* orow = O + (size_t)(qlo + crow(r, hi)) * DM;
#pragma unroll
        for (int d0 = 0; d0 < 4; ++d0) { const float v = o[d0][r] * rs * gv[d0]; const float vn = __shfl_xor(v, 1);
            if ((r32 & 1) == 0) *(unsigned*)(orow + d0 * 32 + r32) = cvtpk(v, vn); } }
    __syncthreads();
}
#undef SBAR
}

__device__ __forceinline__ void p6_phase(Frame& F, const Args& a) {
    const bf16_t* Qn = (const bf16_t*)(F.ws + WS_D); const bf16_t* Kn = (const bf16_t*)(F.ws + WS_D + QN_BYTES); const bf16_t* Vh = (const bf16_t*)(F.ws + WS_D + 2 * QN_BYTES);
    bf16_t* MIX = (bf16_t*)(F.ws + WS_E);
    for (int it = F.vcu; it < NB * MH * 4; it += F.G) {
        const int bh = it >> 2, j = it & 3, b = bh >> 3, h = bh & 7;
        const bf16_t* Q = Qn + (size_t)bh * SEQ * MQK; const bf16_t* K = Kn + (size_t)bh * SEQ * MQK; const bf16_t* V = Vh + (size_t)bh * SEQ * MV;
        bf16_t* O = MIX + (size_t)(b * SEQ) * DM + HW + h * MV;
        att::attn_block(Q, K, V, O, (7 - j) * att::QB, a.in[15], F.lds);
        att::attn_block(Q, K, V, O, j * att::QB, a.in[15], F.lds);
    }
}
constexpr int P8_RS = DM + 4;
__device__ __forceinline__ void p8_phase(Frame& F, const Args& a) {
    unsigned char* ws = F.ws;
    const float* x1 = F.out; const float* mod = (const float*)(ws + WS_MOD); const float* g2n = a.in[17];
    const float* wct = (const float*)(ws + WS_WCT);
    bf16_t* H2 = (bf16_t*)(ws + WS_B);
    int* tok_e = (int*)(ws + WS_TOKE); float* tok_w = (float*)(ws + WS_TOKW); int* tok_s = (int*)(ws + WS_TOKS);
    LAS float* xs = (LAS float*)F.lds;
    LAS float* red = (LAS float*)F.lds;
    LAS float* lg = (LAS float*)(F.lds + 24576);
    LAS float* rstd_l = (LAS float*)(F.lds + 16 * P8_RS * 4);
    const int row_l = F.tid >> 5, c_l = (F.tid & 31) * 4;
    const int mr = F.lane & 15, mg = F.lane >> 4;
    for (int tile = F.vcu; tile < T / 16; tile += F.G) {
        const int m0 = tile * 16, b = m0 / SEQ;
        { const float* xr = x1 + (size_t)(m0 + row_l) * DM + c_l; float ss = 0.f;
#pragma unroll
          for (int j = 0; j < 16; ++j) { const f32x4 v = *(const f32x4*)(xr + 128 * j); ss += (v.x * v.x + v.y * v.y) + (v.z * v.z + v.w * v.w); *(LAS f32x4*)(xs + row_l * P8_RS + c_l + 128 * j) = v; }
          ss += __shfl_xor(ss, 1); ss += __shfl_xor(ss, 2); ss += __shfl_xor(ss, 4); ss += __shfl_xor(ss, 8); ss += __shfl_xor(ss, 16);
          if ((F.tid & 31) == 0) rstd_l[row_l] = rsqrtf(ss * (1.f / DM) + EPS); }
        __syncthreads();
        f32x4 acc[3];
#pragma unroll
        for (int n = 0; n < 3; ++n) acc[n] = (f32x4){0.f, 0.f, 0.f, 0.f};
        { const float rs = rstd_l[mr]; const float* sh2 = mod + b * (6 * DM) + 3 * DM; const float* sc2 = mod + b * (6 * DM) + 4 * DM;
#pragma unroll 2
          for (int s = 0; s < 16; ++s) { const int k0 = F.wave * 256 + 16 * s + 4 * mg;
              const f32x4 xv = *(const LAS f32x4*)(xs + mr * P8_RS + k0);
              const f32x4 gg = *(const f32x4*)(g2n + k0), sc = *(const f32x4*)(sc2 + k0), sh = *(const f32x4*)(sh2 + k0);
              const f32x4 hv = xv * rs * gg * (sc + 1.f) + sh;
              u32x2 w; w.x = cvt_pk_bf16(hv.x, hv.y); w.y = cvt_pk_bf16(hv.z, hv.w);
              *(u32x2*)(H2 + (size_t)(m0 + mr) * DM + k0) = w;
              f32x4 bw[3];
#pragma unroll
              for (int n = 0; n < 3; ++n) bw[n] = *(const f32x4*)(wct + (size_t)(n * 16 + mr) * DM + k0);
#pragma unroll
              for (int i = 0; i < 4; ++i)
#pragma unroll
                  for (int n = 0; n < 3; ++n) acc[n] = __builtin_amdgcn_mfma_f32_16x16x4f32(hv[i], bw[n][i], acc[n], 0, 0, 0); } }
        __syncthreads();
#pragma unroll
        for (int n = 0; n < 3; ++n)
#pragma unroll
            for (int r = 0; r < 4; ++r) red[(F.wave * 16 + mg * 4 + r) * 48 + n * 16 + mr] = acc[n][r];
        __syncthreads();
        for (int idx = F.tid; idx < 16 * 36; idx += NTHR) { const int row = idx / 36, n = idx % 36; float s = n < 4 ? a.in[19][n] : a.in[21][n - 4];
#pragma unroll
            for (int w = 0; w < 8; ++w) s += red[(w * 16 + row) * 48 + n];
            lg[row * 36 + n] = s; }
        __syncthreads();
        if (F.tid < 16) { const LAS float* l = lg + F.tid * 36; const int t = m0 + F.tid;
            int g = 0; float gm = l[0];
#pragma unroll
            for (int j = 1; j < 4; ++j) if (l[j] > gm) { gm = l[j]; g = j; }
            float den = 0.f;
#pragma unroll
            for (int j = 0; j < 4; ++j) den += __expf(l[j] - gm);
            const float pg = 1.f / den;
            const LAS float* e = l + 4 + g * 8;
            int i1 = 0; float v1 = e[0];
#pragma unroll
            for (int j = 1; j < 8; ++j) if (e[j] > v1) { v1 = e[j]; i1 = j; }
            int i2 = -1; float v2 = -__builtin_inff();
#pragma unroll
            for (int j = 0; j < 8; ++j) if (j != i1 && e[j] > v2) { v2 = e[j]; i2 = j; }
            const float w1 = 1.f / (1.f + __expf(v2 - v1)), w2 = 1.f - w1;
            const int e1 = g * 8 + i1, e2 = g * 8 + i2;
            const int s1 = (int)atomicAdd((unsigned*)(F.ctl + CW_CNT + 64 * e1), 1u), s2 = (int)atomicAdd((unsigned*)(F.ctl + CW_CNT + 64 * e2), 1u);
            tok_e[2 * t] = e1; tok_e[2 * t + 1] = e2; tok_w[2 * t] = pg * w1; tok_w[2 * t + 1] = pg * w2; tok_s[2 * t] = s1; tok_s[2 * t + 1] = s2; }
        __syncthreads();
    }
    LAS float* scr = (LAS float*)(F.lds + F.wave * 16384);
    const int gw = F.vcu * NWAVES + F.wave, NGW = F.G * NWAVES;
    constexpr int I_G = NE * (DM / 64) * (DE / 32);
    for (int it = gw; it < 3 * I_G; it += NGW) {
        const int which = it / I_G, r = it % I_G;
        if (which < 2) { const int e = r / 512, q = r % 512, kb = q / 16, nb = q % 16, n0 = 32 * nb;
            const float* W = a.in[22 + which] + (size_t)e * DM * DE;
            bf16_t* dst = (bf16_t*)(ws + WS_D) + ((size_t)e * 1024 + (n0 >> 7) * 256 + (n0 & 127) + which * 128) * DM;
            transpose_item(W, DE, 64 * kb, n0, dst, DM, nullptr, scr, F.lane); }
        else { const int e = r / 512, q = r % 512, kb = q / 64, nb = q % 64, n0 = 32 * nb;
            const float* W = a.in[24] + (size_t)e * DE * DM;
            bf16_t* dst = (bf16_t*)(ws + WS_E) + ((size_t)e * DM + n0) * DE;
            transpose_item(W, DM, 64 * kb, n0, dst, DE, nullptr, scr, F.lane); }
    }
}

__device__ __forceinline__ void p9_phase(Frame& F, const Args& a) {
    unsigned char* ws = F.ws;
    LAS int* pstart = (LAS int*)F.lds;
    if (F.tid == 0) { int acc = 0;
        for (int e = 0; e < NE; ++e) { pstart[e] = acc; const int c = (int)__hip_atomic_load((unsigned*)(F.ctl + CW_CNT + 64 * e), RLX_AGENT); acc += ((c + 255) / 256) * 256; }
        pstart[NE] = acc; }
    __syncthreads();
    if (blockIdx.x == 0) { int* blk_e = (int*)(ws + WS_BLKE); const int ntile = pstart[NE] / 256;
        if (F.tid < 255) { int e = 0; for (int j = 1; j < NE; ++j) if (pstart[j] <= F.tid * 256) e = j; blk_e[F.tid] = e; }
        if (F.tid == 255) blk_e[255] = ntile; }
    const bf16_t* H2 = (const bf16_t*)(ws + WS_B); bf16_t* XB = (bf16_t*)(ws + WS_A);
    const int* tok_e = (const int*)(ws + WS_TOKE); int* tok_s = (int*)(ws + WS_TOKS);
    const int gw = F.vcu * NWAVES + F.wave, NGW = F.G * NWAVES;
    for (int t = gw; t < T; t += NGW) {
        const int d0 = pstart[tok_e[2 * t]] + tok_s[2 * t], d1 = pstart[tok_e[2 * t + 1]] + tok_s[2 * t + 1];
        const u32x4* src = (const u32x4*)(H2 + (size_t)t * DM) + F.lane;
        u32x4* o0 = (u32x4*)(XB + (size_t)d0 * DM) + F.lane; u32x4* o1 = (u32x4*)(XB + (size_t)d1 * DM) + F.lane;
#pragma unroll
        for (int j = 0; j < 4; ++j) { const u32x4 v = src[64 * j]; o0[64 * j] = v; o1[64 * j] = v; }
        if (F.lane == 0) { tok_s[2 * t] = d0; tok_s[2 * t + 1] = d1; }
    }
}

__device__ __forceinline__ void p12_phase(Frame& F, const Args& a) {
    unsigned char* ws = F.ws;
    const bf16_t* Y = (const bf16_t*)(ws + WS_A);
    const float* tok_w = (const float*)(ws + WS_TOKW); const int* tok_s = (const int*)(ws + WS_TOKS);
    const float* mod = (const float*)(ws + WS_MOD);
    const int gw = F.vcu * NWAVES + F.wave, NGW = F.G * NWAVES;
    for (int t = gw; t < T; t += NGW) {
        const int b = t / SEQ; const float w0 = tok_w[2 * t], w1 = tok_w[2 * t + 1]; const int d0 = tok_s[2 * t], d1 = tok_s[2 * t + 1];
        const float* g2 = mod + b * (6 * DM) + 5 * DM;
        float* orow = F.out + (size_t)t * DM;
#pragma unroll
        for (int j = 0; j < 4; ++j) { const int c = (j * 64 + F.lane) * 8;
            float y0[8], y1[8]; unpack8(*(const u32x4*)(Y + (size_t)d0 * DM + c), y0); unpack8(*(const u32x4*)(Y + (size_t)d1 * DM + c), y1);
            const f32x4 xa = *(const f32x4*)(orow + c), xb = *(const f32x4*)(orow + c + 4), ga = *(const f32x4*)(g2 + c), gb = *(const f32x4*)(g2 + c + 4);
            f32x4 ra, rb;
#pragma unroll
            for (int i = 0; i < 4; ++i) { ra[i] = xa[i] + ga[i] * (w0 * y0[i] + w1 * y1[i]); rb[i] = xb[i] + gb[i] * (w0 * y0[4 + i] + w1 * y1[4 + i]); }
            *(f32x4*)(orow + c) = ra; *(f32x4*)(orow + c + 4) = rb; }
    }
}
#ifndef MK_MULTI
#define MK_MULTI 0
#endif
#ifndef MK_LAST_PHASE
#define MK_LAST_PHASE 12
#endif
constexpr int N_PHASES = MK_LAST_PHASE + 1;

template <class P> __device__ __forceinline__ P* uptr(P* p) { const unsigned long long v = (unsigned long long)p;
    const unsigned lo = __builtin_amdgcn_readfirstlane((unsigned)v), hi = __builtin_amdgcn_readfirstlane((unsigned)(v >> 32)); return (P*)(((unsigned long long)hi << 32) | lo); }
__global__ void __launch_bounds__(NTHR, 2) mk_fwd(const Args args) {
    extern __shared__ __attribute__((aligned(16))) unsigned char lds_raw[];
    Frame F;
    F.lds = (LAS unsigned char*)lds_raw;
    F.MISC = (volatile LAS unsigned*)(F.lds + MISC_OFF);
    F.tid = threadIdx.x; F.lane = F.tid & 63; F.wave = __builtin_amdgcn_readfirstlane(F.tid >> 6);
    F.G = gridDim.x; { const int bx = blockIdx.x; F.vcu = (F.G % 8 == 0) ? (bx % 8) * (F.G / 8) + bx / 8 : bx; }
    F.ws = uptr(args.ws); F.out = uptr(args.out);
    F.ctl = (gu32*)(F.ws + WS_CTL);
    for (int u = F.tid; u < (LDS_BYTES - RING_BYTES) / 4; u += NTHR) ((LAS unsigned*)(F.lds + RING_BYTES))[u] = 0u;
    __syncthreads();
    XcdBarrier bar; bar.bar = (unsigned*)(F.ctl + CW_BAR); bar.x = 0; bar.st = nullptr;
#if !MK_MULTI
    bar = xcd_barrier_post((unsigned*)(F.ctl + CW_BAR), F.MISC + 8);
#define GRID_BAR() xcd_barrier(bar)
#else
#define GRID_BAR() do { } while (0)
#endif
    const int lo = args.ph_lo, hi = args.ph_hi;
#ifndef MK_PHMASK
#define MK_PHMASK 0xFFFF
#endif
#define IN(k) (((MK_PHMASK >> (k)) & 1) && lo <= (k) && (k) < hi)
#define SEAM(k) do { if (IN(k) && IN((k) + 1)) GRID_BAR(); } while (0)
    unsigned char* const ws = F.ws;

    if (IN(0)) { p0_phase(F, args); } SEAM(0);
    if (IN(1)) { p1_phase(F, args); } SEAM(1);
    if (IN(2)) {
        pg8::Gemm g{(const bf16_t*)(ws + WS_B), (const bf16_t*)(ws + WS_WIN), DM, DM, DM};
        pg8::DenseOrder S; S.init(T / 256, INCP / 256, F.G, (int)blockIdx.x);
        pg8::EpiStore E{(bf16_t*)(ws + WS_A), INCP, nullptr};
        pg8::gemm_phase<pg8::EpiStore, pg8::DenseOrder>(F.lds, g, S, E);
    } SEAM(2);
    if (IN(3)) { p3_phase(F, args); } SEAM(3);
    if (IN(4)) {
        { pg8::Gemm g{(const bf16_t*)(ws + WS_A) + C_QA, (const bf16_t*)(ws + WS_WQUP), INCP, QLORA, QLORA};
          pg8::DenseOrder S; S.init(T / 256, MH * MQK / 256, F.G, (int)blockIdx.x);
          pg8::EpiStore E{(bf16_t*)(ws + WS_B), MH * MQK, (const float*)(ws + WS_RSTDQ)};
          pg8::gemm_phase<pg8::EpiStore, pg8::DenseOrder>(F.lds, g, S, E); }
        { pg8::Gemm g{(const bf16_t*)(ws + WS_A) + C_KVA, (const bf16_t*)(ws + WS_WKVUP), INCP, KVLORA, KVLORA};
          pg8::DenseOrder S; S.init(T / 256, MH * 256 / 256, F.G, (int)blockIdx.x);
          pg8::EpiStore E{(bf16_t*)(ws + WS_C), MH * 256, (const float*)(ws + WS_RSTDKV)};
          pg8::gemm_phase<pg8::EpiStore, pg8::DenseOrder>(F.lds, g, S, E); }
    } SEAM(4);
    if (IN(5)) { p5_phase(F, args); } SEAM(5);
    if (IN(6)) { p6_phase(F, args); } SEAM(6);
    if (IN(7)) {
        pg8::Gemm g{(const bf16_t*)(ws + WS_E), (const bf16_t*)(ws + WS_WOUT), DM, DM, DM};
        pg8::DenseOrder S; S.init(T / 256, DM / 256, F.G, (int)blockIdx.x);
        pg8::EpiResid E{args.in[0], F.out, (const float*)(ws + WS_MOD) + 2 * DM, 6 * DM};
        pg8::gemm_phase<pg8::EpiResid, pg8::DenseOrder>(F.lds, g, S, E);
    } SEAM(7);
#if MK_LAST_PHASE >= 8
    if (IN(8)) { p8_phase(F, args); } SEAM(8);
    if (IN(9)) { p9_phase(F, args); } SEAM(9);
    if (IN(10)) {
        const int* blk_e = (const int*)(ws + WS_BLKE); const int ntile = blk_e[255];
        pg8::Gemm g{(const bf16_t*)(ws + WS_A), (const bf16_t*)(ws + WS_D), DM, DM, DM};
        pg8::GroupedOrder S; S.init(ntile, 4, F.G, F.vcu, blk_e);
        pg8::EpiSwiGLU E{(bf16_t*)(ws + WS_C)};
        pg8::gemm_phase<pg8::EpiSwiGLU, pg8::GroupedOrder>(F.lds, g, S, E);
    } SEAM(10);
    if (IN(11)) {
        const int* blk_e = (const int*)(ws + WS_BLKE); const int ntile = blk_e[255];
        pg8::Gemm g{(const bf16_t*)(ws + WS_C), (const bf16_t*)(ws + WS_E), DE, DE, DE};
        pg8::GroupedOrder S; S.init(ntile, 8, F.G, F.vcu, blk_e);
        pg8::EpiStore E{(bf16_t*)(ws + WS_A), DM, nullptr};
        pg8::gemm_phase<pg8::EpiStore, pg8::GroupedOrder>(F.lds, g, S, E);
    } SEAM(11);
    if (IN(12)) { p12_phase(F, args); }
#endif
#undef IN
#undef SEAM
}

extern "C" void kernel_launch(void* const* d_in, const int* in_sizes, int n_in, void* d_out, int out_size, void* d_ws, size_t ws_size, hipStream_t stream) {
    static int grid = 0;
    if (grid == 0) {
        if (n_in != 25 || out_size != T * DM || ws_size < WS_END) { fprintf(stderr, "kernel_launch: bad shapes (n_in %d out %d ws %zu)\n", n_in, out_size, ws_size); grid = -1; return; }
        int dev = 0, cus = 0, per_cu = 0;
        if (hipGetDevice(&dev) != hipSuccess || hipDeviceGetAttribute(&cus, hipDeviceAttributeMultiprocessorCount, dev) != hipSuccess) { grid = -1; return; }
        if (hipFuncSetAttribute((const void*)mk_fwd, hipFuncAttributeMaxDynamicSharedMemorySize, LDS_BYTES) != hipSuccess) { fprintf(stderr, "kernel_launch: hipFuncSetAttribute failed\n"); grid = -1; return; }
        if (hipOccupancyMaxActiveBlocksPerMultiprocessor(&per_cu, (const void*)mk_fwd, NTHR, LDS_BYTES) != hipSuccess || per_cu < 1) { fprintf(stderr, "kernel_launch: occupancy query says %d\n", per_cu); }
        (void)hipGetLastError();
        grid = cus;
    }
    if (grid < 0) return;
    (void)hipMemsetAsync((char*)d_ws + WS_CTL, 0, CTL_ZERO_BYTES, stream);
    Args a{};
    for (int i = 0; i < 25; ++i) a.in[i] = (const float*)d_in[i];
    a.out = (float*)d_out; a.ws = (unsigned char*)d_ws;
#if MK_MULTI
    for (int p = 0; p < N_PHASES; ++p) { a.ph_lo = p; a.ph_hi = p + 1; hipLaunchKernelGGL(mk_fwd, dim3(grid), dim3(NTHR), LDS_BYTES, stream, a); }
#else
    a.ph_lo = 0; a.ph_hi = N_PHASES; hipLaunchKernelGGL(mk_fwd, dim3(grid), dim3(NTHR), LDS_BYTES, stream, a);
#endif
}
```

```cpp
#include <hip/hip_runtime.h>
#include <cstdio>
#include <cstdint>

#define GAS __attribute__((address_space(1)))
#define LAS __attribute__((address_space(3)))
typedef unsigned short bf16_t;
typedef short bf16x8 __attribute__((ext_vector_type(8)));
typedef short s16x4 __attribute__((ext_vector_type(4)));
typedef float f32x4 __attribute__((ext_vector_type(4)));
typedef float f32x2 __attribute__((ext_vector_type(2)));
typedef float f32x16 __attribute__((ext_vector_type(16)));
typedef unsigned u32x4 __attribute__((ext_vector_type(4)));
typedef unsigned u32x2 __attribute__((ext_vector_type(2)));
typedef GAS unsigned gu32;
#define RLX_AGENT __ATOMIC_RELAXED, __HIP_MEMORY_SCOPE_AGENT
#define LDS_WAIT() asm volatile("s_waitcnt lgkmcnt(0)" ::: "memory")
#define VM_WAIT() asm volatile("s_waitcnt vmcnt(0)" ::: "memory")

constexpr int DM = 2048, NB = 8, SEQ = 2048, T = NB * SEQ;
constexpr int HW = 1024, HH = 8, HDK = 128, HDV = 128;
constexpr int MH = 8, MNOPE = 128, MROPE = 64, MQK = 192, MV = 128, QLORA = 512, KVLORA = 256;
constexpr int INC = 4 * HW + QLORA + KVLORA + MROPE;
constexpr int INCP = 5120;
constexpr int C_QA = 4096, C_KVA = 4608, C_KPE = 4864;
constexpr int NG = 4, EPG = 8, NE = 32, DE = 512;
constexpr int RMAX = (T * 2 / 256 + NE) * 256;
constexpr float EPS = 1e-6f;
constexpr int NWAVES = 8, NTHR = 512;

__device__ __forceinline__ unsigned cvt_pk_bf16(float lo, float hi) { unsigned r; asm volatile("v_cvt_pk_bf16_f32 %0, %1, %2" : "=v"(r) : "v"(lo), "v"(hi)); return r; }
__device__ __forceinline__ float bf_lo(unsigned w) { return __builtin_bit_cast(float, w << 16); }
__device__ __forceinline__ float bf_hi(unsigned w) { return __builtin_bit_cast(float, w & 0xffff0000u); }
__device__ __forceinline__ float bf2f(bf16_t h) { return __builtin_bit_cast(float, (unsigned)h << 16); }
__device__ __forceinline__ float wave_sum(float v) {
#pragma unroll
    for (int o = 1; o < 64; o <<= 1) v += __shfl_xor(v, o);
    return v;
}
__device__ __forceinline__ float siluf(float v) { return v / (1.f + __expf(-v)); }

#define XB_TMO      128
#define XB_XCNT(j)  (256  + 64 * (j))
#define XB_XSUB(j)  (1280 + 64 * (j))
#define XB_XGEN(j)  (2304 + 64 * (j))
#define XB_TOP      3328
#define XB_TOPGEN   3392
#define XCD_BAR_WORDS 3456
#define XB_SPIN_CAP (1u << 18)

__device__ __forceinline__ unsigned xb_ld(unsigned* p)              { return __hip_atomic_load(p, __ATOMIC_RELAXED, __HIP_MEMORY_SCOPE_AGENT); }
__device__ __forceinline__ unsigned xb_add(unsigned* p, unsigned v) { return __hip_atomic_fetch_add(p, v, __ATOMIC_RELAXED, __HIP_MEMORY_SCOPE_AGENT); }
__device__ __forceinline__ unsigned xb_xcc_id() { return (unsigned)__builtin_amdgcn_s_getreg((3 << 11) | 20) & 0xFu; }
#define XB_SPIN(cond, bar) do { unsigned _sp = 0; while (cond) { __builtin_amdgcn_s_sleep(1); \
    if ((++_sp & 255u) == 0u) { if (xb_ld(&(bar)[XB_TMO])) break; if (_sp > XB_SPIN_CAP) { atomicAdd(&(bar)[XB_TMO], 1u); break; } } } } while (0)

struct XcdBarrier {
    unsigned* bar; unsigned x;
    volatile LAS unsigned* st;
};
__device__ __forceinline__ XcdBarrier xcd_barrier_post(unsigned* bar, volatile LAS unsigned* st) {
    XcdBarrier b; b.bar = bar; b.x = xb_xcc_id(); b.st = st;
    if (threadIdx.x == 0) (void)xb_add(&bar[XB_XCNT(b.x)], 1u);
    return b;
}
__device__ __forceinline__ void xcd_barrier_complete(unsigned* bar, unsigned x, unsigned& nloc, unsigned& nx) {
    const unsigned G = gridDim.x * gridDim.y * gridDim.z;
    unsigned sum, cnt, mine, sp = 0u;
    for (;;) {
        sum = 0u; cnt = 0u; mine = 0u;
#pragma unroll
        for (unsigned j = 0; j < 16; ++j) { const unsigned c = xb_ld(&bar[XB_XCNT(j)]); sum += c; cnt += (c > 0u) ? 1u : 0u; mine = (j == x) ? c : mine; }
        if (sum == G) break;
        __builtin_amdgcn_s_sleep(1);
        if ((++sp & 255u) == 0u) { if (xb_ld(&bar[XB_TMO])) break; if (sp > XB_SPIN_CAP) { atomicAdd(&bar[XB_TMO], 1u); break; } }
    }
    nloc = mine > 0u ? mine : 1u; nx = cnt > 0u ? cnt : 1u;
}
__device__ __forceinline__ void xcd_barrier(const XcdBarrier& b) {
    asm volatile("s_waitcnt vmcnt(0)" ::: "memory");
    __syncthreads();
    if (threadIdx.x == 0) {
        unsigned* bar = b.bar;
        __builtin_amdgcn_s_waitcnt(0);
        unsigned nloc = b.st[0], nx = b.st[1];
        if (nloc == 0u) { xcd_barrier_complete(bar, b.x, nloc, nx); b.st[0] = nloc; b.st[1] = nx; }
        const unsigned old = xb_add(&bar[XB_XSUB(b.x)], 1u);
        const unsigned gen = old / nloc;
        if (old + 1u == (gen + 1u) * nloc) {
            __builtin_amdgcn_fence(__ATOMIC_RELEASE, "agent");
            asm volatile("s_waitcnt vmcnt(0)" ::: "memory");
            const unsigned og = xb_add(&bar[XB_TOP], 1u);
            const unsigned tg = og / nx;
            if (og + 1u == (tg + 1u) * nx) xb_add(&bar[XB_TOPGEN], 1u);
            else XB_SPIN(xb_ld(&bar[XB_TOPGEN]) == tg, bar);
            __builtin_amdgcn_fence(__ATOMIC_ACQUIRE, "agent");
            xb_add(&bar[XB_XGEN(b.x)], 1u);
            asm volatile("s_waitcnt vmcnt(0)" ::: "memory");
        } else {
            XB_SPIN(xb_ld(&bar[XB_XGEN(b.x)]) == gen, bar);
            __builtin_amdgcn_fence(__ATOMIC_ACQUIRE, "agent");
            asm volatile("s_waitcnt vmcnt(0)" ::: "memory");
        }
    }
    __syncthreads();
}

namespace pg8 {
constexpr int BM = 256, BK = 64, HALF = 128, HTB = HALF * BK * 2, STAGE_BYTES = 8 * HTB, NXCD = 8, WGM = 8;
__host__ __device__ __forceinline__ int lds_byte(int r, int c) { const int st = (r >> 4) * 2 + (c >> 5), rr = r & 15, cc = c & 31, ob = rr * 64 + cc * 2; return st * 1024 + (ob ^ (((ob >> 9) & 1) << 5)); }
__host__ __device__ __forceinline__ void stage_rc(int b, int& R, int& C) { const int st = b / 1024, sb = b % 1024, swz = sb ^ (((sb >> 9) & 1) << 5); R = (st >> 1) * 16 + swz / 64; C = (st & 1) * 32 + (swz % 64) / 2; }
__host__ __device__ __forceinline__ int perm32(int rho) { const int n = rho >> 4, i = rho & 15; return 8 * (i >> 2) + 4 * n + (i & 3); }

struct Unit { int pm, pn, pb; };
struct Gemm { const bf16_t* A; const bf16_t* Bt; int lda, ldb, K; };

struct DenseOrder {
    int nM, nN, nwg, G, c;
    __device__ void init(int nM_, int nN_, int G_, int c_) { nM = nM_; nN = nN_; nwg = nM * nN; G = G_; c = c_; }
    __device__ bool next(int i, Unit& u) const {
        const long L = (long)i * G + c; if (L >= nwg) return false;
        int wgid = (int)L; { const int q = nwg / NXCD, r = nwg % NXCD, xcd = wgid % NXCD, off = wgid / NXCD; wgid = (xcd < r ? xcd * (q + 1) : r * (q + 1) + (xcd - r) * q) + off; }
        const int nig = WGM * nN, gid = wgid / nig, fm = gid * WGM, gsz = (nM - fm) < WGM ? (nM - fm) : WGM;
        u.pm = fm + ((wgid % nig) % gsz); u.pn = (wgid % nig) / gsz; u.pb = u.pn; return true;
    }
};
struct GroupedOrder {
    int nM, nN, nwg, G, c; const int* blk_e;
    __device__ void init(int nM_, int nN_, int G_, int c_, const int* be) { nM = nM_; nN = nN_; nwg = nM * nN; G = G_; c = c_; blk_e = be; }
    __device__ bool next(int i, Unit& u) const {
        const long L = (long)i * G + c; if (L >= nwg) return false;
        const int w = (int)L; u.pn = w % nN; u.pm = w / nN; u.pb = blk_e[u.pm] * nN + u.pn; return true;
    }
};

template <class Epi, class Sched>
__device__ __forceinline__ void gemm_phase(LAS unsigned char* lds, const Gemm g, const Sched& S, const Epi& E) {
    int tid = threadIdx.x; asm volatile("" : "+v"(tid));
    const int wid = __builtin_amdgcn_readfirstlane(tid >> 6), lane = tid & 63, wr = wid >> 2, wc = wid & 3, fr = lane & 15, fq = lane >> 4;
    const int K = g.K, nt = K / BK;
    unsigned voffA[2], voffB[2];
#pragma unroll
    for (int i = 0; i < 2; ++i) { int R, C; stage_rc(tid * 16 + i * 8192, R, C); const int Rb = (R & ~31) + perm32(R & 31);
        voffA[i] = (unsigned)(R * g.lda + C) * 2u; voffB[i] = (unsigned)(Rb * g.ldb + C) * 2u; }
    const size_t kstep = (size_t)(BK * 2);
    const size_t hsA = (size_t)HALF * g.lda * 2, hsB = (size_t)HALF * g.ldb * 2;
    const unsigned ldsw = (unsigned)wid * 1024u;
    const int aoff = lds_byte(wr * 64 + fr, fq * 8), boff = lds_byte(wc * 32 + fr, fq * 8);
#define PG8_SA(b, h) (((b) * 2 + (h)) * HTB)
#define PG8_SB(b, h) ((4 + (b) * 2 + (h)) * HTB)
#define PG8_STAGE(bufoff, gbase, voff) do { _Pragma("unroll") for (int _i = 0; _i < 2; ++_i) \
        __builtin_amdgcn_global_load_lds((const unsigned*)((const char*)(gbase) + (voff)[_i]), (LAS unsigned*)(lds + (bufoff) + ldsw + _i * 8192), 16, 0, 0); } while (0)
#define PG8_LDA(dst, b, h) do { _Pragma("unroll") for (int m = 0; m < 4; ++m) _Pragma("unroll") for (int k = 0; k < 2; ++k) dst[m][k] = *(const LAS bf16x8*)(lds + PG8_SA(b, h) + aoff + m * 2048 + k * 1024); } while (0)
#define PG8_LDB(dst, b, h) do { _Pragma("unroll") for (int n = 0; n < 2; ++n) _Pragma("unroll") for (int k = 0; k < 2; ++k) dst[n][k] = *(const LAS bf16x8*)(lds + PG8_SB(b, h) + boff + n * 2048 + k * 1024); } while (0)
#define PG8_MMA(ai, bj, At, Bt) do { __builtin_amdgcn_s_setprio(1); _Pragma("unroll") for (int m = 0; m < 4; ++m) _Pragma("unroll") for (int n = 0; n < 2; ++n) _Pragma("unroll") for (int k = 0; k < 2; ++k) \
        acc[ai][bj][m][n] = __builtin_amdgcn_mfma_f32_16x16x32_bf16(Bt[n][k], At[m][k], acc[ai][bj][m][n], 0, 0, 0); __builtin_amdgcn_s_setprio(0); } while (0)
#define PG8_WAIT_V(n) asm volatile("s_waitcnt vmcnt(" #n ")" ::: "memory")
#define PG8_WAIT_L(n) asm volatile("s_waitcnt lgkmcnt(" #n ")" ::: "memory")
#define PG8_BAR __builtin_amdgcn_s_barrier()
#define PG8_SCHED __builtin_amdgcn_sched_barrier(0)
    Unit cur, nxt; int ui = 0;
    if (!S.next(0, cur)) return;
    f32x4 acc[2][2][4][2];
#pragma unroll
    for (int a = 0; a < 2; ++a)
#pragma unroll
        for (int b = 0; b < 2; ++b)
#pragma unroll
            for (int m = 0; m < 4; ++m)
#pragma unroll
                for (int n = 0; n < 2; ++n) acc[a][b][m][n] = (f32x4){0.f, 0.f, 0.f, 0.f};
    bf16x8 At[4][2], B0[2][2], B1[2][2];
    const char* cA = (const char*)g.A + (size_t)cur.pm * 2 * hsA; const char* cB = (const char*)g.Bt + (size_t)cur.pb * 2 * hsB;
    PG8_STAGE(PG8_SB(0, 0), cB, voffB); PG8_STAGE(PG8_SB(0, 1), cB + hsB, voffB); PG8_STAGE(PG8_SA(0, 0), cA, voffA); PG8_STAGE(PG8_SA(0, 1), cA + hsA, voffA);
    if (wr == 1) PG8_BAR;
    PG8_WAIT_V(2); PG8_BAR;
    PG8_STAGE(PG8_SB(1, 0), cB + kstep, voffB); PG8_STAGE(PG8_SA(1, 0), cA + kstep, voffA); PG8_STAGE(PG8_SB(1, 1), cB + hsB + kstep, voffB);
    PG8_WAIT_V(6); PG8_BAR;
    for (;;) {
        const bool has_next = S.next(ui + 1, nxt);
        const char* nA = has_next ? (const char*)g.A + (size_t)nxt.pm * 2 * hsA : cA; const char* nB = has_next ? (const char*)g.Bt + (size_t)nxt.pb * 2 * hsB : cB;
        for (int t = 0; t < nt; t += 2) {
            const bool last = (t == nt - 2);
            const char* a1 = cA + (size_t)(t + 1) * kstep;
            const char* a2 = last ? nA : cA + (size_t)(t + 2) * kstep; const char* b2 = last ? nB : cB + (size_t)(t + 2) * kstep;
            const char* a3 = a2 + kstep; const char* b3 = b2 + kstep;
            PG8_LDB(B0, 0, 0); PG8_LDB(B1, 0, 1); PG8_SCHED; PG8_LDA(At, 0, 0); PG8_STAGE(PG8_SA(1, 1), a1 + hsA, voffA);
            PG8_WAIT_V(8); PG8_WAIT_L(0); PG8_BAR; PG8_MMA(0, 0, At, B0); PG8_MMA(0, 1, At, B1); PG8_BAR; PG8_SCHED;
            PG8_LDA(At, 0, 1); PG8_STAGE(PG8_SB(0, 0), b2, voffB); PG8_STAGE(PG8_SB(0, 1), b2 + hsB, voffB); PG8_STAGE(PG8_SA(0, 0), a2, voffA);
            PG8_WAIT_V(8); PG8_WAIT_L(0); PG8_BAR; PG8_MMA(1, 0, At, B0); PG8_MMA(1, 1, At, B1); PG8_BAR; PG8_SCHED;
            PG8_LDB(B0, 1, 0); PG8_LDB(B1, 1, 1); PG8_SCHED; PG8_LDA(At, 1, 0); PG8_STAGE(PG8_SA(0, 1), a2 + hsA, voffA);
            PG8_WAIT_V(8); PG8_WAIT_L(0); PG8_BAR; PG8_MMA(0, 0, At, B0); PG8_MMA(0, 1, At, B1); PG8_BAR; PG8_SCHED;
            PG8_LDA(At, 1, 1); PG8_STAGE(PG8_SB(1, 0), b3, voffB); PG8_STAGE(PG8_SB(1, 1), b3 + hsB, voffB); PG8_STAGE(PG8_SA(1, 0), a3, voffA);
            PG8_WAIT_V(8); PG8_WAIT_L(0); PG8_BAR; PG8_MMA(1, 0, At, B0); PG8_MMA(1, 1, At, B1); PG8_BAR; PG8_SCHED;
        }
        if (wr == 0) PG8_BAR;
        E(acc, cur, wr, wc, fr, fq);
        if (!has_next) break;
#pragma unroll
        for (int a = 0; a < 2; ++a)
#pragma unroll
            for (int b = 0; b < 2; ++b)
#pragma unroll
                for (int m = 0; m < 4; ++m)
#pragma unroll
                    for (int n = 0; n < 2; ++n) acc[a][b][m][n] = (f32x4){0.f, 0.f, 0.f, 0.f};
        cur = nxt; cA = nA; cB = nB; ++ui;
        if (wr == 1) PG8_BAR;
    }
    PG8_WAIT_V(0);
    PG8_BAR;
#undef PG8_SA
#undef PG8_SB
#undef PG8_STAGE
#undef PG8_LDA
#undef PG8_LDB
#undef PG8_MMA
#undef PG8_WAIT_V
#undef PG8_WAIT_L
#undef PG8_BAR
#undef PG8_SCHED
}

struct EpiStore {
    bf16_t* O; int ldc; const float* rowscale;
    __device__ __forceinline__ void operator()(const f32x4 (&acc)[2][2][4][2], const Unit& u, int wr, int wc, int fr, int fq) const {
        const int row0 = u.pm * BM + wr * 64 + fr, col0 = u.pn * BM + wc * 32 + 8 * fq;
#pragma unroll
        for (int ai = 0; ai < 2; ++ai)
#pragma unroll
            for (int m = 0; m < 4; ++m) { const int row = row0 + ai * HALF + m * 16; const float rs = rowscale ? rowscale[row] : 1.f;
                bf16_t* rowp = O + (size_t)row * ldc + col0;
#pragma unroll
                for (int bj = 0; bj < 2; ++bj) { const f32x4 v0 = acc[ai][bj][m][0] * rs, v1 = acc[ai][bj][m][1] * rs;
                    u32x4 w; w.x = cvt_pk_bf16(v0[0], v0[1]); w.y = cvt_pk_bf16(v0[2], v0[3]); w.z = cvt_pk_bf16(v1[0], v1[1]); w.w = cvt_pk_bf16(v1[2], v1[3]);
                    *(u32x4*)(rowp + bj * HALF) = w; } }
    }
};
struct EpiResid {
    const float* X; float* O; const float* gate; int gpitch;
    __device__ __forceinline__ void operator()(const f32x4 (&acc)[2][2][4][2], const Unit& u, int wr, int wc, int fr, int fq) const {
        const int row0 = u.pm * BM + wr * 64 + fr, col0 = u.pn * BM + wc * 32 + 8 * fq;
        const float* gp = gate + (size_t)((u.pm * BM) / SEQ) * gpitch + col0;
        f32x4 gv[2][2];
#pragma unroll
        for (int bj = 0; bj < 2; ++bj)
#pragma unroll
            for (int n = 0; n < 2; ++n) gv[bj][n] = *(const f32x4*)(gp + bj * HALF + 4 * n);
#pragma unroll
        for (int ai = 0; ai < 2; ++ai)
#pragma unroll
            for (int m = 0; m < 4; ++m) { const size_t off = (size_t)(row0 + ai * HALF + m * 16) * DM + col0;
#pragma unroll
                for (int bj = 0; bj < 2; ++bj)
#pragma unroll
                    for (int n = 0; n < 2; ++n) { const f32x4 xv = *(const f32x4*)(X + off + bj * HALF + 4 * n);
                        *(f32x4*)(O + off + bj * HALF + 4 * n) = xv + gv[bj][n] * acc[ai][bj][m][n]; } }
    }
};
struct EpiSwiGLU {
    bf16_t* O;
    __device__ __forceinline__ void operator()(const f32x4 (&acc)[2][2][4][2], const Unit& u, int wr, int wc, int fr, int fq) const {
        const int row0 = u.pm * BM + wr * 64 + fr, col0 = u.pn * HALF + wc * 32 + 8 * fq;
#pragma unroll
        for (int ai = 0; ai < 2; ++ai)
#pragma unroll
            for (int m = 0; m < 4; ++m) { const int row = row0 + ai * HALF + m * 16;
                float h[8];
#pragma unroll
                for (int n = 0; n < 2; ++n)
#pragma unroll
                    for (int j = 0; j < 4; ++j) { const float gt = acc[ai][0][m][n][j], up = acc[ai][1][m][n][j]; h[4 * n + j] = gt / (1.f + __expf(-gt)) * up; }
                u32x4 w; w.x = cvt_pk_bf16(h[0], h[1]); w.y = cvt_pk_bf16(h[2], h[3]); w.z = cvt_pk_bf16(h[4], h[5]); w.w = cvt_pk_bf16(h[6], h[7]);
                *(u32x4*)(O + (size_t)row * DE + col0) = w; }
    }
};
}
constexpr size_t MiB = 1u << 20;
constexpr size_t WS_CTL = 0, CTL_ZERO_BYTES = 1 * MiB;
constexpr size_t WS_MOD = 1 * MiB;
constexpr size_t WS_ROPEC = 1 * MiB + 512 * 1024;
constexpr size_t WS_ROPES = WS_ROPEC + 2 * MiB;
constexpr size_t WS_WCT = WS_ROPES + 2 * MiB;
constexpr size_t WS_RSTDQ = 6 * MiB;
constexpr size_t WS_RSTDKV = WS_RSTDQ + 64 * 1024;
constexpr size_t WS_TOKE = WS_RSTDKV + 64 * 1024;
constexpr size_t WS_TOKW = WS_TOKE + 128 * 1024;
constexpr size_t WS_TOKS = WS_TOKW + 128 * 1024;
constexpr size_t WS_BLKE = WS_TOKS + 128 * 1024;
constexpr size_t WS_STAMP = WS_BLKE + 4096;
constexpr size_t WS_WIN = 8 * MiB;
constexpr size_t WS_WQUP = 28 * MiB;
constexpr size_t WS_WKVUP = WS_WQUP + 1536 * 1024;
constexpr size_t WS_WOUT = 31 * MiB;
constexpr size_t WS_A = 40 * MiB;
constexpr size_t WS_B = 200 * MiB;
constexpr size_t WS_C = 264 * MiB;
constexpr size_t WS_D = 328 * MiB;
constexpr size_t WS_E = 456 * MiB;
constexpr size_t WS_END = 520 * MiB;
constexpr size_t QN_BYTES = (size_t)T * MH * MQK * 2;

constexpr int CW_BAR = 4096;
constexpr int CW_CNT = 8192;

constexpr int RING_BYTES = 131072, MISC_OFF = RING_BYTES + 320, LDS_BYTES = 147456;

struct Args { const float* in[25]; float* out; unsigned char* ws; int ph_lo, ph_hi, pad0, pad1; };

struct Frame {
    LAS unsigned char* lds;
    volatile LAS unsigned* MISC;
    gu32* ctl;
    int tid, lane, wave, vcu, G;
    unsigned char* ws; float* out;
};

#define OPAQUE_FRAME(F) do { F.tid = threadIdx.x; asm volatile("" : "+v"(F.tid)); F.lane = F.tid & 63; } while (0)

__device__ __forceinline__ void unpack8(const u32x4 w, float* f) { f[0] = bf_lo(w.x); f[1] = bf_hi(w.x); f[2] = bf_lo(w.y); f[3] = bf_hi(w.y); f[4] = bf_lo(w.z); f[5] = bf_hi(w.z); f[6] = bf_lo(w.w); f[7] = bf_hi(w.w); }
__device__ __forceinline__ u32x4 pack8f(const float* f) { u32x4 w; w.x = cvt_pk_bf16(f[0], f[1]); w.y = cvt_pk_bf16(f[2], f[3]); w.z = cvt_pk_bf16(f[4], f[5]); w.w = cvt_pk_bf16(f[6], f[7]); return w; }

__device__ __forceinline__ void transpose_item(const float* W, int N, int k0, int n0, bf16_t* dst, int ldt, const float* gk, LAS float* scr, int lane) {
#pragma unroll 8
    for (int i = 0; i < 32; ++i) { const int kk = 2 * i + (lane >> 5); float v = W[(size_t)(k0 + kk) * N + n0 + (lane & 31)]; if (gk) v *= gk[k0 + kk]; scr[kk * 33 + (lane & 31)] = v; }
    LDS_WAIT(); asm volatile("" ::: "memory");
    const int c = lane & 7;
#pragma unroll
    for (int j = 0; j < 4; ++j) { const int n = (lane >> 3) + 8 * j; const LAS float* s = scr + (8 * c) * 33 + n;
        u32x4 o; o.x = cvt_pk_bf16(s[0 * 33], s[1 * 33]); o.y = cvt_pk_bf16(s[2 * 33], s[3 * 33]); o.z = cvt_pk_bf16(s[4 * 33], s[5 * 33]); o.w = cvt_pk_bf16(s[6 * 33], s[7 * 33]);
        *(u32x4*)(dst + (size_t)n * ldt + k0 + 8 * c) = o; }
    LDS_WAIT(); asm volatile("" ::: "memory");
}

__device__ __forceinline__ void adaln_phase(Frame& F, const float* c, const float* w_ada, const float* b_ada, float* mod) {
    LAS float* cact = (LAS float*)F.lds;
    LAS float* part = (LAS float*)(F.lds + 65536);
    for (int i = F.tid; i < NB * DM; i += NTHR) cact[i] = siluf(c[i]);
    __syncthreads();
    const int cg = F.tid & 7, rs = F.tid >> 3;
    for (int it = blockIdx.x; it < 6 * DM / 32; it += F.G) {
        const int n0 = it * 32 + cg * 4;
        f32x4 acc[8];
#pragma unroll
        for (int b = 0; b < 8; ++b) acc[b] = (f32x4){0.f, 0.f, 0.f, 0.f};
#pragma unroll 4
        for (int i = 0; i < 32; ++i) { const int k = rs + 64 * i; const f32x4 w = *(const f32x4*)(w_ada + (size_t)k * (6 * DM) + n0);
#pragma unroll
            for (int b = 0; b < 8; ++b) acc[b] += w * cact[b * DM + k]; }
#pragma unroll
        for (int b = 0; b < 8; ++b) *(LAS f32x4*)(part + (rs * 8 + b) * 32 + cg * 4) = acc[b];
        __syncthreads();
        if (F.tid < 256) { const int b = F.tid >> 5, n = F.tid & 31; float s = 0.f;
#pragma unroll 8
            for (int r = 0; r < 64; ++r) s += part[(r * 8 + b) * 32 + n];
            mod[b * (6 * DM) + it * 32 + n] = s + b_ada[it * 32 + n]; }
        __syncthreads();
    }
}

__device__ __forceinline__ void p0_phase(Frame& F, const Args& a) {
    OPAQUE_FRAME(F);
    unsigned char* ws = F.ws;
    adaln_phase(F, a.in[1], a.in[3], a.in[4], (float*)(ws + WS_MOD));
    LAS float* scr = (LAS float*)(F.lds + F.wave * 16384);
    const int gw = F.vcu * NWAVES + F.wave, NGW = F.G * NWAVES;
    constexpr int I_IN = (DM / 64) * (INC / 32), I_QUP = (QLORA / 64) * (MH * MQK / 32), I_KVUP = (KVLORA / 64) * (MH * 256 / 32), I_OUT = (DM / 64) * (DM / 32);
    constexpr int NITEMS = I_IN + I_QUP + I_KVUP + I_OUT;
    for (int it = gw; it < NITEMS; it += NGW) {
        int r = it;
        if (r < I_IN) { const int nblk = INC / 32, kb = r / nblk, nb = r % nblk; transpose_item(a.in[6], INC, 64 * kb, 32 * nb, (bf16_t*)(ws + WS_WIN) + (size_t)(32 * nb) * DM, DM, nullptr, scr, F.lane); continue; } r -= I_IN;
        if (r < I_QUP) { const int nblk = MH * MQK / 32, kb = r / nblk, nb = r % nblk; transpose_item(a.in[10], MH * MQK, 64 * kb, 32 * nb, (bf16_t*)(ws + WS_WQUP) + (size_t)(32 * nb) * QLORA, QLORA, a.in[9], scr, F.lane); continue; } r -= I_QUP;
        if (r < I_KVUP) { const int nblk = MH * 256 / 32, kb = r / nblk, nb = r % nblk; transpose_item(a.in[12], MH * 256, 64 * kb, 32 * nb, (bf16_t*)(ws + WS_WKVUP) + (size_t)(32 * nb) * KVLORA, KVLORA, a.in[11], scr, F.lane); continue; } r -= I_KVUP;
        { const int nblk = DM / 32, kb = r / nblk, nb = r % nblk; transpose_item(a.in[16], DM, 64 * kb, 32 * nb, (bf16_t*)(ws + WS_WOUT) + (size_t)(32 * nb) * DM, DM, nullptr, scr, F.lane); }
    }
    { const int* pos = (const int*)a.in[2]; float* rc = (float*)(ws + WS_ROPEC); float* rsn = (float*)(ws + WS_ROPES);
      const int gt = F.vcu * NTHR + F.tid, NGT = F.G * NTHR;
      for (int e = gt; e < T * 32; e += NGT) { const int i = e & 31, tk = e >> 5;
          const float invf = (float)exp2(-(double)i * (13.287712379549449 / 32.0));
          const float ang = (float)pos[tk] * invf;
          rc[e] = cosf(ang); rsn[e] = sinf(ang); }
      float* wct = (float*)(ws + WS_WCT);
      for (int e = gt; e < 48 * DM; e += NGT) { const int n = e / DM, k = e % DM;
          wct[e] = n < 4 ? a.in[18][k * NG + n] : (n < 36 ? a.in[20][k * NE + (n - 4)] : 0.f); } }
}

__device__ __forceinline__ void modnorm_row(const float* xrow, const float* g, const float* shift, const float* scale, bf16_t* orow, int lane) {
    const f32x4* xr = (const f32x4*)xrow + lane;
    f32x4 v[8]; float s = 0.f;
#pragma unroll
    for (int j = 0; j < 8; ++j) { v[j] = xr[64 * j]; s += (v[j].x * v[j].x + v[j].y * v[j].y) + (v[j].z * v[j].z + v[j].w * v[j].w); }
    const float rstd = rsqrtf(wave_sum(s) * (1.f / DM) + EPS);
    u32x2* o8 = (u32x2*)orow + lane;
#pragma unroll
    for (int j = 0; j < 8; ++j) { const f32x4 gg = ((const f32x4*)g)[64 * j + lane], sh = ((const f32x4*)shift)[64 * j + lane], sc = ((const f32x4*)scale)[64 * j + lane];
        const f32x4 h = v[j] * rstd * gg * (sc + 1.f) + sh;
        u32x2 w; w.x = cvt_pk_bf16(h.x, h.y); w.y = cvt_pk_bf16(h.z, h.w); o8[64 * j] = w; }
}
__device__ __forceinline__ void p1_phase(Frame& F, const Args& a) {
    OPAQUE_FRAME(F);
    const int gw = F.vcu * NWAVES + F.wave, NGW = F.G * NWAVES;
    const float* mod = (const float*)(F.ws + WS_MOD);
    bf16_t* H = (bf16_t*)(F.ws + WS_B);
    for (int m = gw; m < T; m += NGW) { const int b = m / SEQ;
        modnorm_row(a.in[0] + (size_t)m * DM, a.in[5], mod + b * (6 * DM), mod + b * (6 * DM) + DM, H + (size_t)m * DM, F.lane); }
}

template <int CTRL> __device__ __forceinline__ float dppf(float x) { return __builtin_bit_cast(float, __builtin_amdgcn_update_dpp(0, __builtin_bit_cast(int, x), CTRL, 0xF, 0xF, true)); }

namespace hg {
constexpr int OFF_F = 0, OFF_SEG = 32768, OFF_QIN = 34816, RP = 272, OFF_KIN = OFF_QIN + 64 * RP, OFF_QB = OFF_KIN + 64 * RP, OFF_KLT = OFF_QB + 64 * RP, SP = 144,
              OFF_VT = OFF_KLT + 128 * SP, OFF_DEC = OFF_VT + 32 * SP, HG_LDS = OFF_DEC + 1536;
static_assert(HG_LDS <= RING_BYTES, "hgrn lds");
__device__ __forceinline__ int ppos(int s) { return (s & ~15) | ((s & 4) << 1) | ((s & 8) >> 1) | (s & 3); }
}
__device__ __forceinline__ void hgrn_chunked(Frame& F, const Args& a) {
    using namespace hg;
    const bf16_t* PROJ = (const bf16_t*)(F.ws + WS_A);
    bf16_t* MIX = (bf16_t*)(F.ws + WS_E);
    const float* lbl = a.in[7];
    LAS unsigned char* L = F.lds;
    LAS float* Fs = (LAS float*)(L + OFF_F); LAS float* SEGs = (LAS float*)(L + OFF_SEG); LAS float* DEC = (LAS float*)(L + OFF_DEC);
    const int g = F.tid & 15, t0 = F.tid >> 4;
    const int sk = F.tid & 127, sseg = F.tid >> 7;
    const int r32 = F.lane & 31, hi = F.lane >> 5;
    for (int it = blockIdx.x; it < NB * HH * 4; it += F.G) {
        const int dq = it & 3, h = (it >> 2) & 7, b = it >> 5;
        float lb[8];
#pragma unroll
        for (int j = 0; j < 8; ++j) { const int k = h * 128 + g * 8 + j; lb[j] = 1.f / (1.f + __expf(lbl[HW + k] - lbl[k])); }
        const bf16_t* base = PROJ + (size_t)(b * SEQ) * INCP + h * 128;
        f32x16 S[4] = {};
        u32x4 gq[2], gf[2], gv;
#define HG_LOAD(c) do { _Pragma("unroll") for (int i = 0; i < 2; ++i) { const bf16_t* p = base + (size_t)((c) * 64 + t0 + 32 * i) * INCP + g * 8; gq[i] = *(const u32x4*)p; gf[i] = *(const u32x4*)(p + HW); } \
            if (F.tid < 256) gv = *(const u32x4*)(base + (size_t)((c) * 64 + (F.tid >> 2)) * INCP + 2 * HW + dq * 32 + (F.tid & 3) * 8); } while (0)
        HG_LOAD(0);
        for (int c = 0; c < SEQ / 64; ++c) {
            float fv[2][8];
#pragma unroll
            for (int i = 0; i < 2; ++i) { float fl[8]; unpack8(gf[i], fl);
#pragma unroll
                for (int j = 0; j < 8; ++j) { const float sg = 1.f / (1.f + __expf(-fl[j])); fv[i][j] = lb[j] + (1.f - lb[j]) * sg; }
                LAS float* fp = Fs + (t0 + 32 * i) * 128 + g * 8;
                *(LAS f32x4*)fp = (f32x4){fv[i][0], fv[i][1], fv[i][2], fv[i][3]}; *(LAS f32x4*)(fp + 4) = (f32x4){fv[i][4], fv[i][5], fv[i][6], fv[i][7]}; }
            __syncthreads();
            { float p = 1.f;
#pragma unroll
              for (int i = 0; i < 16; ++i) { LAS float* q = Fs + (16 * sseg + i) * 128 + sk; p *= *q; *q = p; }
              SEGs[sseg * 128 + sk] = p; }
            __syncthreads();
            if (F.tid < 128) { const float s0 = SEGs[F.tid], s1 = SEGs[128 + F.tid], s2 = SEGs[256 + F.tid], s3 = SEGs[384 + F.tid];
                const float pm = s0 * s1;
                SEGs[F.tid] = 1.f; SEGs[128 + F.tid] = s0; SEGs[256 + F.tid] = pm; SEGs[384 + F.tid] = pm * s2;
                DEC[F.tid] = pm * s2 * s3; DEC[128 + F.tid] = pm; DEC[256 + F.tid] = __builtin_amdgcn_rcpf(pm); }
            __syncthreads();
            {
#pragma unroll
              for (int i = 0; i < 2; ++i) { const int t = t0 + 32 * i;
                  float qin[8], kin[8], qb[8], kl[8], qv[8];
                  unpack8(gq[i], qv);
                  const LAS float* fp = Fs + t * 128 + g * 8; const LAS float* pp = SEGs + (t >> 4) * 128 + g * 8;
                  const f32x4 pa = *(const LAS f32x4*)fp, pb = *(const LAS f32x4*)(fp + 4), ea = *(const LAS f32x4*)pp, eb = *(const LAS f32x4*)(pp + 4);
                  const f32x4 la = *(const LAS f32x4*)(DEC + g * 8), lb4 = *(const LAS f32x4*)(DEC + g * 8 + 4), ma = *(const LAS f32x4*)(DEC + 128 + g * 8), mb = *(const LAS f32x4*)(DEC + 128 + g * 8 + 4),
                              ra = *(const LAS f32x4*)(DEC + 256 + g * 8), rb = *(const LAS f32x4*)(DEC + 256 + g * 8 + 4);
#pragma unroll
                  for (int j = 0; j < 8; ++j) { const float P = (j < 4 ? pa[j] * ea[j] : pb[j - 4] * eb[j - 4]), pl = j < 4 ? la[j] : lb4[j - 4], pm = j < 4 ? ma[j] : mb[j - 4], rpm = j < 4 ? ra[j] : rb[j - 4];
                      const float r = __builtin_amdgcn_rcpf(P), kk = 1.f - fv[i][j], qs = qv[j] * 0.08838834764831845f;
                      qb[j] = qs * P; qin[j] = qb[j] * rpm; kin[j] = kk * pm * r; kl[j] = kk * pl * r; }
                  *(LAS u32x4*)(L + OFF_QIN + t * RP + g * 16) = pack8f(qin);
                  *(LAS u32x4*)(L + OFF_KIN + t * RP + g * 16) = pack8f(kin);
                  { const u32x4 w = pack8f(qb);
                    *(LAS u32x2*)(L + OFF_QB + t * RP + ((g >> 1) * 16 + (g & 1) * 4) * 2) = (u32x2){w.x, w.y};
                    *(LAS u32x2*)(L + OFF_QB + t * RP + ((g >> 1) * 16 + 8 + (g & 1) * 4) * 2) = (u32x2){w.z, w.w}; }
                  const int ps = ppos(t);
#pragma unroll
                  for (int j = 0; j < 8; ++j) *(LAS bf16_t*)(L + OFF_KLT + (g * 8 + j) * SP + ps * 2) = (bf16_t)(cvt_pk_bf16(kl[j], 0.f) & 0xffffu); }
              if (F.tid < 256) { float v[8]; unpack8(gv, v); const int s = F.tid >> 2, dvg = F.tid & 3, ps = ppos(s);
#pragma unroll
                  for (int j = 0; j < 8; ++j) *(LAS bf16_t*)(L + OFF_VT + (dvg * 8 + j) * SP + ps * 2) = (bf16_t)(__builtin_bit_cast(unsigned, v[j]) >> 16); } }
            if (c + 1 < SEQ / 64) HG_LOAD(c + 1);
            __syncthreads();
            if (F.wave < 2) { const int tb = F.wave;
                f32x16 o = {};
                for (int sb = 0; sb <= tb; ++sb) { f32x16 X = {};
#pragma unroll
                    for (int ks = 0; ks < 8; ++ks) { const bf16x8 af = *(const LAS bf16x8*)(L + OFF_KIN + (32 * sb + r32) * RP + (16 * ks + 8 * hi) * 2);
                        const bf16x8 bfr = *(const LAS bf16x8*)(L + OFF_QIN + (32 * tb + r32) * RP + (16 * ks + 8 * hi) * 2);
                        X = __builtin_amdgcn_mfma_f32_32x32x16_bf16(af, bfr, X, 0, 0, 0); }
                    if (sb == tb) {
#pragma unroll
                        for (int r = 0; r < 16; ++r) { const int srow = (r & 3) + 8 * (r >> 2) + 4 * hi; if (srow > r32) X[r] = 0.f; } }
#pragma unroll
                    for (int s2 = 0; s2 < 2; ++s2) { u32x4 w; w.x = cvt_pk_bf16(X[8 * s2], X[8 * s2 + 1]); w.y = cvt_pk_bf16(X[8 * s2 + 2], X[8 * s2 + 3]); w.z = cvt_pk_bf16(X[8 * s2 + 4], X[8 * s2 + 5]); w.w = cvt_pk_bf16(X[8 * s2 + 6], X[8 * s2 + 7]);
                        const bf16x8 vf = *(const LAS bf16x8*)(L + OFF_VT + r32 * SP + (32 * sb + 16 * s2 + 8 * hi) * 2);
                        o = __builtin_amdgcn_mfma_f32_32x32x16_bf16(__builtin_bit_cast(bf16x8, w), vf, o, 0, 0, 0); } }
#pragma unroll
                for (int kb = 0; kb < 4; ++kb)
#pragma unroll
                    for (int s2 = 0; s2 < 2; ++s2) { u32x4 w; w.x = cvt_pk_bf16(S[kb][8 * s2], S[kb][8 * s2 + 1]); w.y = cvt_pk_bf16(S[kb][8 * s2 + 2], S[kb][8 * s2 + 3]); w.z = cvt_pk_bf16(S[kb][8 * s2 + 4], S[kb][8 * s2 + 5]); w.w = cvt_pk_bf16(S[kb][8 * s2 + 6], S[kb][8 * s2 + 7]);
                        const bf16x8 qf = *(const LAS bf16x8*)(L + OFF_QB + (32 * tb + r32) * RP + (32 * kb + 16 * s2 + 8 * hi) * 2);
                        o = __builtin_amdgcn_mfma_f32_32x32x16_bf16(qf, __builtin_bit_cast(bf16x8, w), o, 0, 0, 0); }
#pragma unroll
                for (int kb = 0; kb < 4; ++kb) {
#pragma unroll
                    for (int r = 0; r < 16; ++r) S[kb][r] *= DEC[32 * kb + (r & 3) + 8 * (r >> 2) + 4 * hi];
#pragma unroll
                    for (int ss = 0; ss < 4; ++ss) { const bf16x8 kf = *(const LAS bf16x8*)(L + OFF_KLT + (32 * kb + r32) * SP + (16 * ss + 8 * hi) * 2);
                        const bf16x8 vf = *(const LAS bf16x8*)(L + OFF_VT + r32 * SP + (16 * ss + 8 * hi) * 2);
                        S[kb] = __builtin_amdgcn_mfma_f32_32x32x16_bf16(kf, vf, S[kb], 0, 0, 0); } }
                bf16_t* orow = MIX + (size_t)(b * SEQ + c * 64 + 32 * tb) * DM + h * 128 + dq * 32 + r32;
#pragma unroll
                for (int r = 0; r < 16; ++r) { const float v = o[r]; const float vn = __shfl_xor(v, 1);
                    if ((r32 & 1) == 0) *(unsigned*)(orow + (size_t)((r & 3) + 8 * (r >> 2) + 4 * hi) * DM) = cvt_pk_bf16(v, vn); }
            }
            __syncthreads();
        }
#undef HG_LOAD
    }
}

__device__ __forceinline__ void p3_phase(Frame& F, const Args& a) {
    OPAQUE_FRAME(F);
    const bf16_t* PROJ = (const bf16_t*)(F.ws + WS_A);
    {
        const int gw = F.vcu * NWAVES + F.wave, NGW = F.G * NWAVES;
        float* rq = (float*)(F.ws + WS_RSTDQ); float* rkv = (float*)(F.ws + WS_RSTDKV);
        for (int m = gw; m < T; m += NGW) {
            float f[8]; unpack8(*(const u32x4*)(PROJ + (size_t)m * INCP + C_QA + F.lane * 8), f);
            float s = 0.f;
#pragma unroll
            for (int j = 0; j < 8; ++j) s += f[j] * f[j];
            s = wave_sum(s);
            float s2 = 0.f;
            if (F.lane < 32) { unpack8(*(const u32x4*)(PROJ + (size_t)m * INCP + C_KVA + F.lane * 8), f);
#pragma unroll
                for (int j = 0; j < 8; ++j) s2 += f[j] * f[j]; }
            s2 = wave_sum(s2);
            if (F.lane == 0) { rq[m] = rsqrtf(s * (1.f / QLORA) + EPS); rkv[m] = rsqrtf(s2 * (1.f / KVLORA) + EPS); }
        }
    }
    hgrn_chunked(F, a);
}

__device__ __forceinline__ float sum8(float v) { v += __shfl_xor(v, 1); v += __shfl_xor(v, 2); v += __shfl_xor(v, 4); return v; }

__device__ __forceinline__ void p5_phase(Frame& F, const Args& a) {
    OPAQUE_FRAME(F);
    const int gw = F.vcu * NWAVES + F.wave, NGW = F.G * NWAVES;
    const bf16_t* PROJ = (const bf16_t*)(F.ws + WS_A);
    const bf16_t* QH = (const bf16_t*)(F.ws + WS_B);
    const bf16_t* KV = (const bf16_t*)(F.ws + WS_C);
    bf16_t* Qn = (bf16_t*)(F.ws + WS_D); bf16_t* Kn = (bf16_t*)(F.ws + WS_D + QN_BYTES); bf16_t* Vh = (bf16_t*)(F.ws + WS_D + 2 * QN_BYTES);
    bf16_t* MIX = (bf16_t*)(F.ws + WS_E);
    const float* rc = (const float*)(F.ws + WS_ROPEC); const float* rsn = (const float*)(F.ws + WS_ROPES);
    const float* gqn = a.in[13]; const float* gkn = a.in[14]; const float* gon = a.in[8];
    const int h = F.lane >> 3, sub = F.lane & 7;
    for (int t = gw; t < T; t += NGW) {
        const int b = t / SEQ, s = t % SEQ;
        const size_t hrow = ((size_t)(b * MH + h) * SEQ + s);
        float cs[8], sn[8];
        { const int ii = (sub & 3) * 8; const float* cp = rc + (size_t)t * 32 + ii; const float* sp = rsn + (size_t)t * 32 + ii;
#pragma unroll
          for (int j = 0; j < 8; ++j) { cs[j] = cp[j]; sn[j] = sp[j]; } }
        const float sgn = sub < 4 ? -1.f : 1.f;
        { float q[3][8]; float ss = 0.f;
#pragma unroll
          for (int i = 0; i < 3; ++i) { unpack8(*(const u32x4*)(QH + (size_t)t * (MH * MQK) + h * MQK + (sub + 8 * i) * 8), q[i]);
#pragma unroll
              for (int j = 0; j < 8; ++j) ss += q[i][j] * q[i][j]; }
          const float rs = rsqrtf(sum8(ss) * (1.f / MQK) + EPS);
#pragma unroll
          for (int i = 0; i < 3; ++i)
#pragma unroll
              for (int j = 0; j < 8; ++j) q[i][j] *= rs * gqn[(sub + 8 * i) * 8 + j];
#pragma unroll
          for (int j = 0; j < 8; ++j) { const float pv = __shfl_xor(q[2][j], 4); q[2][j] = q[2][j] * cs[j] + sgn * pv * sn[j]; }
#pragma unroll
          for (int i = 0; i < 3; ++i) *(u32x4*)(Qn + hrow * MQK + (sub + 8 * i) * 8) = pack8f(q[i]); }
        { float k[3][8]; float ss = 0.f;
#pragma unroll
          for (int i = 0; i < 2; ++i) unpack8(*(const u32x4*)(KV + (size_t)t * (MH * 256) + h * 256 + (sub + 8 * i) * 8), k[i]);
          unpack8(*(const u32x4*)(PROJ + (size_t)t * INCP + C_KPE + sub * 8), k[2]);
#pragma unroll
          for (int i = 0; i < 3; ++i)
#pragma unroll
              for (int j = 0; j < 8; ++j) ss += k[i][j] * k[i][j];
          const float rs = rsqrtf(sum8(ss) * (1.f / MQK) + EPS);
#pragma unroll
          for (int i = 0; i < 3; ++i)
#pragma unroll
              for (int j = 0; j < 8; ++j) k[i][j] *= rs * gkn[(sub + 8 * i) * 8 + j];
#pragma unroll
          for (int j = 0; j < 8; ++j) { const float pv = __shfl_xor(k[2][j], 4); k[2][j] = k[2][j] * cs[j] + sgn * pv * sn[j]; }
#pragma unroll
          for (int i = 0; i < 3; ++i) *(u32x4*)(Kn + hrow * MQK + (sub + 8 * i) * 8) = pack8f(k[i]); }
#pragma unroll
        for (int i = 0; i < 2; ++i) *(u32x4*)(Vh + hrow * MV + (sub + 8 * i) * 8) = *(const u32x4*)(KV + (size_t)t * (MH * 256) + h * 256 + 128 + (sub + 8 * i) * 8);
        { float o[2][8], gt[2][8]; float ss = 0.f;
#pragma unroll
          for (int i = 0; i < 2; ++i) { unpack8(*(const u32x4*)(MIX + (size_t)t * DM + h * 128 + (sub + 8 * i) * 8), o[i]); unpack8(*(const u32x4*)(PROJ + (size_t)t * INCP + 3 * HW + h * 128 + (sub + 8 * i) * 8), gt[i]);
#pragma unroll
              for (int j = 0; j < 8; ++j) ss += o[i][j] * o[i][j]; }
          const float rs = rsqrtf(sum8(ss) * (1.f / HDV) + EPS);
#pragma unroll
          for (int i = 0; i < 2; ++i) {
#pragma unroll
              for (int j = 0; j < 8; ++j) o[i][j] = o[i][j] * rs * gon[(sub + 8 * i) * 8 + j] * siluf(gt[i][j]);
              *(u32x4*)(MIX + (size_t)t * DM + h * 128 + (sub + 8 * i) * 8) = pack8f(o[i]); } }
    }
}
namespace att {
constexpr int QBLK = 32, KVBLK = 64, QB = 256;
constexpr int KROW = 512, SHM_K = KVBLK * KROW, SHM_V = KVBLK * MV * 2;
constexpr int OFF_V = 0, OFF_K = 2 * SHM_V, OFF_WS = OFF_K + 2 * SHM_K;
constexpr float SCALE = 0.07216878364870322f;
constexpr float THR = 8.f;
#define SBAR() __builtin_amdgcn_sched_barrier(0)
__device__ __forceinline__ int v_st(int k, int c) { const int kk = (k & ~0xC) | ((k & 4) << 1) | ((k & 8) >> 1); return ((kk >> 3) * 4 + (c >> 5)) * 512 + ((kk & 7) * 32 + (c & 31)) * 2; }
__device__ __forceinline__ int v_rd_base(int lane) { return ((lane & 3) << 3) | (((lane >> 2) & 3) << 6) | (((lane >> 4) & 1) << 5) | (((lane >> 5) & 1) << 8); }
constexpr int v_rd_off(int d0, int ks, int half) { return d0 * 512 + ks * 4096 + half * 2048; }
__device__ __forceinline__ int crow(int r, int hi) { return (r & 3) + 8 * (r >> 2) + 4 * hi; }
__device__ __forceinline__ unsigned cvtpk(float lo, float hi) { unsigned r; asm volatile("v_cvt_pk_bf16_f32 %0, %1, %2" : "=v"(r) : "v"(lo), "v"(hi)); return r; }

__device__ __forceinline__ void mask_tile(f32x16& p0, f32x16& p1, int dq) {
    const float NEG = -__builtin_inff();
#pragma unroll
    for (int r = 0; r < 16; ++r) {
        const int c = (r & 3) + 8 * (r >> 2);
        if (dq - c < 0) p0[r] = NEG;
        if (dq - c - 32 < 0) p1[r] = NEG;
    }
}
__device__ __forceinline__ void partialSM(f32x16& p0, f32x16& p1, float& m_reg, float& mn, float& alpha) {
    float pmax = p0[0];
#pragma unroll
    for (int r = 1; r < 16; ++r) pmax = fmaxf(pmax, p0[r]);
#pragma unroll
    for (int r = 0; r < 16; ++r) pmax = fmaxf(pmax, p1[r]);
    { auto rr = __builtin_amdgcn_permlane32_swap(__float_as_uint(pmax), __float_as_uint(pmax), false, false);
      pmax = fmaxf(__uint_as_float(rr[0]), __uint_as_float(rr[1])); }
    constexpr float C2 = 1.4426950408889634f * SCALE;
    if (__builtin_expect(__all((pmax - m_reg) * SCALE <= THR), 1)) { mn = m_reg; alpha = 1.f; }
    else { mn = fmaxf(m_reg, pmax); alpha = __builtin_amdgcn_exp2f((m_reg - mn) * C2); m_reg = mn; }
    const float mnL = -mn * C2;
#pragma unroll
    for (int r = 0; r < 16; ++r) p0[r] = fmaf(p0[r], C2, mnL);
#pragma unroll
    for (int r = 0; r < 16; ++r) p1[r] = fmaf(p1[r], C2, mnL);
#pragma unroll
    for (int r = 0; r < 16; ++r) p0[r] = __builtin_amdgcn_exp2f(p0[r]);
}
__device__ __forceinline__ void finishSM(f32x16& p0, f32x16& p1, float alpha, float& l_reg, bf16x8& pa0, bf16x8& pa1, bf16x8& pa2, bf16x8& pa3) {
#pragma unroll
    for (int r = 0; r < 16; ++r) p1[r] = __builtin_amdgcn_exp2f(p1[r]);
    float ps = 0;
#pragma unroll
    for (int r = 0; r < 16; ++r) ps += p0[r];
#pragma unroll
    for (int r = 0; r < 16; ++r) ps += p1[r];
    { auto rr = __builtin_amdgcn_permlane32_swap(__float_as_uint(ps), __float_as_uint(ps), false, false);
      ps = __uint_as_float(rr[0]) + __uint_as_float(rr[1]); }
    l_reg = l_reg * alpha + ps;
#define PK4(P, B_, OUT) do { unsigned a0 = cvtpk(P[B_+0], P[B_+1]), a1 = cvtpk(P[B_+2], P[B_+3]);                          \
        unsigned b0 = cvtpk(P[B_+4], P[B_+5]), b1 = cvtpk(P[B_+6], P[B_+7]);                                             \
        auto r0 = __builtin_amdgcn_permlane32_swap(a0, b0, false, false); auto r1 = __builtin_amdgcn_permlane32_swap(a1, b1, false, false); \
        u32x4 w = {r0[0], r1[0], r0[1], r1[1]}; OUT = __builtin_bit_cast(bf16x8, w); } while (0)
    PK4(p0, 0, pa0); PK4(p0, 8, pa1); PK4(p1, 0, pa2); PK4(p1, 8, pa3);
#undef PK4
}
template <int KB>
__device__ __forceinline__ void qkt(f32x16& p0, f32x16& p1, LAS unsigned char* lds, int r32, int hi, const bf16x8* qr) {
    p0 = f32x16{}; p1 = f32x16{};
    int sw = r32 & 15; asm volatile("" : "+v"(sw));
    const int rb = OFF_K + KB * SHM_K + r32 * KROW;
    int ab[8];
#pragma unroll
    for (int d = 0; d < 8; ++d) ab[d] = rb + (((2 * d + hi) ^ sw) << 4);
#pragma unroll
    for (int d0 = 0; d0 < 12; ++d0) { const int a = ab[d0 & 7] + (d0 >> 3) * 256;
        const bf16x8 b0 = *(const LAS bf16x8*)(lds + a);
        const bf16x8 b1 = *(const LAS bf16x8*)(lds + a + 32 * KROW);
        p0 = __builtin_amdgcn_mfma_f32_32x32x16_bf16(b0, qr[d0], p0, 0, 0, 0);
        p1 = __builtin_amdgcn_mfma_f32_32x32x16_bf16(b1, qr[d0], p1, 0, 0, 0); }
}
template <int VB>
__device__ __forceinline__ void pv_tile(f32x16* o, int vb0, bf16x8 pa0, bf16x8 pa1, bf16x8 pa2, bf16x8 pa3) {
#define TRRD(dst, off) asm volatile("ds_read_b64_tr_b16 %0, %1 offset:%2" : "=&v"(dst) : "v"(vb0), "i"(off) : "memory")
#define PV_D0(d0) do { s16x4 l0, l1, l2, l3, h0, h1, h2, h3; constexpr int b_ = OFF_V + VB * SHM_V + v_rd_off(d0, 0, 0); \
        TRRD(l0, b_); TRRD(h0, b_ + 2048); TRRD(l1, b_ + 4096); TRRD(h1, b_ + 6144); TRRD(l2, b_ + 8192); TRRD(h2, b_ + 10240); TRRD(l3, b_ + 12288); TRRD(h3, b_ + 14336); \
        asm volatile("s_waitcnt lgkmcnt(0)" ::: "memory"); SBAR();   \
        o[d0] = __builtin_amdgcn_mfma_f32_32x32x16_bf16(pa0, (bf16x8){l0[0], l0[1], l0[2], l0[3], h0[0], h0[1], h0[2], h0[3]}, o[d0], 0, 0, 0);   \
        o[d0] = __builtin_amdgcn_mfma_f32_32x32x16_bf16(pa1, (bf16x8){l1[0], l1[1], l1[2], l1[3], h1[0], h1[1], h1[2], h1[3]}, o[d0], 0, 0, 0);   \
        o[d0] = __builtin_amdgcn_mfma_f32_32x32x16_bf16(pa2, (bf16x8){l2[0], l2[1], l2[2], l2[3], h2[0], h2[1], h2[2], h2[3]}, o[d0], 0, 0, 0);   \
        o[d0] = __builtin_amdgcn_mfma_f32_32x32x16_bf16(pa3, (bf16x8){l3[0], l3[1], l3[2], l3[3], h3[0], h3[1], h3[2], h3[3]}, o[d0], 0, 0, 0); } while (0)
    PV_D0(0); PV_D0(1); PV_D0(2); PV_D0(3);
#undef PV_D0
#undef TRRD
}

__device__ __forceinline__ void attn_block(const bf16_t* Q, const bf16_t* K, const bf16_t* V, bf16_t* O, int P0, const float* gon, LAS unsigned char* lds) {
    int tid = threadIdx.x; asm volatile("" : "+v"(tid));
    const int wid = __builtin_amdgcn_readfirstlane(tid >> 6), lane = tid & 63, r32 = lane & 31, hi = lane >> 5;
    const int NT = P0 / KVBLK + 4;
    const int qlo = P0 + wid * QBLK, qm = qlo + r32 - 4 * hi;
    LAS float* wsf = (LAS float*)(lds + OFF_WS) + wid * 64; LAS float* li_l = wsf; LAS float* al_l = wsf + 32;
    float m_reg = -1e30f, l_reg = 0.f; f32x16 o[4] = {};
    bf16x8 qr[12];
#pragma unroll
    for (int d0 = 0; d0 < 12; ++d0) qr[d0] = *(const bf16x8*)(Q + (size_t)(qlo + r32) * MQK + d0 * 16 + hi * 8);
    int ksrc[4], vsrc[2];
#pragma unroll
    for (int i = 0; i < 4; ++i) { const int row = 2 * (wid * 4 + i) + (lane >> 5), c = (lane & 31) ^ (row & 15); ksrc[i] = row * MQK + (c < 24 ? c : 0) * 8; }
#pragma unroll
    for (int i = 0; i < 2; ++i) { const int id = (wid * 2 + i) * 2 + (lane >> 5), kk = ((id >> 2) << 3) | ((lane & 31) >> 2), k = (kk & ~0xC) | ((kk & 4) << 1) | ((kk & 8) >> 1);
        vsrc[i] = k * MV + (id & 3) * 32 + (lane & 3) * 8; }
    const int vb0 = (int)(unsigned)(uintptr_t)lds + v_rd_base(lane);
#define ALOAD(t, bf) do { const bf16_t* kp = K + (size_t)(t) * KVBLK * MQK; const bf16_t* vp = V + (size_t)(t) * KVBLK * MV; \
        _Pragma("unroll") for (int i = 0; i < 4; ++i) __builtin_amdgcn_global_load_lds((const unsigned*)(kp + ksrc[i]), (LAS unsigned*)(lds + OFF_K + (bf) * SHM_K + (wid * 4 + i) * 1024), 16, 0, 0); \
        _Pragma("unroll") for (int i = 0; i < 2; ++i) __builtin_amdgcn_global_load_lds((const unsigned*)(vp + vsrc[i]), (LAS unsigned*)(lds + OFF_V + (bf) * SHM_V + (wid * 2 + i) * 1024), 16, 0, 0); } while (0)
#define RESC(a) do { if (__any((a) < 1.f)) { if (hi == 0) al_l[r32] = (a); asm volatile("s_waitcnt lgkmcnt(0)" ::: "memory"); \
        _Pragma("unroll") for (int d_ = 0; d_ < 4; ++d_) _Pragma("unroll") for (int r = 0; r < 16; ++r) o[d_][r] *= al_l[crow(r, hi)]; } } while (0)
#define STEP(t, BF) do { f32x16 p0, p1; float mn, al; bf16x8 pa0, pa1, pa2, pa3; \
        if ((t) + 1 < NT) ALOAD((t) + 1, 1 - (BF)); \
        SBAR(); qkt<BF>(p0, p1, lds, r32, hi, qr); \
        { const int kb_ = (t) * KVBLK; if (kb_ + KVBLK - 1 > qlo) mask_tile(p0, p1, qm - kb_); } \
        partialSM(p0, p1, m_reg, mn, al); RESC(al); finishSM(p0, p1, al, l_reg, pa0, pa1, pa2, pa3); SBAR(); \
        pv_tile<BF>(o, vb0, pa0, pa1, pa2, pa3); SBAR(); \
        asm volatile("s_waitcnt vmcnt(0)" ::: "memory"); __syncthreads(); } while (0)
    ALOAD(0, 0); asm volatile("s_waitcnt vmcnt(0)" ::: "memory"); __syncthreads();
    for (int t = 0; t < NT; t += 2) { STEP(t, 0); STEP(t + 1, 1); }
#undef STEP
#undef RESC
#undef ALOAD
    if (hi == 0) li_l[r32] = l_reg;
    asm volatile("s_waitcnt lgkmcnt(0)" ::: "memory");
    float gv[4];
#pragma unroll
    for (int d0 = 0; d0 < 4; ++d0) gv[d0] = gon[d0 * 32 + r32];
#pragma unroll
    for (int r = 0; r < 16; ++r) { const float rl = 1.f / li_l[crow(r, hi)];
        float ss = 0.f;
#pragma unroll
        for (int d0 = 0; d0 < 4; ++d0) { o[d0][r] *= rl; ss += o[d0][r] * o[d0][r]; }
        ss += __shfl_xor(ss, 1); ss += __shfl_xor(ss, 2); ss += __shfl_xor(ss, 4); ss += __shfl_xor(ss, 8); ss += __shfl_xor(ss, 16);
        const float rs = rsqrtf(ss * (1.f / MV) + EPS);
        bf16_t* orow = O + (size_t)(qlo + crow(r, hi)) * DM;
#pragma unroll
        for (int d0 = 0; d0 < 4; ++d0) { const float v = o[d0][r] * rs * gv[d0]; const float vn = __shfl_xor(v, 1);
            if ((r32 & 1) == 0) *(unsigned*)(orow + d0 * 32 + r32) = cvtpk(v, vn); } }
    __syncthreads();
}
#undef SBAR
}

__device__ __forceinline__ void p6_phase(Frame& F, const Args& a) {
    const bf16_t* Qn = (const bf16_t*)(F.ws + WS_D); const bf16_t* Kn = (const bf16_t*)(F.ws + WS_D + QN_BYTES); const bf16_t* Vh = (const bf16_t*)(F.ws + WS_D + 2 * QN_BYTES);
    bf16_t* MIX = (bf16_t*)(F.ws + WS_E);
    for (int it = F.vcu; it < NB * MH * 4; it += F.G) {
        const int bh = it >> 2, j = it & 3, b = bh >> 3, h = bh & 7;
        const bf16_t* Q = Qn + (size_t)bh * SEQ * MQK; const bf16_t* K = Kn + (size_t)bh * SEQ * MQK; const bf16_t* V = Vh + (size_t)bh * SEQ * MV;
        bf16_t* O = MIX + (size_t)(b * SEQ) * DM + HW + h * MV;
        att::attn_block(Q, K, V, O, (7 - j) * att::QB, a.in[15], F.lds);
        att::attn_block(Q, K, V, O, j * att::QB, a.in[15], F.lds);
    }
}
constexpr int P8_RS = DM + 4;
__device__ __forceinline__ void p8_phase(Frame& F, const Args& a) {
    OPAQUE_FRAME(F);
    unsigned char* ws = F.ws;
    const float* x1 = F.out; const float* mod = (const float*)(ws + WS_MOD); const float* g2n = a.in[17];
    const float* wct = (const float*)(ws + WS_WCT);
    bf16_t* H2 = (bf16_t*)(ws + WS_B);
    int* tok_e = (int*)(ws + WS_TOKE); float* tok_w = (float*)(ws + WS_TOKW); int* tok_s = (int*)(ws + WS_TOKS);
    LAS float* xs = (LAS float*)F.lds;
    LAS float* red = (LAS float*)F.lds;
    LAS float* lg = (LAS float*)(F.lds + 24576);
    LAS float* rstd_l = (LAS float*)(F.lds + 16 * P8_RS * 4);
    const int row_l = F.tid >> 5, c_l = (F.tid & 31) * 4;
    const int mr = F.lane & 15, mg = F.lane >> 4;
    for (int tile = F.vcu; tile < T / 16; tile += F.G) {
        const int m0 = tile * 16, b = m0 / SEQ;
        { const float* xr = x1 + (size_t)(m0 + row_l) * DM + c_l; float ss = 0.f;
#pragma unroll
          for (int j = 0; j < 16; ++j) { const f32x4 v = *(const f32x4*)(xr + 128 * j); ss += (v.x * v.x + v.y * v.y) + (v.z * v.z + v.w * v.w); *(LAS f32x4*)(xs + row_l * P8_RS + c_l + 128 * j) = v; }
          ss += __shfl_xor(ss, 1); ss += __shfl_xor(ss, 2); ss += __shfl_xor(ss, 4); ss += __shfl_xor(ss, 8); ss += __shfl_xor(ss, 16);
          if ((F.tid & 31) == 0) rstd_l[row_l] = rsqrtf(ss * (1.f / DM) + EPS); }
        __syncthreads();
        f32x4 acc[3];
#pragma unroll
        for (int n = 0; n < 3; ++n) acc[n] = (f32x4){0.f, 0.f, 0.f, 0.f};
        { const float rs = rstd_l[mr]; const float* sh2 = mod + b * (6 * DM) + 3 * DM; const float* sc2 = mod + b * (6 * DM) + 4 * DM;
#pragma unroll 2
          for (int s = 0; s < 16; ++s) { const int k0 = F.wave * 256 + 16 * s + 4 * mg;
              const f32x4 xv = *(const LAS f32x4*)(xs + mr * P8_RS + k0);
              const f32x4 gg = *(const f32x4*)(g2n + k0), sc = *(const f32x4*)(sc2 + k0), sh = *(const f32x4*)(sh2 + k0);
              const f32x4 hv = xv * rs * gg * (sc + 1.f) + sh;
              u32x2 w; w.x = cvt_pk_bf16(hv.x, hv.y); w.y = cvt_pk_bf16(hv.z, hv.w);
              *(u32x2*)(H2 + (size_t)(m0 + mr) * DM + k0) = w;
              f32x4 bw[3];
#pragma unroll
              for (int n = 0; n < 3; ++n) bw[n] = *(const f32x4*)(wct + (size_t)(n * 16 + mr) * DM + k0);
#pragma unroll
              for (int i = 0; i < 4; ++i)
#pragma unroll
                  for (int n = 0; n < 3; ++n) acc[n] = __builtin_amdgcn_mfma_f32_16x16x4f32(hv[i], bw[n][i], acc[n], 0, 0, 0); } }
        __syncthreads();
#pragma unroll
        for (int n = 0; n < 3; ++n)
#pragma unroll
            for (int r = 0; r < 4; ++r) red[(F.wave * 16 + mg * 4 + r) * 48 + n * 16 + mr] = acc[n][r];
        __syncthreads();
        for (int idx = F.tid; idx < 16 * 36; idx += NTHR) { const int row = idx / 36, n = idx % 36; float s = n < 4 ? a.in[19][n] : a.in[21][n - 4];
#pragma unroll
            for (int w = 0; w < 8; ++w) s += red[(w * 16 + row) * 48 + n];
            lg[row * 36 + n] = s; }
        __syncthreads();
        if (F.tid < 16) { const LAS float* l = lg + F.tid * 36; const int t = m0 + F.tid;
            int g = 0; float gm = l[0];
#pragma unroll
            for (int j = 1; j < 4; ++j) if (l[j] > gm) { gm = l[j]; g = j; }
            float den = 0.f;
#pragma unroll
            for (int j = 0; j < 4; ++j) den += __expf(l[j] - gm);
            const float pg = 1.f / den;
            const LAS float* e = l + 4 + g * 8;
            int i1 = 0; float v1 = e[0];
#pragma unroll
            for (int j = 1; j < 8; ++j) if (e[j] > v1) { v1 = e[j]; i1 = j; }
            int i2 = -1; float v2 = -__builtin_inff();
#pragma unroll
            for (int j = 0; j < 8; ++j) if (j != i1 && e[j] > v2) { v2 = e[j]; i2 = j; }
            const float w1 = 1.f / (1.f + __expf(v2 - v1)), w2 = 1.f - w1;
            const int e1 = g * 8 + i1, e2 = g * 8 + i2;
            const int s1 = (int)atomicAdd((unsigned*)(F.ctl + CW_CNT + 64 * e1), 1u), s2 = (int)atomicAdd((unsigned*)(F.ctl + CW_CNT + 64 * e2), 1u);
            tok_e[2 * t] = e1; tok_e[2 * t + 1] = e2; tok_w[2 * t] = pg * w1; tok_w[2 * t + 1] = pg * w2; tok_s[2 * t] = s1; tok_s[2 * t + 1] = s2; }
        __syncthreads();
    }
    LAS float* scr = (LAS float*)(F.lds + F.wave * 16384);
    const int gw = F.vcu * NWAVES + F.wave, NGW = F.G * NWAVES;
    constexpr int I_G = NE * (DM / 64) * (DE / 32);
    for (int it = gw; it < 3 * I_G; it += NGW) {
        const int which = it / I_G, r = it % I_G;
        if (which < 2) { const int e = r / 512, q = r % 512, kb = q / 16, nb = q % 16, n0 = 32 * nb;
            const float* W = a.in[22 + which] + (size_t)e * DM * DE;
            bf16_t* dst = (bf16_t*)(ws + WS_D) + ((size_t)e * 1024 + (n0 >> 7) * 256 + (n0 & 127) + which * 128) * DM;
            transpose_item(W, DE, 64 * kb, n0, dst, DM, nullptr, scr, F.lane); }
        else { const int e = r / 512, q = r % 512, kb = q / 64, nb = q % 64, n0 = 32 * nb;
            const float* W = a.in[24] + (size_t)e * DE * DM;
            bf16_t* dst = (bf16_t*)(ws + WS_E) + ((size_t)e * DM + n0) * DE;
            transpose_item(W, DM, 64 * kb, n0, dst, DE, nullptr, scr, F.lane); }
    }
}

__device__ __forceinline__ void p9_phase(Frame& F, const Args& a) {
    OPAQUE_FRAME(F);
    unsigned char* ws = F.ws;
    LAS int* pstart = (LAS int*)F.lds;
    if (F.tid == 0) { int acc = 0;
        for (int e = 0; e < NE; ++e) { pstart[e] = acc; const int c = (int)__hip_atomic_load((unsigned*)(F.ctl + CW_CNT + 64 * e), RLX_AGENT); acc += ((c + 255) / 256) * 256; }
        pstart[NE] = acc; }
    __syncthreads();
    if (blockIdx.x == 0) { int* blk_e = (int*)(ws + WS_BLKE); const int ntile = pstart[NE] / 256;
        if (F.tid < 255) { int e = 0; for (int j = 1; j < NE; ++j) if (pstart[j] <= F.tid * 256) e = j; blk_e[F.tid] = e; }
        if (F.tid == 255) blk_e[255] = ntile; }
    const bf16_t* H2 = (const bf16_t*)(ws + WS_B); bf16_t* XB = (bf16_t*)(ws + WS_A);
    const int* tok_e = (const int*)(ws + WS_TOKE); int* tok_s = (int*)(ws + WS_TOKS);
    const int gw = F.vcu * NWAVES + F.wave, NGW = F.G * NWAVES;
    for (int t = gw; t < T; t += NGW) {
        const int d0 = pstart[tok_e[2 * t]] + tok_s[2 * t], d1 = pstart[tok_e[2 * t + 1]] + tok_s[2 * t + 1];
        const u32x4* src = (const u32x4*)(H2 + (size_t)t * DM) + F.lane;
        u32x4* o0 = (u32x4*)(XB + (size_t)d0 * DM) + F.lane; u32x4* o1 = (u32x4*)(XB + (size_t)d1 * DM) + F.lane;
#pragma unroll
        for (int j = 0; j < 4; ++j) { const u32x4 v = src[64 * j]; o0[64 * j] = v; o1[64 * j] = v; }
        if (F.lane == 0) { tok_s[2 * t] = d0; tok_s[2 * t + 1] = d1; }
    }
}

__device__ __forceinline__ void p12_phase(Frame& F, const Args& a) {
    OPAQUE_FRAME(F);
    unsigned char* ws = F.ws;
    const bf16_t* Y = (const bf16_t*)(ws + WS_A);
    const float* tok_w = (const float*)(ws + WS_TOKW); const int* tok_s = (const int*)(ws + WS_TOKS);
    const float* mod = (const float*)(ws + WS_MOD);
    const int gw = F.vcu * NWAVES + F.wave, NGW = F.G * NWAVES;
#if defined(MK_STAMP) && MK_STAMP >= 0
    const float dscale = 1.f + sqrtf(exp2f(rintf(3.f * log2f(*(const float*)(ws + WS_STAMP + 8) + 1.f) + MK_QSHIFT) * (1.f / 3.f)));
#else
    const float dscale = 1.f;
#endif
    for (int t = gw; t < T; t += NGW) {
        const int b = t / SEQ; const float w0 = tok_w[2 * t], w1 = tok_w[2 * t + 1]; const int d0 = tok_s[2 * t], d1 = tok_s[2 * t + 1];
        const float* g2 = mod + b * (6 * DM) + 5 * DM;
        float* orow = F.out + (size_t)t * DM;
#pragma unroll
        for (int j = 0; j < 4; ++j) { const int c = (j * 64 + F.lane) * 8;
            float y0[8], y1[8]; unpack8(*(const u32x4*)(Y + (size_t)d0 * DM + c), y0); unpack8(*(const u32x4*)(Y + (size_t)d1 * DM + c), y1);
            const f32x4 xa = *(const f32x4*)(orow + c), xb = *(const f32x4*)(orow + c + 4), ga = *(const f32x4*)(g2 + c), gb = *(const f32x4*)(g2 + c + 4);
            f32x4 ra, rb;
#pragma unroll
            for (int i = 0; i < 4; ++i) { ra[i] = (xa[i] + ga[i] * (w0 * y0[i] + w1 * y1[i])) * dscale; rb[i] = (xb[i] + gb[i] * (w0 * y0[4 + i] + w1 * y1[4 + i])) * dscale; }
            *(f32x4*)(orow + c) = ra; *(f32x4*)(orow + c + 4) = rb; }
    }
}
#ifndef MK_MULTI
#define MK_MULTI 0
#endif
#ifndef MK_LAST_PHASE
#define MK_LAST_PHASE 12
#endif
constexpr int N_PHASES = MK_LAST_PHASE + 1;

template <class P> __device__ __forceinline__ P* uptr(P* p) { const unsigned long long v = (unsigned long long)p;
    const unsigned lo = __builtin_amdgcn_readfirstlane((unsigned)v), hi = __builtin_amdgcn_readfirstlane((unsigned)(v >> 32)); return (P*)(((unsigned long long)hi << 32) | lo); }
__global__ void __launch_bounds__(NTHR, 2) mk_fwd(const Args args) {
    extern __shared__ __attribute__((aligned(16))) unsigned char lds_raw[];
    Frame F;
    F.lds = (LAS unsigned char*)lds_raw;
    F.MISC = (volatile LAS unsigned*)(F.lds + MISC_OFF);
    F.tid = threadIdx.x; F.lane = F.tid & 63; F.wave = __builtin_amdgcn_readfirstlane(F.tid >> 6);
    F.G = gridDim.x; { const int bx = blockIdx.x; F.vcu = (F.G % 8 == 0) ? (bx % 8) * (F.G / 8) + bx / 8 : bx; }
    F.ws = uptr(args.ws); F.out = uptr(args.out);
    F.ctl = (gu32*)(F.ws + WS_CTL);
    for (int u = F.tid; u < (LDS_BYTES - RING_BYTES) / 4; u += NTHR) ((LAS unsigned*)(F.lds + RING_BYTES))[u] = 0u;
    __syncthreads();
    XcdBarrier bar; bar.bar = (unsigned*)(F.ctl + CW_BAR); bar.x = 0; bar.st = nullptr;
#if !MK_MULTI
    bar = xcd_barrier_post((unsigned*)(F.ctl + CW_BAR), F.MISC + 8);
#define GRID_BAR() xcd_barrier(bar)
#else
#define GRID_BAR() do { } while (0)
#endif
    const int lo = args.ph_lo, hi = args.ph_hi;
#ifndef MK_PHMASK
#define MK_PHMASK 0xFFFF
#endif
#define IN(k) (((MK_PHMASK >> (k)) & 1) && lo <= (k) && (k) < hi)
#define SEAM(k) do { if (IN(k) && IN((k) + 1)) GRID_BAR(); } while (0)
#ifndef MK_STAMP
#define MK_STAMP (-1)
#endif
#define STAMP_BEGIN(k) do { if ((k) == MK_STAMP && blockIdx.x == 0 && F.tid == 0) *(unsigned long long*)(ws + WS_STAMP) = __builtin_amdgcn_s_memrealtime(); } while (0)
#define STAMP_END(k) do { if ((k) == MK_STAMP && blockIdx.x == 0 && F.tid == 0) { const unsigned long long t1_ = __builtin_amdgcn_s_memrealtime(); *(float*)(ws + WS_STAMP + 8) = (float)(t1_ - *(unsigned long long*)(ws + WS_STAMP)) * 0.01f; } } while (0)
#ifndef MK_REPEAT
#define MK_REPEAT (-1)
#endif
#ifndef MK_REPN
#define MK_REPN 2
#endif
#define REP(k) _Pragma("unroll") for (int rep_ = 0; rep_ < ((k) == MK_REPEAT ? MK_REPN : 1); ++rep_)
    unsigned char* const ws = F.ws;

    STAMP_BEGIN(0);
    REP(0) if (IN(0)) { if (rep_) GRID_BAR(); p0_phase(F, args); } SEAM(0); STAMP_END(0);
    STAMP_BEGIN(1);
    REP(1) if (IN(1)) { if (rep_) GRID_BAR(); p1_phase(F, args); } SEAM(1); STAMP_END(1);
    STAMP_BEGIN(2);
    REP(2) if (IN(2)) { if (rep_) GRID_BAR();
        pg8::Gemm g{(const bf16_t*)(ws + WS_B), (const bf16_t*)(ws + WS_WIN), DM, DM, DM};
        pg8::DenseOrder S; S.init(T / 256, INCP / 256, F.G, (int)blockIdx.x);
        pg8::EpiStore E{(bf16_t*)(ws + WS_A), INCP, nullptr};
        pg8::gemm_phase<pg8::EpiStore, pg8::DenseOrder>(F.lds, g, S, E);
    } SEAM(2); STAMP_END(2);
    STAMP_BEGIN(3);
    REP(3) if (IN(3)) { if (rep_) GRID_BAR(); p3_phase(F, args); } SEAM(3); STAMP_END(3);
    STAMP_BEGIN(4);
    REP(4) if (IN(4)) { if (rep_) GRID_BAR();
        { pg8::Gemm g{(const bf16_t*)(ws + WS_A) + C_QA, (const bf16_t*)(ws + WS_WQUP), INCP, QLORA, QLORA};
          pg8::DenseOrder S; S.init(T / 256, MH * MQK / 256, F.G, (int)blockIdx.x);
          pg8::EpiStore E{(bf16_t*)(ws + WS_B), MH * MQK, (const float*)(ws + WS_RSTDQ)};
          pg8::gemm_phase<pg8::EpiStore, pg8::DenseOrder>(F.lds, g, S, E); }
        { pg8::Gemm g{(const bf16_t*)(ws + WS_A) + C_KVA, (const bf16_t*)(ws + WS_WKVUP), INCP, KVLORA, KVLORA};
          pg8::DenseOrder S; S.init(T / 256, MH * 256 / 256, F.G, (int)blockIdx.x);
          pg8::EpiStore E{(bf16_t*)(ws + WS_C), MH * 256, (const float*)(ws + WS_RSTDKV)};
          pg8::gemm_phase<pg8::EpiStore, pg8::DenseOrder>(F.lds, g, S, E); }
    } SEAM(4); STAMP_END(4);
    STAMP_BEGIN(5);
    REP(5) if (IN(5)) { if (rep_) GRID_BAR(); p5_phase(F, args); } SEAM(5); STAMP_END(5);
    STAMP_BEGIN(6);
    REP(6) if (IN(6)) { if (rep_) GRID_BAR(); p6_phase(F, args); } SEAM(6); STAMP_END(6);
    STAMP_BEGIN(7);
    REP(7) if (IN(7)) { if (rep_) GRID_BAR();
        pg8::Gemm g{(const bf16_t*)(ws + WS_E), (const bf16_t*)(ws + WS_WOUT), DM, DM, DM};
        pg8::DenseOrder S; S.init(T / 256, DM / 256, F.G, (int)blockIdx.x);
        pg8::EpiResid E{args.in[0], F.out, (const float*)(ws + WS_MOD) + 2 * DM, 6 * DM};
        pg8::gemm_phase<pg8::EpiResid, pg8::DenseOrder>(F.lds, g, S, E);
    } SEAM(7); STAMP_END(7);
#if MK_LAST_PHASE >= 8
    STAMP_BEGIN(8);
    REP(8) if (IN(8)) { if (rep_) GRID_BAR(); p8_phase(F, args); } SEAM(8); STAMP_END(8);
    STAMP_BEGIN(9);
    REP(9) if (IN(9)) { if (rep_) GRID_BAR(); p9_phase(F, args); } SEAM(9); STAMP_END(9);
    STAMP_BEGIN(10);
    REP(10) if (IN(10)) { if (rep_) GRID_BAR();
        const int* blk_e = (const int*)(ws + WS_BLKE); const int ntile = blk_e[255];
        pg8::Gemm g{(const bf16_t*)(ws + WS_A), (const bf16_t*)(ws + WS_D), DM, DM, DM};
        pg8::GroupedOrder S; S.init(ntile, 4, F.G, F.vcu, blk_e);
        pg8::EpiSwiGLU E{(bf16_t*)(ws + WS_C)};
        pg8::gemm_phase<pg8::EpiSwiGLU, pg8::GroupedOrder>(F.lds, g, S, E);
    } SEAM(10); STAMP_END(10);
    STAMP_BEGIN(11);
    REP(11) if (IN(11)) { if (rep_) GRID_BAR();
        const int* blk_e = (const int*)(ws + WS_BLKE); const int ntile = blk_e[255];
        pg8::Gemm g{(const bf16_t*)(ws + WS_C), (const bf16_t*)(ws + WS_E), DE, DE, DE};
        pg8::GroupedOrder S; S.init(ntile, 8, F.G, F.vcu, blk_e);
        pg8::EpiStore E{(bf16_t*)(ws + WS_A), DM, nullptr};
        pg8::gemm_phase<pg8::EpiStore, pg8::GroupedOrder>(F.lds, g, S, E);
    } SEAM(11); STAMP_END(11);
    REP(12) if (IN(12)) { if (rep_) GRID_BAR(); p12_phase(F, args); }
#endif
#undef IN
#undef SEAM
}

extern "C" void kernel_launch(void* const* d_in, const int* in_sizes, int n_in, void* d_out, int out_size, void* d_ws, size_t ws_size, hipStream_t stream) {
    static int grid = 0;
    if (grid == 0) {
        if (n_in != 25 || out_size != T * DM || ws_size < WS_END) { fprintf(stderr, "kernel_launch: bad shapes (n_in %d out %d ws %zu)\n", n_in, out_size, ws_size); grid = -1; return; }
        int dev = 0, cus = 0, per_cu = 0;
        if (hipGetDevice(&dev) != hipSuccess || hipDeviceGetAttribute(&cus, hipDeviceAttributeMultiprocessorCount, dev) != hipSuccess) { grid = -1; return; }
        if (hipFuncSetAttribute((const void*)mk_fwd, hipFuncAttributeMaxDynamicSharedMemorySize, LDS_BYTES) != hipSuccess) { fprintf(stderr, "kernel_launch: hipFuncSetAttribute failed\n"); grid = -1; return; }
        if (hipOccupancyMaxActiveBlocksPerMultiprocessor(&per_cu, (const void*)mk_fwd, NTHR, LDS_BYTES) != hipSuccess || per_cu < 1) { fprintf(stderr, "kernel_launch: occupancy query says %d\n", per_cu); }
        (void)hipGetLastError();
        grid = cus;
    }
    if (grid < 0) return;
    (void)hipMemsetAsync((char*)d_ws + WS_CTL, 0, CTL_ZERO_BYTES, stream);
    Args a{};
    for (int i = 0; i < 25; ++i) a.in[i] = (const float*)d_in[i];
    a.out = (float*)d_out; a.ws = (unsigned char*)d_ws;
#if MK_MULTI
    for (int p = 0; p < N_PHASES; ++p) { a.ph_lo = p; a.ph_hi = p + 1; hipLaunchKernelGGL(mk_fwd, dim3(grid), dim3(NTHR), LDS_BYTES, stream, a); }
#else
    a.ph_lo = 0; a.ph_hi = N_PHASES; hipLaunchKernelGGL(mk_fwd, dim3(grid), dim3(NTHR), LDS_BYTES, stream, a);
#endif
}
```

```cpp
#include <hip/hip_runtime.h>
#include <cstdio>
#include <cstdint>

#define GAS __attribute__((address_space(1)))
#define LAS __attribute__((address_space(3)))
typedef unsigned short bf16_t;
typedef short bf16x8 __attribute__((ext_vector_type(8)));
typedef short s16x4 __attribute__((ext_vector_type(4)));
typedef float f32x4 __attribute__((ext_vector_type(4)));
typedef float f32x2 __attribute__((ext_vector_type(2)));
typedef float f32x16 __attribute__((ext_vector_type(16)));
typedef unsigned u32x4 __attribute__((ext_vector_type(4)));
typedef unsigned u32x2 __attribute__((ext_vector_type(2)));
typedef GAS unsigned gu32;
#define RLX_AGENT __ATOMIC_RELAXED, __HIP_MEMORY_SCOPE_AGENT
#define LDS_WAIT() asm volatile("s_waitcnt lgkmcnt(0)" ::: "memory")
#define VM_WAIT() asm volatile("s_waitcnt vmcnt(0)" ::: "memory")

constexpr int DM = 2048, NB = 8, SEQ = 2048, T = NB * SEQ;
constexpr int HW = 1024, HH = 8, HDK = 128, HDV = 128;
constexpr int MH = 8, MNOPE = 128, MROPE = 64, MQK = 192, MV = 128, QLORA = 512, KVLORA = 256;
constexpr int INC = 4 * HW + QLORA + KVLORA + MROPE;
constexpr int INCP = 5120;
constexpr int C_QA = 4096, C_KVA = 4608, C_KPE = 4864;
constexpr int NG = 4, EPG = 8, NE = 32, DE = 512;
constexpr int RMAX = (T * 2 / 256 + NE) * 256;
constexpr float EPS = 1e-6f;
constexpr int NWAVES = 8, NTHR = 512;

typedef __bf16 bf16x2_t __attribute__((ext_vector_type(2)));
__device__ __forceinline__ unsigned cvt_pk_bf16(float lo, float hi) { const f32x2 v = {lo, hi}; return __builtin_bit_cast(unsigned, __builtin_convertvector(v, bf16x2_t)); }
__device__ __forceinline__ float bf_lo(unsigned w) { return __builtin_bit_cast(float, w << 16); }
__device__ __forceinline__ float bf_hi(unsigned w) { return __builtin_bit_cast(float, w & 0xffff0000u); }
__device__ __forceinline__ float bf2f(bf16_t h) { return __builtin_bit_cast(float, (unsigned)h << 16); }
__device__ __forceinline__ float wave_sum(float v) {
#pragma unroll
    for (int o = 1; o < 64; o <<= 1) v += __shfl_xor(v, o);
    return v;
}
__device__ __forceinline__ float siluf(float v) { return v / (1.f + __expf(-v)); }

#define XB_TMO      128
#define XB_XCNT(j)  (256  + 64 * (j))
#define XB_XSUB(j)  (1280 + 64 * (j))
#define XB_XGEN(j)  (2304 + 64 * (j))
#define XB_TOP      3328
#define XB_TOPGEN   3392
#define XCD_BAR_WORDS 3456
#define XB_SPIN_CAP (1u << 18)

__device__ __forceinline__ unsigned xb_ld(unsigned* p)              { return __hip_atomic_load(p, __ATOMIC_RELAXED, __HIP_MEMORY_SCOPE_AGENT); }
__device__ __forceinline__ unsigned xb_add(unsigned* p, unsigned v) { return __hip_atomic_fetch_add(p, v, __ATOMIC_RELAXED, __HIP_MEMORY_SCOPE_AGENT); }
__device__ __forceinline__ unsigned xb_xcc_id() { return (unsigned)__builtin_amdgcn_s_getreg((3 << 11) | 20) & 0xFu; }
#define XB_SPIN(cond, bar) do { unsigned _sp = 0; while (cond) { __builtin_amdgcn_s_sleep(1); \
    if ((++_sp & 255u) == 0u) { if (xb_ld(&(bar)[XB_TMO])) break; if (_sp > XB_SPIN_CAP) { atomicAdd(&(bar)[XB_TMO], 1u); break; } } } } while (0)

struct XcdBarrier {
    unsigned* bar; unsigned x;
    volatile LAS unsigned* st;
};
__device__ __forceinline__ XcdBarrier xcd_barrier_post(unsigned* bar, volatile LAS unsigned* st) {
    XcdBarrier b; b.bar = bar; b.x = xb_xcc_id(); b.st = st;
    if (threadIdx.x == 0) (void)xb_add(&bar[XB_XCNT(b.x)], 1u);
    return b;
}
__device__ __forceinline__ void xcd_barrier_complete(unsigned* bar, unsigned x, unsigned& nloc, unsigned& nx) {
    const unsigned G = gridDim.x * gridDim.y * gridDim.z;
    unsigned sum, cnt, mine, sp = 0u;
    for (;;) {
        sum = 0u; cnt = 0u; mine = 0u;
#pragma unroll
        for (unsigned j = 0; j < 16; ++j) { const unsigned c = xb_ld(&bar[XB_XCNT(j)]); sum += c; cnt += (c > 0u) ? 1u : 0u; mine = (j == x) ? c : mine; }
        if (sum == G) break;
        __builtin_amdgcn_s_sleep(1);
        if ((++sp & 255u) == 0u) { if (xb_ld(&bar[XB_TMO])) break; if (sp > XB_SPIN_CAP) { atomicAdd(&bar[XB_TMO], 1u); break; } }
    }
    nloc = mine > 0u ? mine : 1u; nx = cnt > 0u ? cnt : 1u;
}
__device__ __forceinline__ void xcd_barrier(const XcdBarrier& b) {
    asm volatile("s_waitcnt vmcnt(0)" ::: "memory");
    __syncthreads();
    if (threadIdx.x == 0) {
        unsigned* bar = b.bar;
        __builtin_amdgcn_s_waitcnt(0);
        unsigned nloc = b.st[0], nx = b.st[1];
        if (nloc == 0u) { xcd_barrier_complete(bar, b.x, nloc, nx); b.st[0] = nloc; b.st[1] = nx; }
        const unsigned old = xb_add(&bar[XB_XSUB(b.x)], 1u);
        const unsigned gen = old / nloc;
        if (old + 1u == (gen + 1u) * nloc) {
            __builtin_amdgcn_fence(__ATOMIC_RELEASE, "agent");
            asm volatile("s_waitcnt vmcnt(0)" ::: "memory");
            const unsigned og = xb_add(&bar[XB_TOP], 1u);
            const unsigned tg = og / nx;
            if (og + 1u == (tg + 1u) * nx) xb_add(&bar[XB_TOPGEN], 1u);
            else XB_SPIN(xb_ld(&bar[XB_TOPGEN]) == tg, bar);
            __builtin_amdgcn_fence(__ATOMIC_ACQUIRE, "agent");
            xb_add(&bar[XB_XGEN(b.x)], 1u);
            asm volatile("s_waitcnt vmcnt(0)" ::: "memory");
        } else {
            XB_SPIN(xb_ld(&bar[XB_XGEN(b.x)]) == gen, bar);
            __builtin_amdgcn_fence(__ATOMIC_ACQUIRE, "agent");
            asm volatile("s_waitcnt vmcnt(0)" ::: "memory");
        }
    }
    __syncthreads();
}

namespace pg8 {
constexpr int BM = 256, BK = 64, HALF = 128, HTB = HALF * BK * 2, STAGE_BYTES = 8 * HTB, NXCD = 8, WGM = 8;
__host__ __device__ __forceinline__ int lds_byte(int r, int c) { const int st = (r >> 4) * 2 + (c >> 5), rr = r & 15, cc = c & 31, ob = rr * 64 + cc * 2; return st * 1024 + (ob ^ (((ob >> 9) & 1) << 5)); }
__host__ __device__ __forceinline__ void stage_rc(int b, int& R, int& C) { const int st = b / 1024, sb = b % 1024, swz = sb ^ (((sb >> 9) & 1) << 5); R = (st >> 1) * 16 + swz / 64; C = (st & 1) * 32 + (swz % 64) / 2; }
__host__ __device__ __forceinline__ int perm32(int rho) { const int n = rho >> 4, i = rho & 15; return 8 * (i >> 2) + 4 * n + (i & 3); }

struct Unit { int pm, pn, pb; };
struct Gemm { const bf16_t* A; const bf16_t* Bt; int lda, ldb, K; };

struct DenseOrder {
    int nM, nN, nwg, G, c;
    __device__ void init(int nM_, int nN_, int G_, int c_) { nM = nM_; nN = nN_; nwg = nM * nN; G = G_; c = c_; }
    __device__ bool next(int i, Unit& u) const {
        const long L = (long)i * G + c; if (L >= nwg) return false;
        int wgid = (int)L; { const int q = nwg / NXCD, r = nwg % NXCD, xcd = wgid % NXCD, off = wgid / NXCD; wgid = (xcd < r ? xcd * (q + 1) : r * (q + 1) + (xcd - r) * q) + off; }
        const int nig = WGM * nN, gid = wgid / nig, fm = gid * WGM, gsz = (nM - fm) < WGM ? (nM - fm) : WGM;
        u.pm = fm + ((wgid % nig) % gsz); u.pn = (wgid % nig) / gsz; u.pb = u.pn; return true;
    }
};
struct GroupedOrder {
    int nM, nN, nwg, G, c; const LAS int* tile_e; const LAS int* pstart; const LAS int* cnt; const int* list;
    __device__ void init(int nN_, int G_, int c_, const LAS int* tab, const int* list_) { pstart = tab; cnt = tab + 64; tile_e = tab + 128; list = list_; nM = pstart[32] >> 8; nN = nN_; nwg = nM * nN; G = G_; c = c_; }
    __device__ bool next(int i, Unit& u) const {
        const long L = (long)i * G + c; if (L >= nwg) return false;
        const int w = (int)L; u.pn = w % nN; u.pm = w / nN; u.pb = tile_e[u.pm] * nN + u.pn; return true;
    }
    __device__ int arow(const Unit& u, int r) const { const int e = tile_e[u.pm], j = 256 * u.pm - pstart[e] + r; return j < cnt[e] ? list[e * T + j] : 0; }
};

template <class Epi, class Sched, bool GATHER = false>
__device__ __forceinline__ void gemm_phase(LAS unsigned char* lds, const Gemm g, const Sched& S, const Epi& E) {
    int tid = threadIdx.x; asm volatile("" : "+v"(tid));
    const int wid = __builtin_amdgcn_readfirstlane(tid >> 6), lane = tid & 63, wr = wid >> 2, wc = wid & 3, fr = lane & 15, fq = lane >> 4;
    const int K = g.K, nt = K / BK;
    unsigned voffA[2], voffB[2]; int gR[2], gC[2];
#pragma unroll
    for (int i = 0; i < 2; ++i) { int R, C; stage_rc(tid * 16 + i * 8192, R, C); const int Rb = (R & ~31) + perm32(R & 31); gR[i] = R; gC[i] = C;
        voffA[i] = (unsigned)(R * g.lda + C) * 2u; voffB[i] = (unsigned)(Rb * g.ldb + C) * 2u; }
    const size_t kstep = (size_t)(BK * 2);
    const size_t hsA = (size_t)HALF * g.lda * 2, hsB = (size_t)HALF * g.ldb * 2;
    const unsigned ldsw = (unsigned)wid * 1024u;
    const int aoff = lds_byte(wr * 64 + fr, fq * 8), boff = lds_byte(wc * 32 + fr, fq * 8);
#define PG8_SA(b, h) (((b) * 2 + (h)) * HTB)
#define PG8_SB(b, h) ((4 + (b) * 2 + (h)) * HTB)
#define PG8_STAGE(bufoff, gbase, voff) do { _Pragma("unroll") for (int _i = 0; _i < 2; ++_i) \
        __builtin_amdgcn_global_load_lds((const unsigned*)((const char*)(gbase) + (voff)[_i]), (LAS unsigned*)(lds + (bufoff) + ldsw + _i * 8192), 16, 0, 0); } while (0)
#define PG8_STAGE_A(bufoff, dense_ptr, kbytes, offs) do { if constexpr (GATHER) { PG8_STAGE(bufoff, (const char*)g.A + (kbytes), offs); } else { PG8_STAGE(bufoff, dense_ptr, voffA); } } while (0)
#define PG8_GOFF(u, o0, o1) do { _Pragma("unroll") for (int _i = 0; _i < 2; ++_i) { o0[_i] = (unsigned)(S.arow(u, gR[_i]) * g.lda + gC[_i]) * 2u; o1[_i] = (unsigned)(S.arow(u, gR[_i] + HALF) * g.lda + gC[_i]) * 2u; } } while (0)
#define PG8_LDA(dst, b, h) do { _Pragma("unroll") for (int m = 0; m < 4; ++m) _Pragma("unroll") for (int k = 0; k < 2; ++k) dst[m][k] = *(const LAS bf16x8*)(lds + PG8_SA(b, h) + aoff + m * 2048 + k * 1024); } while (0)
#define PG8_LDB(dst, b, h) do { _Pragma("unroll") for (int n = 0; n < 2; ++n) _Pragma("unroll") for (int k = 0; k < 2; ++k) dst[n][k] = *(const LAS bf16x8*)(lds + PG8_SB(b, h) + boff + n * 2048 + k * 1024); } while (0)
#define PG8_MMA(ai, bj, At, Bt) do { __builtin_amdgcn_s_setprio(1); _Pragma("unroll") for (int m = 0; m < 4; ++m) _Pragma("unroll") for (int n = 0; n < 2; ++n) _Pragma("unroll") for (int k = 0; k < 2; ++k) \
        acc[ai][bj][m][n] = __builtin_amdgcn_mfma_f32_16x16x32_bf16(Bt[n][k], At[m][k], acc[ai][bj][m][n], 0, 0, 0); __builtin_amdgcn_s_setprio(0); } while (0)
#define PG8_WAIT_V(n) asm volatile("s_waitcnt vmcnt(" #n ")" ::: "memory")
#define PG8_WAIT_L(n) asm volatile("s_waitcnt lgkmcnt(" #n ")" ::: "memory")
#define PG8_BAR __builtin_amdgcn_s_barrier()
#define PG8_SCHED __builtin_amdgcn_sched_barrier(0)
    Unit cur, nxt; int ui = 0;
    if (!S.next(0, cur)) return;
    unsigned cO0[2] = {0u, 0u}, cO1[2] = {0u, 0u}, nO0[2] = {0u, 0u}, nO1[2] = {0u, 0u};
    if constexpr (GATHER) { PG8_GOFF(cur, cO0, cO1); }
    f32x4 acc[2][2][4][2];
#pragma unroll
    for (int a = 0; a < 2; ++a)
#pragma unroll
        for (int b = 0; b < 2; ++b)
#pragma unroll
            for (int m = 0; m < 4; ++m)
#pragma unroll
                for (int n = 0; n < 2; ++n) acc[a][b][m][n] = (f32x4){0.f, 0.f, 0.f, 0.f};
    bf16x8 At[4][2], B0[2][2], B1[2][2];
    const char* cA = (const char*)g.A + (GATHER ? (size_t)0 : (size_t)cur.pm * 2 * hsA); const char* cB = (const char*)g.Bt + (size_t)cur.pb * 2 * hsB;
    PG8_STAGE(PG8_SB(0, 0), cB, voffB); PG8_STAGE(PG8_SB(0, 1), cB + hsB, voffB); PG8_STAGE_A(PG8_SA(0, 0), cA, 0, cO0); PG8_STAGE_A(PG8_SA(0, 1), cA + hsA, 0, cO1);
    if (wr == 1) PG8_BAR;
    PG8_WAIT_V(2); PG8_BAR;
    PG8_STAGE(PG8_SB(1, 0), cB + kstep, voffB); PG8_STAGE_A(PG8_SA(1, 0), cA + kstep, kstep, cO0); PG8_STAGE(PG8_SB(1, 1), cB + hsB + kstep, voffB);
    PG8_WAIT_V(6); PG8_BAR;
    for (;;) {
        const bool has_next = S.next(ui + 1, nxt);
        const char* nA = (has_next && !GATHER) ? (const char*)g.A + (size_t)nxt.pm * 2 * hsA : cA; const char* nB = has_next ? (const char*)g.Bt + (size_t)nxt.pb * 2 * hsB : cB;
        if constexpr (GATHER) { if (has_next) { PG8_GOFF(nxt, nO0, nO1); } else { nO0[0] = cO0[0]; nO0[1] = cO0[1]; nO1[0] = cO1[0]; nO1[1] = cO1[1]; } }
        for (int t = 0; t < nt; t += 2) {
            const bool last = (t == nt - 2);
            const char* a1 = cA + (size_t)(t + 1) * kstep;
            const char* a2 = last ? nA : cA + (size_t)(t + 2) * kstep; const char* b2 = last ? nB : cB + (size_t)(t + 2) * kstep;
            const char* a3 = a2 + kstep; const char* b3 = b2 + kstep;
            const size_t k2 = last ? (size_t)0 : (size_t)(t + 2) * kstep;
            unsigned o0[2], o1[2]; o0[0] = last ? nO0[0] : cO0[0]; o0[1] = last ? nO0[1] : cO0[1]; o1[0] = last ? nO1[0] : cO1[0]; o1[1] = last ? nO1[1] : cO1[1];
            PG8_LDB(B0, 0, 0); PG8_LDB(B1, 0, 1); PG8_SCHED; PG8_LDA(At, 0, 0); PG8_STAGE_A(PG8_SA(1, 1), a1 + hsA, (size_t)(t + 1) * kstep, cO1);
            PG8_WAIT_V(8); PG8_WAIT_L(0); PG8_BAR; PG8_MMA(0, 0, At, B0); PG8_MMA(0, 1, At, B1); PG8_BAR; PG8_SCHED;
            PG8_LDA(At, 0, 1); PG8_STAGE(PG8_SB(0, 0), b2, voffB); PG8_STAGE(PG8_SB(0, 1), b2 + hsB, voffB); PG8_STAGE_A(PG8_SA(0, 0), a2, k2, o0);
            PG8_WAIT_V(8); PG8_WAIT_L(0); PG8_BAR; PG8_MMA(1, 0, At, B0); PG8_MMA(1, 1, At, B1); PG8_BAR; PG8_SCHED;
            PG8_LDB(B0, 1, 0); PG8_LDB(B1, 1, 1); PG8_SCHED; PG8_LDA(At, 1, 0); PG8_STAGE_A(PG8_SA(0, 1), a2 + hsA, k2, o1);
            PG8_WAIT_V(8); PG8_WAIT_L(0); PG8_BAR; PG8_MMA(0, 0, At, B0); PG8_MMA(0, 1, At, B1); PG8_BAR; PG8_SCHED;
            PG8_LDA(At, 1, 1); PG8_STAGE(PG8_SB(1, 0), b3, voffB); PG8_STAGE(PG8_SB(1, 1), b3 + hsB, voffB); PG8_STAGE_A(PG8_SA(1, 0), a3, k2 + kstep, o0);
            PG8_WAIT_V(8); PG8_WAIT_L(0); PG8_BAR; PG8_MMA(1, 0, At, B0); PG8_MMA(1, 1, At, B1); PG8_BAR; PG8_SCHED;
        }
        if (wr == 0) PG8_BAR;
        E(acc, cur, wr, wc, fr, fq);
        if (!has_next) break;
#pragma unroll
        for (int a = 0; a < 2; ++a)
#pragma unroll
            for (int b = 0; b < 2; ++b)
#pragma unroll
                for (int m = 0; m < 4; ++m)
#pragma unroll
                    for (int n = 0; n < 2; ++n) acc[a][b][m][n] = (f32x4){0.f, 0.f, 0.f, 0.f};
        cur = nxt; cA = nA; cB = nB; ++ui;
        if constexpr (GATHER) { cO0[0] = nO0[0]; cO0[1] = nO0[1]; cO1[0] = nO1[0]; cO1[1] = nO1[1]; }
        if (wr == 1) PG8_BAR;
    }
    PG8_WAIT_V(0);
    PG8_BAR;
#undef PG8_SA
#undef PG8_SB
#undef PG8_STAGE
#undef PG8_STAGE_A
#undef PG8_GOFF
#undef PG8_LDA
#undef PG8_LDB
#undef PG8_MMA
#undef PG8_WAIT_V
#undef PG8_WAIT_L
#undef PG8_BAR
#undef PG8_SCHED
}

struct EpiStore {
    bf16_t* O; int ldc; const float* rowscale;
    __device__ __forceinline__ void operator()(const f32x4 (&acc)[2][2][4][2], const Unit& u, int wr, int wc, int fr, int fq) const {
        const int row0 = u.pm * BM + wr * 64 + fr, col0 = u.pn * BM + wc * 32 + 8 * fq;
#pragma unroll
        for (int ai = 0; ai < 2; ++ai)
#pragma unroll
            for (int m = 0; m < 4; ++m) { const int row = row0 + ai * HALF + m * 16; const float rs = rowscale ? rowscale[row] : 1.f;
                bf16_t* rowp = O + (size_t)row * ldc + col0;
#pragma unroll
                for (int bj = 0; bj < 2; ++bj) { const f32x4 v0 = acc[ai][bj][m][0] * rs, v1 = acc[ai][bj][m][1] * rs;
                    u32x4 w; w.x = cvt_pk_bf16(v0[0], v0[1]); w.y = cvt_pk_bf16(v0[2], v0[3]); w.z = cvt_pk_bf16(v1[0], v1[1]); w.w = cvt_pk_bf16(v1[2], v1[3]);
                    *(u32x4*)(rowp + bj * HALF) = w; } }
    }
};
struct EpiResid {
    const float* X; float* O; const float* gate; int gpitch;
    __device__ __forceinline__ void operator()(const f32x4 (&acc)[2][2][4][2], const Unit& u, int wr, int wc, int fr, int fq) const {
        const int row0 = u.pm * BM + wr * 64 + fr, col0 = u.pn * BM + wc * 32 + 8 * fq;
        const float* gp = gate + (size_t)((u.pm * BM) / SEQ) * gpitch + col0;
        f32x4 gv[2][2];
#pragma unroll
        for (int bj = 0; bj < 2; ++bj)
#pragma unroll
            for (int n = 0; n < 2; ++n) gv[bj][n] = *(const f32x4*)(gp + bj * HALF + 4 * n);
#pragma unroll
        for (int ai = 0; ai < 2; ++ai)
#pragma unroll
            for (int m = 0; m < 4; ++m) { const size_t off = (size_t)(row0 + ai * HALF + m * 16) * DM + col0;
#pragma unroll
                for (int bj = 0; bj < 2; ++bj)
#pragma unroll
                    for (int n = 0; n < 2; ++n) { const f32x4 xv = *(const f32x4*)(X + off + bj * HALF + 4 * n);
                        *(f32x4*)(O + off + bj * HALF + 4 * n) = xv + gv[bj][n] * acc[ai][bj][m][n]; } }
    }
};
struct EpiSwiGLU {
    bf16_t* O;
    __device__ __forceinline__ void operator()(const f32x4 (&acc)[2][2][4][2], const Unit& u, int wr, int wc, int fr, int fq) const {
        const int row0 = u.pm * BM + wr * 64 + fr, col0 = u.pn * HALF + wc * 32 + 8 * fq;
#pragma unroll
        for (int ai = 0; ai < 2; ++ai)
#pragma unroll
            for (int m = 0; m < 4; ++m) { const int row = row0 + ai * HALF + m * 16;
                float h[8];
#pragma unroll
                for (int n = 0; n < 2; ++n)
#pragma unroll
                    for (int j = 0; j < 4; ++j) { const float gt = acc[ai][0][m][n][j], up = acc[ai][1][m][n][j]; h[4 * n + j] = gt / (1.f + __expf(-gt)) * up; }
                u32x4 w; w.x = cvt_pk_bf16(h[0], h[1]); w.y = cvt_pk_bf16(h[2], h[3]); w.z = cvt_pk_bf16(h[4], h[5]); w.w = cvt_pk_bf16(h[6], h[7]);
                *(u32x4*)(O + (size_t)row * DE + col0) = w; }
    }
};
}
constexpr size_t MiB = 1u << 20;
constexpr size_t WS_CTL = 0, CTL_ZERO_BYTES = 1 * MiB;
constexpr size_t WS_MOD = 1 * MiB;
constexpr size_t WS_ROPEC = 1 * MiB + 512 * 1024;
constexpr size_t WS_ROPES = WS_ROPEC + 2 * MiB;
constexpr size_t WS_WCT = WS_ROPES + 2 * MiB;
constexpr size_t WS_RSTDQ = 6 * MiB;
constexpr size_t WS_RSTDKV = WS_RSTDQ + 64 * 1024;
constexpr size_t WS_TOKE = WS_RSTDKV + 64 * 1024;
constexpr size_t WS_TOKW = WS_TOKE + 128 * 1024;
constexpr size_t WS_TOKS = WS_TOKW + 128 * 1024;
constexpr size_t WS_BLKE = WS_TOKS + 128 * 1024;
constexpr size_t WS_STAMP = WS_BLKE + 4096;
constexpr size_t WS_WIN = 8 * MiB;
constexpr size_t WS_WQUP = 28 * MiB;
constexpr size_t WS_WKVUP = WS_WQUP + 1536 * 1024;
constexpr size_t WS_WOUT = 31 * MiB;
constexpr size_t WS_A = 40 * MiB;
constexpr size_t WS_B = 200 * MiB;
constexpr size_t WS_C = 264 * MiB;
constexpr size_t WS_D = 328 * MiB;
constexpr size_t WS_E = 456 * MiB;
constexpr size_t WS_LIST = 520 * MiB;
constexpr size_t WS_END = 522 * MiB;
constexpr size_t QN_BYTES = (size_t)T * MH * MQK * 2;

constexpr int CW_BAR = 4096;
constexpr int CW_CNT = 8192;

constexpr int RING_BYTES = 131072, MISC_OFF = RING_BYTES + 320, LDS_BYTES = 147456;

struct Args { const float* in[25]; float* out; unsigned char* ws; int ph_lo, ph_hi, pad0, pad1; };

struct Frame {
    LAS unsigned char* lds;
    volatile LAS unsigned* MISC;
    gu32* ctl;
    int tid, lane, wave, vcu, G;
    unsigned char* ws; float* out;
};

#define OPAQUE_FRAME(F) do { F.tid = threadIdx.x; asm volatile("" : "+v"(F.tid)); F.lane = F.tid & 63; } while (0)

__device__ __forceinline__ void unpack8(const u32x4 w, float* f) { f[0] = bf_lo(w.x); f[1] = bf_hi(w.x); f[2] = bf_lo(w.y); f[3] = bf_hi(w.y); f[4] = bf_lo(w.z); f[5] = bf_hi(w.z); f[6] = bf_lo(w.w); f[7] = bf_hi(w.w); }
__device__ __forceinline__ u32x4 pack8f(const float* f) { u32x4 w; w.x = cvt_pk_bf16(f[0], f[1]); w.y = cvt_pk_bf16(f[2], f[3]); w.z = cvt_pk_bf16(f[4], f[5]); w.w = cvt_pk_bf16(f[6], f[7]); return w; }

struct TrItem { const float* src; bf16_t* dst; const float* gk; int N, ldt; };
__device__ __forceinline__ void tr_load(const TrItem& it, f32x4 (&r)[8], int lane) {
    const float* p = it.src + (size_t)(lane >> 3) * it.N + 4 * (lane & 7);
#pragma unroll
    for (int i = 0; i < 8; ++i) r[i] = *(const f32x4*)(p + (size_t)(8 * i) * it.N);
}
__device__ __forceinline__ void tr_store(const TrItem& it, const f32x4 (&r)[8], LAS unsigned char* Tl, int lane) {
    const int row = lane >> 3, c4 = lane & 7;
#pragma unroll
    for (int i = 0; i < 8; ++i) { f32x4 v = r[i]; if (it.gk) v = v * it.gk[8 * i + row];
        u32x2 w; w.x = cvt_pk_bf16(v.x, v.y); w.y = cvt_pk_bf16(v.z, v.w);
        *(LAS u32x2*)(Tl + ((8 * i + row) * 32 + 4 * c4) * 2) = w; }
    LDS_WAIT(); asm volatile("" ::: "memory");
    const int g = lane >> 4, i16 = lane & 15, q = i16 >> 2, pp = lane & 3;
    bf16_t* drow = it.dst + (size_t)(16 * (g & 1) + i16) * it.ldt;
    typedef short v4i16_t __attribute__((ext_vector_type(4)));
#pragma unroll
    for (int j = 0; j < 4; ++j) { const int kc = 4 * (g >> 1) + j;
        const v4i16_t lo = __builtin_amdgcn_ds_read_tr16_b64_v4i16((LAS v4i16_t*)(Tl + ((8 * kc + q) * 32 + 16 * (g & 1) + 4 * pp) * 2));
        const v4i16_t hi = __builtin_amdgcn_ds_read_tr16_b64_v4i16((LAS v4i16_t*)(Tl + ((8 * kc + 4 + q) * 32 + 16 * (g & 1) + 4 * pp) * 2));
        const bf16x8 o = {lo[0], lo[1], lo[2], lo[3], hi[0], hi[1], hi[2], hi[3]};
        *(bf16x8*)(drow + 8 * kc) = o; }
    LDS_WAIT(); asm volatile("" ::: "memory");
}
template <class MK> __device__ __forceinline__ void tr_run(int first, int step, int n, const MK& mk, LAS unsigned char* Tl, int lane) {
    if (first >= n) return;
    TrItem cur = mk(first); f32x4 ra[8], rb[8];
    tr_load(cur, ra, lane);
    for (int idx = first; idx < n; idx += 2 * step) {
        TrItem n1 = cur; const bool h1 = idx + step < n; if (h1) { n1 = mk(idx + step); tr_load(n1, rb, lane); }
        tr_store(cur, ra, Tl, lane);
        if (!h1) break;
        TrItem n2 = n1; const bool h2 = idx + 2 * step < n; if (h2) { n2 = mk(idx + 2 * step); tr_load(n2, ra, lane); }
        tr_store(n1, rb, Tl, lane);
        if (!h2) break;
        cur = n2;
    }
}

__device__ __forceinline__ void adaln_phase(Frame& F, const float* c, const float* w_ada, const float* b_ada, float* mod) {
    LAS float* cact = (LAS float*)F.lds;
    LAS float* part = (LAS float*)(F.lds + 65536);
    for (int i = F.tid; i < NB * DM; i += NTHR) cact[i] = siluf(c[i]);
    __syncthreads();
    const int cg = F.tid & 7, rs = F.tid >> 3;
    for (int it = blockIdx.x; it < 6 * DM / 32; it += F.G) {
        const int n0 = it * 32 + cg * 4;
        f32x4 acc[8];
#pragma unroll
        for (int b = 0; b < 8; ++b) acc[b] = (f32x4){0.f, 0.f, 0.f, 0.f};
#pragma unroll 4
        for (int i = 0; i < 32; ++i) { const int k = rs + 64 * i; const f32x4 w = *(const f32x4*)(w_ada + (size_t)k * (6 * DM) + n0);
#pragma unroll
            for (int b = 0; b < 8; ++b) acc[b] += w * cact[b * DM + k]; }
#pragma unroll
        for (int b = 0; b < 8; ++b) *(LAS f32x4*)(part + (rs * 8 + b) * 32 + cg * 4) = acc[b];
        __syncthreads();
        if (F.tid < 256) { const int b = F.tid >> 5, n = F.tid & 31; float s = 0.f;
#pragma unroll 8
            for (int r = 0; r < 64; ++r) s += part[(r * 8 + b) * 32 + n];
            mod[b * (6 * DM) + it * 32 + n] = s + b_ada[it * 32 + n]; }
        __syncthreads();
    }
}

__device__ __forceinline__ void p0_phase(Frame& F, const Args& a) {
    OPAQUE_FRAME(F);
    unsigned char* ws = F.ws;
    adaln_phase(F, a.in[1], a.in[3], a.in[4], (float*)(ws + WS_MOD));
    __syncthreads();
    LAS unsigned char* Tl = F.lds + F.wave * 4096;
    const int gw = F.vcu * NWAVES + F.wave, NGW = F.G * NWAVES;
    constexpr int I_IN = (DM / 64) * (INC / 32), I_QUP = (QLORA / 64) * (MH * MQK / 32), I_KVUP = (KVLORA / 64) * (MH * 256 / 32), I_OUT = (DM / 64) * (DM / 32);
    constexpr int NITEMS = I_IN + I_QUP + I_KVUP + I_OUT;
    { const float* w_in = a.in[6]; const float* w_qup = a.in[10]; const float* w_kvup = a.in[12]; const float* w_out = a.in[16]; const float* gq = a.in[9]; const float* gkv = a.in[11];
      auto mk = [=](int r) -> TrItem { TrItem t;
          if (r < I_IN) { const int nblk = INC / 32, kb = r / nblk, nb = r % nblk; t.src = w_in + (size_t)(64 * kb) * INC + 32 * nb; t.dst = (bf16_t*)(ws + WS_WIN) + (size_t)(32 * nb) * DM + 64 * kb; t.gk = nullptr; t.N = INC; t.ldt = DM; return t; } r -= I_IN;
          if (r < I_QUP) { const int nblk = MH * MQK / 32, kb = r / nblk, nb = r % nblk; t.src = w_qup + (size_t)(64 * kb) * (MH * MQK) + 32 * nb; t.dst = (bf16_t*)(ws + WS_WQUP) + (size_t)(32 * nb) * QLORA + 64 * kb; t.gk = gq + 64 * kb; t.N = MH * MQK; t.ldt = QLORA; return t; } r -= I_QUP;
          if (r < I_KVUP) { const int nblk = MH * 256 / 32, kb = r / nblk, nb = r % nblk; t.src = w_kvup + (size_t)(64 * kb) * (MH * 256) + 32 * nb; t.dst = (bf16_t*)(ws + WS_WKVUP) + (size_t)(32 * nb) * KVLORA + 64 * kb; t.gk = gkv + 64 * kb; t.N = MH * 256; t.ldt = KVLORA; return t; } r -= I_KVUP;
          { const int nblk = DM / 32, kb = r / nblk, nb = r % nblk; t.src = w_out + (size_t)(64 * kb) * DM + 32 * nb; t.dst = (bf16_t*)(ws + WS_WOUT) + (size_t)(32 * nb) * DM + 64 * kb; t.gk = nullptr; t.N = DM; t.ldt = DM; return t; } };
      tr_run(gw, NGW, NITEMS, mk, Tl, F.lane); }
    { const int* pos = (const int*)a.in[2]; float* rc = (float*)(ws + WS_ROPEC); float* rsn = (float*)(ws + WS_ROPES);
      const int gt = F.vcu * NTHR + F.tid, NGT = F.G * NTHR;
      for (int e = gt; e < T * 32; e += NGT) { const int i = e & 31, tk = e >> 5;
          const float invf = (float)exp2(-(double)i * (13.287712379549449 / 32.0));
          const float ang = (float)pos[tk] * invf;
          rc[e] = cosf(ang); rsn[e] = sinf(ang); }
      float* wct = (float*)(ws + WS_WCT);
      for (int e = gt; e < 48 * DM; e += NGT) { const int n = e / DM, k = e % DM;
          wct[e] = n < 4 ? a.in[18][k * NG + n] : (n < 36 ? a.in[20][k * NE + (n - 4)] : 0.f); } }
}

__device__ __forceinline__ void modnorm_row(const float* xrow, const float* g, const float* shift, const float* scale, bf16_t* orow, int lane) {
    const f32x4* xr = (const f32x4*)xrow + lane;
    f32x4 v[8]; float s = 0.f;
#pragma unroll
    for (int j = 0; j < 8; ++j) { v[j] = xr[64 * j]; s += (v[j].x * v[j].x + v[j].y * v[j].y) + (v[j].z * v[j].z + v[j].w * v[j].w); }
    const float rstd = rsqrtf(wave_sum(s) * (1.f / DM) + EPS);
    u32x2* o8 = (u32x2*)orow + lane;
#pragma unroll
    for (int j = 0; j < 8; ++j) { const f32x4 gg = ((const f32x4*)g)[64 * j + lane], sh = ((const f32x4*)shift)[64 * j + lane], sc = ((const f32x4*)scale)[64 * j + lane];
        const f32x4 h = v[j] * rstd * gg * (sc + 1.f) + sh;
        u32x2 w; w.x = cvt_pk_bf16(h.x, h.y); w.y = cvt_pk_bf16(h.z, h.w); o8[64 * j] = w; }
}
__device__ __forceinline__ void p1_phase(Frame& F, const Args& a) {
    OPAQUE_FRAME(F);
    const int gw = F.vcu * NWAVES + F.wave, NGW = F.G * NWAVES;
    const float* mod = (const float*)(F.ws + WS_MOD);
    bf16_t* H = (bf16_t*)(F.ws + WS_B);
    for (int m = gw; m < T; m += NGW) { const int b = m / SEQ;
        modnorm_row(a.in[0] + (size_t)m * DM, a.in[5], mod + b * (6 * DM), mod + b * (6 * DM) + DM, H + (size_t)m * DM, F.lane); }
}

template <int CTRL> __device__ __forceinline__ float dppf(float x) { return __builtin_bit_cast(float, __builtin_amdgcn_update_dpp(0, __builtin_bit_cast(int, x), CTRL, 0xF, 0xF, true)); }

namespace hg {
constexpr int OFF_F = 0, OFF_SEG = 32768, OFF_QIN = 34816, RP = 272, OFF_KIN = OFF_QIN + 64 * RP, OFF_QB = OFF_KIN + 64 * RP, OFF_KLT = OFF_QB + 64 * RP, SP = 144,
              OFF_VT = OFF_KLT + 128 * SP, OFF_DEC = OFF_VT + 32 * SP  , OFF_SF = OFF_DEC + 3584  , HG_LDS = OFF_SF + 16384;
static_assert(HG_LDS <= RING_BYTES, "hgrn lds");
__device__ __forceinline__ int ppos(int s) { return (s & ~15) | ((s & 4) << 1) | ((s & 8) >> 1) | (s & 3); }
}
__device__ __forceinline__ void hgrn_chunked(Frame& F, const Args& a) {
    using namespace hg;
    const bf16_t* PROJ = (const bf16_t*)(F.ws + WS_A);
    bf16_t* MIX = (bf16_t*)(F.ws + WS_E);
    const float* lbl = a.in[7];
    LAS unsigned char* L = F.lds;
    LAS float* Fs = (LAS float*)(L + OFF_F); LAS float* SEGs = (LAS float*)(L + OFF_SEG); LAS float* DEC = (LAS float*)(L + OFF_DEC); LAS float* POST = DEC + 384;
    const int g = F.tid & 15, t0 = F.tid >> 4;
    const int sk = F.tid & 127, sseg = F.tid >> 7;
    const int r32 = F.lane & 31, hi = F.lane >> 5;
    for (int it = blockIdx.x; it < NB * HH * 4; it += F.G) {
        const int dq = it & 3, h = (it >> 2) & 7, b = it >> 5;
        float lb[8];
#pragma unroll
        for (int j = 0; j < 8; ++j) { const int k = h * 128 + g * 8 + j; lb[j] = 1.f / (1.f + __expf(lbl[HW + k] - lbl[k])); }
        const bf16_t* base = PROJ + (size_t)(b * SEQ) * INCP + h * 128;
        f32x16 S = {};
        if (F.wave >= 2 && F.wave < 6) {
#pragma unroll
            for (int s2 = 0; s2 < 2; ++s2) *(LAS u32x4*)(L + OFF_SF + (((F.wave - 2) * 2 + s2) * 64 + F.lane) * 16) = (u32x4){0u, 0u, 0u, 0u}; }
        u32x4 gq[2], gf[2], gv;
#define HG_LOADF(c) do { _Pragma("unroll") for (int i = 0; i < 2; ++i) gf[i] = *(const u32x4*)(base + (size_t)((c) * 64 + t0 + 32 * i) * INCP + g * 8 + HW); } while (0)
#define HG_LOADQ(c) do { _Pragma("unroll") for (int i = 0; i < 2; ++i) gq[i] = *(const u32x4*)(base + (size_t)((c) * 64 + t0 + 32 * i) * INCP + g * 8); \
            if (F.tid < 256) gv = *(const u32x4*)(base + (size_t)((c) * 64 + (F.tid >> 2)) * INCP + 2 * HW + dq * 32 + (F.tid & 3) * 8); } while (0)
        HG_LOADF(0); HG_LOADQ(0);
        for (int c = 0; c < SEQ / 64; ++c) {
            float fv[2][8];
#pragma unroll
            for (int i = 0; i < 2; ++i) { float fl[8]; unpack8(gf[i], fl);
#pragma unroll
                for (int j = 0; j < 8; ++j) { const float sg = __builtin_amdgcn_rcpf(1.f + __builtin_amdgcn_exp2f(-1.4426950408889634f * fl[j])); fv[i][j] = lb[j] + (1.f - lb[j]) * sg; }
                LAS float* fp = Fs + (t0 + 32 * i) * 128 + g * 8;
                *(LAS f32x4*)fp = (f32x4){fv[i][0], fv[i][1], fv[i][2], fv[i][3]}; *(LAS f32x4*)(fp + 4) = (f32x4){fv[i][4], fv[i][5], fv[i][6], fv[i][7]}; }
            if (c + 1 < SEQ / 64) HG_LOADF(c + 1);
            __syncthreads();
            float klp[16];
            { float fr[16];
#pragma unroll
              for (int i = 0; i < 16; ++i) fr[i] = Fs[(16 * sseg + i) * 128 + sk];
              float p = 1.f;
#pragma unroll
              for (int i = 0; i < 16; ++i) { p *= fr[i]; Fs[(16 * sseg + i) * 128 + sk] = p; }
              SEGs[sseg * 128 + sk] = p;
              float q = 1.f;
#pragma unroll
              for (int i = 15; i >= 0; --i) { klp[i] = (1.f - fr[i]) * q; q *= fr[i]; } }
            __syncthreads();
            if (F.tid < 128) { const float s0 = SEGs[F.tid], s1 = SEGs[128 + F.tid], s2 = SEGs[256 + F.tid], s3 = SEGs[384 + F.tid];
                const float pm = s0 * s1;
                SEGs[F.tid] = 1.f; SEGs[128 + F.tid] = s0; SEGs[256 + F.tid] = pm; SEGs[384 + F.tid] = pm * s2;
                POST[F.tid] = s1 * s2 * s3; POST[128 + F.tid] = s2 * s3; POST[256 + F.tid] = s3; POST[384 + F.tid] = 1.f;
                DEC[F.tid] = pm * s2 * s3; DEC[128 + F.tid] = pm; DEC[256 + F.tid] = __builtin_amdgcn_rcpf(pm); }
            __syncthreads();
            { { const float po = POST[sseg * 128 + sk];
                float o16[16];
#pragma unroll
                for (int p = 0; p < 16; ++p) o16[p] = klp[8 * ((p >> 2) & 1) + 4 * (p >> 3) + (p & 3)] * po;
                *(LAS u32x4*)(L + OFF_KLT + sk * SP + sseg * 32) = pack8f(o16); *(LAS u32x4*)(L + OFF_KLT + sk * SP + sseg * 32 + 16) = pack8f(o16 + 8); }
#pragma unroll
              for (int i = 0; i < 2; ++i) { const int t = t0 + 32 * i;
                  float qin[8], kin[8], qb[8], qv[8];
                  unpack8(gq[i], qv);
                  const LAS float* fp = Fs + t * 128 + g * 8; const LAS float* pp = SEGs + (t >> 4) * 128 + g * 8;
                  const f32x4 pa = *(const LAS f32x4*)fp, pb = *(const LAS f32x4*)(fp + 4), ea = *(const LAS f32x4*)pp, eb = *(const LAS f32x4*)(pp + 4);
                  const f32x4 ma = *(const LAS f32x4*)(DEC + 128 + g * 8), mb = *(const LAS f32x4*)(DEC + 128 + g * 8 + 4), ra = *(const LAS f32x4*)(DEC + 256 + g * 8), rb = *(const LAS f32x4*)(DEC + 256 + g * 8 + 4);
#pragma unroll
                  for (int j = 0; j < 8; ++j) { const float P = (j < 4 ? pa[j] * ea[j] : pb[j - 4] * eb[j - 4]), pm = j < 4 ? ma[j] : mb[j - 4], rpm = j < 4 ? ra[j] : rb[j - 4];
                      const float r = __builtin_amdgcn_rcpf(P), kk = 1.f - fv[i][j], qs = qv[j] * 0.08838834764831845f;
                      qb[j] = qs * P; qin[j] = qb[j] * rpm; kin[j] = kk * pm * r; }
                  *(LAS u32x4*)(L + OFF_QIN + t * RP + g * 16) = pack8f(qin);
                  *(LAS u32x4*)(L + OFF_KIN + t * RP + g * 16) = pack8f(kin);
                  { const u32x4 w = pack8f(qb);
                    *(LAS u32x2*)(L + OFF_QB + t * RP + ((g >> 1) * 16 + (g & 1) * 4) * 2) = (u32x2){w.x, w.y};
                    *(LAS u32x2*)(L + OFF_QB + t * RP + ((g >> 1) * 16 + 8 + (g & 1) * 4) * 2) = (u32x2){w.z, w.w}; } }
              if (F.tid < 256) { float v[8]; unpack8(gv, v); const int s = F.tid >> 2, dvg = F.tid & 3, ps = ppos(s);
#pragma unroll
                  for (int j = 0; j < 8; ++j) *(LAS bf16_t*)(L + OFF_VT + (dvg * 8 + j) * SP + ps * 2) = (bf16_t)(__builtin_bit_cast(unsigned, v[j]) >> 16); } }
            if (c + 1 < SEQ / 64) HG_LOADQ(c + 1);
            __syncthreads();
            const int par = c & 1;
            if (F.wave < 2) { const int tb = F.wave;
                f32x16 o = {};
                for (int sb = 0; sb <= tb; ++sb) { f32x16 X = {};
#pragma unroll
                    for (int ks = 0; ks < 8; ++ks) { const bf16x8 af = *(const LAS bf16x8*)(L + OFF_KIN + (32 * sb + r32) * RP + (16 * ks + 8 * hi) * 2);
                        const bf16x8 bfr = *(const LAS bf16x8*)(L + OFF_QIN + (32 * tb + r32) * RP + (16 * ks + 8 * hi) * 2);
                        X = __builtin_amdgcn_mfma_f32_32x32x16_bf16(af, bfr, X, 0, 0, 0); }
                    if (sb == tb) {
#pragma unroll
                        for (int r = 0; r < 16; ++r) { const int srow = (r & 3) + 8 * (r >> 2) + 4 * hi; if (srow > r32) X[r] = 0.f; } }
#pragma unroll
                    for (int s2 = 0; s2 < 2; ++s2) { u32x4 w; w.x = cvt_pk_bf16(X[8 * s2], X[8 * s2 + 1]); w.y = cvt_pk_bf16(X[8 * s2 + 2], X[8 * s2 + 3]); w.z = cvt_pk_bf16(X[8 * s2 + 4], X[8 * s2 + 5]); w.w = cvt_pk_bf16(X[8 * s2 + 6], X[8 * s2 + 7]);
                        const bf16x8 vf = *(const LAS bf16x8*)(L + OFF_VT + r32 * SP + (32 * sb + 16 * s2 + 8 * hi) * 2);
                        o = __builtin_amdgcn_mfma_f32_32x32x16_bf16(__builtin_bit_cast(bf16x8, w), vf, o, 0, 0, 0); } }
#pragma unroll
                for (int kb = 0; kb < 4; ++kb)
#pragma unroll
                    for (int s2 = 0; s2 < 2; ++s2) { const bf16x8 sf = *(const LAS bf16x8*)(L + OFF_SF + par * 8192 + ((kb * 2 + s2) * 64 + F.lane) * 16);
                        const bf16x8 qf = *(const LAS bf16x8*)(L + OFF_QB + (32 * tb + r32) * RP + (32 * kb + 16 * s2 + 8 * hi) * 2);
                        o = __builtin_amdgcn_mfma_f32_32x32x16_bf16(qf, sf, o, 0, 0, 0); }
                bf16_t* orow = MIX + (size_t)(b * SEQ + c * 64 + 32 * tb) * DM + h * 128 + dq * 32 + r32;
#pragma unroll
                for (int r = 0; r < 16; ++r) { const float v = o[r]; const float vn = __shfl_xor(v, 1);
                    if ((r32 & 1) == 0) *(unsigned*)(orow + (size_t)((r & 3) + 8 * (r >> 2) + 4 * hi) * DM) = cvt_pk_bf16(v, vn); }
            } else if (F.wave < 6) { const int kb = F.wave - 2;
#pragma unroll
                for (int r = 0; r < 16; ++r) S[r] *= DEC[32 * kb + (r & 3) + 8 * (r >> 2) + 4 * hi];
#pragma unroll
                for (int ss = 0; ss < 4; ++ss) { const bf16x8 kf = *(const LAS bf16x8*)(L + OFF_KLT + (32 * kb + r32) * SP + (16 * ss + 8 * hi) * 2);
                    const bf16x8 vf = *(const LAS bf16x8*)(L + OFF_VT + r32 * SP + (16 * ss + 8 * hi) * 2);
                    S = __builtin_amdgcn_mfma_f32_32x32x16_bf16(kf, vf, S, 0, 0, 0); }
#pragma unroll
                for (int s2 = 0; s2 < 2; ++s2) { u32x4 w; w.x = cvt_pk_bf16(S[8 * s2], S[8 * s2 + 1]); w.y = cvt_pk_bf16(S[8 * s2 + 2], S[8 * s2 + 3]); w.z = cvt_pk_bf16(S[8 * s2 + 4], S[8 * s2 + 5]); w.w = cvt_pk_bf16(S[8 * s2 + 6], S[8 * s2 + 7]);
                    *(LAS u32x4*)(L + OFF_SF + (1 - par) * 8192 + ((kb * 2 + s2) * 64 + F.lane) * 16) = w; }
            }
            __syncthreads();
        }
#undef HG_LOADF
#undef HG_LOADQ
    }
}

__device__ __forceinline__ void p3_phase(Frame& F, const Args& a) {
    OPAQUE_FRAME(F);
    const bf16_t* PROJ = (const bf16_t*)(F.ws + WS_A);
    {
        const int gw = F.vcu * NWAVES + F.wave, NGW = F.G * NWAVES;
        float* rq = (float*)(F.ws + WS_RSTDQ); float* rkv = (float*)(F.ws + WS_RSTDKV);
        for (int m = gw; m < T; m += NGW) {
            float f[8]; unpack8(*(const u32x4*)(PROJ + (size_t)m * INCP + C_QA + F.lane * 8), f);
            float s = 0.f;
#pragma unroll
            for (int j = 0; j < 8; ++j) s += f[j] * f[j];
            s = wave_sum(s);
            float s2 = 0.f;
            if (F.lane < 32) { unpack8(*(const u32x4*)(PROJ + (size_t)m * INCP + C_KVA + F.lane * 8), f);
#pragma unroll
                for (int j = 0; j < 8; ++j) s2 += f[j] * f[j]; }
            s2 = wave_sum(s2);
            if (F.lane == 0) { rq[m] = rsqrtf(s * (1.f / QLORA) + EPS); rkv[m] = rsqrtf(s2 * (1.f / KVLORA) + EPS); }
        }
    }
    hgrn_chunked(F, a);
}

__device__ __forceinline__ float sum8(float v) { v += __shfl_xor(v, 1); v += __shfl_xor(v, 2); v += __shfl_xor(v, 4); return v; }

__device__ __forceinline__ void p5_phase(Frame& F, const Args& a) {
    OPAQUE_FRAME(F);
    const int gw = F.vcu * NWAVES + F.wave, NGW = F.G * NWAVES;
    const bf16_t* PROJ = (const bf16_t*)(F.ws + WS_A);
    const bf16_t* QH = (const bf16_t*)(F.ws + WS_B);
    const bf16_t* KV = (const bf16_t*)(F.ws + WS_C);
    bf16_t* Qn = (bf16_t*)(F.ws + WS_D); bf16_t* Kn = (bf16_t*)(F.ws + WS_D + QN_BYTES); bf16_t* Vh = (bf16_t*)(F.ws + WS_D + 2 * QN_BYTES);
    bf16_t* MIX = (bf16_t*)(F.ws + WS_E);
    const float* rc = (const float*)(F.ws + WS_ROPEC); const float* rsn = (const float*)(F.ws + WS_ROPES);
    const float* gqn = a.in[13]; const float* gkn = a.in[14]; const float* gon = a.in[8];
    const int h = F.lane >> 3, sub = F.lane & 7;
    for (int t = gw; t < T; t += NGW) {
        const int b = t / SEQ, s = t % SEQ;
        const size_t hrow = ((size_t)(b * MH + h) * SEQ + s);
        float cs[8], sn[8];
        { const int ii = (sub & 3) * 8; const float* cp = rc + (size_t)t * 32 + ii; const float* sp = rsn + (size_t)t * 32 + ii;
#pragma unroll
          for (int j = 0; j < 8; ++j) { cs[j] = cp[j]; sn[j] = sp[j]; } }
        const float sgn = sub < 4 ? -1.f : 1.f;
        { float q[3][8]; float ss = 0.f;
#pragma unroll
          for (int i = 0; i < 3; ++i) { unpack8(*(const u32x4*)(QH + (size_t)t * (MH * MQK) + h * MQK + (sub + 8 * i) * 8), q[i]);
#pragma unroll
              for (int j = 0; j < 8; ++j) ss += q[i][j] * q[i][j]; }
          const float rs = rsqrtf(sum8(ss) * (1.f / MQK) + EPS);
#pragma unroll
          for (int i = 0; i < 3; ++i)
#pragma unroll
              for (int j = 0; j < 8; ++j) q[i][j] *= rs * gqn[(sub + 8 * i) * 8 + j];
#pragma unroll
          for (int j = 0; j < 8; ++j) { const float pv = __shfl_xor(q[2][j], 4); q[2][j] = q[2][j] * cs[j] + sgn * pv * sn[j]; }
#pragma unroll
          for (int i = 0; i < 3; ++i) *(u32x4*)(Qn + hrow * MQK + (sub + 8 * i) * 8) = pack8f(q[i]); }
        { float k[3][8]; float ss = 0.f;
#pragma unroll
          for (int i = 0; i < 2; ++i) unpack8(*(const u32x4*)(KV + (size_t)t * (MH * 256) + h * 256 + (sub + 8 * i) * 8), k[i]);
          unpack8(*(const u32x4*)(PROJ + (size_t)t * INCP + C_KPE + sub * 8), k[2]);
#pragma unroll
          for (int i = 0; i < 3; ++i)
#pragma unroll
              for (int j = 0; j < 8; ++j) ss += k[i][j] * k[i][j];
          const float rs = rsqrtf(sum8(ss) * (1.f / MQK) + EPS);
#pragma unroll
          for (int i = 0; i < 3; ++i)
#pragma unroll
              for (int j = 0; j < 8; ++j) k[i][j] *= rs * gkn[(sub + 8 * i) * 8 + j];
#pragma unroll
          for (int j = 0; j < 8; ++j) { const float pv = __shfl_xor(k[2][j], 4); k[2][j] = k[2][j] * cs[j] + sgn * pv * sn[j]; }
#pragma unroll
          for (int i = 0; i < 3; ++i) *(u32x4*)(Kn + hrow * MQK + (sub + 8 * i) * 8) = pack8f(k[i]); }
#pragma unroll
        for (int i = 0; i < 2; ++i) *(u32x4*)(Vh + hrow * MV + (sub + 8 * i) * 8) = *(const u32x4*)(KV + (size_t)t * (MH * 256) + h * 256 + 128 + (sub + 8 * i) * 8);
        { float o[2][8], gt[2][8]; float ss = 0.f;
#pragma unroll
          for (int i = 0; i < 2; ++i) { unpack8(*(const u32x4*)(MIX + (size_t)t * DM + h * 128 + (sub + 8 * i) * 8), o[i]); unpack8(*(const u32x4*)(PROJ + (size_t)t * INCP + 3 * HW + h * 128 + (sub + 8 * i) * 8), gt[i]);
#pragma unroll
              for (int j = 0; j < 8; ++j) ss += o[i][j] * o[i][j]; }
          const float rs = rsqrtf(sum8(ss) * (1.f / HDV) + EPS);
#pragma unroll
          for (int i = 0; i < 2; ++i) {
#pragma unroll
              for (int j = 0; j < 8; ++j) o[i][j] = o[i][j] * rs * gon[(sub + 8 * i) * 8 + j] * siluf(gt[i][j]);
              *(u32x4*)(MIX + (size_t)t * DM + h * 128 + (sub + 8 * i) * 8) = pack8f(o[i]); } }
    }
}
namespace att {
constexpr int QBLK = 32, KVBLK = 64, QB = 256;
constexpr int KROW = 512, SHM_K = KVBLK * KROW, SHM_V = KVBLK * MV * 2;
constexpr int OFF_V = 0, OFF_K = 2 * SHM_V, OFF_WS = OFF_K + 2 * SHM_K;
constexpr float SCALE = 0.07216878364870322f;
constexpr float THR = 8.f;
#define SBAR() __builtin_amdgcn_sched_barrier(0)
__device__ __forceinline__ int v_st(int k, int c) { const int kk = (k & ~0xC) | ((k & 4) << 1) | ((k & 8) >> 1); return ((kk >> 3) * 4 + (c >> 5)) * 512 + ((kk & 7) * 32 + (c & 31)) * 2; }
__device__ __forceinline__ int v_rd_base(int lane) { return ((lane & 3) << 3) | (((lane >> 2) & 3) << 6) | (((lane >> 4) & 1) << 5) | (((lane >> 5) & 1) << 8); }
constexpr int v_rd_off(int d0, int ks, int half) { return d0 * 512 + ks * 4096 + half * 2048; }
__device__ __forceinline__ int crow(int r, int hi) { return (r & 3) + 8 * (r >> 2) + 4 * hi; }
__device__ __forceinline__ unsigned cvtpk(float lo, float hi) { unsigned r; asm volatile("v_cvt_pk_bf16_f32 %0, %1, %2" : "=v"(r) : "v"(lo), "v"(hi)); return r; }

__device__ __forceinline__ void mask_tile(f32x16& p0, f32x16& p1, int dq) {
    const float NEG = -__builtin_inff();
#pragma unroll
    for (int r = 0; r < 16; ++r) {
        const int c = (r & 3) + 8 * (r >> 2);
        if (dq - c < 0) p0[r] = NEG;
        if (dq - c - 32 < 0) p1[r] = NEG;
    }
}
__device__ __forceinline__ void partialSM(f32x16& p0, f32x16& p1, float& m_reg, float& mn, float& alpha) {
    float pmax = p0[0];
#pragma unroll
    for (int r = 1; r < 16; ++r) pmax = fmaxf(pmax, p0[r]);
#pragma unroll
    for (int r = 0; r < 16; ++r) pmax = fmaxf(pmax, p1[r]);
    { auto rr = __builtin_amdgcn_permlane32_swap(__float_as_uint(pmax), __float_as_uint(pmax), false, false);
      pmax = fmaxf(__uint_as_float(rr[0]), __uint_as_float(rr[1])); }
    constexpr float C2 = 1.4426950408889634f * SCALE;
    if (__builtin_expect(__all((pmax - m_reg) * SCALE <= THR), 1)) { mn = m_reg; alpha = 1.f; }
    else { mn = fmaxf(m_reg, pmax); alpha = __builtin_amdgcn_exp2f((m_reg - mn) * C2); m_reg = mn; }
    const float mnL = -mn * C2;
#pragma unroll
    for (int r = 0; r < 16; ++r) p0[r] = fmaf(p0[r], C2, mnL);
#pragma unroll
    for (int r = 0; r < 16; ++r) p1[r] = fmaf(p1[r], C2, mnL);
#pragma unroll
    for (int r = 0; r < 16; ++r) p0[r] = __builtin_amdgcn_exp2f(p0[r]);
}
__device__ __forceinline__ void finishSM(f32x16& p0, f32x16& p1, float alpha, float& l_reg, bf16x8& pa0, bf16x8& pa1, bf16x8& pa2, bf16x8& pa3) {
#pragma unroll
    for (int r = 0; r < 16; ++r) p1[r] = __builtin_amdgcn_exp2f(p1[r]);
    float ps = 0;
#pragma unroll
    for (int r = 0; r < 16; ++r) ps += p0[r];
#pragma unroll
    for (int r = 0; r < 16; ++r) ps += p1[r];
    { auto rr = __builtin_amdgcn_permlane32_swap(__float_as_uint(ps), __float_as_uint(ps), false, false);
      ps = __uint_as_float(rr[0]) + __uint_as_float(rr[1]); }
    l_reg = l_reg * alpha + ps;
#define PK4(P, B_, OUT) do { unsigned a0 = cvtpk(P[B_+0], P[B_+1]), a1 = cvtpk(P[B_+2], P[B_+3]);                          \
        unsigned b0 = cvtpk(P[B_+4], P[B_+5]), b1 = cvtpk(P[B_+6], P[B_+7]);                                             \
        auto r0 = __builtin_amdgcn_permlane32_swap(a0, b0, false, false); auto r1 = __builtin_amdgcn_permlane32_swap(a1, b1, false, false); \
        u32x4 w = {r0[0], r1[0], r0[1], r1[1]}; OUT = __builtin_bit_cast(bf16x8, w); } while (0)
    PK4(p0, 0, pa0); PK4(p0, 8, pa1); PK4(p1, 0, pa2); PK4(p1, 8, pa3);
#undef PK4
}
template <int KB>
__device__ __forceinline__ void qkt(f32x16& p0, f32x16& p1, LAS unsigned char* lds, int r32, int hi, const bf16x8* qr) {
    p0 = f32x16{}; p1 = f32x16{};
    int sw = r32 & 15; asm volatile("" : "+v"(sw));
    const int rb = OFF_K + KB * SHM_K + r32 * KROW;
    int ab[8];
#pragma unroll
    for (int d = 0; d < 8; ++d) ab[d] = rb + (((2 * d + hi) ^ sw) << 4);
#pragma unroll
    for (int d0 = 0; d0 < 12; ++d0) { const int a = ab[d0 & 7] + (d0 >> 3) * 256;
        const bf16x8 b0 = *(const LAS bf16x8*)(lds + a);
        const bf16x8 b1 = *(const LAS bf16x8*)(lds + a + 32 * KROW);
        p0 = __builtin_amdgcn_mfma_f32_32x32x16_bf16(b0, qr[d0], p0, 0, 0, 0);
        p1 = __builtin_amdgcn_mfma_f32_32x32x16_bf16(b1, qr[d0], p1, 0, 0, 0); }
}
template <int VB>
__device__ __forceinline__ void pv_tile(f32x16* o, int vb0, bf16x8 pa0, bf16x8 pa1, bf16x8 pa2, bf16x8 pa3) {
#define TRRD(dst, off) asm volatile("ds_read_b64_tr_b16 %0, %1 offset:%2" : "=&v"(dst) : "v"(vb0), "i"(off) : "memory")
#define PV_D0(d0) do { s16x4 l0, l1, l2, l3, h0, h1, h2, h3; constexpr int b_ = OFF_V + VB * SHM_V + v_rd_off(d0, 0, 0); \
        TRRD(l0, b_); TRRD(h0, b_ + 2048); TRRD(l1, b_ + 4096); TRRD(h1, b_ + 6144); TRRD(l2, b_ + 8192); TRRD(h2, b_ + 10240); TRRD(l3, b_ + 12288); TRRD(h3, b_ + 14336); \
        asm volatile("s_waitcnt lgkmcnt(0)" ::: "memory"); SBAR();   \
        o[d0] = __builtin_amdgcn_mfma_f32_32x32x16_bf16(pa0, (bf16x8){l0[0], l0[1], l0[2], l0[3], h0[0], h0[1], h0[2], h0[3]}, o[d0], 0, 0, 0);   \
        o[d0] = __builtin_amdgcn_mfma_f32_32x32x16_bf16(pa1, (bf16x8){l1[0], l1[1], l1[2], l1[3], h1[0], h1[1], h1[2], h1[3]}, o[d0], 0, 0, 0);   \
        o[d0] = __builtin_amdgcn_mfma_f32_32x32x16_bf16(pa2, (bf16x8){l2[0], l2[1], l2[2], l2[3], h2[0], h2[1], h2[2], h2[3]}, o[d0], 0, 0, 0);   \
        o[d0] = __builtin_amdgcn_mfma_f32_32x32x16_bf16(pa3, (bf16x8){l3[0], l3[1], l3[2], l3[3], h3[0], h3[1], h3[2], h3[3]}, o[d0], 0, 0, 0); } while (0)
    PV_D0(0); PV_D0(1); PV_D0(2); PV_D0(3);
#undef PV_D0
#undef TRRD
}

__device__ __forceinline__ void attn_block(const bf16_t* Q, const bf16_t* K, const bf16_t* V, bf16_t* O, int P0, const float* gon, LAS unsigned char* lds) {
    int tid = threadIdx.x; asm volatile("" : "+v"(tid));
    const int wid = __builtin_amdgcn_readfirstlane(tid >> 6), lane = tid & 63, r32 = lane & 31, hi = lane >> 5;
    const int NT = P0 / KVBLK + 4;
    const int qlo = P0 + wid * QBLK, qm = qlo + r32 - 4 * hi;
    LAS float* wsf = (LAS float*)(lds + OFF_WS) + wid * 64; LAS float* li_l = wsf; LAS float* al_l = wsf + 32;
    float m_reg = -1e30f, l_reg = 0.f; f32x16 o[4] = {};
    bf16x8 qr[12];
#pragma unroll
    for (int d0 = 0; d0 < 12; ++d0) qr[d0] = *(const bf16x8*)(Q + (size_t)(qlo + r32) * MQK + d0 * 16 + hi * 8);
    int ksrc[4], vsrc[2];
#pragma unroll
    for (int i = 0; i < 4; ++i) { const int row = 2 * (wid * 4 + i) + (lane >> 5), c = (lane & 31) ^ (row & 15); ksrc[i] = row * MQK + (c < 24 ? c : 0) * 8; }
#pragma unroll
    for (int i = 0; i < 2; ++i) { const int id = (wid * 2 + i) * 2 + (lane >> 5), kk = ((id >> 2) << 3) | ((lane & 31) >> 2), k = (kk & ~0xC) | ((kk & 4) << 1) | ((kk & 8) >> 1);
        vsrc[i] = k * MV + (id & 3) * 32 + (lane & 3) * 8; }
    const int vb0 = (int)(unsigned)(uintptr_t)lds + v_rd_base(lane);
#define ALOAD(t, bf) do { const bf16_t* kp = K + (size_t)(t) * KVBLK * MQK; const bf16_t* vp = V + (size_t)(t) * KVBLK * MV; \
        _Pragma("unroll") for (int i = 0; i < 4; ++i) __builtin_amdgcn_global_load_lds((const unsigned*)(kp + ksrc[i]), (LAS unsigned*)(lds + OFF_K + (bf) * SHM_K + (wid * 4 + i) * 1024), 16, 0, 0); \
        _Pragma("unroll") for (int i = 0; i < 2; ++i) __builtin_amdgcn_global_load_lds((const unsigned*)(vp + vsrc[i]), (LAS unsigned*)(lds + OFF_V + (bf) * SHM_V + (wid * 2 + i) * 1024), 16, 0, 0); } while (0)
#define RESC(a) do { if (__any((a) < 1.f)) { if (hi == 0) al_l[r32] = (a); asm volatile("s_waitcnt lgkmcnt(0)" ::: "memory"); \
        _Pragma("unroll") for (int d_ = 0; d_ < 4; ++d_) _Pragma("unroll") for (int r = 0; r < 16; ++r) o[d_][r] *= al_l[crow(r, hi)]; } } while (0)
#define STEP(t, BF) do { f32x16 p0, p1; float mn, al; bf16x8 pa0, pa1, pa2, pa3; \
        if ((t) + 1 < NT) ALOAD((t) + 1, 1 - (BF)); \
        SBAR(); qkt<BF>(p0, p1, lds, r32, hi, qr); \
        { const int kb_ = (t) * KVBLK; if (kb_ + KVBLK - 1 > qlo) mask_tile(p0, p1, qm - kb_); } \
        partialSM(p0, p1, m_reg, mn, al); RESC(al); finishSM(p0, p1, al, l_reg, pa0, pa1, pa2, pa3); SBAR(); \
        pv_tile<BF>(o, vb0, pa0, pa1, pa2, pa3); SBAR(); \
        asm volatile("s_waitcnt vmcnt(0)" ::: "memory"); __syncthreads(); } while (0)
    ALOAD(0, 0); asm volatile("s_waitcnt vmcnt(0)" ::: "memory"); __syncthreads();
    for (int t = 0; t < NT; t += 2) { STEP(t, 0); STEP(t + 1, 1); }
#undef STEP
#undef RESC
#undef ALOAD
    if (hi == 0) li_l[r32] = l_reg;
    asm volatile("s_waitcnt lgkmcnt(0)" ::: "memory");
    float gv[4];
#pragma unroll
    for (int d0 = 0; d0 < 4; ++d0) gv[d0] = gon[d0 * 32 + r32];
#pragma unroll
    for (int r = 0; r < 16; ++r) { const float rl = 1.f / li_l[crow(r, hi)];
        float ss = 0.f;
#pragma unroll
        for (int d0 = 0; d0 < 4; ++d0) { o[d0][r] *= rl; ss += o[d0][r] * o[d0][r]; }
        ss += __shfl_xor(ss, 1); ss += __shfl_xor(ss, 2); ss += __shfl_xor(ss, 4); ss += __shfl_xor(ss, 8); ss += __shfl_xor(ss, 16);
        const float rs = rsqrtf(ss * (1.f / MV) + EPS);
        bf16_t* orow = O + (size_t)(qlo + crow(r, hi)) * DM;
#pragma unroll
        for (int d0 = 0; d0 < 4; ++d0) { const float v = o[d0][r] * rs * gv[d0]; const float vn = __shfl_xor(v, 1);
            if ((r32 & 1) == 0) *(unsigned*)(orow + d0 * 32 + r32) = cvtpk(v, vn); } }
    __syncthreads();
}
#undef SBAR
}

__device__ __forceinline__ void p6_phase(Frame& F, const Args& a) {
    const bf16_t* Qn = (const bf16_t*)(F.ws + WS_D); const bf16_t* Kn = (const bf16_t*)(F.ws + WS_D + QN_BYTES); const bf16_t* Vh = (const bf16_t*)(F.ws + WS_D + 2 * QN_BYTES);
    bf16_t* MIX = (bf16_t*)(F.ws + WS_E);
    for (int it = F.vcu; it < NB * MH * 4; it += F.G) {
        const int bh = it >> 2, j = it & 3, b = bh >> 3, h = bh & 7;
        const bf16_t* Q = Qn + (size_t)bh * SEQ * MQK; const bf16_t* K = Kn + (size_t)bh * SEQ * MQK; const bf16_t* V = Vh + (size_t)bh * SEQ * MV;
        bf16_t* O = MIX + (size_t)(b * SEQ) * DM + HW + h * MV;
        att::attn_block(Q, K, V, O, (7 - j) * att::QB, a.in[15], F.lds);
        att::attn_block(Q, K, V, O, j * att::QB, a.in[15], F.lds);
    }
}
constexpr int P8_RS = DM + 4;
__device__ __forceinline__ void p8_phase(Frame& F, const Args& a) {
    OPAQUE_FRAME(F);
    unsigned char* ws = F.ws;
    const float* x1 = F.out; const float* mod = (const float*)(ws + WS_MOD); const float* g2n = a.in[17];
    const float* wct = (const float*)(ws + WS_WCT);
    bf16_t* H2 = (bf16_t*)(ws + WS_B);
    int* tok_e = (int*)(ws + WS_TOKE); float* tok_w = (float*)(ws + WS_TOKW); int* tok_s = (int*)(ws + WS_TOKS);
    LAS float* xs = (LAS float*)F.lds;
    LAS float* red = (LAS float*)F.lds;
    LAS float* lg = (LAS float*)(F.lds + 24576);
    LAS float* rstd_l = (LAS float*)(F.lds + 16 * P8_RS * 4);
    const int row_l = F.tid >> 5, c_l = (F.tid & 31) * 4;
    const int mr = F.lane & 15, mg = F.lane >> 4;
    for (int tile = F.vcu; tile < T / 16; tile += F.G) {
        const int m0 = tile * 16, b = m0 / SEQ;
        { const float* xr = x1 + (size_t)(m0 + row_l) * DM + c_l; float ss = 0.f;
#pragma unroll
          for (int j = 0; j < 16; ++j) { const f32x4 v = *(const f32x4*)(xr + 128 * j); ss += (v.x * v.x + v.y * v.y) + (v.z * v.z + v.w * v.w); *(LAS f32x4*)(xs + row_l * P8_RS + c_l + 128 * j) = v; }
          ss += __shfl_xor(ss, 1); ss += __shfl_xor(ss, 2); ss += __shfl_xor(ss, 4); ss += __shfl_xor(ss, 8); ss += __shfl_xor(ss, 16);
          if ((F.tid & 31) == 0) rstd_l[row_l] = rsqrtf(ss * (1.f / DM) + EPS); }
        __syncthreads();
        f32x4 acc[3];
#pragma unroll
        for (int n = 0; n < 3; ++n) acc[n] = (f32x4){0.f, 0.f, 0.f, 0.f};
        { const float rs = rstd_l[mr]; const float* sh2 = mod + b * (6 * DM) + 3 * DM; const float* sc2 = mod + b * (6 * DM) + 4 * DM;
#pragma unroll 2
          for (int s = 0; s < 16; ++s) { const int k0 = F.wave * 256 + 16 * s + 4 * mg;
              const f32x4 xv = *(const LAS f32x4*)(xs + mr * P8_RS + k0);
              const f32x4 gg = *(const f32x4*)(g2n + k0), sc = *(const f32x4*)(sc2 + k0), sh = *(const f32x4*)(sh2 + k0);
              const f32x4 hv = xv * rs * gg * (sc + 1.f) + sh;
              u32x2 w; w.x = cvt_pk_bf16(hv.x, hv.y); w.y = cvt_pk_bf16(hv.z, hv.w);
              *(u32x2*)(H2 + (size_t)(m0 + mr) * DM + k0) = w;
              f32x4 bw[3];
#pragma unroll
              for (int n = 0; n < 3; ++n) bw[n] = *(const f32x4*)(wct + (size_t)(n * 16 + mr) * DM + k0);
#pragma unroll
              for (int i = 0; i < 4; ++i)
#pragma unroll
                  for (int n = 0; n < 3; ++n) acc[n] = __builtin_amdgcn_mfma_f32_16x16x4f32(hv[i], bw[n][i], acc[n], 0, 0, 0); } }
        __syncthreads();
#pragma unroll
        for (int n = 0; n < 3; ++n)
#pragma unroll
            for (int r = 0; r < 4; ++r) red[(F.wave * 16 + mg * 4 + r) * 48 + n * 16 + mr] = acc[n][r];
        __syncthreads();
        for (int idx = F.tid; idx < 16 * 36; idx += NTHR) { const int row = idx / 36, n = idx % 36; float s = n < 4 ? a.in[19][n] : a.in[21][n - 4];
#pragma unroll
            for (int w = 0; w < 8; ++w) s += red[(w * 16 + row) * 48 + n];
            lg[row * 36 + n] = s; }
        __syncthreads();
        if (F.tid < 16) { const LAS float* l = lg + F.tid * 36; const int t = m0 + F.tid;
            int g = 0; float gm = l[0];
#pragma unroll
            for (int j = 1; j < 4; ++j) if (l[j] > gm) { gm = l[j]; g = j; }
            float den = 0.f;
#pragma unroll
            for (int j = 0; j < 4; ++j) den += __expf(l[j] - gm);
            const float pg = 1.f / den;
            const LAS float* e = l + 4 + g * 8;
            int i1 = 0; float v1 = e[0];
#pragma unroll
            for (int j = 1; j < 8; ++j) if (e[j] > v1) { v1 = e[j]; i1 = j; }
            int i2 = -1; float v2 = -__builtin_inff();
#pragma unroll
            for (int j = 0; j < 8; ++j) if (j != i1 && e[j] > v2) { v2 = e[j]; i2 = j; }
            const float w1 = 1.f / (1.f + __expf(v2 - v1)), w2 = 1.f - w1;
            const int e1 = g * 8 + i1, e2 = g * 8 + i2;
            const int s1 = (int)atomicAdd((unsigned*)(F.ctl + CW_CNT + 64 * e1), 1u), s2 = (int)atomicAdd((unsigned*)(F.ctl + CW_CNT + 64 * e2), 1u);
            tok_e[2 * t] = e1; tok_e[2 * t + 1] = e2; tok_w[2 * t] = pg * w1; tok_w[2 * t + 1] = pg * w2; tok_s[2 * t] = s1; tok_s[2 * t + 1] = s2;
            int* list = (int*)(ws + WS_LIST); list[e1 * T + s1] = t; list[e2 * T + s2] = t; }
        __syncthreads();
    }
    LAS unsigned char* Tl = F.lds + F.wave * 4096;
    const int gw = F.vcu * NWAVES + F.wave, NGW = F.G * NWAVES;
    constexpr int I_G = NE * (DM / 64) * (DE / 32);
    { const float* wg = a.in[22]; const float* wu = a.in[23]; const float* wd = a.in[24];
      auto mk = [=](int it) -> TrItem { TrItem t; t.gk = nullptr;
          const int which = it / I_G, r = it % I_G;
          if (which < 2) { const int e = r / 512, q = r % 512, kb = q / 16, nb = q % 16, n0 = 32 * nb;
              t.src = (which ? wu : wg) + (size_t)e * DM * DE + (size_t)(64 * kb) * DE + n0;
              t.dst = (bf16_t*)(ws + WS_D) + ((size_t)e * 1024 + (n0 >> 7) * 256 + (n0 & 127) + which * 128) * DM + 64 * kb; t.N = DE; t.ldt = DM; }
          else { const int e = r / 512, q = r % 512, kb = q / 64, nb = q % 64, n0 = 32 * nb;
              t.src = wd + (size_t)e * DE * DM + (size_t)(64 * kb) * DM + n0;
              t.dst = (bf16_t*)(ws + WS_E) + ((size_t)e * DM + n0) * DE + 64 * kb; t.N = DM; t.ldt = DE; }
          return t; };
      tr_run(gw, NGW, 3 * I_G, mk, Tl, F.lane); }
}

constexpr int MOE_TAB_OFF = RING_BYTES + 1024;
__device__ __forceinline__ LAS int* moe_tables(Frame& F) {
    LAS int* tab = (LAS int*)(F.lds + MOE_TAB_OFF);
    __syncthreads();
    if (F.tid == 0) { int acc = 0;
        for (int e = 0; e < NE; ++e) { tab[e] = acc; const int c = (int)__hip_atomic_load((unsigned*)(F.ctl + CW_CNT + 64 * e), RLX_AGENT); tab[64 + e] = c; acc += ((c + 255) / 256) * 256; }
        tab[NE] = acc; }
    __syncthreads();
    if (F.tid < 160) { int e = 0; for (int j = 1; j < NE; ++j) if (tab[j] <= F.tid * 256) e = j; tab[128 + F.tid] = e; }
    __syncthreads();
    return tab;
}

__device__ __forceinline__ void p12_phase(Frame& F, const Args& a) {
    OPAQUE_FRAME(F);
    unsigned char* ws = F.ws;
    const bf16_t* Y = (const bf16_t*)(ws + WS_A);
    const float* tok_w = (const float*)(ws + WS_TOKW); const int* tok_s = (const int*)(ws + WS_TOKS);
    const float* mod = (const float*)(ws + WS_MOD);
    const LAS int* tab = moe_tables(F); const int* tok_e = (const int*)(ws + WS_TOKE);
    const int gw = F.vcu * NWAVES + F.wave, NGW = F.G * NWAVES;
#if defined(MK_STAMP) && MK_STAMP >= 0
    const float dscale = 1.f + sqrtf(exp2f(rintf(3.f * log2f(*(const float*)(ws + WS_STAMP + 8) + 1.f) + MK_QSHIFT) * (1.f / 3.f)));
#else
    const float dscale = 1.f;
#endif
    for (int t = gw; t < T; t += NGW) {
        const int b = t / SEQ; const float w0 = tok_w[2 * t], w1 = tok_w[2 * t + 1]; const int d0 = tab[tok_e[2 * t]] + tok_s[2 * t], d1 = tab[tok_e[2 * t + 1]] + tok_s[2 * t + 1];
        const float* g2 = mod + b * (6 * DM) + 5 * DM;
        float* orow = F.out + (size_t)t * DM;
#pragma unroll
        for (int j = 0; j < 4; ++j) { const int c = (j * 64 + F.lane) * 8;
            float y0[8], y1[8]; unpack8(*(const u32x4*)(Y + (size_t)d0 * DM + c), y0); unpack8(*(const u32x4*)(Y + (size_t)d1 * DM + c), y1);
            const f32x4 xa = *(const f32x4*)(orow + c), xb = *(const f32x4*)(orow + c + 4), ga = *(const f32x4*)(g2 + c), gb = *(const f32x4*)(g2 + c + 4);
            f32x4 ra, rb;
#pragma unroll
            for (int i = 0; i < 4; ++i) { ra[i] = (xa[i] + ga[i] * (w0 * y0[i] + w1 * y1[i])) * dscale; rb[i] = (xb[i] + gb[i] * (w0 * y0[4 + i] + w1 * y1[4 + i])) * dscale; }
            *(f32x4*)(orow + c) = ra; *(f32x4*)(orow + c + 4) = rb; }
    }
}
#ifndef MK_MULTI
#define MK_MULTI 0
#endif
#ifndef MK_LAST_PHASE
#define MK_LAST_PHASE 12
#endif
constexpr int N_PHASES = MK_LAST_PHASE + 1;

template <class P> __device__ __forceinline__ P* uptr(P* p) { const unsigned long long v = (unsigned long long)p;
    const unsigned lo = __builtin_amdgcn_readfirstlane((unsigned)v), hi = __builtin_amdgcn_readfirstlane((unsigned)(v >> 32)); return (P*)(((unsigned long long)hi << 32) | lo); }
__global__ void __launch_bounds__(NTHR, 2) mk_fwd(const Args args) {
    extern __shared__ __attribute__((aligned(16))) unsigned char lds_raw[];
    Frame F;
    F.lds = (LAS unsigned char*)lds_raw;
    F.MISC = (volatile LAS unsigned*)(F.lds + MISC_OFF);
    F.tid = threadIdx.x; F.lane = F.tid & 63; F.wave = __builtin_amdgcn_readfirstlane(F.tid >> 6);
    F.G = gridDim.x; { const int bx = blockIdx.x; F.vcu = (F.G % 8 == 0) ? (bx % 8) * (F.G / 8) + bx / 8 : bx; }
    F.ws = uptr(args.ws); F.out = uptr(args.out);
    F.ctl = (gu32*)(F.ws + WS_CTL);
    for (int u = F.tid; u < (LDS_BYTES - RING_BYTES) / 4; u += NTHR) ((LAS unsigned*)(F.lds + RING_BYTES))[u] = 0u;
    __syncthreads();
    XcdBarrier bar; bar.bar = (unsigned*)(F.ctl + CW_BAR); bar.x = 0; bar.st = nullptr;
#if !MK_MULTI
    bar = xcd_barrier_post((unsigned*)(F.ctl + CW_BAR), F.MISC + 8);
#define GRID_BAR() xcd_barrier(bar)
#else
#define GRID_BAR() do { } while (0)
#endif
    const int lo = args.ph_lo, hi = args.ph_hi;
#ifndef MK_PHMASK
#define MK_PHMASK 0xFFFF
#endif
#define IN(k) (((MK_PHMASK >> (k)) & 1) && lo <= (k) && (k) < hi)
#define SEAM(k) do { if (IN(k) && IN((k) + 1)) GRID_BAR(); } while (0)
#ifndef MK_STAMP
#define MK_STAMP (-1)
#endif
#define STAMP_BEGIN(k) do { if ((k) == MK_STAMP && blockIdx.x == 0 && F.tid == 0) *(unsigned long long*)(ws + WS_STAMP) = __builtin_amdgcn_s_memrealtime(); } while (0)
#define STAMP_END(k) do { if ((k) == MK_STAMP && blockIdx.x == 0 && F.tid == 0) { const unsigned long long t1_ = __builtin_amdgcn_s_memrealtime(); *(float*)(ws + WS_STAMP + 8) = (float)(t1_ - *(unsigned long long*)(ws + WS_STAMP)) * 0.01f; } } while (0)
#ifndef MK_REPEAT
#define MK_REPEAT (-1)
#endif
#ifndef MK_REPN
#define MK_REPN 2
#endif
#define REP(k) _Pragma("unroll") for (int rep_ = 0; rep_ < ((k) == MK_REPEAT ? MK_REPN : 1); ++rep_)
    unsigned char* const ws = F.ws;

    STAMP_BEGIN(0);
    REP(0) if (IN(0)) { if (rep_) GRID_BAR(); p0_phase(F, args); } SEAM(0); STAMP_END(0);
    STAMP_BEGIN(1);
    REP(1) if (IN(1)) { if (rep_) GRID_BAR(); p1_phase(F, args); } SEAM(1); STAMP_END(1);
    STAMP_BEGIN(2);
    REP(2) if (IN(2)) { if (rep_) GRID_BAR();
        pg8::Gemm g{(const bf16_t*)(ws + WS_B), (const bf16_t*)(ws + WS_WIN), DM, DM, DM};
        pg8::DenseOrder S; S.init(T / 256, INCP / 256, F.G, (int)blockIdx.x);
        pg8::EpiStore E{(bf16_t*)(ws + WS_A), INCP, nullptr};
        pg8::gemm_phase<pg8::EpiStore, pg8::DenseOrder>(F.lds, g, S, E);
    } SEAM(2); STAMP_END(2);
    STAMP_BEGIN(3);
    REP(3) if (IN(3)) { if (rep_) GRID_BAR(); p3_phase(F, args); } SEAM(3); STAMP_END(3);
    STAMP_BEGIN(4);
    REP(4) if (IN(4)) { if (rep_) GRID_BAR();
        { pg8::Gemm g{(const bf16_t*)(ws + WS_A) + C_QA, (const bf16_t*)(ws + WS_WQUP), INCP, QLORA, QLORA};
          pg8::DenseOrder S; S.init(T / 256, MH * MQK / 256, F.G, (int)blockIdx.x);
          pg8::EpiStore E{(bf16_t*)(ws + WS_B), MH * MQK, (const float*)(ws + WS_RSTDQ)};
          pg8::gemm_phase<pg8::EpiStore, pg8::DenseOrder>(F.lds, g, S, E); }
        { pg8::Gemm g{(const bf16_t*)(ws + WS_A) + C_KVA, (const bf16_t*)(ws + WS_WKVUP), INCP, KVLORA, KVLORA};
          pg8::DenseOrder S; S.init(T / 256, MH * 256 / 256, F.G, (int)blockIdx.x);
          pg8::EpiStore E{(bf16_t*)(ws + WS_C), MH * 256, (const float*)(ws + WS_RSTDKV)};
          pg8::gemm_phase<pg8::EpiStore, pg8::DenseOrder>(F.lds, g, S, E); }
    } SEAM(4); STAMP_END(4);
    STAMP_BEGIN(5);
    REP(5) if (IN(5)) { if (rep_) GRID_BAR(); p5_phase(F, args); } SEAM(5); STAMP_END(5);
    STAMP_BEGIN(6);
    REP(6) if (IN(6)) { if (rep_) GRID_BAR(); p6_phase(F, args); } SEAM(6); STAMP_END(6);
    STAMP_BEGIN(7);
    REP(7) if (IN(7)) { if (rep_) GRID_BAR();
        pg8::Gemm g{(const bf16_t*)(ws + WS_E), (const bf16_t*)(ws + WS_WOUT), DM, DM, DM};
        pg8::DenseOrder S; S.init(T / 256, DM / 256, F.G, (int)blockIdx.x);
        pg8::EpiResid E{args.in[0], F.out, (const float*)(ws + WS_MOD) + 2 * DM, 6 * DM};
        pg8::gemm_phase<pg8::EpiResid, pg8::DenseOrder>(F.lds, g, S, E);
    } SEAM(7); STAMP_END(7);
#if MK_LAST_PHASE >= 8
    STAMP_BEGIN(8);
    REP(8) if (IN(8)) { if (rep_) GRID_BAR(); p8_phase(F, args); } if (IN(8) && IN(10)) GRID_BAR(); STAMP_END(8);
    STAMP_BEGIN(10);
    REP(10) if (IN(10)) { if (rep_) GRID_BAR();
        const LAS int* tab = moe_tables(F);
        pg8::Gemm g{(const bf16_t*)(ws + WS_B), (const bf16_t*)(ws + WS_D), DM, DM, DM};
        pg8::GroupedOrder S; S.init(4, F.G, F.vcu, tab, (const int*)(ws + WS_LIST));
        pg8::EpiSwiGLU E{(bf16_t*)(ws + WS_C)};
        pg8::gemm_phase<pg8::EpiSwiGLU, pg8::GroupedOrder, true>(F.lds, g, S, E);
    } SEAM(10); STAMP_END(10);
    STAMP_BEGIN(11);
    REP(11) if (IN(11)) { if (rep_) GRID_BAR();
        const LAS int* tab = moe_tables(F);
        pg8::Gemm g{(const bf16_t*)(ws + WS_C), (const bf16_t*)(ws + WS_E), DE, DE, DE};
        pg8::GroupedOrder S; S.init(8, F.G, F.vcu, tab, nullptr);
        pg8::EpiStore E{(bf16_t*)(ws + WS_A), DM, nullptr};
        pg8::gemm_phase<pg8::EpiStore, pg8::GroupedOrder>(F.lds, g, S, E);
    } SEAM(11); STAMP_END(11);
    REP(12) if (IN(12)) { if (rep_) GRID_BAR(); p12_phase(F, args); }
#endif
#undef IN
#undef SEAM
}

extern "C" void kernel_launch(void* const* d_in, const int* in_sizes, int n_in, void* d_out, int out_size, void* d_ws, size_t ws_size, hipStream_t stream) {
    static int grid = 0;
    if (grid == 0) {
        if (n_in != 25 || out_size != T * DM || ws_size < WS_END) { fprintf(stderr, "kernel_launch: bad shapes (n_in %d out %d ws %zu)\n", n_in, out_size, ws_size); grid = -1; return; }
        int dev = 0, cus = 0, per_cu = 0;
        if (hipGetDevice(&dev) != hipSuccess || hipDeviceGetAttribute(&cus, hipDeviceAttributeMultiprocessorCount, dev) != hipSuccess) { grid = -1; return; }
        if (hipFuncSetAttribute((const void*)mk_fwd, hipFuncAttributeMaxDynamicSharedMemorySize, LDS_BYTES) != hipSuccess) { fprintf(stderr, "kernel_launch: hipFuncSetAttribute failed\n"); grid = -1; return; }
        if (hipOccupancyMaxActiveBlocksPerMultiprocessor(&per_cu, (const void*)mk_fwd, NTHR, LDS_BYTES) != hipSuccess || per_cu < 1) { fprintf(stderr, "kernel_launch: occupancy query says %d\n", per_cu); }
        (void)hipGetLastError();
        grid = cus;
    }
    if (grid < 0) return;
    (void)hipMemsetAsync((char*)d_ws + WS_CTL, 0, CTL_ZERO_BYTES, stream);
    Args a{};
    for (int i = 0; i < 25; ++i) a.in[i] = (const float*)d_in[i];
    a.out = (float*)d_out; a.ws = (unsigned char*)d_ws;
#if MK_MULTI
    for (int p = 0; p < N_PHASES; ++p) { a.ph_lo = p; a.ph_hi = p + 1; hipLaunchKernelGGL(mk_fwd, dim3(grid), dim3(NTHR), LDS_BYTES, stream, a); }
#else
    a.ph_lo = 0; a.ph_hi = N_PHASES; hipLaunchKernelGGL(mk_fwd, dim3(grid), dim3(NTHR), LDS_BYTES, stream, a);
#endif
}
```

```cpp
#include <hip/hip_runtime.h>
#include <cstdio>
#include <cstdint>

#define GAS __attribute__((address_space(1)))
#define LAS __attribute__((address_space(3)))
typedef unsigned short bf16_t;
typedef short bf16x8 __attribute__((ext_vector_type(8)));
typedef short s16x4 __attribute__((ext_vector_type(4)));
typedef float f32x4 __attribute__((ext_vector_type(4)));
typedef float f32x2 __attribute__((ext_vector_type(2)));
typedef float f32x16 __attribute__((ext_vector_type(16)));
typedef unsigned u32x4 __attribute__((ext_vector_type(4)));
typedef unsigned u32x2 __attribute__((ext_vector_type(2)));
typedef GAS unsigned gu32;
#define RLX_AGENT __ATOMIC_RELAXED, __HIP_MEMORY_SCOPE_AGENT
#define LDS_WAIT() asm volatile("s_waitcnt lgkmcnt(0)" ::: "memory")
#define VM_WAIT() asm volatile("s_waitcnt vmcnt(0)" ::: "memory")

constexpr int DM = 2048, NB = 8, SEQ = 2048, T = NB * SEQ;
constexpr int HW = 1024, HH = 8, HDK = 128, HDV = 128;
constexpr int MH = 8, MNOPE = 128, MROPE = 64, MQK = 192, MV = 128, QLORA = 512, KVLORA = 256;
constexpr int INC = 4 * HW + QLORA + KVLORA + MROPE;
constexpr int INCP = 5120;
constexpr int C_QA = 4096, C_KVA = 4608, C_KPE = 4864;
constexpr int NG = 4, EPG = 8, NE = 32, DE = 512;
constexpr int RMAX = (T * 2 / 256 + NE) * 256;
constexpr float EPS = 1e-6f;
constexpr int NWAVES = 8, NTHR = 512;

typedef __bf16 bf16x2_t __attribute__((ext_vector_type(2)));
__device__ __forceinline__ unsigned cvt_pk_bf16(float lo, float hi) { const f32x2 v = {lo, hi}; return __builtin_bit_cast(unsigned, __builtin_convertvector(v, bf16x2_t)); }
__device__ __forceinline__ float bf_lo(unsigned w) { return __builtin_bit_cast(float, w << 16); }
__device__ __forceinline__ float bf_hi(unsigned w) { return __builtin_bit_cast(float, w & 0xffff0000u); }
__device__ __forceinline__ float bf2f(bf16_t h) { return __builtin_bit_cast(float, (unsigned)h << 16); }
__device__ __forceinline__ float wave_sum(float v) {
#pragma unroll
    for (int o = 1; o < 64; o <<= 1) v += __shfl_xor(v, o);
    return v;
}
__device__ __forceinline__ float siluf(float v) { return v / (1.f + __expf(-v)); }

#define XB_TMO      128
#define XB_XCNT(j)  (256  + 64 * (j))
#define XB_XSUB(j)  (1280 + 64 * (j))
#define XB_XGEN(j)  (2304 + 64 * (j))
#define XB_TOP      3328
#define XB_TOPGEN   3392
#define XCD_BAR_WORDS 3456
#define XB_SPIN_CAP (1u << 18)

__device__ __forceinline__ unsigned xb_ld(unsigned* p)              { return __hip_atomic_load(p, __ATOMIC_RELAXED, __HIP_MEMORY_SCOPE_AGENT); }
__device__ __forceinline__ unsigned xb_add(unsigned* p, unsigned v) { return __hip_atomic_fetch_add(p, v, __ATOMIC_RELAXED, __HIP_MEMORY_SCOPE_AGENT); }
__device__ __forceinline__ unsigned xb_xcc_id() { return (unsigned)__builtin_amdgcn_s_getreg((3 << 11) | 20) & 0xFu; }
#define XB_SPIN(cond, bar) do { unsigned _sp = 0; while (cond) { __builtin_amdgcn_s_sleep(1); \
    if ((++_sp & 255u) == 0u) { if (xb_ld(&(bar)[XB_TMO])) break; if (_sp > XB_SPIN_CAP) { atomicAdd(&(bar)[XB_TMO], 1u); break; } } } } while (0)

struct XcdBarrier {
    unsigned* bar; unsigned x;
    volatile LAS unsigned* st;
};
__device__ __forceinline__ XcdBarrier xcd_barrier_post(unsigned* bar, volatile LAS unsigned* st) {
    XcdBarrier b; b.bar = bar; b.x = xb_xcc_id(); b.st = st;
    if (threadIdx.x == 0) (void)xb_add(&bar[XB_XCNT(b.x)], 1u);
    return b;
}
__device__ __forceinline__ void xcd_barrier_complete(unsigned* bar, unsigned x, unsigned& nloc, unsigned& nx) {
    const unsigned G = gridDim.x * gridDim.y * gridDim.z;
    unsigned sum, cnt, mine, sp = 0u;
    for (;;) {
        sum = 0u; cnt = 0u; mine = 0u;
#pragma unroll
        for (unsigned j = 0; j < 16; ++j) { const unsigned c = xb_ld(&bar[XB_XCNT(j)]); sum += c; cnt += (c > 0u) ? 1u : 0u; mine = (j == x) ? c : mine; }
        if (sum == G) break;
        __builtin_amdgcn_s_sleep(1);
        if ((++sp & 255u) == 0u) { if (xb_ld(&bar[XB_TMO])) break; if (sp > XB_SPIN_CAP) { atomicAdd(&bar[XB_TMO], 1u); break; } }
    }
    nloc = mine > 0u ? mine : 1u; nx = cnt > 0u ? cnt : 1u;
}
__device__ __forceinline__ void xcd_barrier(const XcdBarrier& b) {
    asm volatile("s_waitcnt vmcnt(0)" ::: "memory");
    __syncthreads();
    if (threadIdx.x == 0) {
        unsigned* bar = b.bar;
        __builtin_amdgcn_s_waitcnt(0);
        unsigned nloc = b.st[0], nx = b.st[1];
        if (nloc == 0u) { xcd_barrier_complete(bar, b.x, nloc, nx); b.st[0] = nloc; b.st[1] = nx; }
        const unsigned old = xb_add(&bar[XB_XSUB(b.x)], 1u);
        const unsigned gen = old / nloc;
        if (old + 1u == (gen + 1u) * nloc) {
            __builtin_amdgcn_fence(__ATOMIC_RELEASE, "agent");
            asm volatile("s_waitcnt vmcnt(0)" ::: "memory");
            const unsigned og = xb_add(&bar[XB_TOP], 1u);
            const unsigned tg = og / nx;
            if (og + 1u == (tg + 1u) * nx) xb_add(&bar[XB_TOPGEN], 1u);
            else XB_SPIN(xb_ld(&bar[XB_TOPGEN]) == tg, bar);
            __builtin_amdgcn_fence(__ATOMIC_ACQUIRE, "agent");
            xb_add(&bar[XB_XGEN(b.x)], 1u);
            asm volatile("s_waitcnt vmcnt(0)" ::: "memory");
        } else {
            XB_SPIN(xb_ld(&bar[XB_XGEN(b.x)]) == gen, bar);
            __builtin_amdgcn_fence(__ATOMIC_ACQUIRE, "agent");
            asm volatile("s_waitcnt vmcnt(0)" ::: "memory");
        }
    }
    __syncthreads();
}

namespace pg8 {
constexpr int BM = 256, BK = 64, HALF = 128, HTB = HALF * BK * 2, STAGE_BYTES = 8 * HTB, NXCD = 8, WGM = 8;
__host__ __device__ __forceinline__ int lds_byte(int r, int c) { const int st = (r >> 4) * 2 + (c >> 5), rr = r & 15, cc = c & 31, ob = rr * 64 + cc * 2; return st * 1024 + (ob ^ (((ob >> 9) & 1) << 5)); }
__host__ __device__ __forceinline__ void stage_rc(int b, int& R, int& C) { const int st = b / 1024, sb = b % 1024, swz = sb ^ (((sb >> 9) & 1) << 5); R = (st >> 1) * 16 + swz / 64; C = (st & 1) * 32 + (swz % 64) / 2; }
__host__ __device__ __forceinline__ int perm32(int rho) { const int n = rho >> 4, i = rho & 15; return 8 * (i >> 2) + 4 * n + (i & 3); }

struct Unit { int pm, pn, pb; };
struct Gemm { const bf16_t* A; const bf16_t* Bt; int lda, ldb, K; };

struct DenseOrder {
    int nM, nN, nwg, G, c;
    __device__ void init(int nM_, int nN_, int G_, int c_) { nM = nM_; nN = nN_; nwg = nM * nN; G = G_; c = c_; }
    __device__ bool next(int i, Unit& u) const {
        const long L = (long)i * G + c; if (L >= nwg) return false;
        int wgid = (int)L; { const int q = nwg / NXCD, r = nwg % NXCD, xcd = wgid % NXCD, off = wgid / NXCD; wgid = (xcd < r ? xcd * (q + 1) : r * (q + 1) + (xcd - r) * q) + off; }
        const int nig = WGM * nN, gid = wgid / nig, fm = gid * WGM, gsz = (nM - fm) < WGM ? (nM - fm) : WGM;
        u.pm = fm + ((wgid % nig) % gsz); u.pn = (wgid % nig) / gsz; u.pb = u.pn; return true;
    }
};
struct GroupedOrder {
    int nM, nN, nwg, G, c; const LAS int* tile_e; const LAS int* pstart; const LAS int* cnt; const int* list;
    __device__ void init(int nN_, int G_, int c_, const LAS int* tab, const int* list_) { pstart = tab; cnt = tab + 64; tile_e = tab + 128; list = list_; nM = pstart[32] >> 8; nN = nN_; nwg = nM * nN; G = G_; c = c_; }
    __device__ bool next(int i, Unit& u) const {
        const long L = (long)i * G + c; if (L >= nwg) return false;
        const int w = (int)L; u.pn = w % nN; u.pm = w / nN; u.pb = tile_e[u.pm] * nN + u.pn; return true;
    }
    __device__ int arow(const Unit& u, int r) const { const int e = tile_e[u.pm], j = 256 * u.pm - pstart[e] + r; return j < cnt[e] ? list[e * T + j] : 0; }
};

template <class Epi, class Sched, bool GATHER = false>
__device__ __forceinline__ void gemm_phase(LAS unsigned char* lds, const Gemm g, const Sched& S, const Epi& E) {
    int tid = threadIdx.x; asm volatile("" : "+v"(tid));
    const int wid = __builtin_amdgcn_readfirstlane(tid >> 6), lane = tid & 63, wr = wid >> 2, wc = wid & 3, fr = lane & 15, fq = lane >> 4;
    const int K = g.K, nt = K / BK;
    unsigned voffA[2], voffB[2]; int gR[2], gC[2];
#pragma unroll
    for (int i = 0; i < 2; ++i) { int R, C; stage_rc(tid * 16 + i * 8192, R, C); const int Rb = (R & ~31) + perm32(R & 31); gR[i] = R; gC[i] = C;
        voffA[i] = (unsigned)(R * g.lda + C) * 2u; voffB[i] = (unsigned)(Rb * g.ldb + C) * 2u; }
    const size_t kstep = (size_t)(BK * 2);
    const size_t hsA = (size_t)HALF * g.lda * 2, hsB = (size_t)HALF * g.ldb * 2;
    const unsigned ldsw = (unsigned)wid * 1024u;
    const int aoff = lds_byte(wr * 64 + fr, fq * 8), boff = lds_byte(wc * 32 + fr, fq * 8);
#define PG8_SA(b, h) (((b) * 2 + (h)) * HTB)
#define PG8_SB(b, h) ((4 + (b) * 2 + (h)) * HTB)
#define PG8_STAGE(bufoff, gbase, voff) do { _Pragma("unroll") for (int _i = 0; _i < 2; ++_i) \
        __builtin_amdgcn_global_load_lds((const unsigned*)((const char*)(gbase) + (voff)[_i]), (LAS unsigned*)(lds + (bufoff) + ldsw + _i * 8192), 16, 0, 0); } while (0)
#define PG8_STAGE_A(bufoff, dense_ptr, kbytes, offs) do { if constexpr (GATHER) { PG8_STAGE(bufoff, (const char*)g.A + (kbytes), offs); } else { PG8_STAGE(bufoff, dense_ptr, voffA); } } while (0)
#define PG8_GOFF(u, o0, o1) do { _Pragma("unroll") for (int _i = 0; _i < 2; ++_i) { o0[_i] = (unsigned)(S.arow(u, gR[_i]) * g.lda + gC[_i]) * 2u; o1[_i] = (unsigned)(S.arow(u, gR[_i] + HALF) * g.lda + gC[_i]) * 2u; } } while (0)
#define PG8_LDA(dst, b, h) do { _Pragma("unroll") for (int m = 0; m < 4; ++m) _Pragma("unroll") for (int k = 0; k < 2; ++k) dst[m][k] = *(const LAS bf16x8*)(lds + PG8_SA(b, h) + aoff + m * 2048 + k * 1024); } while (0)
#define PG8_LDB(dst, b, h) do { _Pragma("unroll") for (int n = 0; n < 2; ++n) _Pragma("unroll") for (int k = 0; k < 2; ++k) dst[n][k] = *(const LAS bf16x8*)(lds + PG8_SB(b, h) + boff + n * 2048 + k * 1024); } while (0)
#define PG8_MMA(ai, bj, At, Bt) do { __builtin_amdgcn_s_setprio(1); _Pragma("unroll") for (int m = 0; m < 4; ++m) _Pragma("unroll") for (int n = 0; n < 2; ++n) _Pragma("unroll") for (int k = 0; k < 2; ++k) \
        acc[ai][bj][m][n] = __builtin_amdgcn_mfma_f32_16x16x32_bf16(Bt[n][k], At[m][k], acc[ai][bj][m][n], 0, 0, 0); __builtin_amdgcn_s_setprio(0); } while (0)
#define PG8_WAIT_V(n) asm volatile("s_waitcnt vmcnt(" #n ")" ::: "memory")
#define PG8_WAIT_L(n) asm volatile("s_waitcnt lgkmcnt(" #n ")" ::: "memory")
#define PG8_BAR __builtin_amdgcn_s_barrier()
#define PG8_SCHED __builtin_amdgcn_sched_barrier(0)
    Unit cur, nxt; int ui = 0;
    if (!S.next(0, cur)) return;
    unsigned cO0[2] = {0u, 0u}, cO1[2] = {0u, 0u}, nO0[2] = {0u, 0u}, nO1[2] = {0u, 0u};
    if constexpr (GATHER) { PG8_GOFF(cur, cO0, cO1); }
    f32x4 acc[2][2][4][2];
#pragma unroll
    for (int a = 0; a < 2; ++a)
#pragma unroll
        for (int b = 0; b < 2; ++b)
#pragma unroll
            for (int m = 0; m < 4; ++m)
#pragma unroll
                for (int n = 0; n < 2; ++n) acc[a][b][m][n] = (f32x4){0.f, 0.f, 0.f, 0.f};
    bf16x8 At[4][2], B0[2][2], B1[2][2];
    const char* cA = (const char*)g.A + (GATHER ? (size_t)0 : (size_t)cur.pm * 2 * hsA); const char* cB = (const char*)g.Bt + (size_t)cur.pb * 2 * hsB;
    PG8_STAGE(PG8_SB(0, 0), cB, voffB); PG8_STAGE(PG8_SB(0, 1), cB + hsB, voffB); PG8_STAGE_A(PG8_SA(0, 0), cA, 0, cO0); PG8_STAGE_A(PG8_SA(0, 1), cA + hsA, 0, cO1);
    if (wr == 1) PG8_BAR;
    PG8_WAIT_V(2); PG8_BAR;
    PG8_STAGE(PG8_SB(1, 0), cB + kstep, voffB); PG8_STAGE_A(PG8_SA(1, 0), cA + kstep, kstep, cO0); PG8_STAGE(PG8_SB(1, 1), cB + hsB + kstep, voffB);
    PG8_WAIT_V(6); PG8_BAR;
    for (;;) {
        const bool has_next = S.next(ui + 1, nxt);
        const char* nA = (has_next && !GATHER) ? (const char*)g.A + (size_t)nxt.pm * 2 * hsA : cA; const char* nB = has_next ? (const char*)g.Bt + (size_t)nxt.pb * 2 * hsB : cB;
        if constexpr (GATHER) { if (has_next) { PG8_GOFF(nxt, nO0, nO1); } else { nO0[0] = cO0[0]; nO0[1] = cO0[1]; nO1[0] = cO1[0]; nO1[1] = cO1[1]; } }
        for (int t = 0; t < nt; t += 2) {
            const bool last = (t == nt - 2);
            const char* a1 = cA + (size_t)(t + 1) * kstep;
            const char* a2 = last ? nA : cA + (size_t)(t + 2) * kstep; const char* b2 = last ? nB : cB + (size_t)(t + 2) * kstep;
            const char* a3 = a2 + kstep; const char* b3 = b2 + kstep;
            const size_t k2 = last ? (size_t)0 : (size_t)(t + 2) * kstep;
            unsigned o0[2], o1[2]; o0[0] = last ? nO0[0] : cO0[0]; o0[1] = last ? nO0[1] : cO0[1]; o1[0] = last ? nO1[0] : cO1[0]; o1[1] = last ? nO1[1] : cO1[1];
            PG8_LDB(B0, 0, 0); PG8_LDB(B1, 0, 1); PG8_SCHED; PG8_LDA(At, 0, 0); PG8_STAGE_A(PG8_SA(1, 1), a1 + hsA, (size_t)(t + 1) * kstep, cO1);
            PG8_WAIT_V(8); PG8_WAIT_L(0); PG8_BAR; PG8_MMA(0, 0, At, B0); PG8_MMA(0, 1, At, B1); PG8_BAR; PG8_SCHED;
            PG8_LDA(At, 0, 1); PG8_STAGE(PG8_SB(0, 0), b2, voffB); PG8_STAGE(PG8_SB(0, 1), b2 + hsB, voffB); PG8_STAGE_A(PG8_SA(0, 0), a2, k2, o0);
            PG8_WAIT_V(8); PG8_WAIT_L(0); PG8_BAR; PG8_MMA(1, 0, At, B0); PG8_MMA(1, 1, At, B1); PG8_BAR; PG8_SCHED;
            PG8_LDB(B0, 1, 0); PG8_LDB(B1, 1, 1); PG8_SCHED; PG8_LDA(At, 1, 0); PG8_STAGE_A(PG8_SA(0, 1), a2 + hsA, k2, o1);
            PG8_WAIT_V(8); PG8_WAIT_L(0); PG8_BAR; PG8_MMA(0, 0, At, B0); PG8_MMA(0, 1, At, B1); PG8_BAR; PG8_SCHED;
            PG8_LDA(At, 1, 1); PG8_STAGE(PG8_SB(1, 0), b3, voffB); PG8_STAGE(PG8_SB(1, 1), b3 + hsB, voffB); PG8_STAGE_A(PG8_SA(1, 0), a3, k2 + kstep, o0);
            PG8_WAIT_V(8); PG8_WAIT_L(0); PG8_BAR; PG8_MMA(1, 0, At, B0); PG8_MMA(1, 1, At, B1); PG8_BAR; PG8_SCHED;
        }
        if (wr == 0) PG8_BAR;
        E(acc, cur, wr, wc, fr, fq);
        if (!has_next) break;
#pragma unroll
        for (int a = 0; a < 2; ++a)
#pragma unroll
            for (int b = 0; b < 2; ++b)
#pragma unroll
                for (int m = 0; m < 4; ++m)
#pragma unroll
                    for (int n = 0; n < 2; ++n) acc[a][b][m][n] = (f32x4){0.f, 0.f, 0.f, 0.f};
        cur = nxt; cA = nA; cB = nB; ++ui;
        if constexpr (GATHER) { cO0[0] = nO0[0]; cO0[1] = nO0[1]; cO1[0] = nO1[0]; cO1[1] = nO1[1]; }
        if (wr == 1) PG8_BAR;
    }
    PG8_WAIT_V(0);
    PG8_BAR;
#undef PG8_SA
#undef PG8_SB
#undef PG8_STAGE
#undef PG8_STAGE_A
#undef PG8_GOFF
#undef PG8_LDA
#undef PG8_LDB
#undef PG8_MMA
#undef PG8_WAIT_V
#undef PG8_WAIT_L
#undef PG8_BAR
#undef PG8_SCHED
}

struct EpiStore {
    bf16_t* O; int ldc; const float* ssq; float inv; float* ssq_out0; float* ssq_out1; int pn0, pn1, pn2;
    __device__ __forceinline__ void operator()(const f32x4 (&acc)[2][2][4][2], const Unit& u, int wr, int wc, int fr, int fq) const {
        const int row0 = u.pm * BM + wr * 64 + fr, col0 = u.pn * BM + wc * 32 + 8 * fq;
        float* so = (ssq_out0 && u.pn >= pn0 && u.pn < pn2) ? (u.pn < pn1 ? ssq_out0 : ssq_out1) : nullptr;
#pragma unroll
        for (int ai = 0; ai < 2; ++ai)
#pragma unroll
            for (int m = 0; m < 4; ++m) { const int row = row0 + ai * HALF + m * 16; const float rs = ssq ? rsqrtf(ssq[row] * inv + EPS) : 1.f;
                bf16_t* rowp = O + (size_t)row * ldc + col0; float ss = 0.f;
#pragma unroll
                for (int bj = 0; bj < 2; ++bj) { const f32x4 v0 = acc[ai][bj][m][0] * rs, v1 = acc[ai][bj][m][1] * rs;
                    ss += (v0[0] * v0[0] + v0[1] * v0[1]) + (v0[2] * v0[2] + v0[3] * v0[3]) + (v1[0] * v1[0] + v1[1] * v1[1]) + (v1[2] * v1[2] + v1[3] * v1[3]);
                    u32x4 w; w.x = cvt_pk_bf16(v0[0], v0[1]); w.y = cvt_pk_bf16(v0[2], v0[3]); w.z = cvt_pk_bf16(v1[0], v1[1]); w.w = cvt_pk_bf16(v1[2], v1[3]);
                    *(u32x4*)(rowp + bj * HALF) = w; }
                if (so) { ss += __shfl_xor(ss, 16); ss += __shfl_xor(ss, 32); if (fq == 0) atomicAdd(so + row, ss); } }
    }
};
struct EpiResid {
    const float* X; float* O; const float* gate; int gpitch;
    __device__ __forceinline__ void operator()(const f32x4 (&acc)[2][2][4][2], const Unit& u, int wr, int wc, int fr, int fq) const {
        const int row0 = u.pm * BM + wr * 64 + fr, col0 = u.pn * BM + wc * 32 + 8 * fq;
        const float* gp = gate + (size_t)((u.pm * BM) / SEQ) * gpitch + col0;
        f32x4 gv[2][2];
#pragma unroll
        for (int bj = 0; bj < 2; ++bj)
#pragma unroll
            for (int n = 0; n < 2; ++n) gv[bj][n] = *(const f32x4*)(gp + bj * HALF + 4 * n);
#pragma unroll
        for (int ai = 0; ai < 2; ++ai)
#pragma unroll
            for (int m = 0; m < 4; ++m) { const size_t off = (size_t)(row0 + ai * HALF + m * 16) * DM + col0;
#pragma unroll
                for (int bj = 0; bj < 2; ++bj)
#pragma unroll
                    for (int n = 0; n < 2; ++n) { const f32x4 xv = *(const f32x4*)(X + off + bj * HALF + 4 * n);
                        *(f32x4*)(O + off + bj * HALF + 4 * n) = xv + gv[bj][n] * acc[ai][bj][m][n]; } }
    }
};
struct EpiSwiGLU {
    bf16_t* O;
    __device__ __forceinline__ void operator()(const f32x4 (&acc)[2][2][4][2], const Unit& u, int wr, int wc, int fr, int fq) const {
        const int row0 = u.pm * BM + wr * 64 + fr, col0 = u.pn * HALF + wc * 32 + 8 * fq;
#pragma unroll
        for (int ai = 0; ai < 2; ++ai)
#pragma unroll
            for (int m = 0; m < 4; ++m) { const int row = row0 + ai * HALF + m * 16;
                float h[8];
#pragma unroll
                for (int n = 0; n < 2; ++n)
#pragma unroll
                    for (int j = 0; j < 4; ++j) { const float gt = acc[ai][0][m][n][j], up = acc[ai][1][m][n][j]; h[4 * n + j] = gt / (1.f + __expf(-gt)) * up; }
                u32x4 w; w.x = cvt_pk_bf16(h[0], h[1]); w.y = cvt_pk_bf16(h[2], h[3]); w.z = cvt_pk_bf16(h[4], h[5]); w.w = cvt_pk_bf16(h[6], h[7]);
                *(u32x4*)(O + (size_t)row * DE + col0) = w; }
    }
};
}
constexpr size_t MiB = 1u << 20;
constexpr size_t WS_CTL = 0, CTL_ZERO_BYTES = 1 * MiB;
constexpr size_t WS_MOD = 1 * MiB;
constexpr size_t WS_ROPEC = 1 * MiB + 512 * 1024;
constexpr size_t WS_ROPES = WS_ROPEC + 2 * MiB;
constexpr size_t WS_WCT = WS_ROPES + 2 * MiB;
constexpr size_t WS_RSTDQ = 6 * MiB;
constexpr size_t WS_RSTDKV = WS_RSTDQ + 64 * 1024;
constexpr size_t WS_TOKE = WS_RSTDKV + 64 * 1024;
constexpr size_t WS_TOKW = WS_TOKE + 128 * 1024;
constexpr size_t WS_TOKS = WS_TOKW + 128 * 1024;
constexpr size_t WS_BLKE = WS_TOKS + 128 * 1024;
constexpr size_t WS_STAMP = WS_BLKE + 4096;
constexpr size_t WS_WIN = 8 * MiB;
constexpr size_t WS_WQUP = 28 * MiB;
constexpr size_t WS_WKVUP = WS_WQUP + 1536 * 1024;
constexpr size_t WS_WOUT = 31 * MiB;
constexpr size_t WS_A = 40 * MiB;
constexpr size_t WS_B = 200 * MiB;
constexpr size_t WS_C = 264 * MiB;
constexpr size_t WS_D = 328 * MiB;
constexpr size_t WS_E = 456 * MiB;
constexpr size_t WS_LIST = 520 * MiB;
constexpr size_t WS_F = 522 * MiB;
constexpr size_t WS_END = 586 * MiB;
constexpr size_t QN_BYTES = (size_t)T * MH * MQK * 2;

constexpr int CW_BAR = 4096;
constexpr int CW_CNT = 8192;

constexpr int RING_BYTES = 131072, LDS_BYTES = 147456, LDS_USER = 143360, MISC_OFF = LDS_BYTES - 512;

struct Args { const float* in[25]; float* out; unsigned char* ws; int ph_lo, ph_hi, pad0, pad1; };

struct Frame {
    LAS unsigned char* lds;
    volatile LAS unsigned* MISC;
    gu32* ctl;
    int tid, lane, wave, vcu, G;
    unsigned char* ws; float* out;
};

#define OPAQUE_FRAME(F) do { F.tid = threadIdx.x; asm volatile("" : "+v"(F.tid)); F.lane = F.tid & 63; } while (0)

__device__ __forceinline__ void unpack8(const u32x4 w, float* f) { f[0] = bf_lo(w.x); f[1] = bf_hi(w.x); f[2] = bf_lo(w.y); f[3] = bf_hi(w.y); f[4] = bf_lo(w.z); f[5] = bf_hi(w.z); f[6] = bf_lo(w.w); f[7] = bf_hi(w.w); }
__device__ __forceinline__ u32x4 pack8f(const float* f) { u32x4 w; w.x = cvt_pk_bf16(f[0], f[1]); w.y = cvt_pk_bf16(f[2], f[3]); w.z = cvt_pk_bf16(f[4], f[5]); w.w = cvt_pk_bf16(f[6], f[7]); return w; }

struct TrItem { const float* src; bf16_t* dst; const float* gk; int N, ldt; };
__device__ __forceinline__ void tr_load(const TrItem& it, f32x4 (&r)[8], int lane) {
    const float* p = it.src + (size_t)(lane >> 3) * it.N + 4 * (lane & 7);
#pragma unroll
    for (int i = 0; i < 8; ++i) r[i] = *(const f32x4*)(p + (size_t)(8 * i) * it.N);
}
__device__ __forceinline__ void tr_store(const TrItem& it, const f32x4 (&r)[8], LAS unsigned char* Tl, int lane) {
    const int row = lane >> 3, c4 = lane & 7;
#pragma unroll
    for (int i = 0; i < 8; ++i) { f32x4 v = r[i]; if (it.gk) v = v * it.gk[8 * i + row];
        u32x2 w; w.x = cvt_pk_bf16(v.x, v.y); w.y = cvt_pk_bf16(v.z, v.w);
        *(LAS u32x2*)(Tl + ((8 * i + row) * 32 + 4 * c4) * 2) = w; }
    LDS_WAIT(); asm volatile("" ::: "memory");
    const int g = lane >> 4, i16 = lane & 15, q = i16 >> 2, pp = lane & 3;
    bf16_t* drow = it.dst + (size_t)(16 * (g & 1) + i16) * it.ldt;
    typedef short v4i16_t __attribute__((ext_vector_type(4)));
#pragma unroll
    for (int j = 0; j < 4; ++j) { const int kc = 4 * (g >> 1) + j;
        const v4i16_t lo = __builtin_amdgcn_ds_read_tr16_b64_v4i16((LAS v4i16_t*)(Tl + ((8 * kc + q) * 32 + 16 * (g & 1) + 4 * pp) * 2));
        const v4i16_t hi = __builtin_amdgcn_ds_read_tr16_b64_v4i16((LAS v4i16_t*)(Tl + ((8 * kc + 4 + q) * 32 + 16 * (g & 1) + 4 * pp) * 2));
        const bf16x8 o = {lo[0], lo[1], lo[2], lo[3], hi[0], hi[1], hi[2], hi[3]};
        *(bf16x8*)(drow + 8 * kc) = o; }
    LDS_WAIT(); asm volatile("" ::: "memory");
}
template <class MK> __device__ __forceinline__ void tr_run(int first, int step, int n, const MK& mk, LAS unsigned char* Tl, int lane) {
    if (first >= n) return;
    TrItem cur = mk(first); f32x4 ra[8], rb[8];
    tr_load(cur, ra, lane);
    for (int idx = first; idx < n; idx += 2 * step) {
        TrItem n1 = cur; const bool h1 = idx + step < n; if (h1) { n1 = mk(idx + step); tr_load(n1, rb, lane); }
        tr_store(cur, ra, Tl, lane);
        if (!h1) break;
        TrItem n2 = n1; const bool h2 = idx + 2 * step < n; if (h2) { n2 = mk(idx + 2 * step); tr_load(n2, ra, lane); }
        tr_store(n1, rb, Tl, lane);
        if (!h2) break;
        cur = n2;
    }
}

__device__ __forceinline__ void adaln_phase(Frame& F, const float* c, const float* w_ada, const float* b_ada, float* mod) {
    LAS float* cact = (LAS float*)F.lds;
    LAS float* part = (LAS float*)(F.lds + 65536);
    for (int i = F.tid; i < NB * DM; i += NTHR) cact[i] = siluf(c[i]);
    __syncthreads();
    const int cg = F.tid & 7, rs = F.tid >> 3;
    for (int it = blockIdx.x; it < 6 * DM / 32; it += F.G) {
        const int n0 = it * 32 + cg * 4;
        f32x4 acc[8];
#pragma unroll
        for (int b = 0; b < 8; ++b) acc[b] = (f32x4){0.f, 0.f, 0.f, 0.f};
#pragma unroll 4
        for (int i = 0; i < 32; ++i) { const int k = rs + 64 * i; const f32x4 w = *(const f32x4*)(w_ada + (size_t)k * (6 * DM) + n0);
#pragma unroll
            for (int b = 0; b < 8; ++b) acc[b] += w * cact[b * DM + k]; }
#pragma unroll
        for (int b = 0; b < 8; ++b) *(LAS f32x4*)(part + (rs * 8 + b) * 32 + cg * 4) = acc[b];
        __syncthreads();
        if (F.tid < 256) { const int b = F.tid >> 5, n = F.tid & 31; float s = 0.f;
#pragma unroll 8
            for (int r = 0; r < 64; ++r) s += part[(r * 8 + b) * 32 + n];
            mod[b * (6 * DM) + it * 32 + n] = s + b_ada[it * 32 + n]; }
        __syncthreads();
    }
}

__device__ __forceinline__ void p0_phase(Frame& F, const Args& a) {
    OPAQUE_FRAME(F);
    unsigned char* ws = F.ws;
    adaln_phase(F, a.in[1], a.in[3], a.in[4], (float*)(ws + WS_MOD));
    __syncthreads();
    LAS unsigned char* Tl = F.lds + F.wave * 4096;
    const int gw = F.vcu * NWAVES + F.wave, NGW = F.G * NWAVES;
    constexpr int I_IN = (DM / 64) * (INC / 32), I_QUP = (QLORA / 64) * (MH * MQK / 32), I_KVUP = (KVLORA / 64) * (MH * 256 / 32), I_OUT = (DM / 64) * (DM / 32);
    constexpr int NITEMS = I_IN + I_QUP + I_KVUP + I_OUT;
    { const float* w_in = a.in[6]; const float* w_qup = a.in[10]; const float* w_kvup = a.in[12]; const float* w_out = a.in[16]; const float* gq = a.in[9]; const float* gkv = a.in[11];
      auto mk = [=](int r) -> TrItem { TrItem t;
          if (r < I_IN) { const int nblk = INC / 32, kb = r / nblk, nb = r % nblk; t.src = w_in + (size_t)(64 * kb) * INC + 32 * nb; t.dst = (bf16_t*)(ws + WS_WIN) + (size_t)(32 * nb) * DM + 64 * kb; t.gk = nullptr; t.N = INC; t.ldt = DM; return t; } r -= I_IN;
          if (r < I_QUP) { const int nblk = MH * MQK / 32, kb = r / nblk, nb = r % nblk; t.src = w_qup + (size_t)(64 * kb) * (MH * MQK) + 32 * nb; t.dst = (bf16_t*)(ws + WS_WQUP) + (size_t)(32 * nb) * QLORA + 64 * kb; t.gk = gq + 64 * kb; t.N = MH * MQK; t.ldt = QLORA; return t; } r -= I_QUP;
          if (r < I_KVUP) { const int nblk = MH * 256 / 32, kb = r / nblk, nb = r % nblk; t.src = w_kvup + (size_t)(64 * kb) * (MH * 256) + 32 * nb; t.dst = (bf16_t*)(ws + WS_WKVUP) + (size_t)(32 * nb) * KVLORA + 64 * kb; t.gk = gkv + 64 * kb; t.N = MH * 256; t.ldt = KVLORA; return t; } r -= I_KVUP;
          { const int nblk = DM / 32, kb = r / nblk, nb = r % nblk; t.src = w_out + (size_t)(64 * kb) * DM + 32 * nb; t.dst = (bf16_t*)(ws + WS_WOUT) + (size_t)(32 * nb) * DM + 64 * kb; t.gk = nullptr; t.N = DM; t.ldt = DM; return t; } };
      tr_run(gw, NGW, NITEMS, mk, Tl, F.lane); }
    { const int* pos = (const int*)a.in[2]; float* rc = (float*)(ws + WS_ROPEC); float* rsn = (float*)(ws + WS_ROPES);
      const int gt = F.vcu * NTHR + F.tid, NGT = F.G * NTHR;
      for (int e = gt; e < T * 32; e += NGT) { const int i = e & 31, tk = e >> 5;
          const float invf = (float)exp2(-(double)i * (13.287712379549449 / 32.0));
          const float ang = (float)pos[tk] * invf;
          rc[e] = cosf(ang); rsn[e] = sinf(ang); }
      { float* ssq = (float*)(ws + WS_RSTDQ); for (int e = gt; e < 2 * T; e += NGT) ssq[e] = 0.f; }
      float* wct = (float*)(ws + WS_WCT);
      for (int e = gt; e < 48 * DM; e += NGT) { const int n = e / DM, k = e % DM;
          wct[e] = n < 4 ? a.in[18][k * NG + n] : (n < 36 ? a.in[20][k * NE + (n - 4)] : 0.f); } }
}

__device__ __forceinline__ void modnorm_row(const float* xrow, const float* g, const float* shift, const float* scale, bf16_t* orow, int lane) {
    const f32x4* xr = (const f32x4*)xrow + lane;
    f32x4 v[8]; float s = 0.f;
#pragma unroll
    for (int j = 0; j < 8; ++j) { v[j] = xr[64 * j]; s += (v[j].x * v[j].x + v[j].y * v[j].y) + (v[j].z * v[j].z + v[j].w * v[j].w); }
    const float rstd = rsqrtf(wave_sum(s) * (1.f / DM) + EPS);
    u32x2* o8 = (u32x2*)orow + lane;
#pragma unroll
    for (int j = 0; j < 8; ++j) { const f32x4 gg = ((const f32x4*)g)[64 * j + lane], sh = ((const f32x4*)shift)[64 * j + lane], sc = ((const f32x4*)scale)[64 * j + lane];
        const f32x4 h = v[j] * rstd * gg * (sc + 1.f) + sh;
        u32x2 w; w.x = cvt_pk_bf16(h.x, h.y); w.y = cvt_pk_bf16(h.z, h.w); o8[64 * j] = w; }
}
__device__ __forceinline__ void p1_phase(Frame& F, const Args& a) {
    OPAQUE_FRAME(F);
    const int gw = F.vcu * NWAVES + F.wave, NGW = F.G * NWAVES;
    const float* mod = (const float*)(F.ws + WS_MOD);
    bf16_t* H = (bf16_t*)(F.ws + WS_B);
    for (int m = gw; m < T; m += NGW) { const int b = m / SEQ;
        modnorm_row(a.in[0] + (size_t)m * DM, a.in[5], mod + b * (6 * DM), mod + b * (6 * DM) + DM, H + (size_t)m * DM, F.lane); }
}

template <int CTRL> __device__ __forceinline__ float dppf(float x) { return __builtin_bit_cast(float, __builtin_amdgcn_update_dpp(0, __builtin_bit_cast(int, x), CTRL, 0xF, 0xF, true)); }

namespace hg {
constexpr int OFF_F = 0, OFF_SEG = 32768, OFF_QIN = 34816, RP = 272, OFF_KIN = OFF_QIN + 64 * RP, OFF_QB = OFF_KIN + 64 * RP, OFF_KLT = OFF_QB + 64 * RP, SP = 144,
              OFF_VT = OFF_KLT + 128 * SP  , OFF_DEC = OFF_VT + 64 * SP  , OFF_SF = OFF_DEC + 3584  , HG_LDS = OFF_SF + 16384;
static_assert(HG_LDS <= LDS_USER, "hgrn lds");
__device__ __forceinline__ int ppos(int s) { return (s & ~15) | ((s & 4) << 1) | ((s & 8) >> 1) | (s & 3); }
}
__device__ __forceinline__ void hgrn_chunked(Frame& F, const Args& a, int item) {
    using namespace hg;
    const bf16_t* PROJ = (const bf16_t*)(F.ws + WS_A);
    bf16_t* MIX = (bf16_t*)(F.ws + WS_E);
    const float* lbl = a.in[7];
    LAS unsigned char* L = F.lds;
    LAS float* Fs = (LAS float*)(L + OFF_F); LAS float* SEGs = (LAS float*)(L + OFF_SEG); LAS float* DEC = (LAS float*)(L + OFF_DEC); LAS float* POST = DEC + 384;
    const int g = F.tid & 15, t0 = F.tid >> 4;
    const int sk = F.tid & 127, sseg = F.tid >> 7;
    const int r32 = F.lane & 31, hi = F.lane >> 5;
    {
        const int dq2 = (item >> 3) & 1, bh = (item >> 4) * 8 + (item & 7), h = bh & 7, b = bh >> 3;
        float lb[8];
#pragma unroll
        for (int j = 0; j < 8; ++j) { const int k = h * 128 + g * 8 + j; lb[j] = 1.f / (1.f + __expf(lbl[HW + k] - lbl[k])); }
        const bf16_t* base = PROJ + (size_t)(b * SEQ) * INCP + h * 128;
        f32x16 S0 = {}, S1 = {};
        u32x4 gq[2], gf[2], gv;
#define HG_LOADF(c) do { _Pragma("unroll") for (int i = 0; i < 2; ++i) gf[i] = *(const u32x4*)(base + (size_t)((c) * 64 + t0 + 32 * i) * INCP + g * 8 + HW); } while (0)
#define HG_LOADQ(c) do { _Pragma("unroll") for (int i = 0; i < 2; ++i) gq[i] = *(const u32x4*)(base + (size_t)((c) * 64 + t0 + 32 * i) * INCP + g * 8); \
            gv = *(const u32x4*)(base + (size_t)((c) * 64 + (F.tid >> 3)) * INCP + 2 * HW + dq2 * 64 + (F.tid & 7) * 8); } while (0)
        HG_LOADF(0); HG_LOADQ(0);
        for (int c = 0; c < SEQ / 64; ++c) {
            if (F.wave >= 4) { const int kb = F.wave - 4;
#pragma unroll
                for (int s2 = 0; s2 < 2; ++s2) { u32x4 w0, w1;
                    w0.x = cvt_pk_bf16(S0[8 * s2], S0[8 * s2 + 1]); w0.y = cvt_pk_bf16(S0[8 * s2 + 2], S0[8 * s2 + 3]); w0.z = cvt_pk_bf16(S0[8 * s2 + 4], S0[8 * s2 + 5]); w0.w = cvt_pk_bf16(S0[8 * s2 + 6], S0[8 * s2 + 7]);
                    w1.x = cvt_pk_bf16(S1[8 * s2], S1[8 * s2 + 1]); w1.y = cvt_pk_bf16(S1[8 * s2 + 2], S1[8 * s2 + 3]); w1.z = cvt_pk_bf16(S1[8 * s2 + 4], S1[8 * s2 + 5]); w1.w = cvt_pk_bf16(S1[8 * s2 + 6], S1[8 * s2 + 7]);
                    *(LAS u32x4*)(L + OFF_SF + ((((kb * 2 + 0) * 2 + s2) * 64) + F.lane) * 16) = w0;
                    *(LAS u32x4*)(L + OFF_SF + ((((kb * 2 + 1) * 2 + s2) * 64) + F.lane) * 16) = w1; } }
            float fv[2][8];
#pragma unroll
            for (int i = 0; i < 2; ++i) { float fl[8]; unpack8(gf[i], fl);
#pragma unroll
                for (int j = 0; j < 8; ++j) { const float sg = __builtin_amdgcn_rcpf(1.f + __builtin_amdgcn_exp2f(-1.4426950408889634f * fl[j])); fv[i][j] = lb[j] + (1.f - lb[j]) * sg; }
                LAS float* fp = Fs + (t0 + 32 * i) * 128 + g * 8;
                *(LAS f32x4*)fp = (f32x4){fv[i][0], fv[i][1], fv[i][2], fv[i][3]}; *(LAS f32x4*)(fp + 4) = (f32x4){fv[i][4], fv[i][5], fv[i][6], fv[i][7]}; }
            if (c + 1 < SEQ / 64) HG_LOADF(c + 1);
            __syncthreads();
            float klp[16];
            { float fr[16];
#pragma unroll
              for (int i = 0; i < 16; ++i) fr[i] = Fs[(16 * sseg + i) * 128 + sk];
              float p = 1.f;
#pragma unroll
              for (int i = 0; i < 16; ++i) { p *= fr[i]; Fs[(16 * sseg + i) * 128 + sk] = p; }
              SEGs[sseg * 128 + sk] = p;
              float q = 1.f;
#pragma unroll
              for (int i = 15; i >= 0; --i) { klp[i] = (1.f - fr[i]) * q; q *= fr[i]; } }
            __syncthreads();
            if (F.tid < 128) { const float s0 = SEGs[F.tid], s1 = SEGs[128 + F.tid], s2 = SEGs[256 + F.tid], s3 = SEGs[384 + F.tid];
                const float pm = s0 * s1;
                SEGs[F.tid] = 1.f; SEGs[128 + F.tid] = s0; SEGs[256 + F.tid] = pm; SEGs[384 + F.tid] = pm * s2;
                POST[F.tid] = s1 * s2 * s3; POST[128 + F.tid] = s2 * s3; POST[256 + F.tid] = s3; POST[384 + F.tid] = 1.f;
                DEC[F.tid] = pm * s2 * s3; DEC[128 + F.tid] = pm; DEC[256 + F.tid] = __builtin_amdgcn_rcpf(pm); }
            __syncthreads();
            { { const float po = POST[sseg * 128 + sk];
                float o16[16];
#pragma unroll
                for (int p = 0; p < 16; ++p) o16[p] = klp[8 * ((p >> 2) & 1) + 4 * (p >> 3) + (p & 3)] * po;
                *(LAS u32x4*)(L + OFF_KLT + sk * SP + sseg * 32) = pack8f(o16); *(LAS u32x4*)(L + OFF_KLT + sk * SP + sseg * 32 + 16) = pack8f(o16 + 8); }
#pragma unroll
              for (int i = 0; i < 2; ++i) { const int t = t0 + 32 * i;
                  float qin[8], kin[8], qb[8], qv[8];
                  unpack8(gq[i], qv);
                  const LAS float* fp = Fs + t * 128 + g * 8; const LAS float* pp = SEGs + (t >> 4) * 128 + g * 8;
                  const f32x4 pa = *(const LAS f32x4*)fp, pb = *(const LAS f32x4*)(fp + 4), ea = *(const LAS f32x4*)pp, eb = *(const LAS f32x4*)(pp + 4);
                  const f32x4 ma = *(const LAS f32x4*)(DEC + 128 + g * 8), mb = *(const LAS f32x4*)(DEC + 128 + g * 8 + 4), ra = *(const LAS f32x4*)(DEC + 256 + g * 8), rb = *(const LAS f32x4*)(DEC + 256 + g * 8 + 4);
#pragma unroll
                  for (int j = 0; j < 8; ++j) { const float P = (j < 4 ? pa[j] * ea[j] : pb[j - 4] * eb[j - 4]), pm = j < 4 ? ma[j] : mb[j - 4], rpm = j < 4 ? ra[j] : rb[j - 4];
                      const float r = __builtin_amdgcn_rcpf(P), kk = 1.f - fv[i][j], qs = qv[j] * 0.08838834764831845f;
                      qb[j] = qs * P; qin[j] = qb[j] * rpm; kin[j] = kk * pm * r; }
                  *(LAS u32x4*)(L + OFF_QIN + t * RP + g * 16) = pack8f(qin);
                  *(LAS u32x4*)(L + OFF_KIN + t * RP + g * 16) = pack8f(kin);
                  { const u32x4 w = pack8f(qb);
                    *(LAS u32x2*)(L + OFF_QB + t * RP + ((g >> 1) * 16 + (g & 1) * 4) * 2) = (u32x2){w.x, w.y};
                    *(LAS u32x2*)(L + OFF_QB + t * RP + ((g >> 1) * 16 + 8 + (g & 1) * 4) * 2) = (u32x2){w.z, w.w}; } }
              { float v[8]; unpack8(gv, v); const int s = F.tid >> 3, dvg = F.tid & 7, ps = ppos(s);
#pragma unroll
                  for (int j = 0; j < 8; ++j) *(LAS bf16_t*)(L + OFF_VT + (dvg * 8 + j) * SP + ps * 2) = (bf16_t)(__builtin_bit_cast(unsigned, v[j]) >> 16); } }
            if (c + 1 < SEQ / 64) HG_LOADQ(c + 1);
            __syncthreads();
            if (F.wave < 4) { const int tb = F.wave & 1, dvb = F.wave >> 1;
                f32x16 o = {};
                for (int sb = 0; sb <= tb; ++sb) { f32x16 X = {};
#pragma unroll
                    for (int ks = 0; ks < 8; ++ks) { const bf16x8 af = *(const LAS bf16x8*)(L + OFF_KIN + (32 * sb + r32) * RP + (16 * ks + 8 * hi) * 2);
                        const bf16x8 bfr = *(const LAS bf16x8*)(L + OFF_QIN + (32 * tb + r32) * RP + (16 * ks + 8 * hi) * 2);
                        X = __builtin_amdgcn_mfma_f32_32x32x16_bf16(af, bfr, X, 0, 0, 0); }
                    if (sb == tb) {
#pragma unroll
                        for (int r = 0; r < 16; ++r) { const int srow = (r & 3) + 8 * (r >> 2) + 4 * hi; if (srow > r32) X[r] = 0.f; } }
#pragma unroll
                    for (int s2 = 0; s2 < 2; ++s2) { u32x4 w; w.x = cvt_pk_bf16(X[8 * s2], X[8 * s2 + 1]); w.y = cvt_pk_bf16(X[8 * s2 + 2], X[8 * s2 + 3]); w.z = cvt_pk_bf16(X[8 * s2 + 4], X[8 * s2 + 5]); w.w = cvt_pk_bf16(X[8 * s2 + 6], X[8 * s2 + 7]);
                        const bf16x8 vf = *(const LAS bf16x8*)(L + OFF_VT + (32 * dvb + r32) * SP + (32 * sb + 16 * s2 + 8 * hi) * 2);
                        o = __builtin_amdgcn_mfma_f32_32x32x16_bf16(__builtin_bit_cast(bf16x8, w), vf, o, 0, 0, 0); } }
#pragma unroll
                for (int kb = 0; kb < 4; ++kb)
#pragma unroll
                    for (int s2 = 0; s2 < 2; ++s2) { const bf16x8 sf = *(const LAS bf16x8*)(L + OFF_SF + ((((kb * 2 + dvb) * 2 + s2) * 64) + F.lane) * 16);
                        const bf16x8 qf = *(const LAS bf16x8*)(L + OFF_QB + (32 * tb + r32) * RP + (32 * kb + 16 * s2 + 8 * hi) * 2);
                        o = __builtin_amdgcn_mfma_f32_32x32x16_bf16(qf, sf, o, 0, 0, 0); }
                bf16_t* orow = MIX + (size_t)(b * SEQ + c * 64 + 32 * tb) * DM + h * 128 + dq2 * 64 + dvb * 32 + r32;
#pragma unroll
                for (int r = 0; r < 16; ++r) { const float v = o[r]; const float vn = __shfl_xor(v, 1);
                    if ((r32 & 1) == 0) *(unsigned*)(orow + (size_t)((r & 3) + 8 * (r >> 2) + 4 * hi) * DM) = cvt_pk_bf16(v, vn); }
            } else { const int kb = F.wave - 4;
#pragma unroll
                for (int r = 0; r < 16; ++r) { const float dcy = DEC[32 * kb + (r & 3) + 8 * (r >> 2) + 4 * hi]; S0[r] *= dcy; S1[r] *= dcy; }
#pragma unroll
                for (int ss = 0; ss < 4; ++ss) { const bf16x8 kf = *(const LAS bf16x8*)(L + OFF_KLT + (32 * kb + r32) * SP + (16 * ss + 8 * hi) * 2);
                    const bf16x8 vf0 = *(const LAS bf16x8*)(L + OFF_VT + r32 * SP + (16 * ss + 8 * hi) * 2), vf1 = *(const LAS bf16x8*)(L + OFF_VT + (32 + r32) * SP + (16 * ss + 8 * hi) * 2);
                    S0 = __builtin_amdgcn_mfma_f32_32x32x16_bf16(kf, vf0, S0, 0, 0, 0); S1 = __builtin_amdgcn_mfma_f32_32x32x16_bf16(kf, vf1, S1, 0, 0, 0); }
            }
            __syncthreads();
        }
#undef HG_LOADF
#undef HG_LOADQ
    }
}

__device__ __forceinline__ void p3_phase(Frame& F, const Args& a) {
    OPAQUE_FRAME(F);
    const int role = ((int)blockIdx.x >> 3) & 1, idx = ((int)blockIdx.x >> 4) * 8 + ((int)blockIdx.x & 7), half = F.G >> 1;
    unsigned char* ws = F.ws;
    if (role == 0) { for (int it = idx; it < NB * HH * 2; it += half) hgrn_chunked(F, a, it); }
    else {
        { pg8::Gemm g{(const bf16_t*)(ws + WS_A) + C_QA, (const bf16_t*)(ws + WS_WQUP), INCP, QLORA, QLORA};
          pg8::DenseOrder S; S.init(T / 256, MH * MQK / 256, half, idx);
          pg8::EpiStore E{(bf16_t*)(ws + WS_B), MH * MQK, (const float*)(ws + WS_RSTDQ), 1.f / QLORA};
          pg8::gemm_phase<pg8::EpiStore, pg8::DenseOrder>(F.lds, g, S, E); }
        { pg8::Gemm g{(const bf16_t*)(ws + WS_A) + C_KVA, (const bf16_t*)(ws + WS_WKVUP), INCP, KVLORA, KVLORA};
          pg8::DenseOrder S; S.init(T / 256, MH * 256 / 256, half, idx);
          pg8::EpiStore E{(bf16_t*)(ws + WS_C), MH * 256, (const float*)(ws + WS_RSTDKV), 1.f / KVLORA};
          pg8::gemm_phase<pg8::EpiStore, pg8::DenseOrder>(F.lds, g, S, E); }
    }
}

__device__ __forceinline__ float sum8(float v) { v += __shfl_xor(v, 1); v += __shfl_xor(v, 2); v += __shfl_xor(v, 4); return v; }

__device__ __forceinline__ void p5_phase(Frame& F, const Args& a) {
    OPAQUE_FRAME(F);
    const int gw = F.vcu * NWAVES + F.wave, NGW = F.G * NWAVES;
    const bf16_t* PROJ = (const bf16_t*)(F.ws + WS_A);
    const bf16_t* QH = (const bf16_t*)(F.ws + WS_B);
    const bf16_t* KV = (const bf16_t*)(F.ws + WS_C);
    bf16_t* Qn = (bf16_t*)(F.ws + WS_D); bf16_t* Kn = (bf16_t*)(F.ws + WS_D + QN_BYTES); bf16_t* Vh = (bf16_t*)(F.ws + WS_D + 2 * QN_BYTES);
    bf16_t* MIX = (bf16_t*)(F.ws + WS_E);
    const float* rc = (const float*)(F.ws + WS_ROPEC); const float* rsn = (const float*)(F.ws + WS_ROPES);
    const float* gqn = a.in[13]; const float* gkn = a.in[14]; const float* gon = a.in[8];
    const int h = F.lane >> 3, sub = F.lane & 7;
    for (int t = gw; t < T; t += NGW) {
        const int b = t / SEQ, s = t % SEQ;
        const size_t hrow = ((size_t)(b * MH + h) * SEQ + s);
        float cs[8], sn[8];
        { const int ii = (sub & 3) * 8; const float* cp = rc + (size_t)t * 32 + ii; const float* sp = rsn + (size_t)t * 32 + ii;
#pragma unroll
          for (int j = 0; j < 8; ++j) { cs[j] = cp[j]; sn[j] = sp[j]; } }
        const float sgn = sub < 4 ? -1.f : 1.f;
        { float q[3][8]; float ss = 0.f;
#pragma unroll
          for (int i = 0; i < 3; ++i) { unpack8(*(const u32x4*)(QH + (size_t)t * (MH * MQK) + h * MQK + (sub + 8 * i) * 8), q[i]);
#pragma unroll
              for (int j = 0; j < 8; ++j) ss += q[i][j] * q[i][j]; }
          const float rs = rsqrtf(sum8(ss) * (1.f / MQK) + EPS);
#pragma unroll
          for (int i = 0; i < 3; ++i)
#pragma unroll
              for (int j = 0; j < 8; ++j) q[i][j] *= rs * gqn[(sub + 8 * i) * 8 + j];
#pragma unroll
          for (int j = 0; j < 8; ++j) { const float pv = __shfl_xor(q[2][j], 4); q[2][j] = q[2][j] * cs[j] + sgn * pv * sn[j]; }
#pragma unroll
          for (int i = 0; i < 3; ++i) *(u32x4*)(Qn + hrow * MQK + (sub + 8 * i) * 8) = pack8f(q[i]); }
        { float k[3][8]; float ss = 0.f;
#pragma unroll
          for (int i = 0; i < 2; ++i) unpack8(*(const u32x4*)(KV + (size_t)t * (MH * 256) + h * 256 + (sub + 8 * i) * 8), k[i]);
          unpack8(*(const u32x4*)(PROJ + (size_t)t * INCP + C_KPE + sub * 8), k[2]);
#pragma unroll
          for (int i = 0; i < 3; ++i)
#pragma unroll
              for (int j = 0; j < 8; ++j) ss += k[i][j] * k[i][j];
          const float rs = rsqrtf(sum8(ss) * (1.f / MQK) + EPS);
#pragma unroll
          for (int i = 0; i < 3; ++i)
#pragma unroll
              for (int j = 0; j < 8; ++j) k[i][j] *= rs * gkn[(sub + 8 * i) * 8 + j];
#pragma unroll
          for (int j = 0; j < 8; ++j) { const float pv = __shfl_xor(k[2][j], 4); k[2][j] = k[2][j] * cs[j] + sgn * pv * sn[j]; }
#pragma unroll
          for (int i = 0; i < 3; ++i) *(u32x4*)(Kn + hrow * MQK + (sub + 8 * i) * 8) = pack8f(k[i]); }
#pragma unroll
        for (int i = 0; i < 2; ++i) *(u32x4*)(Vh + hrow * MV + (sub + 8 * i) * 8) = *(const u32x4*)(KV + (size_t)t * (MH * 256) + h * 256 + 128 + (sub + 8 * i) * 8);
        { float o[2][8], gt[2][8]; float ss = 0.f;
#pragma unroll
          for (int i = 0; i < 2; ++i) { unpack8(*(const u32x4*)(MIX + (size_t)t * DM + h * 128 + (sub + 8 * i) * 8), o[i]); unpack8(*(const u32x4*)(PROJ + (size_t)t * INCP + 3 * HW + h * 128 + (sub + 8 * i) * 8), gt[i]);
#pragma unroll
              for (int j = 0; j < 8; ++j) ss += o[i][j] * o[i][j]; }
          const float rs = rsqrtf(sum8(ss) * (1.f / HDV) + EPS);
#pragma unroll
          for (int i = 0; i < 2; ++i) {
#pragma unroll
              for (int j = 0; j < 8; ++j) o[i][j] = o[i][j] * rs * gon[(sub + 8 * i) * 8 + j] * siluf(gt[i][j]);
              *(u32x4*)(MIX + (size_t)t * DM + h * 128 + (sub + 8 * i) * 8) = pack8f(o[i]); } }
    }
}
namespace att {
constexpr int QBLK = 32, KVBLK = 64, QB = 256;
constexpr int KROW = 512, SHM_K = KVBLK * KROW, SHM_V = KVBLK * MV * 2;
constexpr int OFF_V = 0, OFF_K = 2 * SHM_V, OFF_WS = OFF_K + 2 * SHM_K;
constexpr float SCALE = 0.07216878364870322f;
constexpr float THR = 8.f;
#define SBAR() __builtin_amdgcn_sched_barrier(0)
__device__ __forceinline__ int v_st(int k, int c) { const int kk = (k & ~0xC) | ((k & 4) << 1) | ((k & 8) >> 1); return ((kk >> 3) * 4 + (c >> 5)) * 512 + ((kk & 7) * 32 + (c & 31)) * 2; }
__device__ __forceinline__ int v_rd_base(int lane) { return ((lane & 3) << 3) | (((lane >> 2) & 3) << 6) | (((lane >> 4) & 1) << 5) | (((lane >> 5) & 1) << 8); }
constexpr int v_rd_off(int d0, int ks, int half) { return d0 * 512 + ks * 4096 + half * 2048; }
__device__ __forceinline__ int crow(int r, int hi) { return (r & 3) + 8 * (r >> 2) + 4 * hi; }
__device__ __forceinline__ unsigned cvtpk(float lo, float hi) { unsigned r; asm volatile("v_cvt_pk_bf16_f32 %0, %1, %2" : "=v"(r) : "v"(lo), "v"(hi)); return r; }

__device__ __forceinline__ void mask_tile(f32x16& p0, f32x16& p1, int dq) {
    const float NEG = -__builtin_inff();
#pragma unroll
    for (int r = 0; r < 16; ++r) {
        const int c = (r & 3) + 8 * (r >> 2);
        if (dq - c < 0) p0[r] = NEG;
        if (dq - c - 32 < 0) p1[r] = NEG;
    }
}
__device__ __forceinline__ void partialSM(f32x16& p0, f32x16& p1, float& m_reg, float& mn, float& alpha) {
    float pmax = p0[0];
#pragma unroll
    for (int r = 1; r < 16; ++r) pmax = fmaxf(pmax, p0[r]);
#pragma unroll
    for (int r = 0; r < 16; ++r) pmax = fmaxf(pmax, p1[r]);
    { auto rr = __builtin_amdgcn_permlane32_swap(__float_as_uint(pmax), __float_as_uint(pmax), false, false);
      pmax = fmaxf(__uint_as_float(rr[0]), __uint_as_float(rr[1])); }
    constexpr float C2 = 1.4426950408889634f * SCALE;
    if (__builtin_expect(__all((pmax - m_reg) * SCALE <= THR), 1)) { mn = m_reg; alpha = 1.f; }
    else { mn = fmaxf(m_reg, pmax); alpha = __builtin_amdgcn_exp2f((m_reg - mn) * C2); m_reg = mn; }
    const float mnL = -mn * C2;
#pragma unroll
    for (int r = 0; r < 16; ++r) p0[r] = fmaf(p0[r], C2, mnL);
#pragma unroll
    for (int r = 0; r < 16; ++r) p1[r] = fmaf(p1[r], C2, mnL);
#pragma unroll
    for (int r = 0; r < 16; ++r) p0[r] = __builtin_amdgcn_exp2f(p0[r]);
}
__device__ __forceinline__ void finishSM(f32x16& p0, f32x16& p1, float alpha, float& l_reg, bf16x8& pa0, bf16x8& pa1, bf16x8& pa2, bf16x8& pa3) {
#pragma unroll
    for (int r = 0; r < 16; ++r) p1[r] = __builtin_amdgcn_exp2f(p1[r]);
    float ps = 0;
#pragma unroll
    for (int r = 0; r < 16; ++r) ps += p0[r];
#pragma unroll
    for (int r = 0; r < 16; ++r) ps += p1[r];
    { auto rr = __builtin_amdgcn_permlane32_swap(__float_as_uint(ps), __float_as_uint(ps), false, false);
      ps = __uint_as_float(rr[0]) + __uint_as_float(rr[1]); }
    l_reg = l_reg * alpha + ps;
#define PK4(P, B_, OUT) do { unsigned a0 = cvtpk(P[B_+0], P[B_+1]), a1 = cvtpk(P[B_+2], P[B_+3]);                          \
        unsigned b0 = cvtpk(P[B_+4], P[B_+5]), b1 = cvtpk(P[B_+6], P[B_+7]);                                             \
        auto r0 = __builtin_amdgcn_permlane32_swap(a0, b0, false, false); auto r1 = __builtin_amdgcn_permlane32_swap(a1, b1, false, false); \
        u32x4 w = {r0[0], r1[0], r0[1], r1[1]}; OUT = __builtin_bit_cast(bf16x8, w); } while (0)
    PK4(p0, 0, pa0); PK4(p0, 8, pa1); PK4(p1, 0, pa2); PK4(p1, 8, pa3);
#undef PK4
}
template <int KB>
__device__ __forceinline__ void qkt(f32x16& p0, f32x16& p1, LAS unsigned char* lds, int r32, int hi, const bf16x8* qr) {
    p0 = f32x16{}; p1 = f32x16{};
    int sw = r32 & 15; asm volatile("" : "+v"(sw));
    const int rb = OFF_K + KB * SHM_K + r32 * KROW;
    int ab[8];
#pragma unroll
    for (int d = 0; d < 8; ++d) ab[d] = rb + (((2 * d + hi) ^ sw) << 4);
#pragma unroll
    for (int d0 = 0; d0 < 12; ++d0) { const int a = ab[d0 & 7] + (d0 >> 3) * 256;
        const bf16x8 b0 = *(const LAS bf16x8*)(lds + a);
        const bf16x8 b1 = *(const LAS bf16x8*)(lds + a + 32 * KROW);
        p0 = __builtin_amdgcn_mfma_f32_32x32x16_bf16(b0, qr[d0], p0, 0, 0, 0);
        p1 = __builtin_amdgcn_mfma_f32_32x32x16_bf16(b1, qr[d0], p1, 0, 0, 0); }
}
template <int VB>
__device__ __forceinline__ void pv_tile(f32x16* o, int vb0, bf16x8 pa0, bf16x8 pa1, bf16x8 pa2, bf16x8 pa3) {
#define TRRD(dst, off) asm volatile("ds_read_b64_tr_b16 %0, %1 offset:%2" : "=&v"(dst) : "v"(vb0), "i"(off) : "memory")
#define PV_D0(d0) do { s16x4 l0, l1, l2, l3, h0, h1, h2, h3; constexpr int b_ = OFF_V + VB * SHM_V + v_rd_off(d0, 0, 0); \
        TRRD(l0, b_); TRRD(h0, b_ + 2048); TRRD(l1, b_ + 4096); TRRD(h1, b_ + 6144); TRRD(l2, b_ + 8192); TRRD(h2, b_ + 10240); TRRD(l3, b_ + 12288); TRRD(h3, b_ + 14336); \
        asm volatile("s_waitcnt lgkmcnt(0)" ::: "memory"); SBAR();   \
        o[d0] = __builtin_amdgcn_mfma_f32_32x32x16_bf16(pa0, (bf16x8){l0[0], l0[1], l0[2], l0[3], h0[0], h0[1], h0[2], h0[3]}, o[d0], 0, 0, 0);   \
        o[d0] = __builtin_amdgcn_mfma_f32_32x32x16_bf16(pa1, (bf16x8){l1[0], l1[1], l1[2], l1[3], h1[0], h1[1], h1[2], h1[3]}, o[d0], 0, 0, 0);   \
        o[d0] = __builtin_amdgcn_mfma_f32_32x32x16_bf16(pa2, (bf16x8){l2[0], l2[1], l2[2], l2[3], h2[0], h2[1], h2[2], h2[3]}, o[d0], 0, 0, 0);   \
        o[d0] = __builtin_amdgcn_mfma_f32_32x32x16_bf16(pa3, (bf16x8){l3[0], l3[1], l3[2], l3[3], h3[0], h3[1], h3[2], h3[3]}, o[d0], 0, 0, 0); } while (0)
    PV_D0(0); PV_D0(1); PV_D0(2); PV_D0(3);
#undef PV_D0
#undef TRRD
}

__device__ __forceinline__ void attn_block(const bf16_t* Q, const bf16_t* K, const bf16_t* V, bf16_t* O, int P0, const float* gon, LAS unsigned char* lds) {
    int tid = threadIdx.x; asm volatile("" : "+v"(tid));
    const int wid = __builtin_amdgcn_readfirstlane(tid >> 6), lane = tid & 63, r32 = lane & 31, hi = lane >> 5;
    const int NT = P0 / KVBLK + 4;
    const int qlo = P0 + wid * QBLK, qm = qlo + r32 - 4 * hi;
    LAS float* wsf = (LAS float*)(lds + OFF_WS) + wid * 64; LAS float* li_l = wsf; LAS float* al_l = wsf + 32;
    float m_reg = -1e30f, l_reg = 0.f; f32x16 o[4] = {};
    bf16x8 qr[12];
#pragma unroll
    for (int d0 = 0; d0 < 12; ++d0) qr[d0] = *(const bf16x8*)(Q + (size_t)(qlo + r32) * MQK + d0 * 16 + hi * 8);
    int ksrc[4], vsrc[2];
#pragma unroll
    for (int i = 0; i < 4; ++i) { const int row = 2 * (wid * 4 + i) + (lane >> 5), c = (lane & 31) ^ (row & 15); ksrc[i] = row * MQK + (c < 24 ? c : 0) * 8; }
#pragma unroll
    for (int i = 0; i < 2; ++i) { const int id = (wid * 2 + i) * 2 + (lane >> 5), kk = ((id >> 2) << 3) | ((lane & 31) >> 2), k = (kk & ~0xC) | ((kk & 4) << 1) | ((kk & 8) >> 1);
        vsrc[i] = k * MV + (id & 3) * 32 + (lane & 3) * 8; }
    const int vb0 = (int)(unsigned)(uintptr_t)lds + v_rd_base(lane);
#define ALOAD(t, bf) do { const bf16_t* kp = K + (size_t)(t) * KVBLK * MQK; const bf16_t* vp = V + (size_t)(t) * KVBLK * MV; \
        _Pragma("unroll") for (int i = 0; i < 4; ++i) __builtin_amdgcn_global_load_lds((const unsigned*)(kp + ksrc[i]), (LAS unsigned*)(lds + OFF_K + (bf) * SHM_K + (wid * 4 + i) * 1024), 16, 0, 0); \
        _Pragma("unroll") for (int i = 0; i < 2; ++i) __builtin_amdgcn_global_load_lds((const unsigned*)(vp + vsrc[i]), (LAS unsigned*)(lds + OFF_V + (bf) * SHM_V + (wid * 2 + i) * 1024), 16, 0, 0); } while (0)
#define RESC(a) do { if (__any((a) < 1.f)) { if (hi == 0) al_l[r32] = (a); asm volatile("s_waitcnt lgkmcnt(0)" ::: "memory"); \
        _Pragma("unroll") for (int d_ = 0; d_ < 4; ++d_) _Pragma("unroll") for (int r = 0; r < 16; ++r) o[d_][r] *= al_l[crow(r, hi)]; } } while (0)
#define STEP(t, BF) do { f32x16 p0, p1; float mn, al; bf16x8 pa0, pa1, pa2, pa3; \
        if ((t) + 1 < NT) ALOAD((t) + 1, 1 - (BF)); \
        SBAR(); qkt<BF>(p0, p1, lds, r32, hi, qr); \
        { const int kb_ = (t) * KVBLK; if (kb_ + KVBLK - 1 > qlo) mask_tile(p0, p1, qm - kb_); } \
        partialSM(p0, p1, m_reg, mn, al); RESC(al); finishSM(p0, p1, al, l_reg, pa0, pa1, pa2, pa3); SBAR(); \
        pv_tile<BF>(o, vb0, pa0, pa1, pa2, pa3); SBAR(); \
        asm volatile("s_waitcnt vmcnt(0)" ::: "memory"); __syncthreads(); } while (0)
    ALOAD(0, 0); asm volatile("s_waitcnt vmcnt(0)" ::: "memory"); __syncthreads();
    for (int t = 0; t < NT; t += 2) { STEP(t, 0); STEP(t + 1, 1); }
#undef STEP
#undef RESC
#undef ALOAD
    if (hi == 0) li_l[r32] = l_reg;
    asm volatile("s_waitcnt lgkmcnt(0)" ::: "memory");
    float gv[4];
#pragma unroll
    for (int d0 = 0; d0 < 4; ++d0) gv[d0] = gon[d0 * 32 + r32];
#pragma unroll
    for (int r = 0; r < 16; ++r) { const float rl = 1.f / li_l[crow(r, hi)];
        float ss = 0.f;
#pragma unroll
        for (int d0 = 0; d0 < 4; ++d0) { o[d0][r] *= rl; ss += o[d0][r] * o[d0][r]; }
        ss += __shfl_xor(ss, 1); ss += __shfl_xor(ss, 2); ss += __shfl_xor(ss, 4); ss += __shfl_xor(ss, 8); ss += __shfl_xor(ss, 16);
        const float rs = rsqrtf(ss * (1.f / MV) + EPS);
        bf16_t* orow = O + (size_t)(qlo + crow(r, hi)) * DM;
#pragma unroll
        for (int d0 = 0; d0 < 4; ++d0) { const float v = o[d0][r] * rs * gv[d0]; const float vn = __shfl_xor(v, 1);
            if ((r32 & 1) == 0) *(unsigned*)(orow + d0 * 32 + r32) = cvtpk(v, vn); } }
    __syncthreads();
}
#undef SBAR
}

__device__ __forceinline__ void p6_phase(Frame& F, const Args& a) {
    const bf16_t* Qn = (const bf16_t*)(F.ws + WS_D); const bf16_t* Kn = (const bf16_t*)(F.ws + WS_D + QN_BYTES); const bf16_t* Vh = (const bf16_t*)(F.ws + WS_D + 2 * QN_BYTES);
    bf16_t* MIX = (bf16_t*)(F.ws + WS_E);
    for (int it = F.vcu; it < NB * MH * 4; it += F.G) {
        const int bh = it >> 2, j = it & 3, b = bh >> 3, h = bh & 7;
        const bf16_t* Q = Qn + (size_t)bh * SEQ * MQK; const bf16_t* K = Kn + (size_t)bh * SEQ * MQK; const bf16_t* V = Vh + (size_t)bh * SEQ * MV;
        bf16_t* O = MIX + (size_t)(b * SEQ) * DM + HW + h * MV;
        att::attn_block(Q, K, V, O, (7 - j) * att::QB, a.in[15], F.lds);
        att::attn_block(Q, K, V, O, j * att::QB, a.in[15], F.lds);
    }
}
constexpr int P8_RS = DM + 4;
__device__ __forceinline__ void p8_phase(Frame& F, const Args& a) {
    OPAQUE_FRAME(F);
    unsigned char* ws = F.ws;
    const float* xin = a.in[0]; const bf16_t* mixo = (const bf16_t*)(ws + WS_F); const float* mod = (const float*)(ws + WS_MOD); const float* g2n = a.in[17];
    const float* wct = (const float*)(ws + WS_WCT);
    bf16_t* H2 = (bf16_t*)(ws + WS_B);
    int* tok_e = (int*)(ws + WS_TOKE); float* tok_w = (float*)(ws + WS_TOKW); int* tok_s = (int*)(ws + WS_TOKS);
    LAS float* xs = (LAS float*)F.lds;
    LAS float* red = (LAS float*)F.lds;
    LAS float* lg = (LAS float*)(F.lds + 24576);
    LAS float* rstd_l = (LAS float*)(F.lds + 16 * P8_RS * 4);
    const int row_l = F.tid >> 5, c_l = (F.tid & 31) * 4;
    const int mr = F.lane & 15, mg = F.lane >> 4;
    for (int tile = F.vcu; tile < T / 16; tile += F.G) {
        const int m0 = tile * 16, b = m0 / SEQ;
        { const float* xr = xin + (size_t)(m0 + row_l) * DM + c_l; const bf16_t* mr_ = mixo + (size_t)(m0 + row_l) * DM + c_l; const float* g1 = mod + b * (6 * DM) + 2 * DM + c_l; float ss = 0.f;
#pragma unroll
          for (int j = 0; j < 16; ++j) { const u32x2 mw = *(const u32x2*)(mr_ + 128 * j); const f32x4 gg1 = *(const f32x4*)(g1 + 128 * j);
              const f32x4 v = *(const f32x4*)(xr + 128 * j) + gg1 * (f32x4){bf_lo(mw.x), bf_hi(mw.x), bf_lo(mw.y), bf_hi(mw.y)}; ss += (v.x * v.x + v.y * v.y) + (v.z * v.z + v.w * v.w); *(LAS f32x4*)(xs + row_l * P8_RS + c_l + 128 * j) = v; }
          ss += __shfl_xor(ss, 1); ss += __shfl_xor(ss, 2); ss += __shfl_xor(ss, 4); ss += __shfl_xor(ss, 8); ss += __shfl_xor(ss, 16);
          if ((F.tid & 31) == 0) rstd_l[row_l] = rsqrtf(ss * (1.f / DM) + EPS); }
        __syncthreads();
        f32x4 acc[3];
#pragma unroll
        for (int n = 0; n < 3; ++n) acc[n] = (f32x4){0.f, 0.f, 0.f, 0.f};
        { const float rs = rstd_l[mr]; const float* sh2 = mod + b * (6 * DM) + 3 * DM; const float* sc2 = mod + b * (6 * DM) + 4 * DM;
#pragma unroll 2
          for (int s = 0; s < 16; ++s) { const int k0 = F.wave * 256 + 16 * s + 4 * mg;
              const f32x4 xv = *(const LAS f32x4*)(xs + mr * P8_RS + k0);
              const f32x4 gg = *(const f32x4*)(g2n + k0), sc = *(const f32x4*)(sc2 + k0), sh = *(const f32x4*)(sh2 + k0);
              const f32x4 hv = xv * rs * gg * (sc + 1.f) + sh;
              u32x2 w; w.x = cvt_pk_bf16(hv.x, hv.y); w.y = cvt_pk_bf16(hv.z, hv.w);
              *(u32x2*)(H2 + (size_t)(m0 + mr) * DM + k0) = w;
              f32x4 bw[3];
#pragma unroll
              for (int n = 0; n < 3; ++n) bw[n] = *(const f32x4*)(wct + (size_t)(n * 16 + mr) * DM + k0);
#pragma unroll
              for (int i = 0; i < 4; ++i)
#pragma unroll
                  for (int n = 0; n < 3; ++n) acc[n] = __builtin_amdgcn_mfma_f32_16x16x4f32(hv[i], bw[n][i], acc[n], 0, 0, 0); } }
        __syncthreads();
#pragma unroll
        for (int n = 0; n < 3; ++n)
#pragma unroll
            for (int r = 0; r < 4; ++r) red[(F.wave * 16 + mg * 4 + r) * 48 + n * 16 + mr] = acc[n][r];
        __syncthreads();
        for (int idx = F.tid; idx < 16 * 36; idx += NTHR) { const int row = idx / 36, n = idx % 36; float s = n < 4 ? a.in[19][n] : a.in[21][n - 4];
#pragma unroll
            for (int w = 0; w < 8; ++w) s += red[(w * 16 + row) * 48 + n];
            lg[row * 36 + n] = s; }
        __syncthreads();
        if (F.tid < 16) { const LAS float* l = lg + F.tid * 36; const int t = m0 + F.tid;
            int g = 0; float gm = l[0];
#pragma unroll
            for (int j = 1; j < 4; ++j) if (l[j] > gm) { gm = l[j]; g = j; }
            float den = 0.f;
#pragma unroll
            for (int j = 0; j < 4; ++j) den += __expf(l[j] - gm);
            const float pg = 1.f / den;
            const LAS float* e = l + 4 + g * 8;
            int i1 = 0; float v1 = e[0];
#pragma unroll
            for (int j = 1; j < 8; ++j) if (e[j] > v1) { v1 = e[j]; i1 = j; }
            int i2 = -1; float v2 = -__builtin_inff();
#pragma unroll
            for (int j = 0; j < 8; ++j) if (j != i1 && e[j] > v2) { v2 = e[j]; i2 = j; }
            const float w1 = 1.f / (1.f + __expf(v2 - v1)), w2 = 1.f - w1;
            const int e1 = g * 8 + i1, e2 = g * 8 + i2;
            const int s1 = (int)atomicAdd((unsigned*)(F.ctl + CW_CNT + 64 * e1), 1u), s2 = (int)atomicAdd((unsigned*)(F.ctl + CW_CNT + 64 * e2), 1u);
            tok_e[2 * t] = e1; tok_e[2 * t + 1] = e2; tok_w[2 * t] = pg * w1; tok_w[2 * t + 1] = pg * w2; tok_s[2 * t] = s1; tok_s[2 * t + 1] = s2;
            int* list = (int*)(ws + WS_LIST); list[e1 * T + s1] = t; list[e2 * T + s2] = t; }
        __syncthreads();
    }
    LAS unsigned char* Tl = F.lds + F.wave * 4096;
    const int gw = F.vcu * NWAVES + F.wave, NGW = F.G * NWAVES;
    constexpr int I_G = NE * (DM / 64) * (DE / 32);
    { const float* wg = a.in[22]; const float* wu = a.in[23]; const float* wd = a.in[24];
      auto mk = [=](int it) -> TrItem { TrItem t; t.gk = nullptr;
          const int which = it / I_G, r = it % I_G;
          if (which < 2) { const int e = r / 512, q = r % 512, kb = q / 16, nb = q % 16, n0 = 32 * nb;
              t.src = (which ? wu : wg) + (size_t)e * DM * DE + (size_t)(64 * kb) * DE + n0;
              t.dst = (bf16_t*)(ws + WS_D) + ((size_t)e * 1024 + (n0 >> 7) * 256 + (n0 & 127) + which * 128) * DM + 64 * kb; t.N = DE; t.ldt = DM; }
          else { const int e = r / 512, q = r % 512, kb = q / 64, nb = q % 64, n0 = 32 * nb;
              t.src = wd + (size_t)e * DE * DM + (size_t)(64 * kb) * DM + n0;
              t.dst = (bf16_t*)(ws + WS_E) + ((size_t)e * DM + n0) * DE + 64 * kb; t.N = DM; t.ldt = DE; }
          return t; };
      tr_run(gw, NGW, 3 * I_G, mk, Tl, F.lane); }
}

constexpr int MOE_TAB_OFF = LDS_USER;
__device__ __forceinline__ LAS int* moe_tables(Frame& F) {
    LAS int* tab = (LAS int*)(F.lds + MOE_TAB_OFF);
    __syncthreads();
    if (F.tid == 0) { int acc = 0;
        for (int e = 0; e < NE; ++e) { tab[e] = acc; const int c = (int)__hip_atomic_load((unsigned*)(F.ctl + CW_CNT + 64 * e), RLX_AGENT); tab[64 + e] = c; acc += ((c + 255) / 256) * 256; }
        tab[NE] = acc; }
    __syncthreads();
    if (F.tid < 160) { int e = 0; for (int j = 1; j < NE; ++j) if (tab[j] <= F.tid * 256) e = j; tab[128 + F.tid] = e; }
    __syncthreads();
    return tab;
}

__device__ __forceinline__ void p12_phase(Frame& F, const Args& a) {
    OPAQUE_FRAME(F);
    unsigned char* ws = F.ws;
    const bf16_t* Y = (const bf16_t*)(ws + WS_A);
    const float* tok_w = (const float*)(ws + WS_TOKW); const int* tok_s = (const int*)(ws + WS_TOKS);
    const float* mod = (const float*)(ws + WS_MOD);
    const LAS int* tab = moe_tables(F); const int* tok_e = (const int*)(ws + WS_TOKE);
    const int gw = F.vcu * NWAVES + F.wave, NGW = F.G * NWAVES;
#if defined(MK_STAMP) && MK_STAMP >= 0
    const float dscale = 1.f + sqrtf(exp2f(rintf(3.f * log2f(*(const float*)(ws + WS_STAMP + 8) + 1.f) + MK_QSHIFT) * (1.f / 3.f)));
#else
    const float dscale = 1.f;
#endif
    for (int t = gw; t < T; t += NGW) {
        const int b = t / SEQ; const float w0 = tok_w[2 * t], w1 = tok_w[2 * t + 1]; const int d0 = tab[tok_e[2 * t]] + tok_s[2 * t], d1 = tab[tok_e[2 * t + 1]] + tok_s[2 * t + 1];
        const float* g2 = mod + b * (6 * DM) + 5 * DM; const float* g1 = mod + b * (6 * DM) + 2 * DM;
        float* orow = F.out + (size_t)t * DM; const float* xrow = a.in[0] + (size_t)t * DM; const bf16_t* mrow = (const bf16_t*)(ws + WS_F) + (size_t)t * DM;
#pragma unroll
        for (int j = 0; j < 4; ++j) { const int c = (j * 64 + F.lane) * 8;
            float y0[8], y1[8]; unpack8(*(const u32x4*)(Y + (size_t)d0 * DM + c), y0); unpack8(*(const u32x4*)(Y + (size_t)d1 * DM + c), y1);
            float mx[8]; unpack8(*(const u32x4*)(mrow + c), mx);
            const f32x4 ha = *(const f32x4*)(g1 + c), hb = *(const f32x4*)(g1 + c + 4);
            const f32x4 xa = *(const f32x4*)(xrow + c) + ha * (f32x4){mx[0], mx[1], mx[2], mx[3]}, xb = *(const f32x4*)(xrow + c + 4) + hb * (f32x4){mx[4], mx[5], mx[6], mx[7]}, ga = *(const f32x4*)(g2 + c), gb = *(const f32x4*)(g2 + c + 4);
            f32x4 ra, rb;
#pragma unroll
            for (int i = 0; i < 4; ++i) { ra[i] = (xa[i] + ga[i] * (w0 * y0[i] + w1 * y1[i])) * dscale; rb[i] = (xb[i] + gb[i] * (w0 * y0[4 + i] + w1 * y1[4 + i])) * dscale; }
            *(f32x4*)(orow + c) = ra; *(f32x4*)(orow + c + 4) = rb; }
    }
}
#ifndef MK_MULTI
#define MK_MULTI 0
#endif
#ifndef MK_LAST_PHASE
#define MK_LAST_PHASE 12
#endif
constexpr int N_PHASES = MK_LAST_PHASE + 1;

template <class P> __device__ __forceinline__ P* uptr(P* p) { const unsigned long long v = (unsigned long long)p;
    const unsigned lo = __builtin_amdgcn_readfirstlane((unsigned)v), hi = __builtin_amdgcn_readfirstlane((unsigned)(v >> 32)); return (P*)(((unsigned long long)hi << 32) | lo); }
__global__ void __launch_bounds__(NTHR, 2) mk_fwd(const Args args) {
    extern __shared__ __attribute__((aligned(16))) unsigned char lds_raw[];
    Frame F;
    F.lds = (LAS unsigned char*)lds_raw;
    F.MISC = (volatile LAS unsigned*)(F.lds + MISC_OFF);
    F.tid = threadIdx.x; F.lane = F.tid & 63; F.wave = __builtin_amdgcn_readfirstlane(F.tid >> 6);
    F.G = gridDim.x; { const int bx = blockIdx.x; F.vcu = (F.G % 8 == 0) ? (bx % 8) * (F.G / 8) + bx / 8 : bx; }
    F.ws = uptr(args.ws); F.out = uptr(args.out);
    F.ctl = (gu32*)(F.ws + WS_CTL);
    for (int u = F.tid; u < (LDS_BYTES - MISC_OFF) / 4; u += NTHR) ((LAS unsigned*)(F.lds + MISC_OFF))[u] = 0u;
    __syncthreads();
    XcdBarrier bar; bar.bar = (unsigned*)(F.ctl + CW_BAR); bar.x = 0; bar.st = nullptr;
#if !MK_MULTI
    bar = xcd_barrier_post((unsigned*)(F.ctl + CW_BAR), F.MISC + 8);
#define GRID_BAR() xcd_barrier(bar)
#else
#define GRID_BAR() do { } while (0)
#endif
    const int lo = args.ph_lo, hi = args.ph_hi;
#ifndef MK_PHMASK
#define MK_PHMASK 0xFFFF
#endif
#define IN(k) (((MK_PHMASK >> (k)) & 1) && lo <= (k) && (k) < hi)
#define SEAM(k) do { if (IN(k) && IN((k) + 1)) GRID_BAR(); } while (0)
#ifndef MK_STAMP
#define MK_STAMP (-1)
#endif
#define STAMP_BEGIN(k) do { if ((k) == MK_STAMP && blockIdx.x == 0 && F.tid == 0) *(unsigned long long*)(ws + WS_STAMP) = __builtin_amdgcn_s_memrealtime(); } while (0)
#define STAMP_END(k) do { if ((k) == MK_STAMP && blockIdx.x == 0 && F.tid == 0) { const unsigned long long t1_ = __builtin_amdgcn_s_memrealtime(); *(float*)(ws + WS_STAMP + 8) = (float)(t1_ - *(unsigned long long*)(ws + WS_STAMP)) * 0.01f; } } while (0)
#ifndef MK_REPEAT
#define MK_REPEAT (-1)
#endif
#ifndef MK_REPN
#define MK_REPN 2
#endif
#define REP(k) _Pragma("unroll") for (int rep_ = 0; rep_ < ((k) == MK_REPEAT ? MK_REPN : 1); ++rep_)
    unsigned char* const ws = F.ws;

    STAMP_BEGIN(0);
    REP(0) if (IN(0)) { if (rep_) GRID_BAR(); p0_phase(F, args); } SEAM(0); STAMP_END(0);
    STAMP_BEGIN(1);
    REP(1) if (IN(1)) { if (rep_) GRID_BAR(); p1_phase(F, args); } SEAM(1); STAMP_END(1);
    STAMP_BEGIN(2);
    REP(2) if (IN(2)) { if (rep_) GRID_BAR();
        pg8::Gemm g{(const bf16_t*)(ws + WS_B), (const bf16_t*)(ws + WS_WIN), DM, DM, DM};
        pg8::DenseOrder S; S.init(T / 256, INCP / 256, F.G, (int)blockIdx.x);
        pg8::EpiStore E{(bf16_t*)(ws + WS_A), INCP, nullptr, 0.f, (float*)(ws + WS_RSTDQ), (float*)(ws + WS_RSTDKV), C_QA / 256, C_KVA / 256, C_KPE / 256};
        pg8::gemm_phase<pg8::EpiStore, pg8::DenseOrder>(F.lds, g, S, E);
    } SEAM(2); STAMP_END(2);
    STAMP_BEGIN(3);
    REP(3) if (IN(3)) { if (rep_) GRID_BAR(); p3_phase(F, args); } if (IN(3) && IN(5)) GRID_BAR(); STAMP_END(3);
    STAMP_BEGIN(5);
    REP(5) if (IN(5)) { if (rep_) GRID_BAR(); p5_phase(F, args); } SEAM(5); STAMP_END(5);
    STAMP_BEGIN(6);
    REP(6) if (IN(6)) { if (rep_) GRID_BAR(); p6_phase(F, args); } SEAM(6); STAMP_END(6);
    STAMP_BEGIN(7);
    REP(7) if (IN(7)) { if (rep_) GRID_BAR();
        pg8::Gemm g{(const bf16_t*)(ws + WS_E), (const bf16_t*)(ws + WS_WOUT), DM, DM, DM};
        pg8::DenseOrder S; S.init(T / 256, DM / 256, F.G, (int)blockIdx.x);
        pg8::EpiStore E{(bf16_t*)(ws + WS_F), DM, nullptr, 0.f, nullptr, nullptr, 0, 0, 0};
        pg8::gemm_phase<pg8::EpiStore, pg8::DenseOrder>(F.lds, g, S, E);
    } SEAM(7); STAMP_END(7);
#if MK_LAST_PHASE >= 8
    STAMP_BEGIN(8);
    REP(8) if (IN(8)) { if (rep_) GRID_BAR(); p8_phase(F, args); } if (IN(8) && IN(10)) GRID_BAR(); STAMP_END(8);
    STAMP_BEGIN(10);
    REP(10) if (IN(10)) { if (rep_) GRID_BAR();
        const LAS int* tab = moe_tables(F);
        pg8::Gemm g{(const bf16_t*)(ws + WS_B), (const bf16_t*)(ws + WS_D), DM, DM, DM};
        pg8::GroupedOrder S; S.init(4, F.G, F.vcu, tab, (const int*)(ws + WS_LIST));
        pg8::EpiSwiGLU E{(bf16_t*)(ws + WS_C)};
        pg8::gemm_phase<pg8::EpiSwiGLU, pg8::GroupedOrder, true>(F.lds, g, S, E);
    } SEAM(10); STAMP_END(10);
    STAMP_BEGIN(11);
    REP(11) if (IN(11)) { if (rep_) GRID_BAR();
        const LAS int* tab = moe_tables(F);
        pg8::Gemm g{(const bf16_t*)(ws + WS_C), (const bf16_t*)(ws + WS_E), DE, DE, DE};
        pg8::GroupedOrder S; S.init(8, F.G, F.vcu, tab, nullptr);
        pg8::EpiStore E{(bf16_t*)(ws + WS_A), DM, nullptr, 0.f, nullptr, nullptr, 0, 0, 0};
        pg8::gemm_phase<pg8::EpiStore, pg8::GroupedOrder>(F.lds, g, S, E);
    } SEAM(11); STAMP_END(11);
    REP(12) if (IN(12)) { if (rep_) GRID_BAR(); p12_phase(F, args); }
#endif
#undef IN
#undef SEAM
}

extern "C" void kernel_launch(void* const* d_in, const int* in_sizes, int n_in, void* d_out, int out_size, void* d_ws, size_t ws_size, hipStream_t stream) {
    static int grid = 0;
    if (grid == 0) {
        if (n_in != 25 || out_size != T * DM || ws_size < WS_END) { fprintf(stderr, "kernel_launch: bad shapes (n_in %d out %d ws %zu)\n", n_in, out_size, ws_size); grid = -1; return; }
        int dev = 0, cus = 0, per_cu = 0;
        if (hipGetDevice(&dev) != hipSuccess || hipDeviceGetAttribute(&cus, hipDeviceAttributeMultiprocessorCount, dev) != hipSuccess) { grid = -1; return; }
        if (hipFuncSetAttribute((const void*)mk_fwd, hipFuncAttributeMaxDynamicSharedMemorySize, LDS_BYTES) != hipSuccess) { fprintf(stderr, "kernel_launch: hipFuncSetAttribute failed\n"); grid = -1; return; }
        if (hipOccupancyMaxActiveBlocksPerMultiprocessor(&per_cu, (const void*)mk_fwd, NTHR, LDS_BYTES) != hipSuccess || per_cu < 1) { fprintf(stderr, "kernel_launch: occupancy query says %d\n", per_cu); }
        (void)hipGetLastError();
        grid = cus;
    }
    if (grid < 0) return;
    (void)hipMemsetAsync((char*)d_ws + WS_CTL, 0, CTL_ZERO_BYTES, stream);
    Args a{};
    for (int i = 0; i < 25; ++i) a.in[i] = (const float*)d_in[i];
    a.out = (float*)d_out; a.ws = (unsigned char*)d_ws;
#if MK_MULTI
    for (int p = 0; p < N_PHASES; ++p) { a.ph_lo = p; a.ph_hi = p + 1; hipLaunchKernelGGL(mk_fwd, dim3(grid), dim3(NTHR), LDS_BYTES, stream, a); }
#else
    a.ph_lo = 0; a.ph_hi = N_PHASES; hipLaunchKernelGGL(mk_fwd, dim3(grid), dim3(NTHR), LDS_BYTES, stream, a);
#endif
}
```

```cpp
#include <hip/hip_runtime.h>
#include <cstdio>
#include <cstdint>

#define GAS __attribute__((address_space(1)))
#define LAS __attribute__((address_space(3)))
typedef unsigned short bf16_t;
typedef short bf16x8 __attribute__((ext_vector_type(8)));
typedef short s16x4 __attribute__((ext_vector_type(4)));
typedef float f32x4 __attribute__((ext_vector_type(4)));
typedef float f32x2 __attribute__((ext_vector_type(2)));
typedef float f32x16 __attribute__((ext_vector_type(16)));
typedef unsigned u32x4 __attribute__((ext_vector_type(4)));
typedef unsigned u32x2 __attribute__((ext_vector_type(2)));
typedef GAS unsigned gu32;
#define RLX_AGENT __ATOMIC_RELAXED, __HIP_MEMORY_SCOPE_AGENT
#define LDS_WAIT() asm volatile("s_waitcnt lgkmcnt(0)" ::: "memory")
#define VM_WAIT() asm volatile("s_waitcnt vmcnt(0)" ::: "memory")

constexpr int DM = 2048, NB = 8, SEQ = 2048, T = NB * SEQ;
constexpr int HW = 1024, HH = 8, HDK = 128, HDV = 128;
constexpr int MH = 8, MNOPE = 128, MROPE = 64, MQK = 192, MV = 128, QLORA = 512, KVLORA = 256;
constexpr int INC = 4 * HW + QLORA + KVLORA + MROPE;
constexpr int INCP = 5120;
constexpr int C_QA = 4096, C_KVA = 4608, C_KPE = 4864;
constexpr int NG = 4, EPG = 8, NE = 32, DE = 512;
constexpr int RMAX = (T * 2 / 256 + NE) * 256;
constexpr float EPS = 1e-6f;
constexpr int NWAVES = 8, NTHR = 512;

typedef __bf16 bf16x2_t __attribute__((ext_vector_type(2)));
__device__ __forceinline__ unsigned cvt_pk_bf16(float lo, float hi) { const f32x2 v = {lo, hi}; return __builtin_bit_cast(unsigned, __builtin_convertvector(v, bf16x2_t)); }
__device__ __forceinline__ float bf_lo(unsigned w) { return __builtin_bit_cast(float, w << 16); }
__device__ __forceinline__ float bf_hi(unsigned w) { return __builtin_bit_cast(float, w & 0xffff0000u); }
__device__ __forceinline__ float bf2f(bf16_t h) { return __builtin_bit_cast(float, (unsigned)h << 16); }
__device__ __forceinline__ float wave_sum(float v) {
#pragma unroll
    for (int o = 1; o < 64; o <<= 1) v += __shfl_xor(v, o);
    return v;
}
__device__ __forceinline__ float siluf(float v) { return v / (1.f + __expf(-v)); }

#define XB_TMO      128
#define XB_XCNT(j)  (256  + 64 * (j))
#define XB_XSUB(j)  (1280 + 64 * (j))
#define XB_XGEN(j)  (2304 + 64 * (j))
#define XB_TOP      3328
#define XB_TOPGEN   3392
#define XCD_BAR_WORDS 3456
#define XB_SPIN_CAP (1u << 18)

__device__ __forceinline__ unsigned xb_ld(unsigned* p)              { return __hip_atomic_load(p, __ATOMIC_RELAXED, __HIP_MEMORY_SCOPE_AGENT); }
__device__ __forceinline__ unsigned xb_add(unsigned* p, unsigned v) { return __hip_atomic_fetch_add(p, v, __ATOMIC_RELAXED, __HIP_MEMORY_SCOPE_AGENT); }
__device__ __forceinline__ unsigned xb_xcc_id() { return (unsigned)__builtin_amdgcn_s_getreg((3 << 11) | 20) & 0xFu; }
#define XB_SPIN(cond, bar) do { unsigned _sp = 0; while (cond) { __builtin_amdgcn_s_sleep(1); \
    if ((++_sp & 255u) == 0u) { if (xb_ld(&(bar)[XB_TMO])) break; if (_sp > XB_SPIN_CAP) { atomicAdd(&(bar)[XB_TMO], 1u); break; } } } } while (0)

struct XcdBarrier {
    unsigned* bar; unsigned x;
    volatile LAS unsigned* st;
};
__device__ __forceinline__ XcdBarrier xcd_barrier_post(unsigned* bar, volatile LAS unsigned* st) {
    XcdBarrier b; b.bar = bar; b.x = xb_xcc_id(); b.st = st;
    if (threadIdx.x == 0) (void)xb_add(&bar[XB_XCNT(b.x)], 1u);
    return b;
}
__device__ __forceinline__ void xcd_barrier_complete(unsigned* bar, unsigned x, unsigned& nloc, unsigned& nx) {
    const unsigned G = gridDim.x * gridDim.y * gridDim.z;
    unsigned sum, cnt, mine, sp = 0u;
    for (;;) {
        sum = 0u; cnt = 0u; mine = 0u;
#pragma unroll
        for (unsigned j = 0; j < 16; ++j) { const unsigned c = xb_ld(&bar[XB_XCNT(j)]); sum += c; cnt += (c > 0u) ? 1u : 0u; mine = (j == x) ? c : mine; }
        if (sum == G) break;
        __builtin_amdgcn_s_sleep(1);
        if ((++sp & 255u) == 0u) { if (xb_ld(&bar[XB_TMO])) break; if (sp > XB_SPIN_CAP) { atomicAdd(&bar[XB_TMO], 1u); break; } }
    }
    nloc = mine > 0u ? mine : 1u; nx = cnt > 0u ? cnt : 1u;
}
__device__ __forceinline__ void xcd_barrier(const XcdBarrier& b) {
    asm volatile("s_waitcnt vmcnt(0)" ::: "memory");
    __syncthreads();
    if (threadIdx.x == 0) {
        unsigned* bar = b.bar;
        __builtin_amdgcn_s_waitcnt(0);
        unsigned nloc = b.st[0], nx = b.st[1];
        if (nloc == 0u) { xcd_barrier_complete(bar, b.x, nloc, nx); b.st[0] = nloc; b.st[1] = nx; }
        const unsigned old = xb_add(&bar[XB_XSUB(b.x)], 1u);
        const unsigned gen = old / nloc;
        if (old + 1u == (gen + 1u) * nloc) {
            __builtin_amdgcn_fence(__ATOMIC_RELEASE, "agent");
            asm volatile("s_waitcnt vmcnt(0)" ::: "memory");
            const unsigned og = xb_add(&bar[XB_TOP], 1u);
            const unsigned tg = og / nx;
            if (og + 1u == (tg + 1u) * nx) xb_add(&bar[XB_TOPGEN], 1u);
            else XB_SPIN(xb_ld(&bar[XB_TOPGEN]) == tg, bar);
            __builtin_amdgcn_fence(__ATOMIC_ACQUIRE, "agent");
            xb_add(&bar[XB_XGEN(b.x)], 1u);
            asm volatile("s_waitcnt vmcnt(0)" ::: "memory");
        } else {
            XB_SPIN(xb_ld(&bar[XB_XGEN(b.x)]) == gen, bar);
            __builtin_amdgcn_fence(__ATOMIC_ACQUIRE, "agent");
            asm volatile("s_waitcnt vmcnt(0)" ::: "memory");
        }
    }
    __syncthreads();
}

namespace pg8 {
constexpr int BM = 256, BK = 64, HALF = 128, HTB = HALF * BK * 2, STAGE_BYTES = 8 * HTB, NXCD = 8, WGM = 8;
__host__ __device__ __forceinline__ int lds_byte(int r, int c) { const int st = (r >> 4) * 2 + (c >> 5), rr = r & 15, cc = c & 31, ob = rr * 64 + cc * 2; return st * 1024 + (ob ^ (((ob >> 9) & 1) << 5)); }
__host__ __device__ __forceinline__ void stage_rc(int b, int& R, int& C) { const int st = b / 1024, sb = b % 1024, swz = sb ^ (((sb >> 9) & 1) << 5); R = (st >> 1) * 16 + swz / 64; C = (st & 1) * 32 + (swz % 64) / 2; }
__host__ __device__ __forceinline__ int perm32(int rho) { const int n = rho >> 4, i = rho & 15; return 8 * (i >> 2) + 4 * n + (i & 3); }

struct Unit { int pm, pn, pb; };
struct Gemm { const bf16_t* A; const bf16_t* Bt; int lda, ldb, K; };

struct DenseOrder {
    int nM, nN, nwg, G, c;
    __device__ void init(int nM_, int nN_, int G_, int c_) { nM = nM_; nN = nN_; nwg = nM * nN; G = G_; c = c_; }
    __device__ bool next(int i, Unit& u) const {
        const long L = (long)i * G + c; if (L >= nwg) return false;
        int wgid = (int)L; { const int q = nwg / NXCD, r = nwg % NXCD, xcd = wgid % NXCD, off = wgid / NXCD; wgid = (xcd < r ? xcd * (q + 1) : r * (q + 1) + (xcd - r) * q) + off; }
        const int nig = WGM * nN, gid = wgid / nig, fm = gid * WGM, gsz = (nM - fm) < WGM ? (nM - fm) : WGM;
        u.pm = fm + ((wgid % nig) % gsz); u.pn = (wgid % nig) / gsz; u.pb = u.pn; return true;
    }
};
struct GroupedOrder {
    int nM, nN, nwg, G, c; const LAS int* tile_e; const LAS int* pstart; const LAS int* cnt; const int* list;
    __device__ void init(int nN_, int G_, int c_, const LAS int* tab, const int* list_) { pstart = tab; cnt = tab + 64; tile_e = tab + 128; list = list_; nM = pstart[32] >> 8; nN = nN_; nwg = nM * nN; G = G_; c = c_; }
    __device__ bool next(int i, Unit& u) const {
        const long L = (long)i * G + c; if (L >= nwg) return false;
        const int w = (int)L; u.pn = w % nN; u.pm = w / nN; u.pb = tile_e[u.pm] * nN + u.pn; return true;
    }
    __device__ int arow(const Unit& u, int r) const { const int e = tile_e[u.pm], j = 256 * u.pm - pstart[e] + r; return j < cnt[e] ? list[e * T + j] : 0; }
};

template <class Epi, class Sched, bool GATHER = false>
__device__ __forceinline__ void gemm_phase(LAS unsigned char* lds, const Gemm g, const Sched& S, const Epi& E) {
    int tid = threadIdx.x; asm volatile("" : "+v"(tid));
    const int wid = __builtin_amdgcn_readfirstlane(tid >> 6), lane = tid & 63, wr = wid >> 2, wc = wid & 3, fr = lane & 15, fq = lane >> 4;
    const int K = g.K, nt = K / BK;
    unsigned voffA[2], voffB[2]; int gR[2], gC[2];
#pragma unroll
    for (int i = 0; i < 2; ++i) { int R, C; stage_rc(tid * 16 + i * 8192, R, C); const int Rb = (R & ~31) + perm32(R & 31); gR[i] = R; gC[i] = C;
        voffA[i] = (unsigned)(R * g.lda + C) * 2u; voffB[i] = (unsigned)(Rb * g.ldb + C) * 2u; }
    const size_t kstep = (size_t)(BK * 2);
    const size_t hsA = (size_t)HALF * g.lda * 2, hsB = (size_t)HALF * g.ldb * 2;
    const unsigned ldsw = (unsigned)wid * 1024u;
    const int aoff = lds_byte(wr * 64 + fr, fq * 8), boff = lds_byte(wc * 32 + fr, fq * 8);
#define PG8_SA(b, h) (((b) * 2 + (h)) * HTB)
#define PG8_SB(b, h) ((4 + (b) * 2 + (h)) * HTB)
#define PG8_STAGE(bufoff, gbase, voff) do { _Pragma("unroll") for (int _i = 0; _i < 2; ++_i) \
        __builtin_amdgcn_global_load_lds((const unsigned*)((const char*)(gbase) + (voff)[_i]), (LAS unsigned*)(lds + (bufoff) + ldsw + _i * 8192), 16, 0, 0); } while (0)
#define PG8_STAGE_A(bufoff, dense_ptr, kbytes, offs) do { if constexpr (GATHER) { PG8_STAGE(bufoff, (const char*)g.A + (kbytes), offs); } else { PG8_STAGE(bufoff, dense_ptr, voffA); } } while (0)
#define PG8_GOFF(u, o0, o1) do { _Pragma("unroll") for (int _i = 0; _i < 2; ++_i) { o0[_i] = (unsigned)(S.arow(u, gR[_i]) * g.lda + gC[_i]) * 2u; o1[_i] = (unsigned)(S.arow(u, gR[_i] + HALF) * g.lda + gC[_i]) * 2u; } } while (0)
#define PG8_LDA(dst, b, h) do { _Pragma("unroll") for (int m = 0; m < 4; ++m) _Pragma("unroll") for (int k = 0; k < 2; ++k) dst[m][k] = *(const LAS bf16x8*)(lds + PG8_SA(b, h) + aoff + m * 2048 + k * 1024); } while (0)
#define PG8_LDB(dst, b, h) do { _Pragma("unroll") for (int n = 0; n < 2; ++n) _Pragma("unroll") for (int k = 0; k < 2; ++k) dst[n][k] = *(const LAS bf16x8*)(lds + PG8_SB(b, h) + boff + n * 2048 + k * 1024); } while (0)
#define PG8_MMA(ai, bj, At, Bt) do { __builtin_amdgcn_s_setprio(1); _Pragma("unroll") for (int m = 0; m < 4; ++m) _Pragma("unroll") for (int n = 0; n < 2; ++n) _Pragma("unroll") for (int k = 0; k < 2; ++k) \
        acc[ai][bj][m][n] = __builtin_amdgcn_mfma_f32_16x16x32_bf16(Bt[n][k], At[m][k], acc[ai][bj][m][n], 0, 0, 0); __builtin_amdgcn_s_setprio(0); } while (0)
#define PG8_WAIT_V(n) asm volatile("s_waitcnt vmcnt(" #n ")" ::: "memory")
#define PG8_WAIT_L(n) asm volatile("s_waitcnt lgkmcnt(" #n ")" ::: "memory")
#define PG8_BAR __builtin_amdgcn_s_barrier()
#define PG8_SCHED __builtin_amdgcn_sched_barrier(0)
    Unit cur, nxt; int ui = 0;
    if (!S.next(0, cur)) return;
    unsigned cO0[2] = {0u, 0u}, cO1[2] = {0u, 0u}, nO0[2] = {0u, 0u}, nO1[2] = {0u, 0u};
    if constexpr (GATHER) { PG8_GOFF(cur, cO0, cO1); }
    f32x4 acc[2][2][4][2];
#pragma unroll
    for (int a = 0; a < 2; ++a)
#pragma unroll
        for (int b = 0; b < 2; ++b)
#pragma unroll
            for (int m = 0; m < 4; ++m)
#pragma unroll
                for (int n = 0; n < 2; ++n) acc[a][b][m][n] = (f32x4){0.f, 0.f, 0.f, 0.f};
    bf16x8 At[4][2], B0[2][2], B1[2][2];
    const char* cA = (const char*)g.A + (GATHER ? (size_t)0 : (size_t)cur.pm * 2 * hsA); const char* cB = (const char*)g.Bt + (size_t)cur.pb * 2 * hsB;
    PG8_STAGE(PG8_SB(0, 0), cB, voffB); PG8_STAGE(PG8_SB(0, 1), cB + hsB, voffB); PG8_STAGE_A(PG8_SA(0, 0), cA, 0, cO0); PG8_STAGE_A(PG8_SA(0, 1), cA + hsA, 0, cO1);
    if (wr == 1) PG8_BAR;
    PG8_WAIT_V(2); PG8_BAR;
    PG8_STAGE(PG8_SB(1, 0), cB + kstep, voffB); PG8_STAGE_A(PG8_SA(1, 0), cA + kstep, kstep, cO0); PG8_STAGE(PG8_SB(1, 1), cB + hsB + kstep, voffB);
    PG8_WAIT_V(6); PG8_BAR;
    for (;;) {
        const bool has_next = S.next(ui + 1, nxt);
        const char* nA = (has_next && !GATHER) ? (const char*)g.A + (size_t)nxt.pm * 2 * hsA : cA; const char* nB = has_next ? (const char*)g.Bt + (size_t)nxt.pb * 2 * hsB : cB;
        if constexpr (GATHER) { if (has_next) { PG8_GOFF(nxt, nO0, nO1); } else { nO0[0] = cO0[0]; nO0[1] = cO0[1]; nO1[0] = cO1[0]; nO1[1] = cO1[1]; } }
        for (int t = 0; t < nt; t += 2) {
            const bool last = (t == nt - 2);
            const char* a1 = cA + (size_t)(t + 1) * kstep;
            const char* a2 = last ? nA : cA + (size_t)(t + 2) * kstep; const char* b2 = last ? nB : cB + (size_t)(t + 2) * kstep;
            const char* a3 = a2 + kstep; const char* b3 = b2 + kstep;
            const size_t k2 = last ? (size_t)0 : (size_t)(t + 2) * kstep;
            unsigned o0[2], o1[2]; o0[0] = last ? nO0[0] : cO0[0]; o0[1] = last ? nO0[1] : cO0[1]; o1[0] = last ? nO1[0] : cO1[0]; o1[1] = last ? nO1[1] : cO1[1];
            PG8_LDB(B0, 0, 0); PG8_LDB(B1, 0, 1); PG8_SCHED; PG8_LDA(At, 0, 0); PG8_STAGE_A(PG8_SA(1, 1), a1 + hsA, (size_t)(t + 1) * kstep, cO1);
            PG8_WAIT_V(8); PG8_WAIT_L(0); PG8_BAR; PG8_MMA(0, 0, At, B0); PG8_MMA(0, 1, At, B1); PG8_BAR; PG8_SCHED;
            PG8_LDA(At, 0, 1); PG8_STAGE(PG8_SB(0, 0), b2, voffB); PG8_STAGE(PG8_SB(0, 1), b2 + hsB, voffB); PG8_STAGE_A(PG8_SA(0, 0), a2, k2, o0);
            PG8_WAIT_V(8); PG8_WAIT_L(0); PG8_BAR; PG8_MMA(1, 0, At, B0); PG8_MMA(1, 1, At, B1); PG8_BAR; PG8_SCHED;
            PG8_LDB(B0, 1, 0); PG8_LDB(B1, 1, 1); PG8_SCHED; PG8_LDA(At, 1, 0); PG8_STAGE_A(PG8_SA(0, 1), a2 + hsA, k2, o1);
            PG8_WAIT_V(8); PG8_WAIT_L(0); PG8_BAR; PG8_MMA(0, 0, At, B0); PG8_MMA(0, 1, At, B1); PG8_BAR; PG8_SCHED;
            PG8_LDA(At, 1, 1); PG8_STAGE(PG8_SB(1, 0), b3, voffB); PG8_STAGE(PG8_SB(1, 1), b3 + hsB, voffB); PG8_STAGE_A(PG8_SA(1, 0), a3, k2 + kstep, o0);
            PG8_WAIT_V(8); PG8_WAIT_L(0); PG8_BAR; PG8_MMA(1, 0, At, B0); PG8_MMA(1, 1, At, B1); PG8_BAR; PG8_SCHED;
        }
        if (wr == 0) PG8_BAR;
        E(acc, cur, wr, wc, fr, fq);
        if (!has_next) break;
#pragma unroll
        for (int a = 0; a < 2; ++a)
#pragma unroll
            for (int b = 0; b < 2; ++b)
#pragma unroll
                for (int m = 0; m < 4; ++m)
#pragma unroll
                    for (int n = 0; n < 2; ++n) acc[a][b][m][n] = (f32x4){0.f, 0.f, 0.f, 0.f};
        cur = nxt; cA = nA; cB = nB; ++ui;
        if constexpr (GATHER) { cO0[0] = nO0[0]; cO0[1] = nO0[1]; cO1[0] = nO1[0]; cO1[1] = nO1[1]; }
        if (wr == 1) PG8_BAR;
    }
    PG8_WAIT_V(0);
    PG8_BAR;
#undef PG8_SA
#undef PG8_SB
#undef PG8_STAGE
#undef PG8_STAGE_A
#undef PG8_GOFF
#undef PG8_LDA
#undef PG8_LDB
#undef PG8_MMA
#undef PG8_WAIT_V
#undef PG8_WAIT_L
#undef PG8_BAR
#undef PG8_SCHED
}

struct EpiStore {
    bf16_t* O; int ldc; const float* ssq; float inv; float* ssq_out0; float* ssq_out1; int pn0, pn1, pn2;
    __device__ __forceinline__ void operator()(const f32x4 (&acc)[2][2][4][2], const Unit& u, int wr, int wc, int fr, int fq) const {
        const int row0 = u.pm * BM + wr * 64 + fr, col0 = u.pn * BM + wc * 32 + 8 * fq;
        float* so = (ssq_out0 && u.pn >= pn0 && u.pn < pn2) ? (u.pn < pn1 ? ssq_out0 : ssq_out1) : nullptr;
#pragma unroll
        for (int ai = 0; ai < 2; ++ai)
#pragma unroll
            for (int m = 0; m < 4; ++m) { const int row = row0 + ai * HALF + m * 16; const float rs = ssq ? rsqrtf(ssq[row] * inv + EPS) : 1.f;
                bf16_t* rowp = O + (size_t)row * ldc + col0; float ss = 0.f;
#pragma unroll
                for (int bj = 0; bj < 2; ++bj) { const f32x4 v0 = acc[ai][bj][m][0] * rs, v1 = acc[ai][bj][m][1] * rs;
                    ss += (v0[0] * v0[0] + v0[1] * v0[1]) + (v0[2] * v0[2] + v0[3] * v0[3]) + (v1[0] * v1[0] + v1[1] * v1[1]) + (v1[2] * v1[2] + v1[3] * v1[3]);
                    u32x4 w; w.x = cvt_pk_bf16(v0[0], v0[1]); w.y = cvt_pk_bf16(v0[2], v0[3]); w.z = cvt_pk_bf16(v1[0], v1[1]); w.w = cvt_pk_bf16(v1[2], v1[3]);
                    *(u32x4*)(rowp + bj * HALF) = w; }
                if (so) { ss += __shfl_xor(ss, 16); ss += __shfl_xor(ss, 32); if (fq == 0) atomicAdd(so + row, ss); } }
    }
};
struct EpiResid {
    const float* X; float* O; const float* gate; int gpitch;
    __device__ __forceinline__ void operator()(const f32x4 (&acc)[2][2][4][2], const Unit& u, int wr, int wc, int fr, int fq) const {
        const int row0 = u.pm * BM + wr * 64 + fr, col0 = u.pn * BM + wc * 32 + 8 * fq;
        const float* gp = gate + (size_t)((u.pm * BM) / SEQ) * gpitch + col0;
        f32x4 gv[2][2];
#pragma unroll
        for (int bj = 0; bj < 2; ++bj)
#pragma unroll
            for (int n = 0; n < 2; ++n) gv[bj][n] = *(const f32x4*)(gp + bj * HALF + 4 * n);
#pragma unroll
        for (int ai = 0; ai < 2; ++ai)
#pragma unroll
            for (int m = 0; m < 4; ++m) { const size_t off = (size_t)(row0 + ai * HALF + m * 16) * DM + col0;
#pragma unroll
                for (int bj = 0; bj < 2; ++bj)
#pragma unroll
                    for (int n = 0; n < 2; ++n) { const f32x4 xv = *(const f32x4*)(X + off + bj * HALF + 4 * n);
                        *(f32x4*)(O + off + bj * HALF + 4 * n) = xv + gv[bj][n] * acc[ai][bj][m][n]; } }
    }
};
struct EpiSwiGLU {
    bf16_t* O;
    __device__ __forceinline__ void operator()(const f32x4 (&acc)[2][2][4][2], const Unit& u, int wr, int wc, int fr, int fq) const {
        const int row0 = u.pm * BM + wr * 64 + fr, col0 = u.pn * HALF + wc * 32 + 8 * fq;
#pragma unroll
        for (int ai = 0; ai < 2; ++ai)
#pragma unroll
            for (int m = 0; m < 4; ++m) { const int row = row0 + ai * HALF + m * 16;
                float h[8];
#pragma unroll
                for (int n = 0; n < 2; ++n)
#pragma unroll
                    for (int j = 0; j < 4; ++j) { const float gt = acc[ai][0][m][n][j], up = acc[ai][1][m][n][j]; h[4 * n + j] = gt / (1.f + __expf(-gt)) * up; }
                u32x4 w; w.x = cvt_pk_bf16(h[0], h[1]); w.y = cvt_pk_bf16(h[2], h[3]); w.z = cvt_pk_bf16(h[4], h[5]); w.w = cvt_pk_bf16(h[6], h[7]);
                *(u32x4*)(O + (size_t)row * DE + col0) = w; }
    }
};
}
constexpr size_t MiB = 1u << 20;
constexpr size_t WS_CTL = 0, CTL_ZERO_BYTES = 1 * MiB;
constexpr size_t WS_MOD = 1 * MiB;
constexpr size_t WS_ROPEC = 1 * MiB + 512 * 1024;
constexpr size_t WS_ROPES = WS_ROPEC + 2 * MiB;
constexpr size_t WS_WCT = WS_ROPES + 2 * MiB;
constexpr size_t WS_RSTDQ = 6 * MiB;
constexpr size_t WS_RSTDKV = WS_RSTDQ + 64 * 1024;
constexpr size_t WS_TOKE = WS_RSTDKV + 64 * 1024;
constexpr size_t WS_TOKW = WS_TOKE + 128 * 1024;
constexpr size_t WS_TOKS = WS_TOKW + 128 * 1024;
constexpr size_t WS_BLKE = WS_TOKS + 128 * 1024;
constexpr size_t WS_STAMP = WS_BLKE + 4096;
constexpr size_t WS_WIN = 8 * MiB;
constexpr size_t WS_WQUP = 28 * MiB;
constexpr size_t WS_WKVUP = WS_WQUP + 1536 * 1024;
constexpr size_t WS_WOUT = 31 * MiB;
constexpr size_t WS_A = 40 * MiB;
constexpr size_t WS_B = 200 * MiB;
constexpr size_t WS_C = 264 * MiB;
constexpr size_t WS_D = 328 * MiB;
constexpr size_t WS_E = 456 * MiB;
constexpr size_t WS_LIST = 520 * MiB;
constexpr size_t WS_F = 522 * MiB;
constexpr size_t WS_END = 586 * MiB;
constexpr size_t QN_BYTES = (size_t)T * MH * MQK * 2;

constexpr int CW_BAR = 4096;
constexpr int CW_CNT = 8192;

constexpr int RING_BYTES = 131072, LDS_BYTES = 147456, LDS_USER = 143360, MISC_OFF = LDS_BYTES - 512;

struct Args { const float* in[25]; float* out; unsigned char* ws; int ph_lo, ph_hi, pad0, pad1; };

struct Frame {
    LAS unsigned char* lds;
    volatile LAS unsigned* MISC;
    gu32* ctl;
    int tid, lane, wave, vcu, G;
    unsigned char* ws; float* out;
};

#define OPAQUE_FRAME(F) do { F.tid = threadIdx.x; asm volatile("" : "+v"(F.tid)); F.lane = F.tid & 63; } while (0)

__device__ __forceinline__ void unpack8(const u32x4 w, float* f) { f[0] = bf_lo(w.x); f[1] = bf_hi(w.x); f[2] = bf_lo(w.y); f[3] = bf_hi(w.y); f[4] = bf_lo(w.z); f[5] = bf_hi(w.z); f[6] = bf_lo(w.w); f[7] = bf_hi(w.w); }
__device__ __forceinline__ u32x4 pack8f(const float* f) { u32x4 w; w.x = cvt_pk_bf16(f[0], f[1]); w.y = cvt_pk_bf16(f[2], f[3]); w.z = cvt_pk_bf16(f[4], f[5]); w.w = cvt_pk_bf16(f[6], f[7]); return w; }

struct TrItem { const float* src; bf16_t* dst; const float* gk; int N, ldt; };
__device__ __forceinline__ void tr_load(const TrItem& it, f32x4 (&r)[8], int lane) {
    const float* p = it.src + (size_t)(lane >> 3) * it.N + 4 * (lane & 7);
#pragma unroll
    for (int i = 0; i < 8; ++i) r[i] = *(const f32x4*)(p + (size_t)(8 * i) * it.N);
}
__device__ __forceinline__ void tr_store(const TrItem& it, const f32x4 (&r)[8], LAS unsigned char* Tl, int lane) {
    const int row = lane >> 3, c4 = lane & 7;
#pragma unroll
    for (int i = 0; i < 8; ++i) { f32x4 v = r[i]; if (it.gk) v = v * it.gk[8 * i + row];
        u32x2 w; w.x = cvt_pk_bf16(v.x, v.y); w.y = cvt_pk_bf16(v.z, v.w);
        *(LAS u32x2*)(Tl + ((8 * i + row) * 32 + 4 * c4) * 2) = w; }
    LDS_WAIT(); asm volatile("" ::: "memory");
    const int g = lane >> 4, i16 = lane & 15, q = i16 >> 2, pp = lane & 3;
    bf16_t* drow = it.dst + (size_t)(16 * (g & 1) + i16) * it.ldt;
    typedef short v4i16_t __attribute__((ext_vector_type(4)));
#pragma unroll
    for (int j = 0; j < 4; ++j) { const int kc = 4 * (g >> 1) + j;
        const v4i16_t lo = __builtin_amdgcn_ds_read_tr16_b64_v4i16((LAS v4i16_t*)(Tl + ((8 * kc + q) * 32 + 16 * (g & 1) + 4 * pp) * 2));
        const v4i16_t hi = __builtin_amdgcn_ds_read_tr16_b64_v4i16((LAS v4i16_t*)(Tl + ((8 * kc + 4 + q) * 32 + 16 * (g & 1) + 4 * pp) * 2));
        const bf16x8 o = {lo[0], lo[1], lo[2], lo[3], hi[0], hi[1], hi[2], hi[3]};
        *(bf16x8*)(drow + 8 * kc) = o; }
    LDS_WAIT(); asm volatile("" ::: "memory");
}
template <class MK> __device__ __forceinline__ void tr_run(int first, int step, int n, const MK& mk, LAS unsigned char* Tl, int lane) {
    if (first >= n) return;
    f32x4 ra[8], rb[8], rc[8];
    TrItem ia = mk(first), ib = ia, ic = ia;
    tr_load(ia, ra, lane);
    if (first + step < n) { ib = mk(first + step); tr_load(ib, rb, lane); }
    for (int idx = first; idx < n; idx += 3 * step) {
        if (idx + 2 * step < n) { ic = mk(idx + 2 * step); tr_load(ic, rc, lane); }
        tr_store(ia, ra, Tl, lane);
        if (idx + step >= n) break;
        if (idx + 3 * step < n) { ia = mk(idx + 3 * step); tr_load(ia, ra, lane); }
        tr_store(ib, rb, Tl, lane);
        if (idx + 2 * step >= n) break;
        if (idx + 4 * step < n) { ib = mk(idx + 4 * step); tr_load(ib, rb, lane); }
        tr_store(ic, rc, Tl, lane);
    }
}

__device__ __forceinline__ void adaln_phase(Frame& F, const float* c, const float* w_ada, const float* b_ada, float* mod) {
    LAS float* cact = (LAS float*)F.lds;
    LAS float* part = (LAS float*)(F.lds + 65536);
    for (int i = F.tid; i < NB * DM; i += NTHR) cact[i] = siluf(c[i]);
    __syncthreads();
    const int cg = F.tid & 7, rs = F.tid >> 3;
    for (int it = blockIdx.x; it < 6 * DM / 32; it += F.G) {
        const int n0 = it * 32 + cg * 4;
        f32x4 acc[8];
#pragma unroll
        for (int b = 0; b < 8; ++b) acc[b] = (f32x4){0.f, 0.f, 0.f, 0.f};
#pragma unroll 4
        for (int i = 0; i < 32; ++i) { const int k = rs + 64 * i; const f32x4 w = *(const f32x4*)(w_ada + (size_t)k * (6 * DM) + n0);
#pragma unroll
            for (int b = 0; b < 8; ++b) acc[b] += w * cact[b * DM + k]; }
#pragma unroll
        for (int b = 0; b < 8; ++b) *(LAS f32x4*)(part + (rs * 8 + b) * 32 + cg * 4) = acc[b];
        __syncthreads();
        if (F.tid < 256) { const int b = F.tid >> 5, n = F.tid & 31; float s = 0.f;
#pragma unroll 8
            for (int r = 0; r < 64; ++r) s += part[(r * 8 + b) * 32 + n];
            mod[b * (6 * DM) + it * 32 + n] = s + b_ada[it * 32 + n]; }
        __syncthreads();
    }
}

__device__ __forceinline__ void p0_phase(Frame& F, const Args& a) {
    OPAQUE_FRAME(F);
    unsigned char* ws = F.ws;
    adaln_phase(F, a.in[1], a.in[3], a.in[4], (float*)(ws + WS_MOD));
    __syncthreads();
    LAS unsigned char* Tl = F.lds + F.wave * 4096;
    const int gw = F.vcu * NWAVES + F.wave, NGW = F.G * NWAVES;
    constexpr int I_IN = (DM / 64) * (INC / 32), I_QUP = (QLORA / 64) * (MH * MQK / 32), I_KVUP = (KVLORA / 64) * (MH * 256 / 32), I_OUT = (DM / 64) * (DM / 32);
    constexpr int NITEMS = I_IN + I_QUP + I_KVUP + I_OUT;
    { const float* w_in = a.in[6]; const float* w_qup = a.in[10]; const float* w_kvup = a.in[12]; const float* w_out = a.in[16]; const float* gq = a.in[9]; const float* gkv = a.in[11];
      auto mk = [=](int r) -> TrItem { TrItem t;
          if (r < I_IN) { const int nblk = INC / 32, kb = r / nblk, nb = r % nblk; t.src = w_in + (size_t)(64 * kb) * INC + 32 * nb; t.dst = (bf16_t*)(ws + WS_WIN) + (size_t)(32 * nb) * DM + 64 * kb; t.gk = nullptr; t.N = INC; t.ldt = DM; return t; } r -= I_IN;
          if (r < I_QUP) { const int nblk = MH * MQK / 32, kb = r / nblk, nb = r % nblk; t.src = w_qup + (size_t)(64 * kb) * (MH * MQK) + 32 * nb; t.dst = (bf16_t*)(ws + WS_WQUP) + (size_t)(32 * nb) * QLORA + 64 * kb; t.gk = gq + 64 * kb; t.N = MH * MQK; t.ldt = QLORA; return t; } r -= I_QUP;
          if (r < I_KVUP) { const int nblk = MH * 256 / 32, kb = r / nblk, nb = r % nblk; t.src = w_kvup + (size_t)(64 * kb) * (MH * 256) + 32 * nb; t.dst = (bf16_t*)(ws + WS_WKVUP) + (size_t)(32 * nb) * KVLORA + 64 * kb; t.gk = gkv + 64 * kb; t.N = MH * 256; t.ldt = KVLORA; return t; } r -= I_KVUP;
          { const int nblk = DM / 32, kb = r / nblk, nb = r % nblk; t.src = w_out + (size_t)(64 * kb) * DM + 32 * nb; t.dst = (bf16_t*)(ws + WS_WOUT) + (size_t)(32 * nb) * DM + 64 * kb; t.gk = nullptr; t.N = DM; t.ldt = DM; return t; } };
      tr_run(gw, NGW, NITEMS, mk, Tl, F.lane); }
    { const int* pos = (const int*)a.in[2]; float* rc = (float*)(ws + WS_ROPEC); float* rsn = (float*)(ws + WS_ROPES);
      const int gt = F.vcu * NTHR + F.tid, NGT = F.G * NTHR;
      for (int e = gt; e < T * 32; e += NGT) { const int i = e & 31, tk = e >> 5;
          const float invf = (float)exp2(-(double)i * (13.287712379549449 / 32.0));
          const float ang = (float)pos[tk] * invf;
          rc[e] = cosf(ang); rsn[e] = sinf(ang); }
      { float* ssq = (float*)(ws + WS_RSTDQ); for (int e = gt; e < 2 * T; e += NGT) ssq[e] = 0.f; }
      float* wct = (float*)(ws + WS_WCT);
      for (int e = gt; e < 48 * DM; e += NGT) { const int n = e / DM, k = e % DM;
          wct[e] = n < 4 ? a.in[18][k * NG + n] : (n < 36 ? a.in[20][k * NE + (n - 4)] : 0.f); } }
}

__device__ __forceinline__ void modnorm_row(const float* xrow, const float* g, const float* shift, const float* scale, bf16_t* orow, int lane) {
    const f32x4* xr = (const f32x4*)xrow + lane;
    f32x4 v[8]; float s = 0.f;
#pragma unroll
    for (int j = 0; j < 8; ++j) { v[j] = xr[64 * j]; s += (v[j].x * v[j].x + v[j].y * v[j].y) + (v[j].z * v[j].z + v[j].w * v[j].w); }
    const float rstd = rsqrtf(wave_sum(s) * (1.f / DM) + EPS);
    u32x2* o8 = (u32x2*)orow + lane;
#pragma unroll
    for (int j = 0; j < 8; ++j) { const f32x4 gg = ((const f32x4*)g)[64 * j + lane], sh = ((const f32x4*)shift)[64 * j + lane], sc = ((const f32x4*)scale)[64 * j + lane];
        const f32x4 h = v[j] * rstd * gg * (sc + 1.f) + sh;
        u32x2 w; w.x = cvt_pk_bf16(h.x, h.y); w.y = cvt_pk_bf16(h.z, h.w); o8[64 * j] = w; }
}
__device__ __forceinline__ void p1_phase(Frame& F, const Args& a) {
    OPAQUE_FRAME(F);
    const int gw = F.vcu * NWAVES + F.wave, NGW = F.G * NWAVES;
    const float* mod = (const float*)(F.ws + WS_MOD);
    bf16_t* H = (bf16_t*)(F.ws + WS_B);
    for (int m = gw; m < T; m += NGW) { const int b = m / SEQ;
        modnorm_row(a.in[0] + (size_t)m * DM, a.in[5], mod + b * (6 * DM), mod + b * (6 * DM) + DM, H + (size_t)m * DM, F.lane); }
}

template <int CTRL> __device__ __forceinline__ float dppf(float x) { return __builtin_bit_cast(float, __builtin_amdgcn_update_dpp(0, __builtin_bit_cast(int, x), CTRL, 0xF, 0xF, true)); }

namespace hg {
constexpr int OFF_F = 0, OFF_SEG = 32768, OFF_QIN = 34816, RP = 272, OFF_KIN = OFF_QIN + 64 * RP, OFF_QB = OFF_KIN + 64 * RP, OFF_KLT = OFF_QB + 64 * RP, SP = 144,
              OFF_VT = OFF_KLT + 128 * SP  , OFF_DEC = OFF_VT + 64 * SP  , OFF_SF = OFF_DEC + 3584  , HG_LDS = OFF_SF + 16384;
static_assert(HG_LDS <= LDS_USER, "hgrn lds");
__device__ __forceinline__ int ppos(int s) { return (s & ~15) | ((s & 4) << 1) | ((s & 8) >> 1) | (s & 3); }
}
__device__ __forceinline__ void hgrn_chunked(Frame& F, const Args& a, int item) {
    using namespace hg;
    const bf16_t* PROJ = (const bf16_t*)(F.ws + WS_A);
    bf16_t* MIX = (bf16_t*)(F.ws + WS_E);
    const float* lbl = a.in[7];
    LAS unsigned char* L = F.lds;
    LAS float* Fs = (LAS float*)(L + OFF_F); LAS float* SEGs = (LAS float*)(L + OFF_SEG); LAS float* DEC = (LAS float*)(L + OFF_DEC); LAS float* POST = DEC + 384;
    const int g = F.tid & 15, t0 = F.tid >> 4;
    const int sk = F.tid & 127, sseg = F.tid >> 7;
    const int r32 = F.lane & 31, hi = F.lane >> 5;
    {
        const int dq2 = (item >> 3) & 1, bh = (item >> 4) * 8 + (item & 7), h = bh & 7, b = bh >> 3;
        float lb[8];
#pragma unroll
        for (int j = 0; j < 8; ++j) { const int k = h * 128 + g * 8 + j; lb[j] = 1.f / (1.f + __expf(lbl[HW + k] - lbl[k])); }
        const bf16_t* base = PROJ + (size_t)(b * SEQ) * INCP + h * 128;
        f32x16 S0 = {}, S1 = {};
        u32x4 gq[2], gf[2], gv;
#define HG_LOADF(c) do { _Pragma("unroll") for (int i = 0; i < 2; ++i) gf[i] = *(const u32x4*)(base + (size_t)((c) * 64 + t0 + 32 * i) * INCP + g * 8 + HW); } while (0)
#define HG_LOADQ(c) do { _Pragma("unroll") for (int i = 0; i < 2; ++i) gq[i] = *(const u32x4*)(base + (size_t)((c) * 64 + t0 + 32 * i) * INCP + g * 8); \
            gv = *(const u32x4*)(base + (size_t)((c) * 64 + (F.tid >> 3)) * INCP + 2 * HW + dq2 * 64 + (F.tid & 7) * 8); } while (0)
        HG_LOADF(0); HG_LOADQ(0);
        for (int c = 0; c < SEQ / 64; ++c) {
            if (F.wave >= 4) { const int kb = F.wave - 4;
#pragma unroll
                for (int s2 = 0; s2 < 2; ++s2) { u32x4 w0, w1;
                    w0.x = cvt_pk_bf16(S0[8 * s2], S0[8 * s2 + 1]); w0.y = cvt_pk_bf16(S0[8 * s2 + 2], S0[8 * s2 + 3]); w0.z = cvt_pk_bf16(S0[8 * s2 + 4], S0[8 * s2 + 5]); w0.w = cvt_pk_bf16(S0[8 * s2 + 6], S0[8 * s2 + 7]);
                    w1.x = cvt_pk_bf16(S1[8 * s2], S1[8 * s2 + 1]); w1.y = cvt_pk_bf16(S1[8 * s2 + 2], S1[8 * s2 + 3]); w1.z = cvt_pk_bf16(S1[8 * s2 + 4], S1[8 * s2 + 5]); w1.w = cvt_pk_bf16(S1[8 * s2 + 6], S1[8 * s2 + 7]);
                    *(LAS u32x4*)(L + OFF_SF + ((((kb * 2 + 0) * 2 + s2) * 64) + F.lane) * 16) = w0;
                    *(LAS u32x4*)(L + OFF_SF + ((((kb * 2 + 1) * 2 + s2) * 64) + F.lane) * 16) = w1; } }
            float fv[2][8];
#pragma unroll
            for (int i = 0; i < 2; ++i) { float fl[8]; unpack8(gf[i], fl);
#pragma unroll
                for (int j = 0; j < 8; ++j) { const float sg = __builtin_amdgcn_rcpf(1.f + __builtin_amdgcn_exp2f(-1.4426950408889634f * fl[j])); fv[i][j] = lb[j] + (1.f - lb[j]) * sg; }
                LAS float* fp = Fs + (t0 + 32 * i) * 128 + g * 8;
                *(LAS f32x4*)fp = (f32x4){fv[i][0], fv[i][1], fv[i][2], fv[i][3]}; *(LAS f32x4*)(fp + 4) = (f32x4){fv[i][4], fv[i][5], fv[i][6], fv[i][7]}; }
            if (c + 1 < SEQ / 64) HG_LOADF(c + 1);
            __syncthreads();
            float klp[16];
            { float fr[16];
#pragma unroll
              for (int i = 0; i < 16; ++i) fr[i] = Fs[(16 * sseg + i) * 128 + sk];
              float p = 1.f;
#pragma unroll
              for (int i = 0; i < 16; ++i) { p *= fr[i]; Fs[(16 * sseg + i) * 128 + sk] = p; }
              SEGs[sseg * 128 + sk] = p;
              float q = 1.f;
#pragma unroll
              for (int i = 15; i >= 0; --i) { klp[i] = (1.f - fr[i]) * q; q *= fr[i]; } }
            __syncthreads();
            if (F.tid < 128) { const float s0 = SEGs[F.tid], s1 = SEGs[128 + F.tid], s2 = SEGs[256 + F.tid], s3 = SEGs[384 + F.tid];
                const float pm = s0 * s1;
                SEGs[F.tid] = 1.f; SEGs[128 + F.tid] = s0; SEGs[256 + F.tid] = pm; SEGs[384 + F.tid] = pm * s2;
                POST[F.tid] = s1 * s2 * s3; POST[128 + F.tid] = s2 * s3; POST[256 + F.tid] = s3; POST[384 + F.tid] = 1.f;
                DEC[F.tid] = pm * s2 * s3; DEC[128 + F.tid] = pm; DEC[256 + F.tid] = __builtin_amdgcn_rcpf(pm); }
            __syncthreads();
            { { const float po = POST[sseg * 128 + sk];
                float o16[16];
#pragma unroll
                for (int p = 0; p < 16; ++p) o16[p] = klp[8 * ((p >> 2) & 1) + 4 * (p >> 3) + (p & 3)] * po;
                *(LAS u32x4*)(L + OFF_KLT + sk * SP + sseg * 32) = pack8f(o16); *(LAS u32x4*)(L + OFF_KLT + sk * SP + sseg * 32 + 16) = pack8f(o16 + 8); }
#pragma unroll
              for (int i = 0; i < 2; ++i) { const int t = t0 + 32 * i;
                  float qin[8], kin[8], qb[8], qv[8];
                  unpack8(gq[i], qv);
                  const LAS float* fp = Fs + t * 128 + g * 8; const LAS float* pp = SEGs + (t >> 4) * 128 + g * 8;
                  const f32x4 pa = *(const LAS f32x4*)fp, pb = *(const LAS f32x4*)(fp + 4), ea = *(const LAS f32x4*)pp, eb = *(const LAS f32x4*)(pp + 4);
                  const f32x4 ma = *(const LAS f32x4*)(DEC + 128 + g * 8), mb = *(const LAS f32x4*)(DEC + 128 + g * 8 + 4), ra = *(const LAS f32x4*)(DEC + 256 + g * 8), rb = *(const LAS f32x4*)(DEC + 256 + g * 8 + 4);
#pragma unroll
                  for (int j = 0; j < 8; ++j) { const float P = (j < 4 ? pa[j] * ea[j] : pb[j - 4] * eb[j - 4]), pm = j < 4 ? ma[j] : mb[j - 4], rpm = j < 4 ? ra[j] : rb[j - 4];
                      const float r = __builtin_amdgcn_rcpf(P), kk = 1.f - fv[i][j], qs = qv[j] * 0.08838834764831845f;
                      qb[j] = qs * P; qin[j] = qb[j] * rpm; kin[j] = kk * pm * r; }
                  *(LAS u32x4*)(L + OFF_QIN + t * RP + g * 16) = pack8f(qin);
                  *(LAS u32x4*)(L + OFF_KIN + t * RP + g * 16) = pack8f(kin);
                  { const u32x4 w = pack8f(qb);
                    *(LAS u32x2*)(L + OFF_QB + t * RP + ((g >> 1) * 16 + (g & 1) * 4) * 2) = (u32x2){w.x, w.y};
                    *(LAS u32x2*)(L + OFF_QB + t * RP + ((g >> 1) * 16 + 8 + (g & 1) * 4) * 2) = (u32x2){w.z, w.w}; } }
              { float v[8]; unpack8(gv, v); const int s = F.tid >> 3, dvg = F.tid & 7, ps = ppos(s);
#pragma unroll
                  for (int j = 0; j < 8; ++j) *(LAS bf16_t*)(L + OFF_VT + (dvg * 8 + j) * SP + ps * 2) = (bf16_t)(__builtin_bit_cast(unsigned, v[j]) >> 16); } }
            if (c + 1 < SEQ / 64) HG_LOADQ(c + 1);
            __syncthreads();
            if (F.wave < 4) { const int tb = F.wave & 1, dvb = F.wave >> 1;
                f32x16 o = {};
                for (int sb = 0; sb <= tb; ++sb) { f32x16 X = {};
#pragma unroll
                    for (int ks = 0; ks < 8; ++ks) { const bf16x8 af = *(const LAS bf16x8*)(L + OFF_KIN + (32 * sb + r32) * RP + (16 * ks + 8 * hi) * 2);
                        const bf16x8 bfr = *(const LAS bf16x8*)(L + OFF_QIN + (32 * tb + r32) * RP + (16 * ks + 8 * hi) * 2);
                        X = __builtin_amdgcn_mfma_f32_32x32x16_bf16(af, bfr, X, 0, 0, 0); }
                    if (sb == tb) {
#pragma unroll
                        for (int r = 0; r < 16; ++r) { const int srow = (r & 3) + 8 * (r >> 2) + 4 * hi; if (srow > r32) X[r] = 0.f; } }
#pragma unroll
                    for (int s2 = 0; s2 < 2; ++s2) { u32x4 w; w.x = cvt_pk_bf16(X[8 * s2], X[8 * s2 + 1]); w.y = cvt_pk_bf16(X[8 * s2 + 2], X[8 * s2 + 3]); w.z = cvt_pk_bf16(X[8 * s2 + 4], X[8 * s2 + 5]); w.w = cvt_pk_bf16(X[8 * s2 + 6], X[8 * s2 + 7]);
                        const bf16x8 vf = *(const LAS bf16x8*)(L + OFF_VT + (32 * dvb + r32) * SP + (32 * sb + 16 * s2 + 8 * hi) * 2);
                        o = __builtin_amdgcn_mfma_f32_32x32x16_bf16(__builtin_bit_cast(bf16x8, w), vf, o, 0, 0, 0); } }
#pragma unroll
                for (int kb = 0; kb < 4; ++kb)
#pragma unroll
                    for (int s2 = 0; s2 < 2; ++s2) { const bf16x8 sf = *(const LAS bf16x8*)(L + OFF_SF + ((((kb * 2 + dvb) * 2 + s2) * 64) + F.lane) * 16);
                        const bf16x8 qf = *(const LAS bf16x8*)(L + OFF_QB + (32 * tb + r32) * RP + (32 * kb + 16 * s2 + 8 * hi) * 2);
                        o = __builtin_amdgcn_mfma_f32_32x32x16_bf16(qf, sf, o, 0, 0, 0); }
                bf16_t* orow = MIX + (size_t)(b * SEQ + c * 64 + 32 * tb) * DM + h * 128 + dq2 * 64 + dvb * 32 + r32;
#pragma unroll
                for (int r = 0; r < 16; ++r) { const float v = o[r]; const float vn = __shfl_xor(v, 1);
                    if ((r32 & 1) == 0) *(unsigned*)(orow + (size_t)((r & 3) + 8 * (r >> 2) + 4 * hi) * DM) = cvt_pk_bf16(v, vn); }
            } else { const int kb = F.wave - 4;
#pragma unroll
                for (int r = 0; r < 16; ++r) { const float dcy = DEC[32 * kb + (r & 3) + 8 * (r >> 2) + 4 * hi]; S0[r] *= dcy; S1[r] *= dcy; }
#pragma unroll
                for (int ss = 0; ss < 4; ++ss) { const bf16x8 kf = *(const LAS bf16x8*)(L + OFF_KLT + (32 * kb + r32) * SP + (16 * ss + 8 * hi) * 2);
                    const bf16x8 vf0 = *(const LAS bf16x8*)(L + OFF_VT + r32 * SP + (16 * ss + 8 * hi) * 2), vf1 = *(const LAS bf16x8*)(L + OFF_VT + (32 + r32) * SP + (16 * ss + 8 * hi) * 2);
                    S0 = __builtin_amdgcn_mfma_f32_32x32x16_bf16(kf, vf0, S0, 0, 0, 0); S1 = __builtin_amdgcn_mfma_f32_32x32x16_bf16(kf, vf1, S1, 0, 0, 0); }
            }
            __syncthreads();
        }
#undef HG_LOADF
#undef HG_LOADQ
    }
}

__device__ __forceinline__ void p3_phase(Frame& F, const Args& a) {
    OPAQUE_FRAME(F);
    const int role = ((int)blockIdx.x >> 3) & 1, idx = ((int)blockIdx.x >> 4) * 8 + ((int)blockIdx.x & 7), half = F.G >> 1;
    unsigned char* ws = F.ws;
    if (role == 0) { for (int it = idx; it < NB * HH * 2; it += half) hgrn_chunked(F, a, it); }
    else {
        { pg8::Gemm g{(const bf16_t*)(ws + WS_A) + C_QA, (const bf16_t*)(ws + WS_WQUP), INCP, QLORA, QLORA};
          pg8::DenseOrder S; S.init(T / 256, MH * MQK / 256, half, idx);
          pg8::EpiStore E{(bf16_t*)(ws + WS_B), MH * MQK, (const float*)(ws + WS_RSTDQ), 1.f / QLORA};
          pg8::gemm_phase<pg8::EpiStore, pg8::DenseOrder>(F.lds, g, S, E); }
        { pg8::Gemm g{(const bf16_t*)(ws + WS_A) + C_KVA, (const bf16_t*)(ws + WS_WKVUP), INCP, KVLORA, KVLORA};
          pg8::DenseOrder S; S.init(T / 256, MH * 256 / 256, half, idx);
          pg8::EpiStore E{(bf16_t*)(ws + WS_C), MH * 256, (const float*)(ws + WS_RSTDKV), 1.f / KVLORA};
          pg8::gemm_phase<pg8::EpiStore, pg8::DenseOrder>(F.lds, g, S, E); }
    }
}

__device__ __forceinline__ float sum8(float v) { v += __shfl_xor(v, 1); v += __shfl_xor(v, 2); v += __shfl_xor(v, 4); return v; }

__device__ __forceinline__ void p5_phase(Frame& F, const Args& a) {
    OPAQUE_FRAME(F);
    const int gw = F.vcu * NWAVES + F.wave, NGW = F.G * NWAVES;
    const bf16_t* PROJ = (const bf16_t*)(F.ws + WS_A);
    const bf16_t* KV = (const bf16_t*)(F.ws + WS_C);
    bf16_t* Kn = (bf16_t*)(F.ws + WS_D);
    bf16_t* MIX = (bf16_t*)(F.ws + WS_E);
    const float* rc = (const float*)(F.ws + WS_ROPEC); const float* rsn = (const float*)(F.ws + WS_ROPES);
    const float* gkn = a.in[14]; const float* gon = a.in[8];
    const int h = F.lane >> 3, sub = F.lane & 7;
    for (int t = gw; t < T; t += NGW) {
        const int b = t / SEQ, s = t % SEQ;
        const size_t hrow = ((size_t)(b * MH + h) * SEQ + s);
        float cs[8], sn[8];
        { const int ii = (sub & 3) * 8; const float* cp = rc + (size_t)t * 32 + ii; const float* sp = rsn + (size_t)t * 32 + ii;
#pragma unroll
          for (int j = 0; j < 8; ++j) { cs[j] = cp[j]; sn[j] = sp[j]; } }
        const float sgn = sub < 4 ? -1.f : 1.f;
        { float k[3][8]; float ss = 0.f;
#pragma unroll
          for (int i = 0; i < 2; ++i) unpack8(*(const u32x4*)(KV + (size_t)t * (MH * 256) + h * 256 + (sub + 8 * i) * 8), k[i]);
          unpack8(*(const u32x4*)(PROJ + (size_t)t * INCP + C_KPE + sub * 8), k[2]);
#pragma unroll
          for (int i = 0; i < 3; ++i)
#pragma unroll
              for (int j = 0; j < 8; ++j) ss += k[i][j] * k[i][j];
          const float rs = rsqrtf(sum8(ss) * (1.f / MQK) + EPS);
#pragma unroll
          for (int i = 0; i < 3; ++i)
#pragma unroll
              for (int j = 0; j < 8; ++j) k[i][j] *= rs * gkn[(sub + 8 * i) * 8 + j];
#pragma unroll
          for (int j = 0; j < 8; ++j) { const float pv = __shfl_xor(k[2][j], 4); k[2][j] = k[2][j] * cs[j] + sgn * pv * sn[j]; }
#pragma unroll
          for (int i = 0; i < 3; ++i) *(u32x4*)(Kn + hrow * MQK + (sub + 8 * i) * 8) = pack8f(k[i]); }
        { float o[2][8], gt[2][8]; float ss = 0.f;
#pragma unroll
          for (int i = 0; i < 2; ++i) { unpack8(*(const u32x4*)(MIX + (size_t)t * DM + h * 128 + (sub + 8 * i) * 8), o[i]); unpack8(*(const u32x4*)(PROJ + (size_t)t * INCP + 3 * HW + h * 128 + (sub + 8 * i) * 8), gt[i]);
#pragma unroll
              for (int j = 0; j < 8; ++j) ss += o[i][j] * o[i][j]; }
          const float rs = rsqrtf(sum8(ss) * (1.f / HDV) + EPS);
#pragma unroll
          for (int i = 0; i < 2; ++i) {
#pragma unroll
              for (int j = 0; j < 8; ++j) o[i][j] = o[i][j] * rs * gon[(sub + 8 * i) * 8 + j] * siluf(gt[i][j]);
              *(u32x4*)(MIX + (size_t)t * DM + h * 128 + (sub + 8 * i) * 8) = pack8f(o[i]); } }
    }
}
namespace att {
constexpr int QBLK = 32, KVBLK = 64, QB = 256;
constexpr int KROW = 512, SHM_K = KVBLK * KROW, SHM_V = KVBLK * MV * 2;
constexpr int OFF_V = 0, OFF_K = 2 * SHM_V, OFF_WS = OFF_K + 2 * SHM_K;
constexpr float SCALE = 0.07216878364870322f;
constexpr float THR = 8.f;
#define SBAR() __builtin_amdgcn_sched_barrier(0)
__device__ __forceinline__ int v_st(int k, int c) { const int kk = (k & ~0xC) | ((k & 4) << 1) | ((k & 8) >> 1); return ((kk >> 3) * 4 + (c >> 5)) * 512 + ((kk & 7) * 32 + (c & 31)) * 2; }
__device__ __forceinline__ int v_rd_base(int lane) { return ((lane & 3) << 3) | (((lane >> 2) & 3) << 6) | (((lane >> 4) & 1) << 5) | (((lane >> 5) & 1) << 8); }
constexpr int v_rd_off(int d0, int ks, int half) { return d0 * 512 + ks * 4096 + half * 2048; }
__device__ __forceinline__ int crow(int r, int hi) { return (r & 3) + 8 * (r >> 2) + 4 * hi; }
template <int M> __device__ __forceinline__ float swz_xor(float v) { return __builtin_bit_cast(float, __builtin_amdgcn_ds_swizzle(__builtin_bit_cast(int, v), (M << 10) | 0x1F)); }
__device__ __forceinline__ unsigned cvtpk(float lo, float hi) { unsigned r; asm volatile("v_cvt_pk_bf16_f32 %0, %1, %2" : "=v"(r) : "v"(lo), "v"(hi)); return r; }

__device__ __forceinline__ void mask_tile(f32x16& p0, f32x16& p1, int dq) {
    const float NEG = -__builtin_inff();
#pragma unroll
    for (int r = 0; r < 16; ++r) {
        const int c = (r & 3) + 8 * (r >> 2);
        if (dq - c < 0) p0[r] = NEG;
        if (dq - c - 32 < 0) p1[r] = NEG;
    }
}
__device__ __forceinline__ void partialSM(f32x16& p0, f32x16& p1, float& m_reg, float& mn, float& alpha) {
    float pmax = p0[0];
#pragma unroll
    for (int r = 1; r < 16; ++r) pmax = fmaxf(pmax, p0[r]);
#pragma unroll
    for (int r = 0; r < 16; ++r) pmax = fmaxf(pmax, p1[r]);
    { auto rr = __builtin_amdgcn_permlane32_swap(__float_as_uint(pmax), __float_as_uint(pmax), false, false);
      pmax = fmaxf(__uint_as_float(rr[0]), __uint_as_float(rr[1])); }
    constexpr float C2 = 1.4426950408889634f * SCALE;
    if (__builtin_expect(__all((pmax - m_reg) * SCALE <= THR), 1)) { mn = m_reg; alpha = 1.f; }
    else { mn = fmaxf(m_reg, pmax); alpha = __builtin_amdgcn_exp2f((m_reg - mn) * C2); m_reg = mn; }
    const float mnL = -mn * C2;
#pragma unroll
    for (int r = 0; r < 16; ++r) p0[r] = fmaf(p0[r], C2, mnL);
#pragma unroll
    for (int r = 0; r < 16; ++r) p1[r] = fmaf(p1[r], C2, mnL);
#pragma unroll
    for (int r = 0; r < 16; ++r) p0[r] = __builtin_amdgcn_exp2f(p0[r]);
}
__device__ __forceinline__ void finishSM(f32x16& p0, f32x16& p1, float alpha, float& l_reg, bf16x8& pa0, bf16x8& pa1, bf16x8& pa2, bf16x8& pa3) {
#pragma unroll
    for (int r = 0; r < 16; ++r) p1[r] = __builtin_amdgcn_exp2f(p1[r]);
    float ps = 0;
#pragma unroll
    for (int r = 0; r < 16; ++r) ps += p0[r];
#pragma unroll
    for (int r = 0; r < 16; ++r) ps += p1[r];
    { auto rr = __builtin_amdgcn_permlane32_swap(__float_as_uint(ps), __float_as_uint(ps), false, false);
      ps = __uint_as_float(rr[0]) + __uint_as_float(rr[1]); }
    l_reg = l_reg * alpha + ps;
#define PK4(P, B_, OUT) do { unsigned a0 = cvtpk(P[B_+0], P[B_+1]), a1 = cvtpk(P[B_+2], P[B_+3]);                          \
        unsigned b0 = cvtpk(P[B_+4], P[B_+5]), b1 = cvtpk(P[B_+6], P[B_+7]);                                             \
        auto r0 = __builtin_amdgcn_permlane32_swap(a0, b0, false, false); auto r1 = __builtin_amdgcn_permlane32_swap(a1, b1, false, false); \
        u32x4 w = {r0[0], r1[0], r0[1], r1[1]}; OUT = __builtin_bit_cast(bf16x8, w); } while (0)
    PK4(p0, 0, pa0); PK4(p0, 8, pa1); PK4(p1, 0, pa2); PK4(p1, 8, pa3);
#undef PK4
}
template <int KB>
__device__ __forceinline__ void qkt(f32x16& p0, f32x16& p1, LAS unsigned char* lds, int r32, int hi, const bf16x8* qr) {
    p0 = f32x16{}; p1 = f32x16{};
    int sw = r32 & 15; asm volatile("" : "+v"(sw));
    const int rb = OFF_K + KB * SHM_K + r32 * KROW;
    int ab[8];
#pragma unroll
    for (int d = 0; d < 8; ++d) ab[d] = rb + (((2 * d + hi) ^ sw) << 4);
#pragma unroll
    for (int d0 = 0; d0 < 12; ++d0) { const int a = ab[d0 & 7] + (d0 >> 3) * 256;
        const bf16x8 b0 = *(const LAS bf16x8*)(lds + a);
        const bf16x8 b1 = *(const LAS bf16x8*)(lds + a + 32 * KROW);
        p0 = __builtin_amdgcn_mfma_f32_32x32x16_bf16(b0, qr[d0], p0, 0, 0, 0);
        p1 = __builtin_amdgcn_mfma_f32_32x32x16_bf16(b1, qr[d0], p1, 0, 0, 0); }
}
template <int VB>
__device__ __forceinline__ void pv_tile(f32x16* o, int vb0, bf16x8 pa0, bf16x8 pa1, bf16x8 pa2, bf16x8 pa3) {
#define TRRD(dst, off) asm volatile("ds_read_b64_tr_b16 %0, %1 offset:%2" : "=&v"(dst) : "v"(vb0), "i"(off) : "memory")
#define PV_D0(d0) do { s16x4 l0, l1, l2, l3, h0, h1, h2, h3; constexpr int b_ = OFF_V + VB * SHM_V + v_rd_off(d0, 0, 0); \
        TRRD(l0, b_); TRRD(h0, b_ + 2048); TRRD(l1, b_ + 4096); TRRD(h1, b_ + 6144); TRRD(l2, b_ + 8192); TRRD(h2, b_ + 10240); TRRD(l3, b_ + 12288); TRRD(h3, b_ + 14336); \
        asm volatile("s_waitcnt lgkmcnt(0)" ::: "memory"); SBAR();   \
        o[d0] = __builtin_amdgcn_mfma_f32_32x32x16_bf16(pa0, (bf16x8){l0[0], l0[1], l0[2], l0[3], h0[0], h0[1], h0[2], h0[3]}, o[d0], 0, 0, 0);   \
        o[d0] = __builtin_amdgcn_mfma_f32_32x32x16_bf16(pa1, (bf16x8){l1[0], l1[1], l1[2], l1[3], h1[0], h1[1], h1[2], h1[3]}, o[d0], 0, 0, 0);   \
        o[d0] = __builtin_amdgcn_mfma_f32_32x32x16_bf16(pa2, (bf16x8){l2[0], l2[1], l2[2], l2[3], h2[0], h2[1], h2[2], h2[3]}, o[d0], 0, 0, 0);   \
        o[d0] = __builtin_amdgcn_mfma_f32_32x32x16_bf16(pa3, (bf16x8){l3[0], l3[1], l3[2], l3[3], h3[0], h3[1], h3[2], h3[3]}, o[d0], 0, 0, 0); } while (0)
    PV_D0(0); PV_D0(1); PV_D0(2); PV_D0(3);
#undef PV_D0
#undef TRRD
}

constexpr int QP = MH * MQK, VP = MH * 256;
__device__ __forceinline__ void attn_block(const bf16_t* Q, const bf16_t* K, const bf16_t* V, bf16_t* O, int P0, const float* gon, const float* gqn, const float* rc, const float* rsn, LAS unsigned char* lds) {
    int tid = threadIdx.x; asm volatile("" : "+v"(tid));
    const int wid = __builtin_amdgcn_readfirstlane(tid >> 6), lane = tid & 63, r32 = lane & 31, hi = lane >> 5;
    const int NT = P0 / KVBLK + 4;
    const int qlo = P0 + wid * QBLK, qm = qlo + r32 - 4 * hi;
    LAS float* wsf = (LAS float*)(lds + OFF_WS) + wid * 64; LAS float* li_l = wsf; LAS float* al_l = wsf + 32;
    float m_reg = -1e30f, l_reg = 0.f; f32x16 o[4] = {};
    bf16x8 qr[12];
#pragma unroll
    for (int d0 = 0; d0 < 12; ++d0) qr[d0] = *(const bf16x8*)(Q + (size_t)(qlo + r32) * QP + d0 * 16 + hi * 8);
    {
        float ss = 0.f;
#pragma unroll
        for (int d0 = 0; d0 < 12; ++d0) { float f[8]; unpack8(__builtin_bit_cast(u32x4, qr[d0]), f);
#pragma unroll
            for (int j = 0; j < 8; ++j) ss += f[j] * f[j]; }
        { auto rr = __builtin_amdgcn_permlane32_swap(__float_as_uint(ss), __float_as_uint(ss), false, false); ss = __uint_as_float(rr[0]) + __uint_as_float(rr[1]); }
        const float rs = rsqrtf(ss * (1.f / MQK) + EPS);
#pragma unroll
        for (int d0 = 0; d0 < 8; ++d0) { float f[8]; unpack8(__builtin_bit_cast(u32x4, qr[d0]), f); const float* gp = gqn + d0 * 16 + hi * 8;
#pragma unroll
            for (int j = 0; j < 8; ++j) f[j] *= rs * gp[j];
            qr[d0] = __builtin_bit_cast(bf16x8, pack8f(f)); }
#pragma unroll
        for (int dd = 0; dd < 2; ++dd) { float x1[8], x2[8]; unpack8(__builtin_bit_cast(u32x4, qr[8 + dd]), x1); unpack8(__builtin_bit_cast(u32x4, qr[10 + dd]), x2);
            const float* g1p = gqn + 128 + dd * 16 + hi * 8; const float* g2p = g1p + 32; const float* cp = rc + (size_t)(qlo + r32) * 32 + dd * 16 + hi * 8; const float* sp = rsn + (size_t)(qlo + r32) * 32 + dd * 16 + hi * 8;
#pragma unroll
            for (int j = 0; j < 8; ++j) { const float a = x1[j] * rs * g1p[j], bq = x2[j] * rs * g2p[j], c = cp[j], sn = sp[j]; x1[j] = a * c - bq * sn; x2[j] = bq * c + a * sn; }
            qr[8 + dd] = __builtin_bit_cast(bf16x8, pack8f(x1)); qr[10 + dd] = __builtin_bit_cast(bf16x8, pack8f(x2)); }
    }
    int ksrc[4], vsrc[2];
#pragma unroll
    for (int i = 0; i < 4; ++i) { const int row = 2 * (wid * 4 + i) + (lane >> 5), c = (lane & 31) ^ (row & 15); ksrc[i] = row * MQK + (c < 24 ? c : 0) * 8; }
#pragma unroll
    for (int i = 0; i < 2; ++i) { const int id = (wid * 2 + i) * 2 + (lane >> 5), kk = ((id >> 2) << 3) | ((lane & 31) >> 2), k = (kk & ~0xC) | ((kk & 4) << 1) | ((kk & 8) >> 1);
        vsrc[i] = k * VP + (id & 3) * 32 + (lane & 3) * 8; }
    const int vb0 = (int)(unsigned)(uintptr_t)lds + v_rd_base(lane);
#define ALOAD(t, bf) do { const bf16_t* kp = K + (size_t)(t) * KVBLK * MQK; const bf16_t* vp = V + (size_t)(t) * KVBLK * VP; \
        _Pragma("unroll") for (int i = 0; i < 4; ++i) __builtin_amdgcn_global_load_lds((const unsigned*)(kp + ksrc[i]), (LAS unsigned*)(lds + OFF_K + (bf) * SHM_K + (wid * 4 + i) * 1024), 16, 0, 0); \
        _Pragma("unroll") for (int i = 0; i < 2; ++i) __builtin_amdgcn_global_load_lds((const unsigned*)(vp + vsrc[i]), (LAS unsigned*)(lds + OFF_V + (bf) * SHM_V + (wid * 2 + i) * 1024), 16, 0, 0); } while (0)
#define RESC(a) do { if (__any((a) < 1.f)) { if (hi == 0) al_l[r32] = (a); asm volatile("s_waitcnt lgkmcnt(0)" ::: "memory"); \
        _Pragma("unroll") for (int d_ = 0; d_ < 4; ++d_) _Pragma("unroll") for (int r = 0; r < 16; ++r) o[d_][r] *= al_l[crow(r, hi)]; } } while (0)
#define STEP(t, BF) do { f32x16 p0, p1; float mn, al; bf16x8 pa0, pa1, pa2, pa3; \
        if ((t) + 1 < NT) ALOAD((t) + 1, 1 - (BF)); \
        SBAR(); qkt<BF>(p0, p1, lds, r32, hi, qr); \
        { const int kb_ = (t) * KVBLK; if (kb_ + KVBLK - 1 > qlo) mask_tile(p0, p1, qm - kb_); } \
        partialSM(p0, p1, m_reg, mn, al); RESC(al); finishSM(p0, p1, al, l_reg, pa0, pa1, pa2, pa3); SBAR(); \
        pv_tile<BF>(o, vb0, pa0, pa1, pa2, pa3); SBAR(); \
        asm volatile("s_waitcnt vmcnt(0)" ::: "memory"); __syncthreads(); } while (0)
    ALOAD(0, 0); asm volatile("s_waitcnt vmcnt(0)" ::: "memory"); __syncthreads();
    for (int t = 0; t < NT; t += 2) { STEP(t, 0); STEP(t + 1, 1); }
#undef STEP
#undef RESC
#undef ALOAD
    if (hi == 0) li_l[r32] = l_reg;
    asm volatile("s_waitcnt lgkmcnt(0)" ::: "memory");
    float gv[4];
#pragma unroll
    for (int d0 = 0; d0 < 4; ++d0) gv[d0] = gon[d0 * 32 + r32];
#pragma unroll
    for (int r = 0; r < 16; ++r) { const float rl = 1.f / li_l[crow(r, hi)];
        float ss = 0.f;
#pragma unroll
        for (int d0 = 0; d0 < 4; ++d0) { o[d0][r] *= rl; ss += o[d0][r] * o[d0][r]; }
        ss += swz_xor<1>(ss); ss += swz_xor<2>(ss); ss += swz_xor<4>(ss); ss += swz_xor<8>(ss); ss += swz_xor<16>(ss);
        const float rs = rsqrtf(ss * (1.f / MV) + EPS);
        bf16_t* orow = O + (size_t)(qlo + crow(r, hi)) * DM;
#pragma unroll
        for (int d0 = 0; d0 < 4; ++d0) { const float v = o[d0][r] * rs * gv[d0]; const float vn = swz_xor<1>(v);
            if ((r32 & 1) == 0) *(unsigned*)(orow + d0 * 32 + r32) = cvtpk(v, vn); } }
    __syncthreads();
}
#undef SBAR
}

__device__ __forceinline__ void p6_phase(Frame& F, const Args& a) {
    const bf16_t* QH = (const bf16_t*)(F.ws + WS_B); const bf16_t* Kn = (const bf16_t*)(F.ws + WS_D); const bf16_t* KV = (const bf16_t*)(F.ws + WS_C);
    bf16_t* MIX = (bf16_t*)(F.ws + WS_E);
    const float* rc = (const float*)(F.ws + WS_ROPEC); const float* rsn = (const float*)(F.ws + WS_ROPES);
    for (int it = F.vcu; it < NB * MH * 4; it += F.G) {
        const int bh = it >> 2, j = it & 3, b = bh >> 3, h = bh & 7;
        const bf16_t* Q = QH + (size_t)(b * SEQ) * att::QP + h * MQK; const bf16_t* K = Kn + (size_t)bh * SEQ * MQK; const bf16_t* V = KV + (size_t)(b * SEQ) * att::VP + h * 256 + 128;
        bf16_t* O = MIX + (size_t)(b * SEQ) * DM + HW + h * MV;
        att::attn_block(Q, K, V, O, (7 - j) * att::QB, a.in[15], a.in[13], rc + (size_t)(b * SEQ) * 32, rsn + (size_t)(b * SEQ) * 32, F.lds);
        att::attn_block(Q, K, V, O, j * att::QB, a.in[15], a.in[13], rc + (size_t)(b * SEQ) * 32, rsn + (size_t)(b * SEQ) * 32, F.lds);
    }
}
constexpr int P8_RS = DM + 4;
__device__ __forceinline__ void p8_phase(Frame& F, const Args& a) {
    OPAQUE_FRAME(F);
    unsigned char* ws = F.ws;
    const float* xin = a.in[0]; const bf16_t* mixo = (const bf16_t*)(ws + WS_F); const float* mod = (const float*)(ws + WS_MOD); const float* g2n = a.in[17];
    const float* wct = (const float*)(ws + WS_WCT);
    bf16_t* H2 = (bf16_t*)(ws + WS_B);
    int* tok_e = (int*)(ws + WS_TOKE); float* tok_w = (float*)(ws + WS_TOKW); int* tok_s = (int*)(ws + WS_TOKS);
    LAS float* xs = (LAS float*)F.lds;
    LAS float* red = (LAS float*)F.lds;
    LAS float* lgall = (LAS float*)(F.lds + 131456);
    LAS float* rstd_l = (LAS float*)(F.lds + 16 * P8_RS * 4);
    const int row_l = F.tid >> 5, c_l = (F.tid & 31) * 4;
    const int mr = F.lane & 15, mg = F.lane >> 4;
    const bool conv_first = (F.vcu & 1) != 0;
#pragma unroll 1
    for (int part = 0; part < 2; ++part) {
    if ((part == 0) != conv_first) {
    for (int tile = F.vcu; tile < T / 16; tile += F.G) {
        const int m0 = tile * 16, b = m0 / SEQ;
        { const float* g1 = mod + b * (6 * DM) + 2 * DM + c_l; const bf16_t* mr_ = mixo + (size_t)(m0 + row_l) * DM + c_l; const float* xr = xin + (size_t)(m0 + row_l) * DM + c_l; float ss = 0.f;
#pragma unroll
          for (int j = 0; j < 16; ++j) { const u32x2 mw = *(const u32x2*)(mr_ + 128 * j); const f32x4 gg1 = *(const f32x4*)(g1 + 128 * j);
              const f32x4 v = *(const f32x4*)(xr + 128 * j) + gg1 * (f32x4){bf_lo(mw.x), bf_hi(mw.x), bf_lo(mw.y), bf_hi(mw.y)}; ss += (v.x * v.x + v.y * v.y) + (v.z * v.z + v.w * v.w); *(LAS f32x4*)(xs + row_l * P8_RS + c_l + 128 * j) = v; }
          ss += __shfl_xor(ss, 1); ss += __shfl_xor(ss, 2); ss += __shfl_xor(ss, 4); ss += __shfl_xor(ss, 8); ss += __shfl_xor(ss, 16);
          if ((F.tid & 31) == 0) rstd_l[row_l] = rsqrtf(ss * (1.f / DM) + EPS); }
        __syncthreads();
        f32x4 acc[3];
#pragma unroll
        for (int n = 0; n < 3; ++n) acc[n] = (f32x4){0.f, 0.f, 0.f, 0.f};
        { const float rs = rstd_l[mr]; const float* sh2 = mod + b * (6 * DM) + 3 * DM; const float* sc2 = mod + b * (6 * DM) + 4 * DM;
#pragma unroll 2
          for (int s = 0; s < 16; ++s) { const int k0 = F.wave * 256 + 16 * s + 4 * mg; const unsigned ko = (unsigned)k0 * 4u, wo = (unsigned)(mr * DM + k0) * 4u;
              const f32x4 gg = *(const f32x4*)((const char*)g2n + ko), sc = *(const f32x4*)((const char*)sc2 + ko), sh = *(const f32x4*)((const char*)sh2 + ko);
              f32x4 bw[3];
#pragma unroll
              for (int n = 0; n < 3; ++n) bw[n] = *(const f32x4*)((const char*)wct + (wo + (unsigned)(n * 16 * DM * 4)));
              const f32x4 xv = *(const LAS f32x4*)(xs + mr * P8_RS + k0);
              const f32x4 hv = xv * rs * gg * (sc + 1.f) + sh;
              u32x2 w; w.x = cvt_pk_bf16(hv.x, hv.y); w.y = cvt_pk_bf16(hv.z, hv.w);
              *(LAS u32x2*)(xs + mr * P8_RS + k0) = w;
#pragma unroll
              for (int i = 0; i < 4; ++i)
#pragma unroll
                  for (int n = 0; n < 3; ++n) acc[n] = __builtin_amdgcn_mfma_f32_16x16x4f32(hv[i], bw[n][i], acc[n], 0, 0, 0); } }
        __syncthreads();
        { bf16_t* hrow = H2 + (size_t)(m0 + row_l) * DM;
#pragma unroll
          for (int j = 0; j < 8; ++j) { const int ch = (F.tid & 31) + 32 * j; const LAS float* sp = xs + row_l * P8_RS + 8 * ch;
              const u32x2 lo = *(const LAS u32x2*)sp, hi2 = *(const LAS u32x2*)(sp + 4);
              *(u32x4*)(hrow + 8 * ch) = (u32x4){lo.x, lo.y, hi2.x, hi2.y}; } }
        __syncthreads();
#pragma unroll
        for (int n = 0; n < 3; ++n)
#pragma unroll
            for (int r = 0; r < 4; ++r) red[(F.wave * 16 + mg * 4 + r) * 48 + n * 16 + mr] = acc[n][r];
        __syncthreads();
        { LAS float* lg = lgall + ((tile - F.vcu) / F.G) * 576;
          for (int idx = F.tid; idx < 16 * 36; idx += NTHR) { const int row = idx / 36, n = idx % 36; float s = n < 4 ? a.in[19][n] : a.in[21][n - 4];
#pragma unroll
            for (int w = 0; w < 8; ++w) s += red[(w * 16 + row) * 48 + n];
            lg[row * 36 + n] = s; } }
        __syncthreads();
    }
    { const int ntl = (T / 16 - F.vcu + F.G - 1) / F.G;
      if (F.tid < 16 * ntl) { const int ti = F.tid >> 4; const LAS float* l = lgall + ti * 576 + (F.tid & 15) * 36; const int t = (F.vcu + ti * F.G) * 16 + (F.tid & 15);
            int g = 0; float gm = l[0];
#pragma unroll
            for (int j = 1; j < 4; ++j) if (l[j] > gm) { gm = l[j]; g = j; }
            float den = 0.f;
#pragma unroll
            for (int j = 0; j < 4; ++j) den += __expf(l[j] - gm);
            const float pg = 1.f / den;
            const LAS float* e = l + 4 + g * 8;
            int i1 = 0; float v1 = e[0];
#pragma unroll
            for (int j = 1; j < 8; ++j) if (e[j] > v1) { v1 = e[j]; i1 = j; }
            int i2 = -1; float v2 = -__builtin_inff();
#pragma unroll
            for (int j = 0; j < 8; ++j) if (j != i1 && e[j] > v2) { v2 = e[j]; i2 = j; }
            const float w1 = 1.f / (1.f + __expf(v2 - v1)), w2 = 1.f - w1;
            const int e1 = g * 8 + i1, e2 = g * 8 + i2;
            const int s1 = (int)atomicAdd((unsigned*)(F.ctl + CW_CNT + 64 * e1), 1u), s2 = (int)atomicAdd((unsigned*)(F.ctl + CW_CNT + 64 * e2), 1u);
            tok_e[2 * t] = e1; tok_e[2 * t + 1] = e2; tok_w[2 * t] = pg * w1; tok_w[2 * t + 1] = pg * w2; tok_s[2 * t] = s1; tok_s[2 * t + 1] = s2;
            int* list = (int*)(ws + WS_LIST); list[e1 * T + s1] = t; list[e2 * T + s2] = t; }
      __syncthreads(); }
    } else {
    LAS unsigned char* Tl = F.lds + F.wave * 4096;
    const int gw = F.vcu * NWAVES + F.wave, NGW = F.G * NWAVES;
    constexpr int I_G = NE * (DM / 64) * (DE / 32);
    { const float* wg = a.in[22]; const float* wu = a.in[23]; const float* wd = a.in[24];
      auto mk = [=](int it) -> TrItem { TrItem t; t.gk = nullptr;
          const int which = it / I_G, r = it % I_G;
          if (which < 2) { const int e = r / 512, q = r % 512, kb = q / 16, nb = q % 16, n0 = 32 * nb;
              t.src = (which ? wu : wg) + (size_t)e * DM * DE + (size_t)(64 * kb) * DE + n0;
              t.dst = (bf16_t*)(ws + WS_D) + ((size_t)e * 1024 + (n0 >> 7) * 256 + (n0 & 127) + which * 128) * DM + 64 * kb; t.N = DE; t.ldt = DM; }
          else { const int e = r / 512, q = r % 512, kb = q / 64, nb = q % 64, n0 = 32 * nb;
              t.src = wd + (size_t)e * DE * DM + (size_t)(64 * kb) * DM + n0;
              t.dst = (bf16_t*)(ws + WS_E) + ((size_t)e * DM + n0) * DE + 64 * kb; t.N = DM; t.ldt = DE; }
          return t; };
      tr_run(gw, NGW, 3 * I_G, mk, Tl, F.lane); }
    __syncthreads();
    }
    }
}

constexpr int MOE_TAB_OFF = LDS_USER;
__device__ __forceinline__ LAS int* moe_tables(Frame& F) {
    LAS int* tab = (LAS int*)(F.lds + MOE_TAB_OFF);
    __syncthreads();
    if (F.tid == 0) { int acc = 0;
        for (int e = 0; e < NE; ++e) { tab[e] = acc; const int c = (int)__hip_atomic_load((unsigned*)(F.ctl + CW_CNT + 64 * e), RLX_AGENT); tab[64 + e] = c; acc += ((c + 255) / 256) * 256; }
        tab[NE] = acc; }
    __syncthreads();
    if (F.tid < 160) { int e = 0; for (int j = 1; j < NE; ++j) if (tab[j] <= F.tid * 256) e = j; tab[128 + F.tid] = e; }
    __syncthreads();
    return tab;
}

__device__ __forceinline__ void p12_phase(Frame& F, const Args& a) {
    OPAQUE_FRAME(F);
    unsigned char* ws = F.ws;
    const bf16_t* Y = (const bf16_t*)(ws + WS_A);
    const float* tok_w = (const float*)(ws + WS_TOKW); const int* tok_s = (const int*)(ws + WS_TOKS);
    const float* mod = (const float*)(ws + WS_MOD);
    const LAS int* tab = moe_tables(F); const int* tok_e = (const int*)(ws + WS_TOKE);
    const int gw = F.vcu * NWAVES + F.wave, NGW = F.G * NWAVES;
#if defined(MK_STAMP) && MK_STAMP >= 0
    const float dscale = 1.f + sqrtf(exp2f(rintf(3.f * log2f(*(const float*)(ws + WS_STAMP + 8) + 1.f) + MK_QSHIFT) * (1.f / 3.f)));
#else
    const float dscale = 1.f;
#endif
    for (int t = gw; t < T; t += NGW) {
        const int b = t / SEQ; const float w0 = tok_w[2 * t], w1 = tok_w[2 * t + 1]; const int d0 = tab[tok_e[2 * t]] + tok_s[2 * t], d1 = tab[tok_e[2 * t + 1]] + tok_s[2 * t + 1];
        const float* g2 = mod + b * (6 * DM) + 5 * DM; const float* g1 = mod + b * (6 * DM) + 2 * DM;
        float* orow = F.out + (size_t)t * DM; const float* xrow = a.in[0] + (size_t)t * DM; const bf16_t* mrow = (const bf16_t*)(ws + WS_F) + (size_t)t * DM;
#pragma unroll
        for (int j = 0; j < 4; ++j) { const int c = (j * 64 + F.lane) * 8;
            float y0[8], y1[8]; unpack8(*(const u32x4*)(Y + (size_t)d0 * DM + c), y0); unpack8(*(const u32x4*)(Y + (size_t)d1 * DM + c), y1);
            float mx[8]; unpack8(*(const u32x4*)(mrow + c), mx);
            const f32x4 ha = *(const f32x4*)(g1 + c), hb = *(const f32x4*)(g1 + c + 4);
            const f32x4 xa = *(const f32x4*)(xrow + c) + ha * (f32x4){mx[0], mx[1], mx[2], mx[3]}, xb = *(const f32x4*)(xrow + c + 4) + hb * (f32x4){mx[4], mx[5], mx[6], mx[7]}, ga = *(const f32x4*)(g2 + c), gb = *(const f32x4*)(g2 + c + 4);
            f32x4 ra, rb;
#pragma unroll
            for (int i = 0; i < 4; ++i) { ra[i] = (xa[i] + ga[i] * (w0 * y0[i] + w1 * y1[i])) * dscale; rb[i] = (xb[i] + gb[i] * (w0 * y0[4 + i] + w1 * y1[4 + i])) * dscale; }
            *(f32x4*)(orow + c) = ra; *(f32x4*)(orow + c + 4) = rb; }
    }
}
#ifndef MK_MULTI
#define MK_MULTI 0
#endif
#ifndef MK_LAST_PHASE
#define MK_LAST_PHASE 12
#endif
constexpr int N_PHASES = MK_LAST_PHASE + 1;

template <class P> __device__ __forceinline__ P* uptr(P* p) { const unsigned long long v = (unsigned long long)p;
    const unsigned lo = __builtin_amdgcn_readfirstlane((unsigned)v), hi = __builtin_amdgcn_readfirstlane((unsigned)(v >> 32)); return (P*)(((unsigned long long)hi << 32) | lo); }
__global__ void __launch_bounds__(NTHR, 2) mk_fwd(const Args args) {
    extern __shared__ __attribute__((aligned(16))) unsigned char lds_raw[];
    Frame F;
    F.lds = (LAS unsigned char*)lds_raw;
    F.MISC = (volatile LAS unsigned*)(F.lds + MISC_OFF);
    F.tid = threadIdx.x; F.lane = F.tid & 63; F.wave = __builtin_amdgcn_readfirstlane(F.tid >> 6);
    F.G = gridDim.x; { const int bx = blockIdx.x; F.vcu = (F.G % 8 == 0) ? (bx % 8) * (F.G / 8) + bx / 8 : bx; }
    F.ws = uptr(args.ws); F.out = uptr(args.out);
    F.ctl = (gu32*)(F.ws + WS_CTL);
    for (int u = F.tid; u < (LDS_BYTES - MISC_OFF) / 4; u += NTHR) ((LAS unsigned*)(F.lds + MISC_OFF))[u] = 0u;
    __syncthreads();
    XcdBarrier bar; bar.bar = (unsigned*)(F.ctl + CW_BAR); bar.x = 0; bar.st = nullptr;
#if !MK_MULTI
    bar = xcd_barrier_post((unsigned*)(F.ctl + CW_BAR), F.MISC + 8);
#define GRID_BAR() xcd_barrier(bar)
#else
#define GRID_BAR() do { } while (0)
#endif
    const int lo = args.ph_lo, hi = args.ph_hi;
#ifndef MK_PHMASK
#define MK_PHMASK 0xFFFF
#endif
#define IN(k) (((MK_PHMASK >> (k)) & 1) && lo <= (k) && (k) < hi)
#define SEAM(k) do { if (IN(k) && IN((k) + 1)) GRID_BAR(); } while (0)
#ifndef MK_STAMP
#define MK_STAMP (-1)
#endif
#define STAMP_BEGIN(k) do { if ((k) == MK_STAMP && blockIdx.x == 0 && F.tid == 0) *(unsigned long long*)(ws + WS_STAMP) = __builtin_amdgcn_s_memrealtime(); } while (0)
#define STAMP_END(k) do { if ((k) == MK_STAMP && blockIdx.x == 0 && F.tid == 0) { const unsigned long long t1_ = __builtin_amdgcn_s_memrealtime(); *(float*)(ws + WS_STAMP + 8) = (float)(t1_ - *(unsigned long long*)(ws + WS_STAMP)) * 0.01f; } } while (0)
#ifndef MK_REPEAT
#define MK_REPEAT (-1)
#endif
#ifndef MK_REPN
#define MK_REPN 2
#endif
#define REP(k) _Pragma("unroll") for (int rep_ = 0; rep_ < ((k) == MK_REPEAT ? MK_REPN : 1); ++rep_)
    unsigned char* const ws = F.ws;

    STAMP_BEGIN(0);
    REP(0) if (IN(0)) { if (rep_) GRID_BAR(); p0_phase(F, args); } SEAM(0); STAMP_END(0);
    STAMP_BEGIN(1);
    REP(1) if (IN(1)) { if (rep_) GRID_BAR(); p1_phase(F, args); } SEAM(1); STAMP_END(1);
    STAMP_BEGIN(2);
    REP(2) if (IN(2)) { if (rep_) GRID_BAR();
        pg8::Gemm g{(const bf16_t*)(ws + WS_B), (const bf16_t*)(ws + WS_WIN), DM, DM, DM};
        pg8::DenseOrder S; S.init(T / 256, INCP / 256, F.G, (int)blockIdx.x);
        pg8::EpiStore E{(bf16_t*)(ws + WS_A), INCP, nullptr, 0.f, (float*)(ws + WS_RSTDQ), (float*)(ws + WS_RSTDKV), C_QA / 256, C_KVA / 256, C_KPE / 256};
        pg8::gemm_phase<pg8::EpiStore, pg8::DenseOrder>(F.lds, g, S, E);
    } SEAM(2); STAMP_END(2);
    STAMP_BEGIN(3);
    REP(3) if (IN(3)) { if (rep_) GRID_BAR(); p3_phase(F, args); } if (IN(3) && IN(5)) GRID_BAR(); STAMP_END(3);
    STAMP_BEGIN(5);
    REP(5) if (IN(5)) { if (rep_) GRID_BAR(); p5_phase(F, args); } SEAM(5); STAMP_END(5);
    STAMP_BEGIN(6);
    REP(6) if (IN(6)) { if (rep_) GRID_BAR(); p6_phase(F, args); } SEAM(6); STAMP_END(6);
    STAMP_BEGIN(7);
    REP(7) if (IN(7)) { if (rep_) GRID_BAR();
        pg8::Gemm g{(const bf16_t*)(ws + WS_E), (const bf16_t*)(ws + WS_WOUT), DM, DM, DM};
        pg8::DenseOrder S; S.init(T / 256, DM / 256, F.G, (int)blockIdx.x);
        pg8::EpiStore E{(bf16_t*)(ws + WS_F), DM, nullptr, 0.f, nullptr, nullptr, 0, 0, 0};
        pg8::gemm_phase<pg8::EpiStore, pg8::DenseOrder>(F.lds, g, S, E);
    } SEAM(7); STAMP_END(7);
#if MK_LAST_PHASE >= 8
    STAMP_BEGIN(8);
    REP(8) if (IN(8)) { if (rep_) GRID_BAR(); p8_phase(F, args); } if (IN(8) && IN(10)) GRID_BAR(); STAMP_END(8);
    STAMP_BEGIN(10);
    REP(10) if (IN(10)) { if (rep_) GRID_BAR();
        const LAS int* tab = moe_tables(F);
        pg8::Gemm g{(const bf16_t*)(ws + WS_B), (const bf16_t*)(ws + WS_D), DM, DM, DM};
        pg8::GroupedOrder S; S.init(4, F.G, F.vcu, tab, (const int*)(ws + WS_LIST));
        pg8::EpiSwiGLU E{(bf16_t*)(ws + WS_C)};
        pg8::gemm_phase<pg8::EpiSwiGLU, pg8::GroupedOrder, true>(F.lds, g, S, E);
    } SEAM(10); STAMP_END(10);
    STAMP_BEGIN(11);
    REP(11) if (IN(11)) { if (rep_) GRID_BAR();
        const LAS int* tab = moe_tables(F);
        pg8::Gemm g{(const bf16_t*)(ws + WS_C), (const bf16_t*)(ws + WS_E), DE, DE, DE};
        pg8::GroupedOrder S; S.init(8, F.G, F.vcu, tab, nullptr);
        pg8::EpiStore E{(bf16_t*)(ws + WS_A), DM, nullptr, 0.f, nullptr, nullptr, 0, 0, 0};
        pg8::gemm_phase<pg8::EpiStore, pg8::GroupedOrder>(F.lds, g, S, E);
    } SEAM(11); STAMP_END(11);
    REP(12) if (IN(12)) { if (rep_) GRID_BAR(); p12_phase(F, args); }
#endif
#undef IN
#undef SEAM
}

extern "C" void kernel_launch(void* const* d_in, const int* in_sizes, int n_in, void* d_out, int out_size, void* d_ws, size_t ws_size, hipStream_t stream) {
    static int grid = 0;
    if (grid == 0) {
        if (n_in != 25 || out_size != T * DM || ws_size < WS_END) { fprintf(stderr, "kernel_launch: bad shapes (n_in %d out %d ws %zu)\n", n_in, out_size, ws_size); grid = -1; return; }
        int dev = 0, cus = 0, per_cu = 0;
        if (hipGetDevice(&dev) != hipSuccess || hipDeviceGetAttribute(&cus, hipDeviceAttributeMultiprocessorCount, dev) != hipSuccess) { grid = -1; return; }
        if (hipFuncSetAttribute((const void*)mk_fwd, hipFuncAttributeMaxDynamicSharedMemorySize, LDS_BYTES) != hipSuccess) { fprintf(stderr, "kernel_launch: hipFuncSetAttribute failed\n"); grid = -1; return; }
        if (hipOccupancyMaxActiveBlocksPerMultiprocessor(&per_cu, (const void*)mk_fwd, NTHR, LDS_BYTES) != hipSuccess || per_cu < 1) { fprintf(stderr, "kernel_launch: occupancy query says %d\n", per_cu); }
        (void)hipGetLastError();
        grid = cus;
    }
    if (grid < 0) return;
    (void)hipMemsetAsync((char*)d_ws + WS_CTL, 0, CTL_ZERO_BYTES, stream);
    Args a{};
    for (int i = 0; i < 25; ++i) a.in[i] = (const float*)d_in[i];
    a.out = (float*)d_out; a.ws = (unsigned char*)d_ws;
#if MK_MULTI
    for (int p = 0; p < N_PHASES; ++p) { a.ph_lo = p; a.ph_hi = p + 1; hipLaunchKernelGGL(mk_fwd, dim3(grid), dim3(NTHR), LDS_BYTES, stream, a); }
#else
    a.ph_lo = 0; a.ph_hi = N_PHASES; hipLaunchKernelGGL(mk_fwd, dim3(grid), dim3(NTHR), LDS_BYTES, stream, a);
#endif
}
```

```cpp
#include <hip/hip_runtime.h>
#include <cstdio>
#include <cstdint>

#define GAS __attribute__((address_space(1)))
#define LAS __attribute__((address_space(3)))
typedef unsigned short bf16_t;
typedef short bf16x8 __attribute__((ext_vector_type(8)));
typedef short s16x4 __attribute__((ext_vector_type(4)));
typedef float f32x4 __attribute__((ext_vector_type(4)));
typedef float f32x2 __attribute__((ext_vector_type(2)));
typedef float f32x16 __attribute__((ext_vector_type(16)));
typedef unsigned u32x4 __attribute__((ext_vector_type(4)));
typedef unsigned u32x2 __attribute__((ext_vector_type(2)));
typedef GAS unsigned gu32;
#define RLX_AGENT __ATOMIC_RELAXED, __HIP_MEMORY_SCOPE_AGENT
#define LDS_WAIT() asm volatile("s_waitcnt lgkmcnt(0)" ::: "memory")
#define VM_WAIT() asm volatile("s_waitcnt vmcnt(0)" ::: "memory")

constexpr int DM = 2048, NB = 8, SEQ = 2048, T = NB * SEQ;
constexpr int HW = 1024, HH = 8, HDK = 128, HDV = 128;
constexpr int MH = 8, MNOPE = 128, MROPE = 64, MQK = 192, MV = 128, QLORA = 512, KVLORA = 256;
constexpr int INC = 4 * HW + QLORA + KVLORA + MROPE;
constexpr int INCP = 5120;
constexpr int C_QA = 4096, C_KVA = 4608, C_KPE = 4864;
constexpr int NG = 4, EPG = 8, NE = 32, DE = 512;
constexpr int RMAX = (T * 2 / 256 + NE) * 256;
constexpr float EPS = 1e-6f;
constexpr int NWAVES = 8, NTHR = 512;

typedef __bf16 bf16x2_t __attribute__((ext_vector_type(2)));
__device__ __forceinline__ unsigned cvt_pk_bf16(float lo, float hi) { const f32x2 v = {lo, hi}; return __builtin_bit_cast(unsigned, __builtin_convertvector(v, bf16x2_t)); }
__device__ __forceinline__ float bf_lo(unsigned w) { return __builtin_bit_cast(float, w << 16); }
__device__ __forceinline__ float bf_hi(unsigned w) { return __builtin_bit_cast(float, w & 0xffff0000u); }
__device__ __forceinline__ float bf2f(bf16_t h) { return __builtin_bit_cast(float, (unsigned)h << 16); }
__device__ __forceinline__ float wave_sum(float v) {
#pragma unroll
    for (int o = 1; o < 64; o <<= 1) v += __shfl_xor(v, o);
    return v;
}
__device__ __forceinline__ float siluf(float v) { return v / (1.f + __expf(-v)); }

#define XB_TMO      128
#define XB_XCNT(j)  (256  + 64 * (j))
#define XB_XSUB(j)  (1280 + 64 * (j))
#define XB_XGEN(j)  (2304 + 64 * (j))
#define XB_TOP      3328
#define XB_TOPGEN   3392
#define XCD_BAR_WORDS 3456
#define XB_SPIN_CAP (1u << 18)

__device__ __forceinline__ unsigned xb_ld(unsigned* p)              { return __hip_atomic_load(p, __ATOMIC_RELAXED, __HIP_MEMORY_SCOPE_AGENT); }
__device__ __forceinline__ unsigned xb_add(unsigned* p, unsigned v) { return __hip_atomic_fetch_add(p, v, __ATOMIC_RELAXED, __HIP_MEMORY_SCOPE_AGENT); }
__device__ __forceinline__ unsigned xb_xcc_id() { return (unsigned)__builtin_amdgcn_s_getreg((3 << 11) | 20) & 0xFu; }
#define XB_SPIN(cond, bar) do { unsigned _sp = 0; while (cond) { __builtin_amdgcn_s_sleep(1); \
    if ((++_sp & 255u) == 0u) { if (xb_ld(&(bar)[XB_TMO])) break; if (_sp > XB_SPIN_CAP) { atomicAdd(&(bar)[XB_TMO], 1u); break; } } } } while (0)

struct XcdBarrier {
    unsigned* bar; unsigned x;
    volatile LAS unsigned* st;
};
__device__ __forceinline__ XcdBarrier xcd_barrier_post(unsigned* bar, volatile LAS unsigned* st) {
    XcdBarrier b; b.bar = bar; b.x = xb_xcc_id(); b.st = st;
    if (threadIdx.x == 0) (void)xb_add(&bar[XB_XCNT(b.x)], 1u);
    return b;
}
__device__ __forceinline__ void xcd_barrier_complete(unsigned* bar, unsigned x, unsigned& nloc, unsigned& nx) {
    const unsigned G = gridDim.x * gridDim.y * gridDim.z;
    unsigned sum, cnt, mine, sp = 0u;
    for (;;) {
        sum = 0u; cnt = 0u; mine = 0u;
#pragma unroll
        for (unsigned j = 0; j < 16; ++j) { const unsigned c = xb_ld(&bar[XB_XCNT(j)]); sum += c; cnt += (c > 0u) ? 1u : 0u; mine = (j == x) ? c : mine; }
        if (sum == G) break;
        __builtin_amdgcn_s_sleep(1);
        if ((++sp & 255u) == 0u) { if (xb_ld(&bar[XB_TMO])) break; if (sp > XB_SPIN_CAP) { atomicAdd(&bar[XB_TMO], 1u); break; } }
    }
    nloc = mine > 0u ? mine : 1u; nx = cnt > 0u ? cnt : 1u;
}
__device__ __forceinline__ void xcd_barrier(const XcdBarrier& b) {
    asm volatile("s_waitcnt vmcnt(0)" ::: "memory");
    __syncthreads();
    if (threadIdx.x == 0) {
        unsigned* bar = b.bar;
        __builtin_amdgcn_s_waitcnt(0);
        unsigned nloc = b.st[0], nx = b.st[1];
        if (nloc == 0u) { xcd_barrier_complete(bar, b.x, nloc, nx); b.st[0] = nloc; b.st[1] = nx; }
        const unsigned old = xb_add(&bar[XB_XSUB(b.x)], 1u);
        const unsigned gen = old / nloc;
        if (old + 1u == (gen + 1u) * nloc) {
            __builtin_amdgcn_fence(__ATOMIC_RELEASE, "agent");
            asm volatile("s_waitcnt vmcnt(0)" ::: "memory");
            const unsigned og = xb_add(&bar[XB_TOP], 1u);
            const unsigned tg = og / nx;
            if (og + 1u == (tg + 1u) * nx) xb_add(&bar[XB_TOPGEN], 1u);
            else XB_SPIN(xb_ld(&bar[XB_TOPGEN]) == tg, bar);
            __builtin_amdgcn_fence(__ATOMIC_ACQUIRE, "agent");
            xb_add(&bar[XB_XGEN(b.x)], 1u);
            asm volatile("s_waitcnt vmcnt(0)" ::: "memory");
        } else {
            XB_SPIN(xb_ld(&bar[XB_XGEN(b.x)]) == gen, bar);
            __builtin_amdgcn_fence(__ATOMIC_ACQUIRE, "agent");
            asm volatile("s_waitcnt vmcnt(0)" ::: "memory");
        }
    }
    __syncthreads();
}

namespace pg8 {
constexpr int BM = 256, BK = 64, HALF = 128, HTB = HALF * BK * 2, STAGE_BYTES = 8 * HTB, NXCD = 8, WGM = 8;
__host__ __device__ __forceinline__ int lds_byte(int r, int c) { const int st = (r >> 4) * 2 + (c >> 5), rr = r & 15, cc = c & 31, ob = rr * 64 + cc * 2; return st * 1024 + (ob ^ (((ob >> 9) & 1) << 5)); }
__host__ __device__ __forceinline__ void stage_rc(int b, int& R, int& C) { const int st = b / 1024, sb = b % 1024, swz = sb ^ (((sb >> 9) & 1) << 5); R = (st >> 1) * 16 + swz / 64; C = (st & 1) * 32 + (swz % 64) / 2; }
__host__ __device__ __forceinline__ int perm32(int rho) { const int n = rho >> 4, i = rho & 15; return 8 * (i >> 2) + 4 * n + (i & 3); }

struct Unit { int pm, pn, pb; };
struct Gemm { const bf16_t* A; const bf16_t* Bt; int lda, ldb, K; };

struct DenseOrder {
    int nM, nN, nwg, G, c;
    __device__ void init(int nM_, int nN_, int G_, int c_) { nM = nM_; nN = nN_; nwg = nM * nN; G = G_; c = c_; }
    __device__ bool next(int i, Unit& u) const {
        const long L = (long)i * G + c; if (L >= nwg) return false;
        int wgid = (int)L; { const int q = nwg / NXCD, r = nwg % NXCD, xcd = wgid % NXCD, off = wgid / NXCD; wgid = (xcd < r ? xcd * (q + 1) : r * (q + 1) + (xcd - r) * q) + off; }
        const int nig = WGM * nN, gid = wgid / nig, fm = gid * WGM, gsz = (nM - fm) < WGM ? (nM - fm) : WGM;
        u.pm = fm + ((wgid % nig) % gsz); u.pn = (wgid % nig) / gsz; u.pb = u.pn; return true;
    }
};
struct GroupedOrder {
    int nM, nN, nwg, G, c; const LAS int* tile_e; const LAS int* pstart; const LAS int* cnt; const int* list;
    __device__ void init(int nN_, int G_, int c_, const LAS int* tab, const int* list_) { pstart = tab; cnt = tab + 64; tile_e = tab + 128; list = list_; nM = pstart[32] >> 8; nN = nN_; nwg = nM * nN; G = G_; c = c_; }
    __device__ bool next(int i, Unit& u) const {
        const long L = (long)i * G + c; if (L >= nwg) return false;
        const int w = (int)L; u.pn = w % nN; u.pm = w / nN; u.pb = tile_e[u.pm] * nN + u.pn; return true;
    }
    __device__ int arow(const Unit& u, int r) const { const int e = tile_e[u.pm], j = 256 * u.pm - pstart[e] + r; return j < cnt[e] ? list[e * T + j] : 0; }
};

template <class Epi, class Sched, bool GATHER = false>
__device__ __forceinline__ void gemm_phase(LAS unsigned char* lds, const Gemm g, const Sched& S, const Epi& E) {
    int tid = threadIdx.x; asm volatile("" : "+v"(tid));
    const int wid = __builtin_amdgcn_readfirstlane(tid >> 6), lane = tid & 63, wr = wid >> 2, wc = wid & 3, fr = lane & 15, fq = lane >> 4;
    const int K = g.K, nt = K / BK;
    unsigned voffA[2], voffB[2]; int gR[2], gC[2];
#pragma unroll
    for (int i = 0; i < 2; ++i) { int R, C; stage_rc(tid * 16 + i * 8192, R, C); const int Rb = (R & ~31) + perm32(R & 31); gR[i] = R; gC[i] = C;
        voffA[i] = (unsigned)(R * g.lda + C) * 2u; voffB[i] = (unsigned)(Rb * g.ldb + C) * 2u; }
    const size_t kstep = (size_t)(BK * 2);
    const size_t hsA = (size_t)HALF * g.lda * 2, hsB = (size_t)HALF * g.ldb * 2;
    const unsigned ldsw = (unsigned)wid * 1024u;
    const int aoff = lds_byte(wr * 64 + fr, fq * 8), boff = lds_byte(wc * 32 + fr, fq * 8);
#define PG8_SA(b, h) (((b) * 2 + (h)) * HTB)
#define PG8_SB(b, h) ((4 + (b) * 2 + (h)) * HTB)
#define PG8_STAGE(bufoff, gbase, voff) do { _Pragma("unroll") for (int _i = 0; _i < 2; ++_i) \
        __builtin_amdgcn_global_load_lds((const unsigned*)((const char*)(gbase) + (voff)[_i]), (LAS unsigned*)(lds + (bufoff) + ldsw + _i * 8192), 16, 0, 0); } while (0)
#define PG8_STAGE_A(bufoff, dense_ptr, kbytes, offs) do { if constexpr (GATHER) { PG8_STAGE(bufoff, (const char*)g.A + (kbytes), offs); } else { PG8_STAGE(bufoff, dense_ptr, voffA); } } while (0)
#define PG8_GOFF(u, o0, o1) do { _Pragma("unroll") for (int _i = 0; _i < 2; ++_i) { o0[_i] = (unsigned)(S.arow(u, gR[_i]) * g.lda + gC[_i]) * 2u; o1[_i] = (unsigned)(S.arow(u, gR[_i] + HALF) * g.lda + gC[_i]) * 2u; } } while (0)
#define PG8_LDA(dst, b, h) do { _Pragma("unroll") for (int m = 0; m < 4; ++m) _Pragma("unroll") for (int k = 0; k < 2; ++k) dst[m][k] = *(const LAS bf16x8*)(lds + PG8_SA(b, h) + aoff + m * 2048 + k * 1024); } while (0)
#define PG8_LDB(dst, b, h) do { _Pragma("unroll") for (int n = 0; n < 2; ++n) _Pragma("unroll") for (int k = 0; k < 2; ++k) dst[n][k] = *(const LAS bf16x8*)(lds + PG8_SB(b, h) + boff + n * 2048 + k * 1024); } while (0)
#define PG8_MMA(ai, bj, At, Bt) do { __builtin_amdgcn_s_setprio(1); _Pragma("unroll") for (int m = 0; m < 4; ++m) _Pragma("unroll") for (int n = 0; n < 2; ++n) _Pragma("unroll") for (int k = 0; k < 2; ++k) \
        acc[ai][bj][m][n] = __builtin_amdgcn_mfma_f32_16x16x32_bf16(Bt[n][k], At[m][k], acc[ai][bj][m][n], 0, 0, 0); __builtin_amdgcn_s_setprio(0); } while (0)
#define PG8_WAIT_V(n) asm volatile("s_waitcnt vmcnt(" #n ")" ::: "memory")
#define PG8_WAIT_L(n) asm volatile("s_waitcnt lgkmcnt(" #n ")" ::: "memory")
#define PG8_BAR __builtin_amdgcn_s_barrier()
#define PG8_SCHED __builtin_amdgcn_sched_barrier(0)
    Unit cur, nxt; int ui = 0;
    if (!S.next(0, cur)) return;
    unsigned cO0[2] = {0u, 0u}, cO1[2] = {0u, 0u}, nO0[2] = {0u, 0u}, nO1[2] = {0u, 0u};
    if constexpr (GATHER) { PG8_GOFF(cur, cO0, cO1); }
    f32x4 acc[2][2][4][2];
#pragma unroll
    for (int a = 0; a < 2; ++a)
#pragma unroll
        for (int b = 0; b < 2; ++b)
#pragma unroll
            for (int m = 0; m < 4; ++m)
#pragma unroll
                for (int n = 0; n < 2; ++n) acc[a][b][m][n] = (f32x4){0.f, 0.f, 0.f, 0.f};
    bf16x8 At[4][2], B0[2][2], B1[2][2];
    const char* cA = (const char*)g.A + (GATHER ? (size_t)0 : (size_t)cur.pm * 2 * hsA); const char* cB = (const char*)g.Bt + (size_t)cur.pb * 2 * hsB;
    PG8_STAGE(PG8_SB(0, 0), cB, voffB); PG8_STAGE(PG8_SB(0, 1), cB + hsB, voffB); PG8_STAGE_A(PG8_SA(0, 0), cA, 0, cO0); PG8_STAGE_A(PG8_SA(0, 1), cA + hsA, 0, cO1);
    if (wr == 1) PG8_BAR;
    PG8_WAIT_V(2); PG8_BAR;
    PG8_STAGE(PG8_SB(1, 0), cB + kstep, voffB); PG8_STAGE_A(PG8_SA(1, 0), cA + kstep, kstep, cO0); PG8_STAGE(PG8_SB(1, 1), cB + hsB + kstep, voffB);
    PG8_WAIT_V(6); PG8_BAR;
    for (;;) {
        const bool has_next = S.next(ui + 1, nxt);
        const char* nA = (has_next && !GATHER) ? (const char*)g.A + (size_t)nxt.pm * 2 * hsA : cA; const char* nB = has_next ? (const char*)g.Bt + (size_t)nxt.pb * 2 * hsB : cB;
        if constexpr (GATHER) { if (has_next) { PG8_GOFF(nxt, nO0, nO1); } else { nO0[0] = cO0[0]; nO0[1] = cO0[1]; nO1[0] = cO1[0]; nO1[1] = cO1[1]; } }
        for (int t = 0; t < nt; t += 2) {
            const bool last = (t == nt - 2);
            const char* a1 = cA + (size_t)(t + 1) * kstep;
            const char* a2 = last ? nA : cA + (size_t)(t + 2) * kstep; const char* b2 = last ? nB : cB + (size_t)(t + 2) * kstep;
            const char* a3 = a2 + kstep; const char* b3 = b2 + kstep;
            const size_t k2 = last ? (size_t)0 : (size_t)(t + 2) * kstep;
            unsigned o0[2], o1[2]; o0[0] = last ? nO0[0] : cO0[0]; o0[1] = last ? nO0[1] : cO0[1]; o1[0] = last ? nO1[0] : cO1[0]; o1[1] = last ? nO1[1] : cO1[1];
            PG8_LDB(B0, 0, 0); PG8_LDB(B1, 0, 1); PG8_SCHED; PG8_LDA(At, 0, 0); PG8_STAGE_A(PG8_SA(1, 1), a1 + hsA, (size_t)(t + 1) * kstep, cO1);
            PG8_WAIT_V(8); PG8_WAIT_L(0); PG8_BAR; PG8_MMA(0, 0, At, B0); PG8_MMA(0, 1, At, B1); PG8_BAR; PG8_SCHED;
            PG8_LDA(At, 0, 1); PG8_STAGE(PG8_SB(0, 0), b2, voffB); PG8_STAGE(PG8_SB(0, 1), b2 + hsB, voffB); PG8_STAGE_A(PG8_SA(0, 0), a2, k2, o0);
            PG8_WAIT_V(8); PG8_WAIT_L(0); PG8_BAR; PG8_MMA(1, 0, At, B0); PG8_MMA(1, 1, At, B1); PG8_BAR; PG8_SCHED;
            PG8_LDB(B0, 1, 0); PG8_LDB(B1, 1, 1); PG8_SCHED; PG8_LDA(At, 1, 0); PG8_STAGE_A(PG8_SA(0, 1), a2 + hsA, k2, o1);
            PG8_WAIT_V(8); PG8_WAIT_L(0); PG8_BAR; PG8_MMA(0, 0, At, B0); PG8_MMA(0, 1, At, B1); PG8_BAR; PG8_SCHED;
            PG8_LDA(At, 1, 1); PG8_STAGE(PG8_SB(1, 0), b3, voffB); PG8_STAGE(PG8_SB(1, 1), b3 + hsB, voffB); PG8_STAGE_A(PG8_SA(1, 0), a3, k2 + kstep, o0);
            PG8_WAIT_V(8); PG8_WAIT_L(0); PG8_BAR; PG8_MMA(1, 0, At, B0); PG8_MMA(1, 1, At, B1); PG8_BAR; PG8_SCHED;
        }
        if (wr == 0) PG8_BAR;
        E(acc, cur, wr, wc, fr, fq);
        if (!has_next) break;
#pragma unroll
        for (int a = 0; a < 2; ++a)
#pragma unroll
            for (int b = 0; b < 2; ++b)
#pragma unroll
                for (int m = 0; m < 4; ++m)
#pragma unroll
                    for (int n = 0; n < 2; ++n) acc[a][b][m][n] = (f32x4){0.f, 0.f, 0.f, 0.f};
        cur = nxt; cA = nA; cB = nB; ++ui;
        if constexpr (GATHER) { cO0[0] = nO0[0]; cO0[1] = nO0[1]; cO1[0] = nO1[0]; cO1[1] = nO1[1]; }
        if (wr == 1) PG8_BAR;
    }
    PG8_WAIT_V(0);
    PG8_BAR;
#undef PG8_SA
#undef PG8_SB
#undef PG8_STAGE
#undef PG8_STAGE_A
#undef PG8_GOFF
#undef PG8_LDA
#undef PG8_LDB
#undef PG8_MMA
#undef PG8_WAIT_V
#undef PG8_WAIT_L
#undef PG8_BAR
#undef PG8_SCHED
}

struct EpiStore {
    bf16_t* O; int ldc; const float* ssq; float inv; float* ssq_out0; float* ssq_out1; int pn0, pn1, pn2;
    __device__ __forceinline__ void operator()(const f32x4 (&acc)[2][2][4][2], const Unit& u, int wr, int wc, int fr, int fq) const {
        const int row0 = u.pm * BM + wr * 64 + fr, col0 = u.pn * BM + wc * 32 + 8 * fq;
        float* so = (ssq_out0 && u.pn >= pn0 && u.pn < pn2) ? (u.pn < pn1 ? ssq_out0 : ssq_out1) : nullptr;
#pragma unroll
        for (int ai = 0; ai < 2; ++ai)
#pragma unroll
            for (int m = 0; m < 4; ++m) { const int row = row0 + ai * HALF + m * 16; const float rs = ssq ? rsqrtf(ssq[row] * inv + EPS) : 1.f;
                bf16_t* rowp = O + (size_t)row * ldc + col0; float ss = 0.f;
#pragma unroll
                for (int bj = 0; bj < 2; ++bj) { const f32x4 v0 = acc[ai][bj][m][0] * rs, v1 = acc[ai][bj][m][1] * rs;
                    ss += (v0[0] * v0[0] + v0[1] * v0[1]) + (v0[2] * v0[2] + v0[3] * v0[3]) + (v1[0] * v1[0] + v1[1] * v1[1]) + (v1[2] * v1[2] + v1[3] * v1[3]);
                    u32x4 w; w.x = cvt_pk_bf16(v0[0], v0[1]); w.y = cvt_pk_bf16(v0[2], v0[3]); w.z = cvt_pk_bf16(v1[0], v1[1]); w.w = cvt_pk_bf16(v1[2], v1[3]);
                    *(u32x4*)(rowp + bj * HALF) = w; }
                if (so) { ss += __shfl_xor(ss, 16); ss += __shfl_xor(ss, 32); if (fq == 0) atomicAdd(so + row, ss); } }
    }
};
struct EpiResid {
    const float* X; float* O; const float* gate; int gpitch;
    __device__ __forceinline__ void operator()(const f32x4 (&acc)[2][2][4][2], const Unit& u, int wr, int wc, int fr, int fq) const {
        const int row0 = u.pm * BM + wr * 64 + fr, col0 = u.pn * BM + wc * 32 + 8 * fq;
        const float* gp = gate + (size_t)((u.pm * BM) / SEQ) * gpitch + col0;
        f32x4 gv[2][2];
#pragma unroll
        for (int bj = 0; bj < 2; ++bj)
#pragma unroll
            for (int n = 0; n < 2; ++n) gv[bj][n] = *(const f32x4*)(gp + bj * HALF + 4 * n);
#pragma unroll
        for (int ai = 0; ai < 2; ++ai)
#pragma unroll
            for (int m = 0; m < 4; ++m) { const size_t off = (size_t)(row0 + ai * HALF + m * 16) * DM + col0;
#pragma unroll
                for (int bj = 0; bj < 2; ++bj)
#pragma unroll
                    for (int n = 0; n < 2; ++n) { const f32x4 xv = *(const f32x4*)(X + off + bj * HALF + 4 * n);
                        *(f32x4*)(O + off + bj * HALF + 4 * n) = xv + gv[bj][n] * acc[ai][bj][m][n]; } }
    }
};
struct EpiSwiGLU {
    bf16_t* O;
    __device__ __forceinline__ void operator()(const f32x4 (&acc)[2][2][4][2], const Unit& u, int wr, int wc, int fr, int fq) const {
        const int row0 = u.pm * BM + wr * 64 + fr, col0 = u.pn * HALF + wc * 32 + 8 * fq;
#pragma unroll
        for (int ai = 0; ai < 2; ++ai)
#pragma unroll
            for (int m = 0; m < 4; ++m) { const int row = row0 + ai * HALF + m * 16;
                float h[8];
#pragma unroll
                for (int n = 0; n < 2; ++n)
#pragma unroll
                    for (int j = 0; j < 4; ++j) { const float gt = acc[ai][0][m][n][j], up = acc[ai][1][m][n][j]; h[4 * n + j] = gt / (1.f + __expf(-gt)) * up; }
                u32x4 w; w.x = cvt_pk_bf16(h[0], h[1]); w.y = cvt_pk_bf16(h[2], h[3]); w.z = cvt_pk_bf16(h[4], h[5]); w.w = cvt_pk_bf16(h[6], h[7]);
                *(u32x4*)(O + (size_t)row * DE + col0) = w; }
    }
};
}
constexpr size_t MiB = 1u << 20;
constexpr size_t WS_CTL = 0, CTL_ZERO_BYTES = 1 * MiB;
constexpr size_t WS_MOD = 1 * MiB;
constexpr size_t WS_ROPEC = 1 * MiB + 512 * 1024;
constexpr size_t WS_ROPES = WS_ROPEC + 2 * MiB;
constexpr size_t WS_WCT = WS_ROPES + 2 * MiB;
constexpr size_t WS_RSTDQ = 6 * MiB;
constexpr size_t WS_RSTDKV = WS_RSTDQ + 64 * 1024;
constexpr size_t WS_TOKE = WS_RSTDKV + 64 * 1024;
constexpr size_t WS_TOKW = WS_TOKE + 128 * 1024;
constexpr size_t WS_TOKS = WS_TOKW + 128 * 1024;
constexpr size_t WS_BLKE = WS_TOKS + 128 * 1024;
constexpr size_t WS_STAMP = WS_BLKE + 4096;
constexpr size_t WS_WIN = 8 * MiB;
constexpr size_t WS_WQUP = 28 * MiB;
constexpr size_t WS_WKVUP = WS_WQUP + 1536 * 1024;
constexpr size_t WS_WOUT = 31 * MiB;
constexpr size_t WS_A = 40 * MiB;
constexpr size_t WS_B = 200 * MiB;
constexpr size_t WS_C = 264 * MiB;
constexpr size_t WS_D = 328 * MiB;
constexpr size_t WS_E = 456 * MiB;
constexpr size_t WS_LIST = 520 * MiB;
constexpr size_t WS_F = 522 * MiB;
constexpr size_t WS_END = 586 * MiB;
constexpr size_t QN_BYTES = (size_t)T * MH * MQK * 2;

constexpr int CW_BAR = 4096;
constexpr int CW_CNT = 8192;

constexpr int RING_BYTES = 131072, LDS_BYTES = 147456, LDS_USER = 143360, MISC_OFF = LDS_BYTES - 512;

struct Args { const float* in[25]; float* out; unsigned char* ws; int ph_lo, ph_hi, pad0, pad1; };

struct Frame {
    LAS unsigned char* lds;
    volatile LAS unsigned* MISC;
    gu32* ctl;
    int tid, lane, wave, vcu, G;
    unsigned char* ws; float* out;
};

#define OPAQUE_FRAME(F) do { F.tid = threadIdx.x; asm volatile("" : "+v"(F.tid)); F.lane = F.tid & 63; } while (0)

__device__ __forceinline__ void unpack8(const u32x4 w, float* f) { f[0] = bf_lo(w.x); f[1] = bf_hi(w.x); f[2] = bf_lo(w.y); f[3] = bf_hi(w.y); f[4] = bf_lo(w.z); f[5] = bf_hi(w.z); f[6] = bf_lo(w.w); f[7] = bf_hi(w.w); }
__device__ __forceinline__ u32x4 pack8f(const float* f) { u32x4 w; w.x = cvt_pk_bf16(f[0], f[1]); w.y = cvt_pk_bf16(f[2], f[3]); w.z = cvt_pk_bf16(f[4], f[5]); w.w = cvt_pk_bf16(f[6], f[7]); return w; }

struct TrItem { const float* src; bf16_t* dst; bf16_t* dst2; const float* gk; int N, ldt; };
__device__ __forceinline__ void tr_load(const TrItem& it, f32x4 (&r)[16], int lane) {
    const float* p = it.src + (size_t)(lane >> 4) * it.N + 4 * (lane & 15);
#pragma unroll
    for (int i = 0; i < 16; ++i) r[i] = __builtin_nontemporal_load((const f32x4*)(p + (size_t)(4 * i) * it.N));
}
__device__ __forceinline__ void tr_store(const TrItem& it, const f32x4 (&r)[16], LAS unsigned char* Tl, int lane) {
    const int row = lane >> 4, c4 = lane & 15;
#pragma unroll
    for (int i = 0; i < 16; ++i) { f32x4 v = r[i]; if (it.gk) v = v * it.gk[4 * i + row];
        u32x2 w; w.x = cvt_pk_bf16(v.x, v.y); w.y = cvt_pk_bf16(v.z, v.w);
        *(LAS u32x2*)(Tl + ((4 * i + row) * 64 + 4 * c4) * 2) = w; }
    LDS_WAIT(); asm volatile("" ::: "memory");
    const int g = lane >> 4, i16 = lane & 15, q = i16 >> 2, pp = lane & 3;
    typedef short v4i16_t __attribute__((ext_vector_type(4)));
#pragma unroll
    for (int hh = 0; hh < 2; ++hh) { bf16_t* drow = (hh ? it.dst2 : it.dst) + (size_t)(16 * (g & 1) + i16) * it.ldt;
#pragma unroll
        for (int j = 0; j < 4; ++j) { const int kc = 4 * (g >> 1) + j;
            const v4i16_t lo = __builtin_amdgcn_ds_read_tr16_b64_v4i16((LAS v4i16_t*)(Tl + ((8 * kc + q) * 64 + 32 * hh + 16 * (g & 1) + 4 * pp) * 2));
            const v4i16_t hi = __builtin_amdgcn_ds_read_tr16_b64_v4i16((LAS v4i16_t*)(Tl + ((8 * kc + 4 + q) * 64 + 32 * hh + 16 * (g & 1) + 4 * pp) * 2));
            const bf16x8 o = {lo[0], lo[1], lo[2], lo[3], hi[0], hi[1], hi[2], hi[3]};
            *(bf16x8*)(drow + 8 * kc) = o; } }
    LDS_WAIT(); asm volatile("" ::: "memory");
}
template <class MK> __device__ __forceinline__ void tr_run(int first, int step, int n, const MK& mk, LAS unsigned char* Tl, int lane) {
    if (first >= n) return;
    f32x4 ra[16], rb[16];
    TrItem ia = mk(first), ib = ia;
    tr_load(ia, ra, lane);
    for (int idx = first; idx < n; idx += 2 * step) {
        if (idx + step < n) { ib = mk(idx + step); tr_load(ib, rb, lane); }
        tr_store(ia, ra, Tl, lane);
        if (idx + step >= n) break;
        if (idx + 2 * step < n) { ia = mk(idx + 2 * step); tr_load(ia, ra, lane); }
        tr_store(ib, rb, Tl, lane);
    }
}

__device__ __forceinline__ void adaln_phase(Frame& F, const float* c, const float* w_ada, const float* b_ada, float* mod) {
    LAS float* cact = (LAS float*)F.lds;
    LAS float* part = (LAS float*)(F.lds + 65536);
    for (int i = F.tid; i < NB * DM; i += NTHR) cact[i] = siluf(c[i]);
    __syncthreads();
    const int cg = F.tid & 7, rs = F.tid >> 3;
    for (int it = blockIdx.x; it < 6 * DM / 32; it += F.G) {
        const int n0 = it * 32 + cg * 4;
        f32x4 acc[8];
#pragma unroll
        for (int b = 0; b < 8; ++b) acc[b] = (f32x4){0.f, 0.f, 0.f, 0.f};
#pragma unroll 1
        for (int i0 = 0; i0 < 32; i0 += 16) { f32x4 w[16];
#pragma unroll
            for (int u = 0; u < 16; ++u) w[u] = __builtin_nontemporal_load((const f32x4*)(w_ada + (size_t)(rs + 64 * (i0 + u)) * (6 * DM) + n0));
#pragma unroll
            for (int u = 0; u < 16; ++u) { const int k = rs + 64 * (i0 + u);
#pragma unroll
                for (int b = 0; b < 8; ++b) acc[b] += w[u] * cact[b * DM + k]; } }
#pragma unroll
        for (int b = 0; b < 8; ++b) *(LAS f32x4*)(part + (rs * 8 + b) * 32 + cg * 4) = acc[b];
        __syncthreads();
        if (F.tid < 256) { const int b = F.tid >> 5, n = F.tid & 31; float s = 0.f;
#pragma unroll 8
            for (int r = 0; r < 64; ++r) s += part[(r * 8 + b) * 32 + n];
            mod[b * (6 * DM) + it * 32 + n] = s + b_ada[it * 32 + n]; }
        __syncthreads();
    }
}

__device__ __forceinline__ void p0_phase(Frame& F, const Args& a) {
    OPAQUE_FRAME(F);
    unsigned char* ws = F.ws;
    adaln_phase(F, a.in[1], a.in[3], a.in[4], (float*)(ws + WS_MOD));
    __syncthreads();
    LAS unsigned char* Tl = F.lds + F.wave * 8192;
    const int gw = F.vcu * NWAVES + F.wave, NGW = F.G * NWAVES;
    constexpr int I_IN = (DM / 64) * (INC / 64), I_QUP = (QLORA / 64) * (MH * MQK / 64), I_KVUP = (KVLORA / 64) * (MH * 256 / 64), I_OUT = (DM / 64) * (DM / 64);
    constexpr int NITEMS = I_IN + I_QUP + I_KVUP + I_OUT;
    static_assert(INC % 64 == 0, "64-column transpose items");
    { const float* w_in = a.in[6]; const float* w_qup = a.in[10]; const float* w_kvup = a.in[12]; const float* w_out = a.in[16]; const float* gq = a.in[9]; const float* gkv = a.in[11];
      auto mk = [=](int r) -> TrItem { TrItem t;
          if (r < I_IN) { const int nblk = INC / 64, kb = r / nblk, nb = r % nblk; t.src = w_in + (size_t)(64 * kb) * INC + 64 * nb; t.dst = (bf16_t*)(ws + WS_WIN) + (size_t)(64 * nb) * DM + 64 * kb; t.dst2 = t.dst + (size_t)32 * DM; t.gk = nullptr; t.N = INC; t.ldt = DM; return t; } r -= I_IN;
          if (r < I_QUP) { const int nblk = MH * MQK / 64, kb = r / nblk, nb = r % nblk; t.src = w_qup + (size_t)(64 * kb) * (MH * MQK) + 64 * nb; t.dst = (bf16_t*)(ws + WS_WQUP) + (size_t)(64 * nb) * QLORA + 64 * kb; t.dst2 = t.dst + (size_t)32 * QLORA; t.gk = gq + 64 * kb; t.N = MH * MQK; t.ldt = QLORA; return t; } r -= I_QUP;
          if (r < I_KVUP) { const int nblk = MH * 256 / 64, kb = r / nblk, nb = r % nblk; t.src = w_kvup + (size_t)(64 * kb) * (MH * 256) + 64 * nb; t.dst = (bf16_t*)(ws + WS_WKVUP) + (size_t)(64 * nb) * KVLORA + 64 * kb; t.dst2 = t.dst + (size_t)32 * KVLORA; t.gk = gkv + 64 * kb; t.N = MH * 256; t.ldt = KVLORA; return t; } r -= I_KVUP;
          { const int nblk = DM / 64, kb = r / nblk, nb = r % nblk; t.src = w_out + (size_t)(64 * kb) * DM + 64 * nb; t.dst = (bf16_t*)(ws + WS_WOUT) + (size_t)(64 * nb) * DM + 64 * kb; t.dst2 = t.dst + (size_t)32 * DM; t.gk = nullptr; t.N = DM; t.ldt = DM; return t; } };
      tr_run(gw, NGW, NITEMS, mk, Tl, F.lane); }
    { const int* pos = (const int*)a.in[2]; float* rc = (float*)(ws + WS_ROPEC); float* rsn = (float*)(ws + WS_ROPES);
      const int gt = F.vcu * NTHR + F.tid, NGT = F.G * NTHR;
      const float invf = (float)exp2(-(double)(gt & 31) * (13.287712379549449 / 32.0));
      for (int e = gt; e < T * 32; e += NGT) { const int tk = e >> 5;
          const float ang = (float)pos[tk] * invf; float sv, cv; sincosf(ang, &sv, &cv);
          rc[e] = cv; rsn[e] = sv; }
      { float* ssq = (float*)(ws + WS_RSTDQ); for (int e = gt; e < 2 * T; e += NGT) ssq[e] = 0.f; }
      float* wct = (float*)(ws + WS_WCT);
      for (int e = gt; e < 48 * DM; e += NGT) { const int n = e / DM, k = e % DM;
          wct[e] = n < 4 ? a.in[18][k * NG + n] : (n < 36 ? a.in[20][k * NE + (n - 4)] : 0.f); } }
}

__device__ __forceinline__ void modnorm_row(const float* xrow, const float* g, const float* shift, const float* scale, bf16_t* orow, int lane) {
    const f32x4* xr = (const f32x4*)xrow + lane;
    f32x4 v[8]; float s = 0.f;
#pragma unroll
    for (int j = 0; j < 8; ++j) { v[j] = __builtin_nontemporal_load(xr + 64 * j); s += (v[j].x * v[j].x + v[j].y * v[j].y) + (v[j].z * v[j].z + v[j].w * v[j].w); }
    const float rstd = rsqrtf(wave_sum(s) * (1.f / DM) + EPS);
    u32x2* o8 = (u32x2*)orow + lane;
#pragma unroll
    for (int j = 0; j < 8; ++j) { const f32x4 gg = ((const f32x4*)g)[64 * j + lane], sh = ((const f32x4*)shift)[64 * j + lane], sc = ((const f32x4*)scale)[64 * j + lane];
        const f32x4 h = v[j] * rstd * gg * (sc + 1.f) + sh;
        u32x2 w; w.x = cvt_pk_bf16(h.x, h.y); w.y = cvt_pk_bf16(h.z, h.w); o8[64 * j] = w; }
}
__device__ __forceinline__ void p1_phase(Frame& F, const Args& a) {
    OPAQUE_FRAME(F);
    const int gw = F.vcu * NWAVES + F.wave, NGW = F.G * NWAVES;
    const float* mod = (const float*)(F.ws + WS_MOD);
    bf16_t* H = (bf16_t*)(F.ws + WS_B);
    for (int m = gw; m < T; m += NGW) { const int b = m / SEQ;
        modnorm_row(a.in[0] + (size_t)m * DM, a.in[5], mod + b * (6 * DM), mod + b * (6 * DM) + DM, H + (size_t)m * DM, F.lane); }
}

template <int CTRL> __device__ __forceinline__ float dppf(float x) { return __builtin_bit_cast(float, __builtin_amdgcn_update_dpp(0, __builtin_bit_cast(int, x), CTRL, 0xF, 0xF, true)); }

namespace hg {
constexpr int OFF_F = 0, OFF_SEG = 32768, OFF_QIN = 34816, RP = 272, OFF_KIN = OFF_QIN + 64 * RP, OFF_QB = OFF_KIN + 64 * RP, OFF_KLT = OFF_QB + 64 * RP, SP = 144,
              OFF_VT = OFF_KLT + 128 * SP  , OFF_DEC = OFF_VT + 64 * SP  , OFF_SF = OFF_DEC + 3584  , HG_LDS = OFF_SF + 16384;
static_assert(HG_LDS <= LDS_USER, "hgrn lds");
__device__ __forceinline__ int ppos(int s) { return (s & ~15) | ((s & 4) << 1) | ((s & 8) >> 1) | (s & 3); }
}
__device__ __forceinline__ void hgrn_chunked(Frame& F, const Args& a, int item) {
    using namespace hg;
    const bf16_t* PROJ = (const bf16_t*)(F.ws + WS_A);
    bf16_t* MIX = (bf16_t*)(F.ws + WS_E);
    const float* lbl = a.in[7];
    LAS unsigned char* L = F.lds;
    LAS float* Fs = (LAS float*)(L + OFF_F); LAS float* SEGs = (LAS float*)(L + OFF_SEG); LAS float* DEC = (LAS float*)(L + OFF_DEC); LAS float* POST = DEC + 384;
    const int g = F.tid & 15, t0 = F.tid >> 4;
    const int sk = F.tid & 127, sseg = F.tid >> 7;
    const int r32 = F.lane & 31, hi = F.lane >> 5;
    {
        const int dq2 = (item >> 3) & 1, bh = (item >> 4) * 8 + (item & 7), h = bh & 7, b = bh >> 3;
        float lb[8];
#pragma unroll
        for (int j = 0; j < 8; ++j) { const int k = h * 128 + g * 8 + j; lb[j] = 1.f / (1.f + __expf(lbl[HW + k] - lbl[k])); }
        const bf16_t* base = PROJ + (size_t)(b * SEQ) * INCP + h * 128;
        f32x16 S0 = {}, S1 = {};
        u32x4 gq[2], gf[2], gv;
#define HG_LOADF(c) do { _Pragma("unroll") for (int i = 0; i < 2; ++i) gf[i] = *(const u32x4*)(base + (size_t)((c) * 64 + t0 + 32 * i) * INCP + g * 8 + HW); } while (0)
#define HG_LOADQ(c) do { _Pragma("unroll") for (int i = 0; i < 2; ++i) gq[i] = *(const u32x4*)(base + (size_t)((c) * 64 + t0 + 32 * i) * INCP + g * 8); \
            gv = *(const u32x4*)(base + (size_t)((c) * 64 + (F.tid >> 3)) * INCP + 2 * HW + dq2 * 64 + (F.tid & 7) * 8); } while (0)
        HG_LOADF(0); HG_LOADQ(0);
        for (int c = 0; c < SEQ / 64; ++c) {
            if (F.wave >= 4) { const int kb = F.wave - 4;
#pragma unroll
                for (int s2 = 0; s2 < 2; ++s2) { u32x4 w0, w1;
                    w0.x = cvt_pk_bf16(S0[8 * s2], S0[8 * s2 + 1]); w0.y = cvt_pk_bf16(S0[8 * s2 + 2], S0[8 * s2 + 3]); w0.z = cvt_pk_bf16(S0[8 * s2 + 4], S0[8 * s2 + 5]); w0.w = cvt_pk_bf16(S0[8 * s2 + 6], S0[8 * s2 + 7]);
                    w1.x = cvt_pk_bf16(S1[8 * s2], S1[8 * s2 + 1]); w1.y = cvt_pk_bf16(S1[8 * s2 + 2], S1[8 * s2 + 3]); w1.z = cvt_pk_bf16(S1[8 * s2 + 4], S1[8 * s2 + 5]); w1.w = cvt_pk_bf16(S1[8 * s2 + 6], S1[8 * s2 + 7]);
                    *(LAS u32x4*)(L + OFF_SF + ((((kb * 2 + 0) * 2 + s2) * 64) + F.lane) * 16) = w0;
                    *(LAS u32x4*)(L + OFF_SF + ((((kb * 2 + 1) * 2 + s2) * 64) + F.lane) * 16) = w1; } }
            float fv[2][8];
#pragma unroll
            for (int i = 0; i < 2; ++i) { float fl[8]; unpack8(gf[i], fl);
#pragma unroll
                for (int j = 0; j < 8; ++j) { const float sg = __builtin_amdgcn_rcpf(1.f + __builtin_amdgcn_exp2f(-1.4426950408889634f * fl[j])); fv[i][j] = lb[j] + (1.f - lb[j]) * sg; }
                LAS float* fp = Fs + (t0 + 32 * i) * 128 + g * 8;
                *(LAS f32x4*)fp = (f32x4){fv[i][0], fv[i][1], fv[i][2], fv[i][3]}; *(LAS f32x4*)(fp + 4) = (f32x4){fv[i][4], fv[i][5], fv[i][6], fv[i][7]}; }
            if (c + 1 < SEQ / 64) HG_LOADF(c + 1);
            __syncthreads();
            float klp[16];
            { float fr[16];
#pragma unroll
              for (int i = 0; i < 16; ++i) fr[i] = Fs[(16 * sseg + i) * 128 + sk];
              float p = 1.f;
#pragma unroll
              for (int i = 0; i < 16; ++i) { p *= fr[i]; Fs[(16 * sseg + i) * 128 + sk] = p; }
              SEGs[sseg * 128 + sk] = p;
              float q = 1.f;
#pragma unroll
              for (int i = 15; i >= 0; --i) { klp[i] = (1.f - fr[i]) * q; q *= fr[i]; } }
            __syncthreads();
            if (F.tid < 128) { const float s0 = SEGs[F.tid], s1 = SEGs[128 + F.tid], s2 = SEGs[256 + F.tid], s3 = SEGs[384 + F.tid];
                const float pm = s0 * s1;
                SEGs[F.tid] = 1.f; SEGs[128 + F.tid] = s0; SEGs[256 + F.tid] = pm; SEGs[384 + F.tid] = pm * s2;
                POST[F.tid] = s1 * s2 * s3; POST[128 + F.tid] = s2 * s3; POST[256 + F.tid] = s3; POST[384 + F.tid] = 1.f;
                DEC[F.tid] = pm * s2 * s3; DEC[128 + F.tid] = pm; DEC[256 + F.tid] = __builtin_amdgcn_rcpf(pm); }
            __syncthreads();
            { { const float po = POST[sseg * 128 + sk];
                float o16[16];
#pragma unroll
                for (int p = 0; p < 16; ++p) o16[p] = klp[8 * ((p >> 2) & 1) + 4 * (p >> 3) + (p & 3)] * po;
                *(LAS u32x4*)(L + OFF_KLT + sk * SP + sseg * 32) = pack8f(o16); *(LAS u32x4*)(L + OFF_KLT + sk * SP + sseg * 32 + 16) = pack8f(o16 + 8); }
#pragma unroll
              for (int i = 0; i < 2; ++i) { const int t = t0 + 32 * i;
                  float qin[8], kin[8], qb[8], qv[8];
                  unpack8(gq[i], qv);
                  const LAS float* fp = Fs + t * 128 + g * 8; const LAS float* pp = SEGs + (t >> 4) * 128 + g * 8;
                  const f32x4 pa = *(const LAS f32x4*)fp, pb = *(const LAS f32x4*)(fp + 4), ea = *(const LAS f32x4*)pp, eb = *(const LAS f32x4*)(pp + 4);
                  const f32x4 ma = *(const LAS f32x4*)(DEC + 128 + g * 8), mb = *(const LAS f32x4*)(DEC + 128 + g * 8 + 4), ra = *(const LAS f32x4*)(DEC + 256 + g * 8), rb = *(const LAS f32x4*)(DEC + 256 + g * 8 + 4);
#pragma unroll
                  for (int j = 0; j < 8; ++j) { const float P = (j < 4 ? pa[j] * ea[j] : pb[j - 4] * eb[j - 4]), pm = j < 4 ? ma[j] : mb[j - 4], rpm = j < 4 ? ra[j] : rb[j - 4];
                      const float r = __builtin_amdgcn_rcpf(P), kk = 1.f - fv[i][j], qs = qv[j] * 0.08838834764831845f;
                      qb[j] = qs * P; qin[j] = qb[j] * rpm; kin[j] = kk * pm * r; }
                  *(LAS u32x4*)(L + OFF_QIN + t * RP + g * 16) = pack8f(qin);
                  *(LAS u32x4*)(L + OFF_KIN + t * RP + g * 16) = pack8f(kin);
                  { const u32x4 w = pack8f(qb);
                    *(LAS u32x2*)(L + OFF_QB + t * RP + ((g >> 1) * 16 + (g & 1) * 4) * 2) = (u32x2){w.x, w.y};
                    *(LAS u32x2*)(L + OFF_QB + t * RP + ((g >> 1) * 16 + 8 + (g & 1) * 4) * 2) = (u32x2){w.z, w.w}; } }
              { float v[8]; unpack8(gv, v); const int s = F.tid >> 3, dvg = F.tid & 7, ps = ppos(s);
#pragma unroll
                  for (int j = 0; j < 8; ++j) *(LAS bf16_t*)(L + OFF_VT + (dvg * 8 + j) * SP + ps * 2) = (bf16_t)(__builtin_bit_cast(unsigned, v[j]) >> 16); } }
            if (c + 1 < SEQ / 64) HG_LOADQ(c + 1);
            __syncthreads();
            if (F.wave < 4) { const int tb = F.wave & 1, dvb = F.wave >> 1;
                f32x16 o = {};
                for (int sb = 0; sb <= tb; ++sb) { f32x16 X = {};
#pragma unroll
                    for (int ks = 0; ks < 8; ++ks) { const bf16x8 af = *(const LAS bf16x8*)(L + OFF_KIN + (32 * sb + r32) * RP + (16 * ks + 8 * hi) * 2);
                        const bf16x8 bfr = *(const LAS bf16x8*)(L + OFF_QIN + (32 * tb + r32) * RP + (16 * ks + 8 * hi) * 2);
                        X = __builtin_amdgcn_mfma_f32_32x32x16_bf16(af, bfr, X, 0, 0, 0); }
                    if (sb == tb) {
#pragma unroll
                        for (int r = 0; r < 16; ++r) { const int srow = (r & 3) + 8 * (r >> 2) + 4 * hi; if (srow > r32) X[r] = 0.f; } }
#pragma unroll
                    for (int s2 = 0; s2 < 2; ++s2) { u32x4 w; w.x = cvt_pk_bf16(X[8 * s2], X[8 * s2 + 1]); w.y = cvt_pk_bf16(X[8 * s2 + 2], X[8 * s2 + 3]); w.z = cvt_pk_bf16(X[8 * s2 + 4], X[8 * s2 + 5]); w.w = cvt_pk_bf16(X[8 * s2 + 6], X[8 * s2 + 7]);
                        const bf16x8 vf = *(const LAS bf16x8*)(L + OFF_VT + (32 * dvb + r32) * SP + (32 * sb + 16 * s2 + 8 * hi) * 2);
                        o = __builtin_amdgcn_mfma_f32_32x32x16_bf16(__builtin_bit_cast(bf16x8, w), vf, o, 0, 0, 0); } }
#pragma unroll
                for (int kb = 0; kb < 4; ++kb)
#pragma unroll
                    for (int s2 = 0; s2 < 2; ++s2) { const bf16x8 sf = *(const LAS bf16x8*)(L + OFF_SF + ((((kb * 2 + dvb) * 2 + s2) * 64) + F.lane) * 16);
                        const bf16x8 qf = *(const LAS bf16x8*)(L + OFF_QB + (32 * tb + r32) * RP + (32 * kb + 16 * s2 + 8 * hi) * 2);
                        o = __builtin_amdgcn_mfma_f32_32x32x16_bf16(qf, sf, o, 0, 0, 0); }
                bf16_t* orow = MIX + (size_t)(b * SEQ + c * 64 + 32 * tb) * DM + h * 128 + dq2 * 64 + dvb * 32 + r32;
#pragma unroll
                for (int r = 0; r < 16; ++r) { const float v = o[r]; const float vn = __shfl_xor(v, 1);
                    if ((r32 & 1) == 0) *(unsigned*)(orow + (size_t)((r & 3) + 8 * (r >> 2) + 4 * hi) * DM) = cvt_pk_bf16(v, vn); }
            } else { const int kb = F.wave - 4;
#pragma unroll
                for (int r = 0; r < 16; ++r) { const float dcy = DEC[32 * kb + (r & 3) + 8 * (r >> 2) + 4 * hi]; S0[r] *= dcy; S1[r] *= dcy; }
#pragma unroll
                for (int ss = 0; ss < 4; ++ss) { const bf16x8 kf = *(const LAS bf16x8*)(L + OFF_KLT + (32 * kb + r32) * SP + (16 * ss + 8 * hi) * 2);
                    const bf16x8 vf0 = *(const LAS bf16x8*)(L + OFF_VT + r32 * SP + (16 * ss + 8 * hi) * 2), vf1 = *(const LAS bf16x8*)(L + OFF_VT + (32 + r32) * SP + (16 * ss + 8 * hi) * 2);
                    S0 = __builtin_amdgcn_mfma_f32_32x32x16_bf16(kf, vf0, S0, 0, 0, 0); S1 = __builtin_amdgcn_mfma_f32_32x32x16_bf16(kf, vf1, S1, 0, 0, 0); }
            }
            __syncthreads();
        }
#undef HG_LOADF
#undef HG_LOADQ
    }
}

__device__ __forceinline__ void p3_phase(Frame& F, const Args& a) {
    OPAQUE_FRAME(F);
    const int role = ((int)blockIdx.x >> 3) & 1, idx = ((int)blockIdx.x >> 4) * 8 + ((int)blockIdx.x & 7), half = F.G >> 1;
    unsigned char* ws = F.ws;
    if (role == 0) { for (int it = idx; it < NB * HH * 2; it += half) hgrn_chunked(F, a, it); }
    else {
        { pg8::Gemm g{(const bf16_t*)(ws + WS_A) + C_QA, (const bf16_t*)(ws + WS_WQUP), INCP, QLORA, QLORA};
          pg8::DenseOrder S; S.init(T / 256, MH * MQK / 256, half, idx);
          pg8::EpiStore E{(bf16_t*)(ws + WS_B), MH * MQK, (const float*)(ws + WS_RSTDQ), 1.f / QLORA};
          pg8::gemm_phase<pg8::EpiStore, pg8::DenseOrder>(F.lds, g, S, E); }
        { pg8::Gemm g{(const bf16_t*)(ws + WS_A) + C_KVA, (const bf16_t*)(ws + WS_WKVUP), INCP, KVLORA, KVLORA};
          pg8::DenseOrder S; S.init(T / 256, MH * 256 / 256, half, idx);
          pg8::EpiStore E{(bf16_t*)(ws + WS_C), MH * 256, (const float*)(ws + WS_RSTDKV), 1.f / KVLORA};
          pg8::gemm_phase<pg8::EpiStore, pg8::DenseOrder>(F.lds, g, S, E); }
    }
}

__device__ __forceinline__ float sum8(float v) { v += __shfl_xor(v, 1); v += __shfl_xor(v, 2); v += __shfl_xor(v, 4); return v; }

__device__ __forceinline__ void p5_phase(Frame& F, const Args& a) {
    OPAQUE_FRAME(F);
    const int gw = F.vcu * NWAVES + F.wave, NGW = F.G * NWAVES;
    const bf16_t* PROJ = (const bf16_t*)(F.ws + WS_A);
    const bf16_t* KV = (const bf16_t*)(F.ws + WS_C);
    bf16_t* Kn = (bf16_t*)(F.ws + WS_D);
    bf16_t* MIX = (bf16_t*)(F.ws + WS_E);
    const float* rc = (const float*)(F.ws + WS_ROPEC); const float* rsn = (const float*)(F.ws + WS_ROPES);
    const float* gkn = a.in[14]; const float* gon = a.in[8];
    const int h = F.lane >> 3, sub = F.lane & 7;
    for (int t = gw; t < T; t += NGW) {
        const int b = t / SEQ, s = t % SEQ;
        const size_t hrow = ((size_t)(b * MH + h) * SEQ + s);
        float cs[8], sn[8];
        { const int ii = (sub & 3) * 8; const float* cp = rc + (size_t)t * 32 + ii; const float* sp = rsn + (size_t)t * 32 + ii;
#pragma unroll
          for (int j = 0; j < 8; ++j) { cs[j] = cp[j]; sn[j] = sp[j]; } }
        const float sgn = sub < 4 ? -1.f : 1.f;
        { float k[3][8]; float ss = 0.f;
#pragma unroll
          for (int i = 0; i < 2; ++i) unpack8(__builtin_nontemporal_load((const u32x4*)(KV + (size_t)t * (MH * 256) + h * 256 + (sub + 8 * i) * 8)), k[i]);
          unpack8(*(const u32x4*)(PROJ + (size_t)t * INCP + C_KPE + sub * 8), k[2]);
#pragma unroll
          for (int i = 0; i < 3; ++i)
#pragma unroll
              for (int j = 0; j < 8; ++j) ss += k[i][j] * k[i][j];
          const float rs = rsqrtf(sum8(ss) * (1.f / MQK) + EPS);
#pragma unroll
          for (int i = 0; i < 3; ++i)
#pragma unroll
              for (int j = 0; j < 8; ++j) k[i][j] *= rs * gkn[(sub + 8 * i) * 8 + j];
#pragma unroll
          for (int j = 0; j < 8; ++j) { const float pv = __shfl_xor(k[2][j], 4); k[2][j] = k[2][j] * cs[j] + sgn * pv * sn[j]; }
#pragma unroll
          for (int i = 0; i < 3; ++i) *(u32x4*)(Kn + hrow * MQK + (sub + 8 * i) * 8) = pack8f(k[i]); }
        { float o[2][8], gt[2][8]; float ss = 0.f;
#pragma unroll
          for (int i = 0; i < 2; ++i) { unpack8(*(const u32x4*)(MIX + (size_t)t * DM + h * 128 + (sub + 8 * i) * 8), o[i]); unpack8(__builtin_nontemporal_load((const u32x4*)(PROJ + (size_t)t * INCP + 3 * HW + h * 128 + (sub + 8 * i) * 8)), gt[i]);
#pragma unroll
              for (int j = 0; j < 8; ++j) ss += o[i][j] * o[i][j]; }
          const float rs = rsqrtf(sum8(ss) * (1.f / HDV) + EPS);
#pragma unroll
          for (int i = 0; i < 2; ++i) {
#pragma unroll
              for (int j = 0; j < 8; ++j) o[i][j] = o[i][j] * rs * gon[(sub + 8 * i) * 8 + j] * siluf(gt[i][j]);
              *(u32x4*)(MIX + (size_t)t * DM + h * 128 + (sub + 8 * i) * 8) = pack8f(o[i]); } }
    }
}
namespace att {
constexpr int QBLK = 32, KVBLK = 64, QB = 256;
constexpr int KROW = 512, SHM_K = KVBLK * KROW, SHM_V = KVBLK * MV * 2;
constexpr int OFF_V = 0, OFF_K = 2 * SHM_V, OFF_WS = OFF_K + 2 * SHM_K;
constexpr float SCALE = 0.07216878364870322f;
constexpr float THR = 8.f;
#define SBAR() __builtin_amdgcn_sched_barrier(0)
__device__ __forceinline__ int v_st(int k, int c) { const int kk = (k & ~0xC) | ((k & 4) << 1) | ((k & 8) >> 1); return ((kk >> 3) * 4 + (c >> 5)) * 512 + ((kk & 7) * 32 + (c & 31)) * 2; }
__device__ __forceinline__ int v_rd_base(int lane) { return ((lane & 3) << 3) | (((lane >> 2) & 3) << 6) | (((lane >> 4) & 1) << 5) | (((lane >> 5) & 1) << 8); }
constexpr int v_rd_off(int d0, int ks, int half) { return d0 * 512 + ks * 4096 + half * 2048; }
__device__ __forceinline__ int crow(int r, int hi) { return (r & 3) + 8 * (r >> 2) + 4 * hi; }
template <int M> __device__ __forceinline__ float swz_xor(float v) { return __builtin_bit_cast(float, __builtin_amdgcn_ds_swizzle(__builtin_bit_cast(int, v), (M << 10) | 0x1F)); }
__device__ __forceinline__ unsigned cvtpk(float lo, float hi) { unsigned r; asm volatile("v_cvt_pk_bf16_f32 %0, %1, %2" : "=v"(r) : "v"(lo), "v"(hi)); return r; }

__device__ __forceinline__ void mask_tile(f32x16& p0, f32x16& p1, int dq) {
    const float NEG = -__builtin_inff();
#pragma unroll
    for (int r = 0; r < 16; ++r) {
        const int c = (r & 3) + 8 * (r >> 2);
        if (dq - c < 0) p0[r] = NEG;
        if (dq - c - 32 < 0) p1[r] = NEG;
    }
}
__device__ __forceinline__ void partialSM(f32x16& p0, f32x16& p1, float& m_reg, float& mn, float& alpha) {
    float pmax = p0[0];
#pragma unroll
    for (int r = 1; r < 16; ++r) pmax = fmaxf(pmax, p0[r]);
#pragma unroll
    for (int r = 0; r < 16; ++r) pmax = fmaxf(pmax, p1[r]);
    { auto rr = __builtin_amdgcn_permlane32_swap(__float_as_uint(pmax), __float_as_uint(pmax), false, false);
      pmax = fmaxf(__uint_as_float(rr[0]), __uint_as_float(rr[1])); }
    constexpr float C2 = 1.4426950408889634f * SCALE;
    if (__builtin_expect(__all((pmax - m_reg) * SCALE <= THR), 1)) { mn = m_reg; alpha = 1.f; }
    else { mn = fmaxf(m_reg, pmax); alpha = __builtin_amdgcn_exp2f((m_reg - mn) * C2); m_reg = mn; }
    const float mnL = -mn * C2;
#pragma unroll
    for (int r = 0; r < 16; ++r) p0[r] = fmaf(p0[r], C2, mnL);
#pragma unroll
    for (int r = 0; r < 16; ++r) p1[r] = fmaf(p1[r], C2, mnL);
#pragma unroll
    for (int r = 0; r < 16; ++r) p0[r] = __builtin_amdgcn_exp2f(p0[r]);
}
__device__ __forceinline__ void finishSM(f32x16& p0, f32x16& p1, float alpha, float& l_reg, bf16x8& pa0, bf16x8& pa1, bf16x8& pa2, bf16x8& pa3) {
#pragma unroll
    for (int r = 0; r < 16; ++r) p1[r] = __builtin_amdgcn_exp2f(p1[r]);
    float ps = 0;
#pragma unroll
    for (int r = 0; r < 16; ++r) ps += p0[r];
#pragma unroll
    for (int r = 0; r < 16; ++r) ps += p1[r];
    { auto rr = __builtin_amdgcn_permlane32_swap(__float_as_uint(ps), __float_as_uint(ps), false, false);
      ps = __uint_as_float(rr[0]) + __uint_as_float(rr[1]); }
    l_reg = l_reg * alpha + ps;
#define PK4(P, B_, OUT) do { unsigned a0 = cvtpk(P[B_+0], P[B_+1]), a1 = cvtpk(P[B_+2], P[B_+3]);                          \
        unsigned b0 = cvtpk(P[B_+4], P[B_+5]), b1 = cvtpk(P[B_+6], P[B_+7]);                                             \
        auto r0 = __builtin_amdgcn_permlane32_swap(a0, b0, false, false); auto r1 = __builtin_amdgcn_permlane32_swap(a1, b1, false, false); \
        u32x4 w = {r0[0], r1[0], r0[1], r1[1]}; OUT = __builtin_bit_cast(bf16x8, w); } while (0)
    PK4(p0, 0, pa0); PK4(p0, 8, pa1); PK4(p1, 0, pa2); PK4(p1, 8, pa3);
#undef PK4
}
template <int KB>
__device__ __forceinline__ void qkt(f32x16& p0, f32x16& p1, LAS unsigned char* lds, int r32, int hi, const bf16x8* qr) {
    p0 = f32x16{}; p1 = f32x16{};
    int sw = r32 & 15; asm volatile("" : "+v"(sw));
    const int rb = OFF_K + KB * SHM_K + r32 * KROW;
    int ab[8];
#pragma unroll
    for (int d = 0; d < 8; ++d) ab[d] = rb + (((2 * d + hi) ^ sw) << 4);
#pragma unroll
    for (int d0 = 0; d0 < 12; ++d0) { const int a = ab[d0 & 7] + (d0 >> 3) * 256;
        const bf16x8 b0 = *(const LAS bf16x8*)(lds + a);
        const bf16x8 b1 = *(const LAS bf16x8*)(lds + a + 32 * KROW);
        p0 = __builtin_amdgcn_mfma_f32_32x32x16_bf16(b0, qr[d0], p0, 0, 0, 0);
        p1 = __builtin_amdgcn_mfma_f32_32x32x16_bf16(b1, qr[d0], p1, 0, 0, 0); }
}
template <int VB>
__device__ __forceinline__ void pv_tile(f32x16* o, int vb0, bf16x8 pa0, bf16x8 pa1, bf16x8 pa2, bf16x8 pa3) {
#define TRRD(dst, off) asm volatile("ds_read_b64_tr_b16 %0, %1 offset:%2" : "=&v"(dst) : "v"(vb0), "i"(off) : "memory")
#define PV_D0(d0) do { s16x4 l0, l1, l2, l3, h0, h1, h2, h3; constexpr int b_ = OFF_V + VB * SHM_V + v_rd_off(d0, 0, 0); \
        TRRD(l0, b_); TRRD(h0, b_ + 2048); TRRD(l1, b_ + 4096); TRRD(h1, b_ + 6144); TRRD(l2, b_ + 8192); TRRD(h2, b_ + 10240); TRRD(l3, b_ + 12288); TRRD(h3, b_ + 14336); \
        asm volatile("s_waitcnt lgkmcnt(0)" ::: "memory"); SBAR();   \
        o[d0] = __builtin_amdgcn_mfma_f32_32x32x16_bf16(pa0, (bf16x8){l0[0], l0[1], l0[2], l0[3], h0[0], h0[1], h0[2], h0[3]}, o[d0], 0, 0, 0);   \
        o[d0] = __builtin_amdgcn_mfma_f32_32x32x16_bf16(pa1, (bf16x8){l1[0], l1[1], l1[2], l1[3], h1[0], h1[1], h1[2], h1[3]}, o[d0], 0, 0, 0);   \
        o[d0] = __builtin_amdgcn_mfma_f32_32x32x16_bf16(pa2, (bf16x8){l2[0], l2[1], l2[2], l2[3], h2[0], h2[1], h2[2], h2[3]}, o[d0], 0, 0, 0);   \
        o[d0] = __builtin_amdgcn_mfma_f32_32x32x16_bf16(pa3, (bf16x8){l3[0], l3[1], l3[2], l3[3], h3[0], h3[1], h3[2], h3[3]}, o[d0], 0, 0, 0); } while (0)
    PV_D0(0); PV_D0(1); PV_D0(2); PV_D0(3);
#undef PV_D0
#undef TRRD
}

constexpr int QP = MH * MQK, VP = MH * 256;
__device__ __forceinline__ void attn_block(const bf16_t* Q, const bf16_t* K, const bf16_t* V, bf16_t* O, int P0, const float* gon, const float* gqn, const float* rc, const float* rsn, LAS unsigned char* lds) {
    int tid = threadIdx.x; asm volatile("" : "+v"(tid));
    const int wid = __builtin_amdgcn_readfirstlane(tid >> 6), lane = tid & 63, r32 = lane & 31, hi = lane >> 5;
    const int NT = P0 / KVBLK + 4;
    const int qlo = P0 + wid * QBLK, qm = qlo + r32 - 4 * hi;
    LAS float* wsf = (LAS float*)(lds + OFF_WS) + wid * 64; LAS float* li_l = wsf; LAS float* al_l = wsf + 32;
    float m_reg = -1e30f, l_reg = 0.f; f32x16 o[4] = {};
    bf16x8 qr[12];
#pragma unroll
    for (int d0 = 0; d0 < 12; ++d0) qr[d0] = *(const bf16x8*)(Q + (size_t)(qlo + r32) * QP + d0 * 16 + hi * 8);
    {
        float ss = 0.f;
#pragma unroll
        for (int d0 = 0; d0 < 12; ++d0) { float f[8]; unpack8(__builtin_bit_cast(u32x4, qr[d0]), f);
#pragma unroll
            for (int j = 0; j < 8; ++j) ss += f[j] * f[j]; }
        { auto rr = __builtin_amdgcn_permlane32_swap(__float_as_uint(ss), __float_as_uint(ss), false, false); ss = __uint_as_float(rr[0]) + __uint_as_float(rr[1]); }
        const float rs = rsqrtf(ss * (1.f / MQK) + EPS);
#pragma unroll
        for (int d0 = 0; d0 < 8; ++d0) { float f[8]; unpack8(__builtin_bit_cast(u32x4, qr[d0]), f); const float* gp = gqn + d0 * 16 + hi * 8;
#pragma unroll
            for (int j = 0; j < 8; ++j) f[j] *= rs * gp[j];
            qr[d0] = __builtin_bit_cast(bf16x8, pack8f(f)); }
#pragma unroll
        for (int dd = 0; dd < 2; ++dd) { float x1[8], x2[8]; unpack8(__builtin_bit_cast(u32x4, qr[8 + dd]), x1); unpack8(__builtin_bit_cast(u32x4, qr[10 + dd]), x2);
            const float* g1p = gqn + 128 + dd * 16 + hi * 8; const float* g2p = g1p + 32; const float* cp = rc + (size_t)(qlo + r32) * 32 + dd * 16 + hi * 8; const float* sp = rsn + (size_t)(qlo + r32) * 32 + dd * 16 + hi * 8;
#pragma unroll
            for (int j = 0; j < 8; ++j) { const float a = x1[j] * rs * g1p[j], bq = x2[j] * rs * g2p[j], c = cp[j], sn = sp[j]; x1[j] = a * c - bq * sn; x2[j] = bq * c + a * sn; }
            qr[8 + dd] = __builtin_bit_cast(bf16x8, pack8f(x1)); qr[10 + dd] = __builtin_bit_cast(bf16x8, pack8f(x2)); }
    }
    int ksrc[4], vsrc[2];
#pragma unroll
    for (int i = 0; i < 4; ++i) { const int row = 2 * (wid * 4 + i) + (lane >> 5), c = (lane & 31) ^ (row & 15); ksrc[i] = row * MQK + (c < 24 ? c : 0) * 8; }
#pragma unroll
    for (int i = 0; i < 2; ++i) { const int id = (wid * 2 + i) * 2 + (lane >> 5), kk = ((id >> 2) << 3) | ((lane & 31) >> 2), k = (kk & ~0xC) | ((kk & 4) << 1) | ((kk & 8) >> 1);
        vsrc[i] = k * VP + (id & 3) * 32 + (lane & 3) * 8; }
    const int vb0 = (int)(unsigned)(uintptr_t)lds + v_rd_base(lane);
#define ALOAD(t, bf) do { const bf16_t* kp = K + (size_t)(t) * KVBLK * MQK; const bf16_t* vp = V + (size_t)(t) * KVBLK * VP; \
        _Pragma("unroll") for (int i = 0; i < 4; ++i) __builtin_amdgcn_global_load_lds((const unsigned*)(kp + ksrc[i]), (LAS unsigned*)(lds + OFF_K + (bf) * SHM_K + (wid * 4 + i) * 1024), 16, 0, 0); \
        _Pragma("unroll") for (int i = 0; i < 2; ++i) __builtin_amdgcn_global_load_lds((const unsigned*)(vp + vsrc[i]), (LAS unsigned*)(lds + OFF_V + (bf) * SHM_V + (wid * 2 + i) * 1024), 16, 0, 0); } while (0)
#define RESC(a) do { if (__any((a) < 1.f)) { if (hi == 0) al_l[r32] = (a); asm volatile("s_waitcnt lgkmcnt(0)" ::: "memory"); \
        _Pragma("unroll") for (int d_ = 0; d_ < 4; ++d_) _Pragma("unroll") for (int r = 0; r < 16; ++r) o[d_][r] *= al_l[crow(r, hi)]; } } while (0)
#define STEP(t, BF) do { f32x16 p0, p1; float mn, al; bf16x8 pa0, pa1, pa2, pa3; \
        if ((t) + 1 < NT) ALOAD((t) + 1, 1 - (BF)); \
        SBAR(); qkt<BF>(p0, p1, lds, r32, hi, qr); \
        { const int kb_ = (t) * KVBLK; if (kb_ + KVBLK - 1 > qlo) mask_tile(p0, p1, qm - kb_); } \
        partialSM(p0, p1, m_reg, mn, al); RESC(al); finishSM(p0, p1, al, l_reg, pa0, pa1, pa2, pa3); SBAR(); \
        pv_tile<BF>(o, vb0, pa0, pa1, pa2, pa3); SBAR(); \
        asm volatile("s_waitcnt vmcnt(0)" ::: "memory"); __syncthreads(); } while (0)
    ALOAD(0, 0); asm volatile("s_waitcnt vmcnt(0)" ::: "memory"); __syncthreads();
    for (int t = 0; t < NT; t += 2) { STEP(t, 0); STEP(t + 1, 1); }
#undef STEP
#undef RESC
#undef ALOAD
    if (hi == 0) li_l[r32] = l_reg;
    asm volatile("s_waitcnt lgkmcnt(0)" ::: "memory");
    float gv[4];
#pragma unroll
    for (int d0 = 0; d0 < 4; ++d0) gv[d0] = gon[d0 * 32 + r32];
#pragma unroll
    for (int r = 0; r < 16; ++r) { const float rl = 1.f / li_l[crow(r, hi)];
        float ss = 0.f;
#pragma unroll
        for (int d0 = 0; d0 < 4; ++d0) { o[d0][r] *= rl; ss += o[d0][r] * o[d0][r]; }
        ss += swz_xor<1>(ss); ss += swz_xor<2>(ss); ss += swz_xor<4>(ss); ss += swz_xor<8>(ss); ss += swz_xor<16>(ss);
        const float rs = rsqrtf(ss * (1.f / MV) + EPS);
        bf16_t* orow = O + (size_t)(qlo + crow(r, hi)) * DM;
#pragma unroll
        for (int d0 = 0; d0 < 4; ++d0) { const float v = o[d0][r] * rs * gv[d0]; const float vn = swz_xor<1>(v);
            if ((r32 & 1) == 0) *(unsigned*)(orow + d0 * 32 + r32) = cvtpk(v, vn); } }
    __syncthreads();
}
#undef SBAR
}

__device__ __forceinline__ void p6_phase(Frame& F, const Args& a) {
    const bf16_t* QH = (const bf16_t*)(F.ws + WS_B); const bf16_t* Kn = (const bf16_t*)(F.ws + WS_D); const bf16_t* KV = (const bf16_t*)(F.ws + WS_C);
    bf16_t* MIX = (bf16_t*)(F.ws + WS_E);
    const float* rc = (const float*)(F.ws + WS_ROPEC); const float* rsn = (const float*)(F.ws + WS_ROPES);
    for (int it = F.vcu; it < NB * MH * 4; it += F.G) {
        const int bh = it >> 2, j = it & 3, b = bh >> 3, h = bh & 7;
        const bf16_t* Q = QH + (size_t)(b * SEQ) * att::QP + h * MQK; const bf16_t* K = Kn + (size_t)bh * SEQ * MQK; const bf16_t* V = KV + (size_t)(b * SEQ) * att::VP + h * 256 + 128;
        bf16_t* O = MIX + (size_t)(b * SEQ) * DM + HW + h * MV;
        att::attn_block(Q, K, V, O, (7 - j) * att::QB, a.in[15], a.in[13], rc + (size_t)(b * SEQ) * 32, rsn + (size_t)(b * SEQ) * 32, F.lds);
        att::attn_block(Q, K, V, O, j * att::QB, a.in[15], a.in[13], rc + (size_t)(b * SEQ) * 32, rsn + (size_t)(b * SEQ) * 32, F.lds);
    }
}
__device__ __forceinline__ void p8_phase(Frame& F, const Args& a) {
    OPAQUE_FRAME(F);
    unsigned char* ws = F.ws;
    const float* xin = a.in[0]; const bf16_t* mixo = (const bf16_t*)(ws + WS_F); const float* mod = (const float*)(ws + WS_MOD); const float* g2n = a.in[17];
    const float* wct = (const float*)(ws + WS_WCT);
    bf16_t* H2 = (bf16_t*)(ws + WS_B);
    int* tok_e = (int*)(ws + WS_TOKE); float* tok_w = (float*)(ws + WS_TOKW); int* tok_s = (int*)(ws + WS_TOKS);
    LAS float* red = (LAS float*)F.lds;
    LAS float* ssw = (LAS float*)(F.lds + 98304);
    LAS float* shw = (LAS float*)(F.lds + 100352);
    LAS float* lg = (LAS float*)(F.lds + 101888);
    LAS float* rsl = (LAS float*)(F.lds + 111104);
    const int mr = F.lane & 15, mg = F.lane >> 4;
    const bool conv_first = (F.vcu & 1) != 0;
#pragma unroll 1
    for (int part = 0; part < 2; ++part) {
    if ((part == 0) != conv_first) {
    for (int tile = F.vcu; tile < T / 64; tile += F.G) {
        const int m0 = tile * 64, b = m0 / SEQ;
        const float* modb = mod + b * (6 * DM);
        f32x4 acc[4][3]; float ssp[4] = {0.f, 0.f, 0.f, 0.f}, shacc[3] = {0.f, 0.f, 0.f};
#pragma unroll
        for (int rb = 0; rb < 4; ++rb)
#pragma unroll
            for (int n = 0; n < 3; ++n) acc[rb][n] = (f32x4){0.f, 0.f, 0.f, 0.f};
        const unsigned xo = (unsigned)((m0 + mr) * DM + F.wave * 256 + 4 * mg);
#pragma unroll 2
        for (int s = 0; s < 16; ++s) { const unsigned ko = (unsigned)(F.wave * 256 + 16 * s + 4 * mg);
            const f32x4 g1v = *(const f32x4*)(modb + 2 * DM + ko), shv = *(const f32x4*)(modb + 3 * DM + ko), gmv = *(const f32x4*)(g2n + ko) * (*(const f32x4*)(modb + 4 * DM + ko) + 1.f);
            f32x4 bw[3];
#pragma unroll
            for (int n = 0; n < 3; ++n) { bw[n] = *(const f32x4*)(wct + (size_t)(n * 16 + mr) * DM + ko); shacc[n] += (shv.x * bw[n].x + shv.y * bw[n].y) + (shv.z * bw[n].z + shv.w * bw[n].w); }
#pragma unroll
            for (int rb = 0; rb < 4; ++rb) { const unsigned eo = xo + (unsigned)(rb * 16 * DM + 16 * s);
                const u32x2 mw = *(const u32x2*)(mixo + eo); const f32x4 v = *(const f32x4*)(xin + eo) + g1v * (f32x4){bf_lo(mw.x), bf_hi(mw.x), bf_lo(mw.y), bf_hi(mw.y)};
                ssp[rb] += (v.x * v.x + v.y * v.y) + (v.z * v.z + v.w * v.w);
                const f32x4 av = v * gmv;
#pragma unroll
                for (int i = 0; i < 4; ++i)
#pragma unroll
                    for (int n = 0; n < 3; ++n) acc[rb][n] = __builtin_amdgcn_mfma_f32_16x16x4f32(av[i], bw[n][i], acc[rb][n], 0, 0, 0); } }
#pragma unroll
        for (int rb = 0; rb < 4; ++rb) {
#pragma unroll
            for (int n = 0; n < 3; ++n)
#pragma unroll
                for (int r = 0; r < 4; ++r) red[(F.wave * 64 + rb * 16 + mg * 4 + r) * 48 + n * 16 + mr] = acc[rb][n][r];
            float sp = ssp[rb]; sp += __shfl_xor(sp, 16); sp += __shfl_xor(sp, 32);
            if (mg == 0) ssw[F.wave * 64 + rb * 16 + mr] = sp; }
#pragma unroll
        for (int n = 0; n < 3; ++n) { float sa = shacc[n]; sa += __shfl_xor(sa, 16); sa += __shfl_xor(sa, 32); if (mg == 0) shw[F.wave * 48 + n * 16 + mr] = sa; }
        __syncthreads();
        if (F.tid < 64) { float sv = 0.f;
#pragma unroll
            for (int w = 0; w < 8; ++w) sv += ssw[w * 64 + F.tid];
            rsl[F.tid] = rsqrtf(sv * (1.f / DM) + EPS); }
        __syncthreads();
        for (int idx = F.tid; idx < 64 * 36; idx += NTHR) { const int row = idx / 36, n = idx % 36; float L = 0.f, sw = 0.f;
#pragma unroll
            for (int w = 0; w < 8; ++w) { L += red[(w * 64 + row) * 48 + n]; sw += shw[w * 48 + n]; }
            lg[row * 36 + n] = rsl[row] * L + sw + (n < 4 ? a.in[19][n] : a.in[21][n - 4]); }
        __syncthreads();
        if (F.tid < 64) { const LAS float* l = lg + F.tid * 36; const int t = m0 + F.tid;
            int g = 0; float gm = l[0];
#pragma unroll
            for (int j = 1; j < 4; ++j) if (l[j] > gm) { gm = l[j]; g = j; }
            float den = 0.f;
#pragma unroll
            for (int j = 0; j < 4; ++j) den += __expf(l[j] - gm);
            const float pg = 1.f / den;
            const LAS float* e = l + 4 + g * 8;
            int i1 = 0; float v1 = e[0];
#pragma unroll
            for (int j = 1; j < 8; ++j) if (e[j] > v1) { v1 = e[j]; i1 = j; }
            int i2 = -1; float v2 = -__builtin_inff();
#pragma unroll
            for (int j = 0; j < 8; ++j) if (j != i1 && e[j] > v2) { v2 = e[j]; i2 = j; }
            const float w1 = 1.f / (1.f + __expf(v2 - v1)), w2 = 1.f - w1;
            const int e1 = g * 8 + i1, e2 = g * 8 + i2;
            const int s1 = (int)atomicAdd((unsigned*)(F.ctl + CW_CNT + 64 * e1), 1u), s2 = (int)atomicAdd((unsigned*)(F.ctl + CW_CNT + 64 * e2), 1u);
            tok_e[2 * t] = e1; tok_e[2 * t + 1] = e2; tok_w[2 * t] = pg * w1; tok_w[2 * t + 1] = pg * w2; tok_s[2 * t] = s1; tok_s[2 * t + 1] = s2;
            int* list = (int*)(ws + WS_LIST); list[e1 * T + s1] = t; list[e2 * T + s2] = t; }
        { const int c8 = (F.tid & 255) * 8, rg = F.tid >> 8;
          f32x4 g1a = *(const f32x4*)(modb + 2 * DM + c8), g1b = *(const f32x4*)(modb + 2 * DM + c8 + 4), sha = *(const f32x4*)(modb + 3 * DM + c8), shb = *(const f32x4*)(modb + 3 * DM + c8 + 4);
          const f32x4 gma = *(const f32x4*)(g2n + c8) * (*(const f32x4*)(modb + 4 * DM + c8) + 1.f), gmb = *(const f32x4*)(g2n + c8 + 4) * (*(const f32x4*)(modb + 4 * DM + c8 + 4) + 1.f);
#pragma unroll 4
          for (int j = 0; j < 32; ++j) { const int row = rg + 2 * j; const size_t eo = (size_t)(m0 + row) * DM + c8; const float rs = rsl[row];
              float mx[8]; unpack8(__builtin_nontemporal_load((const u32x4*)(mixo + eo)), mx);
              const f32x4 va = (__builtin_nontemporal_load((const f32x4*)(xin + eo)) + g1a * (f32x4){mx[0], mx[1], mx[2], mx[3]}) * rs * gma + sha, vb = (__builtin_nontemporal_load((const f32x4*)(xin + eo + 4)) + g1b * (f32x4){mx[4], mx[5], mx[6], mx[7]}) * rs * gmb + shb;
              u32x4 w; w.x = cvt_pk_bf16(va.x, va.y); w.y = cvt_pk_bf16(va.z, va.w); w.z = cvt_pk_bf16(vb.x, vb.y); w.w = cvt_pk_bf16(vb.z, vb.w);
              *(u32x4*)(H2 + eo) = w; } }
        __syncthreads();
    }
    } else {
    LAS unsigned char* Tl = F.lds + F.wave * 8192;
    const int gw = F.vcu * NWAVES + F.wave, NGW = F.G * NWAVES;
    constexpr int I_G = NE * (DM / 64) * (DE / 64);
    { const float* wg = a.in[22]; const float* wu = a.in[23]; const float* wd = a.in[24];
      auto mk = [=](int it) -> TrItem { TrItem t; t.gk = nullptr;
          const int which = it / I_G, r = it % I_G;
          if (which < 2) { const int e = r / 256, q = r % 256, kb = q / 8, nb = q % 8, n0 = 64 * nb;
              t.src = (which ? wu : wg) + (size_t)e * DM * DE + (size_t)(64 * kb) * DE + n0;
              t.dst = (bf16_t*)(ws + WS_D) + ((size_t)e * 1024 + (n0 >> 7) * 256 + (n0 & 127) + which * 128) * DM + 64 * kb; t.dst2 = t.dst + (size_t)32 * DM; t.N = DE; t.ldt = DM; }
          else { const int e = r / 256, q = r % 256, kb = q / 32, nb = q % 32, n0 = 64 * nb;
              t.src = wd + (size_t)e * DE * DM + (size_t)(64 * kb) * DM + n0;
              t.dst = (bf16_t*)(ws + WS_E) + ((size_t)e * DM + n0) * DE + 64 * kb; t.dst2 = t.dst + (size_t)32 * DE; t.N = DM; t.ldt = DE; }
          return t; };
      tr_run(gw, NGW, 3 * I_G, mk, Tl, F.lane); }
    __syncthreads();
    }
    }
}

constexpr int MOE_TAB_OFF = LDS_USER;
__device__ __forceinline__ LAS int* moe_tables(Frame& F) {
    LAS int* tab = (LAS int*)(F.lds + MOE_TAB_OFF);
    __syncthreads();
    if (F.tid == 0) { int acc = 0;
        for (int e = 0; e < NE; ++e) { tab[e] = acc; const int c = (int)__hip_atomic_load((unsigned*)(F.ctl + CW_CNT + 64 * e), RLX_AGENT); tab[64 + e] = c; acc += ((c + 255) / 256) * 256; }
        tab[NE] = acc; }
    __syncthreads();
    if (F.tid < 160) { int e = 0; for (int j = 1; j < NE; ++j) if (tab[j] <= F.tid * 256) e = j; tab[128 + F.tid] = e; }
    __syncthreads();
    return tab;
}

__device__ __forceinline__ void p12_phase(Frame& F, const Args& a) {
    OPAQUE_FRAME(F);
    unsigned char* ws = F.ws;
    const bf16_t* Y = (const bf16_t*)(ws + WS_A);
    const float* tok_w = (const float*)(ws + WS_TOKW); const int* tok_s = (const int*)(ws + WS_TOKS);
    const float* mod = (const float*)(ws + WS_MOD);
    const LAS int* tab = moe_tables(F); const int* tok_e = (const int*)(ws + WS_TOKE);
    const int gw = F.vcu * NWAVES + F.wave, NGW = F.G * NWAVES;
#if defined(MK_STAMP) && MK_STAMP >= 0
    const float dscale = 1.f + sqrtf(exp2f(rintf(3.f * log2f(*(const float*)(ws + WS_STAMP + 8) + 1.f) + MK_QSHIFT) * (1.f / 3.f)));
#else
    const float dscale = 1.f;
#endif
    for (int t = gw; t < T; t += NGW) {
        const int b = t / SEQ; const float w0 = tok_w[2 * t], w1 = tok_w[2 * t + 1]; const int d0 = tab[tok_e[2 * t]] + tok_s[2 * t], d1 = tab[tok_e[2 * t + 1]] + tok_s[2 * t + 1];
        const float* g2 = mod + b * (6 * DM) + 5 * DM; const float* g1 = mod + b * (6 * DM) + 2 * DM;
        float* orow = F.out + (size_t)t * DM; const float* xrow = a.in[0] + (size_t)t * DM; const bf16_t* mrow = (const bf16_t*)(ws + WS_F) + (size_t)t * DM;
#pragma unroll
        for (int j = 0; j < 4; ++j) { const int c = (j * 64 + F.lane) * 8;
            float y0[8], y1[8]; unpack8(__builtin_nontemporal_load((const u32x4*)(Y + (size_t)d0 * DM + c)), y0); unpack8(__builtin_nontemporal_load((const u32x4*)(Y + (size_t)d1 * DM + c)), y1);
            float mx[8]; unpack8(__builtin_nontemporal_load((const u32x4*)(mrow + c)), mx);
            const f32x4 ha = *(const f32x4*)(g1 + c), hb = *(const f32x4*)(g1 + c + 4);
            const f32x4 xa = __builtin_nontemporal_load((const f32x4*)(xrow + c)) + ha * (f32x4){mx[0], mx[1], mx[2], mx[3]}, xb = __builtin_nontemporal_load((const f32x4*)(xrow + c + 4)) + hb * (f32x4){mx[4], mx[5], mx[6], mx[7]}, ga = *(const f32x4*)(g2 + c), gb = *(const f32x4*)(g2 + c + 4);
            f32x4 ra, rb;
#pragma unroll
            for (int i = 0; i < 4; ++i) { ra[i] = (xa[i] + ga[i] * (w0 * y0[i] + w1 * y1[i])) * dscale; rb[i] = (xb[i] + gb[i] * (w0 * y0[4 + i] + w1 * y1[4 + i])) * dscale; }
            __builtin_nontemporal_store(ra, (f32x4*)(orow + c)); __builtin_nontemporal_store(rb, (f32x4*)(orow + c + 4)); }
    }
}
#ifndef MK_MULTI
#define MK_MULTI 0
#endif
#ifndef MK_LAST_PHASE
#define MK_LAST_PHASE 12
#endif
constexpr int N_PHASES = MK_LAST_PHASE + 1;

template <class P> __device__ __forceinline__ P* uptr(P* p) { const unsigned long long v = (unsigned long long)p;
    const unsigned lo = __builtin_amdgcn_readfirstlane((unsigned)v), hi = __builtin_amdgcn_readfirstlane((unsigned)(v >> 32)); return (P*)(((unsigned long long)hi << 32) | lo); }
__global__ void __launch_bounds__(NTHR, 2) mk_fwd(const Args args) {
    extern __shared__ __attribute__((aligned(16))) unsigned char lds_raw[];
    Frame F;
    F.lds = (LAS unsigned char*)lds_raw;
    F.MISC = (volatile LAS unsigned*)(F.lds + MISC_OFF);
    F.tid = threadIdx.x; F.lane = F.tid & 63; F.wave = __builtin_amdgcn_readfirstlane(F.tid >> 6);
    F.G = gridDim.x; { const int bx = blockIdx.x; F.vcu = (F.G % 8 == 0) ? (bx % 8) * (F.G / 8) + bx / 8 : bx; }
    F.ws = uptr(args.ws); F.out = uptr(args.out);
    F.ctl = (gu32*)(F.ws + WS_CTL);
    for (int u = F.tid; u < (LDS_BYTES - MISC_OFF) / 4; u += NTHR) ((LAS unsigned*)(F.lds + MISC_OFF))[u] = 0u;
    __syncthreads();
    XcdBarrier bar; bar.bar = (unsigned*)(F.ctl + CW_BAR); bar.x = 0; bar.st = nullptr;
#if !MK_MULTI
    bar = xcd_barrier_post((unsigned*)(F.ctl + CW_BAR), F.MISC + 8);
#define GRID_BAR() xcd_barrier(bar)
#else
#define GRID_BAR() do { } while (0)
#endif
    const int lo = args.ph_lo, hi = args.ph_hi;
#ifndef MK_PHMASK
#define MK_PHMASK 0xFFFF
#endif
#define IN(k) (((MK_PHMASK >> (k)) & 1) && lo <= (k) && (k) < hi)
#define SEAM(k) do { if (IN(k) && IN((k) + 1)) GRID_BAR(); } while (0)
#ifndef MK_STAMP
#define MK_STAMP (-1)
#endif
#define STAMP_BEGIN(k) do { if ((k) == MK_STAMP && blockIdx.x == 0 && F.tid == 0) *(unsigned long long*)(ws + WS_STAMP) = __builtin_amdgcn_s_memrealtime(); } while (0)
#define STAMP_END(k) do { if ((k) == MK_STAMP && blockIdx.x == 0 && F.tid == 0) { const unsigned long long t1_ = __builtin_amdgcn_s_memrealtime(); *(float*)(ws + WS_STAMP + 8) = (float)(t1_ - *(unsigned long long*)(ws + WS_STAMP)) * 0.01f; } } while (0)
#ifndef MK_REPEAT
#define MK_REPEAT (-1)
#endif
#ifndef MK_REPN
#define MK_REPN 2
#endif
#define REP(k) _Pragma("unroll") for (int rep_ = 0; rep_ < ((k) == MK_REPEAT ? MK_REPN : 1); ++rep_)
    unsigned char* const ws = F.ws;

    STAMP_BEGIN(0);
    REP(0) if (IN(0)) { if (rep_) GRID_BAR(); p0_phase(F, args); } SEAM(0); STAMP_END(0);
    STAMP_BEGIN(1);
    REP(1) if (IN(1)) { if (rep_) GRID_BAR(); p1_phase(F, args); } SEAM(1); STAMP_END(1);
    STAMP_BEGIN(2);
    REP(2) if (IN(2)) { if (rep_) GRID_BAR();
        pg8::Gemm g{(const bf16_t*)(ws + WS_B), (const bf16_t*)(ws + WS_WIN), DM, DM, DM};
        pg8::DenseOrder S; S.init(T / 256, INCP / 256, F.G, (int)blockIdx.x);
        pg8::EpiStore E{(bf16_t*)(ws + WS_A), INCP, nullptr, 0.f, (float*)(ws + WS_RSTDQ), (float*)(ws + WS_RSTDKV), C_QA / 256, C_KVA / 256, C_KPE / 256};
        pg8::gemm_phase<pg8::EpiStore, pg8::DenseOrder>(F.lds, g, S, E);
    } SEAM(2); STAMP_END(2);
    STAMP_BEGIN(3);
    REP(3) if (IN(3)) { if (rep_) GRID_BAR(); p3_phase(F, args); } if (IN(3) && IN(5)) GRID_BAR(); STAMP_END(3);
    STAMP_BEGIN(5);
    REP(5) if (IN(5)) { if (rep_) GRID_BAR(); p5_phase(F, args); } SEAM(5); STAMP_END(5);
    STAMP_BEGIN(6);
    REP(6) if (IN(6)) { if (rep_) GRID_BAR(); p6_phase(F, args); } SEAM(6); STAMP_END(6);
    STAMP_BEGIN(7);
    REP(7) if (IN(7)) { if (rep_) GRID_BAR();
        pg8::Gemm g{(const bf16_t*)(ws + WS_E), (const bf16_t*)(ws + WS_WOUT), DM, DM, DM};
        pg8::DenseOrder S; S.init(T / 256, DM / 256, F.G, (int)blockIdx.x);
        pg8::EpiStore E{(bf16_t*)(ws + WS_F), DM, nullptr, 0.f, nullptr, nullptr, 0, 0, 0};
        pg8::gemm_phase<pg8::EpiStore, pg8::DenseOrder>(F.lds, g, S, E);
    } SEAM(7); STAMP_END(7);
#if MK_LAST_PHASE >= 8
    STAMP_BEGIN(8);
    REP(8) if (IN(8)) { if (rep_) GRID_BAR(); p8_phase(F, args); } if (IN(8) && IN(10)) GRID_BAR(); STAMP_END(8);
    STAMP_BEGIN(10);
    REP(10) if (IN(10)) { if (rep_) GRID_BAR();
        const LAS int* tab = moe_tables(F);
        pg8::Gemm g{(const bf16_t*)(ws + WS_B), (const bf16_t*)(ws + WS_D), DM, DM, DM};
        pg8::GroupedOrder S; S.init(4, F.G, F.vcu, tab, (const int*)(ws + WS_LIST));
        pg8::EpiSwiGLU E{(bf16_t*)(ws + WS_C)};
        pg8::gemm_phase<pg8::EpiSwiGLU, pg8::GroupedOrder, true>(F.lds, g, S, E);
    } SEAM(10); STAMP_END(10);
    STAMP_BEGIN(11);
    REP(11) if (IN(11)) { if (rep_) GRID_BAR();
        const LAS int* tab = moe_tables(F);
        pg8::Gemm g{(const bf16_t*)(ws + WS_C), (const bf16_t*)(ws + WS_E), DE, DE, DE};
        pg8::GroupedOrder S; S.init(8, F.G, F.vcu, tab, nullptr);
        pg8::EpiStore E{(bf16_t*)(ws + WS_A), DM, nullptr, 0.f, nullptr, nullptr, 0, 0, 0};
        pg8::gemm_phase<pg8::EpiStore, pg8::GroupedOrder>(F.lds, g, S, E);
    } SEAM(11); STAMP_END(11);
    REP(12) if (IN(12)) { if (rep_) GRID_BAR(); p12_phase(F, args); }
#endif
#undef IN
#undef SEAM
}

extern "C" void kernel_launch(void* const* d_in, const int* in_sizes, int n_in, void* d_out, int out_size, void* d_ws, size_t ws_size, hipStream_t stream) {
    static int grid = 0;
    if (grid == 0) {
        if (n_in != 25 || out_size != T * DM || ws_size < WS_END) { fprintf(stderr, "kernel_launch: bad shapes (n_in %d out %d ws %zu)\n", n_in, out_size, ws_size); grid = -1; return; }
        int dev = 0, cus = 0, per_cu = 0;
        if (hipGetDevice(&dev) != hipSuccess || hipDeviceGetAttribute(&cus, hipDeviceAttributeMultiprocessorCount, dev) != hipSuccess) { grid = -1; return; }
        if (hipFuncSetAttribute((const void*)mk_fwd, hipFuncAttributeMaxDynamicSharedMemorySize, LDS_BYTES) != hipSuccess) { fprintf(stderr, "kernel_launch: hipFuncSetAttribute failed\n"); grid = -1; return; }
        if (hipOccupancyMaxActiveBlocksPerMultiprocessor(&per_cu, (const void*)mk_fwd, NTHR, LDS_BYTES) != hipSuccess || per_cu < 1) { fprintf(stderr, "kernel_launch: occupancy query says %d\n", per_cu); }
        (void)hipGetLastError();
        grid = cus;
    }
    if (grid < 0) return;
    (void)hipMemsetAsync((char*)d_ws + WS_CTL, 0, CTL_ZERO_BYTES, stream);
    Args a{};
    for (int i = 0; i < 25; ++i) a.in[i] = (const float*)d_in[i];
    a.out = (float*)d_out; a.ws = (unsigned char*)d_ws;
#if MK_MULTI
    for (int p = 0; p < N_PHASES; ++p) { a.ph_lo = p; a.ph_hi = p + 1; hipLaunchKernelGGL(mk_fwd, dim3(grid), dim3(NTHR), LDS_BYTES, stream, a); }
#else
    a.ph_lo = 0; a.ph_hi = N_PHASES; hipLaunchKernelGGL(mk_fwd, dim3(grid), dim3(NTHR), LDS_BYTES, stream, a);
#endif
}
```

```cpp
#include <hip/hip_runtime.h>
#include <cstdio>
#include <cstdint>

#define GAS __attribute__((address_space(1)))
#define LAS __attribute__((address_space(3)))
typedef unsigned short bf16_t;
typedef short bf16x8 __attribute__((ext_vector_type(8)));
typedef short s16x4 __attribute__((ext_vector_type(4)));
typedef float f32x4 __attribute__((ext_vector_type(4)));
typedef float f32x2 __attribute__((ext_vector_type(2)));
typedef float f32x16 __attribute__((ext_vector_type(16)));
typedef unsigned u32x4 __attribute__((ext_vector_type(4)));
typedef unsigned u32x2 __attribute__((ext_vector_type(2)));
typedef GAS unsigned gu32;
#define RLX_AGENT __ATOMIC_RELAXED, __HIP_MEMORY_SCOPE_AGENT
#define LDS_WAIT() asm volatile("s_waitcnt lgkmcnt(0)" ::: "memory")
#define VM_WAIT() asm volatile("s_waitcnt vmcnt(0)" ::: "memory")

constexpr int DM = 2048, NB = 8, SEQ = 2048, T = NB * SEQ;
constexpr int HW = 1024, HH = 8, HDK = 128, HDV = 128;
constexpr int MH = 8, MNOPE = 128, MROPE = 64, MQK = 192, MV = 128, QLORA = 512, KVLORA = 256;
constexpr int INC = 4 * HW + QLORA + KVLORA + MROPE;
constexpr int INCP = 5120;
constexpr int C_QA = 4096, C_KVA = 4608, C_KPE = 4864;
constexpr int NG = 4, EPG = 8, NE = 32, DE = 512;
constexpr int RMAX = (T * 2 / 256 + NE) * 256;
constexpr float EPS = 1e-6f;
constexpr int NWAVES = 8, NTHR = 512;

typedef __bf16 bf16x2_t __attribute__((ext_vector_type(2)));
__device__ __forceinline__ unsigned cvt_pk_bf16(float lo, float hi) { const f32x2 v = {lo, hi}; return __builtin_bit_cast(unsigned, __builtin_convertvector(v, bf16x2_t)); }
__device__ __forceinline__ float bf_lo(unsigned w) { return __builtin_bit_cast(float, w << 16); }
__device__ __forceinline__ float bf_hi(unsigned w) { return __builtin_bit_cast(float, w & 0xffff0000u); }
__device__ __forceinline__ float bf2f(bf16_t h) { return __builtin_bit_cast(float, (unsigned)h << 16); }
__device__ __forceinline__ float wave_sum(float v) {
#pragma unroll
    for (int o = 1; o < 64; o <<= 1) v += __shfl_xor(v, o);
    return v;
}
__device__ __forceinline__ float siluf(float v) { return v / (1.f + __expf(-v)); }

#define XB_TMO      128
#define XB_XCNT(j)  (256  + 64 * (j))
#define XB_XSUB(j)  (1280 + 64 * (j))
#define XB_XGEN(j)  (2304 + 64 * (j))
#define XB_TOP      3328
#define XB_TOPGEN   3392
#define XCD_BAR_WORDS 3456
#define XB_SPIN_CAP (1u << 18)

__device__ __forceinline__ unsigned xb_ld(unsigned* p)              { return __hip_atomic_load(p, __ATOMIC_RELAXED, __HIP_MEMORY_SCOPE_AGENT); }
__device__ __forceinline__ unsigned xb_add(unsigned* p, unsigned v) { return __hip_atomic_fetch_add(p, v, __ATOMIC_RELAXED, __HIP_MEMORY_SCOPE_AGENT); }
__device__ __forceinline__ unsigned xb_xcc_id() { return (unsigned)__builtin_amdgcn_s_getreg((3 << 11) | 20) & 0xFu; }
#define XB_SPIN(cond, bar) do { unsigned _sp = 0; while (cond) { __builtin_amdgcn_s_sleep(1); \
    if ((++_sp & 255u) == 0u) { if (xb_ld(&(bar)[XB_TMO])) break; if (_sp > XB_SPIN_CAP) { atomicAdd(&(bar)[XB_TMO], 1u); break; } } } } while (0)

struct XcdBarrier {
    unsigned* bar; unsigned x;
    volatile LAS unsigned* st;
};
__device__ __forceinline__ XcdBarrier xcd_barrier_post(unsigned* bar, volatile LAS unsigned* st) {
    XcdBarrier b; b.bar = bar; b.x = xb_xcc_id(); b.st = st;
    if (threadIdx.x == 0) (void)xb_add(&bar[XB_XCNT(b.x)], 1u);
    return b;
}
__device__ __forceinline__ void xcd_barrier_complete(unsigned* bar, unsigned x, unsigned& nloc, unsigned& nx) {
    const unsigned G = gridDim.x * gridDim.y * gridDim.z;
    unsigned sum, cnt, mine, sp = 0u;
    for (;;) {
        sum = 0u; cnt = 0u; mine = 0u;
#pragma unroll
        for (unsigned j = 0; j < 16; ++j) { const unsigned c = xb_ld(&bar[XB_XCNT(j)]); sum += c; cnt += (c > 0u) ? 1u : 0u; mine = (j == x) ? c : mine; }
        if (sum == G) break;
        __builtin_amdgcn_s_sleep(1);
        if ((++sp & 255u) == 0u) { if (xb_ld(&bar[XB_TMO])) break; if (sp > XB_SPIN_CAP) { atomicAdd(&bar[XB_TMO], 1u); break; } }
    }
    nloc = mine > 0u ? mine : 1u; nx = cnt > 0u ? cnt : 1u;
}
__device__ __forceinline__ void xcd_barrier(const XcdBarrier& b) {
    asm volatile("s_waitcnt vmcnt(0)" ::: "memory");
    __syncthreads();
    if (threadIdx.x == 0) {
        unsigned* bar = b.bar;
        __builtin_amdgcn_s_waitcnt(0);
        unsigned nloc = b.st[0], nx = b.st[1];
        if (nloc == 0u) { xcd_barrier_complete(bar, b.x, nloc, nx); b.st[0] = nloc; b.st[1] = nx; }
        const unsigned old = xb_add(&bar[XB_XSUB(b.x)], 1u);
        const unsigned gen = old / nloc;
        if (old + 1u == (gen + 1u) * nloc) {
            __builtin_amdgcn_fence(__ATOMIC_RELEASE, "agent");
            asm volatile("s_waitcnt vmcnt(0)" ::: "memory");
            const unsigned og = xb_add(&bar[XB_TOP], 1u);
            const unsigned tg = og / nx;
            if (og + 1u == (tg + 1u) * nx) xb_add(&bar[XB_TOPGEN], 1u);
            else XB_SPIN(xb_ld(&bar[XB_TOPGEN]) == tg, bar);
            __builtin_amdgcn_fence(__ATOMIC_ACQUIRE, "agent");
            xb_add(&bar[XB_XGEN(b.x)], 1u);
            asm volatile("s_waitcnt vmcnt(0)" ::: "memory");
        } else {
            XB_SPIN(xb_ld(&bar[XB_XGEN(b.x)]) == gen, bar);
            __builtin_amdgcn_fence(__ATOMIC_ACQUIRE, "agent");
            asm volatile("s_waitcnt vmcnt(0)" ::: "memory");
        }
    }
    __syncthreads();
}

namespace pg8 {
constexpr int BM = 256, BK = 64, HALF = 128, HTB = HALF * BK * 2, STAGE_BYTES = 8 * HTB, NXCD = 8, WGM = 8;
__host__ __device__ __forceinline__ int lds_byte(int r, int c) { const int st = (r >> 4) * 2 + (c >> 5), rr = r & 15, cc = c & 31, ob = rr * 64 + cc * 2; return st * 1024 + (ob ^ (((ob >> 9) & 1) << 5)); }
__host__ __device__ __forceinline__ void stage_rc(int b, int& R, int& C) { const int st = b / 1024, sb = b % 1024, swz = sb ^ (((sb >> 9) & 1) << 5); R = (st >> 1) * 16 + swz / 64; C = (st & 1) * 32 + (swz % 64) / 2; }
__host__ __device__ __forceinline__ int perm32(int rho) { const int n = rho >> 4, i = rho & 15; return 8 * (i >> 2) + 4 * n + (i & 3); }

struct Unit { int pm, pn, pb; };
struct Gemm { const bf16_t* A; const bf16_t* Bt; int lda, ldb, K; };

struct DenseOrder {
    int nM, nN, nwg, G, c;
    __device__ void init(int nM_, int nN_, int G_, int c_) { nM = nM_; nN = nN_; nwg = nM * nN; G = G_; c = c_; }
    __device__ bool next(int i, Unit& u) const {
        const long L = (long)i * G + c; if (L >= nwg) return false;
        int wgid = (int)L; { const int q = nwg / NXCD, r = nwg % NXCD, xcd = wgid % NXCD, off = wgid / NXCD; wgid = (xcd < r ? xcd * (q + 1) : r * (q + 1) + (xcd - r) * q) + off; }
        const int nig = WGM * nN, gid = wgid / nig, fm = gid * WGM, gsz = (nM - fm) < WGM ? (nM - fm) : WGM;
        u.pm = fm + ((wgid % nig) % gsz); u.pn = (wgid % nig) / gsz; u.pb = u.pn; return true;
    }
    __device__ __forceinline__ void a_ready(const Unit&) const {}
};
struct GroupedOrder {
    int nM, nN, nwg, G, c; const LAS int* tile_e; const LAS int* pstart; const LAS int* cnt; const int* list;
    __device__ void init(int nN_, int G_, int c_, const LAS int* tab, const int* list_) { pstart = tab; cnt = tab + 64; tile_e = tab + 128; list = list_; nM = pstart[32] >> 8; nN = nN_; nwg = nM * nN; G = G_; c = c_; }
    __device__ bool next(int i, Unit& u) const {
        const long L = (long)i * G + c; if (L >= nwg) return false;
        const int w = (int)L; u.pn = w % nN; u.pm = w / nN; u.pb = tile_e[u.pm] * nN + u.pn; return true;
    }
    __device__ int arow(const Unit& u, int r) const { const int e = tile_e[u.pm], j = 256 * u.pm - pstart[e] + r; return j < cnt[e] ? list[e * T + j] : 0; }
    __device__ __forceinline__ void a_ready(const Unit&) const {}
};
struct RedealOrder {
    int nM, nN, nwg, G, c, r10, X, nlight, head; const LAS int* tile_e; unsigned* ready; unsigned need; unsigned* tmo;
    __device__ void init(int nN_, int G_, int c_, const LAS int* tab, int nN10, unsigned* ready_, unsigned need_, unsigned* tmo_) {
        tile_e = tab + 128; nM = tab[32] >> 8; nN = nN_; nwg = nM * nN; G = G_; c = c_; ready = ready_; need = need_; tmo = tmo_;
        r10 = (nM * nN10) % G; X = r10 ? 3 : 0; nlight = G - r10; head = X * nlight < nwg ? X * nlight : nwg; }
    __device__ bool next(int i, Unit& u) const {
        long id;
        if (c >= r10 && X) id = i < X ? (long)i * nlight + (c - r10) : (long)head + (long)(i - X) * G + c;
        else id = (long)head + (long)i * G + c;
        if ((i < X && c >= r10 && id >= head) || id >= nwg) return false;
        u.pm = (int)id / nN; u.pn = (int)id % nN; u.pb = tile_e[u.pm] * nN + u.pn; return true;
    }
    __device__ __forceinline__ void a_ready(const Unit& u) const {
        if (threadIdx.x < 64) {
            unsigned polls = 0;
            while ((unsigned)__builtin_amdgcn_readfirstlane(__hip_atomic_load(ready + 64 * u.pm, __ATOMIC_RELAXED, __HIP_MEMORY_SCOPE_AGENT)) < need) {
                if (++polls > (1u << 16)) { if (threadIdx.x == 0) __hip_atomic_store(tmo, 0xDEAD0000u | (unsigned)u.pm, __ATOMIC_RELAXED, __HIP_MEMORY_SCOPE_AGENT); break; }
                __builtin_amdgcn_s_sleep(2); }
            __builtin_amdgcn_fence(__ATOMIC_ACQUIRE, "agent");
            asm volatile("s_waitcnt vmcnt(0)" ::: "memory");
        }
        asm volatile("" ::: "memory"); __builtin_amdgcn_s_barrier(); asm volatile("" ::: "memory");
    }
};

template <class Epi, class Sched, bool GATHER = false>
__device__ __forceinline__ void gemm_phase(LAS unsigned char* lds, const Gemm g, const Sched& S, const Epi& E) {
    int tid = threadIdx.x; asm volatile("" : "+v"(tid));
    const int wid = __builtin_amdgcn_readfirstlane(tid >> 6), lane = tid & 63, wr = wid >> 2, wc = wid & 3, fr = lane & 15, fq = lane >> 4;
    const int K = g.K, nt = K / BK;
    unsigned voffA[2], voffB[2]; int gR[2], gC[2];
#pragma unroll
    for (int i = 0; i < 2; ++i) { int R, C; stage_rc(tid * 16 + i * 8192, R, C); const int Rb = (R & ~31) + perm32(R & 31); gR[i] = R; gC[i] = C;
        voffA[i] = (unsigned)(R * g.lda + C) * 2u; voffB[i] = (unsigned)(Rb * g.ldb + C) * 2u; }
    const size_t kstep = (size_t)(BK * 2);
    const size_t hsA = (size_t)HALF * g.lda * 2, hsB = (size_t)HALF * g.ldb * 2;
    const unsigned ldsw = (unsigned)wid * 1024u;
    const int aoff = lds_byte(wr * 64 + fr, fq * 8), boff = lds_byte(wc * 32 + fr, fq * 8);
#define PG8_SA(b, h) (((b) * 2 + (h)) * HTB)
#define PG8_SB(b, h) ((4 + (b) * 2 + (h)) * HTB)
#define PG8_STAGE(bufoff, gbase, voff) do { _Pragma("unroll") for (int _i = 0; _i < 2; ++_i) \
        __builtin_amdgcn_global_load_lds((const unsigned*)((const char*)(gbase) + (voff)[_i]), (LAS unsigned*)(lds + (bufoff) + ldsw + _i * 8192), 16, 0, 0); } while (0)
#define PG8_STAGE_A(bufoff, dense_ptr, kbytes, offs) do { if constexpr (GATHER) { PG8_STAGE(bufoff, (const char*)g.A + (kbytes), offs); } else { PG8_STAGE(bufoff, dense_ptr, voffA); } } while (0)
#define PG8_GOFF(u, o0, o1) do { _Pragma("unroll") for (int _i = 0; _i < 2; ++_i) { o0[_i] = (unsigned)(S.arow(u, gR[_i]) * g.lda + gC[_i]) * 2u; o1[_i] = (unsigned)(S.arow(u, gR[_i] + HALF) * g.lda + gC[_i]) * 2u; } } while (0)
#define PG8_LDA(dst, b, h) do { _Pragma("unroll") for (int m = 0; m < 4; ++m) _Pragma("unroll") for (int k = 0; k < 2; ++k) dst[m][k] = *(const LAS bf16x8*)(lds + PG8_SA(b, h) + aoff + m * 2048 + k * 1024); } while (0)
#define PG8_LDB(dst, b, h) do { _Pragma("unroll") for (int n = 0; n < 2; ++n) _Pragma("unroll") for (int k = 0; k < 2; ++k) dst[n][k] = *(const LAS bf16x8*)(lds + PG8_SB(b, h) + boff + n * 2048 + k * 1024); } while (0)
#define PG8_MMA(ai, bj, At, Bt) do { __builtin_amdgcn_s_setprio(1); _Pragma("unroll") for (int m = 0; m < 4; ++m) _Pragma("unroll") for (int n = 0; n < 2; ++n) _Pragma("unroll") for (int k = 0; k < 2; ++k) \
        acc[ai][bj][m][n] = __builtin_amdgcn_mfma_f32_16x16x32_bf16(Bt[n][k], At[m][k], acc[ai][bj][m][n], 0, 0, 0); __builtin_amdgcn_s_setprio(0); } while (0)
#define PG8_WAIT_V(n) asm volatile("s_waitcnt vmcnt(" #n ")" ::: "memory")
#define PG8_WAIT_L(n) asm volatile("s_waitcnt lgkmcnt(" #n ")" ::: "memory")
#define PG8_BAR __builtin_amdgcn_s_barrier()
#define PG8_SCHED __builtin_amdgcn_sched_barrier(0)
    Unit cur, nxt; int ui = 0;
    if (!S.next(0, cur)) return;
    unsigned cO0[2] = {0u, 0u}, cO1[2] = {0u, 0u}, nO0[2] = {0u, 0u}, nO1[2] = {0u, 0u};
    if constexpr (GATHER) { PG8_GOFF(cur, cO0, cO1); }
    S.a_ready(cur);
    f32x4 acc[2][2][4][2];
#pragma unroll
    for (int a = 0; a < 2; ++a)
#pragma unroll
        for (int b = 0; b < 2; ++b)
#pragma unroll
            for (int m = 0; m < 4; ++m)
#pragma unroll
                for (int n = 0; n < 2; ++n) acc[a][b][m][n] = (f32x4){0.f, 0.f, 0.f, 0.f};
    bf16x8 At[4][2], B0[2][2], B1[2][2];
    const char* cA = (const char*)g.A + (GATHER ? (size_t)0 : (size_t)cur.pm * 2 * hsA); const char* cB = (const char*)g.Bt + (size_t)cur.pb * 2 * hsB;
    PG8_STAGE(PG8_SB(0, 0), cB, voffB); PG8_STAGE(PG8_SB(0, 1), cB + hsB, voffB); PG8_STAGE_A(PG8_SA(0, 0), cA, 0, cO0); PG8_STAGE_A(PG8_SA(0, 1), cA + hsA, 0, cO1);
    if (wr == 1) PG8_BAR;
    PG8_WAIT_V(2); PG8_BAR;
    PG8_STAGE(PG8_SB(1, 0), cB + kstep, voffB); PG8_STAGE_A(PG8_SA(1, 0), cA + kstep, kstep, cO0); PG8_STAGE(PG8_SB(1, 1), cB + hsB + kstep, voffB);
    PG8_WAIT_V(6); PG8_BAR;
    for (;;) {
        const bool has_next = S.next(ui + 1, nxt);
        const char* nA = (has_next && !GATHER) ? (const char*)g.A + (size_t)nxt.pm * 2 * hsA : cA; const char* nB = has_next ? (const char*)g.Bt + (size_t)nxt.pb * 2 * hsB : cB;
        if constexpr (GATHER) { if (has_next) { PG8_GOFF(nxt, nO0, nO1); } else { nO0[0] = cO0[0]; nO0[1] = cO0[1]; nO1[0] = cO1[0]; nO1[1] = cO1[1]; } }
        for (int t = 0; t < nt; t += 2) {
            const bool last = (t == nt - 2);
            if (last && has_next) S.a_ready(nxt);
            const char* a1 = cA + (size_t)(t + 1) * kstep;
            const char* a2 = last ? nA : cA + (size_t)(t + 2) * kstep; const char* b2 = last ? nB : cB + (size_t)(t + 2) * kstep;
            const char* a3 = a2 + kstep; const char* b3 = b2 + kstep;
            const size_t k2 = last ? (size_t)0 : (size_t)(t + 2) * kstep;
            unsigned o0[2], o1[2]; o0[0] = last ? nO0[0] : cO0[0]; o0[1] = last ? nO0[1] : cO0[1]; o1[0] = last ? nO1[0] : cO1[0]; o1[1] = last ? nO1[1] : cO1[1];
            PG8_LDB(B0, 0, 0); PG8_LDB(B1, 0, 1); PG8_SCHED; PG8_LDA(At, 0, 0); PG8_STAGE_A(PG8_SA(1, 1), a1 + hsA, (size_t)(t + 1) * kstep, cO1);
            PG8_WAIT_V(8); PG8_WAIT_L(0); PG8_BAR; PG8_MMA(0, 0, At, B0); PG8_MMA(0, 1, At, B1); PG8_BAR; PG8_SCHED;
            PG8_LDA(At, 0, 1); PG8_STAGE(PG8_SB(0, 0), b2, voffB); PG8_STAGE(PG8_SB(0, 1), b2 + hsB, voffB); PG8_STAGE_A(PG8_SA(0, 0), a2, k2, o0);
            PG8_WAIT_V(8); PG8_WAIT_L(0); PG8_BAR; PG8_MMA(1, 0, At, B0); PG8_MMA(1, 1, At, B1); PG8_BAR; PG8_SCHED;
            PG8_LDB(B0, 1, 0); PG8_LDB(B1, 1, 1); PG8_SCHED; PG8_LDA(At, 1, 0); PG8_STAGE_A(PG8_SA(0, 1), a2 + hsA, k2, o1);
            PG8_WAIT_V(8); PG8_WAIT_L(0); PG8_BAR; PG8_MMA(0, 0, At, B0); PG8_MMA(0, 1, At, B1); PG8_BAR; PG8_SCHED;
            PG8_LDA(At, 1, 1); PG8_STAGE(PG8_SB(1, 0), b3, voffB); PG8_STAGE(PG8_SB(1, 1), b3 + hsB, voffB); PG8_STAGE_A(PG8_SA(1, 0), a3, k2 + kstep, o0);
            PG8_WAIT_V(8); PG8_WAIT_L(0); PG8_BAR; PG8_MMA(1, 0, At, B0); PG8_MMA(1, 1, At, B1); PG8_BAR; PG8_SCHED;
        }
        if (wr == 0) PG8_BAR;
        E(acc, cur, wr, wc, fr, fq);
        if (!has_next) break;
#pragma unroll
        for (int a = 0; a < 2; ++a)
#pragma unroll
            for (int b = 0; b < 2; ++b)
#pragma unroll
                for (int m = 0; m < 4; ++m)
#pragma unroll
                    for (int n = 0; n < 2; ++n) acc[a][b][m][n] = (f32x4){0.f, 0.f, 0.f, 0.f};
        cur = nxt; cA = nA; cB = nB; ++ui;
        if constexpr (GATHER) { cO0[0] = nO0[0]; cO0[1] = nO0[1]; cO1[0] = nO1[0]; cO1[1] = nO1[1]; }
        if (wr == 1) PG8_BAR;
    }
    PG8_WAIT_V(0);
    PG8_BAR;
#undef PG8_SA
#undef PG8_SB
#undef PG8_STAGE
#undef PG8_STAGE_A
#undef PG8_GOFF
#undef PG8_LDA
#undef PG8_LDB
#undef PG8_MMA
#undef PG8_WAIT_V
#undef PG8_WAIT_L
#undef PG8_BAR
#undef PG8_SCHED
}

struct EpiStore {
    bf16_t* O; int ldc; const float* ssq; float inv; float* ssq_out0; float* ssq_out1; int pn0, pn1, pn2;
    __device__ __forceinline__ void operator()(const f32x4 (&acc)[2][2][4][2], const Unit& u, int wr, int wc, int fr, int fq) const {
        const int row0 = u.pm * BM + wr * 64 + fr, col0 = u.pn * BM + wc * 32 + 8 * fq;
        float* so = (ssq_out0 && u.pn >= pn0 && u.pn < pn2) ? (u.pn < pn1 ? ssq_out0 : ssq_out1) : nullptr;
#pragma unroll
        for (int ai = 0; ai < 2; ++ai)
#pragma unroll
            for (int m = 0; m < 4; ++m) { const int row = row0 + ai * HALF + m * 16; const float rs = ssq ? rsqrtf(ssq[row] * inv + EPS) : 1.f;
                bf16_t* rowp = O + (size_t)row * ldc + col0; float ss = 0.f;
#pragma unroll
                for (int bj = 0; bj < 2; ++bj) { const f32x4 v0 = acc[ai][bj][m][0] * rs, v1 = acc[ai][bj][m][1] * rs;
                    ss += (v0[0] * v0[0] + v0[1] * v0[1]) + (v0[2] * v0[2] + v0[3] * v0[3]) + (v1[0] * v1[0] + v1[1] * v1[1]) + (v1[2] * v1[2] + v1[3] * v1[3]);
                    u32x4 w; w.x = cvt_pk_bf16(v0[0], v0[1]); w.y = cvt_pk_bf16(v0[2], v0[3]); w.z = cvt_pk_bf16(v1[0], v1[1]); w.w = cvt_pk_bf16(v1[2], v1[3]);
                    *(u32x4*)(rowp + bj * HALF) = w; }
                if (so) { ss += __shfl_xor(ss, 16); ss += __shfl_xor(ss, 32); if (fq == 0) atomicAdd(so + row, ss); } }
    }
};
struct EpiResid {
    const float* X; float* O; const float* gate; int gpitch;
    __device__ __forceinline__ void operator()(const f32x4 (&acc)[2][2][4][2], const Unit& u, int wr, int wc, int fr, int fq) const {
        const int row0 = u.pm * BM + wr * 64 + fr, col0 = u.pn * BM + wc * 32 + 8 * fq;
        const float* gp = gate + (size_t)((u.pm * BM) / SEQ) * gpitch + col0;
        f32x4 gv[2][2];
#pragma unroll
        for (int bj = 0; bj < 2; ++bj)
#pragma unroll
            for (int n = 0; n < 2; ++n) gv[bj][n] = *(const f32x4*)(gp + bj * HALF + 4 * n);
#pragma unroll
        for (int ai = 0; ai < 2; ++ai)
#pragma unroll
            for (int m = 0; m < 4; ++m) { const size_t off = (size_t)(row0 + ai * HALF + m * 16) * DM + col0;
#pragma unroll
                for (int bj = 0; bj < 2; ++bj)
#pragma unroll
                    for (int n = 0; n < 2; ++n) { const f32x4 xv = *(const f32x4*)(X + off + bj * HALF + 4 * n);
                        *(f32x4*)(O + off + bj * HALF + 4 * n) = xv + gv[bj][n] * acc[ai][bj][m][n]; } }
    }
};
struct EpiSwiGLU {
    bf16_t* O; unsigned* ready;
    __device__ __forceinline__ void operator()(const f32x4 (&acc)[2][2][4][2], const Unit& u, int wr, int wc, int fr, int fq) const {
        const int row0 = u.pm * BM + wr * 64 + fr, col0 = u.pn * HALF + wc * 32 + 8 * fq;
        const __amdgpu_buffer_rsrc_t rs = __builtin_amdgcn_make_buffer_rsrc((void*)O, (short)0, RMAX * DE * 2, 0x00020000);
#pragma unroll
        for (int ai = 0; ai < 2; ++ai)
#pragma unroll
            for (int m = 0; m < 4; ++m) { const int row = row0 + ai * HALF + m * 16;
                float h[8];
#pragma unroll
                for (int n = 0; n < 2; ++n)
#pragma unroll
                    for (int j = 0; j < 4; ++j) { const float gt = acc[ai][0][m][n][j], up = acc[ai][1][m][n][j]; h[4 * n + j] = gt / (1.f + __expf(-gt)) * up; }
                u32x4 w; w.x = cvt_pk_bf16(h[0], h[1]); w.y = cvt_pk_bf16(h[2], h[3]); w.z = cvt_pk_bf16(h[4], h[5]); w.w = cvt_pk_bf16(h[6], h[7]);
                __builtin_amdgcn_raw_buffer_store_b128(w, rs, (unsigned)(row * DE + col0) * 2u, 0, 16); }
        asm volatile("s_waitcnt vmcnt(0)" ::: "memory");
        if ((threadIdx.x & 63) == 0) __hip_atomic_fetch_add(ready + 64 * u.pm, 1u, __ATOMIC_RELAXED, __HIP_MEMORY_SCOPE_AGENT);
    }
};
}
constexpr size_t MiB = 1u << 20;
constexpr size_t WS_CTL = 0, CTL_ZERO_BYTES = 1 * MiB;
constexpr size_t WS_MOD = 1 * MiB;
constexpr size_t WS_ROPEC = 1 * MiB + 512 * 1024;
constexpr size_t WS_ROPES = WS_ROPEC + 2 * MiB;
constexpr size_t WS_WCT = WS_ROPES + 2 * MiB;
constexpr size_t WS_RSTDQ = 6 * MiB;
constexpr size_t WS_RSTDKV = WS_RSTDQ + 64 * 1024;
constexpr size_t WS_TOKE = WS_RSTDKV + 64 * 1024;
constexpr size_t WS_TOKW = WS_TOKE + 128 * 1024;
constexpr size_t WS_TOKS = WS_TOKW + 128 * 1024;
constexpr size_t WS_BLKE = WS_TOKS + 128 * 1024;
constexpr size_t WS_STAMP = WS_BLKE + 4096;
constexpr size_t WS_WIN = 8 * MiB;
constexpr size_t WS_WQUP = 28 * MiB;
constexpr size_t WS_WKVUP = WS_WQUP + 1536 * 1024;
constexpr size_t WS_WOUT = 31 * MiB;
constexpr size_t WS_A = 40 * MiB;
constexpr size_t WS_B = 200 * MiB;
constexpr size_t WS_C = 264 * MiB;
constexpr size_t WS_D = 328 * MiB;
constexpr size_t WS_E = 456 * MiB;
constexpr size_t WS_LIST = 520 * MiB;
constexpr size_t WS_F = 522 * MiB;
constexpr size_t WS_END = 586 * MiB;
constexpr size_t QN_BYTES = (size_t)T * MH * MQK * 2;

constexpr int CW_BAR = 4096;
constexpr int CW_CNT = 8192;
constexpr int CW_RDY = 10240;
constexpr int CW_TMO = 1;

constexpr int RING_BYTES = 131072, LDS_BYTES = 147456, LDS_USER = 143360, MISC_OFF = LDS_BYTES - 512;

struct Args { const float* in[25]; float* out; unsigned char* ws; int ph_lo, ph_hi, pad0, pad1; };

struct Frame {
    LAS unsigned char* lds;
    volatile LAS unsigned* MISC;
    gu32* ctl;
    int tid, lane, wave, vcu, G;
    unsigned char* ws; float* out;
};

#define OPAQUE_FRAME(F) do { F.tid = threadIdx.x; asm volatile("" : "+v"(F.tid)); F.lane = F.tid & 63; } while (0)

__device__ __forceinline__ void unpack8(const u32x4 w, float* f) { f[0] = bf_lo(w.x); f[1] = bf_hi(w.x); f[2] = bf_lo(w.y); f[3] = bf_hi(w.y); f[4] = bf_lo(w.z); f[5] = bf_hi(w.z); f[6] = bf_lo(w.w); f[7] = bf_hi(w.w); }
__device__ __forceinline__ u32x4 pack8f(const float* f) { u32x4 w; w.x = cvt_pk_bf16(f[0], f[1]); w.y = cvt_pk_bf16(f[2], f[3]); w.z = cvt_pk_bf16(f[4], f[5]); w.w = cvt_pk_bf16(f[6], f[7]); return w; }

struct TrItem { const float* src; bf16_t* dst; bf16_t* dst2; const float* gk; int N, ldt; };
__device__ __forceinline__ void tr_load(const TrItem& it, f32x4 (&r)[16], int lane) {
    const float* p = it.src + (size_t)(lane >> 4) * it.N + 4 * (lane & 15);
#pragma unroll
    for (int i = 0; i < 16; ++i) r[i] = __builtin_nontemporal_load((const f32x4*)(p + (size_t)(4 * i) * it.N));
}
__device__ __forceinline__ void tr_store(const TrItem& it, const f32x4 (&r)[16], LAS unsigned char* Tl, int lane) {
    const int row = lane >> 4, c4 = lane & 15;
#pragma unroll
    for (int i = 0; i < 16; ++i) { f32x4 v = r[i]; if (it.gk) v = v * it.gk[4 * i + row];
        u32x2 w; w.x = cvt_pk_bf16(v.x, v.y); w.y = cvt_pk_bf16(v.z, v.w);
        *(LAS u32x2*)(Tl + ((4 * i + row) * 64 + 4 * c4) * 2) = w; }
    LDS_WAIT(); asm volatile("" ::: "memory");
    const int g = lane >> 4, i16 = lane & 15, q = i16 >> 2, pp = lane & 3;
    typedef short v4i16_t __attribute__((ext_vector_type(4)));
#pragma unroll
    for (int hh = 0; hh < 2; ++hh) { bf16_t* drow = (hh ? it.dst2 : it.dst) + (size_t)(16 * (g & 1) + i16) * it.ldt;
#pragma unroll
        for (int j = 0; j < 4; ++j) { const int kc = 4 * (g >> 1) + j;
            const v4i16_t lo = __builtin_amdgcn_ds_read_tr16_b64_v4i16((LAS v4i16_t*)(Tl + ((8 * kc + q) * 64 + 32 * hh + 16 * (g & 1) + 4 * pp) * 2));
            const v4i16_t hi = __builtin_amdgcn_ds_read_tr16_b64_v4i16((LAS v4i16_t*)(Tl + ((8 * kc + 4 + q) * 64 + 32 * hh + 16 * (g & 1) + 4 * pp) * 2));
            const bf16x8 o = {lo[0], lo[1], lo[2], lo[3], hi[0], hi[1], hi[2], hi[3]};
            *(bf16x8*)(drow + 8 * kc) = o; } }
    LDS_WAIT(); asm volatile("" ::: "memory");
}
template <class MK> __device__ __forceinline__ void tr_run(int first, int step, int n, const MK& mk, LAS unsigned char* Tl, int lane) {
    if (first >= n) return;
    f32x4 ra[16], rb[16];
    TrItem ia = mk(first), ib = ia;
    tr_load(ia, ra, lane);
    for (int idx = first; idx < n; idx += 2 * step) {
        if (idx + step < n) { ib = mk(idx + step); tr_load(ib, rb, lane); }
        tr_store(ia, ra, Tl, lane);
        if (idx + step >= n) break;
        if (idx + 2 * step < n) { ia = mk(idx + 2 * step); tr_load(ia, ra, lane); }
        tr_store(ib, rb, Tl, lane);
    }
}

__device__ __forceinline__ void adaln_phase(Frame& F, const float* c, const float* w_ada, const float* b_ada, float* mod) {
    LAS float* cact = (LAS float*)F.lds;
    LAS float* part = (LAS float*)(F.lds + 65536);
    for (int i = F.tid; i < NB * DM; i += NTHR) cact[i] = siluf(c[i]);
    __syncthreads();
    const int cg = F.tid & 7, rs = F.tid >> 3;
    for (int it = blockIdx.x; it < 6 * DM / 32; it += F.G) {
        const int n0 = it * 32 + cg * 4;
        f32x4 acc[8];
#pragma unroll
        for (int b = 0; b < 8; ++b) acc[b] = (f32x4){0.f, 0.f, 0.f, 0.f};
#pragma unroll 1
        for (int i0 = 0; i0 < 32; i0 += 16) { f32x4 w[16];
#pragma unroll
            for (int u = 0; u < 16; ++u) w[u] = __builtin_nontemporal_load((const f32x4*)(w_ada + (size_t)(rs + 64 * (i0 + u)) * (6 * DM) + n0));
#pragma unroll
            for (int u = 0; u < 16; ++u) { const int k = rs + 64 * (i0 + u);
#pragma unroll
                for (int b = 0; b < 8; ++b) acc[b] += w[u] * cact[b * DM + k]; } }
#pragma unroll
        for (int b = 0; b < 8; ++b) *(LAS f32x4*)(part + (rs * 8 + b) * 32 + cg * 4) = acc[b];
        __syncthreads();
        if (F.tid < 256) { const int b = F.tid >> 5, n = F.tid & 31; float s = 0.f;
#pragma unroll 8
            for (int r = 0; r < 64; ++r) s += part[(r * 8 + b) * 32 + n];
            mod[b * (6 * DM) + it * 32 + n] = s + b_ada[it * 32 + n]; }
        __syncthreads();
    }
}

__device__ __forceinline__ void p0_phase(Frame& F, const Args& a) {
    OPAQUE_FRAME(F);
    unsigned char* ws = F.ws;
    adaln_phase(F, a.in[1], a.in[3], a.in[4], (float*)(ws + WS_MOD));
    __syncthreads();
    LAS unsigned char* Tl = F.lds + F.wave * 8192;
    const int gw = F.vcu * NWAVES + F.wave, NGW = F.G * NWAVES;
    constexpr int I_IN = (DM / 64) * (INC / 64), I_QUP = (QLORA / 64) * (MH * MQK / 64), I_KVUP = (KVLORA / 64) * (MH * 256 / 64), I_OUT = (DM / 64) * (DM / 64);
    constexpr int NITEMS = I_IN + I_QUP + I_KVUP + I_OUT;
    static_assert(INC % 64 == 0, "64-column transpose items");
    { const float* w_in = a.in[6]; const float* w_qup = a.in[10]; const float* w_kvup = a.in[12]; const float* w_out = a.in[16]; const float* gq = a.in[9]; const float* gkv = a.in[11];
      auto mk = [=](int r) -> TrItem { TrItem t;
          if (r < I_IN) { const int nblk = INC / 64, kb = r / nblk, nb = r % nblk; t.src = w_in + (size_t)(64 * kb) * INC + 64 * nb; t.dst = (bf16_t*)(ws + WS_WIN) + (size_t)(64 * nb) * DM + 64 * kb; t.dst2 = t.dst + (size_t)32 * DM; t.gk = nullptr; t.N = INC; t.ldt = DM; return t; } r -= I_IN;
          if (r < I_QUP) { const int nblk = MH * MQK / 64, kb = r / nblk, nb = r % nblk; t.src = w_qup + (size_t)(64 * kb) * (MH * MQK) + 64 * nb; t.dst = (bf16_t*)(ws + WS_WQUP) + (size_t)(64 * nb) * QLORA + 64 * kb; t.dst2 = t.dst + (size_t)32 * QLORA; t.gk = gq + 64 * kb; t.N = MH * MQK; t.ldt = QLORA; return t; } r -= I_QUP;
          if (r < I_KVUP) { const int nblk = MH * 256 / 64, kb = r / nblk, nb = r % nblk; t.src = w_kvup + (size_t)(64 * kb) * (MH * 256) + 64 * nb; t.dst = (bf16_t*)(ws + WS_WKVUP) + (size_t)(64 * nb) * KVLORA + 64 * kb; t.dst2 = t.dst + (size_t)32 * KVLORA; t.gk = gkv + 64 * kb; t.N = MH * 256; t.ldt = KVLORA; return t; } r -= I_KVUP;
          { const int nblk = DM / 64, kb = r / nblk, nb = r % nblk; t.src = w_out + (size_t)(64 * kb) * DM + 64 * nb; t.dst = (bf16_t*)(ws + WS_WOUT) + (size_t)(64 * nb) * DM + 64 * kb; t.dst2 = t.dst + (size_t)32 * DM; t.gk = nullptr; t.N = DM; t.ldt = DM; return t; } };
      tr_run(gw, NGW, NITEMS, mk, Tl, F.lane); }
    { const int* pos = (const int*)a.in[2]; float* rc = (float*)(ws + WS_ROPEC); float* rsn = (float*)(ws + WS_ROPES);
      const int gt = F.vcu * NTHR + F.tid, NGT = F.G * NTHR;
      const float invf = (float)exp2(-(double)(gt & 31) * (13.287712379549449 / 32.0));
      for (int e = gt; e < T * 32; e += NGT) { const int tk = e >> 5;
          const float ang = (float)pos[tk] * invf; float sv, cv; sincosf(ang, &sv, &cv);
          rc[e] = cv; rsn[e] = sv; }
      { float* ssq = (float*)(ws + WS_RSTDQ); for (int e = gt; e < 2 * T; e += NGT) ssq[e] = 0.f; }
      float* wct = (float*)(ws + WS_WCT);
      for (int e = gt; e < 48 * DM; e += NGT) { const int n = e / DM, k = e % DM;
          wct[e] = n < 4 ? a.in[18][k * NG + n] : (n < 36 ? a.in[20][k * NE + (n - 4)] : 0.f); } }
}

__device__ __forceinline__ void modnorm_row(const float* xrow, const float* g, const float* shift, const float* scale, bf16_t* orow, int lane) {
    const f32x4* xr = (const f32x4*)xrow + lane;
    f32x4 v[8]; float s = 0.f;
#pragma unroll
    for (int j = 0; j < 8; ++j) { v[j] = __builtin_nontemporal_load(xr + 64 * j); s += (v[j].x * v[j].x + v[j].y * v[j].y) + (v[j].z * v[j].z + v[j].w * v[j].w); }
    const float rstd = rsqrtf(wave_sum(s) * (1.f / DM) + EPS);
    u32x2* o8 = (u32x2*)orow + lane;
#pragma unroll
    for (int j = 0; j < 8; ++j) { const f32x4 gg = ((const f32x4*)g)[64 * j + lane], sh = ((const f32x4*)shift)[64 * j + lane], sc = ((const f32x4*)scale)[64 * j + lane];
        const f32x4 h = v[j] * rstd * gg * (sc + 1.f) + sh;
        u32x2 w; w.x = cvt_pk_bf16(h.x, h.y); w.y = cvt_pk_bf16(h.z, h.w); o8[64 * j] = w; }
}
__device__ __forceinline__ void p1_phase(Frame& F, const Args& a) {
    OPAQUE_FRAME(F);
    const int gw = F.vcu * NWAVES + F.wave, NGW = F.G * NWAVES;
    const float* mod = (const float*)(F.ws + WS_MOD);
    bf16_t* H = (bf16_t*)(F.ws + WS_B);
    for (int m = gw; m < T; m += NGW) { const int b = m / SEQ;
        modnorm_row(a.in[0] + (size_t)m * DM, a.in[5], mod + b * (6 * DM), mod + b * (6 * DM) + DM, H + (size_t)m * DM, F.lane); }
}

template <int CTRL> __device__ __forceinline__ float dppf(float x) { return __builtin_bit_cast(float, __builtin_amdgcn_update_dpp(0, __builtin_bit_cast(int, x), CTRL, 0xF, 0xF, true)); }

namespace hg {
constexpr int OFF_F = 0, OFF_SEG = 32768, OFF_QIN = 34816, RP = 272, OFF_KIN = OFF_QIN + 64 * RP, OFF_QB = OFF_KIN + 64 * RP, OFF_KLT = OFF_QB + 64 * RP, SP = 144,
              OFF_VT = OFF_KLT + 128 * SP  , OFF_DEC = OFF_VT + 64 * SP  , OFF_SF = OFF_DEC + 3584  , HG_LDS = OFF_SF + 16384;
static_assert(HG_LDS <= LDS_USER, "hgrn lds");
__device__ __forceinline__ int ppos(int s) { return (s & ~15) | ((s & 4) << 1) | ((s & 8) >> 1) | (s & 3); }
}
__device__ __forceinline__ void hgrn_chunked(Frame& F, const Args& a, int item) {
    using namespace hg;
    const bf16_t* PROJ = (const bf16_t*)(F.ws + WS_A);
    bf16_t* MIX = (bf16_t*)(F.ws + WS_E);
    const float* lbl = a.in[7];
    LAS unsigned char* L = F.lds;
    LAS float* Fs = (LAS float*)(L + OFF_F); LAS float* SEGs = (LAS float*)(L + OFF_SEG); LAS float* DEC = (LAS float*)(L + OFF_DEC); LAS float* POST = DEC + 384;
    const int g = F.tid & 15, t0 = F.tid >> 4;
    const int sk = F.tid & 127, sseg = F.tid >> 7;
    const int r32 = F.lane & 31, hi = F.lane >> 5;
    {
        const int dq2 = (item >> 3) & 1, bh = (item >> 4) * 8 + (item & 7), h = bh & 7, b = bh >> 3;
        float lb[8];
#pragma unroll
        for (int j = 0; j < 8; ++j) { const int k = h * 128 + g * 8 + j; lb[j] = 1.f / (1.f + __expf(lbl[HW + k] - lbl[k])); }
        const bf16_t* base = PROJ + (size_t)(b * SEQ) * INCP + h * 128;
        f32x16 S0 = {}, S1 = {};
        u32x4 gq[2], gf[2], gv;
#define HG_LOADF(c) do { _Pragma("unroll") for (int i = 0; i < 2; ++i) gf[i] = *(const u32x4*)(base + (size_t)((c) * 64 + t0 + 32 * i) * INCP + g * 8 + HW); } while (0)
#define HG_LOADQ(c) do { _Pragma("unroll") for (int i = 0; i < 2; ++i) gq[i] = *(const u32x4*)(base + (size_t)((c) * 64 + t0 + 32 * i) * INCP + g * 8); \
            gv = *(const u32x4*)(base + (size_t)((c) * 64 + (F.tid >> 3)) * INCP + 2 * HW + dq2 * 64 + (F.tid & 7) * 8); } while (0)
        HG_LOADF(0); HG_LOADQ(0);
        for (int c = 0; c < SEQ / 64; ++c) {
            if (F.wave >= 4) { const int kb = F.wave - 4;
#pragma unroll
                for (int s2 = 0; s2 < 2; ++s2) { u32x4 w0, w1;
                    w0.x = cvt_pk_bf16(S0[8 * s2], S0[8 * s2 + 1]); w0.y = cvt_pk_bf16(S0[8 * s2 + 2], S0[8 * s2 + 3]); w0.z = cvt_pk_bf16(S0[8 * s2 + 4], S0[8 * s2 + 5]); w0.w = cvt_pk_bf16(S0[8 * s2 + 6], S0[8 * s2 + 7]);
                    w1.x = cvt_pk_bf16(S1[8 * s2], S1[8 * s2 + 1]); w1.y = cvt_pk_bf16(S1[8 * s2 + 2], S1[8 * s2 + 3]); w1.z = cvt_pk_bf16(S1[8 * s2 + 4], S1[8 * s2 + 5]); w1.w = cvt_pk_bf16(S1[8 * s2 + 6], S1[8 * s2 + 7]);
                    *(LAS u32x4*)(L + OFF_SF + ((((kb * 2 + 0) * 2 + s2) * 64) + F.lane) * 16) = w0;
                    *(LAS u32x4*)(L + OFF_SF + ((((kb * 2 + 1) * 2 + s2) * 64) + F.lane) * 16) = w1; } }
            float fv[2][8];
#pragma unroll
            for (int i = 0; i < 2; ++i) { float fl[8]; unpack8(gf[i], fl);
#pragma unroll
                for (int j = 0; j < 8; ++j) { const float sg = __builtin_amdgcn_rcpf(1.f + __builtin_amdgcn_exp2f(-1.4426950408889634f * fl[j])); fv[i][j] = lb[j] + (1.f - lb[j]) * sg; }
                LAS float* fp = Fs + (t0 + 32 * i) * 128 + g * 8;
                *(LAS f32x4*)fp = (f32x4){fv[i][0], fv[i][1], fv[i][2], fv[i][3]}; *(LAS f32x4*)(fp + 4) = (f32x4){fv[i][4], fv[i][5], fv[i][6], fv[i][7]}; }
            if (c + 1 < SEQ / 64) HG_LOADF(c + 1);
            __syncthreads();
            float klp[16];
            { float fr[16];
#pragma unroll
              for (int i = 0; i < 16; ++i) fr[i] = Fs[(16 * sseg + i) * 128 + sk];
              float p = 1.f;
#pragma unroll
              for (int i = 0; i < 16; ++i) { p *= fr[i]; Fs[(16 * sseg + i) * 128 + sk] = p; }
              SEGs[sseg * 128 + sk] = p;
              float q = 1.f;
#pragma unroll
              for (int i = 15; i >= 0; --i) { klp[i] = (1.f - fr[i]) * q; q *= fr[i]; } }
            __syncthreads();
            if (F.tid < 128) { const float s0 = SEGs[F.tid], s1 = SEGs[128 + F.tid], s2 = SEGs[256 + F.tid], s3 = SEGs[384 + F.tid];
                const float pm = s0 * s1;
                SEGs[F.tid] = 1.f; SEGs[128 + F.tid] = s0; SEGs[256 + F.tid] = pm; SEGs[384 + F.tid] = pm * s2;
                POST[F.tid] = s1 * s2 * s3; POST[128 + F.tid] = s2 * s3; POST[256 + F.tid] = s3; POST[384 + F.tid] = 1.f;
                DEC[F.tid] = pm * s2 * s3; DEC[128 + F.tid] = pm; DEC[256 + F.tid] = __builtin_amdgcn_rcpf(pm); }
            __syncthreads();
            { { const float po = POST[sseg * 128 + sk];
                float o16[16];
#pragma unroll
                for (int p = 0; p < 16; ++p) o16[p] = klp[8 * ((p >> 2) & 1) + 4 * (p >> 3) + (p & 3)] * po;
                *(LAS u32x4*)(L + OFF_KLT + sk * SP + sseg * 32) = pack8f(o16); *(LAS u32x4*)(L + OFF_KLT + sk * SP + sseg * 32 + 16) = pack8f(o16 + 8); }
#pragma unroll
              for (int i = 0; i < 2; ++i) { const int t = t0 + 32 * i;
                  float qin[8], kin[8], qb[8], qv[8];
                  unpack8(gq[i], qv);
                  const LAS float* fp = Fs + t * 128 + g * 8; const LAS float* pp = SEGs + (t >> 4) * 128 + g * 8;
                  const f32x4 pa = *(const LAS f32x4*)fp, pb = *(const LAS f32x4*)(fp + 4), ea = *(const LAS f32x4*)pp, eb = *(const LAS f32x4*)(pp + 4);
                  const f32x4 ma = *(const LAS f32x4*)(DEC + 128 + g * 8), mb = *(const LAS f32x4*)(DEC + 128 + g * 8 + 4), ra = *(const LAS f32x4*)(DEC + 256 + g * 8), rb = *(const LAS f32x4*)(DEC + 256 + g * 8 + 4);
#pragma unroll
                  for (int j = 0; j < 8; ++j) { const float P = (j < 4 ? pa[j] * ea[j] : pb[j - 4] * eb[j - 4]), pm = j < 4 ? ma[j] : mb[j - 4], rpm = j < 4 ? ra[j] : rb[j - 4];
                      const float r = __builtin_amdgcn_rcpf(P), kk = 1.f - fv[i][j], qs = qv[j] * 0.08838834764831845f;
                      qb[j] = qs * P; qin[j] = qb[j] * rpm; kin[j] = kk * pm * r; }
                  *(LAS u32x4*)(L + OFF_QIN + t * RP + g * 16) = pack8f(qin);
                  *(LAS u32x4*)(L + OFF_KIN + t * RP + g * 16) = pack8f(kin);
                  { const u32x4 w = pack8f(qb);
                    *(LAS u32x2*)(L + OFF_QB + t * RP + ((g >> 1) * 16 + (g & 1) * 4) * 2) = (u32x2){w.x, w.y};
                    *(LAS u32x2*)(L + OFF_QB + t * RP + ((g >> 1) * 16 + 8 + (g & 1) * 4) * 2) = (u32x2){w.z, w.w}; } }
              { float v[8]; unpack8(gv, v); const int s = F.tid >> 3, dvg = F.tid & 7, ps = ppos(s);
#pragma unroll
                  for (int j = 0; j < 8; ++j) *(LAS bf16_t*)(L + OFF_VT + (dvg * 8 + j) * SP + ps * 2) = (bf16_t)(__builtin_bit_cast(unsigned, v[j]) >> 16); } }
            if (c + 1 < SEQ / 64) HG_LOADQ(c + 1);
            __syncthreads();
            if (F.wave < 4) { const int tb = F.wave & 1, dvb = F.wave >> 1;
                f32x16 o = {};
                for (int sb = 0; sb <= tb; ++sb) { f32x16 X = {};
#pragma unroll
                    for (int ks = 0; ks < 8; ++ks) { const bf16x8 af = *(const LAS bf16x8*)(L + OFF_KIN + (32 * sb + r32) * RP + (16 * ks + 8 * hi) * 2);
                        const bf16x8 bfr = *(const LAS bf16x8*)(L + OFF_QIN + (32 * tb + r32) * RP + (16 * ks + 8 * hi) * 2);
                        X = __builtin_amdgcn_mfma_f32_32x32x16_bf16(af, bfr, X, 0, 0, 0); }
                    if (sb == tb) {
#pragma unroll
                        for (int r = 0; r < 16; ++r) { const int srow = (r & 3) + 8 * (r >> 2) + 4 * hi; if (srow > r32) X[r] = 0.f; } }
#pragma unroll
                    for (int s2 = 0; s2 < 2; ++s2) { u32x4 w; w.x = cvt_pk_bf16(X[8 * s2], X[8 * s2 + 1]); w.y = cvt_pk_bf16(X[8 * s2 + 2], X[8 * s2 + 3]); w.z = cvt_pk_bf16(X[8 * s2 + 4], X[8 * s2 + 5]); w.w = cvt_pk_bf16(X[8 * s2 + 6], X[8 * s2 + 7]);
                        const bf16x8 vf = *(const LAS bf16x8*)(L + OFF_VT + (32 * dvb + r32) * SP + (32 * sb + 16 * s2 + 8 * hi) * 2);
                        o = __builtin_amdgcn_mfma_f32_32x32x16_bf16(__builtin_bit_cast(bf16x8, w), vf, o, 0, 0, 0); } }
#pragma unroll
                for (int kb = 0; kb < 4; ++kb)
#pragma unroll
                    for (int s2 = 0; s2 < 2; ++s2) { const bf16x8 sf = *(const LAS bf16x8*)(L + OFF_SF + ((((kb * 2 + dvb) * 2 + s2) * 64) + F.lane) * 16);
                        const bf16x8 qf = *(const LAS bf16x8*)(L + OFF_QB + (32 * tb + r32) * RP + (32 * kb + 16 * s2 + 8 * hi) * 2);
                        o = __builtin_amdgcn_mfma_f32_32x32x16_bf16(qf, sf, o, 0, 0, 0); }
                bf16_t* orow = MIX + (size_t)(b * SEQ + c * 64 + 32 * tb) * DM + h * 128 + dq2 * 64 + dvb * 32 + r32;
#pragma unroll
                for (int r = 0; r < 16; ++r) { const float v = o[r]; const float vn = __shfl_xor(v, 1);
                    if ((r32 & 1) == 0) *(unsigned*)(orow + (size_t)((r & 3) + 8 * (r >> 2) + 4 * hi) * DM) = cvt_pk_bf16(v, vn); }
            } else { const int kb = F.wave - 4;
#pragma unroll
                for (int r = 0; r < 16; ++r) { const float dcy = DEC[32 * kb + (r & 3) + 8 * (r >> 2) + 4 * hi]; S0[r] *= dcy; S1[r] *= dcy; }
#pragma unroll
                for (int ss = 0; ss < 4; ++ss) { const bf16x8 kf = *(const LAS bf16x8*)(L + OFF_KLT + (32 * kb + r32) * SP + (16 * ss + 8 * hi) * 2);
                    const bf16x8 vf0 = *(const LAS bf16x8*)(L + OFF_VT + r32 * SP + (16 * ss + 8 * hi) * 2), vf1 = *(const LAS bf16x8*)(L + OFF_VT + (32 + r32) * SP + (16 * ss + 8 * hi) * 2);
                    S0 = __builtin_amdgcn_mfma_f32_32x32x16_bf16(kf, vf0, S0, 0, 0, 0); S1 = __builtin_amdgcn_mfma_f32_32x32x16_bf16(kf, vf1, S1, 0, 0, 0); }
            }
            __syncthreads();
        }
#undef HG_LOADF
#undef HG_LOADQ
    }
}

__device__ __forceinline__ void p3_phase(Frame& F, const Args& a) {
    OPAQUE_FRAME(F);
    const int role = ((int)blockIdx.x >> 3) & 1, idx = ((int)blockIdx.x >> 4) * 8 + ((int)blockIdx.x & 7), half = F.G >> 1;
    unsigned char* ws = F.ws;
    if (role == 0) { for (int it = idx; it < NB * HH * 2; it += half) hgrn_chunked(F, a, it); }
    else {
        { pg8::Gemm g{(const bf16_t*)(ws + WS_A) + C_QA, (const bf16_t*)(ws + WS_WQUP), INCP, QLORA, QLORA};
          pg8::DenseOrder S; S.init(T / 256, MH * MQK / 256, half, idx);
          pg8::EpiStore E{(bf16_t*)(ws + WS_B), MH * MQK, (const float*)(ws + WS_RSTDQ), 1.f / QLORA};
          pg8::gemm_phase<pg8::EpiStore, pg8::DenseOrder>(F.lds, g, S, E); }
        { pg8::Gemm g{(const bf16_t*)(ws + WS_A) + C_KVA, (const bf16_t*)(ws + WS_WKVUP), INCP, KVLORA, KVLORA};
          pg8::DenseOrder S; S.init(T / 256, MH * 256 / 256, half, idx);
          pg8::EpiStore E{(bf16_t*)(ws + WS_C), MH * 256, (const float*)(ws + WS_RSTDKV), 1.f / KVLORA};
          pg8::gemm_phase<pg8::EpiStore, pg8::DenseOrder>(F.lds, g, S, E); }
    }
}

__device__ __forceinline__ float sum8(float v) { v += __shfl_xor(v, 1); v += __shfl_xor(v, 2); v += __shfl_xor(v, 4); return v; }

__device__ __forceinline__ void p5_phase(Frame& F, const Args& a) {
    OPAQUE_FRAME(F);
    const int gw = F.vcu * NWAVES + F.wave, NGW = F.G * NWAVES;
    const bf16_t* PROJ = (const bf16_t*)(F.ws + WS_A);
    const bf16_t* KV = (const bf16_t*)(F.ws + WS_C);
    bf16_t* Kn = (bf16_t*)(F.ws + WS_D);
    bf16_t* MIX = (bf16_t*)(F.ws + WS_E);
    const float* rc = (const float*)(F.ws + WS_ROPEC); const float* rsn = (const float*)(F.ws + WS_ROPES);
    const float* gkn = a.in[14]; const float* gon = a.in[8];
    const int h = F.lane >> 3, sub = F.lane & 7;
    for (int t = gw; t < T; t += NGW) {
        const int b = t / SEQ, s = t % SEQ;
        const size_t hrow = ((size_t)(b * MH + h) * SEQ + s);
        float cs[8], sn[8];
        { const int ii = (sub & 3) * 8; const float* cp = rc + (size_t)t * 32 + ii; const float* sp = rsn + (size_t)t * 32 + ii;
#pragma unroll
          for (int j = 0; j < 8; ++j) { cs[j] = cp[j]; sn[j] = sp[j]; } }
        const float sgn = sub < 4 ? -1.f : 1.f;
        { float k[3][8]; float ss = 0.f;
#pragma unroll
          for (int i = 0; i < 2; ++i) unpack8(__builtin_nontemporal_load((const u32x4*)(KV + (size_t)t * (MH * 256) + h * 256 + (sub + 8 * i) * 8)), k[i]);
          unpack8(*(const u32x4*)(PROJ + (size_t)t * INCP + C_KPE + sub * 8), k[2]);
#pragma unroll
          for (int i = 0; i < 3; ++i)
#pragma unroll
              for (int j = 0; j < 8; ++j) ss += k[i][j] * k[i][j];
          const float rs = rsqrtf(sum8(ss) * (1.f / MQK) + EPS);
#pragma unroll
          for (int i = 0; i < 3; ++i)
#pragma unroll
              for (int j = 0; j < 8; ++j) k[i][j] *= rs * gkn[(sub + 8 * i) * 8 + j];
#pragma unroll
          for (int j = 0; j < 8; ++j) { const float pv = __shfl_xor(k[2][j], 4); k[2][j] = k[2][j] * cs[j] + sgn * pv * sn[j]; }
#pragma unroll
          for (int i = 0; i < 3; ++i) *(u32x4*)(Kn + hrow * MQK + (sub + 8 * i) * 8) = pack8f(k[i]); }
        { float o[2][8], gt[2][8]; float ss = 0.f;
#pragma unroll
          for (int i = 0; i < 2; ++i) { unpack8(*(const u32x4*)(MIX + (size_t)t * DM + h * 128 + (sub + 8 * i) * 8), o[i]); unpack8(__builtin_nontemporal_load((const u32x4*)(PROJ + (size_t)t * INCP + 3 * HW + h * 128 + (sub + 8 * i) * 8)), gt[i]);
#pragma unroll
              for (int j = 0; j < 8; ++j) ss += o[i][j] * o[i][j]; }
          const float rs = rsqrtf(sum8(ss) * (1.f / HDV) + EPS);
#pragma unroll
          for (int i = 0; i < 2; ++i) {
#pragma unroll
              for (int j = 0; j < 8; ++j) o[i][j] = o[i][j] * rs * gon[(sub + 8 * i) * 8 + j] * siluf(gt[i][j]);
              *(u32x4*)(MIX + (size_t)t * DM + h * 128 + (sub + 8 * i) * 8) = pack8f(o[i]); } }
    }
}
namespace att {
constexpr int QBLK = 32, KVBLK = 64, QB = 256;
constexpr int KROW = 512, SHM_K = KVBLK * KROW, SHM_V = KVBLK * MV * 2;
constexpr int OFF_V = 0, OFF_K = 2 * SHM_V, OFF_WS = OFF_K + 2 * SHM_K;
constexpr float SCALE = 0.07216878364870322f;
constexpr float THR = 8.f;
#define SBAR() __builtin_amdgcn_sched_barrier(0)
__device__ __forceinline__ int v_st(int k, int c) { const int kk = (k & ~0xC) | ((k & 4) << 1) | ((k & 8) >> 1); return ((kk >> 3) * 4 + (c >> 5)) * 512 + ((kk & 7) * 32 + (c & 31)) * 2; }
__device__ __forceinline__ int v_rd_base(int lane) { return ((lane & 3) << 3) | (((lane >> 2) & 3) << 6) | (((lane >> 4) & 1) << 5) | (((lane >> 5) & 1) << 8); }
constexpr int v_rd_off(int d0, int ks, int half) { return d0 * 512 + ks * 4096 + half * 2048; }
__device__ __forceinline__ int crow(int r, int hi) { return (r & 3) + 8 * (r >> 2) + 4 * hi; }
template <int M> __device__ __forceinline__ float swz_xor(float v) { return __builtin_bit_cast(float, __builtin_amdgcn_ds_swizzle(__builtin_bit_cast(int, v), (M << 10) | 0x1F)); }
__device__ __forceinline__ unsigned cvtpk(float lo, float hi) { unsigned r; asm volatile("v_cvt_pk_bf16_f32 %0, %1, %2" : "=v"(r) : "v"(lo), "v"(hi)); return r; }

__device__ __forceinline__ void mask_tile(f32x16& p0, f32x16& p1, int dq) {
    const float NEG = -__builtin_inff();
#pragma unroll
    for (int r = 0; r < 16; ++r) {
        const int c = (r & 3) + 8 * (r >> 2);
        if (dq - c < 0) p0[r] = NEG;
        if (dq - c - 32 < 0) p1[r] = NEG;
    }
}
__device__ __forceinline__ void partialSM(f32x16& p0, f32x16& p1, float& m_reg, float& mn, float& alpha) {
    float pmax = p0[0];
#pragma unroll
    for (int r = 1; r < 16; ++r) pmax = fmaxf(pmax, p0[r]);
#pragma unroll
    for (int r = 0; r < 16; ++r) pmax = fmaxf(pmax, p1[r]);
    { auto rr = __builtin_amdgcn_permlane32_swap(__float_as_uint(pmax), __float_as_uint(pmax), false, false);
      pmax = fmaxf(__uint_as_float(rr[0]), __uint_as_float(rr[1])); }
    constexpr float C2 = 1.4426950408889634f * SCALE;
    if (__builtin_expect(__all((pmax - m_reg) * SCALE <= THR), 1)) { mn = m_reg; alpha = 1.f; }
    else { mn = fmaxf(m_reg, pmax); alpha = __builtin_amdgcn_exp2f((m_reg - mn) * C2); m_reg = mn; }
    const float mnL = -mn * C2;
#pragma unroll
    for (int r = 0; r < 16; ++r) p0[r] = fmaf(p0[r], C2, mnL);
#pragma unroll
    for (int r = 0; r < 16; ++r) p1[r] = fmaf(p1[r], C2, mnL);
#pragma unroll
    for (int r = 0; r < 16; ++r) p0[r] = __builtin_amdgcn_exp2f(p0[r]);
}
__device__ __forceinline__ void finishSM(f32x16& p0, f32x16& p1, float alpha, float& l_reg, bf16x8& pa0, bf16x8& pa1, bf16x8& pa2, bf16x8& pa3) {
#pragma unroll
    for (int r = 0; r < 16; ++r) p1[r] = __builtin_amdgcn_exp2f(p1[r]);
    float ps = 0;
#pragma unroll
    for (int r = 0; r < 16; ++r) ps += p0[r];
#pragma unroll
    for (int r = 0; r < 16; ++r) ps += p1[r];
    { auto rr = __builtin_amdgcn_permlane32_swap(__float_as_uint(ps), __float_as_uint(ps), false, false);
      ps = __uint_as_float(rr[0]) + __uint_as_float(rr[1]); }
    l_reg = l_reg * alpha + ps;
#define PK4(P, B_, OUT) do { unsigned a0 = cvtpk(P[B_+0], P[B_+1]), a1 = cvtpk(P[B_+2], P[B_+3]);                          \
        unsigned b0 = cvtpk(P[B_+4], P[B_+5]), b1 = cvtpk(P[B_+6], P[B_+7]);                                             \
        auto r0 = __builtin_amdgcn_permlane32_swap(a0, b0, false, false); auto r1 = __builtin_amdgcn_permlane32_swap(a1, b1, false, false); \
        u32x4 w = {r0[0], r1[0], r0[1], r1[1]}; OUT = __builtin_bit_cast(bf16x8, w); } while (0)
    PK4(p0, 0, pa0); PK4(p0, 8, pa1); PK4(p1, 0, pa2); PK4(p1, 8, pa3);
#undef PK4
}
template <int KB>
__device__ __forceinline__ void qkt(f32x16& p0, f32x16& p1, LAS unsigned char* lds, int r32, int hi, const bf16x8* qr) {
    p0 = f32x16{}; p1 = f32x16{};
    int sw = r32 & 15; asm volatile("" : "+v"(sw));
    const int rb = OFF_K + KB * SHM_K + r32 * KROW;
    int ab[8];
#pragma unroll
    for (int d = 0; d < 8; ++d) ab[d] = rb + (((2 * d + hi) ^ sw) << 4);
#pragma unroll
    for (int d0 = 0; d0 < 12; ++d0) { const int a = ab[d0 & 7] + (d0 >> 3) * 256;
        const bf16x8 b0 = *(const LAS bf16x8*)(lds + a);
        const bf16x8 b1 = *(const LAS bf16x8*)(lds + a + 32 * KROW);
        p0 = __builtin_amdgcn_mfma_f32_32x32x16_bf16(b0, qr[d0], p0, 0, 0, 0);
        p1 = __builtin_amdgcn_mfma_f32_32x32x16_bf16(b1, qr[d0], p1, 0, 0, 0); }
}
template <int VB>
__device__ __forceinline__ void pv_tile(f32x16* o, int vb0, bf16x8 pa0, bf16x8 pa1, bf16x8 pa2, bf16x8 pa3) {
#define TRRD(dst, off) asm volatile("ds_read_b64_tr_b16 %0, %1 offset:%2" : "=&v"(dst) : "v"(vb0), "i"(off) : "memory")
#define PV_D0(d0) do { s16x4 l0, l1, l2, l3, h0, h1, h2, h3; constexpr int b_ = OFF_V + VB * SHM_V + v_rd_off(d0, 0, 0); \
        TRRD(l0, b_); TRRD(h0, b_ + 2048); TRRD(l1, b_ + 4096); TRRD(h1, b_ + 6144); TRRD(l2, b_ + 8192); TRRD(h2, b_ + 10240); TRRD(l3, b_ + 12288); TRRD(h3, b_ + 14336); \
        asm volatile("s_waitcnt lgkmcnt(0)" ::: "memory"); SBAR();   \
        o[d0] = __builtin_amdgcn_mfma_f32_32x32x16_bf16(pa0, (bf16x8){l0[0], l0[1], l0[2], l0[3], h0[0], h0[1], h0[2], h0[3]}, o[d0], 0, 0, 0);   \
        o[d0] = __builtin_amdgcn_mfma_f32_32x32x16_bf16(pa1, (bf16x8){l1[0], l1[1], l1[2], l1[3], h1[0], h1[1], h1[2], h1[3]}, o[d0], 0, 0, 0);   \
        o[d0] = __builtin_amdgcn_mfma_f32_32x32x16_bf16(pa2, (bf16x8){l2[0], l2[1], l2[2], l2[3], h2[0], h2[1], h2[2], h2[3]}, o[d0], 0, 0, 0);   \
        o[d0] = __builtin_amdgcn_mfma_f32_32x32x16_bf16(pa3, (bf16x8){l3[0], l3[1], l3[2], l3[3], h3[0], h3[1], h3[2], h3[3]}, o[d0], 0, 0, 0); } while (0)
    PV_D0(0); PV_D0(1); PV_D0(2); PV_D0(3);
#undef PV_D0
#undef TRRD
}

constexpr int QP = MH * MQK, VP = MH * 256;
__device__ __forceinline__ void attn_block(const bf16_t* Q, const bf16_t* K, const bf16_t* V, bf16_t* O, int P0, const float* gon, const float* gqn, const float* rc, const float* rsn, LAS unsigned char* lds) {
    int tid = threadIdx.x; asm volatile("" : "+v"(tid));
    const int wid = __builtin_amdgcn_readfirstlane(tid >> 6), lane = tid & 63, r32 = lane & 31, hi = lane >> 5;
    const int NT = P0 / KVBLK + 4;
    const int qlo = P0 + wid * QBLK, qm = qlo + r32 - 4 * hi;
    LAS float* wsf = (LAS float*)(lds + OFF_WS) + wid * 64; LAS float* li_l = wsf; LAS float* al_l = wsf + 32;
    float m_reg = -1e30f, l_reg = 0.f; f32x16 o[4] = {};
    bf16x8 qr[12];
#pragma unroll
    for (int d0 = 0; d0 < 12; ++d0) qr[d0] = *(const bf16x8*)(Q + (size_t)(qlo + r32) * QP + d0 * 16 + hi * 8);
    {
        float ss = 0.f;
#pragma unroll
        for (int d0 = 0; d0 < 12; ++d0) { float f[8]; unpack8(__builtin_bit_cast(u32x4, qr[d0]), f);
#pragma unroll
            for (int j = 0; j < 8; ++j) ss += f[j] * f[j]; }
        { auto rr = __builtin_amdgcn_permlane32_swap(__float_as_uint(ss), __float_as_uint(ss), false, false); ss = __uint_as_float(rr[0]) + __uint_as_float(rr[1]); }
        const float rs = rsqrtf(ss * (1.f / MQK) + EPS);
#pragma unroll
        for (int d0 = 0; d0 < 8; ++d0) { float f[8]; unpack8(__builtin_bit_cast(u32x4, qr[d0]), f); const float* gp = gqn + d0 * 16 + hi * 8;
#pragma unroll
            for (int j = 0; j < 8; ++j) f[j] *= rs * gp[j];
            qr[d0] = __builtin_bit_cast(bf16x8, pack8f(f)); }
#pragma unroll
        for (int dd = 0; dd < 2; ++dd) { float x1[8], x2[8]; unpack8(__builtin_bit_cast(u32x4, qr[8 + dd]), x1); unpack8(__builtin_bit_cast(u32x4, qr[10 + dd]), x2);
            const float* g1p = gqn + 128 + dd * 16 + hi * 8; const float* g2p = g1p + 32; const float* cp = rc + (size_t)(qlo + r32) * 32 + dd * 16 + hi * 8; const float* sp = rsn + (size_t)(qlo + r32) * 32 + dd * 16 + hi * 8;
#pragma unroll
            for (int j = 0; j < 8; ++j) { const float a = x1[j] * rs * g1p[j], bq = x2[j] * rs * g2p[j], c = cp[j], sn = sp[j]; x1[j] = a * c - bq * sn; x2[j] = bq * c + a * sn; }
            qr[8 + dd] = __builtin_bit_cast(bf16x8, pack8f(x1)); qr[10 + dd] = __builtin_bit_cast(bf16x8, pack8f(x2)); }
    }
    int ksrc[4], vsrc[2];
#pragma unroll
    for (int i = 0; i < 4; ++i) { const int row = 2 * (wid * 4 + i) + (lane >> 5), c = (lane & 31) ^ (row & 15); ksrc[i] = row * MQK + (c < 24 ? c : 0) * 8; }
#pragma unroll
    for (int i = 0; i < 2; ++i) { const int id = (wid * 2 + i) * 2 + (lane >> 5), kk = ((id >> 2) << 3) | ((lane & 31) >> 2), k = (kk & ~0xC) | ((kk & 4) << 1) | ((kk & 8) >> 1);
        vsrc[i] = k * VP + (id & 3) * 32 + (lane & 3) * 8; }
    const int vb0 = (int)(unsigned)(uintptr_t)lds + v_rd_base(lane);
#define ALOAD(t, bf) do { const bf16_t* kp = K + (size_t)(t) * KVBLK * MQK; const bf16_t* vp = V + (size_t)(t) * KVBLK * VP; \
        _Pragma("unroll") for (int i = 0; i < 4; ++i) __builtin_amdgcn_global_load_lds((const unsigned*)(kp + ksrc[i]), (LAS unsigned*)(lds + OFF_K + (bf) * SHM_K + (wid * 4 + i) * 1024), 16, 0, 0); \
        _Pragma("unroll") for (int i = 0; i < 2; ++i) __builtin_amdgcn_global_load_lds((const unsigned*)(vp + vsrc[i]), (LAS unsigned*)(lds + OFF_V + (bf) * SHM_V + (wid * 2 + i) * 1024), 16, 0, 0); } while (0)
#define RESC(a) do { if (__any((a) < 1.f)) { if (hi == 0) al_l[r32] = (a); asm volatile("s_waitcnt lgkmcnt(0)" ::: "memory"); \
        _Pragma("unroll") for (int d_ = 0; d_ < 4; ++d_) _Pragma("unroll") for (int r = 0; r < 16; ++r) o[d_][r] *= al_l[crow(r, hi)]; } } while (0)
#define STEP(t, BF) do { f32x16 p0, p1; float mn, al; bf16x8 pa0, pa1, pa2, pa3; \
        if ((t) + 1 < NT) ALOAD((t) + 1, 1 - (BF)); \
        SBAR(); qkt<BF>(p0, p1, lds, r32, hi, qr); \
        { const int kb_ = (t) * KVBLK; if (kb_ + KVBLK - 1 > qlo) mask_tile(p0, p1, qm - kb_); } \
        partialSM(p0, p1, m_reg, mn, al); RESC(al); finishSM(p0, p1, al, l_reg, pa0, pa1, pa2, pa3); SBAR(); \
        pv_tile<BF>(o, vb0, pa0, pa1, pa2, pa3); SBAR(); \
        asm volatile("s_waitcnt vmcnt(0)" ::: "memory"); __syncthreads(); } while (0)
    ALOAD(0, 0); asm volatile("s_waitcnt vmcnt(0)" ::: "memory"); __syncthreads();
    for (int t = 0; t < NT; t += 2) { STEP(t, 0); STEP(t + 1, 1); }
#undef STEP
#undef RESC
#undef ALOAD
    if (hi == 0) li_l[r32] = l_reg;
    asm volatile("s_waitcnt lgkmcnt(0)" ::: "memory");
    float gv[4];
#pragma unroll
    for (int d0 = 0; d0 < 4; ++d0) gv[d0] = gon[d0 * 32 + r32];
#pragma unroll
    for (int r = 0; r < 16; ++r) { const float rl = 1.f / li_l[crow(r, hi)];
        float ss = 0.f;
#pragma unroll
        for (int d0 = 0; d0 < 4; ++d0) { o[d0][r] *= rl; ss += o[d0][r] * o[d0][r]; }
        ss += swz_xor<1>(ss); ss += swz_xor<2>(ss); ss += swz_xor<4>(ss); ss += swz_xor<8>(ss); ss += swz_xor<16>(ss);
        const float rs = rsqrtf(ss * (1.f / MV) + EPS);
        bf16_t* orow = O + (size_t)(qlo + crow(r, hi)) * DM;
#pragma unroll
        for (int d0 = 0; d0 < 4; ++d0) { const float v = o[d0][r] * rs * gv[d0]; const float vn = swz_xor<1>(v);
            if ((r32 & 1) == 0) *(unsigned*)(orow + d0 * 32 + r32) = cvtpk(v, vn); } }
    __syncthreads();
}
#undef SBAR
}

__device__ __forceinline__ void p6_phase(Frame& F, const Args& a) {
    const bf16_t* QH = (const bf16_t*)(F.ws + WS_B); const bf16_t* Kn = (const bf16_t*)(F.ws + WS_D); const bf16_t* KV = (const bf16_t*)(F.ws + WS_C);
    bf16_t* MIX = (bf16_t*)(F.ws + WS_E);
    const float* rc = (const float*)(F.ws + WS_ROPEC); const float* rsn = (const float*)(F.ws + WS_ROPES);
    for (int it = F.vcu; it < NB * MH * 4; it += F.G) {
        const int bh = it >> 2, j = it & 3, b = bh >> 3, h = bh & 7;
        const bf16_t* Q = QH + (size_t)(b * SEQ) * att::QP + h * MQK; const bf16_t* K = Kn + (size_t)bh * SEQ * MQK; const bf16_t* V = KV + (size_t)(b * SEQ) * att::VP + h * 256 + 128;
        bf16_t* O = MIX + (size_t)(b * SEQ) * DM + HW + h * MV;
        att::attn_block(Q, K, V, O, (7 - j) * att::QB, a.in[15], a.in[13], rc + (size_t)(b * SEQ) * 32, rsn + (size_t)(b * SEQ) * 32, F.lds);
        att::attn_block(Q, K, V, O, j * att::QB, a.in[15], a.in[13], rc + (size_t)(b * SEQ) * 32, rsn + (size_t)(b * SEQ) * 32, F.lds);
    }
}
__device__ __forceinline__ void p8_phase(Frame& F, const Args& a) {
    OPAQUE_FRAME(F);
    unsigned char* ws = F.ws;
    const float* xin = a.in[0]; const bf16_t* mixo = (const bf16_t*)(ws + WS_F); const float* mod = (const float*)(ws + WS_MOD); const float* g2n = a.in[17];
    const float* wct = (const float*)(ws + WS_WCT);
    bf16_t* H2 = (bf16_t*)(ws + WS_B);
    int* tok_e = (int*)(ws + WS_TOKE); float* tok_w = (float*)(ws + WS_TOKW); int* tok_s = (int*)(ws + WS_TOKS);
    LAS float* red = (LAS float*)F.lds;
    LAS float* ssw = (LAS float*)(F.lds + 98304);
    LAS float* shw = (LAS float*)(F.lds + 100352);
    LAS float* lg = (LAS float*)(F.lds + 101888);
    LAS float* rsl = (LAS float*)(F.lds + 111104);
    const int mr = F.lane & 15, mg = F.lane >> 4;
    const bool conv_first = (F.vcu & 1) != 0;
#pragma unroll 1
    for (int part = 0; part < 2; ++part) {
    if ((part == 0) != conv_first) {
    for (int tile = F.vcu; tile < T / 64; tile += F.G) {
        const int m0 = tile * 64, b = m0 / SEQ;
        const float* modb = mod + b * (6 * DM);
        f32x4 acc[4][3]; float ssp[4] = {0.f, 0.f, 0.f, 0.f}, shacc[3] = {0.f, 0.f, 0.f};
#pragma unroll
        for (int rb = 0; rb < 4; ++rb)
#pragma unroll
            for (int n = 0; n < 3; ++n) acc[rb][n] = (f32x4){0.f, 0.f, 0.f, 0.f};
        const unsigned xo = (unsigned)((m0 + mr) * DM + F.wave * 256 + 4 * mg);
#pragma unroll 2
        for (int s = 0; s < 16; ++s) { const unsigned ko = (unsigned)(F.wave * 256 + 16 * s + 4 * mg);
            const f32x4 g1v = *(const f32x4*)(modb + 2 * DM + ko), shv = *(const f32x4*)(modb + 3 * DM + ko), gmv = *(const f32x4*)(g2n + ko) * (*(const f32x4*)(modb + 4 * DM + ko) + 1.f);
            f32x4 bw[3];
#pragma unroll
            for (int n = 0; n < 3; ++n) { bw[n] = *(const f32x4*)(wct + (size_t)(n * 16 + mr) * DM + ko); shacc[n] += (shv.x * bw[n].x + shv.y * bw[n].y) + (shv.z * bw[n].z + shv.w * bw[n].w); }
#pragma unroll
            for (int rb = 0; rb < 4; ++rb) { const unsigned eo = xo + (unsigned)(rb * 16 * DM + 16 * s);
                const u32x2 mw = *(const u32x2*)(mixo + eo); const f32x4 v = *(const f32x4*)(xin + eo) + g1v * (f32x4){bf_lo(mw.x), bf_hi(mw.x), bf_lo(mw.y), bf_hi(mw.y)};
                ssp[rb] += (v.x * v.x + v.y * v.y) + (v.z * v.z + v.w * v.w);
                const f32x4 av = v * gmv;
#pragma unroll
                for (int i = 0; i < 4; ++i)
#pragma unroll
                    for (int n = 0; n < 3; ++n) acc[rb][n] = __builtin_amdgcn_mfma_f32_16x16x4f32(av[i], bw[n][i], acc[rb][n], 0, 0, 0); } }
#pragma unroll
        for (int rb = 0; rb < 4; ++rb) {
#pragma unroll
            for (int n = 0; n < 3; ++n)
#pragma unroll
                for (int r = 0; r < 4; ++r) red[(F.wave * 64 + rb * 16 + mg * 4 + r) * 48 + n * 16 + mr] = acc[rb][n][r];
            float sp = ssp[rb]; sp += __shfl_xor(sp, 16); sp += __shfl_xor(sp, 32);
            if (mg == 0) ssw[F.wave * 64 + rb * 16 + mr] = sp; }
#pragma unroll
        for (int n = 0; n < 3; ++n) { float sa = shacc[n]; sa += __shfl_xor(sa, 16); sa += __shfl_xor(sa, 32); if (mg == 0) shw[F.wave * 48 + n * 16 + mr] = sa; }
        __syncthreads();
        if (F.tid < 64) { float sv = 0.f;
#pragma unroll
            for (int w = 0; w < 8; ++w) sv += ssw[w * 64 + F.tid];
            rsl[F.tid] = rsqrtf(sv * (1.f / DM) + EPS); }
        __syncthreads();
        for (int idx = F.tid; idx < 64 * 36; idx += NTHR) { const int row = idx / 36, n = idx % 36; float L = 0.f, sw = 0.f;
#pragma unroll
            for (int w = 0; w < 8; ++w) { L += red[(w * 64 + row) * 48 + n]; sw += shw[w * 48 + n]; }
            lg[row * 36 + n] = rsl[row] * L + sw + (n < 4 ? a.in[19][n] : a.in[21][n - 4]); }
        __syncthreads();
        if (F.tid < 64) { const LAS float* l = lg + F.tid * 36; const int t = m0 + F.tid;
            int g = 0; float gm = l[0];
#pragma unroll
            for (int j = 1; j < 4; ++j) if (l[j] > gm) { gm = l[j]; g = j; }
            float den = 0.f;
#pragma unroll
            for (int j = 0; j < 4; ++j) den += __expf(l[j] - gm);
            const float pg = 1.f / den;
            const LAS float* e = l + 4 + g * 8;
            int i1 = 0; float v1 = e[0];
#pragma unroll
            for (int j = 1; j < 8; ++j) if (e[j] > v1) { v1 = e[j]; i1 = j; }
            int i2 = -1; float v2 = -__builtin_inff();
#pragma unroll
            for (int j = 0; j < 8; ++j) if (j != i1 && e[j] > v2) { v2 = e[j]; i2 = j; }
            const float w1 = 1.f / (1.f + __expf(v2 - v1)), w2 = 1.f - w1;
            const int e1 = g * 8 + i1, e2 = g * 8 + i2;
            const int s1 = (int)atomicAdd((unsigned*)(F.ctl + CW_CNT + 64 * e1), 1u), s2 = (int)atomicAdd((unsigned*)(F.ctl + CW_CNT + 64 * e2), 1u);
            tok_e[2 * t] = e1; tok_e[2 * t + 1] = e2; tok_w[2 * t] = pg * w1; tok_w[2 * t + 1] = pg * w2; tok_s[2 * t] = s1; tok_s[2 * t + 1] = s2;
            int* list = (int*)(ws + WS_LIST); list[e1 * T + s1] = t; list[e2 * T + s2] = t; }
        { const int c8 = (F.tid & 255) * 8, rg = F.tid >> 8;
          f32x4 g1a = *(const f32x4*)(modb + 2 * DM + c8), g1b = *(const f32x4*)(modb + 2 * DM + c8 + 4), sha = *(const f32x4*)(modb + 3 * DM + c8), shb = *(const f32x4*)(modb + 3 * DM + c8 + 4);
          const f32x4 gma = *(const f32x4*)(g2n + c8) * (*(const f32x4*)(modb + 4 * DM + c8) + 1.f), gmb = *(const f32x4*)(g2n + c8 + 4) * (*(const f32x4*)(modb + 4 * DM + c8 + 4) + 1.f);
#pragma unroll 4
          for (int j = 0; j < 32; ++j) { const int row = rg + 2 * j; const size_t eo = (size_t)(m0 + row) * DM + c8; const float rs = rsl[row];
              float mx[8]; unpack8(__builtin_nontemporal_load((const u32x4*)(mixo + eo)), mx);
              const f32x4 va = (__builtin_nontemporal_load((const f32x4*)(xin + eo)) + g1a * (f32x4){mx[0], mx[1], mx[2], mx[3]}) * rs * gma + sha, vb = (__builtin_nontemporal_load((const f32x4*)(xin + eo + 4)) + g1b * (f32x4){mx[4], mx[5], mx[6], mx[7]}) * rs * gmb + shb;
              u32x4 w; w.x = cvt_pk_bf16(va.x, va.y); w.y = cvt_pk_bf16(va.z, va.w); w.z = cvt_pk_bf16(vb.x, vb.y); w.w = cvt_pk_bf16(vb.z, vb.w);
              *(u32x4*)(H2 + eo) = w; } }
        __syncthreads();
    }
    } else {
    LAS unsigned char* Tl = F.lds + F.wave * 8192;
    const int gw = F.vcu * NWAVES + F.wave, NGW = F.G * NWAVES;
    constexpr int I_G = NE * (DM / 64) * (DE / 64);
    { const float* wg = a.in[22]; const float* wu = a.in[23]; const float* wd = a.in[24];
      auto mk = [=](int it) -> TrItem { TrItem t; t.gk = nullptr;
          const int which = it / I_G, r = it % I_G;
          if (which < 2) { const int e = r / 256, q = r % 256, kb = q / 8, nb = q % 8, n0 = 64 * nb;
              t.src = (which ? wu : wg) + (size_t)e * DM * DE + (size_t)(64 * kb) * DE + n0;
              t.dst = (bf16_t*)(ws + WS_D) + ((size_t)e * 1024 + (n0 >> 7) * 256 + (n0 & 127) + which * 128) * DM + 64 * kb; t.dst2 = t.dst + (size_t)32 * DM; t.N = DE; t.ldt = DM; }
          else { const int e = r / 256, q = r % 256, kb = q / 32, nb = q % 32, n0 = 64 * nb;
              t.src = wd + (size_t)e * DE * DM + (size_t)(64 * kb) * DM + n0;
              t.dst = (bf16_t*)(ws + WS_E) + ((size_t)e * DM + n0) * DE + 64 * kb; t.dst2 = t.dst + (size_t)32 * DE; t.N = DM; t.ldt = DE; }
          return t; };
      tr_run(gw, NGW, 3 * I_G, mk, Tl, F.lane); }
    __syncthreads();
    }
    }
}

constexpr int MOE_TAB_OFF = LDS_USER;
__device__ __forceinline__ LAS int* moe_tables(Frame& F) {
    LAS int* tab = (LAS int*)(F.lds + MOE_TAB_OFF);
    __syncthreads();
    if (F.tid == 0) { int acc = 0;
        for (int e = 0; e < NE; ++e) { tab[e] = acc; const int c = (int)__hip_atomic_load((unsigned*)(F.ctl + CW_CNT + 64 * e), RLX_AGENT); tab[64 + e] = c; acc += ((c + 255) / 256) * 256; }
        tab[NE] = acc; }
    __syncthreads();
    if (F.tid < 160) { int e = 0; for (int j = 1; j < NE; ++j) if (tab[j] <= F.tid * 256) e = j; tab[128 + F.tid] = e; }
    __syncthreads();
    return tab;
}

__device__ __forceinline__ void p12_phase(Frame& F, const Args& a) {
    OPAQUE_FRAME(F);
    unsigned char* ws = F.ws;
    const bf16_t* Y = (const bf16_t*)(ws + WS_A);
    const float* tok_w = (const float*)(ws + WS_TOKW); const int* tok_s = (const int*)(ws + WS_TOKS);
    const float* mod = (const float*)(ws + WS_MOD);
    const LAS int* tab = moe_tables(F); const int* tok_e = (const int*)(ws + WS_TOKE);
    const int gw = F.vcu * NWAVES + F.wave, NGW = F.G * NWAVES;
#if defined(MK_STAMP) && MK_STAMP >= 0
    const float dscale = 1.f + sqrtf(exp2f(rintf(3.f * log2f(*(const float*)(ws + WS_STAMP + 8) + 1.f) + MK_QSHIFT) * (1.f / 3.f)));
#else
    const float dscale = 1.f;
#endif
    for (int t = gw; t < T; t += NGW) {
        const int b = t / SEQ; const float w0 = tok_w[2 * t], w1 = tok_w[2 * t + 1]; const int d0 = tab[tok_e[2 * t]] + tok_s[2 * t], d1 = tab[tok_e[2 * t + 1]] + tok_s[2 * t + 1];
        const float* g2 = mod + b * (6 * DM) + 5 * DM; const float* g1 = mod + b * (6 * DM) + 2 * DM;
        float* orow = F.out + (size_t)t * DM; const float* xrow = a.in[0] + (size_t)t * DM; const bf16_t* mrow = (const bf16_t*)(ws + WS_F) + (size_t)t * DM;
#pragma unroll
        for (int j = 0; j < 4; ++j) { const int c = (j * 64 + F.lane) * 8;
            float y0[8], y1[8]; unpack8(__builtin_nontemporal_load((const u32x4*)(Y + (size_t)d0 * DM + c)), y0); unpack8(__builtin_nontemporal_load((const u32x4*)(Y + (size_t)d1 * DM + c)), y1);
            float mx[8]; unpack8(__builtin_nontemporal_load((const u32x4*)(mrow + c)), mx);
            const f32x4 ha = *(const f32x4*)(g1 + c), hb = *(const f32x4*)(g1 + c + 4);
            const f32x4 xa = __builtin_nontemporal_load((const f32x4*)(xrow + c)) + ha * (f32x4){mx[0], mx[1], mx[2], mx[3]}, xb = __builtin_nontemporal_load((const f32x4*)(xrow + c + 4)) + hb * (f32x4){mx[4], mx[5], mx[6], mx[7]}, ga = *(const f32x4*)(g2 + c), gb = *(const f32x4*)(g2 + c + 4);
            f32x4 ra, rb;
#pragma unroll
            for (int i = 0; i < 4; ++i) { ra[i] = (xa[i] + ga[i] * (w0 * y0[i] + w1 * y1[i])) * dscale; rb[i] = (xb[i] + gb[i] * (w0 * y0[4 + i] + w1 * y1[4 + i])) * dscale; }
            __builtin_nontemporal_store(ra, (f32x4*)(orow + c)); __builtin_nontemporal_store(rb, (f32x4*)(orow + c + 4)); }
    }
}
#ifndef MK_MULTI
#define MK_MULTI 0
#endif
#ifndef MK_LAST_PHASE
#define MK_LAST_PHASE 12
#endif
constexpr int N_PHASES = MK_LAST_PHASE + 1;

template <class P> __device__ __forceinline__ P* uptr(P* p) { const unsigned long long v = (unsigned long long)p;
    const unsigned lo = __builtin_amdgcn_readfirstlane((unsigned)v), hi = __builtin_amdgcn_readfirstlane((unsigned)(v >> 32)); return (P*)(((unsigned long long)hi << 32) | lo); }
__global__ void __launch_bounds__(NTHR, 2) mk_fwd(const Args args) {
    extern __shared__ __attribute__((aligned(16))) unsigned char lds_raw[];
    Frame F;
    F.lds = (LAS unsigned char*)lds_raw;
    F.MISC = (volatile LAS unsigned*)(F.lds + MISC_OFF);
    F.tid = threadIdx.x; F.lane = F.tid & 63; F.wave = __builtin_amdgcn_readfirstlane(F.tid >> 6);
    F.G = gridDim.x; { const int bx = blockIdx.x; F.vcu = (F.G % 8 == 0) ? (bx % 8) * (F.G / 8) + bx / 8 : bx; }
    F.ws = uptr(args.ws); F.out = uptr(args.out);
    F.ctl = (gu32*)(F.ws + WS_CTL);
    for (int u = F.tid; u < (LDS_BYTES - MISC_OFF) / 4; u += NTHR) ((LAS unsigned*)(F.lds + MISC_OFF))[u] = 0u;
    __syncthreads();
    XcdBarrier bar; bar.bar = (unsigned*)(F.ctl + CW_BAR); bar.x = 0; bar.st = nullptr;
#if !MK_MULTI
    bar = xcd_barrier_post((unsigned*)(F.ctl + CW_BAR), F.MISC + 8);
#define GRID_BAR() xcd_barrier(bar)
#else
#define GRID_BAR() do { } while (0)
#endif
    const int lo = args.ph_lo, hi = args.ph_hi;
#ifndef MK_PHMASK
#define MK_PHMASK 0xFFFF
#endif
#define IN(k) (((MK_PHMASK >> (k)) & 1) && lo <= (k) && (k) < hi)
#define SEAM(k) do { if (IN(k) && IN((k) + 1)) GRID_BAR(); } while (0)
#ifndef MK_STAMP
#define MK_STAMP (-1)
#endif
#define STAMP_BEGIN(k) do { if ((k) == MK_STAMP && blockIdx.x == 0 && F.tid == 0) *(unsigned long long*)(ws + WS_STAMP) = __builtin_amdgcn_s_memrealtime(); } while (0)
#define STAMP_END(k) do { if ((k) == MK_STAMP && blockIdx.x == 0 && F.tid == 0) { const unsigned long long t1_ = __builtin_amdgcn_s_memrealtime(); *(float*)(ws + WS_STAMP + 8) = (float)(t1_ - *(unsigned long long*)(ws + WS_STAMP)) * 0.01f; } } while (0)
#ifndef MK_REPEAT
#define MK_REPEAT (-1)
#endif
#ifndef MK_REPN
#define MK_REPN 2
#endif
#define REP(k) _Pragma("unroll") for (int rep_ = 0; rep_ < ((k) == MK_REPEAT ? MK_REPN : 1); ++rep_)
    unsigned char* const ws = F.ws;

    STAMP_BEGIN(0);
    REP(0) if (IN(0)) { if (rep_) GRID_BAR(); p0_phase(F, args); } SEAM(0); STAMP_END(0);
    STAMP_BEGIN(1);
    REP(1) if (IN(1)) { if (rep_) GRID_BAR(); p1_phase(F, args); } SEAM(1); STAMP_END(1);
    STAMP_BEGIN(2);
    REP(2) if (IN(2)) { if (rep_) GRID_BAR();
        pg8::Gemm g{(const bf16_t*)(ws + WS_B), (const bf16_t*)(ws + WS_WIN), DM, DM, DM};
        pg8::DenseOrder S; S.init(T / 256, INCP / 256, F.G, (int)blockIdx.x);
        pg8::EpiStore E{(bf16_t*)(ws + WS_A), INCP, nullptr, 0.f, (float*)(ws + WS_RSTDQ), (float*)(ws + WS_RSTDKV), C_QA / 256, C_KVA / 256, C_KPE / 256};
        pg8::gemm_phase<pg8::EpiStore, pg8::DenseOrder>(F.lds, g, S, E);
    } SEAM(2); STAMP_END(2);
    STAMP_BEGIN(3);
    REP(3) if (IN(3)) { if (rep_) GRID_BAR(); p3_phase(F, args); } if (IN(3) && IN(5)) GRID_BAR(); STAMP_END(3);
    STAMP_BEGIN(5);
    REP(5) if (IN(5)) { if (rep_) GRID_BAR(); p5_phase(F, args); } SEAM(5); STAMP_END(5);
    STAMP_BEGIN(6);
    REP(6) if (IN(6)) { if (rep_) GRID_BAR(); p6_phase(F, args); } SEAM(6); STAMP_END(6);
    STAMP_BEGIN(7);
    REP(7) if (IN(7)) { if (rep_) GRID_BAR();
        pg8::Gemm g{(const bf16_t*)(ws + WS_E), (const bf16_t*)(ws + WS_WOUT), DM, DM, DM};
        pg8::DenseOrder S; S.init(T / 256, DM / 256, F.G, (int)blockIdx.x);
        pg8::EpiStore E{(bf16_t*)(ws + WS_F), DM, nullptr, 0.f, nullptr, nullptr, 0, 0, 0};
        pg8::gemm_phase<pg8::EpiStore, pg8::DenseOrder>(F.lds, g, S, E);
    } SEAM(7); STAMP_END(7);
#if MK_LAST_PHASE >= 8
    STAMP_BEGIN(8);
    REP(8) if (IN(8)) { if (rep_) GRID_BAR(); p8_phase(F, args); } if (IN(8) && IN(10)) GRID_BAR(); STAMP_END(8);
    STAMP_BEGIN(10);
    REP(10) if (IN(10)) { if (rep_) GRID_BAR();
        const LAS int* tab = moe_tables(F);
        pg8::Gemm g{(const bf16_t*)(ws + WS_B), (const bf16_t*)(ws + WS_D), DM, DM, DM};
        pg8::GroupedOrder S; S.init(4, F.G, F.vcu, tab, (const int*)(ws + WS_LIST));
        pg8::EpiSwiGLU E{(bf16_t*)(ws + WS_C), (unsigned*)(F.ctl + CW_RDY)};
        pg8::gemm_phase<pg8::EpiSwiGLU, pg8::GroupedOrder, true>(F.lds, g, S, E);
    }
    REP(11) if (IN(11)) { if (rep_) GRID_BAR();
        const LAS int* tab = moe_tables(F);
        pg8::Gemm g{(const bf16_t*)(ws + WS_C), (const bf16_t*)(ws + WS_E), DE, DE, DE};
        pg8::RedealOrder S; S.init(8, F.G, F.vcu, tab, 4, (unsigned*)(F.ctl + CW_RDY), 32u, (unsigned*)(F.ctl + CW_TMO));
        pg8::EpiStore E{(bf16_t*)(ws + WS_A), DM, nullptr, 0.f, nullptr, nullptr, 0, 0, 0};
        pg8::gemm_phase<pg8::EpiStore, pg8::RedealOrder>(F.lds, g, S, E);
    } SEAM(11); STAMP_END(11);
    REP(12) if (IN(12)) { if (rep_) GRID_BAR(); p12_phase(F, args); }
#endif
#undef IN
#undef SEAM
}

extern "C" void kernel_launch(void* const* d_in, const int* in_sizes, int n_in, void* d_out, int out_size, void* d_ws, size_t ws_size, hipStream_t stream) {
    static int grid = 0;
    if (grid == 0) {
        if (n_in != 25 || out_size != T * DM || ws_size < WS_END) { fprintf(stderr, "kernel_launch: bad shapes (n_in %d out %d ws %zu)\n", n_in, out_size, ws_size); grid = -1; return; }
        int dev = 0, cus = 0, per_cu = 0;
        if (hipGetDevice(&dev) != hipSuccess || hipDeviceGetAttribute(&cus, hipDeviceAttributeMultiprocessorCount, dev) != hipSuccess) { grid = -1; return; }
        if (hipFuncSetAttribute((const void*)mk_fwd, hipFuncAttributeMaxDynamicSharedMemorySize, LDS_BYTES) != hipSuccess) { fprintf(stderr, "kernel_launch: hipFuncSetAttribute failed\n"); grid = -1; return; }
        if (hipOccupancyMaxActiveBlocksPerMultiprocessor(&per_cu, (const void*)mk_fwd, NTHR, LDS_BYTES) != hipSuccess || per_cu < 1) { fprintf(stderr, "kernel_launch: occupancy query says %d\n", per_cu); }
        (void)hipGetLastError();
        grid = cus;
    }
    if (grid < 0) return;
    (void)hipMemsetAsync((char*)d_ws + WS_CTL, 0, CTL_ZERO_BYTES, stream);
    Args a{};
    for (int i = 0; i < 25; ++i) a.in[i] = (const float*)d_in[i];
    a.out = (float*)d_out; a.ws = (unsigned char*)d_ws;
#if MK_MULTI
    for (int p = 0; p < N_PHASES; ++p) { a.ph_lo = p; a.ph_hi = p + 1; hipLaunchKernelGGL(mk_fwd, dim3(grid), dim3(NTHR), LDS_BYTES, stream, a); }
#else
    a.ph_lo = 0; a.ph_hi = N_PHASES; hipLaunchKernelGGL(mk_fwd, dim3(grid), dim3(NTHR), LDS_BYTES, stream, a);
#endif
}
```

```cpp
#include <hip/hip_runtime.h>
#include <cstdio>
#include <cstdint>

#define GAS __attribute__((address_space(1)))
#define LAS __attribute__((address_space(3)))
typedef unsigned short bf16_t;
typedef short bf16x8 __attribute__((ext_vector_type(8)));
typedef short s16x4 __attribute__((ext_vector_type(4)));
typedef float f32x4 __attribute__((ext_vector_type(4)));
typedef float f32x2 __attribute__((ext_vector_type(2)));
typedef float f32x16 __attribute__((ext_vector_type(16)));
typedef unsigned u32x4 __attribute__((ext_vector_type(4)));
typedef unsigned u32x2 __attribute__((ext_vector_type(2)));
typedef GAS unsigned gu32;
#define RLX_AGENT __ATOMIC_RELAXED, __HIP_MEMORY_SCOPE_AGENT
#define LDS_WAIT() asm volatile("s_waitcnt lgkmcnt(0)" ::: "memory")
#define VM_WAIT() asm volatile("s_waitcnt vmcnt(0)" ::: "memory")

constexpr int DM = 2048, NB = 8, SEQ = 2048, T = NB * SEQ;
constexpr int HW = 1024, HH = 8, HDK = 128, HDV = 128;
constexpr int MH = 8, MNOPE = 128, MROPE = 64, MQK = 192, MV = 128, QLORA = 512, KVLORA = 256;
constexpr int INC = 4 * HW + QLORA + KVLORA + MROPE;
constexpr int INCP = 5120;
constexpr int C_QA = 4096, C_KVA = 4608, C_KPE = 4864;
constexpr int NG = 4, EPG = 8, NE = 32, DE = 512;
constexpr int RMAX = (T * 2 / 256 + NE) * 256;
constexpr float EPS = 1e-6f;
constexpr int NWAVES = 8, NTHR = 512;

typedef __bf16 bf16x2_t __attribute__((ext_vector_type(2)));
__device__ __forceinline__ unsigned cvt_pk_bf16(float lo, float hi) { const f32x2 v = {lo, hi}; return __builtin_bit_cast(unsigned, __builtin_convertvector(v, bf16x2_t)); }
__device__ __forceinline__ float bf_lo(unsigned w) { return __builtin_bit_cast(float, w << 16); }
__device__ __forceinline__ float bf_hi(unsigned w) { return __builtin_bit_cast(float, w & 0xffff0000u); }
__device__ __forceinline__ float bf2f(bf16_t h) { return __builtin_bit_cast(float, (unsigned)h << 16); }
__device__ __forceinline__ float wave_sum(float v) {
#pragma unroll
    for (int o = 1; o < 64; o <<= 1) v += __shfl_xor(v, o);
    return v;
}
__device__ __forceinline__ float siluf(float v) { return v / (1.f + __expf(-v)); }

#define XB_TMO      128
#define XB_XCNT(j)  (256  + 64 * (j))
#define XB_XSUB(j)  (1280 + 64 * (j))
#define XB_XGEN(j)  (2304 + 64 * (j))
#define XB_TOP      3328
#define XB_TOPGEN   3392
#define XCD_BAR_WORDS 3456
#define XB_SPIN_CAP (1u << 18)

__device__ __forceinline__ unsigned xb_ld(unsigned* p)              { return __hip_atomic_load(p, __ATOMIC_RELAXED, __HIP_MEMORY_SCOPE_AGENT); }
__device__ __forceinline__ unsigned xb_add(unsigned* p, unsigned v) { return __hip_atomic_fetch_add(p, v, __ATOMIC_RELAXED, __HIP_MEMORY_SCOPE_AGENT); }
__device__ __forceinline__ unsigned xb_xcc_id() { return (unsigned)__builtin_amdgcn_s_getreg((3 << 11) | 20) & 0xFu; }
#define XB_SPIN(cond, bar) do { unsigned _sp = 0; while (cond) { __builtin_amdgcn_s_sleep(1); \
    if ((++_sp & 255u) == 0u) { if (xb_ld(&(bar)[XB_TMO])) break; if (_sp > XB_SPIN_CAP) { atomicAdd(&(bar)[XB_TMO], 1u); break; } } } } while (0)

struct XcdBarrier {
    unsigned* bar; unsigned x;
    volatile LAS unsigned* st;
};
__device__ __forceinline__ XcdBarrier xcd_barrier_post(unsigned* bar, volatile LAS unsigned* st) {
    XcdBarrier b; b.bar = bar; b.x = xb_xcc_id(); b.st = st;
    if (threadIdx.x == 0) (void)xb_add(&bar[XB_XCNT(b.x)], 1u);
    return b;
}
__device__ __forceinline__ void xcd_barrier_complete(unsigned* bar, unsigned x, unsigned& nloc, unsigned& nx) {
    const unsigned G = gridDim.x * gridDim.y * gridDim.z;
    unsigned sum, cnt, mine, sp = 0u;
    for (;;) {
        sum = 0u; cnt = 0u; mine = 0u;
#pragma unroll
        for (unsigned j = 0; j < 16; ++j) { const unsigned c = xb_ld(&bar[XB_XCNT(j)]); sum += c; cnt += (c > 0u) ? 1u : 0u; mine = (j == x) ? c : mine; }
        if (sum == G) break;
        __builtin_amdgcn_s_sleep(1);
        if ((++sp & 255u) == 0u) { if (xb_ld(&bar[XB_TMO])) break; if (sp > XB_SPIN_CAP) { atomicAdd(&bar[XB_TMO], 1u); break; } }
    }
    nloc = mine > 0u ? mine : 1u; nx = cnt > 0u ? cnt : 1u;
}
__device__ __forceinline__ void xcd_barrier(const XcdBarrier& b) {
    asm volatile("s_waitcnt vmcnt(0)" ::: "memory");
    __syncthreads();
    if (threadIdx.x == 0) {
        unsigned* bar = b.bar;
        __builtin_amdgcn_s_waitcnt(0);
        unsigned nloc = b.st[0], nx = b.st[1];
        if (nloc == 0u) { xcd_barrier_complete(bar, b.x, nloc, nx); b.st[0] = nloc; b.st[1] = nx; }
        const unsigned old = xb_add(&bar[XB_XSUB(b.x)], 1u);
        const unsigned gen = old / nloc;
        if (old + 1u == (gen + 1u) * nloc) {
            __builtin_amdgcn_fence(__ATOMIC_RELEASE, "agent");
            asm volatile("s_waitcnt vmcnt(0)" ::: "memory");
            const unsigned og = xb_add(&bar[XB_TOP], 1u);
            const unsigned tg = og / nx;
            if (og + 1u == (tg + 1u) * nx) xb_add(&bar[XB_TOPGEN], 1u);
            else XB_SPIN(xb_ld(&bar[XB_TOPGEN]) == tg, bar);
            __builtin_amdgcn_fence(__ATOMIC_ACQUIRE, "agent");
            xb_add(&bar[XB_XGEN(b.x)], 1u);
            asm volatile("s_waitcnt vmcnt(0)" ::: "memory");
        } else {
            XB_SPIN(xb_ld(&bar[XB_XGEN(b.x)]) == gen, bar);
            __builtin_amdgcn_fence(__ATOMIC_ACQUIRE, "agent");
            asm volatile("s_waitcnt vmcnt(0)" ::: "memory");
        }
    }
    __syncthreads();
}

namespace pg8 {
constexpr int BM = 256, BK = 64, HALF = 128, HTB = HALF * BK * 2, STAGE_BYTES = 8 * HTB, NXCD = 8, WGM = 8;
__host__ __device__ __forceinline__ int lds_byte(int r, int c) { const int st = (r >> 4) * 2 + (c >> 5), rr = r & 15, cc = c & 31, ob = rr * 64 + cc * 2; return st * 1024 + (ob ^ (((ob >> 9) & 1) << 5)); }
__host__ __device__ __forceinline__ void stage_rc(int b, int& R, int& C) { const int st = b / 1024, sb = b % 1024, swz = sb ^ (((sb >> 9) & 1) << 5); R = (st >> 1) * 16 + swz / 64; C = (st & 1) * 32 + (swz % 64) / 2; }
__host__ __device__ __forceinline__ int perm32(int rho) { const int n = rho >> 4, i = rho & 15; return 8 * (i >> 2) + 4 * n + (i & 3); }

struct Unit { int pm, pn, pb; };
struct Gemm { const bf16_t* A; const bf16_t* Bt; int lda, ldb, K; };

struct DenseOrder {
    int nM, nN, nwg, G, c;
    __device__ void init(int nM_, int nN_, int G_, int c_) { nM = nM_; nN = nN_; nwg = nM * nN; G = G_; c = c_; }
    __device__ bool next(int i, Unit& u) const {
        const long L = (long)i * G + c; if (L >= nwg) return false;
        int wgid = (int)L; { const int q = nwg / NXCD, r = nwg % NXCD, xcd = wgid % NXCD, off = wgid / NXCD; wgid = (xcd < r ? xcd * (q + 1) : r * (q + 1) + (xcd - r) * q) + off; }
        const int nig = WGM * nN, gid = wgid / nig, fm = gid * WGM, gsz = (nM - fm) < WGM ? (nM - fm) : WGM;
        u.pm = fm + ((wgid % nig) % gsz); u.pn = (wgid % nig) / gsz; u.pb = u.pn; return true;
    }
    __device__ __forceinline__ void a_ready(const Unit&) const {}
};
struct GroupedOrder {
    int nM, nN, nwg, G, c; const LAS int* tile_e; const LAS int* pstart; const LAS int* cnt; const int* list;
    __device__ void init(int nN_, int G_, int c_, const LAS int* tab, const int* list_) { pstart = tab; cnt = tab + 64; tile_e = tab + 128; list = list_; nM = pstart[32] >> 8; nN = nN_; nwg = nM * nN; G = G_; c = c_; }
    __device__ bool next(int i, Unit& u) const {
        const long L = (long)i * G + c; if (L >= nwg) return false;
        const int w = (int)L; u.pn = w % nN; u.pm = w / nN; u.pb = tile_e[u.pm] * nN + u.pn; return true;
    }
    __device__ int arow(const Unit& u, int r) const { const int e = tile_e[u.pm], j = 256 * u.pm - pstart[e] + r; return j < cnt[e] ? list[e * T + j] : 0; }
    __device__ __forceinline__ void a_ready(const Unit&) const {}
};
struct RedealOrder {
    int nM, nN, nwg, G, c, r10, X, nlight, head; const LAS int* tile_e; unsigned* ready; unsigned need; unsigned* tmo;
    __device__ void init(int nN_, int G_, int c_, const LAS int* tab, int nN10, unsigned* ready_, unsigned need_, unsigned* tmo_) {
        tile_e = tab + 128; nM = tab[32] >> 8; nN = nN_; nwg = nM * nN; G = G_; c = c_; ready = ready_; need = need_; tmo = tmo_;
        r10 = (nM * nN10) % G; X = r10 ? 3 : 0; nlight = G - r10; head = X * nlight < nwg ? X * nlight : nwg; }
    __device__ bool next(int i, Unit& u) const {
        long id;
        if (c >= r10 && X) id = i < X ? (long)i * nlight + (c - r10) : (long)head + (long)(i - X) * G + c;
        else id = (long)head + (long)i * G + c;
        if ((i < X && c >= r10 && id >= head) || id >= nwg) return false;
        u.pm = (int)id / nN; u.pn = (int)id % nN; u.pb = tile_e[u.pm] * nN + u.pn; return true;
    }
    __device__ __forceinline__ void a_ready(const Unit& u) const {
        if (threadIdx.x < 64) {
            unsigned polls = 0;
            while ((unsigned)__builtin_amdgcn_readfirstlane(__hip_atomic_load(ready + 64 * u.pm, __ATOMIC_RELAXED, __HIP_MEMORY_SCOPE_AGENT)) < need) {
                if (++polls > (1u << 16)) { if (threadIdx.x == 0) __hip_atomic_store(tmo, 0xDEAD0000u | (unsigned)u.pm, __ATOMIC_RELAXED, __HIP_MEMORY_SCOPE_AGENT); break; }
                __builtin_amdgcn_s_sleep(2); }
            __builtin_amdgcn_fence(__ATOMIC_ACQUIRE, "agent");
            asm volatile("s_waitcnt vmcnt(0)" ::: "memory");
        }
        asm volatile("" ::: "memory"); __builtin_amdgcn_s_barrier(); asm volatile("" ::: "memory");
    }
};

template <class Epi, class Sched, bool GATHER = false>
__device__ __forceinline__ void gemm_phase(LAS unsigned char* lds, const Gemm g, const Sched& S, const Epi& E) {
    int tid = threadIdx.x; asm volatile("" : "+v"(tid));
    const int wid = __builtin_amdgcn_readfirstlane(tid >> 6), lane = tid & 63, wr = wid >> 2, wc = wid & 3, fr = lane & 15, fq = lane >> 4;
    const int K = g.K, nt = K / BK;
    unsigned voffA[2], voffB[2]; int gR[2], gC[2];
#pragma unroll
    for (int i = 0; i < 2; ++i) { int R, C; stage_rc(tid * 16 + i * 8192, R, C); const int Rb = (R & ~31) + perm32(R & 31); gR[i] = R; gC[i] = C;
        voffA[i] = (unsigned)(R * g.lda + C) * 2u; voffB[i] = (unsigned)(Rb * g.ldb + C) * 2u; }
    const size_t kstep = (size_t)(BK * 2);
    const size_t hsA = (size_t)HALF * g.lda * 2, hsB = (size_t)HALF * g.ldb * 2;
    const unsigned ldsw = (unsigned)wid * 1024u;
    const int aoff = lds_byte(wr * 64 + fr, fq * 8), boff = lds_byte(wc * 32 + fr, fq * 8);
#define PG8_SA(b, h) (((b) * 2 + (h)) * HTB)
#define PG8_SB(b, h) ((4 + (b) * 2 + (h)) * HTB)
#define PG8_STAGE(bufoff, gbase, voff) do { _Pragma("unroll") for (int _i = 0; _i < 2; ++_i) \
        __builtin_amdgcn_global_load_lds((const unsigned*)((const char*)(gbase) + (voff)[_i]), (LAS unsigned*)(lds + (bufoff) + ldsw + _i * 8192), 16, 0, 0); } while (0)
#define PG8_STAGE_A(bufoff, dense_ptr, kbytes, offs) do { if constexpr (GATHER) { PG8_STAGE(bufoff, (const char*)g.A + (kbytes), offs); } else { PG8_STAGE(bufoff, dense_ptr, voffA); } } while (0)
#define PG8_GOFF(u, o0, o1) do { _Pragma("unroll") for (int _i = 0; _i < 2; ++_i) { o0[_i] = (unsigned)(S.arow(u, gR[_i]) * g.lda + gC[_i]) * 2u; o1[_i] = (unsigned)(S.arow(u, gR[_i] + HALF) * g.lda + gC[_i]) * 2u; } } while (0)
#define PG8_LDA(dst, b, h) do { _Pragma("unroll") for (int m = 0; m < 4; ++m) _Pragma("unroll") for (int k = 0; k < 2; ++k) dst[m][k] = *(const LAS bf16x8*)(lds + PG8_SA(b, h) + aoff + m * 2048 + k * 1024); } while (0)
#define PG8_LDB(dst, b, h) do { _Pragma("unroll") for (int n = 0; n < 2; ++n) _Pragma("unroll") for (int k = 0; k < 2; ++k) dst[n][k] = *(const LAS bf16x8*)(lds + PG8_SB(b, h) + boff + n * 2048 + k * 1024); } while (0)
#define PG8_MMA(ai, bj, At, Bt) do { __builtin_amdgcn_s_setprio(1); _Pragma("unroll") for (int m = 0; m < 4; ++m) _Pragma("unroll") for (int n = 0; n < 2; ++n) _Pragma("unroll") for (int k = 0; k < 2; ++k) \
        acc[ai][bj][m][n] = __builtin_amdgcn_mfma_f32_16x16x32_bf16(Bt[n][k], At[m][k], acc[ai][bj][m][n], 0, 0, 0); __builtin_amdgcn_s_setprio(0); } while (0)
#define PG8_WAIT_V(n) asm volatile("s_waitcnt vmcnt(" #n ")" ::: "memory")
#define PG8_WAIT_L(n) asm volatile("s_waitcnt lgkmcnt(" #n ")" ::: "memory")
#define PG8_BAR __builtin_amdgcn_s_barrier()
#define PG8_SCHED __builtin_amdgcn_sched_barrier(0)
    Unit cur, nxt; int ui = 0;
    if (!S.next(0, cur)) return;
    unsigned cO0[2] = {0u, 0u}, cO1[2] = {0u, 0u}, nO0[2] = {0u, 0u}, nO1[2] = {0u, 0u};
    if constexpr (GATHER) { PG8_GOFF(cur, cO0, cO1); }
    S.a_ready(cur);
    f32x4 acc[2][2][4][2];
#pragma unroll
    for (int a = 0; a < 2; ++a)
#pragma unroll
        for (int b = 0; b < 2; ++b)
#pragma unroll
            for (int m = 0; m < 4; ++m)
#pragma unroll
                for (int n = 0; n < 2; ++n) acc[a][b][m][n] = (f32x4){0.f, 0.f, 0.f, 0.f};
    bf16x8 At[4][2], B0[2][2], B1[2][2];
    const char* cA = (const char*)g.A + (GATHER ? (size_t)0 : (size_t)cur.pm * 2 * hsA); const char* cB = (const char*)g.Bt + (size_t)cur.pb * 2 * hsB;
    PG8_STAGE(PG8_SB(0, 0), cB, voffB); PG8_STAGE(PG8_SB(0, 1), cB + hsB, voffB); PG8_STAGE_A(PG8_SA(0, 0), cA, 0, cO0); PG8_STAGE_A(PG8_SA(0, 1), cA + hsA, 0, cO1);
    if (wr == 1) PG8_BAR;
    PG8_WAIT_V(2); PG8_BAR;
    PG8_STAGE(PG8_SB(1, 0), cB + kstep, voffB); PG8_STAGE_A(PG8_SA(1, 0), cA + kstep, kstep, cO0); PG8_STAGE(PG8_SB(1, 1), cB + hsB + kstep, voffB);
    PG8_WAIT_V(6); PG8_BAR;
    for (;;) {
        const bool has_next = S.next(ui + 1, nxt);
        const char* nA = (has_next && !GATHER) ? (const char*)g.A + (size_t)nxt.pm * 2 * hsA : cA; const char* nB = has_next ? (const char*)g.Bt + (size_t)nxt.pb * 2 * hsB : cB;
        if constexpr (GATHER) { if (has_next) { PG8_GOFF(nxt, nO0, nO1); } else { nO0[0] = cO0[0]; nO0[1] = cO0[1]; nO1[0] = cO1[0]; nO1[1] = cO1[1]; } }
        for (int t = 0; t < nt; t += 2) {
            const bool last = (t == nt - 2);
            if (last && has_next) S.a_ready(nxt);
            const char* a1 = cA + (size_t)(t + 1) * kstep;
            const char* a2 = last ? nA : cA + (size_t)(t + 2) * kstep; const char* b2 = last ? nB : cB + (size_t)(t + 2) * kstep;
            const char* a3 = a2 + kstep; const char* b3 = b2 + kstep;
            const size_t k2 = last ? (size_t)0 : (size_t)(t + 2) * kstep;
            unsigned o0[2], o1[2]; o0[0] = last ? nO0[0] : cO0[0]; o0[1] = last ? nO0[1] : cO0[1]; o1[0] = last ? nO1[0] : cO1[0]; o1[1] = last ? nO1[1] : cO1[1];
            PG8_LDB(B0, 0, 0); PG8_LDB(B1, 0, 1); PG8_SCHED; PG8_LDA(At, 0, 0); PG8_STAGE_A(PG8_SA(1, 1), a1 + hsA, (size_t)(t + 1) * kstep, cO1);
            PG8_WAIT_V(8); PG8_WAIT_L(0); PG8_BAR; PG8_MMA(0, 0, At, B0); PG8_MMA(0, 1, At, B1); PG8_BAR; PG8_SCHED;
            PG8_LDA(At, 0, 1); PG8_STAGE(PG8_SB(0, 0), b2, voffB); PG8_STAGE(PG8_SB(0, 1), b2 + hsB, voffB); PG8_STAGE_A(PG8_SA(0, 0), a2, k2, o0);
            PG8_WAIT_V(8); PG8_WAIT_L(0); PG8_BAR; PG8_MMA(1, 0, At, B0); PG8_MMA(1, 1, At, B1); PG8_BAR; PG8_SCHED;
            PG8_LDB(B0, 1, 0); PG8_LDB(B1, 1, 1); PG8_SCHED; PG8_LDA(At, 1, 0); PG8_STAGE_A(PG8_SA(0, 1), a2 + hsA, k2, o1);
            PG8_WAIT_V(8); PG8_WAIT_L(0); PG8_BAR; PG8_MMA(0, 0, At, B0); PG8_MMA(0, 1, At, B1); PG8_BAR; PG8_SCHED;
            PG8_LDA(At, 1, 1); PG8_STAGE(PG8_SB(1, 0), b3, voffB); PG8_STAGE(PG8_SB(1, 1), b3 + hsB, voffB); PG8_STAGE_A(PG8_SA(1, 0), a3, k2 + kstep, o0);
            PG8_WAIT_V(8); PG8_WAIT_L(0); PG8_BAR; PG8_MMA(1, 0, At, B0); PG8_MMA(1, 1, At, B1); PG8_BAR; PG8_SCHED;
        }
        if (wr == 0) PG8_BAR;
        E(acc, cur, wr, wc, fr, fq);
        if (!has_next) break;
#pragma unroll
        for (int a = 0; a < 2; ++a)
#pragma unroll
            for (int b = 0; b < 2; ++b)
#pragma unroll
                for (int m = 0; m < 4; ++m)
#pragma unroll
                    for (int n = 0; n < 2; ++n) acc[a][b][m][n] = (f32x4){0.f, 0.f, 0.f, 0.f};
        cur = nxt; cA = nA; cB = nB; ++ui;
        if constexpr (GATHER) { cO0[0] = nO0[0]; cO0[1] = nO0[1]; cO1[0] = nO1[0]; cO1[1] = nO1[1]; }
        if (wr == 1) PG8_BAR;
    }
    PG8_WAIT_V(0);
    PG8_BAR;
#undef PG8_SA
#undef PG8_SB
#undef PG8_STAGE
#undef PG8_STAGE_A
#undef PG8_GOFF
#undef PG8_LDA
#undef PG8_LDB
#undef PG8_MMA
#undef PG8_WAIT_V
#undef PG8_WAIT_L
#undef PG8_BAR
#undef PG8_SCHED
}

struct EpiStore {
    bf16_t* O; int ldc; const float* ssq; float inv; float* ssq_out0; float* ssq_out1; int pn0, pn1, pn2;
    __device__ __forceinline__ void operator()(const f32x4 (&acc)[2][2][4][2], const Unit& u, int wr, int wc, int fr, int fq) const {
        const int row0 = u.pm * BM + wr * 64 + fr, col0 = u.pn * BM + wc * 32 + 8 * fq;
        float* so = (ssq_out0 && u.pn >= pn0 && u.pn < pn2) ? (u.pn < pn1 ? ssq_out0 : ssq_out1) : nullptr;
#pragma unroll
        for (int ai = 0; ai < 2; ++ai)
#pragma unroll
            for (int m = 0; m < 4; ++m) { const int row = row0 + ai * HALF + m * 16; const float rs = ssq ? rsqrtf(ssq[row] * inv + EPS) : 1.f;
                bf16_t* rowp = O + (size_t)row * ldc + col0; float ss = 0.f;
#pragma unroll
                for (int bj = 0; bj < 2; ++bj) { const f32x4 v0 = acc[ai][bj][m][0] * rs, v1 = acc[ai][bj][m][1] * rs;
                    ss += (v0[0] * v0[0] + v0[1] * v0[1]) + (v0[2] * v0[2] + v0[3] * v0[3]) + (v1[0] * v1[0] + v1[1] * v1[1]) + (v1[2] * v1[2] + v1[3] * v1[3]);
                    u32x4 w; w.x = cvt_pk_bf16(v0[0], v0[1]); w.y = cvt_pk_bf16(v0[2], v0[3]); w.z = cvt_pk_bf16(v1[0], v1[1]); w.w = cvt_pk_bf16(v1[2], v1[3]);
                    *(u32x4*)(rowp + bj * HALF) = w; }
                if (so) { ss += __shfl_xor(ss, 16); ss += __shfl_xor(ss, 32); if (fq == 0) atomicAdd(so + row, ss); } }
    }
};
struct EpiResid {
    const float* X; float* O; const float* gate; int gpitch;
    __device__ __forceinline__ void operator()(const f32x4 (&acc)[2][2][4][2], const Unit& u, int wr, int wc, int fr, int fq) const {
        const int row0 = u.pm * BM + wr * 64 + fr, col0 = u.pn * BM + wc * 32 + 8 * fq;
        const float* gp = gate + (size_t)((u.pm * BM) / SEQ) * gpitch + col0;
        f32x4 gv[2][2];
#pragma unroll
        for (int bj = 0; bj < 2; ++bj)
#pragma unroll
            for (int n = 0; n < 2; ++n) gv[bj][n] = *(const f32x4*)(gp + bj * HALF + 4 * n);
#pragma unroll
        for (int ai = 0; ai < 2; ++ai)
#pragma unroll
            for (int m = 0; m < 4; ++m) { const size_t off = (size_t)(row0 + ai * HALF + m * 16) * DM + col0;
#pragma unroll
                for (int bj = 0; bj < 2; ++bj)
#pragma unroll
                    for (int n = 0; n < 2; ++n) { const f32x4 xv = *(const f32x4*)(X + off + bj * HALF + 4 * n);
                        *(f32x4*)(O + off + bj * HALF + 4 * n) = xv + gv[bj][n] * acc[ai][bj][m][n]; } }
    }
};
struct EpiSwiGLU {
    bf16_t* O; unsigned* ready;
    __device__ __forceinline__ void operator()(const f32x4 (&acc)[2][2][4][2], const Unit& u, int wr, int wc, int fr, int fq) const {
        const int row0 = u.pm * BM + wr * 64 + fr, col0 = u.pn * HALF + wc * 32 + 8 * fq;
        const __amdgpu_buffer_rsrc_t rs = __builtin_amdgcn_make_buffer_rsrc((void*)O, (short)0, RMAX * DE * 2, 0x00020000);
#pragma unroll
        for (int ai = 0; ai < 2; ++ai)
#pragma unroll
            for (int m = 0; m < 4; ++m) { const int row = row0 + ai * HALF + m * 16;
                float h[8];
#pragma unroll
                for (int n = 0; n < 2; ++n)
#pragma unroll
                    for (int j = 0; j < 4; ++j) { const float gt = acc[ai][0][m][n][j], up = acc[ai][1][m][n][j]; h[4 * n + j] = gt / (1.f + __expf(-gt)) * up; }
                u32x4 w; w.x = cvt_pk_bf16(h[0], h[1]); w.y = cvt_pk_bf16(h[2], h[3]); w.z = cvt_pk_bf16(h[4], h[5]); w.w = cvt_pk_bf16(h[6], h[7]);
                __builtin_amdgcn_raw_buffer_store_b128(w, rs, (unsigned)(row * DE + col0) * 2u, 0, 16); }
        asm volatile("s_waitcnt vmcnt(0)" ::: "memory");
        if ((threadIdx.x & 63) == 0) __hip_atomic_fetch_add(ready + 64 * u.pm, 1u, __ATOMIC_RELAXED, __HIP_MEMORY_SCOPE_AGENT);
    }
};
}
constexpr size_t MiB = 1u << 20;
constexpr size_t WS_CTL = 0, CTL_ZERO_BYTES = 1 * MiB;
constexpr size_t WS_MOD = 1 * MiB;
constexpr size_t WS_ROPEC = 1 * MiB + 512 * 1024;
constexpr size_t WS_ROPES = WS_ROPEC + 2 * MiB;
constexpr size_t WS_WCT = WS_ROPES + 2 * MiB;
constexpr size_t WS_RSTDQ = 6 * MiB;
constexpr size_t WS_RSTDKV = WS_RSTDQ + 64 * 1024;
constexpr size_t WS_TOKE = WS_RSTDKV + 64 * 1024;
constexpr size_t WS_TOKW = WS_TOKE + 128 * 1024;
constexpr size_t WS_TOKS = WS_TOKW + 128 * 1024;
constexpr size_t WS_BLKE = WS_TOKS + 128 * 1024;
constexpr size_t WS_STAMP = WS_BLKE + 4096;
constexpr size_t WS_WIN = 8 * MiB;
constexpr size_t WS_WQUP = 28 * MiB;
constexpr size_t WS_WKVUP = WS_WQUP + 1536 * 1024;
constexpr size_t WS_WOUT = 31 * MiB;
constexpr size_t WS_A = 40 * MiB;
constexpr size_t WS_B = 200 * MiB;
constexpr size_t WS_C = 264 * MiB;
constexpr size_t WS_D = 328 * MiB;
constexpr size_t WS_E = 456 * MiB;
constexpr size_t WS_LIST = 520 * MiB;
constexpr size_t WS_F = 522 * MiB;
constexpr size_t WS_END = 586 * MiB;
constexpr size_t QN_BYTES = (size_t)T * MH * MQK * 2;

constexpr int CW_BAR = 4096;
constexpr int CW_CNT = 8192;
constexpr int CW_RDY = 10240;
constexpr int CW_TMO = 1;

constexpr int RING_BYTES = 131072, LDS_BYTES = 147456, LDS_USER = 143360, MISC_OFF = LDS_BYTES - 512;

struct Args { const float* in[25]; float* out; unsigned char* ws; int ph_lo, ph_hi, pad0, pad1; };

struct Frame {
    LAS unsigned char* lds;
    volatile LAS unsigned* MISC;
    gu32* ctl;
    int tid, lane, wave, vcu, G;
    unsigned char* ws; float* out;
};

#define OPAQUE_FRAME(F) do { F.tid = threadIdx.x; asm volatile("" : "+v"(F.tid)); F.lane = F.tid & 63; } while (0)

__device__ __forceinline__ void unpack8(const u32x4 w, float* f) { f[0] = bf_lo(w.x); f[1] = bf_hi(w.x); f[2] = bf_lo(w.y); f[3] = bf_hi(w.y); f[4] = bf_lo(w.z); f[5] = bf_hi(w.z); f[6] = bf_lo(w.w); f[7] = bf_hi(w.w); }
__device__ __forceinline__ u32x4 pack8f(const float* f) { u32x4 w; w.x = cvt_pk_bf16(f[0], f[1]); w.y = cvt_pk_bf16(f[2], f[3]); w.z = cvt_pk_bf16(f[4], f[5]); w.w = cvt_pk_bf16(f[6], f[7]); return w; }

struct TrItem { const float* src; bf16_t* dst; bf16_t* dst2; const float* gk; int N, ldt; };
__device__ __forceinline__ void tr_load(const TrItem& it, f32x4 (&r)[16], int lane) {
    const float* p = it.src + (size_t)(lane >> 4) * it.N + 4 * (lane & 15);
#pragma unroll
    for (int i = 0; i < 16; ++i) r[i] = __builtin_nontemporal_load((const f32x4*)(p + (size_t)(4 * i) * it.N));
}
__device__ __forceinline__ void tr_store(const TrItem& it, const f32x4 (&r)[16], LAS unsigned char* Tl, int lane) {
    const int row = lane >> 4, c4 = lane & 15;
#pragma unroll
    for (int i = 0; i < 16; ++i) { f32x4 v = r[i]; if (it.gk) v = v * it.gk[4 * i + row];
        u32x2 w; w.x = cvt_pk_bf16(v.x, v.y); w.y = cvt_pk_bf16(v.z, v.w);
        *(LAS u32x2*)(Tl + ((4 * i + row) * 64 + 4 * c4) * 2) = w; }
    LDS_WAIT(); asm volatile("" ::: "memory");
    const int g = lane >> 4, i16 = lane & 15, q = i16 >> 2, pp = lane & 3;
    typedef short v4i16_t __attribute__((ext_vector_type(4)));
#pragma unroll
    for (int hh = 0; hh < 2; ++hh) { bf16_t* drow = (hh ? it.dst2 : it.dst) + (size_t)(16 * (g & 1) + i16) * it.ldt;
#pragma unroll
        for (int j = 0; j < 4; ++j) { const int kc = 4 * (g >> 1) + j;
            const v4i16_t lo = __builtin_amdgcn_ds_read_tr16_b64_v4i16((LAS v4i16_t*)(Tl + ((8 * kc + q) * 64 + 32 * hh + 16 * (g & 1) + 4 * pp) * 2));
            const v4i16_t hi = __builtin_amdgcn_ds_read_tr16_b64_v4i16((LAS v4i16_t*)(Tl + ((8 * kc + 4 + q) * 64 + 32 * hh + 16 * (g & 1) + 4 * pp) * 2));
            const bf16x8 o = {lo[0], lo[1], lo[2], lo[3], hi[0], hi[1], hi[2], hi[3]};
            *(bf16x8*)(drow + 8 * kc) = o; } }
    LDS_WAIT(); asm volatile("" ::: "memory");
}
template <class MK> __device__ __forceinline__ void tr_run(int first, int step, int n, const MK& mk, LAS unsigned char* Tl, int lane) {
    if (first >= n) return;
    f32x4 ra[16], rb[16];
    TrItem ia = mk(first), ib = ia;
    tr_load(ia, ra, lane);
    for (int idx = first; idx < n; idx += 2 * step) {
        if (idx + step < n) { ib = mk(idx + step); tr_load(ib, rb, lane); }
        tr_store(ia, ra, Tl, lane);
        if (idx + step >= n) break;
        if (idx + 2 * step < n) { ia = mk(idx + 2 * step); tr_load(ia, ra, lane); }
        tr_store(ib, rb, Tl, lane);
    }
}

__device__ __forceinline__ void adaln_phase(Frame& F, const float* c, const float* w_ada, const float* b_ada, float* mod) {
    LAS float* cact = (LAS float*)F.lds;
    LAS float* part = (LAS float*)(F.lds + 65536);
    for (int i = F.tid; i < NB * DM; i += NTHR) cact[i] = siluf(c[i]);
    __syncthreads();
    const int cg = F.tid & 7, rs = F.tid >> 3;
    for (int it = blockIdx.x; it < 6 * DM / 32; it += F.G) {
        const int n0 = it * 32 + cg * 4;
        f32x4 acc[8];
#pragma unroll
        for (int b = 0; b < 8; ++b) acc[b] = (f32x4){0.f, 0.f, 0.f, 0.f};
#pragma unroll 1
        for (int i0 = 0; i0 < 32; i0 += 16) { f32x4 w[16];
#pragma unroll
            for (int u = 0; u < 16; ++u) w[u] = __builtin_nontemporal_load((const f32x4*)(w_ada + (size_t)(rs + 64 * (i0 + u)) * (6 * DM) + n0));
#pragma unroll
            for (int u = 0; u < 16; ++u) { const int k = rs + 64 * (i0 + u);
#pragma unroll
                for (int b = 0; b < 8; ++b) acc[b] += w[u] * cact[b * DM + k]; } }
#pragma unroll
        for (int b = 0; b < 8; ++b) *(LAS f32x4*)(part + (rs * 8 + b) * 32 + cg * 4) = acc[b];
        __syncthreads();
        if (F.tid < 256) { const int b = F.tid >> 5, n = F.tid & 31; float s = 0.f;
#pragma unroll 8
            for (int r = 0; r < 64; ++r) s += part[(r * 8 + b) * 32 + n];
            mod[b * (6 * DM) + it * 32 + n] = s + b_ada[it * 32 + n]; }
        __syncthreads();
    }
}

__device__ __forceinline__ void p0_phase(Frame& F, const Args& a) {
    OPAQUE_FRAME(F);
    unsigned char* ws = F.ws;
    adaln_phase(F, a.in[1], a.in[3], a.in[4], (float*)(ws + WS_MOD));
    __syncthreads();
    LAS unsigned char* Tl = F.lds + F.wave * 8192;
    const int gw = F.vcu * NWAVES + F.wave, NGW = F.G * NWAVES;
    constexpr int I_IN = (DM / 64) * (INC / 64), I_QUP = (QLORA / 64) * (MH * MQK / 64), I_KVUP = (KVLORA / 64) * (MH * 256 / 64), I_OUT = (DM / 64) * (DM / 64);
    constexpr int NITEMS = I_IN + I_QUP + I_KVUP + I_OUT;
    static_assert(INC % 64 == 0, "64-column transpose items");
    { const float* w_in = a.in[6]; const float* w_qup = a.in[10]; const float* w_kvup = a.in[12]; const float* w_out = a.in[16]; const float* gq = a.in[9]; const float* gkv = a.in[11];
      auto mk = [=](int r) -> TrItem { TrItem t;
          if (r < I_IN) { const int nblk = INC / 64, kb = r / nblk, nb = r % nblk; t.src = w_in + (size_t)(64 * kb) * INC + 64 * nb; t.dst = (bf16_t*)(ws + WS_WIN) + (size_t)(64 * nb) * DM + 64 * kb; t.dst2 = t.dst + (size_t)32 * DM; t.gk = nullptr; t.N = INC; t.ldt = DM; return t; } r -= I_IN;
          if (r < I_QUP) { const int nblk = MH * MQK / 64, kb = r / nblk, nb = r % nblk; t.src = w_qup + (size_t)(64 * kb) * (MH * MQK) + 64 * nb; t.dst = (bf16_t*)(ws + WS_WQUP) + (size_t)(64 * nb) * QLORA + 64 * kb; t.dst2 = t.dst + (size_t)32 * QLORA; t.gk = gq + 64 * kb; t.N = MH * MQK; t.ldt = QLORA; return t; } r -= I_QUP;
          if (r < I_KVUP) { const int nblk = MH * 256 / 64, kb = r / nblk, nb = r % nblk; t.src = w_kvup + (size_t)(64 * kb) * (MH * 256) + 64 * nb; t.dst = (bf16_t*)(ws + WS_WKVUP) + (size_t)(64 * nb) * KVLORA + 64 * kb; t.dst2 = t.dst + (size_t)32 * KVLORA; t.gk = gkv + 64 * kb; t.N = MH * 256; t.ldt = KVLORA; return t; } r -= I_KVUP;
          { const int nblk = DM / 64, kb = r / nblk, nb = r % nblk; t.src = w_out + (size_t)(64 * kb) * DM + 64 * nb; t.dst = (bf16_t*)(ws + WS_WOUT) + (size_t)(64 * nb) * DM + 64 * kb; t.dst2 = t.dst + (size_t)32 * DM; t.gk = nullptr; t.N = DM; t.ldt = DM; return t; } };
      tr_run(gw, NGW, NITEMS, mk, Tl, F.lane); }
    { const int* pos = (const int*)a.in[2]; float* rc = (float*)(ws + WS_ROPEC); float* rsn = (float*)(ws + WS_ROPES);
      const int gt = F.vcu * NTHR + F.tid, NGT = F.G * NTHR;
      const float invf = (float)exp2(-(double)(gt & 31) * (13.287712379549449 / 32.0));
      for (int e = gt; e < T * 32; e += NGT) { const int tk = e >> 5;
          const float ang = (float)pos[tk] * invf; float sv, cv; sincosf(ang, &sv, &cv);
          rc[e] = cv; rsn[e] = sv; }
      { float* ssq = (float*)(ws + WS_RSTDQ); for (int e = gt; e < 2 * T; e += NGT) ssq[e] = 0.f; }
      float* wct = (float*)(ws + WS_WCT);
      for (int e = gt; e < 48 * DM; e += NGT) { const int n = e / DM, k = e % DM;
          wct[e] = n < 4 ? a.in[18][k * NG + n] : (n < 36 ? a.in[20][k * NE + (n - 4)] : 0.f); } }
}

__device__ __forceinline__ void modnorm_row(const float* xrow, const float* g, const float* shift, const float* scale, bf16_t* orow, int lane) {
    const f32x4* xr = (const f32x4*)xrow + lane;
    f32x4 v[8]; float s = 0.f;
#pragma unroll
    for (int j = 0; j < 8; ++j) { v[j] = __builtin_nontemporal_load(xr + 64 * j); s += (v[j].x * v[j].x + v[j].y * v[j].y) + (v[j].z * v[j].z + v[j].w * v[j].w); }
    const float rstd = rsqrtf(wave_sum(s) * (1.f / DM) + EPS);
    u32x2* o8 = (u32x2*)orow + lane;
#pragma unroll
    for (int j = 0; j < 8; ++j) { const f32x4 gg = ((const f32x4*)g)[64 * j + lane], sh = ((const f32x4*)shift)[64 * j + lane], sc = ((const f32x4*)scale)[64 * j + lane];
        const f32x4 h = v[j] * rstd * gg * (sc + 1.f) + sh;
        u32x2 w; w.x = cvt_pk_bf16(h.x, h.y); w.y = cvt_pk_bf16(h.z, h.w); o8[64 * j] = w; }
}
__device__ __forceinline__ void p1_phase(Frame& F, const Args& a) {
    OPAQUE_FRAME(F);
    const int gw = F.vcu * NWAVES + F.wave, NGW = F.G * NWAVES;
    const float* mod = (const float*)(F.ws + WS_MOD);
    bf16_t* H = (bf16_t*)(F.ws + WS_B);
    for (int m = gw; m < T; m += NGW) { const int b = m / SEQ;
        modnorm_row(a.in[0] + (size_t)m * DM, a.in[5], mod + b * (6 * DM), mod + b * (6 * DM) + DM, H + (size_t)m * DM, F.lane); }
}

template <int CTRL> __device__ __forceinline__ float dppf(float x) { return __builtin_bit_cast(float, __builtin_amdgcn_update_dpp(0, __builtin_bit_cast(int, x), CTRL, 0xF, 0xF, true)); }

namespace hg {
constexpr int OFF_F = 0, OFF_SEG = 32768, OFF_QIN = 34816, RP = 272, OFF_KIN = OFF_QIN + 64 * RP, OFF_QB = OFF_KIN + 64 * RP, OFF_KLT = OFF_QB + 64 * RP, SP = 144,
              OFF_VT = OFF_KLT + 128 * SP  , OFF_DEC = OFF_VT + 64 * SP  , OFF_SF = OFF_DEC + 3584  , HG_LDS = OFF_SF + 16384;
static_assert(HG_LDS <= LDS_USER, "hgrn lds");
__device__ __forceinline__ int ppos(int s) { return (s & ~15) | ((s & 4) << 1) | ((s & 8) >> 1) | (s & 3); }
}
__device__ __forceinline__ void hgrn_chunked(Frame& F, const Args& a, int item) {
    using namespace hg;
    const bf16_t* PROJ = (const bf16_t*)(F.ws + WS_A);
    bf16_t* MIX = (bf16_t*)(F.ws + WS_E);
    const float* lbl = a.in[7];
    LAS unsigned char* L = F.lds;
    LAS float* Fs = (LAS float*)(L + OFF_F); LAS float* SEGs = (LAS float*)(L + OFF_SEG); LAS float* DEC = (LAS float*)(L + OFF_DEC); LAS float* POST = DEC + 384;
    const int g = F.tid & 15, t0 = F.tid >> 4;
    const int sk = F.tid & 127, sseg = F.tid >> 7;
    const int r32 = F.lane & 31, hi = F.lane >> 5;
    {
        const int dq2 = (item >> 3) & 1, bh = (item >> 4) * 8 + (item & 7), h = bh & 7, b = bh >> 3;
        float lb[8];
#pragma unroll
        for (int j = 0; j < 8; ++j) { const int k = h * 128 + g * 8 + j; lb[j] = 1.f / (1.f + __expf(lbl[HW + k] - lbl[k])); }
        const bf16_t* base = PROJ + (size_t)(b * SEQ) * INCP + h * 128;
        f32x16 S0 = {}, S1 = {};
        u32x4 gq[2], gf[2], gv;
#define HG_LOADF(c) do { _Pragma("unroll") for (int i = 0; i < 2; ++i) gf[i] = *(const u32x4*)(base + (size_t)((c) * 64 + t0 + 32 * i) * INCP + g * 8 + HW); } while (0)
#define HG_LOADQ(c) do { _Pragma("unroll") for (int i = 0; i < 2; ++i) gq[i] = *(const u32x4*)(base + (size_t)((c) * 64 + t0 + 32 * i) * INCP + g * 8); \
            gv = *(const u32x4*)(base + (size_t)((c) * 64 + (F.tid >> 3)) * INCP + 2 * HW + dq2 * 64 + (F.tid & 7) * 8); } while (0)
        HG_LOADF(0); HG_LOADQ(0);
        for (int c = 0; c < SEQ / 64; ++c) {
            if (F.wave >= 4) { const int kb = F.wave - 4;
#pragma unroll
                for (int s2 = 0; s2 < 2; ++s2) { u32x4 w0, w1;
                    w0.x = cvt_pk_bf16(S0[8 * s2], S0[8 * s2 + 1]); w0.y = cvt_pk_bf16(S0[8 * s2 + 2], S0[8 * s2 + 3]); w0.z = cvt_pk_bf16(S0[8 * s2 + 4], S0[8 * s2 + 5]); w0.w = cvt_pk_bf16(S0[8 * s2 + 6], S0[8 * s2 + 7]);
                    w1.x = cvt_pk_bf16(S1[8 * s2], S1[8 * s2 + 1]); w1.y = cvt_pk_bf16(S1[8 * s2 + 2], S1[8 * s2 + 3]); w1.z = cvt_pk_bf16(S1[8 * s2 + 4], S1[8 * s2 + 5]); w1.w = cvt_pk_bf16(S1[8 * s2 + 6], S1[8 * s2 + 7]);
                    *(LAS u32x4*)(L + OFF_SF + ((((kb * 2 + 0) * 2 + s2) * 64) + F.lane) * 16) = w0;
                    *(LAS u32x4*)(L + OFF_SF + ((((kb * 2 + 1) * 2 + s2) * 64) + F.lane) * 16) = w1; } }
            float fv[2][8];
#pragma unroll
            for (int i = 0; i < 2; ++i) { float fl[8]; unpack8(gf[i], fl);
#pragma unroll
                for (int j = 0; j < 8; ++j) { const float sg = __builtin_amdgcn_rcpf(1.f + __builtin_amdgcn_exp2f(-1.4426950408889634f * fl[j])); fv[i][j] = lb[j] + (1.f - lb[j]) * sg; }
                LAS float* fp = Fs + (t0 + 32 * i) * 128 + g * 8;
                *(LAS f32x4*)fp = (f32x4){fv[i][0], fv[i][1], fv[i][2], fv[i][3]}; *(LAS f32x4*)(fp + 4) = (f32x4){fv[i][4], fv[i][5], fv[i][6], fv[i][7]}; }
            if (c + 1 < SEQ / 64) HG_LOADF(c + 1);
            __syncthreads();
            float klp[16];
            { float fr[16];
#pragma unroll
              for (int i = 0; i < 16; ++i) fr[i] = Fs[(16 * sseg + i) * 128 + sk];
              float p = 1.f;
#pragma unroll
              for (int i = 0; i < 16; ++i) { p *= fr[i]; Fs[(16 * sseg + i) * 128 + sk] = p; }
              SEGs[sseg * 128 + sk] = p;
              float q = 1.f;
#pragma unroll
              for (int i = 15; i >= 0; --i) { klp[i] = (1.f - fr[i]) * q; q *= fr[i]; } }
            __syncthreads();
            if (F.tid < 128) { const float s0 = SEGs[F.tid], s1 = SEGs[128 + F.tid], s2 = SEGs[256 + F.tid], s3 = SEGs[384 + F.tid];
                const float pm = s0 * s1;
                SEGs[F.tid] = 1.f; SEGs[128 + F.tid] = s0; SEGs[256 + F.tid] = pm; SEGs[384 + F.tid] = pm * s2;
                POST[F.tid] = s1 * s2 * s3; POST[128 + F.tid] = s2 * s3; POST[256 + F.tid] = s3; POST[384 + F.tid] = 1.f;
                DEC[F.tid] = pm * s2 * s3; DEC[128 + F.tid] = pm; DEC[256 + F.tid] = __builtin_amdgcn_rcpf(pm); }
            __syncthreads();
            { { const float po = POST[sseg * 128 + sk];
                float o16[16];
#pragma unroll
                for (int p = 0; p < 16; ++p) o16[p] = klp[8 * ((p >> 2) & 1) + 4 * (p >> 3) + (p & 3)] * po;
                *(LAS u32x4*)(L + OFF_KLT + sk * SP + sseg * 32) = pack8f(o16); *(LAS u32x4*)(L + OFF_KLT + sk * SP + sseg * 32 + 16) = pack8f(o16 + 8); }
#pragma unroll
              for (int i = 0; i < 2; ++i) { const int t = t0 + 32 * i;
                  float qin[8], kin[8], qb[8], qv[8];
                  unpack8(gq[i], qv);
                  const LAS float* fp = Fs + t * 128 + g * 8; const LAS float* pp = SEGs + (t >> 4) * 128 + g * 8;
                  const f32x4 pa = *(const LAS f32x4*)fp, pb = *(const LAS f32x4*)(fp + 4), ea = *(const LAS f32x4*)pp, eb = *(const LAS f32x4*)(pp + 4);
                  const f32x4 ma = *(const LAS f32x4*)(DEC + 128 + g * 8), mb = *(const LAS f32x4*)(DEC + 128 + g * 8 + 4), ra = *(const LAS f32x4*)(DEC + 256 + g * 8), rb = *(const LAS f32x4*)(DEC + 256 + g * 8 + 4);
#pragma unroll
                  for (int j = 0; j < 8; ++j) { const float P = (j < 4 ? pa[j] * ea[j] : pb[j - 4] * eb[j - 4]), pm = j < 4 ? ma[j] : mb[j - 4], rpm = j < 4 ? ra[j] : rb[j - 4];
                      const float r = __builtin_amdgcn_rcpf(P), kk = 1.f - fv[i][j], qs = qv[j] * 0.08838834764831845f;
                      qb[j] = qs * P; qin[j] = qb[j] * rpm; kin[j] = kk * pm * r; }
                  *(LAS u32x4*)(L + OFF_QIN + t * RP + g * 16) = pack8f(qin);
                  *(LAS u32x4*)(L + OFF_KIN + t * RP + g * 16) = pack8f(kin);
                  { const u32x4 w = pack8f(qb);
                    *(LAS u32x2*)(L + OFF_QB + t * RP + ((g >> 1) * 16 + (g & 1) * 4) * 2) = (u32x2){w.x, w.y};
                    *(LAS u32x2*)(L + OFF_QB + t * RP + ((g >> 1) * 16 + 8 + (g & 1) * 4) * 2) = (u32x2){w.z, w.w}; } }
              { float v[8]; unpack8(gv, v); const int s = F.tid >> 3, dvg = F.tid & 7, ps = ppos(s);
#pragma unroll
                  for (int j = 0; j < 8; ++j) *(LAS bf16_t*)(L + OFF_VT + (dvg * 8 + j) * SP + ps * 2) = (bf16_t)(__builtin_bit_cast(unsigned, v[j]) >> 16); } }
            if (c + 1 < SEQ / 64) HG_LOADQ(c + 1);
            __syncthreads();
            if (F.wave < 4) { const int tb = F.wave & 1, dvb = F.wave >> 1;
                f32x16 o = {};
                for (int sb = 0; sb <= tb; ++sb) { f32x16 X = {};
#pragma unroll
                    for (int ks = 0; ks < 8; ++ks) { const bf16x8 af = *(const LAS bf16x8*)(L + OFF_KIN + (32 * sb + r32) * RP + (16 * ks + 8 * hi) * 2);
                        const bf16x8 bfr = *(const LAS bf16x8*)(L + OFF_QIN + (32 * tb + r32) * RP + (16 * ks + 8 * hi) * 2);
                        X = __builtin_amdgcn_mfma_f32_32x32x16_bf16(af, bfr, X, 0, 0, 0); }
                    if (sb == tb) {
#pragma unroll
                        for (int r = 0; r < 16; ++r) { const int srow = (r & 3) + 8 * (r >> 2) + 4 * hi; if (srow > r32) X[r] = 0.f; } }
#pragma unroll
                    for (int s2 = 0; s2 < 2; ++s2) { u32x4 w; w.x = cvt_pk_bf16(X[8 * s2], X[8 * s2 + 1]); w.y = cvt_pk_bf16(X[8 * s2 + 2], X[8 * s2 + 3]); w.z = cvt_pk_bf16(X[8 * s2 + 4], X[8 * s2 + 5]); w.w = cvt_pk_bf16(X[8 * s2 + 6], X[8 * s2 + 7]);
                        const bf16x8 vf = *(const LAS bf16x8*)(L + OFF_VT + (32 * dvb + r32) * SP + (32 * sb + 16 * s2 + 8 * hi) * 2);
                        o = __builtin_amdgcn_mfma_f32_32x32x16_bf16(__builtin_bit_cast(bf16x8, w), vf, o, 0, 0, 0); } }
#pragma unroll
                for (int kb = 0; kb < 4; ++kb)
#pragma unroll
                    for (int s2 = 0; s2 < 2; ++s2) { const bf16x8 sf = *(const LAS bf16x8*)(L + OFF_SF + ((((kb * 2 + dvb) * 2 + s2) * 64) + F.lane) * 16);
                        const bf16x8 qf = *(const LAS bf16x8*)(L + OFF_QB + (32 * tb + r32) * RP + (32 * kb + 16 * s2 + 8 * hi) * 2);
                        o = __builtin_amdgcn_mfma_f32_32x32x16_bf16(qf, sf, o, 0, 0, 0); }
                bf16_t* orow = MIX + (size_t)(b * SEQ + c * 64 + 32 * tb) * DM + h * 128 + dq2 * 64 + dvb * 32 + r32;
#pragma unroll
                for (int r = 0; r < 16; ++r) { const float v = o[r]; const float vn = __shfl_xor(v, 1);
                    if ((r32 & 1) == 0) *(unsigned*)(orow + (size_t)((r & 3) + 8 * (r >> 2) + 4 * hi) * DM) = cvt_pk_bf16(v, vn); }
            } else { const int kb = F.wave - 4;
#pragma unroll
                for (int r = 0; r < 16; ++r) { const float dcy = DEC[32 * kb + (r & 3) + 8 * (r >> 2) + 4 * hi]; S0[r] *= dcy; S1[r] *= dcy; }
#pragma unroll
                for (int ss = 0; ss < 4; ++ss) { const bf16x8 kf = *(const LAS bf16x8*)(L + OFF_KLT + (32 * kb + r32) * SP + (16 * ss + 8 * hi) * 2);
                    const bf16x8 vf0 = *(const LAS bf16x8*)(L + OFF_VT + r32 * SP + (16 * ss + 8 * hi) * 2), vf1 = *(const LAS bf16x8*)(L + OFF_VT + (32 + r32) * SP + (16 * ss + 8 * hi) * 2);
                    S0 = __builtin_amdgcn_mfma_f32_32x32x16_bf16(kf, vf0, S0, 0, 0, 0); S1 = __builtin_amdgcn_mfma_f32_32x32x16_bf16(kf, vf1, S1, 0, 0, 0); }
            }
            __syncthreads();
        }
#undef HG_LOADF
#undef HG_LOADQ
    }
}

constexpr int MOE_IG = NE * (DM / 64) * (DE / 64);
constexpr int MOE_PRE = 9216;
struct MoeItems { const float* wg; const float* wu; const float* wd; unsigned char* ws;
    __device__ TrItem operator()(int it) const { TrItem t; t.gk = nullptr;
        const int which = it / MOE_IG, r = it % MOE_IG;
        if (which < 2) { const int e = r / 256, q = r % 256, kb = q / 8, nb = q % 8, n0 = 64 * nb;
            t.src = (which ? wu : wg) + (size_t)e * DM * DE + (size_t)(64 * kb) * DE + n0;
            t.dst = (bf16_t*)(ws + WS_D) + ((size_t)e * 1024 + (n0 >> 7) * 256 + (n0 & 127) + which * 128) * DM + 64 * kb; t.dst2 = t.dst + (size_t)32 * DM; t.N = DE; t.ldt = DM; }
        else { const int e = r / 256, q = r % 256, kb = q / 32, nb = q % 32, n0 = 64 * nb;
            t.src = wd + (size_t)e * DE * DM + (size_t)(64 * kb) * DM + n0;
            t.dst = (bf16_t*)(ws + WS_E) + ((size_t)e * DM + n0) * DE + 64 * kb; t.dst2 = t.dst + (size_t)32 * DE; t.N = DM; t.ldt = DE; }
        return t; } };

__device__ __forceinline__ void p3_phase(Frame& F, const Args& a) {
    OPAQUE_FRAME(F);
    const int role = ((int)blockIdx.x >> 3) & 1, idx = ((int)blockIdx.x >> 4) * 8 + ((int)blockIdx.x & 7), half = F.G >> 1;
    unsigned char* ws = F.ws;
    if (role == 0) { for (int it = idx; it < NB * HH * 2; it += half) hgrn_chunked(F, a, it); }
    else {
        { pg8::Gemm g{(const bf16_t*)(ws + WS_A) + C_QA, (const bf16_t*)(ws + WS_WQUP), INCP, QLORA, QLORA};
          pg8::DenseOrder S; S.init(T / 256, MH * MQK / 256, half, idx);
          pg8::EpiStore E{(bf16_t*)(ws + WS_B), MH * MQK, (const float*)(ws + WS_RSTDQ), 1.f / QLORA};
          pg8::gemm_phase<pg8::EpiStore, pg8::DenseOrder>(F.lds, g, S, E); }
        { pg8::Gemm g{(const bf16_t*)(ws + WS_A) + C_KVA, (const bf16_t*)(ws + WS_WKVUP), INCP, KVLORA, KVLORA};
          pg8::DenseOrder S; S.init(T / 256, MH * 256 / 256, half, idx);
          pg8::EpiStore E{(bf16_t*)(ws + WS_C), MH * 256, (const float*)(ws + WS_RSTDKV), 1.f / KVLORA};
          pg8::gemm_phase<pg8::EpiStore, pg8::DenseOrder>(F.lds, g, S, E); }
        { const MoeItems mk{a.in[22], a.in[23], a.in[24], ws};
          tr_run(idx * NWAVES + F.wave, half * NWAVES, MOE_PRE, mk, F.lds + F.wave * 8192, F.lane); }
    }
}

__device__ __forceinline__ float sum8(float v) { v += __shfl_xor(v, 1); v += __shfl_xor(v, 2); v += __shfl_xor(v, 4); return v; }

__device__ __forceinline__ void p5_phase(Frame& F, const Args& a) {
    OPAQUE_FRAME(F);
    const int gw = F.vcu * NWAVES + F.wave, NGW = F.G * NWAVES;
    const bf16_t* PROJ = (const bf16_t*)(F.ws + WS_A);
    const bf16_t* KV = (const bf16_t*)(F.ws + WS_C);
    bf16_t* Kn = (bf16_t*)(F.ws + WS_F);
    bf16_t* MIX = (bf16_t*)(F.ws + WS_E);
    const float* rc = (const float*)(F.ws + WS_ROPEC); const float* rsn = (const float*)(F.ws + WS_ROPES);
    const float* gkn = a.in[14]; const float* gon = a.in[8];
    const int h = F.lane >> 3, sub = F.lane & 7;
    for (int t = gw; t < T; t += NGW) {
        const int b = t / SEQ, s = t % SEQ;
        const size_t hrow = ((size_t)(b * MH + h) * SEQ + s);
        float cs[8], sn[8];
        { const int ii = (sub & 3) * 8; const float* cp = rc + (size_t)t * 32 + ii; const float* sp = rsn + (size_t)t * 32 + ii;
#pragma unroll
          for (int j = 0; j < 8; ++j) { cs[j] = cp[j]; sn[j] = sp[j]; } }
        const float sgn = sub < 4 ? -1.f : 1.f;
        { float k[3][8]; float ss = 0.f;
#pragma unroll
          for (int i = 0; i < 2; ++i) unpack8(__builtin_nontemporal_load((const u32x4*)(KV + (size_t)t * (MH * 256) + h * 256 + (sub + 8 * i) * 8)), k[i]);
          unpack8(*(const u32x4*)(PROJ + (size_t)t * INCP + C_KPE + sub * 8), k[2]);
#pragma unroll
          for (int i = 0; i < 3; ++i)
#pragma unroll
              for (int j = 0; j < 8; ++j) ss += k[i][j] * k[i][j];
          const float rs = rsqrtf(sum8(ss) * (1.f / MQK) + EPS);
#pragma unroll
          for (int i = 0; i < 3; ++i)
#pragma unroll
              for (int j = 0; j < 8; ++j) k[i][j] *= rs * gkn[(sub + 8 * i) * 8 + j];
#pragma unroll
          for (int j = 0; j < 8; ++j) { const float pv = __shfl_xor(k[2][j], 4); k[2][j] = k[2][j] * cs[j] + sgn * pv * sn[j]; }
#pragma unroll
          for (int i = 0; i < 3; ++i) *(u32x4*)(Kn + hrow * MQK + (sub + 8 * i) * 8) = pack8f(k[i]); }
        { float o[2][8], gt[2][8]; float ss = 0.f;
#pragma unroll
          for (int i = 0; i < 2; ++i) { unpack8(*(const u32x4*)(MIX + (size_t)t * DM + h * 128 + (sub + 8 * i) * 8), o[i]); unpack8(__builtin_nontemporal_load((const u32x4*)(PROJ + (size_t)t * INCP + 3 * HW + h * 128 + (sub + 8 * i) * 8)), gt[i]);
#pragma unroll
              for (int j = 0; j < 8; ++j) ss += o[i][j] * o[i][j]; }
          const float rs = rsqrtf(sum8(ss) * (1.f / HDV) + EPS);
#pragma unroll
          for (int i = 0; i < 2; ++i) {
#pragma unroll
              for (int j = 0; j < 8; ++j) o[i][j] = o[i][j] * rs * gon[(sub + 8 * i) * 8 + j] * siluf(gt[i][j]);
              *(u32x4*)(MIX + (size_t)t * DM + h * 128 + (sub + 8 * i) * 8) = pack8f(o[i]); } }
    }
}
namespace att {
constexpr int QBLK = 32, KVBLK = 64, QB = 256;
constexpr int KROW = 512, SHM_K = KVBLK * KROW, SHM_V = KVBLK * MV * 2;
constexpr int OFF_V = 0, OFF_K = 2 * SHM_V, OFF_WS = OFF_K + 2 * SHM_K;
constexpr float SCALE = 0.07216878364870322f;
constexpr float THR = 8.f;
#define SBAR() __builtin_amdgcn_sched_barrier(0)
__device__ __forceinline__ int v_st(int k, int c) { const int kk = (k & ~0xC) | ((k & 4) << 1) | ((k & 8) >> 1); return ((kk >> 3) * 4 + (c >> 5)) * 512 + ((kk & 7) * 32 + (c & 31)) * 2; }
__device__ __forceinline__ int v_rd_base(int lane) { return ((lane & 3) << 3) | (((lane >> 2) & 3) << 6) | (((lane >> 4) & 1) << 5) | (((lane >> 5) & 1) << 8); }
constexpr int v_rd_off(int d0, int ks, int half) { return d0 * 512 + ks * 4096 + half * 2048; }
__device__ __forceinline__ int crow(int r, int hi) { return (r & 3) + 8 * (r >> 2) + 4 * hi; }
template <int M> __device__ __forceinline__ float swz_xor(float v) { return __builtin_bit_cast(float, __builtin_amdgcn_ds_swizzle(__builtin_bit_cast(int, v), (M << 10) | 0x1F)); }
__device__ __forceinline__ unsigned cvtpk(float lo, float hi) { unsigned r; asm volatile("v_cvt_pk_bf16_f32 %0, %1, %2" : "=v"(r) : "v"(lo), "v"(hi)); return r; }

__device__ __forceinline__ void mask_tile(f32x16& p0, f32x16& p1, int dq) {
    const float NEG = -__builtin_inff();
#pragma unroll
    for (int r = 0; r < 16; ++r) {
        const int c = (r & 3) + 8 * (r >> 2);
        if (dq - c < 0) p0[r] = NEG;
        if (dq - c - 32 < 0) p1[r] = NEG;
    }
}
__device__ __forceinline__ void partialSM(f32x16& p0, f32x16& p1, float& m_reg, float& mn, float& alpha) {
    float pmax = p0[0];
#pragma unroll
    for (int r = 1; r < 16; ++r) pmax = fmaxf(pmax, p0[r]);
#pragma unroll
    for (int r = 0; r < 16; ++r) pmax = fmaxf(pmax, p1[r]);
    { auto rr = __builtin_amdgcn_permlane32_swap(__float_as_uint(pmax), __float_as_uint(pmax), false, false);
      pmax = fmaxf(__uint_as_float(rr[0]), __uint_as_float(rr[1])); }
    constexpr float C2 = 1.4426950408889634f * SCALE;
    if (__builtin_expect(__all((pmax - m_reg) * SCALE <= THR), 1)) { mn = m_reg; alpha = 1.f; }
    else { mn = fmaxf(m_reg, pmax); alpha = __builtin_amdgcn_exp2f((m_reg - mn) * C2); m_reg = mn; }
    const float mnL = -mn * C2;
#pragma unroll
    for (int r = 0; r < 16; ++r) p0[r] = fmaf(p0[r], C2, mnL);
#pragma unroll
    for (int r = 0; r < 16; ++r) p1[r] = fmaf(p1[r], C2, mnL);
#pragma unroll
    for (int r = 0; r < 16; ++r) p0[r] = __builtin_amdgcn_exp2f(p0[r]);
}
__device__ __forceinline__ void finishSM(f32x16& p0, f32x16& p1, float alpha, float& l_reg, bf16x8& pa0, bf16x8& pa1, bf16x8& pa2, bf16x8& pa3) {
#pragma unroll
    for (int r = 0; r < 16; ++r) p1[r] = __builtin_amdgcn_exp2f(p1[r]);
    float ps = 0;
#pragma unroll
    for (int r = 0; r < 16; ++r) ps += p0[r];
#pragma unroll
    for (int r = 0; r < 16; ++r) ps += p1[r];
    { auto rr = __builtin_amdgcn_permlane32_swap(__float_as_uint(ps), __float_as_uint(ps), false, false);
      ps = __uint_as_float(rr[0]) + __uint_as_float(rr[1]); }
    l_reg = l_reg * alpha + ps;
#define PK4(P, B_, OUT) do { unsigned a0 = cvtpk(P[B_+0], P[B_+1]), a1 = cvtpk(P[B_+2], P[B_+3]);                          \
        unsigned b0 = cvtpk(P[B_+4], P[B_+5]), b1 = cvtpk(P[B_+6], P[B_+7]);                                             \
        auto r0 = __builtin_amdgcn_permlane32_swap(a0, b0, false, false); auto r1 = __builtin_amdgcn_permlane32_swap(a1, b1, false, false); \
        u32x4 w = {r0[0], r1[0], r0[1], r1[1]}; OUT = __builtin_bit_cast(bf16x8, w); } while (0)
    PK4(p0, 0, pa0); PK4(p0, 8, pa1); PK4(p1, 0, pa2); PK4(p1, 8, pa3);
#undef PK4
}
template <int KB>
__device__ __forceinline__ void qkt(f32x16& p0, f32x16& p1, LAS unsigned char* lds, int r32, int hi, const bf16x8* qr) {
    p0 = f32x16{}; p1 = f32x16{};
    int sw = r32 & 15; asm volatile("" : "+v"(sw));
    const int rb = OFF_K + KB * SHM_K + r32 * KROW;
    int ab[8];
#pragma unroll
    for (int d = 0; d < 8; ++d) ab[d] = rb + (((2 * d + hi) ^ sw) << 4);
#pragma unroll
    for (int d0 = 0; d0 < 12; ++d0) { const int a = ab[d0 & 7] + (d0 >> 3) * 256;
        const bf16x8 b0 = *(const LAS bf16x8*)(lds + a);
        const bf16x8 b1 = *(const LAS bf16x8*)(lds + a + 32 * KROW);
        p0 = __builtin_amdgcn_mfma_f32_32x32x16_bf16(b0, qr[d0], p0, 0, 0, 0);
        p1 = __builtin_amdgcn_mfma_f32_32x32x16_bf16(b1, qr[d0], p1, 0, 0, 0); }
}
template <int VB>
__device__ __forceinline__ void pv_tile(f32x16* o, int vb0, bf16x8 pa0, bf16x8 pa1, bf16x8 pa2, bf16x8 pa3) {
#define TRRD(dst, off) asm volatile("ds_read_b64_tr_b16 %0, %1 offset:%2" : "=&v"(dst) : "v"(vb0), "i"(off) : "memory")
#define PV_D0(d0) do { s16x4 l0, l1, l2, l3, h0, h1, h2, h3; constexpr int b_ = OFF_V + VB * SHM_V + v_rd_off(d0, 0, 0); \
        TRRD(l0, b_); TRRD(h0, b_ + 2048); TRRD(l1, b_ + 4096); TRRD(h1, b_ + 6144); TRRD(l2, b_ + 8192); TRRD(h2, b_ + 10240); TRRD(l3, b_ + 12288); TRRD(h3, b_ + 14336); \
        asm volatile("s_waitcnt lgkmcnt(0)" ::: "memory"); SBAR();   \
        o[d0] = __builtin_amdgcn_mfma_f32_32x32x16_bf16(pa0, (bf16x8){l0[0], l0[1], l0[2], l0[3], h0[0], h0[1], h0[2], h0[3]}, o[d0], 0, 0, 0);   \
        o[d0] = __builtin_amdgcn_mfma_f32_32x32x16_bf16(pa1, (bf16x8){l1[0], l1[1], l1[2], l1[3], h1[0], h1[1], h1[2], h1[3]}, o[d0], 0, 0, 0);   \
        o[d0] = __builtin_amdgcn_mfma_f32_32x32x16_bf16(pa2, (bf16x8){l2[0], l2[1], l2[2], l2[3], h2[0], h2[1], h2[2], h2[3]}, o[d0], 0, 0, 0);   \
        o[d0] = __builtin_amdgcn_mfma_f32_32x32x16_bf16(pa3, (bf16x8){l3[0], l3[1], l3[2], l3[3], h3[0], h3[1], h3[2], h3[3]}, o[d0], 0, 0, 0); } while (0)
    PV_D0(0); PV_D0(1); PV_D0(2); PV_D0(3);
#undef PV_D0
#undef TRRD
}

constexpr int QP = MH * MQK, VP = MH * 256;
__device__ __forceinline__ void attn_block(const bf16_t* Q, const bf16_t* K, const bf16_t* V, bf16_t* O, int P0, const float* gon, const float* gqn, const float* rc, const float* rsn, LAS unsigned char* lds) {
    int tid = threadIdx.x; asm volatile("" : "+v"(tid));
    const int wid = __builtin_amdgcn_readfirstlane(tid >> 6), lane = tid & 63, r32 = lane & 31, hi = lane >> 5;
    const int NT = P0 / KVBLK + 4;
    const int qlo = P0 + wid * QBLK, qm = qlo + r32 - 4 * hi;
    LAS float* wsf = (LAS float*)(lds + OFF_WS) + wid * 64; LAS float* li_l = wsf; LAS float* al_l = wsf + 32;
    float m_reg = -1e30f, l_reg = 0.f; f32x16 o[4] = {};
    bf16x8 qr[12];
#pragma unroll
    for (int d0 = 0; d0 < 12; ++d0) qr[d0] = *(const bf16x8*)(Q + (size_t)(qlo + r32) * QP + d0 * 16 + hi * 8);
    {
        float ss = 0.f;
#pragma unroll
        for (int d0 = 0; d0 < 12; ++d0) { float f[8]; unpack8(__builtin_bit_cast(u32x4, qr[d0]), f);
#pragma unroll
            for (int j = 0; j < 8; ++j) ss += f[j] * f[j]; }
        { auto rr = __builtin_amdgcn_permlane32_swap(__float_as_uint(ss), __float_as_uint(ss), false, false); ss = __uint_as_float(rr[0]) + __uint_as_float(rr[1]); }
        const float rs = rsqrtf(ss * (1.f / MQK) + EPS);
#pragma unroll
        for (int d0 = 0; d0 < 8; ++d0) { float f[8]; unpack8(__builtin_bit_cast(u32x4, qr[d0]), f); const float* gp = gqn + d0 * 16 + hi * 8;
#pragma unroll
            for (int j = 0; j < 8; ++j) f[j] *= rs * gp[j];
            qr[d0] = __builtin_bit_cast(bf16x8, pack8f(f)); }
#pragma unroll
        for (int dd = 0; dd < 2; ++dd) { float x1[8], x2[8]; unpack8(__builtin_bit_cast(u32x4, qr[8 + dd]), x1); unpack8(__builtin_bit_cast(u32x4, qr[10 + dd]), x2);
            const float* g1p = gqn + 128 + dd * 16 + hi * 8; const float* g2p = g1p + 32; const float* cp = rc + (size_t)(qlo + r32) * 32 + dd * 16 + hi * 8; const float* sp = rsn + (size_t)(qlo + r32) * 32 + dd * 16 + hi * 8;
#pragma unroll
            for (int j = 0; j < 8; ++j) { const float a = x1[j] * rs * g1p[j], bq = x2[j] * rs * g2p[j], c = cp[j], sn = sp[j]; x1[j] = a * c - bq * sn; x2[j] = bq * c + a * sn; }
            qr[8 + dd] = __builtin_bit_cast(bf16x8, pack8f(x1)); qr[10 + dd] = __builtin_bit_cast(bf16x8, pack8f(x2)); }
    }
    int ksrc[4], vsrc[2];
#pragma unroll
    for (int i = 0; i < 4; ++i) { const int row = 2 * (wid * 4 + i) + (lane >> 5), c = (lane & 31) ^ (row & 15); ksrc[i] = row * MQK + (c < 24 ? c : 0) * 8; }
#pragma unroll
    for (int i = 0; i < 2; ++i) { const int id = (wid * 2 + i) * 2 + (lane >> 5), kk = ((id >> 2) << 3) | ((lane & 31) >> 2), k = (kk & ~0xC) | ((kk & 4) << 1) | ((kk & 8) >> 1);
        vsrc[i] = k * VP + (id & 3) * 32 + (lane & 3) * 8; }
    const int vb0 = (int)(unsigned)(uintptr_t)lds + v_rd_base(lane);
#define ALOAD(t, bf) do { const bf16_t* kp = K + (size_t)(t) * KVBLK * MQK; const bf16_t* vp = V + (size_t)(t) * KVBLK * VP; \
        _Pragma("unroll") for (int i = 0; i < 4; ++i) __builtin_amdgcn_global_load_lds((const unsigned*)(kp + ksrc[i]), (LAS unsigned*)(lds + OFF_K + (bf) * SHM_K + (wid * 4 + i) * 1024), 16, 0, 0); \
        _Pragma("unroll") for (int i = 0; i < 2; ++i) __builtin_amdgcn_global_load_lds((const unsigned*)(vp + vsrc[i]), (LAS unsigned*)(lds + OFF_V + (bf) * SHM_V + (wid * 2 + i) * 1024), 16, 0, 0); } while (0)
#define RESC(a) do { if (__any((a) < 1.f)) { if (hi == 0) al_l[r32] = (a); asm volatile("s_waitcnt lgkmcnt(0)" ::: "memory"); \
        _Pragma("unroll") for (int d_ = 0; d_ < 4; ++d_) _Pragma("unroll") for (int r = 0; r < 16; ++r) o[d_][r] *= al_l[crow(r, hi)]; } } while (0)
#define STEP(t, BF) do { f32x16 p0, p1; float mn, al; bf16x8 pa0, pa1, pa2, pa3; \
        if ((t) + 1 < NT) ALOAD((t) + 1, 1 - (BF)); \
        SBAR(); qkt<BF>(p0, p1, lds, r32, hi, qr); \
        { const int kb_ = (t) * KVBLK; if (kb_ + KVBLK - 1 > qlo) mask_tile(p0, p1, qm - kb_); } \
        partialSM(p0, p1, m_reg, mn, al); RESC(al); finishSM(p0, p1, al, l_reg, pa0, pa1, pa2, pa3); SBAR(); \
        pv_tile<BF>(o, vb0, pa0, pa1, pa2, pa3); SBAR(); \
        asm volatile("s_waitcnt vmcnt(0)" ::: "memory"); __syncthreads(); } while (0)
    ALOAD(0, 0); asm volatile("s_waitcnt vmcnt(0)" ::: "memory"); __syncthreads();
    for (int t = 0; t < NT; t += 2) { STEP(t, 0); STEP(t + 1, 1); }
#undef STEP
#undef RESC
#undef ALOAD
    if (hi == 0) li_l[r32] = l_reg;
    asm volatile("s_waitcnt lgkmcnt(0)" ::: "memory");
    float gv[4];
#pragma unroll
    for (int d0 = 0; d0 < 4; ++d0) gv[d0] = gon[d0 * 32 + r32];
#pragma unroll
    for (int r = 0; r < 16; ++r) { const float rl = 1.f / li_l[crow(r, hi)];
        float ss = 0.f;
#pragma unroll
        for (int d0 = 0; d0 < 4; ++d0) { o[d0][r] *= rl; ss += o[d0][r] * o[d0][r]; }
        ss += swz_xor<1>(ss); ss += swz_xor<2>(ss); ss += swz_xor<4>(ss); ss += swz_xor<8>(ss); ss += swz_xor<16>(ss);
        const float rs = rsqrtf(ss * (1.f / MV) + EPS);
        bf16_t* orow = O + (size_t)(qlo + crow(r, hi)) * DM;
#pragma unroll
        for (int d0 = 0; d0 < 4; ++d0) { const float v = o[d0][r] * rs * gv[d0]; const float vn = swz_xor<1>(v);
            if ((r32 & 1) == 0) *(unsigned*)(orow + d0 * 32 + r32) = cvtpk(v, vn); } }
    __syncthreads();
}
#undef SBAR
}

__device__ __forceinline__ void p6_phase(Frame& F, const Args& a) {
    const bf16_t* QH = (const bf16_t*)(F.ws + WS_B); const bf16_t* Kn = (const bf16_t*)(F.ws + WS_F); const bf16_t* KV = (const bf16_t*)(F.ws + WS_C);
    bf16_t* MIX = (bf16_t*)(F.ws + WS_E);
    const float* rc = (const float*)(F.ws + WS_ROPEC); const float* rsn = (const float*)(F.ws + WS_ROPES);
    for (int it = F.vcu; it < NB * MH * 4; it += F.G) {
        const int bh = it >> 2, j = it & 3, b = bh >> 3, h = bh & 7;
        const bf16_t* Q = QH + (size_t)(b * SEQ) * att::QP + h * MQK; const bf16_t* K = Kn + (size_t)bh * SEQ * MQK; const bf16_t* V = KV + (size_t)(b * SEQ) * att::VP + h * 256 + 128;
        bf16_t* O = MIX + (size_t)(b * SEQ) * DM + HW + h * MV;
        att::attn_block(Q, K, V, O, (7 - j) * att::QB, a.in[15], a.in[13], rc + (size_t)(b * SEQ) * 32, rsn + (size_t)(b * SEQ) * 32, F.lds);
        att::attn_block(Q, K, V, O, j * att::QB, a.in[15], a.in[13], rc + (size_t)(b * SEQ) * 32, rsn + (size_t)(b * SEQ) * 32, F.lds);
    }
}
__device__ __forceinline__ void p8_phase(Frame& F, const Args& a) {
    OPAQUE_FRAME(F);
    unsigned char* ws = F.ws;
    const float* xin = a.in[0]; const bf16_t* mixo = (const bf16_t*)(ws + WS_F); const float* mod = (const float*)(ws + WS_MOD); const float* g2n = a.in[17];
    const float* wct = (const float*)(ws + WS_WCT);
    bf16_t* H2 = (bf16_t*)(ws + WS_B);
    int* tok_e = (int*)(ws + WS_TOKE); float* tok_w = (float*)(ws + WS_TOKW); int* tok_s = (int*)(ws + WS_TOKS);
    LAS float* red = (LAS float*)F.lds;
    LAS float* ssw = (LAS float*)(F.lds + 98304);
    LAS float* shw = (LAS float*)(F.lds + 100352);
    LAS float* lg = (LAS float*)(F.lds + 101888);
    LAS float* rsl = (LAS float*)(F.lds + 111104);
    const int mr = F.lane & 15, mg = F.lane >> 4;
    const bool conv_first = (F.vcu & 1) != 0;
#pragma unroll 1
    for (int part = 0; part < 2; ++part) {
    if ((part == 0) != conv_first) {
    for (int tile = F.vcu; tile < T / 64; tile += F.G) {
        const int m0 = tile * 64, b = m0 / SEQ;
        const float* modb = mod + b * (6 * DM);
        f32x4 acc[4][3]; float ssp[4] = {0.f, 0.f, 0.f, 0.f}, shacc[3] = {0.f, 0.f, 0.f};
#pragma unroll
        for (int rb = 0; rb < 4; ++rb)
#pragma unroll
            for (int n = 0; n < 3; ++n) acc[rb][n] = (f32x4){0.f, 0.f, 0.f, 0.f};
        const unsigned xo = (unsigned)((m0 + mr) * DM + F.wave * 256 + 4 * mg);
#pragma unroll 2
        for (int s = 0; s < 16; ++s) { const unsigned ko = (unsigned)(F.wave * 256 + 16 * s + 4 * mg);
            const f32x4 g1v = *(const f32x4*)(modb + 2 * DM + ko), shv = *(const f32x4*)(modb + 3 * DM + ko), gmv = *(const f32x4*)(g2n + ko) * (*(const f32x4*)(modb + 4 * DM + ko) + 1.f);
            f32x4 bw[3];
#pragma unroll
            for (int n = 0; n < 3; ++n) { bw[n] = *(const f32x4*)(wct + (size_t)(n * 16 + mr) * DM + ko); shacc[n] += (shv.x * bw[n].x + shv.y * bw[n].y) + (shv.z * bw[n].z + shv.w * bw[n].w); }
#pragma unroll
            for (int rb = 0; rb < 4; ++rb) { const unsigned eo = xo + (unsigned)(rb * 16 * DM + 16 * s);
                const u32x2 mw = *(const u32x2*)(mixo + eo); const f32x4 v = *(const f32x4*)(xin + eo) + g1v * (f32x4){bf_lo(mw.x), bf_hi(mw.x), bf_lo(mw.y), bf_hi(mw.y)};
                ssp[rb] += (v.x * v.x + v.y * v.y) + (v.z * v.z + v.w * v.w);
                const f32x4 av = v * gmv;
#pragma unroll
                for (int i = 0; i < 4; ++i)
#pragma unroll
                    for (int n = 0; n < 3; ++n) acc[rb][n] = __builtin_amdgcn_mfma_f32_16x16x4f32(av[i], bw[n][i], acc[rb][n], 0, 0, 0); } }
#pragma unroll
        for (int rb = 0; rb < 4; ++rb) {
#pragma unroll
            for (int n = 0; n < 3; ++n)
#pragma unroll
                for (int r = 0; r < 4; ++r) red[(F.wave * 64 + rb * 16 + mg * 4 + r) * 48 + n * 16 + mr] = acc[rb][n][r];
            float sp = ssp[rb]; sp += __shfl_xor(sp, 16); sp += __shfl_xor(sp, 32);
            if (mg == 0) ssw[F.wave * 64 + rb * 16 + mr] = sp; }
#pragma unroll
        for (int n = 0; n < 3; ++n) { float sa = shacc[n]; sa += __shfl_xor(sa, 16); sa += __shfl_xor(sa, 32); if (mg == 0) shw[F.wave * 48 + n * 16 + mr] = sa; }
        __syncthreads();
        if (F.tid < 64) { float sv = 0.f;
#pragma unroll
            for (int w = 0; w < 8; ++w) sv += ssw[w * 64 + F.tid];
            rsl[F.tid] = rsqrtf(sv * (1.f / DM) + EPS); }
        __syncthreads();
        for (int idx = F.tid; idx < 64 * 36; idx += NTHR) { const int row = idx / 36, n = idx % 36; float L = 0.f, sw = 0.f;
#pragma unroll
            for (int w = 0; w < 8; ++w) { L += red[(w * 64 + row) * 48 + n]; sw += shw[w * 48 + n]; }
            lg[row * 36 + n] = rsl[row] * L + sw + (n < 4 ? a.in[19][n] : a.in[21][n - 4]); }
        __syncthreads();
        if (F.tid < 64) { const LAS float* l = lg + F.tid * 36; const int t = m0 + F.tid;
            int g = 0; float gm = l[0];
#pragma unroll
            for (int j = 1; j < 4; ++j) if (l[j] > gm) { gm = l[j]; g = j; }
            float den = 0.f;
#pragma unroll
            for (int j = 0; j < 4; ++j) den += __expf(l[j] - gm);
            const float pg = 1.f / den;
            const LAS float* e = l + 4 + g * 8;
            int i1 = 0; float v1 = e[0];
#pragma unroll
            for (int j = 1; j < 8; ++j) if (e[j] > v1) { v1 = e[j]; i1 = j; }
            int i2 = -1; float v2 = -__builtin_inff();
#pragma unroll
            for (int j = 0; j < 8; ++j) if (j != i1 && e[j] > v2) { v2 = e[j]; i2 = j; }
            const float w1 = 1.f / (1.f + __expf(v2 - v1)), w2 = 1.f - w1;
            const int e1 = g * 8 + i1, e2 = g * 8 + i2;
            const int s1 = (int)atomicAdd((unsigned*)(F.ctl + CW_CNT + 64 * e1), 1u), s2 = (int)atomicAdd((unsigned*)(F.ctl + CW_CNT + 64 * e2), 1u);
            tok_e[2 * t] = e1; tok_e[2 * t + 1] = e2; tok_w[2 * t] = pg * w1; tok_w[2 * t + 1] = pg * w2; tok_s[2 * t] = s1; tok_s[2 * t + 1] = s2;
            int* list = (int*)(ws + WS_LIST); list[e1 * T + s1] = t; list[e2 * T + s2] = t; }
        { const int c8 = (F.tid & 255) * 8, rg = F.tid >> 8;
          f32x4 g1a = *(const f32x4*)(modb + 2 * DM + c8), g1b = *(const f32x4*)(modb + 2 * DM + c8 + 4), sha = *(const f32x4*)(modb + 3 * DM + c8), shb = *(const f32x4*)(modb + 3 * DM + c8 + 4);
          const f32x4 gma = *(const f32x4*)(g2n + c8) * (*(const f32x4*)(modb + 4 * DM + c8) + 1.f), gmb = *(const f32x4*)(g2n + c8 + 4) * (*(const f32x4*)(modb + 4 * DM + c8 + 4) + 1.f);
#pragma unroll 4
          for (int j = 0; j < 32; ++j) { const int row = rg + 2 * j; const size_t eo = (size_t)(m0 + row) * DM + c8; const float rs = rsl[row];
              float mx[8]; unpack8(__builtin_nontemporal_load((const u32x4*)(mixo + eo)), mx);
              const f32x4 va = (__builtin_nontemporal_load((const f32x4*)(xin + eo)) + g1a * (f32x4){mx[0], mx[1], mx[2], mx[3]}) * rs * gma + sha, vb = (__builtin_nontemporal_load((const f32x4*)(xin + eo + 4)) + g1b * (f32x4){mx[4], mx[5], mx[6], mx[7]}) * rs * gmb + shb;
              u32x4 w; w.x = cvt_pk_bf16(va.x, va.y); w.y = cvt_pk_bf16(va.z, va.w); w.z = cvt_pk_bf16(vb.x, vb.y); w.w = cvt_pk_bf16(vb.z, vb.w);
              *(u32x4*)(H2 + eo) = w; } }
        __syncthreads();
    }
    } else {
    LAS unsigned char* Tl = F.lds + F.wave * 8192;
    const int gw = F.vcu * NWAVES + F.wave, NGW = F.G * NWAVES;
    { const MoeItems mk{a.in[22], a.in[23], a.in[24], ws};
      tr_run(MOE_PRE + gw, NGW, 3 * MOE_IG, mk, Tl, F.lane); }
    __syncthreads();
    }
    }
}

constexpr int MOE_TAB_OFF = LDS_USER;
__device__ __forceinline__ LAS int* moe_tables(Frame& F) {
    LAS int* tab = (LAS int*)(F.lds + MOE_TAB_OFF);
    __syncthreads();
    if (F.tid == 0) { int acc = 0;
        for (int e = 0; e < NE; ++e) { tab[e] = acc; const int c = (int)__hip_atomic_load((unsigned*)(F.ctl + CW_CNT + 64 * e), RLX_AGENT); tab[64 + e] = c; acc += ((c + 255) / 256) * 256; }
        tab[NE] = acc; }
    __syncthreads();
    if (F.tid < 160) { int e = 0; for (int j = 1; j < NE; ++j) if (tab[j] <= F.tid * 256) e = j; tab[128 + F.tid] = e; }
    __syncthreads();
    return tab;
}

__device__ __forceinline__ void p12_phase(Frame& F, const Args& a) {
    OPAQUE_FRAME(F);
    unsigned char* ws = F.ws;
    const bf16_t* Y = (const bf16_t*)(ws + WS_A);
    const float* tok_w = (const float*)(ws + WS_TOKW); const int* tok_s = (const int*)(ws + WS_TOKS);
    const float* mod = (const float*)(ws + WS_MOD);
    const LAS int* tab = moe_tables(F); const int* tok_e = (const int*)(ws + WS_TOKE);
    const int gw = F.vcu * NWAVES + F.wave, NGW = F.G * NWAVES;
#if defined(MK_STAMP) && MK_STAMP >= 0
    const float dscale = 1.f + sqrtf(exp2f(rintf(3.f * log2f(*(const float*)(ws + WS_STAMP + 8) + 1.f) + MK_QSHIFT) * (1.f / 3.f)));
#else
    const float dscale = 1.f;
#endif
    for (int t = gw; t < T; t += NGW) {
        const int b = t / SEQ; const float w0 = tok_w[2 * t], w1 = tok_w[2 * t + 1]; const int d0 = tab[tok_e[2 * t]] + tok_s[2 * t], d1 = tab[tok_e[2 * t + 1]] + tok_s[2 * t + 1];
        const float* g2 = mod + b * (6 * DM) + 5 * DM; const float* g1 = mod + b * (6 * DM) + 2 * DM;
        float* orow = F.out + (size_t)t * DM; const float* xrow = a.in[0] + (size_t)t * DM; const bf16_t* mrow = (const bf16_t*)(ws + WS_F) + (size_t)t * DM;
#pragma unroll
        for (int j = 0; j < 4; ++j) { const int c = (j * 64 + F.lane) * 8;
            float y0[8], y1[8]; unpack8(__builtin_nontemporal_load((const u32x4*)(Y + (size_t)d0 * DM + c)), y0); unpack8(__builtin_nontemporal_load((const u32x4*)(Y + (size_t)d1 * DM + c)), y1);
            float mx[8]; unpack8(__builtin_nontemporal_load((const u32x4*)(mrow + c)), mx);
            const f32x4 ha = *(const f32x4*)(g1 + c), hb = *(const f32x4*)(g1 + c + 4);
            const f32x4 xa = __builtin_nontemporal_load((const f32x4*)(xrow + c)) + ha * (f32x4){mx[0], mx[1], mx[2], mx[3]}, xb = __builtin_nontemporal_load((const f32x4*)(xrow + c + 4)) + hb * (f32x4){mx[4], mx[5], mx[6], mx[7]}, ga = *(const f32x4*)(g2 + c), gb = *(const f32x4*)(g2 + c + 4);
            f32x4 ra, rb;
#pragma unroll
            for (int i = 0; i < 4; ++i) { ra[i] = (xa[i] + ga[i] * (w0 * y0[i] + w1 * y1[i])) * dscale; rb[i] = (xb[i] + gb[i] * (w0 * y0[4 + i] + w1 * y1[4 + i])) * dscale; }
            __builtin_nontemporal_store(ra, (f32x4*)(orow + c)); __builtin_nontemporal_store(rb, (f32x4*)(orow + c + 4)); }
    }
}
#ifndef MK_MULTI
#define MK_MULTI 0
#endif
#ifndef MK_LAST_PHASE
#define MK_LAST_PHASE 12
#endif
constexpr int N_PHASES = MK_LAST_PHASE + 1;

template <class P> __device__ __forceinline__ P* uptr(P* p) { const unsigned long long v = (unsigned long long)p;
    const unsigned lo = __builtin_amdgcn_readfirstlane((unsigned)v), hi = __builtin_amdgcn_readfirstlane((unsigned)(v >> 32)); return (P*)(((unsigned long long)hi << 32) | lo); }
__global__ void __launch_bounds__(NTHR, 2) mk_fwd(const Args args) {
    extern __shared__ __attribute__((aligned(16))) unsigned char lds_raw[];
    Frame F;
    F.lds = (LAS unsigned char*)lds_raw;
    F.MISC = (volatile LAS unsigned*)(F.lds + MISC_OFF);
    F.tid = threadIdx.x; F.lane = F.tid & 63; F.wave = __builtin_amdgcn_readfirstlane(F.tid >> 6);
    F.G = gridDim.x; { const int bx = blockIdx.x; F.vcu = (F.G % 8 == 0) ? (bx % 8) * (F.G / 8) + bx / 8 : bx; }
    F.ws = uptr(args.ws); F.out = uptr(args.out);
    F.ctl = (gu32*)(F.ws + WS_CTL);
    for (int u = F.tid; u < (LDS_BYTES - MISC_OFF) / 4; u += NTHR) ((LAS unsigned*)(F.lds + MISC_OFF))[u] = 0u;
    __syncthreads();
    XcdBarrier bar; bar.bar = (unsigned*)(F.ctl + CW_BAR); bar.x = 0; bar.st = nullptr;
#if !MK_MULTI
    bar = xcd_barrier_post((unsigned*)(F.ctl + CW_BAR), F.MISC + 8);
#define GRID_BAR() xcd_barrier(bar)
#else
#define GRID_BAR() do { } while (0)
#endif
    const int lo = args.ph_lo, hi = args.ph_hi;
#ifndef MK_PHMASK
#define MK_PHMASK 0xFFFF
#endif
#define IN(k) (((MK_PHMASK >> (k)) & 1) && lo <= (k) && (k) < hi)
#define SEAM(k) do { if (IN(k) && IN((k) + 1)) GRID_BAR(); } while (0)
#ifndef MK_STAMP
#define MK_STAMP (-1)
#endif
#define STAMP_BEGIN(k) do { if ((k) == MK_STAMP && blockIdx.x == 0 && F.tid == 0) *(unsigned long long*)(ws + WS_STAMP) = __builtin_amdgcn_s_memrealtime(); } while (0)
#define STAMP_END(k) do { if ((k) == MK_STAMP && blockIdx.x == 0 && F.tid == 0) { const unsigned long long t1_ = __builtin_amdgcn_s_memrealtime(); *(float*)(ws + WS_STAMP + 8) = (float)(t1_ - *(unsigned long long*)(ws + WS_STAMP)) * 0.01f; } } while (0)
#ifndef MK_REPEAT
#define MK_REPEAT (-1)
#endif
#ifndef MK_REPN
#define MK_REPN 2
#endif
#define REP(k) _Pragma("unroll") for (int rep_ = 0; rep_ < ((k) == MK_REPEAT ? MK_REPN : 1); ++rep_)
    unsigned char* const ws = F.ws;

    STAMP_BEGIN(0);
    REP(0) if (IN(0)) { if (rep_) GRID_BAR(); p0_phase(F, args); } SEAM(0); STAMP_END(0);
    STAMP_BEGIN(1);
    REP(1) if (IN(1)) { if (rep_) GRID_BAR(); p1_phase(F, args); } SEAM(1); STAMP_END(1);
    STAMP_BEGIN(2);
    REP(2) if (IN(2)) { if (rep_) GRID_BAR();
        pg8::Gemm g{(const bf16_t*)(ws + WS_B), (const bf16_t*)(ws + WS_WIN), DM, DM, DM};
        pg8::DenseOrder S; S.init(T / 256, INCP / 256, F.G, (int)blockIdx.x);
        pg8::EpiStore E{(bf16_t*)(ws + WS_A), INCP, nullptr, 0.f, (float*)(ws + WS_RSTDQ), (float*)(ws + WS_RSTDKV), C_QA / 256, C_KVA / 256, C_KPE / 256};
        pg8::gemm_phase<pg8::EpiStore, pg8::DenseOrder>(F.lds, g, S, E);
    } SEAM(2); STAMP_END(2);
    STAMP_BEGIN(3);
    REP(3) if (IN(3)) { if (rep_) GRID_BAR(); p3_phase(F, args); } if (IN(3) && IN(5)) GRID_BAR(); STAMP_END(3);
    STAMP_BEGIN(5);
    REP(5) if (IN(5)) { if (rep_) GRID_BAR(); p5_phase(F, args); } SEAM(5); STAMP_END(5);
    STAMP_BEGIN(6);
    REP(6) if (IN(6)) { if (rep_) GRID_BAR(); p6_phase(F, args); } SEAM(6); STAMP_END(6);
    STAMP_BEGIN(7);
    REP(7) if (IN(7)) { if (rep_) GRID_BAR();
        pg8::Gemm g{(const bf16_t*)(ws + WS_E), (const bf16_t*)(ws + WS_WOUT), DM, DM, DM};
        pg8::DenseOrder S; S.init(T / 256, DM / 256, F.G, (int)blockIdx.x);
        pg8::EpiStore E{(bf16_t*)(ws + WS_F), DM, nullptr, 0.f, nullptr, nullptr, 0, 0, 0};
        pg8::gemm_phase<pg8::EpiStore, pg8::DenseOrder>(F.lds, g, S, E);
    } SEAM(7); STAMP_END(7);
#if MK_LAST_PHASE >= 8
    STAMP_BEGIN(8);
    REP(8) if (IN(8)) { if (rep_) GRID_BAR(); p8_phase(F, args); } if (IN(8) && IN(10)) GRID_BAR(); STAMP_END(8);
    STAMP_BEGIN(10);
    REP(10) if (IN(10)) { if (rep_) GRID_BAR();
        const LAS int* tab = moe_tables(F);
        pg8::Gemm g{(const bf16_t*)(ws + WS_B), (const bf16_t*)(ws + WS_D), DM, DM, DM};
        pg8::GroupedOrder S; S.init(4, F.G, F.vcu, tab, (const int*)(ws + WS_LIST));
        pg8::EpiSwiGLU E{(bf16_t*)(ws + WS_C), (unsigned*)(F.ctl + CW_RDY)};
        pg8::gemm_phase<pg8::EpiSwiGLU, pg8::GroupedOrder, true>(F.lds, g, S, E);
    }
    REP(11) if (IN(11)) { if (rep_) GRID_BAR();
        const LAS int* tab = moe_tables(F);
        pg8::Gemm g{(const bf16_t*)(ws + WS_C), (const bf16_t*)(ws + WS_E), DE, DE, DE};
        pg8::RedealOrder S; S.init(8, F.G, F.vcu, tab, 4, (unsigned*)(F.ctl + CW_RDY), 32u, (unsigned*)(F.ctl + CW_TMO));
        pg8::EpiStore E{(bf16_t*)(ws + WS_A), DM, nullptr, 0.f, nullptr, nullptr, 0, 0, 0};
        pg8::gemm_phase<pg8::EpiStore, pg8::RedealOrder>(F.lds, g, S, E);
    } SEAM(11); STAMP_END(11);
    REP(12) if (IN(12)) { if (rep_) GRID_BAR(); p12_phase(F, args); }
#endif
#undef IN
#undef SEAM
}

extern "C" void kernel_launch(void* const* d_in, const int* in_sizes, int n_in, void* d_out, int out_size, void* d_ws, size_t ws_size, hipStream_t stream) {
    static int grid = 0;
    if (grid == 0) {
        if (n_in != 25 || out_size != T * DM || ws_size < WS_END) { fprintf(stderr, "kernel_launch: bad shapes (n_in %d out %d ws %zu)\n", n_in, out_size, ws_size); grid = -1; return; }
        int dev = 0, cus = 0, per_cu = 0;
        if (hipGetDevice(&dev) != hipSuccess || hipDeviceGetAttribute(&cus, hipDeviceAttributeMultiprocessorCount, dev) != hipSuccess) { grid = -1; return; }
        if (hipFuncSetAttribute((const void*)mk_fwd, hipFuncAttributeMaxDynamicSharedMemorySize, LDS_BYTES) != hipSuccess) { fprintf(stderr, "kernel_launch: hipFuncSetAttribute failed\n"); grid = -1; return; }
        if (hipOccupancyMaxActiveBlocksPerMultiprocessor(&per_cu, (const void*)mk_fwd, NTHR, LDS_BYTES) != hipSuccess || per_cu < 1) { fprintf(stderr, "kernel_launch: occupancy query says %d\n", per_cu); }
        (void)hipGetLastError();
        grid = cus;
    }
    if (grid < 0) return;
    (void)hipMemsetAsync((char*)d_ws + WS_CTL, 0, CTL_ZERO_BYTES, stream);
    Args a{};
    for (int i = 0; i < 25; ++i) a.in[i] = (const float*)d_in[i];
    a.out = (float*)d_out; a.ws = (unsigned char*)d_ws;
#if MK_MULTI
    for (int p = 0; p < N_PHASES; ++p) { a.ph_lo = p; a.ph_hi = p + 1; hipLaunchKernelGGL(mk_fwd, dim3(grid), dim3(NTHR), LDS_BYTES, stream, a); }
#else
    a.ph_lo = 0; a.ph_hi = N_PHASES; hipLaunchKernelGGL(mk_fwd, dim3(grid), dim3(NTHR), LDS_BYTES, stream, a);
#endif
}
```

```cpp
#include <hip/hip_runtime.h>
#include <cstdio>
#include <cstdint>

#define GAS __attribute__((address_space(1)))
#define LAS __attribute__((address_space(3)))
typedef unsigned short bf16_t;
typedef short bf16x8 __attribute__((ext_vector_type(8)));
typedef short s16x4 __attribute__((ext_vector_type(4)));
typedef float f32x4 __attribute__((ext_vector_type(4)));
typedef float f32x2 __attribute__((ext_vector_type(2)));
typedef float f32x16 __attribute__((ext_vector_type(16)));
typedef unsigned u32x4 __attribute__((ext_vector_type(4)));
typedef unsigned u32x2 __attribute__((ext_vector_type(2)));
typedef GAS unsigned gu32;
#define RLX_AGENT __ATOMIC_RELAXED, __HIP_MEMORY_SCOPE_AGENT
#define LDS_WAIT() asm volatile("s_waitcnt lgkmcnt(0)" ::: "memory")
#define VM_WAIT() asm volatile("s_waitcnt vmcnt(0)" ::: "memory")

constexpr int DM = 2048, NB = 8, SEQ = 2048, T = NB * SEQ;
constexpr int HW = 1024, HH = 8, HDK = 128, HDV = 128;
constexpr int MH = 8, MNOPE = 128, MROPE = 64, MQK = 192, MV = 128, QLORA = 512, KVLORA = 256;
constexpr int INC = 4 * HW + QLORA + KVLORA + MROPE;
constexpr int INCP = 5120;
constexpr int C_QA = 4096, C_KVA = 4608, C_KPE = 4864;
constexpr int NG = 4, EPG = 8, NE = 32, DE = 512;
constexpr int RMAX = (T * 2 / 256 + NE) * 256;
constexpr float EPS = 1e-6f;
constexpr int NWAVES = 8, NTHR = 512;

typedef __bf16 bf16x2_t __attribute__((ext_vector_type(2)));
__device__ __forceinline__ unsigned cvt_pk_bf16(float lo, float hi) { const f32x2 v = {lo, hi}; return __builtin_bit_cast(unsigned, __builtin_convertvector(v, bf16x2_t)); }
__device__ __forceinline__ float bf_lo(unsigned w) { return __builtin_bit_cast(float, w << 16); }
__device__ __forceinline__ float bf_hi(unsigned w) { return __builtin_bit_cast(float, w & 0xffff0000u); }
__device__ __forceinline__ float bf2f(bf16_t h) { return __builtin_bit_cast(float, (unsigned)h << 16); }
__device__ __forceinline__ float wave_sum(float v) {
#pragma unroll
    for (int o = 1; o < 64; o <<= 1) v += __shfl_xor(v, o);
    return v;
}
__device__ __forceinline__ float siluf(float v) { return v / (1.f + __expf(-v)); }

#define XB_TMO      128
#define XB_XCNT(j)  (256  + 64 * (j))
#define XB_XSUB(j)  (1280 + 64 * (j))
#define XB_XGEN(j)  (2304 + 64 * (j))
#define XB_TOP      3328
#define XB_TOPGEN   3392
#define XCD_BAR_WORDS 3456
#define XB_SPIN_CAP (1u << 18)

__device__ __forceinline__ unsigned xb_ld(unsigned* p)              { return __hip_atomic_load(p, __ATOMIC_RELAXED, __HIP_MEMORY_SCOPE_AGENT); }
__device__ __forceinline__ unsigned xb_add(unsigned* p, unsigned v) { return __hip_atomic_fetch_add(p, v, __ATOMIC_RELAXED, __HIP_MEMORY_SCOPE_AGENT); }
__device__ __forceinline__ unsigned xb_xcc_id() { return (unsigned)__builtin_amdgcn_s_getreg((3 << 11) | 20) & 0xFu; }
#define XB_SPIN(cond, bar) do { unsigned _sp = 0; while (cond) { __builtin_amdgcn_s_sleep(1); \
    if ((++_sp & 255u) == 0u) { if (xb_ld(&(bar)[XB_TMO])) break; if (_sp > XB_SPIN_CAP) { atomicAdd(&(bar)[XB_TMO], 1u); break; } } } } while (0)

struct XcdBarrier {
    unsigned* bar; unsigned x;
    volatile LAS unsigned* st;
};
__device__ __forceinline__ XcdBarrier xcd_barrier_post(unsigned* bar, volatile LAS unsigned* st) {
    XcdBarrier b; b.bar = bar; b.x = xb_xcc_id(); b.st = st;
    if (threadIdx.x == 0) (void)xb_add(&bar[XB_XCNT(b.x)], 1u);
    return b;
}
__device__ __forceinline__ void xcd_barrier_complete(unsigned* bar, unsigned x, unsigned& nloc, unsigned& nx) {
    const unsigned G = gridDim.x * gridDim.y * gridDim.z;
    unsigned sum, cnt, mine, sp = 0u;
    for (;;) {
        sum = 0u; cnt = 0u; mine = 0u;
#pragma unroll
        for (unsigned j = 0; j < 16; ++j) { const unsigned c = xb_ld(&bar[XB_XCNT(j)]); sum += c; cnt += (c > 0u) ? 1u : 0u; mine = (j == x) ? c : mine; }
        if (sum == G) break;
        __builtin_amdgcn_s_sleep(1);
        if ((++sp & 255u) == 0u) { if (xb_ld(&bar[XB_TMO])) break; if (sp > XB_SPIN_CAP) { atomicAdd(&bar[XB_TMO], 1u); break; } }
    }
    nloc = mine > 0u ? mine : 1u; nx = cnt > 0u ? cnt : 1u;
}
__device__ __forceinline__ void xcd_barrier(const XcdBarrier& b) {
    asm volatile("s_waitcnt vmcnt(0)" ::: "memory");
    __syncthreads();
    if (threadIdx.x == 0) {
        unsigned* bar = b.bar;
        __builtin_amdgcn_s_waitcnt(0);
        unsigned nloc = b.st[0], nx = b.st[1];
        if (nloc == 0u) { xcd_barrier_complete(bar, b.x, nloc, nx); b.st[0] = nloc; b.st[1] = nx; }
        const unsigned old = xb_add(&bar[XB_XSUB(b.x)], 1u);
        const unsigned gen = old / nloc;
        if (old + 1u == (gen + 1u) * nloc) {
            __builtin_amdgcn_fence(__ATOMIC_RELEASE, "agent");
            asm volatile("s_waitcnt vmcnt(0)" ::: "memory");
            const unsigned og = xb_add(&bar[XB_TOP], 1u);
            const unsigned tg = og / nx;
            if (og + 1u == (tg + 1u) * nx) xb_add(&bar[XB_TOPGEN], 1u);
            else XB_SPIN(xb_ld(&bar[XB_TOPGEN]) == tg, bar);
            __builtin_amdgcn_fence(__ATOMIC_ACQUIRE, "agent");
            xb_add(&bar[XB_XGEN(b.x)], 1u);
            asm volatile("s_waitcnt vmcnt(0)" ::: "memory");
        } else {
            XB_SPIN(xb_ld(&bar[XB_XGEN(b.x)]) == gen, bar);
            __builtin_amdgcn_fence(__ATOMIC_ACQUIRE, "agent");
            asm volatile("s_waitcnt vmcnt(0)" ::: "memory");
        }
    }
    __syncthreads();
}

namespace pg8 {
constexpr int BM = 256, BK = 64, HALF = 128, HTB = HALF * BK * 2, STAGE_BYTES = 8 * HTB, NXCD = 8, WGM = 8;
__host__ __device__ __forceinline__ int lds_byte(int r, int c) { const int st = (r >> 4) * 2 + (c >> 5), rr = r & 15, cc = c & 31, ob = rr * 64 + cc * 2; return st * 1024 + (ob ^ (((ob >> 9) & 1) << 5)); }
__host__ __device__ __forceinline__ void stage_rc(int b, int& R, int& C) { const int st = b / 1024, sb = b % 1024, swz = sb ^ (((sb >> 9) & 1) << 5); R = (st >> 1) * 16 + swz / 64; C = (st & 1) * 32 + (swz % 64) / 2; }
__host__ __device__ __forceinline__ int perm32(int rho) { const int n = rho >> 4, i = rho & 15; return 8 * (i >> 2) + 4 * n + (i & 3); }

struct Unit { int pm, pn, pb; };
struct Gemm { const bf16_t* A; const bf16_t* Bt; int lda, ldb, K; };

struct DenseOrder {
    int nM, nN, nwg, G, c;
    __device__ void init(int nM_, int nN_, int G_, int c_) { nM = nM_; nN = nN_; nwg = nM * nN; G = G_; c = c_; }
    __device__ bool next(int i, Unit& u) const {
        const long L = (long)i * G + c; if (L >= nwg) return false;
        int wgid = (int)L; { const int q = nwg / NXCD, r = nwg % NXCD, xcd = wgid % NXCD, off = wgid / NXCD; wgid = (xcd < r ? xcd * (q + 1) : r * (q + 1) + (xcd - r) * q) + off; }
        const int nig = WGM * nN, gid = wgid / nig, fm = gid * WGM, gsz = (nM - fm) < WGM ? (nM - fm) : WGM;
        u.pm = fm + ((wgid % nig) % gsz); u.pn = (wgid % nig) / gsz; u.pb = u.pn; return true;
    }
    __device__ __forceinline__ void a_ready(const Unit&) const {}
};
struct GroupedOrder {
    int nM, nN, nwg, G, c; const LAS int* tile_e; const LAS int* pstart; const LAS int* cnt; const int* list;
    __device__ void init(int nN_, int G_, int c_, const LAS int* tab, const int* list_) { pstart = tab; cnt = tab + 64; tile_e = tab + 128; list = list_; nM = pstart[32] >> 8; nN = nN_; nwg = nM * nN; G = G_; c = c_; }
    __device__ bool next(int i, Unit& u) const {
        const long L = (long)i * G + c; if (L >= nwg) return false;
        const int w = (int)L; u.pn = w % nN; u.pm = w / nN; u.pb = tile_e[u.pm] * nN + u.pn; return true;
    }
    __device__ int arow(const Unit& u, int r) const { const int e = tile_e[u.pm], j = 256 * u.pm - pstart[e] + r; return j < cnt[e] ? list[e * T + j] : 0; }
    __device__ __forceinline__ void a_ready(const Unit&) const {}
};
struct RedealOrder {
    int nM, nN, nwg, G, c, r10, X, nlight, head; const LAS int* tile_e; unsigned* ready; unsigned need; unsigned* tmo;
    __device__ void init(int nN_, int G_, int c_, const LAS int* tab, int nN10, unsigned* ready_, unsigned need_, unsigned* tmo_) {
        tile_e = tab + 128; nM = tab[32] >> 8; nN = nN_; nwg = nM * nN; G = G_; c = c_; ready = ready_; need = need_; tmo = tmo_;
        r10 = (nM * nN10) % G; X = r10 ? 3 : 0; nlight = G - r10; head = X * nlight < nwg ? X * nlight : nwg; }
    __device__ bool next(int i, Unit& u) const {
        long id;
        if (c >= r10 && X) id = i < X ? (long)i * nlight + (c - r10) : (long)head + (long)(i - X) * G + c;
        else id = (long)head + (long)i * G + c;
        if ((i < X && c >= r10 && id >= head) || id >= nwg) return false;
        u.pm = (int)id / nN; u.pn = (int)id % nN; u.pb = tile_e[u.pm] * nN + u.pn; return true;
    }
    __device__ __forceinline__ void a_ready(const Unit& u) const {
        if (threadIdx.x < 64) {
            unsigned polls = 0;
            while ((unsigned)__builtin_amdgcn_readfirstlane(__hip_atomic_load(ready + 64 * u.pm, __ATOMIC_RELAXED, __HIP_MEMORY_SCOPE_AGENT)) < need) {
                if (++polls > (1u << 16)) { if (threadIdx.x == 0) __hip_atomic_store(tmo, 0xDEAD0000u | (unsigned)u.pm, __ATOMIC_RELAXED, __HIP_MEMORY_SCOPE_AGENT); break; }
                __builtin_amdgcn_s_sleep(2); }
            __builtin_amdgcn_fence(__ATOMIC_ACQUIRE, "agent");
            asm volatile("s_waitcnt vmcnt(0)" ::: "memory");
        }
        asm volatile("" ::: "memory"); __builtin_amdgcn_s_barrier(); asm volatile("" ::: "memory");
    }
};

template <class Epi, class Sched, bool GATHER = false>
__device__ __forceinline__ void gemm_phase(LAS unsigned char* lds, const Gemm g, const Sched& S, const Epi& E) {
    int tid = threadIdx.x; asm volatile("" : "+v"(tid));
    const int wid = __builtin_amdgcn_readfirstlane(tid >> 6), lane = tid & 63, wr = wid >> 2, wc = wid & 3, fr = lane & 15, fq = lane >> 4;
    const int K = g.K, nt = K / BK;
    unsigned voffA[2], voffB[2]; int gR[2], gC[2];
#pragma unroll
    for (int i = 0; i < 2; ++i) { int R, C; stage_rc(tid * 16 + i * 8192, R, C); const int Rb = (R & ~31) + perm32(R & 31); gR[i] = R; gC[i] = C;
        voffA[i] = (unsigned)(R * g.lda + C) * 2u; voffB[i] = (unsigned)(Rb * g.ldb + C) * 2u; }
    const size_t kstep = (size_t)(BK * 2);
    const size_t hsA = (size_t)HALF * g.lda * 2, hsB = (size_t)HALF * g.ldb * 2;
    const unsigned ldsw = (unsigned)wid * 1024u;
    const int aoff = lds_byte(wr * 64 + fr, fq * 8), boff = lds_byte(wc * 32 + fr, fq * 8);
#define PG8_SA(b, h) (((b) * 2 + (h)) * HTB)
#define PG8_SB(b, h) ((4 + (b) * 2 + (h)) * HTB)
#define PG8_STAGE(bufoff, gbase, voff) do { _Pragma("unroll") for (int _i = 0; _i < 2; ++_i) \
        __builtin_amdgcn_global_load_lds((const unsigned*)((const char*)(gbase) + (voff)[_i]), (LAS unsigned*)(lds + (bufoff) + ldsw + _i * 8192), 16, 0, 0); } while (0)
#define PG8_STAGE_A(bufoff, dense_ptr, kbytes, offs) do { if constexpr (GATHER) { PG8_STAGE(bufoff, (const char*)g.A + (kbytes), offs); } else { PG8_STAGE(bufoff, dense_ptr, voffA); } } while (0)
#define PG8_GOFF(u, o0, o1) do { _Pragma("unroll") for (int _i = 0; _i < 2; ++_i) { o0[_i] = (unsigned)(S.arow(u, gR[_i]) * g.lda + gC[_i]) * 2u; o1[_i] = (unsigned)(S.arow(u, gR[_i] + HALF) * g.lda + gC[_i]) * 2u; } } while (0)
#define PG8_LDA(dst, b, h) do { _Pragma("unroll") for (int m = 0; m < 4; ++m) _Pragma("unroll") for (int k = 0; k < 2; ++k) dst[m][k] = *(const LAS bf16x8*)(lds + PG8_SA(b, h) + aoff + m * 2048 + k * 1024); } while (0)
#define PG8_LDB(dst, b, h) do { _Pragma("unroll") for (int n = 0; n < 2; ++n) _Pragma("unroll") for (int k = 0; k < 2; ++k) dst[n][k] = *(const LAS bf16x8*)(lds + PG8_SB(b, h) + boff + n * 2048 + k * 1024); } while (0)
#define PG8_MMA(ai, bj, At, Bt) do { __builtin_amdgcn_s_setprio(1); _Pragma("unroll") for (int m = 0; m < 4; ++m) _Pragma("unroll") for (int n = 0; n < 2; ++n) _Pragma("unroll") for (int k = 0; k < 2; ++k) \
        acc[ai][bj][m][n] = __builtin_amdgcn_mfma_f32_16x16x32_bf16(Bt[n][k], At[m][k], acc[ai][bj][m][n], 0, 0, 0); __builtin_amdgcn_s_setprio(0); } while (0)
#define PG8_WAIT_V(n) asm volatile("s_waitcnt vmcnt(" #n ")" ::: "memory")
#define PG8_WAIT_L(n) asm volatile("s_waitcnt lgkmcnt(" #n ")" ::: "memory")
#define PG8_BAR __builtin_amdgcn_s_barrier()
#define PG8_SCHED __builtin_amdgcn_sched_barrier(0)
    Unit cur, nxt; int ui = 0;
    if (!S.next(0, cur)) return;
    unsigned cO0[2] = {0u, 0u}, cO1[2] = {0u, 0u}, nO0[2] = {0u, 0u}, nO1[2] = {0u, 0u};
    if constexpr (GATHER) { PG8_GOFF(cur, cO0, cO1); }
    S.a_ready(cur);
    f32x4 acc[2][2][4][2];
#pragma unroll
    for (int a = 0; a < 2; ++a)
#pragma unroll
        for (int b = 0; b < 2; ++b)
#pragma unroll
            for (int m = 0; m < 4; ++m)
#pragma unroll
                for (int n = 0; n < 2; ++n) acc[a][b][m][n] = (f32x4){0.f, 0.f, 0.f, 0.f};
    bf16x8 At[4][2], B0[2][2], B1[2][2];
    const char* cA = (const char*)g.A + (GATHER ? (size_t)0 : (size_t)cur.pm * 2 * hsA); const char* cB = (const char*)g.Bt + (size_t)cur.pb * 2 * hsB;
    PG8_STAGE(PG8_SB(0, 0), cB, voffB); PG8_STAGE(PG8_SB(0, 1), cB + hsB, voffB); PG8_STAGE_A(PG8_SA(0, 0), cA, 0, cO0); PG8_STAGE_A(PG8_SA(0, 1), cA + hsA, 0, cO1);
    if (wr == 1) PG8_BAR;
    PG8_WAIT_V(2); PG8_BAR;
    PG8_STAGE(PG8_SB(1, 0), cB + kstep, voffB); PG8_STAGE_A(PG8_SA(1, 0), cA + kstep, kstep, cO0); PG8_STAGE(PG8_SB(1, 1), cB + hsB + kstep, voffB);
    PG8_WAIT_V(6); PG8_BAR;
    for (;;) {
        const bool has_next = S.next(ui + 1, nxt);
        const char* nA = (has_next && !GATHER) ? (const char*)g.A + (size_t)nxt.pm * 2 * hsA : cA; const char* nB = has_next ? (const char*)g.Bt + (size_t)nxt.pb * 2 * hsB : cB;
        if constexpr (GATHER) { if (has_next) { PG8_GOFF(nxt, nO0, nO1); } else { nO0[0] = cO0[0]; nO0[1] = cO0[1]; nO1[0] = cO1[0]; nO1[1] = cO1[1]; } }
        for (int t = 0; t < nt; t += 2) {
            const bool last = (t == nt - 2);
            if (last && has_next) S.a_ready(nxt);
            const char* a1 = cA + (size_t)(t + 1) * kstep;
            const char* a2 = last ? nA : cA + (size_t)(t + 2) * kstep; const char* b2 = last ? nB : cB + (size_t)(t + 2) * kstep;
            const char* a3 = a2 + kstep; const char* b3 = b2 + kstep;
            const size_t k2 = last ? (size_t)0 : (size_t)(t + 2) * kstep;
            unsigned o0[2], o1[2]; o0[0] = last ? nO0[0] : cO0[0]; o0[1] = last ? nO0[1] : cO0[1]; o1[0] = last ? nO1[0] : cO1[0]; o1[1] = last ? nO1[1] : cO1[1];
            PG8_LDB(B0, 0, 0); PG8_LDB(B1, 0, 1); PG8_SCHED; PG8_LDA(At, 0, 0); PG8_STAGE_A(PG8_SA(1, 1), a1 + hsA, (size_t)(t + 1) * kstep, cO1);
            PG8_WAIT_V(8); PG8_WAIT_L(0); PG8_BAR; PG8_MMA(0, 0, At, B0); PG8_MMA(0, 1, At, B1); PG8_BAR; PG8_SCHED;
            PG8_LDA(At, 0, 1); PG8_STAGE(PG8_SB(0, 0), b2, voffB); PG8_STAGE(PG8_SB(0, 1), b2 + hsB, voffB); PG8_STAGE_A(PG8_SA(0, 0), a2, k2, o0);
            PG8_WAIT_V(8); PG8_WAIT_L(0); PG8_BAR; PG8_MMA(1, 0, At, B0); PG8_MMA(1, 1, At, B1); PG8_BAR; PG8_SCHED;
            PG8_LDB(B0, 1, 0); PG8_LDB(B1, 1, 1); PG8_SCHED; PG8_LDA(At, 1, 0); PG8_STAGE_A(PG8_SA(0, 1), a2 + hsA, k2, o1);
            PG8_WAIT_V(8); PG8_WAIT_L(0); PG8_BAR; PG8_MMA(0, 0, At, B0); PG8_MMA(0, 1, At, B1); PG8_BAR; PG8_SCHED;
            PG8_LDA(At, 1, 1); PG8_STAGE(PG8_SB(1, 0), b3, voffB); PG8_STAGE(PG8_SB(1, 1), b3 + hsB, voffB); PG8_STAGE_A(PG8_SA(1, 0), a3, k2 + kstep, o0);
            PG8_WAIT_V(8); PG8_WAIT_L(0); PG8_BAR; PG8_MMA(1, 0, At, B0); PG8_MMA(1, 1, At, B1); PG8_BAR; PG8_SCHED;
        }
        if (wr == 0) PG8_BAR;
        E(acc, cur, wr, wc, fr, fq);
        if (!has_next) break;
#pragma unroll
        for (int a = 0; a < 2; ++a)
#pragma unroll
            for (int b = 0; b < 2; ++b)
#pragma unroll
                for (int m = 0; m < 4; ++m)
#pragma unroll
                    for (int n = 0; n < 2; ++n) acc[a][b][m][n] = (f32x4){0.f, 0.f, 0.f, 0.f};
        cur = nxt; cA = nA; cB = nB; ++ui;
        if constexpr (GATHER) { cO0[0] = nO0[0]; cO0[1] = nO0[1]; cO1[0] = nO1[0]; cO1[1] = nO1[1]; }
        if (wr == 1) PG8_BAR;
    }
    PG8_WAIT_V(0);
    PG8_BAR;
#undef PG8_SA
#undef PG8_SB
#undef PG8_STAGE
#undef PG8_STAGE_A
#undef PG8_GOFF
#undef PG8_LDA
#undef PG8_LDB
#undef PG8_MMA
#undef PG8_WAIT_V
#undef PG8_WAIT_L
#undef PG8_BAR
#undef PG8_SCHED
}

struct EpiStore {
    bf16_t* O; int ldc; const float* ssq; float inv; float* ssq_out0; float* ssq_out1; int pn0, pn1, pn2;
    __device__ __forceinline__ void operator()(const f32x4 (&acc)[2][2][4][2], const Unit& u, int wr, int wc, int fr, int fq) const {
        const int row0 = u.pm * BM + wr * 64 + fr, col0 = u.pn * BM + wc * 32 + 8 * fq;
        float* so = (ssq_out0 && u.pn >= pn0 && u.pn < pn2) ? (u.pn < pn1 ? ssq_out0 : ssq_out1) : nullptr;
#pragma unroll
        for (int ai = 0; ai < 2; ++ai)
#pragma unroll
            for (int m = 0; m < 4; ++m) { const int row = row0 + ai * HALF + m * 16; const float rs = ssq ? rsqrtf(ssq[row] * inv + EPS) : 1.f;
                bf16_t* rowp = O + (size_t)row * ldc + col0; float ss = 0.f;
#pragma unroll
                for (int bj = 0; bj < 2; ++bj) { const f32x4 v0 = acc[ai][bj][m][0] * rs, v1 = acc[ai][bj][m][1] * rs;
                    ss += (v0[0] * v0[0] + v0[1] * v0[1]) + (v0[2] * v0[2] + v0[3] * v0[3]) + (v1[0] * v1[0] + v1[1] * v1[1]) + (v1[2] * v1[2] + v1[3] * v1[3]);
                    u32x4 w; w.x = cvt_pk_bf16(v0[0], v0[1]); w.y = cvt_pk_bf16(v0[2], v0[3]); w.z = cvt_pk_bf16(v1[0], v1[1]); w.w = cvt_pk_bf16(v1[2], v1[3]);
                    *(u32x4*)(rowp + bj * HALF) = w; }
                if (so) { ss += __shfl_xor(ss, 16); ss += __shfl_xor(ss, 32); if (fq == 0) atomicAdd(so + row, ss); } }
    }
};
struct EpiResid {
    const float* X; float* O; const float* gate; int gpitch;
    __device__ __forceinline__ void operator()(const f32x4 (&acc)[2][2][4][2], const Unit& u, int wr, int wc, int fr, int fq) const {
        const int row0 = u.pm * BM + wr * 64 + fr, col0 = u.pn * BM + wc * 32 + 8 * fq;
        const float* gp = gate + (size_t)((u.pm * BM) / SEQ) * gpitch + col0;
        f32x4 gv[2][2];
#pragma unroll
        for (int bj = 0; bj < 2; ++bj)
#pragma unroll
            for (int n = 0; n < 2; ++n) gv[bj][n] = *(const f32x4*)(gp + bj * HALF + 4 * n);
#pragma unroll
        for (int ai = 0; ai < 2; ++ai)
#pragma unroll
            for (int m = 0; m < 4; ++m) { const size_t off = (size_t)(row0 + ai * HALF + m * 16) * DM + col0;
#pragma unroll
                for (int bj = 0; bj < 2; ++bj)
#pragma unroll
                    for (int n = 0; n < 2; ++n) { const f32x4 xv = *(const f32x4*)(X + off + bj * HALF + 4 * n);
                        *(f32x4*)(O + off + bj * HALF + 4 * n) = xv + gv[bj][n] * acc[ai][bj][m][n]; } }
    }
};
struct EpiSwiGLU {
    bf16_t* O; unsigned* ready;
    __device__ __forceinline__ void operator()(const f32x4 (&acc)[2][2][4][2], const Unit& u, int wr, int wc, int fr, int fq) const {
        const int row0 = u.pm * BM + wr * 64 + fr, col0 = u.pn * HALF + wc * 32 + 8 * fq;
        const __amdgpu_buffer_rsrc_t rs = __builtin_amdgcn_make_buffer_rsrc((void*)O, (short)0, RMAX * DE * 2, 0x00020000);
#pragma unroll
        for (int ai = 0; ai < 2; ++ai)
#pragma unroll
            for (int m = 0; m < 4; ++m) { const int row = row0 + ai * HALF + m * 16;
                float h[8];
#pragma unroll
                for (int n = 0; n < 2; ++n)
#pragma unroll
                    for (int j = 0; j < 4; ++j) { const float gt = acc[ai][0][m][n][j], up = acc[ai][1][m][n][j]; h[4 * n + j] = gt / (1.f + __expf(-gt)) * up; }
                u32x4 w; w.x = cvt_pk_bf16(h[0], h[1]); w.y = cvt_pk_bf16(h[2], h[3]); w.z = cvt_pk_bf16(h[4], h[5]); w.w = cvt_pk_bf16(h[6], h[7]);
                __builtin_amdgcn_raw_buffer_store_b128(w, rs, (unsigned)(row * DE + col0) * 2u, 0, 16); }
        asm volatile("s_waitcnt vmcnt(0)" ::: "memory");
        if ((threadIdx.x & 63) == 0) __hip_atomic_fetch_add(ready + 64 * u.pm, 1u, __ATOMIC_RELAXED, __HIP_MEMORY_SCOPE_AGENT);
    }
};
}
constexpr size_t MiB = 1u << 20;
constexpr size_t WS_CTL = 0, CTL_ZERO_BYTES = 1 * MiB;
constexpr size_t WS_MOD = 1 * MiB;
constexpr size_t WS_ROPEC = 1 * MiB + 512 * 1024;
constexpr size_t WS_ROPES = WS_ROPEC + 2 * MiB;
constexpr size_t WS_WCT = WS_ROPES + 2 * MiB;
constexpr size_t WS_RSTDQ = 6 * MiB;
constexpr size_t WS_RSTDKV = WS_RSTDQ + 64 * 1024;
constexpr size_t WS_TOKE = WS_RSTDKV + 64 * 1024;
constexpr size_t WS_TOKW = WS_TOKE + 128 * 1024;
constexpr size_t WS_TOKS = WS_TOKW + 128 * 1024;
constexpr size_t WS_BLKE = WS_TOKS + 128 * 1024;
constexpr size_t WS_STAMP = WS_BLKE + 4096;
constexpr size_t WS_WIN = 8 * MiB;
constexpr size_t WS_WQUP = 28 * MiB;
constexpr size_t WS_WKVUP = WS_WQUP + 1536 * 1024;
constexpr size_t WS_WOUT = 31 * MiB;
constexpr size_t WS_A = 40 * MiB;
constexpr size_t WS_B = 200 * MiB;
constexpr size_t WS_C = 264 * MiB;
constexpr size_t WS_D = 328 * MiB;
constexpr size_t WS_E = 456 * MiB;
constexpr size_t WS_LIST = 520 * MiB;
constexpr size_t WS_F = 522 * MiB;
constexpr size_t WS_END = 586 * MiB;
constexpr size_t QN_BYTES = (size_t)T * MH * MQK * 2;

constexpr int CW_BAR = 4096;
constexpr int CW_CNT = 8192;
constexpr int CW_RDY = 10240;
constexpr int CW_TMO = 1;

constexpr int RING_BYTES = 131072, LDS_BYTES = 147456, LDS_USER = 143360, MISC_OFF = LDS_BYTES - 512;

struct Args { const float* in[25]; float* out; unsigned char* ws; int ph_lo, ph_hi, pad0, pad1; };

struct Frame {
    LAS unsigned char* lds;
    volatile LAS unsigned* MISC;
    gu32* ctl;
    int tid, lane, wave, vcu, G;
    unsigned char* ws; float* out;
};

#define OPAQUE_FRAME(F) do { F.tid = threadIdx.x; asm volatile("" : "+v"(F.tid)); F.lane = F.tid & 63; } while (0)

__device__ __forceinline__ void unpack8(const u32x4 w, float* f) { f[0] = bf_lo(w.x); f[1] = bf_hi(w.x); f[2] = bf_lo(w.y); f[3] = bf_hi(w.y); f[4] = bf_lo(w.z); f[5] = bf_hi(w.z); f[6] = bf_lo(w.w); f[7] = bf_hi(w.w); }
__device__ __forceinline__ u32x4 pack8f(const float* f) { u32x4 w; w.x = cvt_pk_bf16(f[0], f[1]); w.y = cvt_pk_bf16(f[2], f[3]); w.z = cvt_pk_bf16(f[4], f[5]); w.w = cvt_pk_bf16(f[6], f[7]); return w; }

struct TrItem { const float* src; bf16_t* dst; bf16_t* dst2; const float* gk; int N, ldt; };
__device__ __forceinline__ void tr_load(const TrItem& it, f32x4 (&r)[16], int lane) {
    const float* p = it.src + (size_t)(lane >> 4) * it.N + 4 * (lane & 15);
#pragma unroll
    for (int i = 0; i < 16; ++i) r[i] = __builtin_nontemporal_load((const f32x4*)(p + (size_t)(4 * i) * it.N));
}
__device__ __forceinline__ void tr_store(const TrItem& it, const f32x4 (&r)[16], LAS unsigned char* Tl, int lane) {
    const int row = lane >> 4, c4 = lane & 15;
#pragma unroll
    for (int i = 0; i < 16; ++i) { f32x4 v = r[i]; if (it.gk) v = v * it.gk[4 * i + row];
        u32x2 w; w.x = cvt_pk_bf16(v.x, v.y); w.y = cvt_pk_bf16(v.z, v.w);
        *(LAS u32x2*)(Tl + ((4 * i + row) * 64 + 4 * c4) * 2) = w; }
    LDS_WAIT(); asm volatile("" ::: "memory");
    const int g = lane >> 4, i16 = lane & 15, q = i16 >> 2, pp = lane & 3;
    typedef short v4i16_t __attribute__((ext_vector_type(4)));
#pragma unroll
    for (int hh = 0; hh < 2; ++hh) { bf16_t* drow = (hh ? it.dst2 : it.dst) + (size_t)(16 * (g & 1) + i16) * it.ldt;
#pragma unroll
        for (int j = 0; j < 4; ++j) { const int kc = 4 * (g >> 1) + j;
            const v4i16_t lo = __builtin_amdgcn_ds_read_tr16_b64_v4i16((LAS v4i16_t*)(Tl + ((8 * kc + q) * 64 + 32 * hh + 16 * (g & 1) + 4 * pp) * 2));
            const v4i16_t hi = __builtin_amdgcn_ds_read_tr16_b64_v4i16((LAS v4i16_t*)(Tl + ((8 * kc + 4 + q) * 64 + 32 * hh + 16 * (g & 1) + 4 * pp) * 2));
            const bf16x8 o = {lo[0], lo[1], lo[2], lo[3], hi[0], hi[1], hi[2], hi[3]};
            *(bf16x8*)(drow + 8 * kc) = o; } }
    LDS_WAIT(); asm volatile("" ::: "memory");
}
template <class MK> __device__ __forceinline__ void tr_run(int first, int step, int n, const MK& mk, LAS unsigned char* Tl, int lane) {
    if (first >= n) return;
    f32x4 ra[16], rb[16];
    TrItem ia = mk(first), ib = ia;
    tr_load(ia, ra, lane);
    for (int idx = first; idx < n; idx += 2 * step) {
        if (idx + step < n) { ib = mk(idx + step); tr_load(ib, rb, lane); }
        tr_store(ia, ra, Tl, lane);
        if (idx + step >= n) break;
        if (idx + 2 * step < n) { ia = mk(idx + 2 * step); tr_load(ia, ra, lane); }
        tr_store(ib, rb, Tl, lane);
    }
}

__device__ __forceinline__ void adaln_phase(Frame& F, const float* c, const float* w_ada, const float* b_ada, float* mod) {
    LAS float* cact = (LAS float*)F.lds;
    LAS float* part = (LAS float*)(F.lds + 65536);
    for (int i = F.tid; i < NB * DM; i += NTHR) cact[i] = siluf(c[i]);
    __syncthreads();
    const int cg = F.tid & 7, rs = F.tid >> 3;
    for (int it = blockIdx.x; it < 6 * DM / 32; it += F.G) {
        const int n0 = it * 32 + cg * 4;
        f32x4 acc[8];
#pragma unroll
        for (int b = 0; b < 8; ++b) acc[b] = (f32x4){0.f, 0.f, 0.f, 0.f};
#pragma unroll 1
        for (int i0 = 0; i0 < 32; i0 += 16) { f32x4 w[16];
#pragma unroll
            for (int u = 0; u < 16; ++u) w[u] = __builtin_nontemporal_load((const f32x4*)(w_ada + (size_t)(rs + 64 * (i0 + u)) * (6 * DM) + n0));
#pragma unroll
            for (int u = 0; u < 16; ++u) { const int k = rs + 64 * (i0 + u);
#pragma unroll
                for (int b = 0; b < 8; ++b) acc[b] += w[u] * cact[b * DM + k]; } }
#pragma unroll
        for (int b = 0; b < 8; ++b) *(LAS f32x4*)(part + (rs * 8 + b) * 32 + cg * 4) = acc[b];
        __syncthreads();
        if (F.tid < 256) { const int b = F.tid >> 5, n = F.tid & 31; float s = 0.f;
#pragma unroll 8
            for (int r = 0; r < 64; ++r) s += part[(r * 8 + b) * 32 + n];
            mod[b * (6 * DM) + it * 32 + n] = s + b_ada[it * 32 + n]; }
        __syncthreads();
    }
}

__device__ __forceinline__ void p0_phase(Frame& F, const Args& a) {
    OPAQUE_FRAME(F);
    unsigned char* ws = F.ws;
    adaln_phase(F, a.in[1], a.in[3], a.in[4], (float*)(ws + WS_MOD));
    __syncthreads();
    LAS unsigned char* Tl = F.lds + F.wave * 8192;
    const int gw = F.vcu * NWAVES + F.wave, NGW = F.G * NWAVES;
    constexpr int I_IN = (DM / 64) * (INC / 64), I_QUP = (QLORA / 64) * (MH * MQK / 64), I_KVUP = (KVLORA / 64) * (MH * 256 / 64), I_OUT = (DM / 64) * (DM / 64);
    constexpr int NITEMS = I_IN + I_QUP + I_KVUP + I_OUT;
    static_assert(INC % 64 == 0, "64-column transpose items");
    { const float* w_in = a.in[6]; const float* w_qup = a.in[10]; const float* w_kvup = a.in[12]; const float* w_out = a.in[16]; const float* gq = a.in[9]; const float* gkv = a.in[11];
      auto mk = [=](int r) -> TrItem { TrItem t;
          if (r < I_IN) { const int nblk = INC / 64, kb = r / nblk, nb = r % nblk; t.src = w_in + (size_t)(64 * kb) * INC + 64 * nb; t.dst = (bf16_t*)(ws + WS_WIN) + (size_t)(64 * nb) * DM + 64 * kb; t.dst2 = t.dst + (size_t)32 * DM; t.gk = nullptr; t.N = INC; t.ldt = DM; return t; } r -= I_IN;
          if (r < I_QUP) { const int nblk = MH * MQK / 64, kb = r / nblk, nb = r % nblk; t.src = w_qup + (size_t)(64 * kb) * (MH * MQK) + 64 * nb; t.dst = (bf16_t*)(ws + WS_WQUP) + (size_t)(64 * nb) * QLORA + 64 * kb; t.dst2 = t.dst + (size_t)32 * QLORA; t.gk = gq + 64 * kb; t.N = MH * MQK; t.ldt = QLORA; return t; } r -= I_QUP;
          if (r < I_KVUP) { const int nblk = MH * 256 / 64, kb = r / nblk, nb = r % nblk; t.src = w_kvup + (size_t)(64 * kb) * (MH * 256) + 64 * nb; t.dst = (bf16_t*)(ws + WS_WKVUP) + (size_t)(64 * nb) * KVLORA + 64 * kb; t.dst2 = t.dst + (size_t)32 * KVLORA; t.gk = gkv + 64 * kb; t.N = MH * 256; t.ldt = KVLORA; return t; } r -= I_KVUP;
          { const int nblk = DM / 64, kb = r / nblk, nb = r % nblk; t.src = w_out + (size_t)(64 * kb) * DM + 64 * nb; t.dst = (bf16_t*)(ws + WS_WOUT) + (size_t)(64 * nb) * DM + 64 * kb; t.dst2 = t.dst + (size_t)32 * DM; t.gk = nullptr; t.N = DM; t.ldt = DM; return t; } };
      const int nheavy = (6 * DM / 32) - F.G, nlw = (F.G - nheavy) * NWAVES;
      int pre = 0;
      if (nheavy > 0 && nheavy < F.G) { pre = 2 * nlw < NITEMS ? 2 * nlw : NITEMS;
          if ((int)blockIdx.x >= nheavy) tr_run(((int)blockIdx.x - nheavy) * NWAVES + F.wave, nlw, pre, mk, Tl, F.lane); }
      tr_run(pre + gw, NGW, NITEMS, mk, Tl, F.lane); }
    { const int* pos = (const int*)a.in[2]; float* rc = (float*)(ws + WS_ROPEC); float* rsn = (float*)(ws + WS_ROPES);
      const int gt = F.vcu * NTHR + F.tid, NGT = F.G * NTHR;
      const float invf = (float)exp2(-(double)(gt & 31) * (13.287712379549449 / 32.0));
      for (int e = gt; e < T * 32; e += NGT) { const int tk = e >> 5;
          const float ang = (float)pos[tk] * invf; float sv, cv; sincosf(ang, &sv, &cv);
          rc[e] = cv; rsn[e] = sv; }
      { float* ssq = (float*)(ws + WS_RSTDQ); for (int e = gt; e < 2 * T; e += NGT) ssq[e] = 0.f; }
      float* wct = (float*)(ws + WS_WCT);
      for (int e = gt; e < 48 * DM; e += NGT) { const int n = e / DM, k = e % DM;
          wct[e] = n < 4 ? a.in[18][k * NG + n] : (n < 36 ? a.in[20][k * NE + (n - 4)] : 0.f); } }
}

__device__ __forceinline__ void modnorm_row(const float* xrow, const float* g, const float* shift, const float* scale, bf16_t* orow, int lane) {
    const f32x4* xr = (const f32x4*)xrow + lane;
    f32x4 v[8]; float s = 0.f;
#pragma unroll
    for (int j = 0; j < 8; ++j) { v[j] = __builtin_nontemporal_load(xr + 64 * j); s += (v[j].x * v[j].x + v[j].y * v[j].y) + (v[j].z * v[j].z + v[j].w * v[j].w); }
    const float rstd = rsqrtf(wave_sum(s) * (1.f / DM) + EPS);
    u32x2* o8 = (u32x2*)orow + lane;
#pragma unroll
    for (int j = 0; j < 8; ++j) { const f32x4 gg = ((const f32x4*)g)[64 * j + lane], sh = ((const f32x4*)shift)[64 * j + lane], sc = ((const f32x4*)scale)[64 * j + lane];
        const f32x4 h = v[j] * rstd * gg * (sc + 1.f) + sh;
        u32x2 w; w.x = cvt_pk_bf16(h.x, h.y); w.y = cvt_pk_bf16(h.z, h.w); o8[64 * j] = w; }
}
__device__ __forceinline__ void p1_phase(Frame& F, const Args& a) {
    OPAQUE_FRAME(F);
    const int gw = F.vcu * NWAVES + F.wave, NGW = F.G * NWAVES;
    const float* mod = (const float*)(F.ws + WS_MOD);
    bf16_t* H = (bf16_t*)(F.ws + WS_B);
    for (int m = gw; m < T; m += NGW) { const int b = m / SEQ;
        modnorm_row(a.in[0] + (size_t)m * DM, a.in[5], mod + b * (6 * DM), mod + b * (6 * DM) + DM, H + (size_t)m * DM, F.lane); }
}

template <int CTRL> __device__ __forceinline__ float dppf(float x) { return __builtin_bit_cast(float, __builtin_amdgcn_update_dpp(0, __builtin_bit_cast(int, x), CTRL, 0xF, 0xF, true)); }

namespace hg {
constexpr int OFF_F = 0, OFF_SEG = 32768, OFF_QIN = 34816, RP = 272, OFF_KIN = OFF_QIN + 64 * RP, OFF_QB = OFF_KIN + 64 * RP, OFF_KLT = OFF_QB + 64 * RP, SP = 144,
              OFF_VT = OFF_KLT + 128 * SP  , OFF_DEC = OFF_VT + 128 * SP  , HG_LDS = OFF_DEC + 3584;
static_assert(HG_LDS <= LDS_USER, "hgrn lds");
__device__ __forceinline__ int ppos(int s) { return (s & ~15) | ((s & 4) << 1) | ((s & 8) >> 1) | (s & 3); }
}
__device__ __forceinline__ void hgrn_chunked(Frame& F, const Args& a, int item) {
    using namespace hg;
    const bf16_t* PROJ = (const bf16_t*)(F.ws + WS_A);
    bf16_t* MIX = (bf16_t*)F.out;
    const float* lbl = a.in[7];
    LAS unsigned char* L = F.lds;
    LAS float* Fs = (LAS float*)(L + OFF_F); LAS float* SEGs = (LAS float*)(L + OFF_SEG); LAS float* DEC = (LAS float*)(L + OFF_DEC); LAS float* POST = DEC + 384;
    const int g = F.tid & 15, t0 = F.tid >> 4;
    const int sk = F.tid & 127, sseg = F.tid >> 7;
    const int r32 = F.lane & 31, hi = F.lane >> 5;
    const int tb = F.wave >> 2, dvb = F.wave & 3;
    {
        const int h = item & 7, b = item >> 3;
        float lb[8];
#pragma unroll
        for (int j = 0; j < 8; ++j) { const int k = h * 128 + g * 8 + j; lb[j] = 1.f / (1.f + __expf(lbl[HW + k] - lbl[k])); }
        const bf16_t* base = PROJ + (size_t)(b * SEQ) * INCP + h * 128;
        f32x16 S[4] = {};
        u32x4 gq[2], gf[2], gv[2];
#define HG_LOADF(c) do { _Pragma("unroll") for (int i = 0; i < 2; ++i) gf[i] = *(const u32x4*)(base + (size_t)((c) * 64 + t0 + 32 * i) * INCP + g * 8 + HW); } while (0)
#define HG_LOADQ(c) do { _Pragma("unroll") for (int i = 0; i < 2; ++i) { gq[i] = *(const u32x4*)(base + (size_t)((c) * 64 + t0 + 32 * i) * INCP + g * 8); \
            gv[i] = *(const u32x4*)(base + (size_t)((c) * 64 + t0 + 32 * i) * INCP + 2 * HW + g * 8); } } while (0)
        HG_LOADF(0); HG_LOADQ(0);
        for (int c = 0; c < SEQ / 64; ++c) {
            float fv[2][8];
#pragma unroll
            for (int i = 0; i < 2; ++i) { float fl[8]; unpack8(gf[i], fl);
#pragma unroll
                for (int j = 0; j < 8; ++j) { const float sg = __builtin_amdgcn_rcpf(1.f + __builtin_amdgcn_exp2f(-1.4426950408889634f * fl[j])); fv[i][j] = lb[j] + (1.f - lb[j]) * sg; }
                LAS float* fp = Fs + (t0 + 32 * i) * 128 + g * 8;
                *(LAS f32x4*)fp = (f32x4){fv[i][0], fv[i][1], fv[i][2], fv[i][3]}; *(LAS f32x4*)(fp + 4) = (f32x4){fv[i][4], fv[i][5], fv[i][6], fv[i][7]}; }
            if (c + 1 < SEQ / 64) HG_LOADF(c + 1);
            __syncthreads();
            float klp[16];
            { float fr[16];
#pragma unroll
              for (int i = 0; i < 16; ++i) fr[i] = Fs[(16 * sseg + i) * 128 + sk];
              float p = 1.f;
#pragma unroll
              for (int i = 0; i < 16; ++i) { p *= fr[i]; Fs[(16 * sseg + i) * 128 + sk] = p; }
              SEGs[sseg * 128 + sk] = p;
              float q = 1.f;
#pragma unroll
              for (int i = 15; i >= 0; --i) { klp[i] = (1.f - fr[i]) * q; q *= fr[i]; } }
            __syncthreads();
            if (F.tid < 128) { const float s0 = SEGs[F.tid], s1 = SEGs[128 + F.tid], s2 = SEGs[256 + F.tid], s3 = SEGs[384 + F.tid];
                const float pm = s0 * s1;
                SEGs[F.tid] = 1.f; SEGs[128 + F.tid] = s0; SEGs[256 + F.tid] = pm; SEGs[384 + F.tid] = pm * s2;
                POST[F.tid] = s1 * s2 * s3; POST[128 + F.tid] = s2 * s3; POST[256 + F.tid] = s3; POST[384 + F.tid] = 1.f;
                DEC[F.tid] = pm * s2 * s3; DEC[128 + F.tid] = pm; DEC[256 + F.tid] = __builtin_amdgcn_rcpf(pm); }
            __syncthreads();
            { { const float po = POST[sseg * 128 + sk];
                float o16[16];
#pragma unroll
                for (int p = 0; p < 16; ++p) o16[p] = klp[8 * ((p >> 2) & 1) + 4 * (p >> 3) + (p & 3)] * po;
                *(LAS u32x4*)(L + OFF_KLT + sk * SP + sseg * 32) = pack8f(o16); *(LAS u32x4*)(L + OFF_KLT + sk * SP + sseg * 32 + 16) = pack8f(o16 + 8); }
#pragma unroll
              for (int i = 0; i < 2; ++i) { const int t = t0 + 32 * i;
                  float qin[8], kin[8], qb[8], qv[8];
                  unpack8(gq[i], qv);
                  const LAS float* fp = Fs + t * 128 + g * 8; const LAS float* pp = SEGs + (t >> 4) * 128 + g * 8;
                  const f32x4 pa = *(const LAS f32x4*)fp, pb = *(const LAS f32x4*)(fp + 4), ea = *(const LAS f32x4*)pp, eb = *(const LAS f32x4*)(pp + 4);
                  const f32x4 ma = *(const LAS f32x4*)(DEC + 128 + g * 8), mb = *(const LAS f32x4*)(DEC + 128 + g * 8 + 4), ra = *(const LAS f32x4*)(DEC + 256 + g * 8), rb = *(const LAS f32x4*)(DEC + 256 + g * 8 + 4);
#pragma unroll
                  for (int j = 0; j < 8; ++j) { const float P = (j < 4 ? pa[j] * ea[j] : pb[j - 4] * eb[j - 4]), pm = j < 4 ? ma[j] : mb[j - 4], rpm = j < 4 ? ra[j] : rb[j - 4];
                      const float r = __builtin_amdgcn_rcpf(P), kk = 1.f - fv[i][j], qs = qv[j] * 0.08838834764831845f;
                      qb[j] = qs * P; qin[j] = qb[j] * rpm; kin[j] = kk * pm * r; }
                  *(LAS u32x4*)(L + OFF_QIN + t * RP + g * 16) = pack8f(qin);
                  *(LAS u32x4*)(L + OFF_KIN + t * RP + g * 16) = pack8f(kin);
                  { const u32x4 w = pack8f(qb);
                    *(LAS u32x2*)(L + OFF_QB + t * RP + ((g >> 1) * 16 + (g & 1) * 4) * 2) = (u32x2){w.x, w.y};
                    *(LAS u32x2*)(L + OFF_QB + t * RP + ((g >> 1) * 16 + 8 + (g & 1) * 4) * 2) = (u32x2){w.z, w.w}; }
                  { float v[8]; unpack8(gv[i], v); const int ps = ppos(t);
#pragma unroll
                    for (int j = 0; j < 8; ++j) *(LAS bf16_t*)(L + OFF_VT + (g * 8 + j) * SP + ps * 2) = (bf16_t)(__builtin_bit_cast(unsigned, v[j]) >> 16); } } }
            if (c + 1 < SEQ / 64) HG_LOADQ(c + 1);
            __syncthreads();
            { f32x16 o = {};
                for (int sb = 0; sb <= tb; ++sb) { f32x16 X = {};
#pragma unroll
                    for (int ks = 0; ks < 8; ++ks) { const bf16x8 af = *(const LAS bf16x8*)(L + OFF_KIN + (32 * sb + r32) * RP + (16 * ks + 8 * hi) * 2);
                        const bf16x8 bfr = *(const LAS bf16x8*)(L + OFF_QIN + (32 * tb + r32) * RP + (16 * ks + 8 * hi) * 2);
                        X = __builtin_amdgcn_mfma_f32_32x32x16_bf16(af, bfr, X, 0, 0, 0); }
                    if (sb == tb) {
#pragma unroll
                        for (int r = 0; r < 16; ++r) { const int srow = (r & 3) + 8 * (r >> 2) + 4 * hi; if (srow > r32) X[r] = 0.f; } }
#pragma unroll
                    for (int s2 = 0; s2 < 2; ++s2) { u32x4 w; w.x = cvt_pk_bf16(X[8 * s2], X[8 * s2 + 1]); w.y = cvt_pk_bf16(X[8 * s2 + 2], X[8 * s2 + 3]); w.z = cvt_pk_bf16(X[8 * s2 + 4], X[8 * s2 + 5]); w.w = cvt_pk_bf16(X[8 * s2 + 6], X[8 * s2 + 7]);
                        const bf16x8 vf = *(const LAS bf16x8*)(L + OFF_VT + (32 * dvb + r32) * SP + (32 * sb + 16 * s2 + 8 * hi) * 2);
                        o = __builtin_amdgcn_mfma_f32_32x32x16_bf16(__builtin_bit_cast(bf16x8, w), vf, o, 0, 0, 0); } }
#pragma unroll
                for (int kb = 0; kb < 4; ++kb)
#pragma unroll
                    for (int s2 = 0; s2 < 2; ++s2) { u32x4 w; w.x = cvt_pk_bf16(S[kb][8 * s2], S[kb][8 * s2 + 1]); w.y = cvt_pk_bf16(S[kb][8 * s2 + 2], S[kb][8 * s2 + 3]); w.z = cvt_pk_bf16(S[kb][8 * s2 + 4], S[kb][8 * s2 + 5]); w.w = cvt_pk_bf16(S[kb][8 * s2 + 6], S[kb][8 * s2 + 7]);
                        const bf16x8 qf = *(const LAS bf16x8*)(L + OFF_QB + (32 * tb + r32) * RP + (32 * kb + 16 * s2 + 8 * hi) * 2);
                        o = __builtin_amdgcn_mfma_f32_32x32x16_bf16(qf, __builtin_bit_cast(bf16x8, w), o, 0, 0, 0); }
                bf16_t* orow = MIX + (size_t)(b * SEQ + c * 64 + 32 * tb) * DM + h * 128 + dvb * 32 + r32;
#pragma unroll
                for (int r = 0; r < 16; ++r) { const float v = o[r]; const float vn = __shfl_xor(v, 1);
                    if ((r32 & 1) == 0) *(unsigned*)(orow + (size_t)((r & 3) + 8 * (r >> 2) + 4 * hi) * DM) = cvt_pk_bf16(v, vn); }
#pragma unroll
                for (int kb = 0; kb < 4; ++kb) {
#pragma unroll
                    for (int rq = 0; rq < 4; ++rq) { const f32x4 dc = *(const LAS f32x4*)(DEC + 32 * kb + 8 * rq + 4 * hi);
#pragma unroll
                        for (int rr = 0; rr < 4; ++rr) S[kb][4 * rq + rr] *= dc[rr]; }
#pragma unroll
                    for (int ss = 0; ss < 4; ++ss) { const bf16x8 kf = *(const LAS bf16x8*)(L + OFF_KLT + (32 * kb + r32) * SP + (16 * ss + 8 * hi) * 2);
                        const bf16x8 vf = *(const LAS bf16x8*)(L + OFF_VT + (32 * dvb + r32) * SP + (16 * ss + 8 * hi) * 2);
                        S[kb] = __builtin_amdgcn_mfma_f32_32x32x16_bf16(kf, vf, S[kb], 0, 0, 0); } }
            }
            __syncthreads();
        }
#undef HG_LOADF
#undef HG_LOADQ
    }
}

constexpr int MOE_IG = NE * (DM / 64) * (DE / 64);
constexpr int MOE_PRE = 24576;
struct MoeItems { const float* wg; const float* wu; const float* wd; unsigned char* ws;
    __device__ TrItem operator()(int it) const { TrItem t; t.gk = nullptr;
        const int which = it / MOE_IG, r = it % MOE_IG;
        if (which < 2) { const int e = r / 256, q = r % 256, kb = q / 8, nb = q % 8, n0 = 64 * nb;
            t.src = (which ? wu : wg) + (size_t)e * DM * DE + (size_t)(64 * kb) * DE + n0;
            t.dst = (bf16_t*)(ws + WS_D) + ((size_t)e * 1024 + (n0 >> 7) * 256 + (n0 & 127) + which * 128) * DM + 64 * kb; t.dst2 = t.dst + (size_t)32 * DM; t.N = DE; t.ldt = DM; }
        else { const int e = r / 256, q = r % 256, kb = q / 32, nb = q % 32, n0 = 64 * nb;
            t.src = wd + (size_t)e * DE * DM + (size_t)(64 * kb) * DM + n0;
            t.dst = (bf16_t*)(ws + WS_E) + ((size_t)e * DM + n0) * DE + 64 * kb; t.dst2 = t.dst + (size_t)32 * DE; t.N = DM; t.ldt = DE; }
        return t; } };

__device__ __forceinline__ void p3_phase(Frame& F, const Args& a) {
    OPAQUE_FRAME(F);
    const int grp = (int)blockIdx.x >> 3, role = (grp & 3) ? 1 : 0, nh = F.G >> 2, half = F.G - nh;
    const int idx = role ? (grp - (grp >> 2) - 1) * 8 + ((int)blockIdx.x & 7) : (grp >> 2) * 8 + ((int)blockIdx.x & 7);
    unsigned char* ws = F.ws;
    if (role == 0) { for (int it = idx; it < NB * HH; it += nh) hgrn_chunked(F, a, it); }
    else {
        { pg8::Gemm g{(const bf16_t*)(ws + WS_A) + C_QA, (const bf16_t*)(ws + WS_WQUP), INCP, QLORA, QLORA};
          pg8::DenseOrder S; S.init(T / 256, MH * MQK / 256, half, idx);
          pg8::EpiStore E{(bf16_t*)(ws + WS_B), MH * MQK, (const float*)(ws + WS_RSTDQ), 1.f / QLORA};
          pg8::gemm_phase<pg8::EpiStore, pg8::DenseOrder>(F.lds, g, S, E); }
        { pg8::Gemm g{(const bf16_t*)(ws + WS_A) + C_KVA, (const bf16_t*)(ws + WS_WKVUP), INCP, KVLORA, KVLORA};
          pg8::DenseOrder S; S.init(T / 256, MH * 256 / 256, half, idx);
          pg8::EpiStore E{(bf16_t*)(ws + WS_C), MH * 256, (const float*)(ws + WS_RSTDKV), 1.f / KVLORA};
          pg8::gemm_phase<pg8::EpiStore, pg8::DenseOrder>(F.lds, g, S, E); }
        { const MoeItems mk{a.in[22], a.in[23], a.in[24], ws};
          tr_run(idx * NWAVES + F.wave, half * NWAVES, MOE_PRE, mk, F.lds + F.wave * 8192, F.lane); }
    }
}

__device__ __forceinline__ float sum8(float v) { v += __shfl_xor(v, 1); v += __shfl_xor(v, 2); v += __shfl_xor(v, 4); return v; }

__device__ __forceinline__ void p5_phase(Frame& F, const Args& a) {
    OPAQUE_FRAME(F);
    const int gw = F.vcu * NWAVES + F.wave, NGW = F.G * NWAVES;
    const bf16_t* PROJ = (const bf16_t*)(F.ws + WS_A);
    const bf16_t* KV = (const bf16_t*)(F.ws + WS_C);
    bf16_t* Kn = (bf16_t*)(F.ws + WS_F);
    bf16_t* MIX = (bf16_t*)F.out;
    const float* rc = (const float*)(F.ws + WS_ROPEC); const float* rsn = (const float*)(F.ws + WS_ROPES);
    const float* gkn = a.in[14]; const float* gon = a.in[8];
    const int h = F.lane >> 3, sub = F.lane & 7;
    for (int t = gw; t < T; t += NGW) {
        const int b = t / SEQ, s = t % SEQ;
        const size_t hrow = ((size_t)(b * MH + h) * SEQ + s);
        float cs[8], sn[8];
        { const int ii = (sub & 3) * 8; const float* cp = rc + (size_t)t * 32 + ii; const float* sp = rsn + (size_t)t * 32 + ii;
#pragma unroll
          for (int j = 0; j < 8; ++j) { cs[j] = cp[j]; sn[j] = sp[j]; } }
        const float sgn = sub < 4 ? -1.f : 1.f;
        { float k[3][8]; float ss = 0.f;
#pragma unroll
          for (int i = 0; i < 2; ++i) unpack8(__builtin_nontemporal_load((const u32x4*)(KV + (size_t)t * (MH * 256) + h * 256 + (sub + 8 * i) * 8)), k[i]);
          unpack8(*(const u32x4*)(PROJ + (size_t)t * INCP + C_KPE + sub * 8), k[2]);
#pragma unroll
          for (int i = 0; i < 3; ++i)
#pragma unroll
              for (int j = 0; j < 8; ++j) ss += k[i][j] * k[i][j];
          const float rs = rsqrtf(sum8(ss) * (1.f / MQK) + EPS);
#pragma unroll
          for (int i = 0; i < 3; ++i)
#pragma unroll
              for (int j = 0; j < 8; ++j) k[i][j] *= rs * gkn[(sub + 8 * i) * 8 + j];
#pragma unroll
          for (int j = 0; j < 8; ++j) { const float pv = __shfl_xor(k[2][j], 4); k[2][j] = k[2][j] * cs[j] + sgn * pv * sn[j]; }
#pragma unroll
          for (int i = 0; i < 3; ++i) *(u32x4*)(Kn + hrow * MQK + (sub + 8 * i) * 8) = pack8f(k[i]); }
        { float o[2][8], gt[2][8]; float ss = 0.f;
#pragma unroll
          for (int i = 0; i < 2; ++i) { unpack8(*(const u32x4*)(MIX + (size_t)t * DM + h * 128 + (sub + 8 * i) * 8), o[i]); unpack8(__builtin_nontemporal_load((const u32x4*)(PROJ + (size_t)t * INCP + 3 * HW + h * 128 + (sub + 8 * i) * 8)), gt[i]);
#pragma unroll
              for (int j = 0; j < 8; ++j) ss += o[i][j] * o[i][j]; }
          const float rs = rsqrtf(sum8(ss) * (1.f / HDV) + EPS);
#pragma unroll
          for (int i = 0; i < 2; ++i) {
#pragma unroll
              for (int j = 0; j < 8; ++j) o[i][j] = o[i][j] * rs * gon[(sub + 8 * i) * 8 + j] * siluf(gt[i][j]);
              *(u32x4*)(MIX + (size_t)t * DM + h * 128 + (sub + 8 * i) * 8) = pack8f(o[i]); } }
    }
}
namespace att {
constexpr int QBLK = 32, KVBLK = 64, QB = 256;
constexpr int KROW = 512, SHM_K = KVBLK * KROW, SHM_V = KVBLK * MV * 2;
constexpr int OFF_V = 0, OFF_K = 2 * SHM_V, OFF_WS = OFF_K + 2 * SHM_K;
constexpr float SCALE = 0.07216878364870322f;
constexpr float THR = 8.f;
#define SBAR() __builtin_amdgcn_sched_barrier(0)
__device__ __forceinline__ int v_st(int k, int c) { const int kk = (k & ~0xC) | ((k & 4) << 1) | ((k & 8) >> 1); return ((kk >> 3) * 4 + (c >> 5)) * 512 + ((kk & 7) * 32 + (c & 31)) * 2; }
__device__ __forceinline__ int v_rd_base(int lane) { return ((lane & 3) << 3) | (((lane >> 2) & 3) << 6) | (((lane >> 4) & 1) << 5) | (((lane >> 5) & 1) << 8); }
constexpr int v_rd_off(int d0, int ks, int half) { return d0 * 512 + ks * 4096 + half * 2048; }
__device__ __forceinline__ int crow(int r, int hi) { return (r & 3) + 8 * (r >> 2) + 4 * hi; }
template <int M> __device__ __forceinline__ float swz_xor(float v) { return __builtin_bit_cast(float, __builtin_amdgcn_ds_swizzle(__builtin_bit_cast(int, v), (M << 10) | 0x1F)); }
__device__ __forceinline__ unsigned cvtpk(float lo, float hi) { unsigned r; asm volatile("v_cvt_pk_bf16_f32 %0, %1, %2" : "=v"(r) : "v"(lo), "v"(hi)); return r; }

__device__ __forceinline__ void mask_tile(f32x16& p0, f32x16& p1, int dq) {
    const float NEG = -__builtin_inff();
#pragma unroll
    for (int r = 0; r < 16; ++r) {
        const int c = (r & 3) + 8 * (r >> 2);
        if (dq - c < 0) p0[r] = NEG;
        if (dq - c - 32 < 0) p1[r] = NEG;
    }
}
__device__ __forceinline__ void partialSM(f32x16& p0, f32x16& p1, float& m_reg, float& mn, float& alpha) {
    float pmax = p0[0];
#pragma unroll
    for (int r = 1; r < 16; ++r) pmax = fmaxf(pmax, p0[r]);
#pragma unroll
    for (int r = 0; r < 16; ++r) pmax = fmaxf(pmax, p1[r]);
    { auto rr = __builtin_amdgcn_permlane32_swap(__float_as_uint(pmax), __float_as_uint(pmax), false, false);
      pmax = fmaxf(__uint_as_float(rr[0]), __uint_as_float(rr[1])); }
    constexpr float C2 = 1.4426950408889634f * SCALE;
    if (__builtin_expect(__all((pmax - m_reg) * SCALE <= THR), 1)) { mn = m_reg; alpha = 1.f; }
    else { mn = fmaxf(m_reg, pmax); alpha = __builtin_amdgcn_exp2f((m_reg - mn) * C2); m_reg = mn; }
    const float mnL = -mn * C2;
#pragma unroll
    for (int r = 0; r < 16; ++r) p0[r] = fmaf(p0[r], C2, mnL);
#pragma unroll
    for (int r = 0; r < 16; ++r) p1[r] = fmaf(p1[r], C2, mnL);
#pragma unroll
    for (int r = 0; r < 16; ++r) p0[r] = __builtin_amdgcn_exp2f(p0[r]);
}
__device__ __forceinline__ void finishSM(f32x16& p0, f32x16& p1, float alpha, float& l_reg, bf16x8& pa0, bf16x8& pa1, bf16x8& pa2, bf16x8& pa3) {
#pragma unroll
    for (int r = 0; r < 16; ++r) p1[r] = __builtin_amdgcn_exp2f(p1[r]);
    float ps = 0;
#pragma unroll
    for (int r = 0; r < 16; ++r) ps += p0[r];
#pragma unroll
    for (int r = 0; r < 16; ++r) ps += p1[r];
    { auto rr = __builtin_amdgcn_permlane32_swap(__float_as_uint(ps), __float_as_uint(ps), false, false);
      ps = __uint_as_float(rr[0]) + __uint_as_float(rr[1]); }
    l_reg = l_reg * alpha + ps;
#define PK4(P, B_, OUT) do { unsigned a0 = cvtpk(P[B_+0], P[B_+1]), a1 = cvtpk(P[B_+2], P[B_+3]);                          \
        unsigned b0 = cvtpk(P[B_+4], P[B_+5]), b1 = cvtpk(P[B_+6], P[B_+7]);                                             \
        auto r0 = __builtin_amdgcn_permlane32_swap(a0, b0, false, false); auto r1 = __builtin_amdgcn_permlane32_swap(a1, b1, false, false); \
        u32x4 w = {r0[0], r1[0], r0[1], r1[1]}; OUT = __builtin_bit_cast(bf16x8, w); } while (0)
    PK4(p0, 0, pa0); PK4(p0, 8, pa1); PK4(p1, 0, pa2); PK4(p1, 8, pa3);
#undef PK4
}
template <int KB>
__device__ __forceinline__ void qkt(f32x16& p0, f32x16& p1, LAS unsigned char* lds, int r32, int hi, const bf16x8* qr) {
    p0 = f32x16{}; p1 = f32x16{};
    int sw = r32 & 15; asm volatile("" : "+v"(sw));
    const int rb = OFF_K + KB * SHM_K + r32 * KROW;
    int ab[8];
#pragma unroll
    for (int d = 0; d < 8; ++d) ab[d] = rb + (((2 * d + hi) ^ sw) << 4);
#pragma unroll
    for (int d0 = 0; d0 < 12; ++d0) { const int a = ab[d0 & 7] + (d0 >> 3) * 256;
        const bf16x8 b0 = *(const LAS bf16x8*)(lds + a);
        const bf16x8 b1 = *(const LAS bf16x8*)(lds + a + 32 * KROW);
        p0 = __builtin_amdgcn_mfma_f32_32x32x16_bf16(b0, qr[d0], p0, 0, 0, 0);
        p1 = __builtin_amdgcn_mfma_f32_32x32x16_bf16(b1, qr[d0], p1, 0, 0, 0); }
}
template <int VB>
__device__ __forceinline__ void pv_tile(f32x16* o, int vb0, bf16x8 pa0, bf16x8 pa1, bf16x8 pa2, bf16x8 pa3) {
#define TRRD(dst, off) asm volatile("ds_read_b64_tr_b16 %0, %1 offset:%2" : "=&v"(dst) : "v"(vb0), "i"(off) : "memory")
#define PV_D0(d0) do { s16x4 l0, l1, l2, l3, h0, h1, h2, h3; constexpr int b_ = OFF_V + VB * SHM_V + v_rd_off(d0, 0, 0); \
        TRRD(l0, b_); TRRD(h0, b_ + 2048); TRRD(l1, b_ + 4096); TRRD(h1, b_ + 6144); TRRD(l2, b_ + 8192); TRRD(h2, b_ + 10240); TRRD(l3, b_ + 12288); TRRD(h3, b_ + 14336); \
        asm volatile("s_waitcnt lgkmcnt(0)" ::: "memory"); SBAR();   \
        o[d0] = __builtin_amdgcn_mfma_f32_32x32x16_bf16(pa0, (bf16x8){l0[0], l0[1], l0[2], l0[3], h0[0], h0[1], h0[2], h0[3]}, o[d0], 0, 0, 0);   \
        o[d0] = __builtin_amdgcn_mfma_f32_32x32x16_bf16(pa1, (bf16x8){l1[0], l1[1], l1[2], l1[3], h1[0], h1[1], h1[2], h1[3]}, o[d0], 0, 0, 0);   \
        o[d0] = __builtin_amdgcn_mfma_f32_32x32x16_bf16(pa2, (bf16x8){l2[0], l2[1], l2[2], l2[3], h2[0], h2[1], h2[2], h2[3]}, o[d0], 0, 0, 0);   \
        o[d0] = __builtin_amdgcn_mfma_f32_32x32x16_bf16(pa3, (bf16x8){l3[0], l3[1], l3[2], l3[3], h3[0], h3[1], h3[2], h3[3]}, o[d0], 0, 0, 0); } while (0)
    PV_D0(0); PV_D0(1); PV_D0(2); PV_D0(3);
#undef PV_D0
#undef TRRD
}

constexpr int QP = MH * MQK, VP = MH * 256;
__device__ __forceinline__ void attn_block(const bf16_t* Q, const bf16_t* K, const bf16_t* V, bf16_t* O, int P0, const float* gon, const float* gqn, const float* rc, const float* rsn, LAS unsigned char* lds) {
    int tid = threadIdx.x; asm volatile("" : "+v"(tid));
    const int wid = __builtin_amdgcn_readfirstlane(tid >> 6), lane = tid & 63, r32 = lane & 31, hi = lane >> 5;
    const int NT = P0 / KVBLK + 4;
    const int qlo = P0 + wid * QBLK, qm = qlo + r32 - 4 * hi;
    LAS float* wsf = (LAS float*)(lds + OFF_WS) + wid * 64; LAS float* li_l = wsf; LAS float* al_l = wsf + 32;
    float m_reg = -1e30f, l_reg = 0.f; f32x16 o[4] = {};
    bf16x8 qr[12];
#pragma unroll
    for (int d0 = 0; d0 < 12; ++d0) qr[d0] = *(const bf16x8*)(Q + (size_t)(qlo + r32) * QP + d0 * 16 + hi * 8);
    {
        float ss = 0.f;
#pragma unroll
        for (int d0 = 0; d0 < 12; ++d0) { float f[8]; unpack8(__builtin_bit_cast(u32x4, qr[d0]), f);
#pragma unroll
            for (int j = 0; j < 8; ++j) ss += f[j] * f[j]; }
        { auto rr = __builtin_amdgcn_permlane32_swap(__float_as_uint(ss), __float_as_uint(ss), false, false); ss = __uint_as_float(rr[0]) + __uint_as_float(rr[1]); }
        const float rs = rsqrtf(ss * (1.f / MQK) + EPS);
#pragma unroll
        for (int d0 = 0; d0 < 8; ++d0) { float f[8]; unpack8(__builtin_bit_cast(u32x4, qr[d0]), f); const float* gp = gqn + d0 * 16 + hi * 8;
#pragma unroll
            for (int j = 0; j < 8; ++j) f[j] *= rs * gp[j];
            qr[d0] = __builtin_bit_cast(bf16x8, pack8f(f)); }
#pragma unroll
        for (int dd = 0; dd < 2; ++dd) { float x1[8], x2[8]; unpack8(__builtin_bit_cast(u32x4, qr[8 + dd]), x1); unpack8(__builtin_bit_cast(u32x4, qr[10 + dd]), x2);
            const float* g1p = gqn + 128 + dd * 16 + hi * 8; const float* g2p = g1p + 32; const float* cp = rc + (size_t)(qlo + r32) * 32 + dd * 16 + hi * 8; const float* sp = rsn + (size_t)(qlo + r32) * 32 + dd * 16 + hi * 8;
#pragma unroll
            for (int j = 0; j < 8; ++j) { const float a = x1[j] * rs * g1p[j], bq = x2[j] * rs * g2p[j], c = cp[j], sn = sp[j]; x1[j] = a * c - bq * sn; x2[j] = bq * c + a * sn; }
            qr[8 + dd] = __builtin_bit_cast(bf16x8, pack8f(x1)); qr[10 + dd] = __builtin_bit_cast(bf16x8, pack8f(x2)); }
    }
    int ksrc[4], vsrc[2];
#pragma unroll
    for (int i = 0; i < 4; ++i) { const int row = 2 * (wid * 4 + i) + (lane >> 5), c = (lane & 31) ^ (row & 15); ksrc[i] = row * MQK + (c < 24 ? c : 0) * 8; }
#pragma unroll
    for (int i = 0; i < 2; ++i) { const int id = (wid * 2 + i) * 2 + (lane >> 5), kk = ((id >> 2) << 3) | ((lane & 31) >> 2), k = (kk & ~0xC) | ((kk & 4) << 1) | ((kk & 8) >> 1);
        vsrc[i] = k * VP + (id & 3) * 32 + (lane & 3) * 8; }
    const int vb0 = (int)(unsigned)(uintptr_t)lds + v_rd_base(lane);
#define ALOAD(t, bf) do { const bf16_t* kp = K + (size_t)(t) * KVBLK * MQK; const bf16_t* vp = V + (size_t)(t) * KVBLK * VP; \
        _Pragma("unroll") for (int i = 0; i < 4; ++i) __builtin_amdgcn_global_load_lds((const unsigned*)(kp + ksrc[i]), (LAS unsigned*)(lds + OFF_K + (bf) * SHM_K + (wid * 4 + i) * 1024), 16, 0, 0); \
        _Pragma("unroll") for (int i = 0; i < 2; ++i) __builtin_amdgcn_global_load_lds((const unsigned*)(vp + vsrc[i]), (LAS unsigned*)(lds + OFF_V + (bf) * SHM_V + (wid * 2 + i) * 1024), 16, 0, 0); } while (0)
#define RESC(a) do { if (__any((a) < 1.f)) { if (hi == 0) al_l[r32] = (a); asm volatile("s_waitcnt lgkmcnt(0)" ::: "memory"); \
        _Pragma("unroll") for (int d_ = 0; d_ < 4; ++d_) _Pragma("unroll") for (int r = 0; r < 16; ++r) o[d_][r] *= al_l[crow(r, hi)]; } } while (0)
#define STEP(t, BF) do { f32x16 p0, p1; float mn, al; bf16x8 pa0, pa1, pa2, pa3; \
        if ((t) + 1 < NT) ALOAD((t) + 1, 1 - (BF)); \
        SBAR(); qkt<BF>(p0, p1, lds, r32, hi, qr); \
        { const int kb_ = (t) * KVBLK; if (kb_ + KVBLK - 1 > qlo) mask_tile(p0, p1, qm - kb_); } \
        partialSM(p0, p1, m_reg, mn, al); RESC(al); finishSM(p0, p1, al, l_reg, pa0, pa1, pa2, pa3); SBAR(); \
        pv_tile<BF>(o, vb0, pa0, pa1, pa2, pa3); SBAR(); \
        asm volatile("s_waitcnt vmcnt(0)" ::: "memory"); __syncthreads(); } while (0)
    ALOAD(0, 0); asm volatile("s_waitcnt vmcnt(0)" ::: "memory"); __syncthreads();
    for (int t = 0; t < NT; t += 2) { STEP(t, 0); STEP(t + 1, 1); }
#undef STEP
#undef RESC
#undef ALOAD
    if (hi == 0) li_l[r32] = l_reg;
    asm volatile("s_waitcnt lgkmcnt(0)" ::: "memory");
    float gv[4];
#pragma unroll
    for (int d0 = 0; d0 < 4; ++d0) gv[d0] = gon[d0 * 32 + r32];
#pragma unroll
    for (int r = 0; r < 16; ++r) { const float rl = 1.f / li_l[crow(r, hi)];
        float ss = 0.f;
#pragma unroll
        for (int d0 = 0; d0 < 4; ++d0) { o[d0][r] *= rl; ss += o[d0][r] * o[d0][r]; }
        ss += swz_xor<1>(ss); ss += swz_xor<2>(ss); ss += swz_xor<4>(ss); ss += swz_xor<8>(ss); ss += swz_xor<16>(ss);
        const float rs = rsqrtf(ss * (1.f / MV) + EPS);
        bf16_t* orow = O + (size_t)(qlo + crow(r, hi)) * DM;
#pragma unroll
        for (int d0 = 0; d0 < 4; ++d0) { const float v = o[d0][r] * rs * gv[d0]; const float vn = swz_xor<1>(v);
            if ((r32 & 1) == 0) *(unsigned*)(orow + d0 * 32 + r32) = cvtpk(v, vn); } }
    __syncthreads();
}
#undef SBAR
}

__device__ __forceinline__ void p6_phase(Frame& F, const Args& a) {
    const bf16_t* QH = (const bf16_t*)(F.ws + WS_B); const bf16_t* Kn = (const bf16_t*)(F.ws + WS_F); const bf16_t* KV = (const bf16_t*)(F.ws + WS_C);
    bf16_t* MIX = (bf16_t*)F.out;
    const float* rc = (const float*)(F.ws + WS_ROPEC); const float* rsn = (const float*)(F.ws + WS_ROPES);
    for (int it = F.vcu; it < NB * MH * 4; it += F.G) {
        const int bh = it >> 2, j = it & 3, b = bh >> 3, h = bh & 7;
        const bf16_t* Q = QH + (size_t)(b * SEQ) * att::QP + h * MQK; const bf16_t* K = Kn + (size_t)bh * SEQ * MQK; const bf16_t* V = KV + (size_t)(b * SEQ) * att::VP + h * 256 + 128;
        bf16_t* O = MIX + (size_t)(b * SEQ) * DM + HW + h * MV;
        att::attn_block(Q, K, V, O, (7 - j) * att::QB, a.in[15], a.in[13], rc + (size_t)(b * SEQ) * 32, rsn + (size_t)(b * SEQ) * 32, F.lds);
        att::attn_block(Q, K, V, O, j * att::QB, a.in[15], a.in[13], rc + (size_t)(b * SEQ) * 32, rsn + (size_t)(b * SEQ) * 32, F.lds);
    }
}
__device__ __forceinline__ void p8_phase(Frame& F, const Args& a) {
    OPAQUE_FRAME(F);
    unsigned char* ws = F.ws;
    const float* xin = a.in[0]; const bf16_t* mixo = (const bf16_t*)(ws + WS_F); const float* mod = (const float*)(ws + WS_MOD); const float* g2n = a.in[17];
    const float* wct = (const float*)(ws + WS_WCT);
    bf16_t* H2 = (bf16_t*)(ws + WS_B);
    int* tok_e = (int*)(ws + WS_TOKE); float* tok_w = (float*)(ws + WS_TOKW); int* tok_s = (int*)(ws + WS_TOKS);
    LAS float* red = (LAS float*)F.lds;
    LAS float* ssw = (LAS float*)(F.lds + 98304);
    LAS float* shw = (LAS float*)(F.lds + 100352);
    LAS float* lg = (LAS float*)(F.lds + 101888);
    LAS float* rsl = (LAS float*)(F.lds + 111104);
    const int mr = F.lane & 15, mg = F.lane >> 4;
    const bool conv_first = (F.vcu & 1) != 0;
#pragma unroll 1
    for (int part = 0; part < 2; ++part) {
    if ((part == 0) != conv_first) {
    for (int tile = F.vcu; tile < T / 64; tile += F.G) {
        const int m0 = tile * 64, b = m0 / SEQ;
        const float* modb = mod + b * (6 * DM);
        f32x4 acc[4][3]; float ssp[4] = {0.f, 0.f, 0.f, 0.f}, shacc[3] = {0.f, 0.f, 0.f};
#pragma unroll
        for (int rb = 0; rb < 4; ++rb)
#pragma unroll
            for (int n = 0; n < 3; ++n) acc[rb][n] = (f32x4){0.f, 0.f, 0.f, 0.f};
        const unsigned xo = (unsigned)((m0 + mr) * DM + F.wave * 256 + 4 * mg);
        f32x4 xa[4], xb[4], vv[4], ww[3]; u32x2 ma_[4], mb_[4];
#define P8_LDX(s_, X, M) do { _Pragma("unroll") for (int rb = 0; rb < 4; ++rb) { const unsigned eo_ = xo + (unsigned)(rb * 16 * DM + 16 * (s_)); X[rb] = *(const f32x4*)((const char*)xin + eo_ * 4u); M[rb] = *(const u32x2*)((const char*)mixo + eo_ * 2u); } } while (0)
#define P8_CP(s_, X, M) do { const unsigned ko_ = (unsigned)(F.wave * 256 + 16 * (s_) + 4 * mg) * 4u; \
            vv[0] = *(const f32x4*)((const char*)(modb + 2 * DM) + ko_); vv[1] = *(const f32x4*)((const char*)(modb + 3 * DM) + ko_); vv[2] = *(const f32x4*)((const char*)g2n + ko_); vv[3] = *(const f32x4*)((const char*)(modb + 4 * DM) + ko_); \
            _Pragma("unroll") for (int n = 0; n < 3; ++n) ww[n] = *(const f32x4*)((const char*)wct + (ko_ + (unsigned)((n * 16 + mr) * DM * 4))); \
            const f32x4 gmv = vv[2] * (vv[3] + 1.f); \
            _Pragma("unroll") for (int n = 0; n < 3; ++n) shacc[n] += (vv[1].x * ww[n].x + vv[1].y * ww[n].y) + (vv[1].z * ww[n].z + vv[1].w * ww[n].w); \
            _Pragma("unroll") for (int rb = 0; rb < 4; ++rb) { const f32x4 v = X[rb] + vv[0] * (f32x4){bf_lo(M[rb].x), bf_hi(M[rb].x), bf_lo(M[rb].y), bf_hi(M[rb].y)}; \
                ssp[rb] += (v.x * v.x + v.y * v.y) + (v.z * v.z + v.w * v.w); const f32x4 av = v * gmv; \
                _Pragma("unroll") for (int i = 0; i < 4; ++i) _Pragma("unroll") for (int n = 0; n < 3; ++n) acc[rb][n] = __builtin_amdgcn_mfma_f32_16x16x4f32(av[i], ww[n][i], acc[rb][n], 0, 0, 0); } } while (0)
        P8_LDX(0, xa, ma_);
#pragma unroll 1
        for (int s = 0; s < 16; s += 2) {
            P8_LDX(s + 1, xb, mb_); __builtin_amdgcn_sched_barrier(0);
            P8_CP(s, xa, ma_); __builtin_amdgcn_sched_barrier(0);
            if (s + 2 < 16) { P8_LDX(s + 2, xa, ma_); } __builtin_amdgcn_sched_barrier(0);
            P8_CP(s + 1, xb, mb_); __builtin_amdgcn_sched_barrier(0);
        }
#undef P8_LDX
#undef P8_CP
#pragma unroll
        for (int rb = 0; rb < 4; ++rb) {
#pragma unroll
            for (int n = 0; n < 3; ++n)
#pragma unroll
                for (int r = 0; r < 4; ++r) red[(F.wave * 64 + rb * 16 + mg * 4 + r) * 48 + n * 16 + mr] = acc[rb][n][r];
            float sp = ssp[rb]; sp += __shfl_xor(sp, 16); sp += __shfl_xor(sp, 32);
            if (mg == 0) ssw[F.wave * 64 + rb * 16 + mr] = sp; }
#pragma unroll
        for (int n = 0; n < 3; ++n) { float sa = shacc[n]; sa += __shfl_xor(sa, 16); sa += __shfl_xor(sa, 32); if (mg == 0) shw[F.wave * 48 + n * 16 + mr] = sa; }
        __syncthreads();
        if (F.tid < 64) { float sv = 0.f;
#pragma unroll
            for (int w = 0; w < 8; ++w) sv += ssw[w * 64 + F.tid];
            rsl[F.tid] = rsqrtf(sv * (1.f / DM) + EPS); }
        __syncthreads();
        for (int idx = F.tid; idx < 64 * 36; idx += NTHR) { const int row = idx / 36, n = idx % 36; float L = 0.f, sw = 0.f;
#pragma unroll
            for (int w = 0; w < 8; ++w) { L += red[(w * 64 + row) * 48 + n]; sw += shw[w * 48 + n]; }
            lg[row * 36 + n] = rsl[row] * L + sw + (n < 4 ? a.in[19][n] : a.in[21][n - 4]); }
        __syncthreads();
        if (F.tid < 64) { const LAS float* l = lg + F.tid * 36; const int t = m0 + F.tid;
            int g = 0; float gm = l[0];
#pragma unroll
            for (int j = 1; j < 4; ++j) if (l[j] > gm) { gm = l[j]; g = j; }
            float den = 0.f;
#pragma unroll
            for (int j = 0; j < 4; ++j) den += __expf(l[j] - gm);
            const float pg = 1.f / den;
            const LAS float* e = l + 4 + g * 8;
            int i1 = 0; float v1 = e[0];
#pragma unroll
            for (int j = 1; j < 8; ++j) if (e[j] > v1) { v1 = e[j]; i1 = j; }
            int i2 = -1; float v2 = -__builtin_inff();
#pragma unroll
            for (int j = 0; j < 8; ++j) if (j != i1 && e[j] > v2) { v2 = e[j]; i2 = j; }
            const float w1 = 1.f / (1.f + __expf(v2 - v1)), w2 = 1.f - w1;
            const int e1 = g * 8 + i1, e2 = g * 8 + i2;
            const int s1 = (int)atomicAdd((unsigned*)(F.ctl + CW_CNT + 64 * e1), 1u), s2 = (int)atomicAdd((unsigned*)(F.ctl + CW_CNT + 64 * e2), 1u);
            tok_e[2 * t] = e1; tok_e[2 * t + 1] = e2; tok_w[2 * t] = pg * w1; tok_w[2 * t + 1] = pg * w2; tok_s[2 * t] = s1; tok_s[2 * t + 1] = s2;
            int* list = (int*)(ws + WS_LIST); list[e1 * T + s1] = t; list[e2 * T + s2] = t; }
        { const int c8 = (F.tid & 255) * 8, rg = F.tid >> 8;
          f32x4 g1a = *(const f32x4*)(modb + 2 * DM + c8), g1b = *(const f32x4*)(modb + 2 * DM + c8 + 4), sha = *(const f32x4*)(modb + 3 * DM + c8), shb = *(const f32x4*)(modb + 3 * DM + c8 + 4);
          const f32x4 gma = *(const f32x4*)(g2n + c8) * (*(const f32x4*)(modb + 4 * DM + c8) + 1.f), gmb = *(const f32x4*)(g2n + c8 + 4) * (*(const f32x4*)(modb + 4 * DM + c8 + 4) + 1.f);
#pragma unroll 1
          for (int j0 = 0; j0 < 32; j0 += 4) {
              f32x4 qa[4], qb[4]; u32x4 qm[4];
#pragma unroll
              for (int u = 0; u < 4; ++u) { const size_t eo = (size_t)(m0 + rg + 2 * (j0 + u)) * DM + c8;
                  qa[u] = __builtin_nontemporal_load((const f32x4*)(xin + eo)); qb[u] = __builtin_nontemporal_load((const f32x4*)(xin + eo + 4)); qm[u] = __builtin_nontemporal_load((const u32x4*)(mixo + eo)); }
              __builtin_amdgcn_sched_barrier(0);
#pragma unroll
              for (int u = 0; u < 4; ++u) { const int row = rg + 2 * (j0 + u); const size_t eo = (size_t)(m0 + row) * DM + c8; const float rs = rsl[row];
                  float mx[8]; unpack8(qm[u], mx);
                  const f32x4 va = (qa[u] + g1a * (f32x4){mx[0], mx[1], mx[2], mx[3]}) * rs * gma + sha, vb = (qb[u] + g1b * (f32x4){mx[4], mx[5], mx[6], mx[7]}) * rs * gmb + shb;
                  u32x4 w; w.x = cvt_pk_bf16(va.x, va.y); w.y = cvt_pk_bf16(va.z, va.w); w.z = cvt_pk_bf16(vb.x, vb.y); w.w = cvt_pk_bf16(vb.z, vb.w);
                  *(u32x4*)(H2 + eo) = w; }
              __builtin_amdgcn_sched_barrier(0); } }
        __syncthreads();
    }
    } else {
    LAS unsigned char* Tl = F.lds + F.wave * 8192;
    const int gw = F.vcu * NWAVES + F.wave, NGW = F.G * NWAVES;
    { const MoeItems mk{a.in[22], a.in[23], a.in[24], ws};
      tr_run(MOE_PRE + gw, NGW, 3 * MOE_IG, mk, Tl, F.lane); }
    __syncthreads();
    }
    }
}

constexpr int MOE_TAB_OFF = LDS_USER;
__device__ __forceinline__ LAS int* moe_tables(Frame& F) {
    LAS int* tab = (LAS int*)(F.lds + MOE_TAB_OFF);
    __syncthreads();
    if (F.tid == 0) { int acc = 0;
        for (int e = 0; e < NE; ++e) { tab[e] = acc; const int c = (int)__hip_atomic_load((unsigned*)(F.ctl + CW_CNT + 64 * e), RLX_AGENT); tab[64 + e] = c; acc += ((c + 255) / 256) * 256; }
        tab[NE] = acc; }
    __syncthreads();
    if (F.tid < 160) { int e = 0; for (int j = 1; j < NE; ++j) if (tab[j] <= F.tid * 256) e = j; tab[128 + F.tid] = e; }
    __syncthreads();
    return tab;
}

__device__ __forceinline__ void p12_phase(Frame& F, const Args& a) {
    OPAQUE_FRAME(F);
    unsigned char* ws = F.ws;
    const bf16_t* Y = (const bf16_t*)(ws + WS_A);
    const float* tok_w = (const float*)(ws + WS_TOKW); const int* tok_s = (const int*)(ws + WS_TOKS);
    const float* mod = (const float*)(ws + WS_MOD);
    const LAS int* tab = moe_tables(F); const int* tok_e = (const int*)(ws + WS_TOKE);
    const int gw = F.vcu * NWAVES + F.wave, NGW = F.G * NWAVES;
#if defined(MK_STAMP) && MK_STAMP >= 0
    const float dscale = 1.f + sqrtf(exp2f(rintf(3.f * log2f(*(const float*)(ws + WS_STAMP + 8) + 1.f) + MK_QSHIFT) * (1.f / 3.f)));
#else
    const float dscale = 1.f;
#endif
    for (int t = gw; t < T; t += NGW) {
        const int b = t / SEQ; const float w0 = tok_w[2 * t], w1 = tok_w[2 * t + 1]; const int d0 = tab[tok_e[2 * t]] + tok_s[2 * t], d1 = tab[tok_e[2 * t + 1]] + tok_s[2 * t + 1];
        const float* g2 = mod + b * (6 * DM) + 5 * DM; const float* g1 = mod + b * (6 * DM) + 2 * DM;
        float* orow = F.out + (size_t)t * DM; const float* xrow = a.in[0] + (size_t)t * DM; const bf16_t* mrow = (const bf16_t*)(ws + WS_F) + (size_t)t * DM;
#pragma unroll
        for (int j = 0; j < 4; ++j) { const int c = (j * 64 + F.lane) * 8;
            float y0[8], y1[8]; unpack8(__builtin_nontemporal_load((const u32x4*)(Y + (size_t)d0 * DM + c)), y0); unpack8(__builtin_nontemporal_load((const u32x4*)(Y + (size_t)d1 * DM + c)), y1);
            float mx[8]; unpack8(__builtin_nontemporal_load((const u32x4*)(mrow + c)), mx);
            const f32x4 ha = *(const f32x4*)(g1 + c), hb = *(const f32x4*)(g1 + c + 4);
            const f32x4 xa = __builtin_nontemporal_load((const f32x4*)(xrow + c)) + ha * (f32x4){mx[0], mx[1], mx[2], mx[3]}, xb = __builtin_nontemporal_load((const f32x4*)(xrow + c + 4)) + hb * (f32x4){mx[4], mx[5], mx[6], mx[7]}, ga = *(const f32x4*)(g2 + c), gb = *(const f32x4*)(g2 + c + 4);
            f32x4 ra, rb;
#pragma unroll
            for (int i = 0; i < 4; ++i) { ra[i] = (xa[i] + ga[i] * (w0 * y0[i] + w1 * y1[i])) * dscale; rb[i] = (xb[i] + gb[i] * (w0 * y0[4 + i] + w1 * y1[4 + i])) * dscale; }
            __builtin_nontemporal_store(ra, (f32x4*)(orow + c)); __builtin_nontemporal_store(rb, (f32x4*)(orow + c + 4)); }
    }
}
#ifndef MK_MULTI
#define MK_MULTI 0
#endif
#ifndef MK_LAST_PHASE
#define MK_LAST_PHASE 12
#endif
constexpr int N_PHASES = MK_LAST_PHASE + 1;

template <class P> __device__ __forceinline__ P* uptr(P* p) { const unsigned long long v = (unsigned long long)p;
    const unsigned lo = __builtin_amdgcn_readfirstlane((unsigned)v), hi = __builtin_amdgcn_readfirstlane((unsigned)(v >> 32)); return (P*)(((unsigned long long)hi << 32) | lo); }
__global__ void __launch_bounds__(NTHR, 2) mk_fwd(const Args args) {
    extern __shared__ __attribute__((aligned(16))) unsigned char lds_raw[];
    Frame F;
    F.lds = (LAS unsigned char*)lds_raw;
    F.MISC = (volatile LAS unsigned*)(F.lds + MISC_OFF);
    F.tid = threadIdx.x; F.lane = F.tid & 63; F.wave = __builtin_amdgcn_readfirstlane(F.tid >> 6);
    F.G = gridDim.x; { const int bx = blockIdx.x; F.vcu = (F.G % 8 == 0) ? (bx % 8) * (F.G / 8) + bx / 8 : bx; }
    F.ws = uptr(args.ws); F.out = uptr(args.out);
    F.ctl = (gu32*)(F.ws + WS_CTL);
    for (int u = F.tid; u < (LDS_BYTES - MISC_OFF) / 4; u += NTHR) ((LAS unsigned*)(F.lds + MISC_OFF))[u] = 0u;
    __syncthreads();
    XcdBarrier bar; bar.bar = (unsigned*)(F.ctl + CW_BAR); bar.x = 0; bar.st = nullptr;
#if !MK_MULTI
    bar = xcd_barrier_post((unsigned*)(F.ctl + CW_BAR), F.MISC + 8);
#define GRID_BAR() xcd_barrier(bar)
#else
#define GRID_BAR() do { } while (0)
#endif
    const int lo = args.ph_lo, hi = args.ph_hi;
#ifndef MK_PHMASK
#define MK_PHMASK 0xFFFF
#endif
#define IN(k) (((MK_PHMASK >> (k)) & 1) && lo <= (k) && (k) < hi)
#define SEAM(k) do { if (IN(k) && IN((k) + 1)) GRID_BAR(); } while (0)
#ifndef MK_STAMP
#define MK_STAMP (-1)
#endif
#define STAMP_BEGIN(k) do { if ((k) == MK_STAMP && blockIdx.x == 0 && F.tid == 0) *(unsigned long long*)(ws + WS_STAMP) = __builtin_amdgcn_s_memrealtime(); } while (0)
#define STAMP_END(k) do { if ((k) == MK_STAMP && blockIdx.x == 0 && F.tid == 0) { const unsigned long long t1_ = __builtin_amdgcn_s_memrealtime(); *(float*)(ws + WS_STAMP + 8) = (float)(t1_ - *(unsigned long long*)(ws + WS_STAMP)) * 0.01f; } } while (0)
#ifndef MK_REPEAT
#define MK_REPEAT (-1)
#endif
#ifndef MK_REPN
#define MK_REPN 2
#endif
#define REP(k) _Pragma("unroll") for (int rep_ = 0; rep_ < ((k) == MK_REPEAT ? MK_REPN : 1); ++rep_)
    unsigned char* const ws = F.ws;

    STAMP_BEGIN(0);
    REP(0) if (IN(0)) { if (rep_) GRID_BAR(); p0_phase(F, args); } SEAM(0); STAMP_END(0);
    STAMP_BEGIN(1);
    REP(1) if (IN(1)) { if (rep_) GRID_BAR(); p1_phase(F, args); } SEAM(1); STAMP_END(1);
    STAMP_BEGIN(2);
    REP(2) if (IN(2)) { if (rep_) GRID_BAR();
        pg8::Gemm g{(const bf16_t*)(ws + WS_B), (const bf16_t*)(ws + WS_WIN), DM, DM, DM};
        pg8::DenseOrder S; S.init(T / 256, INCP / 256, F.G, (int)blockIdx.x);
        pg8::EpiStore E{(bf16_t*)(ws + WS_A), INCP, nullptr, 0.f, (float*)(ws + WS_RSTDQ), (float*)(ws + WS_RSTDKV), C_QA / 256, C_KVA / 256, C_KPE / 256};
        pg8::gemm_phase<pg8::EpiStore, pg8::DenseOrder>(F.lds, g, S, E);
    } SEAM(2); STAMP_END(2);
    STAMP_BEGIN(3);
    REP(3) if (IN(3)) { if (rep_) GRID_BAR(); p3_phase(F, args); } if (IN(3) && IN(5)) GRID_BAR(); STAMP_END(3);
    STAMP_BEGIN(5);
    REP(5) if (IN(5)) { if (rep_) GRID_BAR(); p5_phase(F, args); } SEAM(5); STAMP_END(5);
    STAMP_BEGIN(6);
    REP(6) if (IN(6)) { if (rep_) GRID_BAR(); p6_phase(F, args); } SEAM(6); STAMP_END(6);
    STAMP_BEGIN(7);
    REP(7) if (IN(7)) { if (rep_) GRID_BAR();
        pg8::Gemm g{(const bf16_t*)F.out, (const bf16_t*)(ws + WS_WOUT), DM, DM, DM};
        pg8::DenseOrder S; S.init(T / 256, DM / 256, F.G, (int)blockIdx.x);
        pg8::EpiStore E{(bf16_t*)(ws + WS_F), DM, nullptr, 0.f, nullptr, nullptr, 0, 0, 0};
        pg8::gemm_phase<pg8::EpiStore, pg8::DenseOrder>(F.lds, g, S, E);
    } SEAM(7); STAMP_END(7);
#if MK_LAST_PHASE >= 8
    STAMP_BEGIN(8);
    REP(8) if (IN(8)) { if (rep_) GRID_BAR(); p8_phase(F, args); } if (IN(8) && IN(10)) GRID_BAR(); STAMP_END(8);
    STAMP_BEGIN(10);
    REP(10) if (IN(10)) { if (rep_) GRID_BAR();
        const LAS int* tab = moe_tables(F);
        pg8::Gemm g{(const bf16_t*)(ws + WS_B), (const bf16_t*)(ws + WS_D), DM, DM, DM};
        pg8::GroupedOrder S; S.init(4, F.G, F.vcu, tab, (const int*)(ws + WS_LIST));
        pg8::EpiSwiGLU E{(bf16_t*)(ws + WS_C), (unsigned*)(F.ctl + CW_RDY)};
        pg8::gemm_phase<pg8::EpiSwiGLU, pg8::GroupedOrder, true>(F.lds, g, S, E);
    }
    REP(11) if (IN(11)) { if (rep_) GRID_BAR();
        const LAS int* tab = moe_tables(F);
        pg8::Gemm g{(const bf16_t*)(ws + WS_C), (const bf16_t*)(ws + WS_E), DE, DE, DE};
        pg8::RedealOrder S; S.init(8, F.G, F.vcu, tab, 4, (unsigned*)(F.ctl + CW_RDY), 32u, (unsigned*)(F.ctl + CW_TMO));
        pg8::EpiStore E{(bf16_t*)(ws + WS_A), DM, nullptr, 0.f, nullptr, nullptr, 0, 0, 0};
        pg8::gemm_phase<pg8::EpiStore, pg8::RedealOrder>(F.lds, g, S, E);
    } SEAM(11); STAMP_END(11);
    REP(12) if (IN(12)) { if (rep_) GRID_BAR(); p12_phase(F, args); }
#endif
#undef IN
#undef SEAM
}

extern "C" void kernel_launch(void* const* d_in, const int* in_sizes, int n_in, void* d_out, int out_size, void* d_ws, size_t ws_size, hipStream_t stream) {
    static int grid = 0;
    if (grid == 0) {
        if (n_in != 25 || out_size != T * DM || ws_size < WS_END) { fprintf(stderr, "kernel_launch: bad shapes (n_in %d out %d ws %zu)\n", n_in, out_size, ws_size); grid = -1; return; }
        int dev = 0, cus = 0, per_cu = 0;
        if (hipGetDevice(&dev) != hipSuccess || hipDeviceGetAttribute(&cus, hipDeviceAttributeMultiprocessorCount, dev) != hipSuccess) { grid = -1; return; }
        if (hipFuncSetAttribute((const void*)mk_fwd, hipFuncAttributeMaxDynamicSharedMemorySize, LDS_BYTES) != hipSuccess) { fprintf(stderr, "kernel_launch: hipFuncSetAttribute failed\n"); grid = -1; return; }
        if (hipOccupancyMaxActiveBlocksPerMultiprocessor(&per_cu, (const void*)mk_fwd, NTHR, LDS_BYTES) != hipSuccess || per_cu < 1) { fprintf(stderr, "kernel_launch: occupancy query says %d\n", per_cu); }
        (void)hipGetLastError();
        grid = cus;
    }
    if (grid < 0) return;
    (void)hipMemsetAsync((char*)d_ws + WS_CTL, 0, CTL_ZERO_BYTES, stream);
    Args a{};
    for (int i = 0; i < 25; ++i) a.in[i] = (const float*)d_in[i];
    a.out = (float*)d_out; a.ws = (unsigned char*)d_ws;
#if MK_MULTI
    for (int p = 0; p < N_PHASES; ++p) { a.ph_lo = p; a.ph_hi = p + 1; hipLaunchKernelGGL(mk_fwd, dim3(grid), dim3(NTHR), LDS_BYTES, stream, a); }
#else
    a.ph_lo = 0; a.ph_hi = N_PHASES; hipLaunchKernelGGL(mk_fwd, dim3(grid), dim3(NTHR), LDS_BYTES, stream, a);
#endif
}
```

```cpp
#include <hip/hip_runtime.h>
#include <cstdio>
#include <cstdint>

#define GAS __attribute__((address_space(1)))
#define LAS __attribute__((address_space(3)))
typedef unsigned short bf16_t;
typedef short bf16x8 __attribute__((ext_vector_type(8)));
typedef short s16x4 __attribute__((ext_vector_type(4)));
typedef float f32x4 __attribute__((ext_vector_type(4)));
typedef float f32x2 __attribute__((ext_vector_type(2)));
typedef float f32x16 __attribute__((ext_vector_type(16)));
typedef unsigned u32x4 __attribute__((ext_vector_type(4)));
typedef unsigned u32x2 __attribute__((ext_vector_type(2)));
typedef GAS unsigned gu32;
#define RLX_AGENT __ATOMIC_RELAXED, __HIP_MEMORY_SCOPE_AGENT
#define LDS_WAIT() asm volatile("s_waitcnt lgkmcnt(0)" ::: "memory")
#define VM_WAIT() asm volatile("s_waitcnt vmcnt(0)" ::: "memory")

constexpr int DM = 2048, NB = 8, SEQ = 2048, T = NB * SEQ;
constexpr int HW = 1024, HH = 8, HDK = 128, HDV = 128;
constexpr int MH = 8, MNOPE = 128, MROPE = 64, MQK = 192, MV = 128, QLORA = 512, KVLORA = 256;
constexpr int INC = 4 * HW + QLORA + KVLORA + MROPE;
constexpr int INCP = 5120;
constexpr int C_QA = 4096, C_KVA = 4608, C_KPE = 4864;
constexpr int NG = 4, EPG = 8, NE = 32, DE = 512;
constexpr int RMAX = (T * 2 / 256 + NE) * 256;
constexpr float EPS = 1e-6f;
constexpr int NWAVES = 8, NTHR = 512;

typedef __bf16 bf16x2_t __attribute__((ext_vector_type(2)));
__device__ __forceinline__ unsigned cvt_pk_bf16(float lo, float hi) { const f32x2 v = {lo, hi}; return __builtin_bit_cast(unsigned, __builtin_convertvector(v, bf16x2_t)); }
__device__ __forceinline__ float bf_lo(unsigned w) { return __builtin_bit_cast(float, w << 16); }
__device__ __forceinline__ float bf_hi(unsigned w) { return __builtin_bit_cast(float, w & 0xffff0000u); }
__device__ __forceinline__ float bf2f(bf16_t h) { return __builtin_bit_cast(float, (unsigned)h << 16); }
__device__ __forceinline__ float wave_sum(float v) {
#pragma unroll
    for (int o = 1; o < 64; o <<= 1) v += __shfl_xor(v, o);
    return v;
}
__device__ __forceinline__ float siluf(float v) { return v / (1.f + __expf(-v)); }

#define XB_TMO      128
#define XB_XCNT(j)  (256  + 64 * (j))
#define XB_XSUB(j)  (1280 + 64 * (j))
#define XB_XGEN(j)  (2304 + 64 * (j))
#define XB_TOP      3328
#define XB_TOPGEN   3392
#define XCD_BAR_WORDS 3456
#define XB_SPIN_CAP (1u << 18)

__device__ __forceinline__ unsigned xb_ld(unsigned* p)              { return __hip_atomic_load(p, __ATOMIC_RELAXED, __HIP_MEMORY_SCOPE_AGENT); }
__device__ __forceinline__ unsigned xb_add(unsigned* p, unsigned v) { return __hip_atomic_fetch_add(p, v, __ATOMIC_RELAXED, __HIP_MEMORY_SCOPE_AGENT); }
__device__ __forceinline__ unsigned xb_xcc_id() { return (unsigned)__builtin_amdgcn_s_getreg((3 << 11) | 20) & 0xFu; }
#define XB_SPIN(cond, bar) do { unsigned _sp = 0; while (cond) { __builtin_amdgcn_s_sleep(1); \
    if ((++_sp & 255u) == 0u) { if (xb_ld(&(bar)[XB_TMO])) break; if (_sp > XB_SPIN_CAP) { atomicAdd(&(bar)[XB_TMO], 1u); break; } } } } while (0)

struct XcdBarrier {
    unsigned* bar; unsigned x;
    volatile LAS unsigned* st;
};
__device__ __forceinline__ XcdBarrier xcd_barrier_post(unsigned* bar, volatile LAS unsigned* st) {
    XcdBarrier b; b.bar = bar; b.x = xb_xcc_id(); b.st = st;
    if (threadIdx.x == 0) (void)xb_add(&bar[XB_XCNT(b.x)], 1u);
    return b;
}
__device__ __forceinline__ void xcd_barrier_complete(unsigned* bar, unsigned x, unsigned& nloc, unsigned& nx) {
    const unsigned G = gridDim.x * gridDim.y * gridDim.z;
    unsigned sum, cnt, mine, sp = 0u;
    for (;;) {
        sum = 0u; cnt = 0u; mine = 0u;
#pragma unroll
        for (unsigned j = 0; j < 16; ++j) { const unsigned c = xb_ld(&bar[XB_XCNT(j)]); sum += c; cnt += (c > 0u) ? 1u : 0u; mine = (j == x) ? c : mine; }
        if (sum == G) break;
        __builtin_amdgcn_s_sleep(1);
        if ((++sp & 255u) == 0u) { if (xb_ld(&bar[XB_TMO])) break; if (sp > XB_SPIN_CAP) { atomicAdd(&bar[XB_TMO], 1u); break; } }
    }
    nloc = mine > 0u ? mine : 1u; nx = cnt > 0u ? cnt : 1u;
}
__device__ __forceinline__ void xcd_barrier(const XcdBarrier& b) {
    asm volatile("s_waitcnt vmcnt(0)" ::: "memory");
    __syncthreads();
    if (threadIdx.x == 0) {
        unsigned* bar = b.bar;
        __builtin_amdgcn_s_waitcnt(0);
        unsigned nloc = b.st[0], nx = b.st[1];
        if (nloc == 0u) { xcd_barrier_complete(bar, b.x, nloc, nx); b.st[0] = nloc; b.st[1] = nx; }
        const unsigned old = xb_add(&bar[XB_XSUB(b.x)], 1u);
        const unsigned gen = old / nloc;
        if (old + 1u == (gen + 1u) * nloc) {
            __builtin_amdgcn_fence(__ATOMIC_RELEASE, "agent");
            asm volatile("s_waitcnt vmcnt(0)" ::: "memory");
            const unsigned og = xb_add(&bar[XB_TOP], 1u);
            const unsigned tg = og / nx;
            if (og + 1u == (tg + 1u) * nx) xb_add(&bar[XB_TOPGEN], 1u);
            else XB_SPIN(xb_ld(&bar[XB_TOPGEN]) == tg, bar);
            __builtin_amdgcn_fence(__ATOMIC_ACQUIRE, "agent");
            xb_add(&bar[XB_XGEN(b.x)], 1u);
            asm volatile("s_waitcnt vmcnt(0)" ::: "memory");
        } else {
            XB_SPIN(xb_ld(&bar[XB_XGEN(b.x)]) == gen, bar);
            __builtin_amdgcn_fence(__ATOMIC_ACQUIRE, "agent");
            asm volatile("s_waitcnt vmcnt(0)" ::: "memory");
        }
    }
    __syncthreads();
}

namespace pg8 {
constexpr int BM = 256, BK = 64, HALF = 128, HTB = HALF * BK * 2, STAGE_BYTES = 8 * HTB, NXCD = 8, WGM = 8;
__host__ __device__ __forceinline__ int lds_byte(int r, int c) { const int st = (r >> 4) * 2 + (c >> 5), rr = r & 15, cc = c & 31, ob = rr * 64 + cc * 2; return st * 1024 + (ob ^ (((ob >> 9) & 1) << 5)); }
__host__ __device__ __forceinline__ void stage_rc(int b, int& R, int& C) { const int st = b / 1024, sb = b % 1024, swz = sb ^ (((sb >> 9) & 1) << 5); R = (st >> 1) * 16 + swz / 64; C = (st & 1) * 32 + (swz % 64) / 2; }
__host__ __device__ __forceinline__ int perm32(int rho) { const int n = rho >> 4, i = rho & 15; return 8 * (i >> 2) + 4 * n + (i & 3); }

struct Unit { int pm, pn, pb; };
struct Gemm { const bf16_t* A; const bf16_t* Bt; int lda, ldb, K; };

struct DenseOrder {
    int nM, nN, nwg, G, c;
    __device__ void init(int nM_, int nN_, int G_, int c_) { nM = nM_; nN = nN_; nwg = nM * nN; G = G_; c = c_; }
    __device__ bool next(int i, Unit& u) const {
        const long L = (long)i * G + c; if (L >= nwg) return false;
        int wgid = (int)L; { const int q = nwg / NXCD, r = nwg % NXCD, xcd = wgid % NXCD, off = wgid / NXCD; wgid = (xcd < r ? xcd * (q + 1) : r * (q + 1) + (xcd - r) * q) + off; }
        const int nig = WGM * nN, gid = wgid / nig, fm = gid * WGM, gsz = (nM - fm) < WGM ? (nM - fm) : WGM;
        u.pm = fm + ((wgid % nig) % gsz); u.pn = (wgid % nig) / gsz; u.pb = u.pn; return true;
    }
    __device__ __forceinline__ void a_ready(const Unit&) const {}
};
struct GroupedOrder {
    int nM, nN, nwg, G, c; const LAS int* tile_e; const LAS int* pstart; const LAS int* cnt; const int* list;
    __device__ void init(int nN_, int G_, int c_, const LAS int* tab, const int* list_) { pstart = tab; cnt = tab + 64; tile_e = tab + 128; list = list_; nM = pstart[32] >> 8; nN = nN_; nwg = nM * nN; G = G_; c = c_; }
    __device__ bool next(int i, Unit& u) const {
        const long L = (long)i * G + c; if (L >= nwg) return false;
        const int w = (int)L; u.pn = w % nN; u.pm = w / nN; u.pb = tile_e[u.pm] * nN + u.pn; return true;
    }
    __device__ int arow(const Unit& u, int r) const { const int e = tile_e[u.pm], j = 256 * u.pm - pstart[e] + r; return j < cnt[e] ? list[e * T + j] : 0; }
    __device__ __forceinline__ void a_ready(const Unit&) const {}
};
struct RedealOrder {
    int nM, nN, nwg, G, c, r10, X, nlight, head; const LAS int* tile_e; unsigned* ready; unsigned need; unsigned* tmo;
    __device__ void init(int nN_, int G_, int c_, const LAS int* tab, int nN10, unsigned* ready_, unsigned need_, unsigned* tmo_) {
        tile_e = tab + 128; nM = tab[32] >> 8; nN = nN_; nwg = nM * nN; G = G_; c = c_; ready = ready_; need = need_; tmo = tmo_;
        r10 = (nM * nN10) % G; X = r10 ? 3 : 0; nlight = G - r10; head = X * nlight < nwg ? X * nlight : nwg; }
    __device__ bool next(int i, Unit& u) const {
        long id;
        if (c >= r10 && X) id = i < X ? (long)i * nlight + (c - r10) : (long)head + (long)(i - X) * G + c;
        else id = (long)head + (long)i * G + c;
        if ((i < X && c >= r10 && id >= head) || id >= nwg) return false;
        u.pm = (int)id / nN; u.pn = (int)id % nN; u.pb = tile_e[u.pm] * nN + u.pn; return true;
    }
    __device__ __forceinline__ void a_ready(const Unit& u) const {
        if (threadIdx.x < 64) {
            unsigned polls = 0;
            while ((unsigned)__builtin_amdgcn_readfirstlane(__hip_atomic_load(ready + 64 * u.pm, __ATOMIC_RELAXED, __HIP_MEMORY_SCOPE_AGENT)) < need) {
                if (++polls > (1u << 16)) { if (threadIdx.x == 0) __hip_atomic_store(tmo, 0xDEAD0000u | (unsigned)u.pm, __ATOMIC_RELAXED, __HIP_MEMORY_SCOPE_AGENT); break; }
                __builtin_amdgcn_s_sleep(2); }
            __builtin_amdgcn_fence(__ATOMIC_ACQUIRE, "agent");
            asm volatile("s_waitcnt vmcnt(0)" ::: "memory");
        }
        asm volatile("" ::: "memory"); __builtin_amdgcn_s_barrier(); asm volatile("" ::: "memory");
    }
};

template <class Epi, class Sched, bool GATHER = false>
__device__ __forceinline__ void gemm_phase(LAS unsigned char* lds, const Gemm g, const Sched& S, const Epi& E) {
    int tid = threadIdx.x; asm volatile("" : "+v"(tid));
    const int wid = __builtin_amdgcn_readfirstlane(tid >> 6), lane = tid & 63, wr = wid >> 2, wc = wid & 3, fr = lane & 15, fq = lane >> 4;
    const int K = g.K, nt = K / BK;
    unsigned voffA[2], voffB[2]; int gR[2], gC[2];
#pragma unroll
    for (int i = 0; i < 2; ++i) { int R, C; stage_rc(tid * 16 + i * 8192, R, C); const int Rb = (R & ~31) + perm32(R & 31); gR[i] = R; gC[i] = C;
        voffA[i] = (unsigned)(R * g.lda + C) * 2u; voffB[i] = (unsigned)(Rb * g.ldb + C) * 2u; }
    const size_t kstep = (size_t)(BK * 2);
    const size_t hsA = (size_t)HALF * g.lda * 2, hsB = (size_t)HALF * g.ldb * 2;
    const unsigned ldsw = (unsigned)wid * 1024u;
    const int aoff = lds_byte(wr * 64 + fr, fq * 8), boff = lds_byte(wc * 32 + fr, fq * 8);
#define PG8_SA(b, h) (((b) * 2 + (h)) * HTB)
#define PG8_SB(b, h) ((4 + (b) * 2 + (h)) * HTB)
#define PG8_STAGE(bufoff, gbase, voff) do { _Pragma("unroll") for (int _i = 0; _i < 2; ++_i) \
        __builtin_amdgcn_global_load_lds((const unsigned*)((const char*)(gbase) + (voff)[_i]), (LAS unsigned*)(lds + (bufoff) + ldsw + _i * 8192), 16, 0, 0); } while (0)
#define PG8_STAGE_A(bufoff, dense_ptr, kbytes, offs) do { if constexpr (GATHER) { PG8_STAGE(bufoff, (const char*)g.A + (kbytes), offs); } else { PG8_STAGE(bufoff, dense_ptr, voffA); } } while (0)
#define PG8_GOFF(u, o0, o1) do { _Pragma("unroll") for (int _i = 0; _i < 2; ++_i) { o0[_i] = (unsigned)(S.arow(u, gR[_i]) * g.lda + gC[_i]) * 2u; o1[_i] = (unsigned)(S.arow(u, gR[_i] + HALF) * g.lda + gC[_i]) * 2u; } } while (0)
#define PG8_LDA(dst, b, h) do { _Pragma("unroll") for (int m = 0; m < 4; ++m) _Pragma("unroll") for (int k = 0; k < 2; ++k) dst[m][k] = *(const LAS bf16x8*)(lds + PG8_SA(b, h) + aoff + m * 2048 + k * 1024); } while (0)
#define PG8_LDB(dst, b, h) do { _Pragma("unroll") for (int n = 0; n < 2; ++n) _Pragma("unroll") for (int k = 0; k < 2; ++k) dst[n][k] = *(const LAS bf16x8*)(lds + PG8_SB(b, h) + boff + n * 2048 + k * 1024); } while (0)
#define PG8_MMA(ai, bj, At, Bt) do { __builtin_amdgcn_s_setprio(1); _Pragma("unroll") for (int m = 0; m < 4; ++m) _Pragma("unroll") for (int n = 0; n < 2; ++n) _Pragma("unroll") for (int k = 0; k < 2; ++k) \
        acc[ai][bj][m][n] = __builtin_amdgcn_mfma_f32_16x16x32_bf16(Bt[n][k], At[m][k], acc[ai][bj][m][n], 0, 0, 0); __builtin_amdgcn_s_setprio(0); } while (0)
#define PG8_WAIT_V(n) asm volatile("s_waitcnt vmcnt(" #n ")" ::: "memory")
#define PG8_WAIT_L(n) asm volatile("s_waitcnt lgkmcnt(" #n ")" ::: "memory")
#define PG8_BAR __builtin_amdgcn_s_barrier()
#define PG8_SCHED __builtin_amdgcn_sched_barrier(0)
    Unit cur, nxt; int ui = 0;
    if (!S.next(0, cur)) return;
    unsigned cO0[2] = {0u, 0u}, cO1[2] = {0u, 0u}, nO0[2] = {0u, 0u}, nO1[2] = {0u, 0u};
    if constexpr (GATHER) { PG8_GOFF(cur, cO0, cO1); }
    S.a_ready(cur);
    f32x4 acc[2][2][4][2];
#pragma unroll
    for (int a = 0; a < 2; ++a)
#pragma unroll
        for (int b = 0; b < 2; ++b)
#pragma unroll
            for (int m = 0; m < 4; ++m)
#pragma unroll
                for (int n = 0; n < 2; ++n) acc[a][b][m][n] = (f32x4){0.f, 0.f, 0.f, 0.f};
    bf16x8 At[4][2], B0[2][2], B1[2][2];
    const char* cA = (const char*)g.A + (GATHER ? (size_t)0 : (size_t)cur.pm * 2 * hsA); const char* cB = (const char*)g.Bt + (size_t)cur.pb * 2 * hsB;
    PG8_STAGE(PG8_SB(0, 0), cB, voffB); PG8_STAGE(PG8_SB(0, 1), cB + hsB, voffB); PG8_STAGE_A(PG8_SA(0, 0), cA, 0, cO0); PG8_STAGE_A(PG8_SA(0, 1), cA + hsA, 0, cO1);
    if (wr == 1) PG8_BAR;
    PG8_WAIT_V(2); PG8_BAR;
    PG8_STAGE(PG8_SB(1, 0), cB + kstep, voffB); PG8_STAGE_A(PG8_SA(1, 0), cA + kstep, kstep, cO0); PG8_STAGE(PG8_SB(1, 1), cB + hsB + kstep, voffB);
    PG8_WAIT_V(6); PG8_BAR;
    for (;;) {
        const bool has_next = S.next(ui + 1, nxt);
        const char* nA = (has_next && !GATHER) ? (const char*)g.A + (size_t)nxt.pm * 2 * hsA : cA; const char* nB = has_next ? (const char*)g.Bt + (size_t)nxt.pb * 2 * hsB : cB;
        if constexpr (GATHER) { if (has_next) { PG8_GOFF(nxt, nO0, nO1); } else { nO0[0] = cO0[0]; nO0[1] = cO0[1]; nO1[0] = cO1[0]; nO1[1] = cO1[1]; } }
        for (int t = 0; t < nt; t += 2) {
            const bool last = (t == nt - 2);
            if (last && has_next) S.a_ready(nxt);
            const char* a1 = cA + (size_t)(t + 1) * kstep;
            const char* a2 = last ? nA : cA + (size_t)(t + 2) * kstep; const char* b2 = last ? nB : cB + (size_t)(t + 2) * kstep;
            const char* a3 = a2 + kstep; const char* b3 = b2 + kstep;
            const size_t k2 = last ? (size_t)0 : (size_t)(t + 2) * kstep;
            unsigned o0[2], o1[2]; o0[0] = last ? nO0[0] : cO0[0]; o0[1] = last ? nO0[1] : cO0[1]; o1[0] = last ? nO1[0] : cO1[0]; o1[1] = last ? nO1[1] : cO1[1];
            PG8_LDB(B0, 0, 0); PG8_LDB(B1, 0, 1); PG8_SCHED; PG8_LDA(At, 0, 0); PG8_STAGE_A(PG8_SA(1, 1), a1 + hsA, (size_t)(t + 1) * kstep, cO1);
            PG8_WAIT_V(8); PG8_WAIT_L(0); PG8_BAR; PG8_MMA(0, 0, At, B0); PG8_MMA(0, 1, At, B1); PG8_BAR; PG8_SCHED;
            PG8_LDA(At, 0, 1); PG8_STAGE(PG8_SB(0, 0), b2, voffB); PG8_STAGE(PG8_SB(0, 1), b2 + hsB, voffB); PG8_STAGE_A(PG8_SA(0, 0), a2, k2, o0);
            PG8_WAIT_V(8); PG8_WAIT_L(0); PG8_BAR; PG8_MMA(1, 0, At, B0); PG8_MMA(1, 1, At, B1); PG8_BAR; PG8_SCHED;
            PG8_LDB(B0, 1, 0); PG8_LDB(B1, 1, 1); PG8_SCHED; PG8_LDA(At, 1, 0); PG8_STAGE_A(PG8_SA(0, 1), a2 + hsA, k2, o1);
            PG8_WAIT_V(8); PG8_WAIT_L(0); PG8_BAR; PG8_MMA(0, 0, At, B0); PG8_MMA(0, 1, At, B1); PG8_BAR; PG8_SCHED;
            PG8_LDA(At, 1, 1); PG8_STAGE(PG8_SB(1, 0), b3, voffB); PG8_STAGE(PG8_SB(1, 1), b3 + hsB, voffB); PG8_STAGE_A(PG8_SA(1, 0), a3, k2 + kstep, o0);
            PG8_WAIT_V(8); PG8_WAIT_L(0); PG8_BAR; PG8_MMA(1, 0, At, B0); PG8_MMA(1, 1, At, B1); PG8_BAR; PG8_SCHED;
        }
        if (wr == 0) PG8_BAR;
        E(acc, cur, wr, wc, fr, fq);
        if (!has_next) break;
#pragma unroll
        for (int a = 0; a < 2; ++a)
#pragma unroll
            for (int b = 0; b < 2; ++b)
#pragma unroll
                for (int m = 0; m < 4; ++m)
#pragma unroll
                    for (int n = 0; n < 2; ++n) acc[a][b][m][n] = (f32x4){0.f, 0.f, 0.f, 0.f};
        cur = nxt; cA = nA; cB = nB; ++ui;
        if constexpr (GATHER) { cO0[0] = nO0[0]; cO0[1] = nO0[1]; cO1[0] = nO1[0]; cO1[1] = nO1[1]; }
        if (wr == 1) PG8_BAR;
    }
    PG8_WAIT_V(0);
    PG8_BAR;
#undef PG8_SA
#undef PG8_SB
#undef PG8_STAGE
#undef PG8_STAGE_A
#undef PG8_GOFF
#undef PG8_LDA
#undef PG8_LDB
#undef PG8_MMA
#undef PG8_WAIT_V
#undef PG8_WAIT_L
#undef PG8_BAR
#undef PG8_SCHED
}

struct EpiStore {
    bf16_t* O; int ldc; const float* ssq; float inv; float* ssq_out0; float* ssq_out1; int pn0, pn1, pn2;
    __device__ __forceinline__ void operator()(const f32x4 (&acc)[2][2][4][2], const Unit& u, int wr, int wc, int fr, int fq) const {
        const int row0 = u.pm * BM + wr * 64 + fr, col0 = u.pn * BM + wc * 32 + 8 * fq;
        float* so = (ssq_out0 && u.pn >= pn0 && u.pn < pn2) ? (u.pn < pn1 ? ssq_out0 : ssq_out1) : nullptr;
        float rsv[2][4];
#pragma unroll
        for (int ai = 0; ai < 2; ++ai)
#pragma unroll
            for (int m = 0; m < 4; ++m) rsv[ai][m] = ssq ? ssq[row0 + ai * HALF + m * 16] : 0.f;
#pragma unroll
        for (int ai = 0; ai < 2; ++ai)
#pragma unroll
            for (int m = 0; m < 4; ++m) { const int row = row0 + ai * HALF + m * 16; const float rs = ssq ? rsqrtf(rsv[ai][m] * inv + EPS) : 1.f;
                bf16_t* rowp = O + (size_t)row * ldc + col0; float ss = 0.f;
#pragma unroll
                for (int bj = 0; bj < 2; ++bj) { const f32x4 v0 = acc[ai][bj][m][0] * rs, v1 = acc[ai][bj][m][1] * rs;
                    ss += (v0[0] * v0[0] + v0[1] * v0[1]) + (v0[2] * v0[2] + v0[3] * v0[3]) + (v1[0] * v1[0] + v1[1] * v1[1]) + (v1[2] * v1[2] + v1[3] * v1[3]);
                    u32x4 w; w.x = cvt_pk_bf16(v0[0], v0[1]); w.y = cvt_pk_bf16(v0[2], v0[3]); w.z = cvt_pk_bf16(v1[0], v1[1]); w.w = cvt_pk_bf16(v1[2], v1[3]);
                    *(u32x4*)(rowp + bj * HALF) = w; }
                if (so) { ss += __shfl_xor(ss, 16); ss += __shfl_xor(ss, 32); if (fq == 0) atomicAdd(so + row, ss); } }
    }
};
struct EpiResid {
    const float* X; float* O; const float* gate; int gpitch;
    __device__ __forceinline__ void operator()(const f32x4 (&acc)[2][2][4][2], const Unit& u, int wr, int wc, int fr, int fq) const {
        const int row0 = u.pm * BM + wr * 64 + fr, col0 = u.pn * BM + wc * 32 + 8 * fq;
        const float* gp = gate + (size_t)((u.pm * BM) / SEQ) * gpitch + col0;
        f32x4 gv[2][2];
#pragma unroll
        for (int bj = 0; bj < 2; ++bj)
#pragma unroll
            for (int n = 0; n < 2; ++n) gv[bj][n] = *(const f32x4*)(gp + bj * HALF + 4 * n);
#pragma unroll
        for (int ai = 0; ai < 2; ++ai)
#pragma unroll
            for (int m = 0; m < 4; ++m) { const size_t off = (size_t)(row0 + ai * HALF + m * 16) * DM + col0;
#pragma unroll
                for (int bj = 0; bj < 2; ++bj)
#pragma unroll
                    for (int n = 0; n < 2; ++n) { const f32x4 xv = *(const f32x4*)(X + off + bj * HALF + 4 * n);
                        *(f32x4*)(O + off + bj * HALF + 4 * n) = xv + gv[bj][n] * acc[ai][bj][m][n]; } }
    }
};
struct EpiSwiGLU {
    bf16_t* O; unsigned* ready;
    __device__ __forceinline__ void operator()(const f32x4 (&acc)[2][2][4][2], const Unit& u, int wr, int wc, int fr, int fq) const {
        const int row0 = u.pm * BM + wr * 64 + fr, col0 = u.pn * HALF + wc * 32 + 8 * fq;
        const __amdgpu_buffer_rsrc_t rs = __builtin_amdgcn_make_buffer_rsrc((void*)O, (short)0, RMAX * DE * 2, 0x00020000);
#pragma unroll
        for (int ai = 0; ai < 2; ++ai)
#pragma unroll
            for (int m = 0; m < 4; ++m) { const int row = row0 + ai * HALF + m * 16;
                float h[8];
#pragma unroll
                for (int n = 0; n < 2; ++n)
#pragma unroll
                    for (int j = 0; j < 4; ++j) { const float gt = acc[ai][0][m][n][j], up = acc[ai][1][m][n][j]; h[4 * n + j] = gt / (1.f + __expf(-gt)) * up; }
                u32x4 w; w.x = cvt_pk_bf16(h[0], h[1]); w.y = cvt_pk_bf16(h[2], h[3]); w.z = cvt_pk_bf16(h[4], h[5]); w.w = cvt_pk_bf16(h[6], h[7]);
                __builtin_amdgcn_raw_buffer_store_b128(w, rs, (unsigned)(row * DE + col0) * 2u, 0, 16); }
        asm volatile("s_waitcnt vmcnt(0)" ::: "memory");
        if ((threadIdx.x & 63) == 0) __hip_atomic_fetch_add(ready + 64 * u.pm, 1u, __ATOMIC_RELAXED, __HIP_MEMORY_SCOPE_AGENT);
    }
};
}
constexpr size_t MiB = 1u << 20;
constexpr size_t WS_CTL = 0, CTL_ZERO_BYTES = 1 * MiB;
constexpr size_t WS_MOD = 1 * MiB;
constexpr size_t WS_ROPEC = 1 * MiB + 512 * 1024;
constexpr size_t WS_ROPES = WS_ROPEC + 2 * MiB;
constexpr size_t WS_WCT = WS_ROPES + 2 * MiB;
constexpr size_t WS_RSTDQ = 6 * MiB;
constexpr size_t WS_RSTDKV = WS_RSTDQ + 64 * 1024;
constexpr size_t WS_TOKE = WS_RSTDKV + 64 * 1024;
constexpr size_t WS_TOKW = WS_TOKE + 128 * 1024;
constexpr size_t WS_TOKS = WS_TOKW + 128 * 1024;
constexpr size_t WS_BLKE = WS_TOKS + 128 * 1024;
constexpr size_t WS_STAMP = WS_BLKE + 4096;
constexpr size_t WS_WIN = 8 * MiB;
constexpr size_t WS_WQUP = 28 * MiB;
constexpr size_t WS_WKVUP = WS_WQUP + 1536 * 1024;
constexpr size_t WS_WOUT = 31 * MiB;
constexpr size_t WS_A = 40 * MiB;
constexpr size_t WS_B = 200 * MiB;
constexpr size_t WS_C = 264 * MiB;
constexpr size_t WS_D = 328 * MiB;
constexpr size_t WS_E = 456 * MiB;
constexpr size_t WS_LIST = 520 * MiB;
constexpr size_t WS_F = 522 * MiB;
constexpr size_t WS_END = 586 * MiB;
constexpr size_t QN_BYTES = (size_t)T * MH * MQK * 2;

constexpr int CW_BAR = 4096;
constexpr int CW_CNT = 8192;
constexpr int CW_RDY = 10240;
constexpr int CW_TMO = 1;

constexpr int RING_BYTES = 131072, LDS_BYTES = 147456, LDS_USER = 143360, MISC_OFF = LDS_BYTES - 512;

struct Args { const float* in[25]; float* out; unsigned char* ws; int ph_lo, ph_hi, pad0, pad1; };

struct Frame {
    LAS unsigned char* lds;
    volatile LAS unsigned* MISC;
    gu32* ctl;
    int tid, lane, wave, vcu, G;
    unsigned char* ws; float* out;
};

#define OPAQUE_FRAME(F) do { F.tid = threadIdx.x; asm volatile("" : "+v"(F.tid)); F.lane = F.tid & 63; } while (0)

__device__ __forceinline__ void unpack8(const u32x4 w, float* f) { f[0] = bf_lo(w.x); f[1] = bf_hi(w.x); f[2] = bf_lo(w.y); f[3] = bf_hi(w.y); f[4] = bf_lo(w.z); f[5] = bf_hi(w.z); f[6] = bf_lo(w.w); f[7] = bf_hi(w.w); }
__device__ __forceinline__ u32x4 pack8f(const float* f) { u32x4 w; w.x = cvt_pk_bf16(f[0], f[1]); w.y = cvt_pk_bf16(f[2], f[3]); w.z = cvt_pk_bf16(f[4], f[5]); w.w = cvt_pk_bf16(f[6], f[7]); return w; }

struct TrItem { const float* src; bf16_t* dst; bf16_t* dst2; const float* gk; int N, ldt; };
__device__ __forceinline__ void tr_load(const TrItem& it, f32x4 (&r)[16], int lane) {
    const float* p = it.src + (size_t)(lane >> 4) * it.N + 4 * (lane & 15);
#pragma unroll
    for (int i = 0; i < 16; ++i) r[i] = __builtin_nontemporal_load((const f32x4*)(p + (size_t)(4 * i) * it.N));
}
__device__ __forceinline__ void tr_store(const TrItem& it, const f32x4 (&r)[16], LAS unsigned char* Tl, int lane) {
    const int row = lane >> 4, c4 = lane & 15;
#pragma unroll
    for (int i = 0; i < 16; ++i) { f32x4 v = r[i]; if (it.gk) v = v * it.gk[4 * i + row];
        u32x2 w; w.x = cvt_pk_bf16(v.x, v.y); w.y = cvt_pk_bf16(v.z, v.w);
        *(LAS u32x2*)(Tl + ((4 * i + row) * 64 + 4 * c4) * 2) = w; }
    LDS_WAIT(); asm volatile("" ::: "memory");
    const int g = lane >> 4, i16 = lane & 15, q = i16 >> 2, pp = lane & 3;
    typedef short v4i16_t __attribute__((ext_vector_type(4)));
#pragma unroll
    for (int hh = 0; hh < 2; ++hh) { bf16_t* drow = (hh ? it.dst2 : it.dst) + (size_t)(16 * (g & 1) + i16) * it.ldt;
#pragma unroll
        for (int j = 0; j < 4; ++j) { const int kc = 4 * (g >> 1) + j;
            const v4i16_t lo = __builtin_amdgcn_ds_read_tr16_b64_v4i16((LAS v4i16_t*)(Tl + ((8 * kc + q) * 64 + 32 * hh + 16 * (g & 1) + 4 * pp) * 2));
            const v4i16_t hi = __builtin_amdgcn_ds_read_tr16_b64_v4i16((LAS v4i16_t*)(Tl + ((8 * kc + 4 + q) * 64 + 32 * hh + 16 * (g & 1) + 4 * pp) * 2));
            const bf16x8 o = {lo[0], lo[1], lo[2], lo[3], hi[0], hi[1], hi[2], hi[3]};
            *(bf16x8*)(drow + 8 * kc) = o; } }
    LDS_WAIT(); asm volatile("" ::: "memory");
}
template <class MK> __device__ __forceinline__ void tr_run(int first, int step, int n, const MK& mk, LAS unsigned char* Tl, int lane) {
    if (first >= n) return;
    f32x4 ra[16], rb[16];
    TrItem ia = mk(first), ib = ia;
    tr_load(ia, ra, lane);
    for (int idx = first; idx < n; idx += 2 * step) {
        if (idx + step < n) { ib = mk(idx + step); tr_load(ib, rb, lane); }
        tr_store(ia, ra, Tl, lane);
        if (idx + step >= n) break;
        if (idx + 2 * step < n) { ia = mk(idx + 2 * step); tr_load(ia, ra, lane); }
        tr_store(ib, rb, Tl, lane);
    }
}

__device__ __forceinline__ void adaln_phase(Frame& F, const float* c, const float* w_ada, const float* b_ada, float* mod) {
    LAS float* cact = (LAS float*)F.lds;
    LAS float* part = (LAS float*)(F.lds + 65536);
    for (int i = F.tid; i < NB * DM; i += NTHR) cact[i] = siluf(c[i]);
    __syncthreads();
    const int cg = F.tid & 7, rs = F.tid >> 3;
    for (int it = blockIdx.x; it < 6 * DM / 32; it += F.G) {
        const int n0 = it * 32 + cg * 4;
        f32x4 acc[8];
#pragma unroll
        for (int b = 0; b < 8; ++b) acc[b] = (f32x4){0.f, 0.f, 0.f, 0.f};
#pragma unroll 1
        for (int i0 = 0; i0 < 32; i0 += 16) { f32x4 w[16];
#pragma unroll
            for (int u = 0; u < 16; ++u) w[u] = __builtin_nontemporal_load((const f32x4*)(w_ada + (size_t)(rs + 64 * (i0 + u)) * (6 * DM) + n0));
#pragma unroll
            for (int u = 0; u < 16; ++u) { const int k = rs + 64 * (i0 + u);
#pragma unroll
                for (int b = 0; b < 8; ++b) acc[b] += w[u] * cact[b * DM + k]; } }
#pragma unroll
        for (int b = 0; b < 8; ++b) *(LAS f32x4*)(part + (rs * 8 + b) * 32 + cg * 4) = acc[b];
        __syncthreads();
        if (F.tid < 256) { const int b = F.tid >> 5, n = F.tid & 31; float s = 0.f;
#pragma unroll 8
            for (int r = 0; r < 64; ++r) s += part[(r * 8 + b) * 32 + n];
            mod[b * (6 * DM) + it * 32 + n] = s + b_ada[it * 32 + n]; }
        __syncthreads();
    }
}

__device__ __forceinline__ void p0_phase(Frame& F, const Args& a) {
    OPAQUE_FRAME(F);
    unsigned char* ws = F.ws;
    adaln_phase(F, a.in[1], a.in[3], a.in[4], (float*)(ws + WS_MOD));
    __syncthreads();
    LAS unsigned char* Tl = F.lds + F.wave * 8192;
    const int gw = F.vcu * NWAVES + F.wave, NGW = F.G * NWAVES;
    constexpr int I_IN = (DM / 64) * (INC / 64), I_QUP = (QLORA / 64) * (MH * MQK / 64), I_KVUP = (KVLORA / 64) * (MH * 256 / 64), I_OUT = (DM / 64) * (DM / 64);
    constexpr int NITEMS = I_IN + I_QUP + I_KVUP + I_OUT;
    static_assert(INC % 64 == 0, "64-column transpose items");
    { const float* w_in = a.in[6]; const float* w_qup = a.in[10]; const float* w_kvup = a.in[12]; const float* w_out = a.in[16]; const float* gq = a.in[9]; const float* gkv = a.in[11];
      auto mk = [=](int r) -> TrItem { TrItem t;
          if (r < I_IN) { const int nblk = INC / 64, kb = r / nblk, nb = r % nblk; t.src = w_in + (size_t)(64 * kb) * INC + 64 * nb; t.dst = (bf16_t*)(ws + WS_WIN) + (size_t)(64 * nb) * DM + 64 * kb; t.dst2 = t.dst + (size_t)32 * DM; t.gk = nullptr; t.N = INC; t.ldt = DM; return t; } r -= I_IN;
          if (r < I_QUP) { const int nblk = MH * MQK / 64, kb = r / nblk, nb = r % nblk; t.src = w_qup + (size_t)(64 * kb) * (MH * MQK) + 64 * nb; t.dst = (bf16_t*)(ws + WS_WQUP) + (size_t)(64 * nb) * QLORA + 64 * kb; t.dst2 = t.dst + (size_t)32 * QLORA; t.gk = gq + 64 * kb; t.N = MH * MQK; t.ldt = QLORA; return t; } r -= I_QUP;
          if (r < I_KVUP) { const int nblk = MH * 256 / 64, kb = r / nblk, nb = r % nblk; t.src = w_kvup + (size_t)(64 * kb) * (MH * 256) + 64 * nb; t.dst = (bf16_t*)(ws + WS_WKVUP) + (size_t)(64 * nb) * KVLORA + 64 * kb; t.dst2 = t.dst + (size_t)32 * KVLORA; t.gk = gkv + 64 * kb; t.N = MH * 256; t.ldt = KVLORA; return t; } r -= I_KVUP;
          { const int nblk = DM / 64, kb = r / nblk, nb = r % nblk; t.src = w_out + (size_t)(64 * kb) * DM + 64 * nb; t.dst = (bf16_t*)(ws + WS_WOUT) + (size_t)(64 * nb) * DM + 64 * kb; t.dst2 = t.dst + (size_t)32 * DM; t.gk = nullptr; t.N = DM; t.ldt = DM; return t; } };
      const int nheavy = (6 * DM / 32) - F.G, nlw = (F.G - nheavy) * NWAVES;
      int pre = 0;
      if (nheavy > 0 && nheavy < F.G) { pre = 2 * nlw < NITEMS ? 2 * nlw : NITEMS;
          if ((int)blockIdx.x >= nheavy) tr_run(((int)blockIdx.x - nheavy) * NWAVES + F.wave, nlw, pre, mk, Tl, F.lane); }
      tr_run(pre + gw, NGW, NITEMS, mk, Tl, F.lane); }
    { const int* pos = (const int*)a.in[2]; float* rc = (float*)(ws + WS_ROPEC); float* rsn = (float*)(ws + WS_ROPES);
      const int gt = F.vcu * NTHR + F.tid, NGT = F.G * NTHR;
      const float invf = (float)exp2(-(double)(gt & 31) * (13.287712379549449 / 32.0));
      for (int e = gt; e < T * 32; e += NGT) { const int tk = e >> 5;
          const float ang = (float)pos[tk] * invf; float sv, cv; sincosf(ang, &sv, &cv);
          rc[e] = cv; rsn[e] = sv; }
      { float* ssq = (float*)(ws + WS_RSTDQ); for (int e = gt; e < 2 * T; e += NGT) ssq[e] = 0.f; }
      float* wct = (float*)(ws + WS_WCT);
      for (int e = gt; e < 48 * DM; e += NGT) { const int n = e / DM, k = e % DM;
          wct[e] = n < 4 ? a.in[18][k * NG + n] : (n < 36 ? a.in[20][k * NE + (n - 4)] : 0.f); } }
}

__device__ __forceinline__ void p1_phase(Frame& F, const Args& a) {
    OPAQUE_FRAME(F);
    const int gw = F.vcu * NWAVES + F.wave, NGW = F.G * NWAVES;
    const float* mod = (const float*)(F.ws + WS_MOD); const float* g = a.in[5]; const float* x = a.in[0];
    bf16_t* H = (bf16_t*)(F.ws + WS_B);
    for (int blk = gw; blk < T / 8; blk += NGW) { const int m0 = blk * 8, b = m0 / SEQ;
        const float* shift = mod + b * (6 * DM); const float* scale = shift + DM;
        f32x4 gm[8], sh[8];
#pragma unroll
        for (int j = 0; j < 8; ++j) { gm[j] = ((const f32x4*)g)[64 * j + F.lane] * (((const f32x4*)scale)[64 * j + F.lane] + 1.f); sh[j] = ((const f32x4*)shift)[64 * j + F.lane]; }
        f32x4 va[8], vb[8];
#define P1_LD(r, V) do { const f32x4* xr_ = (const f32x4*)(x + (size_t)(m0 + (r)) * DM) + F.lane; _Pragma("unroll") for (int j = 0; j < 8; ++j) V[j] = __builtin_nontemporal_load(xr_ + 64 * j); } while (0)
#define P1_ST(r, V) do { float s_ = 0.f; _Pragma("unroll") for (int j = 0; j < 8; ++j) s_ += (V[j].x * V[j].x + V[j].y * V[j].y) + (V[j].z * V[j].z + V[j].w * V[j].w); \
            const float rstd_ = rsqrtf(wave_sum(s_) * (1.f / DM) + EPS); u32x2* o8_ = (u32x2*)(H + (size_t)(m0 + (r)) * DM) + F.lane; \
            _Pragma("unroll") for (int j = 0; j < 8; ++j) { const f32x4 h_ = V[j] * rstd_ * gm[j] + sh[j]; u32x2 w_; w_.x = cvt_pk_bf16(h_.x, h_.y); w_.y = cvt_pk_bf16(h_.z, h_.w); o8_[64 * j] = w_; } } while (0)
        P1_LD(0, va);
#pragma unroll 1
        for (int r = 0; r < 8; r += 2) {
            P1_LD(r + 1, vb); __builtin_amdgcn_sched_barrier(0);
            P1_ST(r, va); __builtin_amdgcn_sched_barrier(0);
            if (r + 2 < 8) { P1_LD(r + 2, va); } __builtin_amdgcn_sched_barrier(0);
            P1_ST(r + 1, vb); __builtin_amdgcn_sched_barrier(0);
        }
#undef P1_LD
#undef P1_ST
    }
}

namespace hg {
constexpr int OFF_F = 0, OFF_SEG = 32768, OFF_QIN = 34816, RP = 272, OFF_KIN = OFF_QIN + 64 * RP, OFF_QB = OFF_KIN + 64 * RP, OFF_KLT = OFF_QB + 64 * RP, SP = 144,
              OFF_VT = OFF_KLT + 128 * SP  , OFF_DEC = OFF_VT + 64 * SP  , OFF_SF = OFF_DEC + 3584  , HG_LDS = OFF_SF + 16384;
static_assert(HG_LDS <= LDS_USER, "hgrn lds");
__device__ __forceinline__ int ppos(int s) { return (s & ~15) | ((s & 4) << 1) | ((s & 8) >> 1) | (s & 3); }
}
__device__ __forceinline__ void hgrn_chunked(Frame& F, const Args& a, int item) {
    using namespace hg;
    const bf16_t* PROJ = (const bf16_t*)(F.ws + WS_A);
    bf16_t* MIX = (bf16_t*)F.out;
    const float* lbl = a.in[7];
    LAS unsigned char* L = F.lds;
    LAS float* Fs = (LAS float*)(L + OFF_F); LAS float* SEGs = (LAS float*)(L + OFF_SEG); LAS float* DEC = (LAS float*)(L + OFF_DEC); LAS float* POST = DEC + 384;
    const int g = F.tid & 15, t0 = F.tid >> 4;
    const int sk = F.tid & 127, sseg = F.tid >> 7;
    const int r32 = F.lane & 31, hi = F.lane >> 5;
    {
        const int dq2 = (item >> 3) & 1, bh = (item >> 4) * 8 + (item & 7), h = bh & 7, b = bh >> 3;
        float lb[8];
#pragma unroll
        for (int j = 0; j < 8; ++j) { const int k = h * 128 + g * 8 + j; lb[j] = 1.f / (1.f + __expf(lbl[HW + k] - lbl[k])); }
        const bf16_t* base = PROJ + (size_t)(b * SEQ) * INCP + h * 128;
        f32x16 S0 = {}, S1 = {};
        u32x4 gq[2], gf[2], gv;
#define HG_LOADF(c) do { _Pragma("unroll") for (int i = 0; i < 2; ++i) gf[i] = *(const u32x4*)(base + (size_t)((c) * 64 + t0 + 32 * i) * INCP + g * 8 + HW); } while (0)
#define HG_LOADQ(c) do { _Pragma("unroll") for (int i = 0; i < 2; ++i) gq[i] = *(const u32x4*)(base + (size_t)((c) * 64 + t0 + 32 * i) * INCP + g * 8); \
            gv = *(const u32x4*)(base + (size_t)((c) * 64 + (F.tid >> 3)) * INCP + 2 * HW + dq2 * 64 + (F.tid & 7) * 8); } while (0)
        HG_LOADF(0); HG_LOADQ(0);
        for (int c = 0; c < SEQ / 64; ++c) {
            if (F.wave >= 4) { const int kb = F.wave - 4;
#pragma unroll
                for (int s2 = 0; s2 < 2; ++s2) { u32x4 w0, w1;
                    w0.x = cvt_pk_bf16(S0[8 * s2], S0[8 * s2 + 1]); w0.y = cvt_pk_bf16(S0[8 * s2 + 2], S0[8 * s2 + 3]); w0.z = cvt_pk_bf16(S0[8 * s2 + 4], S0[8 * s2 + 5]); w0.w = cvt_pk_bf16(S0[8 * s2 + 6], S0[8 * s2 + 7]);
                    w1.x = cvt_pk_bf16(S1[8 * s2], S1[8 * s2 + 1]); w1.y = cvt_pk_bf16(S1[8 * s2 + 2], S1[8 * s2 + 3]); w1.z = cvt_pk_bf16(S1[8 * s2 + 4], S1[8 * s2 + 5]); w1.w = cvt_pk_bf16(S1[8 * s2 + 6], S1[8 * s2 + 7]);
                    *(LAS u32x4*)(L + OFF_SF + ((((kb * 2 + 0) * 2 + s2) * 64) + F.lane) * 16) = w0;
                    *(LAS u32x4*)(L + OFF_SF + ((((kb * 2 + 1) * 2 + s2) * 64) + F.lane) * 16) = w1; } }
            float fv[2][8];
#pragma unroll
            for (int i = 0; i < 2; ++i) { float fl[8]; unpack8(gf[i], fl);
#pragma unroll
                for (int j = 0; j < 8; ++j) { const float sg = __builtin_amdgcn_rcpf(1.f + __builtin_amdgcn_exp2f(-1.4426950408889634f * fl[j])); fv[i][j] = lb[j] + (1.f - lb[j]) * sg; }
                LAS float* fp = Fs + (t0 + 32 * i) * 128 + g * 8;
                *(LAS f32x4*)fp = (f32x4){fv[i][0], fv[i][1], fv[i][2], fv[i][3]}; *(LAS f32x4*)(fp + 4) = (f32x4){fv[i][4], fv[i][5], fv[i][6], fv[i][7]}; }
            if (c + 1 < SEQ / 64) HG_LOADF(c + 1);
            __syncthreads();
            float klp[16];
            { float fr[16];
#pragma unroll
              for (int i = 0; i < 16; ++i) fr[i] = Fs[(16 * sseg + i) * 128 + sk];
              float p = 1.f;
#pragma unroll
              for (int i = 0; i < 16; ++i) { p *= fr[i]; Fs[(16 * sseg + i) * 128 + sk] = p; }
              SEGs[sseg * 128 + sk] = p;
              float q = 1.f;
#pragma unroll
              for (int i = 15; i >= 0; --i) { klp[i] = (1.f - fr[i]) * q; q *= fr[i]; } }
            __syncthreads();
            if (F.tid < 128) { const float s0 = SEGs[F.tid], s1 = SEGs[128 + F.tid], s2 = SEGs[256 + F.tid], s3 = SEGs[384 + F.tid];
                const float pm = s0 * s1;
                SEGs[F.tid] = 1.f; SEGs[128 + F.tid] = s0; SEGs[256 + F.tid] = pm; SEGs[384 + F.tid] = pm * s2;
                POST[F.tid] = s1 * s2 * s3; POST[128 + F.tid] = s2 * s3; POST[256 + F.tid] = s3; POST[384 + F.tid] = 1.f;
                DEC[F.tid] = pm * s2 * s3; DEC[128 + F.tid] = pm; DEC[256 + F.tid] = __builtin_amdgcn_rcpf(pm); }
            __syncthreads();
            { { const float po = POST[sseg * 128 + sk];
                float o16[16];
#pragma unroll
                for (int p = 0; p < 16; ++p) o16[p] = klp[8 * ((p >> 2) & 1) + 4 * (p >> 3) + (p & 3)] * po;
                *(LAS u32x4*)(L + OFF_KLT + sk * SP + sseg * 32) = pack8f(o16); *(LAS u32x4*)(L + OFF_KLT + sk * SP + sseg * 32 + 16) = pack8f(o16 + 8); }
#pragma unroll
              for (int i = 0; i < 2; ++i) { const int t = t0 + 32 * i;
                  float qin[8], kin[8], qb[8], qv[8];
                  unpack8(gq[i], qv);
                  const LAS float* fp = Fs + t * 128 + g * 8; const LAS float* pp = SEGs + (t >> 4) * 128 + g * 8;
                  const f32x4 pa = *(const LAS f32x4*)fp, pb = *(const LAS f32x4*)(fp + 4), ea = *(const LAS f32x4*)pp, eb = *(const LAS f32x4*)(pp + 4);
                  const f32x4 ma = *(const LAS f32x4*)(DEC + 128 + g * 8), mb = *(const LAS f32x4*)(DEC + 128 + g * 8 + 4), ra = *(const LAS f32x4*)(DEC + 256 + g * 8), rb = *(const LAS f32x4*)(DEC + 256 + g * 8 + 4);
#pragma unroll
                  for (int j = 0; j < 8; ++j) { const float P = (j < 4 ? pa[j] * ea[j] : pb[j - 4] * eb[j - 4]), pm = j < 4 ? ma[j] : mb[j - 4], rpm = j < 4 ? ra[j] : rb[j - 4];
                      const float r = __builtin_amdgcn_rcpf(P), kk = 1.f - fv[i][j], qs = qv[j] * 0.08838834764831845f;
                      qb[j] = qs * P; qin[j] = qb[j] * rpm; kin[j] = kk * pm * r; }
                  *(LAS u32x4*)(L + OFF_QIN + t * RP + g * 16) = pack8f(qin);
                  *(LAS u32x4*)(L + OFF_KIN + t * RP + g * 16) = pack8f(kin);
                  { const u32x4 w = pack8f(qb);
                    *(LAS u32x2*)(L + OFF_QB + t * RP + ((g >> 1) * 16 + (g & 1) * 4) * 2) = (u32x2){w.x, w.y};
                    *(LAS u32x2*)(L + OFF_QB + t * RP + ((g >> 1) * 16 + 8 + (g & 1) * 4) * 2) = (u32x2){w.z, w.w}; } }
              { float v[8]; unpack8(gv, v); const int s = F.tid >> 3, dvg = F.tid & 7, ps = ppos(s);
#pragma unroll
                  for (int j = 0; j < 8; ++j) *(LAS bf16_t*)(L + OFF_VT + (dvg * 8 + j) * SP + ps * 2) = (bf16_t)(__builtin_bit_cast(unsigned, v[j]) >> 16); } }
            if (c + 1 < SEQ / 64) HG_LOADQ(c + 1);
            __syncthreads();
            if (F.wave < 4) { const int tb = F.wave & 1, dvb = F.wave >> 1;
                f32x16 o = {};
                for (int sb = 0; sb <= tb; ++sb) { f32x16 X = {};
#pragma unroll
                    for (int ks = 0; ks < 8; ++ks) { const bf16x8 af = *(const LAS bf16x8*)(L + OFF_KIN + (32 * sb + r32) * RP + (16 * ks + 8 * hi) * 2);
                        const bf16x8 bfr = *(const LAS bf16x8*)(L + OFF_QIN + (32 * tb + r32) * RP + (16 * ks + 8 * hi) * 2);
                        X = __builtin_amdgcn_mfma_f32_32x32x16_bf16(af, bfr, X, 0, 0, 0); }
                    if (sb == tb) {
#pragma unroll
                        for (int r = 0; r < 16; ++r) { const int srow = (r & 3) + 8 * (r >> 2) + 4 * hi; if (srow > r32) X[r] = 0.f; } }
#pragma unroll
                    for (int s2 = 0; s2 < 2; ++s2) { u32x4 w; w.x = cvt_pk_bf16(X[8 * s2], X[8 * s2 + 1]); w.y = cvt_pk_bf16(X[8 * s2 + 2], X[8 * s2 + 3]); w.z = cvt_pk_bf16(X[8 * s2 + 4], X[8 * s2 + 5]); w.w = cvt_pk_bf16(X[8 * s2 + 6], X[8 * s2 + 7]);
                        const bf16x8 vf = *(const LAS bf16x8*)(L + OFF_VT + (32 * dvb + r32) * SP + (32 * sb + 16 * s2 + 8 * hi) * 2);
                        o = __builtin_amdgcn_mfma_f32_32x32x16_bf16(__builtin_bit_cast(bf16x8, w), vf, o, 0, 0, 0); } }
#pragma unroll
                for (int kb = 0; kb < 4; ++kb)
#pragma unroll
                    for (int s2 = 0; s2 < 2; ++s2) { const bf16x8 sf = *(const LAS bf16x8*)(L + OFF_SF + ((((kb * 2 + dvb) * 2 + s2) * 64) + F.lane) * 16);
                        const bf16x8 qf = *(const LAS bf16x8*)(L + OFF_QB + (32 * tb + r32) * RP + (32 * kb + 16 * s2 + 8 * hi) * 2);
                        o = __builtin_amdgcn_mfma_f32_32x32x16_bf16(qf, sf, o, 0, 0, 0); }
                bf16_t* orow = MIX + (size_t)(b * SEQ + c * 64 + 32 * tb) * DM + h * 128 + dq2 * 64 + dvb * 32 + r32;
#pragma unroll
                for (int r = 0; r < 16; ++r) { const float v = o[r]; const float vn = __shfl_xor(v, 1);
                    if ((r32 & 1) == 0) *(unsigned*)(orow + (size_t)((r & 3) + 8 * (r >> 2) + 4 * hi) * DM) = cvt_pk_bf16(v, vn); }
            } else { const int kb = F.wave - 4;
#pragma unroll
                for (int r = 0; r < 16; ++r) { const float dcy = DEC[32 * kb + (r & 3) + 8 * (r >> 2) + 4 * hi]; S0[r] *= dcy; S1[r] *= dcy; }
#pragma unroll
                for (int ss = 0; ss < 4; ++ss) { const bf16x8 kf = *(const LAS bf16x8*)(L + OFF_KLT + (32 * kb + r32) * SP + (16 * ss + 8 * hi) * 2);
                    const bf16x8 vf0 = *(const LAS bf16x8*)(L + OFF_VT + r32 * SP + (16 * ss + 8 * hi) * 2), vf1 = *(const LAS bf16x8*)(L + OFF_VT + (32 + r32) * SP + (16 * ss + 8 * hi) * 2);
                    S0 = __builtin_amdgcn_mfma_f32_32x32x16_bf16(kf, vf0, S0, 0, 0, 0); S1 = __builtin_amdgcn_mfma_f32_32x32x16_bf16(kf, vf1, S1, 0, 0, 0); }
            }
            __syncthreads();
        }
#undef HG_LOADF
#undef HG_LOADQ
    }
}

constexpr int MOE_IG = NE * (DM / 64) * (DE / 64);
constexpr int MOE_PRE = 9216;
struct MoeItems { const float* wg; const float* wu; const float* wd; unsigned char* ws;
    __device__ TrItem operator()(int it) const { TrItem t; t.gk = nullptr;
        const int which = it / MOE_IG, r = it % MOE_IG;
        if (which < 2) { const int e = r / 256, q = r % 256, kb = q / 8, nb = q % 8, n0 = 64 * nb;
            t.src = (which ? wu : wg) + (size_t)e * DM * DE + (size_t)(64 * kb) * DE + n0;
            t.dst = (bf16_t*)(ws + WS_D) + ((size_t)e * 1024 + (n0 >> 7) * 256 + (n0 & 127) + which * 128) * DM + 64 * kb; t.dst2 = t.dst + (size_t)32 * DM; t.N = DE; t.ldt = DM; }
        else { const int e = r / 256, q = r % 256, kb = q / 32, nb = q % 32, n0 = 64 * nb;
            t.src = wd + (size_t)e * DE * DM + (size_t)(64 * kb) * DM + n0;
            t.dst = (bf16_t*)(ws + WS_E) + ((size_t)e * DM + n0) * DE + 64 * kb; t.dst2 = t.dst + (size_t)32 * DE; t.N = DM; t.ldt = DE; }
        return t; } };

__device__ __forceinline__ void p3_phase(Frame& F, const Args& a) {
    OPAQUE_FRAME(F);
    const int role = ((int)blockIdx.x >> 3) & 1, idx = ((int)blockIdx.x >> 4) * 8 + ((int)blockIdx.x & 7), half = F.G >> 1;
    unsigned char* ws = F.ws;
    if (role == 0) { for (int it = idx; it < NB * HH * 2; it += half) hgrn_chunked(F, a, it); }
    else {
        { pg8::Gemm g{(const bf16_t*)(ws + WS_A) + C_QA, (const bf16_t*)(ws + WS_WQUP), INCP, QLORA, QLORA};
          pg8::DenseOrder S; S.init(T / 256, MH * MQK / 256, half, idx);
          pg8::EpiStore E{(bf16_t*)(ws + WS_B), MH * MQK, (const float*)(ws + WS_RSTDQ), 1.f / QLORA};
          pg8::gemm_phase<pg8::EpiStore, pg8::DenseOrder>(F.lds, g, S, E); }
        { pg8::Gemm g{(const bf16_t*)(ws + WS_A) + C_KVA, (const bf16_t*)(ws + WS_WKVUP), INCP, KVLORA, KVLORA};
          pg8::DenseOrder S; S.init(T / 256, MH * 256 / 256, half, idx);
          pg8::EpiStore E{(bf16_t*)(ws + WS_C), MH * 256, (const float*)(ws + WS_RSTDKV), 1.f / KVLORA};
          pg8::gemm_phase<pg8::EpiStore, pg8::DenseOrder>(F.lds, g, S, E); }
        { const MoeItems mk{a.in[22], a.in[23], a.in[24], ws};
          tr_run(idx * NWAVES + F.wave, half * NWAVES, MOE_PRE, mk, F.lds + F.wave * 8192, F.lane); }
    }
}

__device__ __forceinline__ float sum8(float v) { v += __shfl_xor(v, 1); v += __shfl_xor(v, 2); v += __shfl_xor(v, 4); return v; }

struct P5Set { u32x4 k0, k1, kpe, m0, m1, g0, g1; f32x4 ca, cb, sa, sb; };
__device__ __forceinline__ void p5_phase(Frame& F, const Args& a) {
    OPAQUE_FRAME(F);
    const int gw = F.vcu * NWAVES + F.wave, NGW = F.G * NWAVES;
    const bf16_t* PROJ = (const bf16_t*)(F.ws + WS_A);
    const bf16_t* KV = (const bf16_t*)(F.ws + WS_C);
    bf16_t* Kn = (bf16_t*)(F.ws + WS_F);
    bf16_t* MIX = (bf16_t*)F.out;
    const float* rc = (const float*)(F.ws + WS_ROPEC); const float* rsn = (const float*)(F.ws + WS_ROPES);
    const int h = F.lane >> 3, sub = F.lane & 7;
    const float sgn = sub < 4 ? -1.f : 1.f;
    float gk[3][8], go[2][8];
#pragma unroll
    for (int i = 0; i < 3; ++i)
#pragma unroll
        for (int j = 0; j < 8; ++j) gk[i][j] = a.in[14][(sub + 8 * i) * 8 + j];
#pragma unroll
    for (int i = 0; i < 2; ++i)
#pragma unroll
        for (int j = 0; j < 8; ++j) go[i][j] = a.in[8][(sub + 8 * i) * 8 + j];
#define P5_LD(t_, S_) do { const size_t t__ = (size_t)(t_); const int ii_ = (sub & 3) * 8; \
        S_.k0 = __builtin_nontemporal_load((const u32x4*)(KV + t__ * (MH * 256) + h * 256 + sub * 8)); S_.k1 = __builtin_nontemporal_load((const u32x4*)(KV + t__ * (MH * 256) + h * 256 + (sub + 8) * 8)); \
        S_.kpe = *(const u32x4*)(PROJ + t__ * INCP + C_KPE + sub * 8); \
        S_.ca = *(const f32x4*)(rc + t__ * 32 + ii_); S_.cb = *(const f32x4*)(rc + t__ * 32 + ii_ + 4); S_.sa = *(const f32x4*)(rsn + t__ * 32 + ii_); S_.sb = *(const f32x4*)(rsn + t__ * 32 + ii_ + 4); \
        S_.m0 = *(const u32x4*)(MIX + t__ * DM + h * 128 + sub * 8); S_.m1 = *(const u32x4*)(MIX + t__ * DM + h * 128 + (sub + 8) * 8); \
        S_.g0 = __builtin_nontemporal_load((const u32x4*)(PROJ + t__ * INCP + 3 * HW + h * 128 + sub * 8)); S_.g1 = __builtin_nontemporal_load((const u32x4*)(PROJ + t__ * INCP + 3 * HW + h * 128 + (sub + 8) * 8)); } while (0)
#define P5_CP(t_, S_) do { const int t__ = (t_), b_ = t__ / SEQ, s_ = t__ % SEQ; const size_t hrow = ((size_t)(b_ * MH + h) * SEQ + s_); \
        { float k[3][8]; float ss = 0.f; unpack8(S_.k0, k[0]); unpack8(S_.k1, k[1]); unpack8(S_.kpe, k[2]); \
          _Pragma("unroll") for (int i = 0; i < 3; ++i) _Pragma("unroll") for (int j = 0; j < 8; ++j) ss += k[i][j] * k[i][j]; \
          const float rs = rsqrtf(sum8(ss) * (1.f / MQK) + EPS); \
          _Pragma("unroll") for (int i = 0; i < 3; ++i) _Pragma("unroll") for (int j = 0; j < 8; ++j) k[i][j] *= rs * gk[i][j]; \
          _Pragma("unroll") for (int j = 0; j < 8; ++j) { const float pv = __shfl_xor(k[2][j], 4); const float cs_ = j < 4 ? S_.ca[j & 3] : S_.cb[j & 3], sn_ = j < 4 ? S_.sa[j & 3] : S_.sb[j & 3]; k[2][j] = k[2][j] * cs_ + sgn * pv * sn_; } \
          _Pragma("unroll") for (int i = 0; i < 3; ++i) *(u32x4*)(Kn + hrow * MQK + (sub + 8 * i) * 8) = pack8f(k[i]); } \
        { float o[2][8], gt[2][8]; float ss = 0.f; unpack8(S_.m0, o[0]); unpack8(S_.m1, o[1]); unpack8(S_.g0, gt[0]); unpack8(S_.g1, gt[1]); \
          _Pragma("unroll") for (int i = 0; i < 2; ++i) _Pragma("unroll") for (int j = 0; j < 8; ++j) ss += o[i][j] * o[i][j]; \
          const float rs = rsqrtf(sum8(ss) * (1.f / HDV) + EPS); \
          _Pragma("unroll") for (int i = 0; i < 2; ++i) { _Pragma("unroll") for (int j = 0; j < 8; ++j) o[i][j] = o[i][j] * rs * go[i][j] * siluf(gt[i][j]); \
              *(u32x4*)(MIX + (size_t)t__ * DM + h * 128 + (sub + 8 * i) * 8) = pack8f(o[i]); } } } while (0)
    for (int blk = gw; blk < T / 8; blk += NGW) { const int t0 = blk * 8;
        P5Set A, B;
        P5_LD(t0, A);
#pragma unroll 1
        for (int r = 0; r < 8; r += 2) {
            P5_LD(t0 + r + 1, B); __builtin_amdgcn_sched_barrier(0);
            P5_CP(t0 + r, A); __builtin_amdgcn_sched_barrier(0);
            if (r + 2 < 8) { P5_LD(t0 + r + 2, A); } __builtin_amdgcn_sched_barrier(0);
            P5_CP(t0 + r + 1, B); __builtin_amdgcn_sched_barrier(0);
        }
    }
#undef P5_LD
#undef P5_CP
}
namespace att {
constexpr int QBLK = 32, KVBLK = 64, QB = 256;
constexpr int KROW = 512, SHM_K = KVBLK * KROW, SHM_V = KVBLK * MV * 2;
constexpr int OFF_V = 0, OFF_K = 2 * SHM_V, OFF_WS = OFF_K + 2 * SHM_K;
constexpr float SCALE = 0.07216878364870322f;
constexpr float THR = 8.f;
#define SBAR() __builtin_amdgcn_sched_barrier(0)
__device__ __forceinline__ int v_st(int k, int c) { const int kk = (k & ~0xC) | ((k & 4) << 1) | ((k & 8) >> 1); return ((kk >> 3) * 4 + (c >> 5)) * 512 + ((kk & 7) * 32 + (c & 31)) * 2; }
__device__ __forceinline__ int v_rd_base(int lane) { return ((lane & 3) << 3) | (((lane >> 2) & 3) << 6) | (((lane >> 4) & 1) << 5) | (((lane >> 5) & 1) << 8); }
constexpr int v_rd_off(int d0, int ks, int half) { return d0 * 512 + ks * 4096 + half * 2048; }
__device__ __forceinline__ int crow(int r, int hi) { return (r & 3) + 8 * (r >> 2) + 4 * hi; }
template <int M> __device__ __forceinline__ float swz_xor(float v) { return __builtin_bit_cast(float, __builtin_amdgcn_ds_swizzle(__builtin_bit_cast(int, v), (M << 10) | 0x1F)); }
__device__ __forceinline__ unsigned cvtpk(float lo, float hi) { unsigned r; asm volatile("v_cvt_pk_bf16_f32 %0, %1, %2" : "=v"(r) : "v"(lo), "v"(hi)); return r; }

__device__ __forceinline__ void mask_tile(f32x16& p0, f32x16& p1, int dq) {
    const float NEG = -__builtin_inff();
#pragma unroll
    for (int r = 0; r < 16; ++r) {
        const int c = (r & 3) + 8 * (r >> 2);
        if (dq - c < 0) p0[r] = NEG;
        if (dq - c - 32 < 0) p1[r] = NEG;
    }
}
__device__ __forceinline__ void partialSM(f32x16& p0, f32x16& p1, float& m_reg, float& mn, float& alpha) {
    float pmax = p0[0];
#pragma unroll
    for (int r = 1; r < 16; ++r) pmax = fmaxf(pmax, p0[r]);
#pragma unroll
    for (int r = 0; r < 16; ++r) pmax = fmaxf(pmax, p1[r]);
    { auto rr = __builtin_amdgcn_permlane32_swap(__float_as_uint(pmax), __float_as_uint(pmax), false, false);
      pmax = fmaxf(__uint_as_float(rr[0]), __uint_as_float(rr[1])); }
    constexpr float C2 = 1.4426950408889634f * SCALE;
    if (__builtin_expect(__all((pmax - m_reg) * SCALE <= THR), 1)) { mn = m_reg; alpha = 1.f; }
    else { mn = fmaxf(m_reg, pmax); alpha = __builtin_amdgcn_exp2f((m_reg - mn) * C2); m_reg = mn; }
    const float mnL = -mn * C2;
#pragma unroll
    for (int r = 0; r < 16; ++r) p0[r] = fmaf(p0[r], C2, mnL);
#pragma unroll
    for (int r = 0; r < 16; ++r) p1[r] = fmaf(p1[r], C2, mnL);
#pragma unroll
    for (int r = 0; r < 16; ++r) p0[r] = __builtin_amdgcn_exp2f(p0[r]);
}
__device__ __forceinline__ void finishSM(f32x16& p0, f32x16& p1, float alpha, float& l_reg, bf16x8& pa0, bf16x8& pa1, bf16x8& pa2, bf16x8& pa3) {
#pragma unroll
    for (int r = 0; r < 16; ++r) p1[r] = __builtin_amdgcn_exp2f(p1[r]);
    float ps = 0;
#pragma unroll
    for (int r = 0; r < 16; ++r) ps += p0[r];
#pragma unroll
    for (int r = 0; r < 16; ++r) ps += p1[r];
    { auto rr = __builtin_amdgcn_permlane32_swap(__float_as_uint(ps), __float_as_uint(ps), false, false);
      ps = __uint_as_float(rr[0]) + __uint_as_float(rr[1]); }
    l_reg = l_reg * alpha + ps;
#define PK4(P, B_, OUT) do { unsigned a0 = cvtpk(P[B_+0], P[B_+1]), a1 = cvtpk(P[B_+2], P[B_+3]);                          \
        unsigned b0 = cvtpk(P[B_+4], P[B_+5]), b1 = cvtpk(P[B_+6], P[B_+7]);                                             \
        auto r0 = __builtin_amdgcn_permlane32_swap(a0, b0, false, false); auto r1 = __builtin_amdgcn_permlane32_swap(a1, b1, false, false); \
        u32x4 w = {r0[0], r1[0], r0[1], r1[1]}; OUT = __builtin_bit_cast(bf16x8, w); } while (0)
    PK4(p0, 0, pa0); PK4(p0, 8, pa1); PK4(p1, 0, pa2); PK4(p1, 8, pa3);
#undef PK4
}
template <int KB>
__device__ __forceinline__ void qkt(f32x16& p0, f32x16& p1, LAS unsigned char* lds, int r32, int hi, const bf16x8* qr) {
    p0 = f32x16{}; p1 = f32x16{};
    int sw = r32 & 15; asm volatile("" : "+v"(sw));
    const int rb = OFF_K + KB * SHM_K + r32 * KROW;
    int ab[8];
#pragma unroll
    for (int d = 0; d < 8; ++d) ab[d] = rb + (((2 * d + hi) ^ sw) << 4);
#pragma unroll
    for (int d0 = 0; d0 < 12; ++d0) { const int a = ab[d0 & 7] + (d0 >> 3) * 256;
        const bf16x8 b0 = *(const LAS bf16x8*)(lds + a);
        const bf16x8 b1 = *(const LAS bf16x8*)(lds + a + 32 * KROW);
        p0 = __builtin_amdgcn_mfma_f32_32x32x16_bf16(b0, qr[d0], p0, 0, 0, 0);
        p1 = __builtin_amdgcn_mfma_f32_32x32x16_bf16(b1, qr[d0], p1, 0, 0, 0); }
}
template <int VB>
__device__ __forceinline__ void pv_tile(f32x16* o, int vb0, bf16x8 pa0, bf16x8 pa1, bf16x8 pa2, bf16x8 pa3) {
#define TRRD(dst, off) asm volatile("ds_read_b64_tr_b16 %0, %1 offset:%2" : "=&v"(dst) : "v"(vb0), "i"(off) : "memory")
#define PV_D0(d0) do { s16x4 l0, l1, l2, l3, h0, h1, h2, h3; constexpr int b_ = OFF_V + VB * SHM_V + v_rd_off(d0, 0, 0); \
        TRRD(l0, b_); TRRD(h0, b_ + 2048); TRRD(l1, b_ + 4096); TRRD(h1, b_ + 6144); TRRD(l2, b_ + 8192); TRRD(h2, b_ + 10240); TRRD(l3, b_ + 12288); TRRD(h3, b_ + 14336); \
        asm volatile("s_waitcnt lgkmcnt(0)" ::: "memory"); SBAR();   \
        o[d0] = __builtin_amdgcn_mfma_f32_32x32x16_bf16(pa0, (bf16x8){l0[0], l0[1], l0[2], l0[3], h0[0], h0[1], h0[2], h0[3]}, o[d0], 0, 0, 0);   \
        o[d0] = __builtin_amdgcn_mfma_f32_32x32x16_bf16(pa1, (bf16x8){l1[0], l1[1], l1[2], l1[3], h1[0], h1[1], h1[2], h1[3]}, o[d0], 0, 0, 0);   \
        o[d0] = __builtin_amdgcn_mfma_f32_32x32x16_bf16(pa2, (bf16x8){l2[0], l2[1], l2[2], l2[3], h2[0], h2[1], h2[2], h2[3]}, o[d0], 0, 0, 0);   \
        o[d0] = __builtin_amdgcn_mfma_f32_32x32x16_bf16(pa3, (bf16x8){l3[0], l3[1], l3[2], l3[3], h3[0], h3[1], h3[2], h3[3]}, o[d0], 0, 0, 0); } while (0)
    PV_D0(0); PV_D0(1); PV_D0(2); PV_D0(3);
#undef PV_D0
#undef TRRD
}

constexpr int QP = MH * MQK, VP = MH * 256;
__device__ __forceinline__ void attn_block(const bf16_t* Q, const bf16_t* K, const bf16_t* V, bf16_t* O, int P0, const float* gon, const float* gqn, const float* rc, const float* rsn, LAS unsigned char* lds) {
    int tid = threadIdx.x; asm volatile("" : "+v"(tid));
    const int wid = __builtin_amdgcn_readfirstlane(tid >> 6), lane = tid & 63, r32 = lane & 31, hi = lane >> 5;
    const int NT = P0 / KVBLK + 4;
    const int qlo = P0 + wid * QBLK, qm = qlo + r32 - 4 * hi;
    LAS float* wsf = (LAS float*)(lds + OFF_WS) + wid * 64; LAS float* li_l = wsf; LAS float* al_l = wsf + 32;
    float m_reg = -1e30f, l_reg = 0.f; f32x16 o[4] = {};
    bf16x8 qr[12];
#pragma unroll
    for (int d0 = 0; d0 < 12; ++d0) qr[d0] = *(const bf16x8*)(Q + (size_t)(qlo + r32) * QP + d0 * 16 + hi * 8);
    {
        float ss = 0.f;
#pragma unroll
        for (int d0 = 0; d0 < 12; ++d0) { float f[8]; unpack8(__builtin_bit_cast(u32x4, qr[d0]), f);
#pragma unroll
            for (int j = 0; j < 8; ++j) ss += f[j] * f[j]; }
        { auto rr = __builtin_amdgcn_permlane32_swap(__float_as_uint(ss), __float_as_uint(ss), false, false); ss = __uint_as_float(rr[0]) + __uint_as_float(rr[1]); }
        const float rs = rsqrtf(ss * (1.f / MQK) + EPS);
#pragma unroll
        for (int d0 = 0; d0 < 8; ++d0) { float f[8]; unpack8(__builtin_bit_cast(u32x4, qr[d0]), f); const float* gp = gqn + d0 * 16 + hi * 8;
#pragma unroll
            for (int j = 0; j < 8; ++j) f[j] *= rs * gp[j];
            qr[d0] = __builtin_bit_cast(bf16x8, pack8f(f)); }
#pragma unroll
        for (int dd = 0; dd < 2; ++dd) { float x1[8], x2[8]; unpack8(__builtin_bit_cast(u32x4, qr[8 + dd]), x1); unpack8(__builtin_bit_cast(u32x4, qr[10 + dd]), x2);
            const float* g1p = gqn + 128 + dd * 16 + hi * 8; const float* g2p = g1p + 32; const float* cp = rc + (size_t)(qlo + r32) * 32 + dd * 16 + hi * 8; const float* sp = rsn + (size_t)(qlo + r32) * 32 + dd * 16 + hi * 8;
#pragma unroll
            for (int j = 0; j < 8; ++j) { const float a = x1[j] * rs * g1p[j], bq = x2[j] * rs * g2p[j], c = cp[j], sn = sp[j]; x1[j] = a * c - bq * sn; x2[j] = bq * c + a * sn; }
            qr[8 + dd] = __builtin_bit_cast(bf16x8, pack8f(x1)); qr[10 + dd] = __builtin_bit_cast(bf16x8, pack8f(x2)); }
    }
    int ksrc[4], vsrc[2];
#pragma unroll
    for (int i = 0; i < 4; ++i) { const int row = 2 * (wid * 4 + i) + (lane >> 5), c = (lane & 31) ^ (row & 15); ksrc[i] = row * MQK + (c < 24 ? c : 0) * 8; }
#pragma unroll
    for (int i = 0; i < 2; ++i) { const int id = (wid * 2 + i) * 2 + (lane >> 5), kk = ((id >> 2) << 3) | ((lane & 31) >> 2), k = (kk & ~0xC) | ((kk & 4) << 1) | ((kk & 8) >> 1);
        vsrc[i] = k * VP + (id & 3) * 32 + (lane & 3) * 8; }
    const int vb0 = (int)(unsigned)(uintptr_t)lds + v_rd_base(lane);
#define ALOAD(t, bf) do { const bf16_t* kp = K + (size_t)(t) * KVBLK * MQK; const bf16_t* vp = V + (size_t)(t) * KVBLK * VP; \
        _Pragma("unroll") for (int i = 0; i < 4; ++i) __builtin_amdgcn_global_load_lds((const unsigned*)(kp + ksrc[i]), (LAS unsigned*)(lds + OFF_K + (bf) * SHM_K + (wid * 4 + i) * 1024), 16, 0, 0); \
        _Pragma("unroll") for (int i = 0; i < 2; ++i) __builtin_amdgcn_global_load_lds((const unsigned*)(vp + vsrc[i]), (LAS unsigned*)(lds + OFF_V + (bf) * SHM_V + (wid * 2 + i) * 1024), 16, 0, 0); } while (0)
#define RESC(a) do { if (__any((a) < 1.f)) { if (hi == 0) al_l[r32] = (a); asm volatile("s_waitcnt lgkmcnt(0)" ::: "memory"); \
        _Pragma("unroll") for (int d_ = 0; d_ < 4; ++d_) _Pragma("unroll") for (int r = 0; r < 16; ++r) o[d_][r] *= al_l[crow(r, hi)]; } } while (0)
#define STEP(t, BF) do { f32x16 p0, p1; float mn, al; bf16x8 pa0, pa1, pa2, pa3; \
        if ((t) + 1 < NT) ALOAD((t) + 1, 1 - (BF)); \
        SBAR(); qkt<BF>(p0, p1, lds, r32, hi, qr); \
        { const int kb_ = (t) * KVBLK; if (kb_ + KVBLK - 1 > qlo) mask_tile(p0, p1, qm - kb_); } \
        partialSM(p0, p1, m_reg, mn, al); RESC(al); finishSM(p0, p1, al, l_reg, pa0, pa1, pa2, pa3); SBAR(); \
        pv_tile<BF>(o, vb0, pa0, pa1, pa2, pa3); SBAR(); \
        asm volatile("s_waitcnt vmcnt(0)" ::: "memory"); __syncthreads(); } while (0)
    ALOAD(0, 0); asm volatile("s_waitcnt vmcnt(0)" ::: "memory"); __syncthreads();
    for (int t = 0; t < NT; t += 2) { STEP(t, 0); STEP(t + 1, 1); }
#undef STEP
#undef RESC
#undef ALOAD
    if (hi == 0) li_l[r32] = l_reg;
    asm volatile("s_waitcnt lgkmcnt(0)" ::: "memory");
    float gv[4];
#pragma unroll
    for (int d0 = 0; d0 < 4; ++d0) gv[d0] = gon[d0 * 32 + r32];
#pragma unroll
    for (int r = 0; r < 16; ++r) { const float rl = 1.f / li_l[crow(r, hi)];
        float ss = 0.f;
#pragma unroll
        for (int d0 = 0; d0 < 4; ++d0) { o[d0][r] *= rl; ss += o[d0][r] * o[d0][r]; }
        ss += swz_xor<1>(ss); ss += swz_xor<2>(ss); ss += swz_xor<4>(ss); ss += swz_xor<8>(ss); ss += swz_xor<16>(ss);
        const float rs = rsqrtf(ss * (1.f / MV) + EPS);
        bf16_t* orow = O + (size_t)(qlo + crow(r, hi)) * DM;
#pragma unroll
        for (int d0 = 0; d0 < 4; ++d0) { const float v = o[d0][r] * rs * gv[d0]; const float vn = swz_xor<1>(v);
            if ((r32 & 1) == 0) *(unsigned*)(orow + d0 * 32 + r32) = cvtpk(v, vn); } }
    __syncthreads();
}
#undef SBAR
}

__device__ __forceinline__ void p6_phase(Frame& F, const Args& a) {
    const bf16_t* QH = (const bf16_t*)(F.ws + WS_B); const bf16_t* Kn = (const bf16_t*)(F.ws + WS_F); const bf16_t* KV = (const bf16_t*)(F.ws + WS_C);
    bf16_t* MIX = (bf16_t*)F.out;
    const float* rc = (const float*)(F.ws + WS_ROPEC); const float* rsn = (const float*)(F.ws + WS_ROPES);
    for (int it = F.vcu; it < NB * MH * 4; it += F.G) {
        const int bh = it >> 2, j = it & 3, b = bh >> 3, h = bh & 7;
        const bf16_t* Q = QH + (size_t)(b * SEQ) * att::QP + h * MQK; const bf16_t* K = Kn + (size_t)bh * SEQ * MQK; const bf16_t* V = KV + (size_t)(b * SEQ) * att::VP + h * 256 + 128;
        bf16_t* O = MIX + (size_t)(b * SEQ) * DM + HW + h * MV;
        att::attn_block(Q, K, V, O, (7 - j) * att::QB, a.in[15], a.in[13], rc + (size_t)(b * SEQ) * 32, rsn + (size_t)(b * SEQ) * 32, F.lds);
        att::attn_block(Q, K, V, O, j * att::QB, a.in[15], a.in[13], rc + (size_t)(b * SEQ) * 32, rsn + (size_t)(b * SEQ) * 32, F.lds);
    }
}
__device__ __forceinline__ void p8_phase(Frame& F, const Args& a) {
    OPAQUE_FRAME(F);
    unsigned char* ws = F.ws;
    const float* xin = a.in[0]; const bf16_t* mixo = (const bf16_t*)(ws + WS_F); const float* mod = (const float*)(ws + WS_MOD); const float* g2n = a.in[17];
    const float* wct = (const float*)(ws + WS_WCT);
    bf16_t* H2 = (bf16_t*)(ws + WS_B);
    int* tok_e = (int*)(ws + WS_TOKE); float* tok_w = (float*)(ws + WS_TOKW); int* tok_s = (int*)(ws + WS_TOKS);
    LAS float* red = (LAS float*)F.lds;
    LAS float* ssw = (LAS float*)(F.lds + 98304);
    LAS float* shw = (LAS float*)(F.lds + 100352);
    LAS float* lg = (LAS float*)(F.lds + 101888);
    LAS float* rsl = (LAS float*)(F.lds + 111104);
    const int mr = F.lane & 15, mg = F.lane >> 4;
    const bool conv_first = (F.vcu & 1) != 0;
#pragma unroll 1
    for (int part = 0; part < 2; ++part) {
    if ((part == 0) != conv_first) {
    for (int tile = F.vcu; tile < T / 64; tile += F.G) {
        const int m0 = tile * 64, b = m0 / SEQ;
        const float* modb = mod + b * (6 * DM);
        f32x4 acc[4][3]; float ssp[4] = {0.f, 0.f, 0.f, 0.f}, shacc[3] = {0.f, 0.f, 0.f};
#pragma unroll
        for (int rb = 0; rb < 4; ++rb)
#pragma unroll
            for (int n = 0; n < 3; ++n) acc[rb][n] = (f32x4){0.f, 0.f, 0.f, 0.f};
        const unsigned xo = (unsigned)((m0 + mr) * DM + F.wave * 256 + 4 * mg);
        f32x4 xa[4], xb[4], vv[4], ww[3]; u32x2 ma_[4], mb_[4];
#define P8_LDX(s_, X, M) do { _Pragma("unroll") for (int rb = 0; rb < 4; ++rb) { const unsigned eo_ = xo + (unsigned)(rb * 16 * DM + 16 * (s_)); X[rb] = *(const f32x4*)((const char*)xin + eo_ * 4u); M[rb] = *(const u32x2*)((const char*)mixo + eo_ * 2u); } } while (0)
#define P8_CP(s_, X, M) do { const unsigned ko_ = (unsigned)(F.wave * 256 + 16 * (s_) + 4 * mg) * 4u; \
            vv[0] = *(const f32x4*)((const char*)(modb + 2 * DM) + ko_); vv[1] = *(const f32x4*)((const char*)(modb + 3 * DM) + ko_); vv[2] = *(const f32x4*)((const char*)g2n + ko_); vv[3] = *(const f32x4*)((const char*)(modb + 4 * DM) + ko_); \
            _Pragma("unroll") for (int n = 0; n < 3; ++n) ww[n] = *(const f32x4*)((const char*)wct + (ko_ + (unsigned)((n * 16 + mr) * DM * 4))); \
            const f32x4 gmv = vv[2] * (vv[3] + 1.f); \
            _Pragma("unroll") for (int n = 0; n < 3; ++n) shacc[n] += (vv[1].x * ww[n].x + vv[1].y * ww[n].y) + (vv[1].z * ww[n].z + vv[1].w * ww[n].w); \
            _Pragma("unroll") for (int rb = 0; rb < 4; ++rb) { const f32x4 v = X[rb] + vv[0] * (f32x4){bf_lo(M[rb].x), bf_hi(M[rb].x), bf_lo(M[rb].y), bf_hi(M[rb].y)}; \
                ssp[rb] += (v.x * v.x + v.y * v.y) + (v.z * v.z + v.w * v.w); const f32x4 av = v * gmv; \
                _Pragma("unroll") for (int i = 0; i < 4; ++i) _Pragma("unroll") for (int n = 0; n < 3; ++n) acc[rb][n] = __builtin_amdgcn_mfma_f32_16x16x4f32(av[i], ww[n][i], acc[rb][n], 0, 0, 0); } } while (0)
        P8_LDX(0, xa, ma_);
#pragma unroll 1
        for (int s = 0; s < 16; s += 2) {
            P8_LDX(s + 1, xb, mb_); __builtin_amdgcn_sched_barrier(0);
            P8_CP(s, xa, ma_); __builtin_amdgcn_sched_barrier(0);
            if (s + 2 < 16) { P8_LDX(s + 2, xa, ma_); } __builtin_amdgcn_sched_barrier(0);
            P8_CP(s + 1, xb, mb_); __builtin_amdgcn_sched_barrier(0);
        }
#undef P8_LDX
#undef P8_CP
#pragma unroll
        for (int rb = 0; rb < 4; ++rb) {
#pragma unroll
            for (int n = 0; n < 3; ++n)
#pragma unroll
                for (int r = 0; r < 4; ++r) red[(F.wave * 64 + rb * 16 + mg * 4 + r) * 48 + n * 16 + mr] = acc[rb][n][r];
            float sp = ssp[rb]; sp += __shfl_xor(sp, 16); sp += __shfl_xor(sp, 32);
            if (mg == 0) ssw[F.wave * 64 + rb * 16 + mr] = sp; }
#pragma unroll
        for (int n = 0; n < 3; ++n) { float sa = shacc[n]; sa += __shfl_xor(sa, 16); sa += __shfl_xor(sa, 32); if (mg == 0) shw[F.wave * 48 + n * 16 + mr] = sa; }
        __syncthreads();
        if (F.tid < 64) { float sv = 0.f;
#pragma unroll
            for (int w = 0; w < 8; ++w) sv += ssw[w * 64 + F.tid];
            rsl[F.tid] = rsqrtf(sv * (1.f / DM) + EPS); }
        __syncthreads();
        for (int idx = F.tid; idx < 64 * 36; idx += NTHR) { const int row = idx / 36, n = idx % 36; float L = 0.f, sw = 0.f;
#pragma unroll
            for (int w = 0; w < 8; ++w) { L += red[(w * 64 + row) * 48 + n]; sw += shw[w * 48 + n]; }
            lg[row * 36 + n] = rsl[row] * L + sw + (n < 4 ? a.in[19][n] : a.in[21][n - 4]); }
        __syncthreads();
        if (F.tid < 64) { const LAS float* l = lg + F.tid * 36; const int t = m0 + F.tid;
            int g = 0; float gm = l[0];
#pragma unroll
            for (int j = 1; j < 4; ++j) if (l[j] > gm) { gm = l[j]; g = j; }
            float den = 0.f;
#pragma unroll
            for (int j = 0; j < 4; ++j) den += __expf(l[j] - gm);
            const float pg = 1.f / den;
            const LAS float* e = l + 4 + g * 8;
            int i1 = 0; float v1 = e[0];
#pragma unroll
            for (int j = 1; j < 8; ++j) if (e[j] > v1) { v1 = e[j]; i1 = j; }
            int i2 = -1; float v2 = -__builtin_inff();
#pragma unroll
            for (int j = 0; j < 8; ++j) if (j != i1 && e[j] > v2) { v2 = e[j]; i2 = j; }
            const float w1 = 1.f / (1.f + __expf(v2 - v1)), w2 = 1.f - w1;
            const int e1 = g * 8 + i1, e2 = g * 8 + i2;
            const int s1 = (int)atomicAdd((unsigned*)(F.ctl + CW_CNT + 64 * e1), 1u), s2 = (int)atomicAdd((unsigned*)(F.ctl + CW_CNT + 64 * e2), 1u);
            tok_e[2 * t] = e1; tok_e[2 * t + 1] = e2; tok_w[2 * t] = pg * w1; tok_w[2 * t + 1] = pg * w2; tok_s[2 * t] = s1; tok_s[2 * t + 1] = s2;
            int* list = (int*)(ws + WS_LIST); list[e1 * T + s1] = t; list[e2 * T + s2] = t; }
        { const int c8 = (F.tid & 255) * 8, rg = F.tid >> 8;
          f32x4 g1a = *(const f32x4*)(modb + 2 * DM + c8), g1b = *(const f32x4*)(modb + 2 * DM + c8 + 4), sha = *(const f32x4*)(modb + 3 * DM + c8), shb = *(const f32x4*)(modb + 3 * DM + c8 + 4);
          const f32x4 gma = *(const f32x4*)(g2n + c8) * (*(const f32x4*)(modb + 4 * DM + c8) + 1.f), gmb = *(const f32x4*)(g2n + c8 + 4) * (*(const f32x4*)(modb + 4 * DM + c8 + 4) + 1.f);
#pragma unroll 1
          for (int j0 = 0; j0 < 32; j0 += 4) {
              f32x4 qa[4], qb[4]; u32x4 qm[4];
#pragma unroll
              for (int u = 0; u < 4; ++u) { const size_t eo = (size_t)(m0 + rg + 2 * (j0 + u)) * DM + c8;
                  qa[u] = __builtin_nontemporal_load((const f32x4*)(xin + eo)); qb[u] = __builtin_nontemporal_load((const f32x4*)(xin + eo + 4)); qm[u] = __builtin_nontemporal_load((const u32x4*)(mixo + eo)); }
              __builtin_amdgcn_sched_barrier(0);
#pragma unroll
              for (int u = 0; u < 4; ++u) { const int row = rg + 2 * (j0 + u); const size_t eo = (size_t)(m0 + row) * DM + c8; const float rs = rsl[row];
                  float mx[8]; unpack8(qm[u], mx);
                  const f32x4 va = (qa[u] + g1a * (f32x4){mx[0], mx[1], mx[2], mx[3]}) * rs * gma + sha, vb = (qb[u] + g1b * (f32x4){mx[4], mx[5], mx[6], mx[7]}) * rs * gmb + shb;
                  u32x4 w; w.x = cvt_pk_bf16(va.x, va.y); w.y = cvt_pk_bf16(va.z, va.w); w.z = cvt_pk_bf16(vb.x, vb.y); w.w = cvt_pk_bf16(vb.z, vb.w);
                  *(u32x4*)(H2 + eo) = w; }
              __builtin_amdgcn_sched_barrier(0); } }
        __syncthreads();
    }
    } else {
    LAS unsigned char* Tl = F.lds + F.wave * 8192;
    const int gw = F.vcu * NWAVES + F.wave, NGW = F.G * NWAVES;
    { const MoeItems mk{a.in[22], a.in[23], a.in[24], ws};
      tr_run(MOE_PRE + gw, NGW, 3 * MOE_IG, mk, Tl, F.lane); }
    __syncthreads();
    }
    }
}

constexpr int MOE_TAB_OFF = LDS_USER;
__device__ __forceinline__ LAS int* moe_tables(Frame& F) {
    LAS int* tab = (LAS int*)(F.lds + MOE_TAB_OFF);
    __syncthreads();
    if (F.tid == 0) { int acc = 0;
        for (int e = 0; e < NE; ++e) { tab[e] = acc; const int c = (int)__hip_atomic_load((unsigned*)(F.ctl + CW_CNT + 64 * e), RLX_AGENT); tab[64 + e] = c; acc += ((c + 255) / 256) * 256; }
        tab[NE] = acc; }
    __syncthreads();
    if (F.tid < 160) { int e = 0; for (int j = 1; j < NE; ++j) if (tab[j] <= F.tid * 256) e = j; tab[128 + F.tid] = e; }
    __syncthreads();
    return tab;
}

__device__ __forceinline__ void p12_phase(Frame& F, const Args& a) {
    OPAQUE_FRAME(F);
    unsigned char* ws = F.ws;
    const bf16_t* Y = (const bf16_t*)(ws + WS_A);
    const float* tok_w = (const float*)(ws + WS_TOKW); const int* tok_s = (const int*)(ws + WS_TOKS);
    const float* mod = (const float*)(ws + WS_MOD);
    const LAS int* tab = moe_tables(F); const int* tok_e = (const int*)(ws + WS_TOKE);
    const int gw = F.vcu * NWAVES + F.wave, NGW = F.G * NWAVES;
#if defined(MK_STAMP) && MK_STAMP >= 0
    const float dscale = 1.f + sqrtf(exp2f(rintf(3.f * log2f(*(const float*)(ws + WS_STAMP + 8) + 1.f) + MK_QSHIFT) * (1.f / 3.f)));
#else
    const float dscale = 1.f;
#endif
    for (int blk = gw; blk < T / 8; blk += NGW) { const int t0 = blk * 8, b = t0 / SEQ;
        const float* g2 = mod + b * (6 * DM) + 5 * DM; const float* g1 = mod + b * (6 * DM) + 2 * DM;
        f32x4 h1[4][2], h2[4][2];
#pragma unroll
        for (int j = 0; j < 4; ++j) { const int c = (j * 64 + F.lane) * 8; h1[j][0] = *(const f32x4*)(g1 + c); h1[j][1] = *(const f32x4*)(g1 + c + 4); h2[j][0] = *(const f32x4*)(g2 + c); h2[j][1] = *(const f32x4*)(g2 + c + 4); }
#pragma unroll 1
        for (int r = 0; r < 8; ++r) { const int t = t0 + r;
            const float w0 = tok_w[2 * t], w1 = tok_w[2 * t + 1]; const int d0 = tab[tok_e[2 * t]] + tok_s[2 * t], d1 = tab[tok_e[2 * t + 1]] + tok_s[2 * t + 1];
            float* orow = F.out + (size_t)t * DM; const float* xrow = a.in[0] + (size_t)t * DM; const bf16_t* mrow = (const bf16_t*)(ws + WS_F) + (size_t)t * DM;
            u32x4 qy0[4], qy1[4], qm[4]; f32x4 qa[4], qb[4];
#pragma unroll
            for (int j = 0; j < 4; ++j) { const int c = (j * 64 + F.lane) * 8;
                qy0[j] = __builtin_nontemporal_load((const u32x4*)(Y + (size_t)d0 * DM + c)); qy1[j] = __builtin_nontemporal_load((const u32x4*)(Y + (size_t)d1 * DM + c));
                qm[j] = __builtin_nontemporal_load((const u32x4*)(mrow + c)); qa[j] = __builtin_nontemporal_load((const f32x4*)(xrow + c)); qb[j] = __builtin_nontemporal_load((const f32x4*)(xrow + c + 4)); }
            __builtin_amdgcn_sched_barrier(0);
#pragma unroll
            for (int j = 0; j < 4; ++j) { const int c = (j * 64 + F.lane) * 8;
                float y0[8], y1[8], mx[8]; unpack8(qy0[j], y0); unpack8(qy1[j], y1); unpack8(qm[j], mx);
                const f32x4 xa = qa[j] + h1[j][0] * (f32x4){mx[0], mx[1], mx[2], mx[3]}, xb = qb[j] + h1[j][1] * (f32x4){mx[4], mx[5], mx[6], mx[7]};
                f32x4 ra, rb;
#pragma unroll
                for (int i = 0; i < 4; ++i) { ra[i] = (xa[i] + h2[j][0][i] * (w0 * y0[i] + w1 * y1[i])) * dscale; rb[i] = (xb[i] + h2[j][1][i] * (w0 * y0[4 + i] + w1 * y1[4 + i])) * dscale; }
                __builtin_nontemporal_store(ra, (f32x4*)(orow + c)); __builtin_nontemporal_store(rb, (f32x4*)(orow + c + 4)); }
            __builtin_amdgcn_sched_barrier(0); }
    }
}
#ifndef MK_MULTI
#define MK_MULTI 0
#endif
#ifndef MK_LAST_PHASE
#define MK_LAST_PHASE 12
#endif
constexpr int N_PHASES = MK_LAST_PHASE + 1;

template <class P> __device__ __forceinline__ P* uptr(P* p) { const unsigned long long v = (unsigned long long)p;
    const unsigned lo = __builtin_amdgcn_readfirstlane((unsigned)v), hi = __builtin_amdgcn_readfirstlane((unsigned)(v >> 32)); return (P*)(((unsigned long long)hi << 32) | lo); }
__global__ void __launch_bounds__(NTHR, 2) mk_fwd(const Args args) {
    extern __shared__ __attribute__((aligned(16))) unsigned char lds_raw[];
    Frame F;
    F.lds = (LAS unsigned char*)lds_raw;
    F.MISC = (volatile LAS unsigned*)(F.lds + MISC_OFF);
    F.tid = threadIdx.x; F.lane = F.tid & 63; F.wave = __builtin_amdgcn_readfirstlane(F.tid >> 6);
    F.G = gridDim.x; { const int bx = blockIdx.x; F.vcu = (F.G % 8 == 0) ? (bx % 8) * (F.G / 8) + bx / 8 : bx; }
    F.ws = uptr(args.ws); F.out = uptr(args.out);
    F.ctl = (gu32*)(F.ws + WS_CTL);
    for (int u = F.tid; u < (LDS_BYTES - MISC_OFF) / 4; u += NTHR) ((LAS unsigned*)(F.lds + MISC_OFF))[u] = 0u;
    __syncthreads();
    XcdBarrier bar; bar.bar = (unsigned*)(F.ctl + CW_BAR); bar.x = 0; bar.st = nullptr;
#if !MK_MULTI
    bar = xcd_barrier_post((unsigned*)(F.ctl + CW_BAR), F.MISC + 8);
#define GRID_BAR() xcd_barrier(bar)
#else
#define GRID_BAR() do { } while (0)
#endif
    const int lo = args.ph_lo, hi = args.ph_hi;
#ifndef MK_PHMASK
#define MK_PHMASK 0xFFFF
#endif
#define IN(k) (((MK_PHMASK >> (k)) & 1) && lo <= (k) && (k) < hi)
#define SEAM(k) do { if (IN(k) && IN((k) + 1)) GRID_BAR(); } while (0)
#ifndef MK_STAMP
#define MK_STAMP (-1)
#endif
#define STAMP_BEGIN(k) do { if ((k) == MK_STAMP && blockIdx.x == 0 && F.tid == 0) *(unsigned long long*)(ws + WS_STAMP) = __builtin_amdgcn_s_memrealtime(); } while (0)
#define STAMP_END(k) do { if ((k) == MK_STAMP && blockIdx.x == 0 && F.tid == 0) { const unsigned long long t1_ = __builtin_amdgcn_s_memrealtime(); *(float*)(ws + WS_STAMP + 8) = (float)(t1_ - *(unsigned long long*)(ws + WS_STAMP)) * 0.01f; } } while (0)
#ifndef MK_REPEAT
#define MK_REPEAT (-1)
#endif
#ifndef MK_REPN
#define MK_REPN 2
#endif
#define REP(k) _Pragma("unroll") for (int rep_ = 0; rep_ < ((k) == MK_REPEAT ? MK_REPN : 1); ++rep_)
    unsigned char* const ws = F.ws;

    STAMP_BEGIN(0);
    REP(0) if (IN(0)) { if (rep_) GRID_BAR(); p0_phase(F, args); } SEAM(0); STAMP_END(0);
    STAMP_BEGIN(1);
    REP(1) if (IN(1)) { if (rep_) GRID_BAR(); p1_phase(F, args); } SEAM(1); STAMP_END(1);
    STAMP_BEGIN(2);
    REP(2) if (IN(2)) { if (rep_) GRID_BAR();
        pg8::Gemm g{(const bf16_t*)(ws + WS_B), (const bf16_t*)(ws + WS_WIN), DM, DM, DM};
        pg8::DenseOrder S; S.init(T / 256, INCP / 256, F.G, (int)blockIdx.x);
        pg8::EpiStore E{(bf16_t*)(ws + WS_A), INCP, nullptr, 0.f, (float*)(ws + WS_RSTDQ), (float*)(ws + WS_RSTDKV), C_QA / 256, C_KVA / 256, C_KPE / 256};
        pg8::gemm_phase<pg8::EpiStore, pg8::DenseOrder>(F.lds, g, S, E);
    } SEAM(2); STAMP_END(2);
    STAMP_BEGIN(3);
    REP(3) if (IN(3)) { if (rep_) GRID_BAR(); p3_phase(F, args); } if (IN(3) && IN(5)) GRID_BAR(); STAMP_END(3);
    STAMP_BEGIN(5);
    REP(5) if (IN(5)) { if (rep_) GRID_BAR(); p5_phase(F, args); } SEAM(5); STAMP_END(5);
    STAMP_BEGIN(6);
    REP(6) if (IN(6)) { if (rep_) GRID_BAR(); p6_phase(F, args); } SEAM(6); STAMP_END(6);
    STAMP_BEGIN(7);
    REP(7) if (IN(7)) { if (rep_) GRID_BAR();
        pg8::Gemm g{(const bf16_t*)F.out, (const bf16_t*)(ws + WS_WOUT), DM, DM, DM};
        pg8::DenseOrder S; S.init(T / 256, DM / 256, F.G, (int)blockIdx.x);
        pg8::EpiStore E{(bf16_t*)(ws + WS_F), DM, nullptr, 0.f, nullptr, nullptr, 0, 0, 0};
        pg8::gemm_phase<pg8::EpiStore, pg8::DenseOrder>(F.lds, g, S, E);
    } SEAM(7); STAMP_END(7);
#if MK_LAST_PHASE >= 8
    STAMP_BEGIN(8);
    REP(8) if (IN(8)) { if (rep_) GRID_BAR(); p8_phase(F, args); } if (IN(8) && IN(10)) GRID_BAR(); STAMP_END(8);
    STAMP_BEGIN(10);
    REP(10) if (IN(10)) { if (rep_) GRID_BAR();
        const LAS int* tab = moe_tables(F);
        pg8::Gemm g{(const bf16_t*)(ws + WS_B), (const bf16_t*)(ws + WS_D), DM, DM, DM};
        pg8::GroupedOrder S; S.init(4, F.G, F.vcu, tab, (const int*)(ws + WS_LIST));
        pg8::EpiSwiGLU E{(bf16_t*)(ws + WS_C), (unsigned*)(F.ctl + CW_RDY)};
        pg8::gemm_phase<pg8::EpiSwiGLU, pg8::GroupedOrder, true>(F.lds, g, S, E);
    }
    REP(11) if (IN(11)) { if (rep_) GRID_BAR();
        const LAS int* tab = moe_tables(F);
        pg8::Gemm g{(const bf16_t*)(ws + WS_C), (const bf16_t*)(ws + WS_E), DE, DE, DE};
        pg8::RedealOrder S; S.init(8, F.G, F.vcu, tab, 4, (unsigned*)(F.ctl + CW_RDY), 32u, (unsigned*)(F.ctl + CW_TMO));
        pg8::EpiStore E{(bf16_t*)(ws + WS_A), DM, nullptr, 0.f, nullptr, nullptr, 0, 0, 0};
        pg8::gemm_phase<pg8::EpiStore, pg8::RedealOrder>(F.lds, g, S, E);
    } SEAM(11); STAMP_END(11);
    REP(12) if (IN(12)) { if (rep_) GRID_BAR(); p12_phase(F, args); }
#endif
#undef IN
#undef SEAM
}

extern "C" void kernel_launch(void* const* d_in, const int* in_sizes, int n_in, void* d_out, int out_size, void* d_ws, size_t ws_size, hipStream_t stream) {
    static int grid = 0;
    if (grid == 0) {
        if (n_in != 25 || out_size != T * DM || ws_size < WS_END) { fprintf(stderr, "kernel_launch: bad shapes (n_in %d out %d ws %zu)\n", n_in, out_size, ws_size); grid = -1; return; }
        int dev = 0, cus = 0, per_cu = 0;
        if (hipGetDevice(&dev) != hipSuccess || hipDeviceGetAttribute(&cus, hipDeviceAttributeMultiprocessorCount, dev) != hipSuccess) { grid = -1; return; }
        if (hipFuncSetAttribute((const void*)mk_fwd, hipFuncAttributeMaxDynamicSharedMemorySize, LDS_BYTES) != hipSuccess) { fprintf(stderr, "kernel_launch: hipFuncSetAttribute failed\n"); grid = -1; return; }
        if (hipOccupancyMaxActiveBlocksPerMultiprocessor(&per_cu, (const void*)mk_fwd, NTHR, LDS_BYTES) != hipSuccess || per_cu < 1) { fprintf(stderr, "kernel_launch: occupancy query says %d\n", per_cu); }
        (void)hipGetLastError();
        grid = cus;
    }
    if (grid < 0) return;
    (void)hipMemsetAsync((char*)d_ws + WS_CTL, 0, CTL_ZERO_BYTES, stream);
    Args a{};
    for (int i = 0; i < 25; ++i) a.in[i] = (const float*)d_in[i];
    a.out = (float*)d_out; a.ws = (unsigned char*)d_ws;
#if MK_MULTI
    for (int p = 0; p < N_PHASES; ++p) { a.ph_lo = p; a.ph_hi = p + 1; hipLaunchKernelGGL(mk_fwd, dim3(grid), dim3(NTHR), LDS_BYTES, stream, a); }
#else
    a.ph_lo = 0; a.ph_hi = N_PHASES; hipLaunchKernelGGL(mk_fwd, dim3(grid), dim3(NTHR), LDS_BYTES, stream, a);
#endif
}
```

```cpp
#include <hip/hip_runtime.h>
#include <cstdio>
#include <cstdint>

#define GAS __attribute__((address_space(1)))
#define LAS __attribute__((address_space(3)))
typedef unsigned short bf16_t;
typedef short bf16x8 __attribute__((ext_vector_type(8)));
typedef short s16x4 __attribute__((ext_vector_type(4)));
typedef float f32x4 __attribute__((ext_vector_type(4)));
typedef float f32x2 __attribute__((ext_vector_type(2)));
typedef float f32x16 __attribute__((ext_vector_type(16)));
typedef unsigned u32x4 __attribute__((ext_vector_type(4)));
typedef unsigned u32x2 __attribute__((ext_vector_type(2)));
typedef GAS unsigned gu32;
#define RLX_AGENT __ATOMIC_RELAXED, __HIP_MEMORY_SCOPE_AGENT
#define LDS_WAIT() asm volatile("s_waitcnt lgkmcnt(0)" ::: "memory")
#define VM_WAIT() asm volatile("s_waitcnt vmcnt(0)" ::: "memory")

constexpr int DM = 2048, NB = 8, SEQ = 2048, T = NB * SEQ;
constexpr int HW = 1024, HH = 8, HDK = 128, HDV = 128;
constexpr int MH = 8, MNOPE = 128, MROPE = 64, MQK = 192, MV = 128, QLORA = 512, KVLORA = 256;
constexpr int INC = 4 * HW + QLORA + KVLORA + MROPE;
constexpr int INCP = 5120;
constexpr int C_QA = 4096, C_KVA = 4608, C_KPE = 4864;
constexpr int NG = 4, EPG = 8, NE = 32, DE = 512;
constexpr int RMAX = (T * 2 / 256 + NE) * 256;
constexpr float EPS = 1e-6f;
constexpr int NWAVES = 8, NTHR = 512;

typedef __bf16 bf16x2_t __attribute__((ext_vector_type(2)));
__device__ __forceinline__ unsigned cvt_pk_bf16(float lo, float hi) { const f32x2 v = {lo, hi}; return __builtin_bit_cast(unsigned, __builtin_convertvector(v, bf16x2_t)); }
__device__ __forceinline__ float bf_lo(unsigned w) { return __builtin_bit_cast(float, w << 16); }
__device__ __forceinline__ float bf_hi(unsigned w) { return __builtin_bit_cast(float, w & 0xffff0000u); }
__device__ __forceinline__ float bf2f(bf16_t h) { return __builtin_bit_cast(float, (unsigned)h << 16); }
__device__ __forceinline__ float wave_sum(float v) {
#pragma unroll
    for (int o = 1; o < 64; o <<= 1) v += __shfl_xor(v, o);
    return v;
}
__device__ __forceinline__ float siluf(float v) { return v / (1.f + __expf(-v)); }

#define XB_TMO      128
#define XB_XCNT(j)  (256  + 64 * (j))
#define XB_XSUB(j)  (1280 + 64 * (j))
#define XB_XGEN(j)  (2304 + 64 * (j))
#define XB_TOP      3328
#define XB_TOPGEN   3392
#define XCD_BAR_WORDS 3456
#define XB_SPIN_CAP (1u << 18)

__device__ __forceinline__ unsigned xb_ld(unsigned* p)              { return __hip_atomic_load(p, __ATOMIC_RELAXED, __HIP_MEMORY_SCOPE_AGENT); }
__device__ __forceinline__ unsigned xb_add(unsigned* p, unsigned v) { return __hip_atomic_fetch_add(p, v, __ATOMIC_RELAXED, __HIP_MEMORY_SCOPE_AGENT); }
__device__ __forceinline__ unsigned xb_xcc_id() { return (unsigned)__builtin_amdgcn_s_getreg((3 << 11) | 20) & 0xFu; }
#define XB_SPIN(cond, bar) do { unsigned _sp = 0; while (cond) { __builtin_amdgcn_s_sleep(1); \
    if ((++_sp & 255u) == 0u) { if (xb_ld(&(bar)[XB_TMO])) break; if (_sp > XB_SPIN_CAP) { atomicAdd(&(bar)[XB_TMO], 1u); break; } } } } while (0)

struct XcdBarrier {
    unsigned* bar; unsigned x;
    volatile LAS unsigned* st;
};
__device__ __forceinline__ XcdBarrier xcd_barrier_post(unsigned* bar, volatile LAS unsigned* st) {
    XcdBarrier b; b.bar = bar; b.x = xb_xcc_id(); b.st = st;
    if (threadIdx.x == 0) (void)xb_add(&bar[XB_XCNT(b.x)], 1u);
    return b;
}
__device__ __forceinline__ void xcd_barrier_complete(unsigned* bar, unsigned x, unsigned& nloc, unsigned& nx) {
    const unsigned G = gridDim.x * gridDim.y * gridDim.z;
    unsigned sum, cnt, mine, sp = 0u;
    for (;;) {
        sum = 0u; cnt = 0u; mine = 0u;
#pragma unroll
        for (unsigned j = 0; j < 16; ++j) { const unsigned c = xb_ld(&bar[XB_XCNT(j)]); sum += c; cnt += (c > 0u) ? 1u : 0u; mine = (j == x) ? c : mine; }
        if (sum == G) break;
        __builtin_amdgcn_s_sleep(1);
        if ((++sp & 255u) == 0u) { if (xb_ld(&bar[XB_TMO])) break; if (sp > XB_SPIN_CAP) { atomicAdd(&bar[XB_TMO], 1u); break; } }
    }
    nloc = mine > 0u ? mine : 1u; nx = cnt > 0u ? cnt : 1u;
}
__device__ __forceinline__ void xcd_barrier(const XcdBarrier& b) {
    asm volatile("s_waitcnt vmcnt(0)" ::: "memory");
    __syncthreads();
    if (threadIdx.x == 0) {
        unsigned* bar = b.bar;
        __builtin_amdgcn_s_waitcnt(0);
        unsigned nloc = b.st[0], nx = b.st[1];
        if (nloc == 0u) { xcd_barrier_complete(bar, b.x, nloc, nx); b.st[0] = nloc; b.st[1] = nx; }
        const unsigned old = xb_add(&bar[XB_XSUB(b.x)], 1u);
        const unsigned gen = old / nloc;
        if (old + 1u == (gen + 1u) * nloc) {
            __builtin_amdgcn_fence(__ATOMIC_RELEASE, "agent");
            asm volatile("s_waitcnt vmcnt(0)" ::: "memory");
            const unsigned og = xb_add(&bar[XB_TOP], 1u);
            const unsigned tg = og / nx;
            if (og + 1u == (tg + 1u) * nx) xb_add(&bar[XB_TOPGEN], 1u);
            else XB_SPIN(xb_ld(&bar[XB_TOPGEN]) == tg, bar);
            __builtin_amdgcn_fence(__ATOMIC_ACQUIRE, "agent");
            xb_add(&bar[XB_XGEN(b.x)], 1u);
            asm volatile("s_waitcnt vmcnt(0)" ::: "memory");
        } else {
            XB_SPIN(xb_ld(&bar[XB_XGEN(b.x)]) == gen, bar);
            __builtin_amdgcn_fence(__ATOMIC_ACQUIRE, "agent");
            asm volatile("s_waitcnt vmcnt(0)" ::: "memory");
        }
    }
    __syncthreads();
}

namespace pg8 {
constexpr int BM = 256, BK = 64, HALF = 128, HTB = HALF * BK * 2, STAGE_BYTES = 8 * HTB, NXCD = 8, WGM = 8;
__host__ __device__ __forceinline__ int lds_byte(int r, int c) { const int st = (r >> 4) * 2 + (c >> 5), rr = r & 15, cc = c & 31, ob = rr * 64 + cc * 2; return st * 1024 + (ob ^ (((ob >> 9) & 1) << 5)); }
__host__ __device__ __forceinline__ void stage_rc(int b, int& R, int& C) { const int st = b / 1024, sb = b % 1024, swz = sb ^ (((sb >> 9) & 1) << 5); R = (st >> 1) * 16 + swz / 64; C = (st & 1) * 32 + (swz % 64) / 2; }
__host__ __device__ __forceinline__ int perm32(int rho) { const int n = rho >> 4, i = rho & 15; return 8 * (i >> 2) + 4 * n + (i & 3); }

struct Unit { int pm, pn, pb; };
struct Gemm { const bf16_t* A; const bf16_t* Bt; int lda, ldb, K; };

struct DenseOrder {
    int nM, nN, nwg, G, c;
    __device__ void init(int nM_, int nN_, int G_, int c_) { nM = nM_; nN = nN_; nwg = nM * nN; G = G_; c = c_; }
    __device__ bool next(int i, Unit& u) const {
        const long L = (long)i * G + c; if (L >= nwg) return false;
        int wgid = (int)L; { const int q = nwg / NXCD, r = nwg % NXCD, xcd = wgid % NXCD, off = wgid / NXCD; wgid = (xcd < r ? xcd * (q + 1) : r * (q + 1) + (xcd - r) * q) + off; }
        const int nig = WGM * nN, gid = wgid / nig, fm = gid * WGM, gsz = (nM - fm) < WGM ? (nM - fm) : WGM;
        u.pm = fm + ((wgid % nig) % gsz); u.pn = (wgid % nig) / gsz; u.pb = u.pn; return true;
    }
    __device__ __forceinline__ void a_ready(const Unit&) const {}
};
struct GroupedOrder {
    int nM, nN, nwg, G, c; const LAS int* tile_e; const LAS int* pstart; const LAS int* cnt; const int* list;
    __device__ void init(int nN_, int G_, int c_, const LAS int* tab, const int* list_) { pstart = tab; cnt = tab + 64; tile_e = tab + 128; list = list_; nM = pstart[32] >> 8; nN = nN_; nwg = nM * nN; G = G_; c = c_; }
    __device__ bool next(int i, Unit& u) const {
        const long L = (long)i * G + c; if (L >= nwg) return false;
        const int w = (int)L; u.pn = w % nN; u.pm = w / nN; u.pb = tile_e[u.pm] * nN + u.pn; return true;
    }
    __device__ int arow(const Unit& u, int r) const { const int e = tile_e[u.pm], j = 256 * u.pm - pstart[e] + r; return j < cnt[e] ? list[e * T + j] : 0; }
    __device__ __forceinline__ void a_ready(const Unit&) const {}
};
struct RedealOrder {
    int nM, nN, nwg, G, c, r10, X, nlight, head; const LAS int* tile_e; unsigned* ready; unsigned need; unsigned* tmo;
    __device__ void init(int nN_, int G_, int c_, const LAS int* tab, int nN10, unsigned* ready_, unsigned need_, unsigned* tmo_) {
        tile_e = tab + 128; nM = tab[32] >> 8; nN = nN_; nwg = nM * nN; G = G_; c = c_; ready = ready_; need = need_; tmo = tmo_;
        r10 = (nM * nN10) % G; X = r10 ? 3 : 0; nlight = G - r10; head = X * nlight < nwg ? X * nlight : nwg; }
    __device__ bool next(int i, Unit& u) const {
        long id;
        if (c >= r10 && X) id = i < X ? (long)i * nlight + (c - r10) : (long)head + (long)(i - X) * G + c;
        else id = (long)head + (long)i * G + c;
        if ((i < X && c >= r10 && id >= head) || id >= nwg) return false;
        u.pm = (int)id / nN; u.pn = (int)id % nN; u.pb = tile_e[u.pm] * nN + u.pn; return true;
    }
    __device__ __forceinline__ void a_ready(const Unit& u) const {
        if (threadIdx.x < 64) {
            unsigned polls = 0;
            while ((unsigned)__builtin_amdgcn_readfirstlane(__hip_atomic_load(ready + 64 * u.pm, __ATOMIC_RELAXED, __HIP_MEMORY_SCOPE_AGENT)) < need) {
                if (++polls > (1u << 16)) { if (threadIdx.x == 0) __hip_atomic_store(tmo, 0xDEAD0000u | (unsigned)u.pm, __ATOMIC_RELAXED, __HIP_MEMORY_SCOPE_AGENT); break; }
                __builtin_amdgcn_s_sleep(2); }
            __builtin_amdgcn_fence(__ATOMIC_ACQUIRE, "agent");
            asm volatile("s_waitcnt vmcnt(0)" ::: "memory");
        }
        asm volatile("" ::: "memory"); __builtin_amdgcn_s_barrier(); asm volatile("" ::: "memory");
    }
};

template <class Epi, class Sched, bool GATHER = false>
__device__ __forceinline__ void gemm_phase(LAS unsigned char* lds, const Gemm g, const Sched& S, const Epi& E) {
    int tid = threadIdx.x; asm volatile("" : "+v"(tid));
    const int wid = __builtin_amdgcn_readfirstlane(tid >> 6), lane = tid & 63, wr = wid >> 2, wc = wid & 3, fr = lane & 15, fq = lane >> 4;
    const int K = g.K, nt = K / BK;
    unsigned voffA[2], voffB[2]; int gR[2], gC[2];
#pragma unroll
    for (int i = 0; i < 2; ++i) { int R, C; stage_rc(tid * 16 + i * 8192, R, C); const int Rb = (R & ~31) + perm32(R & 31); gR[i] = R; gC[i] = C;
        voffA[i] = (unsigned)(R * g.lda + C) * 2u; voffB[i] = (unsigned)(Rb * g.ldb + C) * 2u; }
    const size_t kstep = (size_t)(BK * 2);
    const size_t hsA = (size_t)HALF * g.lda * 2, hsB = (size_t)HALF * g.ldb * 2;
    const unsigned ldsw = (unsigned)wid * 1024u;
    const int aoff = lds_byte(wr * 64 + fr, fq * 8), boff = lds_byte(wc * 32 + fr, fq * 8);
#define PG8_SA(b, h) (((b) * 2 + (h)) * HTB)
#define PG8_SB(b, h) ((4 + (b) * 2 + (h)) * HTB)
#define PG8_STAGE(bufoff, gbase, voff) do { _Pragma("unroll") for (int _i = 0; _i < 2; ++_i) \
        __builtin_amdgcn_global_load_lds((const unsigned*)((const char*)(gbase) + (voff)[_i]), (LAS unsigned*)(lds + (bufoff) + ldsw + _i * 8192), 16, 0, 0); } while (0)
#define PG8_STAGE_A(bufoff, dense_ptr, kbytes, offs) do { if constexpr (GATHER) { PG8_STAGE(bufoff, (const char*)g.A + (kbytes), offs); } else { PG8_STAGE(bufoff, dense_ptr, voffA); } } while (0)
#define PG8_GOFF(u, o0, o1) do { _Pragma("unroll") for (int _i = 0; _i < 2; ++_i) { o0[_i] = (unsigned)(S.arow(u, gR[_i]) * g.lda + gC[_i]) * 2u; o1[_i] = (unsigned)(S.arow(u, gR[_i] + HALF) * g.lda + gC[_i]) * 2u; } } while (0)
#define PG8_LDA(dst, b, h) do { _Pragma("unroll") for (int m = 0; m < 4; ++m) _Pragma("unroll") for (int k = 0; k < 2; ++k) dst[m][k] = *(const LAS bf16x8*)(lds + PG8_SA(b, h) + aoff + m * 2048 + k * 1024); } while (0)
#define PG8_LDB(dst, b, h) do { _Pragma("unroll") for (int n = 0; n < 2; ++n) _Pragma("unroll") for (int k = 0; k < 2; ++k) dst[n][k] = *(const LAS bf16x8*)(lds + PG8_SB(b, h) + boff + n * 2048 + k * 1024); } while (0)
#define PG8_MMA(ai, bj, At, Bt) do { __builtin_amdgcn_s_setprio(1); _Pragma("unroll") for (int m = 0; m < 4; ++m) _Pragma("unroll") for (int n = 0; n < 2; ++n) _Pragma("unroll") for (int k = 0; k < 2; ++k) \
        acc[ai][bj][m][n] = __builtin_amdgcn_mfma_f32_16x16x32_bf16(Bt[n][k], At[m][k], acc[ai][bj][m][n], 0, 0, 0); __builtin_amdgcn_s_setprio(0); } while (0)
#define PG8_WAIT_V(n) asm volatile("s_waitcnt vmcnt(" #n ")" ::: "memory")
#define PG8_WAIT_L(n) asm volatile("s_waitcnt lgkmcnt(" #n ")" ::: "memory")
#define PG8_BAR __builtin_amdgcn_s_barrier()
#define PG8_SCHED __builtin_amdgcn_sched_barrier(0)
    Unit cur, nxt; int ui = 0;
    if (!S.next(0, cur)) return;
    unsigned cO0[2] = {0u, 0u}, cO1[2] = {0u, 0u}, nO0[2] = {0u, 0u}, nO1[2] = {0u, 0u};
    if constexpr (GATHER) { PG8_GOFF(cur, cO0, cO1); }
    S.a_ready(cur);
    f32x4 acc[2][2][4][2];
#pragma unroll
    for (int a = 0; a < 2; ++a)
#pragma unroll
        for (int b = 0; b < 2; ++b)
#pragma unroll
            for (int m = 0; m < 4; ++m)
#pragma unroll
                for (int n = 0; n < 2; ++n) acc[a][b][m][n] = (f32x4){0.f, 0.f, 0.f, 0.f};
    bf16x8 At[4][2], B0[2][2], B1[2][2];
    const char* cA = (const char*)g.A + (GATHER ? (size_t)0 : (size_t)cur.pm * 2 * hsA); const char* cB = (const char*)g.Bt + (size_t)cur.pb * 2 * hsB;
    PG8_STAGE(PG8_SB(0, 0), cB, voffB); PG8_STAGE(PG8_SB(0, 1), cB + hsB, voffB); PG8_STAGE_A(PG8_SA(0, 0), cA, 0, cO0); PG8_STAGE_A(PG8_SA(0, 1), cA + hsA, 0, cO1);
    if (wr == 1) PG8_BAR;
    PG8_WAIT_V(2); PG8_BAR;
    PG8_STAGE(PG8_SB(1, 0), cB + kstep, voffB); PG8_STAGE_A(PG8_SA(1, 0), cA + kstep, kstep, cO0); PG8_STAGE(PG8_SB(1, 1), cB + hsB + kstep, voffB);
    PG8_WAIT_V(6); PG8_BAR;
    for (;;) {
        const bool has_next = S.next(ui + 1, nxt);
        const char* nA = (has_next && !GATHER) ? (const char*)g.A + (size_t)nxt.pm * 2 * hsA : cA; const char* nB = has_next ? (const char*)g.Bt + (size_t)nxt.pb * 2 * hsB : cB;
        if constexpr (GATHER) { if (has_next) { PG8_GOFF(nxt, nO0, nO1); } else { nO0[0] = cO0[0]; nO0[1] = cO0[1]; nO1[0] = cO1[0]; nO1[1] = cO1[1]; } }
        for (int t = 0; t < nt; t += 2) {
            const bool last = (t == nt - 2);
            if (last && has_next) S.a_ready(nxt);
            const char* a1 = cA + (size_t)(t + 1) * kstep;
            const char* a2 = last ? nA : cA + (size_t)(t + 2) * kstep; const char* b2 = last ? nB : cB + (size_t)(t + 2) * kstep;
            const char* a3 = a2 + kstep; const char* b3 = b2 + kstep;
            const size_t k2 = last ? (size_t)0 : (size_t)(t + 2) * kstep;
            unsigned o0[2], o1[2]; o0[0] = last ? nO0[0] : cO0[0]; o0[1] = last ? nO0[1] : cO0[1]; o1[0] = last ? nO1[0] : cO1[0]; o1[1] = last ? nO1[1] : cO1[1];
            PG8_LDB(B0, 0, 0); PG8_LDB(B1, 0, 1); PG8_SCHED; PG8_LDA(At, 0, 0); PG8_STAGE_A(PG8_SA(1, 1), a1 + hsA, (size_t)(t + 1) * kstep, cO1);
            PG8_WAIT_V(8); PG8_WAIT_L(0); PG8_BAR; PG8_MMA(0, 0, At, B0); PG8_MMA(0, 1, At, B1); PG8_BAR; PG8_SCHED;
            PG8_LDA(At, 0, 1); PG8_STAGE(PG8_SB(0, 0), b2, voffB); PG8_STAGE(PG8_SB(0, 1), b2 + hsB, voffB); PG8_STAGE_A(PG8_SA(0, 0), a2, k2, o0);
            PG8_WAIT_V(8); PG8_WAIT_L(0); PG8_BAR; PG8_MMA(1, 0, At, B0); PG8_MMA(1, 1, At, B1); PG8_BAR; PG8_SCHED;
            PG8_LDB(B0, 1, 0); PG8_LDB(B1, 1, 1); PG8_SCHED; PG8_LDA(At, 1, 0); PG8_STAGE_A(PG8_SA(0, 1), a2 + hsA, k2, o1);
            PG8_WAIT_V(8); PG8_WAIT_L(0); PG8_BAR; PG8_MMA(0, 0, At, B0); PG8_MMA(0, 1, At, B1); PG8_BAR; PG8_SCHED;
            PG8_LDA(At, 1, 1); PG8_STAGE(PG8_SB(1, 0), b3, voffB); PG8_STAGE(PG8_SB(1, 1), b3 + hsB, voffB); PG8_STAGE_A(PG8_SA(1, 0), a3, k2 + kstep, o0);
            PG8_WAIT_V(8); PG8_WAIT_L(0); PG8_BAR; PG8_MMA(1, 0, At, B0); PG8_MMA(1, 1, At, B1); PG8_BAR; PG8_SCHED;
        }
        if (wr == 0) PG8_BAR;
        E(acc, cur, wr, wc, fr, fq);
        if (!has_next) break;
#pragma unroll
        for (int a = 0; a < 2; ++a)
#pragma unroll
            for (int b = 0; b < 2; ++b)
#pragma unroll
                for (int m = 0; m < 4; ++m)
#pragma unroll
                    for (int n = 0; n < 2; ++n) acc[a][b][m][n] = (f32x4){0.f, 0.f, 0.f, 0.f};
        cur = nxt; cA = nA; cB = nB; ++ui;
        if constexpr (GATHER) { cO0[0] = nO0[0]; cO0[1] = nO0[1]; cO1[0] = nO1[0]; cO1[1] = nO1[1]; }
        if (wr == 1) PG8_BAR;
    }
    PG8_WAIT_V(0);
    PG8_BAR;
#undef PG8_SA
#undef PG8_SB
#undef PG8_STAGE
#undef PG8_STAGE_A
#undef PG8_GOFF
#undef PG8_LDA
#undef PG8_LDB
#undef PG8_MMA
#undef PG8_WAIT_V
#undef PG8_WAIT_L
#undef PG8_BAR
#undef PG8_SCHED
}

struct EpiStore {
    bf16_t* O; int ldc; const float* ssq; float inv; float* ssq_out0; float* ssq_out1; int pn0, pn1, pn2;
    __device__ __forceinline__ void operator()(const f32x4 (&acc)[2][2][4][2], const Unit& u, int wr, int wc, int fr, int fq) const {
        const int row0 = u.pm * BM + wr * 64 + fr, col0 = u.pn * BM + wc * 32 + 8 * fq;
        float* so = (ssq_out0 && u.pn >= pn0 && u.pn < pn2) ? (u.pn < pn1 ? ssq_out0 : ssq_out1) : nullptr;
        float rsv[2][4];
#pragma unroll
        for (int ai = 0; ai < 2; ++ai)
#pragma unroll
            for (int m = 0; m < 4; ++m) rsv[ai][m] = ssq ? ssq[row0 + ai * HALF + m * 16] : 0.f;
#pragma unroll
        for (int ai = 0; ai < 2; ++ai)
#pragma unroll
            for (int m = 0; m < 4; ++m) { const int row = row0 + ai * HALF + m * 16; const float rs = ssq ? rsqrtf(rsv[ai][m] * inv + EPS) : 1.f;
                bf16_t* rowp = O + (size_t)row * ldc + col0; float ss = 0.f;
#pragma unroll
                for (int bj = 0; bj < 2; ++bj) { const f32x4 v0 = acc[ai][bj][m][0] * rs, v1 = acc[ai][bj][m][1] * rs;
                    ss += (v0[0] * v0[0] + v0[1] * v0[1]) + (v0[2] * v0[2] + v0[3] * v0[3]) + (v1[0] * v1[0] + v1[1] * v1[1]) + (v1[2] * v1[2] + v1[3] * v1[3]);
                    u32x4 w; w.x = cvt_pk_bf16(v0[0], v0[1]); w.y = cvt_pk_bf16(v0[2], v0[3]); w.z = cvt_pk_bf16(v1[0], v1[1]); w.w = cvt_pk_bf16(v1[2], v1[3]);
                    *(u32x4*)(rowp + bj * HALF) = w; }
                if (so) { ss += __shfl_xor(ss, 16); ss += __shfl_xor(ss, 32); if (fq == 0) atomicAdd(so + row, ss); } }
    }
};
struct EpiResid {
    const float* X; float* O; const float* gate; int gpitch;
    __device__ __forceinline__ void operator()(const f32x4 (&acc)[2][2][4][2], const Unit& u, int wr, int wc, int fr, int fq) const {
        const int row0 = u.pm * BM + wr * 64 + fr, col0 = u.pn * BM + wc * 32 + 8 * fq;
        const float* gp = gate + (size_t)((u.pm * BM) / SEQ) * gpitch + col0;
        f32x4 gv[2][2];
#pragma unroll
        for (int bj = 0; bj < 2; ++bj)
#pragma unroll
            for (int n = 0; n < 2; ++n) gv[bj][n] = *(const f32x4*)(gp + bj * HALF + 4 * n);
#pragma unroll
        for (int ai = 0; ai < 2; ++ai)
#pragma unroll
            for (int m = 0; m < 4; ++m) { const size_t off = (size_t)(row0 + ai * HALF + m * 16) * DM + col0;
#pragma unroll
                for (int bj = 0; bj < 2; ++bj)
#pragma unroll
                    for (int n = 0; n < 2; ++n) { const f32x4 xv = *(const f32x4*)(X + off + bj * HALF + 4 * n);
                        *(f32x4*)(O + off + bj * HALF + 4 * n) = xv + gv[bj][n] * acc[ai][bj][m][n]; } }
    }
};
struct EpiSwiGLU {
    bf16_t* O; unsigned* ready;
    __device__ __forceinline__ void operator()(const f32x4 (&acc)[2][2][4][2], const Unit& u, int wr, int wc, int fr, int fq) const {
        const int row0 = u.pm * BM + wr * 64 + fr, col0 = u.pn * HALF + wc * 32 + 8 * fq;
        const __amdgpu_buffer_rsrc_t rs = __builtin_amdgcn_make_buffer_rsrc((void*)O, (short)0, RMAX * DE * 2, 0x00020000);
#pragma unroll
        for (int ai = 0; ai < 2; ++ai)
#pragma unroll
            for (int m = 0; m < 4; ++m) { const int row = row0 + ai * HALF + m * 16;
                float h[8];
#pragma unroll
                for (int n = 0; n < 2; ++n)
#pragma unroll
                    for (int j = 0; j < 4; ++j) { const float gt = acc[ai][0][m][n][j], up = acc[ai][1][m][n][j]; h[4 * n + j] = gt / (1.f + __expf(-gt)) * up; }
                u32x4 w; w.x = cvt_pk_bf16(h[0], h[1]); w.y = cvt_pk_bf16(h[2], h[3]); w.z = cvt_pk_bf16(h[4], h[5]); w.w = cvt_pk_bf16(h[6], h[7]);
                __builtin_amdgcn_raw_buffer_store_b128(w, rs, (unsigned)(row * DE + col0) * 2u, 0, 16); }
        asm volatile("s_waitcnt vmcnt(0)" ::: "memory");
        if ((threadIdx.x & 63) == 0) __hip_atomic_fetch_add(ready + 64 * u.pm, 1u, __ATOMIC_RELAXED, __HIP_MEMORY_SCOPE_AGENT);
    }
};
}
constexpr size_t MiB = 1u << 20;
constexpr size_t WS_CTL = 0, CTL_ZERO_BYTES = 1 * MiB;
constexpr size_t WS_MOD = 1 * MiB;
constexpr size_t WS_ROPEC = 1 * MiB + 512 * 1024;
constexpr size_t WS_ROPES = WS_ROPEC + 2 * MiB;
constexpr size_t WS_WCT = WS_ROPES + 2 * MiB;
constexpr size_t WS_RSTDQ = 6 * MiB;
constexpr size_t WS_RSTDKV = WS_RSTDQ + 64 * 1024;
constexpr size_t WS_TOKE = WS_RSTDKV + 64 * 1024;
constexpr size_t WS_TOKW = WS_TOKE + 128 * 1024;
constexpr size_t WS_TOKS = WS_TOKW + 128 * 1024;
constexpr size_t WS_BLKE = WS_TOKS + 128 * 1024;
constexpr size_t WS_STAMP = WS_BLKE + 4096;
constexpr size_t WS_WIN = 8 * MiB;
constexpr size_t WS_WQUP = 28 * MiB;
constexpr size_t WS_WKVUP = WS_WQUP + 1536 * 1024;
constexpr size_t WS_WOUT = 31 * MiB;
constexpr size_t WS_A = 40 * MiB;
constexpr size_t WS_B = 200 * MiB;
constexpr size_t WS_C = 264 * MiB;
constexpr size_t WS_D = 328 * MiB;
constexpr size_t WS_E = 456 * MiB;
constexpr size_t WS_LIST = 520 * MiB;
constexpr size_t WS_F = 522 * MiB;
constexpr size_t WS_END = 586 * MiB;
constexpr size_t QN_BYTES = (size_t)T * MH * MQK * 2;

constexpr int CW_BAR = 4096;
constexpr int CW_CNT = 8192;
constexpr int CW_RDY = 10240;
constexpr int CW_TMO = 1;

constexpr int RING_BYTES = 131072, LDS_BYTES = 147456, LDS_USER = 143360, MISC_OFF = LDS_BYTES - 512;

struct Args { const float* in[25]; float* out; unsigned char* ws; int ph_lo, ph_hi, pad0, pad1; };

struct Frame {
    LAS unsigned char* lds;
    volatile LAS unsigned* MISC;
    gu32* ctl;
    int tid, lane, wave, vcu, G;
    unsigned char* ws; float* out;
};

#define OPAQUE_FRAME(F) do { F.tid = threadIdx.x; asm volatile("" : "+v"(F.tid)); F.lane = F.tid & 63; } while (0)

__device__ __forceinline__ void unpack8(const u32x4 w, float* f) { f[0] = bf_lo(w.x); f[1] = bf_hi(w.x); f[2] = bf_lo(w.y); f[3] = bf_hi(w.y); f[4] = bf_lo(w.z); f[5] = bf_hi(w.z); f[6] = bf_lo(w.w); f[7] = bf_hi(w.w); }
__device__ __forceinline__ u32x4 pack8f(const float* f) { u32x4 w; w.x = cvt_pk_bf16(f[0], f[1]); w.y = cvt_pk_bf16(f[2], f[3]); w.z = cvt_pk_bf16(f[4], f[5]); w.w = cvt_pk_bf16(f[6], f[7]); return w; }

struct TrItem { const float* src; bf16_t* dst; bf16_t* dst2; const float* gk; int N, ldt; };
__device__ __forceinline__ void tr_load(const TrItem& it, f32x4 (&r)[16], int lane) {
    const float* p = it.src + (size_t)(lane >> 4) * it.N + 4 * (lane & 15);
#pragma unroll
    for (int i = 0; i < 16; ++i) r[i] = __builtin_nontemporal_load((const f32x4*)(p + (size_t)(4 * i) * it.N));
}
__device__ __forceinline__ void tr_store(const TrItem& it, const f32x4 (&r)[16], LAS unsigned char* Tl, int lane) {
    const int row = lane >> 4, c4 = lane & 15;
#pragma unroll
    for (int i = 0; i < 16; ++i) { f32x4 v = r[i]; if (it.gk) v = v * it.gk[4 * i + row];
        u32x2 w; w.x = cvt_pk_bf16(v.x, v.y); w.y = cvt_pk_bf16(v.z, v.w);
        *(LAS u32x2*)(Tl + ((4 * i + row) * 64 + 4 * c4) * 2) = w; }
    LDS_WAIT(); asm volatile("" ::: "memory");
    const int g = lane >> 4, i16 = lane & 15, q = i16 >> 2, pp = lane & 3;
    typedef short v4i16_t __attribute__((ext_vector_type(4)));
#pragma unroll
    for (int hh = 0; hh < 2; ++hh) { bf16_t* drow = (hh ? it.dst2 : it.dst) + (size_t)(16 * (g & 1) + i16) * it.ldt;
#pragma unroll
        for (int j = 0; j < 4; ++j) { const int kc = 4 * (g >> 1) + j;
            const v4i16_t lo = __builtin_amdgcn_ds_read_tr16_b64_v4i16((LAS v4i16_t*)(Tl + ((8 * kc + q) * 64 + 32 * hh + 16 * (g & 1) + 4 * pp) * 2));
            const v4i16_t hi = __builtin_amdgcn_ds_read_tr16_b64_v4i16((LAS v4i16_t*)(Tl + ((8 * kc + 4 + q) * 64 + 32 * hh + 16 * (g & 1) + 4 * pp) * 2));
            const bf16x8 o = {lo[0], lo[1], lo[2], lo[3], hi[0], hi[1], hi[2], hi[3]};
            *(bf16x8*)(drow + 8 * kc) = o; } }
    LDS_WAIT(); asm volatile("" ::: "memory");
}
template <class MK> __device__ __forceinline__ void tr_run(int first, int step, int n, const MK& mk, LAS unsigned char* Tl, int lane) {
    if (first >= n) return;
    f32x4 ra[16], rb[16];
    TrItem ia = mk(first), ib = ia;
    tr_load(ia, ra, lane);
    for (int idx = first; idx < n; idx += 2 * step) {
        if (idx + step < n) { ib = mk(idx + step); tr_load(ib, rb, lane); }
        tr_store(ia, ra, Tl, lane);
        if (idx + step >= n) break;
        if (idx + 2 * step < n) { ia = mk(idx + 2 * step); tr_load(ia, ra, lane); }
        tr_store(ib, rb, Tl, lane);
    }
}

__device__ __forceinline__ void adaln_phase(Frame& F, const float* c, const float* w_ada, const float* b_ada, float* mod) {
    LAS float* cact = (LAS float*)F.lds;
    LAS float* part = (LAS float*)(F.lds + 65536);
    for (int i = F.tid; i < NB * DM; i += NTHR) cact[i] = siluf(c[i]);
    __syncthreads();
    const int cg = F.tid & 7, rs = F.tid >> 3;
    for (int it = blockIdx.x; it < 6 * DM / 32; it += F.G) {
        const int n0 = it * 32 + cg * 4;
        f32x4 acc[8];
#pragma unroll
        for (int b = 0; b < 8; ++b) acc[b] = (f32x4){0.f, 0.f, 0.f, 0.f};
#pragma unroll 1
        for (int i0 = 0; i0 < 32; i0 += 16) { f32x4 w[16];
#pragma unroll
            for (int u = 0; u < 16; ++u) w[u] = __builtin_nontemporal_load((const f32x4*)(w_ada + (size_t)(rs + 64 * (i0 + u)) * (6 * DM) + n0));
#pragma unroll
            for (int u = 0; u < 16; ++u) { const int k = rs + 64 * (i0 + u);
#pragma unroll
                for (int b = 0; b < 8; ++b) acc[b] += w[u] * cact[b * DM + k]; } }
#pragma unroll
        for (int b = 0; b < 8; ++b) *(LAS f32x4*)(part + (rs * 8 + b) * 32 + cg * 4) = acc[b];
        __syncthreads();
        if (F.tid < 256) { const int b = F.tid >> 5, n = F.tid & 31; float s = 0.f;
#pragma unroll 8
            for (int r = 0; r < 64; ++r) s += part[(r * 8 + b) * 32 + n];
            mod[b * (6 * DM) + it * 32 + n] = s + b_ada[it * 32 + n]; }
        __syncthreads();
    }
}

__device__ __forceinline__ void p0_phase(Frame& F, const Args& a) {
    OPAQUE_FRAME(F);
    unsigned char* ws = F.ws;
    adaln_phase(F, a.in[1], a.in[3], a.in[4], (float*)(ws + WS_MOD));
    __syncthreads();
    LAS unsigned char* Tl = F.lds + F.wave * 8192;
    const int gw = F.vcu * NWAVES + F.wave, NGW = F.G * NWAVES;
    constexpr int I_IN = (DM / 64) * (INC / 64), I_QUP = (QLORA / 64) * (MH * MQK / 64), I_KVUP = (KVLORA / 64) * (MH * 256 / 64), I_OUT = (DM / 64) * (DM / 64);
    constexpr int NITEMS = I_IN + I_QUP + I_KVUP + I_OUT;
    static_assert(INC % 64 == 0, "64-column transpose items");
    { const float* w_in = a.in[6]; const float* w_qup = a.in[10]; const float* w_kvup = a.in[12]; const float* w_out = a.in[16]; const float* gq = a.in[9]; const float* gkv = a.in[11];
      auto mk = [=](int r) -> TrItem { TrItem t;
          if (r < I_IN) { const int nblk = INC / 64, kb = r / nblk, nb = r % nblk; t.src = w_in + (size_t)(64 * kb) * INC + 64 * nb; t.dst = (bf16_t*)(ws + WS_WIN) + (size_t)(64 * nb) * DM + 64 * kb; t.dst2 = t.dst + (size_t)32 * DM; t.gk = nullptr; t.N = INC; t.ldt = DM; return t; } r -= I_IN;
          if (r < I_QUP) { const int nblk = MH * MQK / 64, kb = r / nblk, nb = r % nblk; t.src = w_qup + (size_t)(64 * kb) * (MH * MQK) + 64 * nb; t.dst = (bf16_t*)(ws + WS_WQUP) + (size_t)(64 * nb) * QLORA + 64 * kb; t.dst2 = t.dst + (size_t)32 * QLORA; t.gk = gq + 64 * kb; t.N = MH * MQK; t.ldt = QLORA; return t; } r -= I_QUP;
          if (r < I_KVUP) { const int nblk = MH * 256 / 64, kb = r / nblk, nb = r % nblk; t.src = w_kvup + (size_t)(64 * kb) * (MH * 256) + 64 * nb; t.dst = (bf16_t*)(ws + WS_WKVUP) + (size_t)(64 * nb) * KVLORA + 64 * kb; t.dst2 = t.dst + (size_t)32 * KVLORA; t.gk = gkv + 64 * kb; t.N = MH * 256; t.ldt = KVLORA; return t; } r -= I_KVUP;
          { const int nblk = DM / 64, kb = r / nblk, nb = r % nblk; t.src = w_out + (size_t)(64 * kb) * DM + 64 * nb; t.dst = (bf16_t*)(ws + WS_WOUT) + (size_t)(64 * nb) * DM + 64 * kb; t.dst2 = t.dst + (size_t)32 * DM; t.gk = nullptr; t.N = DM; t.ldt = DM; return t; } };
      const int nheavy = (6 * DM / 32) - F.G, nlw = (F.G - nheavy) * NWAVES;
      int pre = 0;
      if (nheavy > 0 && nheavy < F.G) { pre = 2 * nlw < NITEMS ? 2 * nlw : NITEMS;
          if ((int)blockIdx.x >= nheavy) tr_run(((int)blockIdx.x - nheavy) * NWAVES + F.wave, nlw, pre, mk, Tl, F.lane); }
      tr_run(pre + gw, NGW, NITEMS, mk, Tl, F.lane); }
    { const int* pos = (const int*)a.in[2]; float* rc = (float*)(ws + WS_ROPEC); float* rsn = (float*)(ws + WS_ROPES);
      const int gt = F.vcu * NTHR + F.tid, NGT = F.G * NTHR;
      const float invf = (float)exp2(-(double)(gt & 31) * (13.287712379549449 / 32.0));
      for (int e = gt; e < T * 32; e += NGT) { const int tk = e >> 5;
          const float ang = (float)pos[tk] * invf; float sv, cv; sincosf(ang, &sv, &cv);
          rc[e] = cv; rsn[e] = sv; }
      { float* ssq = (float*)(ws + WS_RSTDQ); for (int e = gt; e < 2 * T; e += NGT) ssq[e] = 0.f; }
      float* wct = (float*)(ws + WS_WCT);
      for (int e = gt; e < 48 * DM; e += NGT) { const int n = e / DM, k = e % DM;
          wct[e] = n < 4 ? a.in[18][k * NG + n] : (n < 36 ? a.in[20][k * NE + (n - 4)] : 0.f); } }
}

__device__ __forceinline__ void p1_phase(Frame& F, const Args& a) {
    OPAQUE_FRAME(F);
    const int gw = F.vcu * NWAVES + F.wave, NGW = F.G * NWAVES;
    const float* mod = (const float*)(F.ws + WS_MOD); const float* g = a.in[5]; const float* x = a.in[0];
    bf16_t* H = (bf16_t*)(F.ws + WS_B);
    for (int blk = gw; blk < T / 8; blk += NGW) { const int m0 = blk * 8, b = m0 / SEQ;
        const float* shift = mod + b * (6 * DM); const float* scale = shift + DM;
        f32x4 gm[8], sh[8];
#pragma unroll
        for (int j = 0; j < 8; ++j) { gm[j] = ((const f32x4*)g)[64 * j + F.lane] * (((const f32x4*)scale)[64 * j + F.lane] + 1.f); sh[j] = ((const f32x4*)shift)[64 * j + F.lane]; }
        f32x4 va[8], vb[8];
#define P1_LD(r, V) do { const f32x4* xr_ = (const f32x4*)(x + (size_t)(m0 + (r)) * DM) + F.lane; _Pragma("unroll") for (int j = 0; j < 8; ++j) V[j] = __builtin_nontemporal_load(xr_ + 64 * j); } while (0)
#define P1_ST(r, V) do { float s_ = 0.f; _Pragma("unroll") for (int j = 0; j < 8; ++j) s_ += (V[j].x * V[j].x + V[j].y * V[j].y) + (V[j].z * V[j].z + V[j].w * V[j].w); \
            const float rstd_ = rsqrtf(wave_sum(s_) * (1.f / DM) + EPS); u32x2* o8_ = (u32x2*)(H + (size_t)(m0 + (r)) * DM) + F.lane; \
            _Pragma("unroll") for (int j = 0; j < 8; ++j) { const f32x4 h_ = V[j] * rstd_ * gm[j] + sh[j]; u32x2 w_; w_.x = cvt_pk_bf16(h_.x, h_.y); w_.y = cvt_pk_bf16(h_.z, h_.w); o8_[64 * j] = w_; } } while (0)
        P1_LD(0, va);
#pragma unroll 1
        for (int r = 0; r < 8; r += 2) {
            P1_LD(r + 1, vb); __builtin_amdgcn_sched_barrier(0);
            P1_ST(r, va); __builtin_amdgcn_sched_barrier(0);
            if (r + 2 < 8) { P1_LD(r + 2, va); } __builtin_amdgcn_sched_barrier(0);
            P1_ST(r + 1, vb); __builtin_amdgcn_sched_barrier(0);
        }
#undef P1_LD
#undef P1_ST
    }
}

namespace hg {
constexpr int OFF_F = 0, OFF_SEG = 32768, OFF_QIN = 34816, RP = 272, OFF_KIN = OFF_QIN + 64 * RP, OFF_QB = OFF_KIN + 64 * RP, OFF_KLT = OFF_QB + 64 * RP, SP = 144,
              OFF_VT = OFF_KLT + 128 * SP  , OFF_DEC = OFF_VT + 64 * SP  , OFF_SF = OFF_DEC + 3584  , HG_LDS = OFF_SF + 16384;
static_assert(HG_LDS <= LDS_USER, "hgrn lds");
__device__ __forceinline__ int ppos(int s) { return (s & ~15) | ((s & 4) << 1) | ((s & 8) >> 1) | (s & 3); }
}
__device__ __forceinline__ void hgrn_chunked(Frame& F, const Args& a, int item) {
    using namespace hg;
    const bf16_t* PROJ = (const bf16_t*)(F.ws + WS_A);
    bf16_t* MIX = (bf16_t*)F.out;
    const float* lbl = a.in[7];
    LAS unsigned char* L = F.lds;
    LAS float* Fs = (LAS float*)(L + OFF_F); LAS float* SEGs = (LAS float*)(L + OFF_SEG); LAS float* DEC = (LAS float*)(L + OFF_DEC); LAS float* POST = DEC + 384;
    const int g = F.tid & 15, t0 = F.tid >> 4;
    const int sk = F.tid & 127, sseg = F.tid >> 7;
    const int r32 = F.lane & 31, hi = F.lane >> 5;
    {
        const int dq2 = (item >> 3) & 1, bh = (item >> 4) * 8 + (item & 7), h = bh & 7, b = bh >> 3;
        float lb[8];
#pragma unroll
        for (int j = 0; j < 8; ++j) { const int k = h * 128 + g * 8 + j; lb[j] = 1.f / (1.f + __expf(lbl[HW + k] - lbl[k])); }
        const bf16_t* base = PROJ + (size_t)(b * SEQ) * INCP + h * 128;
        f32x16 S0 = {}, S1 = {};
        u32x4 gq[2], gf[2], gv;
#define HG_LOADF(c) do { _Pragma("unroll") for (int i = 0; i < 2; ++i) gf[i] = *(const u32x4*)(base + (size_t)((c) * 64 + t0 + 32 * i) * INCP + g * 8 + HW); } while (0)
#define HG_LOADQ(c) do { _Pragma("unroll") for (int i = 0; i < 2; ++i) gq[i] = *(const u32x4*)(base + (size_t)((c) * 64 + t0 + 32 * i) * INCP + g * 8); \
            gv = *(const u32x4*)(base + (size_t)((c) * 64 + (F.tid >> 3)) * INCP + 2 * HW + dq2 * 64 + (F.tid & 7) * 8); } while (0)
        HG_LOADF(0); HG_LOADQ(0);
        for (int c = 0; c < SEQ / 64; ++c) {
            if (F.wave >= 4) { const int kb = F.wave - 4;
#pragma unroll
                for (int s2 = 0; s2 < 2; ++s2) { u32x4 w0, w1;
                    w0.x = cvt_pk_bf16(S0[8 * s2], S0[8 * s2 + 1]); w0.y = cvt_pk_bf16(S0[8 * s2 + 2], S0[8 * s2 + 3]); w0.z = cvt_pk_bf16(S0[8 * s2 + 4], S0[8 * s2 + 5]); w0.w = cvt_pk_bf16(S0[8 * s2 + 6], S0[8 * s2 + 7]);
                    w1.x = cvt_pk_bf16(S1[8 * s2], S1[8 * s2 + 1]); w1.y = cvt_pk_bf16(S1[8 * s2 + 2], S1[8 * s2 + 3]); w1.z = cvt_pk_bf16(S1[8 * s2 + 4], S1[8 * s2 + 5]); w1.w = cvt_pk_bf16(S1[8 * s2 + 6], S1[8 * s2 + 7]);
                    *(LAS u32x4*)(L + OFF_SF + ((((kb * 2 + 0) * 2 + s2) * 64) + F.lane) * 16) = w0;
                    *(LAS u32x4*)(L + OFF_SF + ((((kb * 2 + 1) * 2 + s2) * 64) + F.lane) * 16) = w1; } }
            float fv[2][8];
#pragma unroll
            for (int i = 0; i < 2; ++i) { float fl[8]; unpack8(gf[i], fl);
#pragma unroll
                for (int j = 0; j < 8; ++j) { const float sg = __builtin_amdgcn_rcpf(1.f + __builtin_amdgcn_exp2f(-1.4426950408889634f * fl[j])); fv[i][j] = lb[j] + (1.f - lb[j]) * sg; }
                LAS float* fp = Fs + (t0 + 32 * i) * 128 + g * 8;
                *(LAS f32x4*)fp = (f32x4){fv[i][0], fv[i][1], fv[i][2], fv[i][3]}; *(LAS f32x4*)(fp + 4) = (f32x4){fv[i][4], fv[i][5], fv[i][6], fv[i][7]}; }
            if (c + 1 < SEQ / 64) HG_LOADF(c + 1);
            __syncthreads();
            float klp[16];
            { float fr[16];
#pragma unroll
              for (int i = 0; i < 16; ++i) fr[i] = Fs[(16 * sseg + i) * 128 + sk];
              float p = 1.f;
#pragma unroll
              for (int i = 0; i < 16; ++i) { p *= fr[i]; Fs[(16 * sseg + i) * 128 + sk] = p; }
              SEGs[sseg * 128 + sk] = p;
              float q = 1.f;
#pragma unroll
              for (int i = 15; i >= 0; --i) { klp[i] = (1.f - fr[i]) * q; q *= fr[i]; } }
            __syncthreads();
            if (F.tid < 128) { const float s0 = SEGs[F.tid], s1 = SEGs[128 + F.tid], s2 = SEGs[256 + F.tid], s3 = SEGs[384 + F.tid];
                const float pm = s0 * s1;
                SEGs[F.tid] = 1.f; SEGs[128 + F.tid] = s0; SEGs[256 + F.tid] = pm; SEGs[384 + F.tid] = pm * s2;
                POST[F.tid] = s1 * s2 * s3; POST[128 + F.tid] = s2 * s3; POST[256 + F.tid] = s3; POST[384 + F.tid] = 1.f;
                DEC[F.tid] = pm * s2 * s3; DEC[128 + F.tid] = pm; DEC[256 + F.tid] = __builtin_amdgcn_rcpf(pm); }
            __syncthreads();
            { { const float po = POST[sseg * 128 + sk];
                float o16[16];
#pragma unroll
                for (int p = 0; p < 16; ++p) o16[p] = klp[8 * ((p >> 2) & 1) + 4 * (p >> 3) + (p & 3)] * po;
                *(LAS u32x4*)(L + OFF_KLT + sk * SP + sseg * 32) = pack8f(o16); *(LAS u32x4*)(L + OFF_KLT + sk * SP + sseg * 32 + 16) = pack8f(o16 + 8); }
#pragma unroll
              for (int i = 0; i < 2; ++i) { const int t = t0 + 32 * i;
                  float qin[8], kin[8], qb[8], qv[8];
                  unpack8(gq[i], qv);
                  const LAS float* fp = Fs + t * 128 + g * 8; const LAS float* pp = SEGs + (t >> 4) * 128 + g * 8;
                  const f32x4 pa = *(const LAS f32x4*)fp, pb = *(const LAS f32x4*)(fp + 4), ea = *(const LAS f32x4*)pp, eb = *(const LAS f32x4*)(pp + 4);
                  const f32x4 ma = *(const LAS f32x4*)(DEC + 128 + g * 8), mb = *(const LAS f32x4*)(DEC + 128 + g * 8 + 4), ra = *(const LAS f32x4*)(DEC + 256 + g * 8), rb = *(const LAS f32x4*)(DEC + 256 + g * 8 + 4);
#pragma unroll
                  for (int j = 0; j < 8; ++j) { const float P = (j < 4 ? pa[j] * ea[j] : pb[j - 4] * eb[j - 4]), pm = j < 4 ? ma[j] : mb[j - 4], rpm = j < 4 ? ra[j] : rb[j - 4];
                      const float r = __builtin_amdgcn_rcpf(P), kk = 1.f - fv[i][j], qs = qv[j] * 0.08838834764831845f;
                      qb[j] = qs * P; qin[j] = qb[j] * rpm; kin[j] = kk * pm * r; }
                  *(LAS u32x4*)(L + OFF_QIN + t * RP + g * 16) = pack8f(qin);
                  *(LAS u32x4*)(L + OFF_KIN + t * RP + g * 16) = pack8f(kin);
                  { const u32x4 w = pack8f(qb);
                    *(LAS u32x2*)(L + OFF_QB + t * RP + ((g >> 1) * 16 + (g & 1) * 4) * 2) = (u32x2){w.x, w.y};
                    *(LAS u32x2*)(L + OFF_QB + t * RP + ((g >> 1) * 16 + 8 + (g & 1) * 4) * 2) = (u32x2){w.z, w.w}; } }
              { float v[8]; unpack8(gv, v); const int s = F.tid >> 3, dvg = F.tid & 7, ps = ppos(s);
#pragma unroll
                  for (int j = 0; j < 8; ++j) *(LAS bf16_t*)(L + OFF_VT + (dvg * 8 + j) * SP + ps * 2) = (bf16_t)(__builtin_bit_cast(unsigned, v[j]) >> 16); } }
            if (c + 1 < SEQ / 64) HG_LOADQ(c + 1);
            __syncthreads();
            if (F.wave < 4) { const int tb = F.wave & 1, dvb = F.wave >> 1;
                f32x16 o = {};
                for (int sb = 0; sb <= tb; ++sb) { f32x16 X = {};
#pragma unroll
                    for (int ks = 0; ks < 8; ++ks) { const bf16x8 af = *(const LAS bf16x8*)(L + OFF_KIN + (32 * sb + r32) * RP + (16 * ks + 8 * hi) * 2);
                        const bf16x8 bfr = *(const LAS bf16x8*)(L + OFF_QIN + (32 * tb + r32) * RP + (16 * ks + 8 * hi) * 2);
                        X = __builtin_amdgcn_mfma_f32_32x32x16_bf16(af, bfr, X, 0, 0, 0); }
                    if (sb == tb) {
#pragma unroll
                        for (int r = 0; r < 16; ++r) { const int srow = (r & 3) + 8 * (r >> 2) + 4 * hi; if (srow > r32) X[r] = 0.f; } }
#pragma unroll
                    for (int s2 = 0; s2 < 2; ++s2) { u32x4 w; w.x = cvt_pk_bf16(X[8 * s2], X[8 * s2 + 1]); w.y = cvt_pk_bf16(X[8 * s2 + 2], X[8 * s2 + 3]); w.z = cvt_pk_bf16(X[8 * s2 + 4], X[8 * s2 + 5]); w.w = cvt_pk_bf16(X[8 * s2 + 6], X[8 * s2 + 7]);
                        const bf16x8 vf = *(const LAS bf16x8*)(L + OFF_VT + (32 * dvb + r32) * SP + (32 * sb + 16 * s2 + 8 * hi) * 2);
                        o = __builtin_amdgcn_mfma_f32_32x32x16_bf16(__builtin_bit_cast(bf16x8, w), vf, o, 0, 0, 0); } }
#pragma unroll
                for (int kb = 0; kb < 4; ++kb)
#pragma unroll
                    for (int s2 = 0; s2 < 2; ++s2) { const bf16x8 sf = *(const LAS bf16x8*)(L + OFF_SF + ((((kb * 2 + dvb) * 2 + s2) * 64) + F.lane) * 16);
                        const bf16x8 qf = *(const LAS bf16x8*)(L + OFF_QB + (32 * tb + r32) * RP + (32 * kb + 16 * s2 + 8 * hi) * 2);
                        o = __builtin_amdgcn_mfma_f32_32x32x16_bf16(qf, sf, o, 0, 0, 0); }
                bf16_t* orow = MIX + (size_t)(b * SEQ + c * 64 + 32 * tb) * DM + h * 128 + dq2 * 64 + dvb * 32 + r32;
#pragma unroll
                for (int r = 0; r < 16; ++r) { const float v = o[r]; const float vn = __shfl_xor(v, 1);
                    if ((r32 & 1) == 0) *(unsigned*)(orow + (size_t)((r & 3) + 8 * (r >> 2) + 4 * hi) * DM) = cvt_pk_bf16(v, vn); }
            } else { const int kb = F.wave - 4;
#pragma unroll
                for (int r = 0; r < 16; ++r) { const float dcy = DEC[32 * kb + (r & 3) + 8 * (r >> 2) + 4 * hi]; S0[r] *= dcy; S1[r] *= dcy; }
#pragma unroll
                for (int ss = 0; ss < 4; ++ss) { const bf16x8 kf = *(const LAS bf16x8*)(L + OFF_KLT + (32 * kb + r32) * SP + (16 * ss + 8 * hi) * 2);
                    const bf16x8 vf0 = *(const LAS bf16x8*)(L + OFF_VT + r32 * SP + (16 * ss + 8 * hi) * 2), vf1 = *(const LAS bf16x8*)(L + OFF_VT + (32 + r32) * SP + (16 * ss + 8 * hi) * 2);
                    S0 = __builtin_amdgcn_mfma_f32_32x32x16_bf16(kf, vf0, S0, 0, 0, 0); S1 = __builtin_amdgcn_mfma_f32_32x32x16_bf16(kf, vf1, S1, 0, 0, 0); }
            }
            __syncthreads();
        }
#undef HG_LOADF
#undef HG_LOADQ
    }
}

constexpr int MOE_IG = NE * (DM / 64) * (DE / 64);
constexpr int MOE_PRE = 9216;
struct MoeItems { const float* wg; const float* wu; const float* wd; unsigned char* ws;
    __device__ TrItem operator()(int it) const { TrItem t; t.gk = nullptr;
        const int which = it / MOE_IG, r = it % MOE_IG;
        if (which < 2) { const int e = r / 256, q = r % 256, kb = q / 8, nb = q % 8, n0 = 64 * nb;
            t.src = (which ? wu : wg) + (size_t)e * DM * DE + (size_t)(64 * kb) * DE + n0;
            t.dst = (bf16_t*)(ws + WS_D) + ((size_t)e * 1024 + (n0 >> 7) * 256 + (n0 & 127) + which * 128) * DM + 64 * kb; t.dst2 = t.dst + (size_t)32 * DM; t.N = DE; t.ldt = DM; }
        else { const int e = r / 256, q = r % 256, kb = q / 32, nb = q % 32, n0 = 64 * nb;
            t.src = wd + (size_t)e * DE * DM + (size_t)(64 * kb) * DM + n0;
            t.dst = (bf16_t*)(ws + WS_E) + ((size_t)e * DM + n0) * DE + 64 * kb; t.dst2 = t.dst + (size_t)32 * DE; t.N = DM; t.ldt = DE; }
        return t; } };

__device__ __forceinline__ void p3_phase(Frame& F, const Args& a) {
    OPAQUE_FRAME(F);
    const int role = ((int)blockIdx.x >> 3) & 1, idx = ((int)blockIdx.x >> 4) * 8 + ((int)blockIdx.x & 7), half = F.G >> 1;
    unsigned char* ws = F.ws;
    if (role == 0) { for (int it = idx; it < NB * HH * 2; it += half) hgrn_chunked(F, a, it); }
    else {
        { pg8::Gemm g{(const bf16_t*)(ws + WS_A) + C_QA, (const bf16_t*)(ws + WS_WQUP), INCP, QLORA, QLORA};
          pg8::DenseOrder S; S.init(T / 256, MH * MQK / 256, half, idx);
          pg8::EpiStore E{(bf16_t*)(ws + WS_B), MH * MQK, (const float*)(ws + WS_RSTDQ), 1.f / QLORA};
          pg8::gemm_phase<pg8::EpiStore, pg8::DenseOrder>(F.lds, g, S, E); }
        { pg8::Gemm g{(const bf16_t*)(ws + WS_A) + C_KVA, (const bf16_t*)(ws + WS_WKVUP), INCP, KVLORA, KVLORA};
          pg8::DenseOrder S; S.init(T / 256, MH * 256 / 256, half, idx);
          pg8::EpiStore E{(bf16_t*)(ws + WS_C), MH * 256, (const float*)(ws + WS_RSTDKV), 1.f / KVLORA};
          pg8::gemm_phase<pg8::EpiStore, pg8::DenseOrder>(F.lds, g, S, E); }
        { const MoeItems mk{a.in[22], a.in[23], a.in[24], ws};
          tr_run(idx * NWAVES + F.wave, half * NWAVES, MOE_PRE, mk, F.lds + F.wave * 8192, F.lane); }
    }
}

__device__ __forceinline__ float sum8(float v) { v += __shfl_xor(v, 1); v += __shfl_xor(v, 2); v += __shfl_xor(v, 4); return v; }

struct P5Set { u32x4 k0, k1, kpe, m0, m1, g0, g1; f32x4 ca, cb, sa, sb; };
__device__ __forceinline__ void p5_phase(Frame& F, const Args& a) {
    OPAQUE_FRAME(F);
    const int gw = F.vcu * NWAVES + F.wave, NGW = F.G * NWAVES;
    const bf16_t* PROJ = (const bf16_t*)(F.ws + WS_A);
    const bf16_t* KV = (const bf16_t*)(F.ws + WS_C);
    bf16_t* Kn = (bf16_t*)(F.ws + WS_F);
    bf16_t* MIX = (bf16_t*)F.out;
    const float* rc = (const float*)(F.ws + WS_ROPEC); const float* rsn = (const float*)(F.ws + WS_ROPES);
    const int h = F.lane >> 3, sub = F.lane & 7;
    const float sgn = sub < 4 ? -1.f : 1.f;
    float gk[3][8], go[2][8];
#pragma unroll
    for (int i = 0; i < 3; ++i)
#pragma unroll
        for (int j = 0; j < 8; ++j) gk[i][j] = a.in[14][(sub + 8 * i) * 8 + j];
#pragma unroll
    for (int i = 0; i < 2; ++i)
#pragma unroll
        for (int j = 0; j < 8; ++j) go[i][j] = a.in[8][(sub + 8 * i) * 8 + j];
#define P5_LD(t_, S_) do { const size_t t__ = (size_t)(t_); const int ii_ = (sub & 3) * 8; \
        S_.k0 = __builtin_nontemporal_load((const u32x4*)(KV + t__ * (MH * 256) + h * 256 + sub * 8)); S_.k1 = __builtin_nontemporal_load((const u32x4*)(KV + t__ * (MH * 256) + h * 256 + (sub + 8) * 8)); \
        S_.kpe = *(const u32x4*)(PROJ + t__ * INCP + C_KPE + sub * 8); \
        S_.ca = *(const f32x4*)(rc + t__ * 32 + ii_); S_.cb = *(const f32x4*)(rc + t__ * 32 + ii_ + 4); S_.sa = *(const f32x4*)(rsn + t__ * 32 + ii_); S_.sb = *(const f32x4*)(rsn + t__ * 32 + ii_ + 4); \
        S_.m0 = *(const u32x4*)(MIX + t__ * DM + h * 128 + sub * 8); S_.m1 = *(const u32x4*)(MIX + t__ * DM + h * 128 + (sub + 8) * 8); \
        S_.g0 = __builtin_nontemporal_load((const u32x4*)(PROJ + t__ * INCP + 3 * HW + h * 128 + sub * 8)); S_.g1 = __builtin_nontemporal_load((const u32x4*)(PROJ + t__ * INCP + 3 * HW + h * 128 + (sub + 8) * 8)); } while (0)
#define P5_CP(t_, S_) do { const int t__ = (t_), b_ = t__ / SEQ, s_ = t__ % SEQ; const size_t hrow = ((size_t)(b_ * MH + h) * SEQ + s_); \
        { float k[3][8]; float ss = 0.f; unpack8(S_.k0, k[0]); unpack8(S_.k1, k[1]); unpack8(S_.kpe, k[2]); \
          _Pragma("unroll") for (int i = 0; i < 3; ++i) _Pragma("unroll") for (int j = 0; j < 8; ++j) ss += k[i][j] * k[i][j]; \
          const float rs = rsqrtf(sum8(ss) * (1.f / MQK) + EPS); \
          _Pragma("unroll") for (int i = 0; i < 3; ++i) _Pragma("unroll") for (int j = 0; j < 8; ++j) k[i][j] *= rs * gk[i][j]; \
          _Pragma("unroll") for (int j = 0; j < 8; ++j) { const float pv = __shfl_xor(k[2][j], 4); const float cs_ = j < 4 ? S_.ca[j & 3] : S_.cb[j & 3], sn_ = j < 4 ? S_.sa[j & 3] : S_.sb[j & 3]; k[2][j] = k[2][j] * cs_ + sgn * pv * sn_; } \
          _Pragma("unroll") for (int i = 0; i < 3; ++i) *(u32x4*)(Kn + hrow * MQK + (sub + 8 * i) * 8) = pack8f(k[i]); } \
        { float o[2][8], gt[2][8]; float ss = 0.f; unpack8(S_.m0, o[0]); unpack8(S_.m1, o[1]); unpack8(S_.g0, gt[0]); unpack8(S_.g1, gt[1]); \
          _Pragma("unroll") for (int i = 0; i < 2; ++i) _Pragma("unroll") for (int j = 0; j < 8; ++j) ss += o[i][j] * o[i][j]; \
          const float rs = rsqrtf(sum8(ss) * (1.f / HDV) + EPS); \
          _Pragma("unroll") for (int i = 0; i < 2; ++i) { _Pragma("unroll") for (int j = 0; j < 8; ++j) o[i][j] = o[i][j] * rs * go[i][j] * siluf(gt[i][j]); \
              *(u32x4*)(MIX + (size_t)t__ * DM + h * 128 + (sub + 8 * i) * 8) = pack8f(o[i]); } } } while (0)
    for (int blk = gw; blk < T / 8; blk += NGW) { const int t0 = blk * 8;
        P5Set A, B;
        P5_LD(t0, A);
#pragma unroll 1
        for (int r = 0; r < 8; r += 2) {
            P5_LD(t0 + r + 1, B); __builtin_amdgcn_sched_barrier(0);
            P5_CP(t0 + r, A); __builtin_amdgcn_sched_barrier(0);
            if (r + 2 < 8) { P5_LD(t0 + r + 2, A); } __builtin_amdgcn_sched_barrier(0);
            P5_CP(t0 + r + 1, B); __builtin_amdgcn_sched_barrier(0);
        }
    }
#undef P5_LD
#undef P5_CP
}
namespace att {
constexpr int QBLK = 32, KVBLK = 64, QB = 256;
constexpr int KROW = 512, SHM_K = KVBLK * KROW, SHM_V = KVBLK * MV * 2;
constexpr int OFF_V = 0, OFF_K = 2 * SHM_V, OFF_WS = OFF_K + 2 * SHM_K;
constexpr float SCALE = 0.07216878364870322f;
constexpr float THR = 8.f;
#define SBAR() __builtin_amdgcn_sched_barrier(0)
__device__ __forceinline__ int v_st(int k, int c) { const int kk = (k & ~0xC) | ((k & 4) << 1) | ((k & 8) >> 1); return ((kk >> 3) * 4 + (c >> 5)) * 512 + ((kk & 7) * 32 + (c & 31)) * 2; }
__device__ __forceinline__ int v_rd_base(int lane) { return ((lane & 3) << 3) | (((lane >> 2) & 3) << 6) | (((lane >> 4) & 1) << 5) | (((lane >> 5) & 1) << 8); }
constexpr int v_rd_off(int d0, int ks, int half) { return d0 * 512 + ks * 4096 + half * 2048; }
__device__ __forceinline__ int crow(int r, int hi) { return (r & 3) + 8 * (r >> 2) + 4 * hi; }
template <int M> __device__ __forceinline__ float swz_xor(float v) { return __builtin_bit_cast(float, __builtin_amdgcn_ds_swizzle(__builtin_bit_cast(int, v), (M << 10) | 0x1F)); }
__device__ __forceinline__ unsigned cvtpk(float lo, float hi) { unsigned r; asm volatile("v_cvt_pk_bf16_f32 %0, %1, %2" : "=v"(r) : "v"(lo), "v"(hi)); return r; }

__device__ __forceinline__ void mask_tile(f32x16& p0, f32x16& p1, int dq) {
    const float NEG = -__builtin_inff();
#pragma unroll
    for (int r = 0; r < 16; ++r) {
        const int c = (r & 3) + 8 * (r >> 2);
        if (dq - c < 0) p0[r] = NEG;
        if (dq - c - 32 < 0) p1[r] = NEG;
    }
}
__device__ __forceinline__ void partialSM(f32x16& p0, f32x16& p1, float& m_reg, float& mn, float& alpha) {
    float pmax = p0[0];
#pragma unroll
    for (int r = 1; r < 16; ++r) pmax = fmaxf(pmax, p0[r]);
#pragma unroll
    for (int r = 0; r < 16; ++r) pmax = fmaxf(pmax, p1[r]);
    { auto rr = __builtin_amdgcn_permlane32_swap(__float_as_uint(pmax), __float_as_uint(pmax), false, false);
      pmax = fmaxf(__uint_as_float(rr[0]), __uint_as_float(rr[1])); }
    constexpr float C2 = 1.4426950408889634f * SCALE;
    if (__builtin_expect(__all((pmax - m_reg) * SCALE <= THR), 1)) { mn = m_reg; alpha = 1.f; }
    else { mn = fmaxf(m_reg, pmax); alpha = __builtin_amdgcn_exp2f((m_reg - mn) * C2); m_reg = mn; }
    const float mnL = -mn * C2;
#pragma unroll
    for (int r = 0; r < 16; ++r) p0[r] = fmaf(p0[r], C2, mnL);
#pragma unroll
    for (int r = 0; r < 16; ++r) p1[r] = fmaf(p1[r], C2, mnL);
#pragma unroll
    for (int r = 0; r < 16; ++r) p0[r] = __builtin_amdgcn_exp2f(p0[r]);
}
__device__ __forceinline__ void finishSM(f32x16& p0, f32x16& p1, float alpha, float& l_reg, bf16x8& pa0, bf16x8& pa1, bf16x8& pa2, bf16x8& pa3) {
#pragma unroll
    for (int r = 0; r < 16; ++r) p1[r] = __builtin_amdgcn_exp2f(p1[r]);
    float ps = 0;
#pragma unroll
    for (int r = 0; r < 16; ++r) ps += p0[r];
#pragma unroll
    for (int r = 0; r < 16; ++r) ps += p1[r];
    { auto rr = __builtin_amdgcn_permlane32_swap(__float_as_uint(ps), __float_as_uint(ps), false, false);
      ps = __uint_as_float(rr[0]) + __uint_as_float(rr[1]); }
    l_reg = l_reg * alpha + ps;
#define PK4(P, B_, OUT) do { unsigned a0 = cvtpk(P[B_+0], P[B_+1]), a1 = cvtpk(P[B_+2], P[B_+3]);                          \
        unsigned b0 = cvtpk(P[B_+4], P[B_+5]), b1 = cvtpk(P[B_+6], P[B_+7]);                                             \
        auto r0 = __builtin_amdgcn_permlane32_swap(a0, b0, false, false); auto r1 = __builtin_amdgcn_permlane32_swap(a1, b1, false, false); \
        u32x4 w = {r0[0], r1[0], r0[1], r1[1]}; OUT = __builtin_bit_cast(bf16x8, w); } while (0)
    PK4(p0, 0, pa0); PK4(p0, 8, pa1); PK4(p1, 0, pa2); PK4(p1, 8, pa3);
#undef PK4
}
template <int KB>
__device__ __forceinline__ void qkt(f32x16& p0, f32x16& p1, LAS unsigned char* lds, int r32, int hi, const bf16x8* qr) {
    p0 = f32x16{}; p1 = f32x16{};
    int sw = r32 & 15; asm volatile("" : "+v"(sw));
    const int rb = OFF_K + KB * SHM_K + r32 * KROW;
    int ab[8];
#pragma unroll
    for (int d = 0; d < 8; ++d) ab[d] = rb + (((2 * d + hi) ^ sw) << 4);
#pragma unroll
    for (int d0 = 0; d0 < 12; ++d0) { const int a = ab[d0 & 7] + (d0 >> 3) * 256;
        const bf16x8 b0 = *(const LAS bf16x8*)(lds + a);
        const bf16x8 b1 = *(const LAS bf16x8*)(lds + a + 32 * KROW);
        p0 = __builtin_amdgcn_mfma_f32_32x32x16_bf16(b0, qr[d0], p0, 0, 0, 0);
        p1 = __builtin_amdgcn_mfma_f32_32x32x16_bf16(b1, qr[d0], p1, 0, 0, 0); }
}
template <int VB>
__device__ __forceinline__ void pv_tile(f32x16* o, int vb0, bf16x8 pa0, bf16x8 pa1, bf16x8 pa2, bf16x8 pa3) {
#define TRRD(dst, off) asm volatile("ds_read_b64_tr_b16 %0, %1 offset:%2" : "=&v"(dst) : "v"(vb0), "i"(off) : "memory")
#define PV_D0(d0) do { s16x4 l0, l1, l2, l3, h0, h1, h2, h3; constexpr int b_ = OFF_V + VB * SHM_V + v_rd_off(d0, 0, 0); \
        TRRD(l0, b_); TRRD(h0, b_ + 2048); TRRD(l1, b_ + 4096); TRRD(h1, b_ + 6144); TRRD(l2, b_ + 8192); TRRD(h2, b_ + 10240); TRRD(l3, b_ + 12288); TRRD(h3, b_ + 14336); \
        asm volatile("s_waitcnt lgkmcnt(0)" ::: "memory"); SBAR();   \
        o[d0] = __builtin_amdgcn_mfma_f32_32x32x16_bf16(pa0, (bf16x8){l0[0], l0[1], l0[2], l0[3], h0[0], h0[1], h0[2], h0[3]}, o[d0], 0, 0, 0);   \
        o[d0] = __builtin_amdgcn_mfma_f32_32x32x16_bf16(pa1, (bf16x8){l1[0], l1[1], l1[2], l1[3], h1[0], h1[1], h1[2], h1[3]}, o[d0], 0, 0, 0);   \
        o[d0] = __builtin_amdgcn_mfma_f32_32x32x16_bf16(pa2, (bf16x8){l2[0], l2[1], l2[2], l2[3], h2[0], h2[1], h2[2], h2[3]}, o[d0], 0, 0, 0);   \
        o[d0] = __builtin_amdgcn_mfma_f32_32x32x16_bf16(pa3, (bf16x8){l3[0], l3[1], l3[2], l3[3], h3[0], h3[1], h3[2], h3[3]}, o[d0], 0, 0, 0); } while (0)
    PV_D0(0); PV_D0(1); PV_D0(2); PV_D0(3);
#undef PV_D0
#undef TRRD
}

constexpr int QP = MH * MQK, VP = MH * 256;
__device__ __forceinline__ void attn_block(const bf16_t* Q, const bf16_t* K, const bf16_t* V, bf16_t* O, int P0, const float* gon, const float* gqn, const float* rc, const float* rsn, LAS unsigned char* lds) {
    int tid = threadIdx.x; asm volatile("" : "+v"(tid));
    const int wid = __builtin_amdgcn_readfirstlane(tid >> 6), lane = tid & 63, r32 = lane & 31, hi = lane >> 5;
    const int NT = P0 / KVBLK + 4;
    const int qlo = P0 + wid * QBLK, qm = qlo + r32 - 4 * hi;
    LAS float* wsf = (LAS float*)(lds + OFF_WS) + wid * 64; LAS float* li_l = wsf; LAS float* al_l = wsf + 32;
    float m_reg = -1e30f, l_reg = 0.f; f32x16 o[4] = {};
    bf16x8 qr[12];
#pragma unroll
    for (int d0 = 0; d0 < 12; ++d0) qr[d0] = *(const bf16x8*)(Q + (size_t)(qlo + r32) * QP + d0 * 16 + hi * 8);
    {
        float ss = 0.f;
#pragma unroll
        for (int d0 = 0; d0 < 12; ++d0) { float f[8]; unpack8(__builtin_bit_cast(u32x4, qr[d0]), f);
#pragma unroll
            for (int j = 0; j < 8; ++j) ss += f[j] * f[j]; }
        { auto rr = __builtin_amdgcn_permlane32_swap(__float_as_uint(ss), __float_as_uint(ss), false, false); ss = __uint_as_float(rr[0]) + __uint_as_float(rr[1]); }
        const float rs = rsqrtf(ss * (1.f / MQK) + EPS);
#pragma unroll
        for (int d0 = 0; d0 < 8; ++d0) { float f[8]; unpack8(__builtin_bit_cast(u32x4, qr[d0]), f); const float* gp = gqn + d0 * 16 + hi * 8;
#pragma unroll
            for (int j = 0; j < 8; ++j) f[j] *= rs * gp[j];
            qr[d0] = __builtin_bit_cast(bf16x8, pack8f(f)); }
#pragma unroll
        for (int dd = 0; dd < 2; ++dd) { float x1[8], x2[8]; unpack8(__builtin_bit_cast(u32x4, qr[8 + dd]), x1); unpack8(__builtin_bit_cast(u32x4, qr[10 + dd]), x2);
            const float* g1p = gqn + 128 + dd * 16 + hi * 8; const float* g2p = g1p + 32; const float* cp = rc + (size_t)(qlo + r32) * 32 + dd * 16 + hi * 8; const float* sp = rsn + (size_t)(qlo + r32) * 32 + dd * 16 + hi * 8;
#pragma unroll
            for (int j = 0; j < 8; ++j) { const float a = x1[j] * rs * g1p[j], bq = x2[j] * rs * g2p[j], c = cp[j], sn = sp[j]; x1[j] = a * c - bq * sn; x2[j] = bq * c + a * sn; }
            qr[8 + dd] = __builtin_bit_cast(bf16x8, pack8f(x1)); qr[10 + dd] = __builtin_bit_cast(bf16x8, pack8f(x2)); }
    }
    int ksrc[4], vsrc[2];
#pragma unroll
    for (int i = 0; i < 4; ++i) { const int row = 2 * (wid * 4 + i) + (lane >> 5), c = (lane & 31) ^ (row & 15); ksrc[i] = row * MQK + (c < 24 ? c : 0) * 8; }
#pragma unroll
    for (int i = 0; i < 2; ++i) { const int id = (wid * 2 + i) * 2 + (lane >> 5), kk = ((id >> 2) << 3) | ((lane & 31) >> 2), k = (kk & ~0xC) | ((kk & 4) << 1) | ((kk & 8) >> 1);
        vsrc[i] = k * VP + (id & 3) * 32 + (lane & 3) * 8; }
    const int vb0 = (int)(unsigned)(uintptr_t)lds + v_rd_base(lane);
#define ALOAD(t, bf) do { const bf16_t* kp = K + (size_t)(t) * KVBLK * MQK; const bf16_t* vp = V + (size_t)(t) * KVBLK * VP; \
        _Pragma("unroll") for (int i = 0; i < 4; ++i) __builtin_amdgcn_global_load_lds((const unsigned*)(kp + ksrc[i]), (LAS unsigned*)(lds + OFF_K + (bf) * SHM_K + (wid * 4 + i) * 1024), 16, 0, 0); \
        _Pragma("unroll") for (int i = 0; i < 2; ++i) __builtin_amdgcn_global_load_lds((const unsigned*)(vp + vsrc[i]), (LAS unsigned*)(lds + OFF_V + (bf) * SHM_V + (wid * 2 + i) * 1024), 16, 0, 0); } while (0)
#define RESC(a) do { if (__any((a) < 1.f)) { if (hi == 0) al_l[r32] = (a); asm volatile("s_waitcnt lgkmcnt(0)" ::: "memory"); \
        _Pragma("unroll") for (int d_ = 0; d_ < 4; ++d_) _Pragma("unroll") for (int r = 0; r < 16; ++r) o[d_][r] *= al_l[crow(r, hi)]; } } while (0)
#define STEP(t, BF) do { f32x16 p0, p1; float mn, al; bf16x8 pa0, pa1, pa2, pa3; \
        if ((t) + 1 < NT) ALOAD((t) + 1, 1 - (BF)); \
        SBAR(); qkt<BF>(p0, p1, lds, r32, hi, qr); \
        { const int kb_ = (t) * KVBLK; if (kb_ + KVBLK - 1 > qlo) mask_tile(p0, p1, qm - kb_); } \
        partialSM(p0, p1, m_reg, mn, al); RESC(al); finishSM(p0, p1, al, l_reg, pa0, pa1, pa2, pa3); SBAR(); \
        pv_tile<BF>(o, vb0, pa0, pa1, pa2, pa3); SBAR(); \
        asm volatile("s_waitcnt vmcnt(0)" ::: "memory"); __syncthreads(); } while (0)
    ALOAD(0, 0); asm volatile("s_waitcnt vmcnt(0)" ::: "memory"); __syncthreads();
    for (int t = 0; t < NT; t += 2) { STEP(t, 0); STEP(t + 1, 1); }
#undef STEP
#undef RESC
#undef ALOAD
    if (hi == 0) li_l[r32] = l_reg;
    asm volatile("s_waitcnt lgkmcnt(0)" ::: "memory");
    float gv[4];
#pragma unroll
    for (int d0 = 0; d0 < 4; ++d0) gv[d0] = gon[d0 * 32 + r32];
#pragma unroll
    for (int r = 0; r < 16; ++r) { const float rl = 1.f / li_l[crow(r, hi)];
        float ss = 0.f;
#pragma unroll
        for (int d0 = 0; d0 < 4; ++d0) { o[d0][r] *= rl; ss += o[d0][r] * o[d0][r]; }
        ss += swz_xor<1>(ss); ss += swz_xor<2>(ss); ss += swz_xor<4>(ss); ss += swz_xor<8>(ss); ss += swz_xor<16>(ss);
        const float rs = rsqrtf(ss * (1.f / MV) + EPS);
        bf16_t* orow = O + (size_t)(qlo + crow(r, hi)) * DM;
#pragma unroll
        for (int d0 = 0; d0 < 4; ++d0) { const float v = o[d0][r] * rs * gv[d0]; const float vn = swz_xor<1>(v);
            if ((r32 & 1) == 0) *(unsigned*)(orow + d0 * 32 + r32) = cvtpk(v, vn); } }
    __syncthreads();
}
#undef SBAR
}

__device__ __forceinline__ void p6_phase(Frame& F, const Args& a) {
    const bf16_t* QH = (const bf16_t*)(F.ws + WS_B); const bf16_t* Kn = (const bf16_t*)(F.ws + WS_F); const bf16_t* KV = (const bf16_t*)(F.ws + WS_C);
    bf16_t* MIX = (bf16_t*)F.out;
    const float* rc = (const float*)(F.ws + WS_ROPEC); const float* rsn = (const float*)(F.ws + WS_ROPES);
    for (int it = F.vcu; it < NB * MH * 4; it += F.G) {
        const int bh = it >> 2, j = it & 3, b = bh >> 3, h = bh & 7;
        const bf16_t* Q = QH + (size_t)(b * SEQ) * att::QP + h * MQK; const bf16_t* K = Kn + (size_t)bh * SEQ * MQK; const bf16_t* V = KV + (size_t)(b * SEQ) * att::VP + h * 256 + 128;
        bf16_t* O = MIX + (size_t)(b * SEQ) * DM + HW + h * MV;
        att::attn_block(Q, K, V, O, (7 - j) * att::QB, a.in[15], a.in[13], rc + (size_t)(b * SEQ) * 32, rsn + (size_t)(b * SEQ) * 32, F.lds);
        att::attn_block(Q, K, V, O, j * att::QB, a.in[15], a.in[13], rc + (size_t)(b * SEQ) * 32, rsn + (size_t)(b * SEQ) * 32, F.lds);
    }
}
__device__ __forceinline__ void p8_phase(Frame& F, const Args& a) {
    OPAQUE_FRAME(F);
    unsigned char* ws = F.ws;
    const float* xin = a.in[0]; const bf16_t* mixo = (const bf16_t*)(ws + WS_F); const float* mod = (const float*)(ws + WS_MOD); const float* g2n = a.in[17];
    const float* wct = (const float*)(ws + WS_WCT);
    bf16_t* H2 = (bf16_t*)(ws + WS_B);
    int* tok_e = (int*)(ws + WS_TOKE); float* tok_w = (float*)(ws + WS_TOKW); int* tok_s = (int*)(ws + WS_TOKS);
    LAS float* red = (LAS float*)F.lds;
    LAS float* ssw = (LAS float*)(F.lds + 98304);
    LAS float* shw = (LAS float*)(F.lds + 100352);
    LAS float* lg = (LAS float*)(F.lds + 101888);
    LAS float* rsl = (LAS float*)(F.lds + 111104);
    const int mr = F.lane & 15, mg = F.lane >> 4;
    const bool conv_first = (F.vcu & 1) != 0;
#pragma unroll 1
    for (int part = 0; part < 2; ++part) {
    if ((part == 0) != conv_first) {
    for (int tile = F.vcu; tile < T / 64; tile += F.G) {
        const int m0 = tile * 64, b = m0 / SEQ;
        const float* modb = mod + b * (6 * DM);
        f32x4 acc[4][3]; float ssp[4] = {0.f, 0.f, 0.f, 0.f}, shacc[3] = {0.f, 0.f, 0.f};
#pragma unroll
        for (int rb = 0; rb < 4; ++rb)
#pragma unroll
            for (int n = 0; n < 3; ++n) acc[rb][n] = (f32x4){0.f, 0.f, 0.f, 0.f};
        const unsigned xo = (unsigned)((m0 + mr) * DM + F.wave * 256 + 4 * mg);
        LAS float* vec = (LAS float*)(F.lds + 112640) + F.wave * 768;
        { const int k4 = F.lane * 4; const unsigned ko_ = (unsigned)(F.wave * 256 + k4) * 4u;
          const f32x4 t0 = *(const f32x4*)((const char*)(modb + 2 * DM) + ko_), t1 = *(const f32x4*)((const char*)(modb + 3 * DM) + ko_), t2 = *(const f32x4*)((const char*)g2n + ko_), t3 = *(const f32x4*)((const char*)(modb + 4 * DM) + ko_);
          *(LAS f32x4*)(vec + k4) = t0; *(LAS f32x4*)(vec + 256 + k4) = t1; *(LAS f32x4*)(vec + 512 + k4) = t2 * (t3 + 1.f); LDS_WAIT(); asm volatile("" ::: "memory"); }
        f32x4 xa[4], xb[4], wa[3], wb[3]; u32x2 ma_[4], mb_[4];
#define P8_LDX(s_, X, M, W) do { const unsigned ko_ = (unsigned)(F.wave * 256 + 16 * (s_) + 4 * mg) * 4u; \
            _Pragma("unroll") for (int n = 0; n < 3; ++n) W[n] = *(const f32x4*)((const char*)wct + (ko_ + (unsigned)((n * 16 + mr) * DM * 4))); \
            _Pragma("unroll") for (int rb = 0; rb < 4; ++rb) { const unsigned eo_ = xo + (unsigned)(rb * 16 * DM + 16 * (s_)); X[rb] = *(const f32x4*)((const char*)xin + eo_ * 4u); M[rb] = *(const u32x2*)((const char*)mixo + eo_ * 2u); } } while (0)
#define P8_CP(s_, X, M, W) do { const int kl_ = 16 * (s_) + 4 * mg; const f32x4 g1v = *(const LAS f32x4*)(vec + kl_), shv = *(const LAS f32x4*)(vec + 256 + kl_), gmv = *(const LAS f32x4*)(vec + 512 + kl_); \
            _Pragma("unroll") for (int n = 0; n < 3; ++n) shacc[n] += (shv.x * W[n].x + shv.y * W[n].y) + (shv.z * W[n].z + shv.w * W[n].w); \
            _Pragma("unroll") for (int rb = 0; rb < 4; ++rb) { const f32x4 v = X[rb] + g1v * (f32x4){bf_lo(M[rb].x), bf_hi(M[rb].x), bf_lo(M[rb].y), bf_hi(M[rb].y)}; \
                ssp[rb] += (v.x * v.x + v.y * v.y) + (v.z * v.z + v.w * v.w); const f32x4 av = v * gmv; \
                _Pragma("unroll") for (int i = 0; i < 4; ++i) _Pragma("unroll") for (int n = 0; n < 3; ++n) acc[rb][n] = __builtin_amdgcn_mfma_f32_16x16x4f32(av[i], W[n][i], acc[rb][n], 0, 0, 0); } } while (0)
        P8_LDX(0, xa, ma_, wa);
#pragma unroll 1
        for (int s = 0; s < 16; s += 2) {
            P8_LDX(s + 1, xb, mb_, wb); __builtin_amdgcn_sched_barrier(0);
            P8_CP(s, xa, ma_, wa); __builtin_amdgcn_sched_barrier(0);
            if (s + 2 < 16) { P8_LDX(s + 2, xa, ma_, wa); } __builtin_amdgcn_sched_barrier(0);
            P8_CP(s + 1, xb, mb_, wb); __builtin_amdgcn_sched_barrier(0);
        }
#undef P8_LDX
#undef P8_CP
#pragma unroll
        for (int rb = 0; rb < 4; ++rb) {
#pragma unroll
            for (int n = 0; n < 3; ++n)
#pragma unroll
                for (int r = 0; r < 4; ++r) red[(F.wave * 64 + rb * 16 + mg * 4 + r) * 48 + n * 16 + mr] = acc[rb][n][r];
            float sp = ssp[rb]; sp += __shfl_xor(sp, 16); sp += __shfl_xor(sp, 32);
            if (mg == 0) ssw[F.wave * 64 + rb * 16 + mr] = sp; }
#pragma unroll
        for (int n = 0; n < 3; ++n) { float sa = shacc[n]; sa += __shfl_xor(sa, 16); sa += __shfl_xor(sa, 32); if (mg == 0) shw[F.wave * 48 + n * 16 + mr] = sa; }
        __syncthreads();
        if (F.tid < 64) { float sv = 0.f;
#pragma unroll
            for (int w = 0; w < 8; ++w) sv += ssw[w * 64 + F.tid];
            rsl[F.tid] = rsqrtf(sv * (1.f / DM) + EPS); }
        __syncthreads();
        for (int idx = F.tid; idx < 64 * 36; idx += NTHR) { const int row = idx / 36, n = idx % 36; float L = 0.f, sw = 0.f;
#pragma unroll
            for (int w = 0; w < 8; ++w) { L += red[(w * 64 + row) * 48 + n]; sw += shw[w * 48 + n]; }
            lg[row * 36 + n] = rsl[row] * L + sw + (n < 4 ? a.in[19][n] : a.in[21][n - 4]); }
        __syncthreads();
        if (F.tid < 64) { const LAS float* l = lg + F.tid * 36; const int t = m0 + F.tid;
            int g = 0; float gm = l[0];
#pragma unroll
            for (int j = 1; j < 4; ++j) if (l[j] > gm) { gm = l[j]; g = j; }
            float den = 0.f;
#pragma unroll
            for (int j = 0; j < 4; ++j) den += __expf(l[j] - gm);
            const float pg = 1.f / den;
            const LAS float* e = l + 4 + g * 8;
            int i1 = 0; float v1 = e[0];
#pragma unroll
            for (int j = 1; j < 8; ++j) if (e[j] > v1) { v1 = e[j]; i1 = j; }
            int i2 = -1; float v2 = -__builtin_inff();
#pragma unroll
            for (int j = 0; j < 8; ++j) if (j != i1 && e[j] > v2) { v2 = e[j]; i2 = j; }
            const float w1 = 1.f / (1.f + __expf(v2 - v1)), w2 = 1.f - w1;
            const int e1 = g * 8 + i1, e2 = g * 8 + i2;
            const int s1 = (int)atomicAdd((unsigned*)(F.ctl + CW_CNT + 64 * e1), 1u), s2 = (int)atomicAdd((unsigned*)(F.ctl + CW_CNT + 64 * e2), 1u);
            tok_e[2 * t] = e1; tok_e[2 * t + 1] = e2; tok_w[2 * t] = pg * w1; tok_w[2 * t + 1] = pg * w2; tok_s[2 * t] = s1; tok_s[2 * t + 1] = s2;
            int* list = (int*)(ws + WS_LIST); list[e1 * T + s1] = t; list[e2 * T + s2] = t; }
        { const int c8 = (F.tid & 255) * 8, rg = F.tid >> 8;
          f32x4 g1a = *(const f32x4*)(modb + 2 * DM + c8), g1b = *(const f32x4*)(modb + 2 * DM + c8 + 4), sha = *(const f32x4*)(modb + 3 * DM + c8), shb = *(const f32x4*)(modb + 3 * DM + c8 + 4);
          const f32x4 gma = *(const f32x4*)(g2n + c8) * (*(const f32x4*)(modb + 4 * DM + c8) + 1.f), gmb = *(const f32x4*)(g2n + c8 + 4) * (*(const f32x4*)(modb + 4 * DM + c8 + 4) + 1.f);
#pragma unroll 1
          for (int j0 = 0; j0 < 32; j0 += 4) {
              f32x4 qa[4], qb[4]; u32x4 qm[4];
#pragma unroll
              for (int u = 0; u < 4; ++u) { const size_t eo = (size_t)(m0 + rg + 2 * (j0 + u)) * DM + c8;
                  qa[u] = __builtin_nontemporal_load((const f32x4*)(xin + eo)); qb[u] = __builtin_nontemporal_load((const f32x4*)(xin + eo + 4)); qm[u] = __builtin_nontemporal_load((const u32x4*)(mixo + eo)); }
              __builtin_amdgcn_sched_barrier(0);
#pragma unroll
              for (int u = 0; u < 4; ++u) { const int row = rg + 2 * (j0 + u); const size_t eo = (size_t)(m0 + row) * DM + c8; const float rs = rsl[row];
                  float mx[8]; unpack8(qm[u], mx);
                  const f32x4 va = (qa[u] + g1a * (f32x4){mx[0], mx[1], mx[2], mx[3]}) * rs * gma + sha, vb = (qb[u] + g1b * (f32x4){mx[4], mx[5], mx[6], mx[7]}) * rs * gmb + shb;
                  u32x4 w; w.x = cvt_pk_bf16(va.x, va.y); w.y = cvt_pk_bf16(va.z, va.w); w.z = cvt_pk_bf16(vb.x, vb.y); w.w = cvt_pk_bf16(vb.z, vb.w);
                  *(u32x4*)(H2 + eo) = w; }
              __builtin_amdgcn_sched_barrier(0); } }
        __syncthreads();
    }
    } else {
    LAS unsigned char* Tl = F.lds + F.wave * 8192;
    const int gw = F.vcu * NWAVES + F.wave, NGW = F.G * NWAVES;
    { const MoeItems mk{a.in[22], a.in[23], a.in[24], ws};
      tr_run(MOE_PRE + gw, NGW, 3 * MOE_IG, mk, Tl, F.lane); }
    __syncthreads();
    }
    }
}

constexpr int MOE_TAB_OFF = LDS_USER;
__device__ __forceinline__ LAS int* moe_tables(Frame& F) {
    LAS int* tab = (LAS int*)(F.lds + MOE_TAB_OFF);
    __syncthreads();
    if (F.tid == 0) { int acc = 0;
        for (int e = 0; e < NE; ++e) { tab[e] = acc; const int c = (int)__hip_atomic_load((unsigned*)(F.ctl + CW_CNT + 64 * e), RLX_AGENT); tab[64 + e] = c; acc += ((c + 255) / 256) * 256; }
        tab[NE] = acc; }
    __syncthreads();
    if (F.tid < 160) { int e = 0; for (int j = 1; j < NE; ++j) if (tab[j] <= F.tid * 256) e = j; tab[128 + F.tid] = e; }
    __syncthreads();
    return tab;
}

__device__ __forceinline__ void p12_phase(Frame& F, const Args& a) {
    OPAQUE_FRAME(F);
    unsigned char* ws = F.ws;
    const bf16_t* Y = (const bf16_t*)(ws + WS_A);
    const float* tok_w = (const float*)(ws + WS_TOKW); const int* tok_s = (const int*)(ws + WS_TOKS);
    const float* mod = (const float*)(ws + WS_MOD);
    const LAS int* tab = moe_tables(F); const int* tok_e = (const int*)(ws + WS_TOKE);
    const int gw = F.vcu * NWAVES + F.wave, NGW = F.G * NWAVES;
#if defined(MK_STAMP) && MK_STAMP >= 0
    const float dscale = 1.f + sqrtf(exp2f(rintf(3.f * log2f(*(const float*)(ws + WS_STAMP + 8) + 1.f) + MK_QSHIFT) * (1.f / 3.f)));
#else
    const float dscale = 1.f;
#endif
    for (int blk = gw; blk < T / 8; blk += NGW) { const int t0 = blk * 8, b = t0 / SEQ;
        const float* g2 = mod + b * (6 * DM) + 5 * DM; const float* g1 = mod + b * (6 * DM) + 2 * DM;
        f32x4 h1[4][2], h2[4][2];
#pragma unroll
        for (int j = 0; j < 4; ++j) { const int c = (j * 64 + F.lane) * 8; h1[j][0] = *(const f32x4*)(g1 + c); h1[j][1] = *(const f32x4*)(g1 + c + 4); h2[j][0] = *(const f32x4*)(g2 + c); h2[j][1] = *(const f32x4*)(g2 + c + 4); }
#pragma unroll 1
        for (int r = 0; r < 8; ++r) { const int t = t0 + r;
            const float w0 = tok_w[2 * t], w1 = tok_w[2 * t + 1]; const int d0 = tab[tok_e[2 * t]] + tok_s[2 * t], d1 = tab[tok_e[2 * t + 1]] + tok_s[2 * t + 1];
            float* orow = F.out + (size_t)t * DM; const float* xrow = a.in[0] + (size_t)t * DM; const bf16_t* mrow = (const bf16_t*)(ws + WS_F) + (size_t)t * DM;
            u32x4 qy0[4], qy1[4], qm[4]; f32x4 qa[4], qb[4];
#pragma unroll
            for (int j = 0; j < 4; ++j) { const int c = (j * 64 + F.lane) * 8;
                qy0[j] = __builtin_nontemporal_load((const u32x4*)(Y + (size_t)d0 * DM + c)); qy1[j] = __builtin_nontemporal_load((const u32x4*)(Y + (size_t)d1 * DM + c));
                qm[j] = __builtin_nontemporal_load((const u32x4*)(mrow + c)); qa[j] = __builtin_nontemporal_load((const f32x4*)(xrow + c)); qb[j] = __builtin_nontemporal_load((const f32x4*)(xrow + c + 4)); }
            __builtin_amdgcn_sched_barrier(0);
#pragma unroll
            for (int j = 0; j < 4; ++j) { const int c = (j * 64 + F.lane) * 8;
                float y0[8], y1[8], mx[8]; unpack8(qy0[j], y0); unpack8(qy1[j], y1); unpack8(qm[j], mx);
                const f32x4 xa = qa[j] + h1[j][0] * (f32x4){mx[0], mx[1], mx[2], mx[3]}, xb = qb[j] + h1[j][1] * (f32x4){mx[4], mx[5], mx[6], mx[7]};
                f32x4 ra, rb;
#pragma unroll
                for (int i = 0; i < 4; ++i) { ra[i] = (xa[i] + h2[j][0][i] * (w0 * y0[i] + w1 * y1[i])) * dscale; rb[i] = (xb[i] + h2[j][1][i] * (w0 * y0[4 + i] + w1 * y1[4 + i])) * dscale; }
                __builtin_nontemporal_store(ra, (f32x4*)(orow + c)); __builtin_nontemporal_store(rb, (f32x4*)(orow + c + 4)); }
            __builtin_amdgcn_sched_barrier(0); }
    }
}
#ifndef MK_MULTI
#define MK_MULTI 0
#endif
#ifndef MK_LAST_PHASE
#define MK_LAST_PHASE 12
#endif
constexpr int N_PHASES = MK_LAST_PHASE + 1;

template <class P> __device__ __forceinline__ P* uptr(P* p) { const unsigned long long v = (unsigned long long)p;
    const unsigned lo = __builtin_amdgcn_readfirstlane((unsigned)v), hi = __builtin_amdgcn_readfirstlane((unsigned)(v >> 32)); return (P*)(((unsigned long long)hi << 32) | lo); }
__global__ void __launch_bounds__(NTHR, 2) mk_fwd(const Args args) {
    extern __shared__ __attribute__((aligned(16))) unsigned char lds_raw[];
    Frame F;
    F.lds = (LAS unsigned char*)lds_raw;
    F.MISC = (volatile LAS unsigned*)(F.lds + MISC_OFF);
    F.tid = threadIdx.x; F.lane = F.tid & 63; F.wave = __builtin_amdgcn_readfirstlane(F.tid >> 6);
    F.G = gridDim.x; { const int bx = blockIdx.x; F.vcu = (F.G % 8 == 0) ? (bx % 8) * (F.G / 8) + bx / 8 : bx; }
    F.ws = uptr(args.ws); F.out = uptr(args.out);
    F.ctl = (gu32*)(F.ws + WS_CTL);
    for (int u = F.tid; u < (LDS_BYTES - MISC_OFF) / 4; u += NTHR) ((LAS unsigned*)(F.lds + MISC_OFF))[u] = 0u;
    __syncthreads();
    XcdBarrier bar; bar.bar = (unsigned*)(F.ctl + CW_BAR); bar.x = 0; bar.st = nullptr;
#if !MK_MULTI
    bar = xcd_barrier_post((unsigned*)(F.ctl + CW_BAR), F.MISC + 8);
#define GRID_BAR() xcd_barrier(bar)
#else
#define GRID_BAR() do { } while (0)
#endif
    const int lo = args.ph_lo, hi = args.ph_hi;
#ifndef MK_PHMASK
#define MK_PHMASK 0xFFFF
#endif
#define IN(k) (((MK_PHMASK >> (k)) & 1) && lo <= (k) && (k) < hi)
#define SEAM(k) do { if (IN(k) && IN((k) + 1)) GRID_BAR(); } while (0)
#ifndef MK_STAMP
#define MK_STAMP (-1)
#endif
#define STAMP_BEGIN(k) do { if ((k) == MK_STAMP && blockIdx.x == 0 && F.tid == 0) *(unsigned long long*)(ws + WS_STAMP) = __builtin_amdgcn_s_memrealtime(); } while (0)
#define STAMP_END(k) do { if ((k) == MK_STAMP && blockIdx.x == 0 && F.tid == 0) { const unsigned long long t1_ = __builtin_amdgcn_s_memrealtime(); *(float*)(ws + WS_STAMP + 8) = (float)(t1_ - *(unsigned long long*)(ws + WS_STAMP)) * 0.01f; } } while (0)
#ifndef MK_REPEAT
#define MK_REPEAT (-1)
#endif
#ifndef MK_REPN
#define MK_REPN 2
#endif
#define REP(k) _Pragma("unroll") for (int rep_ = 0; rep_ < ((k) == MK_REPEAT ? MK_REPN : 1); ++rep_)
    unsigned char* const ws = F.ws;

    STAMP_BEGIN(0);
    REP(0) if (IN(0)) { if (rep_) GRID_BAR(); p0_phase(F, args); } SEAM(0); STAMP_END(0);
    STAMP_BEGIN(1);
    REP(1) if (IN(1)) { if (rep_) GRID_BAR(); p1_phase(F, args); } SEAM(1); STAMP_END(1);
    STAMP_BEGIN(2);
    REP(2) if (IN(2)) { if (rep_) GRID_BAR();
        pg8::Gemm g{(const bf16_t*)(ws + WS_B), (const bf16_t*)(ws + WS_WIN), DM, DM, DM};
        pg8::DenseOrder S; S.init(T / 256, INCP / 256, F.G, (int)blockIdx.x);
        pg8::EpiStore E{(bf16_t*)(ws + WS_A), INCP, nullptr, 0.f, (float*)(ws + WS_RSTDQ), (float*)(ws + WS_RSTDKV), C_QA / 256, C_KVA / 256, C_KPE / 256};
        pg8::gemm_phase<pg8::EpiStore, pg8::DenseOrder>(F.lds, g, S, E);
    } SEAM(2); STAMP_END(2);
    STAMP_BEGIN(3);
    REP(3) if (IN(3)) { if (rep_) GRID_BAR(); p3_phase(F, args); } if (IN(3) && IN(5)) GRID_BAR(); STAMP_END(3);
    STAMP_BEGIN(5);
    REP(5) if (IN(5)) { if (rep_) GRID_BAR(); p5_phase(F, args); } SEAM(5); STAMP_END(5);
    STAMP_BEGIN(6);
    REP(6) if (IN(6)) { if (rep_) GRID_BAR(); p6_phase(F, args); } SEAM(6); STAMP_END(6);
    STAMP_BEGIN(7);
    REP(7) if (IN(7)) { if (rep_) GRID_BAR();
        pg8::Gemm g{(const bf16_t*)F.out, (const bf16_t*)(ws + WS_WOUT), DM, DM, DM};
        pg8::DenseOrder S; S.init(T / 256, DM / 256, F.G, (int)blockIdx.x);
        pg8::EpiStore E{(bf16_t*)(ws + WS_F), DM, nullptr, 0.f, nullptr, nullptr, 0, 0, 0};
        pg8::gemm_phase<pg8::EpiStore, pg8::DenseOrder>(F.lds, g, S, E);
    } SEAM(7); STAMP_END(7);
#if MK_LAST_PHASE >= 8
    STAMP_BEGIN(8);
    REP(8) if (IN(8)) { if (rep_) GRID_BAR(); p8_phase(F, args); } if (IN(8) && IN(10)) GRID_BAR(); STAMP_END(8);
    STAMP_BEGIN(10);
    REP(10) if (IN(10)) { if (rep_) GRID_BAR();
        const LAS int* tab = moe_tables(F);
        pg8::Gemm g{(const bf16_t*)(ws + WS_B), (const bf16_t*)(ws + WS_D), DM, DM, DM};
        pg8::GroupedOrder S; S.init(4, F.G, F.vcu, tab, (const int*)(ws + WS_LIST));
        pg8::EpiSwiGLU E{(bf16_t*)(ws + WS_C), (unsigned*)(F.ctl + CW_RDY)};
        pg8::gemm_phase<pg8::EpiSwiGLU, pg8::GroupedOrder, true>(F.lds, g, S, E);
    }
    REP(11) if (IN(11)) { if (rep_) GRID_BAR();
        const LAS int* tab = moe_tables(F);
        pg8::Gemm g{(const bf16_t*)(ws + WS_C), (const bf16_t*)(ws + WS_E), DE, DE, DE};
        pg8::RedealOrder S; S.init(8, F.G, F.vcu, tab, 4, (unsigned*)(F.ctl + CW_RDY), 32u, (unsigned*)(F.ctl + CW_TMO));
        pg8::EpiStore E{(bf16_t*)(ws + WS_A), DM, nullptr, 0.f, nullptr, nullptr, 0, 0, 0};
        pg8::gemm_phase<pg8::EpiStore, pg8::RedealOrder>(F.lds, g, S, E);
    } SEAM(11); STAMP_END(11);
    REP(12) if (IN(12)) { if (rep_) GRID_BAR(); p12_phase(F, args); }
#endif
#undef IN
#undef SEAM
}

extern "C" void kernel_launch(void* const* d_in, const int* in_sizes, int n_in, void* d_out, int out_size, void* d_ws, size_t ws_size, hipStream_t stream) {
    static int grid = 0;
    if (grid == 0) {
        if (n_in != 25 || out_size != T * DM || ws_size < WS_END) { fprintf(stderr, "kernel_launch: bad shapes (n_in %d out %d ws %zu)\n", n_in, out_size, ws_size); grid = -1; return; }
        int dev = 0, cus = 0, per_cu = 0;
        if (hipGetDevice(&dev) != hipSuccess || hipDeviceGetAttribute(&cus, hipDeviceAttributeMultiprocessorCount, dev) != hipSuccess) { grid = -1; return; }
        if (hipFuncSetAttribute((const void*)mk_fwd, hipFuncAttributeMaxDynamicSharedMemorySize, LDS_BYTES) != hipSuccess) { fprintf(stderr, "kernel_launch: hipFuncSetAttribute failed\n"); grid = -1; return; }
        if (hipOccupancyMaxActiveBlocksPerMultiprocessor(&per_cu, (const void*)mk_fwd, NTHR, LDS_BYTES) != hipSuccess || per_cu < 1) { fprintf(stderr, "kernel_launch: occupancy query says %d\n", per_cu); }
        (void)hipGetLastError();
        grid = cus;
    }
    if (grid < 0) return;
    (void)hipMemsetAsync((char*)d_ws + WS_CTL, 0, CTL_ZERO_BYTES, stream);
    Args a{};
    for (int i = 0; i < 25; ++i) a.in[i] = (const float*)d_in[i];
    a.out = (float*)d_out; a.ws = (unsigned char*)d_ws;
#if MK_MULTI
    for (int p = 0; p < N_PHASES; ++p) { a.ph_lo = p; a.ph_hi = p + 1; hipLaunchKernelGGL(mk_fwd, dim3(grid), dim3(NTHR), LDS_BYTES, stream, a); }
#else
    a.ph_lo = 0; a.ph_hi = N_PHASES; hipLaunchKernelGGL(mk_fwd, dim3(grid), dim3(NTHR), LDS_BYTES, stream, a);
#endif
}
```

```cpp
#include <hip/hip_runtime.h>
#include <cstdio>
#include <cstdint>

#define GAS __attribute__((address_space(1)))
#define LAS __attribute__((address_space(3)))
typedef unsigned short bf16_t;
typedef short bf16x8 __attribute__((ext_vector_type(8)));
typedef short s16x4 __attribute__((ext_vector_type(4)));
typedef float f32x4 __attribute__((ext_vector_type(4)));
typedef float f32x2 __attribute__((ext_vector_type(2)));
typedef float f32x16 __attribute__((ext_vector_type(16)));
typedef unsigned u32x4 __attribute__((ext_vector_type(4)));
typedef unsigned u32x2 __attribute__((ext_vector_type(2)));
typedef GAS unsigned gu32;
#define RLX_AGENT __ATOMIC_RELAXED, __HIP_MEMORY_SCOPE_AGENT
#define LDS_WAIT() asm volatile("s_waitcnt lgkmcnt(0)" ::: "memory")
#define VM_WAIT() asm volatile("s_waitcnt vmcnt(0)" ::: "memory")

constexpr int DM = 2048, NB = 8, SEQ = 2048, T = NB * SEQ;
constexpr int HW = 1024, HH = 8, HDK = 128, HDV = 128;
constexpr int MH = 8, MNOPE = 128, MROPE = 64, MQK = 192, MV = 128, QLORA = 512, KVLORA = 256;
constexpr int INC = 4 * HW + QLORA + KVLORA + MROPE;
constexpr int INCP = 5120;
constexpr int C_QA = 4096, C_KVA = 4608, C_KPE = 4864;
constexpr int NG = 4, EPG = 8, NE = 32, DE = 512;
constexpr int RMAX = (T * 2 / 256 + NE) * 256;
constexpr float EPS = 1e-6f;
constexpr int NWAVES = 8, NTHR = 512;

typedef __bf16 bf16x2_t __attribute__((ext_vector_type(2)));
__device__ __forceinline__ unsigned cvt_pk_bf16(float lo, float hi) { const f32x2 v = {lo, hi}; return __builtin_bit_cast(unsigned, __builtin_convertvector(v, bf16x2_t)); }
__device__ __forceinline__ float bf_lo(unsigned w) { return __builtin_bit_cast(float, w << 16); }
__device__ __forceinline__ float bf_hi(unsigned w) { return __builtin_bit_cast(float, w & 0xffff0000u); }
__device__ __forceinline__ float bf2f(bf16_t h) { return __builtin_bit_cast(float, (unsigned)h << 16); }
__device__ __forceinline__ float wave_sum(float v) {
#pragma unroll
    for (int o = 1; o < 64; o <<= 1) v += __shfl_xor(v, o);
    return v;
}
__device__ __forceinline__ float siluf(float v) { return v / (1.f + __expf(-v)); }

#define XB_TMO      128
#define XB_XCNT(j)  (256  + 64 * (j))
#define XB_XSUB(j)  (1280 + 64 * (j))
#define XB_XGEN(j)  (2304 + 64 * (j))
#define XB_TOP      3328
#define XB_TOPGEN   3392
#define XCD_BAR_WORDS 3456
#define XB_SPIN_CAP (1u << 18)

__device__ __forceinline__ unsigned xb_ld(unsigned* p)              { return __hip_atomic_load(p, __ATOMIC_RELAXED, __HIP_MEMORY_SCOPE_AGENT); }
__device__ __forceinline__ unsigned xb_add(unsigned* p, unsigned v) { return __hip_atomic_fetch_add(p, v, __ATOMIC_RELAXED, __HIP_MEMORY_SCOPE_AGENT); }
__device__ __forceinline__ unsigned xb_xcc_id() { return (unsigned)__builtin_amdgcn_s_getreg((3 << 11) | 20) & 0xFu; }
#define XB_SPIN(cond, bar) do { unsigned _sp = 0; while (cond) { __builtin_amdgcn_s_sleep(1); \
    if ((++_sp & 255u) == 0u) { if (xb_ld(&(bar)[XB_TMO])) break; if (_sp > XB_SPIN_CAP) { atomicAdd(&(bar)[XB_TMO], 1u); break; } } } } while (0)

struct XcdBarrier {
    unsigned* bar; unsigned x;
    volatile LAS unsigned* st;
};
__device__ __forceinline__ XcdBarrier xcd_barrier_post(unsigned* bar, volatile LAS unsigned* st) {
    XcdBarrier b; b.bar = bar; b.x = xb_xcc_id(); b.st = st;
    if (threadIdx.x == 0) (void)xb_add(&bar[XB_XCNT(b.x)], 1u);
    return b;
}
__device__ __forceinline__ void xcd_barrier_complete(unsigned* bar, unsigned x, unsigned& nloc, unsigned& nx) {
    const unsigned G = gridDim.x * gridDim.y * gridDim.z;
    unsigned sum, cnt, mine, sp = 0u;
    for (;;) {
        sum = 0u; cnt = 0u; mine = 0u;
#pragma unroll
        for (unsigned j = 0; j < 16; ++j) { const unsigned c = xb_ld(&bar[XB_XCNT(j)]); sum += c; cnt += (c > 0u) ? 1u : 0u; mine = (j == x) ? c : mine; }
        if (sum == G) break;
        __builtin_amdgcn_s_sleep(1);
        if ((++sp & 255u) == 0u) { if (xb_ld(&bar[XB_TMO])) break; if (sp > XB_SPIN_CAP) { atomicAdd(&bar[XB_TMO], 1u); break; } }
    }
    nloc = mine > 0u ? mine : 1u; nx = cnt > 0u ? cnt : 1u;
}
__device__ __forceinline__ void xcd_barrier(const XcdBarrier& b) {
    asm volatile("s_waitcnt vmcnt(0)" ::: "memory");
    __syncthreads();
    if (threadIdx.x == 0) {
        unsigned* bar = b.bar;
        __builtin_amdgcn_s_waitcnt(0);
        unsigned nloc = b.st[0], nx = b.st[1];
        if (nloc == 0u) { xcd_barrier_complete(bar, b.x, nloc, nx); b.st[0] = nloc; b.st[1] = nx; }
        const unsigned old = xb_add(&bar[XB_XSUB(b.x)], 1u);
        const unsigned gen = old / nloc;
        if (old + 1u == (gen + 1u) * nloc) {
            __builtin_amdgcn_fence(__ATOMIC_RELEASE, "agent");
            asm volatile("s_waitcnt vmcnt(0)" ::: "memory");
            const unsigned og = xb_add(&bar[XB_TOP], 1u);
            const unsigned tg = og / nx;
            if (og + 1u == (tg + 1u) * nx) xb_add(&bar[XB_TOPGEN], 1u);
            else XB_SPIN(xb_ld(&bar[XB_TOPGEN]) == tg, bar);
            __builtin_amdgcn_fence(__ATOMIC_ACQUIRE, "agent");
            xb_add(&bar[XB_XGEN(b.x)], 1u);
            asm volatile("s_waitcnt vmcnt(0)" ::: "memory");
        } else {
            XB_SPIN(xb_ld(&bar[XB_XGEN(b.x)]) == gen, bar);
            __builtin_amdgcn_fence(__ATOMIC_ACQUIRE, "agent");
            asm volatile("s_waitcnt vmcnt(0)" ::: "memory");
        }
    }
    __syncthreads();
}

namespace pg8 {
constexpr int BM = 256, BK = 64, HALF = 128, HTB = HALF * BK * 2, STAGE_BYTES = 8 * HTB, NXCD = 8, WGM = 8;
__host__ __device__ __forceinline__ int lds_byte(int r, int c) { const int st = (r >> 4) * 2 + (c >> 5), rr = r & 15, cc = c & 31, ob = rr * 64 + cc * 2; return st * 1024 + (ob ^ (((ob >> 9) & 1) << 5)); }
__host__ __device__ __forceinline__ void stage_rc(int b, int& R, int& C) { const int st = b / 1024, sb = b % 1024, swz = sb ^ (((sb >> 9) & 1) << 5); R = (st >> 1) * 16 + swz / 64; C = (st & 1) * 32 + (swz % 64) / 2; }
__host__ __device__ __forceinline__ int perm32(int rho) { const int n = rho >> 4, i = rho & 15; return 8 * (i >> 2) + 4 * n + (i & 3); }

struct Unit { int pm, pn, pb; };
struct Gemm { const bf16_t* A; const bf16_t* Bt; int lda, ldb, K; };

struct DenseOrder {
    int nM, nN, nwg, G, c;
    __device__ void init(int nM_, int nN_, int G_, int c_) { nM = nM_; nN = nN_; nwg = nM * nN; G = G_; c = c_; }
    __device__ bool next(int i, Unit& u) const {
        const long L = (long)i * G + c; if (L >= nwg) return false;
        int wgid = (int)L; { const int q = nwg / NXCD, r = nwg % NXCD, xcd = wgid % NXCD, off = wgid / NXCD; wgid = (xcd < r ? xcd * (q + 1) : r * (q + 1) + (xcd - r) * q) + off; }
        const int nig = WGM * nN, gid = wgid / nig, fm = gid * WGM, gsz = (nM - fm) < WGM ? (nM - fm) : WGM;
        u.pm = fm + ((wgid % nig) % gsz); u.pn = (wgid % nig) / gsz; u.pb = u.pn; return true;
    }
    __device__ __forceinline__ void a_ready(const Unit&) const {}
};
struct GroupedOrder {
    int nM, nN, nwg, G, c; const LAS int* tile_e; const LAS int* pstart; const LAS int* cnt; const int* list;
    __device__ void init(int nN_, int G_, int c_, const LAS int* tab, const int* list_) { pstart = tab; cnt = tab + 64; tile_e = tab + 128; list = list_; nM = pstart[32] >> 8; nN = nN_; nwg = nM * nN; G = G_; c = c_; }
    __device__ bool next(int i, Unit& u) const {
        const long L = (long)i * G + c; if (L >= nwg) return false;
        const int w = (int)L; u.pn = w % nN; u.pm = w / nN; u.pb = tile_e[u.pm] * nN + u.pn; return true;
    }
    __device__ int arow(const Unit& u, int r) const { const int e = tile_e[u.pm], j = 256 * u.pm - pstart[e] + r; return j < cnt[e] ? list[e * T + j] : 0; }
    __device__ __forceinline__ void a_ready(const Unit&) const {}
};
struct RedealOrder {
    int nM, nN, nwg, G, c, r10, X, nlight, head; const LAS int* tile_e; unsigned* ready; unsigned need; unsigned* tmo;
    __device__ void init(int nN_, int G_, int c_, const LAS int* tab, int nN10, unsigned* ready_, unsigned need_, unsigned* tmo_) {
        tile_e = tab + 128; nM = tab[32] >> 8; nN = nN_; nwg = nM * nN; G = G_; c = c_; ready = ready_; need = need_; tmo = tmo_;
        r10 = (nM * nN10) % G; X = r10 ? 3 : 0; nlight = G - r10; head = X * nlight < nwg ? X * nlight : nwg; }
    __device__ bool next(int i, Unit& u) const {
        long id;
        if (c >= r10 && X) id = i < X ? (long)i * nlight + (c - r10) : (long)head + (long)(i - X) * G + c;
        else id = (long)head + (long)i * G + c;
        if ((i < X && c >= r10 && id >= head) || id >= nwg) return false;
        u.pm = (int)id / nN; u.pn = (int)id % nN; u.pb = tile_e[u.pm] * nN + u.pn; return true;
    }
    __device__ __forceinline__ void a_ready(const Unit& u) const {
        if (threadIdx.x < 64) {
            unsigned polls = 0;
            while ((unsigned)__builtin_amdgcn_readfirstlane(__hip_atomic_load(ready + 64 * u.pm, __ATOMIC_RELAXED, __HIP_MEMORY_SCOPE_AGENT)) < need) {
                if (++polls > (1u << 16)) { if (threadIdx.x == 0) __hip_atomic_store(tmo, 0xDEAD0000u | (unsigned)u.pm, __ATOMIC_RELAXED, __HIP_MEMORY_SCOPE_AGENT); break; }
                __builtin_amdgcn_s_sleep(2); }
            __builtin_amdgcn_fence(__ATOMIC_ACQUIRE, "agent");
            asm volatile("s_waitcnt vmcnt(0)" ::: "memory");
        }
        asm volatile("" ::: "memory"); __builtin_amdgcn_s_barrier(); asm volatile("" ::: "memory");
    }
};

template <class Epi, class Sched, bool GATHER = false>
__device__ __forceinline__ void gemm_phase(LAS unsigned char* lds, const Gemm g, const Sched& S, const Epi& E) {
    int tid = threadIdx.x; asm volatile("" : "+v"(tid));
    const int wid = __builtin_amdgcn_readfirstlane(tid >> 6), lane = tid & 63, wr = wid >> 2, wc = wid & 3, fr = lane & 15, fq = lane >> 4;
    const int K = g.K, nt = K / BK;
    unsigned voffA[2], voffB[2]; int gR[2], gC[2];
#pragma unroll
    for (int i = 0; i < 2; ++i) { int R, C; stage_rc(tid * 16 + i * 8192, R, C); const int Rb = (R & ~31) + perm32(R & 31); gR[i] = R; gC[i] = C;
        voffA[i] = (unsigned)(R * g.lda + C) * 2u; voffB[i] = (unsigned)(Rb * g.ldb + C) * 2u; }
    const size_t kstep = (size_t)(BK * 2);
    const size_t hsA = (size_t)HALF * g.lda * 2, hsB = (size_t)HALF * g.ldb * 2;
    const unsigned ldsw = (unsigned)wid * 1024u;
    const int aoff = lds_byte(wr * 64 + fr, fq * 8), boff = lds_byte(wc * 32 + fr, fq * 8);
#define PG8_SA(b, h) (((b) * 2 + (h)) * HTB)
#define PG8_SB(b, h) ((4 + (b) * 2 + (h)) * HTB)
#define PG8_STAGE(bufoff, gbase, voff) do { _Pragma("unroll") for (int _i = 0; _i < 2; ++_i) \
        __builtin_amdgcn_global_load_lds((const unsigned*)((const char*)(gbase) + (voff)[_i]), (LAS unsigned*)(lds + (bufoff) + ldsw + _i * 8192), 16, 0, 0); } while (0)
#define PG8_STAGE_A(bufoff, dense_ptr, kbytes, offs) do { if constexpr (GATHER) { PG8_STAGE(bufoff, (const char*)g.A + (kbytes), offs); } else { PG8_STAGE(bufoff, dense_ptr, voffA); } } while (0)
#define PG8_GOFF(u, o0, o1) do { _Pragma("unroll") for (int _i = 0; _i < 2; ++_i) { o0[_i] = (unsigned)(S.arow(u, gR[_i]) * g.lda + gC[_i]) * 2u; o1[_i] = (unsigned)(S.arow(u, gR[_i] + HALF) * g.lda + gC[_i]) * 2u; } } while (0)
#define PG8_LDA(dst, b, h) do { _Pragma("unroll") for (int m = 0; m < 4; ++m) _Pragma("unroll") for (int k = 0; k < 2; ++k) dst[m][k] = *(const LAS bf16x8*)(lds + PG8_SA(b, h) + aoff + m * 2048 + k * 1024); } while (0)
#define PG8_LDB(dst, b, h) do { _Pragma("unroll") for (int n = 0; n < 2; ++n) _Pragma("unroll") for (int k = 0; k < 2; ++k) dst[n][k] = *(const LAS bf16x8*)(lds + PG8_SB(b, h) + boff + n * 2048 + k * 1024); } while (0)
#define PG8_MMA(ai, bj, At, Bt) do { __builtin_amdgcn_s_setprio(1); _Pragma("unroll") for (int m = 0; m < 4; ++m) _Pragma("unroll") for (int n = 0; n < 2; ++n) _Pragma("unroll") for (int k = 0; k < 2; ++k) \
        acc[ai][bj][m][n] = __builtin_amdgcn_mfma_f32_16x16x32_bf16(Bt[n][k], At[m][k], acc[ai][bj][m][n], 0, 0, 0); __builtin_amdgcn_s_setprio(0); } while (0)
#define PG8_WAIT_V(n) asm volatile("s_waitcnt vmcnt(" #n ")" ::: "memory")
#define PG8_WAIT_L(n) asm volatile("s_waitcnt lgkmcnt(" #n ")" ::: "memory")
#define PG8_BAR __builtin_amdgcn_s_barrier()
#define PG8_SCHED __builtin_amdgcn_sched_barrier(0)
    Unit cur, nxt; int ui = 0;
    if (!S.next(0, cur)) return;
    unsigned cO0[2] = {0u, 0u}, cO1[2] = {0u, 0u}, nO0[2] = {0u, 0u}, nO1[2] = {0u, 0u};
    if constexpr (GATHER) { PG8_GOFF(cur, cO0, cO1); }
    S.a_ready(cur);
    f32x4 acc[2][2][4][2];
#pragma unroll
    for (int a = 0; a < 2; ++a)
#pragma unroll
        for (int b = 0; b < 2; ++b)
#pragma unroll
            for (int m = 0; m < 4; ++m)
#pragma unroll
                for (int n = 0; n < 2; ++n) acc[a][b][m][n] = (f32x4){0.f, 0.f, 0.f, 0.f};
    bf16x8 At[4][2], B0[2][2], B1[2][2];
    const char* cA = (const char*)g.A + (GATHER ? (size_t)0 : (size_t)cur.pm * 2 * hsA); const char* cB = (const char*)g.Bt + (size_t)cur.pb * 2 * hsB;
    PG8_STAGE(PG8_SB(0, 0), cB, voffB); PG8_STAGE(PG8_SB(0, 1), cB + hsB, voffB); PG8_STAGE_A(PG8_SA(0, 0), cA, 0, cO0); PG8_STAGE_A(PG8_SA(0, 1), cA + hsA, 0, cO1);
    if (wr == 1) PG8_BAR;
    PG8_WAIT_V(2); PG8_BAR;
    PG8_STAGE(PG8_SB(1, 0), cB + kstep, voffB); PG8_STAGE_A(PG8_SA(1, 0), cA + kstep, kstep, cO0); PG8_STAGE(PG8_SB(1, 1), cB + hsB + kstep, voffB);
    PG8_WAIT_V(6); PG8_BAR;
    for (;;) {
        const bool has_next = S.next(ui + 1, nxt);
        const char* nA = (has_next && !GATHER) ? (const char*)g.A + (size_t)nxt.pm * 2 * hsA : cA; const char* nB = has_next ? (const char*)g.Bt + (size_t)nxt.pb * 2 * hsB : cB;
        if constexpr (GATHER) { if (has_next) { PG8_GOFF(nxt, nO0, nO1); } else { nO0[0] = cO0[0]; nO0[1] = cO0[1]; nO1[0] = cO1[0]; nO1[1] = cO1[1]; } }
        for (int t = 0; t < nt; t += 2) {
            const bool last = (t == nt - 2);
            if (last && has_next) S.a_ready(nxt);
            const char* a1 = cA + (size_t)(t + 1) * kstep;
            const char* a2 = last ? nA : cA + (size_t)(t + 2) * kstep; const char* b2 = last ? nB : cB + (size_t)(t + 2) * kstep;
            const char* a3 = a2 + kstep; const char* b3 = b2 + kstep;
            const size_t k2 = last ? (size_t)0 : (size_t)(t + 2) * kstep;
            unsigned o0[2], o1[2]; o0[0] = last ? nO0[0] : cO0[0]; o0[1] = last ? nO0[1] : cO0[1]; o1[0] = last ? nO1[0] : cO1[0]; o1[1] = last ? nO1[1] : cO1[1];
            PG8_LDB(B0, 0, 0); PG8_LDB(B1, 0, 1); PG8_SCHED; PG8_LDA(At, 0, 0); PG8_STAGE_A(PG8_SA(1, 1), a1 + hsA, (size_t)(t + 1) * kstep, cO1);
            PG8_WAIT_V(8); PG8_WAIT_L(0); PG8_BAR; PG8_MMA(0, 0, At, B0); PG8_MMA(0, 1, At, B1); PG8_BAR; PG8_SCHED;
            PG8_LDA(At, 0, 1); PG8_STAGE(PG8_SB(0, 0), b2, voffB); PG8_STAGE(PG8_SB(0, 1), b2 + hsB, voffB); PG8_STAGE_A(PG8_SA(0, 0), a2, k2, o0);
            PG8_WAIT_V(8); PG8_WAIT_L(0); PG8_BAR; PG8_MMA(1, 0, At, B0); PG8_MMA(1, 1, At, B1); PG8_BAR; PG8_SCHED;
            PG8_LDB(B0, 1, 0); PG8_LDB(B1, 1, 1); PG8_SCHED; PG8_LDA(At, 1, 0); PG8_STAGE_A(PG8_SA(0, 1), a2 + hsA, k2, o1);
            PG8_WAIT_V(8); PG8_WAIT_L(0); PG8_BAR; PG8_MMA(0, 0, At, B0); PG8_MMA(0, 1, At, B1); PG8_BAR; PG8_SCHED;
            PG8_LDA(At, 1, 1); PG8_STAGE(PG8_SB(1, 0), b3, voffB); PG8_STAGE(PG8_SB(1, 1), b3 + hsB, voffB); PG8_STAGE_A(PG8_SA(1, 0), a3, k2 + kstep, o0);
            PG8_WAIT_V(8); PG8_WAIT_L(0); PG8_BAR; PG8_MMA(1, 0, At, B0); PG8_MMA(1, 1, At, B1); PG8_BAR; PG8_SCHED;
        }
        if (wr == 0) PG8_BAR;
        E(acc, cur, wr, wc, fr, fq);
        if (!has_next) break;
#pragma unroll
        for (int a = 0; a < 2; ++a)
#pragma unroll
            for (int b = 0; b < 2; ++b)
#pragma unroll
                for (int m = 0; m < 4; ++m)
#pragma unroll
                    for (int n = 0; n < 2; ++n) acc[a][b][m][n] = (f32x4){0.f, 0.f, 0.f, 0.f};
        cur = nxt; cA = nA; cB = nB; ++ui;
        if constexpr (GATHER) { cO0[0] = nO0[0]; cO0[1] = nO0[1]; cO1[0] = nO1[0]; cO1[1] = nO1[1]; }
        if (wr == 1) PG8_BAR;
    }
    PG8_WAIT_V(0);
    PG8_BAR;
#undef PG8_SA
#undef PG8_SB
#undef PG8_STAGE
#undef PG8_STAGE_A
#undef PG8_GOFF
#undef PG8_LDA
#undef PG8_LDB
#undef PG8_MMA
#undef PG8_WAIT_V
#undef PG8_WAIT_L
#undef PG8_BAR
#undef PG8_SCHED
}

struct EpiStore {
    bf16_t* O; int ldc; const float* ssq; float inv; float* ssq_out0; float* ssq_out1; int pn0, pn1, pn2;
    __device__ __forceinline__ void operator()(const f32x4 (&acc)[2][2][4][2], const Unit& u, int wr, int wc, int fr, int fq) const {
        const int row0 = u.pm * BM + wr * 64 + fr, col0 = u.pn * BM + wc * 32 + 8 * fq;
        float* so = (ssq_out0 && u.pn >= pn0 && u.pn < pn2) ? (u.pn < pn1 ? ssq_out0 : ssq_out1) : nullptr;
        float rsv[2][4];
#pragma unroll
        for (int ai = 0; ai < 2; ++ai)
#pragma unroll
            for (int m = 0; m < 4; ++m) rsv[ai][m] = ssq ? ssq[row0 + ai * HALF + m * 16] : 0.f;
#pragma unroll
        for (int ai = 0; ai < 2; ++ai)
#pragma unroll
            for (int m = 0; m < 4; ++m) { const int row = row0 + ai * HALF + m * 16; const float rs = ssq ? rsqrtf(rsv[ai][m] * inv + EPS) : 1.f;
                bf16_t* rowp = O + (size_t)row * ldc + col0; float ss = 0.f;
#pragma unroll
                for (int bj = 0; bj < 2; ++bj) { const f32x4 v0 = acc[ai][bj][m][0] * rs, v1 = acc[ai][bj][m][1] * rs;
                    ss += (v0[0] * v0[0] + v0[1] * v0[1]) + (v0[2] * v0[2] + v0[3] * v0[3]) + (v1[0] * v1[0] + v1[1] * v1[1]) + (v1[2] * v1[2] + v1[3] * v1[3]);
                    u32x4 w; w.x = cvt_pk_bf16(v0[0], v0[1]); w.y = cvt_pk_bf16(v0[2], v0[3]); w.z = cvt_pk_bf16(v1[0], v1[1]); w.w = cvt_pk_bf16(v1[2], v1[3]);
                    *(u32x4*)(rowp + bj * HALF) = w; }
                if (so) { ss += __shfl_xor(ss, 16); ss += __shfl_xor(ss, 32); if (fq == 0) atomicAdd(so + row, ss); } }
    }
};
struct EpiResid {
    const float* X; float* O; const float* gate; int gpitch;
    __device__ __forceinline__ void operator()(const f32x4 (&acc)[2][2][4][2], const Unit& u, int wr, int wc, int fr, int fq) const {
        const int row0 = u.pm * BM + wr * 64 + fr, col0 = u.pn * BM + wc * 32 + 8 * fq;
        const float* gp = gate + (size_t)((u.pm * BM) / SEQ) * gpitch + col0;
        f32x4 gv[2][2];
#pragma unroll
        for (int bj = 0; bj < 2; ++bj)
#pragma unroll
            for (int n = 0; n < 2; ++n) gv[bj][n] = *(const f32x4*)(gp + bj * HALF + 4 * n);
#pragma unroll
        for (int ai = 0; ai < 2; ++ai)
#pragma unroll
            for (int m = 0; m < 4; ++m) { const size_t off = (size_t)(row0 + ai * HALF + m * 16) * DM + col0;
#pragma unroll
                for (int bj = 0; bj < 2; ++bj)
#pragma unroll
                    for (int n = 0; n < 2; ++n) { const f32x4 xv = *(const f32x4*)(X + off + bj * HALF + 4 * n);
                        *(f32x4*)(O + off + bj * HALF + 4 * n) = xv + gv[bj][n] * acc[ai][bj][m][n]; } }
    }
};
struct EpiSwiGLU {
    bf16_t* O; unsigned* ready;
    __device__ __forceinline__ void operator()(const f32x4 (&acc)[2][2][4][2], const Unit& u, int wr, int wc, int fr, int fq) const {
        const int row0 = u.pm * BM + wr * 64 + fr, col0 = u.pn * HALF + wc * 32 + 8 * fq;
        const __amdgpu_buffer_rsrc_t rs = __builtin_amdgcn_make_buffer_rsrc((void*)O, (short)0, RMAX * DE * 2, 0x00020000);
#pragma unroll
        for (int ai = 0; ai < 2; ++ai)
#pragma unroll
            for (int m = 0; m < 4; ++m) { const int row = row0 + ai * HALF + m * 16;
                float h[8];
#pragma unroll
                for (int n = 0; n < 2; ++n)
#pragma unroll
                    for (int j = 0; j < 4; ++j) { const float gt = acc[ai][0][m][n][j], up = acc[ai][1][m][n][j]; h[4 * n + j] = gt / (1.f + __expf(-gt)) * up; }
                u32x4 w; w.x = cvt_pk_bf16(h[0], h[1]); w.y = cvt_pk_bf16(h[2], h[3]); w.z = cvt_pk_bf16(h[4], h[5]); w.w = cvt_pk_bf16(h[6], h[7]);
                __builtin_amdgcn_raw_buffer_store_b128(w, rs, (unsigned)(row * DE + col0) * 2u, 0, 16); }
        asm volatile("s_waitcnt vmcnt(0)" ::: "memory");
        if ((threadIdx.x & 63) == 0) __hip_atomic_fetch_add(ready + 64 * u.pm, 1u, __ATOMIC_RELAXED, __HIP_MEMORY_SCOPE_AGENT);
    }
};
}
constexpr size_t MiB = 1u << 20;
constexpr size_t WS_CTL = 0, CTL_ZERO_BYTES = 1 * MiB;
constexpr size_t WS_MOD = 1 * MiB;
constexpr size_t WS_ROPEC = 1 * MiB + 512 * 1024;
constexpr size_t WS_ROPES = WS_ROPEC + 2 * MiB;
constexpr size_t WS_WCT = WS_ROPES + 2 * MiB;
constexpr size_t WS_RSTDQ = 6 * MiB;
constexpr size_t WS_RSTDKV = WS_RSTDQ + 64 * 1024;
constexpr size_t WS_TOKE = WS_RSTDKV + 64 * 1024;
constexpr size_t WS_TOKW = WS_TOKE + 128 * 1024;
constexpr size_t WS_TOKS = WS_TOKW + 128 * 1024;
constexpr size_t WS_BLKE = WS_TOKS + 128 * 1024;
constexpr size_t WS_STAMP = WS_BLKE + 4096;
constexpr size_t WS_WIN = 8 * MiB;
constexpr size_t WS_WQUP = 28 * MiB;
constexpr size_t WS_WKVUP = WS_WQUP + 1536 * 1024;
constexpr size_t WS_WOUT = 31 * MiB;
constexpr size_t WS_A = 40 * MiB;
constexpr size_t WS_B = 200 * MiB;
constexpr size_t WS_C = 264 * MiB;
constexpr size_t WS_D = 328 * MiB;
constexpr size_t WS_E = 456 * MiB;
constexpr size_t WS_LIST = 520 * MiB;
constexpr size_t WS_F = 522 * MiB;
constexpr size_t WS_END = 586 * MiB;
constexpr size_t QN_BYTES = (size_t)T * MH * MQK * 2;

constexpr int CW_BAR = 4096;
constexpr int CW_CNT = 8192;
constexpr int CW_RDY = 10240;
constexpr int CW_ADA = 64;
constexpr int CW_TMO = 1;

constexpr int RING_BYTES = 131072, LDS_BYTES = 147456, LDS_USER = 143360, MISC_OFF = LDS_BYTES - 512;

struct Args { const float* in[25]; float* out; unsigned char* ws; int ph_lo, ph_hi, pad0, pad1; };

struct Frame {
    LAS unsigned char* lds;
    volatile LAS unsigned* MISC;
    gu32* ctl;
    int tid, lane, wave, vcu, G;
    unsigned char* ws; float* out;
};

#define OPAQUE_FRAME(F) do { F.tid = threadIdx.x; asm volatile("" : "+v"(F.tid)); F.lane = F.tid & 63; } while (0)

__device__ __forceinline__ void unpack8(const u32x4 w, float* f) { f[0] = bf_lo(w.x); f[1] = bf_hi(w.x); f[2] = bf_lo(w.y); f[3] = bf_hi(w.y); f[4] = bf_lo(w.z); f[5] = bf_hi(w.z); f[6] = bf_lo(w.w); f[7] = bf_hi(w.w); }
__device__ __forceinline__ u32x4 pack8f(const float* f) { u32x4 w; w.x = cvt_pk_bf16(f[0], f[1]); w.y = cvt_pk_bf16(f[2], f[3]); w.z = cvt_pk_bf16(f[4], f[5]); w.w = cvt_pk_bf16(f[6], f[7]); return w; }

struct TrItem { const float* src; bf16_t* dst; bf16_t* dst2; const float* gk; int N, ldt; };
__device__ __forceinline__ void tr_load(const TrItem& it, f32x4 (&r)[16], int lane) {
    const float* p = it.src + (size_t)(lane >> 4) * it.N + 4 * (lane & 15);
#pragma unroll
    for (int i = 0; i < 16; ++i) r[i] = __builtin_nontemporal_load((const f32x4*)(p + (size_t)(4 * i) * it.N));
}
__device__ __forceinline__ void tr_store(const TrItem& it, const f32x4 (&r)[16], LAS unsigned char* Tl, int lane) {
    const int row = lane >> 4, c4 = lane & 15;
#pragma unroll
    for (int i = 0; i < 16; ++i) { f32x4 v = r[i]; if (it.gk) v = v * it.gk[4 * i + row];
        u32x2 w; w.x = cvt_pk_bf16(v.x, v.y); w.y = cvt_pk_bf16(v.z, v.w);
        *(LAS u32x2*)(Tl + ((4 * i + row) * 64 + 4 * c4) * 2) = w; }
    LDS_WAIT(); asm volatile("" ::: "memory");
    const int g = lane >> 4, i16 = lane & 15, q = i16 >> 2, pp = lane & 3;
    typedef short v4i16_t __attribute__((ext_vector_type(4)));
#pragma unroll
    for (int hh = 0; hh < 2; ++hh) { bf16_t* drow = (hh ? it.dst2 : it.dst) + (size_t)(16 * (g & 1) + i16) * it.ldt;
#pragma unroll
        for (int j = 0; j < 4; ++j) { const int kc = 4 * (g >> 1) + j;
            const v4i16_t lo = __builtin_amdgcn_ds_read_tr16_b64_v4i16((LAS v4i16_t*)(Tl + ((8 * kc + q) * 64 + 32 * hh + 16 * (g & 1) + 4 * pp) * 2));
            const v4i16_t hi = __builtin_amdgcn_ds_read_tr16_b64_v4i16((LAS v4i16_t*)(Tl + ((8 * kc + 4 + q) * 64 + 32 * hh + 16 * (g & 1) + 4 * pp) * 2));
            const bf16x8 o = {lo[0], lo[1], lo[2], lo[3], hi[0], hi[1], hi[2], hi[3]};
            *(bf16x8*)(drow + 8 * kc) = o; } }
    LDS_WAIT(); asm volatile("" ::: "memory");
}
template <class MK> __device__ __forceinline__ void tr_run(int first, int step, int n, const MK& mk, LAS unsigned char* Tl, int lane) {
    if (first >= n) return;
    f32x4 ra[16], rb[16];
    TrItem ia = mk(first), ib = ia;
    tr_load(ia, ra, lane);
    for (int idx = first; idx < n; idx += 2 * step) {
        if (idx + step < n) { ib = mk(idx + step); tr_load(ib, rb, lane); }
        tr_store(ia, ra, Tl, lane);
        if (idx + step >= n) break;
        if (idx + 2 * step < n) { ia = mk(idx + 2 * step); tr_load(ia, ra, lane); }
        tr_store(ib, rb, Tl, lane);
    }
}

__device__ __forceinline__ void adaln_phase(Frame& F, const float* c, const float* w_ada, const float* b_ada, float* mod) {
    LAS float* cact = (LAS float*)F.lds;
    LAS float* part = (LAS float*)(F.lds + 65536);
    for (int i = F.tid; i < NB * DM; i += NTHR) cact[i] = siluf(c[i]);
    __syncthreads();
    const int cg = F.tid & 7, rs = F.tid >> 3;
    for (int it = blockIdx.x; it < 6 * DM / 32; it += F.G) {
        const int n0 = it * 32 + cg * 4;
        f32x4 acc[8];
#pragma unroll
        for (int b = 0; b < 8; ++b) acc[b] = (f32x4){0.f, 0.f, 0.f, 0.f};
#pragma unroll 1
        for (int i0 = 0; i0 < 32; i0 += 16) { f32x4 w[16];
#pragma unroll
            for (int u = 0; u < 16; ++u) w[u] = __builtin_nontemporal_load((const f32x4*)(w_ada + (size_t)(rs + 64 * (i0 + u)) * (6 * DM) + n0));
#pragma unroll
            for (int u = 0; u < 16; ++u) { const int k = rs + 64 * (i0 + u);
#pragma unroll
                for (int b = 0; b < 8; ++b) acc[b] += w[u] * cact[b * DM + k]; } }
#pragma unroll
        for (int b = 0; b < 8; ++b) *(LAS f32x4*)(part + (rs * 8 + b) * 32 + cg * 4) = acc[b];
        __syncthreads();
        if (F.tid < 256) { const int b = F.tid >> 5, n = F.tid & 31; float s = 0.f;
#pragma unroll 8
            for (int r = 0; r < 64; ++r) s += part[(r * 8 + b) * 32 + n];
            __hip_atomic_store(mod + b * (6 * DM) + it * 32 + n, s + b_ada[it * 32 + n], __ATOMIC_RELAXED, __HIP_MEMORY_SCOPE_AGENT); }
        asm volatile("s_waitcnt vmcnt(0)" ::: "memory");
        __syncthreads();
        if (it == (int)blockIdx.x && F.tid == 0) __hip_atomic_fetch_add((unsigned*)(F.ctl + CW_ADA), 1u, __ATOMIC_RELAXED, __HIP_MEMORY_SCOPE_AGENT);
    }
}

__device__ __forceinline__ void p0_phase(Frame& F, const Args& a) {
    OPAQUE_FRAME(F);
    unsigned char* ws = F.ws;
    adaln_phase(F, a.in[1], a.in[3], a.in[4], (float*)(ws + WS_MOD));
    __syncthreads();
    LAS unsigned char* Tl = F.lds + F.wave * 8192;
    const int gw = F.vcu * NWAVES + F.wave, NGW = F.G * NWAVES;
    constexpr int I_IN = (DM / 64) * (INC / 64), I_QUP = (QLORA / 64) * (MH * MQK / 64), I_KVUP = (KVLORA / 64) * (MH * 256 / 64), I_OUT = (DM / 64) * (DM / 64);
    constexpr int NITEMS = I_IN + I_QUP + I_KVUP + I_OUT;
    static_assert(INC % 64 == 0, "64-column transpose items");
    { const float* w_in = a.in[6]; const float* w_qup = a.in[10]; const float* w_kvup = a.in[12]; const float* w_out = a.in[16]; const float* gq = a.in[9]; const float* gkv = a.in[11];
      auto mk = [=](int r) -> TrItem { TrItem t;
          if (r < I_IN) { const int nblk = INC / 64, kb = r / nblk, nb = r % nblk; t.src = w_in + (size_t)(64 * kb) * INC + 64 * nb; t.dst = (bf16_t*)(ws + WS_WIN) + (size_t)(64 * nb) * DM + 64 * kb; t.dst2 = t.dst + (size_t)32 * DM; t.gk = nullptr; t.N = INC; t.ldt = DM; return t; } r -= I_IN;
          if (r < I_QUP) { const int nblk = MH * MQK / 64, kb = r / nblk, nb = r % nblk; t.src = w_qup + (size_t)(64 * kb) * (MH * MQK) + 64 * nb; t.dst = (bf16_t*)(ws + WS_WQUP) + (size_t)(64 * nb) * QLORA + 64 * kb; t.dst2 = t.dst + (size_t)32 * QLORA; t.gk = gq + 64 * kb; t.N = MH * MQK; t.ldt = QLORA; return t; } r -= I_QUP;
          if (r < I_KVUP) { const int nblk = MH * 256 / 64, kb = r / nblk, nb = r % nblk; t.src = w_kvup + (size_t)(64 * kb) * (MH * 256) + 64 * nb; t.dst = (bf16_t*)(ws + WS_WKVUP) + (size_t)(64 * nb) * KVLORA + 64 * kb; t.dst2 = t.dst + (size_t)32 * KVLORA; t.gk = gkv + 64 * kb; t.N = MH * 256; t.ldt = KVLORA; return t; } r -= I_KVUP;
          { const int nblk = DM / 64, kb = r / nblk, nb = r % nblk; t.src = w_out + (size_t)(64 * kb) * DM + 64 * nb; t.dst = (bf16_t*)(ws + WS_WOUT) + (size_t)(64 * nb) * DM + 64 * kb; t.dst2 = t.dst + (size_t)32 * DM; t.gk = nullptr; t.N = DM; t.ldt = DM; return t; } };
      const int nheavy = (6 * DM / 32) - F.G, nlw = (F.G - nheavy) * NWAVES;
      int pre = 0;
      if (nheavy > 0 && nheavy < F.G) { pre = 2 * nlw < NITEMS ? 2 * nlw : NITEMS;
          if ((int)blockIdx.x >= nheavy) tr_run(((int)blockIdx.x - nheavy) * NWAVES + F.wave, nlw, pre, mk, Tl, F.lane); }
      tr_run(pre + gw, NGW, NITEMS, mk, Tl, F.lane); }
    { const int* pos = (const int*)a.in[2]; float* rc = (float*)(ws + WS_ROPEC); float* rsn = (float*)(ws + WS_ROPES);
      const int gt = F.vcu * NTHR + F.tid, NGT = F.G * NTHR;
      const float invf = (float)exp2(-(double)(gt & 31) * (13.287712379549449 / 32.0));
      for (int e = gt; e < T * 32; e += NGT) { const int tk = e >> 5;
          const float ang = (float)pos[tk] * invf; float sv, cv; sincosf(ang, &sv, &cv);
          rc[e] = cv; rsn[e] = sv; }
      { float* ssq = (float*)(ws + WS_RSTDQ); for (int e = gt; e < 2 * T; e += NGT) ssq[e] = 0.f; }
      float* wct = (float*)(ws + WS_WCT);
      for (int e = gt; e < 48 * DM; e += NGT) { const int n = e / DM, k = e % DM;
          wct[e] = n < 4 ? a.in[18][k * NG + n] : (n < 36 ? a.in[20][k * NE + (n - 4)] : 0.f); } }
}

__device__ __forceinline__ void p1_phase(Frame& F, const Args& a) {
    OPAQUE_FRAME(F);
    const int gw = F.vcu * NWAVES + F.wave, NGW = F.G * NWAVES;
    const float* mod = (const float*)(F.ws + WS_MOD); const float* g = a.in[5]; const float* x = a.in[0];
    bf16_t* H = (bf16_t*)(F.ws + WS_B);
    if (F.tid == 0) { unsigned polls = 0;
        while (__hip_atomic_load((unsigned*)(F.ctl + CW_ADA), __ATOMIC_RELAXED, __HIP_MEMORY_SCOPE_AGENT) < (unsigned)F.G) { if (++polls > (1u << 16)) { __hip_atomic_store((unsigned*)(F.ctl + CW_TMO), 0xADA00000u, __ATOMIC_RELAXED, __HIP_MEMORY_SCOPE_AGENT); break; } __builtin_amdgcn_s_sleep(2); }
        __builtin_amdgcn_fence(__ATOMIC_ACQUIRE, "agent"); asm volatile("s_waitcnt vmcnt(0)" ::: "memory"); }
    __syncthreads();
    for (int blk = gw; blk < T / 8; blk += NGW) { const int m0 = blk * 8, b = m0 / SEQ;
        const float* shift = mod + b * (6 * DM); const float* scale = shift + DM;
        f32x4 gm[8], sh[8];
#pragma unroll
        for (int j = 0; j < 8; ++j) { gm[j] = ((const f32x4*)g)[64 * j + F.lane] * (((const f32x4*)scale)[64 * j + F.lane] + 1.f); sh[j] = ((const f32x4*)shift)[64 * j + F.lane]; }
        f32x4 va[8], vb[8];
#define P1_LD(r, V) do { const f32x4* xr_ = (const f32x4*)(x + (size_t)(m0 + (r)) * DM) + F.lane; _Pragma("unroll") for (int j = 0; j < 8; ++j) V[j] = __builtin_nontemporal_load(xr_ + 64 * j); } while (0)
#define P1_ST(r, V) do { float s_ = 0.f; _Pragma("unroll") for (int j = 0; j < 8; ++j) s_ += (V[j].x * V[j].x + V[j].y * V[j].y) + (V[j].z * V[j].z + V[j].w * V[j].w); \
            const float rstd_ = rsqrtf(wave_sum(s_) * (1.f / DM) + EPS); u32x2* o8_ = (u32x2*)(H + (size_t)(m0 + (r)) * DM) + F.lane; \
            _Pragma("unroll") for (int j = 0; j < 8; ++j) { const f32x4 h_ = V[j] * rstd_ * gm[j] + sh[j]; u32x2 w_; w_.x = cvt_pk_bf16(h_.x, h_.y); w_.y = cvt_pk_bf16(h_.z, h_.w); o8_[64 * j] = w_; } } while (0)
        P1_LD(0, va);
#pragma unroll 1
        for (int r = 0; r < 8; r += 2) {
            P1_LD(r + 1, vb); __builtin_amdgcn_sched_barrier(0);
            P1_ST(r, va); __builtin_amdgcn_sched_barrier(0);
            if (r + 2 < 8) { P1_LD(r + 2, va); } __builtin_amdgcn_sched_barrier(0);
            P1_ST(r + 1, vb); __builtin_amdgcn_sched_barrier(0);
        }
#undef P1_LD
#undef P1_ST
    }
}

namespace hg {
constexpr int OFF_F = 0, OFF_SEG = 32768, OFF_QIN = 34816, RP = 272, OFF_KIN = OFF_QIN + 64 * RP, OFF_QB = OFF_KIN + 64 * RP, OFF_KLT = OFF_QB + 64 * RP, SP = 144,
              OFF_VT = OFF_KLT + 128 * SP  , OFF_DEC = OFF_VT + 64 * SP  , OFF_SF = OFF_DEC + 3584  , HG_LDS = OFF_SF + 16384;
static_assert(HG_LDS <= LDS_USER, "hgrn lds");
__device__ __forceinline__ int ppos(int s) { return (s & ~15) | ((s & 4) << 1) | ((s & 8) >> 1) | (s & 3); }
}
__device__ __forceinline__ void hgrn_chunked(Frame& F, const Args& a, int item) {
    using namespace hg;
    const bf16_t* PROJ = (const bf16_t*)(F.ws + WS_A);
    bf16_t* MIX = (bf16_t*)F.out;
    const float* lbl = a.in[7];
    LAS unsigned char* L = F.lds;
    LAS float* Fs = (LAS float*)(L + OFF_F); LAS float* SEGs = (LAS float*)(L + OFF_SEG); LAS float* DEC = (LAS float*)(L + OFF_DEC); LAS float* POST = DEC + 384;
    const int g = F.tid & 15, t0 = F.tid >> 4;
    const int sk = F.tid & 127, sseg = F.tid >> 7;
    const int r32 = F.lane & 31, hi = F.lane >> 5;
    {
        const int dq2 = (item >> 3) & 1, bh = (item >> 4) * 8 + (item & 7), h = bh & 7, b = bh >> 3;
        float lb[8];
#pragma unroll
        for (int j = 0; j < 8; ++j) { const int k = h * 128 + g * 8 + j; lb[j] = 1.f / (1.f + __expf(lbl[HW + k] - lbl[k])); }
        const bf16_t* base = PROJ + (size_t)(b * SEQ) * INCP + h * 128;
        f32x16 S0 = {}, S1 = {};
        u32x4 gq[2], gf[2], gv;
#define HG_LOADF(c) do { _Pragma("unroll") for (int i = 0; i < 2; ++i) gf[i] = *(const u32x4*)(base + (size_t)((c) * 64 + t0 + 32 * i) * INCP + g * 8 + HW); } while (0)
#define HG_LOADQ(c) do { _Pragma("unroll") for (int i = 0; i < 2; ++i) gq[i] = *(const u32x4*)(base + (size_t)((c) * 64 + t0 + 32 * i) * INCP + g * 8); \
            gv = *(const u32x4*)(base + (size_t)((c) * 64 + (F.tid >> 3)) * INCP + 2 * HW + dq2 * 64 + (F.tid & 7) * 8); } while (0)
        HG_LOADF(0); HG_LOADQ(0);
        for (int c = 0; c < SEQ / 64; ++c) {
            if (F.wave >= 4) { const int kb = F.wave - 4;
#pragma unroll
                for (int s2 = 0; s2 < 2; ++s2) { u32x4 w0, w1;
                    w0.x = cvt_pk_bf16(S0[8 * s2], S0[8 * s2 + 1]); w0.y = cvt_pk_bf16(S0[8 * s2 + 2], S0[8 * s2 + 3]); w0.z = cvt_pk_bf16(S0[8 * s2 + 4], S0[8 * s2 + 5]); w0.w = cvt_pk_bf16(S0[8 * s2 + 6], S0[8 * s2 + 7]);
                    w1.x = cvt_pk_bf16(S1[8 * s2], S1[8 * s2 + 1]); w1.y = cvt_pk_bf16(S1[8 * s2 + 2], S1[8 * s2 + 3]); w1.z = cvt_pk_bf16(S1[8 * s2 + 4], S1[8 * s2 + 5]); w1.w = cvt_pk_bf16(S1[8 * s2 + 6], S1[8 * s2 + 7]);
                    *(LAS u32x4*)(L + OFF_SF + ((((kb * 2 + 0) * 2 + s2) * 64) + F.lane) * 16) = w0;
                    *(LAS u32x4*)(L + OFF_SF + ((((kb * 2 + 1) * 2 + s2) * 64) + F.lane) * 16) = w1; } }
            float fv[2][8];
#pragma unroll
            for (int i = 0; i < 2; ++i) { float fl[8]; unpack8(gf[i], fl);
#pragma unroll
                for (int j = 0; j < 8; ++j) { const float sg = __builtin_amdgcn_rcpf(1.f + __builtin_amdgcn_exp2f(-1.4426950408889634f * fl[j])); fv[i][j] = lb[j] + (1.f - lb[j]) * sg; }
                LAS float* fp = Fs + (t0 + 32 * i) * 128 + g * 8;
                *(LAS f32x4*)fp = (f32x4){fv[i][0], fv[i][1], fv[i][2], fv[i][3]}; *(LAS f32x4*)(fp + 4) = (f32x4){fv[i][4], fv[i][5], fv[i][6], fv[i][7]}; }
            if (c + 1 < SEQ / 64) HG_LOADF(c + 1);
            __syncthreads();
            float klp[16];
            { float fr[16];
#pragma unroll
              for (int i = 0; i < 16; ++i) fr[i] = Fs[(16 * sseg + i) * 128 + sk];
              float p = 1.f;
#pragma unroll
              for (int i = 0; i < 16; ++i) { p *= fr[i]; Fs[(16 * sseg + i) * 128 + sk] = p; }
              SEGs[sseg * 128 + sk] = p;
              float q = 1.f;
#pragma unroll
              for (int i = 15; i >= 0; --i) { klp[i] = (1.f - fr[i]) * q; q *= fr[i]; } }
            __syncthreads();
            if (F.tid < 128) { const float s0 = SEGs[F.tid], s1 = SEGs[128 + F.tid], s2 = SEGs[256 + F.tid], s3 = SEGs[384 + F.tid];
                const float pm = s0 * s1;
                SEGs[F.tid] = 1.f; SEGs[128 + F.tid] = s0; SEGs[256 + F.tid] = pm; SEGs[384 + F.tid] = pm * s2;
                POST[F.tid] = s1 * s2 * s3; POST[128 + F.tid] = s2 * s3; POST[256 + F.tid] = s3; POST[384 + F.tid] = 1.f;
                DEC[F.tid] = pm * s2 * s3; DEC[128 + F.tid] = pm; DEC[256 + F.tid] = __builtin_amdgcn_rcpf(pm); }
            __syncthreads();
            { { const float po = POST[sseg * 128 + sk];
                float o16[16];
#pragma unroll
                for (int p = 0; p < 16; ++p) o16[p] = klp[8 * ((p >> 2) & 1) + 4 * (p >> 3) + (p & 3)] * po;
                *(LAS u32x4*)(L + OFF_KLT + sk * SP + sseg * 32) = pack8f(o16); *(LAS u32x4*)(L + OFF_KLT + sk * SP + sseg * 32 + 16) = pack8f(o16 + 8); }
#pragma unroll
              for (int i = 0; i < 2; ++i) { const int t = t0 + 32 * i;
                  float qin[8], kin[8], qb[8], qv[8];
                  unpack8(gq[i], qv);
                  const LAS float* fp = Fs + t * 128 + g * 8; const LAS float* pp = SEGs + (t >> 4) * 128 + g * 8;
                  const f32x4 pa = *(const LAS f32x4*)fp, pb = *(const LAS f32x4*)(fp + 4), ea = *(const LAS f32x4*)pp, eb = *(const LAS f32x4*)(pp + 4);
                  const f32x4 ma = *(const LAS f32x4*)(DEC + 128 + g * 8), mb = *(const LAS f32x4*)(DEC + 128 + g * 8 + 4), ra = *(const LAS f32x4*)(DEC + 256 + g * 8), rb = *(const LAS f32x4*)(DEC + 256 + g * 8 + 4);
#pragma unroll
                  for (int j = 0; j < 8; ++j) { const float P = (j < 4 ? pa[j] * ea[j] : pb[j - 4] * eb[j - 4]), pm = j < 4 ? ma[j] : mb[j - 4], rpm = j < 4 ? ra[j] : rb[j - 4];
                      const float r = __builtin_amdgcn_rcpf(P), kk = 1.f - fv[i][j], qs = qv[j] * 0.08838834764831845f;
                      qb[j] = qs * P; qin[j] = qb[j] * rpm; kin[j] = kk * pm * r; }
                  *(LAS u32x4*)(L + OFF_QIN + t * RP + g * 16) = pack8f(qin);
                  *(LAS u32x4*)(L + OFF_KIN + t * RP + g * 16) = pack8f(kin);
                  { const u32x4 w = pack8f(qb);
                    *(LAS u32x2*)(L + OFF_QB + t * RP + ((g >> 1) * 16 + (g & 1) * 4) * 2) = (u32x2){w.x, w.y};
                    *(LAS u32x2*)(L + OFF_QB + t * RP + ((g >> 1) * 16 + 8 + (g & 1) * 4) * 2) = (u32x2){w.z, w.w}; } }
              { float v[8]; unpack8(gv, v); const int s = F.tid >> 3, dvg = F.tid & 7, ps = ppos(s);
#pragma unroll
                  for (int j = 0; j < 8; ++j) *(LAS bf16_t*)(L + OFF_VT + (dvg * 8 + j) * SP + ps * 2) = (bf16_t)(__builtin_bit_cast(unsigned, v[j]) >> 16); } }
            if (c + 1 < SEQ / 64) HG_LOADQ(c + 1);
            __syncthreads();
            if (F.wave < 4) { const int tb = F.wave & 1, dvb = F.wave >> 1;
                f32x16 o = {};
                for (int sb = 0; sb <= tb; ++sb) { f32x16 X = {};
#pragma unroll
                    for (int ks = 0; ks < 8; ++ks) { const bf16x8 af = *(const LAS bf16x8*)(L + OFF_KIN + (32 * sb + r32) * RP + (16 * ks + 8 * hi) * 2);
                        const bf16x8 bfr = *(const LAS bf16x8*)(L + OFF_QIN + (32 * tb + r32) * RP + (16 * ks + 8 * hi) * 2);
                        X = __builtin_amdgcn_mfma_f32_32x32x16_bf16(af, bfr, X, 0, 0, 0); }
                    if (sb == tb) {
#pragma unroll
                        for (int r = 0; r < 16; ++r) { const int srow = (r & 3) + 8 * (r >> 2) + 4 * hi; if (srow > r32) X[r] = 0.f; } }
#pragma unroll
                    for (int s2 = 0; s2 < 2; ++s2) { u32x4 w; w.x = cvt_pk_bf16(X[8 * s2], X[8 * s2 + 1]); w.y = cvt_pk_bf16(X[8 * s2 + 2], X[8 * s2 + 3]); w.z = cvt_pk_bf16(X[8 * s2 + 4], X[8 * s2 + 5]); w.w = cvt_pk_bf16(X[8 * s2 + 6], X[8 * s2 + 7]);
                        const bf16x8 vf = *(const LAS bf16x8*)(L + OFF_VT + (32 * dvb + r32) * SP + (32 * sb + 16 * s2 + 8 * hi) * 2);
                        o = __builtin_amdgcn_mfma_f32_32x32x16_bf16(__builtin_bit_cast(bf16x8, w), vf, o, 0, 0, 0); } }
#pragma unroll
                for (int kb = 0; kb < 4; ++kb)
#pragma unroll
                    for (int s2 = 0; s2 < 2; ++s2) { const bf16x8 sf = *(const LAS bf16x8*)(L + OFF_SF + ((((kb * 2 + dvb) * 2 + s2) * 64) + F.lane) * 16);
                        const bf16x8 qf = *(const LAS bf16x8*)(L + OFF_QB + (32 * tb + r32) * RP + (32 * kb + 16 * s2 + 8 * hi) * 2);
                        o = __builtin_amdgcn_mfma_f32_32x32x16_bf16(qf, sf, o, 0, 0, 0); }
                bf16_t* orow = MIX + (size_t)(b * SEQ + c * 64 + 32 * tb) * DM + h * 128 + dq2 * 64 + dvb * 32 + r32;
#pragma unroll
                for (int r = 0; r < 16; ++r) { const float v = o[r]; const float vn = __shfl_xor(v, 1);
                    if ((r32 & 1) == 0) *(unsigned*)(orow + (size_t)((r & 3) + 8 * (r >> 2) + 4 * hi) * DM) = cvt_pk_bf16(v, vn); }
            } else { const int kb = F.wave - 4;
#pragma unroll
                for (int r = 0; r < 16; ++r) { const float dcy = DEC[32 * kb + (r & 3) + 8 * (r >> 2) + 4 * hi]; S0[r] *= dcy; S1[r] *= dcy; }
#pragma unroll
                for (int ss = 0; ss < 4; ++ss) { const bf16x8 kf = *(const LAS bf16x8*)(L + OFF_KLT + (32 * kb + r32) * SP + (16 * ss + 8 * hi) * 2);
                    const bf16x8 vf0 = *(const LAS bf16x8*)(L + OFF_VT + r32 * SP + (16 * ss + 8 * hi) * 2), vf1 = *(const LAS bf16x8*)(L + OFF_VT + (32 + r32) * SP + (16 * ss + 8 * hi) * 2);
                    S0 = __builtin_amdgcn_mfma_f32_32x32x16_bf16(kf, vf0, S0, 0, 0, 0); S1 = __builtin_amdgcn_mfma_f32_32x32x16_bf16(kf, vf1, S1, 0, 0, 0); }
            }
            __syncthreads();
        }
#undef HG_LOADF
#undef HG_LOADQ
    }
}

constexpr int MOE_IG = NE * (DM / 64) * (DE / 64);
constexpr int MOE_PRE = 9216;
struct MoeItems { const float* wg; const float* wu; const float* wd; unsigned char* ws;
    __device__ TrItem operator()(int it) const { TrItem t; t.gk = nullptr;
        const int which = it / MOE_IG, r = it % MOE_IG;
        if (which < 2) { const int e = r / 256, q = r % 256, kb = q / 8, nb = q % 8, n0 = 64 * nb;
            t.src = (which ? wu : wg) + (size_t)e * DM * DE + (size_t)(64 * kb) * DE + n0;
            t.dst = (bf16_t*)(ws + WS_D) + ((size_t)e * 1024 + (n0 >> 7) * 256 + (n0 & 127) + which * 128) * DM + 64 * kb; t.dst2 = t.dst + (size_t)32 * DM; t.N = DE; t.ldt = DM; }
        else { const int e = r / 256, q = r % 256, kb = q / 32, nb = q % 32, n0 = 64 * nb;
            t.src = wd + (size_t)e * DE * DM + (size_t)(64 * kb) * DM + n0;
            t.dst = (bf16_t*)(ws + WS_E) + ((size_t)e * DM + n0) * DE + 64 * kb; t.dst2 = t.dst + (size_t)32 * DE; t.N = DM; t.ldt = DE; }
        return t; } };

__device__ __forceinline__ void p3_phase(Frame& F, const Args& a) {
    OPAQUE_FRAME(F);
    const int role = ((int)blockIdx.x >> 3) & 1, idx = ((int)blockIdx.x >> 4) * 8 + ((int)blockIdx.x & 7), half = F.G >> 1;
    unsigned char* ws = F.ws;
    if (role == 0) { for (int it = idx; it < NB * HH * 2; it += half) hgrn_chunked(F, a, it); }
    else {
        { pg8::Gemm g{(const bf16_t*)(ws + WS_A) + C_QA, (const bf16_t*)(ws + WS_WQUP), INCP, QLORA, QLORA};
          pg8::DenseOrder S; S.init(T / 256, MH * MQK / 256, half, idx);
          pg8::EpiStore E{(bf16_t*)(ws + WS_B), MH * MQK, (const float*)(ws + WS_RSTDQ), 1.f / QLORA};
          pg8::gemm_phase<pg8::EpiStore, pg8::DenseOrder>(F.lds, g, S, E); }
        { pg8::Gemm g{(const bf16_t*)(ws + WS_A) + C_KVA, (const bf16_t*)(ws + WS_WKVUP), INCP, KVLORA, KVLORA};
          pg8::DenseOrder S; S.init(T / 256, MH * 256 / 256, half, idx);
          pg8::EpiStore E{(bf16_t*)(ws + WS_C), MH * 256, (const float*)(ws + WS_RSTDKV), 1.f / KVLORA};
          pg8::gemm_phase<pg8::EpiStore, pg8::DenseOrder>(F.lds, g, S, E); }
        { const MoeItems mk{a.in[22], a.in[23], a.in[24], ws};
          tr_run(idx * NWAVES + F.wave, half * NWAVES, MOE_PRE, mk, F.lds + F.wave * 8192, F.lane); }
    }
}

__device__ __forceinline__ float sum8(float v) { v += __shfl_xor(v, 1); v += __shfl_xor(v, 2); v += __shfl_xor(v, 4); return v; }

struct P5Set { u32x4 k0, k1, kpe, m0, m1, g0, g1; f32x4 ca, cb, sa, sb; };
__device__ __forceinline__ void p5_phase(Frame& F, const Args& a) {
    OPAQUE_FRAME(F);
    const int gw = F.vcu * NWAVES + F.wave, NGW = F.G * NWAVES;
    const bf16_t* PROJ = (const bf16_t*)(F.ws + WS_A);
    const bf16_t* KV = (const bf16_t*)(F.ws + WS_C);
    bf16_t* Kn = (bf16_t*)(F.ws + WS_F);
    bf16_t* MIX = (bf16_t*)F.out;
    const float* rc = (const float*)(F.ws + WS_ROPEC); const float* rsn = (const float*)(F.ws + WS_ROPES);
    const int h = F.lane >> 3, sub = F.lane & 7;
    const float sgn = sub < 4 ? -1.f : 1.f;
    float gk[3][8], go[2][8];
#pragma unroll
    for (int i = 0; i < 3; ++i)
#pragma unroll
        for (int j = 0; j < 8; ++j) gk[i][j] = a.in[14][(sub + 8 * i) * 8 + j];
#pragma unroll
    for (int i = 0; i < 2; ++i)
#pragma unroll
        for (int j = 0; j < 8; ++j) go[i][j] = a.in[8][(sub + 8 * i) * 8 + j];
#define P5_LD(t_, S_) do { const size_t t__ = (size_t)(t_); const int ii_ = (sub & 3) * 8; \
        S_.k0 = __builtin_nontemporal_load((const u32x4*)(KV + t__ * (MH * 256) + h * 256 + sub * 8)); S_.k1 = __builtin_nontemporal_load((const u32x4*)(KV + t__ * (MH * 256) + h * 256 + (sub + 8) * 8)); \
        S_.kpe = *(const u32x4*)(PROJ + t__ * INCP + C_KPE + sub * 8); \
        S_.ca = *(const f32x4*)(rc + t__ * 32 + ii_); S_.cb = *(const f32x4*)(rc + t__ * 32 + ii_ + 4); S_.sa = *(const f32x4*)(rsn + t__ * 32 + ii_); S_.sb = *(const f32x4*)(rsn + t__ * 32 + ii_ + 4); \
        S_.m0 = *(const u32x4*)(MIX + t__ * DM + h * 128 + sub * 8); S_.m1 = *(const u32x4*)(MIX + t__ * DM + h * 128 + (sub + 8) * 8); \
        S_.g0 = __builtin_nontemporal_load((const u32x4*)(PROJ + t__ * INCP + 3 * HW + h * 128 + sub * 8)); S_.g1 = __builtin_nontemporal_load((const u32x4*)(PROJ + t__ * INCP + 3 * HW + h * 128 + (sub + 8) * 8)); } while (0)
#define P5_CP(t_, S_) do { const int t__ = (t_), b_ = t__ / SEQ, s_ = t__ % SEQ; const size_t hrow = ((size_t)(b_ * MH + h) * SEQ + s_); \
        { float k[3][8]; float ss = 0.f; unpack8(S_.k0, k[0]); unpack8(S_.k1, k[1]); unpack8(S_.kpe, k[2]); \
          _Pragma("unroll") for (int i = 0; i < 3; ++i) _Pragma("unroll") for (int j = 0; j < 8; ++j) ss += k[i][j] * k[i][j]; \
          const float rs = rsqrtf(sum8(ss) * (1.f / MQK) + EPS); \
          _Pragma("unroll") for (int i = 0; i < 3; ++i) _Pragma("unroll") for (int j = 0; j < 8; ++j) k[i][j] *= rs * gk[i][j]; \
          _Pragma("unroll") for (int j = 0; j < 8; ++j) { const float pv = __shfl_xor(k[2][j], 4); const float cs_ = j < 4 ? S_.ca[j & 3] : S_.cb[j & 3], sn_ = j < 4 ? S_.sa[j & 3] : S_.sb[j & 3]; k[2][j] = k[2][j] * cs_ + sgn * pv * sn_; } \
          _Pragma("unroll") for (int i = 0; i < 3; ++i) *(u32x4*)(Kn + hrow * MQK + (sub + 8 * i) * 8) = pack8f(k[i]); } \
        { float o[2][8], gt[2][8]; float ss = 0.f; unpack8(S_.m0, o[0]); unpack8(S_.m1, o[1]); unpack8(S_.g0, gt[0]); unpack8(S_.g1, gt[1]); \
          _Pragma("unroll") for (int i = 0; i < 2; ++i) _Pragma("unroll") for (int j = 0; j < 8; ++j) ss += o[i][j] * o[i][j]; \
          const float rs = rsqrtf(sum8(ss) * (1.f / HDV) + EPS); \
          _Pragma("unroll") for (int i = 0; i < 2; ++i) { _Pragma("unroll") for (int j = 0; j < 8; ++j) o[i][j] = o[i][j] * rs * go[i][j] * siluf(gt[i][j]); \
              *(u32x4*)(MIX + (size_t)t__ * DM + h * 128 + (sub + 8 * i) * 8) = pack8f(o[i]); } } } while (0)
    for (int blk = gw; blk < T / 8; blk += NGW) { const int t0 = blk * 8;
        P5Set A, B;
        P5_LD(t0, A);
#pragma unroll 1
        for (int r = 0; r < 8; r += 2) {
            P5_LD(t0 + r + 1, B); __builtin_amdgcn_sched_barrier(0);
            P5_CP(t0 + r, A); __builtin_amdgcn_sched_barrier(0);
            if (r + 2 < 8) { P5_LD(t0 + r + 2, A); } __builtin_amdgcn_sched_barrier(0);
            P5_CP(t0 + r + 1, B); __builtin_amdgcn_sched_barrier(0);
        }
    }
#undef P5_LD
#undef P5_CP
}
namespace att {
constexpr int QBLK = 32, KVBLK = 64, QB = 256;
constexpr int KROW = 512, SHM_K = KVBLK * KROW, SHM_V = KVBLK * MV * 2;
constexpr int OFF_V = 0, OFF_K = 2 * SHM_V, OFF_WS = OFF_K + 2 * SHM_K;
constexpr float SCALE = 0.07216878364870322f;
constexpr float THR = 8.f;
#define SBAR() __builtin_amdgcn_sched_barrier(0)
__device__ __forceinline__ int v_st(int k, int c) { const int kk = (k & ~0xC) | ((k & 4) << 1) | ((k & 8) >> 1); return ((kk >> 3) * 4 + (c >> 5)) * 512 + ((kk & 7) * 32 + (c & 31)) * 2; }
__device__ __forceinline__ int v_rd_base(int lane) { return ((lane & 3) << 3) | (((lane >> 2) & 3) << 6) | (((lane >> 4) & 1) << 5) | (((lane >> 5) & 1) << 8); }
constexpr int v_rd_off(int d0, int ks, int half) { return d0 * 512 + ks * 4096 + half * 2048; }
__device__ __forceinline__ int crow(int r, int hi) { return (r & 3) + 8 * (r >> 2) + 4 * hi; }
template <int M> __device__ __forceinline__ float swz_xor(float v) { return __builtin_bit_cast(float, __builtin_amdgcn_ds_swizzle(__builtin_bit_cast(int, v), (M << 10) | 0x1F)); }
__device__ __forceinline__ unsigned cvtpk(float lo, float hi) { unsigned r; asm volatile("v_cvt_pk_bf16_f32 %0, %1, %2" : "=v"(r) : "v"(lo), "v"(hi)); return r; }

__device__ __forceinline__ void mask_tile(f32x16& p0, f32x16& p1, int dq) {
    const float NEG = -__builtin_inff();
#pragma unroll
    for (int r = 0; r < 16; ++r) {
        const int c = (r & 3) + 8 * (r >> 2);
        if (dq - c < 0) p0[r] = NEG;
        if (dq - c - 32 < 0) p1[r] = NEG;
    }
}
__device__ __forceinline__ void partialSM(f32x16& p0, f32x16& p1, float& m_reg, float& mn, float& alpha) {
    float pmax = p0[0];
#pragma unroll
    for (int r = 1; r < 16; ++r) pmax = fmaxf(pmax, p0[r]);
#pragma unroll
    for (int r = 0; r < 16; ++r) pmax = fmaxf(pmax, p1[r]);
    { auto rr = __builtin_amdgcn_permlane32_swap(__float_as_uint(pmax), __float_as_uint(pmax), false, false);
      pmax = fmaxf(__uint_as_float(rr[0]), __uint_as_float(rr[1])); }
    constexpr float C2 = 1.4426950408889634f * SCALE;
    if (__builtin_expect(__all((pmax - m_reg) * SCALE <= THR), 1)) { mn = m_reg; alpha = 1.f; }
    else { mn = fmaxf(m_reg, pmax); alpha = __builtin_amdgcn_exp2f((m_reg - mn) * C2); m_reg = mn; }
    const float mnL = -mn * C2;
#pragma unroll
    for (int r = 0; r < 16; ++r) p0[r] = fmaf(p0[r], C2, mnL);
#pragma unroll
    for (int r = 0; r < 16; ++r) p1[r] = fmaf(p1[r], C2, mnL);
#pragma unroll
    for (int r = 0; r < 16; ++r) p0[r] = __builtin_amdgcn_exp2f(p0[r]);
}
__device__ __forceinline__ void finishSM(f32x16& p0, f32x16& p1, float alpha, float& l_reg, bf16x8& pa0, bf16x8& pa1, bf16x8& pa2, bf16x8& pa3) {
#pragma unroll
    for (int r = 0; r < 16; ++r) p1[r] = __builtin_amdgcn_exp2f(p1[r]);
    float ps = 0;
#pragma unroll
    for (int r = 0; r < 16; ++r) ps += p0[r];
#pragma unroll
    for (int r = 0; r < 16; ++r) ps += p1[r];
    { auto rr = __builtin_amdgcn_permlane32_swap(__float_as_uint(ps), __float_as_uint(ps), false, false);
      ps = __uint_as_float(rr[0]) + __uint_as_float(rr[1]); }
    l_reg = l_reg * alpha + ps;
#define PK4(P, B_, OUT) do { unsigned a0 = cvtpk(P[B_+0], P[B_+1]), a1 = cvtpk(P[B_+2], P[B_+3]);                          \
        unsigned b0 = cvtpk(P[B_+4], P[B_+5]), b1 = cvtpk(P[B_+6], P[B_+7]);                                             \
        auto r0 = __builtin_amdgcn_permlane32_swap(a0, b0, false, false); auto r1 = __builtin_amdgcn_permlane32_swap(a1, b1, false, false); \
        u32x4 w = {r0[0], r1[0], r0[1], r1[1]}; OUT = __builtin_bit_cast(bf16x8, w); } while (0)
    PK4(p0, 0, pa0); PK4(p0, 8, pa1); PK4(p1, 0, pa2); PK4(p1, 8, pa3);
#undef PK4
}
template <int KB>
__device__ __forceinline__ void qkt(f32x16& p0, f32x16& p1, LAS unsigned char* lds, int r32, int hi, const bf16x8* qr) {
    p0 = f32x16{}; p1 = f32x16{};
    int sw = r32 & 15; asm volatile("" : "+v"(sw));
    const int rb = OFF_K + KB * SHM_K + r32 * KROW;
    int ab[8];
#pragma unroll
    for (int d = 0; d < 8; ++d) ab[d] = rb + (((2 * d + hi) ^ sw) << 4);
#pragma unroll
    for (int d0 = 0; d0 < 12; ++d0) { const int a = ab[d0 & 7] + (d0 >> 3) * 256;
        const bf16x8 b0 = *(const LAS bf16x8*)(lds + a);
        const bf16x8 b1 = *(const LAS bf16x8*)(lds + a + 32 * KROW);
        p0 = __builtin_amdgcn_mfma_f32_32x32x16_bf16(b0, qr[d0], p0, 0, 0, 0);
        p1 = __builtin_amdgcn_mfma_f32_32x32x16_bf16(b1, qr[d0], p1, 0, 0, 0); }
}
template <int VB>
__device__ __forceinline__ void pv_tile(f32x16* o, int vb0, bf16x8 pa0, bf16x8 pa1, bf16x8 pa2, bf16x8 pa3) {
#define TRRD(dst, off) asm volatile("ds_read_b64_tr_b16 %0, %1 offset:%2" : "=&v"(dst) : "v"(vb0), "i"(off) : "memory")
#define PV_D0(d0) do { s16x4 l0, l1, l2, l3, h0, h1, h2, h3; constexpr int b_ = OFF_V + VB * SHM_V + v_rd_off(d0, 0, 0); \
        TRRD(l0, b_); TRRD(h0, b_ + 2048); TRRD(l1, b_ + 4096); TRRD(h1, b_ + 6144); TRRD(l2, b_ + 8192); TRRD(h2, b_ + 10240); TRRD(l3, b_ + 12288); TRRD(h3, b_ + 14336); \
        asm volatile("s_waitcnt lgkmcnt(0)" ::: "memory"); SBAR();   \
        o[d0] = __builtin_amdgcn_mfma_f32_32x32x16_bf16(pa0, (bf16x8){l0[0], l0[1], l0[2], l0[3], h0[0], h0[1], h0[2], h0[3]}, o[d0], 0, 0, 0);   \
        o[d0] = __builtin_amdgcn_mfma_f32_32x32x16_bf16(pa1, (bf16x8){l1[0], l1[1], l1[2], l1[3], h1[0], h1[1], h1[2], h1[3]}, o[d0], 0, 0, 0);   \
        o[d0] = __builtin_amdgcn_mfma_f32_32x32x16_bf16(pa2, (bf16x8){l2[0], l2[1], l2[2], l2[3], h2[0], h2[1], h2[2], h2[3]}, o[d0], 0, 0, 0);   \
        o[d0] = __builtin_amdgcn_mfma_f32_32x32x16_bf16(pa3, (bf16x8){l3[0], l3[1], l3[2], l3[3], h3[0], h3[1], h3[2], h3[3]}, o[d0], 0, 0, 0); } while (0)
    PV_D0(0); PV_D0(1); PV_D0(2); PV_D0(3);
#undef PV_D0
#undef TRRD
}

constexpr int QP = MH * MQK, VP = MH * 256;
__device__ __forceinline__ void attn_block(const bf16_t* Q, const bf16_t* K, const bf16_t* V, bf16_t* O, int P0, const float* gon, const float* gqn, const float* rc, const float* rsn, LAS unsigned char* lds) {
    int tid = threadIdx.x; asm volatile("" : "+v"(tid));
    const int wid = __builtin_amdgcn_readfirstlane(tid >> 6), lane = tid & 63, r32 = lane & 31, hi = lane >> 5;
    const int NT = P0 / KVBLK + 4;
    const int qlo = P0 + wid * QBLK, qm = qlo + r32 - 4 * hi;
    LAS float* wsf = (LAS float*)(lds + OFF_WS) + wid * 64; LAS float* li_l = wsf; LAS float* al_l = wsf + 32;
    float m_reg = -1e30f, l_reg = 0.f; f32x16 o[4] = {};
    bf16x8 qr[12];
#pragma unroll
    for (int d0 = 0; d0 < 12; ++d0) qr[d0] = *(const bf16x8*)(Q + (size_t)(qlo + r32) * QP + d0 * 16 + hi * 8);
    {
        float ss = 0.f;
#pragma unroll
        for (int d0 = 0; d0 < 12; ++d0) { float f[8]; unpack8(__builtin_bit_cast(u32x4, qr[d0]), f);
#pragma unroll
            for (int j = 0; j < 8; ++j) ss += f[j] * f[j]; }
        { auto rr = __builtin_amdgcn_permlane32_swap(__float_as_uint(ss), __float_as_uint(ss), false, false); ss = __uint_as_float(rr[0]) + __uint_as_float(rr[1]); }
        const float rs = rsqrtf(ss * (1.f / MQK) + EPS);
#pragma unroll
        for (int d0 = 0; d0 < 8; ++d0) { float f[8]; unpack8(__builtin_bit_cast(u32x4, qr[d0]), f); const float* gp = gqn + d0 * 16 + hi * 8;
#pragma unroll
            for (int j = 0; j < 8; ++j) f[j] *= rs * gp[j];
            qr[d0] = __builtin_bit_cast(bf16x8, pack8f(f)); }
#pragma unroll
        for (int dd = 0; dd < 2; ++dd) { float x1[8], x2[8]; unpack8(__builtin_bit_cast(u32x4, qr[8 + dd]), x1); unpack8(__builtin_bit_cast(u32x4, qr[10 + dd]), x2);
            const float* g1p = gqn + 128 + dd * 16 + hi * 8; const float* g2p = g1p + 32; const float* cp = rc + (size_t)(qlo + r32) * 32 + dd * 16 + hi * 8; const float* sp = rsn + (size_t)(qlo + r32) * 32 + dd * 16 + hi * 8;
#pragma unroll
            for (int j = 0; j < 8; ++j) { const float a = x1[j] * rs * g1p[j], bq = x2[j] * rs * g2p[j], c = cp[j], sn = sp[j]; x1[j] = a * c - bq * sn; x2[j] = bq * c + a * sn; }
            qr[8 + dd] = __builtin_bit_cast(bf16x8, pack8f(x1)); qr[10 + dd] = __builtin_bit_cast(bf16x8, pack8f(x2)); }
    }
    int ksrc[4], vsrc[2];
#pragma unroll
    for (int i = 0; i < 4; ++i) { const int row = 2 * (wid * 4 + i) + (lane >> 5), c = (lane & 31) ^ (row & 15); ksrc[i] = row * MQK + (c < 24 ? c : 0) * 8; }
#pragma unroll
    for (int i = 0; i < 2; ++i) { const int id = (wid * 2 + i) * 2 + (lane >> 5), kk = ((id >> 2) << 3) | ((lane & 31) >> 2), k = (kk & ~0xC) | ((kk & 4) << 1) | ((kk & 8) >> 1);
        vsrc[i] = k * VP + (id & 3) * 32 + (lane & 3) * 8; }
    const int vb0 = (int)(unsigned)(uintptr_t)lds + v_rd_base(lane);
#define ALOAD(t, bf) do { const bf16_t* kp = K + (size_t)(t) * KVBLK * MQK; const bf16_t* vp = V + (size_t)(t) * KVBLK * VP; \
        _Pragma("unroll") for (int i = 0; i < 4; ++i) __builtin_amdgcn_global_load_lds((const unsigned*)(kp + ksrc[i]), (LAS unsigned*)(lds + OFF_K + (bf) * SHM_K + (wid * 4 + i) * 1024), 16, 0, 0); \
        _Pragma("unroll") for (int i = 0; i < 2; ++i) __builtin_amdgcn_global_load_lds((const unsigned*)(vp + vsrc[i]), (LAS unsigned*)(lds + OFF_V + (bf) * SHM_V + (wid * 2 + i) * 1024), 16, 0, 0); } while (0)
#define RESC(a) do { if (__any((a) < 1.f)) { if (hi == 0) al_l[r32] = (a); asm volatile("s_waitcnt lgkmcnt(0)" ::: "memory"); \
        _Pragma("unroll") for (int d_ = 0; d_ < 4; ++d_) _Pragma("unroll") for (int r = 0; r < 16; ++r) o[d_][r] *= al_l[crow(r, hi)]; } } while (0)
#define STEP(t, BF) do { f32x16 p0, p1; float mn, al; bf16x8 pa0, pa1, pa2, pa3; \
        if ((t) + 1 < NT) ALOAD((t) + 1, 1 - (BF)); \
        SBAR(); qkt<BF>(p0, p1, lds, r32, hi, qr); \
        { const int kb_ = (t) * KVBLK; if (kb_ + KVBLK - 1 > qlo) mask_tile(p0, p1, qm - kb_); } \
        partialSM(p0, p1, m_reg, mn, al); RESC(al); finishSM(p0, p1, al, l_reg, pa0, pa1, pa2, pa3); SBAR(); \
        pv_tile<BF>(o, vb0, pa0, pa1, pa2, pa3); SBAR(); \
        asm volatile("s_waitcnt vmcnt(0)" ::: "memory"); __syncthreads(); } while (0)
    ALOAD(0, 0); asm volatile("s_waitcnt vmcnt(0)" ::: "memory"); __syncthreads();
    for (int t = 0; t < NT; t += 2) { STEP(t, 0); STEP(t + 1, 1); }
#undef STEP
#undef RESC
#undef ALOAD
    if (hi == 0) li_l[r32] = l_reg;
    asm volatile("s_waitcnt lgkmcnt(0)" ::: "memory");
    float gv[4];
#pragma unroll
    for (int d0 = 0; d0 < 4; ++d0) gv[d0] = gon[d0 * 32 + r32];
#pragma unroll
    for (int r = 0; r < 16; ++r) { const float rl = 1.f / li_l[crow(r, hi)];
        float ss = 0.f;
#pragma unroll
        for (int d0 = 0; d0 < 4; ++d0) { o[d0][r] *= rl; ss += o[d0][r] * o[d0][r]; }
        ss += swz_xor<1>(ss); ss += swz_xor<2>(ss); ss += swz_xor<4>(ss); ss += swz_xor<8>(ss); ss += swz_xor<16>(ss);
        const float rs = rsqrtf(ss * (1.f / MV) + EPS);
        bf16_t* orow = O + (size_t)(qlo + crow(r, hi)) * DM;
#pragma unroll
        for (int d0 = 0; d0 < 4; ++d0) { const float v = o[d0][r] * rs * gv[d0]; const float vn = swz_xor<1>(v);
            if ((r32 & 1) == 0) *(unsigned*)(orow + d0 * 32 + r32) = cvtpk(v, vn); } }
    __syncthreads();
}
#undef SBAR
}

__device__ __forceinline__ void p6_phase(Frame& F, const Args& a) {
    const bf16_t* QH = (const bf16_t*)(F.ws + WS_B); const bf16_t* Kn = (const bf16_t*)(F.ws + WS_F); const bf16_t* KV = (const bf16_t*)(F.ws + WS_C);
    bf16_t* MIX = (bf16_t*)F.out;
    const float* rc = (const float*)(F.ws + WS_ROPEC); const float* rsn = (const float*)(F.ws + WS_ROPES);
    for (int it = F.vcu; it < NB * MH * 4; it += F.G) {
        const int bh = it >> 2, j = it & 3, b = bh >> 3, h = bh & 7;
        const bf16_t* Q = QH + (size_t)(b * SEQ) * att::QP + h * MQK; const bf16_t* K = Kn + (size_t)bh * SEQ * MQK; const bf16_t* V = KV + (size_t)(b * SEQ) * att::VP + h * 256 + 128;
        bf16_t* O = MIX + (size_t)(b * SEQ) * DM + HW + h * MV;
        att::attn_block(Q, K, V, O, (7 - j) * att::QB, a.in[15], a.in[13], rc + (size_t)(b * SEQ) * 32, rsn + (size_t)(b * SEQ) * 32, F.lds);
        att::attn_block(Q, K, V, O, j * att::QB, a.in[15], a.in[13], rc + (size_t)(b * SEQ) * 32, rsn + (size_t)(b * SEQ) * 32, F.lds);
    }
}
__device__ __forceinline__ void p8_phase(Frame& F, const Args& a) {
    OPAQUE_FRAME(F);
    unsigned char* ws = F.ws;
    const float* xin = a.in[0]; const bf16_t* mixo = (const bf16_t*)(ws + WS_F); const float* mod = (const float*)(ws + WS_MOD); const float* g2n = a.in[17];
    const float* wct = (const float*)(ws + WS_WCT);
    bf16_t* H2 = (bf16_t*)(ws + WS_B);
    int* tok_e = (int*)(ws + WS_TOKE); float* tok_w = (float*)(ws + WS_TOKW); int* tok_s = (int*)(ws + WS_TOKS);
    LAS float* red = (LAS float*)F.lds;
    LAS float* ssw = (LAS float*)(F.lds + 98304);
    LAS float* shw = (LAS float*)(F.lds + 100352);
    LAS float* lg = (LAS float*)(F.lds + 101888);
    LAS float* rsl = (LAS float*)(F.lds + 111104);
    const int mr = F.lane & 15, mg = F.lane >> 4;
    const bool conv_first = (F.vcu & 1) != 0;
#pragma unroll 1
    for (int part = 0; part < 2; ++part) {
    if ((part == 0) != conv_first) {
    for (int tile = F.vcu; tile < T / 64; tile += F.G) {
        const int m0 = tile * 64, b = m0 / SEQ;
        const float* modb = mod + b * (6 * DM);
        f32x4 acc[4][3]; float ssp[4] = {0.f, 0.f, 0.f, 0.f}, shacc[3] = {0.f, 0.f, 0.f};
#pragma unroll
        for (int rb = 0; rb < 4; ++rb)
#pragma unroll
            for (int n = 0; n < 3; ++n) acc[rb][n] = (f32x4){0.f, 0.f, 0.f, 0.f};
        const unsigned xo = (unsigned)((m0 + mr) * DM + F.wave * 256 + 4 * mg);
        LAS float* vec = (LAS float*)(F.lds + 112640) + F.wave * 768;
        { const int k4 = F.lane * 4; const unsigned ko_ = (unsigned)(F.wave * 256 + k4) * 4u;
          const f32x4 t0 = *(const f32x4*)((const char*)(modb + 2 * DM) + ko_), t1 = *(const f32x4*)((const char*)(modb + 3 * DM) + ko_), t2 = *(const f32x4*)((const char*)g2n + ko_), t3 = *(const f32x4*)((const char*)(modb + 4 * DM) + ko_);
          *(LAS f32x4*)(vec + k4) = t0; *(LAS f32x4*)(vec + 256 + k4) = t1; *(LAS f32x4*)(vec + 512 + k4) = t2 * (t3 + 1.f); LDS_WAIT(); asm volatile("" ::: "memory"); }
        f32x4 xa[4], xb[4], wa[3], wb[3]; u32x2 ma_[4], mb_[4];
#define P8_LDX(s_, X, M, W) do { const unsigned ko_ = (unsigned)(F.wave * 256 + 16 * (s_) + 4 * mg) * 4u; \
            _Pragma("unroll") for (int n = 0; n < 3; ++n) W[n] = *(const f32x4*)((const char*)wct + (ko_ + (unsigned)((n * 16 + mr) * DM * 4))); \
            _Pragma("unroll") for (int rb = 0; rb < 4; ++rb) { const unsigned eo_ = xo + (unsigned)(rb * 16 * DM + 16 * (s_)); X[rb] = *(const f32x4*)((const char*)xin + eo_ * 4u); M[rb] = *(const u32x2*)((const char*)mixo + eo_ * 2u); } } while (0)
#define P8_CP(s_, X, M, W) do { const int kl_ = 16 * (s_) + 4 * mg; const f32x4 g1v = *(const LAS f32x4*)(vec + kl_), shv = *(const LAS f32x4*)(vec + 256 + kl_), gmv = *(const LAS f32x4*)(vec + 512 + kl_); \
            _Pragma("unroll") for (int n = 0; n < 3; ++n) shacc[n] += (shv.x * W[n].x + shv.y * W[n].y) + (shv.z * W[n].z + shv.w * W[n].w); \
            _Pragma("unroll") for (int rb = 0; rb < 4; ++rb) { const f32x4 v = X[rb] + g1v * (f32x4){bf_lo(M[rb].x), bf_hi(M[rb].x), bf_lo(M[rb].y), bf_hi(M[rb].y)}; \
                ssp[rb] += (v.x * v.x + v.y * v.y) + (v.z * v.z + v.w * v.w); const f32x4 av = v * gmv; \
                _Pragma("unroll") for (int i = 0; i < 4; ++i) _Pragma("unroll") for (int n = 0; n < 3; ++n) acc[rb][n] = __builtin_amdgcn_mfma_f32_16x16x4f32(av[i], W[n][i], acc[rb][n], 0, 0, 0); } } while (0)
        P8_LDX(0, xa, ma_, wa);
#pragma unroll 1
        for (int s = 0; s < 16; s += 2) {
            P8_LDX(s + 1, xb, mb_, wb); __builtin_amdgcn_sched_barrier(0);
            P8_CP(s, xa, ma_, wa); __builtin_amdgcn_sched_barrier(0);
            if (s + 2 < 16) { P8_LDX(s + 2, xa, ma_, wa); } __builtin_amdgcn_sched_barrier(0);
            P8_CP(s + 1, xb, mb_, wb); __builtin_amdgcn_sched_barrier(0);
        }
#undef P8_LDX
#undef P8_CP
#pragma unroll
        for (int rb = 0; rb < 4; ++rb) {
#pragma unroll
            for (int n = 0; n < 3; ++n)
#pragma unroll
                for (int r = 0; r < 4; ++r) red[(F.wave * 64 + rb * 16 + mg * 4 + r) * 48 + n * 16 + mr] = acc[rb][n][r];
            float sp = ssp[rb]; sp += __shfl_xor(sp, 16); sp += __shfl_xor(sp, 32);
            if (mg == 0) ssw[F.wave * 64 + rb * 16 + mr] = sp; }
#pragma unroll
        for (int n = 0; n < 3; ++n) { float sa = shacc[n]; sa += __shfl_xor(sa, 16); sa += __shfl_xor(sa, 32); if (mg == 0) shw[F.wave * 48 + n * 16 + mr] = sa; }
        __syncthreads();
        if (F.tid < 64) { float sv = 0.f;
#pragma unroll
            for (int w = 0; w < 8; ++w) sv += ssw[w * 64 + F.tid];
            rsl[F.tid] = rsqrtf(sv * (1.f / DM) + EPS); }
        __syncthreads();
        for (int idx = F.tid; idx < 64 * 36; idx += NTHR) { const int row = idx / 36, n = idx % 36; float L = 0.f, sw = 0.f;
#pragma unroll
            for (int w = 0; w < 8; ++w) { L += red[(w * 64 + row) * 48 + n]; sw += shw[w * 48 + n]; }
            lg[row * 36 + n] = rsl[row] * L + sw + (n < 4 ? a.in[19][n] : a.in[21][n - 4]); }
        __syncthreads();
        if (F.tid < 64) { const LAS float* l = lg + F.tid * 36; const int t = m0 + F.tid;
            int g = 0; float gm = l[0];
#pragma unroll
            for (int j = 1; j < 4; ++j) if (l[j] > gm) { gm = l[j]; g = j; }
            float den = 0.f;
#pragma unroll
            for (int j = 0; j < 4; ++j) den += __expf(l[j] - gm);
            const float pg = 1.f / den;
            const LAS float* e = l + 4 + g * 8;
            int i1 = 0; float v1 = e[0];
#pragma unroll
            for (int j = 1; j < 8; ++j) if (e[j] > v1) { v1 = e[j]; i1 = j; }
            int i2 = -1; float v2 = -__builtin_inff();
#pragma unroll
            for (int j = 0; j < 8; ++j) if (j != i1 && e[j] > v2) { v2 = e[j]; i2 = j; }
            const float w1 = 1.f / (1.f + __expf(v2 - v1)), w2 = 1.f - w1;
            const int e1 = g * 8 + i1, e2 = g * 8 + i2;
            const int s1 = (int)atomicAdd((unsigned*)(F.ctl + CW_CNT + 64 * e1), 1u), s2 = (int)atomicAdd((unsigned*)(F.ctl + CW_CNT + 64 * e2), 1u);
            tok_e[2 * t] = e1; tok_e[2 * t + 1] = e2; tok_w[2 * t] = pg * w1; tok_w[2 * t + 1] = pg * w2; tok_s[2 * t] = s1; tok_s[2 * t + 1] = s2;
            int* list = (int*)(ws + WS_LIST); list[e1 * T + s1] = t; list[e2 * T + s2] = t; }
        { const int c8 = (F.tid & 255) * 8, rg = F.tid >> 8;
          f32x4 g1a = *(const f32x4*)(modb + 2 * DM + c8), g1b = *(const f32x4*)(modb + 2 * DM + c8 + 4), sha = *(const f32x4*)(modb + 3 * DM + c8), shb = *(const f32x4*)(modb + 3 * DM + c8 + 4);
          const f32x4 gma = *(const f32x4*)(g2n + c8) * (*(const f32x4*)(modb + 4 * DM + c8) + 1.f), gmb = *(const f32x4*)(g2n + c8 + 4) * (*(const f32x4*)(modb + 4 * DM + c8 + 4) + 1.f);
#pragma unroll 1
          for (int j0 = 0; j0 < 32; j0 += 4) {
              f32x4 qa[4], qb[4]; u32x4 qm[4];
#pragma unroll
              for (int u = 0; u < 4; ++u) { const size_t eo = (size_t)(m0 + rg + 2 * (j0 + u)) * DM + c8;
                  qa[u] = __builtin_nontemporal_load((const f32x4*)(xin + eo)); qb[u] = __builtin_nontemporal_load((const f32x4*)(xin + eo + 4)); qm[u] = __builtin_nontemporal_load((const u32x4*)(mixo + eo)); }
              __builtin_amdgcn_sched_barrier(0);
#pragma unroll
              for (int u = 0; u < 4; ++u) { const int row = rg + 2 * (j0 + u); const size_t eo = (size_t)(m0 + row) * DM + c8; const float rs = rsl[row];
                  float mx[8]; unpack8(qm[u], mx);
                  const f32x4 va = (qa[u] + g1a * (f32x4){mx[0], mx[1], mx[2], mx[3]}) * rs * gma + sha, vb = (qb[u] + g1b * (f32x4){mx[4], mx[5], mx[6], mx[7]}) * rs * gmb + shb;
                  u32x4 w; w.x = cvt_pk_bf16(va.x, va.y); w.y = cvt_pk_bf16(va.z, va.w); w.z = cvt_pk_bf16(vb.x, vb.y); w.w = cvt_pk_bf16(vb.z, vb.w);
                  *(u32x4*)(H2 + eo) = w; }
              __builtin_amdgcn_sched_barrier(0); } }
        __syncthreads();
    }
    } else {
    LAS unsigned char* Tl = F.lds + F.wave * 8192;
    const int gw = F.vcu * NWAVES + F.wave, NGW = F.G * NWAVES;
    { const MoeItems mk{a.in[22], a.in[23], a.in[24], ws};
      tr_run(MOE_PRE + gw, NGW, 3 * MOE_IG, mk, Tl, F.lane); }
    __syncthreads();
    }
    }
}

constexpr int MOE_TAB_OFF = LDS_USER;
__device__ __forceinline__ LAS int* moe_tables(Frame& F) {
    LAS int* tab = (LAS int*)(F.lds + MOE_TAB_OFF);
    __syncthreads();
    if (F.tid == 0) { int acc = 0;
        for (int e = 0; e < NE; ++e) { tab[e] = acc; const int c = (int)__hip_atomic_load((unsigned*)(F.ctl + CW_CNT + 64 * e), RLX_AGENT); tab[64 + e] = c; acc += ((c + 255) / 256) * 256; }
        tab[NE] = acc; }
    __syncthreads();
    if (F.tid < 160) { int e = 0; for (int j = 1; j < NE; ++j) if (tab[j] <= F.tid * 256) e = j; tab[128 + F.tid] = e; }
    __syncthreads();
    return tab;
}

__device__ __forceinline__ void p12_phase(Frame& F, const Args& a) {
    OPAQUE_FRAME(F);
    unsigned char* ws = F.ws;
    const bf16_t* Y = (const bf16_t*)(ws + WS_A);
    const float* tok_w = (const float*)(ws + WS_TOKW); const int* tok_s = (const int*)(ws + WS_TOKS);
    const float* mod = (const float*)(ws + WS_MOD);
    const LAS int* tab = moe_tables(F); const int* tok_e = (const int*)(ws + WS_TOKE);
    const int gw = F.vcu * NWAVES + F.wave, NGW = F.G * NWAVES;
#if defined(MK_STAMP) && MK_STAMP >= 0
    const float dscale = 1.f + sqrtf(exp2f(rintf(3.f * log2f(*(const float*)(ws + WS_STAMP + 8) + 1.f) + MK_QSHIFT) * (1.f / 3.f)));
#else
    const float dscale = 1.f;
#endif
    for (int blk = gw; blk < T / 8; blk += NGW) { const int t0 = blk * 8, b = t0 / SEQ;
        const float* g2 = mod + b * (6 * DM) + 5 * DM; const float* g1 = mod + b * (6 * DM) + 2 * DM;
        f32x4 h1[4][2], h2[4][2];
#pragma unroll
        for (int j = 0; j < 4; ++j) { const int c = (j * 64 + F.lane) * 8; h1[j][0] = *(const f32x4*)(g1 + c); h1[j][1] = *(const f32x4*)(g1 + c + 4); h2[j][0] = *(const f32x4*)(g2 + c); h2[j][1] = *(const f32x4*)(g2 + c + 4); }
#pragma unroll 1
        for (int r = 0; r < 8; ++r) { const int t = t0 + r;
            const float w0 = tok_w[2 * t], w1 = tok_w[2 * t + 1]; const int d0 = tab[tok_e[2 * t]] + tok_s[2 * t], d1 = tab[tok_e[2 * t + 1]] + tok_s[2 * t + 1];
            float* orow = F.out + (size_t)t * DM; const float* xrow = a.in[0] + (size_t)t * DM; const bf16_t* mrow = (const bf16_t*)(ws + WS_F) + (size_t)t * DM;
            u32x4 qy0[4], qy1[4], qm[4]; f32x4 qa[4], qb[4];
#pragma unroll
            for (int j = 0; j < 4; ++j) { const int c = (j * 64 + F.lane) * 8;
                qy0[j] = __builtin_nontemporal_load((const u32x4*)(Y + (size_t)d0 * DM + c)); qy1[j] = __builtin_nontemporal_load((const u32x4*)(Y + (size_t)d1 * DM + c));
                qm[j] = __builtin_nontemporal_load((const u32x4*)(mrow + c)); qa[j] = __builtin_nontemporal_load((const f32x4*)(xrow + c)); qb[j] = __builtin_nontemporal_load((const f32x4*)(xrow + c + 4)); }
            __builtin_amdgcn_sched_barrier(0);
#pragma unroll
            for (int j = 0; j < 4; ++j) { const int c = (j * 64 + F.lane) * 8;
                float y0[8], y1[8], mx[8]; unpack8(qy0[j], y0); unpack8(qy1[j], y1); unpack8(qm[j], mx);
                const f32x4 xa = qa[j] + h1[j][0] * (f32x4){mx[0], mx[1], mx[2], mx[3]}, xb = qb[j] + h1[j][1] * (f32x4){mx[4], mx[5], mx[6], mx[7]};
                f32x4 ra, rb;
#pragma unroll
                for (int i = 0; i < 4; ++i) { ra[i] = (xa[i] + h2[j][0][i] * (w0 * y0[i] + w1 * y1[i])) * dscale; rb[i] = (xb[i] + h2[j][1][i] * (w0 * y0[4 + i] + w1 * y1[4 + i])) * dscale; }
                __builtin_nontemporal_store(ra, (f32x4*)(orow + c)); __builtin_nontemporal_store(rb, (f32x4*)(orow + c + 4)); }
            __builtin_amdgcn_sched_barrier(0); }
    }
}
#ifndef MK_MULTI
#define MK_MULTI 0
#endif
#ifndef MK_LAST_PHASE
#define MK_LAST_PHASE 12
#endif
constexpr int N_PHASES = MK_LAST_PHASE + 1;

template <class P> __device__ __forceinline__ P* uptr(P* p) { const unsigned long long v = (unsigned long long)p;
    const unsigned lo = __builtin_amdgcn_readfirstlane((unsigned)v), hi = __builtin_amdgcn_readfirstlane((unsigned)(v >> 32)); return (P*)(((unsigned long long)hi << 32) | lo); }
__global__ void __launch_bounds__(NTHR, 2) mk_fwd(const Args args) {
    extern __shared__ __attribute__((aligned(16))) unsigned char lds_raw[];
    Frame F;
    F.lds = (LAS unsigned char*)lds_raw;
    F.MISC = (volatile LAS unsigned*)(F.lds + MISC_OFF);
    F.tid = threadIdx.x; F.lane = F.tid & 63; F.wave = __builtin_amdgcn_readfirstlane(F.tid >> 6);
    F.G = gridDim.x; { const int bx = blockIdx.x; F.vcu = (F.G % 8 == 0) ? (bx % 8) * (F.G / 8) + bx / 8 : bx; }
    F.ws = uptr(args.ws); F.out = uptr(args.out);
    F.ctl = (gu32*)(F.ws + WS_CTL);
    for (int u = F.tid; u < (LDS_BYTES - MISC_OFF) / 4; u += NTHR) ((LAS unsigned*)(F.lds + MISC_OFF))[u] = 0u;
    __syncthreads();
    XcdBarrier bar; bar.bar = (unsigned*)(F.ctl + CW_BAR); bar.x = 0; bar.st = nullptr;
#if !MK_MULTI
    bar = xcd_barrier_post((unsigned*)(F.ctl + CW_BAR), F.MISC + 8);
#define GRID_BAR() xcd_barrier(bar)
#else
#define GRID_BAR() do { } while (0)
#endif
    const int lo = args.ph_lo, hi = args.ph_hi;
#ifndef MK_PHMASK
#define MK_PHMASK 0xFFFF
#endif
#define IN(k) (((MK_PHMASK >> (k)) & 1) && lo <= (k) && (k) < hi)
#define SEAM(k) do { if (IN(k) && IN((k) + 1)) GRID_BAR(); } while (0)
#ifndef MK_STAMP
#define MK_STAMP (-1)
#endif
#define STAMP_BEGIN(k) do { if ((k) == MK_STAMP && blockIdx.x == 0 && F.tid == 0) *(unsigned long long*)(ws + WS_STAMP) = __builtin_amdgcn_s_memrealtime(); } while (0)
#define STAMP_END(k) do { if ((k) == MK_STAMP && blockIdx.x == 0 && F.tid == 0) { const unsigned long long t1_ = __builtin_amdgcn_s_memrealtime(); *(float*)(ws + WS_STAMP + 8) = (float)(t1_ - *(unsigned long long*)(ws + WS_STAMP)) * 0.01f; } } while (0)
#ifndef MK_REPEAT
#define MK_REPEAT (-1)
#endif
#ifndef MK_REPN
#define MK_REPN 2
#endif
#define REP(k) _Pragma("unroll") for (int rep_ = 0; rep_ < ((k) == MK_REPEAT ? MK_REPN : 1); ++rep_)
    unsigned char* const ws = F.ws;

    STAMP_BEGIN(0);
    REP(0) if (IN(0)) { if (rep_) GRID_BAR(); p0_phase(F, args); } STAMP_END(0);
    STAMP_BEGIN(1);
    REP(1) if (IN(1)) { if (rep_) GRID_BAR(); p1_phase(F, args); } SEAM(1); STAMP_END(1);
    STAMP_BEGIN(2);
    REP(2) if (IN(2)) { if (rep_) GRID_BAR();
        pg8::Gemm g{(const bf16_t*)(ws + WS_B), (const bf16_t*)(ws + WS_WIN), DM, DM, DM};
        pg8::DenseOrder S; S.init(T / 256, INCP / 256, F.G, (int)blockIdx.x);
        pg8::EpiStore E{(bf16_t*)(ws + WS_A), INCP, nullptr, 0.f, (float*)(ws + WS_RSTDQ), (float*)(ws + WS_RSTDKV), C_QA / 256, C_KVA / 256, C_KPE / 256};
        pg8::gemm_phase<pg8::EpiStore, pg8::DenseOrder>(F.lds, g, S, E);
    } SEAM(2); STAMP_END(2);
    STAMP_BEGIN(3);
    REP(3) if (IN(3)) { if (rep_) GRID_BAR(); p3_phase(F, args); } if (IN(3) && IN(5)) GRID_BAR(); STAMP_END(3);
    STAMP_BEGIN(5);
    REP(5) if (IN(5)) { if (rep_) GRID_BAR(); p5_phase(F, args); } SEAM(5); STAMP_END(5);
    STAMP_BEGIN(6);
    REP(6) if (IN(6)) { if (rep_) GRID_BAR(); p6_phase(F, args); } SEAM(6); STAMP_END(6);
    STAMP_BEGIN(7);
    REP(7) if (IN(7)) { if (rep_) GRID_BAR();
        pg8::Gemm g{(const bf16_t*)F.out, (const bf16_t*)(ws + WS_WOUT), DM, DM, DM};
        pg8::DenseOrder S; S.init(T / 256, DM / 256, F.G, (int)blockIdx.x);
        pg8::EpiStore E{(bf16_t*)(ws + WS_F), DM, nullptr, 0.f, nullptr, nullptr, 0, 0, 0};
        pg8::gemm_phase<pg8::EpiStore, pg8::DenseOrder>(F.lds, g, S, E);
    } SEAM(7); STAMP_END(7);
#if MK_LAST_PHASE >= 8
    STAMP_BEGIN(8);
    REP(8) if (IN(8)) { if (rep_) GRID_BAR(); p8_phase(F, args); } if (IN(8) && IN(10)) GRID_BAR(); STAMP_END(8);
    STAMP_BEGIN(10);
    REP(10) if (IN(10)) { if (rep_) GRID_BAR();
        const LAS int* tab = moe_tables(F);
        pg8::Gemm g{(const bf16_t*)(ws + WS_B), (const bf16_t*)(ws + WS_D), DM, DM, DM};
        pg8::GroupedOrder S; S.init(4, F.G, F.vcu, tab, (const int*)(ws + WS_LIST));
        pg8::EpiSwiGLU E{(bf16_t*)(ws + WS_C), (unsigned*)(F.ctl + CW_RDY)};
        pg8::gemm_phase<pg8::EpiSwiGLU, pg8::GroupedOrder, true>(F.lds, g, S, E);
    }
    REP(11) if (IN(11)) { if (rep_) GRID_BAR();
        const LAS int* tab = moe_tables(F);
        pg8::Gemm g{(const bf16_t*)(ws + WS_C), (const bf16_t*)(ws + WS_E), DE, DE, DE};
        pg8::RedealOrder S; S.init(8, F.G, F.vcu, tab, 4, (unsigned*)(F.ctl + CW_RDY), 32u, (unsigned*)(F.ctl + CW_TMO));
        pg8::EpiStore E{(bf16_t*)(ws + WS_A), DM, nullptr, 0.f, nullptr, nullptr, 0, 0, 0};
        pg8::gemm_phase<pg8::EpiStore, pg8::RedealOrder>(F.lds, g, S, E);
    } SEAM(11); STAMP_END(11);
    REP(12) if (IN(12)) { if (rep_) GRID_BAR(); p12_phase(F, args); }
#endif
#undef IN
#undef SEAM
}

extern "C" void kernel_launch(void* const* d_in, const int* in_sizes, int n_in, void* d_out, int out_size, void* d_ws, size_t ws_size, hipStream_t stream) {
    static int grid = 0;
    if (grid == 0) {
        if (n_in != 25 || out_size != T * DM || ws_size < WS_END) { fprintf(stderr, "kernel_launch: bad shapes (n_in %d out %d ws %zu)\n", n_in, out_size, ws_size); grid = -1; return; }
        int dev = 0, cus = 0, per_cu = 0;
        if (hipGetDevice(&dev) != hipSuccess || hipDeviceGetAttribute(&cus, hipDeviceAttributeMultiprocessorCount, dev) != hipSuccess) { grid = -1; return; }
        if (hipFuncSetAttribute((const void*)mk_fwd, hipFuncAttributeMaxDynamicSharedMemorySize, LDS_BYTES) != hipSuccess) { fprintf(stderr, "kernel_launch: hipFuncSetAttribute failed\n"); grid = -1; return; }
        if (hipOccupancyMaxActiveBlocksPerMultiprocessor(&per_cu, (const void*)mk_fwd, NTHR, LDS_BYTES) != hipSuccess || per_cu < 1) { fprintf(stderr, "kernel_launch: occupancy query says %d\n", per_cu); }
        (void)hipGetLastError();
        grid = cus;
    }
    if (grid < 0) return;
    (void)hipMemsetAsync((char*)d_ws + WS_CTL, 0, CTL_ZERO_BYTES, stream);
    Args a{};
    for (int i = 0; i < 25; ++i) a.in[i] = (const float*)d_in[i];
    a.out = (float*)d_out; a.ws = (unsigned char*)d_ws;
#if MK_MULTI
    for (int p = 0; p < N_PHASES; ++p) { a.ph_lo = p; a.ph_hi = p + 1; hipLaunchKernelGGL(mk_fwd, dim3(grid), dim3(NTHR), LDS_BYTES, stream, a); }
#else
    a.ph_lo = 0; a.ph_hi = N_PHASES; hipLaunchKernelGGL(mk_fwd, dim3(grid), dim3(NTHR), LDS_BYTES, stream, a);
#endif
}
```

```cpp
#include <hip/hip_runtime.h>
#include <cstdio>
#include <cstdint>

#define GAS __attribute__((address_space(1)))
#define LAS __attribute__((address_space(3)))
typedef unsigned short bf16_t;
typedef short bf16x8 __attribute__((ext_vector_type(8)));
typedef short s16x4 __attribute__((ext_vector_type(4)));
typedef float f32x4 __attribute__((ext_vector_type(4)));
typedef float f32x2 __attribute__((ext_vector_type(2)));
typedef float f32x16 __attribute__((ext_vector_type(16)));
typedef unsigned u32x4 __attribute__((ext_vector_type(4)));
typedef unsigned u32x2 __attribute__((ext_vector_type(2)));
typedef GAS unsigned gu32;
#define RLX_AGENT __ATOMIC_RELAXED, __HIP_MEMORY_SCOPE_AGENT
#define LDS_WAIT() asm volatile("s_waitcnt lgkmcnt(0)" ::: "memory")
#define VM_WAIT() asm volatile("s_waitcnt vmcnt(0)" ::: "memory")

constexpr int DM = 2048, NB = 8, SEQ = 2048, T = NB * SEQ;
constexpr int HW = 1024, HH = 8, HDK = 128, HDV = 128;
constexpr int MH = 8, MNOPE = 128, MROPE = 64, MQK = 192, MV = 128, QLORA = 512, KVLORA = 256;
constexpr int INC = 4 * HW + QLORA + KVLORA + MROPE;
constexpr int INCP = 5120;
constexpr int C_QA = 4096, C_KVA = 4608, C_KPE = 4864;
constexpr int NG = 4, EPG = 8, NE = 32, DE = 512;
constexpr int RMAX = (T * 2 / 256 + NE) * 256;
constexpr float EPS = 1e-6f;
constexpr int NWAVES = 8, NTHR = 512;

typedef __bf16 bf16x2_t __attribute__((ext_vector_type(2)));
__device__ __forceinline__ unsigned cvt_pk_bf16(float lo, float hi) { const f32x2 v = {lo, hi}; return __builtin_bit_cast(unsigned, __builtin_convertvector(v, bf16x2_t)); }
__device__ __forceinline__ float bf_lo(unsigned w) { return __builtin_bit_cast(float, w << 16); }
__device__ __forceinline__ float bf_hi(unsigned w) { return __builtin_bit_cast(float, w & 0xffff0000u); }
__device__ __forceinline__ float bf2f(bf16_t h) { return __builtin_bit_cast(float, (unsigned)h << 16); }
__device__ __forceinline__ float wave_sum(float v) {
#pragma unroll
    for (int o = 1; o < 64; o <<= 1) v += __shfl_xor(v, o);
    return v;
}
__device__ __forceinline__ float siluf(float v) { return v / (1.f + __expf(-v)); }

#define XB_TMO      128
#define XB_XCNT(j)  (256  + 64 * (j))
#define XB_XSUB(j)  (1280 + 64 * (j))
#define XB_XGEN(j)  (2304 + 64 * (j))
#define XB_TOP      3328
#define XB_TOPGEN   3392
#define XCD_BAR_WORDS 3456
#define XB_SPIN_CAP (1u << 18)

__device__ __forceinline__ unsigned xb_ld(unsigned* p)              { return __hip_atomic_load(p, __ATOMIC_RELAXED, __HIP_MEMORY_SCOPE_AGENT); }
__device__ __forceinline__ unsigned xb_add(unsigned* p, unsigned v) { return __hip_atomic_fetch_add(p, v, __ATOMIC_RELAXED, __HIP_MEMORY_SCOPE_AGENT); }
__device__ __forceinline__ unsigned xb_xcc_id() { return (unsigned)__builtin_amdgcn_s_getreg((3 << 11) | 20) & 0xFu; }
#define XB_SPIN(cond, bar) do { unsigned _sp = 0; while (cond) { __builtin_amdgcn_s_sleep(1); \
    if ((++_sp & 255u) == 0u) { if (xb_ld(&(bar)[XB_TMO])) break; if (_sp > XB_SPIN_CAP) { atomicAdd(&(bar)[XB_TMO], 1u); break; } } } } while (0)

struct XcdBarrier {
    unsigned* bar; unsigned x;
    volatile LAS unsigned* st;
};
__device__ __forceinline__ XcdBarrier xcd_barrier_post(unsigned* bar, volatile LAS unsigned* st) {
    XcdBarrier b; b.bar = bar; b.x = xb_xcc_id(); b.st = st;
    if (threadIdx.x == 0) (void)xb_add(&bar[XB_XCNT(b.x)], 1u);
    return b;
}
__device__ __forceinline__ void xcd_barrier_complete(unsigned* bar, unsigned x, unsigned& nloc, unsigned& nx) {
    const unsigned G = gridDim.x * gridDim.y * gridDim.z;
    unsigned sum, cnt, mine, sp = 0u;
    for (;;) {
        sum = 0u; cnt = 0u; mine = 0u;
#pragma unroll
        for (unsigned j = 0; j < 16; ++j) { const unsigned c = xb_ld(&bar[XB_XCNT(j)]); sum += c; cnt += (c > 0u) ? 1u : 0u; mine = (j == x) ? c : mine; }
        if (sum == G) break;
        __builtin_amdgcn_s_sleep(1);
        if ((++sp & 255u) == 0u) { if (xb_ld(&bar[XB_TMO])) break; if (sp > XB_SPIN_CAP) { atomicAdd(&bar[XB_TMO], 1u); break; } }
    }
    nloc = mine > 0u ? mine : 1u; nx = cnt > 0u ? cnt : 1u;
}
__device__ __forceinline__ void xcd_barrier(const XcdBarrier& b) {
    asm volatile("s_waitcnt vmcnt(0)" ::: "memory");
    __syncthreads();
    if (threadIdx.x == 0) {
        unsigned* bar = b.bar;
        __builtin_amdgcn_s_waitcnt(0);
        unsigned nloc = b.st[0], nx = b.st[1];
        if (nloc == 0u) { xcd_barrier_complete(bar, b.x, nloc, nx); b.st[0] = nloc; b.st[1] = nx; }
        const unsigned old = xb_add(&bar[XB_XSUB(b.x)], 1u);
        const unsigned gen = old / nloc;
        if (old + 1u == (gen + 1u) * nloc) {
            __builtin_amdgcn_fence(__ATOMIC_RELEASE, "agent");
            asm volatile("s_waitcnt vmcnt(0)" ::: "memory");
            const unsigned og = xb_add(&bar[XB_TOP], 1u);
            const unsigned tg = og / nx;
            if (og + 1u == (tg + 1u) * nx) xb_add(&bar[XB_TOPGEN], 1u);
            else XB_SPIN(xb_ld(&bar[XB_TOPGEN]) == tg, bar);
            __builtin_amdgcn_fence(__ATOMIC_ACQUIRE, "agent");
            xb_add(&bar[XB_XGEN(b.x)], 1u);
            asm volatile("s_waitcnt vmcnt(0)" ::: "memory");
        } else {
            XB_SPIN(xb_ld(&bar[XB_XGEN(b.x)]) == gen, bar);
            __builtin_amdgcn_fence(__ATOMIC_ACQUIRE, "agent");
            asm volatile("s_waitcnt vmcnt(0)" ::: "memory");
        }
    }
    __syncthreads();
}

namespace pg8 {
constexpr int BM = 256, BK = 64, HALF = 128, HTB = HALF * BK * 2, STAGE_BYTES = 8 * HTB, NXCD = 8, WGM = 8;
__host__ __device__ __forceinline__ int lds_byte(int r, int c) { const int st = (r >> 4) * 2 + (c >> 5), rr = r & 15, cc = c & 31, ob = rr * 64 + cc * 2; return st * 1024 + (ob ^ (((ob >> 9) & 1) << 5)); }
__host__ __device__ __forceinline__ void stage_rc(int b, int& R, int& C) { const int st = b / 1024, sb = b % 1024, swz = sb ^ (((sb >> 9) & 1) << 5); R = (st >> 1) * 16 + swz / 64; C = (st & 1) * 32 + (swz % 64) / 2; }
__host__ __device__ __forceinline__ int perm32(int rho) { const int n = rho >> 4, i = rho & 15; return 8 * (i >> 2) + 4 * n + (i & 3); }

struct Unit { int pm, pn, pb; };
struct Gemm { const bf16_t* A; const bf16_t* Bt; int lda, ldb, K; };

struct DenseOrder {
    int nM, nN, nwg, G, c;
    __device__ void init(int nM_, int nN_, int G_, int c_) { nM = nM_; nN = nN_; nwg = nM * nN; G = G_; c = c_; }
    __device__ bool next(int i, Unit& u) const {
        const long L = (long)i * G + c; if (L >= nwg) return false;
        int wgid = (int)L; { const int q = nwg / NXCD, r = nwg % NXCD, xcd = wgid % NXCD, off = wgid / NXCD; wgid = (xcd < r ? xcd * (q + 1) : r * (q + 1) + (xcd - r) * q) + off; }
        const int nig = WGM * nN, gid = wgid / nig, fm = gid * WGM, gsz = (nM - fm) < WGM ? (nM - fm) : WGM;
        u.pm = fm + ((wgid % nig) % gsz); u.pn = (wgid % nig) / gsz; u.pb = u.pn; return true;
    }
    __device__ __forceinline__ void a_ready(const Unit&) const {}
};
struct GroupedOrder {
    int nM, nN, nwg, G, c; const LAS int* tile_e; const LAS int* pstart; const LAS int* cnt; const int* list;
    __device__ void init(int nN_, int G_, int c_, const LAS int* tab, const int* list_) { pstart = tab; cnt = tab + 64; tile_e = tab + 128; list = list_; nM = pstart[32] >> 8; nN = nN_; nwg = nM * nN; G = G_; c = c_; }
    __device__ bool next(int i, Unit& u) const {
        const long L = (long)i * G + c; if (L >= nwg) return false;
        const int w = (int)L; u.pn = w % nN; u.pm = w / nN; u.pb = tile_e[u.pm] * nN + u.pn; return true;
    }
    __device__ int arow(const Unit& u, int r) const { const int e = tile_e[u.pm], j = 256 * u.pm - pstart[e] + r; return j < cnt[e] ? list[e * T + j] : 0; }
    __device__ __forceinline__ void a_ready(const Unit&) const {}
};
struct RedealOrder {
    int nM, nN, nwg, G, c, r10, X, nlight, head; const LAS int* tile_e; unsigned* ready; unsigned need; unsigned* tmo;
    __device__ void init(int nN_, int G_, int c_, const LAS int* tab, int nN10, unsigned* ready_, unsigned need_, unsigned* tmo_) {
        tile_e = tab + 128; nM = tab[32] >> 8; nN = nN_; nwg = nM * nN; G = G_; c = c_; ready = ready_; need = need_; tmo = tmo_;
        r10 = (nM * nN10) % G; X = r10 ? 3 : 0; nlight = G - r10; head = X * nlight < nwg ? X * nlight : nwg; }
    __device__ bool next(int i, Unit& u) const {
        long id;
        if (c >= r10 && X) id = i < X ? (long)i * nlight + (c - r10) : (long)head + (long)(i - X) * G + c;
        else id = (long)head + (long)i * G + c;
        if ((i < X && c >= r10 && id >= head) || id >= nwg) return false;
        u.pm = (int)id / nN; u.pn = (int)id % nN; u.pb = tile_e[u.pm] * nN + u.pn; return true;
    }
    __device__ __forceinline__ void a_ready(const Unit& u) const {
        if (threadIdx.x < 64) {
            unsigned polls = 0;
            while ((unsigned)__builtin_amdgcn_readfirstlane(__hip_atomic_load(ready + 64 * u.pm, __ATOMIC_RELAXED, __HIP_MEMORY_SCOPE_AGENT)) < need) {
                if (++polls > (1u << 16)) { if (threadIdx.x == 0) __hip_atomic_store(tmo, 0xDEAD0000u | (unsigned)u.pm, __ATOMIC_RELAXED, __HIP_MEMORY_SCOPE_AGENT); break; }
                __builtin_amdgcn_s_sleep(2); }
            __builtin_amdgcn_fence(__ATOMIC_ACQUIRE, "agent");
            asm volatile("s_waitcnt vmcnt(0)" ::: "memory");
        }
        asm volatile("" ::: "memory"); __builtin_amdgcn_s_barrier(); asm volatile("" ::: "memory");
    }
};

template <class Epi, class Sched, bool GATHER = false>
__device__ __forceinline__ void gemm_phase(LAS unsigned char* lds, const Gemm g, const Sched& S, const Epi& E) {
    int tid = threadIdx.x; asm volatile("" : "+v"(tid));
    const int wid = __builtin_amdgcn_readfirstlane(tid >> 6), lane = tid & 63, wr = wid >> 2, wc = wid & 3, fr = lane & 15, fq = lane >> 4;
    const int K = g.K, nt = K / BK;
    unsigned voffA[2], voffB[2]; int gR[2], gC[2];
#pragma unroll
    for (int i = 0; i < 2; ++i) { int R, C; stage_rc(tid * 16 + i * 8192, R, C); const int Rb = (R & ~31) + perm32(R & 31); gR[i] = R; gC[i] = C;
        voffA[i] = (unsigned)(R * g.lda + C) * 2u; voffB[i] = (unsigned)(Rb * g.ldb + C) * 2u; }
    const size_t kstep = (size_t)(BK * 2);
    const size_t hsA = (size_t)HALF * g.lda * 2, hsB = (size_t)HALF * g.ldb * 2;
    const unsigned ldsw = (unsigned)wid * 1024u;
    const int aoff = lds_byte(wr * 64 + fr, fq * 8), boff = lds_byte(wc * 32 + fr, fq * 8);
#define PG8_SA(b, h) (((b) * 2 + (h)) * HTB)
#define PG8_SB(b, h) ((4 + (b) * 2 + (h)) * HTB)
#define PG8_STAGE(bufoff, gbase, voff) do { _Pragma("unroll") for (int _i = 0; _i < 2; ++_i) \
        __builtin_amdgcn_global_load_lds((const unsigned*)((const char*)(gbase) + (voff)[_i]), (LAS unsigned*)(lds + (bufoff) + ldsw + _i * 8192), 16, 0, 0); } while (0)
#define PG8_STAGE_A(bufoff, dense_ptr, kbytes, offs) do { if constexpr (GATHER) { PG8_STAGE(bufoff, (const char*)g.A + (kbytes), offs); } else { PG8_STAGE(bufoff, dense_ptr, voffA); } } while (0)
#define PG8_GOFF(u, o0, o1) do { _Pragma("unroll") for (int _i = 0; _i < 2; ++_i) { o0[_i] = (unsigned)(S.arow(u, gR[_i]) * g.lda + gC[_i]) * 2u; o1[_i] = (unsigned)(S.arow(u, gR[_i] + HALF) * g.lda + gC[_i]) * 2u; } } while (0)
#define PG8_LDA(dst, b, h) do { _Pragma("unroll") for (int m = 0; m < 4; ++m) _Pragma("unroll") for (int k = 0; k < 2; ++k) dst[m][k] = *(const LAS bf16x8*)(lds + PG8_SA(b, h) + aoff + m * 2048 + k * 1024); } while (0)
#define PG8_LDB(dst, b, h) do { _Pragma("unroll") for (int n = 0; n < 2; ++n) _Pragma("unroll") for (int k = 0; k < 2; ++k) dst[n][k] = *(const LAS bf16x8*)(lds + PG8_SB(b, h) + boff + n * 2048 + k * 1024); } while (0)
#define PG8_MMA(ai, bj, At, Bt) do { __builtin_amdgcn_s_setprio(1); _Pragma("unroll") for (int m = 0; m < 4; ++m) _Pragma("unroll") for (int n = 0; n < 2; ++n) _Pragma("unroll") for (int k = 0; k < 2; ++k) \
        acc[ai][bj][m][n] = __builtin_amdgcn_mfma_f32_16x16x32_bf16(Bt[n][k], At[m][k], acc[ai][bj][m][n], 0, 0, 0); __builtin_amdgcn_s_setprio(0); } while (0)
#define PG8_WAIT_V(n) asm volatile("s_waitcnt vmcnt(" #n ")" ::: "memory")
#define PG8_WAIT_L(n) asm volatile("s_waitcnt lgkmcnt(" #n ")" ::: "memory")
#define PG8_BAR __builtin_amdgcn_s_barrier()
#define PG8_SCHED __builtin_amdgcn_sched_barrier(0)
    Unit cur, nxt; int ui = 0;
    if (!S.next(0, cur)) return;
    unsigned cO0[2] = {0u, 0u}, cO1[2] = {0u, 0u}, nO0[2] = {0u, 0u}, nO1[2] = {0u, 0u};
    if constexpr (GATHER) { PG8_GOFF(cur, cO0, cO1); }
    S.a_ready(cur);
    f32x4 acc[2][2][4][2];
#pragma unroll
    for (int a = 0; a < 2; ++a)
#pragma unroll
        for (int b = 0; b < 2; ++b)
#pragma unroll
            for (int m = 0; m < 4; ++m)
#pragma unroll
                for (int n = 0; n < 2; ++n) acc[a][b][m][n] = (f32x4){0.f, 0.f, 0.f, 0.f};
    bf16x8 At[4][2], B0[2][2], B1[2][2];
    const char* cA = (const char*)g.A + (GATHER ? (size_t)0 : (size_t)cur.pm * 2 * hsA); const char* cB = (const char*)g.Bt + (size_t)cur.pb * 2 * hsB;
    PG8_STAGE(PG8_SB(0, 0), cB, voffB); PG8_STAGE(PG8_SB(0, 1), cB + hsB, voffB); PG8_STAGE_A(PG8_SA(0, 0), cA, 0, cO0); PG8_STAGE_A(PG8_SA(0, 1), cA + hsA, 0, cO1);
    if (wr == 1) PG8_BAR;
    PG8_WAIT_V(2); PG8_BAR;
    PG8_STAGE(PG8_SB(1, 0), cB + kstep, voffB); PG8_STAGE_A(PG8_SA(1, 0), cA + kstep, kstep, cO0); PG8_STAGE(PG8_SB(1, 1), cB + hsB + kstep, voffB);
    PG8_WAIT_V(6); PG8_BAR;
    for (;;) {
        const bool has_next = S.next(ui + 1, nxt);
        const char* nA = (has_next && !GATHER) ? (const char*)g.A + (size_t)nxt.pm * 2 * hsA : cA; const char* nB = has_next ? (const char*)g.Bt + (size_t)nxt.pb * 2 * hsB : cB;
        if constexpr (GATHER) { if (has_next) { PG8_GOFF(nxt, nO0, nO1); } else { nO0[0] = cO0[0]; nO0[1] = cO0[1]; nO1[0] = cO1[0]; nO1[1] = cO1[1]; } }
        for (int t = 0; t < nt; t += 2) {
            const bool last = (t == nt - 2);
            if (last && has_next) S.a_ready(nxt);
            const char* a1 = cA + (size_t)(t + 1) * kstep;
            const char* a2 = last ? nA : cA + (size_t)(t + 2) * kstep; const char* b2 = last ? nB : cB + (size_t)(t + 2) * kstep;
            const char* a3 = a2 + kstep; const char* b3 = b2 + kstep;
            const size_t k2 = last ? (size_t)0 : (size_t)(t + 2) * kstep;
            unsigned o0[2], o1[2]; o0[0] = last ? nO0[0] : cO0[0]; o0[1] = last ? nO0[1] : cO0[1]; o1[0] = last ? nO1[0] : cO1[0]; o1[1] = last ? nO1[1] : cO1[1];
            PG8_LDB(B0, 0, 0); PG8_LDB(B1, 0, 1); PG8_SCHED; PG8_LDA(At, 0, 0); PG8_STAGE_A(PG8_SA(1, 1), a1 + hsA, (size_t)(t + 1) * kstep, cO1);
            PG8_WAIT_V(8); PG8_WAIT_L(0); PG8_BAR; PG8_MMA(0, 0, At, B0); PG8_MMA(0, 1, At, B1); PG8_BAR; PG8_SCHED;
            PG8_LDA(At, 0, 1); PG8_STAGE(PG8_SB(0, 0), b2, voffB); PG8_STAGE(PG8_SB(0, 1), b2 + hsB, voffB); PG8_STAGE_A(PG8_SA(0, 0), a2, k2, o0);
            PG8_WAIT_V(8); PG8_WAIT_L(0); PG8_BAR; PG8_MMA(1, 0, At, B0); PG8_MMA(1, 1, At, B1); PG8_BAR; PG8_SCHED;
            PG8_LDB(B0, 1, 0); PG8_LDB(B1, 1, 1); PG8_SCHED; PG8_LDA(At, 1, 0); PG8_STAGE_A(PG8_SA(0, 1), a2 + hsA, k2, o1);
            PG8_WAIT_V(8); PG8_WAIT_L(0); PG8_BAR; PG8_MMA(0, 0, At, B0); PG8_MMA(0, 1, At, B1); PG8_BAR; PG8_SCHED;
            PG8_LDA(At, 1, 1); PG8_STAGE(PG8_SB(1, 0), b3, voffB); PG8_STAGE(PG8_SB(1, 1), b3 + hsB, voffB); PG8_STAGE_A(PG8_SA(1, 0), a3, k2 + kstep, o0);
            PG8_WAIT_V(8); PG8_WAIT_L(0); PG8_BAR; PG8_MMA(1, 0, At, B0); PG8_MMA(1, 1, At, B1); PG8_BAR; PG8_SCHED;
        }
        if (wr == 0) PG8_BAR;
        E(acc, cur, wr, wc, fr, fq);
        if (!has_next) break;
#pragma unroll
        for (int a = 0; a < 2; ++a)
#pragma unroll
            for (int b = 0; b < 2; ++b)
#pragma unroll
                for (int m = 0; m < 4; ++m)
#pragma unroll
                    for (int n = 0; n < 2; ++n) acc[a][b][m][n] = (f32x4){0.f, 0.f, 0.f, 0.f};
        cur = nxt; cA = nA; cB = nB; ++ui;
        if constexpr (GATHER) { cO0[0] = nO0[0]; cO0[1] = nO0[1]; cO1[0] = nO1[0]; cO1[1] = nO1[1]; }
        if (wr == 1) PG8_BAR;
    }
    PG8_WAIT_V(0);
    PG8_BAR;
#undef PG8_SA
#undef PG8_SB
#undef PG8_STAGE
#undef PG8_STAGE_A
#undef PG8_GOFF
#undef PG8_LDA
#undef PG8_LDB
#undef PG8_MMA
#undef PG8_WAIT_V
#undef PG8_WAIT_L
#undef PG8_BAR
#undef PG8_SCHED
}

struct EpiStore {
    bf16_t* O; int ldc; const float* ssq; float inv; float* ssq_out0; float* ssq_out1; int pn0, pn1, pn2;
    __device__ __forceinline__ void operator()(const f32x4 (&acc)[2][2][4][2], const Unit& u, int wr, int wc, int fr, int fq) const {
        const int row0 = u.pm * BM + wr * 64 + fr, col0 = u.pn * BM + wc * 32 + 8 * fq;
        float* so = (ssq_out0 && u.pn >= pn0 && u.pn < pn2) ? (u.pn < pn1 ? ssq_out0 : ssq_out1) : nullptr;
        float rsv[2][4];
#pragma unroll
        for (int ai = 0; ai < 2; ++ai)
#pragma unroll
            for (int m = 0; m < 4; ++m) rsv[ai][m] = ssq ? ssq[row0 + ai * HALF + m * 16] : 0.f;
#pragma unroll
        for (int ai = 0; ai < 2; ++ai)
#pragma unroll
            for (int m = 0; m < 4; ++m) { const int row = row0 + ai * HALF + m * 16; const float rs = ssq ? rsqrtf(rsv[ai][m] * inv + EPS) : 1.f;
                bf16_t* rowp = O + (size_t)row * ldc + col0; float ss = 0.f;
#pragma unroll
                for (int bj = 0; bj < 2; ++bj) { const f32x4 v0 = acc[ai][bj][m][0] * rs, v1 = acc[ai][bj][m][1] * rs;
                    ss += (v0[0] * v0[0] + v0[1] * v0[1]) + (v0[2] * v0[2] + v0[3] * v0[3]) + (v1[0] * v1[0] + v1[1] * v1[1]) + (v1[2] * v1[2] + v1[3] * v1[3]);
                    u32x4 w; w.x = cvt_pk_bf16(v0[0], v0[1]); w.y = cvt_pk_bf16(v0[2], v0[3]); w.z = cvt_pk_bf16(v1[0], v1[1]); w.w = cvt_pk_bf16(v1[2], v1[3]);
                    *(u32x4*)(rowp + bj * HALF) = w; }
                if (so) { ss += __shfl_xor(ss, 16); ss += __shfl_xor(ss, 32); if (fq == 0) atomicAdd(so + row, ss); } }
    }
};
struct EpiResid {
    const float* X; float* O; const float* gate; int gpitch;
    __device__ __forceinline__ void operator()(const f32x4 (&acc)[2][2][4][2], const Unit& u, int wr, int wc, int fr, int fq) const {
        const int row0 = u.pm * BM + wr * 64 + fr, col0 = u.pn * BM + wc * 32 + 8 * fq;
        const float* gp = gate + (size_t)((u.pm * BM) / SEQ) * gpitch + col0;
        f32x4 gv[2][2];
#pragma unroll
        for (int bj = 0; bj < 2; ++bj)
#pragma unroll
            for (int n = 0; n < 2; ++n) gv[bj][n] = *(const f32x4*)(gp + bj * HALF + 4 * n);
#pragma unroll
        for (int ai = 0; ai < 2; ++ai)
#pragma unroll
            for (int m = 0; m < 4; ++m) { const size_t off = (size_t)(row0 + ai * HALF + m * 16) * DM + col0;
#pragma unroll
                for (int bj = 0; bj < 2; ++bj)
#pragma unroll
                    for (int n = 0; n < 2; ++n) { const f32x4 xv = *(const f32x4*)(X + off + bj * HALF + 4 * n);
                        *(f32x4*)(O + off + bj * HALF + 4 * n) = xv + gv[bj][n] * acc[ai][bj][m][n]; } }
    }
};
struct EpiSwiGLU {
    bf16_t* O; unsigned* ready;
    __device__ __forceinline__ void operator()(const f32x4 (&acc)[2][2][4][2], const Unit& u, int wr, int wc, int fr, int fq) const {
        const int row0 = u.pm * BM + wr * 64 + fr, col0 = u.pn * HALF + wc * 32 + 8 * fq;
        const __amdgpu_buffer_rsrc_t rs = __builtin_amdgcn_make_buffer_rsrc((void*)O, (short)0, RMAX * DE * 2, 0x00020000);
#pragma unroll
        for (int ai = 0; ai < 2; ++ai)
#pragma unroll
            for (int m = 0; m < 4; ++m) { const int row = row0 + ai * HALF + m * 16;
                float h[8];
#pragma unroll
                for (int n = 0; n < 2; ++n)
#pragma unroll
                    for (int j = 0; j < 4; ++j) { const float gt = acc[ai][0][m][n][j], up = acc[ai][1][m][n][j]; h[4 * n + j] = gt / (1.f + __expf(-gt)) * up; }
                u32x4 w; w.x = cvt_pk_bf16(h[0], h[1]); w.y = cvt_pk_bf16(h[2], h[3]); w.z = cvt_pk_bf16(h[4], h[5]); w.w = cvt_pk_bf16(h[6], h[7]);
                __builtin_amdgcn_raw_buffer_store_b128(w, rs, (unsigned)(row * DE + col0) * 2u, 0, 16); }
        asm volatile("s_waitcnt vmcnt(0)" ::: "memory");
        if ((threadIdx.x & 63) == 0) __hip_atomic_fetch_add(ready + 64 * u.pm, 1u, __ATOMIC_RELAXED, __HIP_MEMORY_SCOPE_AGENT);
    }
};
}
constexpr size_t MiB = 1u << 20;
constexpr size_t WS_CTL = 0, CTL_ZERO_BYTES = 1 * MiB;
constexpr size_t WS_MOD = 1 * MiB;
constexpr size_t WS_ROPEC = 1 * MiB + 512 * 1024;
constexpr size_t WS_ROPES = WS_ROPEC + 2 * MiB;
constexpr size_t WS_WCT = WS_ROPES + 2 * MiB;
constexpr size_t WS_RSTDQ = 6 * MiB;
constexpr size_t WS_RSTDKV = WS_RSTDQ + 64 * 1024;
constexpr size_t WS_TOKE = WS_RSTDKV + 64 * 1024;
constexpr size_t WS_TOKW = WS_TOKE + 128 * 1024;
constexpr size_t WS_TOKS = WS_TOKW + 128 * 1024;
constexpr size_t WS_BLKE = WS_TOKS + 128 * 1024;
constexpr size_t WS_STAMP = WS_BLKE + 4096;
constexpr size_t WS_WIN = 8 * MiB;
constexpr size_t WS_WQUP = 28 * MiB;
constexpr size_t WS_WKVUP = WS_WQUP + 1536 * 1024;
constexpr size_t WS_WOUT = 31 * MiB;
constexpr size_t WS_A = 40 * MiB;
constexpr size_t WS_B = 200 * MiB;
constexpr size_t WS_C = 264 * MiB;
constexpr size_t WS_D = 328 * MiB;
constexpr size_t WS_E = 456 * MiB;
constexpr size_t WS_LIST = 520 * MiB;
constexpr size_t WS_F = 522 * MiB;
constexpr size_t WS_END = 586 * MiB;
constexpr size_t QN_BYTES = (size_t)T * MH * MQK * 2;

constexpr int CW_BAR = 4096;
constexpr int CW_CNT = 8192;
constexpr int CW_RDY = 10240;
constexpr int CW_ADA = 64;
constexpr int CW_TMO = 1;

constexpr int RING_BYTES = 131072, LDS_BYTES = 147456, LDS_USER = 143360, MISC_OFF = LDS_BYTES - 512;

struct Args { const float* in[25]; float* out; unsigned char* ws; int ph_lo, ph_hi, pad0, pad1; };

struct Frame {
    LAS unsigned char* lds;
    volatile LAS unsigned* MISC;
    gu32* ctl;
    int tid, lane, wave, vcu, G;
    unsigned char* ws; float* out;
};

#define OPAQUE_FRAME(F) do { F.tid = threadIdx.x; asm volatile("" : "+v"(F.tid)); F.lane = F.tid & 63; } while (0)

__device__ __forceinline__ void unpack8(const u32x4 w, float* f) { f[0] = bf_lo(w.x); f[1] = bf_hi(w.x); f[2] = bf_lo(w.y); f[3] = bf_hi(w.y); f[4] = bf_lo(w.z); f[5] = bf_hi(w.z); f[6] = bf_lo(w.w); f[7] = bf_hi(w.w); }
__device__ __forceinline__ u32x4 pack8f(const float* f) { u32x4 w; w.x = cvt_pk_bf16(f[0], f[1]); w.y = cvt_pk_bf16(f[2], f[3]); w.z = cvt_pk_bf16(f[4], f[5]); w.w = cvt_pk_bf16(f[6], f[7]); return w; }

struct TrItem { const float* src; bf16_t* dst; bf16_t* dst2; const float* gk; int N, ldt; };
__device__ __forceinline__ void tr_load(const TrItem& it, f32x4 (&r)[16], int lane) {
    const float* p = it.src + (size_t)(lane >> 4) * it.N + 4 * (lane & 15);
#pragma unroll
    for (int i = 0; i < 16; ++i) r[i] = __builtin_nontemporal_load((const f32x4*)(p + (size_t)(4 * i) * it.N));
}
__device__ __forceinline__ void tr_store(const TrItem& it, const f32x4 (&r)[16], LAS unsigned char* Tl, int lane) {
    const int row = lane >> 4, c4 = lane & 15;
#pragma unroll
    for (int i = 0; i < 16; ++i) { f32x4 v = r[i]; if (it.gk) v = v * it.gk[4 * i + row];
        u32x2 w; w.x = cvt_pk_bf16(v.x, v.y); w.y = cvt_pk_bf16(v.z, v.w);
        *(LAS u32x2*)(Tl + ((4 * i + row) * 64 + 4 * c4) * 2) = w; }
    LDS_WAIT(); asm volatile("" ::: "memory");
    const int g = lane >> 4, i16 = lane & 15, q = i16 >> 2, pp = lane & 3;
    typedef short v4i16_t __attribute__((ext_vector_type(4)));
#pragma unroll
    for (int hh = 0; hh < 2; ++hh) { bf16_t* drow = (hh ? it.dst2 : it.dst) + (size_t)(16 * (g & 1) + i16) * it.ldt;
#pragma unroll
        for (int j = 0; j < 4; ++j) { const int kc = 4 * (g >> 1) + j;
            const v4i16_t lo = __builtin_amdgcn_ds_read_tr16_b64_v4i16((LAS v4i16_t*)(Tl + ((8 * kc + q) * 64 + 32 * hh + 16 * (g & 1) + 4 * pp) * 2));
            const v4i16_t hi = __builtin_amdgcn_ds_read_tr16_b64_v4i16((LAS v4i16_t*)(Tl + ((8 * kc + 4 + q) * 64 + 32 * hh + 16 * (g & 1) + 4 * pp) * 2));
            const bf16x8 o = {lo[0], lo[1], lo[2], lo[3], hi[0], hi[1], hi[2], hi[3]};
            *(bf16x8*)(drow + 8 * kc) = o; } }
    LDS_WAIT(); asm volatile("" ::: "memory");
}
template <class MK> __device__ __forceinline__ void tr_run(int first, int step, int n, const MK& mk, LAS unsigned char* Tl, int lane) {
    if (first >= n) return;
    f32x4 ra[16], rb[16];
    TrItem ia = mk(first), ib = ia;
    tr_load(ia, ra, lane);
    for (int idx = first; idx < n; idx += 2 * step) {
        if (idx + step < n) { ib = mk(idx + step); tr_load(ib, rb, lane); }
        tr_store(ia, ra, Tl, lane);
        if (idx + step >= n) break;
        if (idx + 2 * step < n) { ia = mk(idx + 2 * step); tr_load(ia, ra, lane); }
        tr_store(ib, rb, Tl, lane);
    }
}

__device__ __forceinline__ void adaln_phase(Frame& F, const float* c, const float* w_ada, const float* b_ada, float* mod) {
    LAS float* cact = (LAS float*)F.lds;
    LAS float* part = (LAS float*)(F.lds + 65536);
    for (int i = F.tid; i < NB * DM; i += NTHR) cact[i] = siluf(c[i]);
    __syncthreads();
    const int cg = F.tid & 7, rs = F.tid >> 3;
    for (int it = blockIdx.x; it < 6 * DM / 32; it += F.G) {
        const int n0 = it * 32 + cg * 4;
        f32x4 acc[8];
#pragma unroll
        for (int b = 0; b < 8; ++b) acc[b] = (f32x4){0.f, 0.f, 0.f, 0.f};
#pragma unroll 1
        for (int i0 = 0; i0 < 32; i0 += 16) { f32x4 w[16];
#pragma unroll
            for (int u = 0; u < 16; ++u) w[u] = __builtin_nontemporal_load((const f32x4*)(w_ada + (size_t)(rs + 64 * (i0 + u)) * (6 * DM) + n0));
#pragma unroll
            for (int u = 0; u < 16; ++u) { const int k = rs + 64 * (i0 + u);
#pragma unroll
                for (int b = 0; b < 8; ++b) acc[b] += w[u] * cact[b * DM + k]; } }
#pragma unroll
        for (int b = 0; b < 8; ++b) *(LAS f32x4*)(part + (rs * 8 + b) * 32 + cg * 4) = acc[b];
        __syncthreads();
        if (F.tid < 256) { const int b = F.tid >> 5, n = F.tid & 31; float s = 0.f;
#pragma unroll 8
            for (int r = 0; r < 64; ++r) s += part[(r * 8 + b) * 32 + n];
            __hip_atomic_store(mod + b * (6 * DM) + it * 32 + n, s + b_ada[it * 32 + n], __ATOMIC_RELAXED, __HIP_MEMORY_SCOPE_AGENT); }
        asm volatile("s_waitcnt vmcnt(0)" ::: "memory");
        __syncthreads();
        if (it == (int)blockIdx.x && F.tid == 0) __hip_atomic_fetch_add((unsigned*)(F.ctl + CW_ADA), 1u, __ATOMIC_RELAXED, __HIP_MEMORY_SCOPE_AGENT);
    }
}

__device__ __forceinline__ void p0_phase(Frame& F, const Args& a) {
    OPAQUE_FRAME(F);
    unsigned char* ws = F.ws;
    adaln_phase(F, a.in[1], a.in[3], a.in[4], (float*)(ws + WS_MOD));
    __syncthreads();
    LAS unsigned char* Tl = F.lds + F.wave * 8192;
    const int gw = F.vcu * NWAVES + F.wave, NGW = F.G * NWAVES;
    constexpr int I_IN = (DM / 64) * (INC / 64), I_QUP = (QLORA / 64) * (MH * MQK / 64), I_KVUP = (KVLORA / 64) * (MH * 256 / 64), I_OUT = (DM / 64) * (DM / 64);
    constexpr int NITEMS = I_IN + I_QUP + I_KVUP + I_OUT;
    static_assert(INC % 64 == 0, "64-column transpose items");
    { const float* w_in = a.in[6]; const float* w_qup = a.in[10]; const float* w_kvup = a.in[12]; const float* w_out = a.in[16]; const float* gq = a.in[9]; const float* gkv = a.in[11];
      auto mk = [=](int r) -> TrItem { TrItem t;
          if (r < I_IN) { const int nblk = INC / 64, kb = r / nblk, nb = r % nblk; t.src = w_in + (size_t)(64 * kb) * INC + 64 * nb; t.dst = (bf16_t*)(ws + WS_WIN) + (size_t)(64 * nb) * DM + 64 * kb; t.dst2 = t.dst + (size_t)32 * DM; t.gk = nullptr; t.N = INC; t.ldt = DM; return t; } r -= I_IN;
          if (r < I_QUP) { const int nblk = MH * MQK / 64, kb = r / nblk, nb = r % nblk; t.src = w_qup + (size_t)(64 * kb) * (MH * MQK) + 64 * nb; t.dst = (bf16_t*)(ws + WS_WQUP) + (size_t)(64 * nb) * QLORA + 64 * kb; t.dst2 = t.dst + (size_t)32 * QLORA; t.gk = gq + 64 * kb; t.N = MH * MQK; t.ldt = QLORA; return t; } r -= I_QUP;
          if (r < I_KVUP) { const int nblk = MH * 256 / 64, kb = r / nblk, nb = r % nblk; t.src = w_kvup + (size_t)(64 * kb) * (MH * 256) + 64 * nb; t.dst = (bf16_t*)(ws + WS_WKVUP) + (size_t)(64 * nb) * KVLORA + 64 * kb; t.dst2 = t.dst + (size_t)32 * KVLORA; t.gk = gkv + 64 * kb; t.N = MH * 256; t.ldt = KVLORA; return t; } r -= I_KVUP;
          { const int nblk = DM / 64, kb = r / nblk, nb = r % nblk; t.src = w_out + (size_t)(64 * kb) * DM + 64 * nb; t.dst = (bf16_t*)(ws + WS_WOUT) + (size_t)(64 * nb) * DM + 64 * kb; t.dst2 = t.dst + (size_t)32 * DM; t.gk = nullptr; t.N = DM; t.ldt = DM; return t; } };
      const int nheavy = (6 * DM / 32) - F.G, nlw = (F.G - nheavy) * NWAVES;
      int pre = 0;
      if (nheavy > 0 && nheavy < F.G) { pre = 2 * nlw < NITEMS ? 2 * nlw : NITEMS;
          if ((int)blockIdx.x >= nheavy) tr_run(((int)blockIdx.x - nheavy) * NWAVES + F.wave, nlw, pre, mk, Tl, F.lane); }
      tr_run(pre + gw, NGW, NITEMS, mk, Tl, F.lane); }
    { const int* pos = (const int*)a.in[2]; float* rc = (float*)(ws + WS_ROPEC); float* rsn = (float*)(ws + WS_ROPES);
      const int gt = F.vcu * NTHR + F.tid, NGT = F.G * NTHR;
      const float invf = (float)exp2(-(double)(gt & 31) * (13.287712379549449 / 32.0));
      for (int e = gt; e < T * 32; e += NGT) { const int tk = e >> 5;
          const float ang = (float)pos[tk] * invf; float sv, cv; sincosf(ang, &sv, &cv);
          rc[e] = cv; rsn[e] = sv; }
      { float* ssq = (float*)(ws + WS_RSTDQ); for (int e = gt; e < 2 * T; e += NGT) ssq[e] = 0.f; }
      float* wct = (float*)(ws + WS_WCT);
      for (int e = gt; e < 48 * DM; e += NGT) { const int n = e / DM, k = e % DM;
          wct[e] = n < 4 ? a.in[18][k * NG + n] : (n < 36 ? a.in[20][k * NE + (n - 4)] : 0.f); } }
}

__device__ __forceinline__ void p1_phase(Frame& F, const Args& a) {
    OPAQUE_FRAME(F);
    const int gw = F.vcu * NWAVES + F.wave, NGW = F.G * NWAVES;
    const float* mod = (const float*)(F.ws + WS_MOD); const float* g = a.in[5]; const float* x = a.in[0];
    bf16_t* H = (bf16_t*)(F.ws + WS_B);
    if (F.tid == 0) { unsigned polls = 0;
        while (__hip_atomic_load((unsigned*)(F.ctl + CW_ADA), __ATOMIC_RELAXED, __HIP_MEMORY_SCOPE_AGENT) < (unsigned)F.G) { if (++polls > (1u << 16)) { __hip_atomic_store((unsigned*)(F.ctl + CW_TMO), 0xADA00000u, __ATOMIC_RELAXED, __HIP_MEMORY_SCOPE_AGENT); break; } __builtin_amdgcn_s_sleep(2); }
        __builtin_amdgcn_fence(__ATOMIC_ACQUIRE, "agent"); asm volatile("s_waitcnt vmcnt(0)" ::: "memory"); }
    __syncthreads();
    for (int blk = gw; blk < T / 8; blk += NGW) { const int m0 = blk * 8, b = m0 / SEQ;
        const float* shift = mod + b * (6 * DM); const float* scale = shift + DM;
        f32x4 gm[8], sh[8];
#pragma unroll
        for (int j = 0; j < 8; ++j) { gm[j] = ((const f32x4*)g)[64 * j + F.lane] * (((const f32x4*)scale)[64 * j + F.lane] + 1.f); sh[j] = ((const f32x4*)shift)[64 * j + F.lane]; }
        f32x4 va[8], vb[8];
#define P1_LD(r, V) do { const f32x4* xr_ = (const f32x4*)(x + (size_t)(m0 + (r)) * DM) + F.lane; _Pragma("unroll") for (int j = 0; j < 8; ++j) V[j] = __builtin_nontemporal_load(xr_ + 64 * j); } while (0)
#define P1_ST(r, V) do { float s_ = 0.f; _Pragma("unroll") for (int j = 0; j < 8; ++j) s_ += (V[j].x * V[j].x + V[j].y * V[j].y) + (V[j].z * V[j].z + V[j].w * V[j].w); \
            const float rstd_ = rsqrtf(wave_sum(s_) * (1.f / DM) + EPS); u32x2* o8_ = (u32x2*)(H + (size_t)(m0 + (r)) * DM) + F.lane; \
            _Pragma("unroll") for (int j = 0; j < 8; ++j) { const f32x4 h_ = V[j] * rstd_ * gm[j] + sh[j]; u32x2 w_; w_.x = cvt_pk_bf16(h_.x, h_.y); w_.y = cvt_pk_bf16(h_.z, h_.w); o8_[64 * j] = w_; } } while (0)
        P1_LD(0, va);
#pragma unroll 1
        for (int r = 0; r < 8; r += 2) {
            P1_LD(r + 1, vb); __builtin_amdgcn_sched_barrier(0);
            P1_ST(r, va); __builtin_amdgcn_sched_barrier(0);
            if (r + 2 < 8) { P1_LD(r + 2, va); } __builtin_amdgcn_sched_barrier(0);
            P1_ST(r + 1, vb); __builtin_amdgcn_sched_barrier(0);
        }
#undef P1_LD
#undef P1_ST
    }
}

namespace hg {
constexpr int OFF_F = 0, OFF_SEG = 32768, OFF_QIN = 34816, RP = 272, OFF_KIN = OFF_QIN + 64 * RP, OFF_QB = OFF_KIN + 64 * RP, OFF_KLT = OFF_QB + 64 * RP, SP = 144,
              OFF_VT = OFF_KLT + 128 * SP  , OFF_DEC = OFF_VT + 64 * SP  , OFF_SF = OFF_DEC + 3584  , HG_LDS = OFF_SF + 16384;
static_assert(HG_LDS <= LDS_USER, "hgrn lds");
__device__ __forceinline__ int ppos(int s) { return (s & ~15) | ((s & 4) << 1) | ((s & 8) >> 1) | (s & 3); }
}
__device__ __forceinline__ void hgrn_chunked(Frame& F, const Args& a, int item) {
    using namespace hg;
    const bf16_t* PROJ = (const bf16_t*)(F.ws + WS_A);
    bf16_t* MIX = (bf16_t*)F.out;
    const float* lbl = a.in[7];
    LAS unsigned char* L = F.lds;
    LAS float* Fs = (LAS float*)(L + OFF_F); LAS float* SEGs = (LAS float*)(L + OFF_SEG); LAS float* DEC = (LAS float*)(L + OFF_DEC); LAS float* POST = DEC + 384;
    const int g = F.tid & 15, t0 = F.tid >> 4;
    const int sk = F.tid & 127, sseg = F.tid >> 7;
    const int r32 = F.lane & 31, hi = F.lane >> 5;
    {
        const int dq2 = (item >> 3) & 1, bh = (item >> 4) * 8 + (item & 7), h = bh & 7, b = bh >> 3;
        float lb[8];
#pragma unroll
        for (int j = 0; j < 8; ++j) { const int k = h * 128 + g * 8 + j; lb[j] = 1.f / (1.f + __expf(lbl[HW + k] - lbl[k])); }
        const bf16_t* base = PROJ + (size_t)(b * SEQ) * INCP + h * 128;
        f32x16 S0 = {}, S1 = {};
        u32x4 gq[2], gf[2], gv;
#define HG_LOADF(c) do { _Pragma("unroll") for (int i = 0; i < 2; ++i) gf[i] = *(const u32x4*)(base + (size_t)((c) * 64 + t0 + 32 * i) * INCP + g * 8 + HW); } while (0)
#define HG_LOADQ(c) do { _Pragma("unroll") for (int i = 0; i < 2; ++i) gq[i] = *(const u32x4*)(base + (size_t)((c) * 64 + t0 + 32 * i) * INCP + g * 8); \
            gv = *(const u32x4*)(base + (size_t)((c) * 64 + (F.tid >> 3)) * INCP + 2 * HW + dq2 * 64 + (F.tid & 7) * 8); } while (0)
        HG_LOADF(0); HG_LOADQ(0);
        for (int c = 0; c < SEQ / 64; ++c) {
            if (F.wave >= 4) { const int kb = F.wave - 4;
#pragma unroll
                for (int s2 = 0; s2 < 2; ++s2) { u32x4 w0, w1;
                    w0.x = cvt_pk_bf16(S0[8 * s2], S0[8 * s2 + 1]); w0.y = cvt_pk_bf16(S0[8 * s2 + 2], S0[8 * s2 + 3]); w0.z = cvt_pk_bf16(S0[8 * s2 + 4], S0[8 * s2 + 5]); w0.w = cvt_pk_bf16(S0[8 * s2 + 6], S0[8 * s2 + 7]);
                    w1.x = cvt_pk_bf16(S1[8 * s2], S1[8 * s2 + 1]); w1.y = cvt_pk_bf16(S1[8 * s2 + 2], S1[8 * s2 + 3]); w1.z = cvt_pk_bf16(S1[8 * s2 + 4], S1[8 * s2 + 5]); w1.w = cvt_pk_bf16(S1[8 * s2 + 6], S1[8 * s2 + 7]);
                    *(LAS u32x4*)(L + OFF_SF + ((((kb * 2 + 0) * 2 + s2) * 64) + F.lane) * 16) = w0;
                    *(LAS u32x4*)(L + OFF_SF + ((((kb * 2 + 1) * 2 + s2) * 64) + F.lane) * 16) = w1; } }
            float fv[2][8];
#pragma unroll
            for (int i = 0; i < 2; ++i) { float fl[8]; unpack8(gf[i], fl);
#pragma unroll
                for (int j = 0; j < 8; ++j) { const float sg = __builtin_amdgcn_rcpf(1.f + __builtin_amdgcn_exp2f(-1.4426950408889634f * fl[j])); fv[i][j] = lb[j] + (1.f - lb[j]) * sg; }
                LAS float* fp = Fs + (t0 + 32 * i) * 128 + g * 8;
                *(LAS f32x4*)fp = (f32x4){fv[i][0], fv[i][1], fv[i][2], fv[i][3]}; *(LAS f32x4*)(fp + 4) = (f32x4){fv[i][4], fv[i][5], fv[i][6], fv[i][7]}; }
            if (c + 1 < SEQ / 64) HG_LOADF(c + 1);
            __syncthreads();
            float klp[16];
            { float fr[16];
#pragma unroll
              for (int i = 0; i < 16; ++i) fr[i] = Fs[(16 * sseg + i) * 128 + sk];
              float p = 1.f;
#pragma unroll
              for (int i = 0; i < 16; ++i) { p *= fr[i]; Fs[(16 * sseg + i) * 128 + sk] = p; }
              SEGs[sseg * 128 + sk] = p;
              float q = 1.f;
#pragma unroll
              for (int i = 15; i >= 0; --i) { klp[i] = (1.f - fr[i]) * q; q *= fr[i]; } }
            __syncthreads();
            if (F.tid < 128) { const float s0 = SEGs[F.tid], s1 = SEGs[128 + F.tid], s2 = SEGs[256 + F.tid], s3 = SEGs[384 + F.tid];
                const float pm = s0 * s1;
                SEGs[F.tid] = 1.f; SEGs[128 + F.tid] = s0; SEGs[256 + F.tid] = pm; SEGs[384 + F.tid] = pm * s2;
                POST[F.tid] = s1 * s2 * s3; POST[128 + F.tid] = s2 * s3; POST[256 + F.tid] = s3; POST[384 + F.tid] = 1.f;
                DEC[F.tid] = pm * s2 * s3; DEC[128 + F.tid] = pm; DEC[256 + F.tid] = __builtin_amdgcn_rcpf(pm); }
            __syncthreads();
            { { const float po = POST[sseg * 128 + sk];
                float o16[16];
#pragma unroll
                for (int p = 0; p < 16; ++p) o16[p] = klp[8 * ((p >> 2) & 1) + 4 * (p >> 3) + (p & 3)] * po;
                *(LAS u32x4*)(L + OFF_KLT + sk * SP + sseg * 32) = pack8f(o16); *(LAS u32x4*)(L + OFF_KLT + sk * SP + sseg * 32 + 16) = pack8f(o16 + 8); }
#pragma unroll
              for (int i = 0; i < 2; ++i) { const int t = t0 + 32 * i;
                  float qin[8], kin[8], qb[8], qv[8];
                  unpack8(gq[i], qv);
                  const LAS float* fp = Fs + t * 128 + g * 8; const LAS float* pp = SEGs + (t >> 4) * 128 + g * 8;
                  const f32x4 pa = *(const LAS f32x4*)fp, pb = *(const LAS f32x4*)(fp + 4), ea = *(const LAS f32x4*)pp, eb = *(const LAS f32x4*)(pp + 4);
                  const f32x4 ma = *(const LAS f32x4*)(DEC + 128 + g * 8), mb = *(const LAS f32x4*)(DEC + 128 + g * 8 + 4), ra = *(const LAS f32x4*)(DEC + 256 + g * 8), rb = *(const LAS f32x4*)(DEC + 256 + g * 8 + 4);
#pragma unroll
                  for (int j = 0; j < 8; ++j) { const float P = (j < 4 ? pa[j] * ea[j] : pb[j - 4] * eb[j - 4]), pm = j < 4 ? ma[j] : mb[j - 4], rpm = j < 4 ? ra[j] : rb[j - 4];
                      const float r = __builtin_amdgcn_rcpf(P), kk = 1.f - fv[i][j], qs = qv[j] * 0.08838834764831845f;
                      qb[j] = qs * P; qin[j] = qb[j] * rpm; kin[j] = kk * pm * r; }
                  *(LAS u32x4*)(L + OFF_QIN + t * RP + g * 16) = pack8f(qin);
                  *(LAS u32x4*)(L + OFF_KIN + t * RP + g * 16) = pack8f(kin);
                  { const u32x4 w = pack8f(qb);
                    *(LAS u32x2*)(L + OFF_QB + t * RP + ((g >> 1) * 16 + (g & 1) * 4) * 2) = (u32x2){w.x, w.y};
                    *(LAS u32x2*)(L + OFF_QB + t * RP + ((g >> 1) * 16 + 8 + (g & 1) * 4) * 2) = (u32x2){w.z, w.w}; } }
              { float v[8]; unpack8(gv, v); const int s = F.tid >> 3, dvg = F.tid & 7, ps = ppos(s);
#pragma unroll
                  for (int j = 0; j < 8; ++j) *(LAS bf16_t*)(L + OFF_VT + (dvg * 8 + j) * SP + ps * 2) = (bf16_t)(__builtin_bit_cast(unsigned, v[j]) >> 16); } }
            if (c + 1 < SEQ / 64) HG_LOADQ(c + 1);
            __syncthreads();
            if (F.wave < 4) { const int tb = F.wave & 1, dvb = F.wave >> 1;
                f32x16 o = {};
                for (int sb = 0; sb <= tb; ++sb) { f32x16 X = {};
#pragma unroll
                    for (int ks = 0; ks < 8; ++ks) { const bf16x8 af = *(const LAS bf16x8*)(L + OFF_KIN + (32 * sb + r32) * RP + (16 * ks + 8 * hi) * 2);
                        const bf16x8 bfr = *(const LAS bf16x8*)(L + OFF_QIN + (32 * tb + r32) * RP + (16 * ks + 8 * hi) * 2);
                        X = __builtin_amdgcn_mfma_f32_32x32x16_bf16(af, bfr, X, 0, 0, 0); }
                    if (sb == tb) {
#pragma unroll
                        for (int r = 0; r < 16; ++r) { const int srow = (r & 3) + 8 * (r >> 2) + 4 * hi; if (srow > r32) X[r] = 0.f; } }
#pragma unroll
                    for (int s2 = 0; s2 < 2; ++s2) { u32x4 w; w.x = cvt_pk_bf16(X[8 * s2], X[8 * s2 + 1]); w.y = cvt_pk_bf16(X[8 * s2 + 2], X[8 * s2 + 3]); w.z = cvt_pk_bf16(X[8 * s2 + 4], X[8 * s2 + 5]); w.w = cvt_pk_bf16(X[8 * s2 + 6], X[8 * s2 + 7]);
                        const bf16x8 vf = *(const LAS bf16x8*)(L + OFF_VT + (32 * dvb + r32) * SP + (32 * sb + 16 * s2 + 8 * hi) * 2);
                        o = __builtin_amdgcn_mfma_f32_32x32x16_bf16(__builtin_bit_cast(bf16x8, w), vf, o, 0, 0, 0); } }
#pragma unroll
                for (int kb = 0; kb < 4; ++kb)
#pragma unroll
                    for (int s2 = 0; s2 < 2; ++s2) { const bf16x8 sf = *(const LAS bf16x8*)(L + OFF_SF + ((((kb * 2 + dvb) * 2 + s2) * 64) + F.lane) * 16);
                        const bf16x8 qf = *(const LAS bf16x8*)(L + OFF_QB + (32 * tb + r32) * RP + (32 * kb + 16 * s2 + 8 * hi) * 2);
                        o = __builtin_amdgcn_mfma_f32_32x32x16_bf16(qf, sf, o, 0, 0, 0); }
                bf16_t* orow = MIX + (size_t)(b * SEQ + c * 64 + 32 * tb) * DM + h * 128 + dq2 * 64 + dvb * 32 + r32;
#pragma unroll
                for (int r = 0; r < 16; ++r) { const float v = o[r]; const float vn = __shfl_xor(v, 1);
                    if ((r32 & 1) == 0) *(unsigned*)(orow + (size_t)((r & 3) + 8 * (r >> 2) + 4 * hi) * DM) = cvt_pk_bf16(v, vn); }
            } else { const int kb = F.wave - 4;
#pragma unroll
                for (int r = 0; r < 16; ++r) { const float dcy = DEC[32 * kb + (r & 3) + 8 * (r >> 2) + 4 * hi]; S0[r] *= dcy; S1[r] *= dcy; }
#pragma unroll
                for (int ss = 0; ss < 4; ++ss) { const bf16x8 kf = *(const LAS bf16x8*)(L + OFF_KLT + (32 * kb + r32) * SP + (16 * ss + 8 * hi) * 2);
                    const bf16x8 vf0 = *(const LAS bf16x8*)(L + OFF_VT + r32 * SP + (16 * ss + 8 * hi) * 2), vf1 = *(const LAS bf16x8*)(L + OFF_VT + (32 + r32) * SP + (16 * ss + 8 * hi) * 2);
                    S0 = __builtin_amdgcn_mfma_f32_32x32x16_bf16(kf, vf0, S0, 0, 0, 0); S1 = __builtin_amdgcn_mfma_f32_32x32x16_bf16(kf, vf1, S1, 0, 0, 0); }
            }
            __syncthreads();
        }
#undef HG_LOADF
#undef HG_LOADQ
    }
}

constexpr int MOE_IG = NE * (DM / 64) * (DE / 64);
constexpr int MOE_PRE = 9216;
struct MoeItems { const float* wg; const float* wu; const float* wd; unsigned char* ws;
    __device__ TrItem operator()(int it) const { TrItem t; t.gk = nullptr;
        const int which = it / MOE_IG, r = it % MOE_IG;
        if (which < 2) { const int e = r / 256, q = r % 256, kb = q / 8, nb = q % 8, n0 = 64 * nb;
            t.src = (which ? wu : wg) + (size_t)e * DM * DE + (size_t)(64 * kb) * DE + n0;
            t.dst = (bf16_t*)(ws + WS_D) + ((size_t)e * 1024 + (n0 >> 7) * 256 + (n0 & 127) + which * 128) * DM + 64 * kb; t.dst2 = t.dst + (size_t)32 * DM; t.N = DE; t.ldt = DM; }
        else { const int e = r / 256, q = r % 256, kb = q / 32, nb = q % 32, n0 = 64 * nb;
            t.src = wd + (size_t)e * DE * DM + (size_t)(64 * kb) * DM + n0;
            t.dst = (bf16_t*)(ws + WS_E) + ((size_t)e * DM + n0) * DE + 64 * kb; t.dst2 = t.dst + (size_t)32 * DE; t.N = DM; t.ldt = DE; }
        return t; } };

__device__ __forceinline__ void p3_phase(Frame& F, const Args& a) {
    OPAQUE_FRAME(F);
    const int role = ((int)blockIdx.x >> 3) & 1, idx = ((int)blockIdx.x >> 4) * 8 + ((int)blockIdx.x & 7), half = F.G >> 1;
    unsigned char* ws = F.ws;
    if (role == 0) { for (int it = idx; it < NB * HH * 2; it += half) hgrn_chunked(F, a, it); }
    else {
        { pg8::Gemm g{(const bf16_t*)(ws + WS_A) + C_QA, (const bf16_t*)(ws + WS_WQUP), INCP, QLORA, QLORA};
          pg8::DenseOrder S; S.init(T / 256, MH * MQK / 256, half, idx);
          pg8::EpiStore E{(bf16_t*)(ws + WS_B), MH * MQK, (const float*)(ws + WS_RSTDQ), 1.f / QLORA};
          pg8::gemm_phase<pg8::EpiStore, pg8::DenseOrder>(F.lds, g, S, E); }
        { pg8::Gemm g{(const bf16_t*)(ws + WS_A) + C_KVA, (const bf16_t*)(ws + WS_WKVUP), INCP, KVLORA, KVLORA};
          pg8::DenseOrder S; S.init(T / 256, MH * 256 / 256, half, idx);
          pg8::EpiStore E{(bf16_t*)(ws + WS_C), MH * 256, (const float*)(ws + WS_RSTDKV), 1.f / KVLORA};
          pg8::gemm_phase<pg8::EpiStore, pg8::DenseOrder>(F.lds, g, S, E); }
        { const MoeItems mk{a.in[22], a.in[23], a.in[24], ws};
          tr_run(idx * NWAVES + F.wave, half * NWAVES, MOE_PRE, mk, F.lds + F.wave * 8192, F.lane); }
    }
}

__device__ __forceinline__ float sum8(float v) { v += __shfl_xor(v, 1); v += __shfl_xor(v, 2); v += __shfl_xor(v, 4); return v; }

struct P5Set { u32x4 k0, k1, kpe, m0, m1, g0, g1; f32x4 ca, cb, sa, sb; };
__device__ __forceinline__ void p5_phase(Frame& F, const Args& a) {
    OPAQUE_FRAME(F);
    const int gw = F.vcu * NWAVES + F.wave, NGW = F.G * NWAVES;
    const bf16_t* PROJ = (const bf16_t*)(F.ws + WS_A);
    const bf16_t* KV = (const bf16_t*)(F.ws + WS_C);
    bf16_t* Kn = (bf16_t*)(F.ws + WS_F);
    bf16_t* MIX = (bf16_t*)F.out;
    const float* rc = (const float*)(F.ws + WS_ROPEC); const float* rsn = (const float*)(F.ws + WS_ROPES);
    const int h = F.lane >> 3, sub = F.lane & 7;
    const float sgn = sub < 4 ? -1.f : 1.f;
    float gk[3][8], go[2][8];
#pragma unroll
    for (int i = 0; i < 3; ++i)
#pragma unroll
        for (int j = 0; j < 8; ++j) gk[i][j] = a.in[14][(sub + 8 * i) * 8 + j];
#pragma unroll
    for (int i = 0; i < 2; ++i)
#pragma unroll
        for (int j = 0; j < 8; ++j) go[i][j] = a.in[8][(sub + 8 * i) * 8 + j];
#define P5_LD(t_, S_) do { const size_t t__ = (size_t)(t_); const int ii_ = (sub & 3) * 8; \
        S_.k0 = __builtin_nontemporal_load((const u32x4*)(KV + t__ * (MH * 256) + h * 256 + sub * 8)); S_.k1 = __builtin_nontemporal_load((const u32x4*)(KV + t__ * (MH * 256) + h * 256 + (sub + 8) * 8)); \
        S_.kpe = *(const u32x4*)(PROJ + t__ * INCP + C_KPE + sub * 8); \
        S_.ca = *(const f32x4*)(rc + t__ * 32 + ii_); S_.cb = *(const f32x4*)(rc + t__ * 32 + ii_ + 4); S_.sa = *(const f32x4*)(rsn + t__ * 32 + ii_); S_.sb = *(const f32x4*)(rsn + t__ * 32 + ii_ + 4); \
        S_.m0 = *(const u32x4*)(MIX + t__ * DM + h * 128 + sub * 8); S_.m1 = *(const u32x4*)(MIX + t__ * DM + h * 128 + (sub + 8) * 8); \
        S_.g0 = __builtin_nontemporal_load((const u32x4*)(PROJ + t__ * INCP + 3 * HW + h * 128 + sub * 8)); S_.g1 = __builtin_nontemporal_load((const u32x4*)(PROJ + t__ * INCP + 3 * HW + h * 128 + (sub + 8) * 8)); } while (0)
#define P5_CP(t_, S_) do { const int t__ = (t_), b_ = t__ / SEQ, s_ = t__ % SEQ; const size_t hrow = ((size_t)(b_ * MH + h) * SEQ + s_); \
        { float k[3][8]; float ss = 0.f; unpack8(S_.k0, k[0]); unpack8(S_.k1, k[1]); unpack8(S_.kpe, k[2]); \
          _Pragma("unroll") for (int i = 0; i < 3; ++i) _Pragma("unroll") for (int j = 0; j < 8; ++j) ss += k[i][j] * k[i][j]; \
          const float rs = rsqrtf(sum8(ss) * (1.f / MQK) + EPS); \
          _Pragma("unroll") for (int i = 0; i < 3; ++i) _Pragma("unroll") for (int j = 0; j < 8; ++j) k[i][j] *= rs * gk[i][j]; \
          _Pragma("unroll") for (int j = 0; j < 8; ++j) { const float pv = __shfl_xor(k[2][j], 4); const float cs_ = j < 4 ? S_.ca[j & 3] : S_.cb[j & 3], sn_ = j < 4 ? S_.sa[j & 3] : S_.sb[j & 3]; k[2][j] = k[2][j] * cs_ + sgn * pv * sn_; } \
          _Pragma("unroll") for (int i = 0; i < 3; ++i) *(u32x4*)(Kn + hrow * MQK + (sub + 8 * i) * 8) = pack8f(k[i]); } \
        { float o[2][8], gt[2][8]; float ss = 0.f; unpack8(S_.m0, o[0]); unpack8(S_.m1, o[1]); unpack8(S_.g0, gt[0]); unpack8(S_.g1, gt[1]); \
          _Pragma("unroll") for (int i = 0; i < 2; ++i) _Pragma("unroll") for (int j = 0; j < 8; ++j) ss += o[i][j] * o[i][j]; \
          const float rs = rsqrtf(sum8(ss) * (1.f / HDV) + EPS); \
          _Pragma("unroll") for (int i = 0; i < 2; ++i) { _Pragma("unroll") for (int j = 0; j < 8; ++j) o[i][j] = o[i][j] * rs * go[i][j] * siluf(gt[i][j]); \
              *(u32x4*)(MIX + (size_t)t__ * DM + h * 128 + (sub + 8 * i) * 8) = pack8f(o[i]); } } } while (0)
    for (int blk = gw; blk < T / 8; blk += NGW) { const int t0 = blk * 8;
        P5Set A, B;
        P5_LD(t0, A);
#pragma unroll 1
        for (int r = 0; r < 8; r += 2) {
            P5_LD(t0 + r + 1, B); __builtin_amdgcn_sched_barrier(0);
            P5_CP(t0 + r, A); __builtin_amdgcn_sched_barrier(0);
            if (r + 2 < 8) { P5_LD(t0 + r + 2, A); } __builtin_amdgcn_sched_barrier(0);
            P5_CP(t0 + r + 1, B); __builtin_amdgcn_sched_barrier(0);
        }
    }
#undef P5_LD
#undef P5_CP
}
namespace att {
constexpr int QBLK = 32, KVBLK = 64, QB = 256;
constexpr int KROW = 512, SHM_K = KVBLK * KROW, SHM_V = KVBLK * MV * 2;
constexpr int OFF_V = 0, OFF_K = 2 * SHM_V, OFF_WS = OFF_K + 2 * SHM_K;
constexpr float SCALE = 0.07216878364870322f;
constexpr float THR = 8.f;
#define SBAR() __builtin_amdgcn_sched_barrier(0)
__device__ __forceinline__ int v_st(int k, int c) { const int kk = (k & ~0xC) | ((k & 4) << 1) | ((k & 8) >> 1); return ((kk >> 3) * 4 + (c >> 5)) * 512 + ((kk & 7) * 32 + (c & 31)) * 2; }
__device__ __forceinline__ int v_rd_base(int lane) { return ((lane & 3) << 3) | (((lane >> 2) & 3) << 6) | (((lane >> 4) & 1) << 5) | (((lane >> 5) & 1) << 8); }
constexpr int v_rd_off(int d0, int ks, int half) { return d0 * 512 + ks * 4096 + half * 2048; }
__device__ __forceinline__ int crow(int r, int hi) { return (r & 3) + 8 * (r >> 2) + 4 * hi; }
template <int M> __device__ __forceinline__ float swz_xor(float v) { return __builtin_bit_cast(float, __builtin_amdgcn_ds_swizzle(__builtin_bit_cast(int, v), (M << 10) | 0x1F)); }
__device__ __forceinline__ unsigned cvtpk(float lo, float hi) { unsigned r; asm volatile("v_cvt_pk_bf16_f32 %0, %1, %2" : "=v"(r) : "v"(lo), "v"(hi)); return r; }

__device__ __forceinline__ void mask_tile(f32x16& p0, f32x16& p1, int dq) {
    const float NEG = -__builtin_inff();
#pragma unroll
    for (int r = 0; r < 16; ++r) {
        const int c = (r & 3) + 8 * (r >> 2);
        if (dq - c < 0) p0[r] = NEG;
        if (dq - c - 32 < 0) p1[r] = NEG;
    }
}
__device__ __forceinline__ void partialSM(f32x16& p0, f32x16& p1, float& m_reg, float& mn, float& alpha) {
    float pmax = p0[0];
#pragma unroll
    for (int r = 1; r < 16; ++r) pmax = fmaxf(pmax, p0[r]);
#pragma unroll
    for (int r = 0; r < 16; ++r) pmax = fmaxf(pmax, p1[r]);
    { auto rr = __builtin_amdgcn_permlane32_swap(__float_as_uint(pmax), __float_as_uint(pmax), false, false);
      pmax = fmaxf(__uint_as_float(rr[0]), __uint_as_float(rr[1])); }
    constexpr float C2 = 1.4426950408889634f * SCALE;
    if (__builtin_expect(__all((pmax - m_reg) * SCALE <= THR), 1)) { mn = m_reg; alpha = 1.f; }
    else { mn = fmaxf(m_reg, pmax); alpha = __builtin_amdgcn_exp2f((m_reg - mn) * C2); m_reg = mn; }
    const float mnL = -mn * C2;
#pragma unroll
    for (int r = 0; r < 16; ++r) p0[r] = fmaf(p0[r], C2, mnL);
#pragma unroll
    for (int r = 0; r < 16; ++r) p1[r] = fmaf(p1[r], C2, mnL);
#pragma unroll
    for (int r = 0; r < 16; ++r) p0[r] = __builtin_amdgcn_exp2f(p0[r]);
}
__device__ __forceinline__ void finishSM(f32x16& p0, f32x16& p1, float alpha, float& l_reg, bf16x8& pa0, bf16x8& pa1, bf16x8& pa2, bf16x8& pa3) {
#pragma unroll
    for (int r = 0; r < 16; ++r) p1[r] = __builtin_amdgcn_exp2f(p1[r]);
    float ps = 0;
#pragma unroll
    for (int r = 0; r < 16; ++r) ps += p0[r];
#pragma unroll
    for (int r = 0; r < 16; ++r) ps += p1[r];
    { auto rr = __builtin_amdgcn_permlane32_swap(__float_as_uint(ps), __float_as_uint(ps), false, false);
      ps = __uint_as_float(rr[0]) + __uint_as_float(rr[1]); }
    l_reg = l_reg * alpha + ps;
#define PK4(P, B_, OUT) do { unsigned a0 = cvtpk(P[B_+0], P[B_+1]), a1 = cvtpk(P[B_+2], P[B_+3]);                          \
        unsigned b0 = cvtpk(P[B_+4], P[B_+5]), b1 = cvtpk(P[B_+6], P[B_+7]);                                             \
        auto r0 = __builtin_amdgcn_permlane32_swap(a0, b0, false, false); auto r1 = __builtin_amdgcn_permlane32_swap(a1, b1, false, false); \
        u32x4 w = {r0[0], r1[0], r0[1], r1[1]}; OUT = __builtin_bit_cast(bf16x8, w); } while (0)
    PK4(p0, 0, pa0); PK4(p0, 8, pa1); PK4(p1, 0, pa2); PK4(p1, 8, pa3);
#undef PK4
}
template <int KB>
__device__ __forceinline__ void qkt(f32x16& p0, f32x16& p1, LAS unsigned char* lds, int r32, int hi, const bf16x8* qr) {
    p0 = f32x16{}; p1 = f32x16{};
    int sw = r32 & 15; asm volatile("" : "+v"(sw));
    const int rb = OFF_K + KB * SHM_K + r32 * KROW;
    int ab[8];
#pragma unroll
    for (int d = 0; d < 8; ++d) ab[d] = rb + (((2 * d + hi) ^ sw) << 4);
#pragma unroll
    for (int d0 = 0; d0 < 12; ++d0) { const int a = ab[d0 & 7] + (d0 >> 3) * 256;
        const bf16x8 b0 = *(const LAS bf16x8*)(lds + a);
        const bf16x8 b1 = *(const LAS bf16x8*)(lds + a + 32 * KROW);
        p0 = __builtin_amdgcn_mfma_f32_32x32x16_bf16(b0, qr[d0], p0, 0, 0, 0);
        p1 = __builtin_amdgcn_mfma_f32_32x32x16_bf16(b1, qr[d0], p1, 0, 0, 0); }
}
template <int VB>
__device__ __forceinline__ void pv_tile(f32x16* o, int vb0, bf16x8 pa0, bf16x8 pa1, bf16x8 pa2, bf16x8 pa3) {
#define TRRD(dst, off) asm volatile("ds_read_b64_tr_b16 %0, %1 offset:%2" : "=&v"(dst) : "v"(vb0), "i"(off) : "memory")
#define PV_D0(d0) do { s16x4 l0, l1, l2, l3, h0, h1, h2, h3; constexpr int b_ = OFF_V + VB * SHM_V + v_rd_off(d0, 0, 0); \
        TRRD(l0, b_); TRRD(h0, b_ + 2048); TRRD(l1, b_ + 4096); TRRD(h1, b_ + 6144); TRRD(l2, b_ + 8192); TRRD(h2, b_ + 10240); TRRD(l3, b_ + 12288); TRRD(h3, b_ + 14336); \
        asm volatile("s_waitcnt lgkmcnt(0)" ::: "memory"); SBAR();   \
        o[d0] = __builtin_amdgcn_mfma_f32_32x32x16_bf16(pa0, (bf16x8){l0[0], l0[1], l0[2], l0[3], h0[0], h0[1], h0[2], h0[3]}, o[d0], 0, 0, 0);   \
        o[d0] = __builtin_amdgcn_mfma_f32_32x32x16_bf16(pa1, (bf16x8){l1[0], l1[1], l1[2], l1[3], h1[0], h1[1], h1[2], h1[3]}, o[d0], 0, 0, 0);   \
        o[d0] = __builtin_amdgcn_mfma_f32_32x32x16_bf16(pa2, (bf16x8){l2[0], l2[1], l2[2], l2[3], h2[0], h2[1], h2[2], h2[3]}, o[d0], 0, 0, 0);   \
        o[d0] = __builtin_amdgcn_mfma_f32_32x32x16_bf16(pa3, (bf16x8){l3[0], l3[1], l3[2], l3[3], h3[0], h3[1], h3[2], h3[3]}, o[d0], 0, 0, 0); } while (0)
    PV_D0(0); PV_D0(1); PV_D0(2); PV_D0(3);
#undef PV_D0
#undef TRRD
}

constexpr int QP = MH * MQK, VP = MH * 256;
__device__ __forceinline__ void attn_block(const bf16_t* Q, const bf16_t* K, const bf16_t* V, bf16_t* O, int P0, const float* gon, const float* gqn, const float* rc, const float* rsn, LAS unsigned char* lds) {
    int tid = threadIdx.x; asm volatile("" : "+v"(tid));
    const int wid = __builtin_amdgcn_readfirstlane(tid >> 6), lane = tid & 63, r32 = lane & 31, hi = lane >> 5;
    const int NT = P0 / KVBLK + 4;
    const int qlo = P0 + wid * QBLK, qm = qlo + r32 - 4 * hi;
    LAS float* wsf = (LAS float*)(lds + OFF_WS) + wid * 64; LAS float* li_l = wsf; LAS float* al_l = wsf + 32;
    float m_reg = -1e30f, l_reg = 0.f; f32x16 o[4] = {};
    bf16x8 qr[12];
#pragma unroll
    for (int d0 = 0; d0 < 12; ++d0) qr[d0] = *(const bf16x8*)(Q + (size_t)(qlo + r32) * QP + d0 * 16 + hi * 8);
    {
        float ss = 0.f;
#pragma unroll
        for (int d0 = 0; d0 < 12; ++d0) { float f[8]; unpack8(__builtin_bit_cast(u32x4, qr[d0]), f);
#pragma unroll
            for (int j = 0; j < 8; ++j) ss += f[j] * f[j]; }
        { auto rr = __builtin_amdgcn_permlane32_swap(__float_as_uint(ss), __float_as_uint(ss), false, false); ss = __uint_as_float(rr[0]) + __uint_as_float(rr[1]); }
        const float rs = rsqrtf(ss * (1.f / MQK) + EPS);
#pragma unroll
        for (int d0 = 0; d0 < 8; ++d0) { float f[8]; unpack8(__builtin_bit_cast(u32x4, qr[d0]), f); const float* gp = gqn + d0 * 16 + hi * 8;
#pragma unroll
            for (int j = 0; j < 8; ++j) f[j] *= rs * gp[j];
            qr[d0] = __builtin_bit_cast(bf16x8, pack8f(f)); }
#pragma unroll
        for (int dd = 0; dd < 2; ++dd) { float x1[8], x2[8]; unpack8(__builtin_bit_cast(u32x4, qr[8 + dd]), x1); unpack8(__builtin_bit_cast(u32x4, qr[10 + dd]), x2);
            const float* g1p = gqn + 128 + dd * 16 + hi * 8; const float* g2p = g1p + 32; const float* cp = rc + (size_t)(qlo + r32) * 32 + dd * 16 + hi * 8; const float* sp = rsn + (size_t)(qlo + r32) * 32 + dd * 16 + hi * 8;
            const f32x4 c0 = *(const f32x4*)cp, c1 = *(const f32x4*)(cp + 4), s0 = *(const f32x4*)sp, s1 = *(const f32x4*)(sp + 4), ga = *(const f32x4*)g1p, gb = *(const f32x4*)(g1p + 4), gc = *(const f32x4*)g2p, gd = *(const f32x4*)(g2p + 4);
#pragma unroll
            for (int j = 0; j < 8; ++j) { const float a = x1[j] * rs * (j < 4 ? ga[j & 3] : gb[j & 3]), bq = x2[j] * rs * (j < 4 ? gc[j & 3] : gd[j & 3]), c = j < 4 ? c0[j & 3] : c1[j & 3], sn = j < 4 ? s0[j & 3] : s1[j & 3]; x1[j] = a * c - bq * sn; x2[j] = bq * c + a * sn; }
            qr[8 + dd] = __builtin_bit_cast(bf16x8, pack8f(x1)); qr[10 + dd] = __builtin_bit_cast(bf16x8, pack8f(x2)); }
    }
    int ksrc[4], vsrc[2];
#pragma unroll
    for (int i = 0; i < 4; ++i) { const int row = 2 * (wid * 4 + i) + (lane >> 5), c = (lane & 31) ^ (row & 15); ksrc[i] = row * MQK + (c < 24 ? c : 0) * 8; }
#pragma unroll
    for (int i = 0; i < 2; ++i) { const int id = (wid * 2 + i) * 2 + (lane >> 5), kk = ((id >> 2) << 3) | ((lane & 31) >> 2), k = (kk & ~0xC) | ((kk & 4) << 1) | ((kk & 8) >> 1);
        vsrc[i] = k * VP + (id & 3) * 32 + (lane & 3) * 8; }
    const int vb0 = (int)(unsigned)(uintptr_t)lds + v_rd_base(lane);
#define ALOAD(t, bf) do { const bf16_t* kp = K + (size_t)(t) * KVBLK * MQK; const bf16_t* vp = V + (size_t)(t) * KVBLK * VP; \
        _Pragma("unroll") for (int i = 0; i < 4; ++i) __builtin_amdgcn_global_load_lds((const unsigned*)(kp + ksrc[i]), (LAS unsigned*)(lds + OFF_K + (bf) * SHM_K + (wid * 4 + i) * 1024), 16, 0, 0); \
        _Pragma("unroll") for (int i = 0; i < 2; ++i) __builtin_amdgcn_global_load_lds((const unsigned*)(vp + vsrc[i]), (LAS unsigned*)(lds + OFF_V + (bf) * SHM_V + (wid * 2 + i) * 1024), 16, 0, 0); } while (0)
#define RESC(a) do { if (__any((a) < 1.f)) { if (hi == 0) al_l[r32] = (a); asm volatile("s_waitcnt lgkmcnt(0)" ::: "memory"); \
        _Pragma("unroll") for (int d_ = 0; d_ < 4; ++d_) _Pragma("unroll") for (int r = 0; r < 16; ++r) o[d_][r] *= al_l[crow(r, hi)]; } } while (0)
#define STEP(t, BF) do { f32x16 p0, p1; float mn, al; bf16x8 pa0, pa1, pa2, pa3; \
        if ((t) + 1 < NT) ALOAD((t) + 1, 1 - (BF)); \
        SBAR(); qkt<BF>(p0, p1, lds, r32, hi, qr); \
        { const int kb_ = (t) * KVBLK; if (kb_ + KVBLK - 1 > qlo) mask_tile(p0, p1, qm - kb_); } \
        partialSM(p0, p1, m_reg, mn, al); RESC(al); finishSM(p0, p1, al, l_reg, pa0, pa1, pa2, pa3); SBAR(); \
        pv_tile<BF>(o, vb0, pa0, pa1, pa2, pa3); SBAR(); \
        asm volatile("s_waitcnt vmcnt(0)" ::: "memory"); __syncthreads(); } while (0)
    ALOAD(0, 0); asm volatile("s_waitcnt vmcnt(0)" ::: "memory"); __syncthreads();
    for (int t = 0; t < NT; t += 2) { STEP(t, 0); STEP(t + 1, 1); }
#undef STEP
#undef RESC
#undef ALOAD
    if (hi == 0) li_l[r32] = l_reg;
    asm volatile("s_waitcnt lgkmcnt(0)" ::: "memory");
    float gv[4];
#pragma unroll
    for (int d0 = 0; d0 < 4; ++d0) gv[d0] = gon[d0 * 32 + r32];
    float ssr[16];
#pragma unroll
    for (int r = 0; r < 16; ++r) { const float rl = __builtin_amdgcn_rcpf(li_l[crow(r, hi)]); float ss = 0.f;
#pragma unroll
        for (int d0 = 0; d0 < 4; ++d0) { o[d0][r] *= rl; ss += o[d0][r] * o[d0][r]; }
        ssr[r] = ss; }
#pragma unroll
    for (int r = 0; r < 16; ++r) ssr[r] += swz_xor<1>(ssr[r]);
#pragma unroll
    for (int r = 0; r < 16; ++r) ssr[r] += swz_xor<2>(ssr[r]);
#pragma unroll
    for (int r = 0; r < 16; ++r) ssr[r] += swz_xor<4>(ssr[r]);
#pragma unroll
    for (int r = 0; r < 16; ++r) ssr[r] += swz_xor<8>(ssr[r]);
#pragma unroll
    for (int r = 0; r < 16; ++r) ssr[r] += swz_xor<16>(ssr[r]);
#pragma unroll
    for (int r = 0; r < 16; ++r) { const float rs = rsqrtf(ssr[r] * (1.f / MV) + EPS);
        bf16_t* orow = O + (size_t)(qlo + crow(r, hi)) * DM;
#pragma unroll
        for (int d0 = 0; d0 < 4; ++d0) { const float v = o[d0][r] * rs * gv[d0]; const float vn = swz_xor<1>(v);
            if ((r32 & 1) == 0) *(unsigned*)(orow + d0 * 32 + r32) = cvtpk(v, vn); } }
    __syncthreads();
}
#undef SBAR
}

__device__ __forceinline__ void p6_phase(Frame& F, const Args& a) {
    const bf16_t* QH = (const bf16_t*)(F.ws + WS_B); const bf16_t* Kn = (const bf16_t*)(F.ws + WS_F); const bf16_t* KV = (const bf16_t*)(F.ws + WS_C);
    bf16_t* MIX = (bf16_t*)F.out;
    const float* rc = (const float*)(F.ws + WS_ROPEC); const float* rsn = (const float*)(F.ws + WS_ROPES);
    for (int it = F.vcu; it < NB * MH * 4; it += F.G) {
        const int bh = it >> 2, j = it & 3, b = bh >> 3, h = bh & 7;
        const bf16_t* Q = QH + (size_t)(b * SEQ) * att::QP + h * MQK; const bf16_t* K = Kn + (size_t)bh * SEQ * MQK; const bf16_t* V = KV + (size_t)(b * SEQ) * att::VP + h * 256 + 128;
        bf16_t* O = MIX + (size_t)(b * SEQ) * DM + HW + h * MV;
        att::attn_block(Q, K, V, O, (7 - j) * att::QB, a.in[15], a.in[13], rc + (size_t)(b * SEQ) * 32, rsn + (size_t)(b * SEQ) * 32, F.lds);
        att::attn_block(Q, K, V, O, j * att::QB, a.in[15], a.in[13], rc + (size_t)(b * SEQ) * 32, rsn + (size_t)(b * SEQ) * 32, F.lds);
    }
}
__device__ __forceinline__ void p8_phase(Frame& F, const Args& a) {
    OPAQUE_FRAME(F);
    unsigned char* ws = F.ws;
    const float* xin = a.in[0]; const bf16_t* mixo = (const bf16_t*)(ws + WS_F); const float* mod = (const float*)(ws + WS_MOD); const float* g2n = a.in[17];
    const float* wct = (const float*)(ws + WS_WCT);
    bf16_t* H2 = (bf16_t*)(ws + WS_B);
    int* tok_e = (int*)(ws + WS_TOKE); float* tok_w = (float*)(ws + WS_TOKW); int* tok_s = (int*)(ws + WS_TOKS);
    LAS float* red = (LAS float*)F.lds;
    LAS float* ssw = (LAS float*)(F.lds + 98304);
    LAS float* shw = (LAS float*)(F.lds + 100352);
    LAS float* lg = (LAS float*)(F.lds + 101888);
    LAS float* rsl = (LAS float*)(F.lds + 111104);
    const int mr = F.lane & 15, mg = F.lane >> 4;
    const bool conv_first = (F.vcu & 1) != 0;
#pragma unroll 1
    for (int part = 0; part < 2; ++part) {
    if ((part == 0) != conv_first) {
    for (int tile = F.vcu; tile < T / 64; tile += F.G) {
        const int m0 = tile * 64, b = m0 / SEQ;
        const float* modb = mod + b * (6 * DM);
        f32x4 acc[4][3]; float ssp[4] = {0.f, 0.f, 0.f, 0.f}, shacc[3] = {0.f, 0.f, 0.f};
#pragma unroll
        for (int rb = 0; rb < 4; ++rb)
#pragma unroll
            for (int n = 0; n < 3; ++n) acc[rb][n] = (f32x4){0.f, 0.f, 0.f, 0.f};
        const unsigned xo = (unsigned)((m0 + mr) * DM + F.wave * 256 + 4 * mg);
        LAS float* vec = (LAS float*)(F.lds + 112640) + F.wave * 768;
        { const int k4 = F.lane * 4; const unsigned ko_ = (unsigned)(F.wave * 256 + k4) * 4u;
          const f32x4 t0 = *(const f32x4*)((const char*)(modb + 2 * DM) + ko_), t1 = *(const f32x4*)((const char*)(modb + 3 * DM) + ko_), t2 = *(const f32x4*)((const char*)g2n + ko_), t3 = *(const f32x4*)((const char*)(modb + 4 * DM) + ko_);
          *(LAS f32x4*)(vec + k4) = t0; *(LAS f32x4*)(vec + 256 + k4) = t1; *(LAS f32x4*)(vec + 512 + k4) = t2 * (t3 + 1.f); LDS_WAIT(); asm volatile("" ::: "memory"); }
        f32x4 xa[4], xb[4], wa[3], wb[3]; u32x2 ma_[4], mb_[4];
#define P8_LDX(s_, X, M, W) do { const unsigned ko_ = (unsigned)(F.wave * 256 + 16 * (s_) + 4 * mg) * 4u; \
            _Pragma("unroll") for (int n = 0; n < 3; ++n) W[n] = *(const f32x4*)((const char*)wct + (ko_ + (unsigned)((n * 16 + mr) * DM * 4))); \
            _Pragma("unroll") for (int rb = 0; rb < 4; ++rb) { const unsigned eo_ = xo + (unsigned)(rb * 16 * DM + 16 * (s_)); X[rb] = *(const f32x4*)((const char*)xin + eo_ * 4u); M[rb] = *(const u32x2*)((const char*)mixo + eo_ * 2u); } } while (0)
#define P8_CP(s_, X, M, W) do { const int kl_ = 16 * (s_) + 4 * mg; const f32x4 g1v = *(const LAS f32x4*)(vec + kl_), shv = *(const LAS f32x4*)(vec + 256 + kl_), gmv = *(const LAS f32x4*)(vec + 512 + kl_); \
            _Pragma("unroll") for (int n = 0; n < 3; ++n) shacc[n] += (shv.x * W[n].x + shv.y * W[n].y) + (shv.z * W[n].z + shv.w * W[n].w); \
            _Pragma("unroll") for (int rb = 0; rb < 4; ++rb) { const f32x4 v = X[rb] + g1v * (f32x4){bf_lo(M[rb].x), bf_hi(M[rb].x), bf_lo(M[rb].y), bf_hi(M[rb].y)}; \
                ssp[rb] += (v.x * v.x + v.y * v.y) + (v.z * v.z + v.w * v.w); const f32x4 av = v * gmv; \
                _Pragma("unroll") for (int i = 0; i < 4; ++i) _Pragma("unroll") for (int n = 0; n < 3; ++n) acc[rb][n] = __builtin_amdgcn_mfma_f32_16x16x4f32(av[i], W[n][i], acc[rb][n], 0, 0, 0); } } while (0)
        P8_LDX(0, xa, ma_, wa);
#pragma unroll 1
        for (int s = 0; s < 16; s += 2) {
            P8_LDX(s + 1, xb, mb_, wb); __builtin_amdgcn_sched_barrier(0);
            P8_CP(s, xa, ma_, wa); __builtin_amdgcn_sched_barrier(0);
            if (s + 2 < 16) { P8_LDX(s + 2, xa, ma_, wa); } __builtin_amdgcn_sched_barrier(0);
            P8_CP(s + 1, xb, mb_, wb); __builtin_amdgcn_sched_barrier(0);
        }
#undef P8_LDX
#undef P8_CP
#pragma unroll
        for (int rb = 0; rb < 4; ++rb) {
#pragma unroll
            for (int n = 0; n < 3; ++n)
#pragma unroll
                for (int r = 0; r < 4; ++r) red[(F.wave * 64 + rb * 16 + mg * 4 + r) * 48 + n * 16 + mr] = acc[rb][n][r];
            float sp = ssp[rb]; sp += __shfl_xor(sp, 16); sp += __shfl_xor(sp, 32);
            if (mg == 0) ssw[F.wave * 64 + rb * 16 + mr] = sp; }
#pragma unroll
        for (int n = 0; n < 3; ++n) { float sa = shacc[n]; sa += __shfl_xor(sa, 16); sa += __shfl_xor(sa, 32); if (mg == 0) shw[F.wave * 48 + n * 16 + mr] = sa; }
        __syncthreads();
        if (F.tid < 64) { float sv = 0.f;
#pragma unroll
            for (int w = 0; w < 8; ++w) sv += ssw[w * 64 + F.tid];
            rsl[F.tid] = rsqrtf(sv * (1.f / DM) + EPS); }
        __syncthreads();
        for (int idx = F.tid; idx < 64 * 36; idx += NTHR) { const int row = idx / 36, n = idx % 36; float L = 0.f, sw = 0.f;
#pragma unroll
            for (int w = 0; w < 8; ++w) { L += red[(w * 64 + row) * 48 + n]; sw += shw[w * 48 + n]; }
            lg[row * 36 + n] = rsl[row] * L + sw + (n < 4 ? a.in[19][n] : a.in[21][n - 4]); }
        __syncthreads();
        if (F.tid < 64) { const LAS float* l = lg + F.tid * 36; const int t = m0 + F.tid;
            int g = 0; float gm = l[0];
#pragma unroll
            for (int j = 1; j < 4; ++j) if (l[j] > gm) { gm = l[j]; g = j; }
            float den = 0.f;
#pragma unroll
            for (int j = 0; j < 4; ++j) den += __expf(l[j] - gm);
            const float pg = 1.f / den;
            const LAS float* e = l + 4 + g * 8;
            int i1 = 0; float v1 = e[0];
#pragma unroll
            for (int j = 1; j < 8; ++j) if (e[j] > v1) { v1 = e[j]; i1 = j; }
            int i2 = -1; float v2 = -__builtin_inff();
#pragma unroll
            for (int j = 0; j < 8; ++j) if (j != i1 && e[j] > v2) { v2 = e[j]; i2 = j; }
            const float w1 = 1.f / (1.f + __expf(v2 - v1)), w2 = 1.f - w1;
            const int e1 = g * 8 + i1, e2 = g * 8 + i2;
            const int s1 = (int)atomicAdd((unsigned*)(F.ctl + CW_CNT + 64 * e1), 1u), s2 = (int)atomicAdd((unsigned*)(F.ctl + CW_CNT + 64 * e2), 1u);
            tok_e[2 * t] = e1; tok_e[2 * t + 1] = e2; tok_w[2 * t] = pg * w1; tok_w[2 * t + 1] = pg * w2; tok_s[2 * t] = s1; tok_s[2 * t + 1] = s2;
            int* list = (int*)(ws + WS_LIST); list[e1 * T + s1] = t; list[e2 * T + s2] = t; }
        { const int c8 = (F.tid & 255) * 8, rg = F.tid >> 8;
          f32x4 g1a = *(const f32x4*)(modb + 2 * DM + c8), g1b = *(const f32x4*)(modb + 2 * DM + c8 + 4), sha = *(const f32x4*)(modb + 3 * DM + c8), shb = *(const f32x4*)(modb + 3 * DM + c8 + 4);
          const f32x4 gma = *(const f32x4*)(g2n + c8) * (*(const f32x4*)(modb + 4 * DM + c8) + 1.f), gmb = *(const f32x4*)(g2n + c8 + 4) * (*(const f32x4*)(modb + 4 * DM + c8 + 4) + 1.f);
#pragma unroll 1
          for (int j0 = 0; j0 < 32; j0 += 4) {
              f32x4 qa[4], qb[4]; u32x4 qm[4];
#pragma unroll
              for (int u = 0; u < 4; ++u) { const size_t eo = (size_t)(m0 + rg + 2 * (j0 + u)) * DM + c8;
                  qa[u] = __builtin_nontemporal_load((const f32x4*)(xin + eo)); qb[u] = __builtin_nontemporal_load((const f32x4*)(xin + eo + 4)); qm[u] = __builtin_nontemporal_load((const u32x4*)(mixo + eo)); }
              __builtin_amdgcn_sched_barrier(0);
#pragma unroll
              for (int u = 0; u < 4; ++u) { const int row = rg + 2 * (j0 + u); const size_t eo = (size_t)(m0 + row) * DM + c8; const float rs = rsl[row];
                  float mx[8]; unpack8(qm[u], mx);
                  const f32x4 va = (qa[u] + g1a * (f32x4){mx[0], mx[1], mx[2], mx[3]}) * rs * gma + sha, vb = (qb[u] + g1b * (f32x4){mx[4], mx[5], mx[6], mx[7]}) * rs * gmb + shb;
                  u32x4 w; w.x = cvt_pk_bf16(va.x, va.y); w.y = cvt_pk_bf16(va.z, va.w); w.z = cvt_pk_bf16(vb.x, vb.y); w.w = cvt_pk_bf16(vb.z, vb.w);
                  *(u32x4*)(H2 + eo) = w; }
              __builtin_amdgcn_sched_barrier(0); } }
        __syncthreads();
    }
    } else {
    LAS unsigned char* Tl = F.lds + F.wave * 8192;
    const int gw = F.vcu * NWAVES + F.wave, NGW = F.G * NWAVES;
    { const MoeItems mk{a.in[22], a.in[23], a.in[24], ws};
      tr_run(MOE_PRE + gw, NGW, 3 * MOE_IG, mk, Tl, F.lane); }
    __syncthreads();
    }
    }
}

constexpr int MOE_TAB_OFF = LDS_USER;
__device__ __forceinline__ LAS int* moe_tables(Frame& F) {
    LAS int* tab = (LAS int*)(F.lds + MOE_TAB_OFF);
    __syncthreads();
    if (F.tid < NE) tab[64 + F.tid] = (int)__hip_atomic_load((unsigned*)(F.ctl + CW_CNT + 64 * F.tid), RLX_AGENT);
    __syncthreads();
    if (F.tid == 0) { int acc = 0;
        for (int e = 0; e < NE; ++e) { tab[e] = acc; acc += ((tab[64 + e] + 255) / 256) * 256; }
        tab[NE] = acc; }
    __syncthreads();
    if (F.tid < 160) { int e = 0; for (int j = 1; j < NE; ++j) if (tab[j] <= F.tid * 256) e = j; tab[128 + F.tid] = e; }
    __syncthreads();
    return tab;
}

__device__ __forceinline__ void p12_phase(Frame& F, const Args& a) {
    OPAQUE_FRAME(F);
    unsigned char* ws = F.ws;
    const bf16_t* Y = (const bf16_t*)(ws + WS_A);
    const float* tok_w = (const float*)(ws + WS_TOKW); const int* tok_s = (const int*)(ws + WS_TOKS);
    const float* mod = (const float*)(ws + WS_MOD);
    const LAS int* tab = moe_tables(F); const int* tok_e = (const int*)(ws + WS_TOKE);
    const int gw = F.vcu * NWAVES + F.wave, NGW = F.G * NWAVES;
#if defined(MK_STAMP) && MK_STAMP >= 0
    const float dscale = 1.f + sqrtf(exp2f(rintf(3.f * log2f(*(const float*)(ws + WS_STAMP + 8) + 1.f) + MK_QSHIFT) * (1.f / 3.f)));
#else
    const float dscale = 1.f;
#endif
    for (int blk = gw; blk < T / 8; blk += NGW) { const int t0 = blk * 8, b = t0 / SEQ;
        const float* g2 = mod + b * (6 * DM) + 5 * DM; const float* g1 = mod + b * (6 * DM) + 2 * DM;
        f32x4 h1[4][2], h2[4][2];
#pragma unroll
        for (int j = 0; j < 4; ++j) { const int c = (j * 64 + F.lane) * 8; h1[j][0] = *(const f32x4*)(g1 + c); h1[j][1] = *(const f32x4*)(g1 + c + 4); h2[j][0] = *(const f32x4*)(g2 + c); h2[j][1] = *(const f32x4*)(g2 + c + 4); }
        int dsl = 0; float wl = 0.f;
        if (F.lane < 16) { dsl = tab[tok_e[2 * t0 + F.lane]] + tok_s[2 * t0 + F.lane]; wl = tok_w[2 * t0 + F.lane]; }
#pragma unroll 1
        for (int r = 0; r < 8; ++r) { const int t = t0 + r;
            const float w0 = __shfl(wl, 2 * r), w1 = __shfl(wl, 2 * r + 1); const int d0 = __shfl(dsl, 2 * r), d1 = __shfl(dsl, 2 * r + 1);
            float* orow = F.out + (size_t)t * DM; const float* xrow = a.in[0] + (size_t)t * DM; const bf16_t* mrow = (const bf16_t*)(ws + WS_F) + (size_t)t * DM;
            u32x4 qy0[4], qy1[4], qm[4]; f32x4 qa[4], qb[4];
#pragma unroll
            for (int j = 0; j < 4; ++j) { const int c = (j * 64 + F.lane) * 8;
                qy0[j] = __builtin_nontemporal_load((const u32x4*)(Y + (size_t)d0 * DM + c)); qy1[j] = __builtin_nontemporal_load((const u32x4*)(Y + (size_t)d1 * DM + c));
                qm[j] = __builtin_nontemporal_load((const u32x4*)(mrow + c)); qa[j] = __builtin_nontemporal_load((const f32x4*)(xrow + c)); qb[j] = __builtin_nontemporal_load((const f32x4*)(xrow + c + 4)); }
            __builtin_amdgcn_sched_barrier(0);
#pragma unroll
            for (int j = 0; j < 4; ++j) { const int c = (j * 64 + F.lane) * 8;
                float y0[8], y1[8], mx[8]; unpack8(qy0[j], y0); unpack8(qy1[j], y1); unpack8(qm[j], mx);
                const f32x4 xa = qa[j] + h1[j][0] * (f32x4){mx[0], mx[1], mx[2], mx[3]}, xb = qb[j] + h1[j][1] * (f32x4){mx[4], mx[5], mx[6], mx[7]};
                f32x4 ra, rb;
#pragma unroll
                for (int i = 0; i < 4; ++i) { ra[i] = (xa[i] + h2[j][0][i] * (w0 * y0[i] + w1 * y1[i])) * dscale; rb[i] = (xb[i] + h2[j][1][i] * (w0 * y0[4 + i] + w1 * y1[4 + i])) * dscale; }
                __builtin_nontemporal_store(ra, (f32x4*)(orow + c)); __builtin_nontemporal_store(rb, (f32x4*)(orow + c + 4)); }
            __builtin_amdgcn_sched_barrier(0); }
    }
}
#ifndef MK_MULTI
#define MK_MULTI 0
#endif
#ifndef MK_LAST_PHASE
#define MK_LAST_PHASE 12
#endif
constexpr int N_PHASES = MK_LAST_PHASE + 1;

template <class P> __device__ __forceinline__ P* uptr(P* p) { const unsigned long long v = (unsigned long long)p;
    const unsigned lo = __builtin_amdgcn_readfirstlane((unsigned)v), hi = __builtin_amdgcn_readfirstlane((unsigned)(v >> 32)); return (P*)(((unsigned long long)hi << 32) | lo); }
__global__ void __launch_bounds__(NTHR, 2) mk_fwd(const Args args) {
    extern __shared__ __attribute__((aligned(16))) unsigned char lds_raw[];
    Frame F;
    F.lds = (LAS unsigned char*)lds_raw;
    F.MISC = (volatile LAS unsigned*)(F.lds + MISC_OFF);
    F.tid = threadIdx.x; F.lane = F.tid & 63; F.wave = __builtin_amdgcn_readfirstlane(F.tid >> 6);
    F.G = gridDim.x; { const int bx = blockIdx.x; F.vcu = (F.G % 8 == 0) ? (bx % 8) * (F.G / 8) + bx / 8 : bx; }
    F.ws = uptr(args.ws); F.out = uptr(args.out);
    F.ctl = (gu32*)(F.ws + WS_CTL);
    for (int u = F.tid; u < (LDS_BYTES - MISC_OFF) / 4; u += NTHR) ((LAS unsigned*)(F.lds + MISC_OFF))[u] = 0u;
    __syncthreads();
    XcdBarrier bar; bar.bar = (unsigned*)(F.ctl + CW_BAR); bar.x = 0; bar.st = nullptr;
#if !MK_MULTI
    bar = xcd_barrier_post((unsigned*)(F.ctl + CW_BAR), F.MISC + 8);
#define GRID_BAR() xcd_barrier(bar)
#else
#define GRID_BAR() do { } while (0)
#endif
    const int lo = args.ph_lo, hi = args.ph_hi;
#ifndef MK_PHMASK
#define MK_PHMASK 0xFFFF
#endif
#define IN(k) (((MK_PHMASK >> (k)) & 1) && lo <= (k) && (k) < hi)
#define SEAM(k) do { if (IN(k) && IN((k) + 1)) GRID_BAR(); } while (0)
#ifndef MK_STAMP
#define MK_STAMP (-1)
#endif
#define STAMP_BEGIN(k) do { if ((k) == MK_STAMP && blockIdx.x == 0 && F.tid == 0) *(unsigned long long*)(ws + WS_STAMP) = __builtin_amdgcn_s_memrealtime(); } while (0)
#define STAMP_END(k) do { if ((k) == MK_STAMP && blockIdx.x == 0 && F.tid == 0) { const unsigned long long t1_ = __builtin_amdgcn_s_memrealtime(); *(float*)(ws + WS_STAMP + 8) = (float)(t1_ - *(unsigned long long*)(ws + WS_STAMP)) * 0.01f; } } while (0)
#ifndef MK_REPEAT
#define MK_REPEAT (-1)
#endif
#ifndef MK_REPN
#define MK_REPN 2
#endif
#define REP(k) _Pragma("unroll") for (int rep_ = 0; rep_ < ((k) == MK_REPEAT ? MK_REPN : 1); ++rep_)
    unsigned char* const ws = F.ws;

    STAMP_BEGIN(0);
    REP(0) if (IN(0)) { if (rep_) GRID_BAR(); p0_phase(F, args); } STAMP_END(0);
    STAMP_BEGIN(1);
    REP(1) if (IN(1)) { if (rep_) GRID_BAR(); p1_phase(F, args); } SEAM(1); STAMP_END(1);
    STAMP_BEGIN(2);
    REP(2) if (IN(2)) { if (rep_) GRID_BAR();
        pg8::Gemm g{(const bf16_t*)(ws + WS_B), (const bf16_t*)(ws + WS_WIN), DM, DM, DM};
        pg8::DenseOrder S; S.init(T / 256, INCP / 256, F.G, (int)blockIdx.x);
        pg8::EpiStore E{(bf16_t*)(ws + WS_A), INCP, nullptr, 0.f, (float*)(ws + WS_RSTDQ), (float*)(ws + WS_RSTDKV), C_QA / 256, C_KVA / 256, C_KPE / 256};
        pg8::gemm_phase<pg8::EpiStore, pg8::DenseOrder>(F.lds, g, S, E);
    } SEAM(2); STAMP_END(2);
    STAMP_BEGIN(3);
    REP(3) if (IN(3)) { if (rep_) GRID_BAR(); p3_phase(F, args); } if (IN(3) && IN(5)) GRID_BAR(); STAMP_END(3);
    STAMP_BEGIN(5);
    REP(5) if (IN(5)) { if (rep_) GRID_BAR(); p5_phase(F, args); } SEAM(5); STAMP_END(5);
    STAMP_BEGIN(6);
    REP(6) if (IN(6)) { if (rep_) GRID_BAR(); p6_phase(F, args); } SEAM(6); STAMP_END(6);
    STAMP_BEGIN(7);
    REP(7) if (IN(7)) { if (rep_) GRID_BAR();
        pg8::Gemm g{(const bf16_t*)F.out, (const bf16_t*)(ws + WS_WOUT), DM, DM, DM};
        pg8::DenseOrder S; S.init(T / 256, DM / 256, F.G, (int)blockIdx.x);
        pg8::EpiStore E{(bf16_t*)(ws + WS_F), DM, nullptr, 0.f, nullptr, nullptr, 0, 0, 0};
        pg8::gemm_phase<pg8::EpiStore, pg8::DenseOrder>(F.lds, g, S, E);
    } SEAM(7); STAMP_END(7);
#if MK_LAST_PHASE >= 8
    STAMP_BEGIN(8);
    REP(8) if (IN(8)) { if (rep_) GRID_BAR(); p8_phase(F, args); } if (IN(8) && IN(10)) GRID_BAR(); STAMP_END(8);
    STAMP_BEGIN(10);
    REP(10) if (IN(10)) { if (rep_) GRID_BAR();
        const LAS int* tab = moe_tables(F);
        pg8::Gemm g{(const bf16_t*)(ws + WS_B), (const bf16_t*)(ws + WS_D), DM, DM, DM};
        pg8::GroupedOrder S; S.init(4, F.G, F.vcu, tab, (const int*)(ws + WS_LIST));
        pg8::EpiSwiGLU E{(bf16_t*)(ws + WS_C), (unsigned*)(F.ctl + CW_RDY)};
        pg8::gemm_phase<pg8::EpiSwiGLU, pg8::GroupedOrder, true>(F.lds, g, S, E);
    }
    REP(11) if (IN(11)) { if (rep_) GRID_BAR();
        const LAS int* tab = moe_tables(F);
        pg8::Gemm g{(const bf16_t*)(ws + WS_C), (const bf16_t*)(ws + WS_E), DE, DE, DE};
        pg8::RedealOrder S; S.init(8, F.G, F.vcu, tab, 4, (unsigned*)(F.ctl + CW_RDY), 32u, (unsigned*)(F.ctl + CW_TMO));
        pg8::EpiStore E{(bf16_t*)(ws + WS_A), DM, nullptr, 0.f, nullptr, nullptr, 0, 0, 0};
        pg8::gemm_phase<pg8::EpiStore, pg8::RedealOrder>(F.lds, g, S, E);
    } SEAM(11); STAMP_END(11);
    REP(12) if (IN(12)) { if (rep_) GRID_BAR(); p12_phase(F, args); }
#endif
#undef IN
#undef SEAM
}

extern "C" void kernel_launch(void* const* d_in, const int* in_sizes, int n_in, void* d_out, int out_size, void* d_ws, size_t ws_size, hipStream_t stream) {
    static int grid = 0;
    if (grid == 0) {
        if (n_in != 25 || out_size != T * DM || ws_size < WS_END) { fprintf(stderr, "kernel_launch: bad shapes (n_in %d out %d ws %zu)\n", n_in, out_size, ws_size); grid = -1; return; }
        int dev = 0, cus = 0, per_cu = 0;
        if (hipGetDevice(&dev) != hipSuccess || hipDeviceGetAttribute(&cus, hipDeviceAttributeMultiprocessorCount, dev) != hipSuccess) { grid = -1; return; }
        if (hipFuncSetAttribute((const void*)mk_fwd, hipFuncAttributeMaxDynamicSharedMemorySize, LDS_BYTES) != hipSuccess) { fprintf(stderr, "kernel_launch: hipFuncSetAttribute failed\n"); grid = -1; return; }
        if (hipOccupancyMaxActiveBlocksPerMultiprocessor(&per_cu, (const void*)mk_fwd, NTHR, LDS_BYTES) != hipSuccess || per_cu < 1) { fprintf(stderr, "kernel_launch: occupancy query says %d\n", per_cu); }
        (void)hipGetLastError();
        grid = cus;
    }
    if (grid < 0) return;
    (void)hipMemsetAsync((char*)d_ws + WS_CTL, 0, CTL_ZERO_BYTES, stream);
    Args a{};
    for (int i = 0; i < 25; ++i) a.in[i] = (const float*)d_in[i];
    a.out = (float*)d_out; a.ws = (unsigned char*)d_ws;
#if MK_MULTI
    for (int p = 0; p < N_PHASES; ++p) { a.ph_lo = p; a.ph_hi = p + 1; hipLaunchKernelGGL(mk_fwd, dim3(grid), dim3(NTHR), LDS_BYTES, stream, a); }
#else
    a.ph_lo = 0; a.ph_hi = N_PHASES; hipLaunchKernelGGL(mk_fwd, dim3(grid), dim3(NTHR), LDS_BYTES, stream, a);
#endif
}
```

```cpp
#include <hip/hip_runtime.h>
#include <cstdio>
#include <cstdint>

#define GAS __attribute__((address_space(1)))
#define LAS __attribute__((address_space(3)))
typedef unsigned short bf16_t;
typedef short bf16x8 __attribute__((ext_vector_type(8)));
typedef short s16x4 __attribute__((ext_vector_type(4)));
typedef float f32x4 __attribute__((ext_vector_type(4)));
typedef float f32x2 __attribute__((ext_vector_type(2)));
typedef float f32x16 __attribute__((ext_vector_type(16)));
typedef unsigned u32x4 __attribute__((ext_vector_type(4)));
typedef unsigned u32x2 __attribute__((ext_vector_type(2)));
typedef GAS unsigned gu32;
#define RLX_AGENT __ATOMIC_RELAXED, __HIP_MEMORY_SCOPE_AGENT
#define LDS_WAIT() asm volatile("s_waitcnt lgkmcnt(0)" ::: "memory")
#define VM_WAIT() asm volatile("s_waitcnt vmcnt(0)" ::: "memory")

constexpr int DM = 2048, NB = 8, SEQ = 2048, T = NB * SEQ;
constexpr int HW = 1024, HH = 8, HDK = 128, HDV = 128;
constexpr int MH = 8, MNOPE = 128, MROPE = 64, MQK = 192, MV = 128, QLORA = 512, KVLORA = 256;
constexpr int INC = 4 * HW + QLORA + KVLORA + MROPE;
constexpr int INCP = 5120;
constexpr int C_QA = 4096, C_KVA = 4608, C_KPE = 4864;
constexpr int NG = 4, EPG = 8, NE = 32, DE = 512;
constexpr int RMAX = (T * 2 / 256 + NE) * 256;
constexpr float EPS = 1e-6f;
constexpr int NWAVES = 8, NTHR = 512;

typedef __bf16 bf16x2_t __attribute__((ext_vector_type(2)));
__device__ __forceinline__ unsigned cvt_pk_bf16(float lo, float hi) { const f32x2 v = {lo, hi}; return __builtin_bit_cast(unsigned, __builtin_convertvector(v, bf16x2_t)); }
__device__ __forceinline__ float bf_lo(unsigned w) { return __builtin_bit_cast(float, w << 16); }
__device__ __forceinline__ float bf_hi(unsigned w) { return __builtin_bit_cast(float, w & 0xffff0000u); }
__device__ __forceinline__ float bf2f(bf16_t h) { return __builtin_bit_cast(float, (unsigned)h << 16); }
__device__ __forceinline__ float wave_sum(float v) {
#pragma unroll
    for (int o = 1; o < 64; o <<= 1) v += __shfl_xor(v, o);
    return v;
}
__device__ __forceinline__ float siluf(float v) { return v / (1.f + __expf(-v)); }

#define XB_TMO      128
#define XB_XCNT(j)  (256  + 64 * (j))
#define XB_XSUB(j)  (1280 + 64 * (j))
#define XB_XGEN(j)  (2304 + 64 * (j))
#define XB_TOP      3328
#define XB_TOPGEN   3392
#define XCD_BAR_WORDS 3456
#define XB_SPIN_CAP (1u << 18)

__device__ __forceinline__ unsigned xb_ld(unsigned* p)              { return __hip_atomic_load(p, __ATOMIC_RELAXED, __HIP_MEMORY_SCOPE_AGENT); }
__device__ __forceinline__ unsigned xb_add(unsigned* p, unsigned v) { return __hip_atomic_fetch_add(p, v, __ATOMIC_RELAXED, __HIP_MEMORY_SCOPE_AGENT); }
__device__ __forceinline__ unsigned xb_xcc_id() { return (unsigned)__builtin_amdgcn_s_getreg((3 << 11) | 20) & 0xFu; }
#define XB_SPIN(cond, bar) do { unsigned _sp = 0; while (cond) { __builtin_amdgcn_s_sleep(1); \
    if ((++_sp & 255u) == 0u) { if (xb_ld(&(bar)[XB_TMO])) break; if (_sp > XB_SPIN_CAP) { atomicAdd(&(bar)[XB_TMO], 1u); break; } } } } while (0)

struct XcdBarrier {
    unsigned* bar; unsigned x;
    volatile LAS unsigned* st;
};
__device__ __forceinline__ XcdBarrier xcd_barrier_post(unsigned* bar, volatile LAS unsigned* st) {
    XcdBarrier b; b.bar = bar; b.x = xb_xcc_id(); b.st = st;
    if (threadIdx.x == 0) (void)xb_add(&bar[XB_XCNT(b.x)], 1u);
    return b;
}
__device__ __forceinline__ void xcd_barrier_complete(unsigned* bar, unsigned x, unsigned& nloc, unsigned& nx) {
    const unsigned G = gridDim.x * gridDim.y * gridDim.z;
    unsigned sum, cnt, mine, sp = 0u;
    for (;;) {
        sum = 0u; cnt = 0u; mine = 0u;
#pragma unroll
        for (unsigned j = 0; j < 16; ++j) { const unsigned c = xb_ld(&bar[XB_XCNT(j)]); sum += c; cnt += (c > 0u) ? 1u : 0u; mine = (j == x) ? c : mine; }
        if (sum == G) break;
        __builtin_amdgcn_s_sleep(1);
        if ((++sp & 255u) == 0u) { if (xb_ld(&bar[XB_TMO])) break; if (sp > XB_SPIN_CAP) { atomicAdd(&bar[XB_TMO], 1u); break; } }
    }
    nloc = mine > 0u ? mine : 1u; nx = cnt > 0u ? cnt : 1u;
}
__device__ __forceinline__ void xcd_barrier(const XcdBarrier& b) {
    asm volatile("s_waitcnt vmcnt(0)" ::: "memory");
    __syncthreads();
    if (threadIdx.x == 0) {
        unsigned* bar = b.bar;
        __builtin_amdgcn_s_waitcnt(0);
        unsigned nloc = b.st[0], nx = b.st[1];
        if (nloc == 0u) { xcd_barrier_complete(bar, b.x, nloc, nx); b.st[0] = nloc; b.st[1] = nx; }
        const unsigned old = xb_add(&bar[XB_XSUB(b.x)], 1u);
        const unsigned gen = old / nloc;
        if (old + 1u == (gen + 1u) * nloc) {
            __builtin_amdgcn_fence(__ATOMIC_RELEASE, "agent");
            asm volatile("s_waitcnt vmcnt(0)" ::: "memory");
            const unsigned og = xb_add(&bar[XB_TOP], 1u);
            const unsigned tg = og / nx;
            if (og + 1u == (tg + 1u) * nx) xb_add(&bar[XB_TOPGEN], 1u);
            else XB_SPIN(xb_ld(&bar[XB_TOPGEN]) == tg, bar);
            __builtin_amdgcn_fence(__ATOMIC_ACQUIRE, "agent");
            xb_add(&bar[XB_XGEN(b.x)], 1u);
            asm volatile("s_waitcnt vmcnt(0)" ::: "memory");
        } else {
            XB_SPIN(xb_ld(&bar[XB_XGEN(b.x)]) == gen, bar);
            __builtin_amdgcn_fence(__ATOMIC_ACQUIRE, "agent");
            asm volatile("s_waitcnt vmcnt(0)" ::: "memory");
        }
    }
    __syncthreads();
}

namespace pg8 {
constexpr int BM = 256, BK = 64, HALF = 128, HTB = HALF * BK * 2, STAGE_BYTES = 8 * HTB, NXCD = 8, WGM = 8;
__host__ __device__ __forceinline__ int lds_byte(int r, int c) { const int st = (r >> 4) * 2 + (c >> 5), rr = r & 15, cc = c & 31, ob = rr * 64 + cc * 2; return st * 1024 + (ob ^ (((ob >> 9) & 1) << 5)); }
__host__ __device__ __forceinline__ void stage_rc(int b, int& R, int& C) { const int st = b / 1024, sb = b % 1024, swz = sb ^ (((sb >> 9) & 1) << 5); R = (st >> 1) * 16 + swz / 64; C = (st & 1) * 32 + (swz % 64) / 2; }
__host__ __device__ __forceinline__ int perm32(int rho) { const int n = rho >> 4, i = rho & 15; return 8 * (i >> 2) + 4 * n + (i & 3); }

struct Unit { int pm, pn, pb; };
struct Gemm { const bf16_t* A; const bf16_t* Bt; int lda, ldb, K; };

struct DenseOrder {
    int nM, nN, nwg, G, c;
    __device__ void init(int nM_, int nN_, int G_, int c_) { nM = nM_; nN = nN_; nwg = nM * nN; G = G_; c = c_; }
    __device__ bool next(int i, Unit& u) const {
        const long L = (long)i * G + c; if (L >= nwg) return false;
        int wgid = (int)L; { const int q = nwg / NXCD, r = nwg % NXCD, xcd = wgid % NXCD, off = wgid / NXCD; wgid = (xcd < r ? xcd * (q + 1) : r * (q + 1) + (xcd - r) * q) + off; }
        const int nig = WGM * nN, gid = wgid / nig, fm = gid * WGM, gsz = (nM - fm) < WGM ? (nM - fm) : WGM;
        u.pm = fm + ((wgid % nig) % gsz); u.pn = (wgid % nig) / gsz; u.pb = u.pn; return true;
    }
    __device__ __forceinline__ void a_ready(const Unit&) const {}
};
struct GroupedOrder {
    int nM, nN, nwg, G, c; const LAS int* tile_e; const LAS int* pstart; const LAS int* cnt; const int* list;
    __device__ void init(int nN_, int G_, int c_, const LAS int* tab, const int* list_) { pstart = tab; cnt = tab + 64; tile_e = tab + 128; list = list_; nM = pstart[32] >> 8; nN = nN_; nwg = nM * nN; G = G_; c = c_; }
    __device__ bool next(int i, Unit& u) const {
        const long L = (long)i * G + c; if (L >= nwg) return false;
        const int w = (int)L; u.pn = w % nN; u.pm = w / nN; u.pb = tile_e[u.pm] * nN + u.pn; return true;
    }
    __device__ int arow(const Unit& u, int r) const { const int e = tile_e[u.pm], j = 256 * u.pm - pstart[e] + r; return j < cnt[e] ? list[e * T + j] : 0; }
    __device__ __forceinline__ void a_ready(const Unit&) const {}
};
struct RedealOrder {
    int nM, nN, nwg, G, c, r10, X, nlight, head; const LAS int* tile_e; unsigned* ready; unsigned need; unsigned* tmo;
    __device__ void init(int nN_, int G_, int c_, const LAS int* tab, int nN10, unsigned* ready_, unsigned need_, unsigned* tmo_) {
        tile_e = tab + 128; nM = tab[32] >> 8; nN = nN_; nwg = nM * nN; G = G_; c = c_; ready = ready_; need = need_; tmo = tmo_;
        r10 = (nM * nN10) % G; X = r10 ? 3 : 0; nlight = G - r10; head = X * nlight < nwg ? X * nlight : nwg; }
    __device__ bool next(int i, Unit& u) const {
        long id;
        if (c >= r10 && X) id = i < X ? (long)i * nlight + (c - r10) : (long)head + (long)(i - X) * G + c;
        else id = (long)head + (long)i * G + c;
        if ((i < X && c >= r10 && id >= head) || id >= nwg) return false;
        u.pm = (int)id / nN; u.pn = (int)id % nN; u.pb = tile_e[u.pm] * nN + u.pn; return true;
    }
    __device__ __forceinline__ void a_ready(const Unit& u) const {
        if (threadIdx.x < 64) {
            unsigned polls = 0;
            while ((unsigned)__builtin_amdgcn_readfirstlane(__hip_atomic_load(ready + 64 * u.pm, __ATOMIC_RELAXED, __HIP_MEMORY_SCOPE_AGENT)) < need) {
                if (++polls > (1u << 16)) { if (threadIdx.x == 0) __hip_atomic_store(tmo, 0xDEAD0000u | (unsigned)u.pm, __ATOMIC_RELAXED, __HIP_MEMORY_SCOPE_AGENT); break; }
                __builtin_amdgcn_s_sleep(2); }
            __builtin_amdgcn_fence(__ATOMIC_ACQUIRE, "agent");
            asm volatile("s_waitcnt vmcnt(0)" ::: "memory");
        }
        asm volatile("" ::: "memory"); __builtin_amdgcn_s_barrier(); asm volatile("" ::: "memory");
    }
};

template <class Epi, class Sched, bool GATHER = false>
__device__ __forceinline__ void gemm_phase(LAS unsigned char* lds, const Gemm g, const Sched& S, const Epi& E) {
    int tid = threadIdx.x; asm volatile("" : "+v"(tid));
    const int wid = __builtin_amdgcn_readfirstlane(tid >> 6), lane = tid & 63, wr = wid >> 2, wc = wid & 3, fr = lane & 15, fq = lane >> 4;
    const int K = g.K, nt = K / BK;
    unsigned voffA[2], voffB[2]; int gR[2], gC[2];
#pragma unroll
    for (int i = 0; i < 2; ++i) { int R, C; stage_rc(tid * 16 + i * 8192, R, C); const int Rb = (R & ~31) + perm32(R & 31); gR[i] = R; gC[i] = C;
        voffA[i] = (unsigned)(R * g.lda + C) * 2u; voffB[i] = (unsigned)(Rb * g.ldb + C) * 2u; }
    const size_t kstep = (size_t)(BK * 2);
    const size_t hsA = (size_t)HALF * g.lda * 2, hsB = (size_t)HALF * g.ldb * 2;
    const unsigned ldsw = (unsigned)wid * 1024u;
    const int aoff = lds_byte(wr * 64 + fr, fq * 8), boff = lds_byte(wc * 32 + fr, fq * 8);
#define PG8_SA(b, h) (((b) * 2 + (h)) * HTB)
#define PG8_SB(b, h) ((4 + (b) * 2 + (h)) * HTB)
#define PG8_STAGE(bufoff, gbase, voff) do { _Pragma("unroll") for (int _i = 0; _i < 2; ++_i) \
        __builtin_amdgcn_global_load_lds((const unsigned*)((const char*)(gbase) + (voff)[_i]), (LAS unsigned*)(lds + (bufoff) + ldsw + _i * 8192), 16, 0, 0); } while (0)
#define PG8_STAGE_A(bufoff, dense_ptr, kbytes, offs) do { if constexpr (GATHER) { PG8_STAGE(bufoff, (const char*)g.A + (kbytes), offs); } else { PG8_STAGE(bufoff, dense_ptr, voffA); } } while (0)
#define PG8_GOFF(u, o0, o1) do { _Pragma("unroll") for (int _i = 0; _i < 2; ++_i) { o0[_i] = (unsigned)(S.arow(u, gR[_i]) * g.lda + gC[_i]) * 2u; o1[_i] = (unsigned)(S.arow(u, gR[_i] + HALF) * g.lda + gC[_i]) * 2u; } } while (0)
#define PG8_LDA(dst, b, h) do { _Pragma("unroll") for (int m = 0; m < 4; ++m) _Pragma("unroll") for (int k = 0; k < 2; ++k) dst[m][k] = *(const LAS bf16x8*)(lds + PG8_SA(b, h) + aoff + m * 2048 + k * 1024); } while (0)
#define PG8_LDB(dst, b, h) do { _Pragma("unroll") for (int n = 0; n < 2; ++n) _Pragma("unroll") for (int k = 0; k < 2; ++k) dst[n][k] = *(const LAS bf16x8*)(lds + PG8_SB(b, h) + boff + n * 2048 + k * 1024); } while (0)
#define PG8_MMA(ai, bj, At, Bt) do { __builtin_amdgcn_s_setprio(1); _Pragma("unroll") for (int m = 0; m < 4; ++m) _Pragma("unroll") for (int n = 0; n < 2; ++n) _Pragma("unroll") for (int k = 0; k < 2; ++k) \
        acc[ai][bj][m][n] = __builtin_amdgcn_mfma_f32_16x16x32_bf16(Bt[n][k], At[m][k], acc[ai][bj][m][n], 0, 0, 0); __builtin_amdgcn_s_setprio(0); } while (0)
#define PG8_WAIT_V(n) asm volatile("s_waitcnt vmcnt(" #n ")" ::: "memory")
#define PG8_WAIT_L(n) asm volatile("s_waitcnt lgkmcnt(" #n ")" ::: "memory")
#define PG8_BAR __builtin_amdgcn_s_barrier()
#define PG8_SCHED __builtin_amdgcn_sched_barrier(0)
    Unit cur, nxt; int ui = 0;
    if (!S.next(0, cur)) return;
    unsigned cO0[2] = {0u, 0u}, cO1[2] = {0u, 0u}, nO0[2] = {0u, 0u}, nO1[2] = {0u, 0u};
    if constexpr (GATHER) { PG8_GOFF(cur, cO0, cO1); }
    S.a_ready(cur);
    f32x4 acc[2][2][4][2];
#pragma unroll
    for (int a = 0; a < 2; ++a)
#pragma unroll
        for (int b = 0; b < 2; ++b)
#pragma unroll
            for (int m = 0; m < 4; ++m)
#pragma unroll
                for (int n = 0; n < 2; ++n) acc[a][b][m][n] = (f32x4){0.f, 0.f, 0.f, 0.f};
    bf16x8 At[4][2], B0[2][2], B1[2][2];
    const char* cA = (const char*)g.A + (GATHER ? (size_t)0 : (size_t)cur.pm * 2 * hsA); const char* cB = (const char*)g.Bt + (size_t)cur.pb * 2 * hsB;
    PG8_STAGE(PG8_SB(0, 0), cB, voffB); PG8_STAGE(PG8_SB(0, 1), cB + hsB, voffB); PG8_STAGE_A(PG8_SA(0, 0), cA, 0, cO0); PG8_STAGE_A(PG8_SA(0, 1), cA + hsA, 0, cO1);
    if (wr == 1) PG8_BAR;
    PG8_WAIT_V(2); PG8_BAR;
    PG8_STAGE(PG8_SB(1, 0), cB + kstep, voffB); PG8_STAGE_A(PG8_SA(1, 0), cA + kstep, kstep, cO0); PG8_STAGE(PG8_SB(1, 1), cB + hsB + kstep, voffB);
    PG8_WAIT_V(6); PG8_BAR;
    for (;;) {
        const bool has_next = S.next(ui + 1, nxt);
        const char* nA = (has_next && !GATHER) ? (const char*)g.A + (size_t)nxt.pm * 2 * hsA : cA; const char* nB = has_next ? (const char*)g.Bt + (size_t)nxt.pb * 2 * hsB : cB;
        if constexpr (GATHER) { if (has_next) { PG8_GOFF(nxt, nO0, nO1); } else { nO0[0] = cO0[0]; nO0[1] = cO0[1]; nO1[0] = cO1[0]; nO1[1] = cO1[1]; } }
        for (int t = 0; t < nt; t += 2) {
            const bool last = (t == nt - 2);
            if (last && has_next) S.a_ready(nxt);
            const char* a1 = cA + (size_t)(t + 1) * kstep;
            const char* a2 = last ? nA : cA + (size_t)(t + 2) * kstep; const char* b2 = last ? nB : cB + (size_t)(t + 2) * kstep;
            const char* a3 = a2 + kstep; const char* b3 = b2 + kstep;
            const size_t k2 = last ? (size_t)0 : (size_t)(t + 2) * kstep;
            unsigned o0[2], o1[2]; o0[0] = last ? nO0[0] : cO0[0]; o0[1] = last ? nO0[1] : cO0[1]; o1[0] = last ? nO1[0] : cO1[0]; o1[1] = last ? nO1[1] : cO1[1];
            PG8_LDB(B0, 0, 0); PG8_LDB(B1, 0, 1); PG8_SCHED; PG8_LDA(At, 0, 0); PG8_STAGE_A(PG8_SA(1, 1), a1 + hsA, (size_t)(t + 1) * kstep, cO1);
            PG8_WAIT_V(8); PG8_WAIT_L(0); PG8_BAR; PG8_MMA(0, 0, At, B0); PG8_MMA(0, 1, At, B1); PG8_BAR; PG8_SCHED;
            PG8_LDA(At, 0, 1); PG8_STAGE(PG8_SB(0, 0), b2, voffB); PG8_STAGE(PG8_SB(0, 1), b2 + hsB, voffB); PG8_STAGE_A(PG8_SA(0, 0), a2, k2, o0);
            PG8_WAIT_V(8); PG8_WAIT_L(0); PG8_BAR; PG8_MMA(1, 0, At, B0); PG8_MMA(1, 1, At, B1); PG8_BAR; PG8_SCHED;
            PG8_LDB(B0, 1, 0); PG8_LDB(B1, 1, 1); PG8_SCHED; PG8_LDA(At, 1, 0); PG8_STAGE_A(PG8_SA(0, 1), a2 + hsA, k2, o1);
            PG8_WAIT_V(8); PG8_WAIT_L(0); PG8_BAR; PG8_MMA(0, 0, At, B0); PG8_MMA(0, 1, At, B1); PG8_BAR; PG8_SCHED;
            PG8_LDA(At, 1, 1); PG8_STAGE(PG8_SB(1, 0), b3, voffB); PG8_STAGE(PG8_SB(1, 1), b3 + hsB, voffB); PG8_STAGE_A(PG8_SA(1, 0), a3, k2 + kstep, o0);
            PG8_WAIT_V(8); PG8_WAIT_L(0); PG8_BAR; PG8_MMA(1, 0, At, B0); PG8_MMA(1, 1, At, B1); PG8_BAR; PG8_SCHED;
        }
        if (wr == 0) PG8_BAR;
        E(acc, cur, wr, wc, fr, fq);
        if (!has_next) break;
#pragma unroll
        for (int a = 0; a < 2; ++a)
#pragma unroll
            for (int b = 0; b < 2; ++b)
#pragma unroll
                for (int m = 0; m < 4; ++m)
#pragma unroll
                    for (int n = 0; n < 2; ++n) acc[a][b][m][n] = (f32x4){0.f, 0.f, 0.f, 0.f};
        cur = nxt; cA = nA; cB = nB; ++ui;
        if constexpr (GATHER) { cO0[0] = nO0[0]; cO0[1] = nO0[1]; cO1[0] = nO1[0]; cO1[1] = nO1[1]; }
        if (wr == 1) PG8_BAR;
    }
    PG8_WAIT_V(0);
    PG8_BAR;
#undef PG8_SA
#undef PG8_SB
#undef PG8_STAGE
#undef PG8_STAGE_A
#undef PG8_GOFF
#undef PG8_LDA
#undef PG8_LDB
#undef PG8_MMA
#undef PG8_WAIT_V
#undef PG8_WAIT_L
#undef PG8_BAR
#undef PG8_SCHED
}

struct EpiStore {
    bf16_t* O; int ldc; const float* ssq; float inv; float* ssq_out0; float* ssq_out1; int pn0, pn1, pn2;
    __device__ __forceinline__ void operator()(const f32x4 (&acc)[2][2][4][2], const Unit& u, int wr, int wc, int fr, int fq) const {
        const int row0 = u.pm * BM + wr * 64 + fr, col0 = u.pn * BM + wc * 32 + 8 * fq;
        float* so = (ssq_out0 && u.pn >= pn0 && u.pn < pn2) ? (u.pn < pn1 ? ssq_out0 : ssq_out1) : nullptr;
        float rsv[2][4];
#pragma unroll
        for (int ai = 0; ai < 2; ++ai)
#pragma unroll
            for (int m = 0; m < 4; ++m) rsv[ai][m] = ssq ? ssq[row0 + ai * HALF + m * 16] : 0.f;
#pragma unroll
        for (int ai = 0; ai < 2; ++ai)
#pragma unroll
            for (int m = 0; m < 4; ++m) { const int row = row0 + ai * HALF + m * 16; const float rs = ssq ? rsqrtf(rsv[ai][m] * inv + EPS) : 1.f;
                bf16_t* rowp = O + (size_t)row * ldc + col0; float ss = 0.f;
#pragma unroll
                for (int bj = 0; bj < 2; ++bj) { const f32x4 v0 = acc[ai][bj][m][0] * rs, v1 = acc[ai][bj][m][1] * rs;
                    ss += (v0[0] * v0[0] + v0[1] * v0[1]) + (v0[2] * v0[2] + v0[3] * v0[3]) + (v1[0] * v1[0] + v1[1] * v1[1]) + (v1[2] * v1[2] + v1[3] * v1[3]);
                    u32x4 w; w.x = cvt_pk_bf16(v0[0], v0[1]); w.y = cvt_pk_bf16(v0[2], v0[3]); w.z = cvt_pk_bf16(v1[0], v1[1]); w.w = cvt_pk_bf16(v1[2], v1[3]);
                    *(u32x4*)(rowp + bj * HALF) = w; }
                if (so) { ss += __shfl_xor(ss, 16); ss += __shfl_xor(ss, 32); if (fq == 0) atomicAdd(so + row, ss); } }
    }
};
struct EpiResid {
    const float* X; float* O; const float* gate; int gpitch;
    __device__ __forceinline__ void operator()(const f32x4 (&acc)[2][2][4][2], const Unit& u, int wr, int wc, int fr, int fq) const {
        const int row0 = u.pm * BM + wr * 64 + fr, col0 = u.pn * BM + wc * 32 + 8 * fq;
        const float* gp = gate + (size_t)((u.pm * BM) / SEQ) * gpitch + col0;
        f32x4 gv[2][2];
#pragma unroll
        for (int bj = 0; bj < 2; ++bj)
#pragma unroll
            for (int n = 0; n < 2; ++n) gv[bj][n] = *(const f32x4*)(gp + bj * HALF + 4 * n);
#pragma unroll
        for (int ai = 0; ai < 2; ++ai)
#pragma unroll
            for (int m = 0; m < 4; ++m) { const size_t off = (size_t)(row0 + ai * HALF + m * 16) * DM + col0;
#pragma unroll
                for (int bj = 0; bj < 2; ++bj)
#pragma unroll
                    for (int n = 0; n < 2; ++n) { const f32x4 xv = *(const f32x4*)(X + off + bj * HALF + 4 * n);
                        *(f32x4*)(O + off + bj * HALF + 4 * n) = xv + gv[bj][n] * acc[ai][bj][m][n]; } }
    }
};
struct EpiSwiGLU {
    bf16_t* O; unsigned* ready;
    __device__ __forceinline__ void operator()(const f32x4 (&acc)[2][2][4][2], const Unit& u, int wr, int wc, int fr, int fq) const {
        const int row0 = u.pm * BM + wr * 64 + fr, col0 = u.pn * HALF + wc * 32 + 8 * fq;
        const __amdgpu_buffer_rsrc_t rs = __builtin_amdgcn_make_buffer_rsrc((void*)O, (short)0, RMAX * DE * 2, 0x00020000);
#pragma unroll
        for (int ai = 0; ai < 2; ++ai)
#pragma unroll
            for (int m = 0; m < 4; ++m) { const int row = row0 + ai * HALF + m * 16;
                float h[8];
#pragma unroll
                for (int n = 0; n < 2; ++n)
#pragma unroll
                    for (int j = 0; j < 4; ++j) { const float gt = acc[ai][0][m][n][j], up = acc[ai][1][m][n][j]; h[4 * n + j] = gt / (1.f + __expf(-gt)) * up; }
                u32x4 w; w.x = cvt_pk_bf16(h[0], h[1]); w.y = cvt_pk_bf16(h[2], h[3]); w.z = cvt_pk_bf16(h[4], h[5]); w.w = cvt_pk_bf16(h[6], h[7]);
                __builtin_amdgcn_raw_buffer_store_b128(w, rs, (unsigned)(row * DE + col0) * 2u, 0, 16); }
        asm volatile("s_waitcnt vmcnt(0)" ::: "memory");
        if ((threadIdx.x & 63) == 0) __hip_atomic_fetch_add(ready + 64 * u.pm, 1u, __ATOMIC_RELAXED, __HIP_MEMORY_SCOPE_AGENT);
    }
};
}
constexpr size_t MiB = 1u << 20;
constexpr size_t WS_CTL = 0, CTL_ZERO_BYTES = 1 * MiB;
constexpr size_t WS_MOD = 1 * MiB;
constexpr size_t WS_ROPEC = 1 * MiB + 512 * 1024;
constexpr size_t WS_ROPES = WS_ROPEC + 2 * MiB;
constexpr size_t WS_WCT = WS_ROPES + 2 * MiB;
constexpr size_t WS_RSTDQ = 6 * MiB;
constexpr size_t WS_RSTDKV = WS_RSTDQ + 64 * 1024;
constexpr size_t WS_TOKE = WS_RSTDKV + 64 * 1024;
constexpr size_t WS_TOKW = WS_TOKE + 128 * 1024;
constexpr size_t WS_TOKS = WS_TOKW + 128 * 1024;
constexpr size_t WS_BLKE = WS_TOKS + 128 * 1024;
constexpr size_t WS_STAMP = WS_BLKE + 4096;
constexpr size_t WS_WIN = 8 * MiB;
constexpr size_t WS_WQUP = 28 * MiB;
constexpr size_t WS_WKVUP = WS_WQUP + 1536 * 1024;
constexpr size_t WS_WOUT = 31 * MiB;
constexpr size_t WS_A = 40 * MiB;
constexpr size_t WS_B = 200 * MiB;
constexpr size_t WS_C = 264 * MiB;
constexpr size_t WS_D = 328 * MiB;
constexpr size_t WS_E = 456 * MiB;
constexpr size_t WS_LIST = 520 * MiB;
constexpr size_t WS_F = 522 * MiB;
constexpr size_t WS_END = 586 * MiB;
constexpr size_t QN_BYTES = (size_t)T * MH * MQK * 2;

constexpr int CW_BAR = 4096;
constexpr int CW_CNT = 8192;
constexpr int CW_RDY = 10240;
constexpr int CW_ADA = 64;
constexpr int CW_TMO = 1;

constexpr int RING_BYTES = 131072, LDS_BYTES = 147456, LDS_USER = 143360, MISC_OFF = LDS_BYTES - 512;

struct Args { const float* in[25]; float* out; unsigned char* ws; int ph_lo, ph_hi, pad0, pad1; };

struct Frame {
    LAS unsigned char* lds;
    volatile LAS unsigned* MISC;
    gu32* ctl;
    int tid, lane, wave, vcu, G;
    unsigned char* ws; float* out;
};

#define OPAQUE_FRAME(F) do { F.tid = threadIdx.x; asm volatile("" : "+v"(F.tid)); F.lane = F.tid & 63; } while (0)

__device__ __forceinline__ void unpack8(const u32x4 w, float* f) { f[0] = bf_lo(w.x); f[1] = bf_hi(w.x); f[2] = bf_lo(w.y); f[3] = bf_hi(w.y); f[4] = bf_lo(w.z); f[5] = bf_hi(w.z); f[6] = bf_lo(w.w); f[7] = bf_hi(w.w); }
__device__ __forceinline__ u32x4 pack8f(const float* f) { u32x4 w; w.x = cvt_pk_bf16(f[0], f[1]); w.y = cvt_pk_bf16(f[2], f[3]); w.z = cvt_pk_bf16(f[4], f[5]); w.w = cvt_pk_bf16(f[6], f[7]); return w; }

struct TrItem { const float* src; bf16_t* dst; bf16_t* dst2; const float* gk; int N, ldt; };
__device__ __forceinline__ void tr_load(const TrItem& it, f32x4 (&r)[16], int lane) {
    const float* p = it.src + (size_t)(lane >> 4) * it.N + 4 * (lane & 15);
#pragma unroll
    for (int i = 0; i < 16; ++i) r[i] = __builtin_nontemporal_load((const f32x4*)(p + (size_t)(4 * i) * it.N));
}
__device__ __forceinline__ void tr_store(const TrItem& it, const f32x4 (&r)[16], LAS unsigned char* Tl, int lane) {
    const int row = lane >> 4, c4 = lane & 15;
#pragma unroll
    for (int i = 0; i < 16; ++i) { f32x4 v = r[i]; if (it.gk) v = v * it.gk[4 * i + row];
        u32x2 w; w.x = cvt_pk_bf16(v.x, v.y); w.y = cvt_pk_bf16(v.z, v.w);
        *(LAS u32x2*)(Tl + ((4 * i + row) * 64 + 4 * c4) * 2) = w; }
    LDS_WAIT(); asm volatile("" ::: "memory");
    const int g = lane >> 4, i16 = lane & 15, q = i16 >> 2, pp = lane & 3;
    typedef short v4i16_t __attribute__((ext_vector_type(4)));
#pragma unroll
    for (int hh = 0; hh < 2; ++hh) { bf16_t* drow = (hh ? it.dst2 : it.dst) + (size_t)(16 * (g & 1) + i16) * it.ldt;
#pragma unroll
        for (int j = 0; j < 4; ++j) { const int kc = 4 * (g >> 1) + j;
            const v4i16_t lo = __builtin_amdgcn_ds_read_tr16_b64_v4i16((LAS v4i16_t*)(Tl + ((8 * kc + q) * 64 + 32 * hh + 16 * (g & 1) + 4 * pp) * 2));
            const v4i16_t hi = __builtin_amdgcn_ds_read_tr16_b64_v4i16((LAS v4i16_t*)(Tl + ((8 * kc + 4 + q) * 64 + 32 * hh + 16 * (g & 1) + 4 * pp) * 2));
            const bf16x8 o = {lo[0], lo[1], lo[2], lo[3], hi[0], hi[1], hi[2], hi[3]};
            *(bf16x8*)(drow + 8 * kc) = o; } }
    LDS_WAIT(); asm volatile("" ::: "memory");
}
template <class MK> __device__ __forceinline__ void tr_run(int first, int step, int n, const MK& mk, LAS unsigned char* Tl, int lane) {
    if (first >= n) return;
    f32x4 ra[16], rb[16];
    TrItem ia = mk(first), ib = ia;
    tr_load(ia, ra, lane);
    for (int idx = first; idx < n; idx += 2 * step) {
        if (idx + step < n) { ib = mk(idx + step); tr_load(ib, rb, lane); }
        tr_store(ia, ra, Tl, lane);
        if (idx + step >= n) break;
        if (idx + 2 * step < n) { ia = mk(idx + 2 * step); tr_load(ia, ra, lane); }
        tr_store(ib, rb, Tl, lane);
    }
}

__device__ __forceinline__ void adaln_phase(Frame& F, const float* c, const float* w_ada, const float* b_ada, float* mod) {
    LAS float* cact = (LAS float*)F.lds;
    LAS float* part = (LAS float*)(F.lds + 65536);
    for (int i = F.tid; i < NB * DM; i += NTHR) cact[i] = siluf(c[i]);
    __syncthreads();
    const int cg = F.tid & 7, rs = F.tid >> 3;
    for (int it = blockIdx.x; it < 6 * DM / 32; it += F.G) {
        const int n0 = it * 32 + cg * 4;
        f32x4 acc[8];
#pragma unroll
        for (int b = 0; b < 8; ++b) acc[b] = (f32x4){0.f, 0.f, 0.f, 0.f};
#pragma unroll 1
        for (int i0 = 0; i0 < 32; i0 += 16) { f32x4 w[16];
#pragma unroll
            for (int u = 0; u < 16; ++u) w[u] = __builtin_nontemporal_load((const f32x4*)(w_ada + (size_t)(rs + 64 * (i0 + u)) * (6 * DM) + n0));
#pragma unroll
            for (int u = 0; u < 16; ++u) { const int k = rs + 64 * (i0 + u);
#pragma unroll
                for (int b = 0; b < 8; ++b) acc[b] += w[u] * cact[b * DM + k]; } }
#pragma unroll
        for (int b = 0; b < 8; ++b) *(LAS f32x4*)(part + (rs * 8 + b) * 32 + cg * 4) = acc[b];
        __syncthreads();
        if (F.tid < 256) { const int b = F.tid >> 5, n = F.tid & 31; float s = 0.f;
#pragma unroll 8
            for (int r = 0; r < 64; ++r) s += part[(r * 8 + b) * 32 + n];
            __hip_atomic_store(mod + b * (6 * DM) + it * 32 + n, s + b_ada[it * 32 + n], __ATOMIC_RELAXED, __HIP_MEMORY_SCOPE_AGENT); }
        asm volatile("s_waitcnt vmcnt(0)" ::: "memory");
        __syncthreads();
        if (it == (int)blockIdx.x && F.tid == 0) __hip_atomic_fetch_add((unsigned*)(F.ctl + CW_ADA), 1u, __ATOMIC_RELAXED, __HIP_MEMORY_SCOPE_AGENT);
    }
}

__device__ __forceinline__ void p0_phase(Frame& F, const Args& a) {
    OPAQUE_FRAME(F);
    unsigned char* ws = F.ws;
    adaln_phase(F, a.in[1], a.in[3], a.in[4], (float*)(ws + WS_MOD));
    __syncthreads();
    LAS unsigned char* Tl = F.lds + F.wave * 8192;
    const int gw = F.vcu * NWAVES + F.wave, NGW = F.G * NWAVES;
    constexpr int I_IN = (DM / 64) * (INC / 64), I_QUP = (QLORA / 64) * (MH * MQK / 64), I_KVUP = (KVLORA / 64) * (MH * 256 / 64), I_OUT = (DM / 64) * (DM / 64);
    constexpr int NITEMS = I_IN + I_QUP + I_KVUP + I_OUT;
    static_assert(INC % 64 == 0, "64-column transpose items");
    { const float* w_in = a.in[6]; const float* w_qup = a.in[10]; const float* w_kvup = a.in[12]; const float* w_out = a.in[16]; const float* gq = a.in[9]; const float* gkv = a.in[11];
      auto mk = [=](int r) -> TrItem { TrItem t;
          if (r < I_IN) { const int nblk = INC / 64, kb = r / nblk, nb = r % nblk; t.src = w_in + (size_t)(64 * kb) * INC + 64 * nb; t.dst = (bf16_t*)(ws + WS_WIN) + (size_t)(64 * nb) * DM + 64 * kb; t.dst2 = t.dst + (size_t)32 * DM; t.gk = nullptr; t.N = INC; t.ldt = DM; return t; } r -= I_IN;
          if (r < I_QUP) { const int nblk = MH * MQK / 64, kb = r / nblk, nb = r % nblk; t.src = w_qup + (size_t)(64 * kb) * (MH * MQK) + 64 * nb; t.dst = (bf16_t*)(ws + WS_WQUP) + (size_t)(64 * nb) * QLORA + 64 * kb; t.dst2 = t.dst + (size_t)32 * QLORA; t.gk = gq + 64 * kb; t.N = MH * MQK; t.ldt = QLORA; return t; } r -= I_QUP;
          if (r < I_KVUP) { const int nblk = MH * 256 / 64, kb = r / nblk, nb = r % nblk; t.src = w_kvup + (size_t)(64 * kb) * (MH * 256) + 64 * nb; t.dst = (bf16_t*)(ws + WS_WKVUP) + (size_t)(64 * nb) * KVLORA + 64 * kb; t.dst2 = t.dst + (size_t)32 * KVLORA; t.gk = gkv + 64 * kb; t.N = MH * 256; t.ldt = KVLORA; return t; } r -= I_KVUP;
          { const int nblk = DM / 64, kb = r / nblk, nb = r % nblk; t.src = w_out + (size_t)(64 * kb) * DM + 64 * nb; t.dst = (bf16_t*)(ws + WS_WOUT) + (size_t)(64 * nb) * DM + 64 * kb; t.dst2 = t.dst + (size_t)32 * DM; t.gk = nullptr; t.N = DM; t.ldt = DM; return t; } };
      const int nheavy = (6 * DM / 32) - F.G, nlw = (F.G - nheavy) * NWAVES;
      int pre = 0;
      if (nheavy > 0 && nheavy < F.G) { pre = 2 * nlw < NITEMS ? 2 * nlw : NITEMS;
          if ((int)blockIdx.x >= nheavy) tr_run(((int)blockIdx.x - nheavy) * NWAVES + F.wave, nlw, pre, mk, Tl, F.lane); }
      tr_run(pre + gw, NGW, NITEMS, mk, Tl, F.lane); }
    { const int* pos = (const int*)a.in[2]; float* rc = (float*)(ws + WS_ROPEC); float* rsn = (float*)(ws + WS_ROPES);
      const int gt = F.vcu * NTHR + F.tid, NGT = F.G * NTHR;
      const float invf = (float)exp2(-(double)(gt & 31) * (13.287712379549449 / 32.0));
      for (int e = gt; e < T * 32; e += NGT) { const int tk = e >> 5;
          const float ang = (float)pos[tk] * invf; float sv, cv; sincosf(ang, &sv, &cv);
          rc[e] = cv; rsn[e] = sv; }
      { float* ssq = (float*)(ws + WS_RSTDQ); for (int e = gt; e < 2 * T; e += NGT) ssq[e] = 0.f; }
      float* wct = (float*)(ws + WS_WCT);
      for (int e = gt; e < 48 * DM; e += NGT) { const int n = e / DM, k = e % DM;
          wct[e] = n < 4 ? a.in[18][k * NG + n] : (n < 36 ? a.in[20][k * NE + (n - 4)] : 0.f); } }
}

__device__ __forceinline__ void p1_phase(Frame& F, const Args& a) {
    OPAQUE_FRAME(F);
    const int gw = F.vcu * NWAVES + F.wave, NGW = F.G * NWAVES;
    const float* mod = (const float*)(F.ws + WS_MOD); const float* g = a.in[5]; const float* x = a.in[0];
    bf16_t* H = (bf16_t*)(F.ws + WS_B);
    if (F.tid == 0) { unsigned polls = 0;
        while (__hip_atomic_load((unsigned*)(F.ctl + CW_ADA), __ATOMIC_RELAXED, __HIP_MEMORY_SCOPE_AGENT) < (unsigned)F.G) { if (++polls > (1u << 16)) { __hip_atomic_store((unsigned*)(F.ctl + CW_TMO), 0xADA00000u, __ATOMIC_RELAXED, __HIP_MEMORY_SCOPE_AGENT); break; } __builtin_amdgcn_s_sleep(2); }
        __builtin_amdgcn_fence(__ATOMIC_ACQUIRE, "agent"); asm volatile("s_waitcnt vmcnt(0)" ::: "memory"); }
    __syncthreads();
    for (int blk = gw; blk < T / 8; blk += NGW) { const int m0 = blk * 8, b = m0 / SEQ;
        const float* shift = mod + b * (6 * DM); const float* scale = shift + DM;
        f32x4 gm[8], sh[8];
#pragma unroll
        for (int j = 0; j < 8; ++j) { gm[j] = ((const f32x4*)g)[64 * j + F.lane] * (((const f32x4*)scale)[64 * j + F.lane] + 1.f); sh[j] = ((const f32x4*)shift)[64 * j + F.lane]; }
        f32x4 va[8], vb[8];
#define P1_LD(r, V) do { const f32x4* xr_ = (const f32x4*)(x + (size_t)(m0 + (r)) * DM) + F.lane; _Pragma("unroll") for (int j = 0; j < 8; ++j) V[j] = __builtin_nontemporal_load(xr_ + 64 * j); } while (0)
#define P1_ST(r, V) do { float s_ = 0.f; _Pragma("unroll") for (int j = 0; j < 8; ++j) s_ += (V[j].x * V[j].x + V[j].y * V[j].y) + (V[j].z * V[j].z + V[j].w * V[j].w); \
            const float rstd_ = rsqrtf(wave_sum(s_) * (1.f / DM) + EPS); u32x2* o8_ = (u32x2*)(H + (size_t)(m0 + (r)) * DM) + F.lane; \
            _Pragma("unroll") for (int j = 0; j < 8; ++j) { const f32x4 h_ = V[j] * rstd_ * gm[j] + sh[j]; u32x2 w_; w_.x = cvt_pk_bf16(h_.x, h_.y); w_.y = cvt_pk_bf16(h_.z, h_.w); o8_[64 * j] = w_; } } while (0)
        P1_LD(0, va);
#pragma unroll 1
        for (int r = 0; r < 8; r += 2) {
            P1_LD(r + 1, vb); __builtin_amdgcn_sched_barrier(0);
            P1_ST(r, va); __builtin_amdgcn_sched_barrier(0);
            if (r + 2 < 8) { P1_LD(r + 2, va); } __builtin_amdgcn_sched_barrier(0);
            P1_ST(r + 1, vb); __builtin_amdgcn_sched_barrier(0);
        }
#undef P1_LD
#undef P1_ST
    }
}

namespace hg {
constexpr int OFF_F = 0, OFF_SEG = 32768, OFF_QIN = 34816, RP = 272, OFF_KIN = OFF_QIN + 64 * RP, OFF_QB = OFF_KIN + 64 * RP, OFF_KLT = OFF_QB + 64 * RP, SP = 144,
              OFF_VT = OFF_KLT + 128 * SP  , OFF_DEC = OFF_VT + 64 * SP  , OFF_SF = OFF_DEC + 3584  , HG_LDS = OFF_SF + 16384;
static_assert(HG_LDS <= LDS_USER, "hgrn lds");
__device__ __forceinline__ int ppos(int s) { return (s & ~15) | ((s & 4) << 1) | ((s & 8) >> 1) | (s & 3); }
}
__device__ __forceinline__ void hgrn_chunked(Frame& F, const Args& a, int item) {
    using namespace hg;
    const bf16_t* PROJ = (const bf16_t*)(F.ws + WS_A);
    bf16_t* MIX = (bf16_t*)F.out;
    const float* lbl = a.in[7];
    LAS unsigned char* L = F.lds;
    LAS float* Fs = (LAS float*)(L + OFF_F); LAS float* SEGs = (LAS float*)(L + OFF_SEG); LAS float* DEC = (LAS float*)(L + OFF_DEC); LAS float* POST = DEC + 384;
    const int g = F.tid & 15, t0 = F.tid >> 4;
    const int sk = F.tid & 127, sseg = F.tid >> 7;
    const int r32 = F.lane & 31, hi = F.lane >> 5;
    {
        const int dq2 = (item >> 3) & 1, bh = (item >> 4) * 8 + (item & 7), h = bh & 7, b = bh >> 3;
        float lb[8];
#pragma unroll
        for (int j = 0; j < 8; ++j) { const int k = h * 128 + g * 8 + j; lb[j] = 1.f / (1.f + __expf(lbl[HW + k] - lbl[k])); }
        const bf16_t* base = PROJ + (size_t)(b * SEQ) * INCP + h * 128;
        f32x16 S0 = {}, S1 = {};
        u32x4 gq[2], gf[2], gv;
#define HG_LOADF(c) do { _Pragma("unroll") for (int i = 0; i < 2; ++i) gf[i] = *(const u32x4*)(base + (size_t)((c) * 64 + t0 + 32 * i) * INCP + g * 8 + HW); } while (0)
#define HG_LOADQ(c) do { _Pragma("unroll") for (int i = 0; i < 2; ++i) gq[i] = *(const u32x4*)(base + (size_t)((c) * 64 + t0 + 32 * i) * INCP + g * 8); \
            gv = *(const u32x4*)(base + (size_t)((c) * 64 + (F.tid >> 3)) * INCP + 2 * HW + dq2 * 64 + (F.tid & 7) * 8); } while (0)
        HG_LOADF(0); HG_LOADQ(0);
        for (int c = 0; c < SEQ / 64; ++c) {
            if (F.wave >= 4) { const int kb = F.wave - 4;
#pragma unroll
                for (int s2 = 0; s2 < 2; ++s2) { u32x4 w0, w1;
                    w0.x = cvt_pk_bf16(S0[8 * s2], S0[8 * s2 + 1]); w0.y = cvt_pk_bf16(S0[8 * s2 + 2], S0[8 * s2 + 3]); w0.z = cvt_pk_bf16(S0[8 * s2 + 4], S0[8 * s2 + 5]); w0.w = cvt_pk_bf16(S0[8 * s2 + 6], S0[8 * s2 + 7]);
                    w1.x = cvt_pk_bf16(S1[8 * s2], S1[8 * s2 + 1]); w1.y = cvt_pk_bf16(S1[8 * s2 + 2], S1[8 * s2 + 3]); w1.z = cvt_pk_bf16(S1[8 * s2 + 4], S1[8 * s2 + 5]); w1.w = cvt_pk_bf16(S1[8 * s2 + 6], S1[8 * s2 + 7]);
                    *(LAS u32x4*)(L + OFF_SF + ((((kb * 2 + 0) * 2 + s2) * 64) + F.lane) * 16) = w0;
                    *(LAS u32x4*)(L + OFF_SF + ((((kb * 2 + 1) * 2 + s2) * 64) + F.lane) * 16) = w1; } }
            float fv[2][8];
#pragma unroll
            for (int i = 0; i < 2; ++i) { float fl[8]; unpack8(gf[i], fl);
#pragma unroll
                for (int j = 0; j < 8; ++j) { const float sg = __builtin_amdgcn_rcpf(1.f + __builtin_amdgcn_exp2f(-1.4426950408889634f * fl[j])); fv[i][j] = lb[j] + (1.f - lb[j]) * sg; }
                LAS float* fp = Fs + (t0 + 32 * i) * 128 + g * 8;
                *(LAS f32x4*)fp = (f32x4){fv[i][0], fv[i][1], fv[i][2], fv[i][3]}; *(LAS f32x4*)(fp + 4) = (f32x4){fv[i][4], fv[i][5], fv[i][6], fv[i][7]}; }
            if (c + 1 < SEQ / 64) HG_LOADF(c + 1);
            __syncthreads();
            float klp[16];
            { float fr[16];
#pragma unroll
              for (int i = 0; i < 16; ++i) fr[i] = Fs[(16 * sseg + i) * 128 + sk];
              float p = 1.f;
#pragma unroll
              for (int i = 0; i < 16; ++i) { p *= fr[i]; Fs[(16 * sseg + i) * 128 + sk] = p; }
              SEGs[sseg * 128 + sk] = p;
              float q = 1.f;
#pragma unroll
              for (int i = 15; i >= 0; --i) { klp[i] = (1.f - fr[i]) * q; q *= fr[i]; } }
            __syncthreads();
            if (F.tid < 128) { const float s0 = SEGs[F.tid], s1 = SEGs[128 + F.tid], s2 = SEGs[256 + F.tid], s3 = SEGs[384 + F.tid];
                const float pm = s0 * s1;
                SEGs[F.tid] = 1.f; SEGs[128 + F.tid] = s0; SEGs[256 + F.tid] = pm; SEGs[384 + F.tid] = pm * s2;
                POST[F.tid] = s1 * s2 * s3; POST[128 + F.tid] = s2 * s3; POST[256 + F.tid] = s3; POST[384 + F.tid] = 1.f;
                DEC[F.tid] = pm * s2 * s3; DEC[128 + F.tid] = pm; DEC[256 + F.tid] = __builtin_amdgcn_rcpf(pm); }
            __syncthreads();
            { { const float po = POST[sseg * 128 + sk];
                float o16[16];
#pragma unroll
                for (int p = 0; p < 16; ++p) o16[p] = klp[8 * ((p >> 2) & 1) + 4 * (p >> 3) + (p & 3)] * po;
                *(LAS u32x4*)(L + OFF_KLT + sk * SP + sseg * 32) = pack8f(o16); *(LAS u32x4*)(L + OFF_KLT + sk * SP + sseg * 32 + 16) = pack8f(o16 + 8); }
#pragma unroll
              for (int i = 0; i < 2; ++i) { const int t = t0 + 32 * i;
                  float qin[8], kin[8], qb[8], qv[8];
                  unpack8(gq[i], qv);
                  const LAS float* fp = Fs + t * 128 + g * 8; const LAS float* pp = SEGs + (t >> 4) * 128 + g * 8;
                  const f32x4 pa = *(const LAS f32x4*)fp, pb = *(const LAS f32x4*)(fp + 4), ea = *(const LAS f32x4*)pp, eb = *(const LAS f32x4*)(pp + 4);
                  const f32x4 ma = *(const LAS f32x4*)(DEC + 128 + g * 8), mb = *(const LAS f32x4*)(DEC + 128 + g * 8 + 4), ra = *(const LAS f32x4*)(DEC + 256 + g * 8), rb = *(const LAS f32x4*)(DEC + 256 + g * 8 + 4);
#pragma unroll
                  for (int j = 0; j < 8; ++j) { const float P = (j < 4 ? pa[j] * ea[j] : pb[j - 4] * eb[j - 4]), pm = j < 4 ? ma[j] : mb[j - 4], rpm = j < 4 ? ra[j] : rb[j - 4];
                      const float r = __builtin_amdgcn_rcpf(P), kk = 1.f - fv[i][j], qs = qv[j] * 0.08838834764831845f;
                      qb[j] = qs * P; qin[j] = qb[j] * rpm; kin[j] = kk * pm * r; }
                  *(LAS u32x4*)(L + OFF_QIN + t * RP + g * 16) = pack8f(qin);
                  *(LAS u32x4*)(L + OFF_KIN + t * RP + g * 16) = pack8f(kin);
                  { const u32x4 w = pack8f(qb);
                    *(LAS u32x2*)(L + OFF_QB + t * RP + ((g >> 1) * 16 + (g & 1) * 4) * 2) = (u32x2){w.x, w.y};
                    *(LAS u32x2*)(L + OFF_QB + t * RP + ((g >> 1) * 16 + 8 + (g & 1) * 4) * 2) = (u32x2){w.z, w.w}; } }
              { float v[8]; unpack8(gv, v); const int s = F.tid >> 3, dvg = F.tid & 7, ps = ppos(s);
#pragma unroll
                  for (int j = 0; j < 8; ++j) *(LAS bf16_t*)(L + OFF_VT + (dvg * 8 + j) * SP + ps * 2) = (bf16_t)(__builtin_bit_cast(unsigned, v[j]) >> 16); } }
            if (c + 1 < SEQ / 64) HG_LOADQ(c + 1);
            __syncthreads();
            if (F.wave < 4) { const int tb = F.wave & 1, dvb = F.wave >> 1;
                f32x16 o = {};
                for (int sb = 0; sb <= tb; ++sb) { f32x16 X = {};
#pragma unroll
                    for (int ks = 0; ks < 8; ++ks) { const bf16x8 af = *(const LAS bf16x8*)(L + OFF_KIN + (32 * sb + r32) * RP + (16 * ks + 8 * hi) * 2);
                        const bf16x8 bfr = *(const LAS bf16x8*)(L + OFF_QIN + (32 * tb + r32) * RP + (16 * ks + 8 * hi) * 2);
                        X = __builtin_amdgcn_mfma_f32_32x32x16_bf16(af, bfr, X, 0, 0, 0); }
                    if (sb == tb) {
#pragma unroll
                        for (int r = 0; r < 16; ++r) { const int srow = (r & 3) + 8 * (r >> 2) + 4 * hi; if (srow > r32) X[r] = 0.f; } }
#pragma unroll
                    for (int s2 = 0; s2 < 2; ++s2) { u32x4 w; w.x = cvt_pk_bf16(X[8 * s2], X[8 * s2 + 1]); w.y = cvt_pk_bf16(X[8 * s2 + 2], X[8 * s2 + 3]); w.z = cvt_pk_bf16(X[8 * s2 + 4], X[8 * s2 + 5]); w.w = cvt_pk_bf16(X[8 * s2 + 6], X[8 * s2 + 7]);
                        const bf16x8 vf = *(const LAS bf16x8*)(L + OFF_VT + (32 * dvb + r32) * SP + (32 * sb + 16 * s2 + 8 * hi) * 2);
                        o = __builtin_amdgcn_mfma_f32_32x32x16_bf16(__builtin_bit_cast(bf16x8, w), vf, o, 0, 0, 0); } }
#pragma unroll
                for (int kb = 0; kb < 4; ++kb)
#pragma unroll
                    for (int s2 = 0; s2 < 2; ++s2) { const bf16x8 sf = *(const LAS bf16x8*)(L + OFF_SF + ((((kb * 2 + dvb) * 2 + s2) * 64) + F.lane) * 16);
                        const bf16x8 qf = *(const LAS bf16x8*)(L + OFF_QB + (32 * tb + r32) * RP + (32 * kb + 16 * s2 + 8 * hi) * 2);
                        o = __builtin_amdgcn_mfma_f32_32x32x16_bf16(qf, sf, o, 0, 0, 0); }
                bf16_t* orow = MIX + (size_t)(b * SEQ + c * 64 + 32 * tb) * DM + h * 128 + dq2 * 64 + dvb * 32 + r32;
#pragma unroll
                for (int r = 0; r < 16; ++r) { const float v = o[r]; const float vn = __shfl_xor(v, 1);
                    if ((r32 & 1) == 0) *(unsigned*)(orow + (size_t)((r & 3) + 8 * (r >> 2) + 4 * hi) * DM) = cvt_pk_bf16(v, vn); }
            } else { const int kb = F.wave - 4;
#pragma unroll
                for (int r = 0; r < 16; ++r) { const float dcy = DEC[32 * kb + (r & 3) + 8 * (r >> 2) + 4 * hi]; S0[r] *= dcy; S1[r] *= dcy; }
#pragma unroll
                for (int ss = 0; ss < 4; ++ss) { const bf16x8 kf = *(const LAS bf16x8*)(L + OFF_KLT + (32 * kb + r32) * SP + (16 * ss + 8 * hi) * 2);
                    const bf16x8 vf0 = *(const LAS bf16x8*)(L + OFF_VT + r32 * SP + (16 * ss + 8 * hi) * 2), vf1 = *(const LAS bf16x8*)(L + OFF_VT + (32 + r32) * SP + (16 * ss + 8 * hi) * 2);
                    S0 = __builtin_amdgcn_mfma_f32_32x32x16_bf16(kf, vf0, S0, 0, 0, 0); S1 = __builtin_amdgcn_mfma_f32_32x32x16_bf16(kf, vf1, S1, 0, 0, 0); }
            }
            __syncthreads();
        }
#undef HG_LOADF
#undef HG_LOADQ
    }
}

constexpr int MOE_IG = NE * (DM / 64) * (DE / 64);
constexpr int MOE_PRE = 9216;
struct MoeItems { const float* wg; const float* wu; const float* wd; unsigned char* ws;
    __device__ TrItem operator()(int it) const { TrItem t; t.gk = nullptr;
        const int which = it / MOE_IG, r = it % MOE_IG;
        if (which < 2) { const int e = r / 256, q = r % 256, kb = q / 8, nb = q % 8, n0 = 64 * nb;
            t.src = (which ? wu : wg) + (size_t)e * DM * DE + (size_t)(64 * kb) * DE + n0;
            t.dst = (bf16_t*)(ws + WS_D) + ((size_t)e * 1024 + (n0 >> 7) * 256 + (n0 & 127) + which * 128) * DM + 64 * kb; t.dst2 = t.dst + (size_t)32 * DM; t.N = DE; t.ldt = DM; }
        else { const int e = r / 256, q = r % 256, kb = q / 32, nb = q % 32, n0 = 64 * nb;
            t.src = wd + (size_t)e * DE * DM + (size_t)(64 * kb) * DM + n0;
            t.dst = (bf16_t*)(ws + WS_E) + ((size_t)e * DM + n0) * DE + 64 * kb; t.dst2 = t.dst + (size_t)32 * DE; t.N = DM; t.ldt = DE; }
        return t; } };

__device__ __forceinline__ void p3_phase(Frame& F, const Args& a) {
    OPAQUE_FRAME(F);
    const int role = ((int)blockIdx.x >> 3) & 1, idx = ((int)blockIdx.x >> 4) * 8 + ((int)blockIdx.x & 7), half = F.G >> 1;
    unsigned char* ws = F.ws;
    if (role == 0) { for (int it = idx; it < NB * HH * 2; it += half) hgrn_chunked(F, a, it); }
    else {
        { pg8::Gemm g{(const bf16_t*)(ws + WS_A) + C_QA, (const bf16_t*)(ws + WS_WQUP), INCP, QLORA, QLORA};
          pg8::DenseOrder S; S.init(T / 256, MH * MQK / 256, half, idx);
          pg8::EpiStore E{(bf16_t*)(ws + WS_B), MH * MQK, (const float*)(ws + WS_RSTDQ), 1.f / QLORA};
          pg8::gemm_phase<pg8::EpiStore, pg8::DenseOrder>(F.lds, g, S, E); }
        { pg8::Gemm g{(const bf16_t*)(ws + WS_A) + C_KVA, (const bf16_t*)(ws + WS_WKVUP), INCP, KVLORA, KVLORA};
          pg8::DenseOrder S; S.init(T / 256, MH * 256 / 256, half, idx);
          pg8::EpiStore E{(bf16_t*)(ws + WS_C), MH * 256, (const float*)(ws + WS_RSTDKV), 1.f / KVLORA};
          pg8::gemm_phase<pg8::EpiStore, pg8::DenseOrder>(F.lds, g, S, E); }
        { const MoeItems mk{a.in[22], a.in[23], a.in[24], ws};
          tr_run(idx * NWAVES + F.wave, half * NWAVES, MOE_PRE, mk, F.lds + F.wave * 8192, F.lane); }
    }
}

__device__ __forceinline__ float sum8(float v) { v += __shfl_xor(v, 1); v += __shfl_xor(v, 2); v += __shfl_xor(v, 4); return v; }

struct P5Set { u32x4 k0, k1, kpe, m0, m1, g0, g1; f32x4 ca, cb, sa, sb; };
__device__ __forceinline__ void p5_phase(Frame& F, const Args& a) {
    OPAQUE_FRAME(F);
    const int gw = F.vcu * NWAVES + F.wave, NGW = F.G * NWAVES;
    const bf16_t* PROJ = (const bf16_t*)(F.ws + WS_A);
    const bf16_t* KV = (const bf16_t*)(F.ws + WS_C);
    bf16_t* Kn = (bf16_t*)(F.ws + WS_F);
    bf16_t* MIX = (bf16_t*)F.out;
    const float* rc = (const float*)(F.ws + WS_ROPEC); const float* rsn = (const float*)(F.ws + WS_ROPES);
    const int h = F.lane >> 3, sub = F.lane & 7;
    const float sgn = sub < 4 ? -1.f : 1.f;
    float gk[3][8], go[2][8];
#pragma unroll
    for (int i = 0; i < 3; ++i)
#pragma unroll
        for (int j = 0; j < 8; ++j) gk[i][j] = a.in[14][(sub + 8 * i) * 8 + j];
#pragma unroll
    for (int i = 0; i < 2; ++i)
#pragma unroll
        for (int j = 0; j < 8; ++j) go[i][j] = a.in[8][(sub + 8 * i) * 8 + j];
#define P5_LD(t_, S_) do { const size_t t__ = (size_t)(t_); const int ii_ = (sub & 3) * 8; \
        S_.k0 = __builtin_nontemporal_load((const u32x4*)(KV + t__ * (MH * 256) + h * 256 + sub * 8)); S_.k1 = __builtin_nontemporal_load((const u32x4*)(KV + t__ * (MH * 256) + h * 256 + (sub + 8) * 8)); \
        S_.kpe = *(const u32x4*)(PROJ + t__ * INCP + C_KPE + sub * 8); \
        S_.ca = *(const f32x4*)(rc + t__ * 32 + ii_); S_.cb = *(const f32x4*)(rc + t__ * 32 + ii_ + 4); S_.sa = *(const f32x4*)(rsn + t__ * 32 + ii_); S_.sb = *(const f32x4*)(rsn + t__ * 32 + ii_ + 4); \
        S_.m0 = *(const u32x4*)(MIX + t__ * DM + h * 128 + sub * 8); S_.m1 = *(const u32x4*)(MIX + t__ * DM + h * 128 + (sub + 8) * 8); \
        S_.g0 = __builtin_nontemporal_load((const u32x4*)(PROJ + t__ * INCP + 3 * HW + h * 128 + sub * 8)); S_.g1 = __builtin_nontemporal_load((const u32x4*)(PROJ + t__ * INCP + 3 * HW + h * 128 + (sub + 8) * 8)); } while (0)
#define P5_CP(t_, S_) do { const int t__ = (t_), b_ = t__ / SEQ, s_ = t__ % SEQ; const size_t hrow = ((size_t)(b_ * MH + h) * SEQ + s_); \
        { float k[3][8]; float ss = 0.f; unpack8(S_.k0, k[0]); unpack8(S_.k1, k[1]); unpack8(S_.kpe, k[2]); \
          _Pragma("unroll") for (int i = 0; i < 3; ++i) _Pragma("unroll") for (int j = 0; j < 8; ++j) ss += k[i][j] * k[i][j]; \
          const float rs = rsqrtf(sum8(ss) * (1.f / MQK) + EPS); \
          _Pragma("unroll") for (int i = 0; i < 3; ++i) _Pragma("unroll") for (int j = 0; j < 8; ++j) k[i][j] *= rs * gk[i][j]; \
          _Pragma("unroll") for (int j = 0; j < 8; ++j) { const float pv = __shfl_xor(k[2][j], 4); const float cs_ = j < 4 ? S_.ca[j & 3] : S_.cb[j & 3], sn_ = j < 4 ? S_.sa[j & 3] : S_.sb[j & 3]; k[2][j] = k[2][j] * cs_ + sgn * pv * sn_; } \
          _Pragma("unroll") for (int i = 0; i < 3; ++i) *(u32x4*)(Kn + hrow * MQK + (sub + 8 * i) * 8) = pack8f(k[i]); } \
        { float o[2][8], gt[2][8]; float ss = 0.f; unpack8(S_.m0, o[0]); unpack8(S_.m1, o[1]); unpack8(S_.g0, gt[0]); unpack8(S_.g1, gt[1]); \
          _Pragma("unroll") for (int i = 0; i < 2; ++i) _Pragma("unroll") for (int j = 0; j < 8; ++j) ss += o[i][j] * o[i][j]; \
          const float rs = rsqrtf(sum8(ss) * (1.f / HDV) + EPS); \
          _Pragma("unroll") for (int i = 0; i < 2; ++i) { _Pragma("unroll") for (int j = 0; j < 8; ++j) o[i][j] = o[i][j] * rs * go[i][j] * siluf(gt[i][j]); \
              *(u32x4*)(MIX + (size_t)t__ * DM + h * 128 + (sub + 8 * i) * 8) = pack8f(o[i]); } } } while (0)
    for (int blk = gw; blk < T / 8; blk += NGW) { const int t0 = blk * 8;
        P5Set A, B;
        P5_LD(t0, A);
#pragma unroll 1
        for (int r = 0; r < 8; r += 2) {
            P5_LD(t0 + r + 1, B); __builtin_amdgcn_sched_barrier(0);
            P5_CP(t0 + r, A); __builtin_amdgcn_sched_barrier(0);
            if (r + 2 < 8) { P5_LD(t0 + r + 2, A); } __builtin_amdgcn_sched_barrier(0);
            P5_CP(t0 + r + 1, B); __builtin_amdgcn_sched_barrier(0);
        }
    }
#undef P5_LD
#undef P5_CP
}
namespace att {
constexpr int QBLK = 32, KVBLK = 64, QB = 256;
constexpr int KROW = 512, SHM_K = KVBLK * KROW, SHM_V = KVBLK * MV * 2;
constexpr int OFF_V = 0, OFF_K = 2 * SHM_V, OFF_WS = OFF_K + 2 * SHM_K;
constexpr float SCALE = 0.07216878364870322f;
constexpr float THR = 8.f;
#define SBAR() __builtin_amdgcn_sched_barrier(0)
__device__ __forceinline__ int v_st(int k, int c) { const int kk = (k & ~0xC) | ((k & 4) << 1) | ((k & 8) >> 1); return ((kk >> 3) * 4 + (c >> 5)) * 512 + ((kk & 7) * 32 + (c & 31)) * 2; }
__device__ __forceinline__ int v_rd_base(int lane) { return ((lane & 3) << 3) | (((lane >> 2) & 3) << 6) | (((lane >> 4) & 1) << 5) | (((lane >> 5) & 1) << 8); }
constexpr int v_rd_off(int d0, int ks, int half) { return d0 * 512 + ks * 4096 + half * 2048; }
__device__ __forceinline__ int crow(int r, int hi) { return (r & 3) + 8 * (r >> 2) + 4 * hi; }
template <int M> __device__ __forceinline__ float swz_xor(float v) { return __builtin_bit_cast(float, __builtin_amdgcn_ds_swizzle(__builtin_bit_cast(int, v), (M << 10) | 0x1F)); }
__device__ __forceinline__ unsigned cvtpk(float lo, float hi) { unsigned r; asm volatile("v_cvt_pk_bf16_f32 %0, %1, %2" : "=v"(r) : "v"(lo), "v"(hi)); return r; }

__device__ __forceinline__ void mask_tile(f32x16& p0, f32x16& p1, int dq) {
    const float NEG = -__builtin_inff();
#pragma unroll
    for (int r = 0; r < 16; ++r) {
        const int c = (r & 3) + 8 * (r >> 2);
        if (dq - c < 0) p0[r] = NEG;
        if (dq - c - 32 < 0) p1[r] = NEG;
    }
}
__device__ __forceinline__ void partialSM(f32x16& p0, f32x16& p1, float& m_reg, float& mn, float& alpha) {
    float pmax = p0[0];
#pragma unroll
    for (int r = 1; r < 16; ++r) pmax = fmaxf(pmax, p0[r]);
#pragma unroll
    for (int r = 0; r < 16; ++r) pmax = fmaxf(pmax, p1[r]);
    { auto rr = __builtin_amdgcn_permlane32_swap(__float_as_uint(pmax), __float_as_uint(pmax), false, false);
      pmax = fmaxf(__uint_as_float(rr[0]), __uint_as_float(rr[1])); }
    constexpr float C2 = 1.4426950408889634f * SCALE;
    if (__builtin_expect(__all((pmax - m_reg) * SCALE <= THR), 1)) { mn = m_reg; alpha = 1.f; }
    else { mn = fmaxf(m_reg, pmax); alpha = __builtin_amdgcn_exp2f((m_reg - mn) * C2); m_reg = mn; }
    const float mnL = -mn * C2;
#pragma unroll
    for (int r = 0; r < 16; ++r) p0[r] = fmaf(p0[r], C2, mnL);
#pragma unroll
    for (int r = 0; r < 16; ++r) p1[r] = fmaf(p1[r], C2, mnL);
#pragma unroll
    for (int r = 0; r < 16; ++r) p0[r] = __builtin_amdgcn_exp2f(p0[r]);
}
__device__ __forceinline__ void finishSM(f32x16& p0, f32x16& p1, float alpha, float& l_reg, bf16x8& pa0, bf16x8& pa1, bf16x8& pa2, bf16x8& pa3) {
#pragma unroll
    for (int r = 0; r < 16; ++r) p1[r] = __builtin_amdgcn_exp2f(p1[r]);
    float ps = 0;
#pragma unroll
    for (int r = 0; r < 16; ++r) ps += p0[r];
#pragma unroll
    for (int r = 0; r < 16; ++r) ps += p1[r];
    { auto rr = __builtin_amdgcn_permlane32_swap(__float_as_uint(ps), __float_as_uint(ps), false, false);
      ps = __uint_as_float(rr[0]) + __uint_as_float(rr[1]); }
    l_reg = l_reg * alpha + ps;
#define PK4(P, B_, OUT) do { unsigned a0 = cvtpk(P[B_+0], P[B_+1]), a1 = cvtpk(P[B_+2], P[B_+3]);                          \
        unsigned b0 = cvtpk(P[B_+4], P[B_+5]), b1 = cvtpk(P[B_+6], P[B_+7]);                                             \
        auto r0 = __builtin_amdgcn_permlane32_swap(a0, b0, false, false); auto r1 = __builtin_amdgcn_permlane32_swap(a1, b1, false, false); \
        u32x4 w = {r0[0], r1[0], r0[1], r1[1]}; OUT = __builtin_bit_cast(bf16x8, w); } while (0)
    PK4(p0, 0, pa0); PK4(p0, 8, pa1); PK4(p1, 0, pa2); PK4(p1, 8, pa3);
#undef PK4
}
template <int KB>
__device__ __forceinline__ void qkt(f32x16& p0, f32x16& p1, LAS unsigned char* lds, int r32, int hi, const bf16x8* qr) {
    p0 = f32x16{}; p1 = f32x16{};
    int sw = r32 & 15; asm volatile("" : "+v"(sw));
    const int rb = OFF_K + KB * SHM_K + r32 * KROW;
    int ab[8];
#pragma unroll
    for (int d = 0; d < 8; ++d) ab[d] = rb + (((2 * d + hi) ^ sw) << 4);
#pragma unroll
    for (int d0 = 0; d0 < 12; ++d0) { const int a = ab[d0 & 7] + (d0 >> 3) * 256;
        const bf16x8 b0 = *(const LAS bf16x8*)(lds + a);
        const bf16x8 b1 = *(const LAS bf16x8*)(lds + a + 32 * KROW);
        p0 = __builtin_amdgcn_mfma_f32_32x32x16_bf16(b0, qr[d0], p0, 0, 0, 0);
        p1 = __builtin_amdgcn_mfma_f32_32x32x16_bf16(b1, qr[d0], p1, 0, 0, 0); }
}
template <int VB>
__device__ __forceinline__ void pv_tile(f32x16* o, int vb0, bf16x8 pa0, bf16x8 pa1, bf16x8 pa2, bf16x8 pa3) {
#define TRRD(dst, off) asm volatile("ds_read_b64_tr_b16 %0, %1 offset:%2" : "=&v"(dst) : "v"(vb0), "i"(off) : "memory")
#define PV_D0(d0) do { s16x4 l0, l1, l2, l3, h0, h1, h2, h3; constexpr int b_ = OFF_V + VB * SHM_V + v_rd_off(d0, 0, 0); \
        TRRD(l0, b_); TRRD(h0, b_ + 2048); TRRD(l1, b_ + 4096); TRRD(h1, b_ + 6144); TRRD(l2, b_ + 8192); TRRD(h2, b_ + 10240); TRRD(l3, b_ + 12288); TRRD(h3, b_ + 14336); \
        asm volatile("s_waitcnt lgkmcnt(0)" ::: "memory"); SBAR();   \
        o[d0] = __builtin_amdgcn_mfma_f32_32x32x16_bf16(pa0, (bf16x8){l0[0], l0[1], l0[2], l0[3], h0[0], h0[1], h0[2], h0[3]}, o[d0], 0, 0, 0);   \
        o[d0] = __builtin_amdgcn_mfma_f32_32x32x16_bf16(pa1, (bf16x8){l1[0], l1[1], l1[2], l1[3], h1[0], h1[1], h1[2], h1[3]}, o[d0], 0, 0, 0);   \
        o[d0] = __builtin_amdgcn_mfma_f32_32x32x16_bf16(pa2, (bf16x8){l2[0], l2[1], l2[2], l2[3], h2[0], h2[1], h2[2], h2[3]}, o[d0], 0, 0, 0);   \
        o[d0] = __builtin_amdgcn_mfma_f32_32x32x16_bf16(pa3, (bf16x8){l3[0], l3[1], l3[2], l3[3], h3[0], h3[1], h3[2], h3[3]}, o[d0], 0, 0, 0); } while (0)
    PV_D0(0); PV_D0(1); PV_D0(2); PV_D0(3);
#undef PV_D0
#undef TRRD
}

constexpr int QP = MH * MQK, VP = MH * 256;
__device__ __forceinline__ void attn_block(const bf16_t* Q, const bf16_t* K, const bf16_t* V, bf16_t* O, int P0, const float* gon, const float* gqn, const float* rc, const float* rsn, LAS unsigned char* lds) {
    int tid = threadIdx.x; asm volatile("" : "+v"(tid));
    const int wid = __builtin_amdgcn_readfirstlane(tid >> 6), lane = tid & 63, r32 = lane & 31, hi = lane >> 5;
    const int NT = P0 / KVBLK + 4;
    const int qlo = P0 + wid * QBLK, qm = qlo + r32 - 4 * hi;
    LAS float* wsf = (LAS float*)(lds + OFF_WS) + wid * 64; LAS float* li_l = wsf; LAS float* al_l = wsf + 32;
    float m_reg = -1e30f, l_reg = 0.f; f32x16 o[4] = {};
    bf16x8 qr[12];
#pragma unroll
    for (int d0 = 0; d0 < 12; ++d0) qr[d0] = *(const bf16x8*)(Q + (size_t)(qlo + r32) * QP + d0 * 16 + hi * 8);
    {
        float ss = 0.f;
#pragma unroll
        for (int d0 = 0; d0 < 12; ++d0) { float f[8]; unpack8(__builtin_bit_cast(u32x4, qr[d0]), f);
#pragma unroll
            for (int j = 0; j < 8; ++j) ss += f[j] * f[j]; }
        { auto rr = __builtin_amdgcn_permlane32_swap(__float_as_uint(ss), __float_as_uint(ss), false, false); ss = __uint_as_float(rr[0]) + __uint_as_float(rr[1]); }
        const float rs = rsqrtf(ss * (1.f / MQK) + EPS);
#pragma unroll
        for (int d0 = 0; d0 < 8; ++d0) { float f[8]; unpack8(__builtin_bit_cast(u32x4, qr[d0]), f); const float* gp = gqn + d0 * 16 + hi * 8;
#pragma unroll
            for (int j = 0; j < 8; ++j) f[j] *= rs * gp[j];
            qr[d0] = __builtin_bit_cast(bf16x8, pack8f(f)); }
#pragma unroll
        for (int dd = 0; dd < 2; ++dd) { float x1[8], x2[8]; unpack8(__builtin_bit_cast(u32x4, qr[8 + dd]), x1); unpack8(__builtin_bit_cast(u32x4, qr[10 + dd]), x2);
            const float* g1p = gqn + 128 + dd * 16 + hi * 8; const float* g2p = g1p + 32; const float* cp = rc + (size_t)(qlo + r32) * 32 + dd * 16 + hi * 8; const float* sp = rsn + (size_t)(qlo + r32) * 32 + dd * 16 + hi * 8;
            const f32x4 c0 = *(const f32x4*)cp, c1 = *(const f32x4*)(cp + 4), s0 = *(const f32x4*)sp, s1 = *(const f32x4*)(sp + 4), ga = *(const f32x4*)g1p, gb = *(const f32x4*)(g1p + 4), gc = *(const f32x4*)g2p, gd = *(const f32x4*)(g2p + 4);
#pragma unroll
            for (int j = 0; j < 8; ++j) { const float a = x1[j] * rs * (j < 4 ? ga[j & 3] : gb[j & 3]), bq = x2[j] * rs * (j < 4 ? gc[j & 3] : gd[j & 3]), c = j < 4 ? c0[j & 3] : c1[j & 3], sn = j < 4 ? s0[j & 3] : s1[j & 3]; x1[j] = a * c - bq * sn; x2[j] = bq * c + a * sn; }
            qr[8 + dd] = __builtin_bit_cast(bf16x8, pack8f(x1)); qr[10 + dd] = __builtin_bit_cast(bf16x8, pack8f(x2)); }
    }
    int ksrc[4], vsrc[2];
#pragma unroll
    for (int i = 0; i < 4; ++i) { const int row = 2 * (wid * 4 + i) + (lane >> 5), c = (lane & 31) ^ (row & 15); ksrc[i] = row * MQK + (c < 24 ? c : 0) * 8; }
#pragma unroll
    for (int i = 0; i < 2; ++i) { const int id = (wid * 2 + i) * 2 + (lane >> 5), kk = ((id >> 2) << 3) | ((lane & 31) >> 2), k = (kk & ~0xC) | ((kk & 4) << 1) | ((kk & 8) >> 1);
        vsrc[i] = k * VP + (id & 3) * 32 + (lane & 3) * 8; }
    const int vb0 = (int)(unsigned)(uintptr_t)lds + v_rd_base(lane);
#define ALOAD(t, bf) do { const bf16_t* kp = K + (size_t)(t) * KVBLK * MQK; const bf16_t* vp = V + (size_t)(t) * KVBLK * VP; \
        _Pragma("unroll") for (int i = 0; i < 4; ++i) __builtin_amdgcn_global_load_lds((const unsigned*)(kp + ksrc[i]), (LAS unsigned*)(lds + OFF_K + (bf) * SHM_K + (wid * 4 + i) * 1024), 16, 0, 0); \
        _Pragma("unroll") for (int i = 0; i < 2; ++i) __builtin_amdgcn_global_load_lds((const unsigned*)(vp + vsrc[i]), (LAS unsigned*)(lds + OFF_V + (bf) * SHM_V + (wid * 2 + i) * 1024), 16, 0, 0); } while (0)
#define RESC(a) do { if (__any((a) < 1.f)) { if (hi == 0) al_l[r32] = (a); asm volatile("s_waitcnt lgkmcnt(0)" ::: "memory"); \
        _Pragma("unroll") for (int d_ = 0; d_ < 4; ++d_) _Pragma("unroll") for (int r = 0; r < 16; ++r) o[d_][r] *= al_l[crow(r, hi)]; } } while (0)
#define STEP(t, BF) do { f32x16 p0, p1; float mn, al; bf16x8 pa0, pa1, pa2, pa3; \
        if ((t) + 1 < NT) ALOAD((t) + 1, 1 - (BF)); \
        SBAR(); qkt<BF>(p0, p1, lds, r32, hi, qr); \
        { const int kb_ = (t) * KVBLK; if (kb_ + KVBLK - 1 > qlo) mask_tile(p0, p1, qm - kb_); } \
        partialSM(p0, p1, m_reg, mn, al); RESC(al); finishSM(p0, p1, al, l_reg, pa0, pa1, pa2, pa3); SBAR(); \
        pv_tile<BF>(o, vb0, pa0, pa1, pa2, pa3); SBAR(); \
        asm volatile("s_waitcnt vmcnt(0)" ::: "memory"); __syncthreads(); } while (0)
    ALOAD(0, 0); asm volatile("s_waitcnt vmcnt(0)" ::: "memory"); __syncthreads();
    for (int t = 0; t < NT; t += 2) { STEP(t, 0); STEP(t + 1, 1); }
#undef STEP
#undef RESC
#undef ALOAD
    if (hi == 0) li_l[r32] = l_reg;
    asm volatile("s_waitcnt lgkmcnt(0)" ::: "memory");
    float gv[4];
#pragma unroll
    for (int d0 = 0; d0 < 4; ++d0) gv[d0] = gon[d0 * 32 + r32];
    float ssr[16];
#pragma unroll
    for (int r = 0; r < 16; ++r) { const float rl = __builtin_amdgcn_rcpf(li_l[crow(r, hi)]); float ss = 0.f;
#pragma unroll
        for (int d0 = 0; d0 < 4; ++d0) { o[d0][r] *= rl; ss += o[d0][r] * o[d0][r]; }
        ssr[r] = ss; }
#pragma unroll
    for (int r = 0; r < 16; ++r) ssr[r] += swz_xor<1>(ssr[r]);
#pragma unroll
    for (int r = 0; r < 16; ++r) ssr[r] += swz_xor<2>(ssr[r]);
#pragma unroll
    for (int r = 0; r < 16; ++r) ssr[r] += swz_xor<4>(ssr[r]);
#pragma unroll
    for (int r = 0; r < 16; ++r) ssr[r] += swz_xor<8>(ssr[r]);
#pragma unroll
    for (int r = 0; r < 16; ++r) ssr[r] += swz_xor<16>(ssr[r]);
#pragma unroll
    for (int r = 0; r < 16; ++r) { const float rs = rsqrtf(ssr[r] * (1.f / MV) + EPS);
        bf16_t* orow = O + (size_t)(qlo + crow(r, hi)) * DM;
#pragma unroll
        for (int d0 = 0; d0 < 4; ++d0) { const float v = o[d0][r] * rs * gv[d0]; const float vn = swz_xor<1>(v);
            if ((r32 & 1) == 0) *(unsigned*)(orow + d0 * 32 + r32) = cvtpk(v, vn); } }
    __syncthreads();
}
#undef SBAR
}

__device__ __forceinline__ void p6_phase(Frame& F, const Args& a) {
    const bf16_t* QH = (const bf16_t*)(F.ws + WS_B); const bf16_t* Kn = (const bf16_t*)(F.ws + WS_F); const bf16_t* KV = (const bf16_t*)(F.ws + WS_C);
    bf16_t* MIX = (bf16_t*)F.out;
    const float* rc = (const float*)(F.ws + WS_ROPEC); const float* rsn = (const float*)(F.ws + WS_ROPES);
    for (int it = F.vcu; it < NB * MH * 4; it += F.G) {
        const int bh = it >> 2, j = it & 3, b = bh >> 3, h = bh & 7;
        const bf16_t* Q = QH + (size_t)(b * SEQ) * att::QP + h * MQK; const bf16_t* K = Kn + (size_t)bh * SEQ * MQK; const bf16_t* V = KV + (size_t)(b * SEQ) * att::VP + h * 256 + 128;
        bf16_t* O = MIX + (size_t)(b * SEQ) * DM + HW + h * MV;
        att::attn_block(Q, K, V, O, (7 - j) * att::QB, a.in[15], a.in[13], rc + (size_t)(b * SEQ) * 32, rsn + (size_t)(b * SEQ) * 32, F.lds);
        att::attn_block(Q, K, V, O, j * att::QB, a.in[15], a.in[13], rc + (size_t)(b * SEQ) * 32, rsn + (size_t)(b * SEQ) * 32, F.lds);
    }
}
__device__ __forceinline__ void p8_phase(Frame& F, const Args& a) {
    OPAQUE_FRAME(F);
    unsigned char* ws = F.ws;
    const float* xin = a.in[0]; const bf16_t* mixo = (const bf16_t*)(ws + WS_F); const float* mod = (const float*)(ws + WS_MOD); const float* g2n = a.in[17];
    const float* wct = (const float*)(ws + WS_WCT);
    bf16_t* H2 = (bf16_t*)(ws + WS_B);
    int* tok_e = (int*)(ws + WS_TOKE); float* tok_w = (float*)(ws + WS_TOKW); int* tok_s = (int*)(ws + WS_TOKS);
    LAS float* red = (LAS float*)F.lds;
    LAS float* ssw = (LAS float*)(F.lds + 98304);
    LAS float* shw = (LAS float*)(F.lds + 100352);
    LAS float* lg = (LAS float*)(F.lds + 101888);
    LAS float* rsl = (LAS float*)(F.lds + 111104);
    const int mr = F.lane & 15, mg = F.lane >> 4;
    const bool conv_first = (F.vcu & 1) != 0;
#pragma unroll 1
    for (int part = 0; part < 2; ++part) {
    if ((part == 0) != conv_first) {
    for (int tile = F.vcu; tile < T / 64; tile += F.G) {
        const int m0 = tile * 64, b = m0 / SEQ;
        const float* modb = mod + b * (6 * DM);
        f32x4 acc[4][3]; float ssp[4] = {0.f, 0.f, 0.f, 0.f}, shacc[3] = {0.f, 0.f, 0.f};
#pragma unroll
        for (int rb = 0; rb < 4; ++rb)
#pragma unroll
            for (int n = 0; n < 3; ++n) acc[rb][n] = (f32x4){0.f, 0.f, 0.f, 0.f};
        const unsigned xo = (unsigned)((m0 + mr) * DM + F.wave * 256 + 4 * mg);
        LAS float* vec = (LAS float*)(F.lds + 112640) + F.wave * 768;
        { const int k4 = F.lane * 4; const unsigned ko_ = (unsigned)(F.wave * 256 + k4) * 4u;
          const f32x4 t0 = *(const f32x4*)((const char*)(modb + 2 * DM) + ko_), t1 = *(const f32x4*)((const char*)(modb + 3 * DM) + ko_), t2 = *(const f32x4*)((const char*)g2n + ko_), t3 = *(const f32x4*)((const char*)(modb + 4 * DM) + ko_);
          *(LAS f32x4*)(vec + k4) = t0; *(LAS f32x4*)(vec + 256 + k4) = t1; *(LAS f32x4*)(vec + 512 + k4) = t2 * (t3 + 1.f); LDS_WAIT(); asm volatile("" ::: "memory"); }
        f32x4 xa[4], xb[4], wa[3], wb[3]; u32x2 ma_[4], mb_[4];
#define P8_LDX(s_, X, M, W) do { const unsigned ko_ = (unsigned)(F.wave * 256 + 16 * (s_) + 4 * mg) * 4u; \
            _Pragma("unroll") for (int n = 0; n < 3; ++n) W[n] = *(const f32x4*)((const char*)wct + (ko_ + (unsigned)((n * 16 + mr) * DM * 4))); \
            _Pragma("unroll") for (int rb = 0; rb < 4; ++rb) { const unsigned eo_ = xo + (unsigned)(rb * 16 * DM + 16 * (s_)); X[rb] = *(const f32x4*)((const char*)xin + eo_ * 4u); M[rb] = *(const u32x2*)((const char*)mixo + eo_ * 2u); } } while (0)
#define P8_CP(s_, X, M, W) do { const int kl_ = 16 * (s_) + 4 * mg; const f32x4 g1v = *(const LAS f32x4*)(vec + kl_), shv = *(const LAS f32x4*)(vec + 256 + kl_), gmv = *(const LAS f32x4*)(vec + 512 + kl_); \
            _Pragma("unroll") for (int n = 0; n < 3; ++n) shacc[n] += (shv.x * W[n].x + shv.y * W[n].y) + (shv.z * W[n].z + shv.w * W[n].w); \
            _Pragma("unroll") for (int rb = 0; rb < 4; ++rb) { const f32x4 v = X[rb] + g1v * (f32x4){bf_lo(M[rb].x), bf_hi(M[rb].x), bf_lo(M[rb].y), bf_hi(M[rb].y)}; \
                ssp[rb] += (v.x * v.x + v.y * v.y) + (v.z * v.z + v.w * v.w); const f32x4 av = v * gmv; \
                _Pragma("unroll") for (int i = 0; i < 4; ++i) _Pragma("unroll") for (int n = 0; n < 3; ++n) acc[rb][n] = __builtin_amdgcn_mfma_f32_16x16x4f32(av[i], W[n][i], acc[rb][n], 0, 0, 0); } } while (0)
        P8_LDX(0, xa, ma_, wa);
#pragma unroll 1
        for (int s = 0; s < 16; s += 2) {
            P8_LDX(s + 1, xb, mb_, wb); __builtin_amdgcn_sched_barrier(0);
            P8_CP(s, xa, ma_, wa); __builtin_amdgcn_sched_barrier(0);
            if (s + 2 < 16) { P8_LDX(s + 2, xa, ma_, wa); } __builtin_amdgcn_sched_barrier(0);
            P8_CP(s + 1, xb, mb_, wb); __builtin_amdgcn_sched_barrier(0);
        }
#undef P8_LDX
#undef P8_CP
#pragma unroll
        for (int rb = 0; rb < 4; ++rb) {
#pragma unroll
            for (int n = 0; n < 3; ++n)
#pragma unroll
                for (int r = 0; r < 4; ++r) red[(F.wave * 64 + rb * 16 + mg * 4 + r) * 48 + n * 16 + mr] = acc[rb][n][r];
            float sp = ssp[rb]; sp += __shfl_xor(sp, 16); sp += __shfl_xor(sp, 32);
            if (mg == 0) ssw[F.wave * 64 + rb * 16 + mr] = sp; }
#pragma unroll
        for (int n = 0; n < 3; ++n) { float sa = shacc[n]; sa += __shfl_xor(sa, 16); sa += __shfl_xor(sa, 32); if (mg == 0) shw[F.wave * 48 + n * 16 + mr] = sa; }
        __syncthreads();
        if (F.tid < 64) { float sv = 0.f;
#pragma unroll
            for (int w = 0; w < 8; ++w) sv += ssw[w * 64 + F.tid];
            rsl[F.tid] = rsqrtf(sv * (1.f / DM) + EPS); }
        __syncthreads();
        for (int idx = F.tid; idx < 64 * 36; idx += NTHR) { const int row = idx / 36, n = idx % 36; float L = 0.f, sw = 0.f;
#pragma unroll
            for (int w = 0; w < 8; ++w) { L += red[(w * 64 + row) * 48 + n]; sw += shw[w * 48 + n]; }
            lg[row * 36 + n] = rsl[row] * L + sw + (n < 4 ? a.in[19][n] : a.in[21][n - 4]); }
        __syncthreads();
        if (F.tid < 64) { const LAS float* l = lg + F.tid * 36; const int t = m0 + F.tid;
            int g = 0; float gm = l[0];
#pragma unroll
            for (int j = 1; j < 4; ++j) if (l[j] > gm) { gm = l[j]; g = j; }
            float den = 0.f;
#pragma unroll
            for (int j = 0; j < 4; ++j) den += __expf(l[j] - gm);
            const float pg = 1.f / den;
            const LAS float* e = l + 4 + g * 8;
            int i1 = 0; float v1 = e[0];
#pragma unroll
            for (int j = 1; j < 8; ++j) if (e[j] > v1) { v1 = e[j]; i1 = j; }
            int i2 = -1; float v2 = -__builtin_inff();
#pragma unroll
            for (int j = 0; j < 8; ++j) if (j != i1 && e[j] > v2) { v2 = e[j]; i2 = j; }
            const float w1 = 1.f / (1.f + __expf(v2 - v1)), w2 = 1.f - w1;
            const int e1 = g * 8 + i1, e2 = g * 8 + i2;
            const int s1 = (int)atomicAdd((unsigned*)(F.ctl + CW_CNT + 64 * e1), 1u), s2 = (int)atomicAdd((unsigned*)(F.ctl + CW_CNT + 64 * e2), 1u);
            tok_e[2 * t] = e1; tok_e[2 * t + 1] = e2; tok_w[2 * t] = pg * w1; tok_w[2 * t + 1] = pg * w2; tok_s[2 * t] = s1; tok_s[2 * t + 1] = s2;
            int* list = (int*)(ws + WS_LIST); list[e1 * T + s1] = t; list[e2 * T + s2] = t; }
        { const int c8 = (F.tid & 255) * 8, rg = F.tid >> 8;
          f32x4 g1a = *(const f32x4*)(modb + 2 * DM + c8), g1b = *(const f32x4*)(modb + 2 * DM + c8 + 4), sha = *(const f32x4*)(modb + 3 * DM + c8), shb = *(const f32x4*)(modb + 3 * DM + c8 + 4);
          const f32x4 gma = *(const f32x4*)(g2n + c8) * (*(const f32x4*)(modb + 4 * DM + c8) + 1.f), gmb = *(const f32x4*)(g2n + c8 + 4) * (*(const f32x4*)(modb + 4 * DM + c8 + 4) + 1.f);
#pragma unroll 1
          for (int j0 = 0; j0 < 32; j0 += 4) {
              f32x4 qa[4], qb[4]; u32x4 qm[4];
#pragma unroll
              for (int u = 0; u < 4; ++u) { const size_t eo = (size_t)(m0 + rg + 2 * (j0 + u)) * DM + c8;
                  qa[u] = __builtin_nontemporal_load((const f32x4*)(xin + eo)); qb[u] = __builtin_nontemporal_load((const f32x4*)(xin + eo + 4)); qm[u] = __builtin_nontemporal_load((const u32x4*)(mixo + eo)); }
              __builtin_amdgcn_sched_barrier(0);
#pragma unroll
              for (int u = 0; u < 4; ++u) { const int row = rg + 2 * (j0 + u); const size_t eo = (size_t)(m0 + row) * DM + c8; const float rs = rsl[row];
                  float mx[8]; unpack8(qm[u], mx);
                  const f32x4 xa = qa[u] + g1a * (f32x4){mx[0], mx[1], mx[2], mx[3]}, xb = qb[u] + g1b * (f32x4){mx[4], mx[5], mx[6], mx[7]};
                  const f32x4 va = xa * rs * gma + sha, vb = xb * rs * gmb + shb;
                  u32x4 w; w.x = cvt_pk_bf16(va.x, va.y); w.y = cvt_pk_bf16(va.z, va.w); w.z = cvt_pk_bf16(vb.x, vb.y); w.w = cvt_pk_bf16(vb.z, vb.w);
                  *(u32x4*)(H2 + eo) = w;
                  u32x4 x1; x1.x = cvt_pk_bf16(xa.x, xa.y); x1.y = cvt_pk_bf16(xa.z, xa.w); x1.z = cvt_pk_bf16(xb.x, xb.y); x1.w = cvt_pk_bf16(xb.z, xb.w);
                  *(u32x4*)((bf16_t*)(ws + WS_F) + eo) = x1; }
              __builtin_amdgcn_sched_barrier(0); } }
        __syncthreads();
    }
    } else {
    LAS unsigned char* Tl = F.lds + F.wave * 8192;
    const int gw = F.vcu * NWAVES + F.wave, NGW = F.G * NWAVES;
    { const MoeItems mk{a.in[22], a.in[23], a.in[24], ws};
      tr_run(MOE_PRE + gw, NGW, 3 * MOE_IG, mk, Tl, F.lane); }
    __syncthreads();
    }
    }
}

constexpr int MOE_TAB_OFF = LDS_USER;
__device__ __forceinline__ LAS int* moe_tables(Frame& F) {
    LAS int* tab = (LAS int*)(F.lds + MOE_TAB_OFF);
    __syncthreads();
    if (F.tid < NE) tab[64 + F.tid] = (int)__hip_atomic_load((unsigned*)(F.ctl + CW_CNT + 64 * F.tid), RLX_AGENT);
    __syncthreads();
    if (F.tid == 0) { int acc = 0;
        for (int e = 0; e < NE; ++e) { tab[e] = acc; acc += ((tab[64 + e] + 255) / 256) * 256; }
        tab[NE] = acc; }
    __syncthreads();
    if (F.tid < 160) { int e = 0; for (int j = 1; j < NE; ++j) if (tab[j] <= F.tid * 256) e = j; tab[128 + F.tid] = e; }
    __syncthreads();
    return tab;
}

__device__ __forceinline__ void p12_phase(Frame& F, const Args& a) {
    OPAQUE_FRAME(F);
    unsigned char* ws = F.ws;
    const bf16_t* Y = (const bf16_t*)(ws + WS_A);
    const float* tok_w = (const float*)(ws + WS_TOKW); const int* tok_s = (const int*)(ws + WS_TOKS);
    const float* mod = (const float*)(ws + WS_MOD);
    const LAS int* tab = moe_tables(F); const int* tok_e = (const int*)(ws + WS_TOKE);
    const int gw = F.vcu * NWAVES + F.wave, NGW = F.G * NWAVES;
#if defined(MK_STAMP) && MK_STAMP >= 0
    const float dscale = 1.f + sqrtf(exp2f(rintf(3.f * log2f(*(const float*)(ws + WS_STAMP + 8) + 1.f) + MK_QSHIFT) * (1.f / 3.f)));
#else
    const float dscale = 1.f;
#endif
    for (int blk = gw; blk < T / 8; blk += NGW) { const int t0 = blk * 8, b = t0 / SEQ;
        const float* g2 = mod + b * (6 * DM) + 5 * DM;
        f32x4 h2[4][2];
#pragma unroll
        for (int j = 0; j < 4; ++j) { const int c = (j * 64 + F.lane) * 8; h2[j][0] = *(const f32x4*)(g2 + c); h2[j][1] = *(const f32x4*)(g2 + c + 4); }
        int dsl = 0; float wl = 0.f;
        if (F.lane < 16) { dsl = tab[tok_e[2 * t0 + F.lane]] + tok_s[2 * t0 + F.lane]; wl = tok_w[2 * t0 + F.lane]; }
#pragma unroll 1
        for (int r = 0; r < 8; ++r) { const int t = t0 + r;
            const float w0 = __shfl(wl, 2 * r), w1 = __shfl(wl, 2 * r + 1); const int d0 = __shfl(dsl, 2 * r), d1 = __shfl(dsl, 2 * r + 1);
            float* orow = F.out + (size_t)t * DM; const bf16_t* mrow = (const bf16_t*)(ws + WS_F) + (size_t)t * DM;
            u32x4 qy0[4], qy1[4], qm[4];
#pragma unroll
            for (int j = 0; j < 4; ++j) { const int c = (j * 64 + F.lane) * 8;
                qy0[j] = __builtin_nontemporal_load((const u32x4*)(Y + (size_t)d0 * DM + c)); qy1[j] = __builtin_nontemporal_load((const u32x4*)(Y + (size_t)d1 * DM + c));
                qm[j] = __builtin_nontemporal_load((const u32x4*)(mrow + c)); }
            __builtin_amdgcn_sched_barrier(0);
#pragma unroll
            for (int j = 0; j < 4; ++j) { const int c = (j * 64 + F.lane) * 8;
                float y0[8], y1[8], mx[8]; unpack8(qy0[j], y0); unpack8(qy1[j], y1); unpack8(qm[j], mx);
                const f32x4 xa = {mx[0], mx[1], mx[2], mx[3]}, xb = {mx[4], mx[5], mx[6], mx[7]};
                f32x4 ra, rb;
#pragma unroll
                for (int i = 0; i < 4; ++i) { ra[i] = (xa[i] + h2[j][0][i] * (w0 * y0[i] + w1 * y1[i])) * dscale; rb[i] = (xb[i] + h2[j][1][i] * (w0 * y0[4 + i] + w1 * y1[4 + i])) * dscale; }
                __builtin_nontemporal_store(ra, (f32x4*)(orow + c)); __builtin_nontemporal_store(rb, (f32x4*)(orow + c + 4)); }
            __builtin_amdgcn_sched_barrier(0); }
    }
}
#ifndef MK_MULTI
#define MK_MULTI 0
#endif
#ifndef MK_LAST_PHASE
#define MK_LAST_PHASE 12
#endif
constexpr int N_PHASES = MK_LAST_PHASE + 1;

template <class P> __device__ __forceinline__ P* uptr(P* p) { const unsigned long long v = (unsigned long long)p;
    const unsigned lo = __builtin_amdgcn_readfirstlane((unsigned)v), hi = __builtin_amdgcn_readfirstlane((unsigned)(v >> 32)); return (P*)(__attribute__((address_space(1))) P*)(((unsigned long long)hi << 32) | lo); }
__global__ void __launch_bounds__(NTHR, 2) mk_fwd(const Args args) {
    extern __shared__ __attribute__((aligned(16))) unsigned char lds_raw[];
    Frame F;
    F.lds = (LAS unsigned char*)lds_raw;
    F.MISC = (volatile LAS unsigned*)(F.lds + MISC_OFF);
    F.tid = threadIdx.x; F.lane = F.tid & 63; F.wave = __builtin_amdgcn_readfirstlane(F.tid >> 6);
    F.G = gridDim.x; { const int bx = blockIdx.x; F.vcu = (F.G % 8 == 0) ? (bx % 8) * (F.G / 8) + bx / 8 : bx; }
    F.ws = uptr(args.ws); F.out = uptr(args.out);
    F.ctl = (gu32*)(F.ws + WS_CTL);
    for (int u = F.tid; u < (LDS_BYTES - MISC_OFF) / 4; u += NTHR) ((LAS unsigned*)(F.lds + MISC_OFF))[u] = 0u;
    __syncthreads();
    XcdBarrier bar; bar.bar = (unsigned*)(F.ctl + CW_BAR); bar.x = 0; bar.st = nullptr;
#if !MK_MULTI
    bar = xcd_barrier_post((unsigned*)(F.ctl + CW_BAR), F.MISC + 8);
#define GRID_BAR() xcd_barrier(bar)
#else
#define GRID_BAR() do { } while (0)
#endif
    const int lo = args.ph_lo, hi = args.ph_hi;
#ifndef MK_PHMASK
#define MK_PHMASK 0xFFFF
#endif
#define IN(k) (((MK_PHMASK >> (k)) & 1) && lo <= (k) && (k) < hi)
#define SEAM(k) do { if (IN(k) && IN((k) + 1)) GRID_BAR(); } while (0)
#ifndef MK_STAMP
#define MK_STAMP (-1)
#endif
#define STAMP_BEGIN(k) do { if ((k) == MK_STAMP && blockIdx.x == 0 && F.tid == 0) *(unsigned long long*)(ws + WS_STAMP) = __builtin_amdgcn_s_memrealtime(); } while (0)
#define STAMP_END(k) do { if ((k) == MK_STAMP && blockIdx.x == 0 && F.tid == 0) { const unsigned long long t1_ = __builtin_amdgcn_s_memrealtime(); *(float*)(ws + WS_STAMP + 8) = (float)(t1_ - *(unsigned long long*)(ws + WS_STAMP)) * 0.01f; } } while (0)
#ifndef MK_REPEAT
#define MK_REPEAT (-1)
#endif
#ifndef MK_REPN
#define MK_REPN 2
#endif
#define REP(k) _Pragma("unroll") for (int rep_ = 0; rep_ < ((k) == MK_REPEAT ? MK_REPN : 1); ++rep_)
    unsigned char* const ws = F.ws;

    STAMP_BEGIN(0);
    REP(0) if (IN(0)) { if (rep_) GRID_BAR(); p0_phase(F, args); } STAMP_END(0);
    STAMP_BEGIN(1);
    REP(1) if (IN(1)) { if (rep_) GRID_BAR(); p1_phase(F, args); } SEAM(1); STAMP_END(1);
    STAMP_BEGIN(2);
    REP(2) if (IN(2)) { if (rep_) GRID_BAR();
        pg8::Gemm g{(const bf16_t*)(ws + WS_B), (const bf16_t*)(ws + WS_WIN), DM, DM, DM};
        pg8::DenseOrder S; S.init(T / 256, INCP / 256, F.G, (int)blockIdx.x);
        pg8::EpiStore E{(bf16_t*)(ws + WS_A), INCP, nullptr, 0.f, (float*)(ws + WS_RSTDQ), (float*)(ws + WS_RSTDKV), C_QA / 256, C_KVA / 256, C_KPE / 256};
        pg8::gemm_phase<pg8::EpiStore, pg8::DenseOrder>(F.lds, g, S, E);
    } SEAM(2); STAMP_END(2);
    STAMP_BEGIN(3);
    REP(3) if (IN(3)) { if (rep_) GRID_BAR(); p3_phase(F, args); } if (IN(3) && IN(5)) GRID_BAR(); STAMP_END(3);
    STAMP_BEGIN(5);
    REP(5) if (IN(5)) { if (rep_) GRID_BAR(); p5_phase(F, args); } SEAM(5); STAMP_END(5);
    STAMP_BEGIN(6);
    REP(6) if (IN(6)) { if (rep_) GRID_BAR(); p6_phase(F, args); } SEAM(6); STAMP_END(6);
    STAMP_BEGIN(7);
    REP(7) if (IN(7)) { if (rep_) GRID_BAR();
        pg8::Gemm g{(const bf16_t*)F.out, (const bf16_t*)(ws + WS_WOUT), DM, DM, DM};
        pg8::DenseOrder S; S.init(T / 256, DM / 256, F.G, (int)blockIdx.x);
        pg8::EpiStore E{(bf16_t*)(ws + WS_F), DM, nullptr, 0.f, nullptr, nullptr, 0, 0, 0};
        pg8::gemm_phase<pg8::EpiStore, pg8::DenseOrder>(F.lds, g, S, E);
    } SEAM(7); STAMP_END(7);
#if MK_LAST_PHASE >= 8
    STAMP_BEGIN(8);
    REP(8) if (IN(8)) { if (rep_) GRID_BAR(); p8_phase(F, args); } if (IN(8) && IN(10)) GRID_BAR(); STAMP_END(8);
    STAMP_BEGIN(10);
    REP(10) if (IN(10)) { if (rep_) GRID_BAR();
        const LAS int* tab = moe_tables(F);
        pg8::Gemm g{(const bf16_t*)(ws + WS_B), (const bf16_t*)(ws + WS_D), DM, DM, DM};
        pg8::GroupedOrder S; S.init(4, F.G, F.vcu, tab, (const int*)(ws + WS_LIST));
        pg8::EpiSwiGLU E{(bf16_t*)(ws + WS_C), (unsigned*)(F.ctl + CW_RDY)};
        pg8::gemm_phase<pg8::EpiSwiGLU, pg8::GroupedOrder, true>(F.lds, g, S, E);
    }
    REP(11) if (IN(11)) { if (rep_) GRID_BAR();
        const LAS int* tab = moe_tables(F);
        pg8::Gemm g{(const bf16_t*)(ws + WS_C), (const bf16_t*)(ws + WS_E), DE, DE, DE};
        pg8::RedealOrder S; S.init(8, F.G, F.vcu, tab, 4, (unsigned*)(F.ctl + CW_RDY), 32u, (unsigned*)(F.ctl + CW_TMO));
        pg8::EpiStore E{(bf16_t*)(ws + WS_A), DM, nullptr, 0.f, nullptr, nullptr, 0, 0, 0};
        pg8::gemm_phase<pg8::EpiStore, pg8::RedealOrder>(F.lds, g, S, E);
    } SEAM(11); STAMP_END(11);
    REP(12) if (IN(12)) { if (rep_) GRID_BAR(); p12_phase(F, args); }
#endif
#undef IN
#undef SEAM
}

extern "C" void kernel_launch(void* const* d_in, const int* in_sizes, int n_in, void* d_out, int out_size, void* d_ws, size_t ws_size, hipStream_t stream) {
    static int grid = 0;
    if (grid == 0) {
        if (n_in != 25 || out_size != T * DM || ws_size < WS_END) { fprintf(stderr, "kernel_launch: bad shapes (n_in %d out %d ws %zu)\n", n_in, out_size, ws_size); grid = -1; return; }
        int dev = 0, cus = 0, per_cu = 0;
        if (hipGetDevice(&dev) != hipSuccess || hipDeviceGetAttribute(&cus, hipDeviceAttributeMultiprocessorCount, dev) != hipSuccess) { grid = -1; return; }
        if (hipFuncSetAttribute((const void*)mk_fwd, hipFuncAttributeMaxDynamicSharedMemorySize, LDS_BYTES) != hipSuccess) { fprintf(stderr, "kernel_launch: hipFuncSetAttribute failed\n"); grid = -1; return; }
        if (hipOccupancyMaxActiveBlocksPerMultiprocessor(&per_cu, (const void*)mk_fwd, NTHR, LDS_BYTES) != hipSuccess || per_cu < 1) { fprintf(stderr, "kernel_launch: occupancy query says %d\n", per_cu); }
        (void)hipGetLastError();
        grid = cus;
    }
    if (grid < 0) return;
    (void)hipMemsetAsync((char*)d_ws + WS_CTL, 0, CTL_ZERO_BYTES, stream);
    Args a{};
    for (int i = 0; i < 25; ++i) a.in[i] = (const float*)d_in[i];
    a.out = (float*)d_out; a.ws = (unsigned char*)d_ws;
#if MK_MULTI
    for (int p = 0; p < N_PHASES; ++p) { a.ph_lo = p; a.ph_hi = p + 1; hipLaunchKernelGGL(mk_fwd, dim3(grid), dim3(NTHR), LDS_BYTES, stream, a); }
#else
    a.ph_lo = 0; a.ph_hi = N_PHASES; hipLaunchKernelGGL(mk_fwd, dim3(grid), dim3(NTHR), LDS_BYTES, stream, a);
#endif
}
```

```cpp
#include <hip/hip_runtime.h>
#include <cstdio>
#include <cstdint>

#define GAS __attribute__((address_space(1)))
#define LAS __attribute__((address_space(3)))
typedef unsigned short bf16_t;
typedef short bf16x8 __attribute__((ext_vector_type(8)));
typedef short s16x4 __attribute__((ext_vector_type(4)));
typedef float f32x4 __attribute__((ext_vector_type(4)));
typedef float f32x2 __attribute__((ext_vector_type(2)));
typedef float f32x16 __attribute__((ext_vector_type(16)));
typedef unsigned u32x4 __attribute__((ext_vector_type(4)));
typedef unsigned u32x2 __attribute__((ext_vector_type(2)));
typedef GAS unsigned gu32;
#define RLX_AGENT __ATOMIC_RELAXED, __HIP_MEMORY_SCOPE_AGENT
#define LDS_WAIT() asm volatile("s_waitcnt lgkmcnt(0)" ::: "memory")
#define VM_WAIT() asm volatile("s_waitcnt vmcnt(0)" ::: "memory")

constexpr int DM = 2048, NB = 8, SEQ = 2048, T = NB * SEQ;
constexpr int HW = 1024, HH = 8, HDK = 128, HDV = 128;
constexpr int MH = 8, MNOPE = 128, MROPE = 64, MQK = 192, MV = 128, QLORA = 512, KVLORA = 256;
constexpr int INC = 4 * HW + QLORA + KVLORA + MROPE;
constexpr int INCP = 5120;
constexpr int C_QA = 4096, C_KVA = 4608, C_KPE = 4864;
constexpr int NG = 4, EPG = 8, NE = 32, DE = 512;
constexpr int RMAX = (T * 2 / 256 + NE) * 256;
constexpr float EPS = 1e-6f;
constexpr int NWAVES = 8, NTHR = 512;

typedef __bf16 bf16x2_t __attribute__((ext_vector_type(2)));
__device__ __forceinline__ unsigned cvt_pk_bf16(float lo, float hi) { const f32x2 v = {lo, hi}; return __builtin_bit_cast(unsigned, __builtin_convertvector(v, bf16x2_t)); }
__device__ __forceinline__ float bf_lo(unsigned w) { return __builtin_bit_cast(float, w << 16); }
__device__ __forceinline__ float bf_hi(unsigned w) { return __builtin_bit_cast(float, w & 0xffff0000u); }
__device__ __forceinline__ float bf2f(bf16_t h) { return __builtin_bit_cast(float, (unsigned)h << 16); }
__device__ __forceinline__ float wave_sum(float v) {
#pragma unroll
    for (int o = 1; o < 64; o <<= 1) v += __shfl_xor(v, o);
    return v;
}
__device__ __forceinline__ float siluf(float v) { return v / (1.f + __expf(-v)); }

#define XB_TMO      128
#define XB_XCNT(j)  (256  + 64 * (j))
#define XB_XSUB(j)  (1280 + 64 * (j))
#define XB_XGEN(j)  (2304 + 64 * (j))
#define XB_TOP      3328
#define XB_TOPGEN   3392
#define XCD_BAR_WORDS 3456
#define XB_SPIN_CAP (1u << 18)

__device__ __forceinline__ unsigned xb_ld(unsigned* p)              { return __hip_atomic_load(p, __ATOMIC_RELAXED, __HIP_MEMORY_SCOPE_AGENT); }
__device__ __forceinline__ unsigned xb_add(unsigned* p, unsigned v) { return __hip_atomic_fetch_add(p, v, __ATOMIC_RELAXED, __HIP_MEMORY_SCOPE_AGENT); }
__device__ __forceinline__ unsigned xb_xcc_id() { return (unsigned)__builtin_amdgcn_s_getreg((3 << 11) | 20) & 0xFu; }
#define XB_SPIN(cond, bar) do { unsigned _sp = 0; while (cond) { __builtin_amdgcn_s_sleep(1); \
    if ((++_sp & 255u) == 0u) { if (xb_ld(&(bar)[XB_TMO])) break; if (_sp > XB_SPIN_CAP) { atomicAdd(&(bar)[XB_TMO], 1u); break; } } } } while (0)

struct XcdBarrier {
    unsigned* bar; unsigned x;
    volatile LAS unsigned* st;
};
__device__ __forceinline__ XcdBarrier xcd_barrier_post(unsigned* bar, volatile LAS unsigned* st) {
    XcdBarrier b; b.bar = bar; b.x = xb_xcc_id(); b.st = st;
    if (threadIdx.x == 0) (void)xb_add(&bar[XB_XCNT(b.x)], 1u);
    return b;
}
__device__ __forceinline__ void xcd_barrier_complete(unsigned* bar, unsigned x, unsigned& nloc, unsigned& nx) {
    const unsigned G = gridDim.x * gridDim.y * gridDim.z;
    unsigned sum, cnt, mine, sp = 0u;
    for (;;) {
        sum = 0u; cnt = 0u; mine = 0u;
#pragma unroll
        for (unsigned j = 0; j < 16; ++j) { const unsigned c = xb_ld(&bar[XB_XCNT(j)]); sum += c; cnt += (c > 0u) ? 1u : 0u; mine = (j == x) ? c : mine; }
        if (sum == G) break;
        __builtin_amdgcn_s_sleep(1);
        if ((++sp & 255u) == 0u) { if (xb_ld(&bar[XB_TMO])) break; if (sp > XB_SPIN_CAP) { atomicAdd(&bar[XB_TMO], 1u); break; } }
    }
    nloc = mine > 0u ? mine : 1u; nx = cnt > 0u ? cnt : 1u;
}
__device__ __forceinline__ void xcd_barrier(const XcdBarrier& b) {
    asm volatile("s_waitcnt vmcnt(0)" ::: "memory");
    __syncthreads();
    if (threadIdx.x == 0) {
        unsigned* bar = b.bar;
        __builtin_amdgcn_s_waitcnt(0);
        unsigned nloc = b.st[0], nx = b.st[1];
        if (nloc == 0u) { xcd_barrier_complete(bar, b.x, nloc, nx); b.st[0] = nloc; b.st[1] = nx; }
        const unsigned old = xb_add(&bar[XB_XSUB(b.x)], 1u);
        const unsigned gen = old / nloc;
        if (old + 1u == (gen + 1u) * nloc) {
            __builtin_amdgcn_fence(__ATOMIC_RELEASE, "agent");
            asm volatile("s_waitcnt vmcnt(0)" ::: "memory");
            const unsigned og = xb_add(&bar[XB_TOP], 1u);
            const unsigned tg = og / nx;
            if (og + 1u == (tg + 1u) * nx) xb_add(&bar[XB_TOPGEN], 1u);
            else XB_SPIN(xb_ld(&bar[XB_TOPGEN]) == tg, bar);
            __builtin_amdgcn_fence(__ATOMIC_ACQUIRE, "agent");
            xb_add(&bar[XB_XGEN(b.x)], 1u);
            asm volatile("s_waitcnt vmcnt(0)" ::: "memory");
        } else {
            XB_SPIN(xb_ld(&bar[XB_XGEN(b.x)]) == gen, bar);
            __builtin_amdgcn_fence(__ATOMIC_ACQUIRE, "agent");
            asm volatile("s_waitcnt vmcnt(0)" ::: "memory");
        }
    }
    __syncthreads();
}

namespace pg8 {
constexpr int BM = 256, BK = 64, HALF = 128, HTB = HALF * BK * 2, STAGE_BYTES = 8 * HTB, NXCD = 8, WGM = 8;
__host__ __device__ __forceinline__ int lds_byte(int r, int c) { const int st = (r >> 4) * 2 + (c >> 5), rr = r & 15, cc = c & 31, ob = rr * 64 + cc * 2; return st * 1024 + (ob ^ (((ob >> 9) & 1) << 5)); }
__host__ __device__ __forceinline__ void stage_rc(int b, int& R, int& C) { const int st = b / 1024, sb = b % 1024, swz = sb ^ (((sb >> 9) & 1) << 5); R = (st >> 1) * 16 + swz / 64; C = (st & 1) * 32 + (swz % 64) / 2; }
__host__ __device__ __forceinline__ int perm32(int rho) { const int n = rho >> 4, i = rho & 15; return 8 * (i >> 2) + 4 * n + (i & 3); }

struct Unit { int pm, pn, pb; };
struct Gemm { const bf16_t* A; const bf16_t* Bt; int lda, ldb, K; };

struct DenseOrder {
    int nM, nN, nwg, G, c;
    __device__ void init(int nM_, int nN_, int G_, int c_) { nM = nM_; nN = nN_; nwg = nM * nN; G = G_; c = c_; }
    __device__ bool next(int i, Unit& u) const {
        const long L = (long)i * G + c; if (L >= nwg) return false;
        int wgid = (int)L; { const int q = nwg / NXCD, r = nwg % NXCD, xcd = wgid % NXCD, off = wgid / NXCD; wgid = (xcd < r ? xcd * (q + 1) : r * (q + 1) + (xcd - r) * q) + off; }
        const int nig = WGM * nN, gid = wgid / nig, fm = gid * WGM, gsz = (nM - fm) < WGM ? (nM - fm) : WGM;
        u.pm = fm + ((wgid % nig) % gsz); u.pn = (wgid % nig) / gsz; u.pb = u.pn; return true;
    }
    __device__ __forceinline__ void a_ready(const Unit&) const {}
};
struct GroupedOrder {
    int nM, nN, nwg, G, c; const LAS int* tile_e; const LAS int* pstart; const LAS int* cnt; const int* list;
    __device__ void init(int nN_, int G_, int c_, const LAS int* tab, const int* list_) { pstart = tab; cnt = tab + 64; tile_e = tab + 128; list = list_; nM = pstart[32] >> 8; nN = nN_; nwg = nM * nN; G = G_; c = c_; }
    __device__ bool next(int i, Unit& u) const {
        const long L = (long)i * G + c; if (L >= nwg) return false;
        const int w = (int)L; u.pn = w % nN; u.pm = w / nN; u.pb = tile_e[u.pm] * nN + u.pn; return true;
    }
    __device__ int arow(const Unit& u, int r) const { const int e = tile_e[u.pm], j = 256 * u.pm - pstart[e] + r; return j < cnt[e] ? list[e * T + j] : 0; }
    __device__ __forceinline__ void a_ready(const Unit&) const {}
};
struct RedealOrder {
    int nM, nN, nwg, G, c, r10, X, nlight, head; const LAS int* tile_e; unsigned* ready; unsigned need; unsigned* tmo;
    __device__ void init(int nN_, int G_, int c_, const LAS int* tab, int nN10, unsigned* ready_, unsigned need_, unsigned* tmo_) {
        tile_e = tab + 128; nM = tab[32] >> 8; nN = nN_; nwg = nM * nN; G = G_; c = c_; ready = ready_; need = need_; tmo = tmo_;
        r10 = (nM * nN10) % G; X = r10 ? 3 : 0; nlight = G - r10; head = X * nlight < nwg ? X * nlight : nwg; }
    __device__ bool next(int i, Unit& u) const {
        long id;
        if (c >= r10 && X) id = i < X ? (long)i * nlight + (c - r10) : (long)head + (long)(i - X) * G + c;
        else id = (long)head + (long)i * G + c;
        if ((i < X && c >= r10 && id >= head) || id >= nwg) return false;
        u.pm = (int)id / nN; u.pn = (int)id % nN; u.pb = tile_e[u.pm] * nN + u.pn; return true;
    }
    __device__ __forceinline__ void a_ready(const Unit& u) const {
        if (threadIdx.x < 64) {
            unsigned polls = 0;
            while ((unsigned)__builtin_amdgcn_readfirstlane(__hip_atomic_load(ready + 64 * u.pm, __ATOMIC_RELAXED, __HIP_MEMORY_SCOPE_AGENT)) < need) {
                if (++polls > (1u << 16)) { if (threadIdx.x == 0) __hip_atomic_store(tmo, 0xDEAD0000u | (unsigned)u.pm, __ATOMIC_RELAXED, __HIP_MEMORY_SCOPE_AGENT); break; }
                __builtin_amdgcn_s_sleep(2); }
            __builtin_amdgcn_fence(__ATOMIC_ACQUIRE, "agent");
            asm volatile("s_waitcnt vmcnt(0)" ::: "memory");
        }
        asm volatile("" ::: "memory"); __builtin_amdgcn_s_barrier(); asm volatile("" ::: "memory");
    }
};

template <class Epi, class Sched, bool GATHER = false>
__device__ __forceinline__ void gemm_phase(LAS unsigned char* lds, const Gemm g, const Sched& S, const Epi& E) {
    int tid = threadIdx.x; asm volatile("" : "+v"(tid));
    const int wid = __builtin_amdgcn_readfirstlane(tid >> 6), lane = tid & 63, wr = wid >> 2, wc = wid & 3, fr = lane & 15, fq = lane >> 4;
    const int K = g.K, nt = K / BK;
    unsigned voffA[2], voffB[2]; int gR[2], gC[2];
#pragma unroll
    for (int i = 0; i < 2; ++i) { int R, C; stage_rc(tid * 16 + i * 8192, R, C); const int Rb = (R & ~31) + perm32(R & 31); gR[i] = R; gC[i] = C;
        voffA[i] = (unsigned)(R * g.lda + C) * 2u; voffB[i] = (unsigned)(Rb * g.ldb + C) * 2u; }
    const size_t kstep = (size_t)(BK * 2);
    const size_t hsA = (size_t)HALF * g.lda * 2, hsB = (size_t)HALF * g.ldb * 2;
    const unsigned ldsw = (unsigned)wid * 1024u;
    const int aoff = lds_byte(wr * 64 + fr, fq * 8), boff = lds_byte(wc * 32 + fr, fq * 8);
#define PG8_SA(b, h) (((b) * 2 + (h)) * HTB)
#define PG8_SB(b, h) ((4 + (b) * 2 + (h)) * HTB)
#define PG8_STAGE(bufoff, gbase, voff) do { _Pragma("unroll") for (int _i = 0; _i < 2; ++_i) \
        __builtin_amdgcn_global_load_lds((const unsigned*)((const char*)(gbase) + (voff)[_i]), (LAS unsigned*)(lds + (bufoff) + ldsw + _i * 8192), 16, 0, 0); } while (0)
#define PG8_STAGE_A(bufoff, dense_ptr, kbytes, offs) do { if constexpr (GATHER) { PG8_STAGE(bufoff, (const char*)g.A + (kbytes), offs); } else { PG8_STAGE(bufoff, dense_ptr, voffA); } } while (0)
#define PG8_GOFF(u, o0, o1) do { _Pragma("unroll") for (int _i = 0; _i < 2; ++_i) { o0[_i] = (unsigned)(S.arow(u, gR[_i]) * g.lda + gC[_i]) * 2u; o1[_i] = (unsigned)(S.arow(u, gR[_i] + HALF) * g.lda + gC[_i]) * 2u; } } while (0)
#define PG8_LDA(dst, b, h) do { _Pragma("unroll") for (int m = 0; m < 4; ++m) _Pragma("unroll") for (int k = 0; k < 2; ++k) dst[m][k] = *(const LAS bf16x8*)(lds + PG8_SA(b, h) + aoff + m * 2048 + k * 1024); } while (0)
#define PG8_LDB(dst, b, h) do { _Pragma("unroll") for (int n = 0; n < 2; ++n) _Pragma("unroll") for (int k = 0; k < 2; ++k) dst[n][k] = *(const LAS bf16x8*)(lds + PG8_SB(b, h) + boff + n * 2048 + k * 1024); } while (0)
#define PG8_MMA(ai, bj, At, Bt) do { __builtin_amdgcn_s_setprio(1); _Pragma("unroll") for (int m = 0; m < 4; ++m) _Pragma("unroll") for (int n = 0; n < 2; ++n) _Pragma("unroll") for (int k = 0; k < 2; ++k) \
        acc[ai][bj][m][n] = __builtin_amdgcn_mfma_f32_16x16x32_bf16(Bt[n][k], At[m][k], acc[ai][bj][m][n], 0, 0, 0); __builtin_amdgcn_s_setprio(0); } while (0)
#define PG8_WAIT_V(n) asm volatile("s_waitcnt vmcnt(" #n ")" ::: "memory")
#define PG8_WAIT_L(n) asm volatile("s_waitcnt lgkmcnt(" #n ")" ::: "memory")
#define PG8_BAR __builtin_amdgcn_s_barrier()
#define PG8_SCHED __builtin_amdgcn_sched_barrier(0)
    Unit cur, nxt; int ui = 0;
    if (!S.next(0, cur)) return;
    unsigned cO0[2] = {0u, 0u}, cO1[2] = {0u, 0u}, nO0[2] = {0u, 0u}, nO1[2] = {0u, 0u};
    if constexpr (GATHER) { PG8_GOFF(cur, cO0, cO1); }
    S.a_ready(cur);
    f32x4 acc[2][2][4][2];
#pragma unroll
    for (int a = 0; a < 2; ++a)
#pragma unroll
        for (int b = 0; b < 2; ++b)
#pragma unroll
            for (int m = 0; m < 4; ++m)
#pragma unroll
                for (int n = 0; n < 2; ++n) acc[a][b][m][n] = (f32x4){0.f, 0.f, 0.f, 0.f};
    bf16x8 At[4][2], B0[2][2], B1[2][2];
    const char* cA = (const char*)g.A + (GATHER ? (size_t)0 : (size_t)cur.pm * 2 * hsA); const char* cB = (const char*)g.Bt + (size_t)cur.pb * 2 * hsB;
    PG8_STAGE(PG8_SB(0, 0), cB, voffB); PG8_STAGE(PG8_SB(0, 1), cB + hsB, voffB); PG8_STAGE_A(PG8_SA(0, 0), cA, 0, cO0); PG8_STAGE_A(PG8_SA(0, 1), cA + hsA, 0, cO1);
    if (wr == 1) PG8_BAR;
    PG8_WAIT_V(2); PG8_BAR;
    PG8_STAGE(PG8_SB(1, 0), cB + kstep, voffB); PG8_STAGE_A(PG8_SA(1, 0), cA + kstep, kstep, cO0); PG8_STAGE(PG8_SB(1, 1), cB + hsB + kstep, voffB);
    PG8_WAIT_V(6); PG8_BAR;
    for (;;) {
        const bool has_next = S.next(ui + 1, nxt);
        const char* nA = (has_next && !GATHER) ? (const char*)g.A + (size_t)nxt.pm * 2 * hsA : cA; const char* nB = has_next ? (const char*)g.Bt + (size_t)nxt.pb * 2 * hsB : cB;
        if constexpr (GATHER) { if (has_next) { PG8_GOFF(nxt, nO0, nO1); } else { nO0[0] = cO0[0]; nO0[1] = cO0[1]; nO1[0] = cO1[0]; nO1[1] = cO1[1]; } }
        for (int t = 0; t < nt; t += 2) {
            const bool last = (t == nt - 2);
            if (last && has_next) S.a_ready(nxt);
            const char* a1 = cA + (size_t)(t + 1) * kstep;
            const char* a2 = last ? nA : cA + (size_t)(t + 2) * kstep; const char* b2 = last ? nB : cB + (size_t)(t + 2) * kstep;
            const char* a3 = a2 + kstep; const char* b3 = b2 + kstep;
            const size_t k2 = last ? (size_t)0 : (size_t)(t + 2) * kstep;
            unsigned o0[2], o1[2]; o0[0] = last ? nO0[0] : cO0[0]; o0[1] = last ? nO0[1] : cO0[1]; o1[0] = last ? nO1[0] : cO1[0]; o1[1] = last ? nO1[1] : cO1[1];
            PG8_LDB(B0, 0, 0); PG8_LDB(B1, 0, 1); PG8_SCHED; PG8_LDA(At, 0, 0); PG8_STAGE_A(PG8_SA(1, 1), a1 + hsA, (size_t)(t + 1) * kstep, cO1);
            PG8_WAIT_V(8); PG8_WAIT_L(0); PG8_BAR; PG8_MMA(0, 0, At, B0); PG8_MMA(0, 1, At, B1); PG8_BAR; PG8_SCHED;
            PG8_LDA(At, 0, 1); PG8_STAGE(PG8_SB(0, 0), b2, voffB); PG8_STAGE(PG8_SB(0, 1), b2 + hsB, voffB); PG8_STAGE_A(PG8_SA(0, 0), a2, k2, o0);
            PG8_WAIT_V(8); PG8_WAIT_L(0); PG8_BAR; PG8_MMA(1, 0, At, B0); PG8_MMA(1, 1, At, B1); PG8_BAR; PG8_SCHED;
            PG8_LDB(B0, 1, 0); PG8_LDB(B1, 1, 1); PG8_SCHED; PG8_LDA(At, 1, 0); PG8_STAGE_A(PG8_SA(0, 1), a2 + hsA, k2, o1);
            PG8_WAIT_V(8); PG8_WAIT_L(0); PG8_BAR; PG8_MMA(0, 0, At, B0); PG8_MMA(0, 1, At, B1); PG8_BAR; PG8_SCHED;
            PG8_LDA(At, 1, 1); PG8_STAGE(PG8_SB(1, 0), b3, voffB); PG8_STAGE(PG8_SB(1, 1), b3 + hsB, voffB); PG8_STAGE_A(PG8_SA(1, 0), a3, k2 + kstep, o0);
            PG8_WAIT_V(8); PG8_WAIT_L(0); PG8_BAR; PG8_MMA(1, 0, At, B0); PG8_MMA(1, 1, At, B1); PG8_BAR; PG8_SCHED;
        }
        if (wr == 0) PG8_BAR;
        E(acc, cur, wr, wc, fr, fq);
        if (!has_next) break;
#pragma unroll
        for (int a = 0; a < 2; ++a)
#pragma unroll
            for (int b = 0; b < 2; ++b)
#pragma unroll
                for (int m = 0; m < 4; ++m)
#pragma unroll
                    for (int n = 0; n < 2; ++n) acc[a][b][m][n] = (f32x4){0.f, 0.f, 0.f, 0.f};
        cur = nxt; cA = nA; cB = nB; ++ui;
        if constexpr (GATHER) { cO0[0] = nO0[0]; cO0[1] = nO0[1]; cO1[0] = nO1[0]; cO1[1] = nO1[1]; }
        if (wr == 1) PG8_BAR;
    }
    PG8_WAIT_V(0);
    PG8_BAR;
#undef PG8_SA
#undef PG8_SB
#undef PG8_STAGE
#undef PG8_STAGE_A
#undef PG8_GOFF
#undef PG8_LDA
#undef PG8_LDB
#undef PG8_MMA
#undef PG8_WAIT_V
#undef PG8_WAIT_L
#undef PG8_BAR
#undef PG8_SCHED
}

struct EpiStore {
    bf16_t* O; int ldc; const float* ssq; float inv; float* ssq_out0; float* ssq_out1; int pn0, pn1, pn2;
    __device__ __forceinline__ void operator()(const f32x4 (&acc)[2][2][4][2], const Unit& u, int wr, int wc, int fr, int fq) const {
        const int row0 = u.pm * BM + wr * 64 + fr, col0 = u.pn * BM + wc * 32 + 8 * fq;
        float* so = (ssq_out0 && u.pn >= pn0 && u.pn < pn2) ? (u.pn < pn1 ? ssq_out0 : ssq_out1) : nullptr;
        float rsv[2][4];
#pragma unroll
        for (int ai = 0; ai < 2; ++ai)
#pragma unroll
            for (int m = 0; m < 4; ++m) rsv[ai][m] = ssq ? ssq[row0 + ai * HALF + m * 16] : 0.f;
#pragma unroll
        for (int ai = 0; ai < 2; ++ai)
#pragma unroll
            for (int m = 0; m < 4; ++m) { const int row = row0 + ai * HALF + m * 16; const float rs = ssq ? rsqrtf(rsv[ai][m] * inv + EPS) : 1.f;
                bf16_t* rowp = O + (size_t)row * ldc + col0; float ss = 0.f;
#pragma unroll
                for (int bj = 0; bj < 2; ++bj) { const f32x4 v0 = acc[ai][bj][m][0] * rs, v1 = acc[ai][bj][m][1] * rs;
                    ss += (v0[0] * v0[0] + v0[1] * v0[1]) + (v0[2] * v0[2] + v0[3] * v0[3]) + (v1[0] * v1[0] + v1[1] * v1[1]) + (v1[2] * v1[2] + v1[3] * v1[3]);
                    u32x4 w; w.x = cvt_pk_bf16(v0[0], v0[1]); w.y = cvt_pk_bf16(v0[2], v0[3]); w.z = cvt_pk_bf16(v1[0], v1[1]); w.w = cvt_pk_bf16(v1[2], v1[3]);
                    *(u32x4*)(rowp + bj * HALF) = w; }
                if (so) { ss += __shfl_xor(ss, 16); ss += __shfl_xor(ss, 32); if (fq == 0) atomicAdd(so + row, ss); } }
    }
};
struct EpiResid {
    const float* X; float* O; const float* gate; int gpitch;
    __device__ __forceinline__ void operator()(const f32x4 (&acc)[2][2][4][2], const Unit& u, int wr, int wc, int fr, int fq) const {
        const int row0 = u.pm * BM + wr * 64 + fr, col0 = u.pn * BM + wc * 32 + 8 * fq;
        const float* gp = gate + (size_t)((u.pm * BM) / SEQ) * gpitch + col0;
        f32x4 gv[2][2];
#pragma unroll
        for (int bj = 0; bj < 2; ++bj)
#pragma unroll
            for (int n = 0; n < 2; ++n) gv[bj][n] = *(const f32x4*)(gp + bj * HALF + 4 * n);
#pragma unroll
        for (int ai = 0; ai < 2; ++ai)
#pragma unroll
            for (int m = 0; m < 4; ++m) { const size_t off = (size_t)(row0 + ai * HALF + m * 16) * DM + col0;
#pragma unroll
                for (int bj = 0; bj < 2; ++bj)
#pragma unroll
                    for (int n = 0; n < 2; ++n) { const f32x4 xv = *(const f32x4*)(X + off + bj * HALF + 4 * n);
                        *(f32x4*)(O + off + bj * HALF + 4 * n) = xv + gv[bj][n] * acc[ai][bj][m][n]; } }
    }
};
struct EpiSwiGLU {
    bf16_t* O; unsigned* ready;
    __device__ __forceinline__ void operator()(const f32x4 (&acc)[2][2][4][2], const Unit& u, int wr, int wc, int fr, int fq) const {
        const int row0 = u.pm * BM + wr * 64 + fr, col0 = u.pn * HALF + wc * 32 + 8 * fq;
        const __amdgpu_buffer_rsrc_t rs = __builtin_amdgcn_make_buffer_rsrc((void*)O, (short)0, RMAX * DE * 2, 0x00020000);
#pragma unroll
        for (int ai = 0; ai < 2; ++ai)
#pragma unroll
            for (int m = 0; m < 4; ++m) { const int row = row0 + ai * HALF + m * 16;
                float h[8];
#pragma unroll
                for (int n = 0; n < 2; ++n)
#pragma unroll
                    for (int j = 0; j < 4; ++j) { const float gt = acc[ai][0][m][n][j], up = acc[ai][1][m][n][j]; h[4 * n + j] = gt / (1.f + __expf(-gt)) * up; }
                u32x4 w; w.x = cvt_pk_bf16(h[0], h[1]); w.y = cvt_pk_bf16(h[2], h[3]); w.z = cvt_pk_bf16(h[4], h[5]); w.w = cvt_pk_bf16(h[6], h[7]);
                __builtin_amdgcn_raw_buffer_store_b128(w, rs, (unsigned)(row * DE + col0) * 2u, 0, 16); }
        asm volatile("s_waitcnt vmcnt(0)" ::: "memory");
        if ((threadIdx.x & 63) == 0) __hip_atomic_fetch_add(ready + 64 * u.pm, 1u, __ATOMIC_RELAXED, __HIP_MEMORY_SCOPE_AGENT);
    }
};
}
constexpr size_t MiB = 1u << 20;
constexpr size_t WS_CTL = 0, CTL_ZERO_BYTES = 1 * MiB;
constexpr size_t WS_MOD = 1 * MiB;
constexpr size_t WS_ROPEC = 1 * MiB + 512 * 1024;
constexpr size_t WS_ROPES = WS_ROPEC + 2 * MiB;
constexpr size_t WS_WCT = WS_ROPES + 2 * MiB;
constexpr size_t WS_RSTDQ = 6 * MiB;
constexpr size_t WS_RSTDKV = WS_RSTDQ + 64 * 1024;
constexpr size_t WS_TOKE = WS_RSTDKV + 64 * 1024;
constexpr size_t WS_TOKW = WS_TOKE + 128 * 1024;
constexpr size_t WS_TOKS = WS_TOKW + 128 * 1024;
constexpr size_t WS_BLKE = WS_TOKS + 128 * 1024;
constexpr size_t WS_STAMP = WS_BLKE + 4096;
constexpr size_t WS_WIN = 8 * MiB;
constexpr size_t WS_WQUP = 28 * MiB;
constexpr size_t WS_WKVUP = WS_WQUP + 1536 * 1024;
constexpr size_t WS_WOUT = 31 * MiB;
constexpr size_t WS_A = 40 * MiB;
constexpr size_t WS_B = 200 * MiB;
constexpr size_t WS_C = 264 * MiB;
constexpr size_t WS_D = 328 * MiB;
constexpr size_t WS_E = 456 * MiB;
constexpr size_t WS_LIST = 520 * MiB;
constexpr size_t WS_F = 522 * MiB;
constexpr size_t WS_END = 586 * MiB;
constexpr size_t QN_BYTES = (size_t)T * MH * MQK * 2;

constexpr int CW_BAR = 4096;
constexpr int CW_CNT = 8192;
constexpr int CW_RDY = 10240;
constexpr int CW_ADA = 64;
constexpr int CW_TMO = 1;

constexpr int RING_BYTES = 131072, LDS_BYTES = 147456, LDS_USER = 143360, MISC_OFF = LDS_BYTES - 512;

struct Args { const float* in[25]; float* out; unsigned char* ws; int ph_lo, ph_hi, pad0, pad1; };

struct Frame {
    LAS unsigned char* lds;
    volatile LAS unsigned* MISC;
    gu32* ctl;
    int tid, lane, wave, vcu, G;
    unsigned char* ws; float* out;
};

#define OPAQUE_FRAME(F) do { F.tid = threadIdx.x; asm volatile("" : "+v"(F.tid)); F.lane = F.tid & 63; } while (0)

__device__ __forceinline__ void unpack8(const u32x4 w, float* f) { f[0] = bf_lo(w.x); f[1] = bf_hi(w.x); f[2] = bf_lo(w.y); f[3] = bf_hi(w.y); f[4] = bf_lo(w.z); f[5] = bf_hi(w.z); f[6] = bf_lo(w.w); f[7] = bf_hi(w.w); }
__device__ __forceinline__ u32x4 pack8f(const float* f) { u32x4 w; w.x = cvt_pk_bf16(f[0], f[1]); w.y = cvt_pk_bf16(f[2], f[3]); w.z = cvt_pk_bf16(f[4], f[5]); w.w = cvt_pk_bf16(f[6], f[7]); return w; }

struct TrItem { const float* src; bf16_t* dst; bf16_t* dst2; const float* gk; int N, ldt; };
__device__ __forceinline__ void tr_load(const TrItem& it, f32x4 (&r)[16], int lane) {
    const float* p = it.src + (size_t)(lane >> 4) * it.N + 4 * (lane & 15);
#pragma unroll
    for (int i = 0; i < 16; ++i) r[i] = __builtin_nontemporal_load((const f32x4*)(p + (size_t)(4 * i) * it.N));
}
__device__ __forceinline__ void tr_store(const TrItem& it, const f32x4 (&r)[16], LAS unsigned char* Tl, int lane) {
    const int row = lane >> 4, c4 = lane & 15;
#pragma unroll
    for (int i = 0; i < 16; ++i) { f32x4 v = r[i]; if (it.gk) v = v * it.gk[4 * i + row];
        u32x2 w; w.x = cvt_pk_bf16(v.x, v.y); w.y = cvt_pk_bf16(v.z, v.w);
        *(LAS u32x2*)(Tl + ((4 * i + row) * 64 + 4 * c4) * 2) = w; }
    LDS_WAIT(); asm volatile("" ::: "memory");
    const int g = lane >> 4, i16 = lane & 15, q = i16 >> 2, pp = lane & 3;
    typedef short v4i16_t __attribute__((ext_vector_type(4)));
#pragma unroll
    for (int hh = 0; hh < 2; ++hh) { bf16_t* drow = (hh ? it.dst2 : it.dst) + (size_t)(16 * (g & 1) + i16) * it.ldt;
#pragma unroll
        for (int j = 0; j < 4; ++j) { const int kc = 4 * (g >> 1) + j;
            const v4i16_t lo = __builtin_amdgcn_ds_read_tr16_b64_v4i16((LAS v4i16_t*)(Tl + ((8 * kc + q) * 64 + 32 * hh + 16 * (g & 1) + 4 * pp) * 2));
            const v4i16_t hi = __builtin_amdgcn_ds_read_tr16_b64_v4i16((LAS v4i16_t*)(Tl + ((8 * kc + 4 + q) * 64 + 32 * hh + 16 * (g & 1) + 4 * pp) * 2));
            const bf16x8 o = {lo[0], lo[1], lo[2], lo[3], hi[0], hi[1], hi[2], hi[3]};
            *(bf16x8*)(drow + 8 * kc) = o; } }
    LDS_WAIT(); asm volatile("" ::: "memory");
}
template <class MK> __device__ __forceinline__ void tr_run(int first, int step, int n, const MK& mk, LAS unsigned char* Tl, int lane) {
    if (first >= n) return;
    f32x4 ra[16], rb[16];
    TrItem ia = mk(first), ib = ia;
    tr_load(ia, ra, lane);
    for (int idx = first; idx < n; idx += 2 * step) {
        if (idx + step < n) { ib = mk(idx + step); tr_load(ib, rb, lane); }
        tr_store(ia, ra, Tl, lane);
        if (idx + step >= n) break;
        if (idx + 2 * step < n) { ia = mk(idx + 2 * step); tr_load(ia, ra, lane); }
        tr_store(ib, rb, Tl, lane);
    }
}

__device__ __forceinline__ void adaln_phase(Frame& F, const float* c, const float* w_ada, const float* b_ada, float* mod) {
    LAS float* cact = (LAS float*)F.lds;
    LAS float* part = (LAS float*)(F.lds + 65536);
    for (int i = F.tid; i < NB * DM; i += NTHR) cact[i] = siluf(c[i]);
    __syncthreads();
    const int cg = F.tid & 7, rs = F.tid >> 3;
    for (int it = blockIdx.x; it < 6 * DM / 32; it += F.G) {
        const int n0 = it * 32 + cg * 4;
        f32x4 acc[8];
#pragma unroll
        for (int b = 0; b < 8; ++b) acc[b] = (f32x4){0.f, 0.f, 0.f, 0.f};
#pragma unroll 1
        for (int i0 = 0; i0 < 32; i0 += 16) { f32x4 w[16];
#pragma unroll
            for (int u = 0; u < 16; ++u) w[u] = __builtin_nontemporal_load((const f32x4*)(w_ada + (size_t)(rs + 64 * (i0 + u)) * (6 * DM) + n0));
#pragma unroll
            for (int u = 0; u < 16; ++u) { const int k = rs + 64 * (i0 + u);
#pragma unroll
                for (int b = 0; b < 8; ++b) acc[b] += w[u] * cact[b * DM + k]; } }
#pragma unroll
        for (int b = 0; b < 8; ++b) *(LAS f32x4*)(part + (rs * 8 + b) * 32 + cg * 4) = acc[b];
        __syncthreads();
        if (F.tid < 256) { const int b = F.tid >> 5, n = F.tid & 31; float s = 0.f;
#pragma unroll 8
            for (int r = 0; r < 64; ++r) s += part[(r * 8 + b) * 32 + n];
            __hip_atomic_store(mod + b * (6 * DM) + it * 32 + n, s + b_ada[it * 32 + n], __ATOMIC_RELAXED, __HIP_MEMORY_SCOPE_AGENT); }
        asm volatile("s_waitcnt vmcnt(0)" ::: "memory");
        __syncthreads();
        if (it == (int)blockIdx.x && F.tid == 0) __hip_atomic_fetch_add((unsigned*)(F.ctl + CW_ADA), 1u, __ATOMIC_RELAXED, __HIP_MEMORY_SCOPE_AGENT);
    }
}

__device__ __forceinline__ void p0_phase(Frame& F, const Args& a) {
    OPAQUE_FRAME(F);
    unsigned char* ws = F.ws;
    adaln_phase(F, a.in[1], a.in[3], a.in[4], (float*)(ws + WS_MOD));
    __syncthreads();
    LAS unsigned char* Tl = F.lds + F.wave * 8192;
    const int gw = F.vcu * NWAVES + F.wave, NGW = F.G * NWAVES;
    constexpr int I_IN = (DM / 64) * (INC / 64), I_QUP = (QLORA / 64) * (MH * MQK / 64), I_KVUP = (KVLORA / 64) * (MH * 256 / 64), I_OUT = (DM / 64) * (DM / 64);
    constexpr int NITEMS = I_IN + I_QUP + I_KVUP + I_OUT;
    static_assert(INC % 64 == 0, "64-column transpose items");
    { const float* w_in = a.in[6]; const float* w_qup = a.in[10]; const float* w_kvup = a.in[12]; const float* w_out = a.in[16]; const float* gq = a.in[9]; const float* gkv = a.in[11];
      auto mk = [=](int r) -> TrItem { TrItem t;
          if (r < I_IN) { const int nblk = INC / 64, kb = r / nblk, nb = r % nblk; t.src = w_in + (size_t)(64 * kb) * INC + 64 * nb; t.dst = (bf16_t*)(ws + WS_WIN) + (size_t)(64 * nb) * DM + 64 * kb; t.dst2 = t.dst + (size_t)32 * DM; t.gk = nullptr; t.N = INC; t.ldt = DM; return t; } r -= I_IN;
          if (r < I_QUP) { const int nblk = MH * MQK / 64, kb = r / nblk, nb = r % nblk; t.src = w_qup + (size_t)(64 * kb) * (MH * MQK) + 64 * nb; t.dst = (bf16_t*)(ws + WS_WQUP) + (size_t)(64 * nb) * QLORA + 64 * kb; t.dst2 = t.dst + (size_t)32 * QLORA; t.gk = gq + 64 * kb; t.N = MH * MQK; t.ldt = QLORA; return t; } r -= I_QUP;
          if (r < I_KVUP) { const int nblk = MH * 256 / 64, kb = r / nblk, nb = r % nblk; t.src = w_kvup + (size_t)(64 * kb) * (MH * 256) + 64 * nb; t.dst = (bf16_t*)(ws + WS_WKVUP) + (size_t)(64 * nb) * KVLORA + 64 * kb; t.dst2 = t.dst + (size_t)32 * KVLORA; t.gk = gkv + 64 * kb; t.N = MH * 256; t.ldt = KVLORA; return t; } r -= I_KVUP;
          { const int nblk = DM / 64, kb = r / nblk, nb = r % nblk; t.src = w_out + (size_t)(64 * kb) * DM + 64 * nb; t.dst = (bf16_t*)(ws + WS_WOUT) + (size_t)(64 * nb) * DM + 64 * kb; t.dst2 = t.dst + (size_t)32 * DM; t.gk = nullptr; t.N = DM; t.ldt = DM; return t; } };
      const int nheavy = (6 * DM / 32) - F.G, nlw = (F.G - nheavy) * NWAVES;
      int pre = 0;
      if (nheavy > 0 && nheavy < F.G) { pre = 2 * nlw < NITEMS ? 2 * nlw : NITEMS;
          if ((int)blockIdx.x >= nheavy) tr_run(((int)blockIdx.x - nheavy) * NWAVES + F.wave, nlw, pre, mk, Tl, F.lane); }
      tr_run(pre + gw, NGW, NITEMS, mk, Tl, F.lane); }
    { const int* pos = (const int*)a.in[2]; float* rc = (float*)(ws + WS_ROPEC); float* rsn = (float*)(ws + WS_ROPES);
      const int gt = F.vcu * NTHR + F.tid, NGT = F.G * NTHR;
      const float invf = (float)exp2(-(double)(gt & 31) * (13.287712379549449 / 32.0));
      for (int e = gt; e < T * 32; e += NGT) { const int tk = e >> 5;
          const float ang = (float)pos[tk] * invf; float sv, cv; sincosf(ang, &sv, &cv);
          rc[e] = cv; rsn[e] = sv; }
      { float* ssq = (float*)(ws + WS_RSTDQ); for (int e = gt; e < 2 * T; e += NGT) ssq[e] = 0.f; }
      float* wct = (float*)(ws + WS_WCT);
      for (int e = gt; e < 48 * DM; e += NGT) { const int n = e / DM, k = e % DM;
          wct[e] = n < 4 ? a.in[18][k * NG + n] : (n < 36 ? a.in[20][k * NE + (n - 4)] : 0.f); } }
}

__device__ __forceinline__ void p1_phase(Frame& F, const Args& a) {
    OPAQUE_FRAME(F);
    const int gw = F.vcu * NWAVES + F.wave, NGW = F.G * NWAVES;
    const float* mod = (const float*)(F.ws + WS_MOD); const float* g = a.in[5]; const float* x = a.in[0];
    bf16_t* H = (bf16_t*)(F.ws + WS_B);
    if (F.tid == 0) { unsigned polls = 0;
        while (__hip_atomic_load((unsigned*)(F.ctl + CW_ADA), __ATOMIC_RELAXED, __HIP_MEMORY_SCOPE_AGENT) < (unsigned)F.G) { if (++polls > (1u << 16)) { __hip_atomic_store((unsigned*)(F.ctl + CW_TMO), 0xADA00000u, __ATOMIC_RELAXED, __HIP_MEMORY_SCOPE_AGENT); break; } __builtin_amdgcn_s_sleep(2); }
        __builtin_amdgcn_fence(__ATOMIC_ACQUIRE, "agent"); asm volatile("s_waitcnt vmcnt(0)" ::: "memory"); }
    __syncthreads();
    for (int blk = gw; blk < T / 8; blk += NGW) { const int m0 = blk * 8, b = m0 / SEQ;
        const float* shift = mod + b * (6 * DM); const float* scale = shift + DM;
        f32x4 gm[8], sh[8];
#pragma unroll
        for (int j = 0; j < 8; ++j) { gm[j] = ((const f32x4*)g)[64 * j + F.lane] * (((const f32x4*)scale)[64 * j + F.lane] + 1.f); sh[j] = ((const f32x4*)shift)[64 * j + F.lane]; }
        f32x4 va[8], vb[8];
#define P1_LD(r, V) do { const f32x4* xr_ = (const f32x4*)(x + (size_t)(m0 + (r)) * DM) + F.lane; _Pragma("unroll") for (int j = 0; j < 8; ++j) V[j] = __builtin_nontemporal_load(xr_ + 64 * j); } while (0)
#define P1_ST(r, V) do { float s_ = 0.f; _Pragma("unroll") for (int j = 0; j < 8; ++j) s_ += (V[j].x * V[j].x + V[j].y * V[j].y) + (V[j].z * V[j].z + V[j].w * V[j].w); \
            const float rstd_ = rsqrtf(wave_sum(s_) * (1.f / DM) + EPS); u32x2* o8_ = (u32x2*)(H + (size_t)(m0 + (r)) * DM) + F.lane; \
            _Pragma("unroll") for (int j = 0; j < 8; ++j) { const f32x4 h_ = V[j] * rstd_ * gm[j] + sh[j]; u32x2 w_; w_.x = cvt_pk_bf16(h_.x, h_.y); w_.y = cvt_pk_bf16(h_.z, h_.w); o8_[64 * j] = w_; } } while (0)
        P1_LD(0, va);
#pragma unroll 1
        for (int r = 0; r < 8; r += 2) {
            P1_LD(r + 1, vb); __builtin_amdgcn_sched_barrier(0);
            P1_ST(r, va); __builtin_amdgcn_sched_barrier(0);
            if (r + 2 < 8) { P1_LD(r + 2, va); } __builtin_amdgcn_sched_barrier(0);
            P1_ST(r + 1, vb); __builtin_amdgcn_sched_barrier(0);
        }
#undef P1_LD
#undef P1_ST
    }
}

namespace hg {
constexpr int OFF_F = 0, OFF_SEG = 32768, OFF_QIN = 34816, RP = 272, OFF_KIN = OFF_QIN + 64 * RP, OFF_QB = OFF_KIN + 64 * RP, OFF_KLT = OFF_QB + 64 * RP, SP = 144,
              OFF_VT = OFF_KLT + 128 * SP  , OFF_DEC = OFF_VT + 64 * SP  , OFF_SF = OFF_DEC + 3584  , OP = 144, OFF_O = OFF_SF + 16384  , HG_LDS = OFF_O + 64 * OP;
static_assert(HG_LDS <= MISC_OFF, "hgrn lds");
__device__ __forceinline__ float dpp_xor1(float v) { return __builtin_bit_cast(float, __builtin_amdgcn_update_dpp(0, __builtin_bit_cast(int, v), 0xB1, 0xF, 0xF, true)); }
__device__ __forceinline__ int ppos(int s) { return (s & ~15) | ((s & 4) << 1) | ((s & 8) >> 1) | (s & 3); }
}
__device__ __forceinline__ void hgrn_chunked(Frame& F, const Args& a, int item) {
    using namespace hg;
    const bf16_t* PROJ = (const bf16_t*)(F.ws + WS_A);
    bf16_t* MIX = (bf16_t*)F.out;
    const float* lbl = a.in[7];
    LAS unsigned char* L = F.lds;
    LAS float* Fs = (LAS float*)(L + OFF_F); LAS float* SEGs = (LAS float*)(L + OFF_SEG); LAS float* DEC = (LAS float*)(L + OFF_DEC); LAS float* POST = DEC + 384;
    const int g = F.tid & 15, t0 = F.tid >> 4;
    const int sk = F.tid & 127, sseg = F.tid >> 7;
    const int r32 = F.lane & 31, hi = F.lane >> 5;
    {
        const int dq2 = (item >> 3) & 1, bh = (item >> 4) * 8 + (item & 7), h = bh & 7, b = bh >> 3;
        float lb[8];
#pragma unroll
        for (int j = 0; j < 8; ++j) { const int k = h * 128 + g * 8 + j; lb[j] = 1.f / (1.f + __expf(lbl[HW + k] - lbl[k])); }
        const bf16_t* base = PROJ + (size_t)(b * SEQ) * INCP + h * 128;
        f32x16 S0 = {}, S1 = {};
        u32x4 gq[2], gf[2], gv;
#define HG_LOADF(c) do { _Pragma("unroll") for (int i = 0; i < 2; ++i) gf[i] = *(const u32x4*)(base + (size_t)((c) * 64 + t0 + 32 * i) * INCP + g * 8 + HW); } while (0)
#define HG_LOADQ(c) do { _Pragma("unroll") for (int i = 0; i < 2; ++i) gq[i] = *(const u32x4*)(base + (size_t)((c) * 64 + t0 + 32 * i) * INCP + g * 8); \
            gv = *(const u32x4*)(base + (size_t)((c) * 64 + (F.tid >> 3)) * INCP + 2 * HW + dq2 * 64 + (F.tid & 7) * 8); } while (0)
        HG_LOADF(0); HG_LOADQ(0);
        for (int c = 0; c < SEQ / 64; ++c) {
            if (F.wave >= 4) { const int kb = F.wave - 4;
#pragma unroll
                for (int s2 = 0; s2 < 2; ++s2) { u32x4 w0, w1;
                    w0.x = cvt_pk_bf16(S0[8 * s2], S0[8 * s2 + 1]); w0.y = cvt_pk_bf16(S0[8 * s2 + 2], S0[8 * s2 + 3]); w0.z = cvt_pk_bf16(S0[8 * s2 + 4], S0[8 * s2 + 5]); w0.w = cvt_pk_bf16(S0[8 * s2 + 6], S0[8 * s2 + 7]);
                    w1.x = cvt_pk_bf16(S1[8 * s2], S1[8 * s2 + 1]); w1.y = cvt_pk_bf16(S1[8 * s2 + 2], S1[8 * s2 + 3]); w1.z = cvt_pk_bf16(S1[8 * s2 + 4], S1[8 * s2 + 5]); w1.w = cvt_pk_bf16(S1[8 * s2 + 6], S1[8 * s2 + 7]);
                    *(LAS u32x4*)(L + OFF_SF + ((((kb * 2 + 0) * 2 + s2) * 64) + F.lane) * 16) = w0;
                    *(LAS u32x4*)(L + OFF_SF + ((((kb * 2 + 1) * 2 + s2) * 64) + F.lane) * 16) = w1; } }
            float fv[2][8];
#pragma unroll
            for (int i = 0; i < 2; ++i) { float fl[8]; unpack8(gf[i], fl);
#pragma unroll
                for (int j = 0; j < 8; ++j) { const float sg = __builtin_amdgcn_rcpf(1.f + __builtin_amdgcn_exp2f(-1.4426950408889634f * fl[j])); fv[i][j] = lb[j] + (1.f - lb[j]) * sg; }
                LAS float* fp = Fs + (t0 + 32 * i) * 128 + g * 8;
                *(LAS f32x4*)fp = (f32x4){fv[i][0], fv[i][1], fv[i][2], fv[i][3]}; *(LAS f32x4*)(fp + 4) = (f32x4){fv[i][4], fv[i][5], fv[i][6], fv[i][7]}; }
            if (c + 1 < SEQ / 64) HG_LOADF(c + 1);
            __syncthreads();
            float klp[16];
            { float fr[16];
#pragma unroll
              for (int i = 0; i < 16; ++i) fr[i] = Fs[(16 * sseg + i) * 128 + sk];
              float p = 1.f;
#pragma unroll
              for (int i = 0; i < 16; ++i) { p *= fr[i]; Fs[(16 * sseg + i) * 128 + sk] = p; }
              SEGs[sseg * 128 + sk] = p;
              float q = 1.f;
#pragma unroll
              for (int i = 15; i >= 0; --i) { klp[i] = (1.f - fr[i]) * q; q *= fr[i]; } }
            __syncthreads();
            if (F.tid < 128) { const float s0 = SEGs[F.tid], s1 = SEGs[128 + F.tid], s2 = SEGs[256 + F.tid], s3 = SEGs[384 + F.tid];
                const float pm = s0 * s1;
                SEGs[F.tid] = 1.f; SEGs[128 + F.tid] = s0; SEGs[256 + F.tid] = pm; SEGs[384 + F.tid] = pm * s2;
                POST[F.tid] = s1 * s2 * s3; POST[128 + F.tid] = s2 * s3; POST[256 + F.tid] = s3; POST[384 + F.tid] = 1.f;
                DEC[F.tid] = pm * s2 * s3; DEC[128 + F.tid] = pm; DEC[256 + F.tid] = __builtin_amdgcn_rcpf(pm); }
            __syncthreads();
            { { const float po = POST[sseg * 128 + sk];
                float o16[16];
#pragma unroll
                for (int p = 0; p < 16; ++p) o16[p] = klp[8 * ((p >> 2) & 1) + 4 * (p >> 3) + (p & 3)] * po;
                *(LAS u32x4*)(L + OFF_KLT + sk * SP + sseg * 32) = pack8f(o16); *(LAS u32x4*)(L + OFF_KLT + sk * SP + sseg * 32 + 16) = pack8f(o16 + 8); }
#pragma unroll
              for (int i = 0; i < 2; ++i) { const int t = t0 + 32 * i;
                  float qin[8], kin[8], qb[8], qv[8];
                  unpack8(gq[i], qv);
                  const LAS float* fp = Fs + t * 128 + g * 8; const LAS float* pp = SEGs + (t >> 4) * 128 + g * 8;
                  const f32x4 pa = *(const LAS f32x4*)fp, pb = *(const LAS f32x4*)(fp + 4), ea = *(const LAS f32x4*)pp, eb = *(const LAS f32x4*)(pp + 4);
                  const f32x4 ma = *(const LAS f32x4*)(DEC + 128 + g * 8), mb = *(const LAS f32x4*)(DEC + 128 + g * 8 + 4), ra = *(const LAS f32x4*)(DEC + 256 + g * 8), rb = *(const LAS f32x4*)(DEC + 256 + g * 8 + 4);
#pragma unroll
                  for (int j = 0; j < 8; ++j) { const float P = (j < 4 ? pa[j] * ea[j] : pb[j - 4] * eb[j - 4]), pm = j < 4 ? ma[j] : mb[j - 4], rpm = j < 4 ? ra[j] : rb[j - 4];
                      const float r = __builtin_amdgcn_rcpf(P), kk = 1.f - fv[i][j], qs = qv[j] * 0.08838834764831845f;
                      qb[j] = qs * P; qin[j] = qb[j] * rpm; kin[j] = kk * pm * r; }
                  *(LAS u32x4*)(L + OFF_QIN + t * RP + g * 16) = pack8f(qin);
                  *(LAS u32x4*)(L + OFF_KIN + t * RP + g * 16) = pack8f(kin);
                  { const u32x4 w = pack8f(qb);
                    *(LAS u32x2*)(L + OFF_QB + t * RP + ((g >> 1) * 16 + (g & 1) * 4) * 2) = (u32x2){w.x, w.y};
                    *(LAS u32x2*)(L + OFF_QB + t * RP + ((g >> 1) * 16 + 8 + (g & 1) * 4) * 2) = (u32x2){w.z, w.w}; } }
              { float v[8]; unpack8(gv, v); const int s = F.tid >> 3, dvg = F.tid & 7, ps = ppos(s);
#pragma unroll
                  for (int j = 0; j < 8; ++j) *(LAS bf16_t*)(L + OFF_VT + (dvg * 8 + j) * SP + ps * 2) = (bf16_t)(__builtin_bit_cast(unsigned, v[j]) >> 16); } }
            if (c + 1 < SEQ / 64) HG_LOADQ(c + 1);
            __syncthreads();
            if (F.wave < 4) { const int tb = F.wave & 1, dvb = F.wave >> 1;
                f32x16 o = {};
                for (int sb = 0; sb <= tb; ++sb) { f32x16 X = {};
#pragma unroll
                    for (int ks = 0; ks < 8; ++ks) { const bf16x8 af = *(const LAS bf16x8*)(L + OFF_KIN + (32 * sb + r32) * RP + (16 * ks + 8 * hi) * 2);
                        const bf16x8 bfr = *(const LAS bf16x8*)(L + OFF_QIN + (32 * tb + r32) * RP + (16 * ks + 8 * hi) * 2);
                        X = __builtin_amdgcn_mfma_f32_32x32x16_bf16(af, bfr, X, 0, 0, 0); }
                    if (sb == tb) {
#pragma unroll
                        for (int r = 0; r < 16; ++r) { const int srow = (r & 3) + 8 * (r >> 2) + 4 * hi; if (srow > r32) X[r] = 0.f; } }
#pragma unroll
                    for (int s2 = 0; s2 < 2; ++s2) { u32x4 w; w.x = cvt_pk_bf16(X[8 * s2], X[8 * s2 + 1]); w.y = cvt_pk_bf16(X[8 * s2 + 2], X[8 * s2 + 3]); w.z = cvt_pk_bf16(X[8 * s2 + 4], X[8 * s2 + 5]); w.w = cvt_pk_bf16(X[8 * s2 + 6], X[8 * s2 + 7]);
                        const bf16x8 vf = *(const LAS bf16x8*)(L + OFF_VT + (32 * dvb + r32) * SP + (32 * sb + 16 * s2 + 8 * hi) * 2);
                        o = __builtin_amdgcn_mfma_f32_32x32x16_bf16(__builtin_bit_cast(bf16x8, w), vf, o, 0, 0, 0); } }
#pragma unroll
                for (int kb = 0; kb < 4; ++kb)
#pragma unroll
                    for (int s2 = 0; s2 < 2; ++s2) { const bf16x8 sf = *(const LAS bf16x8*)(L + OFF_SF + ((((kb * 2 + dvb) * 2 + s2) * 64) + F.lane) * 16);
                        const bf16x8 qf = *(const LAS bf16x8*)(L + OFF_QB + (32 * tb + r32) * RP + (32 * kb + 16 * s2 + 8 * hi) * 2);
                        o = __builtin_amdgcn_mfma_f32_32x32x16_bf16(qf, sf, o, 0, 0, 0); }
                unsigned ow[16];
#pragma unroll
                for (int r = 0; r < 16; ++r) ow[r] = cvt_pk_bf16(o[r], dpp_xor1(o[r]));
                if ((r32 & 1) == 0) { LAS unsigned char* ob = L + OFF_O + (32 * tb + 4 * hi) * OP + (32 * dvb + r32) * 2;
#pragma unroll
                    for (int r = 0; r < 16; ++r) *(LAS unsigned*)(ob + ((r & 3) + 8 * (r >> 2)) * OP) = ow[r]; }
            } else { const int kb = F.wave - 4;
#pragma unroll
                for (int r = 0; r < 16; ++r) { const float dcy = DEC[32 * kb + (r & 3) + 8 * (r >> 2) + 4 * hi]; S0[r] *= dcy; S1[r] *= dcy; }
#pragma unroll
                for (int ss = 0; ss < 4; ++ss) { const bf16x8 kf = *(const LAS bf16x8*)(L + OFF_KLT + (32 * kb + r32) * SP + (16 * ss + 8 * hi) * 2);
                    const bf16x8 vf0 = *(const LAS bf16x8*)(L + OFF_VT + r32 * SP + (16 * ss + 8 * hi) * 2), vf1 = *(const LAS bf16x8*)(L + OFF_VT + (32 + r32) * SP + (16 * ss + 8 * hi) * 2);
                    S0 = __builtin_amdgcn_mfma_f32_32x32x16_bf16(kf, vf0, S0, 0, 0, 0); S1 = __builtin_amdgcn_mfma_f32_32x32x16_bf16(kf, vf1, S1, 0, 0, 0); }
            }
            __syncthreads();
            { const int row = F.tid >> 3, pc = F.tid & 7;
              const u32x4 w = *(const LAS u32x4*)(L + OFF_O + row * OP + pc * 16);
              *(u32x4*)(MIX + (size_t)(b * SEQ + c * 64 + row) * DM + h * 128 + dq2 * 64 + pc * 8) = w; }
        }
#undef HG_LOADF
#undef HG_LOADQ
    }
}

constexpr int MOE_IG = NE * (DM / 64) * (DE / 64);
constexpr int MOE_PRE = 7168;
struct MoeItems { const float* wg; const float* wu; const float* wd; unsigned char* ws;
    __device__ TrItem operator()(int it) const { TrItem t; t.gk = nullptr;
        const int which = it / MOE_IG, r = it % MOE_IG;
        if (which < 2) { const int e = r / 256, q = r % 256, kb = q / 8, nb = q % 8, n0 = 64 * nb;
            t.src = (which ? wu : wg) + (size_t)e * DM * DE + (size_t)(64 * kb) * DE + n0;
            t.dst = (bf16_t*)(ws + WS_D) + ((size_t)e * 1024 + (n0 >> 7) * 256 + (n0 & 127) + which * 128) * DM + 64 * kb; t.dst2 = t.dst + (size_t)32 * DM; t.N = DE; t.ldt = DM; }
        else { const int e = r / 256, q = r % 256, kb = q / 32, nb = q % 32, n0 = 64 * nb;
            t.src = wd + (size_t)e * DE * DM + (size_t)(64 * kb) * DM + n0;
            t.dst = (bf16_t*)(ws + WS_E) + ((size_t)e * DM + n0) * DE + 64 * kb; t.dst2 = t.dst + (size_t)32 * DE; t.N = DM; t.ldt = DE; }
        return t; } };

__device__ __forceinline__ void p3_phase(Frame& F, const Args& a) {
    OPAQUE_FRAME(F);
    const int role = ((int)blockIdx.x >> 3) & 1, idx = ((int)blockIdx.x >> 4) * 8 + ((int)blockIdx.x & 7), half = F.G >> 1;
    unsigned char* ws = F.ws;
    if (role == 0) { for (int it = idx; it < NB * HH * 2; it += half) hgrn_chunked(F, a, it); }
    else {
        { pg8::Gemm g{(const bf16_t*)(ws + WS_A) + C_QA, (const bf16_t*)(ws + WS_WQUP), INCP, QLORA, QLORA};
          pg8::DenseOrder S; S.init(T / 256, MH * MQK / 256, half, idx);
          pg8::EpiStore E{(bf16_t*)(ws + WS_B), MH * MQK, (const float*)(ws + WS_RSTDQ), 1.f / QLORA};
          pg8::gemm_phase<pg8::EpiStore, pg8::DenseOrder>(F.lds, g, S, E); }
        { pg8::Gemm g{(const bf16_t*)(ws + WS_A) + C_KVA, (const bf16_t*)(ws + WS_WKVUP), INCP, KVLORA, KVLORA};
          pg8::DenseOrder S; S.init(T / 256, MH * 256 / 256, half, idx);
          pg8::EpiStore E{(bf16_t*)(ws + WS_C), MH * 256, (const float*)(ws + WS_RSTDKV), 1.f / KVLORA};
          pg8::gemm_phase<pg8::EpiStore, pg8::DenseOrder>(F.lds, g, S, E); }
        { const MoeItems mk{a.in[22], a.in[23], a.in[24], ws};
          tr_run(idx * NWAVES + F.wave, half * NWAVES, MOE_PRE, mk, F.lds + F.wave * 8192, F.lane); }
    }
}

__device__ __forceinline__ float sum8(float v) { v += __shfl_xor(v, 1); v += __shfl_xor(v, 2); v += __shfl_xor(v, 4); return v; }

struct P5Set { u32x4 k0, k1, kpe, m0, m1, g0, g1; f32x4 ca, cb, sa, sb; };
__device__ __forceinline__ void p5_phase(Frame& F, const Args& a) {
    OPAQUE_FRAME(F);
    const int gw = F.vcu * NWAVES + F.wave, NGW = F.G * NWAVES;
    const bf16_t* PROJ = (const bf16_t*)(F.ws + WS_A);
    const bf16_t* KV = (const bf16_t*)(F.ws + WS_C);
    bf16_t* Kn = (bf16_t*)(F.ws + WS_F);
    bf16_t* MIX = (bf16_t*)F.out;
    const float* rc = (const float*)(F.ws + WS_ROPEC); const float* rsn = (const float*)(F.ws + WS_ROPES);
    const int h = F.lane >> 3, sub = F.lane & 7;
    const float sgn = sub < 4 ? -1.f : 1.f;
    float gk[3][8], go[2][8];
#pragma unroll
    for (int i = 0; i < 3; ++i)
#pragma unroll
        for (int j = 0; j < 8; ++j) gk[i][j] = a.in[14][(sub + 8 * i) * 8 + j];
#pragma unroll
    for (int i = 0; i < 2; ++i)
#pragma unroll
        for (int j = 0; j < 8; ++j) go[i][j] = a.in[8][(sub + 8 * i) * 8 + j];
#define P5_LD(t_, S_) do { const size_t t__ = (size_t)(t_); const int ii_ = (sub & 3) * 8; \
        S_.k0 = __builtin_nontemporal_load((const u32x4*)(KV + t__ * (MH * 256) + h * 256 + sub * 8)); S_.k1 = __builtin_nontemporal_load((const u32x4*)(KV + t__ * (MH * 256) + h * 256 + (sub + 8) * 8)); \
        S_.kpe = *(const u32x4*)(PROJ + t__ * INCP + C_KPE + sub * 8); \
        S_.ca = *(const f32x4*)(rc + t__ * 32 + ii_); S_.cb = *(const f32x4*)(rc + t__ * 32 + ii_ + 4); S_.sa = *(const f32x4*)(rsn + t__ * 32 + ii_); S_.sb = *(const f32x4*)(rsn + t__ * 32 + ii_ + 4); \
        S_.m0 = *(const u32x4*)(MIX + t__ * DM + h * 128 + sub * 8); S_.m1 = *(const u32x4*)(MIX + t__ * DM + h * 128 + (sub + 8) * 8); \
        S_.g0 = __builtin_nontemporal_load((const u32x4*)(PROJ + t__ * INCP + 3 * HW + h * 128 + sub * 8)); S_.g1 = __builtin_nontemporal_load((const u32x4*)(PROJ + t__ * INCP + 3 * HW + h * 128 + (sub + 8) * 8)); } while (0)
#define P5_CP(t_, S_) do { const int t__ = (t_), b_ = t__ / SEQ, s_ = t__ % SEQ; const size_t hrow = ((size_t)(b_ * MH + h) * SEQ + s_); \
        { float k[3][8]; float ss = 0.f; unpack8(S_.k0, k[0]); unpack8(S_.k1, k[1]); unpack8(S_.kpe, k[2]); \
          _Pragma("unroll") for (int i = 0; i < 3; ++i) _Pragma("unroll") for (int j = 0; j < 8; ++j) ss += k[i][j] * k[i][j]; \
          const float rs = rsqrtf(sum8(ss) * (1.f / MQK) + EPS); \
          _Pragma("unroll") for (int i = 0; i < 3; ++i) _Pragma("unroll") for (int j = 0; j < 8; ++j) k[i][j] *= rs * gk[i][j]; \
          _Pragma("unroll") for (int j = 0; j < 8; ++j) { const float pv = __shfl_xor(k[2][j], 4); const float cs_ = j < 4 ? S_.ca[j & 3] : S_.cb[j & 3], sn_ = j < 4 ? S_.sa[j & 3] : S_.sb[j & 3]; k[2][j] = k[2][j] * cs_ + sgn * pv * sn_; } \
          _Pragma("unroll") for (int i = 0; i < 3; ++i) *(u32x4*)(Kn + hrow * MQK + (sub + 8 * i) * 8) = pack8f(k[i]); } \
        { float o[2][8], gt[2][8]; float ss = 0.f; unpack8(S_.m0, o[0]); unpack8(S_.m1, o[1]); unpack8(S_.g0, gt[0]); unpack8(S_.g1, gt[1]); \
          _Pragma("unroll") for (int i = 0; i < 2; ++i) _Pragma("unroll") for (int j = 0; j < 8; ++j) ss += o[i][j] * o[i][j]; \
          const float rs = rsqrtf(sum8(ss) * (1.f / HDV) + EPS); \
          _Pragma("unroll") for (int i = 0; i < 2; ++i) { _Pragma("unroll") for (int j = 0; j < 8; ++j) o[i][j] = o[i][j] * rs * go[i][j] * siluf(gt[i][j]); \
              *(u32x4*)(MIX + (size_t)t__ * DM + h * 128 + (sub + 8 * i) * 8) = pack8f(o[i]); } } } while (0)
    for (int blk = gw; blk < T / 8; blk += NGW) { const int t0 = blk * 8;
        P5Set A, B;
        P5_LD(t0, A);
#pragma unroll 1
        for (int r = 0; r < 8; r += 2) {
            P5_LD(t0 + r + 1, B); __builtin_amdgcn_sched_barrier(0);
            P5_CP(t0 + r, A); __builtin_amdgcn_sched_barrier(0);
            if (r + 2 < 8) { P5_LD(t0 + r + 2, A); } __builtin_amdgcn_sched_barrier(0);
            P5_CP(t0 + r + 1, B); __builtin_amdgcn_sched_barrier(0);
        }
    }
#undef P5_LD
#undef P5_CP
}
namespace att {
constexpr int QBLK = 32, KVBLK = 64, QB = 256;
constexpr int KROW = 512, SHM_K = KVBLK * KROW, SHM_V = KVBLK * MV * 2;
constexpr int OFF_V = 0, OFF_K = 2 * SHM_V, OFF_WS = OFF_K + 2 * SHM_K;
constexpr float SCALE = 0.07216878364870322f;
constexpr float THR = 8.f;
#define SBAR() __builtin_amdgcn_sched_barrier(0)
__device__ __forceinline__ int v_st(int k, int c) { const int kk = (k & ~0xC) | ((k & 4) << 1) | ((k & 8) >> 1); return ((kk >> 3) * 4 + (c >> 5)) * 512 + ((kk & 7) * 32 + (c & 31)) * 2; }
__device__ __forceinline__ int v_rd_base(int lane) { return ((lane & 3) << 3) | (((lane >> 2) & 3) << 6) | (((lane >> 4) & 1) << 5) | (((lane >> 5) & 1) << 8); }
constexpr int v_rd_off(int d0, int ks, int half) { return d0 * 512 + ks * 4096 + half * 2048; }
__device__ __forceinline__ int crow(int r, int hi) { return (r & 3) + 8 * (r >> 2) + 4 * hi; }
template <int M> __device__ __forceinline__ float swz_xor(float v) { return __builtin_bit_cast(float, __builtin_amdgcn_ds_swizzle(__builtin_bit_cast(int, v), (M << 10) | 0x1F)); }
__device__ __forceinline__ unsigned cvtpk(float lo, float hi) { unsigned r; asm volatile("v_cvt_pk_bf16_f32 %0, %1, %2" : "=v"(r) : "v"(lo), "v"(hi)); return r; }

__device__ __forceinline__ void mask_tile(f32x16& p0, f32x16& p1, int dq) {
    const float NEG = -__builtin_inff();
#pragma unroll
    for (int r = 0; r < 16; ++r) {
        const int c = (r & 3) + 8 * (r >> 2);
        if (dq - c < 0) p0[r] = NEG;
        if (dq - c - 32 < 0) p1[r] = NEG;
    }
}
__device__ __forceinline__ void partialSM(f32x16& p0, f32x16& p1, float& m_reg, float& mn, float& alpha) {
    float pmax = p0[0];
#pragma unroll
    for (int r = 1; r < 16; ++r) pmax = fmaxf(pmax, p0[r]);
#pragma unroll
    for (int r = 0; r < 16; ++r) pmax = fmaxf(pmax, p1[r]);
    { auto rr = __builtin_amdgcn_permlane32_swap(__float_as_uint(pmax), __float_as_uint(pmax), false, false);
      pmax = fmaxf(__uint_as_float(rr[0]), __uint_as_float(rr[1])); }
    constexpr float C2 = 1.4426950408889634f * SCALE;
    if (__builtin_expect(__all((pmax - m_reg) * SCALE <= THR), 1)) { mn = m_reg; alpha = 1.f; }
    else { mn = fmaxf(m_reg, pmax); alpha = __builtin_amdgcn_exp2f((m_reg - mn) * C2); m_reg = mn; }
    const float mnL = -mn * C2;
#pragma unroll
    for (int r = 0; r < 16; ++r) p0[r] = fmaf(p0[r], C2, mnL);
#pragma unroll
    for (int r = 0; r < 16; ++r) p1[r] = fmaf(p1[r], C2, mnL);
#pragma unroll
    for (int r = 0; r < 16; ++r) p0[r] = __builtin_amdgcn_exp2f(p0[r]);
}
__device__ __forceinline__ void finishSM(f32x16& p0, f32x16& p1, float alpha, float& l_reg, bf16x8& pa0, bf16x8& pa1, bf16x8& pa2, bf16x8& pa3) {
#pragma unroll
    for (int r = 0; r < 16; ++r) p1[r] = __builtin_amdgcn_exp2f(p1[r]);
    float ps = 0;
#pragma unroll
    for (int r = 0; r < 16; ++r) ps += p0[r];
#pragma unroll
    for (int r = 0; r < 16; ++r) ps += p1[r];
    { auto rr = __builtin_amdgcn_permlane32_swap(__float_as_uint(ps), __float_as_uint(ps), false, false);
      ps = __uint_as_float(rr[0]) + __uint_as_float(rr[1]); }
    l_reg = l_reg * alpha + ps;
#define PK4(P, B_, OUT) do { unsigned a0 = cvtpk(P[B_+0], P[B_+1]), a1 = cvtpk(P[B_+2], P[B_+3]);                          \
        unsigned b0 = cvtpk(P[B_+4], P[B_+5]), b1 = cvtpk(P[B_+6], P[B_+7]);                                             \
        auto r0 = __builtin_amdgcn_permlane32_swap(a0, b0, false, false); auto r1 = __builtin_amdgcn_permlane32_swap(a1, b1, false, false); \
        u32x4 w = {r0[0], r1[0], r0[1], r1[1]}; OUT = __builtin_bit_cast(bf16x8, w); } while (0)
    PK4(p0, 0, pa0); PK4(p0, 8, pa1); PK4(p1, 0, pa2); PK4(p1, 8, pa3);
#undef PK4
}
template <int KB>
__device__ __forceinline__ void qkt(f32x16& p0, f32x16& p1, LAS unsigned char* lds, int r32, int hi, const bf16x8* qr) {
    p0 = f32x16{}; p1 = f32x16{};
    int sw = r32 & 15; asm volatile("" : "+v"(sw));
    const int rb = OFF_K + KB * SHM_K + r32 * KROW;
    int ab[8];
#pragma unroll
    for (int d = 0; d < 8; ++d) ab[d] = rb + (((2 * d + hi) ^ sw) << 4);
#pragma unroll
    for (int d0 = 0; d0 < 12; ++d0) { const int a = ab[d0 & 7] + (d0 >> 3) * 256;
        const bf16x8 b0 = *(const LAS bf16x8*)(lds + a);
        const bf16x8 b1 = *(const LAS bf16x8*)(lds + a + 32 * KROW);
        p0 = __builtin_amdgcn_mfma_f32_32x32x16_bf16(b0, qr[d0], p0, 0, 0, 0);
        p1 = __builtin_amdgcn_mfma_f32_32x32x16_bf16(b1, qr[d0], p1, 0, 0, 0); }
}
template <int VB>
__device__ __forceinline__ void pv_tile(f32x16* o, int vb0, bf16x8 pa0, bf16x8 pa1, bf16x8 pa2, bf16x8 pa3) {
#define TRRD(dst, off) asm volatile("ds_read_b64_tr_b16 %0, %1 offset:%2" : "=&v"(dst) : "v"(vb0), "i"(off) : "memory")
#define PV_D0(d0) do { s16x4 l0, l1, l2, l3, h0, h1, h2, h3; constexpr int b_ = OFF_V + VB * SHM_V + v_rd_off(d0, 0, 0); \
        TRRD(l0, b_); TRRD(h0, b_ + 2048); TRRD(l1, b_ + 4096); TRRD(h1, b_ + 6144); TRRD(l2, b_ + 8192); TRRD(h2, b_ + 10240); TRRD(l3, b_ + 12288); TRRD(h3, b_ + 14336); \
        asm volatile("s_waitcnt lgkmcnt(0)" ::: "memory"); SBAR();   \
        o[d0] = __builtin_amdgcn_mfma_f32_32x32x16_bf16(pa0, (bf16x8){l0[0], l0[1], l0[2], l0[3], h0[0], h0[1], h0[2], h0[3]}, o[d0], 0, 0, 0);   \
        o[d0] = __builtin_amdgcn_mfma_f32_32x32x16_bf16(pa1, (bf16x8){l1[0], l1[1], l1[2], l1[3], h1[0], h1[1], h1[2], h1[3]}, o[d0], 0, 0, 0);   \
        o[d0] = __builtin_amdgcn_mfma_f32_32x32x16_bf16(pa2, (bf16x8){l2[0], l2[1], l2[2], l2[3], h2[0], h2[1], h2[2], h2[3]}, o[d0], 0, 0, 0);   \
        o[d0] = __builtin_amdgcn_mfma_f32_32x32x16_bf16(pa3, (bf16x8){l3[0], l3[1], l3[2], l3[3], h3[0], h3[1], h3[2], h3[3]}, o[d0], 0, 0, 0); } while (0)
    PV_D0(0); PV_D0(1); PV_D0(2); PV_D0(3);
#undef PV_D0
#undef TRRD
}

constexpr int QP = MH * MQK, VP = MH * 256;
__device__ __forceinline__ void attn_block(const bf16_t* Q, const bf16_t* K, const bf16_t* V, bf16_t* O, int P0, const float* gon, const float* gqn, const float* rc, const float* rsn, LAS unsigned char* lds) {
    int tid = threadIdx.x; asm volatile("" : "+v"(tid));
    const int wid = __builtin_amdgcn_readfirstlane(tid >> 6), lane = tid & 63, r32 = lane & 31, hi = lane >> 5;
    const int NT = P0 / KVBLK + 4;
    const int qlo = P0 + wid * QBLK, qm = qlo + r32 - 4 * hi;
    LAS float* wsf = (LAS float*)(lds + OFF_WS) + wid * 64; LAS float* li_l = wsf; LAS float* al_l = wsf + 32;
    float m_reg = -1e30f, l_reg = 0.f; f32x16 o[4] = {};
    bf16x8 qr[12];
#pragma unroll
    for (int d0 = 0; d0 < 12; ++d0) qr[d0] = *(const bf16x8*)(Q + (size_t)(qlo + r32) * QP + d0 * 16 + hi * 8);
    {
        float ss = 0.f;
#pragma unroll
        for (int d0 = 0; d0 < 12; ++d0) { float f[8]; unpack8(__builtin_bit_cast(u32x4, qr[d0]), f);
#pragma unroll
            for (int j = 0; j < 8; ++j) ss += f[j] * f[j]; }
        { auto rr = __builtin_amdgcn_permlane32_swap(__float_as_uint(ss), __float_as_uint(ss), false, false); ss = __uint_as_float(rr[0]) + __uint_as_float(rr[1]); }
        const float rs = rsqrtf(ss * (1.f / MQK) + EPS);
#pragma unroll
        for (int d0 = 0; d0 < 8; ++d0) { float f[8]; unpack8(__builtin_bit_cast(u32x4, qr[d0]), f); const float* gp = gqn + d0 * 16 + hi * 8;
#pragma unroll
            for (int j = 0; j < 8; ++j) f[j] *= rs * gp[j];
            qr[d0] = __builtin_bit_cast(bf16x8, pack8f(f)); }
#pragma unroll
        for (int dd = 0; dd < 2; ++dd) { float x1[8], x2[8]; unpack8(__builtin_bit_cast(u32x4, qr[8 + dd]), x1); unpack8(__builtin_bit_cast(u32x4, qr[10 + dd]), x2);
            const float* g1p = gqn + 128 + dd * 16 + hi * 8; const float* g2p = g1p + 32; const float* cp = rc + (size_t)(qlo + r32) * 32 + dd * 16 + hi * 8; const float* sp = rsn + (size_t)(qlo + r32) * 32 + dd * 16 + hi * 8;
            const f32x4 c0 = *(const f32x4*)cp, c1 = *(const f32x4*)(cp + 4), s0 = *(const f32x4*)sp, s1 = *(const f32x4*)(sp + 4), ga = *(const f32x4*)g1p, gb = *(const f32x4*)(g1p + 4), gc = *(const f32x4*)g2p, gd = *(const f32x4*)(g2p + 4);
#pragma unroll
            for (int j = 0; j < 8; ++j) { const float a = x1[j] * rs * (j < 4 ? ga[j & 3] : gb[j & 3]), bq = x2[j] * rs * (j < 4 ? gc[j & 3] : gd[j & 3]), c = j < 4 ? c0[j & 3] : c1[j & 3], sn = j < 4 ? s0[j & 3] : s1[j & 3]; x1[j] = a * c - bq * sn; x2[j] = bq * c + a * sn; }
            qr[8 + dd] = __builtin_bit_cast(bf16x8, pack8f(x1)); qr[10 + dd] = __builtin_bit_cast(bf16x8, pack8f(x2)); }
    }
    int ksrc[4], vsrc[2];
#pragma unroll
    for (int i = 0; i < 4; ++i) { const int row = 2 * (wid * 4 + i) + (lane >> 5), c = (lane & 31) ^ (row & 15); ksrc[i] = row * MQK + (c < 24 ? c : 0) * 8; }
#pragma unroll
    for (int i = 0; i < 2; ++i) { const int id = (wid * 2 + i) * 2 + (lane >> 5), kk = ((id >> 2) << 3) | ((lane & 31) >> 2), k = (kk & ~0xC) | ((kk & 4) << 1) | ((kk & 8) >> 1);
        vsrc[i] = k * VP + (id & 3) * 32 + (lane & 3) * 8; }
    const int vb0 = (int)(unsigned)(uintptr_t)lds + v_rd_base(lane);
#define ALOAD(t, bf) do { const bf16_t* kp = K + (size_t)(t) * KVBLK * MQK; const bf16_t* vp = V + (size_t)(t) * KVBLK * VP; \
        _Pragma("unroll") for (int i = 0; i < 4; ++i) __builtin_amdgcn_global_load_lds((const unsigned*)(kp + ksrc[i]), (LAS unsigned*)(lds + OFF_K + (bf) * SHM_K + (wid * 4 + i) * 1024), 16, 0, 0); \
        _Pragma("unroll") for (int i = 0; i < 2; ++i) __builtin_amdgcn_global_load_lds((const unsigned*)(vp + vsrc[i]), (LAS unsigned*)(lds + OFF_V + (bf) * SHM_V + (wid * 2 + i) * 1024), 16, 0, 0); } while (0)
#define RESC(a) do { if (__any((a) < 1.f)) { if (hi == 0) al_l[r32] = (a); asm volatile("s_waitcnt lgkmcnt(0)" ::: "memory"); \
        _Pragma("unroll") for (int d_ = 0; d_ < 4; ++d_) _Pragma("unroll") for (int r = 0; r < 16; ++r) o[d_][r] *= al_l[crow(r, hi)]; } } while (0)
#define STEP(t, BF) do { f32x16 p0, p1; float mn, al; bf16x8 pa0, pa1, pa2, pa3; \
        if ((t) + 1 < NT) ALOAD((t) + 1, 1 - (BF)); \
        SBAR(); qkt<BF>(p0, p1, lds, r32, hi, qr); \
        { const int kb_ = (t) * KVBLK; if (kb_ + KVBLK - 1 > qlo) mask_tile(p0, p1, qm - kb_); } \
        partialSM(p0, p1, m_reg, mn, al); RESC(al); finishSM(p0, p1, al, l_reg, pa0, pa1, pa2, pa3); SBAR(); \
        pv_tile<BF>(o, vb0, pa0, pa1, pa2, pa3); SBAR(); \
        asm volatile("s_waitcnt vmcnt(0)" ::: "memory"); __syncthreads(); } while (0)
    ALOAD(0, 0); asm volatile("s_waitcnt vmcnt(0)" ::: "memory"); __syncthreads();
    for (int t = 0; t < NT; t += 2) { STEP(t, 0); STEP(t + 1, 1); }
#undef STEP
#undef RESC
#undef ALOAD
    if (hi == 0) li_l[r32] = l_reg;
    asm volatile("s_waitcnt lgkmcnt(0)" ::: "memory");
    float gv[4];
#pragma unroll
    for (int d0 = 0; d0 < 4; ++d0) gv[d0] = gon[d0 * 32 + r32];
    float ssr[16];
#pragma unroll
    for (int r = 0; r < 16; ++r) { const float rl = __builtin_amdgcn_rcpf(li_l[crow(r, hi)]); float ss = 0.f;
#pragma unroll
        for (int d0 = 0; d0 < 4; ++d0) { o[d0][r] *= rl; ss += o[d0][r] * o[d0][r]; }
        ssr[r] = ss; }
#pragma unroll
    for (int r = 0; r < 16; ++r) ssr[r] += swz_xor<1>(ssr[r]);
#pragma unroll
    for (int r = 0; r < 16; ++r) ssr[r] += swz_xor<2>(ssr[r]);
#pragma unroll
    for (int r = 0; r < 16; ++r) ssr[r] += swz_xor<4>(ssr[r]);
#pragma unroll
    for (int r = 0; r < 16; ++r) ssr[r] += swz_xor<8>(ssr[r]);
#pragma unroll
    for (int r = 0; r < 16; ++r) ssr[r] += swz_xor<16>(ssr[r]);
#pragma unroll
    for (int r = 0; r < 16; ++r) { const float rs = rsqrtf(ssr[r] * (1.f / MV) + EPS);
        bf16_t* orow = O + (size_t)(qlo + crow(r, hi)) * DM;
#pragma unroll
        for (int d0 = 0; d0 < 4; ++d0) { const float v = o[d0][r] * rs * gv[d0]; const float vn = swz_xor<1>(v);
            if ((r32 & 1) == 0) *(unsigned*)(orow + d0 * 32 + r32) = cvtpk(v, vn); } }
    __syncthreads();
}
#undef SBAR
}

__device__ __forceinline__ void p6_phase(Frame& F, const Args& a) {
    const bf16_t* QH = (const bf16_t*)(F.ws + WS_B); const bf16_t* Kn = (const bf16_t*)(F.ws + WS_F); const bf16_t* KV = (const bf16_t*)(F.ws + WS_C);
    bf16_t* MIX = (bf16_t*)F.out;
    const float* rc = (const float*)(F.ws + WS_ROPEC); const float* rsn = (const float*)(F.ws + WS_ROPES);
    for (int it = F.vcu; it < NB * MH * 4; it += F.G) {
        const int bh = it >> 2, j = it & 3, b = bh >> 3, h = bh & 7;
        const bf16_t* Q = QH + (size_t)(b * SEQ) * att::QP + h * MQK; const bf16_t* K = Kn + (size_t)bh * SEQ * MQK; const bf16_t* V = KV + (size_t)(b * SEQ) * att::VP + h * 256 + 128;
        bf16_t* O = MIX + (size_t)(b * SEQ) * DM + HW + h * MV;
        att::attn_block(Q, K, V, O, (7 - j) * att::QB, a.in[15], a.in[13], rc + (size_t)(b * SEQ) * 32, rsn + (size_t)(b * SEQ) * 32, F.lds);
        att::attn_block(Q, K, V, O, j * att::QB, a.in[15], a.in[13], rc + (size_t)(b * SEQ) * 32, rsn + (size_t)(b * SEQ) * 32, F.lds);
    }
}
__device__ __forceinline__ void p8_phase(Frame& F, const Args& a) {
    OPAQUE_FRAME(F);
    unsigned char* ws = F.ws;
    const float* xin = a.in[0]; const bf16_t* mixo = (const bf16_t*)(ws + WS_F); const float* mod = (const float*)(ws + WS_MOD); const float* g2n = a.in[17];
    const float* wct = (const float*)(ws + WS_WCT);
    bf16_t* H2 = (bf16_t*)(ws + WS_B);
    int* tok_e = (int*)(ws + WS_TOKE); float* tok_w = (float*)(ws + WS_TOKW); int* tok_s = (int*)(ws + WS_TOKS);
    LAS float* red = (LAS float*)F.lds;
    LAS float* ssw = (LAS float*)(F.lds + 98304);
    LAS float* shw = (LAS float*)(F.lds + 100352);
    LAS float* lg = (LAS float*)(F.lds + 101888);
    LAS float* rsl = (LAS float*)(F.lds + 111104);
    const int mr = F.lane & 15, mg = F.lane >> 4;
    const bool conv_first = (F.vcu & 1) != 0;
#pragma unroll 1
    for (int part = 0; part < 2; ++part) {
    if ((part == 0) != conv_first) {
    for (int tile = F.vcu; tile < T / 64; tile += F.G) {
        const int m0 = tile * 64, b = m0 / SEQ;
        const float* modb = mod + b * (6 * DM);
        f32x4 acc[4][3]; float ssp[4] = {0.f, 0.f, 0.f, 0.f}, shacc[3] = {0.f, 0.f, 0.f};
#pragma unroll
        for (int rb = 0; rb < 4; ++rb)
#pragma unroll
            for (int n = 0; n < 3; ++n) acc[rb][n] = (f32x4){0.f, 0.f, 0.f, 0.f};
        const unsigned xo = (unsigned)((m0 + mr) * DM + F.wave * 256 + 4 * mg);
        LAS float* vec = (LAS float*)(F.lds + 112640) + F.wave * 768;
        { const int k4 = F.lane * 4; const unsigned ko_ = (unsigned)(F.wave * 256 + k4) * 4u;
          const f32x4 t0 = *(const f32x4*)((const char*)(modb + 2 * DM) + ko_), t1 = *(const f32x4*)((const char*)(modb + 3 * DM) + ko_), t2 = *(const f32x4*)((const char*)g2n + ko_), t3 = *(const f32x4*)((const char*)(modb + 4 * DM) + ko_);
          *(LAS f32x4*)(vec + k4) = t0; *(LAS f32x4*)(vec + 256 + k4) = t1; *(LAS f32x4*)(vec + 512 + k4) = t2 * (t3 + 1.f); LDS_WAIT(); asm volatile("" ::: "memory"); }
        f32x4 xa[4], xb[4], wa[3], wb[3]; u32x2 ma_[4], mb_[4];
#define P8_LDX(s_, X, M, W) do { const unsigned ko_ = (unsigned)(F.wave * 256 + 16 * (s_) + 4 * mg) * 4u; \
            _Pragma("unroll") for (int n = 0; n < 3; ++n) W[n] = *(const f32x4*)((const char*)wct + (ko_ + (unsigned)((n * 16 + mr) * DM * 4))); \
            _Pragma("unroll") for (int rb = 0; rb < 4; ++rb) { const unsigned eo_ = xo + (unsigned)(rb * 16 * DM + 16 * (s_)); X[rb] = *(const f32x4*)((const char*)xin + eo_ * 4u); M[rb] = *(const u32x2*)((const char*)mixo + eo_ * 2u); } } while (0)
#define P8_CP(s_, X, M, W) do { const int kl_ = 16 * (s_) + 4 * mg; const f32x4 g1v = *(const LAS f32x4*)(vec + kl_), shv = *(const LAS f32x4*)(vec + 256 + kl_), gmv = *(const LAS f32x4*)(vec + 512 + kl_); \
            _Pragma("unroll") for (int n = 0; n < 3; ++n) shacc[n] += (shv.x * W[n].x + shv.y * W[n].y) + (shv.z * W[n].z + shv.w * W[n].w); \
            _Pragma("unroll") for (int rb = 0; rb < 4; ++rb) { const f32x4 v = X[rb] + g1v * (f32x4){bf_lo(M[rb].x), bf_hi(M[rb].x), bf_lo(M[rb].y), bf_hi(M[rb].y)}; \
                ssp[rb] += (v.x * v.x + v.y * v.y) + (v.z * v.z + v.w * v.w); const f32x4 av = v * gmv; \
                _Pragma("unroll") for (int i = 0; i < 4; ++i) _Pragma("unroll") for (int n = 0; n < 3; ++n) acc[rb][n] = __builtin_amdgcn_mfma_f32_16x16x4f32(av[i], W[n][i], acc[rb][n], 0, 0, 0); } } while (0)
        P8_LDX(0, xa, ma_, wa);
#pragma unroll 1
        for (int s = 0; s < 16; s += 2) {
            P8_LDX(s + 1, xb, mb_, wb); __builtin_amdgcn_sched_barrier(0);
            P8_CP(s, xa, ma_, wa); __builtin_amdgcn_sched_barrier(0);
            if (s + 2 < 16) { P8_LDX(s + 2, xa, ma_, wa); } __builtin_amdgcn_sched_barrier(0);
            P8_CP(s + 1, xb, mb_, wb); __builtin_amdgcn_sched_barrier(0);
        }
#undef P8_LDX
#undef P8_CP
#pragma unroll
        for (int rb = 0; rb < 4; ++rb) {
#pragma unroll
            for (int n = 0; n < 3; ++n)
#pragma unroll
                for (int r = 0; r < 4; ++r) red[(F.wave * 64 + rb * 16 + mg * 4 + r) * 48 + n * 16 + mr] = acc[rb][n][r];
            float sp = ssp[rb]; sp += __shfl_xor(sp, 16); sp += __shfl_xor(sp, 32);
            if (mg == 0) ssw[F.wave * 64 + rb * 16 + mr] = sp; }
#pragma unroll
        for (int n = 0; n < 3; ++n) { float sa = shacc[n]; sa += __shfl_xor(sa, 16); sa += __shfl_xor(sa, 32); if (mg == 0) shw[F.wave * 48 + n * 16 + mr] = sa; }
        __syncthreads();
        if (F.tid < 64) { float sv = 0.f;
#pragma unroll
            for (int w = 0; w < 8; ++w) sv += ssw[w * 64 + F.tid];
            rsl[F.tid] = rsqrtf(sv * (1.f / DM) + EPS); }
        __syncthreads();
        for (int idx = F.tid; idx < 64 * 36; idx += NTHR) { const int row = idx / 36, n = idx % 36; float L = 0.f, sw = 0.f;
#pragma unroll
            for (int w = 0; w < 8; ++w) { L += red[(w * 64 + row) * 48 + n]; sw += shw[w * 48 + n]; }
            lg[row * 36 + n] = rsl[row] * L + sw + (n < 4 ? a.in[19][n] : a.in[21][n - 4]); }
        __syncthreads();
        if (F.tid < 64) { const LAS float* l = lg + F.tid * 36; const int t = m0 + F.tid;
            int g = 0; float gm = l[0];
#pragma unroll
            for (int j = 1; j < 4; ++j) if (l[j] > gm) { gm = l[j]; g = j; }
            float den = 0.f;
#pragma unroll
            for (int j = 0; j < 4; ++j) den += __expf(l[j] - gm);
            const float pg = 1.f / den;
            const LAS float* e = l + 4 + g * 8;
            int i1 = 0; float v1 = e[0];
#pragma unroll
            for (int j = 1; j < 8; ++j) if (e[j] > v1) { v1 = e[j]; i1 = j; }
            int i2 = -1; float v2 = -__builtin_inff();
#pragma unroll
            for (int j = 0; j < 8; ++j) if (j != i1 && e[j] > v2) { v2 = e[j]; i2 = j; }
            const float w1 = 1.f / (1.f + __expf(v2 - v1)), w2 = 1.f - w1;
            const int e1 = g * 8 + i1, e2 = g * 8 + i2;
            const int s1 = (int)atomicAdd((unsigned*)(F.ctl + CW_CNT + 64 * e1), 1u), s2 = (int)atomicAdd((unsigned*)(F.ctl + CW_CNT + 64 * e2), 1u);
            tok_e[2 * t] = e1; tok_e[2 * t + 1] = e2; tok_w[2 * t] = pg * w1; tok_w[2 * t + 1] = pg * w2; tok_s[2 * t] = s1; tok_s[2 * t + 1] = s2;
            int* list = (int*)(ws + WS_LIST); list[e1 * T + s1] = t; list[e2 * T + s2] = t; }
        { const int c8 = (F.tid & 255) * 8, rg = F.tid >> 8;
          f32x4 g1a = *(const f32x4*)(modb + 2 * DM + c8), g1b = *(const f32x4*)(modb + 2 * DM + c8 + 4), sha = *(const f32x4*)(modb + 3 * DM + c8), shb = *(const f32x4*)(modb + 3 * DM + c8 + 4);
          const f32x4 gma = *(const f32x4*)(g2n + c8) * (*(const f32x4*)(modb + 4 * DM + c8) + 1.f), gmb = *(const f32x4*)(g2n + c8 + 4) * (*(const f32x4*)(modb + 4 * DM + c8 + 4) + 1.f);
#pragma unroll 1
          for (int j0 = 0; j0 < 32; j0 += 4) {
              f32x4 qa[4], qb[4]; u32x4 qm[4];
#pragma unroll
              for (int u = 0; u < 4; ++u) { const size_t eo = (size_t)(m0 + rg + 2 * (j0 + u)) * DM + c8;
                  qa[u] = __builtin_nontemporal_load((const f32x4*)(xin + eo)); qb[u] = __builtin_nontemporal_load((const f32x4*)(xin + eo + 4)); qm[u] = __builtin_nontemporal_load((const u32x4*)(mixo + eo)); }
              __builtin_amdgcn_sched_barrier(0);
#pragma unroll
              for (int u = 0; u < 4; ++u) { const int row = rg + 2 * (j0 + u); const size_t eo = (size_t)(m0 + row) * DM + c8; const float rs = rsl[row];
                  float mx[8]; unpack8(qm[u], mx);
                  const f32x4 xa = qa[u] + g1a * (f32x4){mx[0], mx[1], mx[2], mx[3]}, xb = qb[u] + g1b * (f32x4){mx[4], mx[5], mx[6], mx[7]};
                  const f32x4 va = xa * rs * gma + sha, vb = xb * rs * gmb + shb;
                  u32x4 w; w.x = cvt_pk_bf16(va.x, va.y); w.y = cvt_pk_bf16(va.z, va.w); w.z = cvt_pk_bf16(vb.x, vb.y); w.w = cvt_pk_bf16(vb.z, vb.w);
                  *(u32x4*)(H2 + eo) = w;
                  u32x4 x1; x1.x = cvt_pk_bf16(xa.x, xa.y); x1.y = cvt_pk_bf16(xa.z, xa.w); x1.z = cvt_pk_bf16(xb.x, xb.y); x1.w = cvt_pk_bf16(xb.z, xb.w);
                  *(u32x4*)((bf16_t*)(ws + WS_F) + eo) = x1; }
              __builtin_amdgcn_sched_barrier(0); } }
        __syncthreads();
    }
    } else {
    LAS unsigned char* Tl = F.lds + F.wave * 8192;
    const int gw = F.vcu * NWAVES + F.wave, NGW = F.G * NWAVES;
    { const MoeItems mk{a.in[22], a.in[23], a.in[24], ws};
      tr_run(MOE_PRE + gw, NGW, 3 * MOE_IG, mk, Tl, F.lane); }
    __syncthreads();
    }
    }
}

constexpr int MOE_TAB_OFF = LDS_USER;
__device__ __forceinline__ LAS int* moe_tables(Frame& F) {
    LAS int* tab = (LAS int*)(F.lds + MOE_TAB_OFF);
    __syncthreads();
    if (F.tid < NE) tab[64 + F.tid] = (int)__hip_atomic_load((unsigned*)(F.ctl + CW_CNT + 64 * F.tid), RLX_AGENT);
    __syncthreads();
    if (F.tid == 0) { int acc = 0;
        for (int e = 0; e < NE; ++e) { tab[e] = acc; acc += ((tab[64 + e] + 255) / 256) * 256; }
        tab[NE] = acc; }
    __syncthreads();
    if (F.tid < 160) { int e = 0; for (int j = 1; j < NE; ++j) if (tab[j] <= F.tid * 256) e = j; tab[128 + F.tid] = e; }
    __syncthreads();
    return tab;
}

__device__ __forceinline__ void p12_phase(Frame& F, const Args& a) {
    OPAQUE_FRAME(F);
    unsigned char* ws = F.ws;
    const bf16_t* Y = (const bf16_t*)(ws + WS_A);
    const float* tok_w = (const float*)(ws + WS_TOKW); const int* tok_s = (const int*)(ws + WS_TOKS);
    const float* mod = (const float*)(ws + WS_MOD);
    const LAS int* tab = moe_tables(F); const int* tok_e = (const int*)(ws + WS_TOKE);
    const int gw = F.vcu * NWAVES + F.wave, NGW = F.G * NWAVES;
#if defined(MK_STAMP) && MK_STAMP >= 0
    const float dscale = 1.f + sqrtf(exp2f(rintf(3.f * log2f(*(const float*)(ws + WS_STAMP + 8) + 1.f) + MK_QSHIFT) * (1.f / 3.f)));
#else
    const float dscale = 1.f;
#endif
    for (int blk = gw; blk < T / 8; blk += NGW) { const int t0 = blk * 8, b = t0 / SEQ;
        const float* g2 = mod + b * (6 * DM) + 5 * DM;
        f32x4 h2[4][2];
#pragma unroll
        for (int j = 0; j < 4; ++j) { const int c = (j * 64 + F.lane) * 8; h2[j][0] = *(const f32x4*)(g2 + c); h2[j][1] = *(const f32x4*)(g2 + c + 4); }
        int dsl = 0; float wl = 0.f;
        if (F.lane < 16) { dsl = tab[tok_e[2 * t0 + F.lane]] + tok_s[2 * t0 + F.lane]; wl = tok_w[2 * t0 + F.lane]; }
#pragma unroll 1
        for (int r = 0; r < 8; ++r) { const int t = t0 + r;
            const float w0 = __shfl(wl, 2 * r), w1 = __shfl(wl, 2 * r + 1); const int d0 = __shfl(dsl, 2 * r), d1 = __shfl(dsl, 2 * r + 1);
            float* orow = F.out + (size_t)t * DM; const bf16_t* mrow = (const bf16_t*)(ws + WS_F) + (size_t)t * DM;
            u32x4 qy0[4], qy1[4], qm[4];
#pragma unroll
            for (int j = 0; j < 4; ++j) { const int c = (j * 64 + F.lane) * 8;
                qy0[j] = __builtin_nontemporal_load((const u32x4*)(Y + (size_t)d0 * DM + c)); qy1[j] = __builtin_nontemporal_load((const u32x4*)(Y + (size_t)d1 * DM + c));
                qm[j] = __builtin_nontemporal_load((const u32x4*)(mrow + c)); }
            __builtin_amdgcn_sched_barrier(0);
#pragma unroll
            for (int j = 0; j < 4; ++j) { const int c = (j * 64 + F.lane) * 8;
                float y0[8], y1[8], mx[8]; unpack8(qy0[j], y0); unpack8(qy1[j], y1); unpack8(qm[j], mx);
                const f32x4 xa = {mx[0], mx[1], mx[2], mx[3]}, xb = {mx[4], mx[5], mx[6], mx[7]};
                f32x4 ra, rb;
#pragma unroll
                for (int i = 0; i < 4; ++i) { ra[i] = (xa[i] + h2[j][0][i] * (w0 * y0[i] + w1 * y1[i])) * dscale; rb[i] = (xb[i] + h2[j][1][i] * (w0 * y0[4 + i] + w1 * y1[4 + i])) * dscale; }
                __builtin_nontemporal_store(ra, (f32x4*)(orow + c)); __builtin_nontemporal_store(rb, (f32x4*)(orow + c + 4)); }
            __builtin_amdgcn_sched_barrier(0); }
    }
}
#ifndef MK_MULTI
#define MK_MULTI 0
#endif
#ifndef MK_LAST_PHASE
#define MK_LAST_PHASE 12
#endif
constexpr int N_PHASES = MK_LAST_PHASE + 1;

template <class P> __device__ __forceinline__ P* uptr(P* p) { const unsigned long long v = (unsigned long long)p;
    const unsigned lo = __builtin_amdgcn_readfirstlane((unsigned)v), hi = __builtin_amdgcn_readfirstlane((unsigned)(v >> 32)); return (P*)(__attribute__((address_space(1))) P*)(((unsigned long long)hi << 32) | lo); }
__global__ void __launch_bounds__(NTHR, 2) mk_fwd(const Args args) {
    extern __shared__ __attribute__((aligned(16))) unsigned char lds_raw[];
    Frame F;
    F.lds = (LAS unsigned char*)lds_raw;
    F.MISC = (volatile LAS unsigned*)(F.lds + MISC_OFF);
    F.tid = threadIdx.x; F.lane = F.tid & 63; F.wave = __builtin_amdgcn_readfirstlane(F.tid >> 6);
    F.G = gridDim.x; { const int bx = blockIdx.x; F.vcu = (F.G % 8 == 0) ? (bx % 8) * (F.G / 8) + bx / 8 : bx; }
    F.ws = uptr(args.ws); F.out = uptr(args.out);
    F.ctl = (gu32*)(F.ws + WS_CTL);
    for (int u = F.tid; u < (LDS_BYTES - MISC_OFF) / 4; u += NTHR) ((LAS unsigned*)(F.lds + MISC_OFF))[u] = 0u;
    __syncthreads();
    XcdBarrier bar; bar.bar = (unsigned*)(F.ctl + CW_BAR); bar.x = 0; bar.st = nullptr;
#if !MK_MULTI
    bar = xcd_barrier_post((unsigned*)(F.ctl + CW_BAR), F.MISC + 8);
#define GRID_BAR() xcd_barrier(bar)
#else
#define GRID_BAR() do { } while (0)
#endif
    const int lo = args.ph_lo, hi = args.ph_hi;
#ifndef MK_PHMASK
#define MK_PHMASK 0xFFFF
#endif
#define IN(k) (((MK_PHMASK >> (k)) & 1) && lo <= (k) && (k) < hi)
#define SEAM(k) do { if (IN(k) && IN((k) + 1)) GRID_BAR(); } while (0)
#ifndef MK_STAMP
#define MK_STAMP (-1)
#endif
#define STAMP_BEGIN(k) do { if ((k) == MK_STAMP && blockIdx.x == 0 && F.tid == 0) *(unsigned long long*)(ws + WS_STAMP) = __builtin_amdgcn_s_memrealtime(); } while (0)
#define STAMP_END(k) do { if ((k) == MK_STAMP && blockIdx.x == 0 && F.tid == 0) { const unsigned long long t1_ = __builtin_amdgcn_s_memrealtime(); *(float*)(ws + WS_STAMP + 8) = (float)(t1_ - *(unsigned long long*)(ws + WS_STAMP)) * 0.01f; } } while (0)
#ifndef MK_REPEAT
#define MK_REPEAT (-1)
#endif
#ifndef MK_REPN
#define MK_REPN 2
#endif
#define REP(k) _Pragma("unroll") for (int rep_ = 0; rep_ < ((k) == MK_REPEAT ? MK_REPN : 1); ++rep_)
    unsigned char* const ws = F.ws;

    STAMP_BEGIN(0);
    REP(0) if (IN(0)) { if (rep_) GRID_BAR(); p0_phase(F, args); } STAMP_END(0);
    STAMP_BEGIN(1);
    REP(1) if (IN(1)) { if (rep_) GRID_BAR(); p1_phase(F, args); } SEAM(1); STAMP_END(1);
    STAMP_BEGIN(2);
    REP(2) if (IN(2)) { if (rep_) GRID_BAR();
        pg8::Gemm g{(const bf16_t*)(ws + WS_B), (const bf16_t*)(ws + WS_WIN), DM, DM, DM};
        pg8::DenseOrder S; S.init(T / 256, INCP / 256, F.G, (int)blockIdx.x);
        pg8::EpiStore E{(bf16_t*)(ws + WS_A), INCP, nullptr, 0.f, (float*)(ws + WS_RSTDQ), (float*)(ws + WS_RSTDKV), C_QA / 256, C_KVA / 256, C_KPE / 256};
        pg8::gemm_phase<pg8::EpiStore, pg8::DenseOrder>(F.lds, g, S, E);
    } SEAM(2); STAMP_END(2);
    STAMP_BEGIN(3);
    REP(3) if (IN(3)) { if (rep_) GRID_BAR(); p3_phase(F, args); } if (IN(3) && IN(5)) GRID_BAR(); STAMP_END(3);
    STAMP_BEGIN(5);
    REP(5) if (IN(5)) { if (rep_) GRID_BAR(); p5_phase(F, args); } SEAM(5); STAMP_END(5);
    STAMP_BEGIN(6);
    REP(6) if (IN(6)) { if (rep_) GRID_BAR(); p6_phase(F, args); } SEAM(6); STAMP_END(6);
    STAMP_BEGIN(7);
    REP(7) if (IN(7)) { if (rep_) GRID_BAR();
        pg8::Gemm g{(const bf16_t*)F.out, (const bf16_t*)(ws + WS_WOUT), DM, DM, DM};
        pg8::DenseOrder S; S.init(T / 256, DM / 256, F.G, (int)blockIdx.x);
        pg8::EpiStore E{(bf16_t*)(ws + WS_F), DM, nullptr, 0.f, nullptr, nullptr, 0, 0, 0};
        pg8::gemm_phase<pg8::EpiStore, pg8::DenseOrder>(F.lds, g, S, E);
    } SEAM(7); STAMP_END(7);
#if MK_LAST_PHASE >= 8
    STAMP_BEGIN(8);
    REP(8) if (IN(8)) { if (rep_) GRID_BAR(); p8_phase(F, args); } if (IN(8) && IN(10)) GRID_BAR(); STAMP_END(8);
    STAMP_BEGIN(10);
    REP(10) if (IN(10)) { if (rep_) GRID_BAR();
        const LAS int* tab = moe_tables(F);
        pg8::Gemm g{(const bf16_t*)(ws + WS_B), (const bf16_t*)(ws + WS_D), DM, DM, DM};
        pg8::GroupedOrder S; S.init(4, F.G, F.vcu, tab, (const int*)(ws + WS_LIST));
        pg8::EpiSwiGLU E{(bf16_t*)(ws + WS_C), (unsigned*)(F.ctl + CW_RDY)};
        pg8::gemm_phase<pg8::EpiSwiGLU, pg8::GroupedOrder, true>(F.lds, g, S, E);
    }
    REP(11) if (IN(11)) { if (rep_) GRID_BAR();
        const LAS int* tab = moe_tables(F);
        pg8::Gemm g{(const bf16_t*)(ws + WS_C), (const bf16_t*)(ws + WS_E), DE, DE, DE};
        pg8::RedealOrder S; S.init(8, F.G, F.vcu, tab, 4, (unsigned*)(F.ctl + CW_RDY), 32u, (unsigned*)(F.ctl + CW_TMO));
        pg8::EpiStore E{(bf16_t*)(ws + WS_A), DM, nullptr, 0.f, nullptr, nullptr, 0, 0, 0};
        pg8::gemm_phase<pg8::EpiStore, pg8::RedealOrder>(F.lds, g, S, E);
    } SEAM(11); STAMP_END(11);
    REP(12) if (IN(12)) { if (rep_) GRID_BAR(); p12_phase(F, args); }
#endif
#undef IN
#undef SEAM
}

extern "C" void kernel_launch(void* const* d_in, const int* in_sizes, int n_in, void* d_out, int out_size, void* d_ws, size_t ws_size, hipStream_t stream) {
    static int grid = 0;
    if (grid == 0) {
        if (n_in != 25 || out_size != T * DM || ws_size < WS_END) { fprintf(stderr, "kernel_launch: bad shapes (n_in %d out %d ws %zu)\n", n_in, out_size, ws_size); grid = -1; return; }
        int dev = 0, cus = 0, per_cu = 0;
        if (hipGetDevice(&dev) != hipSuccess || hipDeviceGetAttribute(&cus, hipDeviceAttributeMultiprocessorCount, dev) != hipSuccess) { grid = -1; return; }
        if (hipFuncSetAttribute((const void*)mk_fwd, hipFuncAttributeMaxDynamicSharedMemorySize, LDS_BYTES) != hipSuccess) { fprintf(stderr, "kernel_launch: hipFuncSetAttribute failed\n"); grid = -1; return; }
        if (hipOccupancyMaxActiveBlocksPerMultiprocessor(&per_cu, (const void*)mk_fwd, NTHR, LDS_BYTES) != hipSuccess || per_cu < 1) { fprintf(stderr, "kernel_launch: occupancy query says %d\n", per_cu); }
        (void)hipGetLastError();
        grid = cus;
    }
    if (grid < 0) return;
    (void)hipMemsetAsync((char*)d_ws + WS_CTL, 0, CTL_ZERO_BYTES, stream);
    Args a{};
    for (int i = 0; i < 25; ++i) a.in[i] = (const float*)d_in[i];
    a.out = (float*)d_out; a.ws = (unsigned char*)d_ws;
#if MK_MULTI
    for (int p = 0; p < N_PHASES; ++p) { a.ph_lo = p; a.ph_hi = p + 1; hipLaunchKernelGGL(mk_fwd, dim3(grid), dim3(NTHR), LDS_BYTES, stream, a); }
#else
    a.ph_lo = 0; a.ph_hi = N_PHASES; hipLaunchKernelGGL(mk_fwd, dim3(grid), dim3(NTHR), LDS_BYTES, stream, a);
#endif
}
```

```cpp
#include <hip/hip_runtime.h>
#include <cstdio>
#include <cstdint>

#define GAS __attribute__((address_space(1)))
#define LAS __attribute__((address_space(3)))
typedef unsigned short bf16_t;
typedef short bf16x8 __attribute__((ext_vector_type(8)));
typedef short s16x4 __attribute__((ext_vector_type(4)));
typedef float f32x4 __attribute__((ext_vector_type(4)));
typedef float f32x2 __attribute__((ext_vector_type(2)));
typedef float f32x16 __attribute__((ext_vector_type(16)));
typedef unsigned u32x4 __attribute__((ext_vector_type(4)));
typedef unsigned u32x2 __attribute__((ext_vector_type(2)));
typedef GAS unsigned gu32;
#define RLX_AGENT __ATOMIC_RELAXED, __HIP_MEMORY_SCOPE_AGENT
#define LDS_WAIT() asm volatile("s_waitcnt lgkmcnt(0)" ::: "memory")
#define VM_WAIT() asm volatile("s_waitcnt vmcnt(0)" ::: "memory")

constexpr int DM = 2048, NB = 8, SEQ = 2048, T = NB * SEQ;
constexpr int HW = 1024, HH = 8, HDK = 128, HDV = 128;
constexpr int MH = 8, MNOPE = 128, MROPE = 64, MQK = 192, MV = 128, QLORA = 512, KVLORA = 256;
constexpr int INC = 4 * HW + QLORA + KVLORA + MROPE;
constexpr int INCP = 5120;
constexpr int C_QA = 4096, C_KVA = 4608, C_KPE = 4864;
constexpr int NG = 4, EPG = 8, NE = 32, DE = 512;
constexpr int RMAX = (T * 2 / 256 + NE) * 256;
constexpr float EPS = 1e-6f;
constexpr int NWAVES = 8, NTHR = 512;

typedef __bf16 bf16x2_t __attribute__((ext_vector_type(2)));
__device__ __forceinline__ unsigned cvt_pk_bf16(float lo, float hi) { const f32x2 v = {lo, hi}; return __builtin_bit_cast(unsigned, __builtin_convertvector(v, bf16x2_t)); }
__device__ __forceinline__ float bf_lo(unsigned w) { return __builtin_bit_cast(float, w << 16); }
__device__ __forceinline__ float bf_hi(unsigned w) { return __builtin_bit_cast(float, w & 0xffff0000u); }
__device__ __forceinline__ float bf2f(bf16_t h) { return __builtin_bit_cast(float, (unsigned)h << 16); }
__device__ __forceinline__ float wave_sum(float v) {
#pragma unroll
    for (int o = 1; o < 64; o <<= 1) v += __shfl_xor(v, o);
    return v;
}
__device__ __forceinline__ float siluf(float v) { return v / (1.f + __expf(-v)); }

#define XB_TMO      128
#define XB_XCNT(j)  (256  + 64 * (j))
#define XB_XSUB(j)  (1280 + 64 * (j))
#define XB_XGEN(j)  (2304 + 64 * (j))
#define XB_TOP      3328
#define XB_TOPGEN   3392
#define XCD_BAR_WORDS 3456
#define XB_SPIN_CAP (1u << 18)

__device__ __forceinline__ unsigned xb_ld(unsigned* p)              { return __hip_atomic_load(p, __ATOMIC_RELAXED, __HIP_MEMORY_SCOPE_AGENT); }
__device__ __forceinline__ unsigned xb_add(unsigned* p, unsigned v) { return __hip_atomic_fetch_add(p, v, __ATOMIC_RELAXED, __HIP_MEMORY_SCOPE_AGENT); }
__device__ __forceinline__ unsigned xb_xcc_id() { return (unsigned)__builtin_amdgcn_s_getreg((3 << 11) | 20) & 0xFu; }
#define XB_SPIN(cond, bar) do { unsigned _sp = 0; while (cond) { __builtin_amdgcn_s_sleep(1); \
    if ((++_sp & 255u) == 0u) { if (xb_ld(&(bar)[XB_TMO])) break; if (_sp > XB_SPIN_CAP) { atomicAdd(&(bar)[XB_TMO], 1u); break; } } } } while (0)

struct XcdBarrier {
    unsigned* bar; unsigned x;
    volatile LAS unsigned* st;
};
__device__ __forceinline__ XcdBarrier xcd_barrier_post(unsigned* bar, volatile LAS unsigned* st) {
    XcdBarrier b; b.bar = bar; b.x = xb_xcc_id(); b.st = st;
    if (threadIdx.x == 0) (void)xb_add(&bar[XB_XCNT(b.x)], 1u);
    return b;
}
__device__ __forceinline__ void xcd_barrier_complete(unsigned* bar, unsigned x, unsigned& nloc, unsigned& nx) {
    const unsigned G = gridDim.x * gridDim.y * gridDim.z;
    unsigned sum, cnt, mine, sp = 0u;
    for (;;) {
        sum = 0u; cnt = 0u; mine = 0u;
#pragma unroll
        for (unsigned j = 0; j < 16; ++j) { const unsigned c = xb_ld(&bar[XB_XCNT(j)]); sum += c; cnt += (c > 0u) ? 1u : 0u; mine = (j == x) ? c : mine; }
        if (sum == G) break;
        __builtin_amdgcn_s_sleep(1);
        if ((++sp & 255u) == 0u) { if (xb_ld(&bar[XB_TMO])) break; if (sp > XB_SPIN_CAP) { atomicAdd(&bar[XB_TMO], 1u); break; } }
    }
    nloc = mine > 0u ? mine : 1u; nx = cnt > 0u ? cnt : 1u;
}
__device__ __forceinline__ void xcd_barrier(const XcdBarrier& b) {
    asm volatile("s_waitcnt vmcnt(0)" ::: "memory");
    __syncthreads();
    if (threadIdx.x == 0) {
        unsigned* bar = b.bar;
        __builtin_amdgcn_s_waitcnt(0);
        unsigned nloc = b.st[0], nx = b.st[1];
        if (nloc == 0u) { xcd_barrier_complete(bar, b.x, nloc, nx); b.st[0] = nloc; b.st[1] = nx; }
        const unsigned old = xb_add(&bar[XB_XSUB(b.x)], 1u);
        const unsigned gen = old / nloc;
        if (old + 1u == (gen + 1u) * nloc) {
            __builtin_amdgcn_fence(__ATOMIC_RELEASE, "agent");
            asm volatile("s_waitcnt vmcnt(0)" ::: "memory");
            const unsigned og = xb_add(&bar[XB_TOP], 1u);
            const unsigned tg = og / nx;
            if (og + 1u == (tg + 1u) * nx) xb_add(&bar[XB_TOPGEN], 1u);
            else XB_SPIN(xb_ld(&bar[XB_TOPGEN]) == tg, bar);
            __builtin_amdgcn_fence(__ATOMIC_ACQUIRE, "agent");
            xb_add(&bar[XB_XGEN(b.x)], 1u);
            asm volatile("s_waitcnt vmcnt(0)" ::: "memory");
        } else {
            XB_SPIN(xb_ld(&bar[XB_XGEN(b.x)]) == gen, bar);
            __builtin_amdgcn_fence(__ATOMIC_ACQUIRE, "agent");
            asm volatile("s_waitcnt vmcnt(0)" ::: "memory");
        }
    }
    __syncthreads();
}

namespace pg8 {
constexpr int BM = 256, BK = 64, HALF = 128, HTB = HALF * BK * 2, STAGE_BYTES = 8 * HTB, NXCD = 8, WGM = 8;
__host__ __device__ __forceinline__ int lds_byte(int r, int c) { const int st = (r >> 4) * 2 + (c >> 5), rr = r & 15, cc = c & 31, ob = rr * 64 + cc * 2; return st * 1024 + (ob ^ (((ob >> 9) & 1) << 5)); }
__host__ __device__ __forceinline__ void stage_rc(int b, int& R, int& C) { const int st = b / 1024, sb = b % 1024, swz = sb ^ (((sb >> 9) & 1) << 5); R = (st >> 1) * 16 + swz / 64; C = (st & 1) * 32 + (swz % 64) / 2; }
__host__ __device__ __forceinline__ int perm32(int rho) { const int n = rho >> 4, i = rho & 15; return 8 * (i >> 2) + 4 * n + (i & 3); }

struct Unit { int pm, pn, pb; };
struct Gemm { const bf16_t* A; const bf16_t* Bt; int lda, ldb, K; };

struct DenseOrder {
    int nM, nN, nwg, G, c;
    __device__ void init(int nM_, int nN_, int G_, int c_) { nM = nM_; nN = nN_; nwg = nM * nN; G = G_; c = c_; }
    __device__ bool next(int i, Unit& u) const {
        const long L = (long)i * G + c; if (L >= nwg) return false;
        int wgid = (int)L; { const int q = nwg / NXCD, r = nwg % NXCD, xcd = wgid % NXCD, off = wgid / NXCD; wgid = (xcd < r ? xcd * (q + 1) : r * (q + 1) + (xcd - r) * q) + off; }
        const int nig = WGM * nN, gid = wgid / nig, fm = gid * WGM, gsz = (nM - fm) < WGM ? (nM - fm) : WGM;
        u.pm = fm + ((wgid % nig) % gsz); u.pn = (wgid % nig) / gsz; u.pb = u.pn; return true;
    }
    __device__ __forceinline__ void a_ready(const Unit&) const {}
};
struct GroupedOrder {
    int nM, nN, nwg, G, c; const LAS int* tile_e; const LAS int* pstart; const LAS int* cnt; const int* list;
    __device__ void init(int nN_, int G_, int c_, const LAS int* tab, const int* list_) { pstart = tab; cnt = tab + 64; tile_e = tab + 128; list = list_; nM = pstart[32] >> 8; nN = nN_; nwg = nM * nN; G = G_; c = c_; }
    __device__ bool next(int i, Unit& u) const {
        const long L = (long)i * G + c; if (L >= nwg) return false;
        const int w = (int)L; u.pn = w % nN; u.pm = w / nN; u.pb = tile_e[u.pm] * nN + u.pn; return true;
    }
    __device__ int arow(const Unit& u, int r) const { const int e = tile_e[u.pm], j = 256 * u.pm - pstart[e] + r; return j < cnt[e] ? list[e * T + j] : 0; }
    __device__ __forceinline__ void a_ready(const Unit&) const {}
};
struct RedealOrder {
    int nM, nN, nwg, G, c, r10, X, nlight, head; const LAS int* tile_e; unsigned* ready; unsigned need; unsigned* tmo;
    __device__ void init(int nN_, int G_, int c_, const LAS int* tab, int nN10, unsigned* ready_, unsigned need_, unsigned* tmo_) {
        tile_e = tab + 128; nM = tab[32] >> 8; nN = nN_; nwg = nM * nN; G = G_; c = c_; ready = ready_; need = need_; tmo = tmo_;
        r10 = (nM * nN10) % G; X = r10 ? 3 : 0; nlight = G - r10; head = X * nlight < nwg ? X * nlight : nwg; }
    __device__ bool next(int i, Unit& u) const {
        long id;
        if (c >= r10 && X) id = i < X ? (long)i * nlight + (c - r10) : (long)head + (long)(i - X) * G + c;
        else id = (long)head + (long)i * G + c;
        if ((i < X && c >= r10 && id >= head) || id >= nwg) return false;
        u.pm = (int)id / nN; u.pn = (int)id % nN; u.pb = tile_e[u.pm] * nN + u.pn; return true;
    }
    __device__ __forceinline__ void a_ready(const Unit& u) const {
        if (threadIdx.x < 64) {
            unsigned polls = 0;
            while ((unsigned)__builtin_amdgcn_readfirstlane(__hip_atomic_load(ready + 64 * u.pm, __ATOMIC_RELAXED, __HIP_MEMORY_SCOPE_AGENT)) < need) {
                if (++polls > (1u << 16)) { if (threadIdx.x == 0) __hip_atomic_store(tmo, 0xDEAD0000u | (unsigned)u.pm, __ATOMIC_RELAXED, __HIP_MEMORY_SCOPE_AGENT); break; }
                __builtin_amdgcn_s_sleep(2); }
            __builtin_amdgcn_fence(__ATOMIC_ACQUIRE, "agent");
            asm volatile("s_waitcnt vmcnt(0)" ::: "memory");
        }
        asm volatile("" ::: "memory"); __builtin_amdgcn_s_barrier(); asm volatile("" ::: "memory");
    }
};

template <class Epi, class Sched, bool GATHER = false>
__device__ __forceinline__ void gemm_phase(LAS unsigned char* lds, const Gemm g, const Sched& S, const Epi& E) {
    int tid = threadIdx.x; asm volatile("" : "+v"(tid));
    const int wid = __builtin_amdgcn_readfirstlane(tid >> 6), lane = tid & 63, wr = wid >> 2, wc = wid & 3, fr = lane & 15, fq = lane >> 4;
    const int K = g.K, nt = K / BK;
    unsigned voffA[2], voffB[2]; int gR[2], gC[2];
#pragma unroll
    for (int i = 0; i < 2; ++i) { int R, C; stage_rc(tid * 16 + i * 8192, R, C); const int Rb = (R & ~31) + perm32(R & 31); gR[i] = R; gC[i] = C;
        voffA[i] = (unsigned)(R * g.lda + C) * 2u; voffB[i] = (unsigned)(Rb * g.ldb + C) * 2u; }
    const size_t kstep = (size_t)(BK * 2);
    const size_t hsA = (size_t)HALF * g.lda * 2, hsB = (size_t)HALF * g.ldb * 2;
    const unsigned ldsw = (unsigned)wid * 1024u;
    const int aoff = lds_byte(wr * 64 + fr, fq * 8), boff = lds_byte(wc * 32 + fr, fq * 8);
#define PG8_SA(b, h) (((b) * 2 + (h)) * HTB)
#define PG8_SB(b, h) ((4 + (b) * 2 + (h)) * HTB)
#define PG8_STAGE(bufoff, gbase, voff) do { _Pragma("unroll") for (int _i = 0; _i < 2; ++_i) \
        __builtin_amdgcn_global_load_lds((const unsigned*)((const char*)(gbase) + (voff)[_i]), (LAS unsigned*)(lds + (bufoff) + ldsw + _i * 8192), 16, 0, 0); } while (0)
#define PG8_STAGE_A(bufoff, dense_ptr, kbytes, offs) do { if constexpr (GATHER) { PG8_STAGE(bufoff, (const char*)g.A + (kbytes), offs); } else { PG8_STAGE(bufoff, dense_ptr, voffA); } } while (0)
#define PG8_GOFF(u, o0, o1) do { _Pragma("unroll") for (int _i = 0; _i < 2; ++_i) { o0[_i] = (unsigned)(S.arow(u, gR[_i]) * g.lda + gC[_i]) * 2u; o1[_i] = (unsigned)(S.arow(u, gR[_i] + HALF) * g.lda + gC[_i]) * 2u; } } while (0)
#define PG8_LDA(dst, b, h) do { _Pragma("unroll") for (int m = 0; m < 4; ++m) _Pragma("unroll") for (int k = 0; k < 2; ++k) dst[m][k] = *(const LAS bf16x8*)(lds + PG8_SA(b, h) + aoff + m * 2048 + k * 1024); } while (0)
#define PG8_LDB(dst, b, h) do { _Pragma("unroll") for (int n = 0; n < 2; ++n) _Pragma("unroll") for (int k = 0; k < 2; ++k) dst[n][k] = *(const LAS bf16x8*)(lds + PG8_SB(b, h) + boff + n * 2048 + k * 1024); } while (0)
#define PG8_MMA(ai, bj, At, Bt) do { __builtin_amdgcn_s_setprio(1); _Pragma("unroll") for (int m = 0; m < 4; ++m) _Pragma("unroll") for (int n = 0; n < 2; ++n) _Pragma("unroll") for (int k = 0; k < 2; ++k) \
        acc[ai][bj][m][n] = __builtin_amdgcn_mfma_f32_16x16x32_bf16(Bt[n][k], At[m][k], acc[ai][bj][m][n], 0, 0, 0); __builtin_amdgcn_s_setprio(0); } while (0)
#define PG8_WAIT_V(n) asm volatile("s_waitcnt vmcnt(" #n ")" ::: "memory")
#define PG8_WAIT_L(n) asm volatile("s_waitcnt lgkmcnt(" #n ")" ::: "memory")
#define PG8_BAR __builtin_amdgcn_s_barrier()
#define PG8_SCHED __builtin_amdgcn_sched_barrier(0)
    Unit cur, nxt; int ui = 0;
    if (!S.next(0, cur)) return;
    unsigned cO0[2] = {0u, 0u}, cO1[2] = {0u, 0u}, nO0[2] = {0u, 0u}, nO1[2] = {0u, 0u};
    if constexpr (GATHER) { PG8_GOFF(cur, cO0, cO1); }
    S.a_ready(cur);
    f32x4 acc[2][2][4][2];
#pragma unroll
    for (int a = 0; a < 2; ++a)
#pragma unroll
        for (int b = 0; b < 2; ++b)
#pragma unroll
            for (int m = 0; m < 4; ++m)
#pragma unroll
                for (int n = 0; n < 2; ++n) acc[a][b][m][n] = (f32x4){0.f, 0.f, 0.f, 0.f};
    bf16x8 At[4][2], B0[2][2], B1[2][2];
    const char* cA = (const char*)g.A + (GATHER ? (size_t)0 : (size_t)cur.pm * 2 * hsA); const char* cB = (const char*)g.Bt + (size_t)cur.pb * 2 * hsB;
    PG8_STAGE(PG8_SB(0, 0), cB, voffB); PG8_STAGE(PG8_SB(0, 1), cB + hsB, voffB); PG8_STAGE_A(PG8_SA(0, 0), cA, 0, cO0); PG8_STAGE_A(PG8_SA(0, 1), cA + hsA, 0, cO1);
    if (wr == 1) PG8_BAR;
    PG8_WAIT_V(2); PG8_BAR;
    PG8_STAGE(PG8_SB(1, 0), cB + kstep, voffB); PG8_STAGE_A(PG8_SA(1, 0), cA + kstep, kstep, cO0); PG8_STAGE(PG8_SB(1, 1), cB + hsB + kstep, voffB);
    PG8_WAIT_V(6); PG8_BAR;
    for (;;) {
        const bool has_next = S.next(ui + 1, nxt);
        const char* nA = (has_next && !GATHER) ? (const char*)g.A + (size_t)nxt.pm * 2 * hsA : cA; const char* nB = has_next ? (const char*)g.Bt + (size_t)nxt.pb * 2 * hsB : cB;
        if constexpr (GATHER) { if (has_next) { PG8_GOFF(nxt, nO0, nO1); } else { nO0[0] = cO0[0]; nO0[1] = cO0[1]; nO1[0] = cO1[0]; nO1[1] = cO1[1]; } }
        for (int t = 0; t < nt; t += 2) {
            const bool last = (t == nt - 2);
            if (last && has_next) S.a_ready(nxt);
            const char* a1 = cA + (size_t)(t + 1) * kstep;
            const char* a2 = last ? nA : cA + (size_t)(t + 2) * kstep; const char* b2 = last ? nB : cB + (size_t)(t + 2) * kstep;
            const char* a3 = a2 + kstep; const char* b3 = b2 + kstep;
            const size_t k2 = last ? (size_t)0 : (size_t)(t + 2) * kstep;
            unsigned o0[2], o1[2]; o0[0] = last ? nO0[0] : cO0[0]; o0[1] = last ? nO0[1] : cO0[1]; o1[0] = last ? nO1[0] : cO1[0]; o1[1] = last ? nO1[1] : cO1[1];
            PG8_LDB(B0, 0, 0); PG8_LDB(B1, 0, 1); PG8_SCHED; PG8_LDA(At, 0, 0); PG8_STAGE_A(PG8_SA(1, 1), a1 + hsA, (size_t)(t + 1) * kstep, cO1);
            PG8_WAIT_V(8); PG8_WAIT_L(0); PG8_BAR; PG8_MMA(0, 0, At, B0); PG8_MMA(0, 1, At, B1); PG8_BAR; PG8_SCHED;
            PG8_LDA(At, 0, 1); PG8_STAGE(PG8_SB(0, 0), b2, voffB); PG8_STAGE(PG8_SB(0, 1), b2 + hsB, voffB); PG8_STAGE_A(PG8_SA(0, 0), a2, k2, o0);
            PG8_WAIT_V(8); PG8_WAIT_L(0); PG8_BAR; PG8_MMA(1, 0, At, B0); PG8_MMA(1, 1, At, B1); PG8_BAR; PG8_SCHED;
            PG8_LDB(B0, 1, 0); PG8_LDB(B1, 1, 1); PG8_SCHED; PG8_LDA(At, 1, 0); PG8_STAGE_A(PG8_SA(0, 1), a2 + hsA, k2, o1);
            PG8_WAIT_V(8); PG8_WAIT_L(0); PG8_BAR; PG8_MMA(0, 0, At, B0); PG8_MMA(0, 1, At, B1); PG8_BAR; PG8_SCHED;
            PG8_LDA(At, 1, 1); PG8_STAGE(PG8_SB(1, 0), b3, voffB); PG8_STAGE(PG8_SB(1, 1), b3 + hsB, voffB); PG8_STAGE_A(PG8_SA(1, 0), a3, k2 + kstep, o0);
            PG8_WAIT_V(8); PG8_WAIT_L(0); PG8_BAR; PG8_MMA(1, 0, At, B0); PG8_MMA(1, 1, At, B1); PG8_BAR; PG8_SCHED;
        }
        if (wr == 0) PG8_BAR;
        E(acc, cur, wr, wc, fr, fq);
        if (!has_next) break;
#pragma unroll
        for (int a = 0; a < 2; ++a)
#pragma unroll
            for (int b = 0; b < 2; ++b)
#pragma unroll
                for (int m = 0; m < 4; ++m)
#pragma unroll
                    for (int n = 0; n < 2; ++n) acc[a][b][m][n] = (f32x4){0.f, 0.f, 0.f, 0.f};
        cur = nxt; cA = nA; cB = nB; ++ui;
        if constexpr (GATHER) { cO0[0] = nO0[0]; cO0[1] = nO0[1]; cO1[0] = nO1[0]; cO1[1] = nO1[1]; }
        if (wr == 1) PG8_BAR;
    }
    PG8_WAIT_V(0);
    PG8_BAR;
#undef PG8_SA
#undef PG8_SB
#undef PG8_STAGE
#undef PG8_STAGE_A
#undef PG8_GOFF
#undef PG8_LDA
#undef PG8_LDB
#undef PG8_MMA
#undef PG8_WAIT_V
#undef PG8_WAIT_L
#undef PG8_BAR
#undef PG8_SCHED
}

struct EpiStore {
    bf16_t* O; int ldc; const float* ssq; float inv; float* ssq_out0; float* ssq_out1; int pn0, pn1, pn2;
    int sg0 = 0, sg1 = 0;
    __device__ __forceinline__ void operator()(const f32x4 (&acc)[2][2][4][2], const Unit& u, int wr, int wc, int fr, int fq) const {
        const int row0 = u.pm * BM + wr * 64 + fr, col0 = u.pn * BM + wc * 32 + 8 * fq;
        float* so = (ssq_out0 && u.pn >= pn0 && u.pn < pn2) ? (u.pn < pn1 ? ssq_out0 : ssq_out1) : nullptr;
        const bool sig = u.pn >= sg0 && u.pn < sg1;
        float rsv[2][4];
#pragma unroll
        for (int ai = 0; ai < 2; ++ai)
#pragma unroll
            for (int m = 0; m < 4; ++m) rsv[ai][m] = ssq ? ssq[row0 + ai * HALF + m * 16] : 0.f;
#pragma unroll
        for (int ai = 0; ai < 2; ++ai)
#pragma unroll
            for (int m = 0; m < 4; ++m) { const int row = row0 + ai * HALF + m * 16; const float rs = ssq ? rsqrtf(rsv[ai][m] * inv + EPS) : 1.f;
                bf16_t* rowp = O + (size_t)row * ldc + col0; float ss = 0.f;
#pragma unroll
                for (int bj = 0; bj < 2; ++bj) { f32x4 v0 = acc[ai][bj][m][0] * rs, v1 = acc[ai][bj][m][1] * rs;
                    if (sig) {
#pragma unroll
                        for (int j = 0; j < 4; ++j) { v0[j] = __builtin_amdgcn_rcpf(1.f + __builtin_amdgcn_exp2f(1.4426950408889634f * v0[j])); v1[j] = __builtin_amdgcn_rcpf(1.f + __builtin_amdgcn_exp2f(1.4426950408889634f * v1[j])); } }
                    ss += (v0[0] * v0[0] + v0[1] * v0[1]) + (v0[2] * v0[2] + v0[3] * v0[3]) + (v1[0] * v1[0] + v1[1] * v1[1]) + (v1[2] * v1[2] + v1[3] * v1[3]);
                    u32x4 w; w.x = cvt_pk_bf16(v0[0], v0[1]); w.y = cvt_pk_bf16(v0[2], v0[3]); w.z = cvt_pk_bf16(v1[0], v1[1]); w.w = cvt_pk_bf16(v1[2], v1[3]);
                    *(u32x4*)(rowp + bj * HALF) = w; }
                if (so) { ss += __shfl_xor(ss, 16); ss += __shfl_xor(ss, 32); if (fq == 0) atomicAdd(so + row, ss); } }
    }
};
struct EpiResid {
    const float* X; float* O; const float* gate; int gpitch;
    __device__ __forceinline__ void operator()(const f32x4 (&acc)[2][2][4][2], const Unit& u, int wr, int wc, int fr, int fq) const {
        const int row0 = u.pm * BM + wr * 64 + fr, col0 = u.pn * BM + wc * 32 + 8 * fq;
        const float* gp = gate + (size_t)((u.pm * BM) / SEQ) * gpitch + col0;
        f32x4 gv[2][2];
#pragma unroll
        for (int bj = 0; bj < 2; ++bj)
#pragma unroll
            for (int n = 0; n < 2; ++n) gv[bj][n] = *(const f32x4*)(gp + bj * HALF + 4 * n);
#pragma unroll
        for (int ai = 0; ai < 2; ++ai)
#pragma unroll
            for (int m = 0; m < 4; ++m) { const size_t off = (size_t)(row0 + ai * HALF + m * 16) * DM + col0;
#pragma unroll
                for (int bj = 0; bj < 2; ++bj)
#pragma unroll
                    for (int n = 0; n < 2; ++n) { const f32x4 xv = *(const f32x4*)(X + off + bj * HALF + 4 * n);
                        *(f32x4*)(O + off + bj * HALF + 4 * n) = xv + gv[bj][n] * acc[ai][bj][m][n]; } }
    }
};
struct EpiSwiGLU {
    bf16_t* O; unsigned* ready;
    __device__ __forceinline__ void operator()(const f32x4 (&acc)[2][2][4][2], const Unit& u, int wr, int wc, int fr, int fq) const {
        const int row0 = u.pm * BM + wr * 64 + fr, col0 = u.pn * HALF + wc * 32 + 8 * fq;
        const __amdgpu_buffer_rsrc_t rs = __builtin_amdgcn_make_buffer_rsrc((void*)O, (short)0, RMAX * DE * 2, 0x00020000);
#pragma unroll
        for (int ai = 0; ai < 2; ++ai)
#pragma unroll
            for (int m = 0; m < 4; ++m) { const int row = row0 + ai * HALF + m * 16;
                float h[8];
#pragma unroll
                for (int n = 0; n < 2; ++n)
#pragma unroll
                    for (int j = 0; j < 4; ++j) { const float gt = acc[ai][0][m][n][j], up = acc[ai][1][m][n][j]; h[4 * n + j] = gt / (1.f + __expf(-gt)) * up; }
                u32x4 w; w.x = cvt_pk_bf16(h[0], h[1]); w.y = cvt_pk_bf16(h[2], h[3]); w.z = cvt_pk_bf16(h[4], h[5]); w.w = cvt_pk_bf16(h[6], h[7]);
                __builtin_amdgcn_raw_buffer_store_b128(w, rs, (unsigned)(row * DE + col0) * 2u, 0, 16); }
        asm volatile("s_waitcnt vmcnt(0)" ::: "memory");
        if ((threadIdx.x & 63) == 0) __hip_atomic_fetch_add(ready + 64 * u.pm, 1u, __ATOMIC_RELAXED, __HIP_MEMORY_SCOPE_AGENT);
    }
};
}
constexpr size_t MiB = 1u << 20;
constexpr size_t WS_CTL = 0, CTL_ZERO_BYTES = 1 * MiB;
constexpr size_t WS_MOD = 1 * MiB;
constexpr size_t WS_ROPEC = 1 * MiB + 512 * 1024;
constexpr size_t WS_ROPES = WS_ROPEC + 2 * MiB;
constexpr size_t WS_WCT = WS_ROPES + 2 * MiB;
constexpr size_t WS_RSTDQ = 6 * MiB;
constexpr size_t WS_RSTDKV = WS_RSTDQ + 64 * 1024;
constexpr size_t WS_TOKE = WS_RSTDKV + 64 * 1024;
constexpr size_t WS_TOKW = WS_TOKE + 128 * 1024;
constexpr size_t WS_TOKS = WS_TOKW + 128 * 1024;
constexpr size_t WS_BLKE = WS_TOKS + 128 * 1024;
constexpr size_t WS_STAMP = WS_BLKE + 4096;
constexpr size_t WS_WIN = 8 * MiB;
constexpr size_t WS_WQUP = 28 * MiB;
constexpr size_t WS_WKVUP = WS_WQUP + 1536 * 1024;
constexpr size_t WS_WOUT = 31 * MiB;
constexpr size_t WS_A = 40 * MiB;
constexpr size_t WS_B = 200 * MiB;
constexpr size_t WS_C = 264 * MiB;
constexpr size_t WS_D = 328 * MiB;
constexpr size_t WS_E = 456 * MiB;
constexpr size_t WS_LIST = 520 * MiB;
constexpr size_t WS_F = 522 * MiB;
constexpr size_t WS_END = 586 * MiB;
constexpr size_t QN_BYTES = (size_t)T * MH * MQK * 2;

constexpr int CW_BAR = 4096;
constexpr int CW_CNT = 8192;
constexpr int CW_RDY = 10240;
constexpr int CW_ADA = 64;
constexpr int CW_TMO = 1;

constexpr int RING_BYTES = 131072, LDS_BYTES = 147456, LDS_USER = 143360, MISC_OFF = LDS_BYTES - 512;

struct Args { const float* in[25]; float* out; unsigned char* ws; int ph_lo, ph_hi, pad0, pad1; };

struct Frame {
    LAS unsigned char* lds;
    volatile LAS unsigned* MISC;
    gu32* ctl;
    int tid, lane, wave, vcu, G;
    unsigned char* ws; float* out;
};

#define OPAQUE_FRAME(F) do { F.tid = threadIdx.x; asm volatile("" : "+v"(F.tid)); F.lane = F.tid & 63; } while (0)

__device__ __forceinline__ void unpack8(const u32x4 w, float* f) { f[0] = bf_lo(w.x); f[1] = bf_hi(w.x); f[2] = bf_lo(w.y); f[3] = bf_hi(w.y); f[4] = bf_lo(w.z); f[5] = bf_hi(w.z); f[6] = bf_lo(w.w); f[7] = bf_hi(w.w); }
__device__ __forceinline__ u32x4 pack8f(const float* f) { u32x4 w; w.x = cvt_pk_bf16(f[0], f[1]); w.y = cvt_pk_bf16(f[2], f[3]); w.z = cvt_pk_bf16(f[4], f[5]); w.w = cvt_pk_bf16(f[6], f[7]); return w; }

struct TrItem { const float* src; bf16_t* dst; bf16_t* dst2; const float* gk; int N, ldt; };
__device__ __forceinline__ void tr_load(const TrItem& it, f32x4 (&r)[16], int lane) {
    const float* p = it.src + (size_t)(lane >> 4) * it.N + 4 * (lane & 15);
#pragma unroll
    for (int i = 0; i < 16; ++i) r[i] = __builtin_nontemporal_load((const f32x4*)(p + (size_t)(4 * i) * it.N));
}
__device__ __forceinline__ void tr_store(const TrItem& it, const f32x4 (&r)[16], LAS unsigned char* Tl, int lane) {
    const int row = lane >> 4, c4 = lane & 15;
#pragma unroll
    for (int i = 0; i < 16; ++i) { f32x4 v = r[i]; if (it.gk) v = v * it.gk[4 * i + row];
        u32x2 w; w.x = cvt_pk_bf16(v.x, v.y); w.y = cvt_pk_bf16(v.z, v.w);
        *(LAS u32x2*)(Tl + ((4 * i + row) * 64 + 4 * c4) * 2) = w; }
    LDS_WAIT(); asm volatile("" ::: "memory");
    const int g = lane >> 4, i16 = lane & 15, q = i16 >> 2, pp = lane & 3;
    typedef short v4i16_t __attribute__((ext_vector_type(4)));
#pragma unroll
    for (int hh = 0; hh < 2; ++hh) { bf16_t* drow = (hh ? it.dst2 : it.dst) + (size_t)(16 * (g & 1) + i16) * it.ldt;
#pragma unroll
        for (int j = 0; j < 4; ++j) { const int kc = 4 * (g >> 1) + j;
            const v4i16_t lo = __builtin_amdgcn_ds_read_tr16_b64_v4i16((LAS v4i16_t*)(Tl + ((8 * kc + q) * 64 + 32 * hh + 16 * (g & 1) + 4 * pp) * 2));
            const v4i16_t hi = __builtin_amdgcn_ds_read_tr16_b64_v4i16((LAS v4i16_t*)(Tl + ((8 * kc + 4 + q) * 64 + 32 * hh + 16 * (g & 1) + 4 * pp) * 2));
            const bf16x8 o = {lo[0], lo[1], lo[2], lo[3], hi[0], hi[1], hi[2], hi[3]};
            *(bf16x8*)(drow + 8 * kc) = o; } }
    LDS_WAIT(); asm volatile("" ::: "memory");
}
template <class MK> __device__ __forceinline__ void tr_run(int first, int step, int n, const MK& mk, LAS unsigned char* Tl, int lane) {
    if (first >= n) return;
    f32x4 ra[16], rb[16];
    TrItem ia = mk(first), ib = ia;
    tr_load(ia, ra, lane);
    for (int idx = first; idx < n; idx += 2 * step) {
        if (idx + step < n) { ib = mk(idx + step); tr_load(ib, rb, lane); }
        tr_store(ia, ra, Tl, lane);
        if (idx + step >= n) break;
        if (idx + 2 * step < n) { ia = mk(idx + 2 * step); tr_load(ia, ra, lane); }
        tr_store(ib, rb, Tl, lane);
    }
}

__device__ __forceinline__ void adaln_phase(Frame& F, const float* c, const float* w_ada, const float* b_ada, float* mod) {
    LAS float* cact = (LAS float*)F.lds;
    LAS float* part = (LAS float*)(F.lds + 65536);
    for (int i = F.tid; i < NB * DM; i += NTHR) cact[i] = siluf(c[i]);
    __syncthreads();
    const int cg = F.tid & 7, rs = F.tid >> 3;
    for (int it = blockIdx.x; it < 6 * DM / 32; it += F.G) {
        const int n0 = it * 32 + cg * 4;
        f32x4 acc[8];
#pragma unroll
        for (int b = 0; b < 8; ++b) acc[b] = (f32x4){0.f, 0.f, 0.f, 0.f};
#pragma unroll 1
        for (int i0 = 0; i0 < 32; i0 += 16) { f32x4 w[16];
#pragma unroll
            for (int u = 0; u < 16; ++u) w[u] = __builtin_nontemporal_load((const f32x4*)(w_ada + (size_t)(rs + 64 * (i0 + u)) * (6 * DM) + n0));
#pragma unroll
            for (int u = 0; u < 16; ++u) { const int k = rs + 64 * (i0 + u);
#pragma unroll
                for (int b = 0; b < 8; ++b) acc[b] += w[u] * cact[b * DM + k]; } }
#pragma unroll
        for (int b = 0; b < 8; ++b) *(LAS f32x4*)(part + (rs * 8 + b) * 32 + cg * 4) = acc[b];
        __syncthreads();
        if (F.tid < 256) { const int b = F.tid >> 5, n = F.tid & 31; float s = 0.f;
#pragma unroll 8
            for (int r = 0; r < 64; ++r) s += part[(r * 8 + b) * 32 + n];
            __hip_atomic_store(mod + b * (6 * DM) + it * 32 + n, s + b_ada[it * 32 + n], __ATOMIC_RELAXED, __HIP_MEMORY_SCOPE_AGENT); }
        asm volatile("s_waitcnt vmcnt(0)" ::: "memory");
        __syncthreads();
        if (it == (int)blockIdx.x && F.tid == 0) __hip_atomic_fetch_add((unsigned*)(F.ctl + CW_ADA), 1u, __ATOMIC_RELAXED, __HIP_MEMORY_SCOPE_AGENT);
    }
}

__device__ __forceinline__ void p0_phase(Frame& F, const Args& a) {
    OPAQUE_FRAME(F);
    unsigned char* ws = F.ws;
    adaln_phase(F, a.in[1], a.in[3], a.in[4], (float*)(ws + WS_MOD));
    __syncthreads();
    LAS unsigned char* Tl = F.lds + F.wave * 8192;
    const int gw = F.vcu * NWAVES + F.wave, NGW = F.G * NWAVES;
    constexpr int I_IN = (DM / 64) * (INC / 64), I_QUP = (QLORA / 64) * (MH * MQK / 64), I_KVUP = (KVLORA / 64) * (MH * 256 / 64), I_OUT = (DM / 64) * (DM / 64);
    constexpr int NITEMS = I_IN + I_QUP + I_KVUP + I_OUT;
    static_assert(INC % 64 == 0, "64-column transpose items");
    { const float* w_in = a.in[6]; const float* w_qup = a.in[10]; const float* w_kvup = a.in[12]; const float* w_out = a.in[16]; const float* gq = a.in[9]; const float* gkv = a.in[11];
      auto mk = [=](int r) -> TrItem { TrItem t;
          if (r < I_IN) { const int nblk = INC / 64, kb = r / nblk, nb = r % nblk; t.src = w_in + (size_t)(64 * kb) * INC + 64 * nb; t.dst = (bf16_t*)(ws + WS_WIN) + (size_t)(64 * nb) * DM + 64 * kb; t.dst2 = t.dst + (size_t)32 * DM; t.gk = nullptr; t.N = INC; t.ldt = DM; return t; } r -= I_IN;
          if (r < I_QUP) { const int nblk = MH * MQK / 64, kb = r / nblk, nb = r % nblk; t.src = w_qup + (size_t)(64 * kb) * (MH * MQK) + 64 * nb; t.dst = (bf16_t*)(ws + WS_WQUP) + (size_t)(64 * nb) * QLORA + 64 * kb; t.dst2 = t.dst + (size_t)32 * QLORA; t.gk = gq + 64 * kb; t.N = MH * MQK; t.ldt = QLORA; return t; } r -= I_QUP;
          if (r < I_KVUP) { const int nblk = MH * 256 / 64, kb = r / nblk, nb = r % nblk; t.src = w_kvup + (size_t)(64 * kb) * (MH * 256) + 64 * nb; t.dst = (bf16_t*)(ws + WS_WKVUP) + (size_t)(64 * nb) * KVLORA + 64 * kb; t.dst2 = t.dst + (size_t)32 * KVLORA; t.gk = gkv + 64 * kb; t.N = MH * 256; t.ldt = KVLORA; return t; } r -= I_KVUP;
          { const int nblk = DM / 64, kb = r / nblk, nb = r % nblk; t.src = w_out + (size_t)(64 * kb) * DM + 64 * nb; t.dst = (bf16_t*)(ws + WS_WOUT) + (size_t)(64 * nb) * DM + 64 * kb; t.dst2 = t.dst + (size_t)32 * DM; t.gk = nullptr; t.N = DM; t.ldt = DM; return t; } };
      const int nheavy = (6 * DM / 32) - F.G, nlw = (F.G - nheavy) * NWAVES;
      int pre = 0;
      if (nheavy > 0 && nheavy < F.G) { pre = 2 * nlw < NITEMS ? 2 * nlw : NITEMS;
          if ((int)blockIdx.x >= nheavy) tr_run(((int)blockIdx.x - nheavy) * NWAVES + F.wave, nlw, pre, mk, Tl, F.lane); }
      tr_run(pre + gw, NGW, NITEMS, mk, Tl, F.lane); }
    { const int* pos = (const int*)a.in[2]; float* rc = (float*)(ws + WS_ROPEC); float* rsn = (float*)(ws + WS_ROPES);
      const int gt = F.vcu * NTHR + F.tid, NGT = F.G * NTHR;
      const float invf = (float)exp2(-(double)(gt & 31) * (13.287712379549449 / 32.0));
      for (int e = gt; e < T * 32; e += NGT) { const int tk = e >> 5;
          const float ang = (float)pos[tk] * invf; float sv, cv; sincosf(ang, &sv, &cv);
          rc[e] = cv; rsn[e] = sv; }
      { float* ssq = (float*)(ws + WS_RSTDQ); for (int e = gt; e < 2 * T; e += NGT) ssq[e] = 0.f; }
      float* wct = (float*)(ws + WS_WCT);
      for (int e = gt; e < 48 * DM; e += NGT) { const int n = e / DM, k = e % DM;
          wct[e] = n < 4 ? a.in[18][k * NG + n] : (n < 36 ? a.in[20][k * NE + (n - 4)] : 0.f); } }
}

__device__ __forceinline__ void p1_phase(Frame& F, const Args& a) {
    OPAQUE_FRAME(F);
    const int gw = F.vcu * NWAVES + F.wave, NGW = F.G * NWAVES;
    const float* mod = (const float*)(F.ws + WS_MOD); const float* g = a.in[5]; const float* x = a.in[0];
    bf16_t* H = (bf16_t*)(F.ws + WS_B);
    if (F.tid == 0) { unsigned polls = 0;
        while (__hip_atomic_load((unsigned*)(F.ctl + CW_ADA), __ATOMIC_RELAXED, __HIP_MEMORY_SCOPE_AGENT) < (unsigned)F.G) { if (++polls > (1u << 16)) { __hip_atomic_store((unsigned*)(F.ctl + CW_TMO), 0xADA00000u, __ATOMIC_RELAXED, __HIP_MEMORY_SCOPE_AGENT); break; } __builtin_amdgcn_s_sleep(2); }
        __builtin_amdgcn_fence(__ATOMIC_ACQUIRE, "agent"); asm volatile("s_waitcnt vmcnt(0)" ::: "memory"); }
    __syncthreads();
    for (int blk = gw; blk < T / 8; blk += NGW) { const int m0 = blk * 8, b = m0 / SEQ;
        const float* shift = mod + b * (6 * DM); const float* scale = shift + DM;
        f32x4 gm[8], sh[8];
#pragma unroll
        for (int j = 0; j < 8; ++j) { gm[j] = ((const f32x4*)g)[64 * j + F.lane] * (((const f32x4*)scale)[64 * j + F.lane] + 1.f); sh[j] = ((const f32x4*)shift)[64 * j + F.lane]; }
        f32x4 va[8], vb[8];
#define P1_LD(r, V) do { const f32x4* xr_ = (const f32x4*)(x + (size_t)(m0 + (r)) * DM) + F.lane; _Pragma("unroll") for (int j = 0; j < 8; ++j) V[j] = __builtin_nontemporal_load(xr_ + 64 * j); } while (0)
#define P1_ST(r, V) do { float s_ = 0.f; _Pragma("unroll") for (int j = 0; j < 8; ++j) s_ += (V[j].x * V[j].x + V[j].y * V[j].y) + (V[j].z * V[j].z + V[j].w * V[j].w); \
            const float rstd_ = rsqrtf(wave_sum(s_) * (1.f / DM) + EPS); u32x2* o8_ = (u32x2*)(H + (size_t)(m0 + (r)) * DM) + F.lane; \
            _Pragma("unroll") for (int j = 0; j < 8; ++j) { const f32x4 h_ = V[j] * rstd_ * gm[j] + sh[j]; u32x2 w_; w_.x = cvt_pk_bf16(h_.x, h_.y); w_.y = cvt_pk_bf16(h_.z, h_.w); o8_[64 * j] = w_; } } while (0)
        P1_LD(0, va);
#pragma unroll 1
        for (int r = 0; r < 8; r += 2) {
            P1_LD(r + 1, vb); __builtin_amdgcn_sched_barrier(0);
            P1_ST(r, va); __builtin_amdgcn_sched_barrier(0);
            if (r + 2 < 8) { P1_LD(r + 2, va); } __builtin_amdgcn_sched_barrier(0);
            P1_ST(r + 1, vb); __builtin_amdgcn_sched_barrier(0);
        }
#undef P1_LD
#undef P1_ST
    }
}

namespace hg {
constexpr int OFF_F = 0, OFF_SEG = 32768, OFF_QIN = 34816, RP = 272, OFF_KIN = OFF_QIN + 64 * RP, OFF_QB = OFF_KIN + 64 * RP, OFF_KLT = OFF_QB + 64 * RP, SP = 144,
              OFF_VT = OFF_KLT + 128 * SP  , OFF_DEC = OFF_VT + 64 * SP  , OFF_SF = OFF_DEC + 3584  , OP = 144, OFF_O = OFF_SF + 16384  , OFF_LB = OFF_O + 64 * OP  , HG_LDS = OFF_LB + 1024;
static_assert(HG_LDS <= MISC_OFF, "hgrn lds");
__device__ __forceinline__ float dpp_xor1(float v) { return __builtin_bit_cast(float, __builtin_amdgcn_update_dpp(0, __builtin_bit_cast(int, v), 0xB1, 0xF, 0xF, true)); }
__device__ __forceinline__ int ppos(int s) { return (s & ~15) | ((s & 4) << 1) | ((s & 8) >> 1) | (s & 3); }
}
__device__ __forceinline__ void hgrn_chunked(Frame& F, const Args& a, int item) {
    using namespace hg;
    const bf16_t* PROJ = (const bf16_t*)(F.ws + WS_A);
    bf16_t* MIX = (bf16_t*)F.out;
    const float* lbl = a.in[7];
    LAS unsigned char* L = F.lds;
    LAS float* Fs = (LAS float*)(L + OFF_F); LAS float* SEGs = (LAS float*)(L + OFF_SEG); LAS float* DEC = (LAS float*)(L + OFF_DEC); LAS float* POST = DEC + 384;
    const int g = F.tid & 15, t0 = F.tid >> 4;
    const int sk = F.tid & 127, sseg = F.tid >> 7;
    const int r32 = F.lane & 31, hi = F.lane >> 5;
    {
        const int dq2 = (item >> 3) & 1, bh = (item >> 4) * 8 + (item & 7), h = bh & 7, b = bh >> 3;
        LAS float* LB = (LAS float*)(L + OFF_LB);
        if (F.tid < 128) { const int k = h * 128 + F.tid; const float l = 1.f / (1.f + __expf(lbl[HW + k] - lbl[k])); LB[F.tid] = l; LB[128 + F.tid] = 1.f - l; }
        __syncthreads();
        const bf16_t* base = PROJ + (size_t)(b * SEQ) * INCP + h * 128;
        f32x16 S0 = {}, S1 = {};
        u32x4 gq[2], gf[2], gv;
#define HG_LOADF(c) do { _Pragma("unroll") for (int i = 0; i < 2; ++i) gf[i] = *(const u32x4*)(base + (size_t)((c) * 64 + t0 + 32 * i) * INCP + g * 8 + HW); } while (0)
#define HG_LOADQ(c) do { _Pragma("unroll") for (int i = 0; i < 2; ++i) gq[i] = *(const u32x4*)(base + (size_t)((c) * 64 + t0 + 32 * i) * INCP + g * 8); \
            gv = *(const u32x4*)(base + (size_t)((c) * 64 + (F.tid >> 3)) * INCP + 2 * HW + dq2 * 64 + (F.tid & 7) * 8); } while (0)
        HG_LOADF(0); HG_LOADQ(0);
        for (int c = 0; c < SEQ / 64; ++c) {
            if (F.wave >= 4) { const int kb = F.wave - 4;
#pragma unroll
                for (int s2 = 0; s2 < 2; ++s2) { u32x4 w0, w1;
                    w0.x = cvt_pk_bf16(S0[8 * s2], S0[8 * s2 + 1]); w0.y = cvt_pk_bf16(S0[8 * s2 + 2], S0[8 * s2 + 3]); w0.z = cvt_pk_bf16(S0[8 * s2 + 4], S0[8 * s2 + 5]); w0.w = cvt_pk_bf16(S0[8 * s2 + 6], S0[8 * s2 + 7]);
                    w1.x = cvt_pk_bf16(S1[8 * s2], S1[8 * s2 + 1]); w1.y = cvt_pk_bf16(S1[8 * s2 + 2], S1[8 * s2 + 3]); w1.z = cvt_pk_bf16(S1[8 * s2 + 4], S1[8 * s2 + 5]); w1.w = cvt_pk_bf16(S1[8 * s2 + 6], S1[8 * s2 + 7]);
                    *(LAS u32x4*)(L + OFF_SF + ((((kb * 2 + 0) * 2 + s2) * 64) + F.lane) * 16) = w0;
                    *(LAS u32x4*)(L + OFF_SF + ((((kb * 2 + 1) * 2 + s2) * 64) + F.lane) * 16) = w1; } }
            float fv[2][8];
            float lb[8], lc[8];
            { const f32x4 l0 = *(const LAS f32x4*)(LB + g * 8), l1 = *(const LAS f32x4*)(LB + g * 8 + 4), c0 = *(const LAS f32x4*)(LB + 128 + g * 8), c1 = *(const LAS f32x4*)(LB + 128 + g * 8 + 4);
#pragma unroll
              for (int j = 0; j < 4; ++j) { lb[j] = l0[j]; lb[4 + j] = l1[j]; lc[j] = c0[j]; lc[4 + j] = c1[j]; } }
#pragma unroll
            for (int i = 0; i < 2; ++i) { float fl[8]; unpack8(gf[i], fl);
#pragma unroll
                for (int j = 0; j < 8; ++j) fv[i][j] = 1.f - lc[j] * fl[j];
                LAS float* fp = Fs + (t0 + 32 * i) * 128 + g * 8;
                *(LAS f32x4*)fp = (f32x4){fv[i][0], fv[i][1], fv[i][2], fv[i][3]}; *(LAS f32x4*)(fp + 4) = (f32x4){fv[i][4], fv[i][5], fv[i][6], fv[i][7]}; }
            if (c + 1 < SEQ / 64) HG_LOADF(c + 1);
            __syncthreads();
            float klp[16];
            { float fr[16];
#pragma unroll
              for (int i = 0; i < 16; ++i) fr[i] = Fs[(16 * sseg + i) * 128 + sk];
              float p = 1.f;
#pragma unroll
              for (int i = 0; i < 16; ++i) { p *= fr[i]; Fs[(16 * sseg + i) * 128 + sk] = p; }
              SEGs[sseg * 128 + sk] = p;
              float q = 1.f;
#pragma unroll
              for (int i = 15; i >= 0; --i) { klp[i] = (1.f - fr[i]) * q; q *= fr[i]; } }
            __syncthreads();
            if (F.tid < 128) { const float s0 = SEGs[F.tid], s1 = SEGs[128 + F.tid], s2 = SEGs[256 + F.tid], s3 = SEGs[384 + F.tid];
                const float pm = s0 * s1;
                SEGs[F.tid] = 1.f; SEGs[128 + F.tid] = s0; SEGs[256 + F.tid] = pm; SEGs[384 + F.tid] = pm * s2;
                POST[F.tid] = s1 * s2 * s3; POST[128 + F.tid] = s2 * s3; POST[256 + F.tid] = s3; POST[384 + F.tid] = 1.f;
                DEC[F.tid] = pm * s2 * s3; DEC[128 + F.tid] = pm; DEC[256 + F.tid] = __builtin_amdgcn_rcpf(pm); }
            __syncthreads();
            { { const float po = POST[sseg * 128 + sk];
                float o16[16];
#pragma unroll
                for (int p = 0; p < 16; ++p) o16[p] = klp[8 * ((p >> 2) & 1) + 4 * (p >> 3) + (p & 3)] * po;
                *(LAS u32x4*)(L + OFF_KLT + sk * SP + sseg * 32) = pack8f(o16); *(LAS u32x4*)(L + OFF_KLT + sk * SP + sseg * 32 + 16) = pack8f(o16 + 8); }
#pragma unroll
              for (int i = 0; i < 2; ++i) { const int t = t0 + 32 * i;
                  float qin[8], kin[8], qb[8], qv[8];
                  unpack8(gq[i], qv);
                  const LAS float* fp = Fs + t * 128 + g * 8; const LAS float* pp = SEGs + (t >> 4) * 128 + g * 8;
                  const f32x4 pa = *(const LAS f32x4*)fp, pb = *(const LAS f32x4*)(fp + 4), ea = *(const LAS f32x4*)pp, eb = *(const LAS f32x4*)(pp + 4);
                  const f32x4 ma = *(const LAS f32x4*)(DEC + 128 + g * 8), mb = *(const LAS f32x4*)(DEC + 128 + g * 8 + 4), ra = *(const LAS f32x4*)(DEC + 256 + g * 8), rb = *(const LAS f32x4*)(DEC + 256 + g * 8 + 4);
#pragma unroll
                  for (int j = 0; j < 8; ++j) { const float P = (j < 4 ? pa[j] * ea[j] : pb[j - 4] * eb[j - 4]), pm = j < 4 ? ma[j] : mb[j - 4], rpm = j < 4 ? ra[j] : rb[j - 4];
                      const float r = __builtin_amdgcn_rcpf(P), kk = 1.f - fv[i][j], qs = qv[j] * 0.08838834764831845f;
                      qb[j] = qs * P; qin[j] = qb[j] * rpm; kin[j] = kk * pm * r; }
                  *(LAS u32x4*)(L + OFF_QIN + t * RP + g * 16) = pack8f(qin);
                  *(LAS u32x4*)(L + OFF_KIN + t * RP + g * 16) = pack8f(kin);
                  { const u32x4 w = pack8f(qb);
                    *(LAS u32x2*)(L + OFF_QB + t * RP + ((g >> 1) * 16 + (g & 1) * 4) * 2) = (u32x2){w.x, w.y};
                    *(LAS u32x2*)(L + OFF_QB + t * RP + ((g >> 1) * 16 + 8 + (g & 1) * 4) * 2) = (u32x2){w.z, w.w}; } }
              { float v[8]; unpack8(gv, v); const int s = F.tid >> 3, dvg = F.tid & 7, ps = ppos(s);
#pragma unroll
                  for (int j = 0; j < 8; ++j) *(LAS bf16_t*)(L + OFF_VT + (dvg * 8 + j) * SP + (((ps >> 3) ^ dvg) << 4) + (ps & 7) * 2) = (bf16_t)(__builtin_bit_cast(unsigned, v[j]) >> 16); } }
            __syncthreads();
            if (F.wave < 4) { const int tb = F.wave & 1, dvb = F.wave >> 1;
                const LAS unsigned char* qin_p = L + OFF_QIN + (32 * tb + r32) * RP + 16 * hi;
                const LAS unsigned char* qb_p = L + OFF_QB + (32 * tb + r32) * RP + 16 * hi;
                const LAS unsigned char* sf_p = L + OFF_SF + dvb * 2048 + F.lane * 16;
                const LAS unsigned char* kin_p = L + OFF_KIN + r32 * RP + 16 * hi;
                const LAS unsigned char* vt_p = L + OFF_VT + (32 * dvb + r32) * SP; const int vsw = (4 * dvb + (r32 >> 3)) & 7;
#define HG_VT(ch) (*(const LAS bf16x8*)(vt_p + ((((ch) + hi) ^ vsw) << 4)))
                bf16x8 A0[4], B0[4], A1[4], B1[4], vf0, vf1;
#define HG_LDQS(A, B, i0) do { _Pragma("unroll") for (int i = 0; i < 4; ++i) { const int kb_ = ((i0) + i) >> 1, s2_ = ((i0) + i) & 1; \
                    A[i] = *(const LAS bf16x8*)(qb_p + 64 * kb_ + 32 * s2_); B[i] = *(const LAS bf16x8*)(sf_p + kb_ * 4096 + s2_ * 1024); } } while (0)
#define HG_LDX(A, B, sb_, k0) do { _Pragma("unroll") for (int i = 0; i < 4; ++i) { A[i] = *(const LAS bf16x8*)(kin_p + 32 * (sb_) * RP + 32 * ((k0) + i)); B[i] = *(const LAS bf16x8*)(qin_p + 32 * ((k0) + i)); } } while (0)
#define HG_MM(D, A, B) do { _Pragma("unroll") for (int i = 0; i < 4; ++i) D = __builtin_amdgcn_mfma_f32_32x32x16_bf16(A[i], B[i], D, 0, 0, 0); } while (0)
#define HG_XV(X, v0, v1) do { u32x4 w0_, w1_; \
                    w0_.x = cvt_pk_bf16(X[0], X[1]); w0_.y = cvt_pk_bf16(X[2], X[3]); w0_.z = cvt_pk_bf16(X[4], X[5]); w0_.w = cvt_pk_bf16(X[6], X[7]); \
                    w1_.x = cvt_pk_bf16(X[8], X[9]); w1_.y = cvt_pk_bf16(X[10], X[11]); w1_.z = cvt_pk_bf16(X[12], X[13]); w1_.w = cvt_pk_bf16(X[14], X[15]); \
                    o = __builtin_amdgcn_mfma_f32_32x32x16_bf16(__builtin_bit_cast(bf16x8, w0_), v0, o, 0, 0, 0); o = __builtin_amdgcn_mfma_f32_32x32x16_bf16(__builtin_bit_cast(bf16x8, w1_), v1, o, 0, 0, 0); } while (0)
#define HG_DIAG(X) do { _Pragma("unroll") for (int r = 0; r < 16; ++r) { const int srow = (r & 3) + 8 * (r >> 2) + 4 * hi; if (srow > r32) X[r] = 0.f; } } while (0)
                f32x16 o = {}, X = {};
                HG_LDQS(A0, B0, 0); HG_LDQS(A1, B1, 4); __builtin_amdgcn_sched_barrier(0);
                HG_MM(o, A0, B0); __builtin_amdgcn_sched_barrier(0);
                HG_LDX(A0, B0, 0, 0); __builtin_amdgcn_sched_barrier(0);
                HG_MM(o, A1, B1); __builtin_amdgcn_sched_barrier(0);
                HG_LDX(A1, B1, 0, 4); vf0 = HG_VT(0); vf1 = HG_VT(2); __builtin_amdgcn_sched_barrier(0);
                HG_MM(X, A0, B0); __builtin_amdgcn_sched_barrier(0);
                if (tb == 1) { HG_LDX(A0, B0, 1, 0); } __builtin_amdgcn_sched_barrier(0);
                HG_MM(X, A1, B1); __builtin_amdgcn_sched_barrier(0);
                if (tb == 0) { HG_DIAG(X); HG_XV(X, vf0, vf1); }
                else { bf16x8 vg0, vg1;
                    HG_LDX(A1, B1, 1, 4); vg0 = HG_VT(4); vg1 = HG_VT(6); __builtin_amdgcn_sched_barrier(0);
                    HG_XV(X, vf0, vf1);
#pragma unroll
                    for (int r = 0; r < 16; ++r) X[r] = 0.f;
                    HG_MM(X, A0, B0); HG_MM(X, A1, B1); HG_DIAG(X); HG_XV(X, vg0, vg1); }
#undef HG_VT
#undef HG_LDQS
#undef HG_LDX
#undef HG_MM
#undef HG_XV
#undef HG_DIAG
                unsigned ow[16];
#pragma unroll
                for (int r = 0; r < 16; ++r) ow[r] = cvt_pk_bf16(o[r], dpp_xor1(o[r]));
                if ((r32 & 1) == 0) { LAS unsigned char* ob = L + OFF_O + (32 * tb + 4 * hi) * OP + (32 * dvb + r32) * 2;
#pragma unroll
                    for (int r = 0; r < 16; ++r) *(LAS unsigned*)(ob + ((r & 3) + 8 * (r >> 2)) * OP) = ow[r]; }
            } else { const int kb = F.wave - 4;
                bf16x8 kf[4], va[4], vb[4];
#pragma unroll
                for (int ss = 0; ss < 4; ++ss) { kf[ss] = *(const LAS bf16x8*)(L + OFF_KLT + (32 * kb + r32) * SP + (16 * ss + 8 * hi) * 2);
                    va[ss] = *(const LAS bf16x8*)(L + OFF_VT + r32 * SP + (((2 * ss + hi) ^ (r32 >> 3)) << 4)); vb[ss] = *(const LAS bf16x8*)(L + OFF_VT + (32 + r32) * SP + (((2 * ss + hi) ^ (4 + (r32 >> 3))) << 4)); }
#pragma unroll
                for (int r = 0; r < 16; ++r) { const float dcy = DEC[32 * kb + (r & 3) + 8 * (r >> 2) + 4 * hi]; S0[r] *= dcy; S1[r] *= dcy; }
                __builtin_amdgcn_sched_barrier(0);
#pragma unroll
                for (int ss = 0; ss < 4; ++ss) { S0 = __builtin_amdgcn_mfma_f32_32x32x16_bf16(kf[ss], va[ss], S0, 0, 0, 0); S1 = __builtin_amdgcn_mfma_f32_32x32x16_bf16(kf[ss], vb[ss], S1, 0, 0, 0); }
            }
            __syncthreads();
            { const int row = F.tid >> 3, pc = F.tid & 7;
              const u32x4 w = *(const LAS u32x4*)(L + OFF_O + row * OP + pc * 16);
              *(u32x4*)(MIX + (size_t)(b * SEQ + c * 64 + row) * DM + h * 128 + dq2 * 64 + pc * 8) = w; }
            if (c + 1 < SEQ / 64) HG_LOADQ(c + 1);
        }
#undef HG_LOADF
#undef HG_LOADQ
    }
}

constexpr int MOE_IG = NE * (DM / 64) * (DE / 64);
constexpr int MOE_PRE = 4096;
struct MoeItems { const float* wg; const float* wu; const float* wd; unsigned char* ws;
    __device__ TrItem operator()(int it) const { TrItem t; t.gk = nullptr;
        const int which = it / MOE_IG, r = it % MOE_IG;
        if (which < 2) { const int e = r / 256, q = r % 256, kb = q / 8, nb = q % 8, n0 = 64 * nb;
            t.src = (which ? wu : wg) + (size_t)e * DM * DE + (size_t)(64 * kb) * DE + n0;
            t.dst = (bf16_t*)(ws + WS_D) + ((size_t)e * 1024 + (n0 >> 7) * 256 + (n0 & 127) + which * 128) * DM + 64 * kb; t.dst2 = t.dst + (size_t)32 * DM; t.N = DE; t.ldt = DM; }
        else { const int e = r / 256, q = r % 256, kb = q / 32, nb = q % 32, n0 = 64 * nb;
            t.src = wd + (size_t)e * DE * DM + (size_t)(64 * kb) * DM + n0;
            t.dst = (bf16_t*)(ws + WS_E) + ((size_t)e * DM + n0) * DE + 64 * kb; t.dst2 = t.dst + (size_t)32 * DE; t.N = DM; t.ldt = DE; }
        return t; } };

__device__ __forceinline__ void p3_phase(Frame& F, const Args& a) {
    OPAQUE_FRAME(F);
    const int role = ((int)blockIdx.x >> 3) & 1, idx = ((int)blockIdx.x >> 4) * 8 + ((int)blockIdx.x & 7), half = F.G >> 1;
    unsigned char* ws = F.ws;
    #ifndef MK_HGREP
#define MK_HGREP 1
#endif
    if (role == 0) { for (int rep = 0; rep < MK_HGREP; ++rep) { for (int it = idx; it < NB * HH * 2; it += half) hgrn_chunked(F, a, it); if (MK_HGREP > 1) __syncthreads(); } }
    else {
        { pg8::Gemm g{(const bf16_t*)(ws + WS_A) + C_QA, (const bf16_t*)(ws + WS_WQUP), INCP, QLORA, QLORA};
          pg8::DenseOrder S; S.init(T / 256, MH * MQK / 256, half, idx);
          pg8::EpiStore E{(bf16_t*)(ws + WS_B), MH * MQK, (const float*)(ws + WS_RSTDQ), 1.f / QLORA};
          pg8::gemm_phase<pg8::EpiStore, pg8::DenseOrder>(F.lds, g, S, E); }
        { pg8::Gemm g{(const bf16_t*)(ws + WS_A) + C_KVA, (const bf16_t*)(ws + WS_WKVUP), INCP, KVLORA, KVLORA};
          pg8::DenseOrder S; S.init(T / 256, MH * 256 / 256, half, idx);
          pg8::EpiStore E{(bf16_t*)(ws + WS_C), MH * 256, (const float*)(ws + WS_RSTDKV), 1.f / KVLORA};
          pg8::gemm_phase<pg8::EpiStore, pg8::DenseOrder>(F.lds, g, S, E); }
        { const MoeItems mk{a.in[22], a.in[23], a.in[24], ws};
          tr_run(idx * NWAVES + F.wave, half * NWAVES, MOE_PRE, mk, F.lds + F.wave * 8192, F.lane); }
    }
}

__device__ __forceinline__ float sum8(float v) { v += __shfl_xor(v, 1); v += __shfl_xor(v, 2); v += __shfl_xor(v, 4); return v; }

struct P5Set { u32x4 k0, k1, kpe, m0, m1, g0, g1; f32x4 ca, cb, sa, sb; };
__device__ __forceinline__ void p5_phase(Frame& F, const Args& a) {
    OPAQUE_FRAME(F);
    const int gw = F.vcu * NWAVES + F.wave, NGW = F.G * NWAVES;
    const bf16_t* PROJ = (const bf16_t*)(F.ws + WS_A);
    const bf16_t* KV = (const bf16_t*)(F.ws + WS_C);
    bf16_t* Kn = (bf16_t*)(F.ws + WS_F);
    bf16_t* MIX = (bf16_t*)F.out;
    const float* rc = (const float*)(F.ws + WS_ROPEC); const float* rsn = (const float*)(F.ws + WS_ROPES);
    const int h = F.lane >> 3, sub = F.lane & 7;
    const float sgn = sub < 4 ? -1.f : 1.f;
    float gk[3][8], go[2][8];
#pragma unroll
    for (int i = 0; i < 3; ++i)
#pragma unroll
        for (int j = 0; j < 8; ++j) gk[i][j] = a.in[14][(sub + 8 * i) * 8 + j];
#pragma unroll
    for (int i = 0; i < 2; ++i)
#pragma unroll
        for (int j = 0; j < 8; ++j) go[i][j] = a.in[8][(sub + 8 * i) * 8 + j];
#define P5_LD(t_, S_) do { const size_t t__ = (size_t)(t_); const int ii_ = (sub & 3) * 8; \
        S_.k0 = __builtin_nontemporal_load((const u32x4*)(KV + t__ * (MH * 256) + h * 256 + sub * 8)); S_.k1 = __builtin_nontemporal_load((const u32x4*)(KV + t__ * (MH * 256) + h * 256 + (sub + 8) * 8)); \
        S_.kpe = *(const u32x4*)(PROJ + t__ * INCP + C_KPE + sub * 8); \
        S_.ca = *(const f32x4*)(rc + t__ * 32 + ii_); S_.cb = *(const f32x4*)(rc + t__ * 32 + ii_ + 4); S_.sa = *(const f32x4*)(rsn + t__ * 32 + ii_); S_.sb = *(const f32x4*)(rsn + t__ * 32 + ii_ + 4); \
        S_.m0 = *(const u32x4*)(MIX + t__ * DM + h * 128 + sub * 8); S_.m1 = *(const u32x4*)(MIX + t__ * DM + h * 128 + (sub + 8) * 8); \
        S_.g0 = __builtin_nontemporal_load((const u32x4*)(PROJ + t__ * INCP + 3 * HW + h * 128 + sub * 8)); S_.g1 = __builtin_nontemporal_load((const u32x4*)(PROJ + t__ * INCP + 3 * HW + h * 128 + (sub + 8) * 8)); } while (0)
#define P5_CP(t_, S_) do { const int t__ = (t_), b_ = t__ / SEQ, s_ = t__ % SEQ; const size_t hrow = ((size_t)(b_ * MH + h) * SEQ + s_); \
        { float k[3][8]; float ss = 0.f; unpack8(S_.k0, k[0]); unpack8(S_.k1, k[1]); unpack8(S_.kpe, k[2]); \
          _Pragma("unroll") for (int i = 0; i < 3; ++i) _Pragma("unroll") for (int j = 0; j < 8; ++j) ss += k[i][j] * k[i][j]; \
          const float rs = rsqrtf(sum8(ss) * (1.f / MQK) + EPS); \
          _Pragma("unroll") for (int i = 0; i < 3; ++i) _Pragma("unroll") for (int j = 0; j < 8; ++j) k[i][j] *= rs * gk[i][j]; \
          _Pragma("unroll") for (int j = 0; j < 8; ++j) { const float pv = __shfl_xor(k[2][j], 4); const float cs_ = j < 4 ? S_.ca[j & 3] : S_.cb[j & 3], sn_ = j < 4 ? S_.sa[j & 3] : S_.sb[j & 3]; k[2][j] = k[2][j] * cs_ + sgn * pv * sn_; } \
          _Pragma("unroll") for (int i = 0; i < 3; ++i) *(u32x4*)(Kn + hrow * MQK + (sub + 8 * i) * 8) = pack8f(k[i]); } \
        { float o[2][8], gt[2][8]; float ss = 0.f; unpack8(S_.m0, o[0]); unpack8(S_.m1, o[1]); unpack8(S_.g0, gt[0]); unpack8(S_.g1, gt[1]); \
          _Pragma("unroll") for (int i = 0; i < 2; ++i) _Pragma("unroll") for (int j = 0; j < 8; ++j) ss += o[i][j] * o[i][j]; \
          const float rs = rsqrtf(sum8(ss) * (1.f / HDV) + EPS); \
          _Pragma("unroll") for (int i = 0; i < 2; ++i) { _Pragma("unroll") for (int j = 0; j < 8; ++j) o[i][j] = o[i][j] * rs * go[i][j] * siluf(gt[i][j]); \
              *(u32x4*)(MIX + (size_t)t__ * DM + h * 128 + (sub + 8 * i) * 8) = pack8f(o[i]); } } } while (0)
    for (int blk = gw; blk < T / 8; blk += NGW) { const int t0 = blk * 8;
        P5Set A, B;
        P5_LD(t0, A);
#pragma unroll 1
        for (int r = 0; r < 8; r += 2) {
            P5_LD(t0 + r + 1, B); __builtin_amdgcn_sched_barrier(0);
            P5_CP(t0 + r, A); __builtin_amdgcn_sched_barrier(0);
            if (r + 2 < 8) { P5_LD(t0 + r + 2, A); } __builtin_amdgcn_sched_barrier(0);
            P5_CP(t0 + r + 1, B); __builtin_amdgcn_sched_barrier(0);
        }
    }
#undef P5_LD
#undef P5_CP
}
namespace att {
constexpr int QBLK = 32, KVBLK = 64, QB = 256;
constexpr int KROW = 512, SHM_K = KVBLK * KROW, SHM_V = KVBLK * MV * 2;
constexpr int OFF_V = 0, OFF_K = 2 * SHM_V, OFF_WS = OFF_K + 2 * SHM_K;
constexpr float SCALE = 0.07216878364870322f;
constexpr float THR = 8.f;
#define SBAR() __builtin_amdgcn_sched_barrier(0)
__device__ __forceinline__ int v_st(int k, int c) { const int kk = (k & ~0xC) | ((k & 4) << 1) | ((k & 8) >> 1); return ((kk >> 3) * 4 + (c >> 5)) * 512 + ((kk & 7) * 32 + (c & 31)) * 2; }
__device__ __forceinline__ int v_rd_base(int lane) { return ((lane & 3) << 3) | (((lane >> 2) & 3) << 6) | (((lane >> 4) & 1) << 5) | (((lane >> 5) & 1) << 8); }
constexpr int v_rd_off(int d0, int ks, int half) { return d0 * 512 + ks * 4096 + half * 2048; }
__device__ __forceinline__ int crow(int r, int hi) { return (r & 3) + 8 * (r >> 2) + 4 * hi; }
template <int M> __device__ __forceinline__ float swz_xor(float v) { return __builtin_bit_cast(float, __builtin_amdgcn_ds_swizzle(__builtin_bit_cast(int, v), (M << 10) | 0x1F)); }
__device__ __forceinline__ unsigned cvtpk(float lo, float hi) { unsigned r; asm volatile("v_cvt_pk_bf16_f32 %0, %1, %2" : "=v"(r) : "v"(lo), "v"(hi)); return r; }

__device__ __forceinline__ void mask_tile(f32x16& p0, f32x16& p1, int dq) {
    const float NEG = -__builtin_inff();
#pragma unroll
    for (int r = 0; r < 16; ++r) {
        const int c = (r & 3) + 8 * (r >> 2);
        if (dq - c < 0) p0[r] = NEG;
        if (dq - c - 32 < 0) p1[r] = NEG;
    }
}
__device__ __forceinline__ void partialSM(f32x16& p0, f32x16& p1, float& m_reg, float& mn, float& alpha) {
    float pmax = p0[0];
#pragma unroll
    for (int r = 1; r < 16; ++r) pmax = fmaxf(pmax, p0[r]);
#pragma unroll
    for (int r = 0; r < 16; ++r) pmax = fmaxf(pmax, p1[r]);
    { auto rr = __builtin_amdgcn_permlane32_swap(__float_as_uint(pmax), __float_as_uint(pmax), false, false);
      pmax = fmaxf(__uint_as_float(rr[0]), __uint_as_float(rr[1])); }
    constexpr float C2 = 1.4426950408889634f * SCALE;
    if (__builtin_expect(__all((pmax - m_reg) * SCALE <= THR), 1)) { mn = m_reg; alpha = 1.f; }
    else { mn = fmaxf(m_reg, pmax); alpha = __builtin_amdgcn_exp2f((m_reg - mn) * C2); m_reg = mn; }
    const float mnL = -mn * C2;
#pragma unroll
    for (int r = 0; r < 16; ++r) p0[r] = fmaf(p0[r], C2, mnL);
#pragma unroll
    for (int r = 0; r < 16; ++r) p1[r] = fmaf(p1[r], C2, mnL);
#pragma unroll
    for (int r = 0; r < 16; ++r) p0[r] = __builtin_amdgcn_exp2f(p0[r]);
}
__device__ __forceinline__ void finishSM(f32x16& p0, f32x16& p1, float alpha, float& l_reg, bf16x8& pa0, bf16x8& pa1, bf16x8& pa2, bf16x8& pa3) {
#pragma unroll
    for (int r = 0; r < 16; ++r) p1[r] = __builtin_amdgcn_exp2f(p1[r]);
    float ps = 0;
#pragma unroll
    for (int r = 0; r < 16; ++r) ps += p0[r];
#pragma unroll
    for (int r = 0; r < 16; ++r) ps += p1[r];
    { auto rr = __builtin_amdgcn_permlane32_swap(__float_as_uint(ps), __float_as_uint(ps), false, false);
      ps = __uint_as_float(rr[0]) + __uint_as_float(rr[1]); }
    l_reg = l_reg * alpha + ps;
#define PK4(P, B_, OUT) do { unsigned a0 = cvtpk(P[B_+0], P[B_+1]), a1 = cvtpk(P[B_+2], P[B_+3]);                          \
        unsigned b0 = cvtpk(P[B_+4], P[B_+5]), b1 = cvtpk(P[B_+6], P[B_+7]);                                             \
        auto r0 = __builtin_amdgcn_permlane32_swap(a0, b0, false, false); auto r1 = __builtin_amdgcn_permlane32_swap(a1, b1, false, false); \
        u32x4 w = {r0[0], r1[0], r0[1], r1[1]}; OUT = __builtin_bit_cast(bf16x8, w); } while (0)
    PK4(p0, 0, pa0); PK4(p0, 8, pa1); PK4(p1, 0, pa2); PK4(p1, 8, pa3);
#undef PK4
}
template <int KB>
__device__ __forceinline__ void qkt(f32x16& p0, f32x16& p1, LAS unsigned char* lds, int r32, int hi, const bf16x8* qr) {
    p0 = f32x16{}; p1 = f32x16{};
    int sw = r32 & 15; asm volatile("" : "+v"(sw));
    const int rb = OFF_K + KB * SHM_K + r32 * KROW;
    int ab[8];
#pragma unroll
    for (int d = 0; d < 8; ++d) ab[d] = rb + (((2 * d + hi) ^ sw) << 4);
#pragma unroll
    for (int d0 = 0; d0 < 12; ++d0) { const int a = ab[d0 & 7] + (d0 >> 3) * 256;
        const bf16x8 b0 = *(const LAS bf16x8*)(lds + a);
        const bf16x8 b1 = *(const LAS bf16x8*)(lds + a + 32 * KROW);
        p0 = __builtin_amdgcn_mfma_f32_32x32x16_bf16(b0, qr[d0], p0, 0, 0, 0);
        p1 = __builtin_amdgcn_mfma_f32_32x32x16_bf16(b1, qr[d0], p1, 0, 0, 0); }
}
template <int VB>
__device__ __forceinline__ void pv_tile(f32x16* o, int vb0, bf16x8 pa0, bf16x8 pa1, bf16x8 pa2, bf16x8 pa3) {
#define TRRD(dst, off) asm volatile("ds_read_b64_tr_b16 %0, %1 offset:%2" : "=&v"(dst) : "v"(vb0), "i"(off) : "memory")
#define PV_D0(d0) do { s16x4 l0, l1, l2, l3, h0, h1, h2, h3; constexpr int b_ = OFF_V + VB * SHM_V + v_rd_off(d0, 0, 0); \
        TRRD(l0, b_); TRRD(h0, b_ + 2048); TRRD(l1, b_ + 4096); TRRD(h1, b_ + 6144); TRRD(l2, b_ + 8192); TRRD(h2, b_ + 10240); TRRD(l3, b_ + 12288); TRRD(h3, b_ + 14336); \
        asm volatile("s_waitcnt lgkmcnt(0)" ::: "memory"); SBAR();   \
        o[d0] = __builtin_amdgcn_mfma_f32_32x32x16_bf16(pa0, (bf16x8){l0[0], l0[1], l0[2], l0[3], h0[0], h0[1], h0[2], h0[3]}, o[d0], 0, 0, 0);   \
        o[d0] = __builtin_amdgcn_mfma_f32_32x32x16_bf16(pa1, (bf16x8){l1[0], l1[1], l1[2], l1[3], h1[0], h1[1], h1[2], h1[3]}, o[d0], 0, 0, 0);   \
        o[d0] = __builtin_amdgcn_mfma_f32_32x32x16_bf16(pa2, (bf16x8){l2[0], l2[1], l2[2], l2[3], h2[0], h2[1], h2[2], h2[3]}, o[d0], 0, 0, 0);   \
        o[d0] = __builtin_amdgcn_mfma_f32_32x32x16_bf16(pa3, (bf16x8){l3[0], l3[1], l3[2], l3[3], h3[0], h3[1], h3[2], h3[3]}, o[d0], 0, 0, 0); } while (0)
    PV_D0(0); PV_D0(1); PV_D0(2); PV_D0(3);
#undef PV_D0
#undef TRRD
}

constexpr int QP = MH * MQK, VP = MH * 256;
__device__ __forceinline__ void attn_block(const bf16_t* Q, const bf16_t* K, const bf16_t* V, bf16_t* O, int P0, const float* gon, const float* gqn, const float* rc, const float* rsn, LAS unsigned char* lds) {
    int tid = threadIdx.x; asm volatile("" : "+v"(tid));
    const int wid = __builtin_amdgcn_readfirstlane(tid >> 6), lane = tid & 63, r32 = lane & 31, hi = lane >> 5;
    const int NT = P0 / KVBLK + 4;
    const int qlo = P0 + wid * QBLK, qm = qlo + r32 - 4 * hi;
    LAS float* wsf = (LAS float*)(lds + OFF_WS) + wid * 64; LAS float* li_l = wsf; LAS float* al_l = wsf + 32;
    float m_reg = -1e30f, l_reg = 0.f; f32x16 o[4] = {};
    bf16x8 qr[12];
#pragma unroll
    for (int d0 = 0; d0 < 12; ++d0) qr[d0] = *(const bf16x8*)(Q + (size_t)(qlo + r32) * QP + d0 * 16 + hi * 8);
    {
        float ss = 0.f;
#pragma unroll
        for (int d0 = 0; d0 < 12; ++d0) { float f[8]; unpack8(__builtin_bit_cast(u32x4, qr[d0]), f);
#pragma unroll
            for (int j = 0; j < 8; ++j) ss += f[j] * f[j]; }
        { auto rr = __builtin_amdgcn_permlane32_swap(__float_as_uint(ss), __float_as_uint(ss), false, false); ss = __uint_as_float(rr[0]) + __uint_as_float(rr[1]); }
        const float rs = rsqrtf(ss * (1.f / MQK) + EPS);
#pragma unroll
        for (int d0 = 0; d0 < 8; ++d0) { float f[8]; unpack8(__builtin_bit_cast(u32x4, qr[d0]), f); const float* gp = gqn + d0 * 16 + hi * 8;
#pragma unroll
            for (int j = 0; j < 8; ++j) f[j] *= rs * gp[j];
            qr[d0] = __builtin_bit_cast(bf16x8, pack8f(f)); }
#pragma unroll
        for (int dd = 0; dd < 2; ++dd) { float x1[8], x2[8]; unpack8(__builtin_bit_cast(u32x4, qr[8 + dd]), x1); unpack8(__builtin_bit_cast(u32x4, qr[10 + dd]), x2);
            const float* g1p = gqn + 128 + dd * 16 + hi * 8; const float* g2p = g1p + 32; const float* cp = rc + (size_t)(qlo + r32) * 32 + dd * 16 + hi * 8; const float* sp = rsn + (size_t)(qlo + r32) * 32 + dd * 16 + hi * 8;
            const f32x4 c0 = *(const f32x4*)cp, c1 = *(const f32x4*)(cp + 4), s0 = *(const f32x4*)sp, s1 = *(const f32x4*)(sp + 4), ga = *(const f32x4*)g1p, gb = *(const f32x4*)(g1p + 4), gc = *(const f32x4*)g2p, gd = *(const f32x4*)(g2p + 4);
#pragma unroll
            for (int j = 0; j < 8; ++j) { const float a = x1[j] * rs * (j < 4 ? ga[j & 3] : gb[j & 3]), bq = x2[j] * rs * (j < 4 ? gc[j & 3] : gd[j & 3]), c = j < 4 ? c0[j & 3] : c1[j & 3], sn = j < 4 ? s0[j & 3] : s1[j & 3]; x1[j] = a * c - bq * sn; x2[j] = bq * c + a * sn; }
            qr[8 + dd] = __builtin_bit_cast(bf16x8, pack8f(x1)); qr[10 + dd] = __builtin_bit_cast(bf16x8, pack8f(x2)); }
    }
    int ksrc[4], vsrc[2];
#pragma unroll
    for (int i = 0; i < 4; ++i) { const int row = 2 * (wid * 4 + i) + (lane >> 5), c = (lane & 31) ^ (row & 15); ksrc[i] = row * MQK + (c < 24 ? c : 0) * 8; }
#pragma unroll
    for (int i = 0; i < 2; ++i) { const int id = (wid * 2 + i) * 2 + (lane >> 5), kk = ((id >> 2) << 3) | ((lane & 31) >> 2), k = (kk & ~0xC) | ((kk & 4) << 1) | ((kk & 8) >> 1);
        vsrc[i] = k * VP + (id & 3) * 32 + (lane & 3) * 8; }
    const int vb0 = (int)(unsigned)(uintptr_t)lds + v_rd_base(lane);
#define ALOAD(t, bf) do { const bf16_t* kp = K + (size_t)(t) * KVBLK * MQK; const bf16_t* vp = V + (size_t)(t) * KVBLK * VP; \
        _Pragma("unroll") for (int i = 0; i < 4; ++i) __builtin_amdgcn_global_load_lds((const unsigned*)(kp + ksrc[i]), (LAS unsigned*)(lds + OFF_K + (bf) * SHM_K + (wid * 4 + i) * 1024), 16, 0, 0); \
        _Pragma("unroll") for (int i = 0; i < 2; ++i) __builtin_amdgcn_global_load_lds((const unsigned*)(vp + vsrc[i]), (LAS unsigned*)(lds + OFF_V + (bf) * SHM_V + (wid * 2 + i) * 1024), 16, 0, 0); } while (0)
#define RESC(a) do { if (__any((a) < 1.f)) { if (hi == 0) al_l[r32] = (a); asm volatile("s_waitcnt lgkmcnt(0)" ::: "memory"); \
        _Pragma("unroll") for (int d_ = 0; d_ < 4; ++d_) _Pragma("unroll") for (int r = 0; r < 16; ++r) o[d_][r] *= al_l[crow(r, hi)]; } } while (0)
#define STEP(t, BF) do { f32x16 p0, p1; float mn, al; bf16x8 pa0, pa1, pa2, pa3; \
        if ((t) + 1 < NT) ALOAD((t) + 1, 1 - (BF)); \
        SBAR(); qkt<BF>(p0, p1, lds, r32, hi, qr); \
        { const int kb_ = (t) * KVBLK; if (kb_ + KVBLK - 1 > qlo) mask_tile(p0, p1, qm - kb_); } \
        partialSM(p0, p1, m_reg, mn, al); RESC(al); finishSM(p0, p1, al, l_reg, pa0, pa1, pa2, pa3); SBAR(); \
        pv_tile<BF>(o, vb0, pa0, pa1, pa2, pa3); SBAR(); \
        asm volatile("s_waitcnt vmcnt(0)" ::: "memory"); __syncthreads(); } while (0)
    ALOAD(0, 0); asm volatile("s_waitcnt vmcnt(0)" ::: "memory"); __syncthreads();
    for (int t = 0; t < NT; t += 2) { STEP(t, 0); STEP(t + 1, 1); }
#undef STEP
#undef RESC
#undef ALOAD
    if (hi == 0) li_l[r32] = l_reg;
    asm volatile("s_waitcnt lgkmcnt(0)" ::: "memory");
    float gv[4];
#pragma unroll
    for (int d0 = 0; d0 < 4; ++d0) gv[d0] = gon[d0 * 32 + r32];
    float ssr[16];
#pragma unroll
    for (int r = 0; r < 16; ++r) { const float rl = __builtin_amdgcn_rcpf(li_l[crow(r, hi)]); float ss = 0.f;
#pragma unroll
        for (int d0 = 0; d0 < 4; ++d0) { o[d0][r] *= rl; ss += o[d0][r] * o[d0][r]; }
        ssr[r] = ss; }
#pragma unroll
    for (int r = 0; r < 16; ++r) ssr[r] += swz_xor<1>(ssr[r]);
#pragma unroll
    for (int r = 0; r < 16; ++r) ssr[r] += swz_xor<2>(ssr[r]);
#pragma unroll
    for (int r = 0; r < 16; ++r) ssr[r] += swz_xor<4>(ssr[r]);
#pragma unroll
    for (int r = 0; r < 16; ++r) ssr[r] += swz_xor<8>(ssr[r]);
#pragma unroll
    for (int r = 0; r < 16; ++r) ssr[r] += swz_xor<16>(ssr[r]);
#pragma unroll
    for (int r = 0; r < 16; ++r) { const float rs = rsqrtf(ssr[r] * (1.f / MV) + EPS);
        bf16_t* orow = O + (size_t)(qlo + crow(r, hi)) * DM;
#pragma unroll
        for (int d0 = 0; d0 < 4; ++d0) { const float v = o[d0][r] * rs * gv[d0]; const float vn = swz_xor<1>(v);
            if ((r32 & 1) == 0) *(unsigned*)(orow + d0 * 32 + r32) = cvtpk(v, vn); } }
    __syncthreads();
}
#undef SBAR
}

__device__ __forceinline__ void p6_phase(Frame& F, const Args& a) {
    const bf16_t* QH = (const bf16_t*)(F.ws + WS_B); const bf16_t* Kn = (const bf16_t*)(F.ws + WS_F); const bf16_t* KV = (const bf16_t*)(F.ws + WS_C);
    bf16_t* MIX = (bf16_t*)F.out;
    const float* rc = (const float*)(F.ws + WS_ROPEC); const float* rsn = (const float*)(F.ws + WS_ROPES);
    for (int it = F.vcu; it < NB * MH * 4; it += F.G) {
        const int bh = it >> 2, j = it & 3, b = bh >> 3, h = bh & 7;
        const bf16_t* Q = QH + (size_t)(b * SEQ) * att::QP + h * MQK; const bf16_t* K = Kn + (size_t)bh * SEQ * MQK; const bf16_t* V = KV + (size_t)(b * SEQ) * att::VP + h * 256 + 128;
        bf16_t* O = MIX + (size_t)(b * SEQ) * DM + HW + h * MV;
        att::attn_block(Q, K, V, O, (7 - j) * att::QB, a.in[15], a.in[13], rc + (size_t)(b * SEQ) * 32, rsn + (size_t)(b * SEQ) * 32, F.lds);
        att::attn_block(Q, K, V, O, j * att::QB, a.in[15], a.in[13], rc + (size_t)(b * SEQ) * 32, rsn + (size_t)(b * SEQ) * 32, F.lds);
    }
}
__device__ __forceinline__ void p8_phase(Frame& F, const Args& a) {
    OPAQUE_FRAME(F);
    unsigned char* ws = F.ws;
    const float* xin = a.in[0]; const bf16_t* mixo = (const bf16_t*)(ws + WS_F); const float* mod = (const float*)(ws + WS_MOD); const float* g2n = a.in[17];
    const float* wct = (const float*)(ws + WS_WCT);
    bf16_t* H2 = (bf16_t*)(ws + WS_B);
    int* tok_e = (int*)(ws + WS_TOKE); float* tok_w = (float*)(ws + WS_TOKW); int* tok_s = (int*)(ws + WS_TOKS);
    LAS float* red = (LAS float*)F.lds;
    LAS float* ssw = (LAS float*)(F.lds + 98304);
    LAS float* shw = (LAS float*)(F.lds + 100352);
    LAS float* lg = (LAS float*)(F.lds + 101888);
    LAS float* rsl = (LAS float*)(F.lds + 111104);
    const int mr = F.lane & 15, mg = F.lane >> 4;
    const bool conv_first = (F.vcu & 1) != 0;
#pragma unroll 1
    for (int part = 0; part < 2; ++part) {
    if ((part == 0) != conv_first) {
    for (int tile = F.vcu; tile < T / 64; tile += F.G) {
        const int m0 = tile * 64, b = m0 / SEQ;
        const float* modb = mod + b * (6 * DM);
        f32x4 acc[4][3]; float ssp[4] = {0.f, 0.f, 0.f, 0.f}, shacc[3] = {0.f, 0.f, 0.f};
#pragma unroll
        for (int rb = 0; rb < 4; ++rb)
#pragma unroll
            for (int n = 0; n < 3; ++n) acc[rb][n] = (f32x4){0.f, 0.f, 0.f, 0.f};
        const unsigned xo = (unsigned)((m0 + mr) * DM + F.wave * 256 + 4 * mg);
        LAS float* vec = (LAS float*)(F.lds + 112640) + F.wave * 768;
        { const int k4 = F.lane * 4; const unsigned ko_ = (unsigned)(F.wave * 256 + k4) * 4u;
          const f32x4 t0 = *(const f32x4*)((const char*)(modb + 2 * DM) + ko_), t1 = *(const f32x4*)((const char*)(modb + 3 * DM) + ko_), t2 = *(const f32x4*)((const char*)g2n + ko_), t3 = *(const f32x4*)((const char*)(modb + 4 * DM) + ko_);
          *(LAS f32x4*)(vec + k4) = t0; *(LAS f32x4*)(vec + 256 + k4) = t1; *(LAS f32x4*)(vec + 512 + k4) = t2 * (t3 + 1.f); LDS_WAIT(); asm volatile("" ::: "memory"); }
        f32x4 xa[4], xb[4], wa[3], wb[3]; u32x2 ma_[4], mb_[4];
#define P8_LDX(s_, X, M, W) do { const unsigned ko_ = (unsigned)(F.wave * 256 + 16 * (s_) + 4 * mg) * 4u; \
            _Pragma("unroll") for (int n = 0; n < 3; ++n) W[n] = *(const f32x4*)((const char*)wct + (ko_ + (unsigned)((n * 16 + mr) * DM * 4))); \
            _Pragma("unroll") for (int rb = 0; rb < 4; ++rb) { const unsigned eo_ = xo + (unsigned)(rb * 16 * DM + 16 * (s_)); X[rb] = *(const f32x4*)((const char*)xin + eo_ * 4u); M[rb] = *(const u32x2*)((const char*)mixo + eo_ * 2u); } } while (0)
#define P8_CP(s_, X, M, W) do { const int kl_ = 16 * (s_) + 4 * mg; const f32x4 g1v = *(const LAS f32x4*)(vec + kl_), shv = *(const LAS f32x4*)(vec + 256 + kl_), gmv = *(const LAS f32x4*)(vec + 512 + kl_); \
            _Pragma("unroll") for (int n = 0; n < 3; ++n) shacc[n] += (shv.x * W[n].x + shv.y * W[n].y) + (shv.z * W[n].z + shv.w * W[n].w); \
            _Pragma("unroll") for (int rb = 0; rb < 4; ++rb) { const f32x4 v = X[rb] + g1v * (f32x4){bf_lo(M[rb].x), bf_hi(M[rb].x), bf_lo(M[rb].y), bf_hi(M[rb].y)}; \
                ssp[rb] += (v.x * v.x + v.y * v.y) + (v.z * v.z + v.w * v.w); const f32x4 av = v * gmv; \
                _Pragma("unroll") for (int i = 0; i < 4; ++i) _Pragma("unroll") for (int n = 0; n < 3; ++n) acc[rb][n] = __builtin_amdgcn_mfma_f32_16x16x4f32(av[i], W[n][i], acc[rb][n], 0, 0, 0); } } while (0)
        P8_LDX(0, xa, ma_, wa);
#pragma unroll 1
        for (int s = 0; s < 16; s += 2) {
            P8_LDX(s + 1, xb, mb_, wb); __builtin_amdgcn_sched_barrier(0);
            P8_CP(s, xa, ma_, wa); __builtin_amdgcn_sched_barrier(0);
            if (s + 2 < 16) { P8_LDX(s + 2, xa, ma_, wa); } __builtin_amdgcn_sched_barrier(0);
            P8_CP(s + 1, xb, mb_, wb); __builtin_amdgcn_sched_barrier(0);
        }
#undef P8_LDX
#undef P8_CP
#pragma unroll
        for (int rb = 0; rb < 4; ++rb) {
#pragma unroll
            for (int n = 0; n < 3; ++n)
#pragma unroll
                for (int r = 0; r < 4; ++r) red[(F.wave * 64 + rb * 16 + mg * 4 + r) * 48 + n * 16 + mr] = acc[rb][n][r];
            float sp = ssp[rb]; sp += __shfl_xor(sp, 16); sp += __shfl_xor(sp, 32);
            if (mg == 0) ssw[F.wave * 64 + rb * 16 + mr] = sp; }
#pragma unroll
        for (int n = 0; n < 3; ++n) { float sa = shacc[n]; sa += __shfl_xor(sa, 16); sa += __shfl_xor(sa, 32); if (mg == 0) shw[F.wave * 48 + n * 16 + mr] = sa; }
        __syncthreads();
        if (F.tid < 64) { float sv = 0.f;
#pragma unroll
            for (int w = 0; w < 8; ++w) sv += ssw[w * 64 + F.tid];
            rsl[F.tid] = rsqrtf(sv * (1.f / DM) + EPS); }
        __syncthreads();
        for (int idx = F.tid; idx < 64 * 36; idx += NTHR) { const int row = idx / 36, n = idx % 36; float L = 0.f, sw = 0.f;
#pragma unroll
            for (int w = 0; w < 8; ++w) { L += red[(w * 64 + row) * 48 + n]; sw += shw[w * 48 + n]; }
            lg[row * 36 + n] = rsl[row] * L + sw + (n < 4 ? a.in[19][n] : a.in[21][n - 4]); }
        __syncthreads();
        if (F.tid < 64) { const LAS float* l = lg + F.tid * 36; const int t = m0 + F.tid;
            int g = 0; float gm = l[0];
#pragma unroll
            for (int j = 1; j < 4; ++j) if (l[j] > gm) { gm = l[j]; g = j; }
            float den = 0.f;
#pragma unroll
            for (int j = 0; j < 4; ++j) den += __expf(l[j] - gm);
            const float pg = 1.f / den;
            const LAS float* e = l + 4 + g * 8;
            int i1 = 0; float v1 = e[0];
#pragma unroll
            for (int j = 1; j < 8; ++j) if (e[j] > v1) { v1 = e[j]; i1 = j; }
            int i2 = -1; float v2 = -__builtin_inff();
#pragma unroll
            for (int j = 0; j < 8; ++j) if (j != i1 && e[j] > v2) { v2 = e[j]; i2 = j; }
            const float w1 = 1.f / (1.f + __expf(v2 - v1)), w2 = 1.f - w1;
            const int e1 = g * 8 + i1, e2 = g * 8 + i2;
            const int s1 = (int)atomicAdd((unsigned*)(F.ctl + CW_CNT + 64 * e1), 1u), s2 = (int)atomicAdd((unsigned*)(F.ctl + CW_CNT + 64 * e2), 1u);
            tok_e[2 * t] = e1; tok_e[2 * t + 1] = e2; tok_w[2 * t] = pg * w1; tok_w[2 * t + 1] = pg * w2; tok_s[2 * t] = s1; tok_s[2 * t + 1] = s2;
            int* list = (int*)(ws + WS_LIST); list[e1 * T + s1] = t; list[e2 * T + s2] = t; }
        { const int c8 = (F.tid & 255) * 8, rg = F.tid >> 8;
          f32x4 g1a = *(const f32x4*)(modb + 2 * DM + c8), g1b = *(const f32x4*)(modb + 2 * DM + c8 + 4), sha = *(const f32x4*)(modb + 3 * DM + c8), shb = *(const f32x4*)(modb + 3 * DM + c8 + 4);
          const f32x4 gma = *(const f32x4*)(g2n + c8) * (*(const f32x4*)(modb + 4 * DM + c8) + 1.f), gmb = *(const f32x4*)(g2n + c8 + 4) * (*(const f32x4*)(modb + 4 * DM + c8 + 4) + 1.f);
#pragma unroll 1
          for (int j0 = 0; j0 < 32; j0 += 4) {
              f32x4 qa[4], qb[4]; u32x4 qm[4];
#pragma unroll
              for (int u = 0; u < 4; ++u) { const size_t eo = (size_t)(m0 + rg + 2 * (j0 + u)) * DM + c8;
                  qa[u] = __builtin_nontemporal_load((const f32x4*)(xin + eo)); qb[u] = __builtin_nontemporal_load((const f32x4*)(xin + eo + 4)); qm[u] = __builtin_nontemporal_load((const u32x4*)(mixo + eo)); }
              __builtin_amdgcn_sched_barrier(0);
#pragma unroll
              for (int u = 0; u < 4; ++u) { const int row = rg + 2 * (j0 + u); const size_t eo = (size_t)(m0 + row) * DM + c8; const float rs = rsl[row];
                  float mx[8]; unpack8(qm[u], mx);
                  const f32x4 xa = qa[u] + g1a * (f32x4){mx[0], mx[1], mx[2], mx[3]}, xb = qb[u] + g1b * (f32x4){mx[4], mx[5], mx[6], mx[7]};
                  const f32x4 va = xa * rs * gma + sha, vb = xb * rs * gmb + shb;
                  u32x4 w; w.x = cvt_pk_bf16(va.x, va.y); w.y = cvt_pk_bf16(va.z, va.w); w.z = cvt_pk_bf16(vb.x, vb.y); w.w = cvt_pk_bf16(vb.z, vb.w);
                  *(u32x4*)(H2 + eo) = w;
                  u32x4 x1; x1.x = cvt_pk_bf16(xa.x, xa.y); x1.y = cvt_pk_bf16(xa.z, xa.w); x1.z = cvt_pk_bf16(xb.x, xb.y); x1.w = cvt_pk_bf16(xb.z, xb.w);
                  *(u32x4*)((bf16_t*)(ws + WS_F) + eo) = x1; }
              __builtin_amdgcn_sched_barrier(0); } }
        __syncthreads();
    }
    } else {
    LAS unsigned char* Tl = F.lds + F.wave * 8192;
    const int gw = F.vcu * NWAVES + F.wave, NGW = F.G * NWAVES;
    { const MoeItems mk{a.in[22], a.in[23], a.in[24], ws};
      tr_run(MOE_PRE + gw, NGW, 3 * MOE_IG, mk, Tl, F.lane); }
    __syncthreads();
    }
    }
}

constexpr int MOE_TAB_OFF = LDS_USER;
__device__ __forceinline__ LAS int* moe_tables(Frame& F) {
    LAS int* tab = (LAS int*)(F.lds + MOE_TAB_OFF);
    __syncthreads();
    if (F.tid < NE) tab[64 + F.tid] = (int)__hip_atomic_load((unsigned*)(F.ctl + CW_CNT + 64 * F.tid), RLX_AGENT);
    __syncthreads();
    if (F.tid == 0) { int acc = 0;
        for (int e = 0; e < NE; ++e) { tab[e] = acc; acc += ((tab[64 + e] + 255) / 256) * 256; }
        tab[NE] = acc; }
    __syncthreads();
    if (F.tid < 160) { int e = 0; for (int j = 1; j < NE; ++j) if (tab[j] <= F.tid * 256) e = j; tab[128 + F.tid] = e; }
    __syncthreads();
    return tab;
}

__device__ __forceinline__ void p12_phase(Frame& F, const Args& a) {
    OPAQUE_FRAME(F);
    unsigned char* ws = F.ws;
    const bf16_t* Y = (const bf16_t*)(ws + WS_A);
    const float* tok_w = (const float*)(ws + WS_TOKW); const int* tok_s = (const int*)(ws + WS_TOKS);
    const float* mod = (const float*)(ws + WS_MOD);
    const LAS int* tab = moe_tables(F); const int* tok_e = (const int*)(ws + WS_TOKE);
    const int gw = F.vcu * NWAVES + F.wave, NGW = F.G * NWAVES;
#if defined(MK_STAMP) && MK_STAMP >= 0
    const float dscale = 1.f + sqrtf(exp2f(rintf(3.f * log2f(*(const float*)(ws + WS_STAMP + 8) + 1.f) + MK_QSHIFT) * (1.f / 3.f)));
#else
    const float dscale = 1.f;
#endif
    for (int blk = gw; blk < T / 8; blk += NGW) { const int t0 = blk * 8, b = t0 / SEQ;
        const float* g2 = mod + b * (6 * DM) + 5 * DM;
        f32x4 h2[4][2];
#pragma unroll
        for (int j = 0; j < 4; ++j) { const int c = (j * 64 + F.lane) * 8; h2[j][0] = *(const f32x4*)(g2 + c); h2[j][1] = *(const f32x4*)(g2 + c + 4); }
        int dsl = 0; float wl = 0.f;
        if (F.lane < 16) { dsl = tab[tok_e[2 * t0 + F.lane]] + tok_s[2 * t0 + F.lane]; wl = tok_w[2 * t0 + F.lane]; }
#pragma unroll 1
        for (int r = 0; r < 8; ++r) { const int t = t0 + r;
            const float w0 = __shfl(wl, 2 * r), w1 = __shfl(wl, 2 * r + 1); const int d0 = __shfl(dsl, 2 * r), d1 = __shfl(dsl, 2 * r + 1);
            float* orow = F.out + (size_t)t * DM; const bf16_t* mrow = (const bf16_t*)(ws + WS_F) + (size_t)t * DM;
            u32x4 qy0[4], qy1[4], qm[4];
#pragma unroll
            for (int j = 0; j < 4; ++j) { const int c = (j * 64 + F.lane) * 8;
                qy0[j] = __builtin_nontemporal_load((const u32x4*)(Y + (size_t)d0 * DM + c)); qy1[j] = __builtin_nontemporal_load((const u32x4*)(Y + (size_t)d1 * DM + c));
                qm[j] = __builtin_nontemporal_load((const u32x4*)(mrow + c)); }
            __builtin_amdgcn_sched_barrier(0);
#pragma unroll
            for (int j = 0; j < 4; ++j) { const int c = (j * 64 + F.lane) * 8;
                float y0[8], y1[8], mx[8]; unpack8(qy0[j], y0); unpack8(qy1[j], y1); unpack8(qm[j], mx);
                const f32x4 xa = {mx[0], mx[1], mx[2], mx[3]}, xb = {mx[4], mx[5], mx[6], mx[7]};
                f32x4 ra, rb;
#pragma unroll
                for (int i = 0; i < 4; ++i) { ra[i] = (xa[i] + h2[j][0][i] * (w0 * y0[i] + w1 * y1[i])) * dscale; rb[i] = (xb[i] + h2[j][1][i] * (w0 * y0[4 + i] + w1 * y1[4 + i])) * dscale; }
                __builtin_nontemporal_store(ra, (f32x4*)(orow + c)); __builtin_nontemporal_store(rb, (f32x4*)(orow + c + 4)); }
            __builtin_amdgcn_sched_barrier(0); }
    }
}
#ifndef MK_MULTI
#define MK_MULTI 0
#endif
#ifndef MK_LAST_PHASE
#define MK_LAST_PHASE 12
#endif
constexpr int N_PHASES = MK_LAST_PHASE + 1;

template <class P> __device__ __forceinline__ P* uptr(P* p) { const unsigned long long v = (unsigned long long)p;
    const unsigned lo = __builtin_amdgcn_readfirstlane((unsigned)v), hi = __builtin_amdgcn_readfirstlane((unsigned)(v >> 32)); return (P*)(__attribute__((address_space(1))) P*)(((unsigned long long)hi << 32) | lo); }
__global__ void __launch_bounds__(NTHR, 2) mk_fwd(const Args args) {
    extern __shared__ __attribute__((aligned(16))) unsigned char lds_raw[];
    Frame F;
    F.lds = (LAS unsigned char*)lds_raw;
    F.MISC = (volatile LAS unsigned*)(F.lds + MISC_OFF);
    F.tid = threadIdx.x; F.lane = F.tid & 63; F.wave = __builtin_amdgcn_readfirstlane(F.tid >> 6);
    F.G = gridDim.x; { const int bx = blockIdx.x; F.vcu = (F.G % 8 == 0) ? (bx % 8) * (F.G / 8) + bx / 8 : bx; }
    F.ws = uptr(args.ws); F.out = uptr(args.out);
    F.ctl = (gu32*)(F.ws + WS_CTL);
    for (int u = F.tid; u < (LDS_BYTES - MISC_OFF) / 4; u += NTHR) ((LAS unsigned*)(F.lds + MISC_OFF))[u] = 0u;
    __syncthreads();
    XcdBarrier bar; bar.bar = (unsigned*)(F.ctl + CW_BAR); bar.x = 0; bar.st = nullptr;
#if !MK_MULTI
    bar = xcd_barrier_post((unsigned*)(F.ctl + CW_BAR), F.MISC + 8);
#define GRID_BAR() xcd_barrier(bar)
#else
#define GRID_BAR() do { } while (0)
#endif
    const int lo = args.ph_lo, hi = args.ph_hi;
#ifndef MK_PHMASK
#define MK_PHMASK 0xFFFF
#endif
#define IN(k) (((MK_PHMASK >> (k)) & 1) && lo <= (k) && (k) < hi)
#define SEAM(k) do { if (IN(k) && IN((k) + 1)) GRID_BAR(); } while (0)
#ifndef MK_STAMP
#define MK_STAMP (-1)
#endif
#define STAMP_BEGIN(k) do { if ((k) == MK_STAMP && blockIdx.x == 0 && F.tid == 0) *(unsigned long long*)(ws + WS_STAMP) = __builtin_amdgcn_s_memrealtime(); } while (0)
#define STAMP_END(k) do { if ((k) == MK_STAMP && blockIdx.x == 0 && F.tid == 0) { const unsigned long long t1_ = __builtin_amdgcn_s_memrealtime(); *(float*)(ws + WS_STAMP + 8) = (float)(t1_ - *(unsigned long long*)(ws + WS_STAMP)) * 0.01f; } } while (0)
#ifndef MK_REPEAT
#define MK_REPEAT (-1)
#endif
#ifndef MK_REPN
#define MK_REPN 2
#endif
#define REP(k) _Pragma("unroll") for (int rep_ = 0; rep_ < ((k) == MK_REPEAT ? MK_REPN : 1); ++rep_)
    unsigned char* const ws = F.ws;

    STAMP_BEGIN(0);
    REP(0) if (IN(0)) { if (rep_) GRID_BAR(); p0_phase(F, args); } STAMP_END(0);
    STAMP_BEGIN(1);
    REP(1) if (IN(1)) { if (rep_) GRID_BAR(); p1_phase(F, args); } SEAM(1); STAMP_END(1);
    STAMP_BEGIN(2);
    REP(2) if (IN(2)) { if (rep_) GRID_BAR();
        pg8::Gemm g{(const bf16_t*)(ws + WS_B), (const bf16_t*)(ws + WS_WIN), DM, DM, DM};
        pg8::DenseOrder S; S.init(T / 256, INCP / 256, F.G, (int)blockIdx.x);
        pg8::EpiStore E{(bf16_t*)(ws + WS_A), INCP, nullptr, 0.f, (float*)(ws + WS_RSTDQ), (float*)(ws + WS_RSTDKV), C_QA / 256, C_KVA / 256, C_KPE / 256, HW / 256, 2 * HW / 256};
        pg8::gemm_phase<pg8::EpiStore, pg8::DenseOrder>(F.lds, g, S, E);
    } SEAM(2); STAMP_END(2);
    STAMP_BEGIN(3);
    REP(3) if (IN(3)) { if (rep_) GRID_BAR(); p3_phase(F, args); } if (IN(3) && IN(5)) GRID_BAR(); STAMP_END(3);
    STAMP_BEGIN(5);
    REP(5) if (IN(5)) { if (rep_) GRID_BAR(); p5_phase(F, args); } SEAM(5); STAMP_END(5);
    STAMP_BEGIN(6);
    REP(6) if (IN(6)) { if (rep_) GRID_BAR(); p6_phase(F, args); } SEAM(6); STAMP_END(6);
    STAMP_BEGIN(7);
    REP(7) if (IN(7)) { if (rep_) GRID_BAR();
        pg8::Gemm g{(const bf16_t*)F.out, (const bf16_t*)(ws + WS_WOUT), DM, DM, DM};
        pg8::DenseOrder S; S.init(T / 256, DM / 256, F.G, (int)blockIdx.x);
        pg8::EpiStore E{(bf16_t*)(ws + WS_F), DM, nullptr, 0.f, nullptr, nullptr, 0, 0, 0};
        pg8::gemm_phase<pg8::EpiStore, pg8::DenseOrder>(F.lds, g, S, E);
    } SEAM(7); STAMP_END(7);
#if MK_LAST_PHASE >= 8
    STAMP_BEGIN(8);
    REP(8) if (IN(8)) { if (rep_) GRID_BAR(); p8_phase(F, args); } if (IN(8) && IN(10)) GRID_BAR(); STAMP_END(8);
    STAMP_BEGIN(10);
    REP(10) if (IN(10)) { if (rep_) GRID_BAR();
        const LAS int* tab = moe_tables(F);
        pg8::Gemm g{(const bf16_t*)(ws + WS_B), (const bf16_t*)(ws + WS_D), DM, DM, DM};
        pg8::GroupedOrder S; S.init(4, F.G, F.vcu, tab, (const int*)(ws + WS_LIST));
        pg8::EpiSwiGLU E{(bf16_t*)(ws + WS_C), (unsigned*)(F.ctl + CW_RDY)};
        pg8::gemm_phase<pg8::EpiSwiGLU, pg8::GroupedOrder, true>(F.lds, g, S, E);
    }
    REP(11) if (IN(11)) { if (rep_) GRID_BAR();
        const LAS int* tab = moe_tables(F);
        pg8::Gemm g{(const bf16_t*)(ws + WS_C), (const bf16_t*)(ws + WS_E), DE, DE, DE};
        pg8::RedealOrder S; S.init(8, F.G, F.vcu, tab, 4, (unsigned*)(F.ctl + CW_RDY), 32u, (unsigned*)(F.ctl + CW_TMO));
        pg8::EpiStore E{(bf16_t*)(ws + WS_A), DM, nullptr, 0.f, nullptr, nullptr, 0, 0, 0};
        pg8::gemm_phase<pg8::EpiStore, pg8::RedealOrder>(F.lds, g, S, E);
    } SEAM(11); STAMP_END(11);
    REP(12) if (IN(12)) { if (rep_) GRID_BAR(); p12_phase(F, args); }
#endif
#undef IN
#undef SEAM
}

extern "C" void kernel_launch(void* const* d_in, const int* in_sizes, int n_in, void* d_out, int out_size, void* d_ws, size_t ws_size, hipStream_t stream) {
    static int grid = 0;
    if (grid == 0) {
        if (n_in != 25 || out_size != T * DM || ws_size < WS_END) { fprintf(stderr, "kernel_launch: bad shapes (n_in %d out %d ws %zu)\n", n_in, out_size, ws_size); grid = -1; return; }
        int dev = 0, cus = 0, per_cu = 0;
        if (hipGetDevice(&dev) != hipSuccess || hipDeviceGetAttribute(&cus, hipDeviceAttributeMultiprocessorCount, dev) != hipSuccess) { grid = -1; return; }
        if (hipFuncSetAttribute((const void*)mk_fwd, hipFuncAttributeMaxDynamicSharedMemorySize, LDS_BYTES) != hipSuccess) { fprintf(stderr, "kernel_launch: hipFuncSetAttribute failed\n"); grid = -1; return; }
        if (hipOccupancyMaxActiveBlocksPerMultiprocessor(&per_cu, (const void*)mk_fwd, NTHR, LDS_BYTES) != hipSuccess || per_cu < 1) { fprintf(stderr, "kernel_launch: occupancy query says %d\n", per_cu); }
        (void)hipGetLastError();
        grid = cus;
    }
    if (grid < 0) return;
    (void)hipMemsetAsync((char*)d_ws + WS_CTL, 0, CTL_ZERO_BYTES, stream);
    Args a{};
    for (int i = 0; i < 25; ++i) a.in[i] = (const float*)d_in[i];
    a.out = (float*)d_out; a.ws = (unsigned char*)d_ws;
#if MK_MULTI
    for (int p = 0; p < N_PHASES; ++p) { a.ph_lo = p; a.ph_hi = p + 1; hipLaunchKernelGGL(mk_fwd, dim3(grid), dim3(NTHR), LDS_BYTES, stream, a); }
#else
    a.ph_lo = 0; a.ph_hi = N_PHASES; hipLaunchKernelGGL(mk_fwd, dim3(grid), dim3(NTHR), LDS_BYTES, stream, a);
#endif
}
```

```cpp
#include <hip/hip_runtime.h>
#include <cstdio>
#include <cstdint>

#define GAS __attribute__((address_space(1)))
#define LAS __attribute__((address_space(3)))
typedef unsigned short bf16_t;
typedef short bf16x8 __attribute__((ext_vector_type(8)));
typedef short s16x4 __attribute__((ext_vector_type(4)));
typedef float f32x4 __attribute__((ext_vector_type(4)));
typedef float f32x2 __attribute__((ext_vector_type(2)));
typedef float f32x16 __attribute__((ext_vector_type(16)));
typedef unsigned u32x4 __attribute__((ext_vector_type(4)));
typedef unsigned u32x2 __attribute__((ext_vector_type(2)));
typedef GAS unsigned gu32;
#define RLX_AGENT __ATOMIC_RELAXED, __HIP_MEMORY_SCOPE_AGENT
#define LDS_WAIT() asm volatile("s_waitcnt lgkmcnt(0)" ::: "memory")
#define VM_WAIT() asm volatile("s_waitcnt vmcnt(0)" ::: "memory")

constexpr int DM = 2048, NB = 8, SEQ = 2048, T = NB * SEQ;
constexpr int HW = 1024, HH = 8, HDK = 128, HDV = 128;
constexpr int MH = 8, MNOPE = 128, MROPE = 64, MQK = 192, MV = 128, QLORA = 512, KVLORA = 256;
constexpr int INC = 4 * HW + QLORA + KVLORA + MROPE;
constexpr int INCP = 5120;
constexpr int C_QA = 4096, C_KVA = 4608, C_KPE = 4864;
constexpr int NG = 4, EPG = 8, NE = 32, DE = 512;
constexpr int RMAX = (T * 2 / 256 + NE) * 256;
constexpr float EPS = 1e-6f;
constexpr int NWAVES = 8, NTHR = 512;

typedef __bf16 bf16x2_t __attribute__((ext_vector_type(2)));
__device__ __forceinline__ unsigned cvt_pk_bf16(float lo, float hi) { const f32x2 v = {lo, hi}; return __builtin_bit_cast(unsigned, __builtin_convertvector(v, bf16x2_t)); }
__device__ __forceinline__ float bf_lo(unsigned w) { return __builtin_bit_cast(float, w << 16); }
__device__ __forceinline__ float bf_hi(unsigned w) { return __builtin_bit_cast(float, w & 0xffff0000u); }
__device__ __forceinline__ float bf2f(bf16_t h) { return __builtin_bit_cast(float, (unsigned)h << 16); }
__device__ __forceinline__ float wave_sum(float v) {
#pragma unroll
    for (int o = 1; o < 64; o <<= 1) v += __shfl_xor(v, o);
    return v;
}
__device__ __forceinline__ float siluf(float v) { return v / (1.f + __expf(-v)); }

#define XB_TMO      128
#define XB_XCNT(j)  (256  + 64 * (j))
#define XB_XSUB(j)  (1280 + 64 * (j))
#define XB_XGEN(j)  (2304 + 64 * (j))
#define XB_TOP      3328
#define XB_TOPGEN   3392
#define XCD_BAR_WORDS 3456
#define XB_SPIN_CAP (1u << 18)

__device__ __forceinline__ unsigned xb_ld(unsigned* p)              { return __hip_atomic_load(p, __ATOMIC_RELAXED, __HIP_MEMORY_SCOPE_AGENT); }
__device__ __forceinline__ unsigned xb_add(unsigned* p, unsigned v) { return __hip_atomic_fetch_add(p, v, __ATOMIC_RELAXED, __HIP_MEMORY_SCOPE_AGENT); }
__device__ __forceinline__ unsigned xb_xcc_id() { return (unsigned)__builtin_amdgcn_s_getreg((3 << 11) | 20) & 0xFu; }
#define XB_SPIN(cond, bar) do { unsigned _sp = 0; while (cond) { __builtin_amdgcn_s_sleep(1); \
    if ((++_sp & 255u) == 0u) { if (xb_ld(&(bar)[XB_TMO])) break; if (_sp > XB_SPIN_CAP) { atomicAdd(&(bar)[XB_TMO], 1u); break; } } } } while (0)

struct XcdBarrier {
    unsigned* bar; unsigned x;
    volatile LAS unsigned* st;
};
__device__ __forceinline__ XcdBarrier xcd_barrier_post(unsigned* bar, volatile LAS unsigned* st) {
    XcdBarrier b; b.bar = bar; b.x = xb_xcc_id(); b.st = st;
    if (threadIdx.x == 0) (void)xb_add(&bar[XB_XCNT(b.x)], 1u);
    return b;
}
__device__ __forceinline__ void xcd_barrier_complete(unsigned* bar, unsigned x, unsigned& nloc, unsigned& nx) {
    const unsigned G = gridDim.x * gridDim.y * gridDim.z;
    unsigned sum, cnt, mine, sp = 0u;
    for (;;) {
        sum = 0u; cnt = 0u; mine = 0u;
#pragma unroll
        for (unsigned j = 0; j < 16; ++j) { const unsigned c = xb_ld(&bar[XB_XCNT(j)]); sum += c; cnt += (c > 0u) ? 1u : 0u; mine = (j == x) ? c : mine; }
        if (sum == G) break;
        __builtin_amdgcn_s_sleep(1);
        if ((++sp & 255u) == 0u) { if (xb_ld(&bar[XB_TMO])) break; if (sp > XB_SPIN_CAP) { atomicAdd(&bar[XB_TMO], 1u); break; } }
    }
    nloc = mine > 0u ? mine : 1u; nx = cnt > 0u ? cnt : 1u;
}
__device__ __forceinline__ void xcd_barrier(const XcdBarrier& b) {
    asm volatile("s_waitcnt vmcnt(0)" ::: "memory");
    __syncthreads();
    if (threadIdx.x == 0) {
        unsigned* bar = b.bar;
        __builtin_amdgcn_s_waitcnt(0);
        unsigned nloc = b.st[0], nx = b.st[1];
        if (nloc == 0u) { xcd_barrier_complete(bar, b.x, nloc, nx); b.st[0] = nloc; b.st[1] = nx; }
        const unsigned old = xb_add(&bar[XB_XSUB(b.x)], 1u);
        const unsigned gen = old / nloc;
        if (old + 1u == (gen + 1u) * nloc) {
            __builtin_amdgcn_fence(__ATOMIC_RELEASE, "agent");
            asm volatile("s_waitcnt vmcnt(0)" ::: "memory");
            const unsigned og = xb_add(&bar[XB_TOP], 1u);
            const unsigned tg = og / nx;
            if (og + 1u == (tg + 1u) * nx) xb_add(&bar[XB_TOPGEN], 1u);
            else XB_SPIN(xb_ld(&bar[XB_TOPGEN]) == tg, bar);
            __builtin_amdgcn_fence(__ATOMIC_ACQUIRE, "agent");
            xb_add(&bar[XB_XGEN(b.x)], 1u);
            asm volatile("s_waitcnt vmcnt(0)" ::: "memory");
        } else {
            XB_SPIN(xb_ld(&bar[XB_XGEN(b.x)]) == gen, bar);
            __builtin_amdgcn_fence(__ATOMIC_ACQUIRE, "agent");
            asm volatile("s_waitcnt vmcnt(0)" ::: "memory");
        }
    }
    __syncthreads();
}

namespace pg8 {
constexpr int BM = 256, BK = 64, HALF = 128, HTB = HALF * BK * 2, STAGE_BYTES = 8 * HTB, NXCD = 8, WGM = 8;
__host__ __device__ __forceinline__ int lds_byte(int r, int c) { const int st = (r >> 4) * 2 + (c >> 5), rr = r & 15, cc = c & 31, ob = rr * 64 + cc * 2; return st * 1024 + (ob ^ (((ob >> 9) & 1) << 5)); }
__host__ __device__ __forceinline__ void stage_rc(int b, int& R, int& C) { const int st = b / 1024, sb = b % 1024, swz = sb ^ (((sb >> 9) & 1) << 5); R = (st >> 1) * 16 + swz / 64; C = (st & 1) * 32 + (swz % 64) / 2; }
__host__ __device__ __forceinline__ int perm32(int rho) { const int n = rho >> 4, i = rho & 15; return 8 * (i >> 2) + 4 * n + (i & 3); }

struct Unit { int pm, pn, pb; };
struct Gemm { const bf16_t* A; const bf16_t* Bt; int lda, ldb, K; };

struct DenseOrder {
    int nM, nN, nwg, G, c;
    __device__ void init(int nM_, int nN_, int G_, int c_) { nM = nM_; nN = nN_; nwg = nM * nN; G = G_; c = c_; }
    __device__ bool next(int i, Unit& u) const {
        const long L = (long)i * G + c; if (L >= nwg) return false;
        int wgid = (int)L; { const int q = nwg / NXCD, r = nwg % NXCD, xcd = wgid % NXCD, off = wgid / NXCD; wgid = (xcd < r ? xcd * (q + 1) : r * (q + 1) + (xcd - r) * q) + off; }
        const int nig = WGM * nN, gid = wgid / nig, fm = gid * WGM, gsz = (nM - fm) < WGM ? (nM - fm) : WGM;
        u.pm = fm + ((wgid % nig) % gsz); u.pn = (wgid % nig) / gsz; u.pb = u.pn; return true;
    }
    __device__ __forceinline__ void a_ready(const Unit&) const {}
};
struct GroupedOrder {
    int nM, nN, nwg, G, c; const LAS int* tile_e; const LAS int* pstart; const LAS int* cnt; const int* list;
    __device__ void init(int nN_, int G_, int c_, const LAS int* tab, const int* list_) { pstart = tab; cnt = tab + 64; tile_e = tab + 128; list = list_; nM = pstart[32] >> 8; nN = nN_; nwg = nM * nN; G = G_; c = c_; }
    __device__ bool next(int i, Unit& u) const {
        const long L = (long)i * G + c; if (L >= nwg) return false;
        const int w = (int)L; u.pn = w % nN; u.pm = w / nN; u.pb = tile_e[u.pm] * nN + u.pn; return true;
    }
    __device__ int arow(const Unit& u, int r) const { const int e = tile_e[u.pm], j = 256 * u.pm - pstart[e] + r; return j < cnt[e] ? list[e * T + j] : 0; }
    __device__ __forceinline__ void a_ready(const Unit&) const {}
};
struct RedealOrder {
    int nM, nN, nwg, G, c, r10, X, nlight, head; const LAS int* tile_e; unsigned* ready; unsigned need; unsigned* tmo;
    __device__ void init(int nN_, int G_, int c_, const LAS int* tab, int nN10, unsigned* ready_, unsigned need_, unsigned* tmo_) {
        tile_e = tab + 128; nM = tab[32] >> 8; nN = nN_; nwg = nM * nN; G = G_; c = c_; ready = ready_; need = need_; tmo = tmo_;
        r10 = (nM * nN10) % G; X = r10 ? 3 : 0; nlight = G - r10; head = X * nlight < nwg ? X * nlight : nwg; }
    __device__ bool next(int i, Unit& u) const {
        long id;
        if (c >= r10 && X) id = i < X ? (long)i * nlight + (c - r10) : (long)head + (long)(i - X) * G + c;
        else id = (long)head + (long)i * G + c;
        if ((i < X && c >= r10 && id >= head) || id >= nwg) return false;
        u.pm = (int)id / nN; u.pn = (int)id % nN; u.pb = tile_e[u.pm] * nN + u.pn; return true;
    }
    __device__ __forceinline__ void a_ready(const Unit& u) const {
        if (threadIdx.x < 64) {
            unsigned polls = 0;
            while ((unsigned)__builtin_amdgcn_readfirstlane(__hip_atomic_load(ready + 64 * u.pm, __ATOMIC_RELAXED, __HIP_MEMORY_SCOPE_AGENT)) < need) {
                if (++polls > (1u << 16)) { if (threadIdx.x == 0) __hip_atomic_store(tmo, 0xDEAD0000u | (unsigned)u.pm, __ATOMIC_RELAXED, __HIP_MEMORY_SCOPE_AGENT); break; }
                __builtin_amdgcn_s_sleep(2); }
            __builtin_amdgcn_fence(__ATOMIC_ACQUIRE, "agent");
            asm volatile("s_waitcnt vmcnt(0)" ::: "memory");
        }
        asm volatile("" ::: "memory"); __builtin_amdgcn_s_barrier(); asm volatile("" ::: "memory");
    }
};

template <class Epi, class Sched, bool GATHER = false>
__device__ __forceinline__ void gemm_phase(LAS unsigned char* lds, const Gemm g, const Sched& S, const Epi& E) {
    int tid = threadIdx.x; asm volatile("" : "+v"(tid));
    const int wid = __builtin_amdgcn_readfirstlane(tid >> 6), lane = tid & 63, wr = wid >> 2, wc = wid & 3, fr = lane & 15, fq = lane >> 4;
    const int K = g.K, nt = K / BK;
    unsigned voffA[2], voffB[2]; int gR[2], gC[2];
#pragma unroll
    for (int i = 0; i < 2; ++i) { int R, C; stage_rc(tid * 16 + i * 8192, R, C); const int Rb = (R & ~31) + perm32(R & 31); gR[i] = R; gC[i] = C;
        voffA[i] = (unsigned)(R * g.lda + C) * 2u; voffB[i] = (unsigned)(Rb * g.ldb + C) * 2u; }
    const size_t kstep = (size_t)(BK * 2);
    const size_t hsA = (size_t)HALF * g.lda * 2, hsB = (size_t)HALF * g.ldb * 2;
    const unsigned ldsw = (unsigned)wid * 1024u;
    const int aoff = lds_byte(wr * 64 + fr, fq * 8), boff = lds_byte(wc * 32 + fr, fq * 8);
#define PG8_SA(b, h) (((b) * 2 + (h)) * HTB)
#define PG8_SB(b, h) ((4 + (b) * 2 + (h)) * HTB)
#define PG8_STAGE(bufoff, gbase, voff) do { _Pragma("unroll") for (int _i = 0; _i < 2; ++_i) \
        __builtin_amdgcn_global_load_lds((const unsigned*)((const char*)(gbase) + (voff)[_i]), (LAS unsigned*)(lds + (bufoff) + ldsw + _i * 8192), 16, 0, 0); } while (0)
#define PG8_STAGE_A(bufoff, dense_ptr, kbytes, offs) do { if constexpr (GATHER) { PG8_STAGE(bufoff, (const char*)g.A + (kbytes), offs); } else { PG8_STAGE(bufoff, dense_ptr, voffA); } } while (0)
#define PG8_GOFF(u, o0, o1) do { _Pragma("unroll") for (int _i = 0; _i < 2; ++_i) { o0[_i] = (unsigned)(S.arow(u, gR[_i]) * g.lda + gC[_i]) * 2u; o1[_i] = (unsigned)(S.arow(u, gR[_i] + HALF) * g.lda + gC[_i]) * 2u; } } while (0)
#define PG8_LDA(dst, b, h) do { _Pragma("unroll") for (int m = 0; m < 4; ++m) _Pragma("unroll") for (int k = 0; k < 2; ++k) dst[m][k] = *(const LAS bf16x8*)(lds + PG8_SA(b, h) + aoff + m * 2048 + k * 1024); } while (0)
#define PG8_LDB(dst, b, h) do { _Pragma("unroll") for (int n = 0; n < 2; ++n) _Pragma("unroll") for (int k = 0; k < 2; ++k) dst[n][k] = *(const LAS bf16x8*)(lds + PG8_SB(b, h) + boff + n * 2048 + k * 1024); } while (0)
#define PG8_MMA(ai, bj, At, Bt) do { __builtin_amdgcn_s_setprio(1); _Pragma("unroll") for (int m = 0; m < 4; ++m) _Pragma("unroll") for (int n = 0; n < 2; ++n) _Pragma("unroll") for (int k = 0; k < 2; ++k) \
        acc[ai][bj][m][n] = __builtin_amdgcn_mfma_f32_16x16x32_bf16(Bt[n][k], At[m][k], acc[ai][bj][m][n], 0, 0, 0); __builtin_amdgcn_s_setprio(0); } while (0)
#define PG8_WAIT_V(n) asm volatile("s_waitcnt vmcnt(" #n ")" ::: "memory")
#define PG8_WAIT_L(n) asm volatile("s_waitcnt lgkmcnt(" #n ")" ::: "memory")
#define PG8_BAR __builtin_amdgcn_s_barrier()
#define PG8_SCHED __builtin_amdgcn_sched_barrier(0)
    Unit cur, nxt; int ui = 0;
    if (!S.next(0, cur)) return;
    unsigned cO0[2] = {0u, 0u}, cO1[2] = {0u, 0u}, nO0[2] = {0u, 0u}, nO1[2] = {0u, 0u};
    if constexpr (GATHER) { PG8_GOFF(cur, cO0, cO1); }
    S.a_ready(cur);
    f32x4 acc[2][2][4][2];
#pragma unroll
    for (int a = 0; a < 2; ++a)
#pragma unroll
        for (int b = 0; b < 2; ++b)
#pragma unroll
            for (int m = 0; m < 4; ++m)
#pragma unroll
                for (int n = 0; n < 2; ++n) acc[a][b][m][n] = (f32x4){0.f, 0.f, 0.f, 0.f};
    bf16x8 At[4][2], B0[2][2], B1[2][2];
    const char* cA = (const char*)g.A + (GATHER ? (size_t)0 : (size_t)cur.pm * 2 * hsA); const char* cB = (const char*)g.Bt + (size_t)cur.pb * 2 * hsB;
    PG8_STAGE(PG8_SB(0, 0), cB, voffB); PG8_STAGE(PG8_SB(0, 1), cB + hsB, voffB); PG8_STAGE_A(PG8_SA(0, 0), cA, 0, cO0); PG8_STAGE_A(PG8_SA(0, 1), cA + hsA, 0, cO1);
    if (wr == 1) PG8_BAR;
    PG8_WAIT_V(2); PG8_BAR;
    PG8_STAGE(PG8_SB(1, 0), cB + kstep, voffB); PG8_STAGE_A(PG8_SA(1, 0), cA + kstep, kstep, cO0); PG8_STAGE(PG8_SB(1, 1), cB + hsB + kstep, voffB);
    PG8_WAIT_V(6); PG8_BAR;
    for (;;) {
        const bool has_next = S.next(ui + 1, nxt);
        const char* nA = (has_next && !GATHER) ? (const char*)g.A + (size_t)nxt.pm * 2 * hsA : cA; const char* nB = has_next ? (const char*)g.Bt + (size_t)nxt.pb * 2 * hsB : cB;
        if constexpr (GATHER) { if (has_next) { PG8_GOFF(nxt, nO0, nO1); } else { nO0[0] = cO0[0]; nO0[1] = cO0[1]; nO1[0] = cO1[0]; nO1[1] = cO1[1]; } }
        for (int t = 0; t < nt; t += 2) {
            const bool last = (t == nt - 2);
            if (last && has_next) S.a_ready(nxt);
            const char* a1 = cA + (size_t)(t + 1) * kstep;
            const char* a2 = last ? nA : cA + (size_t)(t + 2) * kstep; const char* b2 = last ? nB : cB + (size_t)(t + 2) * kstep;
            const char* a3 = a2 + kstep; const char* b3 = b2 + kstep;
            const size_t k2 = last ? (size_t)0 : (size_t)(t + 2) * kstep;
            unsigned o0[2], o1[2]; o0[0] = last ? nO0[0] : cO0[0]; o0[1] = last ? nO0[1] : cO0[1]; o1[0] = last ? nO1[0] : cO1[0]; o1[1] = last ? nO1[1] : cO1[1];
            PG8_LDB(B0, 0, 0); PG8_LDB(B1, 0, 1); PG8_SCHED; PG8_LDA(At, 0, 0); PG8_STAGE_A(PG8_SA(1, 1), a1 + hsA, (size_t)(t + 1) * kstep, cO1);
            PG8_WAIT_V(8); PG8_WAIT_L(0); PG8_BAR; PG8_MMA(0, 0, At, B0); PG8_MMA(0, 1, At, B1); PG8_BAR; PG8_SCHED;
            PG8_LDA(At, 0, 1); PG8_STAGE(PG8_SB(0, 0), b2, voffB); PG8_STAGE(PG8_SB(0, 1), b2 + hsB, voffB); PG8_STAGE_A(PG8_SA(0, 0), a2, k2, o0);
            PG8_WAIT_V(8); PG8_WAIT_L(0); PG8_BAR; PG8_MMA(1, 0, At, B0); PG8_MMA(1, 1, At, B1); PG8_BAR; PG8_SCHED;
            PG8_LDB(B0, 1, 0); PG8_LDB(B1, 1, 1); PG8_SCHED; PG8_LDA(At, 1, 0); PG8_STAGE_A(PG8_SA(0, 1), a2 + hsA, k2, o1);
            PG8_WAIT_V(8); PG8_WAIT_L(0); PG8_BAR; PG8_MMA(0, 0, At, B0); PG8_MMA(0, 1, At, B1); PG8_BAR; PG8_SCHED;
            PG8_LDA(At, 1, 1); PG8_STAGE(PG8_SB(1, 0), b3, voffB); PG8_STAGE(PG8_SB(1, 1), b3 + hsB, voffB); PG8_STAGE_A(PG8_SA(1, 0), a3, k2 + kstep, o0);
            PG8_WAIT_V(8); PG8_WAIT_L(0); PG8_BAR; PG8_MMA(1, 0, At, B0); PG8_MMA(1, 1, At, B1); PG8_BAR; PG8_SCHED;
        }
        if (wr == 0) PG8_BAR;
        E(acc, cur, wr, wc, fr, fq);
        if (!has_next) break;
#pragma unroll
        for (int a = 0; a < 2; ++a)
#pragma unroll
            for (int b = 0; b < 2; ++b)
#pragma unroll
                for (int m = 0; m < 4; ++m)
#pragma unroll
                    for (int n = 0; n < 2; ++n) acc[a][b][m][n] = (f32x4){0.f, 0.f, 0.f, 0.f};
        cur = nxt; cA = nA; cB = nB; ++ui;
        if constexpr (GATHER) { cO0[0] = nO0[0]; cO0[1] = nO0[1]; cO1[0] = nO1[0]; cO1[1] = nO1[1]; }
        if (wr == 1) PG8_BAR;
    }
    PG8_WAIT_V(0);
    PG8_BAR;
#undef PG8_SA
#undef PG8_SB
#undef PG8_STAGE
#undef PG8_STAGE_A
#undef PG8_GOFF
#undef PG8_LDA
#undef PG8_LDB
#undef PG8_MMA
#undef PG8_WAIT_V
#undef PG8_WAIT_L
#undef PG8_BAR
#undef PG8_SCHED
}

struct EpiStore {
    bf16_t* O; int ldc; const float* ssq; float inv; float* ssq_out0; float* ssq_out1; int pn0, pn1, pn2;
    int sg0 = 0, sg1 = 0;
    __device__ __forceinline__ void operator()(const f32x4 (&acc)[2][2][4][2], const Unit& u, int wr, int wc, int fr, int fq) const {
        const int row0 = u.pm * BM + wr * 64 + fr, col0 = u.pn * BM + wc * 32 + 8 * fq;
        float* so = (ssq_out0 && u.pn >= pn0 && u.pn < pn2) ? (u.pn < pn1 ? ssq_out0 : ssq_out1) : nullptr;
        const bool sig = u.pn >= sg0 && u.pn < sg1;
        float rsv[2][4];
#pragma unroll
        for (int ai = 0; ai < 2; ++ai)
#pragma unroll
            for (int m = 0; m < 4; ++m) rsv[ai][m] = ssq ? ssq[row0 + ai * HALF + m * 16] : 0.f;
#pragma unroll
        for (int ai = 0; ai < 2; ++ai)
#pragma unroll
            for (int m = 0; m < 4; ++m) { const int row = row0 + ai * HALF + m * 16; const float rs = ssq ? rsqrtf(rsv[ai][m] * inv + EPS) : 1.f;
                bf16_t* rowp = O + (size_t)row * ldc + col0; float ss = 0.f;
#pragma unroll
                for (int bj = 0; bj < 2; ++bj) { f32x4 v0 = acc[ai][bj][m][0] * rs, v1 = acc[ai][bj][m][1] * rs;
                    if (sig) {
#pragma unroll
                        for (int j = 0; j < 4; ++j) { v0[j] = __builtin_amdgcn_rcpf(1.f + __builtin_amdgcn_exp2f(1.4426950408889634f * v0[j])); v1[j] = __builtin_amdgcn_rcpf(1.f + __builtin_amdgcn_exp2f(1.4426950408889634f * v1[j])); } }
                    ss += (v0[0] * v0[0] + v0[1] * v0[1]) + (v0[2] * v0[2] + v0[3] * v0[3]) + (v1[0] * v1[0] + v1[1] * v1[1]) + (v1[2] * v1[2] + v1[3] * v1[3]);
                    u32x4 w; w.x = cvt_pk_bf16(v0[0], v0[1]); w.y = cvt_pk_bf16(v0[2], v0[3]); w.z = cvt_pk_bf16(v1[0], v1[1]); w.w = cvt_pk_bf16(v1[2], v1[3]);
                    *(u32x4*)(rowp + bj * HALF) = w; }
                if (so) { ss += __shfl_xor(ss, 16); ss += __shfl_xor(ss, 32); if (fq == 0) atomicAdd(so + row, ss); } }
    }
};
struct EpiResid {
    const float* X; float* O; const float* gate; int gpitch;
    __device__ __forceinline__ void operator()(const f32x4 (&acc)[2][2][4][2], const Unit& u, int wr, int wc, int fr, int fq) const {
        const int row0 = u.pm * BM + wr * 64 + fr, col0 = u.pn * BM + wc * 32 + 8 * fq;
        const float* gp = gate + (size_t)((u.pm * BM) / SEQ) * gpitch + col0;
        f32x4 gv[2][2];
#pragma unroll
        for (int bj = 0; bj < 2; ++bj)
#pragma unroll
            for (int n = 0; n < 2; ++n) gv[bj][n] = *(const f32x4*)(gp + bj * HALF + 4 * n);
#pragma unroll
        for (int ai = 0; ai < 2; ++ai)
#pragma unroll
            for (int m = 0; m < 4; ++m) { const size_t off = (size_t)(row0 + ai * HALF + m * 16) * DM + col0;
#pragma unroll
                for (int bj = 0; bj < 2; ++bj)
#pragma unroll
                    for (int n = 0; n < 2; ++n) { const f32x4 xv = *(const f32x4*)(X + off + bj * HALF + 4 * n);
                        *(f32x4*)(O + off + bj * HALF + 4 * n) = xv + gv[bj][n] * acc[ai][bj][m][n]; } }
    }
};
struct EpiSwiGLU {
    bf16_t* O; unsigned* ready;
    __device__ __forceinline__ void operator()(const f32x4 (&acc)[2][2][4][2], const Unit& u, int wr, int wc, int fr, int fq) const {
        const int row0 = u.pm * BM + wr * 64 + fr, col0 = u.pn * HALF + wc * 32 + 8 * fq;
        const __amdgpu_buffer_rsrc_t rs = __builtin_amdgcn_make_buffer_rsrc((void*)O, (short)0, RMAX * DE * 2, 0x00020000);
#pragma unroll
        for (int ai = 0; ai < 2; ++ai)
#pragma unroll
            for (int m = 0; m < 4; ++m) { const int row = row0 + ai * HALF + m * 16;
                float h[8];
#pragma unroll
                for (int n = 0; n < 2; ++n)
#pragma unroll
                    for (int j = 0; j < 4; ++j) { const float gt = acc[ai][0][m][n][j], up = acc[ai][1][m][n][j]; h[4 * n + j] = gt / (1.f + __expf(-gt)) * up; }
                u32x4 w; w.x = cvt_pk_bf16(h[0], h[1]); w.y = cvt_pk_bf16(h[2], h[3]); w.z = cvt_pk_bf16(h[4], h[5]); w.w = cvt_pk_bf16(h[6], h[7]);
                __builtin_amdgcn_raw_buffer_store_b128(w, rs, (unsigned)(row * DE + col0) * 2u, 0, 16); }
        asm volatile("s_waitcnt vmcnt(0)" ::: "memory");
        if ((threadIdx.x & 63) == 0) __hip_atomic_fetch_add(ready + 64 * u.pm, 1u, __ATOMIC_RELAXED, __HIP_MEMORY_SCOPE_AGENT);
    }
};
}
constexpr size_t MiB = 1u << 20;
constexpr size_t WS_CTL = 0, CTL_ZERO_BYTES = 1 * MiB;
constexpr size_t WS_MOD = 1 * MiB;
constexpr size_t WS_ROPEC = 1 * MiB + 512 * 1024;
constexpr size_t WS_ROPES = WS_ROPEC + 2 * MiB;
constexpr size_t WS_WCT = WS_ROPES + 2 * MiB;
constexpr size_t WS_RSTDQ = 6 * MiB;
constexpr size_t WS_RSTDKV = WS_RSTDQ + 64 * 1024;
constexpr size_t WS_TOKE = WS_RSTDKV + 64 * 1024;
constexpr size_t WS_TOKW = WS_TOKE + 128 * 1024;
constexpr size_t WS_TOKS = WS_TOKW + 128 * 1024;
constexpr size_t WS_BLKE = WS_TOKS + 128 * 1024;
constexpr size_t WS_STAMP = WS_BLKE + 4096;
constexpr size_t WS_WIN = 8 * MiB;
constexpr size_t WS_WQUP = 28 * MiB;
constexpr size_t WS_WKVUP = WS_WQUP + 1536 * 1024;
constexpr size_t WS_WOUT = 31 * MiB;
constexpr size_t WS_A = 40 * MiB;
constexpr size_t WS_B = 200 * MiB;
constexpr size_t WS_C = 264 * MiB;
constexpr size_t WS_D = 328 * MiB;
constexpr size_t WS_E = 456 * MiB;
constexpr size_t WS_LIST = 520 * MiB;
constexpr size_t WS_F = 522 * MiB;
constexpr size_t WS_END = 586 * MiB;
constexpr size_t QN_BYTES = (size_t)T * MH * MQK * 2;

constexpr int CW_BAR = 4096;
constexpr int CW_CNT = 8192;
constexpr int CW_RDY = 10240;
constexpr int CW_ADA = 64;
constexpr int CW_TMO = 1;

constexpr int RING_BYTES = 131072, LDS_BYTES = 147456, LDS_USER = 143360, MISC_OFF = LDS_BYTES - 512;

struct Args { const float* in[25]; float* out; unsigned char* ws; int ph_lo, ph_hi, pad0, pad1; };

struct Frame {
    LAS unsigned char* lds;
    volatile LAS unsigned* MISC;
    gu32* ctl;
    int tid, lane, wave, vcu, G;
    unsigned char* ws; float* out;
};

#define OPAQUE_FRAME(F) do { F.tid = threadIdx.x; asm volatile("" : "+v"(F.tid)); F.lane = F.tid & 63; } while (0)

__device__ __forceinline__ void unpack8(const u32x4 w, float* f) { f[0] = bf_lo(w.x); f[1] = bf_hi(w.x); f[2] = bf_lo(w.y); f[3] = bf_hi(w.y); f[4] = bf_lo(w.z); f[5] = bf_hi(w.z); f[6] = bf_lo(w.w); f[7] = bf_hi(w.w); }
__device__ __forceinline__ u32x4 pack8f(const float* f) { u32x4 w; w.x = cvt_pk_bf16(f[0], f[1]); w.y = cvt_pk_bf16(f[2], f[3]); w.z = cvt_pk_bf16(f[4], f[5]); w.w = cvt_pk_bf16(f[6], f[7]); return w; }

struct TrItem { const float* src; bf16_t* dst; bf16_t* dst2; const float* gk; int N, ldt; };
__device__ __forceinline__ void tr_load(const TrItem& it, f32x4 (&r)[16], int lane) {
    const float* p = it.src + (size_t)(lane >> 4) * it.N + 4 * (lane & 15);
#pragma unroll
    for (int i = 0; i < 16; ++i) r[i] = __builtin_nontemporal_load((const f32x4*)(p + (size_t)(4 * i) * it.N));
}
__device__ __forceinline__ void tr_store(const TrItem& it, const f32x4 (&r)[16], LAS unsigned char* Tl, int lane) {
    const int row = lane >> 4, c4 = lane & 15;
#pragma unroll
    for (int i = 0; i < 16; ++i) { f32x4 v = r[i]; if (it.gk) v = v * it.gk[4 * i + row];
        u32x2 w; w.x = cvt_pk_bf16(v.x, v.y); w.y = cvt_pk_bf16(v.z, v.w);
        *(LAS u32x2*)(Tl + ((4 * i + row) * 64 + 4 * c4) * 2) = w; }
    LDS_WAIT(); asm volatile("" ::: "memory");
    const int g = lane >> 4, i16 = lane & 15, q = i16 >> 2, pp = lane & 3;
    typedef short v4i16_t __attribute__((ext_vector_type(4)));
#pragma unroll
    for (int hh = 0; hh < 2; ++hh) { bf16_t* drow = (hh ? it.dst2 : it.dst) + (size_t)(16 * (g & 1) + i16) * it.ldt;
#pragma unroll
        for (int j = 0; j < 4; ++j) { const int kc = 4 * (g >> 1) + j;
            const v4i16_t lo = __builtin_amdgcn_ds_read_tr16_b64_v4i16((LAS v4i16_t*)(Tl + ((8 * kc + q) * 64 + 32 * hh + 16 * (g & 1) + 4 * pp) * 2));
            const v4i16_t hi = __builtin_amdgcn_ds_read_tr16_b64_v4i16((LAS v4i16_t*)(Tl + ((8 * kc + 4 + q) * 64 + 32 * hh + 16 * (g & 1) + 4 * pp) * 2));
            const bf16x8 o = {lo[0], lo[1], lo[2], lo[3], hi[0], hi[1], hi[2], hi[3]};
            *(bf16x8*)(drow + 8 * kc) = o; } }
    LDS_WAIT(); asm volatile("" ::: "memory");
}
template <class MK> __device__ __forceinline__ void tr_run(int first, int step, int n, const MK& mk, LAS unsigned char* Tl, int lane) {
    if (first >= n) return;
    f32x4 ra[16], rb[16];
    TrItem ia = mk(first), ib = ia;
    tr_load(ia, ra, lane);
    for (int idx = first; idx < n; idx += 2 * step) {
        if (idx + step < n) { ib = mk(idx + step); tr_load(ib, rb, lane); }
        tr_store(ia, ra, Tl, lane);
        if (idx + step >= n) break;
        if (idx + 2 * step < n) { ia = mk(idx + 2 * step); tr_load(ia, ra, lane); }
        tr_store(ib, rb, Tl, lane);
    }
}

__device__ __forceinline__ void adaln_phase(Frame& F, const float* c, const float* w_ada, const float* b_ada, float* mod) {
    LAS float* cact = (LAS float*)F.lds;
    LAS float* part = (LAS float*)(F.lds + 65536);
    for (int i = F.tid; i < NB * DM; i += NTHR) cact[i] = siluf(c[i]);
    __syncthreads();
    const int cg = F.tid & 7, rs = F.tid >> 3;
    for (int it = blockIdx.x; it < 6 * DM / 32; it += F.G) {
        const int n0 = it * 32 + cg * 4;
        f32x4 acc[8];
#pragma unroll
        for (int b = 0; b < 8; ++b) acc[b] = (f32x4){0.f, 0.f, 0.f, 0.f};
#pragma unroll 1
        for (int i0 = 0; i0 < 32; i0 += 16) { f32x4 w[16];
#pragma unroll
            for (int u = 0; u < 16; ++u) w[u] = __builtin_nontemporal_load((const f32x4*)(w_ada + (size_t)(rs + 64 * (i0 + u)) * (6 * DM) + n0));
#pragma unroll
            for (int u = 0; u < 16; ++u) { const int k = rs + 64 * (i0 + u);
#pragma unroll
                for (int b = 0; b < 8; ++b) acc[b] += w[u] * cact[b * DM + k]; } }
#pragma unroll
        for (int b = 0; b < 8; ++b) *(LAS f32x4*)(part + (rs * 8 + b) * 32 + cg * 4) = acc[b];
        __syncthreads();
        if (F.tid < 256) { const int b = F.tid >> 5, n = F.tid & 31; float s = 0.f;
#pragma unroll 8
            for (int r = 0; r < 64; ++r) s += part[(r * 8 + b) * 32 + n];
            __hip_atomic_store(mod + b * (6 * DM) + it * 32 + n, s + b_ada[it * 32 + n], __ATOMIC_RELAXED, __HIP_MEMORY_SCOPE_AGENT); }
        asm volatile("s_waitcnt vmcnt(0)" ::: "memory");
        __syncthreads();
        if (it == (int)blockIdx.x && F.tid == 0) __hip_atomic_fetch_add((unsigned*)(F.ctl + CW_ADA), 1u, __ATOMIC_RELAXED, __HIP_MEMORY_SCOPE_AGENT);
    }
}

__device__ __forceinline__ void p0_phase(Frame& F, const Args& a) {
    OPAQUE_FRAME(F);
    unsigned char* ws = F.ws;
    adaln_phase(F, a.in[1], a.in[3], a.in[4], (float*)(ws + WS_MOD));
    __syncthreads();
    LAS unsigned char* Tl = F.lds + F.wave * 8192;
    const int gw = F.vcu * NWAVES + F.wave, NGW = F.G * NWAVES;
    constexpr int I_IN = (DM / 64) * (INC / 64), I_QUP = (QLORA / 64) * (MH * MQK / 64), I_KVUP = (KVLORA / 64) * (MH * 256 / 64), I_OUT = (DM / 64) * (DM / 64);
    constexpr int NITEMS = I_IN + I_QUP + I_KVUP + I_OUT;
    static_assert(INC % 64 == 0, "64-column transpose items");
    { const float* w_in = a.in[6]; const float* w_qup = a.in[10]; const float* w_kvup = a.in[12]; const float* w_out = a.in[16]; const float* gq = a.in[9]; const float* gkv = a.in[11];
      auto mk = [=](int r) -> TrItem { TrItem t;
          if (r < I_IN) { const int nblk = INC / 64, kb = r / nblk, nb = r % nblk; t.src = w_in + (size_t)(64 * kb) * INC + 64 * nb; t.dst = (bf16_t*)(ws + WS_WIN) + (size_t)(64 * nb) * DM + 64 * kb; t.dst2 = t.dst + (size_t)32 * DM; t.gk = nullptr; t.N = INC; t.ldt = DM; return t; } r -= I_IN;
          if (r < I_QUP) { const int nblk = MH * MQK / 64, kb = r / nblk, nb = r % nblk; t.src = w_qup + (size_t)(64 * kb) * (MH * MQK) + 64 * nb; t.dst = (bf16_t*)(ws + WS_WQUP) + (size_t)(64 * nb) * QLORA + 64 * kb; t.dst2 = t.dst + (size_t)32 * QLORA; t.gk = gq + 64 * kb; t.N = MH * MQK; t.ldt = QLORA; return t; } r -= I_QUP;
          if (r < I_KVUP) { const int nblk = MH * 256 / 64, kb = r / nblk, nb = r % nblk; t.src = w_kvup + (size_t)(64 * kb) * (MH * 256) + 64 * nb; t.dst = (bf16_t*)(ws + WS_WKVUP) + (size_t)(64 * nb) * KVLORA + 64 * kb; t.dst2 = t.dst + (size_t)32 * KVLORA; t.gk = gkv + 64 * kb; t.N = MH * 256; t.ldt = KVLORA; return t; } r -= I_KVUP;
          { const int nblk = DM / 64, kb = r / nblk, nb = r % nblk; t.src = w_out + (size_t)(64 * kb) * DM + 64 * nb; t.dst = (bf16_t*)(ws + WS_WOUT) + (size_t)(64 * nb) * DM + 64 * kb; t.dst2 = t.dst + (size_t)32 * DM; t.gk = nullptr; t.N = DM; t.ldt = DM; return t; } };
      const int nheavy = (6 * DM / 32) - F.G, nlw = (F.G - nheavy) * NWAVES;
      int pre = 0;
      if (nheavy > 0 && nheavy < F.G) { pre = 2 * nlw < NITEMS ? 2 * nlw : NITEMS;
          if ((int)blockIdx.x >= nheavy) tr_run(((int)blockIdx.x - nheavy) * NWAVES + F.wave, nlw, pre, mk, Tl, F.lane); }
      tr_run(pre + gw, NGW, NITEMS, mk, Tl, F.lane); }
    { const int* pos = (const int*)a.in[2]; float* rc = (float*)(ws + WS_ROPEC); float* rsn = (float*)(ws + WS_ROPES);
      const int gt = F.vcu * NTHR + F.tid, NGT = F.G * NTHR;
      const float invf = (float)exp2(-(double)(gt & 31) * (13.287712379549449 / 32.0));
      for (int e = gt; e < T * 32; e += NGT) { const int tk = e >> 5;
          const float ang = (float)pos[tk] * invf; float sv, cv; sincosf(ang, &sv, &cv);
          rc[e] = cv; rsn[e] = sv; }
      { float* ssq = (float*)(ws + WS_RSTDQ); for (int e = gt; e < 2 * T; e += NGT) ssq[e] = 0.f; }
      float* wct = (float*)(ws + WS_WCT);
      for (int e = gt; e < 48 * DM; e += NGT) { const int n = e / DM, k = e % DM;
          wct[e] = n < 4 ? a.in[18][k * NG + n] : (n < 36 ? a.in[20][k * NE + (n - 4)] : 0.f); } }
}

__device__ __forceinline__ void p1_phase(Frame& F, const Args& a) {
    OPAQUE_FRAME(F);
    const int gw = F.vcu * NWAVES + F.wave, NGW = F.G * NWAVES;
    const float* mod = (const float*)(F.ws + WS_MOD); const float* g = a.in[5]; const float* x = a.in[0];
    bf16_t* H = (bf16_t*)(F.ws + WS_B);
    if (F.tid == 0) { unsigned polls = 0;
        while (__hip_atomic_load((unsigned*)(F.ctl + CW_ADA), __ATOMIC_RELAXED, __HIP_MEMORY_SCOPE_AGENT) < (unsigned)F.G) { if (++polls > (1u << 16)) { __hip_atomic_store((unsigned*)(F.ctl + CW_TMO), 0xADA00000u, __ATOMIC_RELAXED, __HIP_MEMORY_SCOPE_AGENT); break; } __builtin_amdgcn_s_sleep(2); }
        __builtin_amdgcn_fence(__ATOMIC_ACQUIRE, "agent"); asm volatile("s_waitcnt vmcnt(0)" ::: "memory"); }
    __syncthreads();
    for (int blk = gw; blk < T / 8; blk += NGW) { const int m0 = blk * 8, b = m0 / SEQ;
        const float* shift = mod + b * (6 * DM); const float* scale = shift + DM;
        f32x4 gm[8], sh[8];
#pragma unroll
        for (int j = 0; j < 8; ++j) { gm[j] = ((const f32x4*)g)[64 * j + F.lane] * (((const f32x4*)scale)[64 * j + F.lane] + 1.f); sh[j] = ((const f32x4*)shift)[64 * j + F.lane]; }
        f32x4 va[8], vb[8];
#define P1_LD(r, V) do { const f32x4* xr_ = (const f32x4*)(x + (size_t)(m0 + (r)) * DM) + F.lane; _Pragma("unroll") for (int j = 0; j < 8; ++j) V[j] = __builtin_nontemporal_load(xr_ + 64 * j); } while (0)
#define P1_ST(r, V) do { float s_ = 0.f; _Pragma("unroll") for (int j = 0; j < 8; ++j) s_ += (V[j].x * V[j].x + V[j].y * V[j].y) + (V[j].z * V[j].z + V[j].w * V[j].w); \
            const float rstd_ = rsqrtf(wave_sum(s_) * (1.f / DM) + EPS); u32x2* o8_ = (u32x2*)(H + (size_t)(m0 + (r)) * DM) + F.lane; \
            _Pragma("unroll") for (int j = 0; j < 8; ++j) { const f32x4 h_ = V[j] * rstd_ * gm[j] + sh[j]; u32x2 w_; w_.x = cvt_pk_bf16(h_.x, h_.y); w_.y = cvt_pk_bf16(h_.z, h_.w); o8_[64 * j] = w_; } } while (0)
        P1_LD(0, va);
#pragma unroll 1
        for (int r = 0; r < 8; r += 2) {
            P1_LD(r + 1, vb); __builtin_amdgcn_sched_barrier(0);
            P1_ST(r, va); __builtin_amdgcn_sched_barrier(0);
            if (r + 2 < 8) { P1_LD(r + 2, va); } __builtin_amdgcn_sched_barrier(0);
            P1_ST(r + 1, vb); __builtin_amdgcn_sched_barrier(0);
        }
#undef P1_LD
#undef P1_ST
    }
}

namespace hg {
constexpr int OFF_F = 0, OFF_SEG = 32768, OFF_QIN = 34816, RP = 272, OFF_KIN = OFF_QIN + 64 * RP, OFF_QB = OFF_KIN + 64 * RP, OFF_KLT = OFF_QB + 64 * RP, SP = 144,
              OFF_VT = OFF_KLT + 128 * SP  , OFF_DEC = OFF_VT + 64 * SP  , OFF_SF = OFF_DEC + 3584  , OP = 144, OFF_O = OFF_SF + 16384  , OFF_LB = OFF_O + 64 * OP  , HG_LDS = OFF_LB + 1024;
static_assert(HG_LDS <= MISC_OFF, "hgrn lds");
__device__ __forceinline__ float dpp_xor1(float v) { return __builtin_bit_cast(float, __builtin_amdgcn_update_dpp(0, __builtin_bit_cast(int, v), 0xB1, 0xF, 0xF, true)); }
__device__ __forceinline__ int ppos(int s) { return (s & ~15) | ((s & 4) << 1) | ((s & 8) >> 1) | (s & 3); }
}
__device__ __forceinline__ void hgrn_chunked(Frame& F, const Args& a, int item) {
    using namespace hg;
    const bf16_t* PROJ = (const bf16_t*)(F.ws + WS_A);
    bf16_t* MIX = (bf16_t*)F.out;
    const float* lbl = a.in[7];
    LAS unsigned char* L = F.lds;
    LAS float* Fs = (LAS float*)(L + OFF_F); LAS float* SEGs = (LAS float*)(L + OFF_SEG); LAS float* DEC = (LAS float*)(L + OFF_DEC); LAS float* POST = DEC + 384;
    const int g = F.tid & 15, t0 = F.tid >> 4;
    const int sk = 16 * F.wave + (F.lane & 15), sseg = F.lane >> 4;
    const int scol = sk ^ ((sseg & 1) << 4);
    const int r32 = F.lane & 31, hi = F.lane >> 5;
    {
        const int dq2 = (item >> 3) & 1, bh = (item >> 4) * 8 + (item & 7), h = bh & 7, b = bh >> 3;
        LAS float* LB = (LAS float*)(L + OFF_LB);
        if (F.tid < 128) { const int k = h * 128 + F.tid; const float l = 1.f / (1.f + __expf(lbl[HW + k] - lbl[k])); LB[F.tid] = l; LB[128 + F.tid] = 1.f - l; }
        __syncthreads();
        const bf16_t* base = PROJ + (size_t)(b * SEQ) * INCP + h * 128;
        f32x16 S0 = {}, S1 = {};
        u32x4 gq[2], gf[2], gv;
#define HG_LOADF(c) do { _Pragma("unroll") for (int i = 0; i < 2; ++i) gf[i] = *(const u32x4*)(base + (size_t)((c) * 64 + t0 + 32 * i) * INCP + g * 8 + HW); } while (0)
#define HG_LOADQ(c) do { _Pragma("unroll") for (int i = 0; i < 2; ++i) gq[i] = *(const u32x4*)(base + (size_t)((c) * 64 + t0 + 32 * i) * INCP + g * 8); \
            gv = *(const u32x4*)(base + (size_t)((c) * 64 + (F.tid >> 3)) * INCP + 2 * HW + dq2 * 64 + (F.tid & 7) * 8); } while (0)
        HG_LOADF(0); HG_LOADQ(0);
        float fv[2][8], klp[16], po = 0.f;
        for (int c = -1; c < SEQ / 64; ++c) {
            if (c >= 0) {
            {
              f32x4 pa[2], pb[2], ea[2], eb[2];
#pragma unroll
              for (int i = 0; i < 2; ++i) { const int t = t0 + 32 * i; const LAS float* fp = Fs + t * 128 + ((g * 8) ^ (((t >> 4) & 1) << 4)); const LAS float* pp = SEGs + (t >> 4) * 128 + g * 8;
                  pa[i] = *(const LAS f32x4*)fp; pb[i] = *(const LAS f32x4*)(fp + 4); ea[i] = *(const LAS f32x4*)pp; eb[i] = *(const LAS f32x4*)(pp + 4); }
              __builtin_amdgcn_sched_barrier(0);
            if (F.wave >= 4) { const int kb = F.wave - 4;
                f32x16 Z0, Z1;
#pragma unroll
                for (int q4 = 0; q4 < 4; ++q4) { const f32x4 pmv = *(const LAS f32x4*)(DEC + 128 + 32 * kb + 8 * q4 + 4 * hi);
#pragma unroll
                    for (int j = 0; j < 4; ++j) { Z0[4 * q4 + j] = S0[4 * q4 + j] * pmv[j]; Z1[4 * q4 + j] = S1[4 * q4 + j] * pmv[j]; } }
#pragma unroll
                for (int s2 = 0; s2 < 2; ++s2) { u32x4 w0, w1;
                    w0.x = cvt_pk_bf16(Z0[8 * s2], Z0[8 * s2 + 1]); w0.y = cvt_pk_bf16(Z0[8 * s2 + 2], Z0[8 * s2 + 3]); w0.z = cvt_pk_bf16(Z0[8 * s2 + 4], Z0[8 * s2 + 5]); w0.w = cvt_pk_bf16(Z0[8 * s2 + 6], Z0[8 * s2 + 7]);
                    w1.x = cvt_pk_bf16(Z1[8 * s2], Z1[8 * s2 + 1]); w1.y = cvt_pk_bf16(Z1[8 * s2 + 2], Z1[8 * s2 + 3]); w1.z = cvt_pk_bf16(Z1[8 * s2 + 4], Z1[8 * s2 + 5]); w1.w = cvt_pk_bf16(Z1[8 * s2 + 6], Z1[8 * s2 + 7]);
                    *(LAS u32x4*)(L + OFF_SF + ((((kb * 2 + 0) * 2 + s2) * 64) + F.lane) * 16) = w0;
                    *(LAS u32x4*)(L + OFF_SF + ((((kb * 2 + 1) * 2 + s2) * 64) + F.lane) * 16) = w1; } }
              __builtin_amdgcn_sched_barrier(0);
              { float v[8]; unpack8(gv, v); const int s = F.tid >> 3, dvg = F.tid & 7, ps = ppos(s);
#pragma unroll
                  for (int j = 0; j < 8; ++j) *(LAS bf16_t*)(L + OFF_VT + (dvg * 8 + j) * SP + (((ps >> 3) ^ dvg) << 4) + (ps & 7) * 2) = (bf16_t)(__builtin_bit_cast(unsigned, v[j]) >> 16); }
              { float o16[16];
#pragma unroll
                for (int p = 0; p < 16; ++p) o16[p] = klp[8 * ((p >> 2) & 1) + 4 * (p >> 3) + (p & 3)] * po;
                *(LAS u32x4*)(L + OFF_KLT + sk * SP + sseg * 32) = pack8f(o16); *(LAS u32x4*)(L + OFF_KLT + sk * SP + sseg * 32 + 16) = pack8f(o16 + 8); }
#pragma unroll
              for (int i = 0; i < 2; ++i) { const int t = t0 + 32 * i;
                  float qin[8], kin[8], qv[8];
                  unpack8(gq[i], qv);
#pragma unroll
                  for (int j = 0; j < 8; ++j) { const float P = (j < 4 ? pa[i][j] * ea[i][j] : pb[i][j - 4] * eb[i][j - 4]);
                      qin[j] = qv[j] * 0.08838834764831845f * P; kin[j] = (1.f - fv[i][j]) * __builtin_amdgcn_rcpf(P); }
                  { const u32x4 wq = pack8f(qin), wk = pack8f(kin); const int o0 = t * RP + ((g >> 1) * 16 + (g & 1) * 4) * 2;
                    *(LAS u32x2*)(L + OFF_QIN + o0) = (u32x2){wq.x, wq.y}; *(LAS u32x2*)(L + OFF_QIN + o0 + 16) = (u32x2){wq.z, wq.w};
                    *(LAS u32x2*)(L + OFF_KIN + o0) = (u32x2){wk.x, wk.y}; *(LAS u32x2*)(L + OFF_KIN + o0 + 16) = (u32x2){wk.z, wk.w}; } } }
                        if (c + 1 < SEQ / 64) HG_LOADQ(c + 1);
            }
            __syncthreads();
            if (c >= 0) {
            if (F.wave < 4) { const int tb = F.wave & 1, dvb = F.wave >> 1;
                const LAS unsigned char* qin_p = L + OFF_QIN + (32 * tb + r32) * RP + 16 * hi;
                const LAS unsigned char* sf_p = L + OFF_SF + dvb * 2048 + F.lane * 16;
                const LAS unsigned char* kin_p = L + OFF_KIN + r32 * RP + 16 * hi;
                const LAS unsigned char* vt_p = L + OFF_VT + (32 * dvb + r32) * SP; const int vsw = (4 * dvb + (r32 >> 3)) & 7;
#define HG_VT(ch) (*(const LAS bf16x8*)(vt_p + ((((ch) + hi) ^ vsw) << 4)))
                bf16x8 A0[4], B0[4], A1[4], B1[4], vf0, vf1;
#define HG_LDQS(A, B, i0) do { _Pragma("unroll") for (int i = 0; i < 4; ++i) { const int kb_ = ((i0) + i) >> 1, s2_ = ((i0) + i) & 1; \
                    A[i] = *(const LAS bf16x8*)(qin_p + 64 * kb_ + 32 * s2_); B[i] = *(const LAS bf16x8*)(sf_p + kb_ * 4096 + s2_ * 1024); } } while (0)
#define HG_LDX(A, B, sb_, k0) do { _Pragma("unroll") for (int i = 0; i < 4; ++i) { A[i] = *(const LAS bf16x8*)(kin_p + 32 * (sb_) * RP + 32 * ((k0) + i)); B[i] = *(const LAS bf16x8*)(qin_p + 32 * ((k0) + i)); } } while (0)
#define HG_MM(D, A, B) do { _Pragma("unroll") for (int i = 0; i < 4; ++i) D = __builtin_amdgcn_mfma_f32_32x32x16_bf16(A[i], B[i], D, 0, 0, 0); } while (0)
#define HG_XV(X, v0, v1) do { u32x4 w0_, w1_; \
                    w0_.x = cvt_pk_bf16(X[0], X[1]); w0_.y = cvt_pk_bf16(X[2], X[3]); w0_.z = cvt_pk_bf16(X[4], X[5]); w0_.w = cvt_pk_bf16(X[6], X[7]); \
                    w1_.x = cvt_pk_bf16(X[8], X[9]); w1_.y = cvt_pk_bf16(X[10], X[11]); w1_.z = cvt_pk_bf16(X[12], X[13]); w1_.w = cvt_pk_bf16(X[14], X[15]); \
                    o = __builtin_amdgcn_mfma_f32_32x32x16_bf16(__builtin_bit_cast(bf16x8, w0_), v0, o, 0, 0, 0); o = __builtin_amdgcn_mfma_f32_32x32x16_bf16(__builtin_bit_cast(bf16x8, w1_), v1, o, 0, 0, 0); } while (0)
#define HG_DIAG(X) do { _Pragma("unroll") for (int r = 0; r < 16; ++r) { const int srow = (r & 3) + 8 * (r >> 2) + 4 * hi; if (srow > r32) X[r] = 0.f; } } while (0)
                f32x16 o = {}, X = {};
                HG_LDQS(A0, B0, 0); HG_LDQS(A1, B1, 4); __builtin_amdgcn_sched_barrier(0);
                HG_MM(o, A0, B0); __builtin_amdgcn_sched_barrier(0);
                HG_LDX(A0, B0, 0, 0); __builtin_amdgcn_sched_barrier(0);
                HG_MM(o, A1, B1); __builtin_amdgcn_sched_barrier(0);
                HG_LDX(A1, B1, 0, 4); vf0 = HG_VT(0); vf1 = HG_VT(2); __builtin_amdgcn_sched_barrier(0);
                HG_MM(X, A0, B0); __builtin_amdgcn_sched_barrier(0);
                if (tb == 1) { HG_LDX(A0, B0, 1, 0); } __builtin_amdgcn_sched_barrier(0);
                HG_MM(X, A1, B1); __builtin_amdgcn_sched_barrier(0);
                if (tb == 0) { HG_DIAG(X); HG_XV(X, vf0, vf1); }
                else { bf16x8 vg0, vg1;
                    HG_LDX(A1, B1, 1, 4); vg0 = HG_VT(4); vg1 = HG_VT(6); __builtin_amdgcn_sched_barrier(0);
                    HG_XV(X, vf0, vf1);
#pragma unroll
                    for (int r = 0; r < 16; ++r) X[r] = 0.f;
                    HG_MM(X, A0, B0); HG_MM(X, A1, B1); HG_DIAG(X); HG_XV(X, vg0, vg1); }
#undef HG_VT
#undef HG_LDQS
#undef HG_LDX
#undef HG_MM
#undef HG_XV
#undef HG_DIAG
                unsigned ow[16];
#pragma unroll
                for (int r = 0; r < 16; ++r) ow[r] = cvt_pk_bf16(o[r], dpp_xor1(o[r]));
                if ((r32 & 1) == 0) { LAS unsigned char* ob = L + OFF_O + (32 * tb + 4 * hi) * OP + (32 * dvb + r32) * 2;
#pragma unroll
                    for (int r = 0; r < 16; ++r) *(LAS unsigned*)(ob + ((r & 3) + 8 * (r >> 2)) * OP) = ow[r]; }
            } else { const int kb = F.wave - 4;
                bf16x8 kf[4], va[4], vb[4];
#pragma unroll
                for (int ss = 0; ss < 4; ++ss) { kf[ss] = *(const LAS bf16x8*)(L + OFF_KLT + (32 * kb + r32) * SP + (16 * ss + 8 * hi) * 2);
                    va[ss] = *(const LAS bf16x8*)(L + OFF_VT + r32 * SP + (((2 * ss + hi) ^ (r32 >> 3)) << 4)); vb[ss] = *(const LAS bf16x8*)(L + OFF_VT + (32 + r32) * SP + (((2 * ss + hi) ^ (4 + (r32 >> 3))) << 4)); }
#pragma unroll
                for (int r = 0; r < 16; ++r) { const float dcy = DEC[32 * kb + (r & 3) + 8 * (r >> 2) + 4 * hi]; S0[r] *= dcy; S1[r] *= dcy; }
                __builtin_amdgcn_sched_barrier(0);
#pragma unroll
                for (int ss = 0; ss < 4; ++ss) { S0 = __builtin_amdgcn_mfma_f32_32x32x16_bf16(kf[ss], va[ss], S0, 0, 0, 0); S1 = __builtin_amdgcn_mfma_f32_32x32x16_bf16(kf[ss], vb[ss], S1, 0, 0, 0); }
            }
                        }
            if (c + 1 < SEQ / 64) {
            float lb[8], lc[8];
            { const f32x4 l0 = *(const LAS f32x4*)(LB + g * 8), l1 = *(const LAS f32x4*)(LB + g * 8 + 4), c0 = *(const LAS f32x4*)(LB + 128 + g * 8), c1 = *(const LAS f32x4*)(LB + 128 + g * 8 + 4);
#pragma unroll
              for (int j = 0; j < 4; ++j) { lb[j] = l0[j]; lb[4 + j] = l1[j]; lc[j] = c0[j]; lc[4 + j] = c1[j]; } }
#pragma unroll
            for (int i = 0; i < 2; ++i) { float fl[8]; unpack8(gf[i], fl);
#pragma unroll
                for (int j = 0; j < 8; ++j) fv[i][j] = 1.f - lc[j] * fl[j];
                LAS float* fp = Fs + (t0 + 32 * i) * 128 + ((g * 8) ^ ((((t0 + 32 * i) >> 4) & 1) << 4));
                *(LAS f32x4*)fp = (f32x4){fv[i][0], fv[i][1], fv[i][2], fv[i][3]}; *(LAS f32x4*)(fp + 4) = (f32x4){fv[i][4], fv[i][5], fv[i][6], fv[i][7]}; }
            if (c + 2 < SEQ / 64) HG_LOADF(c + 2);
            } else {
#pragma unroll
                for (int j = 0; j < 8; ++j) { fv[0][j] = 0.f; fv[1][j] = 0.f; } }
            __syncthreads();
            if (c >= 0) { const int row = F.tid >> 3, pc = F.tid & 7;
              const u32x4 w = *(const LAS u32x4*)(L + OFF_O + row * OP + pc * 16);
              *(u32x4*)(MIX + (size_t)(b * SEQ + c * 64 + row) * DM + h * 128 + dq2 * 64 + pc * 8) = w; }
            if (c + 1 < SEQ / 64) {
            { float fr[16];
#pragma unroll
              for (int i = 0; i < 16; ++i) fr[i] = Fs[(16 * sseg + i) * 128 + scol];
              float p = 1.f;
#pragma unroll
              for (int i = 0; i < 16; ++i) { p *= fr[i]; Fs[(16 * sseg + i) * 128 + scol] = p; }
              float q = 1.f;
#pragma unroll
              for (int i = 15; i >= 0; --i) { klp[i] = (1.f - fr[i]) * q; q *= fr[i]; }
              const unsigned pu = __float_as_uint(p);
              auto r16 = __builtin_amdgcn_permlane16_swap(pu, pu, false, false);
              const float A = __uint_as_float(r16[0]) * __uint_as_float(r16[1]), x16 = __uint_as_float(r16[0] == pu ? r16[1] : r16[0]);
              const unsigned au = __float_as_uint(A);
              auto r32_ = __builtin_amdgcn_permlane32_swap(au, au, false, false);
              const float B = __uint_as_float(r32_[0] == au ? r32_[1] : r32_[0]);
              const float rc = __builtin_amdgcn_rcpf(sseg == 0 ? A : p);
              SEGs[sseg * 128 + sk] = sseg < 2 ? rc : (sseg == 2 ? 1.f : x16);
              po = sseg == 0 ? x16 * B : (sseg == 1 ? B : (sseg == 2 ? x16 : 1.f));
              if (sseg < 2) DEC[sseg * 128 + sk] = sseg == 0 ? A * B : A; }
            } else {
#pragma unroll
                for (int i = 0; i < 16; ++i) klp[i] = 0.f;
                po = 0.f; }
            __syncthreads();
        }
#undef HG_LOADF
#undef HG_LOADQ
    }
}

constexpr int MOE_IG = NE * (DM / 64) * (DE / 64);
constexpr int MOE_PRE = 2048;
struct MoeItems { const float* wg; const float* wu; const float* wd; unsigned char* ws;
    __device__ TrItem operator()(int it) const { TrItem t; t.gk = nullptr;
        const int which = it / MOE_IG, r = it % MOE_IG;
        if (which < 2) { const int e = r / 256, q = r % 256, kb = q / 8, nb = q % 8, n0 = 64 * nb;
            t.src = (which ? wu : wg) + (size_t)e * DM * DE + (size_t)(64 * kb) * DE + n0;
            t.dst = (bf16_t*)(ws + WS_D) + ((size_t)e * 1024 + (n0 >> 7) * 256 + (n0 & 127) + which * 128) * DM + 64 * kb; t.dst2 = t.dst + (size_t)32 * DM; t.N = DE; t.ldt = DM; }
        else { const int e = r / 256, q = r % 256, kb = q / 32, nb = q % 32, n0 = 64 * nb;
            t.src = wd + (size_t)e * DE * DM + (size_t)(64 * kb) * DM + n0;
            t.dst = (bf16_t*)(ws + WS_E) + ((size_t)e * DM + n0) * DE + 64 * kb; t.dst2 = t.dst + (size_t)32 * DE; t.N = DM; t.ldt = DE; }
        return t; } };

__device__ __forceinline__ void p3_phase(Frame& F, const Args& a) {
    OPAQUE_FRAME(F);
    const int role = ((int)blockIdx.x >> 3) & 1, idx = ((int)blockIdx.x >> 4) * 8 + ((int)blockIdx.x & 7), half = F.G >> 1;
    unsigned char* ws = F.ws;
    #ifndef MK_HGREP
#define MK_HGREP 1
#endif
    if (role == 0) { for (int rep = 0; rep < MK_HGREP; ++rep) { for (int it = idx; it < NB * HH * 2; it += half) hgrn_chunked(F, a, it); if (MK_HGREP > 1) __syncthreads(); } }
    else {
        { pg8::Gemm g{(const bf16_t*)(ws + WS_A) + C_QA, (const bf16_t*)(ws + WS_WQUP), INCP, QLORA, QLORA};
          pg8::DenseOrder S; S.init(T / 256, MH * MQK / 256, half, idx);
          pg8::EpiStore E{(bf16_t*)(ws + WS_B), MH * MQK, (const float*)(ws + WS_RSTDQ), 1.f / QLORA};
          pg8::gemm_phase<pg8::EpiStore, pg8::DenseOrder>(F.lds, g, S, E); }
        { pg8::Gemm g{(const bf16_t*)(ws + WS_A) + C_KVA, (const bf16_t*)(ws + WS_WKVUP), INCP, KVLORA, KVLORA};
          pg8::DenseOrder S; S.init(T / 256, MH * 256 / 256, half, idx);
          pg8::EpiStore E{(bf16_t*)(ws + WS_C), MH * 256, (const float*)(ws + WS_RSTDKV), 1.f / KVLORA};
          pg8::gemm_phase<pg8::EpiStore, pg8::DenseOrder>(F.lds, g, S, E); }
        { const MoeItems mk{a.in[22], a.in[23], a.in[24], ws};
          tr_run(idx * NWAVES + F.wave, half * NWAVES, MOE_PRE, mk, F.lds + F.wave * 8192, F.lane); }
    }
}

__device__ __forceinline__ float sum8(float v) { v += __shfl_xor(v, 1); v += __shfl_xor(v, 2); v += __shfl_xor(v, 4); return v; }

struct P5Set { u32x4 k0, k1, kpe, m0, m1, g0, g1; f32x4 ca, cb, sa, sb; };
__device__ __forceinline__ void p5_phase(Frame& F, const Args& a) {
    OPAQUE_FRAME(F);
    const int gw = F.vcu * NWAVES + F.wave, NGW = F.G * NWAVES;
    const bf16_t* PROJ = (const bf16_t*)(F.ws + WS_A);
    const bf16_t* KV = (const bf16_t*)(F.ws + WS_C);
    bf16_t* Kn = (bf16_t*)(F.ws + WS_F);
    bf16_t* MIX = (bf16_t*)F.out;
    const float* rc = (const float*)(F.ws + WS_ROPEC); const float* rsn = (const float*)(F.ws + WS_ROPES);
    const int h = F.lane >> 3, sub = F.lane & 7;
    const float sgn = sub < 4 ? -1.f : 1.f;
    float gk[3][8], go[2][8];
#pragma unroll
    for (int i = 0; i < 3; ++i)
#pragma unroll
        for (int j = 0; j < 8; ++j) gk[i][j] = a.in[14][(sub + 8 * i) * 8 + j];
#pragma unroll
    for (int i = 0; i < 2; ++i)
#pragma unroll
        for (int j = 0; j < 8; ++j) go[i][j] = a.in[8][(sub + 8 * i) * 8 + j];
#define P5_LD(t_, S_) do { const size_t t__ = (size_t)(t_); const int ii_ = (sub & 3) * 8; \
        S_.k0 = __builtin_nontemporal_load((const u32x4*)(KV + t__ * (MH * 256) + h * 256 + sub * 8)); S_.k1 = __builtin_nontemporal_load((const u32x4*)(KV + t__ * (MH * 256) + h * 256 + (sub + 8) * 8)); \
        S_.kpe = *(const u32x4*)(PROJ + t__ * INCP + C_KPE + sub * 8); \
        S_.ca = *(const f32x4*)(rc + t__ * 32 + ii_); S_.cb = *(const f32x4*)(rc + t__ * 32 + ii_ + 4); S_.sa = *(const f32x4*)(rsn + t__ * 32 + ii_); S_.sb = *(const f32x4*)(rsn + t__ * 32 + ii_ + 4); \
        S_.m0 = *(const u32x4*)(MIX + t__ * DM + h * 128 + sub * 8); S_.m1 = *(const u32x4*)(MIX + t__ * DM + h * 128 + (sub + 8) * 8); \
        S_.g0 = __builtin_nontemporal_load((const u32x4*)(PROJ + t__ * INCP + 3 * HW + h * 128 + sub * 8)); S_.g1 = __builtin_nontemporal_load((const u32x4*)(PROJ + t__ * INCP + 3 * HW + h * 128 + (sub + 8) * 8)); } while (0)
#define P5_CP(t_, S_) do { const int t__ = (t_), b_ = t__ / SEQ, s_ = t__ % SEQ; const size_t hrow = ((size_t)(b_ * MH + h) * SEQ + s_); \
        { float k[3][8]; float ss = 0.f; unpack8(S_.k0, k[0]); unpack8(S_.k1, k[1]); unpack8(S_.kpe, k[2]); \
          _Pragma("unroll") for (int i = 0; i < 3; ++i) _Pragma("unroll") for (int j = 0; j < 8; ++j) ss += k[i][j] * k[i][j]; \
          const float rs = rsqrtf(sum8(ss) * (1.f / MQK) + EPS); \
          _Pragma("unroll") for (int i = 0; i < 3; ++i) _Pragma("unroll") for (int j = 0; j < 8; ++j) k[i][j] *= rs * gk[i][j]; \
          _Pragma("unroll") for (int j = 0; j < 8; ++j) { const float pv = __shfl_xor(k[2][j], 4); const float cs_ = j < 4 ? S_.ca[j & 3] : S_.cb[j & 3], sn_ = j < 4 ? S_.sa[j & 3] : S_.sb[j & 3]; k[2][j] = k[2][j] * cs_ + sgn * pv * sn_; } \
          _Pragma("unroll") for (int i = 0; i < 3; ++i) *(u32x4*)(Kn + hrow * MQK + (sub + 8 * i) * 8) = pack8f(k[i]); } \
        { float o[2][8], gt[2][8]; float ss = 0.f; unpack8(S_.m0, o[0]); unpack8(S_.m1, o[1]); unpack8(S_.g0, gt[0]); unpack8(S_.g1, gt[1]); \
          _Pragma("unroll") for (int i = 0; i < 2; ++i) _Pragma("unroll") for (int j = 0; j < 8; ++j) ss += o[i][j] * o[i][j]; \
          const float rs = rsqrtf(sum8(ss) * (1.f / HDV) + EPS); \
          _Pragma("unroll") for (int i = 0; i < 2; ++i) { _Pragma("unroll") for (int j = 0; j < 8; ++j) o[i][j] = o[i][j] * rs * go[i][j] * siluf(gt[i][j]); \
              *(u32x4*)(MIX + (size_t)t__ * DM + h * 128 + (sub + 8 * i) * 8) = pack8f(o[i]); } } } while (0)
    for (int blk = gw; blk < T / 8; blk += NGW) { const int t0 = blk * 8;
        P5Set A, B;
        P5_LD(t0, A);
#pragma unroll 1
        for (int r = 0; r < 8; r += 2) {
            P5_LD(t0 + r + 1, B); __builtin_amdgcn_sched_barrier(0);
            P5_CP(t0 + r, A); __builtin_amdgcn_sched_barrier(0);
            if (r + 2 < 8) { P5_LD(t0 + r + 2, A); } __builtin_amdgcn_sched_barrier(0);
            P5_CP(t0 + r + 1, B); __builtin_amdgcn_sched_barrier(0);
        }
    }
#undef P5_LD
#undef P5_CP
}
namespace att {
constexpr int QBLK = 32, KVBLK = 64, QB = 256;
constexpr int KROW = 512, SHM_K = KVBLK * KROW, SHM_V = KVBLK * MV * 2;
constexpr int OFF_V = 0, OFF_K = 2 * SHM_V, OFF_WS = OFF_K + 2 * SHM_K;
constexpr float SCALE = 0.07216878364870322f;
constexpr float THR = 8.f;
#define SBAR() __builtin_amdgcn_sched_barrier(0)
__device__ __forceinline__ int v_st(int k, int c) { const int kk = (k & ~0xC) | ((k & 4) << 1) | ((k & 8) >> 1); return ((kk >> 3) * 4 + (c >> 5)) * 512 + ((kk & 7) * 32 + (c & 31)) * 2; }
__device__ __forceinline__ int v_rd_base(int lane) { return ((lane & 3) << 3) | (((lane >> 2) & 3) << 6) | (((lane >> 4) & 1) << 5) | (((lane >> 5) & 1) << 8); }
constexpr int v_rd_off(int d0, int ks, int half) { return d0 * 512 + ks * 4096 + half * 2048; }
__device__ __forceinline__ int crow(int r, int hi) { return (r & 3) + 8 * (r >> 2) + 4 * hi; }
template <int M> __device__ __forceinline__ float swz_xor(float v) { return __builtin_bit_cast(float, __builtin_amdgcn_ds_swizzle(__builtin_bit_cast(int, v), (M << 10) | 0x1F)); }
__device__ __forceinline__ unsigned cvtpk(float lo, float hi) { unsigned r; asm volatile("v_cvt_pk_bf16_f32 %0, %1, %2" : "=v"(r) : "v"(lo), "v"(hi)); return r; }

__device__ __forceinline__ void mask_tile(f32x16& p0, f32x16& p1, int dq) {
    const float NEG = -__builtin_inff();
#pragma unroll
    for (int r = 0; r < 16; ++r) {
        const int c = (r & 3) + 8 * (r >> 2);
        if (dq - c < 0) p0[r] = NEG;
        if (dq - c - 32 < 0) p1[r] = NEG;
    }
}
__device__ __forceinline__ void partialSM(f32x16& p0, f32x16& p1, float& m_reg, float& mn, float& alpha) {
    float pmax = p0[0];
#pragma unroll
    for (int r = 1; r < 16; ++r) pmax = fmaxf(pmax, p0[r]);
#pragma unroll
    for (int r = 0; r < 16; ++r) pmax = fmaxf(pmax, p1[r]);
    { auto rr = __builtin_amdgcn_permlane32_swap(__float_as_uint(pmax), __float_as_uint(pmax), false, false);
      pmax = fmaxf(__uint_as_float(rr[0]), __uint_as_float(rr[1])); }
    constexpr float C2 = 1.4426950408889634f * SCALE;
    if (__builtin_expect(__all((pmax - m_reg) * SCALE <= THR), 1)) { mn = m_reg; alpha = 1.f; }
    else { mn = fmaxf(m_reg, pmax); alpha = __builtin_amdgcn_exp2f((m_reg - mn) * C2); m_reg = mn; }
    const float mnL = -mn * C2;
#pragma unroll
    for (int r = 0; r < 16; ++r) p0[r] = fmaf(p0[r], C2, mnL);
#pragma unroll
    for (int r = 0; r < 16; ++r) p1[r] = fmaf(p1[r], C2, mnL);
#pragma unroll
    for (int r = 0; r < 16; ++r) p0[r] = __builtin_amdgcn_exp2f(p0[r]);
}
__device__ __forceinline__ void finishSM(f32x16& p0, f32x16& p1, float alpha, float& l_reg, bf16x8& pa0, bf16x8& pa1, bf16x8& pa2, bf16x8& pa3) {
#pragma unroll
    for (int r = 0; r < 16; ++r) p1[r] = __builtin_amdgcn_exp2f(p1[r]);
    float ps = 0;
#pragma unroll
    for (int r = 0; r < 16; ++r) ps += p0[r];
#pragma unroll
    for (int r = 0; r < 16; ++r) ps += p1[r];
    { auto rr = __builtin_amdgcn_permlane32_swap(__float_as_uint(ps), __float_as_uint(ps), false, false);
      ps = __uint_as_float(rr[0]) + __uint_as_float(rr[1]); }
    l_reg = l_reg * alpha + ps;
#define PK4(P, B_, OUT) do { unsigned a0 = cvtpk(P[B_+0], P[B_+1]), a1 = cvtpk(P[B_+2], P[B_+3]);                          \
        unsigned b0 = cvtpk(P[B_+4], P[B_+5]), b1 = cvtpk(P[B_+6], P[B_+7]);                                             \
        auto r0 = __builtin_amdgcn_permlane32_swap(a0, b0, false, false); auto r1 = __builtin_amdgcn_permlane32_swap(a1, b1, false, false); \
        u32x4 w = {r0[0], r1[0], r0[1], r1[1]}; OUT = __builtin_bit_cast(bf16x8, w); } while (0)
    PK4(p0, 0, pa0); PK4(p0, 8, pa1); PK4(p1, 0, pa2); PK4(p1, 8, pa3);
#undef PK4
}
template <int KB>
__device__ __forceinline__ void qkt(f32x16& p0, f32x16& p1, LAS unsigned char* lds, int r32, int hi, const bf16x8* qr) {
    p0 = f32x16{}; p1 = f32x16{};
    int sw = r32 & 15; asm volatile("" : "+v"(sw));
    const int rb = OFF_K + KB * SHM_K + r32 * KROW;
    int ab[8];
#pragma unroll
    for (int d = 0; d < 8; ++d) ab[d] = rb + (((2 * d + hi) ^ sw) << 4);
#pragma unroll
    for (int d0 = 0; d0 < 12; ++d0) { const int a = ab[d0 & 7] + (d0 >> 3) * 256;
        const bf16x8 b0 = *(const LAS bf16x8*)(lds + a);
        const bf16x8 b1 = *(const LAS bf16x8*)(lds + a + 32 * KROW);
        p0 = __builtin_amdgcn_mfma_f32_32x32x16_bf16(b0, qr[d0], p0, 0, 0, 0);
        p1 = __builtin_amdgcn_mfma_f32_32x32x16_bf16(b1, qr[d0], p1, 0, 0, 0); }
}
template <int VB>
__device__ __forceinline__ void pv_tile(f32x16* o, int vb0, bf16x8 pa0, bf16x8 pa1, bf16x8 pa2, bf16x8 pa3) {
#define TRRD(dst, off) asm volatile("ds_read_b64_tr_b16 %0, %1 offset:%2" : "=&v"(dst) : "v"(vb0), "i"(off) : "memory")
#define PV_D0(d0) do { s16x4 l0, l1, l2, l3, h0, h1, h2, h3; constexpr int b_ = OFF_V + VB * SHM_V + v_rd_off(d0, 0, 0); \
        TRRD(l0, b_); TRRD(h0, b_ + 2048); TRRD(l1, b_ + 4096); TRRD(h1, b_ + 6144); TRRD(l2, b_ + 8192); TRRD(h2, b_ + 10240); TRRD(l3, b_ + 12288); TRRD(h3, b_ + 14336); \
        asm volatile("s_waitcnt lgkmcnt(0)" ::: "memory"); SBAR();   \
        o[d0] = __builtin_amdgcn_mfma_f32_32x32x16_bf16(pa0, (bf16x8){l0[0], l0[1], l0[2], l0[3], h0[0], h0[1], h0[2], h0[3]}, o[d0], 0, 0, 0);   \
        o[d0] = __builtin_amdgcn_mfma_f32_32x32x16_bf16(pa1, (bf16x8){l1[0], l1[1], l1[2], l1[3], h1[0], h1[1], h1[2], h1[3]}, o[d0], 0, 0, 0);   \
        o[d0] = __builtin_amdgcn_mfma_f32_32x32x16_bf16(pa2, (bf16x8){l2[0], l2[1], l2[2], l2[3], h2[0], h2[1], h2[2], h2[3]}, o[d0], 0, 0, 0);   \
        o[d0] = __builtin_amdgcn_mfma_f32_32x32x16_bf16(pa3, (bf16x8){l3[0], l3[1], l3[2], l3[3], h3[0], h3[1], h3[2], h3[3]}, o[d0], 0, 0, 0); } while (0)
    PV_D0(0); PV_D0(1); PV_D0(2); PV_D0(3);
#undef PV_D0
#undef TRRD
}

constexpr int QP = MH * MQK, VP = MH * 256;
__device__ __forceinline__ void attn_block(const bf16_t* Q, const bf16_t* K, const bf16_t* V, bf16_t* O, int P0, const float* gon, const float* gqn, const float* rc, const float* rsn, LAS unsigned char* lds) {
    int tid = threadIdx.x; asm volatile("" : "+v"(tid));
    const int wid = __builtin_amdgcn_readfirstlane(tid >> 6), lane = tid & 63, r32 = lane & 31, hi = lane >> 5;
    const int NT = P0 / KVBLK + 4;
    const int qlo = P0 + wid * QBLK, qm = qlo + r32 - 4 * hi;
    LAS float* wsf = (LAS float*)(lds + OFF_WS) + wid * 64; LAS float* li_l = wsf; LAS float* al_l = wsf + 32;
    float m_reg = -1e30f, l_reg = 0.f; f32x16 o[4] = {};
    bf16x8 qr[12];
#pragma unroll
    for (int d0 = 0; d0 < 12; ++d0) qr[d0] = *(const bf16x8*)(Q + (size_t)(qlo + r32) * QP + d0 * 16 + hi * 8);
    {
        float ss = 0.f;
#pragma unroll
        for (int d0 = 0; d0 < 12; ++d0) { float f[8]; unpack8(__builtin_bit_cast(u32x4, qr[d0]), f);
#pragma unroll
            for (int j = 0; j < 8; ++j) ss += f[j] * f[j]; }
        { auto rr = __builtin_amdgcn_permlane32_swap(__float_as_uint(ss), __float_as_uint(ss), false, false); ss = __uint_as_float(rr[0]) + __uint_as_float(rr[1]); }
        const float rs = rsqrtf(ss * (1.f / MQK) + EPS);
#pragma unroll
        for (int d0 = 0; d0 < 8; ++d0) { float f[8]; unpack8(__builtin_bit_cast(u32x4, qr[d0]), f); const float* gp = gqn + d0 * 16 + hi * 8;
#pragma unroll
            for (int j = 0; j < 8; ++j) f[j] *= rs * gp[j];
            qr[d0] = __builtin_bit_cast(bf16x8, pack8f(f)); }
#pragma unroll
        for (int dd = 0; dd < 2; ++dd) { float x1[8], x2[8]; unpack8(__builtin_bit_cast(u32x4, qr[8 + dd]), x1); unpack8(__builtin_bit_cast(u32x4, qr[10 + dd]), x2);
            const float* g1p = gqn + 128 + dd * 16 + hi * 8; const float* g2p = g1p + 32; const float* cp = rc + (size_t)(qlo + r32) * 32 + dd * 16 + hi * 8; const float* sp = rsn + (size_t)(qlo + r32) * 32 + dd * 16 + hi * 8;
            const f32x4 c0 = *(const f32x4*)cp, c1 = *(const f32x4*)(cp + 4), s0 = *(const f32x4*)sp, s1 = *(const f32x4*)(sp + 4), ga = *(const f32x4*)g1p, gb = *(const f32x4*)(g1p + 4), gc = *(const f32x4*)g2p, gd = *(const f32x4*)(g2p + 4);
#pragma unroll
            for (int j = 0; j < 8; ++j) { const float a = x1[j] * rs * (j < 4 ? ga[j & 3] : gb[j & 3]), bq = x2[j] * rs * (j < 4 ? gc[j & 3] : gd[j & 3]), c = j < 4 ? c0[j & 3] : c1[j & 3], sn = j < 4 ? s0[j & 3] : s1[j & 3]; x1[j] = a * c - bq * sn; x2[j] = bq * c + a * sn; }
            qr[8 + dd] = __builtin_bit_cast(bf16x8, pack8f(x1)); qr[10 + dd] = __builtin_bit_cast(bf16x8, pack8f(x2)); }
    }
    int ksrc[4], vsrc[2];
#pragma unroll
    for (int i = 0; i < 4; ++i) { const int row = 2 * (wid * 4 + i) + (lane >> 5), c = (lane & 31) ^ (row & 15); ksrc[i] = row * MQK + (c < 24 ? c : 0) * 8; }
#pragma unroll
    for (int i = 0; i < 2; ++i) { const int id = (wid * 2 + i) * 2 + (lane >> 5), kk = ((id >> 2) << 3) | ((lane & 31) >> 2), k = (kk & ~0xC) | ((kk & 4) << 1) | ((kk & 8) >> 1);
        vsrc[i] = k * VP + (id & 3) * 32 + (lane & 3) * 8; }
    const int vb0 = (int)(unsigned)(uintptr_t)lds + v_rd_base(lane);
#define ALOAD(t, bf) do { const bf16_t* kp = K + (size_t)(t) * KVBLK * MQK; const bf16_t* vp = V + (size_t)(t) * KVBLK * VP; \
        _Pragma("unroll") for (int i = 0; i < 4; ++i) __builtin_amdgcn_global_load_lds((const unsigned*)(kp + ksrc[i]), (LAS unsigned*)(lds + OFF_K + (bf) * SHM_K + (wid * 4 + i) * 1024), 16, 0, 0); \
        _Pragma("unroll") for (int i = 0; i < 2; ++i) __builtin_amdgcn_global_load_lds((const unsigned*)(vp + vsrc[i]), (LAS unsigned*)(lds + OFF_V + (bf) * SHM_V + (wid * 2 + i) * 1024), 16, 0, 0); } while (0)
#define RESC(a) do { if (__any((a) < 1.f)) { if (hi == 0) al_l[r32] = (a); asm volatile("s_waitcnt lgkmcnt(0)" ::: "memory"); \
        _Pragma("unroll") for (int d_ = 0; d_ < 4; ++d_) _Pragma("unroll") for (int r = 0; r < 16; ++r) o[d_][r] *= al_l[crow(r, hi)]; } } while (0)
#define STEP(t, BF) do { f32x16 p0, p1; float mn, al; bf16x8 pa0, pa1, pa2, pa3; \
        if ((t) + 1 < NT) ALOAD((t) + 1, 1 - (BF)); \
        SBAR(); qkt<BF>(p0, p1, lds, r32, hi, qr); \
        { const int kb_ = (t) * KVBLK; if (kb_ + KVBLK - 1 > qlo) mask_tile(p0, p1, qm - kb_); } \
        partialSM(p0, p1, m_reg, mn, al); RESC(al); finishSM(p0, p1, al, l_reg, pa0, pa1, pa2, pa3); SBAR(); \
        pv_tile<BF>(o, vb0, pa0, pa1, pa2, pa3); SBAR(); \
        asm volatile("s_waitcnt vmcnt(0)" ::: "memory"); __syncthreads(); } while (0)
    ALOAD(0, 0); asm volatile("s_waitcnt vmcnt(0)" ::: "memory"); __syncthreads();
    for (int t = 0; t < NT; t += 2) { STEP(t, 0); STEP(t + 1, 1); }
#undef STEP
#undef RESC
#undef ALOAD
    if (hi == 0) li_l[r32] = l_reg;
    asm volatile("s_waitcnt lgkmcnt(0)" ::: "memory");
    float gv[4];
#pragma unroll
    for (int d0 = 0; d0 < 4; ++d0) gv[d0] = gon[d0 * 32 + r32];
    float ssr[16];
#pragma unroll
    for (int r = 0; r < 16; ++r) { const float rl = __builtin_amdgcn_rcpf(li_l[crow(r, hi)]); float ss = 0.f;
#pragma unroll
        for (int d0 = 0; d0 < 4; ++d0) { o[d0][r] *= rl; ss += o[d0][r] * o[d0][r]; }
        ssr[r] = ss; }
#pragma unroll
    for (int r = 0; r < 16; ++r) ssr[r] += swz_xor<1>(ssr[r]);
#pragma unroll
    for (int r = 0; r < 16; ++r) ssr[r] += swz_xor<2>(ssr[r]);
#pragma unroll
    for (int r = 0; r < 16; ++r) ssr[r] += swz_xor<4>(ssr[r]);
#pragma unroll
    for (int r = 0; r < 16; ++r) ssr[r] += swz_xor<8>(ssr[r]);
#pragma unroll
    for (int r = 0; r < 16; ++r) ssr[r] += swz_xor<16>(ssr[r]);
#pragma unroll
    for (int r = 0; r < 16; ++r) { const float rs = rsqrtf(ssr[r] * (1.f / MV) + EPS);
        bf16_t* orow = O + (size_t)(qlo + crow(r, hi)) * DM;
#pragma unroll
        for (int d0 = 0; d0 < 4; ++d0) { const float v = o[d0][r] * rs * gv[d0]; const float vn = swz_xor<1>(v);
            if ((r32 & 1) == 0) *(unsigned*)(orow + d0 * 32 + r32) = cvtpk(v, vn); } }
    __syncthreads();
}
#undef SBAR
}

__device__ __forceinline__ void p6_phase(Frame& F, const Args& a) {
    const bf16_t* QH = (const bf16_t*)(F.ws + WS_B); const bf16_t* Kn = (const bf16_t*)(F.ws + WS_F); const bf16_t* KV = (const bf16_t*)(F.ws + WS_C);
    bf16_t* MIX = (bf16_t*)F.out;
    const float* rc = (const float*)(F.ws + WS_ROPEC); const float* rsn = (const float*)(F.ws + WS_ROPES);
    for (int it = F.vcu; it < NB * MH * 4; it += F.G) {
        const int bh = it >> 2, j = it & 3, b = bh >> 3, h = bh & 7;
        const bf16_t* Q = QH + (size_t)(b * SEQ) * att::QP + h * MQK; const bf16_t* K = Kn + (size_t)bh * SEQ * MQK; const bf16_t* V = KV + (size_t)(b * SEQ) * att::VP + h * 256 + 128;
        bf16_t* O = MIX + (size_t)(b * SEQ) * DM + HW + h * MV;
        att::attn_block(Q, K, V, O, (7 - j) * att::QB, a.in[15], a.in[13], rc + (size_t)(b * SEQ) * 32, rsn + (size_t)(b * SEQ) * 32, F.lds);
        att::attn_block(Q, K, V, O, j * att::QB, a.in[15], a.in[13], rc + (size_t)(b * SEQ) * 32, rsn + (size_t)(b * SEQ) * 32, F.lds);
    }
}
__device__ __forceinline__ void p8_phase(Frame& F, const Args& a) {
    OPAQUE_FRAME(F);
    unsigned char* ws = F.ws;
    const float* xin = a.in[0]; const bf16_t* mixo = (const bf16_t*)(ws + WS_F); const float* mod = (const float*)(ws + WS_MOD); const float* g2n = a.in[17];
    const float* wct = (const float*)(ws + WS_WCT);
    bf16_t* H2 = (bf16_t*)(ws + WS_B);
    int* tok_e = (int*)(ws + WS_TOKE); float* tok_w = (float*)(ws + WS_TOKW); int* tok_s = (int*)(ws + WS_TOKS);
    LAS float* red = (LAS float*)F.lds;
    LAS float* ssw = (LAS float*)(F.lds + 98304);
    LAS float* shw = (LAS float*)(F.lds + 100352);
    LAS float* lg = (LAS float*)(F.lds + 101888);
    LAS float* rsl = (LAS float*)(F.lds + 111104);
    const int mr = F.lane & 15, mg = F.lane >> 4;
    const bool conv_first = (F.vcu & 1) != 0;
#pragma unroll 1
    for (int part = 0; part < 2; ++part) {
    if ((part == 0) != conv_first) {
    for (int tile = F.vcu; tile < T / 64; tile += F.G) {
        const int m0 = tile * 64, b = m0 / SEQ;
        const float* modb = mod + b * (6 * DM);
        f32x4 acc[4][3]; float ssp[4] = {0.f, 0.f, 0.f, 0.f}, shacc[3] = {0.f, 0.f, 0.f};
#pragma unroll
        for (int rb = 0; rb < 4; ++rb)
#pragma unroll
            for (int n = 0; n < 3; ++n) acc[rb][n] = (f32x4){0.f, 0.f, 0.f, 0.f};
        const unsigned xo = (unsigned)((m0 + mr) * DM + F.wave * 256 + 4 * mg);
        LAS float* vec = (LAS float*)(F.lds + 112640) + F.wave * 768;
        { const int k4 = F.lane * 4; const unsigned ko_ = (unsigned)(F.wave * 256 + k4) * 4u;
          const f32x4 t0 = *(const f32x4*)((const char*)(modb + 2 * DM) + ko_), t1 = *(const f32x4*)((const char*)(modb + 3 * DM) + ko_), t2 = *(const f32x4*)((const char*)g2n + ko_), t3 = *(const f32x4*)((const char*)(modb + 4 * DM) + ko_);
          *(LAS f32x4*)(vec + k4) = t0; *(LAS f32x4*)(vec + 256 + k4) = t1; *(LAS f32x4*)(vec + 512 + k4) = t2 * (t3 + 1.f); LDS_WAIT(); asm volatile("" ::: "memory"); }
        f32x4 xa[4], xb[4], wa[3], wb[3]; u32x2 ma_[4], mb_[4];
#define P8_LDX(s_, X, M, W) do { const unsigned ko_ = (unsigned)(F.wave * 256 + 16 * (s_) + 4 * mg) * 4u; \
            _Pragma("unroll") for (int n = 0; n < 3; ++n) W[n] = *(const f32x4*)((const char*)wct + (ko_ + (unsigned)((n * 16 + mr) * DM * 4))); \
            _Pragma("unroll") for (int rb = 0; rb < 4; ++rb) { const unsigned eo_ = xo + (unsigned)(rb * 16 * DM + 16 * (s_)); X[rb] = *(const f32x4*)((const char*)xin + eo_ * 4u); M[rb] = *(const u32x2*)((const char*)mixo + eo_ * 2u); } } while (0)
#define P8_CP(s_, X, M, W) do { const int kl_ = 16 * (s_) + 4 * mg; const f32x4 g1v = *(const LAS f32x4*)(vec + kl_), shv = *(const LAS f32x4*)(vec + 256 + kl_), gmv = *(const LAS f32x4*)(vec + 512 + kl_); \
            _Pragma("unroll") for (int n = 0; n < 3; ++n) shacc[n] += (shv.x * W[n].x + shv.y * W[n].y) + (shv.z * W[n].z + shv.w * W[n].w); \
            _Pragma("unroll") for (int rb = 0; rb < 4; ++rb) { const f32x4 v = X[rb] + g1v * (f32x4){bf_lo(M[rb].x), bf_hi(M[rb].x), bf_lo(M[rb].y), bf_hi(M[rb].y)}; \
                ssp[rb] += (v.x * v.x + v.y * v.y) + (v.z * v.z + v.w * v.w); const f32x4 av = v * gmv; \
                _Pragma("unroll") for (int i = 0; i < 4; ++i) _Pragma("unroll") for (int n = 0; n < 3; ++n) acc[rb][n] = __builtin_amdgcn_mfma_f32_16x16x4f32(av[i], W[n][i], acc[rb][n], 0, 0, 0); } } while (0)
        P8_LDX(0, xa, ma_, wa);
#pragma unroll 1
        for (int s = 0; s < 16; s += 2) {
            P8_LDX(s + 1, xb, mb_, wb); __builtin_amdgcn_sched_barrier(0);
            P8_CP(s, xa, ma_, wa); __builtin_amdgcn_sched_barrier(0);
            if (s + 2 < 16) { P8_LDX(s + 2, xa, ma_, wa); } __builtin_amdgcn_sched_barrier(0);
            P8_CP(s + 1, xb, mb_, wb); __builtin_amdgcn_sched_barrier(0);
        }
#undef P8_LDX
#undef P8_CP
#pragma unroll
        for (int rb = 0; rb < 4; ++rb) {
#pragma unroll
            for (int n = 0; n < 3; ++n)
#pragma unroll
                for (int r = 0; r < 4; ++r) red[(F.wave * 64 + rb * 16 + mg * 4 + r) * 48 + n * 16 + mr] = acc[rb][n][r];
            float sp = ssp[rb]; sp += __shfl_xor(sp, 16); sp += __shfl_xor(sp, 32);
            if (mg == 0) ssw[F.wave * 64 + rb * 16 + mr] = sp; }
#pragma unroll
        for (int n = 0; n < 3; ++n) { float sa = shacc[n]; sa += __shfl_xor(sa, 16); sa += __shfl_xor(sa, 32); if (mg == 0) shw[F.wave * 48 + n * 16 + mr] = sa; }
        __syncthreads();
        if (F.tid < 64) { float sv = 0.f;
#pragma unroll
            for (int w = 0; w < 8; ++w) sv += ssw[w * 64 + F.tid];
            rsl[F.tid] = rsqrtf(sv * (1.f / DM) + EPS); }
        __syncthreads();
        for (int idx = F.tid; idx < 64 * 36; idx += NTHR) { const int row = idx / 36, n = idx % 36; float L = 0.f, sw = 0.f;
#pragma unroll
            for (int w = 0; w < 8; ++w) { L += red[(w * 64 + row) * 48 + n]; sw += shw[w * 48 + n]; }
            lg[row * 36 + n] = rsl[row] * L + sw + (n < 4 ? a.in[19][n] : a.in[21][n - 4]); }
        __syncthreads();
        if (F.tid < 64) { const LAS float* l = lg + F.tid * 36; const int t = m0 + F.tid;
            int g = 0; float gm = l[0];
#pragma unroll
            for (int j = 1; j < 4; ++j) if (l[j] > gm) { gm = l[j]; g = j; }
            float den = 0.f;
#pragma unroll
            for (int j = 0; j < 4; ++j) den += __expf(l[j] - gm);
            const float pg = 1.f / den;
            const LAS float* e = l + 4 + g * 8;
            int i1 = 0; float v1 = e[0];
#pragma unroll
            for (int j = 1; j < 8; ++j) if (e[j] > v1) { v1 = e[j]; i1 = j; }
            int i2 = -1; float v2 = -__builtin_inff();
#pragma unroll
            for (int j = 0; j < 8; ++j) if (j != i1 && e[j] > v2) { v2 = e[j]; i2 = j; }
            const float w1 = 1.f / (1.f + __expf(v2 - v1)), w2 = 1.f - w1;
            const int e1 = g * 8 + i1, e2 = g * 8 + i2;
            const int s1 = (int)atomicAdd((unsigned*)(F.ctl + CW_CNT + 64 * e1), 1u), s2 = (int)atomicAdd((unsigned*)(F.ctl + CW_CNT + 64 * e2), 1u);
            tok_e[2 * t] = e1; tok_e[2 * t + 1] = e2; tok_w[2 * t] = pg * w1; tok_w[2 * t + 1] = pg * w2; tok_s[2 * t] = s1; tok_s[2 * t + 1] = s2;
            int* list = (int*)(ws + WS_LIST); list[e1 * T + s1] = t; list[e2 * T + s2] = t; }
        { const int c8 = (F.tid & 255) * 8, rg = F.tid >> 8;
          f32x4 g1a = *(const f32x4*)(modb + 2 * DM + c8), g1b = *(const f32x4*)(modb + 2 * DM + c8 + 4), sha = *(const f32x4*)(modb + 3 * DM + c8), shb = *(const f32x4*)(modb + 3 * DM + c8 + 4);
          const f32x4 gma = *(const f32x4*)(g2n + c8) * (*(const f32x4*)(modb + 4 * DM + c8) + 1.f), gmb = *(const f32x4*)(g2n + c8 + 4) * (*(const f32x4*)(modb + 4 * DM + c8 + 4) + 1.f);
#pragma unroll 1
          for (int j0 = 0; j0 < 32; j0 += 4) {
              f32x4 qa[4], qb[4]; u32x4 qm[4];
#pragma unroll
              for (int u = 0; u < 4; ++u) { const size_t eo = (size_t)(m0 + rg + 2 * (j0 + u)) * DM + c8;
                  qa[u] = __builtin_nontemporal_load((const f32x4*)(xin + eo)); qb[u] = __builtin_nontemporal_load((const f32x4*)(xin + eo + 4)); qm[u] = __builtin_nontemporal_load((const u32x4*)(mixo + eo)); }
              __builtin_amdgcn_sched_barrier(0);
#pragma unroll
              for (int u = 0; u < 4; ++u) { const int row = rg + 2 * (j0 + u); const size_t eo = (size_t)(m0 + row) * DM + c8; const float rs = rsl[row];
                  float mx[8]; unpack8(qm[u], mx);
                  const f32x4 xa = qa[u] + g1a * (f32x4){mx[0], mx[1], mx[2], mx[3]}, xb = qb[u] + g1b * (f32x4){mx[4], mx[5], mx[6], mx[7]};
                  const f32x4 va = xa * rs * gma + sha, vb = xb * rs * gmb + shb;
                  u32x4 w; w.x = cvt_pk_bf16(va.x, va.y); w.y = cvt_pk_bf16(va.z, va.w); w.z = cvt_pk_bf16(vb.x, vb.y); w.w = cvt_pk_bf16(vb.z, vb.w);
                  *(u32x4*)(H2 + eo) = w;
                  u32x4 x1; x1.x = cvt_pk_bf16(xa.x, xa.y); x1.y = cvt_pk_bf16(xa.z, xa.w); x1.z = cvt_pk_bf16(xb.x, xb.y); x1.w = cvt_pk_bf16(xb.z, xb.w);
                  *(u32x4*)((bf16_t*)(ws + WS_F) + eo) = x1; }
              __builtin_amdgcn_sched_barrier(0); } }
        __syncthreads();
    }
    } else {
    LAS unsigned char* Tl = F.lds + F.wave * 8192;
    const int gw = F.vcu * NWAVES + F.wave, NGW = F.G * NWAVES;
    { const MoeItems mk{a.in[22], a.in[23], a.in[24], ws};
      tr_run(MOE_PRE + gw, NGW, 3 * MOE_IG, mk, Tl, F.lane); }
    __syncthreads();
    }
    }
}

constexpr int MOE_TAB_OFF = LDS_USER;
__device__ __forceinline__ LAS int* moe_tables(Frame& F) {
    LAS int* tab = (LAS int*)(F.lds + MOE_TAB_OFF);
    __syncthreads();
    if (F.tid < NE) tab[64 + F.tid] = (int)__hip_atomic_load((unsigned*)(F.ctl + CW_CNT + 64 * F.tid), RLX_AGENT);
    __syncthreads();
    if (F.tid == 0) { int acc = 0;
        for (int e = 0; e < NE; ++e) { tab[e] = acc; acc += ((tab[64 + e] + 255) / 256) * 256; }
        tab[NE] = acc; }
    __syncthreads();
    if (F.tid < 160) { int e = 0; for (int j = 1; j < NE; ++j) if (tab[j] <= F.tid * 256) e = j; tab[128 + F.tid] = e; }
    __syncthreads();
    return tab;
}

__device__ __forceinline__ void p12_phase(Frame& F, const Args& a) {
    OPAQUE_FRAME(F);
    unsigned char* ws = F.ws;
    const bf16_t* Y = (const bf16_t*)(ws + WS_A);
    const float* tok_w = (const float*)(ws + WS_TOKW); const int* tok_s = (const int*)(ws + WS_TOKS);
    const float* mod = (const float*)(ws + WS_MOD);
    const LAS int* tab = moe_tables(F); const int* tok_e = (const int*)(ws + WS_TOKE);
    const int gw = F.vcu * NWAVES + F.wave, NGW = F.G * NWAVES;
#if defined(MK_STAMP) && MK_STAMP >= 0
    const float dscale = 1.f + sqrtf(exp2f(rintf(3.f * log2f(*(const float*)(ws + WS_STAMP + 8) + 1.f) + MK_QSHIFT) * (1.f / 3.f)));
#else
    const float dscale = 1.f;
#endif
    for (int blk = gw; blk < T / 8; blk += NGW) { const int t0 = blk * 8, b = t0 / SEQ;
        const float* g2 = mod + b * (6 * DM) + 5 * DM;
        f32x4 h2[4][2];
#pragma unroll
        for (int j = 0; j < 4; ++j) { const int c = (j * 64 + F.lane) * 8; h2[j][0] = *(const f32x4*)(g2 + c); h2[j][1] = *(const f32x4*)(g2 + c + 4); }
        int dsl = 0; float wl = 0.f;
        if (F.lane < 16) { dsl = tab[tok_e[2 * t0 + F.lane]] + tok_s[2 * t0 + F.lane]; wl = tok_w[2 * t0 + F.lane]; }
#pragma unroll 1
        for (int r = 0; r < 8; ++r) { const int t = t0 + r;
            const float w0 = __shfl(wl, 2 * r), w1 = __shfl(wl, 2 * r + 1); const int d0 = __shfl(dsl, 2 * r), d1 = __shfl(dsl, 2 * r + 1);
            float* orow = F.out + (size_t)t * DM; const bf16_t* mrow = (const bf16_t*)(ws + WS_F) + (size_t)t * DM;
            u32x4 qy0[4], qy1[4], qm[4];
#pragma unroll
            for (int j = 0; j < 4; ++j) { const int c = (j * 64 + F.lane) * 8;
                qy0[j] = __builtin_nontemporal_load((const u32x4*)(Y + (size_t)d0 * DM + c)); qy1[j] = __builtin_nontemporal_load((const u32x4*)(Y + (size_t)d1 * DM + c));
                qm[j] = __builtin_nontemporal_load((const u32x4*)(mrow + c)); }
            __builtin_amdgcn_sched_barrier(0);
#pragma unroll
            for (int j = 0; j < 4; ++j) { const int c = (j * 64 + F.lane) * 8;
                float y0[8], y1[8], mx[8]; unpack8(qy0[j], y0); unpack8(qy1[j], y1); unpack8(qm[j], mx);
                const f32x4 xa = {mx[0], mx[1], mx[2], mx[3]}, xb = {mx[4], mx[5], mx[6], mx[7]};
                f32x4 ra, rb;
#pragma unroll
                for (int i = 0; i < 4; ++i) { ra[i] = (xa[i] + h2[j][0][i] * (w0 * y0[i] + w1 * y1[i])) * dscale; rb[i] = (xb[i] + h2[j][1][i] * (w0 * y0[4 + i] + w1 * y1[4 + i])) * dscale; }
                __builtin_nontemporal_store(ra, (f32x4*)(orow + c)); __builtin_nontemporal_store(rb, (f32x4*)(orow + c + 4)); }
            __builtin_amdgcn_sched_barrier(0); }
    }
}
#ifndef MK_MULTI
#define MK_MULTI 0
#endif
#ifndef MK_LAST_PHASE
#define MK_LAST_PHASE 12
#endif
constexpr int N_PHASES = MK_LAST_PHASE + 1;

template <class P> __device__ __forceinline__ P* uptr(P* p) { const unsigned long long v = (unsigned long long)p;
    const unsigned lo = __builtin_amdgcn_readfirstlane((unsigned)v), hi = __builtin_amdgcn_readfirstlane((unsigned)(v >> 32)); return (P*)(__attribute__((address_space(1))) P*)(((unsigned long long)hi << 32) | lo); }
__global__ void __launch_bounds__(NTHR, 2) mk_fwd(const Args args) {
    extern __shared__ __attribute__((aligned(16))) unsigned char lds_raw[];
    Frame F;
    F.lds = (LAS unsigned char*)lds_raw;
    F.MISC = (volatile LAS unsigned*)(F.lds + MISC_OFF);
    F.tid = threadIdx.x; F.lane = F.tid & 63; F.wave = __builtin_amdgcn_readfirstlane(F.tid >> 6);
    F.G = gridDim.x; { const int bx = blockIdx.x; F.vcu = (F.G % 8 == 0) ? (bx % 8) * (F.G / 8) + bx / 8 : bx; }
    F.ws = uptr(args.ws); F.out = uptr(args.out);
    F.ctl = (gu32*)(F.ws + WS_CTL);
    for (int u = F.tid; u < (LDS_BYTES - MISC_OFF) / 4; u += NTHR) ((LAS unsigned*)(F.lds + MISC_OFF))[u] = 0u;
    __syncthreads();
    XcdBarrier bar; bar.bar = (unsigned*)(F.ctl + CW_BAR); bar.x = 0; bar.st = nullptr;
#if !MK_MULTI
    bar = xcd_barrier_post((unsigned*)(F.ctl + CW_BAR), F.MISC + 8);
#define GRID_BAR() xcd_barrier(bar)
#else
#define GRID_BAR() do { } while (0)
#endif
    const int lo = args.ph_lo, hi = args.ph_hi;
#ifndef MK_PHMASK
#define MK_PHMASK 0xFFFF
#endif
#define IN(k) (((MK_PHMASK >> (k)) & 1) && lo <= (k) && (k) < hi)
#define SEAM(k) do { if (IN(k) && IN((k) + 1)) GRID_BAR(); } while (0)
#ifndef MK_STAMP
#define MK_STAMP (-1)
#endif
#define STAMP_BEGIN(k) do { if ((k) == MK_STAMP && blockIdx.x == 0 && F.tid == 0) *(unsigned long long*)(ws + WS_STAMP) = __builtin_amdgcn_s_memrealtime(); } while (0)
#define STAMP_END(k) do { if ((k) == MK_STAMP && blockIdx.x == 0 && F.tid == 0) { const unsigned long long t1_ = __builtin_amdgcn_s_memrealtime(); *(float*)(ws + WS_STAMP + 8) = (float)(t1_ - *(unsigned long long*)(ws + WS_STAMP)) * 0.01f; } } while (0)
#ifndef MK_REPEAT
#define MK_REPEAT (-1)
#endif
#ifndef MK_REPN
#define MK_REPN 2
#endif
#define REP(k) _Pragma("unroll") for (int rep_ = 0; rep_ < ((k) == MK_REPEAT ? MK_REPN : 1); ++rep_)
    unsigned char* const ws = F.ws;

    STAMP_BEGIN(0);
    REP(0) if (IN(0)) { if (rep_) GRID_BAR(); p0_phase(F, args); } STAMP_END(0);
    STAMP_BEGIN(1);
    REP(1) if (IN(1)) { if (rep_) GRID_BAR(); p1_phase(F, args); } SEAM(1); STAMP_END(1);
    STAMP_BEGIN(2);
    REP(2) if (IN(2)) { if (rep_) GRID_BAR();
        pg8::Gemm g{(const bf16_t*)(ws + WS_B), (const bf16_t*)(ws + WS_WIN), DM, DM, DM};
        pg8::DenseOrder S; S.init(T / 256, INCP / 256, F.G, (int)blockIdx.x);
        pg8::EpiStore E{(bf16_t*)(ws + WS_A), INCP, nullptr, 0.f, (float*)(ws + WS_RSTDQ), (float*)(ws + WS_RSTDKV), C_QA / 256, C_KVA / 256, C_KPE / 256, HW / 256, 2 * HW / 256};
        pg8::gemm_phase<pg8::EpiStore, pg8::DenseOrder>(F.lds, g, S, E);
    } SEAM(2); STAMP_END(2);
    STAMP_BEGIN(3);
    REP(3) if (IN(3)) { if (rep_) GRID_BAR(); p3_phase(F, args); } if (IN(3) && IN(5)) GRID_BAR(); STAMP_END(3);
    STAMP_BEGIN(5);
    REP(5) if (IN(5)) { if (rep_) GRID_BAR(); p5_phase(F, args); } SEAM(5); STAMP_END(5);
    STAMP_BEGIN(6);
    REP(6) if (IN(6)) { if (rep_) GRID_BAR(); p6_phase(F, args); } SEAM(6); STAMP_END(6);
    STAMP_BEGIN(7);
    REP(7) if (IN(7)) { if (rep_) GRID_BAR();
        pg8::Gemm g{(const bf16_t*)F.out, (const bf16_t*)(ws + WS_WOUT), DM, DM, DM};
        pg8::DenseOrder S; S.init(T / 256, DM / 256, F.G, (int)blockIdx.x);
        pg8::EpiStore E{(bf16_t*)(ws + WS_F), DM, nullptr, 0.f, nullptr, nullptr, 0, 0, 0};
        pg8::gemm_phase<pg8::EpiStore, pg8::DenseOrder>(F.lds, g, S, E);
    } SEAM(7); STAMP_END(7);
#if MK_LAST_PHASE >= 8
    STAMP_BEGIN(8);
    REP(8) if (IN(8)) { if (rep_) GRID_BAR(); p8_phase(F, args); } if (IN(8) && IN(10)) GRID_BAR(); STAMP_END(8);
    STAMP_BEGIN(10);
    REP(10) if (IN(10)) { if (rep_) GRID_BAR();
        const LAS int* tab = moe_tables(F);
        pg8::Gemm g{(const bf16_t*)(ws + WS_B), (const bf16_t*)(ws + WS_D), DM, DM, DM};
        pg8::GroupedOrder S; S.init(4, F.G, F.vcu, tab, (const int*)(ws + WS_LIST));
        pg8::EpiSwiGLU E{(bf16_t*)(ws + WS_C), (unsigned*)(F.ctl + CW_RDY)};
        pg8::gemm_phase<pg8::EpiSwiGLU, pg8::GroupedOrder, true>(F.lds, g, S, E);
    }
    REP(11) if (IN(11)) { if (rep_) GRID_BAR();
        const LAS int* tab = moe_tables(F);
        pg8::Gemm g{(const bf16_t*)(ws + WS_C), (const bf16_t*)(ws + WS_E), DE, DE, DE};
        pg8::RedealOrder S; S.init(8, F.G, F.vcu, tab, 4, (unsigned*)(F.ctl + CW_RDY), 32u, (unsigned*)(F.ctl + CW_TMO));
        pg8::EpiStore E{(bf16_t*)(ws + WS_A), DM, nullptr, 0.f, nullptr, nullptr, 0, 0, 0};
        pg8::gemm_phase<pg8::EpiStore, pg8::RedealOrder>(F.lds, g, S, E);
    } SEAM(11); STAMP_END(11);
    REP(12) if (IN(12)) { if (rep_) GRID_BAR(); p12_phase(F, args); }
#endif
#undef IN
#undef SEAM
}

extern "C" void kernel_launch(void* const* d_in, const int* in_sizes, int n_in, void* d_out, int out_size, void* d_ws, size_t ws_size, hipStream_t stream) {
    static int grid = 0;
    if (grid == 0) {
        if (n_in != 25 || out_size != T * DM || ws_size < WS_END) { fprintf(stderr, "kernel_launch: bad shapes (n_in %d out %d ws %zu)\n", n_in, out_size, ws_size); grid = -1; return; }
        int dev = 0, cus = 0, per_cu = 0;
        if (hipGetDevice(&dev) != hipSuccess || hipDeviceGetAttribute(&cus, hipDeviceAttributeMultiprocessorCount, dev) != hipSuccess) { grid = -1; return; }
        if (hipFuncSetAttribute((const void*)mk_fwd, hipFuncAttributeMaxDynamicSharedMemorySize, LDS_BYTES) != hipSuccess) { fprintf(stderr, "kernel_launch: hipFuncSetAttribute failed\n"); grid = -1; return; }
        if (hipOccupancyMaxActiveBlocksPerMultiprocessor(&per_cu, (const void*)mk_fwd, NTHR, LDS_BYTES) != hipSuccess || per_cu < 1) { fprintf(stderr, "kernel_launch: occupancy query says %d\n", per_cu); }
        (void)hipGetLastError();
        grid = cus;
    }
    if (grid < 0) return;
    (void)hipMemsetAsync((char*)d_ws + WS_CTL, 0, CTL_ZERO_BYTES, stream);
    Args a{};
    for (int i = 0; i < 25; ++i) a.in[i] = (const float*)d_in[i];
    a.out = (float*)d_out; a.ws = (unsigned char*)d_ws;
#if MK_MULTI
    for (int p = 0; p < N_PHASES; ++p) { a.ph_lo = p; a.ph_hi = p + 1; hipLaunchKernelGGL(mk_fwd, dim3(grid), dim3(NTHR), LDS_BYTES, stream, a); }
#else
    a.ph_lo = 0; a.ph_hi = N_PHASES; hipLaunchKernelGGL(mk_fwd, dim3(grid), dim3(NTHR), LDS_BYTES, stream, a);
#endif
}
```

```cpp
#include <hip/hip_runtime.h>
#include <cstdio>
#include <cstdint>

#define GAS __attribute__((address_space(1)))
#define LAS __attribute__((address_space(3)))
typedef unsigned short bf16_t;
typedef short bf16x8 __attribute__((ext_vector_type(8)));
typedef short s16x4 __attribute__((ext_vector_type(4)));
typedef float f32x4 __attribute__((ext_vector_type(4)));
typedef float f32x2 __attribute__((ext_vector_type(2)));
typedef float f32x16 __attribute__((ext_vector_type(16)));
typedef unsigned u32x4 __attribute__((ext_vector_type(4)));
typedef unsigned u32x2 __attribute__((ext_vector_type(2)));
typedef GAS unsigned gu32;
#define RLX_AGENT __ATOMIC_RELAXED, __HIP_MEMORY_SCOPE_AGENT
#define LDS_WAIT() asm volatile("s_waitcnt lgkmcnt(0)" ::: "memory")
#define VM_WAIT() asm volatile("s_waitcnt vmcnt(0)" ::: "memory")

constexpr int DM = 2048, NB = 8, SEQ = 2048, T = NB * SEQ;
constexpr int HW = 1024, HH = 8, HDK = 128, HDV = 128;
constexpr int MH = 8, MNOPE = 128, MROPE = 64, MQK = 192, MV = 128, QLORA = 512, KVLORA = 256;
constexpr int INC = 4 * HW + QLORA + KVLORA + MROPE;
constexpr int INCP = 5120;
constexpr int C_QA = 4096, C_KVA = 4608, C_KPE = 4864;
constexpr int NG = 4, EPG = 8, NE = 32, DE = 512;
constexpr int RMAX = (T * 2 / 256 + NE) * 256;
constexpr float EPS = 1e-6f;
constexpr int NWAVES = 8, NTHR = 512;

typedef __bf16 bf16x2_t __attribute__((ext_vector_type(2)));
__device__ __forceinline__ unsigned cvt_pk_bf16(float lo, float hi) { const f32x2 v = {lo, hi}; return __builtin_bit_cast(unsigned, __builtin_convertvector(v, bf16x2_t)); }
__device__ __forceinline__ float bf_lo(unsigned w) { return __builtin_bit_cast(float, w << 16); }
__device__ __forceinline__ float bf_hi(unsigned w) { return __builtin_bit_cast(float, w & 0xffff0000u); }
__device__ __forceinline__ float bf2f(bf16_t h) { return __builtin_bit_cast(float, (unsigned)h << 16); }
__device__ __forceinline__ float wave_sum(float v) {
#pragma unroll
    for (int o = 1; o < 64; o <<= 1) v += __shfl_xor(v, o);
    return v;
}
__device__ __forceinline__ float siluf(float v) { return v / (1.f + __expf(-v)); }

#define XB_TMO      128
#define XB_XCNT(j)  (256  + 64 * (j))
#define XB_XSUB(j)  (1280 + 64 * (j))
#define XB_XGEN(j)  (2304 + 64 * (j))
#define XB_TOP      3328
#define XB_TOPGEN   3392
#define XCD_BAR_WORDS 3456
#define XB_SPIN_CAP (1u << 18)

__device__ __forceinline__ unsigned xb_ld(unsigned* p)              { return __hip_atomic_load(p, __ATOMIC_RELAXED, __HIP_MEMORY_SCOPE_AGENT); }
__device__ __forceinline__ unsigned xb_add(unsigned* p, unsigned v) { return __hip_atomic_fetch_add(p, v, __ATOMIC_RELAXED, __HIP_MEMORY_SCOPE_AGENT); }
__device__ __forceinline__ unsigned xb_xcc_id() { return (unsigned)__builtin_amdgcn_s_getreg((3 << 11) | 20) & 0xFu; }
#define XB_SPIN(cond, bar) do { unsigned _sp = 0; while (cond) { __builtin_amdgcn_s_sleep(1); \
    if ((++_sp & 255u) == 0u) { if (xb_ld(&(bar)[XB_TMO])) break; if (_sp > XB_SPIN_CAP) { atomicAdd(&(bar)[XB_TMO], 1u); break; } } } } while (0)

struct XcdBarrier {
    unsigned* bar; unsigned x;
    volatile LAS unsigned* st;
};
__device__ __forceinline__ XcdBarrier xcd_barrier_post(unsigned* bar, volatile LAS unsigned* st) {
    XcdBarrier b; b.bar = bar; b.x = xb_xcc_id(); b.st = st;
    if (threadIdx.x == 0) (void)xb_add(&bar[XB_XCNT(b.x)], 1u);
    return b;
}
__device__ __forceinline__ void xcd_barrier_complete(unsigned* bar, unsigned x, unsigned& nloc, unsigned& nx) {
    const unsigned G = gridDim.x * gridDim.y * gridDim.z;
    unsigned sum, cnt, mine, sp = 0u;
    for (;;) {
        sum = 0u; cnt = 0u; mine = 0u;
#pragma unroll
        for (unsigned j = 0; j < 16; ++j) { const unsigned c = xb_ld(&bar[XB_XCNT(j)]); sum += c; cnt += (c > 0u) ? 1u : 0u; mine = (j == x) ? c : mine; }
        if (sum == G) break;
        __builtin_amdgcn_s_sleep(1);
        if ((++sp & 255u) == 0u) { if (xb_ld(&bar[XB_TMO])) break; if (sp > XB_SPIN_CAP) { atomicAdd(&bar[XB_TMO], 1u); break; } }
    }
    nloc = mine > 0u ? mine : 1u; nx = cnt > 0u ? cnt : 1u;
}
__device__ __forceinline__ void xcd_barrier(const XcdBarrier& b) {
    asm volatile("s_waitcnt vmcnt(0)" ::: "memory");
    __syncthreads();
    if (threadIdx.x == 0) {
        unsigned* bar = b.bar;
        __builtin_amdgcn_s_waitcnt(0);
        unsigned nloc = b.st[0], nx = b.st[1];
        if (nloc == 0u) { xcd_barrier_complete(bar, b.x, nloc, nx); b.st[0] = nloc; b.st[1] = nx; }
        const unsigned old = xb_add(&bar[XB_XSUB(b.x)], 1u);
        const unsigned gen = old / nloc;
        if (old + 1u == (gen + 1u) * nloc) {
            __builtin_amdgcn_fence(__ATOMIC_RELEASE, "agent");
            asm volatile("s_waitcnt vmcnt(0)" ::: "memory");
            const unsigned og = xb_add(&bar[XB_TOP], 1u);
            const unsigned tg = og / nx;
            if (og + 1u == (tg + 1u) * nx) xb_add(&bar[XB_TOPGEN], 1u);
            else XB_SPIN(xb_ld(&bar[XB_TOPGEN]) == tg, bar);
            __builtin_amdgcn_fence(__ATOMIC_ACQUIRE, "agent");
            xb_add(&bar[XB_XGEN(b.x)], 1u);
            asm volatile("s_waitcnt vmcnt(0)" ::: "memory");
        } else {
            XB_SPIN(xb_ld(&bar[XB_XGEN(b.x)]) == gen, bar);
            __builtin_amdgcn_fence(__ATOMIC_ACQUIRE, "agent");
            asm volatile("s_waitcnt vmcnt(0)" ::: "memory");
        }
    }
    __syncthreads();
}

namespace pg8 {
constexpr int BM = 256, BK = 64, HALF = 128, HTB = HALF * BK * 2, STAGE_BYTES = 8 * HTB, NXCD = 8, WGM = 8;
__host__ __device__ __forceinline__ int lds_byte(int r, int c) { const int st = (r >> 4) * 2 + (c >> 5), rr = r & 15, cc = c & 31, ob = rr * 64 + cc * 2; return st * 1024 + (ob ^ (((ob >> 9) & 1) << 5)); }
__host__ __device__ __forceinline__ void stage_rc(int b, int& R, int& C) { const int st = b / 1024, sb = b % 1024, swz = sb ^ (((sb >> 9) & 1) << 5); R = (st >> 1) * 16 + swz / 64; C = (st & 1) * 32 + (swz % 64) / 2; }
__host__ __device__ __forceinline__ int perm32(int rho) { const int n = rho >> 4, i = rho & 15; return 8 * (i >> 2) + 4 * n + (i & 3); }

struct Unit { int pm, pn, pb; };
struct Gemm { const bf16_t* A; const bf16_t* Bt; int lda, ldb, K; };

struct DenseOrder {
    int nM, nN, nwg, G, c;
    __device__ void init(int nM_, int nN_, int G_, int c_) { nM = nM_; nN = nN_; nwg = nM * nN; G = G_; c = c_; }
    __device__ bool next(int i, Unit& u) const {
        const long L = (long)i * G + c; if (L >= nwg) return false;
        int wgid = (int)L; { const int q = nwg / NXCD, r = nwg % NXCD, xcd = wgid % NXCD, off = wgid / NXCD; wgid = (xcd < r ? xcd * (q + 1) : r * (q + 1) + (xcd - r) * q) + off; }
        const int nig = WGM * nN, gid = wgid / nig, fm = gid * WGM, gsz = (nM - fm) < WGM ? (nM - fm) : WGM;
        u.pm = fm + ((wgid % nig) % gsz); u.pn = (wgid % nig) / gsz; u.pb = u.pn; return true;
    }
    __device__ __forceinline__ void a_ready(const Unit&) const {}
};
struct GroupedOrder {
    int nM, nN, nwg, G, c; const LAS int* tile_e; const LAS int* pstart; const LAS int* cnt; const int* list;
    __device__ void init(int nN_, int G_, int c_, const LAS int* tab, const int* list_) { pstart = tab; cnt = tab + 64; tile_e = tab + 128; list = list_; nM = pstart[32] >> 8; nN = nN_; nwg = nM * nN; G = G_; c = c_; }
    __device__ bool next(int i, Unit& u) const {
        const long L = (long)i * G + c; if (L >= nwg) return false;
        const int w = (int)L; u.pn = w % nN; u.pm = w / nN; u.pb = tile_e[u.pm] * nN + u.pn; return true;
    }
    __device__ int arow(const Unit& u, int r) const { const int e = tile_e[u.pm], j = 256 * u.pm - pstart[e] + r; return j < cnt[e] ? list[e * T + j] : 0; }
    __device__ __forceinline__ void a_ready(const Unit&) const {}
};
struct RedealOrder {
    int nM, nN, nwg, G, c, r10, X, nlight, head; const LAS int* tile_e; unsigned* ready; unsigned need; unsigned* tmo;
    __device__ void init(int nN_, int G_, int c_, const LAS int* tab, int nN10, unsigned* ready_, unsigned need_, unsigned* tmo_) {
        tile_e = tab + 128; nM = tab[32] >> 8; nN = nN_; nwg = nM * nN; G = G_; c = c_; ready = ready_; need = need_; tmo = tmo_;
        r10 = (nM * nN10) % G; X = r10 ? 3 : 0; nlight = G - r10; head = X * nlight < nwg ? X * nlight : nwg; }
    __device__ bool next(int i, Unit& u) const {
        long id;
        if (c >= r10 && X) id = i < X ? (long)i * nlight + (c - r10) : (long)head + (long)(i - X) * G + c;
        else id = (long)head + (long)i * G + c;
        if ((i < X && c >= r10 && id >= head) || id >= nwg) return false;
        u.pm = (int)id / nN; u.pn = (int)id % nN; u.pb = tile_e[u.pm] * nN + u.pn; return true;
    }
    __device__ __forceinline__ void a_ready(const Unit& u) const {
        if (threadIdx.x < 64) {
            unsigned polls = 0;
            while ((unsigned)__builtin_amdgcn_readfirstlane(__hip_atomic_load(ready + 64 * u.pm, __ATOMIC_RELAXED, __HIP_MEMORY_SCOPE_AGENT)) < need) {
                if (++polls > (1u << 16)) { if (threadIdx.x == 0) __hip_atomic_store(tmo, 0xDEAD0000u | (unsigned)u.pm, __ATOMIC_RELAXED, __HIP_MEMORY_SCOPE_AGENT); break; }
                __builtin_amdgcn_s_sleep(2); }
            __builtin_amdgcn_fence(__ATOMIC_ACQUIRE, "agent");
            asm volatile("s_waitcnt vmcnt(0)" ::: "memory");
        }
        asm volatile("" ::: "memory"); __builtin_amdgcn_s_barrier(); asm volatile("" ::: "memory");
    }
};

template <class Epi, class Sched, bool GATHER = false>
__device__ __forceinline__ void gemm_phase(LAS unsigned char* lds, const Gemm g, const Sched& S, const Epi& E) {
    int tid = threadIdx.x; asm volatile("" : "+v"(tid));
    const int wid = __builtin_amdgcn_readfirstlane(tid >> 6), lane = tid & 63, wr = wid >> 2, wc = wid & 3, fr = lane & 15, fq = lane >> 4;
    const int K = g.K, nt = K / BK;
    unsigned voffA[2], voffB[2]; int gR[2], gC[2];
#pragma unroll
    for (int i = 0; i < 2; ++i) { int R, C; stage_rc(tid * 16 + i * 8192, R, C); const int Rb = (R & ~31) + perm32(R & 31); gR[i] = R; gC[i] = C;
        voffA[i] = (unsigned)(R * g.lda + C) * 2u; voffB[i] = (unsigned)(Rb * g.ldb + C) * 2u; }
    const size_t kstep = (size_t)(BK * 2);
    const size_t hsA = (size_t)HALF * g.lda * 2, hsB = (size_t)HALF * g.ldb * 2;
    const unsigned ldsw = (unsigned)wid * 1024u;
    const int aoff = lds_byte(wr * 64 + fr, fq * 8), boff = lds_byte(wc * 32 + fr, fq * 8);
#define PG8_SA(b, h) (((b) * 2 + (h)) * HTB)
#define PG8_SB(b, h) ((4 + (b) * 2 + (h)) * HTB)
#define PG8_STAGE(bufoff, gbase, voff) do { _Pragma("unroll") for (int _i = 0; _i < 2; ++_i) \
        __builtin_amdgcn_global_load_lds((const unsigned*)((const char*)(gbase) + (voff)[_i]), (LAS unsigned*)(lds + (bufoff) + ldsw + _i * 8192), 16, 0, 0); } while (0)
#define PG8_STAGE_A(bufoff, dense_ptr, kbytes, offs) do { if constexpr (GATHER) { PG8_STAGE(bufoff, (const char*)g.A + (kbytes), offs); } else { PG8_STAGE(bufoff, dense_ptr, voffA); } } while (0)
#define PG8_GOFF(u, o0, o1) do { _Pragma("unroll") for (int _i = 0; _i < 2; ++_i) { o0[_i] = (unsigned)(S.arow(u, gR[_i]) * g.lda + gC[_i]) * 2u; o1[_i] = (unsigned)(S.arow(u, gR[_i] + HALF) * g.lda + gC[_i]) * 2u; } } while (0)
#define PG8_LDA(dst, b, h) do { _Pragma("unroll") for (int m = 0; m < 4; ++m) _Pragma("unroll") for (int k = 0; k < 2; ++k) dst[m][k] = *(const LAS bf16x8*)(lds + PG8_SA(b, h) + aoff + m * 2048 + k * 1024); } while (0)
#define PG8_LDB(dst, b, h) do { _Pragma("unroll") for (int n = 0; n < 2; ++n) _Pragma("unroll") for (int k = 0; k < 2; ++k) dst[n][k] = *(const LAS bf16x8*)(lds + PG8_SB(b, h) + boff + n * 2048 + k * 1024); } while (0)
#define PG8_MMA(ai, bj, At, Bt) do { __builtin_amdgcn_s_setprio(1); _Pragma("unroll") for (int m = 0; m < 4; ++m) _Pragma("unroll") for (int n = 0; n < 2; ++n) _Pragma("unroll") for (int k = 0; k < 2; ++k) \
        acc[ai][bj][m][n] = __builtin_amdgcn_mfma_f32_16x16x32_bf16(Bt[n][k], At[m][k], acc[ai][bj][m][n], 0, 0, 0); __builtin_amdgcn_s_setprio(0); } while (0)
#define PG8_WAIT_V(n) asm volatile("s_waitcnt vmcnt(" #n ")" ::: "memory")
#define PG8_WAIT_L(n) asm volatile("s_waitcnt lgkmcnt(" #n ")" ::: "memory")
#define PG8_BAR __builtin_amdgcn_s_barrier()
#define PG8_SCHED __builtin_amdgcn_sched_barrier(0)
    Unit cur, nxt; int ui = 0;
    if (!S.next(0, cur)) return;
    unsigned cO0[2] = {0u, 0u}, cO1[2] = {0u, 0u}, nO0[2] = {0u, 0u}, nO1[2] = {0u, 0u};
    if constexpr (GATHER) { PG8_GOFF(cur, cO0, cO1); }
    S.a_ready(cur);
    f32x4 acc[2][2][4][2];
#pragma unroll
    for (int a = 0; a < 2; ++a)
#pragma unroll
        for (int b = 0; b < 2; ++b)
#pragma unroll
            for (int m = 0; m < 4; ++m)
#pragma unroll
                for (int n = 0; n < 2; ++n) acc[a][b][m][n] = (f32x4){0.f, 0.f, 0.f, 0.f};
    bf16x8 At[4][2], B0[2][2], B1[2][2];
    const char* cA = (const char*)g.A + (GATHER ? (size_t)0 : (size_t)cur.pm * 2 * hsA); const char* cB = (const char*)g.Bt + (size_t)cur.pb * 2 * hsB;
    PG8_STAGE(PG8_SB(0, 0), cB, voffB); PG8_STAGE(PG8_SB(0, 1), cB + hsB, voffB); PG8_STAGE_A(PG8_SA(0, 0), cA, 0, cO0); PG8_STAGE_A(PG8_SA(0, 1), cA + hsA, 0, cO1);
    if (wr == 1) PG8_BAR;
    PG8_WAIT_V(2); PG8_BAR;
    PG8_STAGE(PG8_SB(1, 0), cB + kstep, voffB); PG8_STAGE_A(PG8_SA(1, 0), cA + kstep, kstep, cO0); PG8_STAGE(PG8_SB(1, 1), cB + hsB + kstep, voffB);
    PG8_WAIT_V(6); PG8_BAR;
    for (;;) {
        const bool has_next = S.next(ui + 1, nxt);
        const char* nA = (has_next && !GATHER) ? (const char*)g.A + (size_t)nxt.pm * 2 * hsA : cA; const char* nB = has_next ? (const char*)g.Bt + (size_t)nxt.pb * 2 * hsB : cB;
        if constexpr (GATHER) { if (has_next) { PG8_GOFF(nxt, nO0, nO1); } else { nO0[0] = cO0[0]; nO0[1] = cO0[1]; nO1[0] = cO1[0]; nO1[1] = cO1[1]; } }
        for (int t = 0; t < nt; t += 2) {
            const bool last = (t == nt - 2);
            if (last && has_next) S.a_ready(nxt);
            const char* a1 = cA + (size_t)(t + 1) * kstep;
            const char* a2 = last ? nA : cA + (size_t)(t + 2) * kstep; const char* b2 = last ? nB : cB + (size_t)(t + 2) * kstep;
            const char* a3 = a2 + kstep; const char* b3 = b2 + kstep;
            const size_t k2 = last ? (size_t)0 : (size_t)(t + 2) * kstep;
            unsigned o0[2], o1[2]; o0[0] = last ? nO0[0] : cO0[0]; o0[1] = last ? nO0[1] : cO0[1]; o1[0] = last ? nO1[0] : cO1[0]; o1[1] = last ? nO1[1] : cO1[1];
            PG8_LDB(B0, 0, 0); PG8_LDB(B1, 0, 1); PG8_SCHED; PG8_LDA(At, 0, 0); PG8_STAGE_A(PG8_SA(1, 1), a1 + hsA, (size_t)(t + 1) * kstep, cO1);
            PG8_WAIT_V(8); PG8_WAIT_L(0); PG8_BAR; PG8_MMA(0, 0, At, B0); PG8_MMA(0, 1, At, B1); PG8_BAR; PG8_SCHED;
            PG8_LDA(At, 0, 1); PG8_STAGE(PG8_SB(0, 0), b2, voffB); PG8_STAGE(PG8_SB(0, 1), b2 + hsB, voffB); PG8_STAGE_A(PG8_SA(0, 0), a2, k2, o0);
            PG8_WAIT_V(8); PG8_WAIT_L(0); PG8_BAR; PG8_MMA(1, 0, At, B0); PG8_MMA(1, 1, At, B1); PG8_BAR; PG8_SCHED;
            PG8_LDB(B0, 1, 0); PG8_LDB(B1, 1, 1); PG8_SCHED; PG8_LDA(At, 1, 0); PG8_STAGE_A(PG8_SA(0, 1), a2 + hsA, k2, o1);
            PG8_WAIT_V(8); PG8_WAIT_L(0); PG8_BAR; PG8_MMA(0, 0, At, B0); PG8_MMA(0, 1, At, B1); PG8_BAR; PG8_SCHED;
            PG8_LDA(At, 1, 1); PG8_STAGE(PG8_SB(1, 0), b3, voffB); PG8_STAGE(PG8_SB(1, 1), b3 + hsB, voffB); PG8_STAGE_A(PG8_SA(1, 0), a3, k2 + kstep, o0);
            PG8_WAIT_V(8); PG8_WAIT_L(0); PG8_BAR; PG8_MMA(1, 0, At, B0); PG8_MMA(1, 1, At, B1); PG8_BAR; PG8_SCHED;
        }
        if (wr == 0) PG8_BAR;
        E(acc, cur, wr, wc, fr, fq);
        if (!has_next) break;
#pragma unroll
        for (int a = 0; a < 2; ++a)
#pragma unroll
            for (int b = 0; b < 2; ++b)
#pragma unroll
                for (int m = 0; m < 4; ++m)
#pragma unroll
                    for (int n = 0; n < 2; ++n) acc[a][b][m][n] = (f32x4){0.f, 0.f, 0.f, 0.f};
        cur = nxt; cA = nA; cB = nB; ++ui;
        if constexpr (GATHER) { cO0[0] = nO0[0]; cO0[1] = nO0[1]; cO1[0] = nO1[0]; cO1[1] = nO1[1]; }
        if (wr == 1) PG8_BAR;
    }
    PG8_WAIT_V(0);
    PG8_BAR;
#undef PG8_SA
#undef PG8_SB
#undef PG8_STAGE
#undef PG8_STAGE_A
#undef PG8_GOFF
#undef PG8_LDA
#undef PG8_LDB
#undef PG8_MMA
#undef PG8_WAIT_V
#undef PG8_WAIT_L
#undef PG8_BAR
#undef PG8_SCHED
}

struct EpiStore {
    bf16_t* O; int ldc; const float* ssq; float inv; float* ssq_out0; float* ssq_out1; int pn0, pn1, pn2;
    int sg0 = 0, sg1 = 0;
    __device__ __forceinline__ void operator()(const f32x4 (&acc)[2][2][4][2], const Unit& u, int wr, int wc, int fr, int fq) const {
        const int row0 = u.pm * BM + wr * 64 + fr, col0 = u.pn * BM + wc * 32 + 8 * fq;
        float* so = (ssq_out0 && u.pn >= pn0 && u.pn < pn2) ? (u.pn < pn1 ? ssq_out0 : ssq_out1) : nullptr;
        const bool sig = u.pn >= sg0 && u.pn < sg1;
        float rsv[2][4];
#pragma unroll
        for (int ai = 0; ai < 2; ++ai)
#pragma unroll
            for (int m = 0; m < 4; ++m) rsv[ai][m] = ssq ? ssq[row0 + ai * HALF + m * 16] : 0.f;
#pragma unroll
        for (int ai = 0; ai < 2; ++ai)
#pragma unroll
            for (int m = 0; m < 4; ++m) { const int row = row0 + ai * HALF + m * 16; const float rs = ssq ? rsqrtf(rsv[ai][m] * inv + EPS) : 1.f;
                bf16_t* rowp = O + (size_t)row * ldc + col0; float ss = 0.f;
#pragma unroll
                for (int bj = 0; bj < 2; ++bj) { f32x4 v0 = acc[ai][bj][m][0] * rs, v1 = acc[ai][bj][m][1] * rs;
                    if (sig) {
#pragma unroll
                        for (int j = 0; j < 4; ++j) { v0[j] = __builtin_amdgcn_rcpf(1.f + __builtin_amdgcn_exp2f(1.4426950408889634f * v0[j])); v1[j] = __builtin_amdgcn_rcpf(1.f + __builtin_amdgcn_exp2f(1.4426950408889634f * v1[j])); } }
                    ss += (v0[0] * v0[0] + v0[1] * v0[1]) + (v0[2] * v0[2] + v0[3] * v0[3]) + (v1[0] * v1[0] + v1[1] * v1[1]) + (v1[2] * v1[2] + v1[3] * v1[3]);
                    u32x4 w; w.x = cvt_pk_bf16(v0[0], v0[1]); w.y = cvt_pk_bf16(v0[2], v0[3]); w.z = cvt_pk_bf16(v1[0], v1[1]); w.w = cvt_pk_bf16(v1[2], v1[3]);
                    *(u32x4*)(rowp + bj * HALF) = w; }
                if (so) { ss += __shfl_xor(ss, 16); ss += __shfl_xor(ss, 32); if (fq == 0) atomicAdd(so + row, ss); } }
    }
};
struct EpiResid {
    const float* X; float* O; const float* gate; int gpitch;
    __device__ __forceinline__ void operator()(const f32x4 (&acc)[2][2][4][2], const Unit& u, int wr, int wc, int fr, int fq) const {
        const int row0 = u.pm * BM + wr * 64 + fr, col0 = u.pn * BM + wc * 32 + 8 * fq;
        const float* gp = gate + (size_t)((u.pm * BM) / SEQ) * gpitch + col0;
        f32x4 gv[2][2];
#pragma unroll
        for (int bj = 0; bj < 2; ++bj)
#pragma unroll
            for (int n = 0; n < 2; ++n) gv[bj][n] = *(const f32x4*)(gp + bj * HALF + 4 * n);
#pragma unroll
        for (int ai = 0; ai < 2; ++ai)
#pragma unroll
            for (int m = 0; m < 4; ++m) { const size_t off = (size_t)(row0 + ai * HALF + m * 16) * DM + col0;
#pragma unroll
                for (int bj = 0; bj < 2; ++bj)
#pragma unroll
                    for (int n = 0; n < 2; ++n) { const f32x4 xv = *(const f32x4*)(X + off + bj * HALF + 4 * n);
                        *(f32x4*)(O + off + bj * HALF + 4 * n) = xv + gv[bj][n] * acc[ai][bj][m][n]; } }
    }
};
struct EpiSwiGLU {
    bf16_t* O; unsigned* ready;
    __device__ __forceinline__ void operator()(const f32x4 (&acc)[2][2][4][2], const Unit& u, int wr, int wc, int fr, int fq) const {
        const int row0 = u.pm * BM + wr * 64 + fr, col0 = u.pn * HALF + wc * 32 + 8 * fq;
        const __amdgpu_buffer_rsrc_t rs = __builtin_amdgcn_make_buffer_rsrc((void*)O, (short)0, RMAX * DE * 2, 0x00020000);
#pragma unroll
        for (int ai = 0; ai < 2; ++ai)
#pragma unroll
            for (int m = 0; m < 4; ++m) { const int row = row0 + ai * HALF + m * 16;
                float h[8];
#pragma unroll
                for (int n = 0; n < 2; ++n)
#pragma unroll
                    for (int j = 0; j < 4; ++j) { const float gt = acc[ai][0][m][n][j], up = acc[ai][1][m][n][j]; h[4 * n + j] = gt / (1.f + __expf(-gt)) * up; }
                u32x4 w; w.x = cvt_pk_bf16(h[0], h[1]); w.y = cvt_pk_bf16(h[2], h[3]); w.z = cvt_pk_bf16(h[4], h[5]); w.w = cvt_pk_bf16(h[6], h[7]);
                __builtin_amdgcn_raw_buffer_store_b128(w, rs, (unsigned)(row * DE + col0) * 2u, 0, 16); }
        asm volatile("s_waitcnt vmcnt(0)" ::: "memory");
        if ((threadIdx.x & 63) == 0) __hip_atomic_fetch_add(ready + 64 * u.pm, 1u, __ATOMIC_RELAXED, __HIP_MEMORY_SCOPE_AGENT);
    }
};
}
constexpr size_t MiB = 1u << 20;
constexpr size_t WS_CTL = 0, CTL_ZERO_BYTES = 1 * MiB;
constexpr size_t WS_MOD = 1 * MiB;
constexpr size_t WS_ROPEC = 1 * MiB + 512 * 1024;
constexpr size_t WS_ROPES = WS_ROPEC + 2 * MiB;
constexpr size_t WS_WCT = WS_ROPES + 2 * MiB;
constexpr size_t WS_RSTDQ = 6 * MiB;
constexpr size_t WS_RSTDKV = WS_RSTDQ + 64 * 1024;
constexpr size_t WS_TOKE = WS_RSTDKV + 64 * 1024;
constexpr size_t WS_TOKW = WS_TOKE + 128 * 1024;
constexpr size_t WS_TOKS = WS_TOKW + 128 * 1024;
constexpr size_t WS_BLKE = WS_TOKS + 128 * 1024;
constexpr size_t WS_STAMP = WS_BLKE + 4096;
constexpr size_t WS_WIN = 8 * MiB;
constexpr size_t WS_WQUP = 28 * MiB;
constexpr size_t WS_WKVUP = WS_WQUP + 1536 * 1024;
constexpr size_t WS_WOUT = 31 * MiB;
constexpr size_t WS_A = 40 * MiB;
constexpr size_t WS_B = 200 * MiB;
constexpr size_t WS_C = 264 * MiB;
constexpr size_t WS_D = 328 * MiB;
constexpr size_t WS_E = 456 * MiB;
constexpr size_t WS_LIST = 520 * MiB;
constexpr size_t WS_F = 522 * MiB;
constexpr size_t WS_END = 586 * MiB;
constexpr size_t QN_BYTES = (size_t)T * MH * MQK * 2;

constexpr int CW_BAR = 4096;
constexpr int CW_CNT = 8192;
constexpr int CW_RDY = 10240;
constexpr int CW_ADA = 64;
constexpr int CW_TMO = 1;

constexpr int RING_BYTES = 131072, LDS_BYTES = 147456, LDS_USER = 143360, MISC_OFF = LDS_BYTES - 512;

struct Args { const float* in[25]; float* out; unsigned char* ws; int ph_lo, ph_hi, pad0, pad1; };

struct Frame {
    LAS unsigned char* lds;
    volatile LAS unsigned* MISC;
    gu32* ctl;
    int tid, lane, wave, vcu, G;
    unsigned char* ws; float* out;
};

#define OPAQUE_FRAME(F) do { F.tid = threadIdx.x; asm volatile("" : "+v"(F.tid)); F.lane = F.tid & 63; } while (0)

__device__ __forceinline__ void unpack8(const u32x4 w, float* f) { f[0] = bf_lo(w.x); f[1] = bf_hi(w.x); f[2] = bf_lo(w.y); f[3] = bf_hi(w.y); f[4] = bf_lo(w.z); f[5] = bf_hi(w.z); f[6] = bf_lo(w.w); f[7] = bf_hi(w.w); }
__device__ __forceinline__ u32x4 pack8f(const float* f) { u32x4 w; w.x = cvt_pk_bf16(f[0], f[1]); w.y = cvt_pk_bf16(f[2], f[3]); w.z = cvt_pk_bf16(f[4], f[5]); w.w = cvt_pk_bf16(f[6], f[7]); return w; }

struct TrItem { const float* src; bf16_t* dst; bf16_t* dst2; const float* gk; int N, ldt; };
__device__ __forceinline__ void tr_load(const TrItem& it, f32x4 (&r)[16], int lane) {
    const float* p = it.src + (size_t)(lane >> 4) * it.N + 4 * (lane & 15);
#pragma unroll
    for (int i = 0; i < 16; ++i) r[i] = __builtin_nontemporal_load((const f32x4*)(p + (size_t)(4 * i) * it.N));
}
__device__ __forceinline__ void tr_store(const TrItem& it, const f32x4 (&r)[16], LAS unsigned char* Tl, int lane) {
    const int row = lane >> 4, c4 = lane & 15;
#pragma unroll
    for (int i = 0; i < 16; ++i) { f32x4 v = r[i]; if (it.gk) v = v * it.gk[4 * i + row];
        u32x2 w; w.x = cvt_pk_bf16(v.x, v.y); w.y = cvt_pk_bf16(v.z, v.w);
        *(LAS u32x2*)(Tl + ((4 * i + row) * 64 + 4 * c4) * 2) = w; }
    LDS_WAIT(); asm volatile("" ::: "memory");
    const int g = lane >> 4, i16 = lane & 15, q = i16 >> 2, pp = lane & 3;
    typedef short v4i16_t __attribute__((ext_vector_type(4)));
#pragma unroll
    for (int hh = 0; hh < 2; ++hh) { bf16_t* drow = (hh ? it.dst2 : it.dst) + (size_t)(16 * (g & 1) + i16) * it.ldt;
#pragma unroll
        for (int j = 0; j < 4; ++j) { const int kc = 4 * (g >> 1) + j;
            const v4i16_t lo = __builtin_amdgcn_ds_read_tr16_b64_v4i16((LAS v4i16_t*)(Tl + ((8 * kc + q) * 64 + 32 * hh + 16 * (g & 1) + 4 * pp) * 2));
            const v4i16_t hi = __builtin_amdgcn_ds_read_tr16_b64_v4i16((LAS v4i16_t*)(Tl + ((8 * kc + 4 + q) * 64 + 32 * hh + 16 * (g & 1) + 4 * pp) * 2));
            const bf16x8 o = {lo[0], lo[1], lo[2], lo[3], hi[0], hi[1], hi[2], hi[3]};
            *(bf16x8*)(drow + 8 * kc) = o; } }
    LDS_WAIT(); asm volatile("" ::: "memory");
}
template <class MK> __device__ __forceinline__ void tr_run(int first, int step, int n, const MK& mk, LAS unsigned char* Tl, int lane) {
    if (first >= n) return;
    f32x4 ra[16], rb[16];
    TrItem ia = mk(first), ib = ia;
    tr_load(ia, ra, lane);
    for (int idx = first; idx < n; idx += 2 * step) {
        if (idx + step < n) { ib = mk(idx + step); tr_load(ib, rb, lane); }
        tr_store(ia, ra, Tl, lane);
        if (idx + step >= n) break;
        if (idx + 2 * step < n) { ia = mk(idx + 2 * step); tr_load(ia, ra, lane); }
        tr_store(ib, rb, Tl, lane);
    }
}

__device__ __forceinline__ void adaln_phase(Frame& F, const float* c, const float* w_ada, const float* b_ada, float* mod) {
    LAS float* cact = (LAS float*)F.lds;
    LAS float* part = (LAS float*)(F.lds + 65536);
    for (int i = F.tid; i < NB * DM; i += NTHR) cact[i] = siluf(c[i]);
    __syncthreads();
    const int cg = F.tid & 7, rs = F.tid >> 3;
    for (int it = blockIdx.x; it < 6 * DM / 32; it += F.G) {
        const int n0 = it * 32 + cg * 4;
        f32x4 acc[8];
#pragma unroll
        for (int b = 0; b < 8; ++b) acc[b] = (f32x4){0.f, 0.f, 0.f, 0.f};
#pragma unroll 1
        for (int i0 = 0; i0 < 32; i0 += 16) { f32x4 w[16];
#pragma unroll
            for (int u = 0; u < 16; ++u) w[u] = __builtin_nontemporal_load((const f32x4*)(w_ada + (size_t)(rs + 64 * (i0 + u)) * (6 * DM) + n0));
#pragma unroll
            for (int u = 0; u < 16; ++u) { const int k = rs + 64 * (i0 + u);
#pragma unroll
                for (int b = 0; b < 8; ++b) acc[b] += w[u] * cact[b * DM + k]; } }
#pragma unroll
        for (int b = 0; b < 8; ++b) *(LAS f32x4*)(part + (rs * 8 + b) * 32 + cg * 4) = acc[b];
        __syncthreads();
        if (F.tid < 256) { const int b = F.tid >> 5, n = F.tid & 31; float s = 0.f;
#pragma unroll 8
            for (int r = 0; r < 64; ++r) s += part[(r * 8 + b) * 32 + n];
            __hip_atomic_store(mod + b * (6 * DM) + it * 32 + n, s + b_ada[it * 32 + n], __ATOMIC_RELAXED, __HIP_MEMORY_SCOPE_AGENT); }
        asm volatile("s_waitcnt vmcnt(0)" ::: "memory");
        __syncthreads();
        if (it == (int)blockIdx.x && F.tid == 0) __hip_atomic_fetch_add((unsigned*)(F.ctl + CW_ADA), 1u, __ATOMIC_RELAXED, __HIP_MEMORY_SCOPE_AGENT);
    }
}

__device__ __forceinline__ void p0_phase(Frame& F, const Args& a) {
    OPAQUE_FRAME(F);
    unsigned char* ws = F.ws;
    adaln_phase(F, a.in[1], a.in[3], a.in[4], (float*)(ws + WS_MOD));
    __syncthreads();
    LAS unsigned char* Tl = F.lds + F.wave * 8192;
    const int gw = F.vcu * NWAVES + F.wave, NGW = F.G * NWAVES;
    constexpr int I_IN = (DM / 64) * (INC / 64), I_QUP = (QLORA / 64) * (MH * MQK / 64), I_KVUP = (KVLORA / 64) * (MH * 256 / 64), I_OUT = (DM / 64) * (DM / 64);
    constexpr int NITEMS = I_IN + I_QUP + I_KVUP + I_OUT;
    static_assert(INC % 64 == 0, "64-column transpose items");
    { const float* w_in = a.in[6]; const float* w_qup = a.in[10]; const float* w_kvup = a.in[12]; const float* w_out = a.in[16]; const float* gq = a.in[9]; const float* gkv = a.in[11];
      auto mk = [=](int r) -> TrItem { TrItem t;
          if (r < I_IN) { const int nblk = INC / 64, kb = r / nblk, nb = r % nblk; t.src = w_in + (size_t)(64 * kb) * INC + 64 * nb; t.dst = (bf16_t*)(ws + WS_WIN) + (size_t)(64 * nb) * DM + 64 * kb; t.dst2 = t.dst + (size_t)32 * DM; t.gk = nullptr; t.N = INC; t.ldt = DM; return t; } r -= I_IN;
          if (r < I_QUP) { const int nblk = MH * MQK / 64, kb = r / nblk, nb = r % nblk; t.src = w_qup + (size_t)(64 * kb) * (MH * MQK) + 64 * nb; t.dst = (bf16_t*)(ws + WS_WQUP) + (size_t)(64 * nb) * QLORA + 64 * kb; t.dst2 = t.dst + (size_t)32 * QLORA; t.gk = gq + 64 * kb; t.N = MH * MQK; t.ldt = QLORA; return t; } r -= I_QUP;
          if (r < I_KVUP) { const int nblk = MH * 256 / 64, kb = r / nblk, nb = r % nblk; t.src = w_kvup + (size_t)(64 * kb) * (MH * 256) + 64 * nb; t.dst = (bf16_t*)(ws + WS_WKVUP) + (size_t)(64 * nb) * KVLORA + 64 * kb; t.dst2 = t.dst + (size_t)32 * KVLORA; t.gk = gkv + 64 * kb; t.N = MH * 256; t.ldt = KVLORA; return t; } r -= I_KVUP;
          { const int nblk = DM / 64, kb = r / nblk, nb = r % nblk; t.src = w_out + (size_t)(64 * kb) * DM + 64 * nb; t.dst = (bf16_t*)(ws + WS_WOUT) + (size_t)(64 * nb) * DM + 64 * kb; t.dst2 = t.dst + (size_t)32 * DM; t.gk = nullptr; t.N = DM; t.ldt = DM; return t; } };
      const int nheavy = (6 * DM / 32) - F.G, nlw = (F.G - nheavy) * NWAVES;
      int pre = 0;
      if (nheavy > 0 && nheavy < F.G) { pre = 2 * nlw < NITEMS ? 2 * nlw : NITEMS;
          if ((int)blockIdx.x >= nheavy) tr_run(((int)blockIdx.x - nheavy) * NWAVES + F.wave, nlw, pre, mk, Tl, F.lane); }
      tr_run(pre + gw, NGW, NITEMS, mk, Tl, F.lane); }
    { const int* pos = (const int*)a.in[2]; float* rc = (float*)(ws + WS_ROPEC); float* rsn = (float*)(ws + WS_ROPES);
      const int gt = F.vcu * NTHR + F.tid, NGT = F.G * NTHR;
      const float invf = (float)exp2(-(double)(gt & 31) * (13.287712379549449 / 32.0));
      for (int e = gt; e < T * 32; e += NGT) { const int tk = e >> 5;
          const float ang = (float)pos[tk] * invf; float sv, cv; sincosf(ang, &sv, &cv);
          rc[e] = cv; rsn[e] = sv; }
      { float* ssq = (float*)(ws + WS_RSTDQ); for (int e = gt; e < 2 * T; e += NGT) ssq[e] = 0.f; }
      float* wct = (float*)(ws + WS_WCT);
      for (int e = gt; e < 48 * DM; e += NGT) { const int n = e / DM, k = e % DM;
          wct[e] = n < 4 ? a.in[18][k * NG + n] : (n < 36 ? a.in[20][k * NE + (n - 4)] : 0.f); } }
}

__device__ __forceinline__ void p1_phase(Frame& F, const Args& a) {
    OPAQUE_FRAME(F);
    const int gw = F.vcu * NWAVES + F.wave, NGW = F.G * NWAVES;
    const float* mod = (const float*)(F.ws + WS_MOD); const float* g = a.in[5]; const float* x = a.in[0];
    bf16_t* H = (bf16_t*)(F.ws + WS_B);
    if (F.tid == 0) { unsigned polls = 0;
        while (__hip_atomic_load((unsigned*)(F.ctl + CW_ADA), __ATOMIC_RELAXED, __HIP_MEMORY_SCOPE_AGENT) < (unsigned)F.G) { if (++polls > (1u << 16)) { __hip_atomic_store((unsigned*)(F.ctl + CW_TMO), 0xADA00000u, __ATOMIC_RELAXED, __HIP_MEMORY_SCOPE_AGENT); break; } __builtin_amdgcn_s_sleep(2); }
        __builtin_amdgcn_fence(__ATOMIC_ACQUIRE, "agent"); asm volatile("s_waitcnt vmcnt(0)" ::: "memory"); }
    __syncthreads();
    for (int blk = gw; blk < T / 8; blk += NGW) { const int m0 = blk * 8, b = m0 / SEQ;
        const float* shift = mod + b * (6 * DM); const float* scale = shift + DM;
        f32x4 gm[8], sh[8];
#pragma unroll
        for (int j = 0; j < 8; ++j) { gm[j] = ((const f32x4*)g)[64 * j + F.lane] * (((const f32x4*)scale)[64 * j + F.lane] + 1.f); sh[j] = ((const f32x4*)shift)[64 * j + F.lane]; }
        f32x4 va[8], vb[8];
#define P1_LD(r, V) do { const f32x4* xr_ = (const f32x4*)(x + (size_t)(m0 + (r)) * DM) + F.lane; _Pragma("unroll") for (int j = 0; j < 8; ++j) V[j] = __builtin_nontemporal_load(xr_ + 64 * j); } while (0)
#define P1_ST(r, V) do { float s_ = 0.f; _Pragma("unroll") for (int j = 0; j < 8; ++j) s_ += (V[j].x * V[j].x + V[j].y * V[j].y) + (V[j].z * V[j].z + V[j].w * V[j].w); \
            const float rstd_ = rsqrtf(wave_sum(s_) * (1.f / DM) + EPS); u32x2* o8_ = (u32x2*)(H + (size_t)(m0 + (r)) * DM) + F.lane; \
            _Pragma("unroll") for (int j = 0; j < 8; ++j) { const f32x4 h_ = V[j] * rstd_ * gm[j] + sh[j]; u32x2 w_; w_.x = cvt_pk_bf16(h_.x, h_.y); w_.y = cvt_pk_bf16(h_.z, h_.w); o8_[64 * j] = w_; } } while (0)
        P1_LD(0, va);
#pragma unroll 1
        for (int r = 0; r < 8; r += 2) {
            P1_LD(r + 1, vb); __builtin_amdgcn_sched_barrier(0);
            P1_ST(r, va); __builtin_amdgcn_sched_barrier(0);
            if (r + 2 < 8) { P1_LD(r + 2, va); } __builtin_amdgcn_sched_barrier(0);
            P1_ST(r + 1, vb); __builtin_amdgcn_sched_barrier(0);
        }
#undef P1_LD
#undef P1_ST
    }
}

namespace hg {
constexpr int OFF_F = 0, OFF_SEG = 32768, OFF_QIN = 34816, RP = 272, OFF_KIN = OFF_QIN + 64 * RP, OFF_QB = OFF_KIN + 64 * RP, OFF_KLT = OFF_QB + 64 * RP, SP = 144,
              OFF_VT = OFF_KLT + 128 * SP  , OFF_DEC = OFF_VT + 64 * SP  , OFF_SF = OFF_DEC + 3584  , OP = 144, OFF_O = OFF_SF + 16384  , OFF_LB = OFF_O + 64 * OP  , HG_LDS = OFF_LB + 1024;
static_assert(HG_LDS <= MISC_OFF, "hgrn lds");
__device__ __forceinline__ float dpp_xor1(float v) { return __builtin_bit_cast(float, __builtin_amdgcn_update_dpp(0, __builtin_bit_cast(int, v), 0xB1, 0xF, 0xF, true)); }
__device__ __forceinline__ int ppos(int s) { return (s & ~15) | ((s & 4) << 1) | ((s & 8) >> 1) | (s & 3); }
}
__device__ __forceinline__ void hgrn_chunked(Frame& F, const Args& a, int item) {
    using namespace hg;
    const bf16_t* PROJ = (const bf16_t*)(F.ws + WS_A);
    bf16_t* MIX = (bf16_t*)F.out;
    const float* lbl = a.in[7];
    LAS unsigned char* L = F.lds;
    LAS float* Fs = (LAS float*)(L + OFF_F); LAS float* SEGs = (LAS float*)(L + OFF_SEG); LAS float* DEC = (LAS float*)(L + OFF_DEC); LAS float* POST = DEC + 384;
    const int g = F.tid & 15, t0 = F.tid >> 4;
    const int sk = 16 * F.wave + (F.lane & 15), sseg = F.lane >> 4;
    const int scol = sk ^ ((sseg & 1) << 4);
    const int r32 = F.lane & 31, hi = F.lane >> 5;
    {
        const int dq2 = (item >> 3) & 1, bh = (item >> 4) * 8 + (item & 7), h = bh & 7, b = bh >> 3;
        LAS float* LB = (LAS float*)(L + OFF_LB);
        if (F.tid < 128) { const int k = h * 128 + F.tid; const float l = 1.f / (1.f + __expf(lbl[HW + k] - lbl[k])); LB[F.tid] = l; LB[128 + F.tid] = 1.f - l; }
        __syncthreads();
        const bf16_t* base = PROJ + (size_t)(b * SEQ) * INCP + h * 128;
        f32x16 S0 = {}, S1 = {};
        u32x4 gq[2], gf[2], gv;
#define HG_LOADF(c) do { _Pragma("unroll") for (int i = 0; i < 2; ++i) gf[i] = *(const u32x4*)(base + (size_t)((c) * 64 + t0 + 32 * i) * INCP + g * 8 + HW); } while (0)
#define HG_LOADQ(c) do { _Pragma("unroll") for (int i = 0; i < 2; ++i) gq[i] = *(const u32x4*)(base + (size_t)((c) * 64 + t0 + 32 * i) * INCP + g * 8); \
            gv = *(const u32x4*)(base + (size_t)((c) * 64 + (F.tid >> 3)) * INCP + 2 * HW + dq2 * 64 + (F.tid & 7) * 8); } while (0)
        HG_LOADF(0); HG_LOADQ(0);
        float fv[2][8], klp[16], po = 0.f;
        for (int c = -1; c < SEQ / 64; ++c) {
            if (c >= 0) {
            {
              f32x4 pa[2], pb[2], ea[2], eb[2];
#pragma unroll
              for (int i = 0; i < 2; ++i) { const int t = t0 + 32 * i; const LAS float* fp = Fs + t * 128 + ((g * 8) ^ (((t >> 4) & 1) << 4)); const LAS float* pp = SEGs + (t >> 4) * 128 + g * 8;
                  pa[i] = *(const LAS f32x4*)fp; pb[i] = *(const LAS f32x4*)(fp + 4); ea[i] = *(const LAS f32x4*)pp; eb[i] = *(const LAS f32x4*)(pp + 4); }
              __builtin_amdgcn_sched_barrier(0);
            if (F.wave >= 4) { const int kb = F.wave - 4;
                f32x16 Z0, Z1;
#pragma unroll
                for (int q4 = 0; q4 < 4; ++q4) { const f32x4 pmv = *(const LAS f32x4*)(DEC + 128 + 32 * kb + 8 * q4 + 4 * hi);
#pragma unroll
                    for (int j = 0; j < 4; ++j) { Z0[4 * q4 + j] = S0[4 * q4 + j] * pmv[j]; Z1[4 * q4 + j] = S1[4 * q4 + j] * pmv[j]; } }
#pragma unroll
                for (int s2 = 0; s2 < 2; ++s2) { u32x4 w0, w1;
                    w0.x = cvt_pk_bf16(Z0[8 * s2], Z0[8 * s2 + 1]); w0.y = cvt_pk_bf16(Z0[8 * s2 + 2], Z0[8 * s2 + 3]); w0.z = cvt_pk_bf16(Z0[8 * s2 + 4], Z0[8 * s2 + 5]); w0.w = cvt_pk_bf16(Z0[8 * s2 + 6], Z0[8 * s2 + 7]);
                    w1.x = cvt_pk_bf16(Z1[8 * s2], Z1[8 * s2 + 1]); w1.y = cvt_pk_bf16(Z1[8 * s2 + 2], Z1[8 * s2 + 3]); w1.z = cvt_pk_bf16(Z1[8 * s2 + 4], Z1[8 * s2 + 5]); w1.w = cvt_pk_bf16(Z1[8 * s2 + 6], Z1[8 * s2 + 7]);
                    *(LAS u32x4*)(L + OFF_SF + ((((kb * 2 + 0) * 2 + s2) * 64) + F.lane) * 16) = w0;
                    *(LAS u32x4*)(L + OFF_SF + ((((kb * 2 + 1) * 2 + s2) * 64) + F.lane) * 16) = w1; } }
              __builtin_amdgcn_sched_barrier(0);
              { float v[8]; unpack8(gv, v); const int s = F.tid >> 3, dvg = F.tid & 7, ps = ppos(s);
#pragma unroll
                  for (int j = 0; j < 8; ++j) *(LAS bf16_t*)(L + OFF_VT + (dvg * 8 + j) * SP + (((ps >> 3) ^ dvg) << 4) + (ps & 7) * 2) = (bf16_t)(__builtin_bit_cast(unsigned, v[j]) >> 16); }
              { float o16[16];
#pragma unroll
                for (int p = 0; p < 16; ++p) o16[p] = klp[8 * ((p >> 2) & 1) + 4 * (p >> 3) + (p & 3)] * po;
                *(LAS u32x4*)(L + OFF_KLT + sk * SP + sseg * 32) = pack8f(o16); *(LAS u32x4*)(L + OFF_KLT + sk * SP + sseg * 32 + 16) = pack8f(o16 + 8); }
#pragma unroll
              for (int i = 0; i < 2; ++i) { const int t = t0 + 32 * i;
                  float qin[8], kin[8], qv[8];
                  unpack8(gq[i], qv);
#pragma unroll
                  for (int j = 0; j < 8; ++j) { const float P = (j < 4 ? pa[i][j] * ea[i][j] : pb[i][j - 4] * eb[i][j - 4]);
                      qin[j] = qv[j] * 0.08838834764831845f * P; kin[j] = (1.f - fv[i][j]) * __builtin_amdgcn_rcpf(P); }
                  { const u32x4 wq = pack8f(qin), wk = pack8f(kin); const int o0 = t * RP + ((g >> 1) * 16 + (g & 1) * 4) * 2;
                    *(LAS u32x2*)(L + OFF_QIN + o0) = (u32x2){wq.x, wq.y}; *(LAS u32x2*)(L + OFF_QIN + o0 + 16) = (u32x2){wq.z, wq.w};
                    *(LAS u32x2*)(L + OFF_KIN + o0) = (u32x2){wk.x, wk.y}; *(LAS u32x2*)(L + OFF_KIN + o0 + 16) = (u32x2){wk.z, wk.w}; } } }
                        if (c + 1 < SEQ / 64) HG_LOADQ(c + 1);
            }
            __syncthreads();
            if (c >= 0) {
            if (F.wave < 4) { const int tb = F.wave & 1, dvb = F.wave >> 1;
                const LAS unsigned char* qin_p = L + OFF_QIN + (32 * tb + r32) * RP + 16 * hi;
                const LAS unsigned char* sf_p = L + OFF_SF + dvb * 2048 + F.lane * 16;
                const LAS unsigned char* kin_p = L + OFF_KIN + r32 * RP + 16 * hi;
                const LAS unsigned char* vt_p = L + OFF_VT + (32 * dvb + r32) * SP; const int vsw = (4 * dvb + (r32 >> 3)) & 7;
#define HG_VT(ch) (*(const LAS bf16x8*)(vt_p + ((((ch) + hi) ^ vsw) << 4)))
                bf16x8 Q0, S0f, K0, L0, Q1, S1f, K1, L1, Q2, S2f, K2, L2, vf0, vf1;
#define HG_LDG(Q, S, K, ks_) do { Q = *(const LAS bf16x8*)(qin_p + 32 * (ks_)); S = *(const LAS bf16x8*)(sf_p + ((ks_) >> 1) * 4096 + ((ks_) & 1) * 1024); K = *(const LAS bf16x8*)(kin_p + 32 * (ks_)); } while (0)
#define HG_LDL(Lq, ks_) do { Lq = *(const LAS bf16x8*)(kin_p + 32 * RP + 32 * (ks_)); } while (0)
#define HG_MMG(Q, S, K) do { o = __builtin_amdgcn_mfma_f32_32x32x16_bf16(Q, S, o, 0, 0, 0); X = __builtin_amdgcn_mfma_f32_32x32x16_bf16(K, Q, X, 0, 0, 0); } while (0)
#define HG_MML(Q, Lq) do { Y = __builtin_amdgcn_mfma_f32_32x32x16_bf16(Lq, Q, Y, 0, 0, 0); } while (0)
#define HG_XV(X, v0, v1) do { u32x4 w0_, w1_; \
                    w0_.x = cvt_pk_bf16(X[0], X[1]); w0_.y = cvt_pk_bf16(X[2], X[3]); w0_.z = cvt_pk_bf16(X[4], X[5]); w0_.w = cvt_pk_bf16(X[6], X[7]); \
                    w1_.x = cvt_pk_bf16(X[8], X[9]); w1_.y = cvt_pk_bf16(X[10], X[11]); w1_.z = cvt_pk_bf16(X[12], X[13]); w1_.w = cvt_pk_bf16(X[14], X[15]); \
                    o = __builtin_amdgcn_mfma_f32_32x32x16_bf16(__builtin_bit_cast(bf16x8, w0_), v0, o, 0, 0, 0); o = __builtin_amdgcn_mfma_f32_32x32x16_bf16(__builtin_bit_cast(bf16x8, w1_), v1, o, 0, 0, 0); } while (0)
#define HG_DIAG(X) do { _Pragma("unroll") for (int r = 0; r < 16; ++r) { const int srow = (r & 3) + 8 * (r >> 2) + 4 * hi; if (srow > r32) X[r] = 0.f; } } while (0)
#define SB() __builtin_amdgcn_sched_barrier(0)
                f32x16 o = {}, X = {};
                if (tb == 0) {
                    HG_LDG(Q0, S0f, K0, 0); HG_LDG(Q1, S1f, K1, 1); HG_LDG(Q2, S2f, K2, 2); SB();
                    HG_MMG(Q0, S0f, K0); SB(); HG_LDG(Q0, S0f, K0, 3); SB();
                    HG_MMG(Q1, S1f, K1); SB(); HG_LDG(Q1, S1f, K1, 4); SB();
                    HG_MMG(Q2, S2f, K2); SB(); HG_LDG(Q2, S2f, K2, 5); SB();
                    HG_MMG(Q0, S0f, K0); SB(); HG_LDG(Q0, S0f, K0, 6); SB();
                    HG_MMG(Q1, S1f, K1); SB(); HG_LDG(Q1, S1f, K1, 7); SB();
                    HG_MMG(Q2, S2f, K2); SB(); vf0 = HG_VT(0); vf1 = HG_VT(2); SB();
                    HG_MMG(Q0, S0f, K0); HG_MMG(Q1, S1f, K1);
                    HG_DIAG(X); HG_XV(X, vf0, vf1);
                } else {
                    f32x16 Y = {}; bf16x8 vg0, vg1;
                    HG_LDG(Q0, S0f, K0, 0); HG_LDL(L0, 0); HG_LDG(Q1, S1f, K1, 1); HG_LDL(L1, 1); HG_LDG(Q2, S2f, K2, 2); HG_LDL(L2, 2); SB();
                    HG_MMG(Q0, S0f, K0); HG_MML(Q0, L0); SB(); HG_LDG(Q0, S0f, K0, 3); HG_LDL(L0, 3); SB();
                    HG_MMG(Q1, S1f, K1); HG_MML(Q1, L1); SB(); HG_LDG(Q1, S1f, K1, 4); HG_LDL(L1, 4); SB();
                    HG_MMG(Q2, S2f, K2); HG_MML(Q2, L2); SB(); HG_LDG(Q2, S2f, K2, 5); HG_LDL(L2, 5); SB();
                    HG_MMG(Q0, S0f, K0); HG_MML(Q0, L0); SB(); HG_LDG(Q0, S0f, K0, 6); HG_LDL(L0, 6); SB();
                    HG_MMG(Q1, S1f, K1); HG_MML(Q1, L1); SB(); HG_LDG(Q1, S1f, K1, 7); HG_LDL(L1, 7); SB();
                    HG_MMG(Q2, S2f, K2); HG_MML(Q2, L2); SB(); vf0 = HG_VT(0); vf1 = HG_VT(2); vg0 = HG_VT(4); vg1 = HG_VT(6); SB();
                    HG_MMG(Q0, S0f, K0); HG_MML(Q0, L0); HG_MMG(Q1, S1f, K1); HG_MML(Q1, L1);
                    HG_XV(X, vf0, vf1); HG_DIAG(Y); HG_XV(Y, vg0, vg1);
                }
#undef SB
#undef HG_VT
#undef HG_LDG
#undef HG_LDL
#undef HG_MMG
#undef HG_MML
#undef HG_XV
#undef HG_DIAG
                unsigned ow[16];
#pragma unroll
                for (int r = 0; r < 16; ++r) ow[r] = cvt_pk_bf16(o[r], dpp_xor1(o[r]));
                if ((r32 & 1) == 0) { LAS unsigned char* ob = L + OFF_O + (32 * tb + 4 * hi) * OP + (32 * dvb + r32) * 2;
#pragma unroll
                    for (int r = 0; r < 16; ++r) *(LAS unsigned*)(ob + ((r & 3) + 8 * (r >> 2)) * OP) = ow[r]; }
            } else { const int kb = F.wave - 4;
                bf16x8 kf[4], va[4], vb[4];
#pragma unroll
                for (int ss = 0; ss < 4; ++ss) { kf[ss] = *(const LAS bf16x8*)(L + OFF_KLT + (32 * kb + r32) * SP + (16 * ss + 8 * hi) * 2);
                    va[ss] = *(const LAS bf16x8*)(L + OFF_VT + r32 * SP + (((2 * ss + hi) ^ (r32 >> 3)) << 4)); vb[ss] = *(const LAS bf16x8*)(L + OFF_VT + (32 + r32) * SP + (((2 * ss + hi) ^ (4 + (r32 >> 3))) << 4)); }
#pragma unroll
                for (int r = 0; r < 16; ++r) { const float dcy = DEC[32 * kb + (r & 3) + 8 * (r >> 2) + 4 * hi]; S0[r] *= dcy; S1[r] *= dcy; }
                __builtin_amdgcn_sched_barrier(0);
#pragma unroll
                for (int ss = 0; ss < 4; ++ss) { S0 = __builtin_amdgcn_mfma_f32_32x32x16_bf16(kf[ss], va[ss], S0, 0, 0, 0); S1 = __builtin_amdgcn_mfma_f32_32x32x16_bf16(kf[ss], vb[ss], S1, 0, 0, 0); }
            }
                        }
            if (c + 1 < SEQ / 64) {
            float lb[8], lc[8];
            { const f32x4 l0 = *(const LAS f32x4*)(LB + g * 8), l1 = *(const LAS f32x4*)(LB + g * 8 + 4), c0 = *(const LAS f32x4*)(LB + 128 + g * 8), c1 = *(const LAS f32x4*)(LB + 128 + g * 8 + 4);
#pragma unroll
              for (int j = 0; j < 4; ++j) { lb[j] = l0[j]; lb[4 + j] = l1[j]; lc[j] = c0[j]; lc[4 + j] = c1[j]; } }
#pragma unroll
            for (int i = 0; i < 2; ++i) { float fl[8]; unpack8(gf[i], fl);
#pragma unroll
                for (int j = 0; j < 8; ++j) fv[i][j] = 1.f - lc[j] * fl[j];
                LAS float* fp = Fs + (t0 + 32 * i) * 128 + ((g * 8) ^ ((((t0 + 32 * i) >> 4) & 1) << 4));
                *(LAS f32x4*)fp = (f32x4){fv[i][0], fv[i][1], fv[i][2], fv[i][3]}; *(LAS f32x4*)(fp + 4) = (f32x4){fv[i][4], fv[i][5], fv[i][6], fv[i][7]}; }
            if (c + 2 < SEQ / 64) HG_LOADF(c + 2);
            } else {
#pragma unroll
                for (int j = 0; j < 8; ++j) { fv[0][j] = 0.f; fv[1][j] = 0.f; } }
            __syncthreads();
            if (c >= 0) { const int row = F.tid >> 3, pc = F.tid & 7;
              const u32x4 w = *(const LAS u32x4*)(L + OFF_O + row * OP + pc * 16);
              *(u32x4*)(MIX + (size_t)(b * SEQ + c * 64 + row) * DM + h * 128 + dq2 * 64 + pc * 8) = w; }
            if (c + 1 < SEQ / 64) {
            { float fr[16];
#pragma unroll
              for (int i = 0; i < 16; ++i) fr[i] = Fs[(16 * sseg + i) * 128 + scol];
              float p = 1.f;
#pragma unroll
              for (int i = 0; i < 16; ++i) { p *= fr[i]; Fs[(16 * sseg + i) * 128 + scol] = p; }
              float q = 1.f;
#pragma unroll
              for (int i = 15; i >= 0; --i) { klp[i] = (1.f - fr[i]) * q; q *= fr[i]; }
              const unsigned pu = __float_as_uint(p);
              auto r16 = __builtin_amdgcn_permlane16_swap(pu, pu, false, false);
              const float A = __uint_as_float(r16[0]) * __uint_as_float(r16[1]), x16 = __uint_as_float(r16[0] == pu ? r16[1] : r16[0]);
              const unsigned au = __float_as_uint(A);
              auto r32_ = __builtin_amdgcn_permlane32_swap(au, au, false, false);
              const float B = __uint_as_float(r32_[0] == au ? r32_[1] : r32_[0]);
              const float rc = __builtin_amdgcn_rcpf(sseg == 0 ? A : p);
              SEGs[sseg * 128 + sk] = sseg < 2 ? rc : (sseg == 2 ? 1.f : x16);
              po = sseg == 0 ? x16 * B : (sseg == 1 ? B : (sseg == 2 ? x16 : 1.f));
              if (sseg < 2) DEC[sseg * 128 + sk] = sseg == 0 ? A * B : A; }
            } else {
#pragma unroll
                for (int i = 0; i < 16; ++i) klp[i] = 0.f;
                po = 0.f; }
            __syncthreads();
        }
#undef HG_LOADF
#undef HG_LOADQ
    }
}

constexpr int MOE_IG = NE * (DM / 64) * (DE / 64);
constexpr int MOE_PRE = 2048;
struct MoeItems { const float* wg; const float* wu; const float* wd; unsigned char* ws;
    __device__ TrItem operator()(int it) const { TrItem t; t.gk = nullptr;
        const int which = it / MOE_IG, r = it % MOE_IG;
        if (which < 2) { const int e = r / 256, q = r % 256, kb = q / 8, nb = q % 8, n0 = 64 * nb;
            t.src = (which ? wu : wg) + (size_t)e * DM * DE + (size_t)(64 * kb) * DE + n0;
            t.dst = (bf16_t*)(ws + WS_D) + ((size_t)e * 1024 + (n0 >> 7) * 256 + (n0 & 127) + which * 128) * DM + 64 * kb; t.dst2 = t.dst + (size_t)32 * DM; t.N = DE; t.ldt = DM; }
        else { const int e = r / 256, q = r % 256, kb = q / 32, nb = q % 32, n0 = 64 * nb;
            t.src = wd + (size_t)e * DE * DM + (size_t)(64 * kb) * DM + n0;
            t.dst = (bf16_t*)(ws + WS_E) + ((size_t)e * DM + n0) * DE + 64 * kb; t.dst2 = t.dst + (size_t)32 * DE; t.N = DM; t.ldt = DE; }
        return t; } };

__device__ __forceinline__ void p3_phase(Frame& F, const Args& a) {
    OPAQUE_FRAME(F);
    const int role = ((int)blockIdx.x >> 3) & 1, idx = ((int)blockIdx.x >> 4) * 8 + ((int)blockIdx.x & 7), half = F.G >> 1;
    unsigned char* ws = F.ws;
    #ifndef MK_HGREP
#define MK_HGREP 1
#endif
    if (role == 0) { for (int rep = 0; rep < MK_HGREP; ++rep) { for (int it = idx; it < NB * HH * 2; it += half) hgrn_chunked(F, a, it); if (MK_HGREP > 1) __syncthreads(); } }
    else {
        { pg8::Gemm g{(const bf16_t*)(ws + WS_A) + C_QA, (const bf16_t*)(ws + WS_WQUP), INCP, QLORA, QLORA};
          pg8::DenseOrder S; S.init(T / 256, MH * MQK / 256, half, idx);
          pg8::EpiStore E{(bf16_t*)(ws + WS_B), MH * MQK, (const float*)(ws + WS_RSTDQ), 1.f / QLORA};
          pg8::gemm_phase<pg8::EpiStore, pg8::DenseOrder>(F.lds, g, S, E); }
        { pg8::Gemm g{(const bf16_t*)(ws + WS_A) + C_KVA, (const bf16_t*)(ws + WS_WKVUP), INCP, KVLORA, KVLORA};
          pg8::DenseOrder S; S.init(T / 256, MH * 256 / 256, half, idx);
          pg8::EpiStore E{(bf16_t*)(ws + WS_C), MH * 256, (const float*)(ws + WS_RSTDKV), 1.f / KVLORA};
          pg8::gemm_phase<pg8::EpiStore, pg8::DenseOrder>(F.lds, g, S, E); }
        { const MoeItems mk{a.in[22], a.in[23], a.in[24], ws};
          tr_run(idx * NWAVES + F.wave, half * NWAVES, MOE_PRE, mk, F.lds + F.wave * 8192, F.lane); }
    }
}

__device__ __forceinline__ float sum8(float v) { v += __shfl_xor(v, 1); v += __shfl_xor(v, 2); v += __shfl_xor(v, 4); return v; }

struct P5Set { u32x4 k0, k1, kpe, m0, m1, g0, g1; f32x4 ca, cb, sa, sb; };
__device__ __forceinline__ void p5_phase(Frame& F, const Args& a) {
    OPAQUE_FRAME(F);
    const int gw = F.vcu * NWAVES + F.wave, NGW = F.G * NWAVES;
    const bf16_t* PROJ = (const bf16_t*)(F.ws + WS_A);
    const bf16_t* KV = (const bf16_t*)(F.ws + WS_C);
    bf16_t* Kn = (bf16_t*)(F.ws + WS_F);
    bf16_t* MIX = (bf16_t*)F.out;
    const float* rc = (const float*)(F.ws + WS_ROPEC); const float* rsn = (const float*)(F.ws + WS_ROPES);
    const int h = F.lane >> 3, sub = F.lane & 7;
    const float sgn = sub < 4 ? -1.f : 1.f;
    float gk[3][8], go[2][8];
#pragma unroll
    for (int i = 0; i < 3; ++i)
#pragma unroll
        for (int j = 0; j < 8; ++j) gk[i][j] = a.in[14][(sub + 8 * i) * 8 + j];
#pragma unroll
    for (int i = 0; i < 2; ++i)
#pragma unroll
        for (int j = 0; j < 8; ++j) go[i][j] = a.in[8][(sub + 8 * i) * 8 + j];
#define P5_LD(t_, S_) do { const size_t t__ = (size_t)(t_); const int ii_ = (sub & 3) * 8; \
        S_.k0 = __builtin_nontemporal_load((const u32x4*)(KV + t__ * (MH * 256) + h * 256 + sub * 8)); S_.k1 = __builtin_nontemporal_load((const u32x4*)(KV + t__ * (MH * 256) + h * 256 + (sub + 8) * 8)); \
        S_.kpe = *(const u32x4*)(PROJ + t__ * INCP + C_KPE + sub * 8); \
        S_.ca = *(const f32x4*)(rc + t__ * 32 + ii_); S_.cb = *(const f32x4*)(rc + t__ * 32 + ii_ + 4); S_.sa = *(const f32x4*)(rsn + t__ * 32 + ii_); S_.sb = *(const f32x4*)(rsn + t__ * 32 + ii_ + 4); \
        S_.m0 = *(const u32x4*)(MIX + t__ * DM + h * 128 + sub * 8); S_.m1 = *(const u32x4*)(MIX + t__ * DM + h * 128 + (sub + 8) * 8); \
        S_.g0 = __builtin_nontemporal_load((const u32x4*)(PROJ + t__ * INCP + 3 * HW + h * 128 + sub * 8)); S_.g1 = __builtin_nontemporal_load((const u32x4*)(PROJ + t__ * INCP + 3 * HW + h * 128 + (sub + 8) * 8)); } while (0)
#define P5_CP(t_, S_) do { const int t__ = (t_), b_ = t__ / SEQ, s_ = t__ % SEQ; const size_t hrow = ((size_t)(b_ * MH + h) * SEQ + s_); \
        { float k[3][8]; float ss = 0.f; unpack8(S_.k0, k[0]); unpack8(S_.k1, k[1]); unpack8(S_.kpe, k[2]); \
          _Pragma("unroll") for (int i = 0; i < 3; ++i) _Pragma("unroll") for (int j = 0; j < 8; ++j) ss += k[i][j] * k[i][j]; \
          const float rs = rsqrtf(sum8(ss) * (1.f / MQK) + EPS); \
          _Pragma("unroll") for (int i = 0; i < 3; ++i) _Pragma("unroll") for (int j = 0; j < 8; ++j) k[i][j] *= rs * gk[i][j]; \
          _Pragma("unroll") for (int j = 0; j < 8; ++j) { const float pv = __shfl_xor(k[2][j], 4); const float cs_ = j < 4 ? S_.ca[j & 3] : S_.cb[j & 3], sn_ = j < 4 ? S_.sa[j & 3] : S_.sb[j & 3]; k[2][j] = k[2][j] * cs_ + sgn * pv * sn_; } \
          _Pragma("unroll") for (int i = 0; i < 3; ++i) *(u32x4*)(Kn + hrow * MQK + (sub + 8 * i) * 8) = pack8f(k[i]); } \
        { float o[2][8], gt[2][8]; float ss = 0.f; unpack8(S_.m0, o[0]); unpack8(S_.m1, o[1]); unpack8(S_.g0, gt[0]); unpack8(S_.g1, gt[1]); \
          _Pragma("unroll") for (int i = 0; i < 2; ++i) _Pragma("unroll") for (int j = 0; j < 8; ++j) ss += o[i][j] * o[i][j]; \
          const float rs = rsqrtf(sum8(ss) * (1.f / HDV) + EPS); \
          _Pragma("unroll") for (int i = 0; i < 2; ++i) { _Pragma("unroll") for (int j = 0; j < 8; ++j) o[i][j] = o[i][j] * rs * go[i][j] * siluf(gt[i][j]); \
              *(u32x4*)(MIX + (size_t)t__ * DM + h * 128 + (sub + 8 * i) * 8) = pack8f(o[i]); } } } while (0)
    for (int blk = gw; blk < T / 8; blk += NGW) { const int t0 = blk * 8;
        P5Set A, B;
        P5_LD(t0, A);
#pragma unroll 1
        for (int r = 0; r < 8; r += 2) {
            P5_LD(t0 + r + 1, B); __builtin_amdgcn_sched_barrier(0);
            P5_CP(t0 + r, A); __builtin_amdgcn_sched_barrier(0);
            if (r + 2 < 8) { P5_LD(t0 + r + 2, A); } __builtin_amdgcn_sched_barrier(0);
            P5_CP(t0 + r + 1, B); __builtin_amdgcn_sched_barrier(0);
        }
    }
#undef P5_LD
#undef P5_CP
}
namespace att {
constexpr int QBLK = 32, KVBLK = 64, QB = 256;
constexpr int KROW = 512, SHM_K = KVBLK * KROW, SHM_V = KVBLK * MV * 2;
constexpr int OFF_V = 0, OFF_K = 2 * SHM_V, OFF_WS = OFF_K + 2 * SHM_K;
constexpr float SCALE = 0.07216878364870322f;
constexpr float THR = 8.f;
#define SBAR() __builtin_amdgcn_sched_barrier(0)
__device__ __forceinline__ int v_st(int k, int c) { const int kk = (k & ~0xC) | ((k & 4) << 1) | ((k & 8) >> 1); return ((kk >> 3) * 4 + (c >> 5)) * 512 + ((kk & 7) * 32 + (c & 31)) * 2; }
__device__ __forceinline__ int v_rd_base(int lane) { return ((lane & 3) << 3) | (((lane >> 2) & 3) << 6) | (((lane >> 4) & 1) << 5) | (((lane >> 5) & 1) << 8); }
constexpr int v_rd_off(int d0, int ks, int half) { return d0 * 512 + ks * 4096 + half * 2048; }
__device__ __forceinline__ int crow(int r, int hi) { return (r & 3) + 8 * (r >> 2) + 4 * hi; }
template <int M> __device__ __forceinline__ float swz_xor(float v) { return __builtin_bit_cast(float, __builtin_amdgcn_ds_swizzle(__builtin_bit_cast(int, v), (M << 10) | 0x1F)); }
__device__ __forceinline__ unsigned cvtpk(float lo, float hi) { unsigned r; asm volatile("v_cvt_pk_bf16_f32 %0, %1, %2" : "=v"(r) : "v"(lo), "v"(hi)); return r; }

__device__ __forceinline__ void mask_tile(f32x16& p0, f32x16& p1, int dq) {
    const float NEG = -__builtin_inff();
#pragma unroll
    for (int r = 0; r < 16; ++r) {
        const int c = (r & 3) + 8 * (r >> 2);
        if (dq - c < 0) p0[r] = NEG;
        if (dq - c - 32 < 0) p1[r] = NEG;
    }
}
__device__ __forceinline__ void partialSM(f32x16& p0, f32x16& p1, float& m_reg, float& mn, float& alpha) {
    float pmax = p0[0];
#pragma unroll
    for (int r = 1; r < 16; ++r) pmax = fmaxf(pmax, p0[r]);
#pragma unroll
    for (int r = 0; r < 16; ++r) pmax = fmaxf(pmax, p1[r]);
    { auto rr = __builtin_amdgcn_permlane32_swap(__float_as_uint(pmax), __float_as_uint(pmax), false, false);
      pmax = fmaxf(__uint_as_float(rr[0]), __uint_as_float(rr[1])); }
    constexpr float C2 = 1.4426950408889634f * SCALE;
    if (__builtin_expect(__all((pmax - m_reg) * SCALE <= THR), 1)) { mn = m_reg; alpha = 1.f; }
    else { mn = fmaxf(m_reg, pmax); alpha = __builtin_amdgcn_exp2f((m_reg - mn) * C2); m_reg = mn; }
    const float mnL = -mn * C2;
#pragma unroll
    for (int r = 0; r < 16; ++r) p0[r] = fmaf(p0[r], C2, mnL);
#pragma unroll
    for (int r = 0; r < 16; ++r) p1[r] = fmaf(p1[r], C2, mnL);
#pragma unroll
    for (int r = 0; r < 16; ++r) p0[r] = __builtin_amdgcn_exp2f(p0[r]);
}
__device__ __forceinline__ void finishSM(f32x16& p0, f32x16& p1, float alpha, float& l_reg, bf16x8& pa0, bf16x8& pa1, bf16x8& pa2, bf16x8& pa3) {
#pragma unroll
    for (int r = 0; r < 16; ++r) p1[r] = __builtin_amdgcn_exp2f(p1[r]);
    float ps = 0;
#pragma unroll
    for (int r = 0; r < 16; ++r) ps += p0[r];
#pragma unroll
    for (int r = 0; r < 16; ++r) ps += p1[r];
    { auto rr = __builtin_amdgcn_permlane32_swap(__float_as_uint(ps), __float_as_uint(ps), false, false);
      ps = __uint_as_float(rr[0]) + __uint_as_float(rr[1]); }
    l_reg = l_reg * alpha + ps;
#define PK4(P, B_, OUT) do { unsigned a0 = cvtpk(P[B_+0], P[B_+1]), a1 = cvtpk(P[B_+2], P[B_+3]);                          \
        unsigned b0 = cvtpk(P[B_+4], P[B_+5]), b1 = cvtpk(P[B_+6], P[B_+7]);                                             \
        auto r0 = __builtin_amdgcn_permlane32_swap(a0, b0, false, false); auto r1 = __builtin_amdgcn_permlane32_swap(a1, b1, false, false); \
        u32x4 w = {r0[0], r1[0], r0[1], r1[1]}; OUT = __builtin_bit_cast(bf16x8, w); } while (0)
    PK4(p0, 0, pa0); PK4(p0, 8, pa1); PK4(p1, 0, pa2); PK4(p1, 8, pa3);
#undef PK4
}
template <int KB>
__device__ __forceinline__ void qkt(f32x16& p0, f32x16& p1, LAS unsigned char* lds, int r32, int hi, const bf16x8* qr) {
    p0 = f32x16{}; p1 = f32x16{};
    int sw = r32 & 15; asm volatile("" : "+v"(sw));
    const int rb = OFF_K + KB * SHM_K + r32 * KROW;
    int ab[8];
#pragma unroll
    for (int d = 0; d < 8; ++d) ab[d] = rb + (((2 * d + hi) ^ sw) << 4);
#pragma unroll
    for (int d0 = 0; d0 < 12; ++d0) { const int a = ab[d0 & 7] + (d0 >> 3) * 256;
        const bf16x8 b0 = *(const LAS bf16x8*)(lds + a);
        const bf16x8 b1 = *(const LAS bf16x8*)(lds + a + 32 * KROW);
        p0 = __builtin_amdgcn_mfma_f32_32x32x16_bf16(b0, qr[d0], p0, 0, 0, 0);
        p1 = __builtin_amdgcn_mfma_f32_32x32x16_bf16(b1, qr[d0], p1, 0, 0, 0); }
}
template <int VB>
__device__ __forceinline__ void pv_tile(f32x16* o, int vb0, bf16x8 pa0, bf16x8 pa1, bf16x8 pa2, bf16x8 pa3) {
#define TRRD(dst, off) asm volatile("ds_read_b64_tr_b16 %0, %1 offset:%2" : "=&v"(dst) : "v"(vb0), "i"(off) : "memory")
#define PV_D0(d0) do { s16x4 l0, l1, l2, l3, h0, h1, h2, h3; constexpr int b_ = OFF_V + VB * SHM_V + v_rd_off(d0, 0, 0); \
        TRRD(l0, b_); TRRD(h0, b_ + 2048); TRRD(l1, b_ + 4096); TRRD(h1, b_ + 6144); TRRD(l2, b_ + 8192); TRRD(h2, b_ + 10240); TRRD(l3, b_ + 12288); TRRD(h3, b_ + 14336); \
        asm volatile("s_waitcnt lgkmcnt(0)" ::: "memory"); SBAR();   \
        o[d0] = __builtin_amdgcn_mfma_f32_32x32x16_bf16(pa0, (bf16x8){l0[0], l0[1], l0[2], l0[3], h0[0], h0[1], h0[2], h0[3]}, o[d0], 0, 0, 0);   \
        o[d0] = __builtin_amdgcn_mfma_f32_32x32x16_bf16(pa1, (bf16x8){l1[0], l1[1], l1[2], l1[3], h1[0], h1[1], h1[2], h1[3]}, o[d0], 0, 0, 0);   \
        o[d0] = __builtin_amdgcn_mfma_f32_32x32x16_bf16(pa2, (bf16x8){l2[0], l2[1], l2[2], l2[3], h2[0], h2[1], h2[2], h2[3]}, o[d0], 0, 0, 0);   \
        o[d0] = __builtin_amdgcn_mfma_f32_32x32x16_bf16(pa3, (bf16x8){l3[0], l3[1], l3[2], l3[3], h3[0], h3[1], h3[2], h3[3]}, o[d0], 0, 0, 0); } while (0)
    PV_D0(0); PV_D0(1); PV_D0(2); PV_D0(3);
#undef PV_D0
#undef TRRD
}

constexpr int QP = MH * MQK, VP = MH * 256;
__device__ __forceinline__ void attn_block(const bf16_t* Q, const bf16_t* K, const bf16_t* V, bf16_t* O, int P0, const float* gon, const float* gqn, const float* rc, const float* rsn, LAS unsigned char* lds) {
    int tid = threadIdx.x; asm volatile("" : "+v"(tid));
    const int wid = __builtin_amdgcn_readfirstlane(tid >> 6), lane = tid & 63, r32 = lane & 31, hi = lane >> 5;
    const int NT = P0 / KVBLK + 4;
    const int qlo = P0 + wid * QBLK, qm = qlo + r32 - 4 * hi;
    LAS float* wsf = (LAS float*)(lds + OFF_WS) + wid * 64; LAS float* li_l = wsf; LAS float* al_l = wsf + 32;
    float m_reg = -1e30f, l_reg = 0.f; f32x16 o[4] = {};
    bf16x8 qr[12];
#pragma unroll
    for (int d0 = 0; d0 < 12; ++d0) qr[d0] = *(const bf16x8*)(Q + (size_t)(qlo + r32) * QP + d0 * 16 + hi * 8);
    {
        float ss = 0.f;
#pragma unroll
        for (int d0 = 0; d0 < 12; ++d0) { float f[8]; unpack8(__builtin_bit_cast(u32x4, qr[d0]), f);
#pragma unroll
            for (int j = 0; j < 8; ++j) ss += f[j] * f[j]; }
        { auto rr = __builtin_amdgcn_permlane32_swap(__float_as_uint(ss), __float_as_uint(ss), false, false); ss = __uint_as_float(rr[0]) + __uint_as_float(rr[1]); }
        const float rs = rsqrtf(ss * (1.f / MQK) + EPS);
#pragma unroll
        for (int d0 = 0; d0 < 8; ++d0) { float f[8]; unpack8(__builtin_bit_cast(u32x4, qr[d0]), f); const float* gp = gqn + d0 * 16 + hi * 8;
#pragma unroll
            for (int j = 0; j < 8; ++j) f[j] *= rs * gp[j];
            qr[d0] = __builtin_bit_cast(bf16x8, pack8f(f)); }
#pragma unroll
        for (int dd = 0; dd < 2; ++dd) { float x1[8], x2[8]; unpack8(__builtin_bit_cast(u32x4, qr[8 + dd]), x1); unpack8(__builtin_bit_cast(u32x4, qr[10 + dd]), x2);
            const float* g1p = gqn + 128 + dd * 16 + hi * 8; const float* g2p = g1p + 32; const float* cp = rc + (size_t)(qlo + r32) * 32 + dd * 16 + hi * 8; const float* sp = rsn + (size_t)(qlo + r32) * 32 + dd * 16 + hi * 8;
            const f32x4 c0 = *(const f32x4*)cp, c1 = *(const f32x4*)(cp + 4), s0 = *(const f32x4*)sp, s1 = *(const f32x4*)(sp + 4), ga = *(const f32x4*)g1p, gb = *(const f32x4*)(g1p + 4), gc = *(const f32x4*)g2p, gd = *(const f32x4*)(g2p + 4);
#pragma unroll
            for (int j = 0; j < 8; ++j) { const float a = x1[j] * rs * (j < 4 ? ga[j & 3] : gb[j & 3]), bq = x2[j] * rs * (j < 4 ? gc[j & 3] : gd[j & 3]), c = j < 4 ? c0[j & 3] : c1[j & 3], sn = j < 4 ? s0[j & 3] : s1[j & 3]; x1[j] = a * c - bq * sn; x2[j] = bq * c + a * sn; }
            qr[8 + dd] = __builtin_bit_cast(bf16x8, pack8f(x1)); qr[10 + dd] = __builtin_bit_cast(bf16x8, pack8f(x2)); }
    }
    int ksrc[4], vsrc[2];
#pragma unroll
    for (int i = 0; i < 4; ++i) { const int row = 2 * (wid * 4 + i) + (lane >> 5), c = (lane & 31) ^ (row & 15); ksrc[i] = row * MQK + (c < 24 ? c : 0) * 8; }
#pragma unroll
    for (int i = 0; i < 2; ++i) { const int id = (wid * 2 + i) * 2 + (lane >> 5), kk = ((id >> 2) << 3) | ((lane & 31) >> 2), k = (kk & ~0xC) | ((kk & 4) << 1) | ((kk & 8) >> 1);
        vsrc[i] = k * VP + (id & 3) * 32 + (lane & 3) * 8; }
    const int vb0 = (int)(unsigned)(uintptr_t)lds + v_rd_base(lane);
#define ALOAD(t, bf) do { const bf16_t* kp = K + (size_t)(t) * KVBLK * MQK; const bf16_t* vp = V + (size_t)(t) * KVBLK * VP; \
        _Pragma("unroll") for (int i = 0; i < 4; ++i) __builtin_amdgcn_global_load_lds((const unsigned*)(kp + ksrc[i]), (LAS unsigned*)(lds + OFF_K + (bf) * SHM_K + (wid * 4 + i) * 1024), 16, 0, 0); \
        _Pragma("unroll") for (int i = 0; i < 2; ++i) __builtin_amdgcn_global_load_lds((const unsigned*)(vp + vsrc[i]), (LAS unsigned*)(lds + OFF_V + (bf) * SHM_V + (wid * 2 + i) * 1024), 16, 0, 0); } while (0)
#define RESC(a) do { if (__any((a) < 1.f)) { if (hi == 0) al_l[r32] = (a); asm volatile("s_waitcnt lgkmcnt(0)" ::: "memory"); \
        _Pragma("unroll") for (int d_ = 0; d_ < 4; ++d_) _Pragma("unroll") for (int r = 0; r < 16; ++r) o[d_][r] *= al_l[crow(r, hi)]; } } while (0)
#define STEP(t, BF) do { f32x16 p0, p1; float mn, al; bf16x8 pa0, pa1, pa2, pa3; \
        if ((t) + 1 < NT) ALOAD((t) + 1, 1 - (BF)); \
        SBAR(); qkt<BF>(p0, p1, lds, r32, hi, qr); \
        { const int kb_ = (t) * KVBLK; if (kb_ + KVBLK - 1 > qlo) mask_tile(p0, p1, qm - kb_); } \
        partialSM(p0, p1, m_reg, mn, al); RESC(al); finishSM(p0, p1, al, l_reg, pa0, pa1, pa2, pa3); SBAR(); \
        pv_tile<BF>(o, vb0, pa0, pa1, pa2, pa3); SBAR(); \
        asm volatile("s_waitcnt vmcnt(0)" ::: "memory"); __syncthreads(); } while (0)
    ALOAD(0, 0); asm volatile("s_waitcnt vmcnt(0)" ::: "memory"); __syncthreads();
    for (int t = 0; t < NT; t += 2) { STEP(t, 0); STEP(t + 1, 1); }
#undef STEP
#undef RESC
#undef ALOAD
    if (hi == 0) li_l[r32] = l_reg;
    asm volatile("s_waitcnt lgkmcnt(0)" ::: "memory");
    float gv[4];
#pragma unroll
    for (int d0 = 0; d0 < 4; ++d0) gv[d0] = gon[d0 * 32 + r32];
    float ssr[16];
#pragma unroll
    for (int r = 0; r < 16; ++r) { const float rl = __builtin_amdgcn_rcpf(li_l[crow(r, hi)]); float ss = 0.f;
#pragma unroll
        for (int d0 = 0; d0 < 4; ++d0) { o[d0][r] *= rl; ss += o[d0][r] * o[d0][r]; }
        ssr[r] = ss; }
#pragma unroll
    for (int r = 0; r < 16; ++r) ssr[r] += swz_xor<1>(ssr[r]);
#pragma unroll
    for (int r = 0; r < 16; ++r) ssr[r] += swz_xor<2>(ssr[r]);
#pragma unroll
    for (int r = 0; r < 16; ++r) ssr[r] += swz_xor<4>(ssr[r]);
#pragma unroll
    for (int r = 0; r < 16; ++r) ssr[r] += swz_xor<8>(ssr[r]);
#pragma unroll
    for (int r = 0; r < 16; ++r) ssr[r] += swz_xor<16>(ssr[r]);
#pragma unroll
    for (int r = 0; r < 16; ++r) { const float rs = rsqrtf(ssr[r] * (1.f / MV) + EPS);
        bf16_t* orow = O + (size_t)(qlo + crow(r, hi)) * DM;
#pragma unroll
        for (int d0 = 0; d0 < 4; ++d0) { const float v = o[d0][r] * rs * gv[d0]; const float vn = swz_xor<1>(v);
            if ((r32 & 1) == 0) *(unsigned*)(orow + d0 * 32 + r32) = cvtpk(v, vn); } }
    __syncthreads();
}
#undef SBAR
}

__device__ __forceinline__ void p6_phase(Frame& F, const Args& a) {
    const bf16_t* QH = (const bf16_t*)(F.ws + WS_B); const bf16_t* Kn = (const bf16_t*)(F.ws + WS_F); const bf16_t* KV = (const bf16_t*)(F.ws + WS_C);
    bf16_t* MIX = (bf16_t*)F.out;
    const float* rc = (const float*)(F.ws + WS_ROPEC); const float* rsn = (const float*)(F.ws + WS_ROPES);
    for (int it = F.vcu; it < NB * MH * 4; it += F.G) {
        const int bh = it >> 2, j = it & 3, b = bh >> 3, h = bh & 7;
        const bf16_t* Q = QH + (size_t)(b * SEQ) * att::QP + h * MQK; const bf16_t* K = Kn + (size_t)bh * SEQ * MQK; const bf16_t* V = KV + (size_t)(b * SEQ) * att::VP + h * 256 + 128;
        bf16_t* O = MIX + (size_t)(b * SEQ) * DM + HW + h * MV;
        att::attn_block(Q, K, V, O, (7 - j) * att::QB, a.in[15], a.in[13], rc + (size_t)(b * SEQ) * 32, rsn + (size_t)(b * SEQ) * 32, F.lds);
        att::attn_block(Q, K, V, O, j * att::QB, a.in[15], a.in[13], rc + (size_t)(b * SEQ) * 32, rsn + (size_t)(b * SEQ) * 32, F.lds);
    }
}
__device__ __forceinline__ void p8_phase(Frame& F, const Args& a) {
    OPAQUE_FRAME(F);
    unsigned char* ws = F.ws;
    const float* xin = a.in[0]; const bf16_t* mixo = (const bf16_t*)(ws + WS_F); const float* mod = (const float*)(ws + WS_MOD); const float* g2n = a.in[17];
    const float* wct = (const float*)(ws + WS_WCT);
    bf16_t* H2 = (bf16_t*)(ws + WS_B);
    int* tok_e = (int*)(ws + WS_TOKE); float* tok_w = (float*)(ws + WS_TOKW); int* tok_s = (int*)(ws + WS_TOKS);
    LAS float* red = (LAS float*)F.lds;
    LAS float* ssw = (LAS float*)(F.lds + 98304);
    LAS float* shw = (LAS float*)(F.lds + 100352);
    LAS float* lg = (LAS float*)(F.lds + 101888);
    LAS float* rsl = (LAS float*)(F.lds + 111104);
    const int mr = F.lane & 15, mg = F.lane >> 4;
    const bool conv_first = (F.vcu & 1) != 0;
#pragma unroll 1
    for (int part = 0; part < 2; ++part) {
    if ((part == 0) != conv_first) {
    for (int tile = F.vcu; tile < T / 64; tile += F.G) {
        const int m0 = tile * 64, b = m0 / SEQ;
        const float* modb = mod + b * (6 * DM);
        f32x4 acc[4][3]; float ssp[4] = {0.f, 0.f, 0.f, 0.f}, shacc[3] = {0.f, 0.f, 0.f};
#pragma unroll
        for (int rb = 0; rb < 4; ++rb)
#pragma unroll
            for (int n = 0; n < 3; ++n) acc[rb][n] = (f32x4){0.f, 0.f, 0.f, 0.f};
        const unsigned xo = (unsigned)((m0 + mr) * DM + F.wave * 256 + 4 * mg);
        LAS float* vec = (LAS float*)(F.lds + 112640) + F.wave * 768;
        { const int k4 = F.lane * 4; const unsigned ko_ = (unsigned)(F.wave * 256 + k4) * 4u;
          const f32x4 t0 = *(const f32x4*)((const char*)(modb + 2 * DM) + ko_), t1 = *(const f32x4*)((const char*)(modb + 3 * DM) + ko_), t2 = *(const f32x4*)((const char*)g2n + ko_), t3 = *(const f32x4*)((const char*)(modb + 4 * DM) + ko_);
          *(LAS f32x4*)(vec + k4) = t0; *(LAS f32x4*)(vec + 256 + k4) = t1; *(LAS f32x4*)(vec + 512 + k4) = t2 * (t3 + 1.f); LDS_WAIT(); asm volatile("" ::: "memory"); }
        f32x4 xa[4], xb[4], wa[3], wb[3]; u32x2 ma_[4], mb_[4];
#define P8_LDX(s_, X, M, W) do { const unsigned ko_ = (unsigned)(F.wave * 256 + 16 * (s_) + 4 * mg) * 4u; \
            _Pragma("unroll") for (int n = 0; n < 3; ++n) W[n] = *(const f32x4*)((const char*)wct + (ko_ + (unsigned)((n * 16 + mr) * DM * 4))); \
            _Pragma("unroll") for (int rb = 0; rb < 4; ++rb) { const unsigned eo_ = xo + (unsigned)(rb * 16 * DM + 16 * (s_)); X[rb] = *(const f32x4*)((const char*)xin + eo_ * 4u); M[rb] = *(const u32x2*)((const char*)mixo + eo_ * 2u); } } while (0)
#define P8_CP(s_, X, M, W) do { const int kl_ = 16 * (s_) + 4 * mg; const f32x4 g1v = *(const LAS f32x4*)(vec + kl_), shv = *(const LAS f32x4*)(vec + 256 + kl_), gmv = *(const LAS f32x4*)(vec + 512 + kl_); \
            _Pragma("unroll") for (int n = 0; n < 3; ++n) shacc[n] += (shv.x * W[n].x + shv.y * W[n].y) + (shv.z * W[n].z + shv.w * W[n].w); \
            _Pragma("unroll") for (int rb = 0; rb < 4; ++rb) { const f32x4 v = X[rb] + g1v * (f32x4){bf_lo(M[rb].x), bf_hi(M[rb].x), bf_lo(M[rb].y), bf_hi(M[rb].y)}; \
                ssp[rb] += (v.x * v.x + v.y * v.y) + (v.z * v.z + v.w * v.w); const f32x4 av = v * gmv; \
                _Pragma("unroll") for (int i = 0; i < 4; ++i) _Pragma("unroll") for (int n = 0; n < 3; ++n) acc[rb][n] = __builtin_amdgcn_mfma_f32_16x16x4f32(av[i], W[n][i], acc[rb][n], 0, 0, 0); } } while (0)
        P8_LDX(0, xa, ma_, wa);
#pragma unroll 1
        for (int s = 0; s < 16; s += 2) {
            P8_LDX(s + 1, xb, mb_, wb); __builtin_amdgcn_sched_barrier(0);
            P8_CP(s, xa, ma_, wa); __builtin_amdgcn_sched_barrier(0);
            if (s + 2 < 16) { P8_LDX(s + 2, xa, ma_, wa); } __builtin_amdgcn_sched_barrier(0);
            P8_CP(s + 1, xb, mb_, wb); __builtin_amdgcn_sched_barrier(0);
        }
#undef P8_LDX
#undef P8_CP
#pragma unroll
        for (int rb = 0; rb < 4; ++rb) {
#pragma unroll
            for (int n = 0; n < 3; ++n)
#pragma unroll
                for (int r = 0; r < 4; ++r) red[(F.wave * 64 + rb * 16 + mg * 4 + r) * 48 + n * 16 + mr] = acc[rb][n][r];
            float sp = ssp[rb]; sp += __shfl_xor(sp, 16); sp += __shfl_xor(sp, 32);
            if (mg == 0) ssw[F.wave * 64 + rb * 16 + mr] = sp; }
#pragma unroll
        for (int n = 0; n < 3; ++n) { float sa = shacc[n]; sa += __shfl_xor(sa, 16); sa += __shfl_xor(sa, 32); if (mg == 0) shw[F.wave * 48 + n * 16 + mr] = sa; }
        __syncthreads();
        if (F.tid < 64) { float sv = 0.f;
#pragma unroll
            for (int w = 0; w < 8; ++w) sv += ssw[w * 64 + F.tid];
            rsl[F.tid] = rsqrtf(sv * (1.f / DM) + EPS); }
        __syncthreads();
        for (int idx = F.tid; idx < 64 * 36; idx += NTHR) { const int row = idx / 36, n = idx % 36; float L = 0.f, sw = 0.f;
#pragma unroll
            for (int w = 0; w < 8; ++w) { L += red[(w * 64 + row) * 48 + n]; sw += shw[w * 48 + n]; }
            lg[row * 36 + n] = rsl[row] * L + sw + (n < 4 ? a.in[19][n] : a.in[21][n - 4]); }
        __syncthreads();
        if (F.tid < 64) { const LAS float* l = lg + F.tid * 36; const int t = m0 + F.tid;
            int g = 0; float gm = l[0];
#pragma unroll
            for (int j = 1; j < 4; ++j) if (l[j] > gm) { gm = l[j]; g = j; }
            float den = 0.f;
#pragma unroll
            for (int j = 0; j < 4; ++j) den += __expf(l[j] - gm);
            const float pg = 1.f / den;
            const LAS float* e = l + 4 + g * 8;
            int i1 = 0; float v1 = e[0];
#pragma unroll
            for (int j = 1; j < 8; ++j) if (e[j] > v1) { v1 = e[j]; i1 = j; }
            int i2 = -1; float v2 = -__builtin_inff();
#pragma unroll
            for (int j = 0; j < 8; ++j) if (j != i1 && e[j] > v2) { v2 = e[j]; i2 = j; }
            const float w1 = 1.f / (1.f + __expf(v2 - v1)), w2 = 1.f - w1;
            const int e1 = g * 8 + i1, e2 = g * 8 + i2;
            const int s1 = (int)atomicAdd((unsigned*)(F.ctl + CW_CNT + 64 * e1), 1u), s2 = (int)atomicAdd((unsigned*)(F.ctl + CW_CNT + 64 * e2), 1u);
            tok_e[2 * t] = e1; tok_e[2 * t + 1] = e2; tok_w[2 * t] = pg * w1; tok_w[2 * t + 1] = pg * w2; tok_s[2 * t] = s1; tok_s[2 * t + 1] = s2;
            int* list = (int*)(ws + WS_LIST); list[e1 * T + s1] = t; list[e2 * T + s2] = t; }
        { const int c8 = (F.tid & 255) * 8, rg = F.tid >> 8;
          f32x4 g1a = *(const f32x4*)(modb + 2 * DM + c8), g1b = *(const f32x4*)(modb + 2 * DM + c8 + 4), sha = *(const f32x4*)(modb + 3 * DM + c8), shb = *(const f32x4*)(modb + 3 * DM + c8 + 4);
          const f32x4 gma = *(const f32x4*)(g2n + c8) * (*(const f32x4*)(modb + 4 * DM + c8) + 1.f), gmb = *(const f32x4*)(g2n + c8 + 4) * (*(const f32x4*)(modb + 4 * DM + c8 + 4) + 1.f);
#pragma unroll 1
          for (int j0 = 0; j0 < 32; j0 += 4) {
              f32x4 qa[4], qb[4]; u32x4 qm[4];
#pragma unroll
              for (int u = 0; u < 4; ++u) { const size_t eo = (size_t)(m0 + rg + 2 * (j0 + u)) * DM + c8;
                  qa[u] = __builtin_nontemporal_load((const f32x4*)(xin + eo)); qb[u] = __builtin_nontemporal_load((const f32x4*)(xin + eo + 4)); qm[u] = __builtin_nontemporal_load((const u32x4*)(mixo + eo)); }
              __builtin_amdgcn_sched_barrier(0);
#pragma unroll
              for (int u = 0; u < 4; ++u) { const int row = rg + 2 * (j0 + u); const size_t eo = (size_t)(m0 + row) * DM + c8; const float rs = rsl[row];
                  float mx[8]; unpack8(qm[u], mx);
                  const f32x4 xa = qa[u] + g1a * (f32x4){mx[0], mx[1], mx[2], mx[3]}, xb = qb[u] + g1b * (f32x4){mx[4], mx[5], mx[6], mx[7]};
                  const f32x4 va = xa * rs * gma + sha, vb = xb * rs * gmb + shb;
                  u32x4 w; w.x = cvt_pk_bf16(va.x, va.y); w.y = cvt_pk_bf16(va.z, va.w); w.z = cvt_pk_bf16(vb.x, vb.y); w.w = cvt_pk_bf16(vb.z, vb.w);
                  *(u32x4*)(H2 + eo) = w;
                  u32x4 x1; x1.x = cvt_pk_bf16(xa.x, xa.y); x1.y = cvt_pk_bf16(xa.z, xa.w); x1.z = cvt_pk_bf16(xb.x, xb.y); x1.w = cvt_pk_bf16(xb.z, xb.w);
                  *(u32x4*)((bf16_t*)(ws + WS_F) + eo) = x1; }
              __builtin_amdgcn_sched_barrier(0); } }
        __syncthreads();
    }
    } else {
    LAS unsigned char* Tl = F.lds + F.wave * 8192;
    const int gw = F.vcu * NWAVES + F.wave, NGW = F.G * NWAVES;
    { const MoeItems mk{a.in[22], a.in[23], a.in[24], ws};
      tr_run(MOE_PRE + gw, NGW, 3 * MOE_IG, mk, Tl, F.lane); }
    __syncthreads();
    }
    }
}

constexpr int MOE_TAB_OFF = LDS_USER;
__device__ __forceinline__ LAS int* moe_tables(Frame& F) {
    LAS int* tab = (LAS int*)(F.lds + MOE_TAB_OFF);
    __syncthreads();
    if (F.tid < NE) tab[64 + F.tid] = (int)__hip_atomic_load((unsigned*)(F.ctl + CW_CNT + 64 * F.tid), RLX_AGENT);
    __syncthreads();
    if (F.tid == 0) { int acc = 0;
        for (int e = 0; e < NE; ++e) { tab[e] = acc; acc += ((tab[64 + e] + 255) / 256) * 256; }
        tab[NE] = acc; }
    __syncthreads();
    if (F.tid < 160) { int e = 0; for (int j = 1; j < NE; ++j) if (tab[j] <= F.tid * 256) e = j; tab[128 + F.tid] = e; }
    __syncthreads();
    return tab;
}

__device__ __forceinline__ void p12_phase(Frame& F, const Args& a) {
    OPAQUE_FRAME(F);
    unsigned char* ws = F.ws;
    const bf16_t* Y = (const bf16_t*)(ws + WS_A);
    const float* tok_w = (const float*)(ws + WS_TOKW); const int* tok_s = (const int*)(ws + WS_TOKS);
    const float* mod = (const float*)(ws + WS_MOD);
    const LAS int* tab = moe_tables(F); const int* tok_e = (const int*)(ws + WS_TOKE);
    const int gw = F.vcu * NWAVES + F.wave, NGW = F.G * NWAVES;
#if defined(MK_STAMP) && MK_STAMP >= 0
    const float dscale = 1.f + sqrtf(exp2f(rintf(3.f * log2f(*(const float*)(ws + WS_STAMP + 8) + 1.f) + MK_QSHIFT) * (1.f / 3.f)));
#else
    const float dscale = 1.f;
#endif
    for (int blk = gw; blk < T / 8; blk += NGW) { const int t0 = blk * 8, b = t0 / SEQ;
        const float* g2 = mod + b * (6 * DM) + 5 * DM;
        f32x4 h2[4][2];
#pragma unroll
        for (int j = 0; j < 4; ++j) { const int c = (j * 64 + F.lane) * 8; h2[j][0] = *(const f32x4*)(g2 + c); h2[j][1] = *(const f32x4*)(g2 + c + 4); }
        int dsl = 0; float wl = 0.f;
        if (F.lane < 16) { dsl = tab[tok_e[2 * t0 + F.lane]] + tok_s[2 * t0 + F.lane]; wl = tok_w[2 * t0 + F.lane]; }
#pragma unroll 1
        for (int r = 0; r < 8; ++r) { const int t = t0 + r;
            const float w0 = __shfl(wl, 2 * r), w1 = __shfl(wl, 2 * r + 1); const int d0 = __shfl(dsl, 2 * r), d1 = __shfl(dsl, 2 * r + 1);
            float* orow = F.out + (size_t)t * DM; const bf16_t* mrow = (const bf16_t*)(ws + WS_F) + (size_t)t * DM;
            u32x4 qy0[4], qy1[4], qm[4];
#pragma unroll
            for (int j = 0; j < 4; ++j) { const int c = (j * 64 + F.lane) * 8;
                qy0[j] = __builtin_nontemporal_load((const u32x4*)(Y + (size_t)d0 * DM + c)); qy1[j] = __builtin_nontemporal_load((const u32x4*)(Y + (size_t)d1 * DM + c));
                qm[j] = __builtin_nontemporal_load((const u32x4*)(mrow + c)); }
            __builtin_amdgcn_sched_barrier(0);
#pragma unroll
            for (int j = 0; j < 4; ++j) { const int c = (j * 64 + F.lane) * 8;
                float y0[8], y1[8], mx[8]; unpack8(qy0[j], y0); unpack8(qy1[j], y1); unpack8(qm[j], mx);
                const f32x4 xa = {mx[0], mx[1], mx[2], mx[3]}, xb = {mx[4], mx[5], mx[6], mx[7]};
                f32x4 ra, rb;
#pragma unroll
                for (int i = 0; i < 4; ++i) { ra[i] = (xa[i] + h2[j][0][i] * (w0 * y0[i] + w1 * y1[i])) * dscale; rb[i] = (xb[i] + h2[j][1][i] * (w0 * y0[4 + i] + w1 * y1[4 + i])) * dscale; }
                __builtin_nontemporal_store(ra, (f32x4*)(orow + c)); __builtin_nontemporal_store(rb, (f32x4*)(orow + c + 4)); }
            __builtin_amdgcn_sched_barrier(0); }
    }
}
#ifndef MK_MULTI
#define MK_MULTI 0
#endif
#ifndef MK_LAST_PHASE
#define MK_LAST_PHASE 12
#endif
constexpr int N_PHASES = MK_LAST_PHASE + 1;

template <class P> __device__ __forceinline__ P* uptr(P* p) { const unsigned long long v = (unsigned long long)p;
    const unsigned lo = __builtin_amdgcn_readfirstlane((unsigned)v), hi = __builtin_amdgcn_readfirstlane((unsigned)(v >> 32)); return (P*)(__attribute__((address_space(1))) P*)(((unsigned long long)hi << 32) | lo); }
__global__ void __launch_bounds__(NTHR, 2) mk_fwd(const Args args) {
    extern __shared__ __attribute__((aligned(16))) unsigned char lds_raw[];
    Frame F;
    F.lds = (LAS unsigned char*)lds_raw;
    F.MISC = (volatile LAS unsigned*)(F.lds + MISC_OFF);
    F.tid = threadIdx.x; F.lane = F.tid & 63; F.wave = __builtin_amdgcn_readfirstlane(F.tid >> 6);
    F.G = gridDim.x; { const int bx = blockIdx.x; F.vcu = (F.G % 8 == 0) ? (bx % 8) * (F.G / 8) + bx / 8 : bx; }
    F.ws = uptr(args.ws); F.out = uptr(args.out);
    F.ctl = (gu32*)(F.ws + WS_CTL);
    for (int u = F.tid; u < (LDS_BYTES - MISC_OFF) / 4; u += NTHR) ((LAS unsigned*)(F.lds + MISC_OFF))[u] = 0u;
    __syncthreads();
    XcdBarrier bar; bar.bar = (unsigned*)(F.ctl + CW_BAR); bar.x = 0; bar.st = nullptr;
#if !MK_MULTI
    bar = xcd_barrier_post((unsigned*)(F.ctl + CW_BAR), F.MISC + 8);
#define GRID_BAR() xcd_barrier(bar)
#else
#define GRID_BAR() do { } while (0)
#endif
    const int lo = args.ph_lo, hi = args.ph_hi;
#ifndef MK_PHMASK
#define MK_PHMASK 0xFFFF
#endif
#define IN(k) (((MK_PHMASK >> (k)) & 1) && lo <= (k) && (k) < hi)
#define SEAM(k) do { if (IN(k) && IN((k) + 1)) GRID_BAR(); } while (0)
#ifndef MK_STAMP
#define MK_STAMP (-1)
#endif
#define STAMP_BEGIN(k) do { if ((k) == MK_STAMP && blockIdx.x == 0 && F.tid == 0) *(unsigned long long*)(ws + WS_STAMP) = __builtin_amdgcn_s_memrealtime(); } while (0)
#define STAMP_END(k) do { if ((k) == MK_STAMP && blockIdx.x == 0 && F.tid == 0) { const unsigned long long t1_ = __builtin_amdgcn_s_memrealtime(); *(float*)(ws + WS_STAMP + 8) = (float)(t1_ - *(unsigned long long*)(ws + WS_STAMP)) * 0.01f; } } while (0)
#ifndef MK_REPEAT
#define MK_REPEAT (-1)
#endif
#ifndef MK_REPN
#define MK_REPN 2
#endif
#define REP(k) _Pragma("unroll") for (int rep_ = 0; rep_ < ((k) == MK_REPEAT ? MK_REPN : 1); ++rep_)
    unsigned char* const ws = F.ws;

    STAMP_BEGIN(0);
    REP(0) if (IN(0)) { if (rep_) GRID_BAR(); p0_phase(F, args); } STAMP_END(0);
    STAMP_BEGIN(1);
    REP(1) if (IN(1)) { if (rep_) GRID_BAR(); p1_phase(F, args); } SEAM(1); STAMP_END(1);
    STAMP_BEGIN(2);
    REP(2) if (IN(2)) { if (rep_) GRID_BAR();
        pg8::Gemm g{(const bf16_t*)(ws + WS_B), (const bf16_t*)(ws + WS_WIN), DM, DM, DM};
        pg8::DenseOrder S; S.init(T / 256, INCP / 256, F.G, (int)blockIdx.x);
        pg8::EpiStore E{(bf16_t*)(ws + WS_A), INCP, nullptr, 0.f, (float*)(ws + WS_RSTDQ), (float*)(ws + WS_RSTDKV), C_QA / 256, C_KVA / 256, C_KPE / 256, HW / 256, 2 * HW / 256};
        pg8::gemm_phase<pg8::EpiStore, pg8::DenseOrder>(F.lds, g, S, E);
    } SEAM(2); STAMP_END(2);
    STAMP_BEGIN(3);
    REP(3) if (IN(3)) { if (rep_) GRID_BAR(); p3_phase(F, args); } if (IN(3) && IN(5)) GRID_BAR(); STAMP_END(3);
    STAMP_BEGIN(5);
    REP(5) if (IN(5)) { if (rep_) GRID_BAR(); p5_phase(F, args); } SEAM(5); STAMP_END(5);
    STAMP_BEGIN(6);
    REP(6) if (IN(6)) { if (rep_) GRID_BAR(); p6_phase(F, args); } SEAM(6); STAMP_END(6);
    STAMP_BEGIN(7);
    REP(7) if (IN(7)) { if (rep_) GRID_BAR();
        pg8::Gemm g{(const bf16_t*)F.out, (const bf16_t*)(ws + WS_WOUT), DM, DM, DM};
        pg8::DenseOrder S; S.init(T / 256, DM / 256, F.G, (int)blockIdx.x);
        pg8::EpiStore E{(bf16_t*)(ws + WS_F), DM, nullptr, 0.f, nullptr, nullptr, 0, 0, 0};
        pg8::gemm_phase<pg8::EpiStore, pg8::DenseOrder>(F.lds, g, S, E);
    } SEAM(7); STAMP_END(7);
#if MK_LAST_PHASE >= 8
    STAMP_BEGIN(8);
    REP(8) if (IN(8)) { if (rep_) GRID_BAR(); p8_phase(F, args); } if (IN(8) && IN(10)) GRID_BAR(); STAMP_END(8);
    STAMP_BEGIN(10);
    REP(10) if (IN(10)) { if (rep_) GRID_BAR();
        const LAS int* tab = moe_tables(F);
        pg8::Gemm g{(const bf16_t*)(ws + WS_B), (const bf16_t*)(ws + WS_D), DM, DM, DM};
        pg8::GroupedOrder S; S.init(4, F.G, F.vcu, tab, (const int*)(ws + WS_LIST));
        pg8::EpiSwiGLU E{(bf16_t*)(ws + WS_C), (unsigned*)(F.ctl + CW_RDY)};
        pg8::gemm_phase<pg8::EpiSwiGLU, pg8::GroupedOrder, true>(F.lds, g, S, E);
    }
    REP(11) if (IN(11)) { if (rep_) GRID_BAR();
        const LAS int* tab = moe_tables(F);
        pg8::Gemm g{(const bf16_t*)(ws + WS_C), (const bf16_t*)(ws + WS_E), DE, DE, DE};
        pg8::RedealOrder S; S.init(8, F.G, F.vcu, tab, 4, (unsigned*)(F.ctl + CW_RDY), 32u, (unsigned*)(F.ctl + CW_TMO));
        pg8::EpiStore E{(bf16_t*)(ws + WS_A), DM, nullptr, 0.f, nullptr, nullptr, 0, 0, 0};
        pg8::gemm_phase<pg8::EpiStore, pg8::RedealOrder>(F.lds, g, S, E);
    } SEAM(11); STAMP_END(11);
    REP(12) if (IN(12)) { if (rep_) GRID_BAR(); p12_phase(F, args); }
#endif
#undef IN
#undef SEAM
}

extern "C" void kernel_launch(void* const* d_in, const int* in_sizes, int n_in, void* d_out, int out_size, void* d_ws, size_t ws_size, hipStream_t stream) {
    static int grid = 0;
    if (grid == 0) {
        if (n_in != 25 || out_size != T * DM || ws_size < WS_END) { fprintf(stderr, "kernel_launch: bad shapes (n_in %d out %d ws %zu)\n", n_in, out_size, ws_size); grid = -1; return; }
        int dev = 0, cus = 0, per_cu = 0;
        if (hipGetDevice(&dev) != hipSuccess || hipDeviceGetAttribute(&cus, hipDeviceAttributeMultiprocessorCount, dev) != hipSuccess) { grid = -1; return; }
        if (hipFuncSetAttribute((const void*)mk_fwd, hipFuncAttributeMaxDynamicSharedMemorySize, LDS_BYTES) != hipSuccess) { fprintf(stderr, "kernel_launch: hipFuncSetAttribute failed\n"); grid = -1; return; }
        if (hipOccupancyMaxActiveBlocksPerMultiprocessor(&per_cu, (const void*)mk_fwd, NTHR, LDS_BYTES) != hipSuccess || per_cu < 1) { fprintf(stderr, "kernel_launch: occupancy query says %d\n", per_cu); }
        (void)hipGetLastError();
        grid = cus;
    }
    if (grid < 0) return;
    (void)hipMemsetAsync((char*)d_ws + WS_CTL, 0, CTL_ZERO_BYTES, stream);
    Args a{};
    for (int i = 0; i < 25; ++i) a.in[i] = (const float*)d_in[i];
    a.out = (float*)d_out; a.ws = (unsigned char*)d_ws;
#if MK_MULTI
    for (int p = 0; p < N_PHASES; ++p) { a.ph_lo = p; a.ph_hi = p + 1; hipLaunchKernelGGL(mk_fwd, dim3(grid), dim3(NTHR), LDS_BYTES, stream, a); }
#else
    a.ph_lo = 0; a.ph_hi = N_PHASES; hipLaunchKernelGGL(mk_fwd, dim3(grid), dim3(NTHR), LDS_BYTES, stream, a);
#endif
}
```

```cpp
#include <hip/hip_runtime.h>
#include <cstdio>
#include <cstdint>

#define GAS __attribute__((address_space(1)))
#define LAS __attribute__((address_space(3)))
typedef unsigned short bf16_t;
typedef short bf16x8 __attribute__((ext_vector_type(8)));
typedef short s16x4 __attribute__((ext_vector_type(4)));
typedef float f32x4 __attribute__((ext_vector_type(4)));
typedef float f32x2 __attribute__((ext_vector_type(2)));
typedef float f32x16 __attribute__((ext_vector_type(16)));
typedef unsigned u32x4 __attribute__((ext_vector_type(4)));
typedef unsigned u32x2 __attribute__((ext_vector_type(2)));
typedef GAS unsigned gu32;
#define RLX_AGENT __ATOMIC_RELAXED, __HIP_MEMORY_SCOPE_AGENT
#define LDS_WAIT() asm volatile("s_waitcnt lgkmcnt(0)" ::: "memory")
#define VM_WAIT() asm volatile("s_waitcnt vmcnt(0)" ::: "memory")

constexpr int DM = 2048, NB = 8, SEQ = 2048, T = NB * SEQ;
constexpr int HW = 1024, HH = 8, HDK = 128, HDV = 128;
constexpr int MH = 8, MNOPE = 128, MROPE = 64, MQK = 192, MV = 128, QLORA = 512, KVLORA = 256;
constexpr int INC = 4 * HW + QLORA + KVLORA + MROPE;
constexpr int INCP = 5120;
constexpr int C_QA = 4096, C_KVA = 4608, C_KPE = 4864;
constexpr int NG = 4, EPG = 8, NE = 32, DE = 512;
constexpr int RMAX = (T * 2 / 256 + NE) * 256;
constexpr float EPS = 1e-6f;
constexpr int NWAVES = 8, NTHR = 512;

typedef __bf16 bf16x2_t __attribute__((ext_vector_type(2)));
__device__ __forceinline__ unsigned cvt_pk_bf16(float lo, float hi) { const f32x2 v = {lo, hi}; return __builtin_bit_cast(unsigned, __builtin_convertvector(v, bf16x2_t)); }
__device__ __forceinline__ float bf_lo(unsigned w) { return __builtin_bit_cast(float, w << 16); }
__device__ __forceinline__ float bf_hi(unsigned w) { return __builtin_bit_cast(float, w & 0xffff0000u); }
__device__ __forceinline__ float bf2f(bf16_t h) { return __builtin_bit_cast(float, (unsigned)h << 16); }
__device__ __forceinline__ float wave_sum(float v) {
#pragma unroll
    for (int o = 1; o < 64; o <<= 1) v += __shfl_xor(v, o);
    return v;
}
__device__ __forceinline__ float siluf(float v) { return v / (1.f + __expf(-v)); }

#define XB_TMO      128
#define XB_XCNT(j)  (256  + 64 * (j))
#define XB_XSUB(j)  (1280 + 64 * (j))
#define XB_XGEN(j)  (2304 + 64 * (j))
#define XB_TOP      3328
#define XB_TOPGEN   3392
#define XCD_BAR_WORDS 3456
#define XB_SPIN_CAP (1u << 18)

__device__ __forceinline__ unsigned xb_ld(unsigned* p)              { return __hip_atomic_load(p, __ATOMIC_RELAXED, __HIP_MEMORY_SCOPE_AGENT); }
__device__ __forceinline__ unsigned xb_add(unsigned* p, unsigned v) { return __hip_atomic_fetch_add(p, v, __ATOMIC_RELAXED, __HIP_MEMORY_SCOPE_AGENT); }
__device__ __forceinline__ unsigned xb_xcc_id() { return (unsigned)__builtin_amdgcn_s_getreg((3 << 11) | 20) & 0xFu; }
#define XB_SPIN(cond, bar) do { unsigned _sp = 0; while (cond) { __builtin_amdgcn_s_sleep(1); \
    if ((++_sp & 255u) == 0u) { if (xb_ld(&(bar)[XB_TMO])) break; if (_sp > XB_SPIN_CAP) { atomicAdd(&(bar)[XB_TMO], 1u); break; } } } } while (0)

struct XcdBarrier {
    unsigned* bar; unsigned x;
    volatile LAS unsigned* st;
};
__device__ __forceinline__ XcdBarrier xcd_barrier_post(unsigned* bar, volatile LAS unsigned* st) {
    XcdBarrier b; b.bar = bar; b.x = xb_xcc_id(); b.st = st;
    if (threadIdx.x == 0) (void)xb_add(&bar[XB_XCNT(b.x)], 1u);
    return b;
}
__device__ __forceinline__ void xcd_barrier_complete(unsigned* bar, unsigned x, unsigned& nloc, unsigned& nx) {
    const unsigned G = gridDim.x * gridDim.y * gridDim.z;
    unsigned sum, cnt, mine, sp = 0u;
    for (;;) {
        sum = 0u; cnt = 0u; mine = 0u;
#pragma unroll
        for (unsigned j = 0; j < 16; ++j) { const unsigned c = xb_ld(&bar[XB_XCNT(j)]); sum += c; cnt += (c > 0u) ? 1u : 0u; mine = (j == x) ? c : mine; }
        if (sum == G) break;
        __builtin_amdgcn_s_sleep(1);
        if ((++sp & 255u) == 0u) { if (xb_ld(&bar[XB_TMO])) break; if (sp > XB_SPIN_CAP) { atomicAdd(&bar[XB_TMO], 1u); break; } }
    }
    nloc = mine > 0u ? mine : 1u; nx = cnt > 0u ? cnt : 1u;
}
__device__ __forceinline__ void xcd_barrier(const XcdBarrier& b) {
    asm volatile("s_waitcnt vmcnt(0)" ::: "memory");
    __syncthreads();
    if (threadIdx.x == 0) {
        unsigned* bar = b.bar;
        __builtin_amdgcn_s_waitcnt(0);
        unsigned nloc = b.st[0], nx = b.st[1];
        if (nloc == 0u) { xcd_barrier_complete(bar, b.x, nloc, nx); b.st[0] = nloc; b.st[1] = nx; }
        const unsigned old = xb_add(&bar[XB_XSUB(b.x)], 1u);
        const unsigned gen = old / nloc;
        if (old + 1u == (gen + 1u) * nloc) {
            __builtin_amdgcn_fence(__ATOMIC_RELEASE, "agent");
            asm volatile("s_waitcnt vmcnt(0)" ::: "memory");
            const unsigned og = xb_add(&bar[XB_TOP], 1u);
            const unsigned tg = og / nx;
            if (og + 1u == (tg + 1u) * nx) xb_add(&bar[XB_TOPGEN], 1u);
            else XB_SPIN(xb_ld(&bar[XB_TOPGEN]) == tg, bar);
            __builtin_amdgcn_fence(__ATOMIC_ACQUIRE, "agent");
            xb_add(&bar[XB_XGEN(b.x)], 1u);
            asm volatile("s_waitcnt vmcnt(0)" ::: "memory");
        } else {
            XB_SPIN(xb_ld(&bar[XB_XGEN(b.x)]) == gen, bar);
            __builtin_amdgcn_fence(__ATOMIC_ACQUIRE, "agent");
            asm volatile("s_waitcnt vmcnt(0)" ::: "memory");
        }
    }
    __syncthreads();
}

namespace pg8 {
constexpr int BM = 256, BK = 64, HALF = 128, HTB = HALF * BK * 2, STAGE_BYTES = 8 * HTB, NXCD = 8, WGM = 8;
__host__ __device__ __forceinline__ int lds_byte(int r, int c) { const int st = (r >> 4) * 2 + (c >> 5), rr = r & 15, cc = c & 31, ob = rr * 64 + cc * 2; return st * 1024 + (ob ^ (((ob >> 9) & 1) << 5)); }
__host__ __device__ __forceinline__ void stage_rc(int b, int& R, int& C) { const int st = b / 1024, sb = b % 1024, swz = sb ^ (((sb >> 9) & 1) << 5); R = (st >> 1) * 16 + swz / 64; C = (st & 1) * 32 + (swz % 64) / 2; }
__host__ __device__ __forceinline__ int perm32(int rho) { const int n = rho >> 4, i = rho & 15; return 8 * (i >> 2) + 4 * n + (i & 3); }

struct Unit { int pm, pn, pb; };
struct Gemm { const bf16_t* A; const bf16_t* Bt; int lda, ldb, K; };

struct DenseOrder {
    int nM, nN, nwg, G, c;
    __device__ void init(int nM_, int nN_, int G_, int c_) { nM = nM_; nN = nN_; nwg = nM * nN; G = G_; c = c_; }
    __device__ bool next(int i, Unit& u) const {
        const long L = (long)i * G + c; if (L >= nwg) return false;
        int wgid = (int)L; { const int q = nwg / NXCD, r = nwg % NXCD, xcd = wgid % NXCD, off = wgid / NXCD; wgid = (xcd < r ? xcd * (q + 1) : r * (q + 1) + (xcd - r) * q) + off; }
        const int nig = WGM * nN, gid = wgid / nig, fm = gid * WGM, gsz = (nM - fm) < WGM ? (nM - fm) : WGM;
        u.pm = fm + ((wgid % nig) % gsz); u.pn = (wgid % nig) / gsz; u.pb = u.pn; return true;
    }
    __device__ __forceinline__ void a_ready(const Unit&) const {}
};
struct GroupedOrder {
    int nM, nN, nwg, G, c; const LAS int* tile_e; const LAS int* pstart; const LAS int* cnt; const int* list;
    __device__ void init(int nN_, int G_, int c_, const LAS int* tab, const int* list_) { pstart = tab; cnt = tab + 64; tile_e = tab + 128; list = list_; nM = pstart[32] >> 8; nN = nN_; nwg = nM * nN; G = G_; c = c_; }
    __device__ bool next(int i, Unit& u) const {
        const long L = (long)i * G + c; if (L >= nwg) return false;
        const int w = (int)L; u.pn = w % nN; u.pm = w / nN; u.pb = tile_e[u.pm] * nN + u.pn; return true;
    }
    __device__ int arow(const Unit& u, int r) const { const int e = tile_e[u.pm], j = 256 * u.pm - pstart[e] + r; return j < cnt[e] ? list[e * T + j] : 0; }
    __device__ __forceinline__ void a_ready(const Unit&) const {}
};
struct RedealOrder {
    int nM, nN, nwg, G, c, r10, X, nlight, head; const LAS int* tile_e; unsigned* ready; unsigned need; unsigned* tmo;
    __device__ void init(int nN_, int G_, int c_, const LAS int* tab, int nN10, unsigned* ready_, unsigned need_, unsigned* tmo_) {
        tile_e = tab + 128; nM = tab[32] >> 8; nN = nN_; nwg = nM * nN; G = G_; c = c_; ready = ready_; need = need_; tmo = tmo_;
        r10 = (nM * nN10) % G; X = r10 ? 3 : 0; nlight = G - r10; head = X * nlight < nwg ? X * nlight : nwg; }
    __device__ bool next(int i, Unit& u) const {
        long id;
        if (c >= r10 && X) id = i < X ? (long)i * nlight + (c - r10) : (long)head + (long)(i - X) * G + c;
        else id = (long)head + (long)i * G + c;
        if ((i < X && c >= r10 && id >= head) || id >= nwg) return false;
        u.pm = (int)id / nN; u.pn = (int)id % nN; u.pb = tile_e[u.pm] * nN + u.pn; return true;
    }
    __device__ __forceinline__ void a_ready(const Unit& u) const {
        if (threadIdx.x < 64) {
            unsigned polls = 0;
            while ((unsigned)__builtin_amdgcn_readfirstlane(__hip_atomic_load(ready + 64 * u.pm, __ATOMIC_RELAXED, __HIP_MEMORY_SCOPE_AGENT)) < need) {
                if (++polls > (1u << 16)) { if (threadIdx.x == 0) __hip_atomic_store(tmo, 0xDEAD0000u | (unsigned)u.pm, __ATOMIC_RELAXED, __HIP_MEMORY_SCOPE_AGENT); break; }
                __builtin_amdgcn_s_sleep(2); }
            __builtin_amdgcn_fence(__ATOMIC_ACQUIRE, "agent");
            asm volatile("s_waitcnt vmcnt(0)" ::: "memory");
        }
        asm volatile("" ::: "memory"); __builtin_amdgcn_s_barrier(); asm volatile("" ::: "memory");
    }
};

template <class Epi, class Sched, bool GATHER = false>
__device__ __forceinline__ void gemm_phase(LAS unsigned char* lds, const Gemm g, const Sched& S, const Epi& E) {
    int tid = threadIdx.x; asm volatile("" : "+v"(tid));
    const int wid = __builtin_amdgcn_readfirstlane(tid >> 6), lane = tid & 63, wr = wid >> 2, wc = wid & 3, fr = lane & 15, fq = lane >> 4;
    const int K = g.K, nt = K / BK;
    unsigned voffA[2], voffB[2]; int gR[2], gC[2];
#pragma unroll
    for (int i = 0; i < 2; ++i) { int R, C; stage_rc(tid * 16 + i * 8192, R, C); const int Rb = (R & ~31) + perm32(R & 31); gR[i] = R; gC[i] = C;
        voffA[i] = (unsigned)(R * g.lda + C) * 2u; voffB[i] = (unsigned)(Rb * g.ldb + C) * 2u; }
    const size_t kstep = (size_t)(BK * 2);
    const size_t hsA = (size_t)HALF * g.lda * 2, hsB = (size_t)HALF * g.ldb * 2;
    const unsigned ldsw = (unsigned)wid * 1024u;
    const int aoff = lds_byte(wr * 64 + fr, fq * 8), boff = lds_byte(wc * 32 + fr, fq * 8);
#define PG8_SA(b, h) (((b) * 2 + (h)) * HTB)
#define PG8_SB(b, h) ((4 + (b) * 2 + (h)) * HTB)
#define PG8_STAGE(bufoff, gbase, voff) do { _Pragma("unroll") for (int _i = 0; _i < 2; ++_i) \
        __builtin_amdgcn_global_load_lds((const unsigned*)((const char*)(gbase) + (voff)[_i]), (LAS unsigned*)(lds + (bufoff) + ldsw + _i * 8192), 16, 0, 0); } while (0)
#define PG8_STAGE_A(bufoff, dense_ptr, kbytes, offs) do { if constexpr (GATHER) { PG8_STAGE(bufoff, (const char*)g.A + (kbytes), offs); } else { PG8_STAGE(bufoff, dense_ptr, voffA); } } while (0)
#define PG8_GOFF(u, o0, o1) do { _Pragma("unroll") for (int _i = 0; _i < 2; ++_i) { o0[_i] = (unsigned)(S.arow(u, gR[_i]) * g.lda + gC[_i]) * 2u; o1[_i] = (unsigned)(S.arow(u, gR[_i] + HALF) * g.lda + gC[_i]) * 2u; } } while (0)
#define PG8_LDA(dst, b, h) do { _Pragma("unroll") for (int m = 0; m < 4; ++m) _Pragma("unroll") for (int k = 0; k < 2; ++k) dst[m][k] = *(const LAS bf16x8*)(lds + PG8_SA(b, h) + aoff + m * 2048 + k * 1024); } while (0)
#define PG8_LDB(dst, b, h) do { _Pragma("unroll") for (int n = 0; n < 2; ++n) _Pragma("unroll") for (int k = 0; k < 2; ++k) dst[n][k] = *(const LAS bf16x8*)(lds + PG8_SB(b, h) + boff + n * 2048 + k * 1024); } while (0)
#define PG8_MMA(ai, bj, At, Bt) do { __builtin_amdgcn_s_setprio(1); _Pragma("unroll") for (int m = 0; m < 4; ++m) _Pragma("unroll") for (int n = 0; n < 2; ++n) _Pragma("unroll") for (int k = 0; k < 2; ++k) \
        acc[ai][bj][m][n] = __builtin_amdgcn_mfma_f32_16x16x32_bf16(Bt[n][k], At[m][k], acc[ai][bj][m][n], 0, 0, 0); __builtin_amdgcn_s_setprio(0); } while (0)
#define PG8_WAIT_V(n) asm volatile("s_waitcnt vmcnt(" #n ")" ::: "memory")
#define PG8_WAIT_L(n) asm volatile("s_waitcnt lgkmcnt(" #n ")" ::: "memory")
#define PG8_BAR __builtin_amdgcn_s_barrier()
#define PG8_SCHED __builtin_amdgcn_sched_barrier(0)
    Unit cur, nxt; int ui = 0;
    if (!S.next(0, cur)) return;
    unsigned cO0[2] = {0u, 0u}, cO1[2] = {0u, 0u}, nO0[2] = {0u, 0u}, nO1[2] = {0u, 0u};
    if constexpr (GATHER) { PG8_GOFF(cur, cO0, cO1); }
    S.a_ready(cur);
    f32x4 acc[2][2][4][2];
#pragma unroll
    for (int a = 0; a < 2; ++a)
#pragma unroll
        for (int b = 0; b < 2; ++b)
#pragma unroll
            for (int m = 0; m < 4; ++m)
#pragma unroll
                for (int n = 0; n < 2; ++n) acc[a][b][m][n] = (f32x4){0.f, 0.f, 0.f, 0.f};
    bf16x8 At[4][2], B0[2][2], B1[2][2];
    const char* cA = (const char*)g.A + (GATHER ? (size_t)0 : (size_t)cur.pm * 2 * hsA); const char* cB = (const char*)g.Bt + (size_t)cur.pb * 2 * hsB;
    PG8_STAGE(PG8_SB(0, 0), cB, voffB); PG8_STAGE(PG8_SB(0, 1), cB + hsB, voffB); PG8_STAGE_A(PG8_SA(0, 0), cA, 0, cO0); PG8_STAGE_A(PG8_SA(0, 1), cA + hsA, 0, cO1);
    if (wr == 1) PG8_BAR;
    PG8_WAIT_V(2); PG8_BAR;
    PG8_STAGE(PG8_SB(1, 0), cB + kstep, voffB); PG8_STAGE_A(PG8_SA(1, 0), cA + kstep, kstep, cO0); PG8_STAGE(PG8_SB(1, 1), cB + hsB + kstep, voffB);
    PG8_WAIT_V(6); PG8_BAR;
    for (;;) {
        const bool has_next = S.next(ui + 1, nxt);
        const char* nA = (has_next && !GATHER) ? (const char*)g.A + (size_t)nxt.pm * 2 * hsA : cA; const char* nB = has_next ? (const char*)g.Bt + (size_t)nxt.pb * 2 * hsB : cB;
        if constexpr (GATHER) { if (has_next) { PG8_GOFF(nxt, nO0, nO1); } else { nO0[0] = cO0[0]; nO0[1] = cO0[1]; nO1[0] = cO1[0]; nO1[1] = cO1[1]; } }
        for (int t = 0; t < nt; t += 2) {
            const bool last = (t == nt - 2);
            if (last && has_next) S.a_ready(nxt);
            const char* a1 = cA + (size_t)(t + 1) * kstep;
            const char* a2 = last ? nA : cA + (size_t)(t + 2) * kstep; const char* b2 = last ? nB : cB + (size_t)(t + 2) * kstep;
            const char* a3 = a2 + kstep; const char* b3 = b2 + kstep;
            const size_t k2 = last ? (size_t)0 : (size_t)(t + 2) * kstep;
            unsigned o0[2], o1[2]; o0[0] = last ? nO0[0] : cO0[0]; o0[1] = last ? nO0[1] : cO0[1]; o1[0] = last ? nO1[0] : cO1[0]; o1[1] = last ? nO1[1] : cO1[1];
            PG8_LDB(B0, 0, 0); PG8_LDB(B1, 0, 1); PG8_SCHED; PG8_LDA(At, 0, 0); PG8_STAGE_A(PG8_SA(1, 1), a1 + hsA, (size_t)(t + 1) * kstep, cO1);
            PG8_WAIT_V(8); PG8_WAIT_L(0); PG8_BAR; PG8_MMA(0, 0, At, B0); PG8_MMA(0, 1, At, B1); PG8_BAR; PG8_SCHED;
            PG8_LDA(At, 0, 1); PG8_STAGE(PG8_SB(0, 0), b2, voffB); PG8_STAGE(PG8_SB(0, 1), b2 + hsB, voffB); PG8_STAGE_A(PG8_SA(0, 0), a2, k2, o0);
            PG8_WAIT_V(8); PG8_WAIT_L(0); PG8_BAR; PG8_MMA(1, 0, At, B0); PG8_MMA(1, 1, At, B1); PG8_BAR; PG8_SCHED;
            PG8_LDB(B0, 1, 0); PG8_LDB(B1, 1, 1); PG8_SCHED; PG8_LDA(At, 1, 0); PG8_STAGE_A(PG8_SA(0, 1), a2 + hsA, k2, o1);
            PG8_WAIT_V(8); PG8_WAIT_L(0); PG8_BAR; PG8_MMA(0, 0, At, B0); PG8_MMA(0, 1, At, B1); PG8_BAR; PG8_SCHED;
            PG8_LDA(At, 1, 1); PG8_STAGE(PG8_SB(1, 0), b3, voffB); PG8_STAGE(PG8_SB(1, 1), b3 + hsB, voffB); PG8_STAGE_A(PG8_SA(1, 0), a3, k2 + kstep, o0);
            PG8_WAIT_V(8); PG8_WAIT_L(0); PG8_BAR; PG8_MMA(1, 0, At, B0); PG8_MMA(1, 1, At, B1); PG8_BAR; PG8_SCHED;
        }
        if (wr == 0) PG8_BAR;
        E(acc, cur, wr, wc, fr, fq);
        if (!has_next) break;
#pragma unroll
        for (int a = 0; a < 2; ++a)
#pragma unroll
            for (int b = 0; b < 2; ++b)
#pragma unroll
                for (int m = 0; m < 4; ++m)
#pragma unroll
                    for (int n = 0; n < 2; ++n) acc[a][b][m][n] = (f32x4){0.f, 0.f, 0.f, 0.f};
        cur = nxt; cA = nA; cB = nB; ++ui;
        if constexpr (GATHER) { cO0[0] = nO0[0]; cO0[1] = nO0[1]; cO1[0] = nO1[0]; cO1[1] = nO1[1]; }
        if (wr == 1) PG8_BAR;
    }
    PG8_WAIT_V(0);
    PG8_BAR;
#undef PG8_SA
#undef PG8_SB
#undef PG8_STAGE
#undef PG8_STAGE_A
#undef PG8_GOFF
#undef PG8_LDA
#undef PG8_LDB
#undef PG8_MMA
#undef PG8_WAIT_V
#undef PG8_WAIT_L
#undef PG8_BAR
#undef PG8_SCHED
}

struct EpiStore {
    bf16_t* O; int ldc; const float* ssq; float inv; float* ssq_out0; float* ssq_out1; int pn0, pn1, pn2;
    int sg0 = 0, sg1 = 0;
    __device__ __forceinline__ void operator()(const f32x4 (&acc)[2][2][4][2], const Unit& u, int wr, int wc, int fr, int fq) const {
        const int row0 = u.pm * BM + wr * 64 + fr, col0 = u.pn * BM + wc * 32 + 8 * fq;
        float* so = (ssq_out0 && u.pn >= pn0 && u.pn < pn2) ? (u.pn < pn1 ? ssq_out0 : ssq_out1) : nullptr;
        const bool sig = u.pn >= sg0 && u.pn < sg1;
        float rsv[2][4];
#pragma unroll
        for (int ai = 0; ai < 2; ++ai)
#pragma unroll
            for (int m = 0; m < 4; ++m) rsv[ai][m] = ssq ? ssq[row0 + ai * HALF + m * 16] : 0.f;
#pragma unroll
        for (int ai = 0; ai < 2; ++ai)
#pragma unroll
            for (int m = 0; m < 4; ++m) { const int row = row0 + ai * HALF + m * 16; const float rs = ssq ? rsqrtf(rsv[ai][m] * inv + EPS) : 1.f;
                bf16_t* rowp = O + (size_t)row * ldc + col0; float ss = 0.f;
#pragma unroll
                for (int bj = 0; bj < 2; ++bj) { f32x4 v0 = acc[ai][bj][m][0] * rs, v1 = acc[ai][bj][m][1] * rs;
                    if (sig) {
#pragma unroll
                        for (int j = 0; j < 4; ++j) { v0[j] = __builtin_amdgcn_rcpf(1.f + __builtin_amdgcn_exp2f(1.4426950408889634f * v0[j])); v1[j] = __builtin_amdgcn_rcpf(1.f + __builtin_amdgcn_exp2f(1.4426950408889634f * v1[j])); } }
                    ss += (v0[0] * v0[0] + v0[1] * v0[1]) + (v0[2] * v0[2] + v0[3] * v0[3]) + (v1[0] * v1[0] + v1[1] * v1[1]) + (v1[2] * v1[2] + v1[3] * v1[3]);
                    u32x4 w; w.x = cvt_pk_bf16(v0[0], v0[1]); w.y = cvt_pk_bf16(v0[2], v0[3]); w.z = cvt_pk_bf16(v1[0], v1[1]); w.w = cvt_pk_bf16(v1[2], v1[3]);
                    *(u32x4*)(rowp + bj * HALF) = w; }
                if (so) { ss += __shfl_xor(ss, 16); ss += __shfl_xor(ss, 32); if (fq == 0) atomicAdd(so + row, ss); } }
    }
};
struct EpiStoreRdy {
    bf16_t* O; int ldc; unsigned* ready;
    __device__ __forceinline__ void operator()(const f32x4 (&acc)[2][2][4][2], const Unit& u, int wr, int wc, int fr, int fq) const {
        const int row0 = u.pm * BM + wr * 64 + fr, col0 = u.pn * BM + wc * 32 + 8 * fq;
        const __amdgpu_buffer_rsrc_t rs = __builtin_amdgcn_make_buffer_rsrc((void*)O, (short)0, 0x7FFFF000, 0x00020000);
#pragma unroll
        for (int ai = 0; ai < 2; ++ai)
#pragma unroll
            for (int m = 0; m < 4; ++m) { const int row = row0 + ai * HALF + m * 16;
#pragma unroll
                for (int bj = 0; bj < 2; ++bj) { const f32x4 v0 = acc[ai][bj][m][0], v1 = acc[ai][bj][m][1];
                    u32x4 w; w.x = cvt_pk_bf16(v0[0], v0[1]); w.y = cvt_pk_bf16(v0[2], v0[3]); w.z = cvt_pk_bf16(v1[0], v1[1]); w.w = cvt_pk_bf16(v1[2], v1[3]);
                    __builtin_amdgcn_raw_buffer_store_b128(w, rs, (unsigned)(row * ldc + col0 + bj * HALF) * 2u, 0, 16); } }
        asm volatile("s_waitcnt vmcnt(0)" ::: "memory");
        if ((threadIdx.x & 63) == 0) __hip_atomic_fetch_add(ready + 64 * u.pm, 1u, __ATOMIC_RELAXED, __HIP_MEMORY_SCOPE_AGENT);
    }
};
struct EpiResid {
    const float* X; float* O; const float* gate; int gpitch;
    __device__ __forceinline__ void operator()(const f32x4 (&acc)[2][2][4][2], const Unit& u, int wr, int wc, int fr, int fq) const {
        const int row0 = u.pm * BM + wr * 64 + fr, col0 = u.pn * BM + wc * 32 + 8 * fq;
        const float* gp = gate + (size_t)((u.pm * BM) / SEQ) * gpitch + col0;
        f32x4 gv[2][2];
#pragma unroll
        for (int bj = 0; bj < 2; ++bj)
#pragma unroll
            for (int n = 0; n < 2; ++n) gv[bj][n] = *(const f32x4*)(gp + bj * HALF + 4 * n);
#pragma unroll
        for (int ai = 0; ai < 2; ++ai)
#pragma unroll
            for (int m = 0; m < 4; ++m) { const size_t off = (size_t)(row0 + ai * HALF + m * 16) * DM + col0;
#pragma unroll
                for (int bj = 0; bj < 2; ++bj)
#pragma unroll
                    for (int n = 0; n < 2; ++n) { const f32x4 xv = *(const f32x4*)(X + off + bj * HALF + 4 * n);
                        *(f32x4*)(O + off + bj * HALF + 4 * n) = xv + gv[bj][n] * acc[ai][bj][m][n]; } }
    }
};
struct EpiSwiGLU {
    bf16_t* O; unsigned* ready;
    __device__ __forceinline__ void operator()(const f32x4 (&acc)[2][2][4][2], const Unit& u, int wr, int wc, int fr, int fq) const {
        const int row0 = u.pm * BM + wr * 64 + fr, col0 = u.pn * HALF + wc * 32 + 8 * fq;
        const __amdgpu_buffer_rsrc_t rs = __builtin_amdgcn_make_buffer_rsrc((void*)O, (short)0, RMAX * DE * 2, 0x00020000);
#pragma unroll
        for (int ai = 0; ai < 2; ++ai)
#pragma unroll
            for (int m = 0; m < 4; ++m) { const int row = row0 + ai * HALF + m * 16;
                float h[8];
#pragma unroll
                for (int n = 0; n < 2; ++n)
#pragma unroll
                    for (int j = 0; j < 4; ++j) { const float gt = acc[ai][0][m][n][j], up = acc[ai][1][m][n][j]; h[4 * n + j] = gt * __builtin_amdgcn_rcpf(1.f + __builtin_amdgcn_exp2f(-1.4426950408889634f * gt)) * up; }
                u32x4 w; w.x = cvt_pk_bf16(h[0], h[1]); w.y = cvt_pk_bf16(h[2], h[3]); w.z = cvt_pk_bf16(h[4], h[5]); w.w = cvt_pk_bf16(h[6], h[7]);
                __builtin_amdgcn_raw_buffer_store_b128(w, rs, (unsigned)(row * DE + col0) * 2u, 0, 16); }
        asm volatile("s_waitcnt vmcnt(0)" ::: "memory");
        if ((threadIdx.x & 63) == 0) __hip_atomic_fetch_add(ready + 64 * u.pm, 1u, __ATOMIC_RELAXED, __HIP_MEMORY_SCOPE_AGENT);
    }
};
}
constexpr size_t MiB = 1u << 20;
constexpr size_t WS_CTL = 0, CTL_ZERO_BYTES = 128 * 1024;
constexpr size_t WS_MOD = 1 * MiB;
constexpr size_t WS_ROPEC = 1 * MiB + 512 * 1024;
constexpr size_t WS_ROPES = WS_ROPEC + 2 * MiB;
constexpr size_t WS_WCT = WS_ROPES + 2 * MiB;
constexpr size_t WS_RSTDQ = 6 * MiB;
constexpr size_t WS_RSTDKV = WS_RSTDQ + 64 * 1024;
constexpr size_t WS_TOKE = WS_RSTDKV + 64 * 1024;
constexpr size_t WS_TOKW = WS_TOKE + 128 * 1024;
constexpr size_t WS_TOKS = WS_TOKW + 128 * 1024;
constexpr size_t WS_BLKE = WS_TOKS + 128 * 1024;
constexpr size_t WS_STAMP = WS_BLKE + 4096;
constexpr size_t WS_WIN = 8 * MiB;
constexpr size_t WS_WQUP = 28 * MiB;
constexpr size_t WS_WKVUP = WS_WQUP + 1536 * 1024;
constexpr size_t WS_WOUT = 31 * MiB;
constexpr size_t WS_A = 40 * MiB;
constexpr size_t WS_B = 200 * MiB;
constexpr size_t WS_C = 264 * MiB;
constexpr size_t WS_D = 328 * MiB;
constexpr size_t WS_E = 456 * MiB;
constexpr size_t WS_LIST = 520 * MiB;
constexpr size_t WS_F = 522 * MiB;
constexpr size_t WS_END = 586 * MiB;
constexpr size_t QN_BYTES = (size_t)T * MH * MQK * 2;

constexpr int CW_BAR = 4096;
constexpr int CW_CNT = 8192;
constexpr int CW_RDY = 10240;
constexpr int CW_R7 = 24576;
constexpr int CW_ADA = 64;
constexpr int CW_TMO = 1;

constexpr int RING_BYTES = 131072, LDS_BYTES = 147456, LDS_USER = 143360, MISC_OFF = LDS_BYTES - 512;

struct Args { const float* in[25]; float* out; unsigned char* ws; int ph_lo, ph_hi, pad0, pad1; };

struct Frame {
    LAS unsigned char* lds;
    volatile LAS unsigned* MISC;
    gu32* ctl;
    int tid, lane, wave, vcu, G;
    unsigned char* ws; float* out;
};

#define OPAQUE_FRAME(F) do { F.tid = threadIdx.x; asm volatile("" : "+v"(F.tid)); F.lane = F.tid & 63; } while (0)

__device__ __forceinline__ void unpack8(const u32x4 w, float* f) { f[0] = bf_lo(w.x); f[1] = bf_hi(w.x); f[2] = bf_lo(w.y); f[3] = bf_hi(w.y); f[4] = bf_lo(w.z); f[5] = bf_hi(w.z); f[6] = bf_lo(w.w); f[7] = bf_hi(w.w); }
__device__ __forceinline__ u32x4 pack8f(const float* f) { u32x4 w; w.x = cvt_pk_bf16(f[0], f[1]); w.y = cvt_pk_bf16(f[2], f[3]); w.z = cvt_pk_bf16(f[4], f[5]); w.w = cvt_pk_bf16(f[6], f[7]); return w; }

struct TrItem { const float* src; bf16_t* dst; bf16_t* dst2; const float* gk; int N, ldt; };
__device__ __forceinline__ void tr_load(const TrItem& it, f32x4 (&r)[16], int lane) {
    const float* p = it.src + (size_t)(lane >> 4) * it.N + 4 * (lane & 15);
#pragma unroll
    for (int i = 0; i < 16; ++i) r[i] = __builtin_nontemporal_load((const f32x4*)(p + (size_t)(4 * i) * it.N));
}
__device__ __forceinline__ void tr_store(const TrItem& it, const f32x4 (&r)[16], LAS unsigned char* Tl, int lane) {
    const int row = lane >> 4, c4 = lane & 15;
#pragma unroll
    for (int i = 0; i < 16; ++i) { f32x4 v = r[i]; if (it.gk) v = v * it.gk[4 * i + row];
        u32x2 w; w.x = cvt_pk_bf16(v.x, v.y); w.y = cvt_pk_bf16(v.z, v.w);
        *(LAS u32x2*)(Tl + ((4 * i + row) * 64 + 4 * c4) * 2) = w; }
    LDS_WAIT(); asm volatile("" ::: "memory");
    const int g = lane >> 4, i16 = lane & 15, q = i16 >> 2, pp = lane & 3;
    typedef short v4i16_t __attribute__((ext_vector_type(4)));
#pragma unroll
    for (int hh = 0; hh < 2; ++hh) { bf16_t* drow = (hh ? it.dst2 : it.dst) + (size_t)(16 * (g & 1) + i16) * it.ldt;
#pragma unroll
        for (int j = 0; j < 4; ++j) { const int kc = 4 * (g >> 1) + j;
            const v4i16_t lo = __builtin_amdgcn_ds_read_tr16_b64_v4i16((LAS v4i16_t*)(Tl + ((8 * kc + q) * 64 + 32 * hh + 16 * (g & 1) + 4 * pp) * 2));
            const v4i16_t hi = __builtin_amdgcn_ds_read_tr16_b64_v4i16((LAS v4i16_t*)(Tl + ((8 * kc + 4 + q) * 64 + 32 * hh + 16 * (g & 1) + 4 * pp) * 2));
            const bf16x8 o = {lo[0], lo[1], lo[2], lo[3], hi[0], hi[1], hi[2], hi[3]};
            *(bf16x8*)(drow + 8 * kc) = o; } }
    LDS_WAIT(); asm volatile("" ::: "memory");
}
template <class MK> __device__ __forceinline__ void tr_run(int first, int step, int n, const MK& mk, LAS unsigned char* Tl, int lane) {
    if (first >= n) return;
    f32x4 ra[16], rb[16];
    TrItem ia = mk(first), ib = ia;
    tr_load(ia, ra, lane);
    for (int idx = first; idx < n; idx += 2 * step) {
        if (idx + step < n) { ib = mk(idx + step); tr_load(ib, rb, lane); }
        tr_store(ia, ra, Tl, lane);
        if (idx + step >= n) break;
        if (idx + 2 * step < n) { ia = mk(idx + 2 * step); tr_load(ia, ra, lane); }
        tr_store(ib, rb, Tl, lane);
    }
}

__device__ __forceinline__ void adaln_phase(Frame& F, const float* c, const float* w_ada, const float* b_ada, float* mod) {
    LAS float* cact = (LAS float*)F.lds;
    LAS float* part = (LAS float*)(F.lds + 65536);
    for (int i = F.tid; i < NB * DM; i += NTHR) cact[i] = siluf(c[i]);
    __syncthreads();
    const int cg = F.tid & 7, rs = F.tid >> 3;
    for (int it = blockIdx.x; it < 6 * DM / 32; it += F.G) {
        const int n0 = it * 32 + cg * 4;
        f32x4 acc[8];
#pragma unroll
        for (int b = 0; b < 8; ++b) acc[b] = (f32x4){0.f, 0.f, 0.f, 0.f};
#pragma unroll 1
        for (int i0 = 0; i0 < 32; i0 += 32) { f32x4 w[32];
#pragma unroll
            for (int u = 0; u < 32; ++u) w[u] = __builtin_nontemporal_load((const f32x4*)(w_ada + (size_t)(rs + 64 * (i0 + u)) * (6 * DM) + n0));
#pragma unroll
            for (int u = 0; u < 32; ++u) { const int k = rs + 64 * (i0 + u);
#pragma unroll
                for (int b = 0; b < 8; ++b) acc[b] += w[u] * cact[b * DM + k]; } }
#pragma unroll
        for (int b = 0; b < 8; ++b) *(LAS f32x4*)(part + (rs * 8 + b) * 32 + cg * 4) = acc[b];
        __syncthreads();
        if (F.tid < 256) { const int b = F.tid >> 5, n = F.tid & 31; float s = 0.f;
#pragma unroll 8
            for (int r = 0; r < 64; ++r) s += part[(r * 8 + b) * 32 + n];
            __hip_atomic_store(mod + b * (6 * DM) + it * 32 + n, s + b_ada[it * 32 + n], __ATOMIC_RELAXED, __HIP_MEMORY_SCOPE_AGENT); }
        asm volatile("s_waitcnt vmcnt(0)" ::: "memory");
        __syncthreads();
        if (it == (int)blockIdx.x && F.tid == 0) __hip_atomic_fetch_add((unsigned*)(F.ctl + CW_ADA), 1u, __ATOMIC_RELAXED, __HIP_MEMORY_SCOPE_AGENT);
    }
}

__device__ __forceinline__ void p0_phase(Frame& F, const Args& a) {
    OPAQUE_FRAME(F);
    unsigned char* ws = F.ws;
    adaln_phase(F, a.in[1], a.in[3], a.in[4], (float*)(ws + WS_MOD));
    __syncthreads();
    LAS unsigned char* Tl = F.lds + F.wave * 8192;
    const int gw = F.vcu * NWAVES + F.wave, NGW = F.G * NWAVES;
    constexpr int I_IN = (DM / 64) * (INC / 64), I_QUP = (QLORA / 64) * (MH * MQK / 64), I_KVUP = (KVLORA / 64) * (MH * 256 / 64), I_OUT = (DM / 64) * (DM / 64);
    constexpr int NITEMS = I_IN + I_QUP + I_KVUP + I_OUT;
    static_assert(INC % 64 == 0, "64-column transpose items");
    { const float* w_in = a.in[6]; const float* w_qup = a.in[10]; const float* w_kvup = a.in[12]; const float* w_out = a.in[16]; const float* gq = a.in[9]; const float* gkv = a.in[11];
      auto mk = [=](int r) -> TrItem { TrItem t;
          if (r < I_IN) { const int nblk = INC / 64, kb = r / nblk, nb = r % nblk; t.src = w_in + (size_t)(64 * kb) * INC + 64 * nb; t.dst = (bf16_t*)(ws + WS_WIN) + (size_t)(64 * nb) * DM + 64 * kb; t.dst2 = t.dst + (size_t)32 * DM; t.gk = nullptr; t.N = INC; t.ldt = DM; return t; } r -= I_IN;
          if (r < I_QUP) { const int nblk = MH * MQK / 64, kb = r / nblk, nb = r % nblk; t.src = w_qup + (size_t)(64 * kb) * (MH * MQK) + 64 * nb; t.dst = (bf16_t*)(ws + WS_WQUP) + (size_t)(64 * nb) * QLORA + 64 * kb; t.dst2 = t.dst + (size_t)32 * QLORA; t.gk = gq + 64 * kb; t.N = MH * MQK; t.ldt = QLORA; return t; } r -= I_QUP;
          if (r < I_KVUP) { const int nblk = MH * 256 / 64, kb = r / nblk, nb = r % nblk; t.src = w_kvup + (size_t)(64 * kb) * (MH * 256) + 64 * nb; t.dst = (bf16_t*)(ws + WS_WKVUP) + (size_t)(64 * nb) * KVLORA + 64 * kb; t.dst2 = t.dst + (size_t)32 * KVLORA; t.gk = gkv + 64 * kb; t.N = MH * 256; t.ldt = KVLORA; return t; } r -= I_KVUP;
          { const int nblk = DM / 64, kb = r / nblk, nb = r % nblk; t.src = w_out + (size_t)(64 * kb) * DM + 64 * nb; t.dst = (bf16_t*)(ws + WS_WOUT) + (size_t)(64 * nb) * DM + 64 * kb; t.dst2 = t.dst + (size_t)32 * DM; t.gk = nullptr; t.N = DM; t.ldt = DM; return t; } };
      const int nheavy = (6 * DM / 32) - F.G, nlw = (F.G - nheavy) * NWAVES;
      int pre = 0;
      if (nheavy > 0 && nheavy < F.G) { pre = 2 * nlw < NITEMS ? 2 * nlw : NITEMS;
          if ((int)blockIdx.x >= nheavy) tr_run(((int)blockIdx.x - nheavy) * NWAVES + F.wave, nlw, pre, mk, Tl, F.lane); }
      tr_run(pre + gw, NGW, NITEMS, mk, Tl, F.lane); }
    { const int* pos = (const int*)a.in[2]; float* rc = (float*)(ws + WS_ROPEC); float* rsn = (float*)(ws + WS_ROPES);
      const int gt = F.vcu * NTHR + F.tid, NGT = F.G * NTHR;
      const float invf = (float)exp2(-(double)(gt & 31) * (13.287712379549449 / 32.0));
      for (int e = gt; e < T * 32; e += NGT) { const int tk = e >> 5;
          const float ang = (float)pos[tk] * invf; float sv, cv; sincosf(ang, &sv, &cv);
          rc[e] = cv; rsn[e] = sv; }
      { float* ssq = (float*)(ws + WS_RSTDQ); for (int e = gt; e < 2 * T; e += NGT) ssq[e] = 0.f; }
      float* wct = (float*)(ws + WS_WCT);
      for (int e = gt; e < 48 * DM; e += NGT) { const int n = e / DM, k = e % DM;
          wct[e] = n < 4 ? a.in[18][k * NG + n] : (n < 36 ? a.in[20][k * NE + (n - 4)] : 0.f); } }
}

__device__ __forceinline__ void p1_phase(Frame& F, const Args& a) {
    OPAQUE_FRAME(F);
    const int gw = F.vcu * NWAVES + F.wave, NGW = F.G * NWAVES;
    const float* mod = (const float*)(F.ws + WS_MOD); const float* g = a.in[5]; const float* x = a.in[0];
    bf16_t* H = (bf16_t*)(F.ws + WS_B);
    if (F.tid == 0) { unsigned polls = 0;
        while (__hip_atomic_load((unsigned*)(F.ctl + CW_ADA), __ATOMIC_RELAXED, __HIP_MEMORY_SCOPE_AGENT) < (unsigned)F.G) { if (++polls > (1u << 16)) { __hip_atomic_store((unsigned*)(F.ctl + CW_TMO), 0xADA00000u, __ATOMIC_RELAXED, __HIP_MEMORY_SCOPE_AGENT); break; } __builtin_amdgcn_s_sleep(2); }
        __builtin_amdgcn_fence(__ATOMIC_ACQUIRE, "agent"); asm volatile("s_waitcnt vmcnt(0)" ::: "memory"); }
    __syncthreads();
    for (int blk = gw; blk < T / 8; blk += NGW) { const int m0 = blk * 8, b = m0 / SEQ;
        const float* shift = mod + b * (6 * DM); const float* scale = shift + DM;
        f32x4 gm[8], sh[8];
#pragma unroll
        for (int j = 0; j < 8; ++j) { gm[j] = ((const f32x4*)g)[64 * j + F.lane] * (((const f32x4*)scale)[64 * j + F.lane] + 1.f); sh[j] = ((const f32x4*)shift)[64 * j + F.lane]; }
        f32x4 va[8], vb[8];
#define P1_LD(r, V) do { const f32x4* xr_ = (const f32x4*)(x + (size_t)(m0 + (r)) * DM) + F.lane; _Pragma("unroll") for (int j = 0; j < 8; ++j) V[j] = __builtin_nontemporal_load(xr_ + 64 * j); } while (0)
#define P1_ST(r, V) do { float s_ = 0.f; _Pragma("unroll") for (int j = 0; j < 8; ++j) s_ += (V[j].x * V[j].x + V[j].y * V[j].y) + (V[j].z * V[j].z + V[j].w * V[j].w); \
            const float rstd_ = rsqrtf(wave_sum(s_) * (1.f / DM) + EPS); u32x2* o8_ = (u32x2*)(H + (size_t)(m0 + (r)) * DM) + F.lane; \
            _Pragma("unroll") for (int j = 0; j < 8; ++j) { const f32x4 h_ = V[j] * rstd_ * gm[j] + sh[j]; u32x2 w_; w_.x = cvt_pk_bf16(h_.x, h_.y); w_.y = cvt_pk_bf16(h_.z, h_.w); o8_[64 * j] = w_; } } while (0)
        P1_LD(0, va);
#pragma unroll 1
        for (int r = 0; r < 8; r += 2) {
            P1_LD(r + 1, vb); __builtin_amdgcn_sched_barrier(0);
            P1_ST(r, va); __builtin_amdgcn_sched_barrier(0);
            if (r + 2 < 8) { P1_LD(r + 2, va); } __builtin_amdgcn_sched_barrier(0);
            P1_ST(r + 1, vb); __builtin_amdgcn_sched_barrier(0);
        }
#undef P1_LD
#undef P1_ST
    }
}

namespace hg {
constexpr int OFF_F = 0, OFF_SEG = 32768, OFF_QIN = 34816, RP = 272, OFF_KIN = OFF_QIN + 64 * RP, OFF_QB = OFF_KIN + 64 * RP, OFF_KLT = OFF_QB + 64 * RP, SP = 144,
              OFF_VT = OFF_KLT + 128 * SP  , OFF_DEC = OFF_VT + 64 * SP  , OFF_SF = OFF_DEC + 3584  , OP = 144, OFF_O = OFF_SF + 16384  , OFF_LB = OFF_O + 64 * OP  , HG_LDS = OFF_LB + 1024;
static_assert(HG_LDS <= MISC_OFF, "hgrn lds");
__device__ __forceinline__ float dpp_xor1(float v) { return __builtin_bit_cast(float, __builtin_amdgcn_update_dpp(0, __builtin_bit_cast(int, v), 0xB1, 0xF, 0xF, true)); }
__device__ __forceinline__ int ppos(int s) { return (s & ~15) | ((s & 4) << 1) | ((s & 8) >> 1) | (s & 3); }
}
__device__ __forceinline__ void hgrn_chunked(Frame& F, const Args& a, int item) {
    using namespace hg;
    const bf16_t* PROJ = (const bf16_t*)(F.ws + WS_A);
    bf16_t* MIX = (bf16_t*)F.out;
    const float* lbl = a.in[7];
    LAS unsigned char* L = F.lds;
    LAS float* Fs = (LAS float*)(L + OFF_F); LAS float* SEGs = (LAS float*)(L + OFF_SEG); LAS float* DEC = (LAS float*)(L + OFF_DEC);
    const int g = F.tid & 15, t0 = F.tid >> 4;
    const int sk = 16 * F.wave + (F.lane & 15), sseg = F.lane >> 4;
    const int scol = sk ^ ((sseg & 1) << 4);
    const int r32 = F.lane & 31, hi = F.lane >> 5;
    {
        const int dq2 = (item >> 3) & 1, bh = (item >> 4) * 8 + (item & 7), h = bh & 7, b = bh >> 3;
        LAS float* LB = (LAS float*)(L + OFF_LB);
        if (F.tid < 128) { const int k = h * 128 + F.tid; const float l = 1.f / (1.f + __expf(lbl[HW + k] - lbl[k])); LB[F.tid] = l; LB[128 + F.tid] = 1.f - l; }
        __syncthreads();
        const bf16_t* base = PROJ + (size_t)(b * SEQ) * INCP + h * 128;
        f32x16 S0 = {}, S1 = {};
        u32x4 gq[2], gf[2], gv;
#define HG_LOADF(c) do { _Pragma("unroll") for (int i = 0; i < 2; ++i) gf[i] = *(const u32x4*)(base + (size_t)((c) * 64 + t0 + 32 * i) * INCP + g * 8 + HW); } while (0)
#define HG_LOADQ(c) do { _Pragma("unroll") for (int i = 0; i < 2; ++i) gq[i] = *(const u32x4*)(base + (size_t)((c) * 64 + t0 + 32 * i) * INCP + g * 8); \
            gv = *(const u32x4*)(base + (size_t)((c) * 64 + (F.tid >> 3)) * INCP + 2 * HW + dq2 * 64 + (F.tid & 7) * 8); } while (0)
        HG_LOADF(0); HG_LOADQ(0);
        float fv[2][8], klp[16], po = 0.f;
        for (int c = -1; c < SEQ / 64; ++c) {
            if (c >= 0) {
            if (F.wave >= 4) __builtin_amdgcn_s_setprio(1);
            {
              f32x4 pa[2], pb[2], ea[2], eb[2];
#pragma unroll
              for (int i = 0; i < 2; ++i) { const int t = t0 + 32 * i; const LAS float* fp = Fs + t * 128 + ((g * 8) ^ (((t >> 4) & 1) << 4)); const LAS float* pp = SEGs + (t >> 4) * 128 + g * 8;
                  pa[i] = *(const LAS f32x4*)fp; pb[i] = *(const LAS f32x4*)(fp + 4); ea[i] = *(const LAS f32x4*)pp; eb[i] = *(const LAS f32x4*)(pp + 4); }
              __builtin_amdgcn_sched_barrier(0);
            if (F.wave >= 4) { const int kb = F.wave - 4;
                f32x16 Z0, Z1;
#pragma unroll
                for (int q4 = 0; q4 < 4; ++q4) { const f32x4 pmv = *(const LAS f32x4*)(DEC + 128 + 32 * kb + 8 * q4 + 4 * hi);
#pragma unroll
                    for (int j = 0; j < 4; ++j) { Z0[4 * q4 + j] = S0[4 * q4 + j] * pmv[j]; Z1[4 * q4 + j] = S1[4 * q4 + j] * pmv[j]; } }
#pragma unroll
                for (int s2 = 0; s2 < 2; ++s2) { u32x4 w0, w1;
                    w0.x = cvt_pk_bf16(Z0[8 * s2], Z0[8 * s2 + 1]); w0.y = cvt_pk_bf16(Z0[8 * s2 + 2], Z0[8 * s2 + 3]); w0.z = cvt_pk_bf16(Z0[8 * s2 + 4], Z0[8 * s2 + 5]); w0.w = cvt_pk_bf16(Z0[8 * s2 + 6], Z0[8 * s2 + 7]);
                    w1.x = cvt_pk_bf16(Z1[8 * s2], Z1[8 * s2 + 1]); w1.y = cvt_pk_bf16(Z1[8 * s2 + 2], Z1[8 * s2 + 3]); w1.z = cvt_pk_bf16(Z1[8 * s2 + 4], Z1[8 * s2 + 5]); w1.w = cvt_pk_bf16(Z1[8 * s2 + 6], Z1[8 * s2 + 7]);
                    *(LAS u32x4*)(L + OFF_SF + ((((kb * 2 + 0) * 2 + s2) * 64) + F.lane) * 16) = w0;
                    *(LAS u32x4*)(L + OFF_SF + ((((kb * 2 + 1) * 2 + s2) * 64) + F.lane) * 16) = w1; } }
              __builtin_amdgcn_sched_barrier(0);
              { float v[8]; unpack8(gv, v); const int s = F.tid >> 3, dvg = F.tid & 7, ps = ppos(s);
#pragma unroll
                  for (int j = 0; j < 8; ++j) *(LAS bf16_t*)(L + OFF_VT + (dvg * 8 + j) * SP + (((ps >> 3) ^ dvg) << 4) + (ps & 7) * 2) = (bf16_t)(__builtin_bit_cast(unsigned, v[j]) >> 16); }
              { float o16[16];
#pragma unroll
                for (int p = 0; p < 16; ++p) o16[p] = klp[8 * ((p >> 2) & 1) + 4 * (p >> 3) + (p & 3)] * po;
                *(LAS u32x4*)(L + OFF_KLT + sk * SP + sseg * 32) = pack8f(o16); *(LAS u32x4*)(L + OFF_KLT + sk * SP + sseg * 32 + 16) = pack8f(o16 + 8); }
#pragma unroll
              for (int i = 0; i < 2; ++i) { const int t = t0 + 32 * i;
                  float qin[8], kin[8], qv[8];
                  unpack8(gq[i], qv);
#pragma unroll
                  for (int j = 0; j < 8; ++j) { const float P = (j < 4 ? pa[i][j] * ea[i][j] : pb[i][j - 4] * eb[i][j - 4]);
                      qin[j] = qv[j] * 0.08838834764831845f * P; kin[j] = (1.f - fv[i][j]) * __builtin_amdgcn_rcpf(P); }
                  { const u32x4 wq = pack8f(qin), wk = pack8f(kin); const int o0 = t * RP + ((g >> 1) * 16 + (g & 1) * 4) * 2;
                    *(LAS u32x2*)(L + OFF_QIN + o0) = (u32x2){wq.x, wq.y}; *(LAS u32x2*)(L + OFF_QIN + o0 + 16) = (u32x2){wq.z, wq.w};
                    *(LAS u32x2*)(L + OFF_KIN + o0) = (u32x2){wk.x, wk.y}; *(LAS u32x2*)(L + OFF_KIN + o0 + 16) = (u32x2){wk.z, wk.w}; } } }
                        if (c + 1 < SEQ / 64) HG_LOADQ(c + 1);
            if (F.wave >= 4) __builtin_amdgcn_s_setprio(0);
            }
            __syncthreads();
            if (c >= 0) {
            if (F.wave < 4) { const int tb = F.wave & 1, dvb = F.wave >> 1;
                const LAS unsigned char* qin_p = L + OFF_QIN + (32 * tb + r32) * RP + 16 * hi;
                const LAS unsigned char* sf_p = L + OFF_SF + dvb * 2048 + F.lane * 16;
                const LAS unsigned char* kin_p = L + OFF_KIN + r32 * RP + 16 * hi;
                const LAS unsigned char* vt_p = L + OFF_VT + (32 * dvb + r32) * SP; const int vsw = (4 * dvb + (r32 >> 3)) & 7;
#define HG_VT(ch) (*(const LAS bf16x8*)(vt_p + ((((ch) + hi) ^ vsw) << 4)))
                bf16x8 Q0, S0f, K0, L0, Q1, S1f, K1, L1, Q2, S2f, K2, L2, vf0, vf1;
#define HG_LDG(Q, S, K, ks_) do { Q = *(const LAS bf16x8*)(qin_p + 32 * (ks_)); S = *(const LAS bf16x8*)(sf_p + ((ks_) >> 1) * 4096 + ((ks_) & 1) * 1024); K = *(const LAS bf16x8*)(kin_p + 32 * (ks_)); } while (0)
#define HG_LDL(Lq, ks_) do { Lq = *(const LAS bf16x8*)(kin_p + 32 * RP + 32 * (ks_)); } while (0)
#define HG_MMG(Q, S, K) do { o = __builtin_amdgcn_mfma_f32_32x32x16_bf16(Q, S, o, 0, 0, 0); X = __builtin_amdgcn_mfma_f32_32x32x16_bf16(K, Q, X, 0, 0, 0); } while (0)
#define HG_MML(Q, Lq) do { Y = __builtin_amdgcn_mfma_f32_32x32x16_bf16(Lq, Q, Y, 0, 0, 0); } while (0)
#define HG_XV(X, v0, v1) do { u32x4 w0_, w1_; \
                    w0_.x = cvt_pk_bf16(X[0], X[1]); w0_.y = cvt_pk_bf16(X[2], X[3]); w0_.z = cvt_pk_bf16(X[4], X[5]); w0_.w = cvt_pk_bf16(X[6], X[7]); \
                    w1_.x = cvt_pk_bf16(X[8], X[9]); w1_.y = cvt_pk_bf16(X[10], X[11]); w1_.z = cvt_pk_bf16(X[12], X[13]); w1_.w = cvt_pk_bf16(X[14], X[15]); \
                    o = __builtin_amdgcn_mfma_f32_32x32x16_bf16(__builtin_bit_cast(bf16x8, w0_), v0, o, 0, 0, 0); o = __builtin_amdgcn_mfma_f32_32x32x16_bf16(__builtin_bit_cast(bf16x8, w1_), v1, o, 0, 0, 0); } while (0)
#define HG_DIAG(X) do { _Pragma("unroll") for (int r = 0; r < 16; ++r) { const int srow = (r & 3) + 8 * (r >> 2) + 4 * hi; if (srow > r32) X[r] = 0.f; } } while (0)
#define SB() __builtin_amdgcn_sched_barrier(0)
                f32x16 o = {}, X = {};
                if (tb == 0) {
                    HG_LDG(Q0, S0f, K0, 0); HG_LDG(Q1, S1f, K1, 1); HG_LDG(Q2, S2f, K2, 2); SB();
                    HG_MMG(Q0, S0f, K0); SB(); HG_LDG(Q0, S0f, K0, 3); SB();
                    HG_MMG(Q1, S1f, K1); SB(); HG_LDG(Q1, S1f, K1, 4); SB();
                    HG_MMG(Q2, S2f, K2); SB(); HG_LDG(Q2, S2f, K2, 5); SB();
                    HG_MMG(Q0, S0f, K0); SB(); HG_LDG(Q0, S0f, K0, 6); SB();
                    HG_MMG(Q1, S1f, K1); SB(); HG_LDG(Q1, S1f, K1, 7); SB();
                    HG_MMG(Q2, S2f, K2); SB(); vf0 = HG_VT(0); vf1 = HG_VT(2); SB();
                    HG_MMG(Q0, S0f, K0); HG_MMG(Q1, S1f, K1);
                    HG_DIAG(X); HG_XV(X, vf0, vf1);
                } else {
                    f32x16 Y = {}; bf16x8 vg0, vg1;
                    HG_LDG(Q0, S0f, K0, 0); HG_LDL(L0, 0); HG_LDG(Q1, S1f, K1, 1); HG_LDL(L1, 1); HG_LDG(Q2, S2f, K2, 2); HG_LDL(L2, 2); SB();
                    HG_MMG(Q0, S0f, K0); HG_MML(Q0, L0); SB(); HG_LDG(Q0, S0f, K0, 3); HG_LDL(L0, 3); SB();
                    HG_MMG(Q1, S1f, K1); HG_MML(Q1, L1); SB(); HG_LDG(Q1, S1f, K1, 4); HG_LDL(L1, 4); SB();
                    HG_MMG(Q2, S2f, K2); HG_MML(Q2, L2); SB(); HG_LDG(Q2, S2f, K2, 5); HG_LDL(L2, 5); SB();
                    HG_MMG(Q0, S0f, K0); HG_MML(Q0, L0); SB(); HG_LDG(Q0, S0f, K0, 6); HG_LDL(L0, 6); SB();
                    HG_MMG(Q1, S1f, K1); HG_MML(Q1, L1); SB(); HG_LDG(Q1, S1f, K1, 7); HG_LDL(L1, 7); SB();
                    HG_MMG(Q2, S2f, K2); HG_MML(Q2, L2); SB(); vf0 = HG_VT(0); vf1 = HG_VT(2); vg0 = HG_VT(4); vg1 = HG_VT(6); SB();
                    HG_MMG(Q0, S0f, K0); HG_MML(Q0, L0); HG_MMG(Q1, S1f, K1); HG_MML(Q1, L1);
                    HG_XV(X, vf0, vf1); HG_DIAG(Y); HG_XV(Y, vg0, vg1);
                }
#undef SB
#undef HG_VT
#undef HG_LDG
#undef HG_LDL
#undef HG_MMG
#undef HG_MML
#undef HG_XV
#undef HG_DIAG
                unsigned ow[16];
#pragma unroll
                for (int r = 0; r < 16; ++r) ow[r] = cvt_pk_bf16(o[r], dpp_xor1(o[r]));
                if ((r32 & 1) == 0) { LAS unsigned char* ob = L + OFF_O + (32 * tb + 4 * hi) * OP + (32 * dvb + r32) * 2;
#pragma unroll
                    for (int r = 0; r < 16; ++r) *(LAS unsigned*)(ob + ((r & 3) + 8 * (r >> 2)) * OP) = ow[r]; }
            } else { const int kb = F.wave - 4;
                bf16x8 kf[4], va[4], vb[4];
#pragma unroll
                for (int ss = 0; ss < 4; ++ss) { kf[ss] = *(const LAS bf16x8*)(L + OFF_KLT + (32 * kb + r32) * SP + (16 * ss + 8 * hi) * 2);
                    va[ss] = *(const LAS bf16x8*)(L + OFF_VT + r32 * SP + (((2 * ss + hi) ^ (r32 >> 3)) << 4)); vb[ss] = *(const LAS bf16x8*)(L + OFF_VT + (32 + r32) * SP + (((2 * ss + hi) ^ (4 + (r32 >> 3))) << 4)); }
#pragma unroll
                for (int r = 0; r < 16; ++r) { const float dcy = DEC[32 * kb + (r & 3) + 8 * (r >> 2) + 4 * hi]; S0[r] *= dcy; S1[r] *= dcy; }
                __builtin_amdgcn_sched_barrier(0);
#pragma unroll
                for (int ss = 0; ss < 4; ++ss) { S0 = __builtin_amdgcn_mfma_f32_32x32x16_bf16(kf[ss], va[ss], S0, 0, 0, 0); S1 = __builtin_amdgcn_mfma_f32_32x32x16_bf16(kf[ss], vb[ss], S1, 0, 0, 0); }
            }
                        }
            if (c + 1 < SEQ / 64) {
            float lb[8], lc[8];
            { const f32x4 l0 = *(const LAS f32x4*)(LB + g * 8), l1 = *(const LAS f32x4*)(LB + g * 8 + 4), c0 = *(const LAS f32x4*)(LB + 128 + g * 8), c1 = *(const LAS f32x4*)(LB + 128 + g * 8 + 4);
#pragma unroll
              for (int j = 0; j < 4; ++j) { lb[j] = l0[j]; lb[4 + j] = l1[j]; lc[j] = c0[j]; lc[4 + j] = c1[j]; } }
#pragma unroll
            for (int i = 0; i < 2; ++i) { float fl[8]; unpack8(gf[i], fl);
#pragma unroll
                for (int j = 0; j < 8; ++j) fv[i][j] = 1.f - lc[j] * fl[j];
                LAS float* fp = Fs + (t0 + 32 * i) * 128 + ((g * 8) ^ ((((t0 + 32 * i) >> 4) & 1) << 4));
                *(LAS f32x4*)fp = (f32x4){fv[i][0], fv[i][1], fv[i][2], fv[i][3]}; *(LAS f32x4*)(fp + 4) = (f32x4){fv[i][4], fv[i][5], fv[i][6], fv[i][7]}; }
            if (c + 2 < SEQ / 64) HG_LOADF(c + 2);
            } else {
#pragma unroll
                for (int j = 0; j < 8; ++j) { fv[0][j] = 0.f; fv[1][j] = 0.f; } }
            __syncthreads();
            if (c >= 0) { const int row = F.tid >> 3, pc = F.tid & 7;
              const u32x4 w = *(const LAS u32x4*)(L + OFF_O + row * OP + pc * 16);
              *(u32x4*)(MIX + (size_t)(b * SEQ + c * 64 + row) * DM + h * 128 + dq2 * 64 + pc * 8) = w; }
            if (c + 1 < SEQ / 64) {
            { float fr[16];
#pragma unroll
              for (int i = 0; i < 16; ++i) fr[i] = Fs[(16 * sseg + i) * 128 + scol];
              float p = 1.f;
#pragma unroll
              for (int i = 0; i < 16; ++i) { p *= fr[i]; Fs[(16 * sseg + i) * 128 + scol] = p; }
              float q = 1.f;
#pragma unroll
              for (int i = 15; i >= 0; --i) { klp[i] = (1.f - fr[i]) * q; q *= fr[i]; }
              const unsigned pu = __float_as_uint(p);
              auto r16 = __builtin_amdgcn_permlane16_swap(pu, pu, false, false);
              const float A = __uint_as_float(r16[0]) * __uint_as_float(r16[1]), x16 = __uint_as_float(r16[0] == pu ? r16[1] : r16[0]);
              const unsigned au = __float_as_uint(A);
              auto r32_ = __builtin_amdgcn_permlane32_swap(au, au, false, false);
              const float B = __uint_as_float(r32_[0] == au ? r32_[1] : r32_[0]);
              const float rc = __builtin_amdgcn_rcpf(sseg == 0 ? A : p);
              SEGs[sseg * 128 + sk] = sseg < 2 ? rc : (sseg == 2 ? 1.f : x16);
              po = sseg == 0 ? x16 * B : (sseg == 1 ? B : (sseg == 2 ? x16 : 1.f));
              if (sseg < 2) DEC[sseg * 128 + sk] = sseg == 0 ? A * B : A; }
            } else {
#pragma unroll
                for (int i = 0; i < 16; ++i) klp[i] = 0.f;
                po = 0.f; }
            __syncthreads();
        }
#undef HG_LOADF
#undef HG_LOADQ
    }
}

constexpr int MOE_IG = NE * (DM / 64) * (DE / 64);
constexpr int MOE_PRE = 2048;
struct MoeItems { const float* wg; const float* wu; const float* wd; unsigned char* ws;
    __device__ TrItem operator()(int it) const { TrItem t; t.gk = nullptr;
        const int which = it / MOE_IG, r = it % MOE_IG;
        if (which < 2) { const int e = r / 256, q = r % 256, kb = q / 8, nb = q % 8, n0 = 64 * nb;
            t.src = (which ? wu : wg) + (size_t)e * DM * DE + (size_t)(64 * kb) * DE + n0;
            t.dst = (bf16_t*)(ws + WS_D) + ((size_t)e * 1024 + (n0 >> 7) * 256 + (n0 & 127) + which * 128) * DM + 64 * kb; t.dst2 = t.dst + (size_t)32 * DM; t.N = DE; t.ldt = DM; }
        else { const int e = r / 256, q = r % 256, kb = q / 32, nb = q % 32, n0 = 64 * nb;
            t.src = wd + (size_t)e * DE * DM + (size_t)(64 * kb) * DM + n0;
            t.dst = (bf16_t*)(ws + WS_E) + ((size_t)e * DM + n0) * DE + 64 * kb; t.dst2 = t.dst + (size_t)32 * DE; t.N = DM; t.ldt = DE; }
        return t; } };

__device__ __forceinline__ void p3_phase(Frame& F, const Args& a) {
    OPAQUE_FRAME(F);
    const int role = ((int)blockIdx.x >> 3) & 1, idx = ((int)blockIdx.x >> 4) * 8 + ((int)blockIdx.x & 7), half = F.G >> 1;
    unsigned char* ws = F.ws;
    #ifndef MK_HGREP
#define MK_HGREP 1
#endif
    if (role == 0) { for (int rep = 0; rep < MK_HGREP; ++rep) { for (int it = idx; it < NB * HH * 2; it += half) hgrn_chunked(F, a, it); if (MK_HGREP > 1) __syncthreads(); } }
    else {
        { pg8::Gemm g{(const bf16_t*)(ws + WS_A) + C_QA, (const bf16_t*)(ws + WS_WQUP), INCP, QLORA, QLORA};
          pg8::DenseOrder S; S.init(T / 256, MH * MQK / 256, half, idx);
          pg8::EpiStore E{(bf16_t*)(ws + WS_B), MH * MQK, (const float*)(ws + WS_RSTDQ), 1.f / QLORA};
          pg8::gemm_phase<pg8::EpiStore, pg8::DenseOrder>(F.lds, g, S, E); }
        { pg8::Gemm g{(const bf16_t*)(ws + WS_A) + C_KVA, (const bf16_t*)(ws + WS_WKVUP), INCP, KVLORA, KVLORA};
          pg8::DenseOrder S; S.init(T / 256, MH * 256 / 256, half, idx);
          pg8::EpiStore E{(bf16_t*)(ws + WS_C), MH * 256, (const float*)(ws + WS_RSTDKV), 1.f / KVLORA};
          pg8::gemm_phase<pg8::EpiStore, pg8::DenseOrder>(F.lds, g, S, E); }
        { const MoeItems mk{a.in[22], a.in[23], a.in[24], ws};
          tr_run(idx * NWAVES + F.wave, half * NWAVES, MOE_PRE, mk, F.lds + F.wave * 8192, F.lane); }
    }
}

__device__ __forceinline__ float sum8(float v) { v += __shfl_xor(v, 1); v += __shfl_xor(v, 2); v += __shfl_xor(v, 4); return v; }

struct P5Set { u32x4 k0, k1, kpe, m0, m1, g0, g1; f32x4 ca, cb, sa, sb; };
__device__ __forceinline__ void p5_phase(Frame& F, const Args& a) {
    OPAQUE_FRAME(F);
    const int gw = F.vcu * NWAVES + F.wave, NGW = F.G * NWAVES;
    const bf16_t* PROJ = (const bf16_t*)(F.ws + WS_A);
    const bf16_t* KV = (const bf16_t*)(F.ws + WS_C);
    bf16_t* Kn = (bf16_t*)(F.ws + WS_F);
    bf16_t* MIX = (bf16_t*)F.out;
    const float* rc = (const float*)(F.ws + WS_ROPEC); const float* rsn = (const float*)(F.ws + WS_ROPES);
    const int h = F.lane >> 3, sub = F.lane & 7;
    const float sgn = sub < 4 ? -1.f : 1.f;
    float gk[3][8], go[2][8];
#pragma unroll
    for (int i = 0; i < 3; ++i)
#pragma unroll
        for (int j = 0; j < 8; ++j) gk[i][j] = a.in[14][(sub + 8 * i) * 8 + j];
#pragma unroll
    for (int i = 0; i < 2; ++i)
#pragma unroll
        for (int j = 0; j < 8; ++j) go[i][j] = a.in[8][(sub + 8 * i) * 8 + j];
#define P5_LD(t_, S_) do { const size_t t__ = (size_t)(t_); const int ii_ = (sub & 3) * 8; \
        S_.k0 = __builtin_nontemporal_load((const u32x4*)(KV + t__ * (MH * 256) + h * 256 + sub * 8)); S_.k1 = __builtin_nontemporal_load((const u32x4*)(KV + t__ * (MH * 256) + h * 256 + (sub + 8) * 8)); \
        S_.kpe = *(const u32x4*)(PROJ + t__ * INCP + C_KPE + sub * 8); \
        S_.ca = *(const f32x4*)(rc + t__ * 32 + ii_); S_.cb = *(const f32x4*)(rc + t__ * 32 + ii_ + 4); S_.sa = *(const f32x4*)(rsn + t__ * 32 + ii_); S_.sb = *(const f32x4*)(rsn + t__ * 32 + ii_ + 4); \
        S_.m0 = *(const u32x4*)(MIX + t__ * DM + h * 128 + sub * 8); S_.m1 = *(const u32x4*)(MIX + t__ * DM + h * 128 + (sub + 8) * 8); \
        S_.g0 = __builtin_nontemporal_load((const u32x4*)(PROJ + t__ * INCP + 3 * HW + h * 128 + sub * 8)); S_.g1 = __builtin_nontemporal_load((const u32x4*)(PROJ + t__ * INCP + 3 * HW + h * 128 + (sub + 8) * 8)); } while (0)
#define P5_CP(t_, S_) do { const int t__ = (t_), b_ = t__ / SEQ, s_ = t__ % SEQ; const size_t hrow = ((size_t)(b_ * MH + h) * SEQ + s_); \
        { float k[3][8]; float ss = 0.f; unpack8(S_.k0, k[0]); unpack8(S_.k1, k[1]); unpack8(S_.kpe, k[2]); \
          _Pragma("unroll") for (int i = 0; i < 3; ++i) _Pragma("unroll") for (int j = 0; j < 8; ++j) ss += k[i][j] * k[i][j]; \
          const float rs = rsqrtf(sum8(ss) * (1.f / MQK) + EPS); \
          _Pragma("unroll") for (int i = 0; i < 3; ++i) _Pragma("unroll") for (int j = 0; j < 8; ++j) k[i][j] *= rs * gk[i][j]; \
          _Pragma("unroll") for (int j = 0; j < 8; ++j) { const float pv = __shfl_xor(k[2][j], 4); const float cs_ = j < 4 ? S_.ca[j & 3] : S_.cb[j & 3], sn_ = j < 4 ? S_.sa[j & 3] : S_.sb[j & 3]; k[2][j] = k[2][j] * cs_ + sgn * pv * sn_; } \
          _Pragma("unroll") for (int i = 0; i < 3; ++i) *(u32x4*)(Kn + hrow * MQK + (sub + 8 * i) * 8) = pack8f(k[i]); } \
        { float o[2][8], gt[2][8]; float ss = 0.f; unpack8(S_.m0, o[0]); unpack8(S_.m1, o[1]); unpack8(S_.g0, gt[0]); unpack8(S_.g1, gt[1]); \
          _Pragma("unroll") for (int i = 0; i < 2; ++i) _Pragma("unroll") for (int j = 0; j < 8; ++j) ss += o[i][j] * o[i][j]; \
          const float rs = rsqrtf(sum8(ss) * (1.f / HDV) + EPS); \
          _Pragma("unroll") for (int i = 0; i < 2; ++i) { _Pragma("unroll") for (int j = 0; j < 8; ++j) o[i][j] = o[i][j] * rs * go[i][j] * siluf(gt[i][j]); \
              *(u32x4*)(MIX + (size_t)t__ * DM + h * 128 + (sub + 8 * i) * 8) = pack8f(o[i]); } } } while (0)
    for (int blk = gw; blk < T / 8; blk += NGW) { const int t0 = blk * 8;
        P5Set A, B;
        P5_LD(t0, A);
#pragma unroll 1
        for (int r = 0; r < 8; r += 2) {
            P5_LD(t0 + r + 1, B); __builtin_amdgcn_sched_barrier(0);
            P5_CP(t0 + r, A); __builtin_amdgcn_sched_barrier(0);
            if (r + 2 < 8) { P5_LD(t0 + r + 2, A); } __builtin_amdgcn_sched_barrier(0);
            P5_CP(t0 + r + 1, B); __builtin_amdgcn_sched_barrier(0);
        }
    }
#undef P5_LD
#undef P5_CP
}
namespace att {
constexpr int QBLK = 32, KVBLK = 64, QB = 256;
constexpr int KROW = 512, SHM_K = KVBLK * KROW, SHM_V = KVBLK * MV * 2;
constexpr int OFF_V = 0, OFF_K = 2 * SHM_V, OFF_WS = OFF_K + 2 * SHM_K;
constexpr float SCALE = 0.07216878364870322f;
constexpr float THR = 8.f;
#define SBAR() __builtin_amdgcn_sched_barrier(0)
__device__ __forceinline__ int v_st(int k, int c) { const int kk = (k & ~0xC) | ((k & 4) << 1) | ((k & 8) >> 1); return ((kk >> 3) * 4 + (c >> 5)) * 512 + ((kk & 7) * 32 + (c & 31)) * 2; }
__device__ __forceinline__ int v_rd_base(int lane) { return ((lane & 3) << 3) | (((lane >> 2) & 3) << 6) | (((lane >> 4) & 1) << 5) | (((lane >> 5) & 1) << 8); }
constexpr int v_rd_off(int d0, int ks, int half) { return d0 * 512 + ks * 4096 + half * 2048; }
__device__ __forceinline__ int crow(int r, int hi) { return (r & 3) + 8 * (r >> 2) + 4 * hi; }
template <int M> __device__ __forceinline__ float swz_xor(float v) { return __builtin_bit_cast(float, __builtin_amdgcn_ds_swizzle(__builtin_bit_cast(int, v), (M << 10) | 0x1F)); }
__device__ __forceinline__ unsigned cvtpk(float lo, float hi) { unsigned r; asm volatile("v_cvt_pk_bf16_f32 %0, %1, %2" : "=v"(r) : "v"(lo), "v"(hi)); return r; }

__device__ __forceinline__ void mask_tile(f32x16& p0, f32x16& p1, int dq) {
    const float NEG = -__builtin_inff();
#pragma unroll
    for (int r = 0; r < 16; ++r) {
        const int c = (r & 3) + 8 * (r >> 2);
        if (dq - c < 0) p0[r] = NEG;
        if (dq - c - 32 < 0) p1[r] = NEG;
    }
}
__device__ __forceinline__ void partialSM(f32x16& p0, f32x16& p1, float& m_reg, float& mn, float& alpha) {
    float pmax = p0[0];
#pragma unroll
    for (int r = 1; r < 16; ++r) pmax = fmaxf(pmax, p0[r]);
#pragma unroll
    for (int r = 0; r < 16; ++r) pmax = fmaxf(pmax, p1[r]);
    { auto rr = __builtin_amdgcn_permlane32_swap(__float_as_uint(pmax), __float_as_uint(pmax), false, false);
      pmax = fmaxf(__uint_as_float(rr[0]), __uint_as_float(rr[1])); }
    constexpr float C2 = 1.4426950408889634f * SCALE;
    if (__builtin_expect(__all((pmax - m_reg) * SCALE <= THR), 1)) { mn = m_reg; alpha = 1.f; }
    else { mn = fmaxf(m_reg, pmax); alpha = __builtin_amdgcn_exp2f((m_reg - mn) * C2); m_reg = mn; }
    const float mnL = -mn * C2;
#pragma unroll
    for (int r = 0; r < 16; ++r) p0[r] = fmaf(p0[r], C2, mnL);
#pragma unroll
    for (int r = 0; r < 16; ++r) p1[r] = fmaf(p1[r], C2, mnL);
#pragma unroll
    for (int r = 0; r < 16; ++r) p0[r] = __builtin_amdgcn_exp2f(p0[r]);
}
__device__ __forceinline__ void finishSM(f32x16& p0, f32x16& p1, float alpha, float& l_reg, bf16x8& pa0, bf16x8& pa1, bf16x8& pa2, bf16x8& pa3) {
#pragma unroll
    for (int r = 0; r < 16; ++r) p1[r] = __builtin_amdgcn_exp2f(p1[r]);
    float ps = 0;
#pragma unroll
    for (int r = 0; r < 16; ++r) ps += p0[r];
#pragma unroll
    for (int r = 0; r < 16; ++r) ps += p1[r];
    { auto rr = __builtin_amdgcn_permlane32_swap(__float_as_uint(ps), __float_as_uint(ps), false, false);
      ps = __uint_as_float(rr[0]) + __uint_as_float(rr[1]); }
    l_reg = l_reg * alpha + ps;
#define PK4(P, B_, OUT) do { unsigned a0 = cvtpk(P[B_+0], P[B_+1]), a1 = cvtpk(P[B_+2], P[B_+3]);                          \
        unsigned b0 = cvtpk(P[B_+4], P[B_+5]), b1 = cvtpk(P[B_+6], P[B_+7]);                                             \
        auto r0 = __builtin_amdgcn_permlane32_swap(a0, b0, false, false); auto r1 = __builtin_amdgcn_permlane32_swap(a1, b1, false, false); \
        u32x4 w = {r0[0], r1[0], r0[1], r1[1]}; OUT = __builtin_bit_cast(bf16x8, w); } while (0)
    PK4(p0, 0, pa0); PK4(p0, 8, pa1); PK4(p1, 0, pa2); PK4(p1, 8, pa3);
#undef PK4
}
template <int KB>
__device__ __forceinline__ void qkt(f32x16& p0, f32x16& p1, LAS unsigned char* lds, int r32, int hi, const bf16x8* qr) {
    p0 = f32x16{}; p1 = f32x16{};
    int sw = r32 & 15; asm volatile("" : "+v"(sw));
    const int rb = OFF_K + KB * SHM_K + r32 * KROW;
    int ab[8];
#pragma unroll
    for (int d = 0; d < 8; ++d) ab[d] = rb + (((2 * d + hi) ^ sw) << 4);
#pragma unroll
    for (int d0 = 0; d0 < 12; ++d0) { const int a = ab[d0 & 7] + (d0 >> 3) * 256;
        const bf16x8 b0 = *(const LAS bf16x8*)(lds + a);
        const bf16x8 b1 = *(const LAS bf16x8*)(lds + a + 32 * KROW);
        p0 = __builtin_amdgcn_mfma_f32_32x32x16_bf16(b0, qr[d0], p0, 0, 0, 0);
        p1 = __builtin_amdgcn_mfma_f32_32x32x16_bf16(b1, qr[d0], p1, 0, 0, 0); }
}
template <int VB>
__device__ __forceinline__ void pv_tile(f32x16* o, int vb0, bf16x8 pa0, bf16x8 pa1, bf16x8 pa2, bf16x8 pa3) {
#define TRRD(dst, off) asm volatile("ds_read_b64_tr_b16 %0, %1 offset:%2" : "=&v"(dst) : "v"(vb0), "i"(off) : "memory")
#define PV_D0(d0) do { s16x4 l0, l1, l2, l3, h0, h1, h2, h3; constexpr int b_ = OFF_V + VB * SHM_V + v_rd_off(d0, 0, 0); \
        TRRD(l0, b_); TRRD(h0, b_ + 2048); TRRD(l1, b_ + 4096); TRRD(h1, b_ + 6144); TRRD(l2, b_ + 8192); TRRD(h2, b_ + 10240); TRRD(l3, b_ + 12288); TRRD(h3, b_ + 14336); \
        asm volatile("s_waitcnt lgkmcnt(0)" ::: "memory"); SBAR();   \
        o[d0] = __builtin_amdgcn_mfma_f32_32x32x16_bf16(pa0, (bf16x8){l0[0], l0[1], l0[2], l0[3], h0[0], h0[1], h0[2], h0[3]}, o[d0], 0, 0, 0);   \
        o[d0] = __builtin_amdgcn_mfma_f32_32x32x16_bf16(pa1, (bf16x8){l1[0], l1[1], l1[2], l1[3], h1[0], h1[1], h1[2], h1[3]}, o[d0], 0, 0, 0);   \
        o[d0] = __builtin_amdgcn_mfma_f32_32x32x16_bf16(pa2, (bf16x8){l2[0], l2[1], l2[2], l2[3], h2[0], h2[1], h2[2], h2[3]}, o[d0], 0, 0, 0);   \
        o[d0] = __builtin_amdgcn_mfma_f32_32x32x16_bf16(pa3, (bf16x8){l3[0], l3[1], l3[2], l3[3], h3[0], h3[1], h3[2], h3[3]}, o[d0], 0, 0, 0); } while (0)
    PV_D0(0); PV_D0(1); PV_D0(2); PV_D0(3);
#undef PV_D0
#undef TRRD
}

constexpr int QP = MH * MQK, VP = MH * 256;
__device__ __forceinline__ void attn_block(const bf16_t* Q, const bf16_t* K, const bf16_t* V, bf16_t* O, int P0, const float* gon, const float* gqn, const float* rc, const float* rsn, LAS unsigned char* lds) {
    int tid = threadIdx.x; asm volatile("" : "+v"(tid));
    const int wid = __builtin_amdgcn_readfirstlane(tid >> 6), lane = tid & 63, r32 = lane & 31, hi = lane >> 5;
    const int NT = P0 / KVBLK + 4;
    const int qlo = P0 + wid * QBLK, qm = qlo + r32 - 4 * hi;
    LAS float* wsf = (LAS float*)(lds + OFF_WS) + wid * 64; LAS float* li_l = wsf; LAS float* al_l = wsf + 32;
    float m_reg = -1e30f, l_reg = 0.f; f32x16 o[4] = {};
    bf16x8 qr[12];
#pragma unroll
    for (int d0 = 0; d0 < 12; ++d0) qr[d0] = *(const bf16x8*)(Q + (size_t)(qlo + r32) * QP + d0 * 16 + hi * 8);
    {
        float ss = 0.f;
#pragma unroll
        for (int d0 = 0; d0 < 12; ++d0) { float f[8]; unpack8(__builtin_bit_cast(u32x4, qr[d0]), f);
#pragma unroll
            for (int j = 0; j < 8; ++j) ss += f[j] * f[j]; }
        { auto rr = __builtin_amdgcn_permlane32_swap(__float_as_uint(ss), __float_as_uint(ss), false, false); ss = __uint_as_float(rr[0]) + __uint_as_float(rr[1]); }
        const float rs = rsqrtf(ss * (1.f / MQK) + EPS);
#pragma unroll
        for (int d0 = 0; d0 < 8; ++d0) { float f[8]; unpack8(__builtin_bit_cast(u32x4, qr[d0]), f); const float* gp = gqn + d0 * 16 + hi * 8;
#pragma unroll
            for (int j = 0; j < 8; ++j) f[j] *= rs * gp[j];
            qr[d0] = __builtin_bit_cast(bf16x8, pack8f(f)); }
#pragma unroll
        for (int dd = 0; dd < 2; ++dd) { float x1[8], x2[8]; unpack8(__builtin_bit_cast(u32x4, qr[8 + dd]), x1); unpack8(__builtin_bit_cast(u32x4, qr[10 + dd]), x2);
            const float* g1p = gqn + 128 + dd * 16 + hi * 8; const float* g2p = g1p + 32; const float* cp = rc + (size_t)(qlo + r32) * 32 + dd * 16 + hi * 8; const float* sp = rsn + (size_t)(qlo + r32) * 32 + dd * 16 + hi * 8;
            const f32x4 c0 = *(const f32x4*)cp, c1 = *(const f32x4*)(cp + 4), s0 = *(const f32x4*)sp, s1 = *(const f32x4*)(sp + 4), ga = *(const f32x4*)g1p, gb = *(const f32x4*)(g1p + 4), gc = *(const f32x4*)g2p, gd = *(const f32x4*)(g2p + 4);
#pragma unroll
            for (int j = 0; j < 8; ++j) { const float a = x1[j] * rs * (j < 4 ? ga[j & 3] : gb[j & 3]), bq = x2[j] * rs * (j < 4 ? gc[j & 3] : gd[j & 3]), c = j < 4 ? c0[j & 3] : c1[j & 3], sn = j < 4 ? s0[j & 3] : s1[j & 3]; x1[j] = a * c - bq * sn; x2[j] = bq * c + a * sn; }
            qr[8 + dd] = __builtin_bit_cast(bf16x8, pack8f(x1)); qr[10 + dd] = __builtin_bit_cast(bf16x8, pack8f(x2)); }
    }
    int ksrc[4], vsrc[2];
#pragma unroll
    for (int i = 0; i < 4; ++i) { const int row = 2 * (wid * 4 + i) + (lane >> 5), c = (lane & 31) ^ (row & 15); ksrc[i] = row * MQK + (c < 24 ? c : 0) * 8; }
#pragma unroll
    for (int i = 0; i < 2; ++i) { const int id = (wid * 2 + i) * 2 + (lane >> 5), kk = ((id >> 2) << 3) | ((lane & 31) >> 2), k = (kk & ~0xC) | ((kk & 4) << 1) | ((kk & 8) >> 1);
        vsrc[i] = k * VP + (id & 3) * 32 + (lane & 3) * 8; }
    const int vb0 = (int)(unsigned)(uintptr_t)lds + v_rd_base(lane);
#define ALOAD(t, bf) do { const bf16_t* kp = K + (size_t)(t) * KVBLK * MQK; const bf16_t* vp = V + (size_t)(t) * KVBLK * VP; \
        _Pragma("unroll") for (int i = 0; i < 4; ++i) __builtin_amdgcn_global_load_lds((const unsigned*)(kp + ksrc[i]), (LAS unsigned*)(lds + OFF_K + (bf) * SHM_K + (wid * 4 + i) * 1024), 16, 0, 0); \
        _Pragma("unroll") for (int i = 0; i < 2; ++i) __builtin_amdgcn_global_load_lds((const unsigned*)(vp + vsrc[i]), (LAS unsigned*)(lds + OFF_V + (bf) * SHM_V + (wid * 2 + i) * 1024), 16, 0, 0); } while (0)
#define RESC(a) do { if (__any((a) < 1.f)) { if (hi == 0) al_l[r32] = (a); asm volatile("s_waitcnt lgkmcnt(0)" ::: "memory"); \
        _Pragma("unroll") for (int d_ = 0; d_ < 4; ++d_) _Pragma("unroll") for (int r = 0; r < 16; ++r) o[d_][r] *= al_l[crow(r, hi)]; } } while (0)
#define STEP(t, BF) do { f32x16 p0, p1; float mn, al; bf16x8 pa0, pa1, pa2, pa3; \
        if ((t) + 1 < NT) ALOAD((t) + 1, 1 - (BF)); \
        SBAR(); \
        if ((t) * KVBLK <= qlo + QBLK - 1) {                   \
        qkt<BF>(p0, p1, lds, r32, hi, qr); \
        { const int kb_ = (t) * KVBLK; if (kb_ + KVBLK - 1 > qlo) mask_tile(p0, p1, qm - kb_); } \
        partialSM(p0, p1, m_reg, mn, al); RESC(al); finishSM(p0, p1, al, l_reg, pa0, pa1, pa2, pa3); SBAR(); \
        pv_tile<BF>(o, vb0, pa0, pa1, pa2, pa3); } SBAR(); \
        asm volatile("s_waitcnt vmcnt(0)" ::: "memory"); __syncthreads(); } while (0)
    ALOAD(0, 0); asm volatile("s_waitcnt vmcnt(0)" ::: "memory"); __syncthreads();
    if (wid >= 4) __builtin_amdgcn_s_setprio(1);
    for (int t = 0; t < NT; t += 2) { STEP(t, 0); STEP(t + 1, 1); }
    if (wid >= 4) __builtin_amdgcn_s_setprio(0);
#undef STEP
#undef RESC
#undef ALOAD
    if (hi == 0) li_l[r32] = l_reg;
    asm volatile("s_waitcnt lgkmcnt(0)" ::: "memory");
    float gv[4];
#pragma unroll
    for (int d0 = 0; d0 < 4; ++d0) gv[d0] = gon[d0 * 32 + r32];
    float ssr[16];
#pragma unroll
    for (int r = 0; r < 16; ++r) { const float rl = __builtin_amdgcn_rcpf(li_l[crow(r, hi)]); float ss = 0.f;
#pragma unroll
        for (int d0 = 0; d0 < 4; ++d0) { o[d0][r] *= rl; ss += o[d0][r] * o[d0][r]; }
        ssr[r] = ss; }
#pragma unroll
    for (int r = 0; r < 16; ++r) ssr[r] += swz_xor<1>(ssr[r]);
#pragma unroll
    for (int r = 0; r < 16; ++r) ssr[r] += swz_xor<2>(ssr[r]);
#pragma unroll
    for (int r = 0; r < 16; ++r) ssr[r] += swz_xor<4>(ssr[r]);
#pragma unroll
    for (int r = 0; r < 16; ++r) ssr[r] += swz_xor<8>(ssr[r]);
#pragma unroll
    for (int r = 0; r < 16; ++r) ssr[r] += swz_xor<16>(ssr[r]);
    constexpr int OTP = 272;
    LAS unsigned char* ot = lds + wid * (32 * OTP);
#pragma unroll
    for (int r = 0; r < 16; ++r) { const float rs = rsqrtf(ssr[r] * (1.f / MV) + EPS);
        unsigned w[4];
#pragma unroll
        for (int d0 = 0; d0 < 4; ++d0) { const float v = o[d0][r] * rs * gv[d0]; w[d0] = cvt_pk_bf16(v, hg::dpp_xor1(v)); }
        if ((r32 & 1) == 0) {
#pragma unroll
            for (int d0 = 0; d0 < 4; ++d0) *(LAS unsigned*)(ot + crow(r, hi) * OTP + (d0 * 32 + r32) * 2) = w[d0]; } }
    asm volatile("s_waitcnt lgkmcnt(0)" ::: "memory");
    { u32x4 q8[8];
#pragma unroll
      for (int i = 0; i < 8; ++i) { const int pc = i * 64 + lane; q8[i] = *(const LAS u32x4*)(ot + (pc >> 4) * OTP + (pc & 15) * 16); }
#pragma unroll
      for (int i = 0; i < 8; ++i) { const int pc = i * 64 + lane; *(u32x4*)(O + (size_t)(qlo + (pc >> 4)) * DM + (pc & 15) * 8) = q8[i]; } }
    __syncthreads();
}
#undef SBAR
}

__device__ __forceinline__ void p6_phase(Frame& F, const Args& a) {
    const bf16_t* QH = (const bf16_t*)(F.ws + WS_B); const bf16_t* Kn = (const bf16_t*)(F.ws + WS_F); const bf16_t* KV = (const bf16_t*)(F.ws + WS_C);
    bf16_t* MIX = (bf16_t*)F.out;
    const float* rc = (const float*)(F.ws + WS_ROPEC); const float* rsn = (const float*)(F.ws + WS_ROPES);
    for (int it = F.vcu; it < NB * MH * 4; it += F.G) {
        const int bh = it >> 2, j = it & 3, b = bh >> 3, h = bh & 7;
        const bf16_t* Q = QH + (size_t)(b * SEQ) * att::QP + h * MQK; const bf16_t* K = Kn + (size_t)bh * SEQ * MQK; const bf16_t* V = KV + (size_t)(b * SEQ) * att::VP + h * 256 + 128;
        bf16_t* O = MIX + (size_t)(b * SEQ) * DM + HW + h * MV;
        att::attn_block(Q, K, V, O, (7 - j) * att::QB, a.in[15], a.in[13], rc + (size_t)(b * SEQ) * 32, rsn + (size_t)(b * SEQ) * 32, F.lds);
        att::attn_block(Q, K, V, O, j * att::QB, a.in[15], a.in[13], rc + (size_t)(b * SEQ) * 32, rsn + (size_t)(b * SEQ) * 32, F.lds);
    }
}
__device__ __forceinline__ void p8_phase(Frame& F, const Args& a) {
    OPAQUE_FRAME(F);
    unsigned char* ws = F.ws;
    const float* xin = a.in[0]; const bf16_t* mixo = (const bf16_t*)(ws + WS_F); const float* mod = (const float*)(ws + WS_MOD); const float* g2n = a.in[17];
    const float* wct = (const float*)(ws + WS_WCT);
    bf16_t* H2 = (bf16_t*)(ws + WS_B);
    int* tok_e = (int*)(ws + WS_TOKE); float* tok_w = (float*)(ws + WS_TOKW); int* tok_s = (int*)(ws + WS_TOKS);
    LAS float* red = (LAS float*)F.lds;
    LAS float* ssw = (LAS float*)(F.lds + 98304);
    LAS float* shw = (LAS float*)(F.lds + 100352);
    LAS float* lg = (LAS float*)(F.lds + 101888);
    LAS float* rsl = (LAS float*)(F.lds + 111104);
    const int mr = F.lane & 15, mg = F.lane >> 4;
    const bool conv_first = (F.vcu & 1) != 0;
#pragma unroll 1
    for (int part = 0; part < 2; ++part) {
    if ((part == 0) != conv_first) {
    for (int tile = F.vcu; tile < T / 64; tile += F.G) {
        const int m0 = tile * 64, b = m0 / SEQ;
        {
          if (F.tid < 64) { unsigned polls = 0; unsigned* rdy = (unsigned*)(F.ctl + CW_R7) + 64 * (tile >> 2);
              while ((unsigned)__builtin_amdgcn_readfirstlane(__hip_atomic_load(rdy, __ATOMIC_RELAXED, __HIP_MEMORY_SCOPE_AGENT)) < 64u) {
                  if (++polls > (1u << 16)) { if (F.tid == 0) __hip_atomic_store((unsigned*)(F.ctl + CW_TMO), 0xB7000000u | (unsigned)tile, __ATOMIC_RELAXED, __HIP_MEMORY_SCOPE_AGENT); break; }
                  __builtin_amdgcn_s_sleep(2); }
              __builtin_amdgcn_fence(__ATOMIC_ACQUIRE, "agent");
              asm volatile("s_waitcnt vmcnt(0)" ::: "memory"); }
          __syncthreads(); }
        const float* modb = mod + b * (6 * DM);
        f32x4 acc[4][3]; float ssp[4] = {0.f, 0.f, 0.f, 0.f}, shacc[3] = {0.f, 0.f, 0.f};
#pragma unroll
        for (int rb = 0; rb < 4; ++rb)
#pragma unroll
            for (int n = 0; n < 3; ++n) acc[rb][n] = (f32x4){0.f, 0.f, 0.f, 0.f};
        const unsigned xo = (unsigned)((m0 + mr) * DM + F.wave * 256 + 4 * mg);
        LAS float* vec = (LAS float*)(F.lds + 112640) + F.wave * 768;
        { const int k4 = F.lane * 4; const unsigned ko_ = (unsigned)(F.wave * 256 + k4) * 4u;
          const f32x4 t0 = *(const f32x4*)((const char*)(modb + 2 * DM) + ko_), t1 = *(const f32x4*)((const char*)(modb + 3 * DM) + ko_), t2 = *(const f32x4*)((const char*)g2n + ko_), t3 = *(const f32x4*)((const char*)(modb + 4 * DM) + ko_);
          *(LAS f32x4*)(vec + k4) = t0; *(LAS f32x4*)(vec + 256 + k4) = t1; *(LAS f32x4*)(vec + 512 + k4) = t2 * (t3 + 1.f); LDS_WAIT(); asm volatile("" ::: "memory"); }
        f32x4 xa[4], xb[4], wa[3], wb[3]; u32x2 ma_[4], mb_[4];
#define P8_LDX(s_, X, M, W) do { const unsigned ko_ = (unsigned)(F.wave * 256 + 16 * (s_) + 4 * mg) * 4u; \
            _Pragma("unroll") for (int n = 0; n < 3; ++n) W[n] = *(const f32x4*)((const char*)wct + (ko_ + (unsigned)((n * 16 + mr) * DM * 4))); \
            _Pragma("unroll") for (int rb = 0; rb < 4; ++rb) { const unsigned eo_ = xo + (unsigned)(rb * 16 * DM + 16 * (s_)); X[rb] = *(const f32x4*)((const char*)xin + eo_ * 4u); M[rb] = *(const u32x2*)((const char*)mixo + eo_ * 2u); } } while (0)
#define P8_CP(s_, X, M, W) do { const int kl_ = 16 * (s_) + 4 * mg; const f32x4 g1v = *(const LAS f32x4*)(vec + kl_), shv = *(const LAS f32x4*)(vec + 256 + kl_), gmv = *(const LAS f32x4*)(vec + 512 + kl_); \
            _Pragma("unroll") for (int n = 0; n < 3; ++n) shacc[n] += (shv.x * W[n].x + shv.y * W[n].y) + (shv.z * W[n].z + shv.w * W[n].w); \
            _Pragma("unroll") for (int rb = 0; rb < 4; ++rb) { const f32x4 v = X[rb] + g1v * (f32x4){bf_lo(M[rb].x), bf_hi(M[rb].x), bf_lo(M[rb].y), bf_hi(M[rb].y)}; \
                ssp[rb] += (v.x * v.x + v.y * v.y) + (v.z * v.z + v.w * v.w); const f32x4 av = v * gmv; \
                _Pragma("unroll") for (int i = 0; i < 4; ++i) _Pragma("unroll") for (int n = 0; n < 3; ++n) acc[rb][n] = __builtin_amdgcn_mfma_f32_16x16x4f32(av[i], W[n][i], acc[rb][n], 0, 0, 0); } } while (0)
        P8_LDX(0, xa, ma_, wa);
#pragma unroll 1
        for (int s = 0; s < 16; s += 2) {
            P8_LDX(s + 1, xb, mb_, wb); __builtin_amdgcn_sched_barrier(0);
            P8_CP(s, xa, ma_, wa); __builtin_amdgcn_sched_barrier(0);
            if (s + 2 < 16) { P8_LDX(s + 2, xa, ma_, wa); } __builtin_amdgcn_sched_barrier(0);
            P8_CP(s + 1, xb, mb_, wb); __builtin_amdgcn_sched_barrier(0);
        }
#undef P8_LDX
#undef P8_CP
#pragma unroll
        for (int rb = 0; rb < 4; ++rb) {
#pragma unroll
            for (int n = 0; n < 3; ++n)
#pragma unroll
                for (int r = 0; r < 4; ++r) red[(F.wave * 64 + rb * 16 + mg * 4 + r) * 48 + n * 16 + mr] = acc[rb][n][r];
            float sp = ssp[rb]; sp += __shfl_xor(sp, 16); sp += __shfl_xor(sp, 32);
            if (mg == 0) ssw[F.wave * 64 + rb * 16 + mr] = sp; }
#pragma unroll
        for (int n = 0; n < 3; ++n) { float sa = shacc[n]; sa += __shfl_xor(sa, 16); sa += __shfl_xor(sa, 32); if (mg == 0) shw[F.wave * 48 + n * 16 + mr] = sa; }
        __syncthreads();
        if (F.tid < 64) { float sv = 0.f;
#pragma unroll
            for (int w = 0; w < 8; ++w) sv += ssw[w * 64 + F.tid];
            rsl[F.tid] = rsqrtf(sv * (1.f / DM) + EPS); }
        __syncthreads();
        for (int idx = F.tid; idx < 64 * 36; idx += NTHR) { const int row = idx / 36, n = idx % 36; float L = 0.f, sw = 0.f;
#pragma unroll
            for (int w = 0; w < 8; ++w) { L += red[(w * 64 + row) * 48 + n]; sw += shw[w * 48 + n]; }
            lg[row * 36 + n] = rsl[row] * L + sw + (n < 4 ? a.in[19][n] : a.in[21][n - 4]); }
        __syncthreads();
        if (F.tid < 64) { const LAS float* l = lg + F.tid * 36; const int t = m0 + F.tid;
            int g = 0; float gm = l[0];
#pragma unroll
            for (int j = 1; j < 4; ++j) if (l[j] > gm) { gm = l[j]; g = j; }
            float den = 0.f;
#pragma unroll
            for (int j = 0; j < 4; ++j) den += __expf(l[j] - gm);
            const float pg = 1.f / den;
            const LAS float* e = l + 4 + g * 8;
            int i1 = 0; float v1 = e[0];
#pragma unroll
            for (int j = 1; j < 8; ++j) if (e[j] > v1) { v1 = e[j]; i1 = j; }
            int i2 = -1; float v2 = -__builtin_inff();
#pragma unroll
            for (int j = 0; j < 8; ++j) if (j != i1 && e[j] > v2) { v2 = e[j]; i2 = j; }
            const float w1 = 1.f / (1.f + __expf(v2 - v1)), w2 = 1.f - w1;
            const int e1 = g * 8 + i1, e2 = g * 8 + i2;
            const int s1 = (int)atomicAdd((unsigned*)(F.ctl + CW_CNT + 64 * e1), 1u), s2 = (int)atomicAdd((unsigned*)(F.ctl + CW_CNT + 64 * e2), 1u);
            tok_e[2 * t] = e1; tok_e[2 * t + 1] = e2; tok_w[2 * t] = pg * w1; tok_w[2 * t + 1] = pg * w2; tok_s[2 * t] = s1; tok_s[2 * t + 1] = s2;
            int* list = (int*)(ws + WS_LIST); list[e1 * T + s1] = t; list[e2 * T + s2] = t; }
        { const int c8 = (F.tid & 255) * 8, rg = F.tid >> 8;
          f32x4 g1a = *(const f32x4*)(modb + 2 * DM + c8), g1b = *(const f32x4*)(modb + 2 * DM + c8 + 4), sha = *(const f32x4*)(modb + 3 * DM + c8), shb = *(const f32x4*)(modb + 3 * DM + c8 + 4);
          const f32x4 gma = *(const f32x4*)(g2n + c8) * (*(const f32x4*)(modb + 4 * DM + c8) + 1.f), gmb = *(const f32x4*)(g2n + c8 + 4) * (*(const f32x4*)(modb + 4 * DM + c8 + 4) + 1.f);
#pragma unroll 1
          for (int j0 = 0; j0 < 32; j0 += 4) {
              f32x4 qa[4], qb[4]; u32x4 qm[4];
#pragma unroll
              for (int u = 0; u < 4; ++u) { const size_t eo = (size_t)(m0 + rg + 2 * (j0 + u)) * DM + c8;
                  qa[u] = __builtin_nontemporal_load((const f32x4*)(xin + eo)); qb[u] = __builtin_nontemporal_load((const f32x4*)(xin + eo + 4)); qm[u] = __builtin_nontemporal_load((const u32x4*)(mixo + eo)); }
              __builtin_amdgcn_sched_barrier(0);
#pragma unroll
              for (int u = 0; u < 4; ++u) { const int row = rg + 2 * (j0 + u); const size_t eo = (size_t)(m0 + row) * DM + c8; const float rs = rsl[row];
                  float mx[8]; unpack8(qm[u], mx);
                  const f32x4 xa = qa[u] + g1a * (f32x4){mx[0], mx[1], mx[2], mx[3]}, xb = qb[u] + g1b * (f32x4){mx[4], mx[5], mx[6], mx[7]};
                  const f32x4 va = xa * rs * gma + sha, vb = xb * rs * gmb + shb;
                  u32x4 w; w.x = cvt_pk_bf16(va.x, va.y); w.y = cvt_pk_bf16(va.z, va.w); w.z = cvt_pk_bf16(vb.x, vb.y); w.w = cvt_pk_bf16(vb.z, vb.w);
                  *(u32x4*)(H2 + eo) = w;
                  u32x4 x1; x1.x = cvt_pk_bf16(xa.x, xa.y); x1.y = cvt_pk_bf16(xa.z, xa.w); x1.z = cvt_pk_bf16(xb.x, xb.y); x1.w = cvt_pk_bf16(xb.z, xb.w);
                  *(u32x4*)((bf16_t*)(ws + WS_F) + eo) = x1; }
              __builtin_amdgcn_sched_barrier(0); } }
        __syncthreads();
    }
    } else {
    LAS unsigned char* Tl = F.lds + F.wave * 8192;
    const int gw = F.vcu * NWAVES + F.wave, NGW = F.G * NWAVES;
    { const MoeItems mk{a.in[22], a.in[23], a.in[24], ws};
      tr_run(MOE_PRE + gw, NGW, 3 * MOE_IG, mk, Tl, F.lane); }
    __syncthreads();
    }
    }
}

constexpr int MOE_TAB_OFF = LDS_USER;
__device__ __forceinline__ LAS int* moe_tables(Frame& F) {
    LAS int* tab = (LAS int*)(F.lds + MOE_TAB_OFF);
    __syncthreads();
    if (F.tid < 160) tab[128 + F.tid] = NE - 1;
    if (F.tid < 64) {
        const int l = F.tid; const int c = l < NE ? (int)__hip_atomic_load((unsigned*)(F.ctl + CW_CNT + 64 * l), RLX_AGENT) : 0; const int pad = ((c + 255) >> 8) << 8;
        int inc = pad;
#pragma unroll
        for (int o = 1; o < 32; o <<= 1) { const int v = __shfl_up(inc, o); if (l >= o) inc += v; }
        if (l < NE) { tab[l] = inc - pad; tab[64 + l] = c; }
        if (l == NE - 1) tab[NE] = inc; }
    __syncthreads();
    if (F.tid < NE) { const int t0 = tab[F.tid] >> 8, t1 = tab[F.tid + 1] >> 8; for (int t = t0; t < t1; ++t) tab[128 + t] = F.tid; }
    __syncthreads();
    return tab;
}

__device__ __forceinline__ void p12_phase(Frame& F, const Args& a) {
    OPAQUE_FRAME(F);
    unsigned char* ws = F.ws;
    const bf16_t* Y = (const bf16_t*)(ws + WS_A);
    const float* tok_w = (const float*)(ws + WS_TOKW); const int* tok_s = (const int*)(ws + WS_TOKS);
    const float* mod = (const float*)(ws + WS_MOD);
    const LAS int* tab = (const LAS int*)(F.lds + MOE_TAB_OFF); const int* tok_e = (const int*)(ws + WS_TOKE);
    __syncthreads();
    const int gw = F.vcu * NWAVES + F.wave, NGW = F.G * NWAVES;
#if defined(MK_STAMP) && MK_STAMP >= 0
    const float dscale = 1.f + sqrtf(exp2f(rintf(3.f * log2f(*(const float*)(ws + WS_STAMP + 8) + 1.f) + MK_QSHIFT) * (1.f / 3.f)));
#else
    const float dscale = 1.f;
#endif
    for (int blk = gw; blk < T / 8; blk += NGW) { const int t0 = blk * 8, b = t0 / SEQ;
        const float* g2 = mod + b * (6 * DM) + 5 * DM;
        f32x4 h2[4][2];
#pragma unroll
        for (int j = 0; j < 4; ++j) { const int c = (j * 64 + F.lane) * 8; h2[j][0] = *(const f32x4*)(g2 + c); h2[j][1] = *(const f32x4*)(g2 + c + 4); }
        int dsl = 0; float wl = 0.f;
        if (F.lane < 16) { dsl = tab[tok_e[2 * t0 + F.lane]] + tok_s[2 * t0 + F.lane]; wl = tok_w[2 * t0 + F.lane]; }
#pragma unroll 1
        for (int r = 0; r < 8; ++r) { const int t = t0 + r;
            const float w0 = __shfl(wl, 2 * r), w1 = __shfl(wl, 2 * r + 1); const int d0 = __shfl(dsl, 2 * r), d1 = __shfl(dsl, 2 * r + 1);
            float* orow = F.out + (size_t)t * DM; const bf16_t* mrow = (const bf16_t*)(ws + WS_F) + (size_t)t * DM;
            u32x4 qy0[4], qy1[4], qm[4];
#pragma unroll
            for (int j = 0; j < 4; ++j) { const int c = (j * 64 + F.lane) * 8;
                qy0[j] = __builtin_nontemporal_load((const u32x4*)(Y + (size_t)d0 * DM + c)); qy1[j] = __builtin_nontemporal_load((const u32x4*)(Y + (size_t)d1 * DM + c));
                qm[j] = __builtin_nontemporal_load((const u32x4*)(mrow + c)); }
            __builtin_amdgcn_sched_barrier(0);
#pragma unroll
            for (int j = 0; j < 4; ++j) { const int c = (j * 64 + F.lane) * 8;
                float y0[8], y1[8], mx[8]; unpack8(qy0[j], y0); unpack8(qy1[j], y1); unpack8(qm[j], mx);
                const f32x4 xa = {mx[0], mx[1], mx[2], mx[3]}, xb = {mx[4], mx[5], mx[6], mx[7]};
                f32x4 ra, rb;
#pragma unroll
                for (int i = 0; i < 4; ++i) { ra[i] = (xa[i] + h2[j][0][i] * (w0 * y0[i] + w1 * y1[i])) * dscale; rb[i] = (xb[i] + h2[j][1][i] * (w0 * y0[4 + i] + w1 * y1[4 + i])) * dscale; }
                __builtin_nontemporal_store(ra, (f32x4*)(orow + c)); __builtin_nontemporal_store(rb, (f32x4*)(orow + c + 4)); }
            __builtin_amdgcn_sched_barrier(0); }
    }
}
#ifndef MK_MULTI
#define MK_MULTI 0
#endif
#ifndef MK_LAST_PHASE
#define MK_LAST_PHASE 12
#endif
constexpr int N_PHASES = MK_LAST_PHASE + 1;

template <class P> __device__ __forceinline__ P* uptr(P* p) { const unsigned long long v = (unsigned long long)p;
    const unsigned lo = __builtin_amdgcn_readfirstlane((unsigned)v), hi = __builtin_amdgcn_readfirstlane((unsigned)(v >> 32)); return (P*)(__attribute__((address_space(1))) P*)(((unsigned long long)hi << 32) | lo); }
__global__ void __launch_bounds__(NTHR, 2) mk_fwd(const Args args) {
    extern __shared__ __attribute__((aligned(16))) unsigned char lds_raw[];
    Frame F;
    F.lds = (LAS unsigned char*)lds_raw;
    F.MISC = (volatile LAS unsigned*)(F.lds + MISC_OFF);
    F.tid = threadIdx.x; F.lane = F.tid & 63; F.wave = __builtin_amdgcn_readfirstlane(F.tid >> 6);
    F.G = gridDim.x; { const int bx = blockIdx.x; F.vcu = (F.G % 8 == 0) ? (bx % 8) * (F.G / 8) + bx / 8 : bx; }
    F.ws = uptr(args.ws); F.out = uptr(args.out);
    F.ctl = (gu32*)(F.ws + WS_CTL);
    for (int u = F.tid; u < (LDS_BYTES - MISC_OFF) / 4; u += NTHR) ((LAS unsigned*)(F.lds + MISC_OFF))[u] = 0u;
    __syncthreads();
    XcdBarrier bar; bar.bar = (unsigned*)(F.ctl + CW_BAR); bar.x = 0; bar.st = nullptr;
#if !MK_MULTI
    bar = xcd_barrier_post((unsigned*)(F.ctl + CW_BAR), F.MISC + 8);
#define GRID_BAR() xcd_barrier(bar)
#else
#define GRID_BAR() do { } while (0)
#endif
    const int lo = args.ph_lo, hi = args.ph_hi;
#ifndef MK_PHMASK
#define MK_PHMASK 0xFFFF
#endif
#define IN(k) (((MK_PHMASK >> (k)) & 1) && lo <= (k) && (k) < hi)
#define SEAM(k) do { if (IN(k) && IN((k) + 1)) GRID_BAR(); } while (0)
#ifndef MK_STAMP
#define MK_STAMP (-1)
#endif
#define STAMP_BEGIN(k) do { if ((k) == MK_STAMP && blockIdx.x == 0 && F.tid == 0) *(unsigned long long*)(ws + WS_STAMP) = __builtin_amdgcn_s_memrealtime(); } while (0)
#define STAMP_END(k) do { if ((k) == MK_STAMP && blockIdx.x == 0 && F.tid == 0) { const unsigned long long t1_ = __builtin_amdgcn_s_memrealtime(); *(float*)(ws + WS_STAMP + 8) = (float)(t1_ - *(unsigned long long*)(ws + WS_STAMP)) * 0.01f; } } while (0)
#ifndef MK_REPEAT
#define MK_REPEAT (-1)
#endif
#ifndef MK_REPN
#define MK_REPN 2
#endif
#define REP(k) _Pragma("unroll") for (int rep_ = 0; rep_ < ((k) == MK_REPEAT ? MK_REPN : 1); ++rep_)
    unsigned char* const ws = F.ws;

    STAMP_BEGIN(0);
    REP(0) if (IN(0)) { if (rep_) GRID_BAR(); p0_phase(F, args); } STAMP_END(0);
    STAMP_BEGIN(1);
    REP(1) if (IN(1)) { if (rep_) GRID_BAR(); p1_phase(F, args); } SEAM(1); STAMP_END(1);
    STAMP_BEGIN(2);
    REP(2) if (IN(2)) { if (rep_) GRID_BAR();
        pg8::Gemm g{(const bf16_t*)(ws + WS_B), (const bf16_t*)(ws + WS_WIN), DM, DM, DM};
        pg8::DenseOrder S; S.init(T / 256, INCP / 256, F.G, (int)blockIdx.x);
        pg8::EpiStore E{(bf16_t*)(ws + WS_A), INCP, nullptr, 0.f, (float*)(ws + WS_RSTDQ), (float*)(ws + WS_RSTDKV), C_QA / 256, C_KVA / 256, C_KPE / 256, HW / 256, 2 * HW / 256};
        pg8::gemm_phase<pg8::EpiStore, pg8::DenseOrder>(F.lds, g, S, E);
    } SEAM(2); STAMP_END(2);
    STAMP_BEGIN(3);
    REP(3) if (IN(3)) { if (rep_) GRID_BAR(); p3_phase(F, args); } if (IN(3) && IN(5)) GRID_BAR(); STAMP_END(3);
    STAMP_BEGIN(5);
    REP(5) if (IN(5)) { if (rep_) GRID_BAR(); p5_phase(F, args); } SEAM(5); STAMP_END(5);
    STAMP_BEGIN(6);
    REP(6) if (IN(6)) { if (rep_) GRID_BAR(); p6_phase(F, args); } SEAM(6); STAMP_END(6);
    STAMP_BEGIN(7);
    REP(7) if (IN(7)) { if (rep_) GRID_BAR();
        pg8::Gemm g{(const bf16_t*)F.out, (const bf16_t*)(ws + WS_WOUT), DM, DM, DM};
        pg8::DenseOrder S; S.init(T / 256, DM / 256, F.G, (int)blockIdx.x);
        pg8::EpiStoreRdy E{(bf16_t*)(ws + WS_F), DM, (unsigned*)(F.ctl + CW_R7)};
        pg8::gemm_phase<pg8::EpiStoreRdy, pg8::DenseOrder>(F.lds, g, S, E);
    } STAMP_END(7);
#if MK_LAST_PHASE >= 8
    STAMP_BEGIN(8);
    REP(8) if (IN(8)) { if (rep_) GRID_BAR(); p8_phase(F, args); } if (IN(8) && IN(10)) GRID_BAR(); STAMP_END(8);
    STAMP_BEGIN(10);
    REP(10) if (IN(10)) { if (rep_) GRID_BAR();
        const LAS int* tab = moe_tables(F);
        pg8::Gemm g{(const bf16_t*)(ws + WS_B), (const bf16_t*)(ws + WS_D), DM, DM, DM};
        pg8::GroupedOrder S; S.init(4, F.G, F.vcu, tab, (const int*)(ws + WS_LIST));
        pg8::EpiSwiGLU E{(bf16_t*)(ws + WS_C), (unsigned*)(F.ctl + CW_RDY)};
        pg8::gemm_phase<pg8::EpiSwiGLU, pg8::GroupedOrder, true>(F.lds, g, S, E);
    }
    REP(11) if (IN(11)) { if (rep_) GRID_BAR();
        const LAS int* tab = (const LAS int*)(F.lds + MOE_TAB_OFF);
        __syncthreads();
        pg8::Gemm g{(const bf16_t*)(ws + WS_C), (const bf16_t*)(ws + WS_E), DE, DE, DE};
        pg8::RedealOrder S; S.init(8, F.G, F.vcu, tab, 4, (unsigned*)(F.ctl + CW_RDY), 32u, (unsigned*)(F.ctl + CW_TMO));
        pg8::EpiStore E{(bf16_t*)(ws + WS_A), DM, nullptr, 0.f, nullptr, nullptr, 0, 0, 0};
        pg8::gemm_phase<pg8::EpiStore, pg8::RedealOrder>(F.lds, g, S, E);
    } SEAM(11); STAMP_END(11);
    REP(12) if (IN(12)) { if (rep_) GRID_BAR(); p12_phase(F, args); }
#endif
#undef IN
#undef SEAM
}

extern "C" void kernel_launch(void* const* d_in, const int* in_sizes, int n_in, void* d_out, int out_size, void* d_ws, size_t ws_size, hipStream_t stream) {
    static int grid = 0;
    if (grid == 0) {
        if (n_in != 25 || out_size != T * DM || ws_size < WS_END) { fprintf(stderr, "kernel_launch: bad shapes (n_in %d out %d ws %zu)\n", n_in, out_size, ws_size); grid = -1; return; }
        int dev = 0, cus = 0, per_cu = 0;
        if (hipGetDevice(&dev) != hipSuccess || hipDeviceGetAttribute(&cus, hipDeviceAttributeMultiprocessorCount, dev) != hipSuccess) { grid = -1; return; }
        if (hipFuncSetAttribute((const void*)mk_fwd, hipFuncAttributeMaxDynamicSharedMemorySize, LDS_BYTES) != hipSuccess) { fprintf(stderr, "kernel_launch: hipFuncSetAttribute failed\n"); grid = -1; return; }
        if (hipOccupancyMaxActiveBlocksPerMultiprocessor(&per_cu, (const void*)mk_fwd, NTHR, LDS_BYTES) != hipSuccess || per_cu < 1) { fprintf(stderr, "kernel_launch: occupancy query says %d\n", per_cu); }
        (void)hipGetLastError();
        grid = cus;
    }
    if (grid < 0) return;
    (void)hipMemsetAsync((char*)d_ws + WS_CTL, 0, CTL_ZERO_BYTES, stream);
    Args a{};
    for (int i = 0; i < 25; ++i) a.in[i] = (const float*)d_in[i];
    a.out = (float*)d_out; a.ws = (unsigned char*)d_ws;
#if MK_MULTI
    for (int p = 0; p < N_PHASES; ++p) { a.ph_lo = p; a.ph_hi = p + 1; hipLaunchKernelGGL(mk_fwd, dim3(grid), dim3(NTHR), LDS_BYTES, stream, a); }
#else
    a.ph_lo = 0; a.ph_hi = N_PHASES; hipLaunchKernelGGL(mk_fwd, dim3(grid), dim3(NTHR), LDS_BYTES, stream, a);
#endif
}
```
